# Optimizing an MI355X kernel written in HIP

```python
import jax, jax.numpy as jnp
from jax import lax
import numpy as np

D_MODEL = 1024
BATCH = 2
SEQ = 8192
DEPTH = 1

HEAD_DIM = 64
N_NSA_HEADS = 8
N_NSA_KV = 2
NSA_GROUP = N_NSA_HEADS // N_NSA_KV
N_FOX_HEADS = 8
D_NSA = N_NSA_HEADS * HEAD_DIM
D_FOX = N_FOX_HEADS * HEAD_DIM
D_MIX = D_NSA + D_FOX
D_KV = N_NSA_KV * HEAD_DIM
D_PROJ = D_NSA + 6 * D_KV + 3 * N_NSA_HEADS + 3 * D_FOX + N_FOX_HEADS
CMP_BLOCK = 32
CMP_STRIDE = 16
CMP_HIDDEN = 128
SEL_BLOCK = 64
SEL_TOPK = 16
WINDOW = 512
Q_BLOCK = 128
N_EXPERTS = 32
TOP_K = 4
D_FF = D_MODEL
SWIGLU_LIMIT = 7.0
SWIGLU_ALPHA = 1.702
PLE_DIM = 256
EPS = 1e-6
NEG = -1e30
FORCED_SCORE = 1e9

kernel_name = "hybrid_nsa_fox_moe_block"


def rmsnorm(x, g):
    xf = x.astype(jnp.float32)
    y = xf * lax.rsqrt(jnp.mean(xf * xf, axis=-1, keepdims=True) + EPS)
    return (y * g.astype(jnp.float32)).astype(x.dtype)


def masked_softmax(logits, mask):
    logits = jnp.where(mask, logits.astype(jnp.float32), NEG)
    m = jnp.max(logits, axis=-1, keepdims=True)
    e = jnp.exp(logits - m) * mask
    return e / jnp.maximum(jnp.sum(e, axis=-1, keepdims=True), 1e-30)


def alibi_slopes(n):
    return jnp.exp2(-8.0 * jnp.arange(1, n + 1, dtype=jnp.float32) / n)


def proj_split_points():
    sizes = [D_NSA, D_KV, D_KV, D_KV, D_KV, D_KV, D_KV, 3 * N_NSA_HEADS,
             D_FOX, D_FOX, D_FOX, N_FOX_HEADS]
    pts, acc = [], 0
    for s in sizes[:-1]:
        acc += s
        pts.append(acc)
    return pts


def compress(kv, w1, w2, pe):
    B, T, G, Dh = kv.shape
    nc = (T - CMP_BLOCK) // CMP_STRIDE + 1
    idx = jnp.arange(nc)[:, None] * CMP_STRIDE + jnp.arange(CMP_BLOCK)[None, :]
    blocks = kv[:, idx] + pe[None, None, :, None, :]
    blocks = jnp.swapaxes(blocks, 2, 3).reshape(B, nc, G, CMP_BLOCK * Dh)
    return jax.nn.gelu(blocks @ w1) @ w2


def nsa_attention(q, k_c, v_c, k_s, v_s, k_w, v_w, gate_logits, slopes):
    B, T, H, Dh = q.shape
    G = k_s.shape[2]
    R = H // G
    scale = Dh ** -0.5
    nc = k_c.shape[1]
    ns = T // SEL_BLOCK
    topk = min(SEL_TOPK, ns)
    cmp_start = jnp.arange(nc) * CMP_STRIDE
    cmp_end = cmp_start + CMP_BLOCK - 1
    sel_start = jnp.arange(ns) * SEL_BLOCK
    overlap = ((cmp_start[:, None] < sel_start[None, :] + SEL_BLOCK)
               & (cmp_end[:, None] >= sel_start[None, :])).astype(jnp.float32)
    ks_blocks = k_s.reshape(B, ns, SEL_BLOCK, G, Dh).transpose(0, 3, 1, 2, 4)
    vs_blocks = v_s.reshape(B, ns, SEL_BLOCK, G, Dh).transpose(0, 3, 1, 2, 4)
    pad = jnp.zeros((B, WINDOW, G, Dh), k_w.dtype)
    kw_pad = jnp.concatenate([pad, k_w], axis=1)
    vw_pad = jnp.concatenate([pad, v_w], axis=1)
    qg = q.reshape(B, T, G, R, Dh)
    gates = jax.nn.sigmoid(gate_logits.reshape(B, T, G, R, 3))
    sl = slopes.reshape(G, R)
    b_ix = jnp.arange(B)[:, None, None, None]
    g_ix = jnp.arange(G)[None, None, :, None]
    j_sel = jnp.arange(ns)
    l_sel = jnp.arange(SEL_BLOCK)

    def block(start):
        qb = lax.dynamic_slice_in_dim(qg, start, Q_BLOCK, 1)
        gb = lax.dynamic_slice_in_dim(gates, start, Q_BLOCK, 1)
        t = start + jnp.arange(Q_BLOCK)
        lc = jnp.einsum('bqgrd,bcgd->bqgrc', qb, k_c).astype(jnp.float32) * scale
        dist_c = (t[:, None] - cmp_end[None, :]).astype(jnp.float32)
        lc = lc - sl[None, None, :, :, None] * dist_c[None, :, None, None, :]
        mask_c = (cmp_end[None, :] <= t[:, None])[None, :, None, None, :]
        p_c = masked_softmax(lc, mask_c)
        o_c = jnp.einsum('bqgrc,bcgd->bqgrd', p_c.astype(v_c.dtype), v_c)
        imp = jnp.einsum('bqgrc,cn->bqgn', p_c, overlap)
        cur = t // SEL_BLOCK
        valid = j_sel[None, :] <= cur[:, None]
        forced = valid & ((j_sel[None, :] == 0) | (j_sel[None, :] == cur[:, None])
                          | (j_sel[None, :] == cur[:, None] - 1))
        score = jnp.where(forced[None, :, None, :], FORCED_SCORE,
                          jnp.where(valid[None, :, None, :], imp, -1.0))
        _, idx = lax.top_k(score, topk)
        ks = ks_blocks[b_ix, g_ix, idx]
        vs = vs_blocks[b_ix, g_ix, idx]
        ls = jnp.einsum('bqgrd,bqgkld->bqgrkl', qb, ks).astype(jnp.float32) * scale
        pos = idx[..., None] * SEL_BLOCK + l_sel
        dist_s = (t[None, :, None, None, None] - pos)[:, :, :, None]
        ls = ls - sl[None, None, :, :, None, None] * dist_s.astype(jnp.float32)
        mask_s = jnp.broadcast_to(dist_s >= 0, ls.shape)
        flat = (B, Q_BLOCK, G, R, topk * SEL_BLOCK)
        p_s = masked_softmax(ls.reshape(flat), mask_s.reshape(flat)).reshape(ls.shape)
        o_s = jnp.einsum('bqgrkl,bqgkld->bqgrd', p_s.astype(vs.dtype), vs)
        kw = lax.dynamic_slice_in_dim(kw_pad, start, Q_BLOCK + WINDOW, 1)
        vw = lax.dynamic_slice_in_dim(vw_pad, start, Q_BLOCK + WINDOW, 1)
        s = start - WINDOW + jnp.arange(Q_BLOCK + WINDOW)
        dist_w = t[:, None] - s[None, :]
        lw = jnp.einsum('bqgrd,bsgd->bqgrs', qb, kw).astype(jnp.float32) * scale
        lw = lw - sl[None, None, :, :, None] * dist_w.astype(jnp.float32)[None, :, None, None, :]
        mask_w = ((dist_w >= 0) & (dist_w < WINDOW) & (s[None, :] >= 0))[None, :, None, None, :]
        p_w = masked_softmax(lw, mask_w)
        o_w = jnp.einsum('bqgrs,bsgd->bqgrd', p_w.astype(vw.dtype), vw)
        o = gb[..., 0:1] * o_c + gb[..., 1:2] * o_s + gb[..., 2:3] * o_w
        return o.reshape(B, Q_BLOCK, H * Dh)

    starts = jnp.arange(T // Q_BLOCK) * Q_BLOCK
    out = lax.map(block, starts)
    return out.transpose(1, 0, 2, 3).reshape(B, T, H * Dh)


def fox_attention(q, k, v, f_logit):
    B, T, H, Dh = q.shape
    scale = Dh ** -0.5
    c = jnp.cumsum(jax.nn.log_sigmoid(f_logit.astype(jnp.float32)), axis=1).transpose(0, 2, 1)
    kpos = jnp.arange(T)

    def block(start):
        qb = lax.dynamic_slice_in_dim(q, start, Q_BLOCK, 1)
        cb = lax.dynamic_slice_in_dim(c, start, Q_BLOCK, 2)
        t = start + jnp.arange(Q_BLOCK)
        l = jnp.einsum('bqhd,bshd->bhqs', qb, k).astype(jnp.float32) * scale
        l = l + (cb[..., None] - c[:, :, None, :])
        mask = (kpos[None, :] <= t[:, None])[None, None]
        pr = masked_softmax(l, mask)
        o = jnp.einsum('bhqs,bshd->bqhd', pr.astype(v.dtype), v)
        return o.reshape(B, Q_BLOCK, H * Dh)

    starts = jnp.arange(T // Q_BLOCK) * Q_BLOCK
    out = lax.map(block, starts)
    return out.transpose(1, 0, 2, 3).reshape(B, T, H * Dh)


def moe(x, w_router, b_router, w_up, b_up, w_down, b_down):
    B, T, D = x.shape
    xf = x.reshape(-1, D)
    n = xf.shape[0]
    logits = (xf @ w_router + b_router).astype(jnp.float32)
    top_v, top_i = lax.top_k(logits, TOP_K)
    w = jax.nn.softmax(top_v, axis=-1)
    flat_e = top_i.reshape(-1)
    order = jnp.argsort(flat_e)
    sorted_e = flat_e[order]
    tok = order // TOP_K
    sizes = jnp.bincount(flat_e, length=N_EXPERTS).astype(jnp.int32)
    xs = xf[tok]
    h = lax.ragged_dot(xs, w_up, sizes) + b_up[sorted_e]
    g, lin = jnp.split(h, 2, axis=-1)
    g = jnp.minimum(g, SWIGLU_LIMIT)
    lin = jnp.clip(lin, -SWIGLU_LIMIT, SWIGLU_LIMIT)
    act = g * jax.nn.sigmoid(SWIGLU_ALPHA * g) * (lin + 1.0)
    y = lax.ragged_dot(act, w_down, sizes) + b_down[sorted_e]
    y = y * w.reshape(-1)[order][:, None].astype(y.dtype)
    return jax.ops.segment_sum(y, tok, num_segments=n).reshape(B, T, D)


def setup_inputs(seed: int = 0) -> dict:
    key = jax.random.key(seed)
    ks = jax.random.split(key, 32)
    L, D, E, F = DEPTH, D_MODEL, N_EXPERTS, D_FF
    nrm = lambda k, shape, fan: jax.random.normal(k, shape, jnp.float32) * (fan ** -0.5)
    gain = lambda k, shape: 1.0 + 0.02 * jax.random.normal(k, shape, jnp.float32)
    small = lambda k, shape, s: s * jax.random.normal(k, shape, jnp.float32)
    return {
        "x": jax.random.normal(ks[0], (BATCH, SEQ, D), jnp.float32),
        "p": jax.random.normal(ks[1], (L, BATCH, SEQ, PLE_DIM), jnp.float32),
        "ln1": gain(ks[2], (L, D)),
        "w_in": nrm(ks[3], (L, D, D_PROJ), D),
        "b_fg": jax.random.uniform(ks[4], (L, N_FOX_HEADS), jnp.float32, 1.0, 5.0),
        "w_cmp1_k": nrm(ks[5], (L, CMP_BLOCK * HEAD_DIM, CMP_HIDDEN), CMP_BLOCK * HEAD_DIM),
        "w_cmp2_k": nrm(ks[6], (L, CMP_HIDDEN, HEAD_DIM), CMP_HIDDEN),
        "pe_cmp_k": small(ks[7], (L, CMP_BLOCK, HEAD_DIM), 0.1),
        "w_cmp1_v": nrm(ks[8], (L, CMP_BLOCK * HEAD_DIM, CMP_HIDDEN), CMP_BLOCK * HEAD_DIM),
        "w_cmp2_v": nrm(ks[9], (L, CMP_HIDDEN, HEAD_DIM), CMP_HIDDEN),
        "pe_cmp_v": small(ks[10], (L, CMP_BLOCK, HEAD_DIM), 0.1),
        "gn_nsa": gain(ks[11], (L, D_NSA)),
        "gn_fox": gain(ks[12], (L, D_FOX)),
        "w_out": nrm(ks[13], (L, D_MIX, D), D_MIX),
        "ln2": gain(ks[14], (L, D)),
        "w_router": nrm(ks[15], (L, D, E), D),
        "b_router": small(ks[16], (L, E), 0.01),
        "w_up": nrm(ks[17], (L, E, D, 2 * F), D),
        "b_up": small(ks[18], (L, E, 2 * F), 0.01),
        "w_down": nrm(ks[19], (L, E, F, D), F),
        "b_down": small(ks[20], (L, E, D), 0.01),
        "ln_ple": gain(ks[21], (L, D)),
        "w_ple": nrm(ks[22], (L, PLE_DIM, D), PLE_DIM),
        "w_ple_gate": nrm(ks[23], (L, D, D), D),
        "ln_f": gain(ks[24], (D,)),
    }


def reference(x, p, ln1, w_in, b_fg, w_cmp1_k, w_cmp2_k, pe_cmp_k, w_cmp1_v, w_cmp2_v,
              pe_cmp_v, gn_nsa, gn_fox, w_out, ln2, w_router, b_router, w_up, b_up,
              w_down, b_down, ln_ple, w_ple, w_ple_gate, ln_f):
    B, T, _ = x.shape
    G, Dh = N_NSA_KV, HEAD_DIM
    slopes = alibi_slopes(N_NSA_HEADS)
    pts = proj_split_points()
    h = x
    for i in range(DEPTH):
        u = rmsnorm(h, ln1[i])
        proj = u @ w_in[i]
        (q_n, k_c, v_c, k_s, v_s, k_w, v_w, g_n,
         q_f, k_f, v_f, f_f) = jnp.split(proj, pts, axis=-1)
        kc = compress(k_c.reshape(B, T, G, Dh), w_cmp1_k[i], w_cmp2_k[i], pe_cmp_k[i])
        vc = compress(v_c.reshape(B, T, G, Dh), w_cmp1_v[i], w_cmp2_v[i], pe_cmp_v[i])
        o_nsa = nsa_attention(q_n.reshape(B, T, N_NSA_HEADS, Dh), kc, vc,
                              k_s.reshape(B, T, G, Dh), v_s.reshape(B, T, G, Dh),
                              k_w.reshape(B, T, G, Dh), v_w.reshape(B, T, G, Dh),
                              g_n.reshape(B, T, N_NSA_HEADS, 3), slopes)
        o_fox = fox_attention(q_f.reshape(B, T, N_FOX_HEADS, Dh),
                              k_f.reshape(B, T, N_FOX_HEADS, Dh),
                              v_f.reshape(B, T, N_FOX_HEADS, Dh),
                              f_f + b_fg[i])
        mix = jnp.concatenate([rmsnorm(o_nsa, gn_nsa[i]), rmsnorm(o_fox, gn_fox[i])], axis=-1)
        h = h + mix @ w_out[i]
        h = h + moe(rmsnorm(h, ln2[i]), w_router[i], b_router[i], w_up[i], b_up[i],
                    w_down[i], b_down[i])
        h = h + (p[i] @ w_ple[i]) * jax.nn.sigmoid(rmsnorm(h, ln_ple[i]) @ w_ple_gate[i])
    return rmsnorm(h, ln_f)
```

```cpp
#include <hip/hip_runtime.h>
#include <hip/hip_cooperative_groups.h>
#include <stdint.h>
#include <cstdio>

#define DEV __device__ __forceinline__
#define LAS __attribute__((address_space(3)))

typedef unsigned short bf16_t;
typedef short bf16x8 __attribute__((ext_vector_type(8)));
typedef short s16x4 __attribute__((ext_vector_type(4)));
typedef float f32x4 __attribute__((ext_vector_type(4)));
typedef float f32x2_t __attribute__((ext_vector_type(2)));
typedef __bf16 bf16x2_t __attribute__((ext_vector_type(2)));

#ifndef GEMM_EMU
#define GEMM_EMU 0
#endif

constexpr int T_ = 8192, NTOK = 16384;
constexpr float EPS = 1e-6f;
constexpr float LOG2E = 1.4426950408889634f;
constexpr float QS = 0.125f * LOG2E;
constexpr int NWIN = 2944;

constexpr size_t MiB = 1u << 20;
constexpr size_t WS_CTL = 0;
constexpr size_t WS_WIN = 1 * MiB;
constexpr size_t WS_WOUT = 7 * MiB;
constexpr size_t WS_WGATE = 9 * MiB;
constexpr size_t WS_WPLE = 11 * MiB;
constexpr size_t WS_WC1 = 12 * MiB;
constexpr size_t WS_WC2 = 13 * MiB;
constexpr size_t WS_BIAS1 = 13 * MiB + 65536;
constexpr size_t WS_KC = 14 * MiB;
constexpr size_t WS_HID = 15 * MiB;
constexpr size_t WS_GN = 16 * MiB;
constexpr size_t WS_LS = 18 * MiB;
constexpr size_t WS_CUM = 19 * MiB;
constexpr size_t WS_SSQ = 20 * MiB;
constexpr size_t WS_TOPI = 21 * MiB;
constexpr size_t WS_TOPS = 21 * MiB + 262144;
constexpr size_t WS_TOPW = 21 * MiB + 524288;
constexpr size_t WS_TOKOF = 22 * MiB;
constexpr size_t WS_ROWW = 24 * MiB;
constexpr size_t WS_SSQ3 = 26 * MiB;
constexpr size_t WS_PB = 28 * MiB;
constexpr size_t WS_XN = 36 * MiB;
constexpr size_t WS_PROJ = 68 * MiB;
constexpr size_t WS_ONSA = 160 * MiB;
constexpr size_t WS_OFOX = 176 * MiB;
constexpr size_t WS_H1 = 192 * MiB;
constexpr size_t WS_WUP = 256 * MiB;
constexpr size_t WS_WDN = 384 * MiB;
constexpr size_t WS_ACT = 448 * MiB;
constexpr size_t WS_Y = 584 * MiB;
constexpr size_t WS_END = 720 * MiB;

enum { PH_PRO = 0, PH_INPROJ, PH_CMP, PH_ATT, PH_OUTPROJ, PH_ROUTE, PH_UP, PH_DOWN, PH_COMB, PH_GATE, PH_FINAL, PH_N };

struct Args { const float* in[25]; float* out; unsigned char* ws; int ph_lo, ph_hi; };
enum { I_X = 0, I_P, I_LN1, I_WIN, I_BFG, I_WC1K, I_WC2K, I_PEK, I_WC1V, I_WC2V, I_PEV, I_GNN, I_GNF, I_WOUT, I_LN2, I_WR, I_BR,
       I_WUP, I_BUP, I_WDN, I_BDN, I_LNPLE, I_WPLE, I_WGATE, I_LNF };

DEV unsigned cvtpk(float lo, float hi) { f32x2_t v = {lo, hi}; bf16x2_t b = __builtin_convertvector(v, bf16x2_t); return __builtin_bit_cast(unsigned, b); }
DEV float bf2f(unsigned short b) { return __uint_as_float(((unsigned)b) << 16); }
DEV float bflo(unsigned u) { return __uint_as_float(u << 16); }
DEV float bfhi(unsigned u) { return __uint_as_float(u & 0xffff0000u); }
DEV void unpack8(const uint4& u, float* f) { f[0] = bflo(u.x); f[1] = bfhi(u.x); f[2] = bflo(u.y); f[3] = bfhi(u.y); f[4] = bflo(u.z); f[5] = bfhi(u.z); f[6] = bflo(u.w); f[7] = bfhi(u.w); }
DEV float wave_sum(float v) {
#pragma unroll
    for (int o = 1; o < 64; o <<= 1) v += __shfl_xor(v, o);
    return v;
}
DEV float sigmoidf_(float x) { return 1.0f / (1.0f + __expf(-x)); }
DEV float logsigmoidf_(float x) { return fminf(x, 0.f) - log1pf(__expf(-fabsf(x))); }
DEV float gelu_tanh(float x) { const float u = 0.7978845608028654f * (x + 0.044715f * x * x * x); const float th = 1.0f - 2.0f / (__expf(2.0f * u) + 1.0f); return 0.5f * x * (1.0f + th); }

constexpr int GA_BYTES = 128 * 128;
constexpr int GB_STRIDE = 288;
constexpr int GB_BYTES = 64 * GB_STRIDE;
constexpr int GSTAGE = GA_BYTES + GB_BYTES;
constexpr int GEMM_LDS = 2 * GSTAGE;
constexpr int MISC_OFF = GEMM_LDS;
constexpr int LDS_BYTES = GEMM_LDS + 4096;

DEV s16x4 tr_read(const unsigned char* p) {
    typedef short v4i16_t __attribute__((ext_vector_type(4)));
    return __builtin_bit_cast(s16x4, __builtin_amdgcn_ds_read_tr16_b64_v4i16((LAS v4i16_t*)p));
}

template <class AL, class BL>
DEV void gemm_mainloop(unsigned char* smem, int nkt, const AL& al, const BL& bl, f32x4 (&acc)[4][4]) {
    const int tid = threadIdx.x, lane = tid & 63, wid = tid >> 6, wr = wid >> 1, wc = wid & 1;
    uint4 ra[4], rb[4];
#pragma unroll
    for (int mi = 0; mi < 4; ++mi)
#pragma unroll
        for (int ni = 0; ni < 4; ++ni) acc[mi][ni] = (f32x4){0.f, 0.f, 0.f, 0.f};
#define G_LOAD(kt) do { _Pragma("unroll") for (int i_ = 0; i_ < 4; ++i_) { const int id_ = tid + 256 * i_; ra[i_] = al(id_ >> 3, id_ & 7, (kt)); } \
                        _Pragma("unroll") for (int i_ = 0; i_ < 4; ++i_) { const int id_ = tid + 256 * i_; rb[i_] = bl(id_ >> 4, id_ & 15, (kt)); } } while (0)
#define G_STORE(st) do { unsigned char* A_ = smem + (st) * GSTAGE; unsigned char* B_ = A_ + GA_BYTES; \
        _Pragma("unroll") for (int i_ = 0; i_ < 4; ++i_) { const int id_ = tid + 256 * i_; const int r_ = id_ >> 3, kc_ = id_ & 7; *(uint4*)(A_ + r_ * 128 + ((kc_ ^ (r_ & 7)) << 4)) = ra[i_]; } \
        _Pragma("unroll") for (int i_ = 0; i_ < 4; ++i_) { const int id_ = tid + 256 * i_; const int k_ = id_ >> 4, nc_ = id_ & 15; *(uint4*)(B_ + k_ * GB_STRIDE + nc_ * 16) = rb[i_]; } } while (0)
    G_LOAD(0); G_STORE(0); __syncthreads();
    for (int kt = 0; kt < nkt; ++kt) {
        const bool more = (kt + 1 < nkt);
        if (more) G_LOAD(kt + 1);
        const unsigned char* A = smem + (kt & 1) * GSTAGE; const unsigned char* Bt = A + GA_BYTES;
#if GEMM_EMU
        for (int k = 0; k < 64; ++k) {
            float av[4], bv[4][4];
#pragma unroll
            for (int mi = 0; mi < 4; ++mi) { const int m = wr * 64 + mi * 16 + (lane & 15); av[mi] = bf2f(*(const bf16_t*)(A + m * 128 + (((k >> 3) ^ (m & 7)) << 4) + (k & 7) * 2)); }
#pragma unroll
            for (int ni = 0; ni < 4; ++ni)
#pragma unroll
                for (int r = 0; r < 4; ++r) { const int n = wc * 64 + ni * 16 + 4 * (lane >> 4) + r; bv[ni][r] = bf2f(*(const bf16_t*)(Bt + k * GB_STRIDE + n * 2)); }
#pragma unroll
            for (int mi = 0; mi < 4; ++mi)
#pragma unroll
                for (int ni = 0; ni < 4; ++ni)
#pragma unroll
                    for (int r = 0; r < 4; ++r) acc[mi][ni][r] += av[mi] * bv[ni][r];
        }
#else
#pragma unroll
        for (int ks = 0; ks < 2; ++ks) {
            bf16x8 af[4], wf[4];
#pragma unroll
            for (int mi = 0; mi < 4; ++mi) { const int m = wr * 64 + mi * 16 + (lane & 15); const int kc = ks * 4 + (lane >> 4); af[mi] = *(const bf16x8*)(A + m * 128 + ((kc ^ (m & 7)) << 4)); }
#pragma unroll
            for (int ni = 0; ni < 4; ++ni) {
                const int i = lane & 15; const int row = ks * 32 + 8 * (lane >> 4) + (i >> 2); const int col = wc * 64 + ni * 16 + 4 * (i & 3);
                const unsigned char* p = Bt + row * GB_STRIDE + col * 2;
                const s16x4 lo = tr_read(p), hi = tr_read(p + 4 * GB_STRIDE);
                wf[ni] = (bf16x8){lo[0], lo[1], lo[2], lo[3], hi[0], hi[1], hi[2], hi[3]};
            }
#pragma unroll
            for (int mi = 0; mi < 4; ++mi)
#pragma unroll
                for (int ni = 0; ni < 4; ++ni) acc[mi][ni] = __builtin_amdgcn_mfma_f32_16x16x32_bf16(wf[ni], af[mi], acc[mi][ni], 0, 0, 0);
        }
#endif
        if (more) G_STORE((kt + 1) & 1);
        __syncthreads();
    }
#undef G_LOAD
#undef G_STORE
}

DEV void convert_chunk(const float* src, bf16_t* dst, size_t i8) {
    const float4 a = *(const float4*)(src + i8 * 8), b = *(const float4*)(src + i8 * 8 + 4);
    uint4 o; o.x = cvtpk(a.x, a.y); o.y = cvtpk(a.z, a.w); o.z = cvtpk(b.x, b.y); o.w = cvtpk(b.z, b.w);
    *(uint4*)(dst + i8 * 8) = o;
}
DEV void phase_prologue(const Args& a, unsigned char* smem) {
    unsigned char* ws = a.ws;
    const size_t gtid = (size_t)blockIdx.x * 256 + threadIdx.x, gn = (size_t)gridDim.x * 256;
    {
        const float* srcs[10] = {a.in[I_WUP], a.in[I_WDN], a.in[I_WOUT], a.in[I_WGATE], a.in[I_WPLE], a.in[I_WC1K], a.in[I_WC1V], a.in[I_WC2K], a.in[I_WC2V], a.in[I_P]};
        bf16_t* dsts[10] = {(bf16_t*)(ws + WS_WUP), (bf16_t*)(ws + WS_WDN), (bf16_t*)(ws + WS_WOUT), (bf16_t*)(ws + WS_WGATE), (bf16_t*)(ws + WS_WPLE),
                            (bf16_t*)(ws + WS_WC1), (bf16_t*)(ws + WS_WC1) + 2048 * 128, (bf16_t*)(ws + WS_WC2), (bf16_t*)(ws + WS_WC2) + 128 * 64, (bf16_t*)(ws + WS_PB)};
        const size_t cnt8[10] = {(size_t)32 * 1024 * 2048 / 8, (size_t)32 * 1024 * 1024 / 8, 1024 * 1024 / 8, 1024 * 1024 / 8, 256 * 1024 / 8, 2048 * 128 / 8, 2048 * 128 / 8, 128 * 64 / 8, 128 * 64 / 8, (size_t)NTOK * 256 / 8};
#pragma unroll
        for (int s = 0; s < 10; ++s) for (size_t i = gtid; i < cnt8[s]; i += gn) convert_chunk(srcs[s], dsts[s], i);
    }
    {
        const float* W = a.in[I_WIN]; bf16_t* O = (bf16_t*)(ws + WS_WIN);
        for (size_t i = gtid; i < (size_t)1024 * (NWIN / 8); i += gn) {
            const int k = (int)(i / (NWIN / 8)), j = (int)(i % (NWIN / 8)) * 8;
            uint4 o = {0u, 0u, 0u, 0u};
            if (j < 2848) {
                const int sj = (j < 1280) ? j : (j < 2816) ? j + 24 : (j < 2840) ? j - 1536 : j;
                const float4 x = *(const float4*)(W + (size_t)k * 2848 + sj), y = *(const float4*)(W + (size_t)k * 2848 + sj + 4);
                o.x = cvtpk(x.x, x.y); o.y = cvtpk(x.z, x.w); o.z = cvtpk(y.x, y.y); o.w = cvtpk(y.z, y.w);
            }
            *(uint4*)(O + (size_t)k * NWIN + j) = o;
        }
    }
    {
        const int lane = threadIdx.x & 63; const int gw = blockIdx.x * 4 + (threadIdx.x >> 6), ngw = gridDim.x * 4;
        const float* X = a.in[I_X]; const float* g = a.in[I_LN1]; bf16_t* XN = (bf16_t*)(ws + WS_XN);
        for (int m = gw; m < NTOK; m += ngw) {
            float4 v[4]; float s = 0.f;
#pragma unroll
            for (int j = 0; j < 4; ++j) { v[j] = *(const float4*)(X + (size_t)m * 1024 + j * 256 + lane * 4); s += v[j].x * v[j].x + v[j].y * v[j].y + v[j].z * v[j].z + v[j].w * v[j].w; }
            const float rstd = rsqrtf(wave_sum(s) * (1.f / 1024.f) + EPS);
#pragma unroll
            for (int j = 0; j < 4; ++j) { const float4 gg = *(const float4*)(g + j * 256 + lane * 4);
                uint2 o; o.x = cvtpk(v[j].x * rstd * gg.x, v[j].y * rstd * gg.y); o.y = cvtpk(v[j].z * rstd * gg.z, v[j].w * rstd * gg.w);
                *(uint2*)(XN + (size_t)m * 1024 + j * 256 + lane * 4) = o; }
        }
    }
    if (blockIdx.x < 2) {
        const int which = blockIdx.x; const float* pe = a.in[which ? I_PEV : I_PEK]; const float* w1 = a.in[which ? I_WC1V : I_WC1K];
        float* red = (float*)smem; const int n = threadIdx.x & 127, half = threadIdx.x >> 7;
        float s = 0.f;
        for (int k = half * 1024; k < half * 1024 + 1024; ++k) s += pe[k] * w1[(size_t)k * 128 + n];
        red[threadIdx.x] = s; __syncthreads();
        if (threadIdx.x < 128) ((float*)(ws + WS_BIAS1))[which * 128 + n] = red[n] + red[n + 128];
        __syncthreads();
    }
}

DEV void phase_inproj(const Args& a, unsigned char* smem) {
    const bf16_t* XN = (const bf16_t*)(a.ws + WS_XN); const bf16_t* W = (const bf16_t*)(a.ws + WS_WIN);
    bf16_t* PROJ = (bf16_t*)(a.ws + WS_PROJ); float* GN = (float*)(a.ws + WS_GN); float* LS = (float*)(a.ws + WS_LS); const float* bfg = a.in[I_BFG];
    const int lane = threadIdx.x & 63, wid = threadIdx.x >> 6, wr = wid >> 1, wc = wid & 1;
    for (int item = blockIdx.x; item < 128 * 23; item += gridDim.x) {
        const int nt = item / 128, mt = item % 128;
        f32x4 acc[4][4];
        gemm_mainloop(smem, 16,
            [&](int r, int kc, int kt) { return *(const uint4*)(XN + (size_t)(mt * 128 + r) * 1024 + kt * 64 + kc * 8); },
            [&](int k, int nc, int kt) { return *(const uint4*)(W + (size_t)(kt * 64 + k) * NWIN + nt * 128 + nc * 8); }, acc);
#pragma unroll
        for (int mi = 0; mi < 4; ++mi) {
            const int gm = mt * 128 + wr * 64 + mi * 16 + (lane & 15); const int b = gm >> 13, t = gm & 8191;
#pragma unroll
            for (int ni = 0; ni < 4; ++ni) {
                const int n = wc * 64 + ni * 16 + 4 * (lane >> 4); const f32x4 v = acc[mi][ni];
                if (nt < 22) {
                    const int hs = nt * 2 + (n >> 6), d = n & 63; const float sc = (hs < 8 || (hs >= 20 && hs < 28)) ? QS : 1.0f;
                    uint2 o; o.x = cvtpk(v[0] * sc, v[1] * sc); o.y = cvtpk(v[2] * sc, v[3] * sc);
                    *(uint2*)(PROJ + (((size_t)(hs * 2 + b)) * 8192 + t) * 64 + d) = o;
                } else if (n < 24) {
#pragma unroll
                    for (int r = 0; r < 4; ++r) GN[(size_t)gm * 24 + n + r] = sigmoidf_(v[r]);
                } else if (n < 32) {
#pragma unroll
                    for (int r = 0; r < 4; ++r) { const int h = n - 24 + r; LS[((size_t)(b * 8 + h)) * 8192 + t] = logsigmoidf_(v[r] + bfg[h]); }
                }
            }
        }
    }
}

DEV void phase_cmp(const Args& a, unsigned char* smem) {
    const bf16_t* PROJ = (const bf16_t*)(a.ws + WS_PROJ);
    const int tid = threadIdx.x, lane = tid & 63, wid = tid >> 6, wr = wid >> 1, wc = wid & 1;
    for (int item = blockIdx.x; item < 32 + 16; item += gridDim.x) {
        if (item < 32) {
            const int which = item >> 4, b = (item >> 3) & 1, g = (item >> 2) & 1, mt = item & 3;
            const bf16_t* base = PROJ + ((size_t)((8 + 2 * which + g) * 2 + b)) * 8192 * 64;
            const bf16_t* W1 = (const bf16_t*)(a.ws + WS_WC1) + (size_t)which * 2048 * 128;
            const bf16_t* W2 = (const bf16_t*)(a.ws + WS_WC2) + (size_t)which * 128 * 64;
            const float* bias1 = (const float*)(a.ws + WS_BIAS1) + which * 128;
            bf16_t* HID = (bf16_t*)(a.ws + WS_HID) + ((size_t)(which * 4 + b * 2 + g)) * 512 * 128;
            bf16_t* OUT = (bf16_t*)(a.ws + WS_KC) + ((size_t)(which * 4 + b * 2 + g)) * 512 * 64;
            f32x4 acc[4][4];
            gemm_mainloop(smem, 32,
                [&](int r, int kc, int kt) { int c = mt * 128 + r; c = c > 510 ? 510 : c; return *(const uint4*)(base + (size_t)c * 1024 + kt * 64 + kc * 8); },
                [&](int k, int nc, int kt) { return *(const uint4*)(W1 + (size_t)(kt * 64 + k) * 128 + nc * 8); }, acc);
#pragma unroll
            for (int mi = 0; mi < 4; ++mi) { const int c = mt * 128 + wr * 64 + mi * 16 + (lane & 15);
#pragma unroll
                for (int ni = 0; ni < 4; ++ni) { const int n = wc * 64 + ni * 16 + 4 * (lane >> 4); const f32x4 v = acc[mi][ni]; const float4 bb = *(const float4*)(bias1 + n);
                    uint2 o; o.x = cvtpk(gelu_tanh(v[0] + bb.x), gelu_tanh(v[1] + bb.y)); o.y = cvtpk(gelu_tanh(v[2] + bb.z), gelu_tanh(v[3] + bb.w));
                    *(uint2*)(HID + (size_t)c * 128 + n) = o; } }
            __syncthreads();
            gemm_mainloop(smem, 2,
                [&](int r, int kc, int kt) { return *(const uint4*)(HID + (size_t)(mt * 128 + r) * 128 + kt * 64 + kc * 8); },
                [&](int k, int nc, int kt) { uint4 z = {0u, 0u, 0u, 0u}; if (nc < 8) z = *(const uint4*)(W2 + (size_t)(kt * 64 + k) * 64 + nc * 8); return z; }, acc);
            if (wc == 0) {
#pragma unroll
                for (int mi = 0; mi < 4; ++mi) { const int c = mt * 128 + wr * 64 + mi * 16 + (lane & 15);
#pragma unroll
                    for (int ni = 0; ni < 4; ++ni) { const int n = ni * 16 + 4 * (lane >> 4); const f32x4 v = acc[mi][ni];
                        uint2 o; o.x = cvtpk(v[0], v[1]); o.y = cvtpk(v[2], v[3]);
                        if (c >= 511) { o.x = 0u; o.y = 0u; }
                        *(uint2*)(OUT + (size_t)c * 64 + n) = o; } }
            }
            __syncthreads();
        } else {
            const int bh = item - 32; const float* LS = (const float*)(a.ws + WS_LS) + (size_t)bh * 8192; float* CUM = (float*)(a.ws + WS_CUM) + (size_t)bh * 8192;
            float* sc = (float*)smem;
            float v[32]; float s = 0.f;
#pragma unroll
            for (int j = 0; j < 8; ++j) { const float4 x = *(const float4*)(LS + tid * 32 + j * 4); v[4 * j] = x.x; v[4 * j + 1] = x.y; v[4 * j + 2] = x.z; v[4 * j + 3] = x.w; }
#pragma unroll
            for (int j = 0; j < 32; ++j) { s += v[j]; v[j] = s; }
            sc[tid] = s; __syncthreads();
            if (tid == 0) { float run = 0.f; for (int i = 0; i < 256; ++i) { const float x = sc[i]; sc[i] = run; run += x; } }
            __syncthreads();
            const float off = sc[tid];
#pragma unroll
            for (int j = 0; j < 8; ++j) { float4 o = {v[4 * j] + off, v[4 * j + 1] + off, v[4 * j + 2] + off, v[4 * j + 3] + off}; *(float4*)(CUM + tid * 32 + j * 4) = o; }
            __syncthreads();
        }
    }
}

DEV void load_row64(const bf16_t* p, float* f) {
#pragma unroll
    for (int c = 0; c < 8; ++c) { const uint4 u = *(const uint4*)(p + c * 8); unpack8(u, f + c * 8); }
}
DEV float dot64(const float* q, const bf16_t* kp) {
    float s = 0.f;
#pragma unroll
    for (int c = 0; c < 8; ++c) { const uint4 u = *(const uint4*)(kp + c * 8); float f[8]; unpack8(u, f);
#pragma unroll
        for (int j = 0; j < 8; ++j) s += q[c * 8 + j] * f[j]; }
    return s;
}
DEV void axpy64(float* o, float p, const bf16_t* vp) {
#pragma unroll
    for (int c = 0; c < 8; ++c) { const uint4 u = *(const uint4*)(vp + c * 8); float f[8]; unpack8(u, f);
#pragma unroll
        for (int j = 0; j < 8; ++j) o[c * 8 + j] += p * f[j]; }
}
DEV void scale64(float* o, float s) {
#pragma unroll
    for (int j = 0; j < 64; ++j) o[j] *= s;
}
#define ONLINE_STEP(valid, s, vp) do { if (valid) { const float mn_ = fmaxf(m, (s)); const float al_ = exp2f(m - mn_); const float p_ = exp2f((s) - mn_); l = l * al_ + p_; scale64(o, al_); axpy64(o, p_, (vp)); m = mn_; } } while (0)

DEV void nsa_naive_item(const Args& a, unsigned char* smem, int item) {
    const int tid = threadIdx.x, lane = tid & 63, wid = tid >> 6;
    const int b = item / 256, g = (item / 128) & 1, tt = item & 127;
    const int tl = lane >> 2, r = lane & 3, h = g * 4 + r;
    const int t = tt * 64 + wid * 16 + tl; const int token = b * 8192 + t;
    const float slope2 = exp2f(-(float)(h + 1)) * LOG2E;
    float* imp = (float*)smem + wid * (16 * 129) + tl * 129;
    int* seli = (int*)(smem + 4 * 16 * 129 * 4) + wid * 256 + tl * 16;
    const bf16_t* PROJ = (const bf16_t*)(a.ws + WS_PROJ);
    const float* GN = (const float*)(a.ws + WS_GN) + (size_t)token * 24 + h * 3;
    float* TMP = (float*)(a.ws + WS_ACT) + ((size_t)token * 8 + h) * 64;
    float q[64]; load_row64(PROJ + (((size_t)(h * 2 + b)) * 8192 + t) * 64, q);
    float o[64];
    const bf16_t* KC = (const bf16_t*)(a.ws + WS_KC) + ((size_t)(0 * 4 + b * 2 + g)) * 512 * 64;
    const bf16_t* VC = (const bf16_t*)(a.ws + WS_KC) + ((size_t)(1 * 4 + b * 2 + g)) * 512 * 64;
    const int cl = (t >= 31) ? (t - 31) / 16 : -1;
    const int tmaxw = tt * 64 + wid * 16 + 15; const int cmax = (tmaxw - 31) >= 0 ? (tmaxw - 31) / 16 : -1;
    for (int n = r; n < 129; n += 4) imp[n] = 0.f;
    float m = -1e30f, l = 0.f;
    for (int c = 0; c <= cmax; ++c) {
        const float s = dot64(q, KC + (size_t)c * 64) + slope2 * (float)(16 * c + 31 - t);
        if (c <= cl) { const float mn = fmaxf(m, s); l = l * exp2f(m - mn) + exp2f(s - mn); m = mn; }
    }
#pragma unroll
    for (int j = 0; j < 64; ++j) o[j] = 0.f;
    const float linv = 1.0f / fmaxf(l, 1e-30f);
    for (int c = 0; c <= cmax; ++c) {
        const float s = dot64(q, KC + (size_t)c * 64) + slope2 * (float)(16 * c + 31 - t);
        const float p = (c <= cl) ? exp2f(s - m) * linv : 0.f;
        axpy64(o, p, VC + (size_t)c * 64);
        float ps = p; ps += __shfl_xor(ps, 1); ps += __shfl_xor(ps, 2);
        if (r == 0) { imp[c >> 2] += ps; if ((c & 3) == 3) imp[(c >> 2) + 1] += ps; }
    }
    {
        const float g0 = GN[0];
#pragma unroll
        for (int j = 0; j < 64; ++j) TMP[j] = g0 * o[j];
    }
    const int cur = t >> 6;
    {
        unsigned long long tlo = 0ull, thi = 0ull;
        for (int kk = 0; kk < 16; ++kk) {
            float best = -2.0f; int bi = 0;
            for (int n = 0; n < 128; ++n) {
                const bool taken = (n < 64) ? ((tlo >> n) & 1ull) : ((thi >> (n - 64)) & 1ull);
                if (taken) continue;
                const bool valid = n <= cur; const bool forced = valid && (n == 0 || n == cur || n == cur - 1);
                const float sc = forced ? 1e9f : (valid ? imp[n] : -1.0f);
                if (sc > best) { best = sc; bi = n; }
            }
            if (bi < 64) tlo |= 1ull << bi; else thi |= 1ull << (bi - 64);
            if (r == 0) seli[kk] = bi;
        }
    }
    {
        const bf16_t* KS = PROJ + ((size_t)((12 + g) * 2 + b)) * 8192 * 64; const bf16_t* VS = PROJ + ((size_t)((14 + g) * 2 + b)) * 8192 * 64;
        m = -1e30f; l = 0.f;
#pragma unroll
        for (int j = 0; j < 64; ++j) o[j] = 0.f;
        for (int kk = 0; kk < 16; ++kk) {
            const int n = seli[kk];
            for (int j = 0; j < 64; ++j) {
                const int pos = n * 64 + j; const bool valid = pos <= t;
                const int pc = valid ? pos : t;
                const float s = dot64(q, KS + (size_t)pc * 64) + slope2 * (float)(pos - t);
                ONLINE_STEP(valid, s, VS + (size_t)pc * 64);
            }
        }
        const float g1 = GN[1] / fmaxf(l, 1e-30f);
#pragma unroll
        for (int j = 0; j < 64; ++j) TMP[j] += g1 * o[j];
    }
    {
        const bf16_t* KW = PROJ + ((size_t)((16 + g) * 2 + b)) * 8192 * 64; const bf16_t* VW = PROJ + ((size_t)((18 + g) * 2 + b)) * 8192 * 64;
        m = -1e30f; l = 0.f;
#pragma unroll
        for (int j = 0; j < 64; ++j) o[j] = 0.f;
        for (int j = 0; j < 512; ++j) {
            const int pos = t - 511 + j; const bool valid = pos >= 0; const int pc = valid ? pos : 0;
            const float s = dot64(q, KW + (size_t)pc * 64) + slope2 * (float)(pos - t);
            ONLINE_STEP(valid, s, VW + (size_t)pc * 64);
        }
        const float g2 = GN[2] / fmaxf(l, 1e-30f);
        float ss = 0.f;
        bf16_t* O = (bf16_t*)(a.ws + WS_ONSA) + (size_t)token * 512 + h * 64;
#pragma unroll
        for (int j = 0; j < 64; j += 2) { const float v0 = TMP[j] + g2 * o[j], v1 = TMP[j + 1] + g2 * o[j + 1]; ss += v0 * v0 + v1 * v1; *(unsigned*)(O + j) = cvtpk(v0, v1); }
        ((float*)(a.ws + WS_SSQ))[(size_t)token * 16 + h] = ss;
    }
}
DEV void fox_naive_item(const Args& a, int item) {
    const int tid = threadIdx.x;
    const int b = item / 256, h = (item / 32) & 7, tile = item & 31;
    const int t = tile * 256 + tid; const int token = b * 8192 + t;
    const bf16_t* PROJ = (const bf16_t*)(a.ws + WS_PROJ);
    const bf16_t* K = PROJ + ((size_t)((28 + h) * 2 + b)) * 8192 * 64; const bf16_t* V = PROJ + ((size_t)((36 + h) * 2 + b)) * 8192 * 64;
    const float* CUM = (const float*)(a.ws + WS_CUM) + (size_t)(b * 8 + h) * 8192;
    float q[64]; load_row64(PROJ + (((size_t)((20 + h) * 2 + b)) * 8192 + t) * 64, q);
    float o[64];
#pragma unroll
    for (int j = 0; j < 64; ++j) o[j] = 0.f;
    float m = -1e30f, l = 0.f; const float ct = CUM[t];
    const int smax = tile * 256 + (tid | 63);
    for (int s_ = 0; s_ <= smax; ++s_) {
        const bool valid = s_ <= t;
        const float s = dot64(q, K + (size_t)s_ * 64) + (ct - CUM[s_]) * LOG2E;
        ONLINE_STEP(valid, s, V + (size_t)s_ * 64);
    }
    const float li = 1.0f / fmaxf(l, 1e-30f); float ss = 0.f;
    bf16_t* O = (bf16_t*)(a.ws + WS_OFOX) + (size_t)token * 512 + h * 64;
#pragma unroll
    for (int j = 0; j < 64; j += 2) { const float v0 = o[j] * li, v1 = o[j + 1] * li; ss += v0 * v0 + v1 * v1; *(unsigned*)(O + j) = cvtpk(v0, v1); }
    ((float*)(a.ws + WS_SSQ))[(size_t)token * 16 + 8 + h] = ss;
}
DEV void phase_att(const Args& a, unsigned char* smem) {
    for (int item = blockIdx.x; item < 512 + 512; item += gridDim.x) {
        if (item < 512) fox_naive_item(a, 511 - item);
        else { nsa_naive_item(a, smem, item - 512); __syncthreads(); }
    }
}

DEV void phase_outproj(const Args& a, unsigned char* smem) {
    const bf16_t* ONSA = (const bf16_t*)(a.ws + WS_ONSA); const bf16_t* OFOX = (const bf16_t*)(a.ws + WS_OFOX); const float* SSQ = (const float*)(a.ws + WS_SSQ);
    const bf16_t* W = (const bf16_t*)(a.ws + WS_WOUT); float* H1 = (float*)(a.ws + WS_H1); const float* X = a.in[I_X];
    const float* gnn = a.in[I_GNN]; const float* gnf = a.in[I_GNF];
    float* rs = (float*)(smem + MISC_OFF);
    const int tid = threadIdx.x, lane = tid & 63, wid = tid >> 6, wr = wid >> 1, wc = wid & 1;
    for (int item = blockIdx.x; item < 128 * 8; item += gridDim.x) {
        const int nt = item / 128, mt = item % 128;
        if (tid < 128) { const float* s = SSQ + (size_t)(mt * 128 + tid) * 16; float sn = 0.f, sf = 0.f;
#pragma unroll
            for (int j = 0; j < 8; ++j) { sn += s[j]; sf += s[8 + j]; }
            rs[tid * 2] = rsqrtf(sn * (1.f / 512.f) + EPS); rs[tid * 2 + 1] = rsqrtf(sf * (1.f / 512.f) + EPS); }
        __syncthreads();
        f32x4 acc[4][4];
        gemm_mainloop(smem, 16,
            [&](int r, int kc, int kt) { const int k0 = kt * 64 + kc * 8; const bool nsa = k0 < 512; const int kk = nsa ? k0 : k0 - 512;
                const uint4 u = *(const uint4*)((nsa ? ONSA : OFOX) + (size_t)(mt * 128 + r) * 512 + kk);
                const float* gp = (nsa ? gnn : gnf) + kk; const float4 g0 = *(const float4*)gp, g1 = *(const float4*)(gp + 4);
                const float sc = rs[r * 2 + (nsa ? 0 : 1)]; float f[8]; unpack8(u, f);
                uint4 o; o.x = cvtpk(f[0] * sc * g0.x, f[1] * sc * g0.y); o.y = cvtpk(f[2] * sc * g0.z, f[3] * sc * g0.w); o.z = cvtpk(f[4] * sc * g1.x, f[5] * sc * g1.y); o.w = cvtpk(f[6] * sc * g1.z, f[7] * sc * g1.w);
                return o; },
            [&](int k, int nc, int kt) { return *(const uint4*)(W + (size_t)(kt * 64 + k) * 1024 + nt * 128 + nc * 8); }, acc);
#pragma unroll
        for (int mi = 0; mi < 4; ++mi) { const size_t gm = mt * 128 + wr * 64 + mi * 16 + (lane & 15);
#pragma unroll
            for (int ni = 0; ni < 4; ++ni) { const int n = nt * 128 + wc * 64 + ni * 16 + 4 * (lane >> 4); const float4 x = *(const float4*)(X + gm * 1024 + n); const f32x4 v = acc[mi][ni];
                float4 o = {x.x + v[0], x.y + v[1], x.z + v[2], x.w + v[3]}; *(float4*)(H1 + gm * 1024 + n) = o; } }
        __syncthreads();
    }
}

DEV void phase_route(const Args& a, unsigned char* smem) {
    const float* H1 = (const float*)(a.ws + WS_H1); bf16_t* XN = (bf16_t*)(a.ws + WS_XN);
    const float* ln2 = a.in[I_LN2]; const float* wr_ = a.in[I_WR]; const float* br = a.in[I_BR];
    int* CNT = (int*)(a.ws + WS_CTL);
    int* TOPI = (int*)(a.ws + WS_TOPI); int* TOPS = (int*)(a.ws + WS_TOPS); float* TOPW = (float*)(a.ws + WS_TOPW);
    int* TOKOF = (int*)(a.ws + WS_TOKOF); float* ROWW = (float*)(a.ws + WS_ROWW);
    int* lcnt = (int*)smem; int* lbase = lcnt + 32; int* te = lbase + 32; int* trk = te + 256; float* tw = (float*)(trk + 256);
    const int tid = threadIdx.x, lane = tid & 63, wid = tid >> 6;
    for (int item = blockIdx.x; item < 256; item += gridDim.x) {
        if (tid < 32) lcnt[tid] = 0;
        __syncthreads();
        for (int i = 0; i < 16; ++i) {
            const int tok = item * 64 + wid * 16 + i;
            float xv[16]; float s = 0.f;
#pragma unroll
            for (int j = 0; j < 4; ++j) { const float4 v = *(const float4*)(H1 + (size_t)tok * 1024 + j * 256 + lane * 4); xv[4 * j] = v.x; xv[4 * j + 1] = v.y; xv[4 * j + 2] = v.z; xv[4 * j + 3] = v.w; s += v.x * v.x + v.y * v.y + v.z * v.z + v.w * v.w; }
            const float rstd = rsqrtf(wave_sum(s) * (1.f / 1024.f) + EPS);
#pragma unroll
            for (int j = 0; j < 4; ++j) { const float4 gg = *(const float4*)(ln2 + j * 256 + lane * 4);
                xv[4 * j] *= rstd * gg.x; xv[4 * j + 1] *= rstd * gg.y; xv[4 * j + 2] *= rstd * gg.z; xv[4 * j + 3] *= rstd * gg.w;
                uint2 o; o.x = cvtpk(xv[4 * j], xv[4 * j + 1]); o.y = cvtpk(xv[4 * j + 2], xv[4 * j + 3]); *(uint2*)(XN + (size_t)tok * 1024 + j * 256 + lane * 4) = o; }
            float lg[32];
#pragma unroll
            for (int e = 0; e < 32; ++e) lg[e] = 0.f;
#pragma unroll
            for (int j = 0; j < 4; ++j)
#pragma unroll
                for (int c = 0; c < 4; ++c) { const float* wrow = wr_ + (size_t)(j * 256 + lane * 4 + c) * 32; const float x = xv[4 * j + c];
#pragma unroll
                    for (int e4 = 0; e4 < 8; ++e4) { const float4 w = *(const float4*)(wrow + e4 * 4); lg[e4 * 4] += x * w.x; lg[e4 * 4 + 1] += x * w.y; lg[e4 * 4 + 2] += x * w.z; lg[e4 * 4 + 3] += x * w.w; } }
#pragma unroll
            for (int e = 0; e < 32; ++e) lg[e] = wave_sum(lg[e]) + br[e];
            unsigned taken = 0u; float tv[4]; int ti[4];
#pragma unroll
            for (int k = 0; k < 4; ++k) { float best = -3.0e38f; int bi = 0;
#pragma unroll
                for (int e = 0; e < 32; ++e) { const bool ok = !((taken >> e) & 1u) && lg[e] > best; best = ok ? lg[e] : best; bi = ok ? e : bi; }
                taken |= 1u << bi; tv[k] = best; ti[k] = bi; }
            const float e1 = __expf(tv[1] - tv[0]), e2 = __expf(tv[2] - tv[0]), e3 = __expf(tv[3] - tv[0]); const float inv = 1.0f / (1.0f + e1 + e2 + e3);
            const float wv[4] = {inv, e1 * inv, e2 * inv, e3 * inv};
            if (lane == 0) {
#pragma unroll
                for (int k = 0; k < 4; ++k) { const int idx = (wid * 16 + i) * 4 + k; te[idx] = ti[k]; trk[idx] = atomicAdd(&lcnt[ti[k]], 1); tw[idx] = wv[k]; }
            }
        }
        __syncthreads();
        if (tid < 32) lbase[tid] = atomicAdd(&CNT[tid], lcnt[tid]);
        __syncthreads();
        { const int idx = tid; const int tok = item * 64 + (idx >> 2); const int e = te[idx]; const int slot = lbase[e] + trk[idx];
          TOPI[(size_t)tok * 4 + (idx & 3)] = e; TOPS[(size_t)tok * 4 + (idx & 3)] = slot; TOPW[(size_t)tok * 4 + (idx & 3)] = tw[idx];
          TOKOF[(size_t)e * 16384 + slot] = tok; ROWW[(size_t)e * 16384 + slot] = tw[idx]; }
        __syncthreads();
    }
}

struct MoeMap { int e, mt, nt, cnt, off; };
DEV void moe_setup(const Args& a, int* sm) {
    if (threadIdx.x == 0) { const int* CNT = (const int*)(a.ws + WS_CTL); int tot = 0; for (int e = 0; e < 32; ++e) { const int c = CNT[e]; const int mt = (c + 127) >> 7; sm[e] = mt; sm[32 + e] = tot; tot += mt; } sm[64] = tot; }
    __syncthreads();
}
DEV MoeMap moe_map(const Args& a, const int* sm, int item, int NT) {
    MoeMap mm; int e = 0;
    for (int i = 1; i < 32; ++i) if (item >= sm[32 + i] * NT) e = i;
    const int local = item - sm[32 + e] * NT; const int mte = sm[e];
    mm.e = e; mm.nt = local / mte; mm.mt = local % mte; mm.cnt = ((const int*)(a.ws + WS_CTL))[e]; mm.off = sm[32 + e] * 128; return mm;
}
DEV void phase_up(const Args& a, unsigned char* smem) {
    int* sm = (int*)(smem + MISC_OFF); int* tok = sm + 128;
    const bf16_t* XN = (const bf16_t*)(a.ws + WS_XN); const bf16_t* W = (const bf16_t*)(a.ws + WS_WUP); bf16_t* ACT = (bf16_t*)(a.ws + WS_ACT);
    const int* TOKOF = (const int*)(a.ws + WS_TOKOF); const float* bup = a.in[I_BUP];
    const int tid = threadIdx.x, lane = tid & 63, wid = tid >> 6, wr = wid >> 1, wc = wid & 1;
    moe_setup(a, sm);
    const int nitems = sm[64] * 16;
    for (int item = blockIdx.x; item < nitems; item += gridDim.x) {
        const MoeMap mm = moe_map(a, sm, item, 16);
        if (tid < 128) { const int slot = mm.mt * 128 + tid; tok[tid] = slot < mm.cnt ? TOKOF[(size_t)mm.e * 16384 + slot] : 0; }
        __syncthreads();
        const bf16_t* We = W + (size_t)mm.e * 1024 * 2048;
        f32x4 acc[4][4];
        gemm_mainloop(smem, 16,
            [&](int r, int kc, int kt) { return *(const uint4*)(XN + (size_t)tok[r] * 1024 + kt * 64 + kc * 8); },
            [&](int k, int nc, int kt) { const int ni = (nc >> 1) & 3; const int sc = ((ni >> 1) ? 1024 : 0) + mm.nt * 64 + (nc >> 3) * 32 + (ni & 1) * 16 + (nc & 1) * 8;
                return *(const uint4*)(We + (size_t)(kt * 64 + k) * 2048 + sc); }, acc);
#pragma unroll
        for (int mi = 0; mi < 4; ++mi) { const size_t row = (size_t)mm.off + mm.mt * 128 + wr * 64 + mi * 16 + (lane & 15);
#pragma unroll
            for (int ni = 0; ni < 2; ++ni) { const int jc = mm.nt * 64 + wc * 32 + ni * 16 + 4 * (lane >> 4);
                const float4 bg = *(const float4*)(bup + (size_t)mm.e * 2048 + jc), bl_ = *(const float4*)(bup + (size_t)mm.e * 2048 + 1024 + jc);
                const f32x4 gv = acc[mi][ni], lv = acc[mi][ni + 2]; const float bgv[4] = {bg.x, bg.y, bg.z, bg.w}, blv[4] = {bl_.x, bl_.y, bl_.z, bl_.w}; float r4[4];
#pragma unroll
                for (int r = 0; r < 4; ++r) { const float gg = fminf(gv[r] + bgv[r], 7.0f); const float ll = fminf(fmaxf(lv[r] + blv[r], -7.0f), 7.0f); r4[r] = gg * sigmoidf_(1.702f * gg) * (ll + 1.0f); }
                uint2 o; o.x = cvtpk(r4[0], r4[1]); o.y = cvtpk(r4[2], r4[3]); *(uint2*)(ACT + row * 1024 + jc) = o; } }
        __syncthreads();
    }
}
DEV void phase_down(const Args& a, unsigned char* smem) {
    int* sm = (int*)(smem + MISC_OFF); float* rw = (float*)(sm + 128);
    const bf16_t* ACT = (const bf16_t*)(a.ws + WS_ACT); const bf16_t* W = (const bf16_t*)(a.ws + WS_WDN); bf16_t* Y = (bf16_t*)(a.ws + WS_Y);
    const float* ROWW = (const float*)(a.ws + WS_ROWW); const float* bdn = a.in[I_BDN];
    const int tid = threadIdx.x, lane = tid & 63, wid = tid >> 6, wr = wid >> 1, wc = wid & 1;
    moe_setup(a, sm);
    const int nitems = sm[64] * 8;
    for (int item = blockIdx.x; item < nitems; item += gridDim.x) {
        const MoeMap mm = moe_map(a, sm, item, 8);
        if (tid < 128) { const int slot = mm.mt * 128 + tid; rw[tid] = slot < mm.cnt ? ROWW[(size_t)mm.e * 16384 + slot] : 0.f; }
        __syncthreads();
        const bf16_t* We = W + (size_t)mm.e * 1024 * 1024; const bf16_t* Ab = ACT + ((size_t)mm.off + mm.mt * 128) * 1024;
        f32x4 acc[4][4];
        gemm_mainloop(smem, 16,
            [&](int r, int kc, int kt) { return *(const uint4*)(Ab + (size_t)r * 1024 + kt * 64 + kc * 8); },
            [&](int k, int nc, int kt) { return *(const uint4*)(We + (size_t)(kt * 64 + k) * 1024 + mm.nt * 128 + nc * 8); }, acc);
#pragma unroll
        for (int mi = 0; mi < 4; ++mi) { const int rl = wr * 64 + mi * 16 + (lane & 15); const size_t row = (size_t)mm.off + mm.mt * 128 + rl; const float w = rw[rl];
#pragma unroll
            for (int ni = 0; ni < 4; ++ni) { const int n = mm.nt * 128 + wc * 64 + ni * 16 + 4 * (lane >> 4); const float4 bb = *(const float4*)(bdn + (size_t)mm.e * 1024 + n); const f32x4 v = acc[mi][ni];
                uint2 o; o.x = cvtpk((v[0] + bb.x) * w, (v[1] + bb.y) * w); o.y = cvtpk((v[2] + bb.z) * w, (v[3] + bb.w) * w); *(uint2*)(Y + row * 1024 + n) = o; } }
        __syncthreads();
    }
}

DEV void phase_comb(const Args& a, unsigned char* smem) {
    int* sm = (int*)(smem + MISC_OFF);
    moe_setup(a, sm);
    float* H1 = (float*)(a.ws + WS_H1); bf16_t* XN = (bf16_t*)(a.ws + WS_XN); const bf16_t* Y = (const bf16_t*)(a.ws + WS_Y);
    const int* TOPI = (const int*)(a.ws + WS_TOPI); const int* TOPS = (const int*)(a.ws + WS_TOPS); const float* g = a.in[I_LNPLE];
    const int lane = threadIdx.x & 63; const int gw = blockIdx.x * 4 + (threadIdx.x >> 6), ngw = gridDim.x * 4;
    for (int tok = gw; tok < NTOK; tok += ngw) {
        float4 v[4];
#pragma unroll
        for (int j = 0; j < 4; ++j) v[j] = *(const float4*)(H1 + (size_t)tok * 1024 + j * 256 + lane * 4);
#pragma unroll
        for (int k = 0; k < 4; ++k) { const int e = TOPI[(size_t)tok * 4 + k]; const size_t row = (size_t)sm[32 + e] * 128 + TOPS[(size_t)tok * 4 + k];
#pragma unroll
            for (int j = 0; j < 4; ++j) { const uint2 u = *(const uint2*)(Y + row * 1024 + j * 256 + lane * 4); v[j].x += bflo(u.x); v[j].y += bfhi(u.x); v[j].z += bflo(u.y); v[j].w += bfhi(u.y); } }
        float s = 0.f;
#pragma unroll
        for (int j = 0; j < 4; ++j) { *(float4*)(H1 + (size_t)tok * 1024 + j * 256 + lane * 4) = v[j]; s += v[j].x * v[j].x + v[j].y * v[j].y + v[j].z * v[j].z + v[j].w * v[j].w; }
        const float rstd = rsqrtf(wave_sum(s) * (1.f / 1024.f) + EPS);
#pragma unroll
        for (int j = 0; j < 4; ++j) { const float4 gg = *(const float4*)(g + j * 256 + lane * 4);
            uint2 o; o.x = cvtpk(v[j].x * rstd * gg.x, v[j].y * rstd * gg.y); o.y = cvtpk(v[j].z * rstd * gg.z, v[j].w * rstd * gg.w); *(uint2*)(XN + (size_t)tok * 1024 + j * 256 + lane * 4) = o; }
    }
}

DEV void phase_gate(const Args& a, unsigned char* smem) {
    const bf16_t* XN = (const bf16_t*)(a.ws + WS_XN); const bf16_t* WG = (const bf16_t*)(a.ws + WS_WGATE); const bf16_t* PB = (const bf16_t*)(a.ws + WS_PB); const bf16_t* WP = (const bf16_t*)(a.ws + WS_WPLE);
    const float* H2 = (const float*)(a.ws + WS_H1); float* OUT = a.out; float* SSQ3 = (float*)(a.ws + WS_SSQ3);
    const int tid = threadIdx.x, lane = tid & 63, wid = tid >> 6, wr = wid >> 1, wc = wid & 1;
    for (int item = blockIdx.x; item < 128 * 8; item += gridDim.x) {
        const int nt = item / 128, mt = item % 128;
        f32x4 acc[4][4];
        gemm_mainloop(smem, 16,
            [&](int r, int kc, int kt) { return *(const uint4*)(XN + (size_t)(mt * 128 + r) * 1024 + kt * 64 + kc * 8); },
            [&](int k, int nc, int kt) { return *(const uint4*)(WG + (size_t)(kt * 64 + k) * 1024 + nt * 128 + nc * 8); }, acc);
#pragma unroll
        for (int mi = 0; mi < 4; ++mi) { const size_t gm = mt * 128 + wr * 64 + mi * 16 + (lane & 15);
#pragma unroll
            for (int ni = 0; ni < 4; ++ni) { const int n = nt * 128 + wc * 64 + ni * 16 + 4 * (lane >> 4); const f32x4 v = acc[mi][ni];
                float4 o = {sigmoidf_(v[0]), sigmoidf_(v[1]), sigmoidf_(v[2]), sigmoidf_(v[3])}; *(float4*)(OUT + gm * 1024 + n) = o; } }
        gemm_mainloop(smem, 4,
            [&](int r, int kc, int kt) { return *(const uint4*)(PB + (size_t)(mt * 128 + r) * 256 + kt * 64 + kc * 8); },
            [&](int k, int nc, int kt) { return *(const uint4*)(WP + (size_t)(kt * 64 + k) * 1024 + nt * 128 + nc * 8); }, acc);
#pragma unroll
        for (int mi = 0; mi < 4; ++mi) { const size_t gm = mt * 128 + wr * 64 + mi * 16 + (lane & 15); float ss = 0.f;
#pragma unroll
            for (int ni = 0; ni < 4; ++ni) { const int n = nt * 128 + wc * 64 + ni * 16 + 4 * (lane >> 4); const f32x4 v = acc[mi][ni];
                const float4 gt = *(const float4*)(OUT + gm * 1024 + n); const float4 h = *(const float4*)(H2 + gm * 1024 + n);
                float4 o = {h.x + v[0] * gt.x, h.y + v[1] * gt.y, h.z + v[2] * gt.z, h.w + v[3] * gt.w}; *(float4*)(OUT + gm * 1024 + n) = o;
                ss += o.x * o.x + o.y * o.y + o.z * o.z + o.w * o.w; }
            ss += __shfl_xor(ss, 16); ss += __shfl_xor(ss, 32);
            if (lane < 16) SSQ3[gm * 16 + nt * 2 + wc] = ss; }
        __syncthreads();
    }
}

DEV void phase_final(const Args& a) {
    float* OUT = a.out; const float* SSQ3 = (const float*)(a.ws + WS_SSQ3); const float* g = a.in[I_LNF];
    const int lane = threadIdx.x & 63; const int gw = blockIdx.x * 4 + (threadIdx.x >> 6), ngw = gridDim.x * 4;
    for (int m = gw; m < NTOK; m += ngw) {
        float s = 0.f;
#pragma unroll
        for (int j = 0; j < 16; ++j) s += SSQ3[(size_t)m * 16 + j];
        const float rstd = rsqrtf(s * (1.f / 1024.f) + EPS);
#pragma unroll
        for (int j = 0; j < 4; ++j) { float4 v = *(const float4*)(OUT + (size_t)m * 1024 + j * 256 + lane * 4); const float4 gg = *(const float4*)(g + j * 256 + lane * 4);
            v.x *= rstd * gg.x; v.y *= rstd * gg.y; v.z *= rstd * gg.z; v.w *= rstd * gg.w; *(float4*)(OUT + (size_t)m * 1024 + j * 256 + lane * 4) = v; }
    }
}

namespace cg = cooperative_groups;
template <int PH> DEV void run_phase(const Args& a, unsigned char* smem) {
    if constexpr (PH == PH_PRO) phase_prologue(a, smem);
    else if constexpr (PH == PH_INPROJ) phase_inproj(a, smem);
    else if constexpr (PH == PH_CMP) phase_cmp(a, smem);
    else if constexpr (PH == PH_ATT) phase_att(a, smem);
    else if constexpr (PH == PH_OUTPROJ) phase_outproj(a, smem);
    else if constexpr (PH == PH_ROUTE) phase_route(a, smem);
    else if constexpr (PH == PH_UP) phase_up(a, smem);
    else if constexpr (PH == PH_DOWN) phase_down(a, smem);
    else if constexpr (PH == PH_COMB) phase_comb(a, smem);
    else if constexpr (PH == PH_GATE) phase_gate(a, smem);
    else if constexpr (PH == PH_FINAL) phase_final(a);
}
template <int PH> __global__ void __launch_bounds__(256, 2) phase_kernel(Args a) {
    extern __shared__ __attribute__((aligned(16))) unsigned char smem[];
    run_phase<PH>(a, smem);
}
template <int PH> static void launch_phase(int grid, hipStream_t stream, const Args& a) {
    static bool init = false;
    if (!init) { (void)hipFuncSetAttribute((const void*)phase_kernel<PH>, hipFuncAttributeMaxDynamicSharedMemorySize, LDS_BYTES); init = true; }
    hipLaunchKernelGGL(phase_kernel<PH>, dim3(grid), dim3(256), LDS_BYTES, stream, a);
}

extern "C" void kernel_launch(void* const* d_in, const int* in_sizes, int n_in, void* d_out, int out_size, void* d_ws, size_t ws_size, hipStream_t stream) {
    static int grid = 0;
    if (grid == 0) {
        if (n_in != 25 || ws_size < WS_END) { fprintf(stderr, "kernel_launch: unexpected n_in %d / ws %zu\n", n_in, ws_size); grid = -1; return; }
        int dev = 0, cus = 0;
        (void)hipGetDevice(&dev); (void)hipDeviceGetAttribute(&cus, hipDeviceAttributeMultiprocessorCount, dev);
        grid = cus * 2;
    }
    if (grid < 0) return;
    (void)hipMemsetAsync((char*)d_ws + WS_CTL, 0, 1 * MiB, stream);
    Args a{};
    for (int i = 0; i < 25; ++i) a.in[i] = (const float*)d_in[i];
    a.out = (float*)d_out; a.ws = (unsigned char*)d_ws; a.ph_lo = 0; a.ph_hi = PH_N;
    launch_phase<PH_PRO>(grid, stream, a);
    launch_phase<PH_INPROJ>(grid, stream, a);
    launch_phase<PH_CMP>(grid, stream, a);
    launch_phase<PH_ATT>(grid, stream, a);
    launch_phase<PH_OUTPROJ>(grid, stream, a);
    launch_phase<PH_ROUTE>(grid, stream, a);
    launch_phase<PH_UP>(grid, stream, a);
    launch_phase<PH_DOWN>(grid, stream, a);
    launch_phase<PH_COMB>(grid, stream, a);
    launch_phase<PH_GATE>(grid, stream, a);
    launch_phase<PH_FINAL>(grid, stream, a);
}
```

```cpp
#include <hip/hip_runtime.h>
#include <hip/hip_cooperative_groups.h>
#include <stdint.h>
#include <cstdio>

#define DEV __device__ __forceinline__
#define LAS __attribute__((address_space(3)))

typedef unsigned short bf16_t;
typedef short bf16x8 __attribute__((ext_vector_type(8)));
typedef short s16x4 __attribute__((ext_vector_type(4)));
typedef float f32x4 __attribute__((ext_vector_type(4)));
typedef float f32x2_t __attribute__((ext_vector_type(2)));
typedef __bf16 bf16x2_t __attribute__((ext_vector_type(2)));

#ifndef GEMM_EMU
#define GEMM_EMU 0
#endif

constexpr int T_ = 8192, NTOK = 16384;
constexpr float EPS = 1e-6f;
constexpr float LOG2E = 1.4426950408889634f;
constexpr float QS = 0.125f * LOG2E;
constexpr int NWIN = 2944;

constexpr size_t MiB = 1u << 20;
constexpr size_t WS_CTL = 0;
constexpr size_t WS_WIN = 1 * MiB;
constexpr size_t WS_WOUT = 7 * MiB;
constexpr size_t WS_WGATE = 9 * MiB;
constexpr size_t WS_WPLE = 11 * MiB;
constexpr size_t WS_WC1 = 12 * MiB;
constexpr size_t WS_WC2 = 13 * MiB;
constexpr size_t WS_BIAS1 = 13 * MiB + 65536;
constexpr size_t WS_KC = 14 * MiB;
constexpr size_t WS_HID = 15 * MiB;
constexpr size_t WS_GN = 16 * MiB;
constexpr size_t WS_LS = 18 * MiB;
constexpr size_t WS_CUM = 19 * MiB;
constexpr size_t WS_SSQ = 20 * MiB;
constexpr size_t WS_TOPI = 21 * MiB;
constexpr size_t WS_TOPS = 21 * MiB + 262144;
constexpr size_t WS_TOPW = 21 * MiB + 524288;
constexpr size_t WS_TOKOF = 22 * MiB;
constexpr size_t WS_ROWW = 24 * MiB;
constexpr size_t WS_SSQ3 = 26 * MiB;
constexpr size_t WS_PB = 28 * MiB;
constexpr size_t WS_XN = 36 * MiB;
constexpr size_t WS_PROJ = 68 * MiB;
constexpr size_t WS_ONSA = 160 * MiB;
constexpr size_t WS_OFOX = 176 * MiB;
constexpr size_t WS_H1 = 192 * MiB;
constexpr size_t WS_WUP = 256 * MiB;
constexpr size_t WS_WDN = 384 * MiB;
constexpr size_t WS_ACT = 448 * MiB;
constexpr size_t WS_Y = 584 * MiB;
constexpr size_t WS_END = 720 * MiB;

enum { PH_PRO = 0, PH_INPROJ, PH_CMP, PH_ATT, PH_OUTPROJ, PH_ROUTE, PH_UP, PH_DOWN, PH_COMB, PH_GATE, PH_FINAL, PH_N };

struct Args { const float* in[25]; float* out; unsigned char* ws; int ph_lo, ph_hi; };
enum { I_X = 0, I_P, I_LN1, I_WIN, I_BFG, I_WC1K, I_WC2K, I_PEK, I_WC1V, I_WC2V, I_PEV, I_GNN, I_GNF, I_WOUT, I_LN2, I_WR, I_BR,
       I_WUP, I_BUP, I_WDN, I_BDN, I_LNPLE, I_WPLE, I_WGATE, I_LNF };

DEV unsigned cvtpk(float lo, float hi) { f32x2_t v = {lo, hi}; bf16x2_t b = __builtin_convertvector(v, bf16x2_t); return __builtin_bit_cast(unsigned, b); }
DEV float bf2f(unsigned short b) { return __uint_as_float(((unsigned)b) << 16); }
DEV float bflo(unsigned u) { return __uint_as_float(u << 16); }
DEV float bfhi(unsigned u) { return __uint_as_float(u & 0xffff0000u); }
DEV void unpack8(const uint4& u, float* f) { f[0] = bflo(u.x); f[1] = bfhi(u.x); f[2] = bflo(u.y); f[3] = bfhi(u.y); f[4] = bflo(u.z); f[5] = bfhi(u.z); f[6] = bflo(u.w); f[7] = bfhi(u.w); }
DEV float wave_sum(float v) {
#pragma unroll
    for (int o = 1; o < 64; o <<= 1) v += __shfl_xor(v, o);
    return v;
}
DEV float sigmoidf_(float x) { return 1.0f / (1.0f + __expf(-x)); }
DEV float logsigmoidf_(float x) { return fminf(x, 0.f) - log1pf(__expf(-fabsf(x))); }
DEV float gelu_tanh(float x) { const float u = 0.7978845608028654f * (x + 0.044715f * x * x * x); const float th = 1.0f - 2.0f / (__expf(2.0f * u) + 1.0f); return 0.5f * x * (1.0f + th); }

constexpr int GA_BYTES = 128 * 128;
constexpr int GB_STRIDE = 288;
constexpr int GB_BYTES = 64 * GB_STRIDE;
constexpr int GSTAGE = GA_BYTES + GB_BYTES;
constexpr int GEMM_LDS = 2 * GSTAGE;
constexpr int MISC_OFF = GEMM_LDS;
constexpr int LDS_BYTES = GEMM_LDS + 4096;

DEV s16x4 tr_read(const unsigned char* p) {
    typedef short v4i16_t __attribute__((ext_vector_type(4)));
    return __builtin_bit_cast(s16x4, __builtin_amdgcn_ds_read_tr16_b64_v4i16((LAS v4i16_t*)p));
}

template <class AL, class BL>
DEV void gemm_mainloop(unsigned char* smem, int nkt, const AL& al, const BL& bl, f32x4 (&acc)[4][4]) {
    const int tid = threadIdx.x, lane = tid & 63, wid = tid >> 6, wr = wid >> 1, wc = wid & 1;
    uint4 ra[4], rb[4];
#pragma unroll
    for (int mi = 0; mi < 4; ++mi)
#pragma unroll
        for (int ni = 0; ni < 4; ++ni) acc[mi][ni] = (f32x4){0.f, 0.f, 0.f, 0.f};
#define G_LOAD(kt) do { _Pragma("unroll") for (int i_ = 0; i_ < 4; ++i_) { const int id_ = tid + 256 * i_; ra[i_] = al(id_ >> 3, id_ & 7, (kt)); } \
                        _Pragma("unroll") for (int i_ = 0; i_ < 4; ++i_) { const int id_ = tid + 256 * i_; rb[i_] = bl(id_ >> 4, id_ & 15, (kt)); } } while (0)
#define G_STORE(st) do { unsigned char* A_ = smem + (st) * GSTAGE; unsigned char* B_ = A_ + GA_BYTES; \
        _Pragma("unroll") for (int i_ = 0; i_ < 4; ++i_) { const int id_ = tid + 256 * i_; const int r_ = id_ >> 3, kc_ = id_ & 7; *(uint4*)(A_ + r_ * 128 + ((kc_ ^ (r_ & 7)) << 4)) = ra[i_]; } \
        _Pragma("unroll") for (int i_ = 0; i_ < 4; ++i_) { const int id_ = tid + 256 * i_; const int k_ = id_ >> 4, nc_ = id_ & 15; *(uint4*)(B_ + k_ * GB_STRIDE + nc_ * 16) = rb[i_]; } } while (0)
    G_LOAD(0); G_STORE(0); __syncthreads();
    for (int kt = 0; kt < nkt; ++kt) {
        const bool more = (kt + 1 < nkt);
        if (more) G_LOAD(kt + 1);
        const unsigned char* A = smem + (kt & 1) * GSTAGE; const unsigned char* Bt = A + GA_BYTES;
#if GEMM_EMU
        for (int k = 0; k < 64; ++k) {
            float av[4], bv[4][4];
#pragma unroll
            for (int mi = 0; mi < 4; ++mi) { const int m = wr * 64 + mi * 16 + (lane & 15); av[mi] = bf2f(*(const bf16_t*)(A + m * 128 + (((k >> 3) ^ (m & 7)) << 4) + (k & 7) * 2)); }
#pragma unroll
            for (int ni = 0; ni < 4; ++ni)
#pragma unroll
                for (int r = 0; r < 4; ++r) { const int n = wc * 64 + ni * 16 + 4 * (lane >> 4) + r; bv[ni][r] = bf2f(*(const bf16_t*)(Bt + k * GB_STRIDE + n * 2)); }
#pragma unroll
            for (int mi = 0; mi < 4; ++mi)
#pragma unroll
                for (int ni = 0; ni < 4; ++ni)
#pragma unroll
                    for (int r = 0; r < 4; ++r) acc[mi][ni][r] += av[mi] * bv[ni][r];
        }
#else
#pragma unroll
        for (int ks = 0; ks < 2; ++ks) {
            bf16x8 af[4], wf[4];
#pragma unroll
            for (int mi = 0; mi < 4; ++mi) { const int m = wr * 64 + mi * 16 + (lane & 15); const int kc = ks * 4 + (lane >> 4); af[mi] = *(const bf16x8*)(A + m * 128 + ((kc ^ (m & 7)) << 4)); }
#pragma unroll
            for (int ni = 0; ni < 4; ++ni) {
                const int i = lane & 15; const int row = ks * 32 + 8 * (lane >> 4) + (i >> 2); const int col = wc * 64 + ni * 16 + 4 * (i & 3);
                const unsigned char* p = Bt + row * GB_STRIDE + col * 2;
                const s16x4 lo = tr_read(p), hi = tr_read(p + 4 * GB_STRIDE);
                wf[ni] = (bf16x8){lo[0], lo[1], lo[2], lo[3], hi[0], hi[1], hi[2], hi[3]};
            }
#pragma unroll
            for (int mi = 0; mi < 4; ++mi)
#pragma unroll
                for (int ni = 0; ni < 4; ++ni) acc[mi][ni] = __builtin_amdgcn_mfma_f32_16x16x32_bf16(wf[ni], af[mi], acc[mi][ni], 0, 0, 0);
        }
#endif
        if (more) G_STORE((kt + 1) & 1);
        __syncthreads();
    }
#undef G_LOAD
#undef G_STORE
}

DEV void convert_chunk(const float* src, bf16_t* dst, size_t i8) {
    const float4 a = *(const float4*)(src + i8 * 8), b = *(const float4*)(src + i8 * 8 + 4);
    uint4 o; o.x = cvtpk(a.x, a.y); o.y = cvtpk(a.z, a.w); o.z = cvtpk(b.x, b.y); o.w = cvtpk(b.z, b.w);
    *(uint4*)(dst + i8 * 8) = o;
}
DEV void phase_prologue(const Args& a, unsigned char* smem) {
    unsigned char* ws = a.ws;
    const size_t gtid = (size_t)blockIdx.x * 256 + threadIdx.x, gn = (size_t)gridDim.x * 256;
    {
        const float* srcs[10] = {a.in[I_WUP], a.in[I_WDN], a.in[I_WOUT], a.in[I_WGATE], a.in[I_WPLE], a.in[I_WC1K], a.in[I_WC1V], a.in[I_WC2K], a.in[I_WC2V], a.in[I_P]};
        bf16_t* dsts[10] = {(bf16_t*)(ws + WS_WUP), (bf16_t*)(ws + WS_WDN), (bf16_t*)(ws + WS_WOUT), (bf16_t*)(ws + WS_WGATE), (bf16_t*)(ws + WS_WPLE),
                            (bf16_t*)(ws + WS_WC1), (bf16_t*)(ws + WS_WC1) + 2048 * 128, (bf16_t*)(ws + WS_WC2), (bf16_t*)(ws + WS_WC2) + 128 * 64, (bf16_t*)(ws + WS_PB)};
        const size_t cnt8[10] = {(size_t)32 * 1024 * 2048 / 8, (size_t)32 * 1024 * 1024 / 8, 1024 * 1024 / 8, 1024 * 1024 / 8, 256 * 1024 / 8, 2048 * 128 / 8, 2048 * 128 / 8, 128 * 64 / 8, 128 * 64 / 8, (size_t)NTOK * 256 / 8};
#pragma unroll
        for (int s = 0; s < 10; ++s) for (size_t i = gtid; i < cnt8[s]; i += gn) convert_chunk(srcs[s], dsts[s], i);
    }
    {
        const float* W = a.in[I_WIN]; bf16_t* O = (bf16_t*)(ws + WS_WIN);
        for (size_t i = gtid; i < (size_t)1024 * (NWIN / 8); i += gn) {
            const int k = (int)(i / (NWIN / 8)), j = (int)(i % (NWIN / 8)) * 8;
            uint4 o = {0u, 0u, 0u, 0u};
            if (j < 2848) {
                const int sj = (j < 1280) ? j : (j < 2816) ? j + 24 : (j < 2840) ? j - 1536 : j;
                const float4 x = *(const float4*)(W + (size_t)k * 2848 + sj), y = *(const float4*)(W + (size_t)k * 2848 + sj + 4);
                o.x = cvtpk(x.x, x.y); o.y = cvtpk(x.z, x.w); o.z = cvtpk(y.x, y.y); o.w = cvtpk(y.z, y.w);
            }
            *(uint4*)(O + (size_t)k * NWIN + j) = o;
        }
    }
    {
        const int lane = threadIdx.x & 63; const int gw = blockIdx.x * 4 + (threadIdx.x >> 6), ngw = gridDim.x * 4;
        const float* X = a.in[I_X]; const float* g = a.in[I_LN1]; bf16_t* XN = (bf16_t*)(ws + WS_XN);
        for (int m = gw; m < NTOK; m += ngw) {
            float4 v[4]; float s = 0.f;
#pragma unroll
            for (int j = 0; j < 4; ++j) { v[j] = *(const float4*)(X + (size_t)m * 1024 + j * 256 + lane * 4); s += v[j].x * v[j].x + v[j].y * v[j].y + v[j].z * v[j].z + v[j].w * v[j].w; }
            const float rstd = rsqrtf(wave_sum(s) * (1.f / 1024.f) + EPS);
#pragma unroll
            for (int j = 0; j < 4; ++j) { const float4 gg = *(const float4*)(g + j * 256 + lane * 4);
                uint2 o; o.x = cvtpk(v[j].x * rstd * gg.x, v[j].y * rstd * gg.y); o.y = cvtpk(v[j].z * rstd * gg.z, v[j].w * rstd * gg.w);
                *(uint2*)(XN + (size_t)m * 1024 + j * 256 + lane * 4) = o; }
        }
    }
    if (blockIdx.x < 2) {
        const int which = blockIdx.x; const float* pe = a.in[which ? I_PEV : I_PEK]; const float* w1 = a.in[which ? I_WC1V : I_WC1K];
        float* red = (float*)smem; const int n = threadIdx.x & 127, half = threadIdx.x >> 7;
        float s = 0.f;
        for (int k = half * 1024; k < half * 1024 + 1024; ++k) s += pe[k] * w1[(size_t)k * 128 + n];
        red[threadIdx.x] = s; __syncthreads();
        if (threadIdx.x < 128) ((float*)(ws + WS_BIAS1))[which * 128 + n] = red[n] + red[n + 128];
        __syncthreads();
    }
}

DEV void phase_inproj(const Args& a, unsigned char* smem) {
    const bf16_t* XN = (const bf16_t*)(a.ws + WS_XN); const bf16_t* W = (const bf16_t*)(a.ws + WS_WIN);
    bf16_t* PROJ = (bf16_t*)(a.ws + WS_PROJ); float* GN = (float*)(a.ws + WS_GN); float* LS = (float*)(a.ws + WS_LS); const float* bfg = a.in[I_BFG];
    const int lane = threadIdx.x & 63, wid = threadIdx.x >> 6, wr = wid >> 1, wc = wid & 1;
    for (int item = blockIdx.x; item < 128 * 23; item += gridDim.x) {
        const int nt = item / 128, mt = item % 128;
        f32x4 acc[4][4];
        gemm_mainloop(smem, 16,
            [&](int r, int kc, int kt) { return *(const uint4*)(XN + (size_t)(mt * 128 + r) * 1024 + kt * 64 + kc * 8); },
            [&](int k, int nc, int kt) { return *(const uint4*)(W + (size_t)(kt * 64 + k) * NWIN + nt * 128 + nc * 8); }, acc);
#pragma unroll
        for (int mi = 0; mi < 4; ++mi) {
            const int gm = mt * 128 + wr * 64 + mi * 16 + (lane & 15); const int b = gm >> 13, t = gm & 8191;
#pragma unroll
            for (int ni = 0; ni < 4; ++ni) {
                const int n = wc * 64 + ni * 16 + 4 * (lane >> 4); const f32x4 v = acc[mi][ni];
                if (nt < 22) {
                    const int hs = nt * 2 + (n >> 6), d = n & 63; const float sc = (hs < 8 || (hs >= 20 && hs < 28)) ? QS : 1.0f;
                    uint2 o; o.x = cvtpk(v[0] * sc, v[1] * sc); o.y = cvtpk(v[2] * sc, v[3] * sc);
                    *(uint2*)(PROJ + (((size_t)(hs * 2 + b)) * 8192 + t) * 64 + d) = o;
                } else if (n < 24) {
#pragma unroll
                    for (int r = 0; r < 4; ++r) GN[(size_t)gm * 24 + n + r] = sigmoidf_(v[r]);
                } else if (n < 32) {
#pragma unroll
                    for (int r = 0; r < 4; ++r) { const int h = n - 24 + r; LS[((size_t)(b * 8 + h)) * 8192 + t] = logsigmoidf_(v[r] + bfg[h]); }
                }
            }
        }
    }
}

DEV void phase_cmp(const Args& a, unsigned char* smem) {
    const bf16_t* PROJ = (const bf16_t*)(a.ws + WS_PROJ);
    const int tid = threadIdx.x, lane = tid & 63, wid = tid >> 6, wr = wid >> 1, wc = wid & 1;
    for (int item = blockIdx.x; item < 32 + 16; item += gridDim.x) {
        if (item < 32) {
            const int which = item >> 4, b = (item >> 3) & 1, g = (item >> 2) & 1, mt = item & 3;
            const bf16_t* base = PROJ + ((size_t)((8 + 2 * which + g) * 2 + b)) * 8192 * 64;
            const bf16_t* W1 = (const bf16_t*)(a.ws + WS_WC1) + (size_t)which * 2048 * 128;
            const bf16_t* W2 = (const bf16_t*)(a.ws + WS_WC2) + (size_t)which * 128 * 64;
            const float* bias1 = (const float*)(a.ws + WS_BIAS1) + which * 128;
            bf16_t* HID = (bf16_t*)(a.ws + WS_HID) + ((size_t)(which * 4 + b * 2 + g)) * 512 * 128;
            bf16_t* OUT = (bf16_t*)(a.ws + WS_KC) + ((size_t)(which * 4 + b * 2 + g)) * 512 * 64;
            f32x4 acc[4][4];
            gemm_mainloop(smem, 32,
                [&](int r, int kc, int kt) { int c = mt * 128 + r; c = c > 510 ? 510 : c; return *(const uint4*)(base + (size_t)c * 1024 + kt * 64 + kc * 8); },
                [&](int k, int nc, int kt) { return *(const uint4*)(W1 + (size_t)(kt * 64 + k) * 128 + nc * 8); }, acc);
#pragma unroll
            for (int mi = 0; mi < 4; ++mi) { const int c = mt * 128 + wr * 64 + mi * 16 + (lane & 15);
#pragma unroll
                for (int ni = 0; ni < 4; ++ni) { const int n = wc * 64 + ni * 16 + 4 * (lane >> 4); const f32x4 v = acc[mi][ni]; const float4 bb = *(const float4*)(bias1 + n);
                    uint2 o; o.x = cvtpk(gelu_tanh(v[0] + bb.x), gelu_tanh(v[1] + bb.y)); o.y = cvtpk(gelu_tanh(v[2] + bb.z), gelu_tanh(v[3] + bb.w));
                    *(uint2*)(HID + (size_t)c * 128 + n) = o; } }
            __syncthreads();
            gemm_mainloop(smem, 2,
                [&](int r, int kc, int kt) { return *(const uint4*)(HID + (size_t)(mt * 128 + r) * 128 + kt * 64 + kc * 8); },
                [&](int k, int nc, int kt) { uint4 z = {0u, 0u, 0u, 0u}; if (nc < 8) z = *(const uint4*)(W2 + (size_t)(kt * 64 + k) * 64 + nc * 8); return z; }, acc);
            if (wc == 0) {
#pragma unroll
                for (int mi = 0; mi < 4; ++mi) { const int c = mt * 128 + wr * 64 + mi * 16 + (lane & 15);
#pragma unroll
                    for (int ni = 0; ni < 4; ++ni) { const int n = ni * 16 + 4 * (lane >> 4); const f32x4 v = acc[mi][ni];
                        uint2 o; o.x = cvtpk(v[0], v[1]); o.y = cvtpk(v[2], v[3]);
                        if (c >= 511) { o.x = 0u; o.y = 0u; }
                        *(uint2*)(OUT + (size_t)c * 64 + n) = o; } }
            }
            __syncthreads();
        } else {
            const int bh = item - 32; const float* LS = (const float*)(a.ws + WS_LS) + (size_t)bh * 8192; float* CUM = (float*)(a.ws + WS_CUM) + (size_t)bh * 8192;
            float* sc = (float*)smem;
            float v[32]; float s = 0.f;
#pragma unroll
            for (int j = 0; j < 8; ++j) { const float4 x = *(const float4*)(LS + tid * 32 + j * 4); v[4 * j] = x.x; v[4 * j + 1] = x.y; v[4 * j + 2] = x.z; v[4 * j + 3] = x.w; }
#pragma unroll
            for (int j = 0; j < 32; ++j) { s += v[j]; v[j] = s; }
            sc[tid] = s; __syncthreads();
            if (tid == 0) { float run = 0.f; for (int i = 0; i < 256; ++i) { const float x = sc[i]; sc[i] = run; run += x; } }
            __syncthreads();
            const float off = sc[tid];
#pragma unroll
            for (int j = 0; j < 8; ++j) { float4 o = {v[4 * j] + off, v[4 * j + 1] + off, v[4 * j + 2] + off, v[4 * j + 3] + off}; *(float4*)(CUM + tid * 32 + j * 4) = o; }
            __syncthreads();
        }
    }
}

DEV void load_row64(const bf16_t* p, float* f) {
#pragma unroll
    for (int c = 0; c < 8; ++c) { const uint4 u = *(const uint4*)(p + c * 8); unpack8(u, f + c * 8); }
}
DEV float dot64(const float* q, const bf16_t* kp) {
    float s = 0.f;
#pragma unroll
    for (int c = 0; c < 8; ++c) { const uint4 u = *(const uint4*)(kp + c * 8); float f[8]; unpack8(u, f);
#pragma unroll
        for (int j = 0; j < 8; ++j) s += q[c * 8 + j] * f[j]; }
    return s;
}
DEV void axpy64(float* o, float p, const bf16_t* vp) {
#pragma unroll
    for (int c = 0; c < 8; ++c) { const uint4 u = *(const uint4*)(vp + c * 8); float f[8]; unpack8(u, f);
#pragma unroll
        for (int j = 0; j < 8; ++j) o[c * 8 + j] += p * f[j]; }
}
DEV void scale64(float* o, float s) {
#pragma unroll
    for (int j = 0; j < 64; ++j) o[j] *= s;
}
#define ONLINE_STEP(valid, s, vp) do { if (valid) { const float mn_ = fmaxf(m, (s)); const float al_ = exp2f(m - mn_); const float p_ = exp2f((s) - mn_); l = l * al_ + p_; scale64(o, al_); axpy64(o, p_, (vp)); m = mn_; } } while (0)

DEV void nsa_naive_item(const Args& a, unsigned char* smem, int item) {
    const int tid = threadIdx.x, lane = tid & 63, wid = tid >> 6;
    const int b = item / 256, g = (item / 128) & 1, tt = item & 127;
    const int tl = lane >> 2, r = lane & 3, h = g * 4 + r;
    const int t = tt * 64 + wid * 16 + tl; const int token = b * 8192 + t;
    const float slope2 = exp2f(-(float)(h + 1)) * LOG2E;
    float* imp = (float*)smem + wid * (16 * 129) + tl * 129;
    int* seli = (int*)(smem + 4 * 16 * 129 * 4) + wid * 256 + tl * 16;
    const bf16_t* PROJ = (const bf16_t*)(a.ws + WS_PROJ);
    const float* GN = (const float*)(a.ws + WS_GN) + (size_t)token * 24 + h * 3;
    float* TMP = (float*)(a.ws + WS_ACT) + ((size_t)token * 8 + h) * 64;
    float q[64]; load_row64(PROJ + (((size_t)(h * 2 + b)) * 8192 + t) * 64, q);
    float o[64];
    const bf16_t* KC = (const bf16_t*)(a.ws + WS_KC) + ((size_t)(0 * 4 + b * 2 + g)) * 512 * 64;
    const bf16_t* VC = (const bf16_t*)(a.ws + WS_KC) + ((size_t)(1 * 4 + b * 2 + g)) * 512 * 64;
    const int cl = (t >= 31) ? (t - 31) / 16 : -1;
    const int tmaxw = tt * 64 + wid * 16 + 15; const int cmax = (tmaxw - 31) >= 0 ? (tmaxw - 31) / 16 : -1;
    for (int n = r; n < 129; n += 4) imp[n] = 0.f;
    float m = -1e30f, l = 0.f;
    for (int c = 0; c <= cmax; ++c) {
        const float s = dot64(q, KC + (size_t)c * 64) + slope2 * (float)(16 * c + 31 - t);
        if (c <= cl) { const float mn = fmaxf(m, s); l = l * exp2f(m - mn) + exp2f(s - mn); m = mn; }
    }
#pragma unroll
    for (int j = 0; j < 64; ++j) o[j] = 0.f;
    const float linv = 1.0f / fmaxf(l, 1e-30f);
    for (int c = 0; c <= cmax; ++c) {
        const float s = dot64(q, KC + (size_t)c * 64) + slope2 * (float)(16 * c + 31 - t);
        const float p = (c <= cl) ? exp2f(s - m) * linv : 0.f;
        axpy64(o, p, VC + (size_t)c * 64);
        float ps = p; ps += __shfl_xor(ps, 1); ps += __shfl_xor(ps, 2);
        if (r == 0) { imp[c >> 2] += ps; if ((c & 3) == 3) imp[(c >> 2) + 1] += ps; }
    }
    {
        const float g0 = GN[0];
#pragma unroll
        for (int j = 0; j < 64; ++j) TMP[j] = g0 * o[j];
    }
    const int cur = t >> 6;
    {
        unsigned long long tlo = 0ull, thi = 0ull;
        for (int kk = 0; kk < 16; ++kk) {
            float best = -2.0f; int bi = 0;
            for (int n = 0; n < 128; ++n) {
                const bool taken = (n < 64) ? ((tlo >> n) & 1ull) : ((thi >> (n - 64)) & 1ull);
                if (taken) continue;
                const bool valid = n <= cur; const bool forced = valid && (n == 0 || n == cur || n == cur - 1);
                const float sc = forced ? 1e9f : (valid ? imp[n] : -1.0f);
                if (sc > best) { best = sc; bi = n; }
            }
            if (bi < 64) tlo |= 1ull << bi; else thi |= 1ull << (bi - 64);
            if (r == 0) seli[kk] = bi;
        }
    }
    {
        const bf16_t* KS = PROJ + ((size_t)((12 + g) * 2 + b)) * 8192 * 64; const bf16_t* VS = PROJ + ((size_t)((14 + g) * 2 + b)) * 8192 * 64;
        m = -1e30f; l = 0.f;
#pragma unroll
        for (int j = 0; j < 64; ++j) o[j] = 0.f;
        for (int kk = 0; kk < 16; ++kk) {
            const int n = seli[kk];
            for (int j = 0; j < 64; ++j) {
                const int pos = n * 64 + j; const bool valid = pos <= t;
                const int pc = valid ? pos : t;
                const float s = dot64(q, KS + (size_t)pc * 64) + slope2 * (float)(pos - t);
                ONLINE_STEP(valid, s, VS + (size_t)pc * 64);
            }
        }
        const float g1 = GN[1] / fmaxf(l, 1e-30f);
#pragma unroll
        for (int j = 0; j < 64; ++j) TMP[j] += g1 * o[j];
    }
    {
        const bf16_t* KW = PROJ + ((size_t)((16 + g) * 2 + b)) * 8192 * 64; const bf16_t* VW = PROJ + ((size_t)((18 + g) * 2 + b)) * 8192 * 64;
        m = -1e30f; l = 0.f;
#pragma unroll
        for (int j = 0; j < 64; ++j) o[j] = 0.f;
        for (int j = 0; j < 512; ++j) {
            const int pos = t - 511 + j; const bool valid = pos >= 0; const int pc = valid ? pos : 0;
            const float s = dot64(q, KW + (size_t)pc * 64) + slope2 * (float)(pos - t);
            ONLINE_STEP(valid, s, VW + (size_t)pc * 64);
        }
        const float g2 = GN[2] / fmaxf(l, 1e-30f);
        float ss = 0.f;
        bf16_t* O = (bf16_t*)(a.ws + WS_ONSA) + (size_t)token * 512 + h * 64;
#pragma unroll
        for (int j = 0; j < 64; j += 2) { const float v0 = TMP[j] + g2 * o[j], v1 = TMP[j + 1] + g2 * o[j + 1]; ss += v0 * v0 + v1 * v1; *(unsigned*)(O + j) = cvtpk(v0, v1); }
        ((float*)(a.ws + WS_SSQ))[(size_t)token * 16 + h] = ss;
    }
}
DEV void fox_naive_item(const Args& a, int item) {
    const int tid = threadIdx.x;
    const int b = item / 256, h = (item / 32) & 7, tile = item & 31;
    const int t = tile * 256 + tid; const int token = b * 8192 + t;
    const bf16_t* PROJ = (const bf16_t*)(a.ws + WS_PROJ);
    const bf16_t* K = PROJ + ((size_t)((28 + h) * 2 + b)) * 8192 * 64; const bf16_t* V = PROJ + ((size_t)((36 + h) * 2 + b)) * 8192 * 64;
    const float* CUM = (const float*)(a.ws + WS_CUM) + (size_t)(b * 8 + h) * 8192;
    float q[64]; load_row64(PROJ + (((size_t)((20 + h) * 2 + b)) * 8192 + t) * 64, q);
    float o[64];
#pragma unroll
    for (int j = 0; j < 64; ++j) o[j] = 0.f;
    float m = -1e30f, l = 0.f; const float ct = CUM[t];
    const int smax = tile * 256 + (tid | 63);
    for (int s_ = 0; s_ <= smax; ++s_) {
        const bool valid = s_ <= t;
        const float s = dot64(q, K + (size_t)s_ * 64) + (ct - CUM[s_]) * LOG2E;
        ONLINE_STEP(valid, s, V + (size_t)s_ * 64);
    }
    const float li = 1.0f / fmaxf(l, 1e-30f); float ss = 0.f;
    bf16_t* O = (bf16_t*)(a.ws + WS_OFOX) + (size_t)token * 512 + h * 64;
#pragma unroll
    for (int j = 0; j < 64; j += 2) { const float v0 = o[j] * li, v1 = o[j + 1] * li; ss += v0 * v0 + v1 * v1; *(unsigned*)(O + j) = cvtpk(v0, v1); }
    ((float*)(a.ws + WS_SSQ))[(size_t)token * 16 + 8 + h] = ss;
}
typedef float f32x16 __attribute__((ext_vector_type(16)));
constexpr int AT_STAGE = 16384;
constexpr int AT_BIAS_OFF = 2 * AT_STAGE;
constexpr int AT_IMP_OFF = AT_BIAS_OFF + 1024;
constexpr int AT_SEL_OFF = AT_IMP_OFF + 32768;
constexpr int AT_WUN_OFF = AT_SEL_OFF + 512;
constexpr int AT_UCNT_OFF = AT_WUN_OFF + 64;
constexpr int AT_ULIST_OFF = AT_UCNT_OFF + 16;
constexpr int AT_ITEM_OFF = AT_ULIST_OFF + 128;
static_assert(AT_ITEM_OFF + 16 <= LDS_BYTES, "attention LDS map");
#define NEG_INF (-__builtin_inff())

DEV int crow(int r, int hi) { return (r & 3) + 8 * (r >> 2) + 4 * hi; }
#define KV_DECL uint4 rk0_, rk1_, rv0_, rv1_
#define KV_GLOAD(Kt, Vt) do { const bf16_t* kt_ = (Kt); const bf16_t* vt_ = (Vt); rk0_ = *(const uint4*)(kt_ + tid * 8); rk1_ = *(const uint4*)(kt_ + (tid + 256) * 8); \
    rv0_ = *(const uint4*)(vt_ + tid * 8); rv1_ = *(const uint4*)(vt_ + (tid + 256) * 8); } while (0)
#define KV_LSTORE(stp) do { unsigned char* st_ = (stp); \
    { const int c = tid; const int key = c >> 3, ch = c & 7; \
      *(uint4*)(st_ + key * 128 + ((ch ^ (key & 7)) << 4)) = rk0_; \
      *(uint4*)(st_ + 8192 + key * 128 + ((((ch >> 2) ^ ((key >> 1) & 1))) << 6) + ((ch & 3) << 4)) = rv0_; } \
    { const int c = tid + 256; const int key = c >> 3, ch = c & 7; \
      *(uint4*)(st_ + key * 128 + ((ch ^ (key & 7)) << 4)) = rk1_; \
      *(uint4*)(st_ + 8192 + key * 128 + ((((ch >> 2) ^ ((key >> 1) & 1))) << 6) + ((ch & 3) << 4)) = rv1_; } } while (0)
DEV void qk_tile(const unsigned char* Kst, const bf16x8 (&qf)[4], f32x16& p0, f32x16& p1, int lane) {
    const int key = lane & 31, hi = lane >> 5;
#pragma unroll
    for (int ks = 0; ks < 4; ++ks) { const int ch = 2 * ks + hi; const int off = key * 128 + ((ch ^ (key & 7)) << 4);
        const bf16x8 k0 = *(const bf16x8*)(Kst + off), k1 = *(const bf16x8*)(Kst + off + 32 * 128);
        p0 = __builtin_amdgcn_mfma_f32_32x32x16_bf16(k0, qf[ks], p0, 0, 0, 0);
        p1 = __builtin_amdgcn_mfma_f32_32x32x16_bf16(k1, qf[ks], p1, 0, 0, 0); }
}
DEV void pv_tile(const unsigned char* Vst, const f32x16& p0, const f32x16& p1, f32x16 (&o)[2], int lane) {
    const int hi = lane >> 5, i = lane & 15, gg = (lane >> 4) & 1;
    bf16x8 pa[4];
#pragma unroll
    for (int s = 0; s < 4; ++s) { const f32x16& p = (s < 2) ? p0 : p1; const int b = (s & 1) * 8;
        unsigned w[4];
#pragma unroll
        for (int j = 0; j < 4; ++j) w[j] = cvtpk(p[b + 2 * j], p[b + 2 * j + 1]);
        typedef unsigned u32x4_t __attribute__((ext_vector_type(4)));
        u32x4_t ww = {w[0], w[1], w[2], w[3]}; pa[s] = __builtin_bit_cast(bf16x8, ww); }
    const int q = i >> 2; const int sw = (q >> 1) & 1;
#pragma unroll
    for (int s = 0; s < 4; ++s) {
#pragma unroll
        for (int dh = 0; dh < 2; ++dh) {
            const int row0 = 16 * s + 4 * hi + q;
            const unsigned char* p = Vst + row0 * 128 + ((dh ^ sw) << 6) + gg * 32 + (i & 3) * 8;
            const s16x4 lo = tr_read(p), hh = tr_read(p + 8 * 128);
            const bf16x8 vf = {lo[0], lo[1], lo[2], lo[3], hh[0], hh[1], hh[2], hh[3]};
            o[dh] = __builtin_amdgcn_mfma_f32_32x32x16_bf16(vf, pa[s], o[dh], 0, 0, 0);
        }
    }
}
DEV float rowmax32(const f32x16& p0, const f32x16& p1) {
    float a = fmaxf(p0[0], p1[0]);
#pragma unroll
    for (int r = 1; r < 16; ++r) a = fmaxf(a, fmaxf(p0[r], p1[r]));
    return fmaxf(a, __shfl_xor(a, 32));
}
DEV void softmax_step(f32x16& p0, f32x16& p1, float& m, float& l, f32x16 (&o)[2]) {
    const float mt = rowmax32(p0, p1); const float mn = fmaxf(m, mt); const float alpha = __builtin_amdgcn_exp2f(m - mn);
    float rs = 0.f;
#pragma unroll
    for (int r = 0; r < 16; ++r) { p0[r] = __builtin_amdgcn_exp2f(p0[r] - mn); p1[r] = __builtin_amdgcn_exp2f(p1[r] - mn); rs += p0[r] + p1[r]; }
    rs += __shfl_xor(rs, 32);
    l = l * alpha + rs; m = mn;
    if (__any(alpha != 1.0f)) { o[0] *= alpha; o[1] *= alpha; }
}
template <int STRIDE> DEV void mask_tile(f32x16& p0, f32x16& p1, int kpos0, int lo, int hi_lim, int hi) {
#pragma unroll
    for (int r = 0; r < 16; ++r) { const int kp = kpos0 + STRIDE * crow(r, hi);
        if (kp < lo || kp > hi_lim) p0[r] = NEG_INF;
        const int kp1 = kp + 32 * STRIDE; if (kp1 < lo || kp1 > hi_lim) p1[r] = NEG_INF; }
}
template <int STRIDE> DEV void alibi_init(f32x16& p0, f32x16& p1, float slope2, int kpos0, int tref, int hi) {
    const float base = slope2 * (float)(kpos0 - tref + STRIDE * 4 * hi);
#pragma unroll
    for (int r = 0; r < 16; ++r) { const float c = (float)(STRIDE * ((r & 3) + 8 * (r >> 2))); p0[r] = fmaf(slope2, c, base); p1[r] = fmaf(slope2, c + (float)(32 * STRIDE), base); }
}
template <class Src, class Body>
DEV void kv_pipeline(unsigned char* smem, int n, const Src& src, const Body& body) {
    if (n <= 0) return;
    KV_DECL; const int tid = threadIdx.x; const bf16_t *kp, *vp;
    src(0, kp, vp); KV_GLOAD(kp, vp); KV_LSTORE(smem);
    __syncthreads();
    for (int j = 0; j < n; ++j) {
        const bool more = j + 1 < n;
        if (more) { src(j + 1, kp, vp); KV_GLOAD(kp, vp); }
        body(j, smem + (j & 1) * AT_STAGE);
        if (more) KV_LSTORE(smem + ((j + 1) & 1) * AT_STAGE);
        __syncthreads();
    }
}

DEV void fox_item(const Args& a, unsigned char* smem, int b, int h, int qb) {
    const int tid = threadIdx.x, lane = tid & 63, wid = tid >> 6, r32 = lane & 31, hi = lane >> 5;
    const bf16_t* PROJ = (const bf16_t*)(a.ws + WS_PROJ);
    const bf16_t* Q = PROJ + ((size_t)((20 + h) * 2 + b)) * 8192 * 64; const bf16_t* K = PROJ + ((size_t)((28 + h) * 2 + b)) * 8192 * 64; const bf16_t* V = PROJ + ((size_t)((36 + h) * 2 + b)) * 8192 * 64;
    const float* CUM = (const float*)(a.ws + WS_CUM) + (size_t)(b * 8 + h) * 8192;
    const int q0 = qb * 128; const int qrow = q0 + 32 * wid + r32;
    bf16x8 qf[4];
#pragma unroll
    for (int ks = 0; ks < 4; ++ks) qf[ks] = *(const bf16x8*)(Q + (size_t)qrow * 64 + 16 * ks + 8 * hi);
    const float cref = CUM[q0];
    const int ntiles = 2 * qb + 2; const int jmax_w = (q0 + 32 * wid + 31) >> 6; const int jmask_w = (q0 + 32 * wid) >> 6;
    f32x16 o[2]; o[0] = (f32x16){}; o[1] = (f32x16){}; float m = -1e30f, l = 0.f;
    float* biasL = (float*)(smem + AT_BIAS_OFF);
    KV_DECL; float breg = 0.f;
    KV_GLOAD(K, V); if (tid < 64) breg = (cref - CUM[tid]) * LOG2E;
    KV_LSTORE(smem); if (tid < 64) biasL[tid] = breg;
    __syncthreads();
    for (int j = 0; j < ntiles; ++j) {
        const bool more = j + 1 < ntiles;
        if (more) { KV_GLOAD(K + (size_t)(j + 1) * 4096, V + (size_t)(j + 1) * 4096); if (tid < 64) breg = (cref - CUM[(j + 1) * 64 + tid]) * LOG2E; }
        if (j <= jmax_w) {
            const unsigned char* st = smem + (j & 1) * AT_STAGE; const float* bl = biasL + (j & 1) * 64;
            f32x16 p0, p1;
#pragma unroll
            for (int g4 = 0; g4 < 4; ++g4) { const float4 x = *(const float4*)(bl + 8 * g4 + 4 * hi), y = *(const float4*)(bl + 32 + 8 * g4 + 4 * hi);
                p0[4 * g4] = x.x; p0[4 * g4 + 1] = x.y; p0[4 * g4 + 2] = x.z; p0[4 * g4 + 3] = x.w; p1[4 * g4] = y.x; p1[4 * g4 + 1] = y.y; p1[4 * g4 + 2] = y.z; p1[4 * g4 + 3] = y.w; }
            qk_tile(st, qf, p0, p1, lane);
            if (j >= jmask_w) mask_tile<1>(p0, p1, 64 * j, -1, qrow, hi);
            softmax_step(p0, p1, m, l, o);
            pv_tile(st + 8192, p0, p1, o, lane);
        }
        if (more) { KV_LSTORE(smem + ((j + 1) & 1) * AT_STAGE); if (tid < 64) biasL[((j + 1) & 1) * 64 + tid] = breg; }
        __syncthreads();
    }
    const float inv = 1.0f / l; float ss = 0.f;
    const size_t token = (size_t)b * 8192 + qrow;
    bf16_t* O = (bf16_t*)(a.ws + WS_OFOX) + token * 512 + h * 64;
#pragma unroll
    for (int dh = 0; dh < 2; ++dh)
#pragma unroll
        for (int g4 = 0; g4 < 4; ++g4) { const float v0 = o[dh][4 * g4] * inv, v1 = o[dh][4 * g4 + 1] * inv, v2 = o[dh][4 * g4 + 2] * inv, v3 = o[dh][4 * g4 + 3] * inv;
            ss += v0 * v0 + v1 * v1 + v2 * v2 + v3 * v3; uint2 w; w.x = cvtpk(v0, v1); w.y = cvtpk(v2, v3); *(uint2*)(O + 32 * dh + 8 * g4 + 4 * hi) = w; }
    ss += __shfl_xor(ss, 32);
    if (hi == 0) ((float*)(a.ws + WS_SSQ))[token * 16 + 8 + h] = ss;
}

DEV void nsa_item(const Args& a, unsigned char* smem, int b, int g, int tt) {
    const int tid = threadIdx.x, lane = tid & 63, wid = tid >> 6, col = lane & 31, hi = lane >> 5;
    const int t0 = tt * 32, tokw = col >> 2, r = col & 3, h = 4 * g + r; const int tokl = wid * 8 + tokw; const int t = t0 + tokl; const size_t token = (size_t)b * 8192 + t;
    const float slope2 = exp2f(-(float)(h + 1)) * LOG2E;
    const bf16_t* PROJ = (const bf16_t*)(a.ws + WS_PROJ);
    const float* GN = (const float*)(a.ws + WS_GN) + token * 24 + h * 3;
    const int cur = t0 >> 6; const bool need_topk = cur > 15;
    bf16x8 qf[4];
    { const bf16_t* Q = PROJ + (((size_t)(h * 2 + b)) * 8192 + t) * 64;
#pragma unroll
      for (int ks = 0; ks < 4; ++ks) qf[ks] = *(const bf16x8*)(Q + 16 * ks + 8 * hi); }
    float* impw = (float*)(smem + AT_IMP_OFF) + wid * 2048; float* totw = impw + lane;
    unsigned* selmask = (unsigned*)(smem + AT_SEL_OFF); unsigned* wun = (unsigned*)(smem + AT_WUN_OFF); int* ucnt = (int*)(smem + AT_UCNT_OFF); unsigned char* ulist = smem + AT_ULIST_OFF;
    f32x16 o[2]; float m, l;
    const int tmin_w = t0 + wid * 8, tmax_w = tmin_w + 7;
    {
        const bf16_t* KC = (const bf16_t*)(a.ws + WS_KC) + ((size_t)(0 * 4 + b * 2 + g)) * 512 * 64; const bf16_t* VC = (const bf16_t*)(a.ws + WS_KC) + ((size_t)(1 * 4 + b * 2 + g)) * 512 * 64;
        const int ncv = t0 / 16 + 1; const int nct = (ncv + 63) >> 6;
        auto src = [&](int j, const bf16_t*& kp, const bf16_t*& vp) { kp = KC + (size_t)j * 4096; vp = VC + (size_t)j * 4096; };
        m = -1e30f; l = 0.f;
        kv_pipeline(smem, nct, src, [&](int j, const unsigned char* st) {
            const int kpos0 = 1024 * j + 31;
            if (kpos0 > tmax_w) return;
            f32x16 p0, p1; alibi_init<16>(p0, p1, slope2, kpos0, t0, hi);
            qk_tile(st, qf, p0, p1, lane);
            mask_tile<16>(p0, p1, kpos0, -1, t, hi);
            const float mt = rowmax32(p0, p1); const float mn = fmaxf(m, mt); float rs = 0.f;
#pragma unroll
            for (int rr = 0; rr < 16; ++rr) rs += __builtin_amdgcn_exp2f(p0[rr] - mn) + __builtin_amdgcn_exp2f(p1[rr] - mn);
            rs += __shfl_xor(rs, 32);
            l = l * __builtin_amdgcn_exp2f(m - mn) + rs; m = mn;
        });
        const float linv = l > 0.f ? 1.0f / l : 0.f;
        if (need_topk) { for (int i = lane; i < 8 * 129; i += 64) impw[i] = 0.f; }
        o[0] = (f32x16){}; o[1] = (f32x16){};
        kv_pipeline(smem, nct, src, [&](int j, const unsigned char* st) {
            const int kpos0 = 1024 * j + 31;
            if (kpos0 > tmax_w) return;
            f32x16 p0, p1; alibi_init<16>(p0, p1, slope2, kpos0, t0, hi);
            qk_tile(st, qf, p0, p1, lane);
            mask_tile<16>(p0, p1, kpos0, -1, t, hi);
#pragma unroll
            for (int rr = 0; rr < 16; ++rr) { p0[rr] = __builtin_amdgcn_exp2f(p0[rr] - m) * linv; p1[rr] = __builtin_amdgcn_exp2f(p1[rr] - m) * linv; }
            if (need_topk) {
#pragma unroll
                for (int half = 0; half < 2; ++half)
#pragma unroll
                    for (int g4 = 0; g4 < 4; ++g4) { const f32x16& p = half ? p1 : p0;
                        float ms = (p[4 * g4] + p[4 * g4 + 1]) + (p[4 * g4 + 2] + p[4 * g4 + 3]); float ls = p[4 * g4 + 3];
                        ms += __shfl_xor(ms, 1); ms += __shfl_xor(ms, 2); ls += __shfl_xor(ls, 1); ls += __shfl_xor(ls, 2);
                        const int n = 16 * j + 8 * half + 2 * g4 + hi;
                        if (r == 0) { atomicAdd(&impw[tokw * 129 + n], ms); atomicAdd(&impw[tokw * 129 + n + 1], ls); } }
            }
            pv_tile(st + 8192, p0, p1, o, lane);
        });
    }
    {
        unsigned un0 = 0u, un1 = 0u, un2 = 0u, un3 = 0u;
        if (need_topk) {
            for (int tk = 0; tk < 8; ++tk) {
                float v0 = impw[tk * 129 + lane], v1 = impw[tk * 129 + 64 + lane];
                v0 = (lane >= 1 && lane <= cur - 2) ? v0 : -1.0f; v1 = (lane + 64 <= cur - 2) ? v1 : -1.0f;
                unsigned m0 = 1u, m1 = 0u, m2 = 0u, m3 = 0u;
#define SETBIT(n_) do { const int n__ = (n_); const unsigned bit__ = 1u << (n__ & 31); const int w__ = n__ >> 5; if (w__ == 0) m0 |= bit__; else if (w__ == 1) m1 |= bit__; else if (w__ == 2) m2 |= bit__; else m3 |= bit__; } while (0)
                SETBIT(cur); SETBIT(cur - 1);
                for (int it = 0; it < 13; ++it) {
                    float mx = fmaxf(v0, v1);
#pragma unroll
                    for (int off = 1; off < 64; off <<= 1) mx = fmaxf(mx, __shfl_xor(mx, off));
                    const unsigned long long b0 = __ballot(v0 == mx);
                    int n;
                    if (b0) n = __ffsll((long long)b0) - 1; else { const unsigned long long b1 = __ballot(v1 == mx); n = 64 + __ffsll((long long)b1) - 1; }
                    if (lane == (n & 63)) { if (n < 64) v0 = -1.0f; else v1 = -1.0f; }
                    SETBIT(n);
                }
#undef SETBIT
                if (lane == 0) { unsigned* sm_ = selmask + (wid * 8 + tk) * 4; sm_[0] = m0; sm_[1] = m1; sm_[2] = m2; sm_[3] = m3; }
                un0 |= m0; un1 |= m1; un2 |= m2; un3 |= m3;
            }
        } else {
            const unsigned full = (cur >= 31) ? 0xffffffffu : ((2u << cur) - 1u);
            un0 = full;
            if (lane < 8) { unsigned* sm_ = selmask + (wid * 8 + lane) * 4; sm_[0] = full; sm_[1] = 0u; sm_[2] = 0u; sm_[3] = 0u; }
        }
        if (lane == 0) { wun[wid * 4] = un0; wun[wid * 4 + 1] = un1; wun[wid * 4 + 2] = un2; wun[wid * 4 + 3] = un3; }
        __syncthreads();
        if (tid == 0) { int c = 0;
            for (int w = 0; w < 4; ++w) { const unsigned u = wun[w] | wun[4 + w] | wun[8 + w] | wun[12 + w]; for (int bb = 0; bb < 32; ++bb) if ((u >> bb) & 1u) ulist[c++] = (unsigned char)(w * 32 + bb); }
            ucnt[0] = c; }
        __syncthreads();
    }
    { const float g0 = GN[0];
#pragma unroll
      for (int rr = 0; rr < 16; ++rr) { totw[rr * 64] = o[0][rr] * g0; totw[(16 + rr) * 64] = o[1][rr] * g0; } }
    {
        const bf16_t* KS = PROJ + ((size_t)((12 + g) * 2 + b)) * 8192 * 64; const bf16_t* VS = PROJ + ((size_t)((14 + g) * 2 + b)) * 8192 * 64;
        const int nu = ucnt[0];
        m = -1e30f; l = 0.f; o[0] = (f32x16){}; o[1] = (f32x16){};
        kv_pipeline(smem, nu, [&](int j, const bf16_t*& kp, const bf16_t*& vp) { const int n = ulist[j]; kp = KS + (size_t)n * 4096; vp = VS + (size_t)n * 4096; },
            [&](int j, const unsigned char* st) {
                const int n = ulist[j];
                if (!((wun[wid * 4 + (n >> 5)] >> (n & 31)) & 1u)) return;
                const bool sel = (selmask[tokl * 4 + (n >> 5)] >> (n & 31)) & 1u;
                f32x16 p0, p1; alibi_init<1>(p0, p1, slope2, 64 * n, t0, hi);
                qk_tile(st, qf, p0, p1, lane);
                if (n == cur || !__all(sel)) mask_tile<1>(p0, p1, 64 * n, -1, sel ? t : -1, hi);
                softmax_step(p0, p1, m, l, o);
                pv_tile(st + 8192, p0, p1, o, lane);
            });
        const float g1 = GN[1] / fmaxf(l, 1e-30f);
#pragma unroll
        for (int rr = 0; rr < 16; ++rr) { totw[rr * 64] += o[0][rr] * g1; totw[(16 + rr) * 64] += o[1][rr] * g1; }
    }
    {
        const bf16_t* KW = PROJ + ((size_t)((16 + g) * 2 + b)) * 8192 * 64; const bf16_t* VW = PROJ + ((size_t)((18 + g) * 2 + b)) * 8192 * 64;
        const int jlo = (t0 - 511) > 0 ? ((t0 - 511) >> 6) : 0; const int jhi = (t0 + 31) >> 6;
        m = -1e30f; l = 0.f; o[0] = (f32x16){}; o[1] = (f32x16){};
        kv_pipeline(smem, jhi - jlo + 1, [&](int j, const bf16_t*& kp, const bf16_t*& vp) { kp = KW + (size_t)(jlo + j) * 4096; vp = VW + (size_t)(jlo + j) * 4096; },
            [&](int j, const unsigned char* st) {
                const int kpos0 = 64 * (jlo + j);
                if (kpos0 > tmax_w || kpos0 + 63 < tmin_w - 511) return;
                f32x16 p0, p1; alibi_init<1>(p0, p1, slope2, kpos0, t0, hi);
                qk_tile(st, qf, p0, p1, lane);
                if (kpos0 < tmax_w - 511 || kpos0 + 63 > tmin_w) mask_tile<1>(p0, p1, kpos0, t - 511, t, hi);
                softmax_step(p0, p1, m, l, o);
                pv_tile(st + 8192, p0, p1, o, lane);
            });
        const float g2 = GN[2] / fmaxf(l, 1e-30f);
#pragma unroll
        for (int rr = 0; rr < 16; ++rr) { o[0][rr] = totw[rr * 64] + o[0][rr] * g2; o[1][rr] = totw[(16 + rr) * 64] + o[1][rr] * g2; }
    }
    {
        float ss = 0.f; bf16_t* O = (bf16_t*)(a.ws + WS_ONSA) + token * 512 + h * 64;
#pragma unroll
        for (int dh = 0; dh < 2; ++dh)
#pragma unroll
            for (int g4 = 0; g4 < 4; ++g4) { const float v0 = o[dh][4 * g4], v1 = o[dh][4 * g4 + 1], v2 = o[dh][4 * g4 + 2], v3 = o[dh][4 * g4 + 3];
                ss += v0 * v0 + v1 * v1 + v2 * v2 + v3 * v3; uint2 w; w.x = cvtpk(v0, v1); w.y = cvtpk(v2, v3); *(uint2*)(O + 32 * dh + 8 * g4 + 4 * hi) = w; }
        ss += __shfl_xor(ss, 32);
        if (hi == 0) ((float*)(a.ws + WS_SSQ))[token * 16 + h] = ss;
    }
}
#ifndef ATT_NAIVE
#define ATT_NAIVE 0
#endif
DEV void phase_att(const Args& a, unsigned char* smem) {
#if ATT_NAIVE
    for (int item = blockIdx.x; item < 512 + 512; item += gridDim.x) {
        if (item < 512) fox_naive_item(a, 511 - item);
        else { nsa_naive_item(a, smem, item - 512); __syncthreads(); }
    }
#else
    int* qctr = (int*)(a.ws + WS_CTL) + 64; int* sitem = (int*)(smem + AT_ITEM_OFF);
    for (;;) {
        if (threadIdx.x == 0) sitem[0] = atomicAdd(qctr, 1);
        __syncthreads();
        const int item = sitem[0];
        __syncthreads();
        if (item >= 2048) break;
#ifndef ATT_SKIP_FOX
        if (item < 1024) { const int qb = 63 - (item >> 4), bh = item & 15; fox_item(a, smem, bh >> 3, bh & 7, qb); }
        else
#endif
#ifndef ATT_SKIP_NSA
        { const int idx = item - 1024; const int tt = 255 - (idx >> 2), bg = idx & 3; nsa_item(a, smem, bg >> 1, bg & 1, tt); }
#else
        {}
#endif
    }
#endif
}


DEV void phase_outproj(const Args& a, unsigned char* smem) {
    const bf16_t* ONSA = (const bf16_t*)(a.ws + WS_ONSA); const bf16_t* OFOX = (const bf16_t*)(a.ws + WS_OFOX); const float* SSQ = (const float*)(a.ws + WS_SSQ);
    const bf16_t* W = (const bf16_t*)(a.ws + WS_WOUT); float* H1 = (float*)(a.ws + WS_H1); const float* X = a.in[I_X];
    const float* gnn = a.in[I_GNN]; const float* gnf = a.in[I_GNF];
    float* rs = (float*)(smem + MISC_OFF);
    const int tid = threadIdx.x, lane = tid & 63, wid = tid >> 6, wr = wid >> 1, wc = wid & 1;
    for (int item = blockIdx.x; item < 128 * 8; item += gridDim.x) {
        const int nt = item / 128, mt = item % 128;
        if (tid < 128) { const float* s = SSQ + (size_t)(mt * 128 + tid) * 16; float sn = 0.f, sf = 0.f;
#pragma unroll
            for (int j = 0; j < 8; ++j) { sn += s[j]; sf += s[8 + j]; }
            rs[tid * 2] = rsqrtf(sn * (1.f / 512.f) + EPS); rs[tid * 2 + 1] = rsqrtf(sf * (1.f / 512.f) + EPS); }
        __syncthreads();
        f32x4 acc[4][4];
        gemm_mainloop(smem, 16,
            [&](int r, int kc, int kt) { const int k0 = kt * 64 + kc * 8; const bool nsa = k0 < 512; const int kk = nsa ? k0 : k0 - 512;
                const uint4 u = *(const uint4*)((nsa ? ONSA : OFOX) + (size_t)(mt * 128 + r) * 512 + kk);
                const float* gp = (nsa ? gnn : gnf) + kk; const float4 g0 = *(const float4*)gp, g1 = *(const float4*)(gp + 4);
                const float sc = rs[r * 2 + (nsa ? 0 : 1)]; float f[8]; unpack8(u, f);
                uint4 o; o.x = cvtpk(f[0] * sc * g0.x, f[1] * sc * g0.y); o.y = cvtpk(f[2] * sc * g0.z, f[3] * sc * g0.w); o.z = cvtpk(f[4] * sc * g1.x, f[5] * sc * g1.y); o.w = cvtpk(f[6] * sc * g1.z, f[7] * sc * g1.w);
                return o; },
            [&](int k, int nc, int kt) { return *(const uint4*)(W + (size_t)(kt * 64 + k) * 1024 + nt * 128 + nc * 8); }, acc);
#pragma unroll
        for (int mi = 0; mi < 4; ++mi) { const size_t gm = mt * 128 + wr * 64 + mi * 16 + (lane & 15);
#pragma unroll
            for (int ni = 0; ni < 4; ++ni) { const int n = nt * 128 + wc * 64 + ni * 16 + 4 * (lane >> 4); const float4 x = *(const float4*)(X + gm * 1024 + n); const f32x4 v = acc[mi][ni];
                float4 o = {x.x + v[0], x.y + v[1], x.z + v[2], x.w + v[3]}; *(float4*)(H1 + gm * 1024 + n) = o; } }
        __syncthreads();
    }
}

DEV void phase_route(const Args& a, unsigned char* smem) {
    const float* H1 = (const float*)(a.ws + WS_H1); bf16_t* XN = (bf16_t*)(a.ws + WS_XN);
    const float* ln2 = a.in[I_LN2]; const float* wr_ = a.in[I_WR]; const float* br = a.in[I_BR];
    int* CNT = (int*)(a.ws + WS_CTL);
    int* TOPI = (int*)(a.ws + WS_TOPI); int* TOPS = (int*)(a.ws + WS_TOPS); float* TOPW = (float*)(a.ws + WS_TOPW);
    int* TOKOF = (int*)(a.ws + WS_TOKOF); float* ROWW = (float*)(a.ws + WS_ROWW);
    int* lcnt = (int*)smem; int* lbase = lcnt + 32; int* te = lbase + 32; int* trk = te + 256; float* tw = (float*)(trk + 256);
    const int tid = threadIdx.x, lane = tid & 63, wid = tid >> 6;
    for (int item = blockIdx.x; item < 256; item += gridDim.x) {
        if (tid < 32) lcnt[tid] = 0;
        __syncthreads();
        for (int i = 0; i < 16; ++i) {
            const int tok = item * 64 + wid * 16 + i;
            float xv[16]; float s = 0.f;
#pragma unroll
            for (int j = 0; j < 4; ++j) { const float4 v = *(const float4*)(H1 + (size_t)tok * 1024 + j * 256 + lane * 4); xv[4 * j] = v.x; xv[4 * j + 1] = v.y; xv[4 * j + 2] = v.z; xv[4 * j + 3] = v.w; s += v.x * v.x + v.y * v.y + v.z * v.z + v.w * v.w; }
            const float rstd = rsqrtf(wave_sum(s) * (1.f / 1024.f) + EPS);
#pragma unroll
            for (int j = 0; j < 4; ++j) { const float4 gg = *(const float4*)(ln2 + j * 256 + lane * 4);
                xv[4 * j] *= rstd * gg.x; xv[4 * j + 1] *= rstd * gg.y; xv[4 * j + 2] *= rstd * gg.z; xv[4 * j + 3] *= rstd * gg.w;
                uint2 o; o.x = cvtpk(xv[4 * j], xv[4 * j + 1]); o.y = cvtpk(xv[4 * j + 2], xv[4 * j + 3]); *(uint2*)(XN + (size_t)tok * 1024 + j * 256 + lane * 4) = o; }
            float lg[32];
#pragma unroll
            for (int e = 0; e < 32; ++e) lg[e] = 0.f;
#pragma unroll
            for (int j = 0; j < 4; ++j)
#pragma unroll
                for (int c = 0; c < 4; ++c) { const float* wrow = wr_ + (size_t)(j * 256 + lane * 4 + c) * 32; const float x = xv[4 * j + c];
#pragma unroll
                    for (int e4 = 0; e4 < 8; ++e4) { const float4 w = *(const float4*)(wrow + e4 * 4); lg[e4 * 4] += x * w.x; lg[e4 * 4 + 1] += x * w.y; lg[e4 * 4 + 2] += x * w.z; lg[e4 * 4 + 3] += x * w.w; } }
#pragma unroll
            for (int e = 0; e < 32; ++e) lg[e] = wave_sum(lg[e]) + br[e];
            unsigned taken = 0u; float tv[4]; int ti[4];
#pragma unroll
            for (int k = 0; k < 4; ++k) { float best = -3.0e38f; int bi = 0;
#pragma unroll
                for (int e = 0; e < 32; ++e) { const bool ok = !((taken >> e) & 1u) && lg[e] > best; best = ok ? lg[e] : best; bi = ok ? e : bi; }
                taken |= 1u << bi; tv[k] = best; ti[k] = bi; }
            const float e1 = __expf(tv[1] - tv[0]), e2 = __expf(tv[2] - tv[0]), e3 = __expf(tv[3] - tv[0]); const float inv = 1.0f / (1.0f + e1 + e2 + e3);
            const float wv[4] = {inv, e1 * inv, e2 * inv, e3 * inv};
            if (lane == 0) {
#pragma unroll
                for (int k = 0; k < 4; ++k) { const int idx = (wid * 16 + i) * 4 + k; te[idx] = ti[k]; trk[idx] = atomicAdd(&lcnt[ti[k]], 1); tw[idx] = wv[k]; }
            }
        }
        __syncthreads();
        if (tid < 32) lbase[tid] = atomicAdd(&CNT[tid], lcnt[tid]);
        __syncthreads();
        { const int idx = tid; const int tok = item * 64 + (idx >> 2); const int e = te[idx]; const int slot = lbase[e] + trk[idx];
          TOPI[(size_t)tok * 4 + (idx & 3)] = e; TOPS[(size_t)tok * 4 + (idx & 3)] = slot; TOPW[(size_t)tok * 4 + (idx & 3)] = tw[idx];
          TOKOF[(size_t)e * 16384 + slot] = tok; ROWW[(size_t)e * 16384 + slot] = tw[idx]; }
        __syncthreads();
    }
}

struct MoeMap { int e, mt, nt, cnt, off; };
DEV void moe_setup(const Args& a, int* sm) {
    if (threadIdx.x == 0) { const int* CNT = (const int*)(a.ws + WS_CTL); int tot = 0; for (int e = 0; e < 32; ++e) { const int c = CNT[e]; const int mt = (c + 127) >> 7; sm[e] = mt; sm[32 + e] = tot; tot += mt; } sm[64] = tot; }
    __syncthreads();
}
DEV MoeMap moe_map(const Args& a, const int* sm, int item, int NT) {
    MoeMap mm; int e = 0;
    for (int i = 1; i < 32; ++i) if (item >= sm[32 + i] * NT) e = i;
    const int local = item - sm[32 + e] * NT; const int mte = sm[e];
    mm.e = e; mm.nt = local / mte; mm.mt = local % mte; mm.cnt = ((const int*)(a.ws + WS_CTL))[e]; mm.off = sm[32 + e] * 128; return mm;
}
DEV void phase_up(const Args& a, unsigned char* smem) {
    int* sm = (int*)(smem + MISC_OFF); int* tok = sm + 128;
    const bf16_t* XN = (const bf16_t*)(a.ws + WS_XN); const bf16_t* W = (const bf16_t*)(a.ws + WS_WUP); bf16_t* ACT = (bf16_t*)(a.ws + WS_ACT);
    const int* TOKOF = (const int*)(a.ws + WS_TOKOF); const float* bup = a.in[I_BUP];
    const int tid = threadIdx.x, lane = tid & 63, wid = tid >> 6, wr = wid >> 1, wc = wid & 1;
    moe_setup(a, sm);
    const int nitems = sm[64] * 16;
    for (int item = blockIdx.x; item < nitems; item += gridDim.x) {
        const MoeMap mm = moe_map(a, sm, item, 16);
        if (tid < 128) { const int slot = mm.mt * 128 + tid; tok[tid] = slot < mm.cnt ? TOKOF[(size_t)mm.e * 16384 + slot] : 0; }
        __syncthreads();
        const bf16_t* We = W + (size_t)mm.e * 1024 * 2048;
        f32x4 acc[4][4];
        gemm_mainloop(smem, 16,
            [&](int r, int kc, int kt) { return *(const uint4*)(XN + (size_t)tok[r] * 1024 + kt * 64 + kc * 8); },
            [&](int k, int nc, int kt) { const int ni = (nc >> 1) & 3; const int sc = ((ni >> 1) ? 1024 : 0) + mm.nt * 64 + (nc >> 3) * 32 + (ni & 1) * 16 + (nc & 1) * 8;
                return *(const uint4*)(We + (size_t)(kt * 64 + k) * 2048 + sc); }, acc);
#pragma unroll
        for (int mi = 0; mi < 4; ++mi) { const size_t row = (size_t)mm.off + mm.mt * 128 + wr * 64 + mi * 16 + (lane & 15);
#pragma unroll
            for (int ni = 0; ni < 2; ++ni) { const int jc = mm.nt * 64 + wc * 32 + ni * 16 + 4 * (lane >> 4);
                const float4 bg = *(const float4*)(bup + (size_t)mm.e * 2048 + jc), bl_ = *(const float4*)(bup + (size_t)mm.e * 2048 + 1024 + jc);
                const f32x4 gv = acc[mi][ni], lv = acc[mi][ni + 2]; const float bgv[4] = {bg.x, bg.y, bg.z, bg.w}, blv[4] = {bl_.x, bl_.y, bl_.z, bl_.w}; float r4[4];
#pragma unroll
                for (int r = 0; r < 4; ++r) { const float gg = fminf(gv[r] + bgv[r], 7.0f); const float ll = fminf(fmaxf(lv[r] + blv[r], -7.0f), 7.0f); r4[r] = gg * sigmoidf_(1.702f * gg) * (ll + 1.0f); }
                uint2 o; o.x = cvtpk(r4[0], r4[1]); o.y = cvtpk(r4[2], r4[3]); *(uint2*)(ACT + row * 1024 + jc) = o; } }
        __syncthreads();
    }
}
DEV void phase_down(const Args& a, unsigned char* smem) {
    int* sm = (int*)(smem + MISC_OFF); float* rw = (float*)(sm + 128);
    const bf16_t* ACT = (const bf16_t*)(a.ws + WS_ACT); const bf16_t* W = (const bf16_t*)(a.ws + WS_WDN); bf16_t* Y = (bf16_t*)(a.ws + WS_Y);
    const float* ROWW = (const float*)(a.ws + WS_ROWW); const float* bdn = a.in[I_BDN];
    const int tid = threadIdx.x, lane = tid & 63, wid = tid >> 6, wr = wid >> 1, wc = wid & 1;
    moe_setup(a, sm);
    const int nitems = sm[64] * 8;
    for (int item = blockIdx.x; item < nitems; item += gridDim.x) {
        const MoeMap mm = moe_map(a, sm, item, 8);
        if (tid < 128) { const int slot = mm.mt * 128 + tid; rw[tid] = slot < mm.cnt ? ROWW[(size_t)mm.e * 16384 + slot] : 0.f; }
        __syncthreads();
        const bf16_t* We = W + (size_t)mm.e * 1024 * 1024; const bf16_t* Ab = ACT + ((size_t)mm.off + mm.mt * 128) * 1024;
        f32x4 acc[4][4];
        gemm_mainloop(smem, 16,
            [&](int r, int kc, int kt) { return *(const uint4*)(Ab + (size_t)r * 1024 + kt * 64 + kc * 8); },
            [&](int k, int nc, int kt) { return *(const uint4*)(We + (size_t)(kt * 64 + k) * 1024 + mm.nt * 128 + nc * 8); }, acc);
#pragma unroll
        for (int mi = 0; mi < 4; ++mi) { const int rl = wr * 64 + mi * 16 + (lane & 15); const size_t row = (size_t)mm.off + mm.mt * 128 + rl; const float w = rw[rl];
#pragma unroll
            for (int ni = 0; ni < 4; ++ni) { const int n = mm.nt * 128 + wc * 64 + ni * 16 + 4 * (lane >> 4); const float4 bb = *(const float4*)(bdn + (size_t)mm.e * 1024 + n); const f32x4 v = acc[mi][ni];
                uint2 o; o.x = cvtpk((v[0] + bb.x) * w, (v[1] + bb.y) * w); o.y = cvtpk((v[2] + bb.z) * w, (v[3] + bb.w) * w); *(uint2*)(Y + row * 1024 + n) = o; } }
        __syncthreads();
    }
}

DEV void phase_comb(const Args& a, unsigned char* smem) {
    int* sm = (int*)(smem + MISC_OFF);
    moe_setup(a, sm);
    float* H1 = (float*)(a.ws + WS_H1); bf16_t* XN = (bf16_t*)(a.ws + WS_XN); const bf16_t* Y = (const bf16_t*)(a.ws + WS_Y);
    const int* TOPI = (const int*)(a.ws + WS_TOPI); const int* TOPS = (const int*)(a.ws + WS_TOPS); const float* g = a.in[I_LNPLE];
    const int lane = threadIdx.x & 63; const int gw = blockIdx.x * 4 + (threadIdx.x >> 6), ngw = gridDim.x * 4;
    for (int tok = gw; tok < NTOK; tok += ngw) {
        float4 v[4];
#pragma unroll
        for (int j = 0; j < 4; ++j) v[j] = *(const float4*)(H1 + (size_t)tok * 1024 + j * 256 + lane * 4);
#pragma unroll
        for (int k = 0; k < 4; ++k) { const int e = TOPI[(size_t)tok * 4 + k]; const size_t row = (size_t)sm[32 + e] * 128 + TOPS[(size_t)tok * 4 + k];
#pragma unroll
            for (int j = 0; j < 4; ++j) { const uint2 u = *(const uint2*)(Y + row * 1024 + j * 256 + lane * 4); v[j].x += bflo(u.x); v[j].y += bfhi(u.x); v[j].z += bflo(u.y); v[j].w += bfhi(u.y); } }
        float s = 0.f;
#pragma unroll
        for (int j = 0; j < 4; ++j) { *(float4*)(H1 + (size_t)tok * 1024 + j * 256 + lane * 4) = v[j]; s += v[j].x * v[j].x + v[j].y * v[j].y + v[j].z * v[j].z + v[j].w * v[j].w; }
        const float rstd = rsqrtf(wave_sum(s) * (1.f / 1024.f) + EPS);
#pragma unroll
        for (int j = 0; j < 4; ++j) { const float4 gg = *(const float4*)(g + j * 256 + lane * 4);
            uint2 o; o.x = cvtpk(v[j].x * rstd * gg.x, v[j].y * rstd * gg.y); o.y = cvtpk(v[j].z * rstd * gg.z, v[j].w * rstd * gg.w); *(uint2*)(XN + (size_t)tok * 1024 + j * 256 + lane * 4) = o; }
    }
}

DEV void phase_gate(const Args& a, unsigned char* smem) {
    const bf16_t* XN = (const bf16_t*)(a.ws + WS_XN); const bf16_t* WG = (const bf16_t*)(a.ws + WS_WGATE); const bf16_t* PB = (const bf16_t*)(a.ws + WS_PB); const bf16_t* WP = (const bf16_t*)(a.ws + WS_WPLE);
    const float* H2 = (const float*)(a.ws + WS_H1); float* OUT = a.out; float* SSQ3 = (float*)(a.ws + WS_SSQ3);
    const int tid = threadIdx.x, lane = tid & 63, wid = tid >> 6, wr = wid >> 1, wc = wid & 1;
    for (int item = blockIdx.x; item < 128 * 8; item += gridDim.x) {
        const int nt = item / 128, mt = item % 128;
        f32x4 acc[4][4];
        gemm_mainloop(smem, 16,
            [&](int r, int kc, int kt) { return *(const uint4*)(XN + (size_t)(mt * 128 + r) * 1024 + kt * 64 + kc * 8); },
            [&](int k, int nc, int kt) { return *(const uint4*)(WG + (size_t)(kt * 64 + k) * 1024 + nt * 128 + nc * 8); }, acc);
#pragma unroll
        for (int mi = 0; mi < 4; ++mi) { const size_t gm = mt * 128 + wr * 64 + mi * 16 + (lane & 15);
#pragma unroll
            for (int ni = 0; ni < 4; ++ni) { const int n = nt * 128 + wc * 64 + ni * 16 + 4 * (lane >> 4); const f32x4 v = acc[mi][ni];
                float4 o = {sigmoidf_(v[0]), sigmoidf_(v[1]), sigmoidf_(v[2]), sigmoidf_(v[3])}; *(float4*)(OUT + gm * 1024 + n) = o; } }
        gemm_mainloop(smem, 4,
            [&](int r, int kc, int kt) { return *(const uint4*)(PB + (size_t)(mt * 128 + r) * 256 + kt * 64 + kc * 8); },
            [&](int k, int nc, int kt) { return *(const uint4*)(WP + (size_t)(kt * 64 + k) * 1024 + nt * 128 + nc * 8); }, acc);
#pragma unroll
        for (int mi = 0; mi < 4; ++mi) { const size_t gm = mt * 128 + wr * 64 + mi * 16 + (lane & 15); float ss = 0.f;
#pragma unroll
            for (int ni = 0; ni < 4; ++ni) { const int n = nt * 128 + wc * 64 + ni * 16 + 4 * (lane >> 4); const f32x4 v = acc[mi][ni];
                const float4 gt = *(const float4*)(OUT + gm * 1024 + n); const float4 h = *(const float4*)(H2 + gm * 1024 + n);
                float4 o = {h.x + v[0] * gt.x, h.y + v[1] * gt.y, h.z + v[2] * gt.z, h.w + v[3] * gt.w}; *(float4*)(OUT + gm * 1024 + n) = o;
                ss += o.x * o.x + o.y * o.y + o.z * o.z + o.w * o.w; }
            ss += __shfl_xor(ss, 16); ss += __shfl_xor(ss, 32);
            if (lane < 16) SSQ3[gm * 16 + nt * 2 + wc] = ss; }
        __syncthreads();
    }
}

DEV void phase_final(const Args& a) {
    float* OUT = a.out; const float* SSQ3 = (const float*)(a.ws + WS_SSQ3); const float* g = a.in[I_LNF];
    const int lane = threadIdx.x & 63; const int gw = blockIdx.x * 4 + (threadIdx.x >> 6), ngw = gridDim.x * 4;
    for (int m = gw; m < NTOK; m += ngw) {
        float s = 0.f;
#pragma unroll
        for (int j = 0; j < 16; ++j) s += SSQ3[(size_t)m * 16 + j];
        const float rstd = rsqrtf(s * (1.f / 1024.f) + EPS);
#pragma unroll
        for (int j = 0; j < 4; ++j) { float4 v = *(const float4*)(OUT + (size_t)m * 1024 + j * 256 + lane * 4); const float4 gg = *(const float4*)(g + j * 256 + lane * 4);
            v.x *= rstd * gg.x; v.y *= rstd * gg.y; v.z *= rstd * gg.z; v.w *= rstd * gg.w; *(float4*)(OUT + (size_t)m * 1024 + j * 256 + lane * 4) = v; }
    }
}

namespace cg = cooperative_groups;
template <int PH> DEV void run_phase(const Args& a, unsigned char* smem) {
    if constexpr (PH == PH_PRO) phase_prologue(a, smem);
    else if constexpr (PH == PH_INPROJ) phase_inproj(a, smem);
    else if constexpr (PH == PH_CMP) phase_cmp(a, smem);
    else if constexpr (PH == PH_ATT) phase_att(a, smem);
    else if constexpr (PH == PH_OUTPROJ) phase_outproj(a, smem);
    else if constexpr (PH == PH_ROUTE) phase_route(a, smem);
    else if constexpr (PH == PH_UP) phase_up(a, smem);
    else if constexpr (PH == PH_DOWN) phase_down(a, smem);
    else if constexpr (PH == PH_COMB) phase_comb(a, smem);
    else if constexpr (PH == PH_GATE) phase_gate(a, smem);
    else if constexpr (PH == PH_FINAL) phase_final(a);
}
__global__ void __launch_bounds__(256, 2) mega(Args a) {
    extern __shared__ __attribute__((aligned(16))) unsigned char smem[];
    cg::grid_group grid = cg::this_grid();
    run_phase<PH_PRO>(a, smem); grid.sync();
    run_phase<PH_INPROJ>(a, smem); grid.sync();
    run_phase<PH_CMP>(a, smem); grid.sync();
    run_phase<PH_ATT>(a, smem); grid.sync();
    run_phase<PH_OUTPROJ>(a, smem); grid.sync();
    run_phase<PH_ROUTE>(a, smem); grid.sync();
    run_phase<PH_UP>(a, smem); grid.sync();
    run_phase<PH_DOWN>(a, smem); grid.sync();
    run_phase<PH_COMB>(a, smem); grid.sync();
    run_phase<PH_GATE>(a, smem); grid.sync();
    run_phase<PH_FINAL>(a, smem);
}

extern "C" void kernel_launch(void* const* d_in, const int* in_sizes, int n_in, void* d_out, int out_size, void* d_ws, size_t ws_size, hipStream_t stream) {
    static int grid = 0;
    if (grid == 0) {
        if (n_in != 25 || ws_size < WS_END) { fprintf(stderr, "kernel_launch: unexpected n_in %d / ws %zu\n", n_in, ws_size); grid = -1; return; }
        int dev = 0, cus = 0, per_cu = 0;
        (void)hipGetDevice(&dev); (void)hipDeviceGetAttribute(&cus, hipDeviceAttributeMultiprocessorCount, dev);
        (void)hipFuncSetAttribute((const void*)mega, hipFuncAttributeMaxDynamicSharedMemorySize, LDS_BYTES);
        (void)hipOccupancyMaxActiveBlocksPerMultiprocessor(&per_cu, (const void*)mega, 256, LDS_BYTES);
        if (per_cu < 1) { fprintf(stderr, "kernel_launch: occupancy query says %d blocks per CU\n", per_cu); grid = -1; return; }
        if (per_cu > 2) per_cu = 2;
        grid = cus * per_cu;
    }
    if (grid < 0) return;
    (void)hipMemsetAsync((char*)d_ws + WS_CTL, 0, 4096, stream);
    Args a{};
    for (int i = 0; i < 25; ++i) a.in[i] = (const float*)d_in[i];
    a.out = (float*)d_out; a.ws = (unsigned char*)d_ws; a.ph_lo = 0; a.ph_hi = PH_N;
    void* args[] = {&a};
    hipError_t e = hipLaunchCooperativeKernel((const void*)mega, dim3(grid), dim3(256), args, LDS_BYTES, stream);
    if (e != hipSuccess) fprintf(stderr, "cooperative launch failed: %s (grid %d)\n", hipGetErrorString(e), grid);
}
```

```cpp
#include <hip/hip_runtime.h>
#include <hip/hip_cooperative_groups.h>
#include <stdint.h>
#include <cstdio>

#define DEV __device__ __forceinline__
#define LAS __attribute__((address_space(3)))

typedef unsigned short bf16_t;
typedef short bf16x8 __attribute__((ext_vector_type(8)));
typedef short s16x4 __attribute__((ext_vector_type(4)));
typedef float f32x4 __attribute__((ext_vector_type(4)));
typedef float f32x2_t __attribute__((ext_vector_type(2)));
typedef __bf16 bf16x2_t __attribute__((ext_vector_type(2)));

#ifndef GEMM_EMU
#define GEMM_EMU 0
#endif

constexpr int T_ = 8192, NTOK = 16384;
constexpr float EPS = 1e-6f;
constexpr float LOG2E = 1.4426950408889634f;
constexpr float QS = 0.125f * LOG2E;
constexpr int NWIN = 2944;

constexpr size_t MiB = 1u << 20;
constexpr size_t WS_CTL = 0;
constexpr size_t WS_WIN = 1 * MiB;
constexpr size_t WS_WOUT = 7 * MiB;
constexpr size_t WS_WGATE = 9 * MiB;
constexpr size_t WS_WPLE = 11 * MiB;
constexpr size_t WS_WC1 = 12 * MiB;
constexpr size_t WS_WC2 = 13 * MiB;
constexpr size_t WS_BIAS1 = 13 * MiB + 65536;
constexpr size_t WS_KC = 14 * MiB;
constexpr size_t WS_HID = 15 * MiB;
constexpr size_t WS_GN = 16 * MiB;
constexpr size_t WS_LS = 18 * MiB;
constexpr size_t WS_CUM = 19 * MiB;
constexpr size_t WS_SSQ = 20 * MiB;
constexpr size_t WS_TOPI = 21 * MiB;
constexpr size_t WS_TOPS = 21 * MiB + 262144;
constexpr size_t WS_TOPW = 21 * MiB + 524288;
constexpr size_t WS_TOKOF = 22 * MiB;
constexpr size_t WS_ROWW = 24 * MiB;
constexpr size_t WS_SSQ3 = 26 * MiB;
constexpr size_t WS_PB = 28 * MiB;
constexpr size_t WS_XN = 36 * MiB;
constexpr size_t WS_PROJ = 68 * MiB;
constexpr size_t WS_ONSA = 160 * MiB;
constexpr size_t WS_OFOX = 176 * MiB;
constexpr size_t WS_H1 = 192 * MiB;
constexpr size_t WS_WUP = 256 * MiB;
constexpr size_t WS_WDN = 384 * MiB;
constexpr size_t WS_ACT = 448 * MiB;
constexpr size_t WS_Y = 584 * MiB;
constexpr size_t WS_END = 720 * MiB;

enum { PH_PRO = 0, PH_INPROJ, PH_CMP, PH_ATT, PH_OUTPROJ, PH_ROUTE, PH_UP, PH_DOWN, PH_COMB, PH_GATE, PH_FINAL, PH_N };

struct Args { const float* in[25]; float* out; unsigned char* ws; int ph_lo, ph_hi; };
enum { I_X = 0, I_P, I_LN1, I_WIN, I_BFG, I_WC1K, I_WC2K, I_PEK, I_WC1V, I_WC2V, I_PEV, I_GNN, I_GNF, I_WOUT, I_LN2, I_WR, I_BR,
       I_WUP, I_BUP, I_WDN, I_BDN, I_LNPLE, I_WPLE, I_WGATE, I_LNF };

DEV unsigned cvtpk(float lo, float hi) { f32x2_t v = {lo, hi}; bf16x2_t b = __builtin_convertvector(v, bf16x2_t); return __builtin_bit_cast(unsigned, b); }
DEV float bf2f(unsigned short b) { return __uint_as_float(((unsigned)b) << 16); }
DEV float bflo(unsigned u) { return __uint_as_float(u << 16); }
DEV float bfhi(unsigned u) { return __uint_as_float(u & 0xffff0000u); }
DEV void unpack8(const uint4& u, float* f) { f[0] = bflo(u.x); f[1] = bfhi(u.x); f[2] = bflo(u.y); f[3] = bfhi(u.y); f[4] = bflo(u.z); f[5] = bfhi(u.z); f[6] = bflo(u.w); f[7] = bfhi(u.w); }
DEV float wave_sum(float v) {
#pragma unroll
    for (int o = 1; o < 64; o <<= 1) v += __shfl_xor(v, o);
    return v;
}
DEV float sigmoidf_(float x) { return 1.0f / (1.0f + __expf(-x)); }
DEV float logsigmoidf_(float x) { return fminf(x, 0.f) - log1pf(__expf(-fabsf(x))); }
DEV float gelu_tanh(float x) { const float u = 0.7978845608028654f * (x + 0.044715f * x * x * x); const float th = 1.0f - 2.0f / (__expf(2.0f * u) + 1.0f); return 0.5f * x * (1.0f + th); }

constexpr int GA_BYTES = 128 * 128;
constexpr int GB_STRIDE = 288;
constexpr int GB_BYTES = 64 * GB_STRIDE;
constexpr int GSTAGE = GA_BYTES + GB_BYTES;
constexpr int GEMM_LDS = 2 * GSTAGE;
constexpr int MISC_OFF = GEMM_LDS;
constexpr int LDS_BYTES = GEMM_LDS + 4096;

DEV s16x4 tr_read(const unsigned char* p) {
    typedef short v4i16_t __attribute__((ext_vector_type(4)));
    return __builtin_bit_cast(s16x4, __builtin_amdgcn_ds_read_tr16_b64_v4i16((LAS v4i16_t*)p));
}

template <class AL, class BL>
DEV void gemm_mainloop(unsigned char* smem, int nkt, const AL& al, const BL& bl, f32x4 (&acc)[4][4]) {
    const int tid = threadIdx.x, lane = tid & 63, wid = tid >> 6, wr = wid >> 1, wc = wid & 1;
    uint4 ra[4], rb[4];
#pragma unroll
    for (int mi = 0; mi < 4; ++mi)
#pragma unroll
        for (int ni = 0; ni < 4; ++ni) acc[mi][ni] = (f32x4){0.f, 0.f, 0.f, 0.f};
#define G_LOAD(kt) do { _Pragma("unroll") for (int i_ = 0; i_ < 4; ++i_) { const int id_ = tid + 256 * i_; ra[i_] = al(id_ >> 3, id_ & 7, (kt)); } \
                        _Pragma("unroll") for (int i_ = 0; i_ < 4; ++i_) { const int id_ = tid + 256 * i_; rb[i_] = bl(id_ >> 4, id_ & 15, (kt)); } } while (0)
#define G_STORE(st) do { unsigned char* A_ = smem + (st) * GSTAGE; unsigned char* B_ = A_ + GA_BYTES; \
        _Pragma("unroll") for (int i_ = 0; i_ < 4; ++i_) { const int id_ = tid + 256 * i_; const int r_ = id_ >> 3, kc_ = id_ & 7; *(uint4*)(A_ + r_ * 128 + ((kc_ ^ (r_ & 7)) << 4)) = ra[i_]; } \
        _Pragma("unroll") for (int i_ = 0; i_ < 4; ++i_) { const int id_ = tid + 256 * i_; const int k_ = id_ >> 4, nc_ = id_ & 15; *(uint4*)(B_ + k_ * GB_STRIDE + nc_ * 16) = rb[i_]; } } while (0)
    G_LOAD(0); G_STORE(0); __syncthreads();
    for (int kt = 0; kt < nkt; ++kt) {
        const bool more = (kt + 1 < nkt);
        if (more) G_LOAD(kt + 1);
        const unsigned char* A = smem + (kt & 1) * GSTAGE; const unsigned char* Bt = A + GA_BYTES;
#if GEMM_EMU
        for (int k = 0; k < 64; ++k) {
            float av[4], bv[4][4];
#pragma unroll
            for (int mi = 0; mi < 4; ++mi) { const int m = wr * 64 + mi * 16 + (lane & 15); av[mi] = bf2f(*(const bf16_t*)(A + m * 128 + (((k >> 3) ^ (m & 7)) << 4) + (k & 7) * 2)); }
#pragma unroll
            for (int ni = 0; ni < 4; ++ni)
#pragma unroll
                for (int r = 0; r < 4; ++r) { const int n = wc * 64 + ni * 16 + 4 * (lane >> 4) + r; bv[ni][r] = bf2f(*(const bf16_t*)(Bt + k * GB_STRIDE + n * 2)); }
#pragma unroll
            for (int mi = 0; mi < 4; ++mi)
#pragma unroll
                for (int ni = 0; ni < 4; ++ni)
#pragma unroll
                    for (int r = 0; r < 4; ++r) acc[mi][ni][r] += av[mi] * bv[ni][r];
        }
#else
#pragma unroll
        for (int ks = 0; ks < 2; ++ks) {
            bf16x8 af[4], wf[4];
#pragma unroll
            for (int mi = 0; mi < 4; ++mi) { const int m = wr * 64 + mi * 16 + (lane & 15); const int kc = ks * 4 + (lane >> 4); af[mi] = *(const bf16x8*)(A + m * 128 + ((kc ^ (m & 7)) << 4)); }
#pragma unroll
            for (int ni = 0; ni < 4; ++ni) {
                const int i = lane & 15; const int row = ks * 32 + 8 * (lane >> 4) + (i >> 2); const int col = wc * 64 + ni * 16 + 4 * (i & 3);
                const unsigned char* p = Bt + row * GB_STRIDE + col * 2;
                const s16x4 lo = tr_read(p), hi = tr_read(p + 4 * GB_STRIDE);
                wf[ni] = (bf16x8){lo[0], lo[1], lo[2], lo[3], hi[0], hi[1], hi[2], hi[3]};
            }
#pragma unroll
            for (int mi = 0; mi < 4; ++mi)
#pragma unroll
                for (int ni = 0; ni < 4; ++ni) acc[mi][ni] = __builtin_amdgcn_mfma_f32_16x16x32_bf16(wf[ni], af[mi], acc[mi][ni], 0, 0, 0);
        }
#endif
        if (more) G_STORE((kt + 1) & 1);
        __syncthreads();
    }
#undef G_LOAD
#undef G_STORE
}

DEV void convert_chunk(const float* src, bf16_t* dst, size_t i8) {
    const float4 a = *(const float4*)(src + i8 * 8), b = *(const float4*)(src + i8 * 8 + 4);
    uint4 o; o.x = cvtpk(a.x, a.y); o.y = cvtpk(a.z, a.w); o.z = cvtpk(b.x, b.y); o.w = cvtpk(b.z, b.w);
    *(uint4*)(dst + i8 * 8) = o;
}
DEV void phase_prologue(const Args& a, unsigned char* smem) {
    unsigned char* ws = a.ws;
    const size_t gtid = (size_t)blockIdx.x * 256 + threadIdx.x, gn = (size_t)gridDim.x * 256;
    {
        const float* srcs[10] = {a.in[I_WUP], a.in[I_WDN], a.in[I_WOUT], a.in[I_WGATE], a.in[I_WPLE], a.in[I_WC1K], a.in[I_WC1V], a.in[I_WC2K], a.in[I_WC2V], a.in[I_P]};
        bf16_t* dsts[10] = {(bf16_t*)(ws + WS_WUP), (bf16_t*)(ws + WS_WDN), (bf16_t*)(ws + WS_WOUT), (bf16_t*)(ws + WS_WGATE), (bf16_t*)(ws + WS_WPLE),
                            (bf16_t*)(ws + WS_WC1), (bf16_t*)(ws + WS_WC1) + 2048 * 128, (bf16_t*)(ws + WS_WC2), (bf16_t*)(ws + WS_WC2) + 128 * 64, (bf16_t*)(ws + WS_PB)};
        const size_t cnt8[10] = {(size_t)32 * 1024 * 2048 / 8, (size_t)32 * 1024 * 1024 / 8, 1024 * 1024 / 8, 1024 * 1024 / 8, 256 * 1024 / 8, 2048 * 128 / 8, 2048 * 128 / 8, 128 * 64 / 8, 128 * 64 / 8, (size_t)NTOK * 256 / 8};
#pragma unroll
        for (int s = 0; s < 10; ++s) for (size_t i = gtid; i < cnt8[s]; i += gn) convert_chunk(srcs[s], dsts[s], i);
    }
    {
        const float* W = a.in[I_WIN]; bf16_t* O = (bf16_t*)(ws + WS_WIN);
        for (size_t i = gtid; i < (size_t)1024 * (NWIN / 8); i += gn) {
            const int k = (int)(i / (NWIN / 8)), j = (int)(i % (NWIN / 8)) * 8;
            uint4 o = {0u, 0u, 0u, 0u};
            if (j < 2848) {
                const int sj = (j < 1280) ? j : (j < 2816) ? j + 24 : (j < 2840) ? j - 1536 : j;
                const float4 x = *(const float4*)(W + (size_t)k * 2848 + sj), y = *(const float4*)(W + (size_t)k * 2848 + sj + 4);
                o.x = cvtpk(x.x, x.y); o.y = cvtpk(x.z, x.w); o.z = cvtpk(y.x, y.y); o.w = cvtpk(y.z, y.w);
            }
            *(uint4*)(O + (size_t)k * NWIN + j) = o;
        }
    }
    {
        const int lane = threadIdx.x & 63; const int gw = blockIdx.x * 4 + (threadIdx.x >> 6), ngw = gridDim.x * 4;
        const float* X = a.in[I_X]; const float* g = a.in[I_LN1]; bf16_t* XN = (bf16_t*)(ws + WS_XN);
        for (int m = gw; m < NTOK; m += ngw) {
            float4 v[4]; float s = 0.f;
#pragma unroll
            for (int j = 0; j < 4; ++j) { v[j] = *(const float4*)(X + (size_t)m * 1024 + j * 256 + lane * 4); s += v[j].x * v[j].x + v[j].y * v[j].y + v[j].z * v[j].z + v[j].w * v[j].w; }
            const float rstd = rsqrtf(wave_sum(s) * (1.f / 1024.f) + EPS);
#pragma unroll
            for (int j = 0; j < 4; ++j) { const float4 gg = *(const float4*)(g + j * 256 + lane * 4);
                uint2 o; o.x = cvtpk(v[j].x * rstd * gg.x, v[j].y * rstd * gg.y); o.y = cvtpk(v[j].z * rstd * gg.z, v[j].w * rstd * gg.w);
                *(uint2*)(XN + (size_t)m * 1024 + j * 256 + lane * 4) = o; }
        }
    }
    if (blockIdx.x < 2) {
        const int which = blockIdx.x; const float* pe = a.in[which ? I_PEV : I_PEK]; const float* w1 = a.in[which ? I_WC1V : I_WC1K];
        float* red = (float*)smem; const int n = threadIdx.x & 127, half = threadIdx.x >> 7;
        float s = 0.f;
        for (int k = half * 1024; k < half * 1024 + 1024; ++k) s += pe[k] * w1[(size_t)k * 128 + n];
        red[threadIdx.x] = s; __syncthreads();
        if (threadIdx.x < 128) ((float*)(ws + WS_BIAS1))[which * 128 + n] = red[n] + red[n + 128];
        __syncthreads();
    }
}

DEV void phase_inproj(const Args& a, unsigned char* smem) {
    const bf16_t* XN = (const bf16_t*)(a.ws + WS_XN); const bf16_t* W = (const bf16_t*)(a.ws + WS_WIN);
    bf16_t* PROJ = (bf16_t*)(a.ws + WS_PROJ); float* GN = (float*)(a.ws + WS_GN); float* LS = (float*)(a.ws + WS_LS); const float* bfg = a.in[I_BFG];
    const int lane = threadIdx.x & 63, wid = threadIdx.x >> 6, wr = wid >> 1, wc = wid & 1;
    for (int item = blockIdx.x; item < 128 * 23; item += gridDim.x) {
        const int nt = item / 128, mt = item % 128;
        f32x4 acc[4][4];
        gemm_mainloop(smem, 16,
            [&](int r, int kc, int kt) { return *(const uint4*)(XN + (size_t)(mt * 128 + r) * 1024 + kt * 64 + kc * 8); },
            [&](int k, int nc, int kt) { return *(const uint4*)(W + (size_t)(kt * 64 + k) * NWIN + nt * 128 + nc * 8); }, acc);
#pragma unroll
        for (int mi = 0; mi < 4; ++mi) {
            const int gm = mt * 128 + wr * 64 + mi * 16 + (lane & 15); const int b = gm >> 13, t = gm & 8191;
#pragma unroll
            for (int ni = 0; ni < 4; ++ni) {
                const int n = wc * 64 + ni * 16 + 4 * (lane >> 4); const f32x4 v = acc[mi][ni];
                if (nt < 22) {
                    const int hs = nt * 2 + (n >> 6), d = n & 63; const float sc = (hs < 8 || (hs >= 20 && hs < 28)) ? QS : 1.0f;
                    uint2 o; o.x = cvtpk(v[0] * sc, v[1] * sc); o.y = cvtpk(v[2] * sc, v[3] * sc);
                    *(uint2*)(PROJ + (((size_t)(hs * 2 + b)) * 8192 + t) * 64 + d) = o;
                } else if (n < 24) {
#pragma unroll
                    for (int r = 0; r < 4; ++r) GN[(size_t)gm * 24 + n + r] = sigmoidf_(v[r]);
                } else if (n < 32) {
#pragma unroll
                    for (int r = 0; r < 4; ++r) { const int h = n - 24 + r; LS[((size_t)(b * 8 + h)) * 8192 + t] = logsigmoidf_(v[r] + bfg[h]); }
                }
            }
        }
    }
}

DEV void phase_cmp(const Args& a, unsigned char* smem) {
    const bf16_t* PROJ = (const bf16_t*)(a.ws + WS_PROJ);
    const int tid = threadIdx.x, lane = tid & 63, wid = tid >> 6, wr = wid >> 1, wc = wid & 1;
    for (int item = blockIdx.x; item < 32 + 16; item += gridDim.x) {
        if (item < 32) {
            const int which = item >> 4, b = (item >> 3) & 1, g = (item >> 2) & 1, mt = item & 3;
            const bf16_t* base = PROJ + ((size_t)((8 + 2 * which + g) * 2 + b)) * 8192 * 64;
            const bf16_t* W1 = (const bf16_t*)(a.ws + WS_WC1) + (size_t)which * 2048 * 128;
            const bf16_t* W2 = (const bf16_t*)(a.ws + WS_WC2) + (size_t)which * 128 * 64;
            const float* bias1 = (const float*)(a.ws + WS_BIAS1) + which * 128;
            bf16_t* HID = (bf16_t*)(a.ws + WS_HID) + ((size_t)(which * 4 + b * 2 + g)) * 512 * 128;
            bf16_t* OUT = (bf16_t*)(a.ws + WS_KC) + ((size_t)(which * 4 + b * 2 + g)) * 512 * 64;
            f32x4 acc[4][4];
            gemm_mainloop(smem, 32,
                [&](int r, int kc, int kt) { int c = mt * 128 + r; c = c > 510 ? 510 : c; return *(const uint4*)(base + (size_t)c * 1024 + kt * 64 + kc * 8); },
                [&](int k, int nc, int kt) { return *(const uint4*)(W1 + (size_t)(kt * 64 + k) * 128 + nc * 8); }, acc);
#pragma unroll
            for (int mi = 0; mi < 4; ++mi) { const int c = mt * 128 + wr * 64 + mi * 16 + (lane & 15);
#pragma unroll
                for (int ni = 0; ni < 4; ++ni) { const int n = wc * 64 + ni * 16 + 4 * (lane >> 4); const f32x4 v = acc[mi][ni]; const float4 bb = *(const float4*)(bias1 + n);
                    uint2 o; o.x = cvtpk(gelu_tanh(v[0] + bb.x), gelu_tanh(v[1] + bb.y)); o.y = cvtpk(gelu_tanh(v[2] + bb.z), gelu_tanh(v[3] + bb.w));
                    *(uint2*)(HID + (size_t)c * 128 + n) = o; } }
            __syncthreads();
            gemm_mainloop(smem, 2,
                [&](int r, int kc, int kt) { return *(const uint4*)(HID + (size_t)(mt * 128 + r) * 128 + kt * 64 + kc * 8); },
                [&](int k, int nc, int kt) { uint4 z = {0u, 0u, 0u, 0u}; if (nc < 8) z = *(const uint4*)(W2 + (size_t)(kt * 64 + k) * 64 + nc * 8); return z; }, acc);
            if (wc == 0) {
#pragma unroll
                for (int mi = 0; mi < 4; ++mi) { const int c = mt * 128 + wr * 64 + mi * 16 + (lane & 15);
#pragma unroll
                    for (int ni = 0; ni < 4; ++ni) { const int n = ni * 16 + 4 * (lane >> 4); const f32x4 v = acc[mi][ni];
                        uint2 o; o.x = cvtpk(v[0], v[1]); o.y = cvtpk(v[2], v[3]);
                        if (c >= 511) { o.x = 0u; o.y = 0u; }
                        *(uint2*)(OUT + (size_t)c * 64 + n) = o; } }
            }
            __syncthreads();
        } else {
            const int bh = item - 32; const float* LS = (const float*)(a.ws + WS_LS) + (size_t)bh * 8192; float* CUM = (float*)(a.ws + WS_CUM) + (size_t)bh * 8192;
            float* sc = (float*)smem;
            float v[32]; float s = 0.f;
#pragma unroll
            for (int j = 0; j < 8; ++j) { const float4 x = *(const float4*)(LS + tid * 32 + j * 4); v[4 * j] = x.x; v[4 * j + 1] = x.y; v[4 * j + 2] = x.z; v[4 * j + 3] = x.w; }
#pragma unroll
            for (int j = 0; j < 32; ++j) { s += v[j]; v[j] = s; }
            sc[tid] = s; __syncthreads();
            if (tid == 0) { float run = 0.f; for (int i = 0; i < 256; ++i) { const float x = sc[i]; sc[i] = run; run += x; } }
            __syncthreads();
            const float off = sc[tid];
#pragma unroll
            for (int j = 0; j < 8; ++j) { float4 o = {v[4 * j] + off, v[4 * j + 1] + off, v[4 * j + 2] + off, v[4 * j + 3] + off}; *(float4*)(CUM + tid * 32 + j * 4) = o; }
            __syncthreads();
        }
    }
}

DEV void load_row64(const bf16_t* p, float* f) {
#pragma unroll
    for (int c = 0; c < 8; ++c) { const uint4 u = *(const uint4*)(p + c * 8); unpack8(u, f + c * 8); }
}
DEV float dot64(const float* q, const bf16_t* kp) {
    float s = 0.f;
#pragma unroll
    for (int c = 0; c < 8; ++c) { const uint4 u = *(const uint4*)(kp + c * 8); float f[8]; unpack8(u, f);
#pragma unroll
        for (int j = 0; j < 8; ++j) s += q[c * 8 + j] * f[j]; }
    return s;
}
DEV void axpy64(float* o, float p, const bf16_t* vp) {
#pragma unroll
    for (int c = 0; c < 8; ++c) { const uint4 u = *(const uint4*)(vp + c * 8); float f[8]; unpack8(u, f);
#pragma unroll
        for (int j = 0; j < 8; ++j) o[c * 8 + j] += p * f[j]; }
}
DEV void scale64(float* o, float s) {
#pragma unroll
    for (int j = 0; j < 64; ++j) o[j] *= s;
}
#define ONLINE_STEP(valid, s, vp) do { if (valid) { const float mn_ = fmaxf(m, (s)); const float al_ = exp2f(m - mn_); const float p_ = exp2f((s) - mn_); l = l * al_ + p_; scale64(o, al_); axpy64(o, p_, (vp)); m = mn_; } } while (0)

DEV void nsa_naive_item(const Args& a, unsigned char* smem, int item) {
    const int tid = threadIdx.x, lane = tid & 63, wid = tid >> 6;
    const int b = item / 256, g = (item / 128) & 1, tt = item & 127;
    const int tl = lane >> 2, r = lane & 3, h = g * 4 + r;
    const int t = tt * 64 + wid * 16 + tl; const int token = b * 8192 + t;
    const float slope2 = exp2f(-(float)(h + 1)) * LOG2E;
    float* imp = (float*)smem + wid * (16 * 129) + tl * 129;
    int* seli = (int*)(smem + 4 * 16 * 129 * 4) + wid * 256 + tl * 16;
    const bf16_t* PROJ = (const bf16_t*)(a.ws + WS_PROJ);
    const float* GN = (const float*)(a.ws + WS_GN) + (size_t)token * 24 + h * 3;
    float* TMP = (float*)(a.ws + WS_ACT) + ((size_t)token * 8 + h) * 64;
    float q[64]; load_row64(PROJ + (((size_t)(h * 2 + b)) * 8192 + t) * 64, q);
    float o[64];
    const bf16_t* KC = (const bf16_t*)(a.ws + WS_KC) + ((size_t)(0 * 4 + b * 2 + g)) * 512 * 64;
    const bf16_t* VC = (const bf16_t*)(a.ws + WS_KC) + ((size_t)(1 * 4 + b * 2 + g)) * 512 * 64;
    const int cl = (t >= 31) ? (t - 31) / 16 : -1;
    const int tmaxw = tt * 64 + wid * 16 + 15; const int cmax = (tmaxw - 31) >= 0 ? (tmaxw - 31) / 16 : -1;
    for (int n = r; n < 129; n += 4) imp[n] = 0.f;
    float m = -1e30f, l = 0.f;
    for (int c = 0; c <= cmax; ++c) {
        const float s = dot64(q, KC + (size_t)c * 64) + slope2 * (float)(16 * c + 31 - t);
        if (c <= cl) { const float mn = fmaxf(m, s); l = l * exp2f(m - mn) + exp2f(s - mn); m = mn; }
    }
#pragma unroll
    for (int j = 0; j < 64; ++j) o[j] = 0.f;
    const float linv = 1.0f / fmaxf(l, 1e-30f);
    for (int c = 0; c <= cmax; ++c) {
        const float s = dot64(q, KC + (size_t)c * 64) + slope2 * (float)(16 * c + 31 - t);
        const float p = (c <= cl) ? exp2f(s - m) * linv : 0.f;
        axpy64(o, p, VC + (size_t)c * 64);
        float ps = p; ps += __shfl_xor(ps, 1); ps += __shfl_xor(ps, 2);
        if (r == 0) { imp[c >> 2] += ps; if ((c & 3) == 3) imp[(c >> 2) + 1] += ps; }
    }
    {
        const float g0 = GN[0];
#pragma unroll
        for (int j = 0; j < 64; ++j) TMP[j] = g0 * o[j];
    }
    const int cur = t >> 6;
    {
        unsigned long long tlo = 0ull, thi = 0ull;
        for (int kk = 0; kk < 16; ++kk) {
            float best = -2.0f; int bi = 0;
            for (int n = 0; n < 128; ++n) {
                const bool taken = (n < 64) ? ((tlo >> n) & 1ull) : ((thi >> (n - 64)) & 1ull);
                if (taken) continue;
                const bool valid = n <= cur; const bool forced = valid && (n == 0 || n == cur || n == cur - 1);
                const float sc = forced ? 1e9f : (valid ? imp[n] : -1.0f);
                if (sc > best) { best = sc; bi = n; }
            }
            if (bi < 64) tlo |= 1ull << bi; else thi |= 1ull << (bi - 64);
            if (r == 0) seli[kk] = bi;
        }
    }
    {
        const bf16_t* KS = PROJ + ((size_t)((12 + g) * 2 + b)) * 8192 * 64; const bf16_t* VS = PROJ + ((size_t)((14 + g) * 2 + b)) * 8192 * 64;
        m = -1e30f; l = 0.f;
#pragma unroll
        for (int j = 0; j < 64; ++j) o[j] = 0.f;
        for (int kk = 0; kk < 16; ++kk) {
            const int n = seli[kk];
            for (int j = 0; j < 64; ++j) {
                const int pos = n * 64 + j; const bool valid = pos <= t;
                const int pc = valid ? pos : t;
                const float s = dot64(q, KS + (size_t)pc * 64) + slope2 * (float)(pos - t);
                ONLINE_STEP(valid, s, VS + (size_t)pc * 64);
            }
        }
        const float g1 = GN[1] / fmaxf(l, 1e-30f);
#pragma unroll
        for (int j = 0; j < 64; ++j) TMP[j] += g1 * o[j];
    }
    {
        const bf16_t* KW = PROJ + ((size_t)((16 + g) * 2 + b)) * 8192 * 64; const bf16_t* VW = PROJ + ((size_t)((18 + g) * 2 + b)) * 8192 * 64;
        m = -1e30f; l = 0.f;
#pragma unroll
        for (int j = 0; j < 64; ++j) o[j] = 0.f;
        for (int j = 0; j < 512; ++j) {
            const int pos = t - 511 + j; const bool valid = pos >= 0; const int pc = valid ? pos : 0;
            const float s = dot64(q, KW + (size_t)pc * 64) + slope2 * (float)(pos - t);
            ONLINE_STEP(valid, s, VW + (size_t)pc * 64);
        }
        const float g2 = GN[2] / fmaxf(l, 1e-30f);
        float ss = 0.f;
        bf16_t* O = (bf16_t*)(a.ws + WS_ONSA) + (size_t)token * 512 + h * 64;
#pragma unroll
        for (int j = 0; j < 64; j += 2) { const float v0 = TMP[j] + g2 * o[j], v1 = TMP[j + 1] + g2 * o[j + 1]; ss += v0 * v0 + v1 * v1; *(unsigned*)(O + j) = cvtpk(v0, v1); }
        ((float*)(a.ws + WS_SSQ))[(size_t)token * 16 + h] = ss;
    }
}
DEV void fox_naive_item(const Args& a, int item) {
    const int tid = threadIdx.x;
    const int b = item / 256, h = (item / 32) & 7, tile = item & 31;
    const int t = tile * 256 + tid; const int token = b * 8192 + t;
    const bf16_t* PROJ = (const bf16_t*)(a.ws + WS_PROJ);
    const bf16_t* K = PROJ + ((size_t)((28 + h) * 2 + b)) * 8192 * 64; const bf16_t* V = PROJ + ((size_t)((36 + h) * 2 + b)) * 8192 * 64;
    const float* CUM = (const float*)(a.ws + WS_CUM) + (size_t)(b * 8 + h) * 8192;
    float q[64]; load_row64(PROJ + (((size_t)((20 + h) * 2 + b)) * 8192 + t) * 64, q);
    float o[64];
#pragma unroll
    for (int j = 0; j < 64; ++j) o[j] = 0.f;
    float m = -1e30f, l = 0.f; const float ct = CUM[t];
    const int smax = tile * 256 + (tid | 63);
    for (int s_ = 0; s_ <= smax; ++s_) {
        const bool valid = s_ <= t;
        const float s = dot64(q, K + (size_t)s_ * 64) + (ct - CUM[s_]) * LOG2E;
        ONLINE_STEP(valid, s, V + (size_t)s_ * 64);
    }
    const float li = 1.0f / fmaxf(l, 1e-30f); float ss = 0.f;
    bf16_t* O = (bf16_t*)(a.ws + WS_OFOX) + (size_t)token * 512 + h * 64;
#pragma unroll
    for (int j = 0; j < 64; j += 2) { const float v0 = o[j] * li, v1 = o[j + 1] * li; ss += v0 * v0 + v1 * v1; *(unsigned*)(O + j) = cvtpk(v0, v1); }
    ((float*)(a.ws + WS_SSQ))[(size_t)token * 16 + 8 + h] = ss;
}
typedef float f32x16 __attribute__((ext_vector_type(16)));
constexpr int AT_STAGE = 16384;
constexpr int AT_BIAS_OFF = 2 * AT_STAGE;
constexpr int AT_IMP_OFF = AT_BIAS_OFF + 1024;
constexpr int AT_SEL_OFF = AT_IMP_OFF + 32768;
constexpr int AT_WUN_OFF = AT_SEL_OFF + 512;
constexpr int AT_UCNT_OFF = AT_WUN_OFF + 64;
constexpr int AT_ULIST_OFF = AT_UCNT_OFF + 16;
constexpr int AT_ITEM_OFF = AT_ULIST_OFF + 128;
static_assert(AT_ITEM_OFF + 16 <= LDS_BYTES, "attention LDS map");
#define NEG_INF (-__builtin_inff())

DEV int crow(int r, int hi) { return (r & 3) + 8 * (r >> 2) + 4 * hi; }
#define KV_DECL uint4 rk0_, rk1_, rv0_, rv1_
#define KV_GLOAD(Kt, Vt) do { const bf16_t* kt_ = (Kt); const bf16_t* vt_ = (Vt); rk0_ = *(const uint4*)(kt_ + tid * 8); rk1_ = *(const uint4*)(kt_ + (tid + 256) * 8); \
    rv0_ = *(const uint4*)(vt_ + tid * 8); rv1_ = *(const uint4*)(vt_ + (tid + 256) * 8); } while (0)
#define KV_LSTORE(stp) do { unsigned char* st_ = (stp); \
    { const int c = tid; const int key = c >> 3, ch = c & 7; \
      *(uint4*)(st_ + key * 128 + ((ch ^ (key & 7)) << 4)) = rk0_; \
      *(uint4*)(st_ + 8192 + key * 128 + ((((ch >> 2) ^ ((key >> 1) & 1))) << 6) + ((ch & 3) << 4)) = rv0_; } \
    { const int c = tid + 256; const int key = c >> 3, ch = c & 7; \
      *(uint4*)(st_ + key * 128 + ((ch ^ (key & 7)) << 4)) = rk1_; \
      *(uint4*)(st_ + 8192 + key * 128 + ((((ch >> 2) ^ ((key >> 1) & 1))) << 6) + ((ch & 3) << 4)) = rv1_; } } while (0)
DEV void qk_tile(const unsigned char* Kst, const bf16x8 (&qf)[4], f32x16& p0, f32x16& p1, int lane) {
    const int key = lane & 31, hi = lane >> 5;
#pragma unroll
    for (int ks = 0; ks < 4; ++ks) { const int ch = 2 * ks + hi; const int off = key * 128 + ((ch ^ (key & 7)) << 4);
        const bf16x8 k0 = *(const bf16x8*)(Kst + off), k1 = *(const bf16x8*)(Kst + off + 32 * 128);
        p0 = __builtin_amdgcn_mfma_f32_32x32x16_bf16(k0, qf[ks], p0, 0, 0, 0);
        p1 = __builtin_amdgcn_mfma_f32_32x32x16_bf16(k1, qf[ks], p1, 0, 0, 0); }
}
DEV void pv_tile(const unsigned char* Vst, const f32x16& p0, const f32x16& p1, f32x16 (&o)[2], int lane) {
    const int hi = lane >> 5, i = lane & 15, gg = (lane >> 4) & 1;
    bf16x8 pa[4];
#pragma unroll
    for (int s = 0; s < 4; ++s) { const f32x16& p = (s < 2) ? p0 : p1; const int b = (s & 1) * 8;
        unsigned w[4];
#pragma unroll
        for (int j = 0; j < 4; ++j) w[j] = cvtpk(p[b + 2 * j], p[b + 2 * j + 1]);
        typedef unsigned u32x4_t __attribute__((ext_vector_type(4)));
        u32x4_t ww = {w[0], w[1], w[2], w[3]}; pa[s] = __builtin_bit_cast(bf16x8, ww); }
    const int q = i >> 2; const int sw = (q >> 1) & 1;
#pragma unroll
    for (int s = 0; s < 4; ++s) {
#pragma unroll
        for (int dh = 0; dh < 2; ++dh) {
            const int row0 = 16 * s + 4 * hi + q;
            const unsigned char* p = Vst + row0 * 128 + ((dh ^ sw) << 6) + gg * 32 + (i & 3) * 8;
            const s16x4 lo = tr_read(p), hh = tr_read(p + 8 * 128);
            const bf16x8 vf = {lo[0], lo[1], lo[2], lo[3], hh[0], hh[1], hh[2], hh[3]};
            o[dh] = __builtin_amdgcn_mfma_f32_32x32x16_bf16(vf, pa[s], o[dh], 0, 0, 0);
        }
    }
}
DEV float rowmax32(const f32x16& p0, const f32x16& p1) {
    float a = fmaxf(p0[0], p1[0]);
#pragma unroll
    for (int r = 1; r < 16; ++r) a = fmaxf(a, fmaxf(p0[r], p1[r]));
    return fmaxf(a, __shfl_xor(a, 32));
}
DEV void softmax_step(f32x16& p0, f32x16& p1, float& m, float& l, f32x16 (&o)[2]) {
    const float mt = rowmax32(p0, p1); const float mn = fmaxf(m, mt); const float alpha = __builtin_amdgcn_exp2f(m - mn);
    float rs = 0.f;
#pragma unroll
    for (int r = 0; r < 16; ++r) { p0[r] = __builtin_amdgcn_exp2f(p0[r] - mn); p1[r] = __builtin_amdgcn_exp2f(p1[r] - mn); rs += p0[r] + p1[r]; }
    rs += __shfl_xor(rs, 32);
    l = l * alpha + rs; m = mn;
    if (__any(alpha != 1.0f)) { o[0] *= alpha; o[1] *= alpha; }
}
template <int STRIDE> DEV void mask_tile(f32x16& p0, f32x16& p1, int kpos0, int lo, int hi_lim, int hi) {
#pragma unroll
    for (int r = 0; r < 16; ++r) { const int kp = kpos0 + STRIDE * crow(r, hi);
        if (kp < lo || kp > hi_lim) p0[r] = NEG_INF;
        const int kp1 = kp + 32 * STRIDE; if (kp1 < lo || kp1 > hi_lim) p1[r] = NEG_INF; }
}
template <int STRIDE> DEV void alibi_init(f32x16& p0, f32x16& p1, float slope2, int kpos0, int tref, int hi) {
    const float base = slope2 * (float)(kpos0 - tref + STRIDE * 4 * hi);
#pragma unroll
    for (int r = 0; r < 16; ++r) { const float c = (float)(STRIDE * ((r & 3) + 8 * (r >> 2))); p0[r] = fmaf(slope2, c, base); p1[r] = fmaf(slope2, c + (float)(32 * STRIDE), base); }
}
template <class Src, class Body>
DEV void kv_pipeline(unsigned char* smem, int n, const Src& src, const Body& body) {
    if (n <= 0) return;
    KV_DECL; const int tid = threadIdx.x; const bf16_t *kp, *vp;
    src(0, kp, vp); KV_GLOAD(kp, vp); KV_LSTORE(smem);
    __syncthreads();
    for (int j = 0; j < n; ++j) {
        const bool more = j + 1 < n;
        if (more) { src(j + 1, kp, vp); KV_GLOAD(kp, vp); }
        body(j, smem + (j & 1) * AT_STAGE);
        if (more) KV_LSTORE(smem + ((j + 1) & 1) * AT_STAGE);
        __syncthreads();
    }
}

DEV void fox_item(const Args& a, unsigned char* smem, int b, int h, int qb) {
    const int tid = threadIdx.x, lane = tid & 63, wid = tid >> 6, r32 = lane & 31, hi = lane >> 5;
    const bf16_t* PROJ = (const bf16_t*)(a.ws + WS_PROJ);
    const bf16_t* Q = PROJ + ((size_t)((20 + h) * 2 + b)) * 8192 * 64; const bf16_t* K = PROJ + ((size_t)((28 + h) * 2 + b)) * 8192 * 64; const bf16_t* V = PROJ + ((size_t)((36 + h) * 2 + b)) * 8192 * 64;
    const float* CUM = (const float*)(a.ws + WS_CUM) + (size_t)(b * 8 + h) * 8192;
    const int q0 = qb * 128; const int qrow = q0 + 32 * wid + r32;
    bf16x8 qf[4];
#pragma unroll
    for (int ks = 0; ks < 4; ++ks) qf[ks] = *(const bf16x8*)(Q + (size_t)qrow * 64 + 16 * ks + 8 * hi);
    const float cref = CUM[q0];
    const int ntiles = 2 * qb + 2; const int jmax_w = (q0 + 32 * wid + 31) >> 6; const int jmask_w = (q0 + 32 * wid) >> 6;
    f32x16 o[2]; o[0] = (f32x16){}; o[1] = (f32x16){}; float m = -1e30f, l = 0.f;
    float* biasL = (float*)(smem + AT_BIAS_OFF);
    KV_DECL; float breg = 0.f;
    KV_GLOAD(K, V); if (tid < 64) breg = (cref - CUM[tid]) * LOG2E;
    KV_LSTORE(smem); if (tid < 64) biasL[tid] = breg;
    __syncthreads();
    for (int j = 0; j < ntiles; ++j) {
        const bool more = j + 1 < ntiles;
        if (more) { KV_GLOAD(K + (size_t)(j + 1) * 4096, V + (size_t)(j + 1) * 4096); if (tid < 64) breg = (cref - CUM[(j + 1) * 64 + tid]) * LOG2E; }
        if (j <= jmax_w) {
            const unsigned char* st = smem + (j & 1) * AT_STAGE; const float* bl = biasL + (j & 1) * 64;
            f32x16 p0, p1;
#pragma unroll
            for (int g4 = 0; g4 < 4; ++g4) { const float4 x = *(const float4*)(bl + 8 * g4 + 4 * hi), y = *(const float4*)(bl + 32 + 8 * g4 + 4 * hi);
                p0[4 * g4] = x.x; p0[4 * g4 + 1] = x.y; p0[4 * g4 + 2] = x.z; p0[4 * g4 + 3] = x.w; p1[4 * g4] = y.x; p1[4 * g4 + 1] = y.y; p1[4 * g4 + 2] = y.z; p1[4 * g4 + 3] = y.w; }
            qk_tile(st, qf, p0, p1, lane);
            if (j >= jmask_w) mask_tile<1>(p0, p1, 64 * j, -1, qrow, hi);
            softmax_step(p0, p1, m, l, o);
            pv_tile(st + 8192, p0, p1, o, lane);
        }
        if (more) { KV_LSTORE(smem + ((j + 1) & 1) * AT_STAGE); if (tid < 64) biasL[((j + 1) & 1) * 64 + tid] = breg; }
        __syncthreads();
    }
    const float inv = 1.0f / l; float ss = 0.f;
    const size_t token = (size_t)b * 8192 + qrow;
    bf16_t* O = (bf16_t*)(a.ws + WS_OFOX) + token * 512 + h * 64;
#pragma unroll
    for (int dh = 0; dh < 2; ++dh)
#pragma unroll
        for (int g4 = 0; g4 < 4; ++g4) { const float v0 = o[dh][4 * g4] * inv, v1 = o[dh][4 * g4 + 1] * inv, v2 = o[dh][4 * g4 + 2] * inv, v3 = o[dh][4 * g4 + 3] * inv;
            ss += v0 * v0 + v1 * v1 + v2 * v2 + v3 * v3; uint2 w; w.x = cvtpk(v0, v1); w.y = cvtpk(v2, v3); *(uint2*)(O + 32 * dh + 8 * g4 + 4 * hi) = w; }
    ss += __shfl_xor(ss, 32);
    if (hi == 0) ((float*)(a.ws + WS_SSQ))[token * 16 + 8 + h] = ss;
}

DEV void nsa_item(const Args& a, unsigned char* smem, int b, int g, int tt) {
    const int tid = threadIdx.x, lane = tid & 63, wid = tid >> 6, col = lane & 31, hi = lane >> 5;
    const int t0 = tt * 32, tokw = col >> 2, r = col & 3, h = 4 * g + r; const int tokl = wid * 8 + tokw; const int t = t0 + tokl; const size_t token = (size_t)b * 8192 + t;
    const float slope2 = exp2f(-(float)(h + 1)) * LOG2E;
    const bf16_t* PROJ = (const bf16_t*)(a.ws + WS_PROJ);
    const float* GN = (const float*)(a.ws + WS_GN) + token * 24 + h * 3;
    const int cur = t0 >> 6; const bool need_topk = cur > 15;
    bf16x8 qf[4];
    { const bf16_t* Q = PROJ + (((size_t)(h * 2 + b)) * 8192 + t) * 64;
#pragma unroll
      for (int ks = 0; ks < 4; ++ks) qf[ks] = *(const bf16x8*)(Q + 16 * ks + 8 * hi); }
    float* impw = (float*)(smem + AT_IMP_OFF) + wid * 2048; float* totw = impw + lane;
    unsigned* selmask = (unsigned*)(smem + AT_SEL_OFF); unsigned* wun = (unsigned*)(smem + AT_WUN_OFF); int* ucnt = (int*)(smem + AT_UCNT_OFF); unsigned char* ulist = smem + AT_ULIST_OFF;
    f32x16 o[2]; float m, l;
    const int tmin_w = t0 + wid * 8, tmax_w = tmin_w + 7;
    {
        const bf16_t* KC = (const bf16_t*)(a.ws + WS_KC) + ((size_t)(0 * 4 + b * 2 + g)) * 512 * 64; const bf16_t* VC = (const bf16_t*)(a.ws + WS_KC) + ((size_t)(1 * 4 + b * 2 + g)) * 512 * 64;
        const int ncv = t0 / 16 + 1; const int nct = (ncv + 63) >> 6;
        auto src = [&](int j, const bf16_t*& kp, const bf16_t*& vp) { kp = KC + (size_t)j * 4096; vp = VC + (size_t)j * 4096; };
        m = -1e30f; l = 0.f;
        kv_pipeline(smem, nct, src, [&](int j, const unsigned char* st) {
            const int kpos0 = 1024 * j + 31;
            if (kpos0 > tmax_w) return;
            f32x16 p0, p1; alibi_init<16>(p0, p1, slope2, kpos0, t0, hi);
            qk_tile(st, qf, p0, p1, lane);
            mask_tile<16>(p0, p1, kpos0, -1, t, hi);
            const float mt = rowmax32(p0, p1); const float mn = fmaxf(m, mt); float rs = 0.f;
#pragma unroll
            for (int rr = 0; rr < 16; ++rr) rs += __builtin_amdgcn_exp2f(p0[rr] - mn) + __builtin_amdgcn_exp2f(p1[rr] - mn);
            rs += __shfl_xor(rs, 32);
            l = l * __builtin_amdgcn_exp2f(m - mn) + rs; m = mn;
        });
        const float linv = l > 0.f ? 1.0f / l : 0.f;
        if (need_topk) { for (int i = lane; i < 8 * 129; i += 64) impw[i] = 0.f; }
        o[0] = (f32x16){}; o[1] = (f32x16){};
        kv_pipeline(smem, nct, src, [&](int j, const unsigned char* st) {
            const int kpos0 = 1024 * j + 31;
            if (kpos0 > tmax_w) return;
            f32x16 p0, p1; alibi_init<16>(p0, p1, slope2, kpos0, t0, hi);
            qk_tile(st, qf, p0, p1, lane);
            mask_tile<16>(p0, p1, kpos0, -1, t, hi);
#pragma unroll
            for (int rr = 0; rr < 16; ++rr) { p0[rr] = __builtin_amdgcn_exp2f(p0[rr] - m) * linv; p1[rr] = __builtin_amdgcn_exp2f(p1[rr] - m) * linv; }
            if (need_topk) {
#pragma unroll
                for (int half = 0; half < 2; ++half)
#pragma unroll
                    for (int g4 = 0; g4 < 4; ++g4) { const f32x16& p = half ? p1 : p0;
                        float ms = (p[4 * g4] + p[4 * g4 + 1]) + (p[4 * g4 + 2] + p[4 * g4 + 3]); float ls = p[4 * g4 + 3];
                        ms += __shfl_xor(ms, 1); ms += __shfl_xor(ms, 2); ls += __shfl_xor(ls, 1); ls += __shfl_xor(ls, 2);
                        const int n = 16 * j + 8 * half + 2 * g4 + hi;
                        if (r == 0) { atomicAdd(&impw[tokw * 129 + n], ms); atomicAdd(&impw[tokw * 129 + n + 1], ls); } }
            }
            pv_tile(st + 8192, p0, p1, o, lane);
        });
    }
    {
        unsigned un0 = 0u, un1 = 0u, un2 = 0u, un3 = 0u;
        if (need_topk) {
            for (int tk = 0; tk < 8; ++tk) {
                float v0 = impw[tk * 129 + lane], v1 = impw[tk * 129 + 64 + lane];
                v0 = (lane >= 1 && lane <= cur - 2) ? v0 : -1.0f; v1 = (lane + 64 <= cur - 2) ? v1 : -1.0f;
                unsigned m0 = 1u, m1 = 0u, m2 = 0u, m3 = 0u;
#define SETBIT(n_) do { const int n__ = (n_); const unsigned bit__ = 1u << (n__ & 31); const int w__ = n__ >> 5; if (w__ == 0) m0 |= bit__; else if (w__ == 1) m1 |= bit__; else if (w__ == 2) m2 |= bit__; else m3 |= bit__; } while (0)
                SETBIT(cur); SETBIT(cur - 1);
                for (int it = 0; it < 13; ++it) {
                    float mx = fmaxf(v0, v1);
#pragma unroll
                    for (int off = 1; off < 64; off <<= 1) mx = fmaxf(mx, __shfl_xor(mx, off));
                    const unsigned long long b0 = __ballot(v0 == mx);
                    int n;
                    if (b0) n = __ffsll((long long)b0) - 1; else { const unsigned long long b1 = __ballot(v1 == mx); n = 64 + __ffsll((long long)b1) - 1; }
                    if (lane == (n & 63)) { if (n < 64) v0 = -1.0f; else v1 = -1.0f; }
                    SETBIT(n);
                }
#undef SETBIT
                if (lane == 0) { unsigned* sm_ = selmask + (wid * 8 + tk) * 4; sm_[0] = m0; sm_[1] = m1; sm_[2] = m2; sm_[3] = m3; }
                un0 |= m0; un1 |= m1; un2 |= m2; un3 |= m3;
            }
        } else {
            const unsigned full = (cur >= 31) ? 0xffffffffu : ((2u << cur) - 1u);
            un0 = full;
            if (lane < 8) { unsigned* sm_ = selmask + (wid * 8 + lane) * 4; sm_[0] = full; sm_[1] = 0u; sm_[2] = 0u; sm_[3] = 0u; }
        }
        if (lane == 0) { wun[wid * 4] = un0; wun[wid * 4 + 1] = un1; wun[wid * 4 + 2] = un2; wun[wid * 4 + 3] = un3; }
        __syncthreads();
        if (tid == 0) { int c = 0;
            for (int w = 0; w < 4; ++w) { const unsigned u = wun[w] | wun[4 + w] | wun[8 + w] | wun[12 + w]; for (int bb = 0; bb < 32; ++bb) if ((u >> bb) & 1u) ulist[c++] = (unsigned char)(w * 32 + bb); }
            ucnt[0] = c; }
        __syncthreads();
    }
    { const float g0 = GN[0];
#pragma unroll
      for (int rr = 0; rr < 16; ++rr) { totw[rr * 64] = o[0][rr] * g0; totw[(16 + rr) * 64] = o[1][rr] * g0; } }
    {
        const bf16_t* KS = PROJ + ((size_t)((12 + g) * 2 + b)) * 8192 * 64; const bf16_t* VS = PROJ + ((size_t)((14 + g) * 2 + b)) * 8192 * 64;
        const int nu = ucnt[0];
        m = -1e30f; l = 0.f; o[0] = (f32x16){}; o[1] = (f32x16){};
        kv_pipeline(smem, nu, [&](int j, const bf16_t*& kp, const bf16_t*& vp) { const int n = ulist[j]; kp = KS + (size_t)n * 4096; vp = VS + (size_t)n * 4096; },
            [&](int j, const unsigned char* st) {
                const int n = ulist[j];
                if (!((wun[wid * 4 + (n >> 5)] >> (n & 31)) & 1u)) return;
                const bool sel = (selmask[tokl * 4 + (n >> 5)] >> (n & 31)) & 1u;
                f32x16 p0, p1; alibi_init<1>(p0, p1, slope2, 64 * n, t0, hi);
                qk_tile(st, qf, p0, p1, lane);
                if (n == cur || !__all(sel)) mask_tile<1>(p0, p1, 64 * n, -1, sel ? t : -1, hi);
                softmax_step(p0, p1, m, l, o);
                pv_tile(st + 8192, p0, p1, o, lane);
            });
        const float g1 = GN[1] / fmaxf(l, 1e-30f);
#pragma unroll
        for (int rr = 0; rr < 16; ++rr) { totw[rr * 64] += o[0][rr] * g1; totw[(16 + rr) * 64] += o[1][rr] * g1; }
    }
    {
        const bf16_t* KW = PROJ + ((size_t)((16 + g) * 2 + b)) * 8192 * 64; const bf16_t* VW = PROJ + ((size_t)((18 + g) * 2 + b)) * 8192 * 64;
        const int jlo = (t0 - 511) > 0 ? ((t0 - 511) >> 6) : 0; const int jhi = (t0 + 31) >> 6;
        m = -1e30f; l = 0.f; o[0] = (f32x16){}; o[1] = (f32x16){};
        kv_pipeline(smem, jhi - jlo + 1, [&](int j, const bf16_t*& kp, const bf16_t*& vp) { kp = KW + (size_t)(jlo + j) * 4096; vp = VW + (size_t)(jlo + j) * 4096; },
            [&](int j, const unsigned char* st) {
                const int kpos0 = 64 * (jlo + j);
                if (kpos0 > tmax_w || kpos0 + 63 < tmin_w - 511) return;
                f32x16 p0, p1; alibi_init<1>(p0, p1, slope2, kpos0, t0, hi);
                qk_tile(st, qf, p0, p1, lane);
                if (kpos0 < tmax_w - 511 || kpos0 + 63 > tmin_w) mask_tile<1>(p0, p1, kpos0, t - 511, t, hi);
                softmax_step(p0, p1, m, l, o);
                pv_tile(st + 8192, p0, p1, o, lane);
            });
        const float g2 = GN[2] / fmaxf(l, 1e-30f);
#pragma unroll
        for (int rr = 0; rr < 16; ++rr) { o[0][rr] = totw[rr * 64] + o[0][rr] * g2; o[1][rr] = totw[(16 + rr) * 64] + o[1][rr] * g2; }
    }
    {
        float ss = 0.f; bf16_t* O = (bf16_t*)(a.ws + WS_ONSA) + token * 512 + h * 64;
#pragma unroll
        for (int dh = 0; dh < 2; ++dh)
#pragma unroll
            for (int g4 = 0; g4 < 4; ++g4) { const float v0 = o[dh][4 * g4], v1 = o[dh][4 * g4 + 1], v2 = o[dh][4 * g4 + 2], v3 = o[dh][4 * g4 + 3];
                ss += v0 * v0 + v1 * v1 + v2 * v2 + v3 * v3; uint2 w; w.x = cvtpk(v0, v1); w.y = cvtpk(v2, v3); *(uint2*)(O + 32 * dh + 8 * g4 + 4 * hi) = w; }
        ss += __shfl_xor(ss, 32);
        if (hi == 0) ((float*)(a.ws + WS_SSQ))[token * 16 + h] = ss;
    }
}
#ifndef ATT_NAIVE
#define ATT_NAIVE 0
#endif
DEV void phase_att(const Args& a, unsigned char* smem) {
#if ATT_NAIVE
    for (int item = blockIdx.x; item < 512 + 512; item += gridDim.x) {
        if (item < 512) fox_naive_item(a, 511 - item);
        else { nsa_naive_item(a, smem, item - 512); __syncthreads(); }
    }
#else
    int* qctr = (int*)(a.ws + WS_CTL) + 64; int* sitem = (int*)(smem + AT_ITEM_OFF);
    for (;;) {
        if (threadIdx.x == 0) sitem[0] = atomicAdd(qctr, 1);
        __syncthreads();
        const int item = sitem[0];
        __syncthreads();
        if (item >= 2048) break;
#ifndef ATT_SKIP_FOX
        if (item < 1024) { const int qb = 63 - (item >> 4), bh = item & 15; fox_item(a, smem, bh >> 3, bh & 7, qb); }
        else
#endif
#ifndef ATT_SKIP_NSA
        { const int idx = item - 1024; const int tt = 255 - (idx >> 2), bg = idx & 3; nsa_item(a, smem, bg >> 1, bg & 1, tt); }
#else
        {}
#endif
    }
#endif
}


DEV void phase_outproj(const Args& a, unsigned char* smem) {
    const bf16_t* ONSA = (const bf16_t*)(a.ws + WS_ONSA); const bf16_t* OFOX = (const bf16_t*)(a.ws + WS_OFOX); const float* SSQ = (const float*)(a.ws + WS_SSQ);
    const bf16_t* W = (const bf16_t*)(a.ws + WS_WOUT); float* H1 = (float*)(a.ws + WS_H1); const float* X = a.in[I_X];
    const float* gnn = a.in[I_GNN]; const float* gnf = a.in[I_GNF];
    float* rs = (float*)(smem + MISC_OFF);
    const int tid = threadIdx.x, lane = tid & 63, wid = tid >> 6, wr = wid >> 1, wc = wid & 1;
    for (int item = blockIdx.x; item < 128 * 8; item += gridDim.x) {
        const int nt = item / 128, mt = item % 128;
        if (tid < 128) { const float* s = SSQ + (size_t)(mt * 128 + tid) * 16; float sn = 0.f, sf = 0.f;
#pragma unroll
            for (int j = 0; j < 8; ++j) { sn += s[j]; sf += s[8 + j]; }
            rs[tid * 2] = rsqrtf(sn * (1.f / 512.f) + EPS); rs[tid * 2 + 1] = rsqrtf(sf * (1.f / 512.f) + EPS); }
        __syncthreads();
        f32x4 acc[4][4];
        gemm_mainloop(smem, 16,
            [&](int r, int kc, int kt) { const int k0 = kt * 64 + kc * 8; const bool nsa = k0 < 512; const int kk = nsa ? k0 : k0 - 512;
                const uint4 u = *(const uint4*)((nsa ? ONSA : OFOX) + (size_t)(mt * 128 + r) * 512 + kk);
                const float* gp = (nsa ? gnn : gnf) + kk; const float4 g0 = *(const float4*)gp, g1 = *(const float4*)(gp + 4);
                const float sc = rs[r * 2 + (nsa ? 0 : 1)]; float f[8]; unpack8(u, f);
                uint4 o; o.x = cvtpk(f[0] * sc * g0.x, f[1] * sc * g0.y); o.y = cvtpk(f[2] * sc * g0.z, f[3] * sc * g0.w); o.z = cvtpk(f[4] * sc * g1.x, f[5] * sc * g1.y); o.w = cvtpk(f[6] * sc * g1.z, f[7] * sc * g1.w);
                return o; },
            [&](int k, int nc, int kt) { return *(const uint4*)(W + (size_t)(kt * 64 + k) * 1024 + nt * 128 + nc * 8); }, acc);
#pragma unroll
        for (int mi = 0; mi < 4; ++mi) { const size_t gm = mt * 128 + wr * 64 + mi * 16 + (lane & 15);
#pragma unroll
            for (int ni = 0; ni < 4; ++ni) { const int n = nt * 128 + wc * 64 + ni * 16 + 4 * (lane >> 4); const float4 x = *(const float4*)(X + gm * 1024 + n); const f32x4 v = acc[mi][ni];
                float4 o = {x.x + v[0], x.y + v[1], x.z + v[2], x.w + v[3]}; *(float4*)(H1 + gm * 1024 + n) = o; } }
        __syncthreads();
    }
}

DEV void phase_route(const Args& a, unsigned char* smem) {
    const float* H1 = (const float*)(a.ws + WS_H1); bf16_t* XN = (bf16_t*)(a.ws + WS_XN);
    const float* ln2 = a.in[I_LN2]; const float* wr_ = a.in[I_WR]; const float* br = a.in[I_BR];
    int* CNT = (int*)(a.ws + WS_CTL);
    int* TOPI = (int*)(a.ws + WS_TOPI); int* TOPS = (int*)(a.ws + WS_TOPS); float* TOPW = (float*)(a.ws + WS_TOPW);
    int* TOKOF = (int*)(a.ws + WS_TOKOF); float* ROWW = (float*)(a.ws + WS_ROWW);
    int* lcnt = (int*)smem; int* lbase = lcnt + 32; int* te = lbase + 32; int* trk = te + 256; float* tw = (float*)(trk + 256);
    const int tid = threadIdx.x, lane = tid & 63, wid = tid >> 6;
    for (int item = blockIdx.x; item < 256; item += gridDim.x) {
        if (tid < 32) lcnt[tid] = 0;
        __syncthreads();
        for (int i = 0; i < 16; ++i) {
            const int tok = item * 64 + wid * 16 + i;
            float xv[16]; float s = 0.f;
#pragma unroll
            for (int j = 0; j < 4; ++j) { const float4 v = *(const float4*)(H1 + (size_t)tok * 1024 + j * 256 + lane * 4); xv[4 * j] = v.x; xv[4 * j + 1] = v.y; xv[4 * j + 2] = v.z; xv[4 * j + 3] = v.w; s += v.x * v.x + v.y * v.y + v.z * v.z + v.w * v.w; }
            const float rstd = rsqrtf(wave_sum(s) * (1.f / 1024.f) + EPS);
#pragma unroll
            for (int j = 0; j < 4; ++j) { const float4 gg = *(const float4*)(ln2 + j * 256 + lane * 4);
                xv[4 * j] *= rstd * gg.x; xv[4 * j + 1] *= rstd * gg.y; xv[4 * j + 2] *= rstd * gg.z; xv[4 * j + 3] *= rstd * gg.w;
                uint2 o; o.x = cvtpk(xv[4 * j], xv[4 * j + 1]); o.y = cvtpk(xv[4 * j + 2], xv[4 * j + 3]); *(uint2*)(XN + (size_t)tok * 1024 + j * 256 + lane * 4) = o; }
            float lg[32];
#pragma unroll
            for (int e = 0; e < 32; ++e) lg[e] = 0.f;
#pragma unroll
            for (int j = 0; j < 4; ++j)
#pragma unroll
                for (int c = 0; c < 4; ++c) { const float* wrow = wr_ + (size_t)(j * 256 + lane * 4 + c) * 32; const float x = xv[4 * j + c];
#pragma unroll
                    for (int e4 = 0; e4 < 8; ++e4) { const float4 w = *(const float4*)(wrow + e4 * 4); lg[e4 * 4] += x * w.x; lg[e4 * 4 + 1] += x * w.y; lg[e4 * 4 + 2] += x * w.z; lg[e4 * 4 + 3] += x * w.w; } }
#pragma unroll
            for (int e = 0; e < 32; ++e) lg[e] = wave_sum(lg[e]) + br[e];
            unsigned taken = 0u; float tv[4]; int ti[4];
#pragma unroll
            for (int k = 0; k < 4; ++k) { float best = -3.0e38f; int bi = 0;
#pragma unroll
                for (int e = 0; e < 32; ++e) { const bool ok = !((taken >> e) & 1u) && lg[e] > best; best = ok ? lg[e] : best; bi = ok ? e : bi; }
                taken |= 1u << bi; tv[k] = best; ti[k] = bi; }
            const float e1 = __expf(tv[1] - tv[0]), e2 = __expf(tv[2] - tv[0]), e3 = __expf(tv[3] - tv[0]); const float inv = 1.0f / (1.0f + e1 + e2 + e3);
            const float wv[4] = {inv, e1 * inv, e2 * inv, e3 * inv};
            if (lane == 0) {
#pragma unroll
                for (int k = 0; k < 4; ++k) { const int idx = (wid * 16 + i) * 4 + k; te[idx] = ti[k]; trk[idx] = atomicAdd(&lcnt[ti[k]], 1); tw[idx] = wv[k]; }
            }
        }
        __syncthreads();
        if (tid < 32) lbase[tid] = atomicAdd(&CNT[tid], lcnt[tid]);
        __syncthreads();
        { const int idx = tid; const int tok = item * 64 + (idx >> 2); const int e = te[idx]; const int slot = lbase[e] + trk[idx];
          TOPI[(size_t)tok * 4 + (idx & 3)] = e; TOPS[(size_t)tok * 4 + (idx & 3)] = slot; TOPW[(size_t)tok * 4 + (idx & 3)] = tw[idx];
          TOKOF[(size_t)e * 16384 + slot] = tok; ROWW[(size_t)e * 16384 + slot] = tw[idx]; }
        __syncthreads();
    }
}

struct MoeMap { int e, mt, nt, cnt, off; };
DEV void moe_setup(const Args& a, int* sm) {
    if (threadIdx.x == 0) { const int* CNT = (const int*)(a.ws + WS_CTL); int tot = 0; for (int e = 0; e < 32; ++e) { const int c = CNT[e]; const int mt = (c + 127) >> 7; sm[e] = mt; sm[32 + e] = tot; tot += mt; } sm[64] = tot; }
    __syncthreads();
}
DEV MoeMap moe_map(const Args& a, const int* sm, int item, int NT) {
    MoeMap mm; int e = 0;
    for (int i = 1; i < 32; ++i) if (item >= sm[32 + i] * NT) e = i;
    const int local = item - sm[32 + e] * NT; const int mte = sm[e];
    mm.e = e; mm.nt = local / mte; mm.mt = local % mte; mm.cnt = ((const int*)(a.ws + WS_CTL))[e]; mm.off = sm[32 + e] * 128; return mm;
}
DEV void phase_up(const Args& a, unsigned char* smem) {
    int* sm = (int*)(smem + MISC_OFF); int* tok = sm + 128;
    const bf16_t* XN = (const bf16_t*)(a.ws + WS_XN); const bf16_t* W = (const bf16_t*)(a.ws + WS_WUP); bf16_t* ACT = (bf16_t*)(a.ws + WS_ACT);
    const int* TOKOF = (const int*)(a.ws + WS_TOKOF); const float* bup = a.in[I_BUP];
    const int tid = threadIdx.x, lane = tid & 63, wid = tid >> 6, wr = wid >> 1, wc = wid & 1;
    moe_setup(a, sm);
    const int nitems = sm[64] * 16;
    for (int item = blockIdx.x; item < nitems; item += gridDim.x) {
        const MoeMap mm = moe_map(a, sm, item, 16);
        if (tid < 128) { const int slot = mm.mt * 128 + tid; tok[tid] = slot < mm.cnt ? TOKOF[(size_t)mm.e * 16384 + slot] : 0; }
        __syncthreads();
        const bf16_t* We = W + (size_t)mm.e * 1024 * 2048;
        f32x4 acc[4][4];
        gemm_mainloop(smem, 16,
            [&](int r, int kc, int kt) { return *(const uint4*)(XN + (size_t)tok[r] * 1024 + kt * 64 + kc * 8); },
            [&](int k, int nc, int kt) { const int ni = (nc >> 1) & 3; const int sc = ((ni >> 1) ? 1024 : 0) + mm.nt * 64 + (nc >> 3) * 32 + (ni & 1) * 16 + (nc & 1) * 8;
                return *(const uint4*)(We + (size_t)(kt * 64 + k) * 2048 + sc); }, acc);
#pragma unroll
        for (int mi = 0; mi < 4; ++mi) { const size_t row = (size_t)mm.off + mm.mt * 128 + wr * 64 + mi * 16 + (lane & 15);
#pragma unroll
            for (int ni = 0; ni < 2; ++ni) { const int jc = mm.nt * 64 + wc * 32 + ni * 16 + 4 * (lane >> 4);
                const float4 bg = *(const float4*)(bup + (size_t)mm.e * 2048 + jc), bl_ = *(const float4*)(bup + (size_t)mm.e * 2048 + 1024 + jc);
                const f32x4 gv = acc[mi][ni], lv = acc[mi][ni + 2]; const float bgv[4] = {bg.x, bg.y, bg.z, bg.w}, blv[4] = {bl_.x, bl_.y, bl_.z, bl_.w}; float r4[4];
#pragma unroll
                for (int r = 0; r < 4; ++r) { const float gg = fminf(gv[r] + bgv[r], 7.0f); const float ll = fminf(fmaxf(lv[r] + blv[r], -7.0f), 7.0f); r4[r] = gg * sigmoidf_(1.702f * gg) * (ll + 1.0f); }
                uint2 o; o.x = cvtpk(r4[0], r4[1]); o.y = cvtpk(r4[2], r4[3]); *(uint2*)(ACT + row * 1024 + jc) = o; } }
        __syncthreads();
    }
}
DEV void phase_down(const Args& a, unsigned char* smem) {
    int* sm = (int*)(smem + MISC_OFF); float* rw = (float*)(sm + 128);
    const bf16_t* ACT = (const bf16_t*)(a.ws + WS_ACT); const bf16_t* W = (const bf16_t*)(a.ws + WS_WDN); bf16_t* Y = (bf16_t*)(a.ws + WS_Y);
    const float* ROWW = (const float*)(a.ws + WS_ROWW); const float* bdn = a.in[I_BDN];
    const int tid = threadIdx.x, lane = tid & 63, wid = tid >> 6, wr = wid >> 1, wc = wid & 1;
    moe_setup(a, sm);
    const int nitems = sm[64] * 8;
    for (int item = blockIdx.x; item < nitems; item += gridDim.x) {
        const MoeMap mm = moe_map(a, sm, item, 8);
        if (tid < 128) { const int slot = mm.mt * 128 + tid; rw[tid] = slot < mm.cnt ? ROWW[(size_t)mm.e * 16384 + slot] : 0.f; }
        __syncthreads();
        const bf16_t* We = W + (size_t)mm.e * 1024 * 1024; const bf16_t* Ab = ACT + ((size_t)mm.off + mm.mt * 128) * 1024;
        f32x4 acc[4][4];
        gemm_mainloop(smem, 16,
            [&](int r, int kc, int kt) { return *(const uint4*)(Ab + (size_t)r * 1024 + kt * 64 + kc * 8); },
            [&](int k, int nc, int kt) { return *(const uint4*)(We + (size_t)(kt * 64 + k) * 1024 + mm.nt * 128 + nc * 8); }, acc);
#pragma unroll
        for (int mi = 0; mi < 4; ++mi) { const int rl = wr * 64 + mi * 16 + (lane & 15); const size_t row = (size_t)mm.off + mm.mt * 128 + rl; const float w = rw[rl];
#pragma unroll
            for (int ni = 0; ni < 4; ++ni) { const int n = mm.nt * 128 + wc * 64 + ni * 16 + 4 * (lane >> 4); const float4 bb = *(const float4*)(bdn + (size_t)mm.e * 1024 + n); const f32x4 v = acc[mi][ni];
                uint2 o; o.x = cvtpk((v[0] + bb.x) * w, (v[1] + bb.y) * w); o.y = cvtpk((v[2] + bb.z) * w, (v[3] + bb.w) * w); *(uint2*)(Y + row * 1024 + n) = o; } }
        __syncthreads();
    }
}

DEV void phase_comb(const Args& a, unsigned char* smem) {
    int* sm = (int*)(smem + MISC_OFF);
    moe_setup(a, sm);
    float* H1 = (float*)(a.ws + WS_H1); bf16_t* XN = (bf16_t*)(a.ws + WS_XN); const bf16_t* Y = (const bf16_t*)(a.ws + WS_Y);
    const int* TOPI = (const int*)(a.ws + WS_TOPI); const int* TOPS = (const int*)(a.ws + WS_TOPS); const float* g = a.in[I_LNPLE];
    const int lane = threadIdx.x & 63; const int gw = blockIdx.x * 4 + (threadIdx.x >> 6), ngw = gridDim.x * 4;
    for (int tok = gw; tok < NTOK; tok += ngw) {
        float4 v[4];
#pragma unroll
        for (int j = 0; j < 4; ++j) v[j] = *(const float4*)(H1 + (size_t)tok * 1024 + j * 256 + lane * 4);
#pragma unroll
        for (int k = 0; k < 4; ++k) { const int e = TOPI[(size_t)tok * 4 + k]; const size_t row = (size_t)sm[32 + e] * 128 + TOPS[(size_t)tok * 4 + k];
#pragma unroll
            for (int j = 0; j < 4; ++j) { const uint2 u = *(const uint2*)(Y + row * 1024 + j * 256 + lane * 4); v[j].x += bflo(u.x); v[j].y += bfhi(u.x); v[j].z += bflo(u.y); v[j].w += bfhi(u.y); } }
        float s = 0.f;
#pragma unroll
        for (int j = 0; j < 4; ++j) { *(float4*)(H1 + (size_t)tok * 1024 + j * 256 + lane * 4) = v[j]; s += v[j].x * v[j].x + v[j].y * v[j].y + v[j].z * v[j].z + v[j].w * v[j].w; }
        const float rstd = rsqrtf(wave_sum(s) * (1.f / 1024.f) + EPS);
#pragma unroll
        for (int j = 0; j < 4; ++j) { const float4 gg = *(const float4*)(g + j * 256 + lane * 4);
            uint2 o; o.x = cvtpk(v[j].x * rstd * gg.x, v[j].y * rstd * gg.y); o.y = cvtpk(v[j].z * rstd * gg.z, v[j].w * rstd * gg.w); *(uint2*)(XN + (size_t)tok * 1024 + j * 256 + lane * 4) = o; }
    }
}

DEV void phase_gate(const Args& a, unsigned char* smem) {
    const bf16_t* XN = (const bf16_t*)(a.ws + WS_XN); const bf16_t* WG = (const bf16_t*)(a.ws + WS_WGATE); const bf16_t* PB = (const bf16_t*)(a.ws + WS_PB); const bf16_t* WP = (const bf16_t*)(a.ws + WS_WPLE);
    const float* H2 = (const float*)(a.ws + WS_H1); float* OUT = a.out; float* SSQ3 = (float*)(a.ws + WS_SSQ3);
    const int tid = threadIdx.x, lane = tid & 63, wid = tid >> 6, wr = wid >> 1, wc = wid & 1;
    for (int item = blockIdx.x; item < 128 * 8; item += gridDim.x) {
        const int nt = item / 128, mt = item % 128;
        f32x4 acc[4][4];
        gemm_mainloop(smem, 16,
            [&](int r, int kc, int kt) { return *(const uint4*)(XN + (size_t)(mt * 128 + r) * 1024 + kt * 64 + kc * 8); },
            [&](int k, int nc, int kt) { return *(const uint4*)(WG + (size_t)(kt * 64 + k) * 1024 + nt * 128 + nc * 8); }, acc);
#pragma unroll
        for (int mi = 0; mi < 4; ++mi) { const size_t gm = mt * 128 + wr * 64 + mi * 16 + (lane & 15);
#pragma unroll
            for (int ni = 0; ni < 4; ++ni) { const int n = nt * 128 + wc * 64 + ni * 16 + 4 * (lane >> 4); const f32x4 v = acc[mi][ni];
                float4 o = {sigmoidf_(v[0]), sigmoidf_(v[1]), sigmoidf_(v[2]), sigmoidf_(v[3])}; *(float4*)(OUT + gm * 1024 + n) = o; } }
        gemm_mainloop(smem, 4,
            [&](int r, int kc, int kt) { return *(const uint4*)(PB + (size_t)(mt * 128 + r) * 256 + kt * 64 + kc * 8); },
            [&](int k, int nc, int kt) { return *(const uint4*)(WP + (size_t)(kt * 64 + k) * 1024 + nt * 128 + nc * 8); }, acc);
#pragma unroll
        for (int mi = 0; mi < 4; ++mi) { const size_t gm = mt * 128 + wr * 64 + mi * 16 + (lane & 15); float ss = 0.f;
#pragma unroll
            for (int ni = 0; ni < 4; ++ni) { const int n = nt * 128 + wc * 64 + ni * 16 + 4 * (lane >> 4); const f32x4 v = acc[mi][ni];
                const float4 gt = *(const float4*)(OUT + gm * 1024 + n); const float4 h = *(const float4*)(H2 + gm * 1024 + n);
                float4 o = {h.x + v[0] * gt.x, h.y + v[1] * gt.y, h.z + v[2] * gt.z, h.w + v[3] * gt.w}; *(float4*)(OUT + gm * 1024 + n) = o;
                ss += o.x * o.x + o.y * o.y + o.z * o.z + o.w * o.w; }
            ss += __shfl_xor(ss, 16); ss += __shfl_xor(ss, 32);
            if (lane < 16) SSQ3[gm * 16 + nt * 2 + wc] = ss; }
        __syncthreads();
    }
}

DEV void phase_final(const Args& a) {
    float* OUT = a.out; const float* SSQ3 = (const float*)(a.ws + WS_SSQ3); const float* g = a.in[I_LNF];
    const int lane = threadIdx.x & 63; const int gw = blockIdx.x * 4 + (threadIdx.x >> 6), ngw = gridDim.x * 4;
    for (int m = gw; m < NTOK; m += ngw) {
        float s = 0.f;
#pragma unroll
        for (int j = 0; j < 16; ++j) s += SSQ3[(size_t)m * 16 + j];
        const float rstd = rsqrtf(s * (1.f / 1024.f) + EPS);
#pragma unroll
        for (int j = 0; j < 4; ++j) { float4 v = *(const float4*)(OUT + (size_t)m * 1024 + j * 256 + lane * 4); const float4 gg = *(const float4*)(g + j * 256 + lane * 4);
            v.x *= rstd * gg.x; v.y *= rstd * gg.y; v.z *= rstd * gg.z; v.w *= rstd * gg.w; *(float4*)(OUT + (size_t)m * 1024 + j * 256 + lane * 4) = v; }
    }
}

namespace cg = cooperative_groups;
template <int PH> DEV void run_phase(const Args& a, unsigned char* smem) {
    if constexpr (PH == PH_PRO) phase_prologue(a, smem);
    else if constexpr (PH == PH_INPROJ) phase_inproj(a, smem);
    else if constexpr (PH == PH_CMP) phase_cmp(a, smem);
    else if constexpr (PH == PH_ATT) phase_att(a, smem);
    else if constexpr (PH == PH_OUTPROJ) phase_outproj(a, smem);
    else if constexpr (PH == PH_ROUTE) phase_route(a, smem);
    else if constexpr (PH == PH_UP) phase_up(a, smem);
    else if constexpr (PH == PH_DOWN) phase_down(a, smem);
    else if constexpr (PH == PH_COMB) phase_comb(a, smem);
    else if constexpr (PH == PH_GATE) phase_gate(a, smem);
    else if constexpr (PH == PH_FINAL) phase_final(a);
}
#define XB_TMO      128
#define XB_XCNT(j)  (256  + 64 * (j))
#define XB_XSUB(j)  (1280 + 64 * (j))
#define XB_XGEN(j)  (2304 + 64 * (j))
#define XB_TOP      3328
#define XB_TOPGEN   3392
#define XCD_BAR_WORDS 3456
#define XB_SPIN_CAP (1u << 22)
DEV unsigned xb_ld(unsigned* p)              { return __hip_atomic_load(p, __ATOMIC_RELAXED, __HIP_MEMORY_SCOPE_AGENT); }
DEV unsigned xb_add(unsigned* p, unsigned v) { return __hip_atomic_fetch_add(p, v, __ATOMIC_RELAXED, __HIP_MEMORY_SCOPE_AGENT); }
DEV unsigned xb_xcc_id() { return (unsigned)__builtin_amdgcn_s_getreg((3 << 11) | 20) & 0xFu; }
#define XB_SPIN(cond, bar) do { unsigned _sp = 0; while (cond) { __builtin_amdgcn_s_sleep(1); \
    if ((++_sp & 255u) == 0u) { if (xb_ld(&(bar)[XB_TMO])) break; if (_sp > XB_SPIN_CAP) { atomicAdd(&(bar)[XB_TMO], 1u); break; } } } } while (0)
struct XcdBarrier { unsigned* bar; unsigned x; volatile LAS unsigned* st; };
DEV XcdBarrier xcd_barrier_post(unsigned* bar, volatile LAS unsigned* st) {
    XcdBarrier b; b.bar = bar; b.x = xb_xcc_id(); b.st = st;
    if (threadIdx.x == 0) (void)xb_add(&bar[XB_XCNT(b.x)], 1u);
    return b;
}
DEV void xcd_barrier_complete(unsigned* bar, unsigned x, unsigned& nloc, unsigned& nx) {
    const unsigned G = gridDim.x * gridDim.y * gridDim.z;
    unsigned sum, cnt, mine, sp = 0u;
    for (;;) {
        sum = 0u; cnt = 0u; mine = 0u;
#pragma unroll
        for (unsigned j = 0; j < 16; ++j) { const unsigned c = xb_ld(&bar[XB_XCNT(j)]); sum += c; cnt += (c > 0u) ? 1u : 0u; mine = (j == x) ? c : mine; }
        if (sum == G) break;
        __builtin_amdgcn_s_sleep(1);
        if ((++sp & 255u) == 0u) { if (xb_ld(&bar[XB_TMO])) break; if (sp > XB_SPIN_CAP) { atomicAdd(&bar[XB_TMO], 1u); break; } }
    }
    nloc = mine > 0u ? mine : 1u; nx = cnt > 0u ? cnt : 1u;
}
DEV void xcd_barrier(const XcdBarrier& b) {
    asm volatile("s_waitcnt vmcnt(0)" ::: "memory");
    __syncthreads();
    if (threadIdx.x == 0) {
        unsigned* bar = b.bar;
        __builtin_amdgcn_s_waitcnt(0);
        unsigned nloc = b.st[0], nx = b.st[1];
        if (nloc == 0u) { xcd_barrier_complete(bar, b.x, nloc, nx); b.st[0] = nloc; b.st[1] = nx; }
        const unsigned old = xb_add(&bar[XB_XSUB(b.x)], 1u);
        const unsigned gen = old / nloc;
        if (old + 1u == (gen + 1u) * nloc) {
            __builtin_amdgcn_fence(__ATOMIC_RELEASE, "agent");
            asm volatile("s_waitcnt vmcnt(0)" ::: "memory");
            const unsigned og = xb_add(&bar[XB_TOP], 1u);
            const unsigned tg = og / nx;
            if (og + 1u == (tg + 1u) * nx) xb_add(&bar[XB_TOPGEN], 1u);
            else XB_SPIN(xb_ld(&bar[XB_TOPGEN]) == tg, bar);
            __builtin_amdgcn_fence(__ATOMIC_ACQUIRE, "agent");
            xb_add(&bar[XB_XGEN(b.x)], 1u);
            asm volatile("s_waitcnt vmcnt(0)" ::: "memory");
        } else {
            XB_SPIN(xb_ld(&bar[XB_XGEN(b.x)]) == gen, bar);
            __builtin_amdgcn_fence(__ATOMIC_ACQUIRE, "agent");
            asm volatile("s_waitcnt vmcnt(0)" ::: "memory");
        }
    }
    __syncthreads();
}

__global__ void __launch_bounds__(256, 2) mega(Args a) {
    extern __shared__ __attribute__((aligned(16))) unsigned char smem[];
    volatile LAS unsigned* bst = (volatile LAS unsigned*)(LAS unsigned char*)(smem + MISC_OFF + 4000);
    if (threadIdx.x == 0) { bst[0] = 0u; bst[1] = 0u; }
    __syncthreads();
    const XcdBarrier bar = xcd_barrier_post((unsigned*)(a.ws + WS_CTL) + 4096, bst);
#define GSYNC() xcd_barrier(bar)
    run_phase<PH_PRO>(a, smem); GSYNC();
    run_phase<PH_INPROJ>(a, smem); GSYNC();
    run_phase<PH_CMP>(a, smem); GSYNC();
    run_phase<PH_ATT>(a, smem); GSYNC();
    run_phase<PH_OUTPROJ>(a, smem); GSYNC();
    run_phase<PH_ROUTE>(a, smem); GSYNC();
    run_phase<PH_UP>(a, smem); GSYNC();
    run_phase<PH_DOWN>(a, smem); GSYNC();
    run_phase<PH_COMB>(a, smem); GSYNC();
    run_phase<PH_GATE>(a, smem); GSYNC();
    run_phase<PH_FINAL>(a, smem);
#undef GSYNC
}

extern "C" void kernel_launch(void* const* d_in, const int* in_sizes, int n_in, void* d_out, int out_size, void* d_ws, size_t ws_size, hipStream_t stream) {
    static int grid = 0;
    if (grid == 0) {
        if (n_in != 25 || ws_size < WS_END) { fprintf(stderr, "kernel_launch: unexpected n_in %d / ws %zu\n", n_in, ws_size); grid = -1; return; }
        int dev = 0, cus = 0, per_cu = 0;
        (void)hipGetDevice(&dev); (void)hipDeviceGetAttribute(&cus, hipDeviceAttributeMultiprocessorCount, dev);
        (void)hipFuncSetAttribute((const void*)mega, hipFuncAttributeMaxDynamicSharedMemorySize, LDS_BYTES);
        (void)hipOccupancyMaxActiveBlocksPerMultiprocessor(&per_cu, (const void*)mega, 256, LDS_BYTES);
        if (per_cu < 1) { fprintf(stderr, "kernel_launch: occupancy query says %d blocks per CU\n", per_cu); grid = -1; return; }
        if (per_cu > 2) per_cu = 2;
        grid = cus * per_cu;
    }
    if (grid < 0) return;
    (void)hipMemsetAsync((char*)d_ws + WS_CTL, 0, 65536, stream);
    Args a{};
    for (int i = 0; i < 25; ++i) a.in[i] = (const float*)d_in[i];
    a.out = (float*)d_out; a.ws = (unsigned char*)d_ws; a.ph_lo = 0; a.ph_hi = PH_N;
    void* args[] = {&a};
    hipError_t e = hipLaunchCooperativeKernel((const void*)mega, dim3(grid), dim3(256), args, LDS_BYTES, stream);
    if (e != hipSuccess) fprintf(stderr, "cooperative launch failed: %s (grid %d)\n", hipGetErrorString(e), grid);
}
```

```cpp
#include <hip/hip_runtime.h>
#include <hip/hip_cooperative_groups.h>
#include <stdint.h>
#include <cstdio>

#define DEV __device__ __forceinline__
#define LAS __attribute__((address_space(3)))

typedef unsigned short bf16_t;
typedef short bf16x8 __attribute__((ext_vector_type(8)));
typedef short s16x4 __attribute__((ext_vector_type(4)));
typedef float f32x4 __attribute__((ext_vector_type(4)));
typedef float f32x2_t __attribute__((ext_vector_type(2)));
typedef __bf16 bf16x2_t __attribute__((ext_vector_type(2)));

#ifndef GEMM_EMU
#define GEMM_EMU 0
#endif

constexpr int T_ = 8192, NTOK = 16384;
constexpr float EPS = 1e-6f;
constexpr float LOG2E = 1.4426950408889634f;
constexpr float QS = 0.125f * LOG2E;
constexpr int NWIN = 2944;

constexpr size_t MiB = 1u << 20;
constexpr size_t WS_CTL = 0;
constexpr size_t WS_WIN = 1 * MiB;
constexpr size_t WS_WOUT = 7 * MiB;
constexpr size_t WS_WGATE = 9 * MiB;
constexpr size_t WS_WPLE = 11 * MiB;
constexpr size_t WS_WC1 = 12 * MiB;
constexpr size_t WS_WC2 = 13 * MiB;
constexpr size_t WS_BIAS1 = 13 * MiB + 65536;
constexpr size_t WS_KC = 14 * MiB;
constexpr size_t WS_HID = 15 * MiB;
constexpr size_t WS_GN = 16 * MiB;
constexpr size_t WS_LS = 18 * MiB;
constexpr size_t WS_CUM = 19 * MiB;
constexpr size_t WS_SSQ = 20 * MiB;
constexpr size_t WS_TOPI = 21 * MiB;
constexpr size_t WS_TOPS = 21 * MiB + 262144;
constexpr size_t WS_TOPW = 21 * MiB + 524288;
constexpr size_t WS_TOKOF = 22 * MiB;
constexpr size_t WS_ROWW = 24 * MiB;
constexpr size_t WS_SSQ3 = 26 * MiB;
constexpr size_t WS_RSTD2 = 27 * MiB;
constexpr size_t WS_PB = 28 * MiB;
constexpr size_t WS_XN = 36 * MiB;
constexpr size_t WS_PROJ = 68 * MiB;
constexpr size_t WS_ONSA = 160 * MiB;
constexpr size_t WS_OFOX = 176 * MiB;
constexpr size_t WS_H1 = 192 * MiB;
constexpr size_t WS_WUP = 256 * MiB;
constexpr size_t WS_WDN = 384 * MiB;
constexpr size_t WS_ACT = 448 * MiB;
constexpr size_t WS_Y = 584 * MiB;
constexpr size_t WS_END = 720 * MiB;

enum { PH_PRO = 0, PH_INPROJ, PH_CMP, PH_ATT, PH_OUTPROJ, PH_ROUTE, PH_UP, PH_DOWN, PH_COMB, PH_GATE, PH_FINAL, PH_N };

struct Args { const float* in[25]; float* out; unsigned char* ws; int ph_lo, ph_hi; };
enum { I_X = 0, I_P, I_LN1, I_WIN, I_BFG, I_WC1K, I_WC2K, I_PEK, I_WC1V, I_WC2V, I_PEV, I_GNN, I_GNF, I_WOUT, I_LN2, I_WR, I_BR,
       I_WUP, I_BUP, I_WDN, I_BDN, I_LNPLE, I_WPLE, I_WGATE, I_LNF };

DEV int TID() { int t = (int)__builtin_amdgcn_workitem_id_x(); asm volatile("" : "+v"(t)); return t; }
DEV unsigned cvtpk(float lo, float hi) { f32x2_t v = {lo, hi}; bf16x2_t b = __builtin_convertvector(v, bf16x2_t); return __builtin_bit_cast(unsigned, b); }
DEV float bf2f(unsigned short b) { return __uint_as_float(((unsigned)b) << 16); }
DEV float bflo(unsigned u) { return __uint_as_float(u << 16); }
DEV float bfhi(unsigned u) { return __uint_as_float(u & 0xffff0000u); }
DEV void unpack8(const uint4& u, float* f) { f[0] = bflo(u.x); f[1] = bfhi(u.x); f[2] = bflo(u.y); f[3] = bfhi(u.y); f[4] = bflo(u.z); f[5] = bfhi(u.z); f[6] = bflo(u.w); f[7] = bfhi(u.w); }
DEV float wave_sum(float v) {
#pragma unroll
    for (int o = 1; o < 64; o <<= 1) v += __shfl_xor(v, o);
    return v;
}
DEV float sigmoidf_(float x) { return 1.0f / (1.0f + __expf(-x)); }
DEV float logsigmoidf_(float x) { return fminf(x, 0.f) - log1pf(__expf(-fabsf(x))); }
DEV float gelu_tanh(float x) { const float u = 0.7978845608028654f * (x + 0.044715f * x * x * x); const float th = 1.0f - 2.0f / (__expf(2.0f * u) + 1.0f); return 0.5f * x * (1.0f + th); }

constexpr int GA_BYTES = 128 * 128;
constexpr int GB_STRIDE = 288;
constexpr int GB_BYTES = 64 * GB_STRIDE;
constexpr int GSTAGE = GA_BYTES + GB_BYTES;
constexpr int GEMM_LDS = 2 * GSTAGE;
constexpr int MISC_OFF = GEMM_LDS;
constexpr int LDS_BYTES = GEMM_LDS + 4096;

DEV s16x4 tr_read(const unsigned char* p) {
    typedef short v4i16_t __attribute__((ext_vector_type(4)));
    return __builtin_bit_cast(s16x4, __builtin_amdgcn_ds_read_tr16_b64_v4i16((LAS v4i16_t*)p));
}

struct F8 { float4 a, b; };
DEV uint4 f8_to_bf16(const F8& x) { uint4 o; o.x = cvtpk(x.a.x, x.a.y); o.y = cvtpk(x.a.z, x.a.w); o.z = cvtpk(x.b.x, x.b.y); o.w = cvtpk(x.b.z, x.b.w); return o; }
struct IdCvt { DEV uint4 operator()(const uint4& v, int, int, int) const { return v; } };
template <class AL, class ACV, class BL, class BCV>
DEV void gemm_mainloop2(unsigned char* smem, int nkt, const AL& al, const ACV& acv, const BL& bl, const BCV& bcv, f32x4 (&acc)[4][4]) {
    const int tid = TID(), lane = tid & 63, wid = tid >> 6, wr = wid >> 1, wc = wid & 1;
    decltype(al(0, 0, 0)) ra[4]; decltype(bl(0, 0, 0)) rb[4];
#pragma unroll
    for (int mi = 0; mi < 4; ++mi)
#pragma unroll
        for (int ni = 0; ni < 4; ++ni) acc[mi][ni] = (f32x4){0.f, 0.f, 0.f, 0.f};
#define G_LOAD(kt) do { _Pragma("unroll") for (int i_ = 0; i_ < 4; ++i_) { const int id_ = tid + 256 * i_; ra[i_] = al(id_ >> 3, id_ & 7, (kt)); } \
                        _Pragma("unroll") for (int i_ = 0; i_ < 4; ++i_) { const int id_ = tid + 256 * i_; rb[i_] = bl(id_ >> 4, id_ & 15, (kt)); } } while (0)
#define G_STORE(st, kt) do { unsigned char* A_ = smem + (st) * GSTAGE; unsigned char* B_ = A_ + GA_BYTES; \
        _Pragma("unroll") for (int i_ = 0; i_ < 4; ++i_) { const int id_ = tid + 256 * i_; const int r_ = id_ >> 3, kc_ = id_ & 7; *(uint4*)(A_ + r_ * 128 + ((kc_ ^ (r_ & 7)) << 4)) = acv(ra[i_], r_, kc_, (kt)); } \
        _Pragma("unroll") for (int i_ = 0; i_ < 4; ++i_) { const int id_ = tid + 256 * i_; const int k_ = id_ >> 4, nc_ = id_ & 15; *(uint4*)(B_ + k_ * GB_STRIDE + nc_ * 16) = bcv(rb[i_], k_, nc_, (kt)); } } while (0)
    G_LOAD(0); G_STORE(0, 0); __syncthreads();
    for (int kt = 0; kt < nkt; ++kt) {
        const bool more = (kt + 1 < nkt);
        if (more) G_LOAD(kt + 1);
        const unsigned char* A = smem + (kt & 1) * GSTAGE; const unsigned char* Bt = A + GA_BYTES;
#if GEMM_EMU
        for (int k = 0; k < 64; ++k) {
            float av[4], bv[4][4];
#pragma unroll
            for (int mi = 0; mi < 4; ++mi) { const int m = wr * 64 + mi * 16 + (lane & 15); av[mi] = bf2f(*(const bf16_t*)(A + m * 128 + (((k >> 3) ^ (m & 7)) << 4) + (k & 7) * 2)); }
#pragma unroll
            for (int ni = 0; ni < 4; ++ni)
#pragma unroll
                for (int r = 0; r < 4; ++r) { const int n = wc * 64 + ni * 16 + 4 * (lane >> 4) + r; bv[ni][r] = bf2f(*(const bf16_t*)(Bt + k * GB_STRIDE + n * 2)); }
#pragma unroll
            for (int mi = 0; mi < 4; ++mi)
#pragma unroll
                for (int ni = 0; ni < 4; ++ni)
#pragma unroll
                    for (int r = 0; r < 4; ++r) acc[mi][ni][r] += av[mi] * bv[ni][r];
        }
#else
#pragma unroll
        for (int ks = 0; ks < 2; ++ks) {
            bf16x8 af[4], wf[4];
#pragma unroll
            for (int mi = 0; mi < 4; ++mi) { const int m = wr * 64 + mi * 16 + (lane & 15); const int kc = ks * 4 + (lane >> 4); af[mi] = *(const bf16x8*)(A + m * 128 + ((kc ^ (m & 7)) << 4)); }
#pragma unroll
            for (int ni = 0; ni < 4; ++ni) {
                const int i = lane & 15; const int row = ks * 32 + 8 * (lane >> 4) + (i >> 2); const int col = wc * 64 + ni * 16 + 4 * (i & 3);
                const unsigned char* p = Bt + row * GB_STRIDE + col * 2;
                const s16x4 lo = tr_read(p), hi = tr_read(p + 4 * GB_STRIDE);
                wf[ni] = (bf16x8){lo[0], lo[1], lo[2], lo[3], hi[0], hi[1], hi[2], hi[3]};
            }
#pragma unroll
            for (int mi = 0; mi < 4; ++mi)
#pragma unroll
                for (int ni = 0; ni < 4; ++ni) acc[mi][ni] = __builtin_amdgcn_mfma_f32_16x16x32_bf16(wf[ni], af[mi], acc[mi][ni], 0, 0, 0);
        }
#endif
        if (more) G_STORE((kt + 1) & 1, kt + 1);
        __syncthreads();
    }
#undef G_LOAD
#undef G_STORE
}

template <class AL, class BL>
DEV void gemm_mainloop(unsigned char* smem, int nkt, const AL& al, const BL& bl, f32x4 (&acc)[4][4]) { gemm_mainloop2(smem, nkt, al, IdCvt(), bl, IdCvt(), acc); }

DEV void convert_chunk(const float* src, bf16_t* dst, size_t i8) {
    const float4 a = *(const float4*)(src + i8 * 8), b = *(const float4*)(src + i8 * 8 + 4);
    uint4 o; o.x = cvtpk(a.x, a.y); o.y = cvtpk(a.z, a.w); o.z = cvtpk(b.x, b.y); o.w = cvtpk(b.z, b.w);
    *(uint4*)(dst + i8 * 8) = o;
}
DEV void phase_prologue(const Args& a, unsigned char* smem) {
    unsigned char* ws = a.ws;
    const size_t gtid = (size_t)blockIdx.x * 256 + TID(), gn = (size_t)gridDim.x * 256;
    {
        { const float* s0 = a.in[I_WUP]; bf16_t* d0 = (bf16_t*)(ws + WS_WUP); const size_t n0 = (size_t)32 * 1024 * 2048 / 8;
          for (size_t i = gtid; i < n0; i += 4 * gn) {
#pragma unroll
              for (int u = 0; u < 4; ++u) if (i + u * gn < n0) convert_chunk(s0, d0, i + u * gn); }
          const float* s1 = a.in[I_WDN]; bf16_t* d1 = (bf16_t*)(ws + WS_WDN); const size_t n1 = (size_t)32 * 1024 * 1024 / 8;
          for (size_t i = gtid; i < n1; i += 4 * gn) {
#pragma unroll
              for (int u = 0; u < 4; ++u) if (i + u * gn < n1) convert_chunk(s1, d1, i + u * gn); } }
        const float* srcs[8] = {a.in[I_WOUT], a.in[I_WGATE], a.in[I_WPLE], a.in[I_WC1K], a.in[I_WC1V], a.in[I_WC2K], a.in[I_WC2V], a.in[I_P]};
        bf16_t* dsts[8] = {(bf16_t*)(ws + WS_WOUT), (bf16_t*)(ws + WS_WGATE), (bf16_t*)(ws + WS_WPLE),
                            (bf16_t*)(ws + WS_WC1), (bf16_t*)(ws + WS_WC1) + 2048 * 128, (bf16_t*)(ws + WS_WC2), (bf16_t*)(ws + WS_WC2) + 128 * 64, (bf16_t*)(ws + WS_PB)};
        const size_t cnt8[8] = {1024 * 1024 / 8, 1024 * 1024 / 8, 256 * 1024 / 8, 2048 * 128 / 8, 2048 * 128 / 8, 128 * 64 / 8, 128 * 64 / 8, (size_t)NTOK * 256 / 8};
#pragma unroll
        for (int s = 0; s < 8; ++s) for (size_t i = gtid; i < cnt8[s]; i += gn) convert_chunk(srcs[s], dsts[s], i);
    }
    {
        const float* W = a.in[I_WIN]; bf16_t* O = (bf16_t*)(ws + WS_WIN);
        for (size_t i = gtid; i < (size_t)1024 * (NWIN / 8); i += gn) {
            const int k = (int)(i / (NWIN / 8)), j = (int)(i % (NWIN / 8)) * 8;
            uint4 o = {0u, 0u, 0u, 0u};
            if (j < 2848) {
                const int sj = (j < 1280) ? j : (j < 2816) ? j + 24 : (j < 2840) ? j - 1536 : j;
                const float4 x = *(const float4*)(W + (size_t)k * 2848 + sj), y = *(const float4*)(W + (size_t)k * 2848 + sj + 4);
                o.x = cvtpk(x.x, x.y); o.y = cvtpk(x.z, x.w); o.z = cvtpk(y.x, y.y); o.w = cvtpk(y.z, y.w);
            }
            *(uint4*)(O + (size_t)k * NWIN + j) = o;
        }
    }
    {
        const int lane = TID() & 63; const int gw = blockIdx.x * 4 + (TID() >> 6), ngw = gridDim.x * 4;
        const float* X = a.in[I_X]; const float* g = a.in[I_LN1]; bf16_t* XN = (bf16_t*)(ws + WS_XN);
        for (int m = gw; m < NTOK; m += ngw) {
            float4 v[4]; float s = 0.f;
#pragma unroll
            for (int j = 0; j < 4; ++j) { v[j] = *(const float4*)(X + (size_t)m * 1024 + j * 256 + lane * 4); s += v[j].x * v[j].x + v[j].y * v[j].y + v[j].z * v[j].z + v[j].w * v[j].w; }
            const float rstd = rsqrtf(wave_sum(s) * (1.f / 1024.f) + EPS);
#pragma unroll
            for (int j = 0; j < 4; ++j) { const float4 gg = *(const float4*)(g + j * 256 + lane * 4);
                uint2 o; o.x = cvtpk(v[j].x * rstd * gg.x, v[j].y * rstd * gg.y); o.y = cvtpk(v[j].z * rstd * gg.z, v[j].w * rstd * gg.w);
                *(uint2*)(XN + (size_t)m * 1024 + j * 256 + lane * 4) = o; }
        }
    }
    {
        const int lane = TID() & 63; const int gw = blockIdx.x * 4 + (TID() >> 6);
        if (gw < 256) {
            const int which = gw >> 7, n = gw & 127; const float* pe = a.in[which ? I_PEV : I_PEK]; const float* w1 = a.in[which ? I_WC1V : I_WC1K];
            float s = 0.f;
#pragma unroll 8
            for (int i = 0; i < 32; ++i) { const int k = lane + 64 * i; s += pe[k] * w1[(size_t)k * 128 + n]; }
            s = wave_sum(s);
            if (lane == 0) ((float*)(ws + WS_BIAS1))[which * 128 + n] = s;
        }
    }
}

DEV void phase_inproj(const Args& a, unsigned char* smem) {
    const bf16_t* XN = (const bf16_t*)(a.ws + WS_XN); const bf16_t* W = (const bf16_t*)(a.ws + WS_WIN);
    bf16_t* PROJ = (bf16_t*)(a.ws + WS_PROJ); float* GN = (float*)(a.ws + WS_GN); float* LS = (float*)(a.ws + WS_LS); const float* bfg = a.in[I_BFG];
    const int lane = TID() & 63, wid = TID() >> 6, wr = wid >> 1, wc = wid & 1;
    for (int item = blockIdx.x; item < 128 * 23; item += gridDim.x) {
        const int nt = item / 128, mt = item % 128;
        f32x4 acc[4][4];
        gemm_mainloop(smem, 16,
            [&](int r, int kc, int kt) { return *(const uint4*)(XN + (size_t)(mt * 128 + r) * 1024 + kt * 64 + kc * 8); },
            [&](int k, int nc, int kt) { return *(const uint4*)(W + (size_t)(kt * 64 + k) * NWIN + nt * 128 + nc * 8); }, acc);
#pragma unroll
        for (int mi = 0; mi < 4; ++mi) {
            const int gm = mt * 128 + wr * 64 + mi * 16 + (lane & 15); const int b = gm >> 13, t = gm & 8191;
#pragma unroll
            for (int ni = 0; ni < 4; ++ni) {
                const int n = wc * 64 + ni * 16 + 4 * (lane >> 4); const f32x4 v = acc[mi][ni];
                if (nt < 22) {
                    const int hs = nt * 2 + (n >> 6), d = n & 63; const float sc = (hs < 8 || (hs >= 20 && hs < 28)) ? QS : 1.0f;
                    uint2 o; o.x = cvtpk(v[0] * sc, v[1] * sc); o.y = cvtpk(v[2] * sc, v[3] * sc);
                    *(uint2*)(PROJ + (((size_t)(hs * 2 + b)) * 8192 + t) * 64 + d) = o;
                } else if (n < 24) {
#pragma unroll
                    for (int r = 0; r < 4; ++r) GN[(size_t)gm * 24 + n + r] = sigmoidf_(v[r]);
                } else if (n < 32) {
#pragma unroll
                    for (int r = 0; r < 4; ++r) { const int h = n - 24 + r; LS[((size_t)(b * 8 + h)) * 8192 + t] = logsigmoidf_(v[r] + bfg[h]); }
                }
            }
        }
    }
}

DEV void phase_cmp(const Args& a, unsigned char* smem) {
    const bf16_t* PROJ = (const bf16_t*)(a.ws + WS_PROJ);
    const int tid = TID(), lane = tid & 63, wid = tid >> 6, wr = wid >> 1, wc = wid & 1;
    for (int item = blockIdx.x; item < 32 + 16; item += gridDim.x) {
        if (item < 32) {
            const int which = item >> 4, b = (item >> 3) & 1, g = (item >> 2) & 1, mt = item & 3;
            const bf16_t* base = PROJ + ((size_t)((8 + 2 * which + g) * 2 + b)) * 8192 * 64;
            const bf16_t* W1 = (const bf16_t*)(a.ws + WS_WC1) + (size_t)which * 2048 * 128;
            const bf16_t* W2 = (const bf16_t*)(a.ws + WS_WC2) + (size_t)which * 128 * 64;
            const float* bias1 = (const float*)(a.ws + WS_BIAS1) + which * 128;
            bf16_t* HID = (bf16_t*)(a.ws + WS_HID) + ((size_t)(which * 4 + b * 2 + g)) * 512 * 128;
            bf16_t* OUT = (bf16_t*)(a.ws + WS_KC) + ((size_t)(which * 4 + b * 2 + g)) * 512 * 64;
            f32x4 acc[4][4];
            gemm_mainloop(smem, 32,
                [&](int r, int kc, int kt) { int c = mt * 128 + r; c = c > 510 ? 510 : c; return *(const uint4*)(base + (size_t)c * 1024 + kt * 64 + kc * 8); },
                [&](int k, int nc, int kt) { return *(const uint4*)(W1 + (size_t)(kt * 64 + k) * 128 + nc * 8); }, acc);
#pragma unroll
            for (int mi = 0; mi < 4; ++mi) { const int c = mt * 128 + wr * 64 + mi * 16 + (lane & 15);
#pragma unroll
                for (int ni = 0; ni < 4; ++ni) { const int n = wc * 64 + ni * 16 + 4 * (lane >> 4); const f32x4 v = acc[mi][ni]; const float4 bb = *(const float4*)(bias1 + n);
                    uint2 o; o.x = cvtpk(gelu_tanh(v[0] + bb.x), gelu_tanh(v[1] + bb.y)); o.y = cvtpk(gelu_tanh(v[2] + bb.z), gelu_tanh(v[3] + bb.w));
                    *(uint2*)(HID + (size_t)c * 128 + n) = o; } }
            __syncthreads();
            gemm_mainloop(smem, 2,
                [&](int r, int kc, int kt) { return *(const uint4*)(HID + (size_t)(mt * 128 + r) * 128 + kt * 64 + kc * 8); },
                [&](int k, int nc, int kt) { uint4 z = {0u, 0u, 0u, 0u}; if (nc < 8) z = *(const uint4*)(W2 + (size_t)(kt * 64 + k) * 64 + nc * 8); return z; }, acc);
            if (wc == 0) {
#pragma unroll
                for (int mi = 0; mi < 4; ++mi) { const int c = mt * 128 + wr * 64 + mi * 16 + (lane & 15);
#pragma unroll
                    for (int ni = 0; ni < 4; ++ni) { const int n = ni * 16 + 4 * (lane >> 4); const f32x4 v = acc[mi][ni];
                        uint2 o; o.x = cvtpk(v[0], v[1]); o.y = cvtpk(v[2], v[3]);
                        if (c >= 511) { o.x = 0u; o.y = 0u; }
                        *(uint2*)(OUT + (size_t)c * 64 + n) = o; } }
            }
            __syncthreads();
        } else {
            const int bh = item - 32; const float* LS = (const float*)(a.ws + WS_LS) + (size_t)bh * 8192; float* CUM = (float*)(a.ws + WS_CUM) + (size_t)bh * 8192;
            float* sc = (float*)smem;
            float v[32]; float s = 0.f;
#pragma unroll
            for (int j = 0; j < 8; ++j) { const float4 x = *(const float4*)(LS + tid * 32 + j * 4); v[4 * j] = x.x; v[4 * j + 1] = x.y; v[4 * j + 2] = x.z; v[4 * j + 3] = x.w; }
#pragma unroll
            for (int j = 0; j < 32; ++j) { s += v[j]; v[j] = s; }
            sc[tid] = s; __syncthreads();
            if (tid == 0) { float run = 0.f; for (int i = 0; i < 256; ++i) { const float x = sc[i]; sc[i] = run; run += x; } }
            __syncthreads();
            const float off = sc[tid];
#pragma unroll
            for (int j = 0; j < 8; ++j) { float4 o = {v[4 * j] + off, v[4 * j + 1] + off, v[4 * j + 2] + off, v[4 * j + 3] + off}; *(float4*)(CUM + tid * 32 + j * 4) = o; }
            __syncthreads();
        }
    }
}

DEV void load_row64(const bf16_t* p, float* f) {
#pragma unroll
    for (int c = 0; c < 8; ++c) { const uint4 u = *(const uint4*)(p + c * 8); unpack8(u, f + c * 8); }
}
DEV float dot64(const float* q, const bf16_t* kp) {
    float s = 0.f;
#pragma unroll
    for (int c = 0; c < 8; ++c) { const uint4 u = *(const uint4*)(kp + c * 8); float f[8]; unpack8(u, f);
#pragma unroll
        for (int j = 0; j < 8; ++j) s += q[c * 8 + j] * f[j]; }
    return s;
}
DEV void axpy64(float* o, float p, const bf16_t* vp) {
#pragma unroll
    for (int c = 0; c < 8; ++c) { const uint4 u = *(const uint4*)(vp + c * 8); float f[8]; unpack8(u, f);
#pragma unroll
        for (int j = 0; j < 8; ++j) o[c * 8 + j] += p * f[j]; }
}
DEV void scale64(float* o, float s) {
#pragma unroll
    for (int j = 0; j < 64; ++j) o[j] *= s;
}
#define ONLINE_STEP(valid, s, vp) do { if (valid) { const float mn_ = fmaxf(m, (s)); const float al_ = exp2f(m - mn_); const float p_ = exp2f((s) - mn_); l = l * al_ + p_; scale64(o, al_); axpy64(o, p_, (vp)); m = mn_; } } while (0)

DEV void nsa_naive_item(const Args& a, unsigned char* smem, int item) {
    const int tid = TID(), lane = tid & 63, wid = tid >> 6;
    const int b = item / 256, g = (item / 128) & 1, tt = item & 127;
    const int tl = lane >> 2, r = lane & 3, h = g * 4 + r;
    const int t = tt * 64 + wid * 16 + tl; const int token = b * 8192 + t;
    const float slope2 = exp2f(-(float)(h + 1)) * LOG2E;
    float* imp = (float*)smem + wid * (16 * 129) + tl * 129;
    int* seli = (int*)(smem + 4 * 16 * 129 * 4) + wid * 256 + tl * 16;
    const bf16_t* PROJ = (const bf16_t*)(a.ws + WS_PROJ);
    const float* GN = (const float*)(a.ws + WS_GN) + (size_t)token * 24 + h * 3;
    float* TMP = (float*)(a.ws + WS_ACT) + ((size_t)token * 8 + h) * 64;
    float q[64]; load_row64(PROJ + (((size_t)(h * 2 + b)) * 8192 + t) * 64, q);
    float o[64];
    const bf16_t* KC = (const bf16_t*)(a.ws + WS_KC) + ((size_t)(0 * 4 + b * 2 + g)) * 512 * 64;
    const bf16_t* VC = (const bf16_t*)(a.ws + WS_KC) + ((size_t)(1 * 4 + b * 2 + g)) * 512 * 64;
    const int cl = (t >= 31) ? (t - 31) / 16 : -1;
    const int tmaxw = tt * 64 + wid * 16 + 15; const int cmax = (tmaxw - 31) >= 0 ? (tmaxw - 31) / 16 : -1;
    for (int n = r; n < 129; n += 4) imp[n] = 0.f;
    float m = -1e30f, l = 0.f;
    for (int c = 0; c <= cmax; ++c) {
        const float s = dot64(q, KC + (size_t)c * 64) + slope2 * (float)(16 * c + 31 - t);
        if (c <= cl) { const float mn = fmaxf(m, s); l = l * exp2f(m - mn) + exp2f(s - mn); m = mn; }
    }
#pragma unroll
    for (int j = 0; j < 64; ++j) o[j] = 0.f;
    const float linv = 1.0f / fmaxf(l, 1e-30f);
    for (int c = 0; c <= cmax; ++c) {
        const float s = dot64(q, KC + (size_t)c * 64) + slope2 * (float)(16 * c + 31 - t);
        const float p = (c <= cl) ? exp2f(s - m) * linv : 0.f;
        axpy64(o, p, VC + (size_t)c * 64);
        float ps = p; ps += __shfl_xor(ps, 1); ps += __shfl_xor(ps, 2);
        if (r == 0) { imp[c >> 2] += ps; if ((c & 3) == 3) imp[(c >> 2) + 1] += ps; }
    }
    {
        const float g0 = GN[0];
#pragma unroll
        for (int j = 0; j < 64; ++j) TMP[j] = g0 * o[j];
    }
    const int cur = t >> 6;
    {
        unsigned long long tlo = 0ull, thi = 0ull;
        for (int kk = 0; kk < 16; ++kk) {
            float best = -2.0f; int bi = 0;
            for (int n = 0; n < 128; ++n) {
                const bool taken = (n < 64) ? ((tlo >> n) & 1ull) : ((thi >> (n - 64)) & 1ull);
                if (taken) continue;
                const bool valid = n <= cur; const bool forced = valid && (n == 0 || n == cur || n == cur - 1);
                const float sc = forced ? 1e9f : (valid ? imp[n] : -1.0f);
                if (sc > best) { best = sc; bi = n; }
            }
            if (bi < 64) tlo |= 1ull << bi; else thi |= 1ull << (bi - 64);
            if (r == 0) seli[kk] = bi;
        }
    }
    {
        const bf16_t* KS = PROJ + ((size_t)((12 + g) * 2 + b)) * 8192 * 64; const bf16_t* VS = PROJ + ((size_t)((14 + g) * 2 + b)) * 8192 * 64;
        m = -1e30f; l = 0.f;
#pragma unroll
        for (int j = 0; j < 64; ++j) o[j] = 0.f;
        for (int kk = 0; kk < 16; ++kk) {
            const int n = seli[kk];
            for (int j = 0; j < 64; ++j) {
                const int pos = n * 64 + j; const bool valid = pos <= t;
                const int pc = valid ? pos : t;
                const float s = dot64(q, KS + (size_t)pc * 64) + slope2 * (float)(pos - t);
                ONLINE_STEP(valid, s, VS + (size_t)pc * 64);
            }
        }
        const float g1 = GN[1] / fmaxf(l, 1e-30f);
#pragma unroll
        for (int j = 0; j < 64; ++j) TMP[j] += g1 * o[j];
    }
    {
        const bf16_t* KW = PROJ + ((size_t)((16 + g) * 2 + b)) * 8192 * 64; const bf16_t* VW = PROJ + ((size_t)((18 + g) * 2 + b)) * 8192 * 64;
        m = -1e30f; l = 0.f;
#pragma unroll
        for (int j = 0; j < 64; ++j) o[j] = 0.f;
        for (int j = 0; j < 512; ++j) {
            const int pos = t - 511 + j; const bool valid = pos >= 0; const int pc = valid ? pos : 0;
            const float s = dot64(q, KW + (size_t)pc * 64) + slope2 * (float)(pos - t);
            ONLINE_STEP(valid, s, VW + (size_t)pc * 64);
        }
        const float g2 = GN[2] / fmaxf(l, 1e-30f);
        float ss = 0.f;
        bf16_t* O = (bf16_t*)(a.ws + WS_ONSA) + (size_t)token * 512 + h * 64;
#pragma unroll
        for (int j = 0; j < 64; j += 2) { const float v0 = TMP[j] + g2 * o[j], v1 = TMP[j + 1] + g2 * o[j + 1]; ss += v0 * v0 + v1 * v1; *(unsigned*)(O + j) = cvtpk(v0, v1); }
        ((float*)(a.ws + WS_SSQ))[(size_t)token * 16 + h] = ss;
    }
}
DEV void fox_naive_item(const Args& a, int item) {
    const int tid = TID();
    const int b = item / 256, h = (item / 32) & 7, tile = item & 31;
    const int t = tile * 256 + tid; const int token = b * 8192 + t;
    const bf16_t* PROJ = (const bf16_t*)(a.ws + WS_PROJ);
    const bf16_t* K = PROJ + ((size_t)((28 + h) * 2 + b)) * 8192 * 64; const bf16_t* V = PROJ + ((size_t)((36 + h) * 2 + b)) * 8192 * 64;
    const float* CUM = (const float*)(a.ws + WS_CUM) + (size_t)(b * 8 + h) * 8192;
    float q[64]; load_row64(PROJ + (((size_t)((20 + h) * 2 + b)) * 8192 + t) * 64, q);
    float o[64];
#pragma unroll
    for (int j = 0; j < 64; ++j) o[j] = 0.f;
    float m = -1e30f, l = 0.f; const float ct = CUM[t];
    const int smax = tile * 256 + (tid | 63);
    for (int s_ = 0; s_ <= smax; ++s_) {
        const bool valid = s_ <= t;
        const float s = dot64(q, K + (size_t)s_ * 64) + (ct - CUM[s_]) * LOG2E;
        ONLINE_STEP(valid, s, V + (size_t)s_ * 64);
    }
    const float li = 1.0f / fmaxf(l, 1e-30f); float ss = 0.f;
    bf16_t* O = (bf16_t*)(a.ws + WS_OFOX) + (size_t)token * 512 + h * 64;
#pragma unroll
    for (int j = 0; j < 64; j += 2) { const float v0 = o[j] * li, v1 = o[j + 1] * li; ss += v0 * v0 + v1 * v1; *(unsigned*)(O + j) = cvtpk(v0, v1); }
    ((float*)(a.ws + WS_SSQ))[(size_t)token * 16 + 8 + h] = ss;
}
typedef float f32x16 __attribute__((ext_vector_type(16)));
constexpr int AT_STAGE = 16384;
constexpr int AT_BIAS_OFF = 2 * AT_STAGE;
constexpr int AT_IMP_OFF = AT_BIAS_OFF + 1024;
constexpr int AT_SEL_OFF = AT_IMP_OFF + 32768;
constexpr int AT_WUN_OFF = AT_SEL_OFF + 512;
constexpr int AT_UCNT_OFF = AT_WUN_OFF + 64;
constexpr int AT_ULIST_OFF = AT_UCNT_OFF + 16;
constexpr int AT_ITEM_OFF = AT_ULIST_OFF + 128;
static_assert(AT_ITEM_OFF + 16 <= LDS_BYTES, "attention LDS map");
#define NEG_INF (-__builtin_inff())

DEV int crow(int r, int hi) { return (r & 3) + 8 * (r >> 2) + 4 * hi; }
#define KV_DECL uint4 rk0_, rk1_, rv0_, rv1_
#define KV_GLOAD(Kt, Vt) do { const bf16_t* kt_ = (Kt); const bf16_t* vt_ = (Vt); rk0_ = *(const uint4*)(kt_ + tid * 8); rk1_ = *(const uint4*)(kt_ + (tid + 256) * 8); \
    rv0_ = *(const uint4*)(vt_ + tid * 8); rv1_ = *(const uint4*)(vt_ + (tid + 256) * 8); } while (0)
#define KV_LSTORE(stp) do { unsigned char* st_ = (stp); \
    { const int c = tid; const int key = c >> 3, ch = c & 7; \
      *(uint4*)(st_ + key * 128 + ((ch ^ (key & 7)) << 4)) = rk0_; \
      *(uint4*)(st_ + 8192 + key * 128 + ((((ch >> 2) ^ ((key >> 1) & 1))) << 6) + ((ch & 3) << 4)) = rv0_; } \
    { const int c = tid + 256; const int key = c >> 3, ch = c & 7; \
      *(uint4*)(st_ + key * 128 + ((ch ^ (key & 7)) << 4)) = rk1_; \
      *(uint4*)(st_ + 8192 + key * 128 + ((((ch >> 2) ^ ((key >> 1) & 1))) << 6) + ((ch & 3) << 4)) = rv1_; } } while (0)
DEV void qk_tile(const unsigned char* Kst, const bf16x8 (&qf)[4], f32x16& p0, f32x16& p1, int lane) {
    const int key = lane & 31, hi = lane >> 5;
#pragma unroll
    for (int ks = 0; ks < 4; ++ks) { const int ch = 2 * ks + hi; const int off = key * 128 + ((ch ^ (key & 7)) << 4);
        const bf16x8 k0 = *(const bf16x8*)(Kst + off), k1 = *(const bf16x8*)(Kst + off + 32 * 128);
        p0 = __builtin_amdgcn_mfma_f32_32x32x16_bf16(k0, qf[ks], p0, 0, 0, 0);
        p1 = __builtin_amdgcn_mfma_f32_32x32x16_bf16(k1, qf[ks], p1, 0, 0, 0); }
}
DEV void pv_tile(const unsigned char* Vst, const f32x16& p0, const f32x16& p1, f32x16 (&o)[2], int lane) {
    const int hi = lane >> 5, i = lane & 15, gg = (lane >> 4) & 1;
    bf16x8 pa[4];
#pragma unroll
    for (int s = 0; s < 4; ++s) { const f32x16& p = (s < 2) ? p0 : p1; const int b = (s & 1) * 8;
        unsigned w[4];
#pragma unroll
        for (int j = 0; j < 4; ++j) w[j] = cvtpk(p[b + 2 * j], p[b + 2 * j + 1]);
        typedef unsigned u32x4_t __attribute__((ext_vector_type(4)));
        u32x4_t ww = {w[0], w[1], w[2], w[3]}; pa[s] = __builtin_bit_cast(bf16x8, ww); }
    const int q = i >> 2; const int sw = (q >> 1) & 1;
#pragma unroll
    for (int s = 0; s < 4; ++s) {
#pragma unroll
        for (int dh = 0; dh < 2; ++dh) {
            const int row0 = 16 * s + 4 * hi + q;
            const unsigned char* p = Vst + row0 * 128 + ((dh ^ sw) << 6) + gg * 32 + (i & 3) * 8;
            const s16x4 lo = tr_read(p), hh = tr_read(p + 8 * 128);
            const bf16x8 vf = {lo[0], lo[1], lo[2], lo[3], hh[0], hh[1], hh[2], hh[3]};
            o[dh] = __builtin_amdgcn_mfma_f32_32x32x16_bf16(vf, pa[s], o[dh], 0, 0, 0);
        }
    }
}
DEV float rowmax32(const f32x16& p0, const f32x16& p1) {
    float a = fmaxf(p0[0], p1[0]);
#pragma unroll
    for (int r = 1; r < 16; ++r) a = fmaxf(a, fmaxf(p0[r], p1[r]));
    return fmaxf(a, __shfl_xor(a, 32));
}
DEV void softmax_step(f32x16& p0, f32x16& p1, float& m, float& l, f32x16 (&o)[2]) {
    const float mt = rowmax32(p0, p1); const float mn = fmaxf(m, mt); const float alpha = __builtin_amdgcn_exp2f(m - mn);
    float rs = 0.f;
#pragma unroll
    for (int r = 0; r < 16; ++r) { p0[r] = __builtin_amdgcn_exp2f(p0[r] - mn); p1[r] = __builtin_amdgcn_exp2f(p1[r] - mn); rs += p0[r] + p1[r]; }
    rs += __shfl_xor(rs, 32);
    l = l * alpha + rs; m = mn;
    if (__any(alpha != 1.0f)) { o[0] *= alpha; o[1] *= alpha; }
}
template <int STRIDE> DEV void mask_tile(f32x16& p0, f32x16& p1, int kpos0, int lo, int hi_lim, int hi) {
#pragma unroll
    for (int r = 0; r < 16; ++r) { const int kp = kpos0 + STRIDE * crow(r, hi);
        if (kp < lo || kp > hi_lim) p0[r] = NEG_INF;
        const int kp1 = kp + 32 * STRIDE; if (kp1 < lo || kp1 > hi_lim) p1[r] = NEG_INF; }
}
template <int STRIDE> DEV void alibi_init(f32x16& p0, f32x16& p1, float slope2, int kpos0, int tref, int hi) {
    const float base = slope2 * (float)(kpos0 - tref + STRIDE * 4 * hi);
#pragma unroll
    for (int r = 0; r < 16; ++r) { const float c = (float)(STRIDE * ((r & 3) + 8 * (r >> 2))); p0[r] = fmaf(slope2, c, base); p1[r] = fmaf(slope2, c + (float)(32 * STRIDE), base); }
}
template <class Src, class Body>
DEV void kv_pipeline(unsigned char* smem, int n, const Src& src, const Body& body) {
    if (n <= 0) return;
    KV_DECL; const int tid = TID(); const bf16_t *kp, *vp;
    src(0, kp, vp); KV_GLOAD(kp, vp); KV_LSTORE(smem);
    __syncthreads();
    for (int j = 0; j < n; ++j) {
        const bool more = j + 1 < n;
        if (more) { src(j + 1, kp, vp); KV_GLOAD(kp, vp); }
        body(j, smem + (j & 1) * AT_STAGE);
        if (more) KV_LSTORE(smem + ((j + 1) & 1) * AT_STAGE);
        __syncthreads();
    }
}

DEV void fox_item(const Args& a, unsigned char* smem, int b, int h, int qb) {
    const int tid = TID(), lane = tid & 63, wid = tid >> 6, r32 = lane & 31, hi = lane >> 5;
    const bf16_t* PROJ = (const bf16_t*)(a.ws + WS_PROJ);
    const bf16_t* Q = PROJ + ((size_t)((20 + h) * 2 + b)) * 8192 * 64; const bf16_t* K = PROJ + ((size_t)((28 + h) * 2 + b)) * 8192 * 64; const bf16_t* V = PROJ + ((size_t)((36 + h) * 2 + b)) * 8192 * 64;
    const float* CUM = (const float*)(a.ws + WS_CUM) + (size_t)(b * 8 + h) * 8192;
    const int q0 = qb * 128; const int qrow = q0 + 32 * wid + r32;
    bf16x8 qf[4];
#pragma unroll
    for (int ks = 0; ks < 4; ++ks) qf[ks] = *(const bf16x8*)(Q + (size_t)qrow * 64 + 16 * ks + 8 * hi);
    const float cref = CUM[q0];
    const int ntiles = 2 * qb + 2; const int jmax_w = (q0 + 32 * wid + 31) >> 6; const int jmask_w = (q0 + 32 * wid) >> 6;
    f32x16 o[2]; o[0] = (f32x16){}; o[1] = (f32x16){}; float m = -1e30f, l = 0.f;
    float* biasL = (float*)(smem + AT_BIAS_OFF);
    KV_DECL; float breg = 0.f;
    KV_GLOAD(K, V); if (tid < 64) breg = (cref - CUM[tid]) * LOG2E;
    KV_LSTORE(smem); if (tid < 64) biasL[tid] = breg;
    __syncthreads();
    for (int j = 0; j < ntiles; ++j) {
        const bool more = j + 1 < ntiles;
        if (more) { KV_GLOAD(K + (size_t)(j + 1) * 4096, V + (size_t)(j + 1) * 4096); if (tid < 64) breg = (cref - CUM[(j + 1) * 64 + tid]) * LOG2E; }
        if (j <= jmax_w) {
            const unsigned char* st = smem + (j & 1) * AT_STAGE; const float* bl = biasL + (j & 1) * 64;
            f32x16 p0, p1;
#pragma unroll
            for (int g4 = 0; g4 < 4; ++g4) { const float4 x = *(const float4*)(bl + 8 * g4 + 4 * hi), y = *(const float4*)(bl + 32 + 8 * g4 + 4 * hi);
                p0[4 * g4] = x.x; p0[4 * g4 + 1] = x.y; p0[4 * g4 + 2] = x.z; p0[4 * g4 + 3] = x.w; p1[4 * g4] = y.x; p1[4 * g4 + 1] = y.y; p1[4 * g4 + 2] = y.z; p1[4 * g4 + 3] = y.w; }
            qk_tile(st, qf, p0, p1, lane);
            if (j >= jmask_w) mask_tile<1>(p0, p1, 64 * j, -1, qrow, hi);
            softmax_step(p0, p1, m, l, o);
            pv_tile(st + 8192, p0, p1, o, lane);
        }
        if (more) { KV_LSTORE(smem + ((j + 1) & 1) * AT_STAGE); if (tid < 64) biasL[((j + 1) & 1) * 64 + tid] = breg; }
        __syncthreads();
    }
    const float inv = 1.0f / l; float ss = 0.f;
    const size_t token = (size_t)b * 8192 + qrow;
    bf16_t* O = (bf16_t*)(a.ws + WS_OFOX) + token * 512 + h * 64;
#pragma unroll
    for (int dh = 0; dh < 2; ++dh)
#pragma unroll
        for (int g4 = 0; g4 < 4; ++g4) { const float v0 = o[dh][4 * g4] * inv, v1 = o[dh][4 * g4 + 1] * inv, v2 = o[dh][4 * g4 + 2] * inv, v3 = o[dh][4 * g4 + 3] * inv;
            ss += v0 * v0 + v1 * v1 + v2 * v2 + v3 * v3; uint2 w; w.x = cvtpk(v0, v1); w.y = cvtpk(v2, v3); *(uint2*)(O + 32 * dh + 8 * g4 + 4 * hi) = w; }
    ss += __shfl_xor(ss, 32);
    if (hi == 0) ((float*)(a.ws + WS_SSQ))[token * 16 + 8 + h] = ss;
}

DEV void nsa_item(const Args& a, unsigned char* smem, int b, int g, int tt) {
    const int tid = TID(), lane = tid & 63, wid = tid >> 6, col = lane & 31, hi = lane >> 5;
    const int t0 = tt * 32, tokw = col >> 2, r = col & 3, h = 4 * g + r; const int tokl = wid * 8 + tokw; const int t = t0 + tokl; const size_t token = (size_t)b * 8192 + t;
    const float slope2 = exp2f(-(float)(h + 1)) * LOG2E;
    const bf16_t* PROJ = (const bf16_t*)(a.ws + WS_PROJ);
    const float* GN = (const float*)(a.ws + WS_GN) + token * 24 + h * 3;
    const int cur = t0 >> 6; const bool need_topk = cur > 15;
    bf16x8 qf[4];
    { const bf16_t* Q = PROJ + (((size_t)(h * 2 + b)) * 8192 + t) * 64;
#pragma unroll
      for (int ks = 0; ks < 4; ++ks) qf[ks] = *(const bf16x8*)(Q + 16 * ks + 8 * hi); }
    float* impw = (float*)(smem + AT_IMP_OFF) + wid * 2048; float* totw = impw + lane;
    unsigned* selmask = (unsigned*)(smem + AT_SEL_OFF); unsigned* wun = (unsigned*)(smem + AT_WUN_OFF); int* ucnt = (int*)(smem + AT_UCNT_OFF); unsigned char* ulist = smem + AT_ULIST_OFF;
    f32x16 o[2]; float m, l;
    const int tmin_w = t0 + wid * 8, tmax_w = tmin_w + 7;
    {
        const bf16_t* KC = (const bf16_t*)(a.ws + WS_KC) + ((size_t)(0 * 4 + b * 2 + g)) * 512 * 64; const bf16_t* VC = (const bf16_t*)(a.ws + WS_KC) + ((size_t)(1 * 4 + b * 2 + g)) * 512 * 64;
        const int ncv = t0 / 16 + 1; const int nct = (ncv + 63) >> 6;
        auto src = [&](int j, const bf16_t*& kp, const bf16_t*& vp) { kp = KC + (size_t)j * 4096; vp = VC + (size_t)j * 4096; };
        m = -1e30f; l = 0.f;
        kv_pipeline(smem, nct, src, [&](int j, const unsigned char* st) {
            const int kpos0 = 1024 * j + 31;
            if (kpos0 > tmax_w) return;
            f32x16 p0, p1; alibi_init<16>(p0, p1, slope2, kpos0, t0, hi);
            qk_tile(st, qf, p0, p1, lane);
            mask_tile<16>(p0, p1, kpos0, -1, t, hi);
            const float mt = rowmax32(p0, p1); const float mn = fmaxf(m, mt); float rs = 0.f;
#pragma unroll
            for (int rr = 0; rr < 16; ++rr) rs += __builtin_amdgcn_exp2f(p0[rr] - mn) + __builtin_amdgcn_exp2f(p1[rr] - mn);
            rs += __shfl_xor(rs, 32);
            l = l * __builtin_amdgcn_exp2f(m - mn) + rs; m = mn;
        });
        const float linv = l > 0.f ? 1.0f / l : 0.f;
        if (need_topk) { for (int i = lane; i < 8 * 129; i += 64) impw[i] = 0.f; }
        o[0] = (f32x16){}; o[1] = (f32x16){};
        kv_pipeline(smem, nct, src, [&](int j, const unsigned char* st) {
            const int kpos0 = 1024 * j + 31;
            if (kpos0 > tmax_w) return;
            f32x16 p0, p1; alibi_init<16>(p0, p1, slope2, kpos0, t0, hi);
            qk_tile(st, qf, p0, p1, lane);
            mask_tile<16>(p0, p1, kpos0, -1, t, hi);
#pragma unroll
            for (int rr = 0; rr < 16; ++rr) { p0[rr] = __builtin_amdgcn_exp2f(p0[rr] - m) * linv; p1[rr] = __builtin_amdgcn_exp2f(p1[rr] - m) * linv; }
            if (need_topk) {
#pragma unroll
                for (int half = 0; half < 2; ++half)
#pragma unroll
                    for (int g4 = 0; g4 < 4; ++g4) { const f32x16& p = half ? p1 : p0;
                        float ms = (p[4 * g4] + p[4 * g4 + 1]) + (p[4 * g4 + 2] + p[4 * g4 + 3]); float ls = p[4 * g4 + 3];
                        ms += __shfl_xor(ms, 1); ms += __shfl_xor(ms, 2); ls += __shfl_xor(ls, 1); ls += __shfl_xor(ls, 2);
                        const int n = 16 * j + 8 * half + 2 * g4 + hi;
                        if (r == 0) { atomicAdd(&impw[tokw * 129 + n], ms); atomicAdd(&impw[tokw * 129 + n + 1], ls); } }
            }
            pv_tile(st + 8192, p0, p1, o, lane);
        });
    }
    {
        unsigned un0 = 0u, un1 = 0u, un2 = 0u, un3 = 0u;
        if (need_topk) {
            for (int tk = 0; tk < 8; ++tk) {
                float v0 = impw[tk * 129 + lane], v1 = impw[tk * 129 + 64 + lane];
                v0 = (lane >= 1 && lane <= cur - 2) ? v0 : -1.0f; v1 = (lane + 64 <= cur - 2) ? v1 : -1.0f;
                unsigned m0 = 1u, m1 = 0u, m2 = 0u, m3 = 0u;
#define SETBIT(n_) do { const int n__ = (n_); const unsigned bit__ = 1u << (n__ & 31); const int w__ = n__ >> 5; if (w__ == 0) m0 |= bit__; else if (w__ == 1) m1 |= bit__; else if (w__ == 2) m2 |= bit__; else m3 |= bit__; } while (0)
                SETBIT(cur); SETBIT(cur - 1);
                for (int it = 0; it < 13; ++it) {
                    float mx = fmaxf(v0, v1);
#pragma unroll
                    for (int off = 1; off < 64; off <<= 1) mx = fmaxf(mx, __shfl_xor(mx, off));
                    const unsigned long long b0 = __ballot(v0 == mx);
                    int n;
                    if (b0) n = __ffsll((long long)b0) - 1; else { const unsigned long long b1 = __ballot(v1 == mx); n = 64 + __ffsll((long long)b1) - 1; }
                    if (lane == (n & 63)) { if (n < 64) v0 = -1.0f; else v1 = -1.0f; }
                    SETBIT(n);
                }
#undef SETBIT
                if (lane == 0) { unsigned* sm_ = selmask + (wid * 8 + tk) * 4; sm_[0] = m0; sm_[1] = m1; sm_[2] = m2; sm_[3] = m3; }
                un0 |= m0; un1 |= m1; un2 |= m2; un3 |= m3;
            }
        } else {
            const unsigned full = (cur >= 31) ? 0xffffffffu : ((2u << cur) - 1u);
            un0 = full;
            if (lane < 8) { unsigned* sm_ = selmask + (wid * 8 + lane) * 4; sm_[0] = full; sm_[1] = 0u; sm_[2] = 0u; sm_[3] = 0u; }
        }
        if (lane == 0) { wun[wid * 4] = un0; wun[wid * 4 + 1] = un1; wun[wid * 4 + 2] = un2; wun[wid * 4 + 3] = un3; }
        __syncthreads();
        if (tid == 0) { int c = 0;
            for (int w = 0; w < 4; ++w) { const unsigned u = wun[w] | wun[4 + w] | wun[8 + w] | wun[12 + w]; for (int bb = 0; bb < 32; ++bb) if ((u >> bb) & 1u) ulist[c++] = (unsigned char)(w * 32 + bb); }
            ucnt[0] = c; }
        __syncthreads();
    }
    { const float g0 = GN[0];
#pragma unroll
      for (int rr = 0; rr < 16; ++rr) { totw[rr * 64] = o[0][rr] * g0; totw[(16 + rr) * 64] = o[1][rr] * g0; } }
    {
        const bf16_t* KS = PROJ + ((size_t)((12 + g) * 2 + b)) * 8192 * 64; const bf16_t* VS = PROJ + ((size_t)((14 + g) * 2 + b)) * 8192 * 64;
        const int nu = ucnt[0];
        m = -1e30f; l = 0.f; o[0] = (f32x16){}; o[1] = (f32x16){};
        kv_pipeline(smem, nu, [&](int j, const bf16_t*& kp, const bf16_t*& vp) { const int n = ulist[j]; kp = KS + (size_t)n * 4096; vp = VS + (size_t)n * 4096; },
            [&](int j, const unsigned char* st) {
                const int n = ulist[j];
                if (!((wun[wid * 4 + (n >> 5)] >> (n & 31)) & 1u)) return;
                const bool sel = (selmask[tokl * 4 + (n >> 5)] >> (n & 31)) & 1u;
                f32x16 p0, p1; alibi_init<1>(p0, p1, slope2, 64 * n, t0, hi);
                qk_tile(st, qf, p0, p1, lane);
                if (n == cur || !__all(sel)) mask_tile<1>(p0, p1, 64 * n, -1, sel ? t : -1, hi);
                softmax_step(p0, p1, m, l, o);
                pv_tile(st + 8192, p0, p1, o, lane);
            });
        const float g1 = GN[1] / fmaxf(l, 1e-30f);
#pragma unroll
        for (int rr = 0; rr < 16; ++rr) { totw[rr * 64] += o[0][rr] * g1; totw[(16 + rr) * 64] += o[1][rr] * g1; }
    }
    {
        const bf16_t* KW = PROJ + ((size_t)((16 + g) * 2 + b)) * 8192 * 64; const bf16_t* VW = PROJ + ((size_t)((18 + g) * 2 + b)) * 8192 * 64;
        const int jlo = (t0 - 511) > 0 ? ((t0 - 511) >> 6) : 0; const int jhi = (t0 + 31) >> 6;
        m = -1e30f; l = 0.f; o[0] = (f32x16){}; o[1] = (f32x16){};
        kv_pipeline(smem, jhi - jlo + 1, [&](int j, const bf16_t*& kp, const bf16_t*& vp) { kp = KW + (size_t)(jlo + j) * 4096; vp = VW + (size_t)(jlo + j) * 4096; },
            [&](int j, const unsigned char* st) {
                const int kpos0 = 64 * (jlo + j);
                if (kpos0 > tmax_w || kpos0 + 63 < tmin_w - 511) return;
                f32x16 p0, p1; alibi_init<1>(p0, p1, slope2, kpos0, t0, hi);
                qk_tile(st, qf, p0, p1, lane);
                if (kpos0 < tmax_w - 511 || kpos0 + 63 > tmin_w) mask_tile<1>(p0, p1, kpos0, t - 511, t, hi);
                softmax_step(p0, p1, m, l, o);
                pv_tile(st + 8192, p0, p1, o, lane);
            });
        const float g2 = GN[2] / fmaxf(l, 1e-30f);
#pragma unroll
        for (int rr = 0; rr < 16; ++rr) { o[0][rr] = totw[rr * 64] + o[0][rr] * g2; o[1][rr] = totw[(16 + rr) * 64] + o[1][rr] * g2; }
    }
    {
        float ss = 0.f; bf16_t* O = (bf16_t*)(a.ws + WS_ONSA) + token * 512 + h * 64;
#pragma unroll
        for (int dh = 0; dh < 2; ++dh)
#pragma unroll
            for (int g4 = 0; g4 < 4; ++g4) { const float v0 = o[dh][4 * g4], v1 = o[dh][4 * g4 + 1], v2 = o[dh][4 * g4 + 2], v3 = o[dh][4 * g4 + 3];
                ss += v0 * v0 + v1 * v1 + v2 * v2 + v3 * v3; uint2 w; w.x = cvtpk(v0, v1); w.y = cvtpk(v2, v3); *(uint2*)(O + 32 * dh + 8 * g4 + 4 * hi) = w; }
        ss += __shfl_xor(ss, 32);
        if (hi == 0) ((float*)(a.ws + WS_SSQ))[token * 16 + h] = ss;
    }
}
#ifndef ATT_NAIVE
#define ATT_NAIVE 0
#endif
#ifndef PROBE_DUP
#define PROBE_DUP 0
#endif
DEV void phase_att(const Args& a, unsigned char* smem) {
#if ATT_NAIVE
    for (int item = blockIdx.x; item < 512 + 512; item += gridDim.x) {
        if (item < 512) fox_naive_item(a, 511 - item);
        else { nsa_naive_item(a, smem, item - 512); __syncthreads(); }
    }
#else
    int* qctr = (int*)(a.ws + WS_CTL) + 64; int* sitem = (int*)(smem + AT_ITEM_OFF);
    for (;;) {
        if (TID() == 0) sitem[0] = atomicAdd(qctr, 1);
        __syncthreads();
        int item = sitem[0];
        __syncthreads();
        if ((PROBE_DUP >> PH_ATT) & 1) { if (item >= 4096 + (int)gridDim.x) break; if (item >= 2048 && item < 2048 + (int)gridDim.x) break; if (item >= 2048) item -= 2048 + (int)gridDim.x; }
        else if (item >= 2048) break;
#ifndef ATT_SKIP_FOX
        if (item < 1024) { const int qb = 63 - (item >> 4), bh = item & 15; fox_item(a, smem, bh >> 3, bh & 7, qb); }
        else
#endif
#ifndef ATT_SKIP_NSA
        { const int idx = item - 1024; const int tt = 255 - (idx >> 2), bg = idx & 3; nsa_item(a, smem, bg >> 1, bg & 1, tt); }
#else
        {}
#endif
    }
#endif
}


DEV void phase_outproj(const Args& a, unsigned char* smem) {
    const bf16_t* ONSA = (const bf16_t*)(a.ws + WS_ONSA); const bf16_t* OFOX = (const bf16_t*)(a.ws + WS_OFOX); const float* SSQ = (const float*)(a.ws + WS_SSQ);
    const bf16_t* W = (const bf16_t*)(a.ws + WS_WOUT); float* H1 = (float*)(a.ws + WS_H1); const float* X = a.in[I_X];
    const float* gnn = a.in[I_GNN]; const float* gnf = a.in[I_GNF];
    float* rs = (float*)(smem + MISC_OFF);
    const int tid = TID(), lane = tid & 63, wid = tid >> 6, wr = wid >> 1, wc = wid & 1;
    for (int item = blockIdx.x; item < 128 * 8; item += gridDim.x) {
        const int nt = item / 128, mt = item % 128;
        if (tid < 128) { const float* s = SSQ + (size_t)(mt * 128 + tid) * 16; float sn = 0.f, sf = 0.f;
#pragma unroll
            for (int j = 0; j < 8; ++j) { sn += s[j]; sf += s[8 + j]; }
            rs[tid * 2] = rsqrtf(sn * (1.f / 512.f) + EPS); rs[tid * 2 + 1] = rsqrtf(sf * (1.f / 512.f) + EPS); }
        __syncthreads();
        f32x4 acc[4][4];
        gemm_mainloop2(smem, 16,
            [&](int r, int kc, int kt) { const int k0 = kt * 64 + kc * 8; const bool nsa = k0 < 512; const int kk = nsa ? k0 : k0 - 512;
                return *(const uint4*)((nsa ? ONSA : OFOX) + (size_t)(mt * 128 + r) * 512 + kk); },
            [&](const uint4& u, int r, int kc, int kt) { const int k0 = kt * 64 + kc * 8; const bool nsa = k0 < 512; const int kk = nsa ? k0 : k0 - 512;
                const float* gp = (nsa ? gnn : gnf) + kk; const float4 g0 = *(const float4*)gp, g1 = *(const float4*)(gp + 4);
                const float sc = rs[r * 2 + (nsa ? 0 : 1)]; float f[8]; unpack8(u, f);
                uint4 o; o.x = cvtpk(f[0] * sc * g0.x, f[1] * sc * g0.y); o.y = cvtpk(f[2] * sc * g0.z, f[3] * sc * g0.w); o.z = cvtpk(f[4] * sc * g1.x, f[5] * sc * g1.y); o.w = cvtpk(f[6] * sc * g1.z, f[7] * sc * g1.w);
                return o; },
            [&](int k, int nc, int kt) { return *(const uint4*)(W + (size_t)(kt * 64 + k) * 1024 + nt * 128 + nc * 8); }, IdCvt(), acc);
#pragma unroll
        for (int mi = 0; mi < 4; ++mi) { const size_t gm = mt * 128 + wr * 64 + mi * 16 + (lane & 15);
#pragma unroll
            for (int ni = 0; ni < 4; ++ni) { const int n = nt * 128 + wc * 64 + ni * 16 + 4 * (lane >> 4); const float4 x = *(const float4*)(X + gm * 1024 + n); const f32x4 v = acc[mi][ni];
                float4 o = {x.x + v[0], x.y + v[1], x.z + v[2], x.w + v[3]}; *(float4*)(H1 + gm * 1024 + n) = o; } }
        __syncthreads();
    }
}

typedef float f32x16r __attribute__((ext_vector_type(16)));
DEV void phase_route(const Args& a, unsigned char* smem) {
    const float* H1 = (const float*)(a.ws + WS_H1); bf16_t* XN = (bf16_t*)(a.ws + WS_XN); float* RSTD2 = (float*)(a.ws + WS_RSTD2);
    const float* ln2 = a.in[I_LN2]; const float* wr_ = a.in[I_WR]; const float* br = a.in[I_BR];
    int* CNT = (int*)(a.ws + WS_CTL);
    int* TOPI = (int*)(a.ws + WS_TOPI); int* TOPS = (int*)(a.ws + WS_TOPS); float* TOPW = (float*)(a.ws + WS_TOPW);
    int* TOKOF = (int*)(a.ws + WS_TOKOF); float* ROWW = (float*)(a.ws + WS_ROWW);
    float* part = (float*)smem;
    float* ssqp = part + 4 * 32 * 33;
    int* lcnt = (int*)(ssqp + 128); int* lbase = lcnt + 32; int* te = lbase + 32; int* trk = te + 128; float* tw = (float*)(trk + 128);
    const int tid = TID(), lane = tid & 63, wid = tid >> 6, i32 = lane & 31, kh = lane >> 5;
    for (int item = blockIdx.x; item < 512; item += gridDim.x) {
        const int tok = item * 32 + i32;
        if (tid < 32) lcnt[tid] = 0;
        f32x16r acc = (f32x16r){}; float ss = 0.f;
        const float* hrow = H1 + (size_t)tok * 1024 + 256 * wid + 4 * kh; const float* lrow = ln2 + 256 * wid + 4 * kh; bf16_t* xrow = XN + (size_t)tok * 1024 + 256 * wid + 4 * kh;
        const float* wbase = wr_ + (size_t)(256 * wid + 4 * kh) * 32 + i32;
#pragma unroll 4
        for (int c = 0; c < 32; ++c) {
            const float4 hv = *(const float4*)(hrow + 8 * c); const float4 lv = *(const float4*)(lrow + 8 * c);
            ss += hv.x * hv.x + hv.y * hv.y + hv.z * hv.z + hv.w * hv.w;
            const float x0 = hv.x * lv.x, x1 = hv.y * lv.y, x2 = hv.z * lv.z, x3 = hv.w * lv.w;
            uint2 o; o.x = cvtpk(x0, x1); o.y = cvtpk(x2, x3); *(uint2*)(xrow + 8 * c) = o;
            const float* wp = wbase + (size_t)(8 * c) * 32;
            const float w0 = wp[0], w1 = wp[32], w2 = wp[64], w3 = wp[96];
            acc = __builtin_amdgcn_mfma_f32_32x32x2f32(x0, w0, acc, 0, 0, 0);
            acc = __builtin_amdgcn_mfma_f32_32x32x2f32(x1, w1, acc, 0, 0, 0);
            acc = __builtin_amdgcn_mfma_f32_32x32x2f32(x2, w2, acc, 0, 0, 0);
            acc = __builtin_amdgcn_mfma_f32_32x32x2f32(x3, w3, acc, 0, 0, 0);
        }
        ss += __shfl_xor(ss, 32);
        if (kh == 0) ssqp[wid * 32 + i32] = ss;
#pragma unroll
        for (int r = 0; r < 16; ++r) part[(wid * 32 + crow(r, kh)) * 33 + i32] = acc[r];
        __syncthreads();
        if (tid < 32) {
            const float sq = ssqp[tid] + ssqp[32 + tid] + ssqp[64 + tid] + ssqp[96 + tid]; const float rstd = rsqrtf(sq * (1.f / 1024.f) + EPS);
            RSTD2[item * 32 + tid] = rstd;
            float lg[32];
#pragma unroll
            for (int e = 0; e < 32; ++e) lg[e] = (part[(0 * 32 + tid) * 33 + e] + part[(1 * 32 + tid) * 33 + e] + part[(2 * 32 + tid) * 33 + e] + part[(3 * 32 + tid) * 33 + e]) * rstd + br[e];
            unsigned taken = 0u; float tv[4]; int ti[4];
#pragma unroll
            for (int k = 0; k < 4; ++k) { float best = -3.0e38f; int bi = 0;
#pragma unroll
                for (int e = 0; e < 32; ++e) { const bool ok = !((taken >> e) & 1u) && lg[e] > best; best = ok ? lg[e] : best; bi = ok ? e : bi; }
                taken |= 1u << bi; tv[k] = best; ti[k] = bi; }
            const float e1 = __expf(tv[1] - tv[0]), e2 = __expf(tv[2] - tv[0]), e3 = __expf(tv[3] - tv[0]); const float inv = 1.0f / (1.0f + e1 + e2 + e3);
            const float wv[4] = {inv, e1 * inv, e2 * inv, e3 * inv};
#pragma unroll
            for (int k = 0; k < 4; ++k) { const int idx = tid * 4 + k; te[idx] = ti[k]; trk[idx] = atomicAdd(&lcnt[ti[k]], 1); tw[idx] = wv[k]; }
        }
        __syncthreads();
        if (tid < 32) lbase[tid] = atomicAdd(&CNT[tid], lcnt[tid]);
        __syncthreads();
        if (tid < 128) { const int idx = tid; const int tk = item * 32 + (idx >> 2); const int e = te[idx]; const int slot = lbase[e] + trk[idx];
          TOPI[(size_t)tk * 4 + (idx & 3)] = e; TOPS[(size_t)tk * 4 + (idx & 3)] = slot; TOPW[(size_t)tk * 4 + (idx & 3)] = tw[idx];
          TOKOF[(size_t)e * 16384 + slot] = tk; ROWW[(size_t)e * 16384 + slot] = tw[idx]; }
        __syncthreads();
    }
}

struct MoeMap { int e, mt, nt, cnt, off; };
DEV void moe_setup(const Args& a, int* sm) {
    if (TID() == 0) { const int* CNT = (const int*)(a.ws + WS_CTL); int tot = 0; for (int e = 0; e < 32; ++e) { const int c = CNT[e]; const int mt = (c + 127) >> 7; sm[e] = mt; sm[32 + e] = tot; tot += mt; } sm[64] = tot; }
    __syncthreads();
}
DEV MoeMap moe_map(const Args& a, const int* sm, int item, int NT) {
    MoeMap mm; int e = 0;
    for (int i = 1; i < 32; ++i) if (item >= sm[32 + i] * NT) e = i;
    const int local = item - sm[32 + e] * NT; const int mte = sm[e];
    mm.e = e; mm.nt = local / mte; mm.mt = local % mte; mm.cnt = ((const int*)(a.ws + WS_CTL))[e]; mm.off = sm[32 + e] * 128; return mm;
}
DEV void phase_up(const Args& a, unsigned char* smem) {
    int* sm = (int*)(smem + MISC_OFF); int* tok = sm + 128; float* rsd = (float*)(tok + 128);
    const bf16_t* XN = (const bf16_t*)(a.ws + WS_XN); const bf16_t* W = (const bf16_t*)(a.ws + WS_WUP); bf16_t* ACT = (bf16_t*)(a.ws + WS_ACT); const float* RSTD2 = (const float*)(a.ws + WS_RSTD2);
    const int* TOKOF = (const int*)(a.ws + WS_TOKOF); const float* bup = a.in[I_BUP];
    const int tid = TID(), lane = tid & 63, wid = tid >> 6, wr = wid >> 1, wc = wid & 1;
    moe_setup(a, sm);
    const int nitems = sm[64] * 16;
    for (int item = blockIdx.x; item < nitems; item += gridDim.x) {
        const MoeMap mm = moe_map(a, sm, item, 16);
        if (tid < 128) { const int slot = mm.mt * 128 + tid; const int tk_ = slot < mm.cnt ? TOKOF[(size_t)mm.e * 16384 + slot] : 0; tok[tid] = tk_; rsd[tid] = RSTD2[tk_]; }
        __syncthreads();
        const bf16_t* We = W + (size_t)mm.e * 1024 * 2048;
        f32x4 acc[4][4];
        gemm_mainloop2(smem, 16,
            [&](int r, int kc, int kt) { return *(const uint4*)(XN + (size_t)tok[r] * 1024 + kt * 64 + kc * 8); }, IdCvt(),
            [&](int k, int nc, int kt) { const int ni = (nc >> 1) & 3; const int sc = ((ni >> 1) ? 1024 : 0) + mm.nt * 64 + (nc >> 3) * 32 + (ni & 1) * 16 + (nc & 1) * 8;
                return *(const uint4*)(We + (size_t)(kt * 64 + k) * 2048 + sc); }, IdCvt(), acc);
#pragma unroll
        for (int mi = 0; mi < 4; ++mi) { const int rl_ = wr * 64 + mi * 16 + (lane & 15); const size_t row = (size_t)mm.off + mm.mt * 128 + rl_; const float rs_ = rsd[rl_];
#pragma unroll
            for (int ni = 0; ni < 2; ++ni) { const int jc = mm.nt * 64 + wc * 32 + ni * 16 + 4 * (lane >> 4);
                const float4 bg = *(const float4*)(bup + (size_t)mm.e * 2048 + jc), bl_ = *(const float4*)(bup + (size_t)mm.e * 2048 + 1024 + jc);
                const f32x4 gv = acc[mi][ni], lv = acc[mi][ni + 2]; const float bgv[4] = {bg.x, bg.y, bg.z, bg.w}, blv[4] = {bl_.x, bl_.y, bl_.z, bl_.w}; float r4[4];
#pragma unroll
                for (int r = 0; r < 4; ++r) { const float gg = fminf(gv[r] * rs_ + bgv[r], 7.0f); const float ll = fminf(fmaxf(lv[r] * rs_ + blv[r], -7.0f), 7.0f); r4[r] = gg * sigmoidf_(1.702f * gg) * (ll + 1.0f); }
                uint2 o; o.x = cvtpk(r4[0], r4[1]); o.y = cvtpk(r4[2], r4[3]); *(uint2*)(ACT + row * 1024 + jc) = o; } }
        __syncthreads();
    }
}
DEV void phase_down(const Args& a, unsigned char* smem) {
    int* sm = (int*)(smem + MISC_OFF); float* rw = (float*)(sm + 128);
    const bf16_t* ACT = (const bf16_t*)(a.ws + WS_ACT); const bf16_t* W = (const bf16_t*)(a.ws + WS_WDN); bf16_t* Y = (bf16_t*)(a.ws + WS_Y);
    const float* ROWW = (const float*)(a.ws + WS_ROWW); const float* bdn = a.in[I_BDN];
    const int tid = TID(), lane = tid & 63, wid = tid >> 6, wr = wid >> 1, wc = wid & 1;
    moe_setup(a, sm);
    const int nitems = sm[64] * 8;
    for (int item = blockIdx.x; item < nitems; item += gridDim.x) {
        const MoeMap mm = moe_map(a, sm, item, 8);
        if (tid < 128) { const int slot = mm.mt * 128 + tid; rw[tid] = slot < mm.cnt ? ROWW[(size_t)mm.e * 16384 + slot] : 0.f; }
        __syncthreads();
        const bf16_t* We = W + (size_t)mm.e * 1024 * 1024; const bf16_t* Ab = ACT + ((size_t)mm.off + mm.mt * 128) * 1024;
        f32x4 acc[4][4];
        gemm_mainloop2(smem, 16,
            [&](int r, int kc, int kt) { return *(const uint4*)(Ab + (size_t)r * 1024 + kt * 64 + kc * 8); }, IdCvt(),
            [&](int k, int nc, int kt) { return *(const uint4*)(We + (size_t)(kt * 64 + k) * 1024 + mm.nt * 128 + nc * 8); }, IdCvt(), acc);
#pragma unroll
        for (int mi = 0; mi < 4; ++mi) { const int rl = wr * 64 + mi * 16 + (lane & 15); const size_t row = (size_t)mm.off + mm.mt * 128 + rl; const float w = rw[rl];
#pragma unroll
            for (int ni = 0; ni < 4; ++ni) { const int n = mm.nt * 128 + wc * 64 + ni * 16 + 4 * (lane >> 4); const float4 bb = *(const float4*)(bdn + (size_t)mm.e * 1024 + n); const f32x4 v = acc[mi][ni];
                uint2 o; o.x = cvtpk((v[0] + bb.x) * w, (v[1] + bb.y) * w); o.y = cvtpk((v[2] + bb.z) * w, (v[3] + bb.w) * w); *(uint2*)(Y + row * 1024 + n) = o; } }
        __syncthreads();
    }
}

DEV void phase_comb(const Args& a, unsigned char* smem) {
    int* sm = (int*)(smem + MISC_OFF);
    moe_setup(a, sm);
    float* H1 = (float*)(a.ws + WS_H1); bf16_t* XN = (bf16_t*)(a.ws + WS_XN); const bf16_t* Y = (const bf16_t*)(a.ws + WS_Y);
    const int* TOPI = (const int*)(a.ws + WS_TOPI); const int* TOPS = (const int*)(a.ws + WS_TOPS); const float* g = a.in[I_LNPLE];
    const int lane = TID() & 63; const int gw = blockIdx.x * 4 + (TID() >> 6), ngw = gridDim.x * 4;
    for (int tok = gw; tok < NTOK; tok += ngw) {
        float4 v[4];
#pragma unroll
        for (int j = 0; j < 4; ++j) v[j] = *(const float4*)(H1 + (size_t)tok * 1024 + j * 256 + lane * 4);
#pragma unroll
        for (int k = 0; k < 4; ++k) { const int e = TOPI[(size_t)tok * 4 + k]; const size_t row = (size_t)sm[32 + e] * 128 + TOPS[(size_t)tok * 4 + k];
#pragma unroll
            for (int j = 0; j < 4; ++j) { const uint2 u = *(const uint2*)(Y + row * 1024 + j * 256 + lane * 4); v[j].x += bflo(u.x); v[j].y += bfhi(u.x); v[j].z += bflo(u.y); v[j].w += bfhi(u.y); } }
        float s = 0.f;
#pragma unroll
        for (int j = 0; j < 4; ++j) { *(float4*)(H1 + (size_t)tok * 1024 + j * 256 + lane * 4) = v[j]; s += v[j].x * v[j].x + v[j].y * v[j].y + v[j].z * v[j].z + v[j].w * v[j].w; }
        const float rstd = rsqrtf(wave_sum(s) * (1.f / 1024.f) + EPS);
#pragma unroll
        for (int j = 0; j < 4; ++j) { const float4 gg = *(const float4*)(g + j * 256 + lane * 4);
            uint2 o; o.x = cvtpk(v[j].x * rstd * gg.x, v[j].y * rstd * gg.y); o.y = cvtpk(v[j].z * rstd * gg.z, v[j].w * rstd * gg.w); *(uint2*)(XN + (size_t)tok * 1024 + j * 256 + lane * 4) = o; }
    }
}

DEV void phase_gate(const Args& a, unsigned char* smem) {
    const bf16_t* XN = (const bf16_t*)(a.ws + WS_XN); const bf16_t* WG = (const bf16_t*)(a.ws + WS_WGATE); const bf16_t* PB = (const bf16_t*)(a.ws + WS_PB); const bf16_t* WP = (const bf16_t*)(a.ws + WS_WPLE);
    const float* H2 = (const float*)(a.ws + WS_H1); float* OUT = a.out; float* SSQ3 = (float*)(a.ws + WS_SSQ3);
    const int tid = TID(), lane = tid & 63, wid = tid >> 6, wr = wid >> 1, wc = wid & 1;
    for (int item = blockIdx.x; item < 128 * 8; item += gridDim.x) {
        const int nt = item / 128, mt = item % 128;
        f32x4 acc[4][4];
        gemm_mainloop(smem, 16,
            [&](int r, int kc, int kt) { return *(const uint4*)(XN + (size_t)(mt * 128 + r) * 1024 + kt * 64 + kc * 8); },
            [&](int k, int nc, int kt) { return *(const uint4*)(WG + (size_t)(kt * 64 + k) * 1024 + nt * 128 + nc * 8); }, acc);
#pragma unroll
        for (int mi = 0; mi < 4; ++mi) { const size_t gm = mt * 128 + wr * 64 + mi * 16 + (lane & 15);
#pragma unroll
            for (int ni = 0; ni < 4; ++ni) { const int n = nt * 128 + wc * 64 + ni * 16 + 4 * (lane >> 4); const f32x4 v = acc[mi][ni];
                float4 o = {sigmoidf_(v[0]), sigmoidf_(v[1]), sigmoidf_(v[2]), sigmoidf_(v[3])}; *(float4*)(OUT + gm * 1024 + n) = o; } }
        gemm_mainloop(smem, 4,
            [&](int r, int kc, int kt) { return *(const uint4*)(PB + (size_t)(mt * 128 + r) * 256 + kt * 64 + kc * 8); },
            [&](int k, int nc, int kt) { return *(const uint4*)(WP + (size_t)(kt * 64 + k) * 1024 + nt * 128 + nc * 8); }, acc);
#pragma unroll
        for (int mi = 0; mi < 4; ++mi) { const size_t gm = mt * 128 + wr * 64 + mi * 16 + (lane & 15); float ss = 0.f;
#pragma unroll
            for (int ni = 0; ni < 4; ++ni) { const int n = nt * 128 + wc * 64 + ni * 16 + 4 * (lane >> 4); const f32x4 v = acc[mi][ni];
                const float4 gt = *(const float4*)(OUT + gm * 1024 + n); const float4 h = *(const float4*)(H2 + gm * 1024 + n);
                float4 o = {h.x + v[0] * gt.x, h.y + v[1] * gt.y, h.z + v[2] * gt.z, h.w + v[3] * gt.w}; *(float4*)(OUT + gm * 1024 + n) = o;
                ss += o.x * o.x + o.y * o.y + o.z * o.z + o.w * o.w; }
            ss += __shfl_xor(ss, 16); ss += __shfl_xor(ss, 32);
            if (lane < 16) SSQ3[gm * 16 + nt * 2 + wc] = ss; }
        __syncthreads();
    }
}

DEV void phase_final(const Args& a) {
    float* OUT = a.out; const float* SSQ3 = (const float*)(a.ws + WS_SSQ3); const float* g = a.in[I_LNF];
    const int lane = TID() & 63; const int gw = blockIdx.x * 4 + (TID() >> 6), ngw = gridDim.x * 4;
    for (int m = gw; m < NTOK; m += ngw) {
        float s = 0.f;
#pragma unroll
        for (int j = 0; j < 16; ++j) s += SSQ3[(size_t)m * 16 + j];
        const float rstd = rsqrtf(s * (1.f / 1024.f) + EPS);
#pragma unroll
        for (int j = 0; j < 4; ++j) { float4 v = *(const float4*)(OUT + (size_t)m * 1024 + j * 256 + lane * 4); const float4 gg = *(const float4*)(g + j * 256 + lane * 4);
            v.x *= rstd * gg.x; v.y *= rstd * gg.y; v.z *= rstd * gg.z; v.w *= rstd * gg.w; *(float4*)(OUT + (size_t)m * 1024 + j * 256 + lane * 4) = v; }
    }
}

namespace cg = cooperative_groups;
template <int PH> DEV void run_phase(const Args& a, unsigned char* smem) {
    if constexpr (PH == PH_PRO) phase_prologue(a, smem);
    else if constexpr (PH == PH_INPROJ) phase_inproj(a, smem);
    else if constexpr (PH == PH_CMP) phase_cmp(a, smem);
    else if constexpr (PH == PH_ATT) phase_att(a, smem);
    else if constexpr (PH == PH_OUTPROJ) phase_outproj(a, smem);
    else if constexpr (PH == PH_ROUTE) phase_route(a, smem);
    else if constexpr (PH == PH_UP) phase_up(a, smem);
    else if constexpr (PH == PH_DOWN) phase_down(a, smem);
    else if constexpr (PH == PH_COMB) phase_comb(a, smem);
    else if constexpr (PH == PH_GATE) phase_gate(a, smem);
    else if constexpr (PH == PH_FINAL) phase_final(a);
}
#define XB_TMO      128
#define XB_XCNT(j)  (256  + 64 * (j))
#define XB_XSUB(j)  (1280 + 64 * (j))
#define XB_XGEN(j)  (2304 + 64 * (j))
#define XB_TOP      3328
#define XB_TOPGEN   3392
#define XCD_BAR_WORDS 3456
#define XB_SPIN_CAP (1u << 22)
DEV unsigned xb_ld(unsigned* p)              { return __hip_atomic_load(p, __ATOMIC_RELAXED, __HIP_MEMORY_SCOPE_AGENT); }
DEV unsigned xb_add(unsigned* p, unsigned v) { return __hip_atomic_fetch_add(p, v, __ATOMIC_RELAXED, __HIP_MEMORY_SCOPE_AGENT); }
DEV unsigned xb_xcc_id() { return (unsigned)__builtin_amdgcn_s_getreg((3 << 11) | 20) & 0xFu; }
#define XB_SPIN(cond, bar) do { unsigned _sp = 0; while (cond) { __builtin_amdgcn_s_sleep(1); \
    if ((++_sp & 255u) == 0u) { if (xb_ld(&(bar)[XB_TMO])) break; if (_sp > XB_SPIN_CAP) { atomicAdd(&(bar)[XB_TMO], 1u); break; } } } } while (0)
struct XcdBarrier { unsigned* bar; unsigned x; volatile LAS unsigned* st; };
DEV XcdBarrier xcd_barrier_post(unsigned* bar, volatile LAS unsigned* st) {
    XcdBarrier b; b.bar = bar; b.x = xb_xcc_id(); b.st = st;
    if (TID() == 0) (void)xb_add(&bar[XB_XCNT(b.x)], 1u);
    return b;
}
DEV void xcd_barrier_complete(unsigned* bar, unsigned x, unsigned& nloc, unsigned& nx) {
    const unsigned G = gridDim.x * gridDim.y * gridDim.z;
    unsigned sum, cnt, mine, sp = 0u;
    for (;;) {
        sum = 0u; cnt = 0u; mine = 0u;
#pragma unroll
        for (unsigned j = 0; j < 16; ++j) { const unsigned c = xb_ld(&bar[XB_XCNT(j)]); sum += c; cnt += (c > 0u) ? 1u : 0u; mine = (j == x) ? c : mine; }
        if (sum == G) break;
        __builtin_amdgcn_s_sleep(1);
        if ((++sp & 255u) == 0u) { if (xb_ld(&bar[XB_TMO])) break; if (sp > XB_SPIN_CAP) { atomicAdd(&bar[XB_TMO], 1u); break; } }
    }
    nloc = mine > 0u ? mine : 1u; nx = cnt > 0u ? cnt : 1u;
}
DEV void xcd_barrier(const XcdBarrier& b) {
    asm volatile("s_waitcnt vmcnt(0)" ::: "memory");
    __syncthreads();
    if (TID() == 0) {
        unsigned* bar = b.bar;
        __builtin_amdgcn_s_waitcnt(0);
        unsigned nloc = b.st[0], nx = b.st[1];
        if (nloc == 0u) { xcd_barrier_complete(bar, b.x, nloc, nx); b.st[0] = nloc; b.st[1] = nx; }
        const unsigned old = xb_add(&bar[XB_XSUB(b.x)], 1u);
        const unsigned gen = old / nloc;
        if (old + 1u == (gen + 1u) * nloc) {
            __builtin_amdgcn_fence(__ATOMIC_RELEASE, "agent");
            asm volatile("s_waitcnt vmcnt(0)" ::: "memory");
            const unsigned og = xb_add(&bar[XB_TOP], 1u);
            const unsigned tg = og / nx;
            if (og + 1u == (tg + 1u) * nx) xb_add(&bar[XB_TOPGEN], 1u);
            else XB_SPIN(xb_ld(&bar[XB_TOPGEN]) == tg, bar);
            __builtin_amdgcn_fence(__ATOMIC_ACQUIRE, "agent");
            xb_add(&bar[XB_XGEN(b.x)], 1u);
            asm volatile("s_waitcnt vmcnt(0)" ::: "memory");
        } else {
            XB_SPIN(xb_ld(&bar[XB_XGEN(b.x)]) == gen, bar);
            __builtin_amdgcn_fence(__ATOMIC_ACQUIRE, "agent");
            asm volatile("s_waitcnt vmcnt(0)" ::: "memory");
        }
    }
    __syncthreads();
}

__global__ void __launch_bounds__(256, 2) mega(Args a) {
    extern __shared__ __attribute__((aligned(16))) unsigned char smem[];
    volatile LAS unsigned* bst = (volatile LAS unsigned*)(LAS unsigned char*)(smem + MISC_OFF + 4000);
    if (TID() == 0) { bst[0] = 0u; bst[1] = 0u; }
    __syncthreads();
    const XcdBarrier bar = xcd_barrier_post((unsigned*)(a.ws + WS_CTL) + 4096, bst);
#define GSYNC() xcd_barrier(bar)
#ifndef PROBE_DUP
#define PROBE_DUP 0
#endif
#define RUN(ph) do { run_phase<ph>(a, smem); if ((PROBE_DUP >> ph) & 1) { GSYNC(); run_phase<ph>(a, smem); } } while (0)
    RUN(PH_PRO); GSYNC();
    RUN(PH_INPROJ); GSYNC();
    RUN(PH_CMP); GSYNC();
    RUN(PH_ATT); GSYNC();
    RUN(PH_OUTPROJ); GSYNC();
    RUN(PH_ROUTE); GSYNC();
    RUN(PH_UP); GSYNC();
    RUN(PH_DOWN); GSYNC();
    RUN(PH_COMB); GSYNC();
    RUN(PH_GATE); GSYNC();
    RUN(PH_FINAL);
#undef RUN
#undef GSYNC
}

extern "C" void kernel_launch(void* const* d_in, const int* in_sizes, int n_in, void* d_out, int out_size, void* d_ws, size_t ws_size, hipStream_t stream) {
    static int grid = 0;
    if (grid == 0) {
        if (n_in != 25 || ws_size < WS_END) { fprintf(stderr, "kernel_launch: unexpected n_in %d / ws %zu\n", n_in, ws_size); grid = -1; return; }
        int dev = 0, cus = 0, per_cu = 0;
        (void)hipGetDevice(&dev); (void)hipDeviceGetAttribute(&cus, hipDeviceAttributeMultiprocessorCount, dev);
        (void)hipFuncSetAttribute((const void*)mega, hipFuncAttributeMaxDynamicSharedMemorySize, LDS_BYTES);
        (void)hipOccupancyMaxActiveBlocksPerMultiprocessor(&per_cu, (const void*)mega, 256, LDS_BYTES);
        if (per_cu < 1) { fprintf(stderr, "kernel_launch: occupancy query says %d blocks per CU\n", per_cu); grid = -1; return; }
        if (per_cu > 2) per_cu = 2;
        grid = cus * per_cu;
    }
    if (grid < 0) return;
    (void)hipMemsetAsync((char*)d_ws + WS_CTL, 0, 65536, stream);
    Args a{};
    for (int i = 0; i < 25; ++i) a.in[i] = (const float*)d_in[i];
    a.out = (float*)d_out; a.ws = (unsigned char*)d_ws; a.ph_lo = 0; a.ph_hi = PH_N;
    void* args[] = {&a};
    hipError_t e = hipLaunchCooperativeKernel((const void*)mega, dim3(grid), dim3(256), args, LDS_BYTES, stream);
    if (e != hipSuccess) fprintf(stderr, "cooperative launch failed: %s (grid %d)\n", hipGetErrorString(e), grid);
}
```

```cpp
#include <hip/hip_runtime.h>
#include <stdint.h>
#include <cstdio>

#define DEV __device__ __forceinline__
#define LAS __attribute__((address_space(3)))

typedef unsigned short bf16_t;
typedef short bf16x8 __attribute__((ext_vector_type(8)));
typedef short s16x4 __attribute__((ext_vector_type(4)));
typedef float f32x4 __attribute__((ext_vector_type(4)));
typedef float f32x16 __attribute__((ext_vector_type(16)));
typedef float f32x2_t __attribute__((ext_vector_type(2)));
typedef __bf16 bf16x2_t __attribute__((ext_vector_type(2)));

constexpr int NTHR = 512, NWAVE = 8;
constexpr int NTOK = 16384;
constexpr float EPS = 1e-6f;
constexpr float LOG2E = 1.4426950408889634f;
constexpr float QS = 0.125f * LOG2E;
constexpr int NWIN = 3072;

constexpr size_t MiB = 1u << 20;
constexpr size_t WS_CTL = 0;
constexpr size_t WS_WIN = 1 * MiB;
constexpr size_t WS_WOUT = 7 * MiB;
constexpr size_t WS_WGATE = 9 * MiB;
constexpr size_t WS_WPLE = 11 * MiB;
constexpr size_t WS_WC1 = 12 * MiB;
constexpr size_t WS_WC2 = 15 * MiB + 512 * 1024 + 262144;
constexpr size_t WS_BIAS1 = 15 * MiB + 512 * 1024 + 262144 + 131072;
constexpr size_t WS_KC = 14 * MiB;
constexpr size_t WS_HID = 14 * MiB + 512 * 1024;
constexpr size_t WS_GN = 16 * MiB;
constexpr size_t WS_LS = 18 * MiB;
constexpr size_t WS_CUM = 19 * MiB;
constexpr size_t WS_SSQ = 20 * MiB;
constexpr size_t WS_TOPI = 21 * MiB;
constexpr size_t WS_TOPS = 21 * MiB + 262144;
constexpr size_t WS_TOPW = 21 * MiB + 524288;
constexpr size_t WS_TOKOF = 22 * MiB;
constexpr size_t WS_ROWW = 24 * MiB;
constexpr size_t WS_SSQ3 = 26 * MiB;
constexpr size_t WS_RSTD2 = 27 * MiB;
constexpr size_t WS_PB = 28 * MiB;
constexpr size_t WS_XN = 36 * MiB;
constexpr size_t WS_PROJ = 68 * MiB;
constexpr size_t WS_ONSA = 160 * MiB;
constexpr size_t WS_OFOX = 176 * MiB;
constexpr size_t WS_H1 = 192 * MiB;
constexpr size_t WS_WUP = 256 * MiB;
constexpr size_t WS_WDN = 384 * MiB;
constexpr size_t WS_ACT = 448 * MiB;
constexpr size_t WS_Y = 592 * MiB;
constexpr size_t WS_END = 736 * MiB;

enum { PH_PRO = 0, PH_INPROJ, PH_CMP, PH_ATT, PH_OUTPROJ, PH_ROUTE, PH_UP, PH_DOWN, PH_COMB, PH_GATE, PH_FINAL, PH_N };
struct Args { const float* in[25]; float* out; unsigned char* ws; int ph_lo, ph_hi; };
enum { I_X = 0, I_P, I_LN1, I_WIN, I_BFG, I_WC1K, I_WC2K, I_PEK, I_WC1V, I_WC2V, I_PEV, I_GNN, I_GNF, I_WOUT, I_LN2, I_WR, I_BR,
       I_WUP, I_BUP, I_WDN, I_BDN, I_LNPLE, I_WPLE, I_WGATE, I_LNF };

DEV int BID() { int b = (int)blockIdx.x; asm volatile("" : "+s"(b)); return b; }
DEV int VBID() { const int g = (int)gridDim.x, b = BID(); return (g & 7) ? b : (b & 7) * (g >> 3) + (b >> 3); }
DEV int TID() { int t = (int)__builtin_amdgcn_workitem_id_x(); asm volatile("" : "+v"(t)); return t; }
DEV unsigned cvtpk(float lo, float hi) { f32x2_t v = {lo, hi}; bf16x2_t b = __builtin_convertvector(v, bf16x2_t); return __builtin_bit_cast(unsigned, b); }
DEV float bflo(unsigned u) { return __uint_as_float(u << 16); }
DEV float bfhi(unsigned u) { return __uint_as_float(u & 0xffff0000u); }
DEV float wave_sum(float v) {
#pragma unroll
    for (int o = 1; o < 64; o <<= 1) v += __shfl_xor(v, o);
    return v;
}
DEV float sigmoidf_(float x) { return 1.0f / (1.0f + __expf(-x)); }
DEV float logsigmoidf_(float x) { return fminf(x, 0.f) - log1pf(__expf(-fabsf(x))); }
DEV float gelu_tanh(float x) { const float u = 0.7978845608028654f * (x + 0.044715f * x * x * x); const float th = 1.0f - 2.0f / (__expf(2.0f * u) + 1.0f); return 0.5f * x * (1.0f + th); }
DEV s16x4 tr_read(const unsigned char* p) {
    typedef short v4i16_t __attribute__((ext_vector_type(4)));
    return __builtin_bit_cast(s16x4, __builtin_amdgcn_ds_read_tr16_b64_v4i16((LAS v4i16_t*)p));
}
DEV int crow(int r, int hi) { return (r & 3) + 8 * (r >> 2) + 4 * hi; }

constexpr int GL_STAGE = 65536;
constexpr int GEMM_LDS = 2 * GL_STAGE;
constexpr int MISC_OFF = GEMM_LDS;
constexpr int LDS_BYTES = GEMM_LDS + 4096;

DEV void glds16s(const void* sbase, unsigned voff, unsigned lds_dst) { unsigned keep;
    asm volatile("s_mov_b32 %0, m0\n\ts_mov_b32 m0, %3\n\ts_nop 0\n\tglobal_load_lds_dwordx4 %1, %2\n\ts_mov_b32 m0, %0" : "=&s"(keep) : "v"(voff), "s"(sbase), "s"(lds_dst) : "memory"); }

DEV const unsigned char* uptr(const void* p) { const unsigned long long v = (unsigned long long)p; const unsigned lo = __builtin_amdgcn_readfirstlane((unsigned)v), hi = __builtin_amdgcn_readfirstlane((unsigned)(v >> 32)); return (const unsigned char*)(((unsigned long long)hi << 32) | lo); }

template <bool ZERO, class AO, class BO>
DEV void gemm256(unsigned char* smem, int nkt, const void* abase, unsigned akstep, const AO& aoff, const void* bbase, unsigned bkstep, const BO& boff, f32x4 (&acc)[8][4]) {
    const int tid = TID(), lane = tid & 63; const int wid = __builtin_amdgcn_readfirstlane(tid >> 6); const int wr = wid >> 2, wc = wid & 3;
    if (ZERO) {
#pragma unroll
        for (int mi = 0; mi < 8; ++mi)
#pragma unroll
            for (int ni = 0; ni < 4; ++ni) acc[mi][ni] = (f32x4){0.f, 0.f, 0.f, 0.f};
    }
    const unsigned lds0 = (unsigned)(uintptr_t)smem;
    const unsigned char* abase_u = uptr(abase); const unsigned char* bbase_u = uptr(bbase); const unsigned akstep_u = __builtin_amdgcn_readfirstlane(akstep), bkstep_u = __builtin_amdgcn_readfirstlane(bkstep);
    unsigned ao[4], bo[4];
#pragma unroll
    for (int i = 0; i < 4; ++i) { const int p = wid + 8 * i; ao[i] = aoff(8 * p + (lane >> 3), (lane & 7) ^ (lane >> 3));
        const int k = 2 * p + (lane >> 5); const int f = (k & 3) + 4 * ((k >> 3) & 1); bo[i] = boff(k, (lane & 31) ^ (f << 1)); }
#define GL_ISSUE(kt, st) do { const unsigned char* ab_ = abase_u + (size_t)(kt) * akstep_u; const unsigned char* bb_ = bbase_u + (size_t)(kt) * bkstep_u; \
        _Pragma("unroll") for (int i_ = 0; i_ < 4; ++i_) glds16s(ab_, ao[i_], (unsigned)__builtin_amdgcn_readfirstlane(lds0 + (st) * GL_STAGE + (wid + 8 * i_) * 1024)); \
        _Pragma("unroll") for (int i_ = 0; i_ < 4; ++i_) glds16s(bb_, bo[i_], (unsigned)__builtin_amdgcn_readfirstlane(lds0 + (st) * GL_STAGE + 32768 + (wid + 8 * i_) * 1024)); } while (0)
    GL_ISSUE(0, 0);
    asm volatile("s_waitcnt vmcnt(0)" ::: "memory");
    __syncthreads();
    for (int kt = 0; kt < nkt; ++kt) {
        if (kt + 1 < nkt) GL_ISSUE(kt + 1, (kt + 1) & 1);
        const unsigned char* A = smem + (kt & 1) * GL_STAGE; const unsigned char* Bt = A + 32768;
#pragma unroll
        for (int ks = 0; ks < 2; ++ks) {
            bf16x8 wf[4];
#pragma unroll
            for (int ni = 0; ni < 4; ++ni) {
                const int i = lane & 15, g = lane >> 4, q = i >> 2; const int row = ks * 32 + 8 * g + q; const int nc = wc * 8 + ni * 2 + ((i & 3) >> 1); const int f = q + 4 * (g & 1);
                const unsigned char* p = Bt + row * 512 + ((nc ^ (f << 1)) << 4) + (i & 1) * 8;
                const s16x4 lo = tr_read(p), hi = tr_read(p + 4 * 512);
                wf[ni] = (bf16x8){lo[0], lo[1], lo[2], lo[3], hi[0], hi[1], hi[2], hi[3]};
            }
#pragma unroll
            for (int mi = 0; mi < 8; ++mi) {
                const int m = wr * 128 + mi * 16 + (lane & 15); const int kc = ks * 4 + (lane >> 4);
                const bf16x8 af = *(const bf16x8*)(A + m * 128 + ((kc ^ (m & 7)) << 4));
#pragma unroll
                for (int ni = 0; ni < 4; ++ni) acc[mi][ni] = __builtin_amdgcn_mfma_f32_16x16x32_bf16(wf[ni], af, acc[mi][ni], 0, 0, 0);
            }
        }
        asm volatile("s_waitcnt vmcnt(0)" ::: "memory");
        __syncthreads();
    }
#undef GL_ISSUE
}

#define EPI_IDS() do { const int etid_ = TID(); lane = etid_ & 63; wid = etid_ >> 6; wr = wid >> 2; wc = wid & 3; } while (0)

DEV void patch_decode(int local, int MT, int NT, int& mt, int& nt) {
    const int per_mtb = 8 * NT; const int mtb = local / per_mtb; const int rem = local - mtb * per_mtb;
    const int rows = (MT - 8 * mtb) < 8 ? (MT - 8 * mtb) : 8;
    const int per_ntb = rows * 8; const int nfull = NT >> 3; int ntb = rem / per_ntb; int cols = 8;
    if (ntb >= nfull) { ntb = nfull; cols = NT - 8 * nfull; }
    const int r2 = rem - ntb * per_ntb;
    mt = 8 * mtb + r2 / cols; nt = 8 * ntb + r2 % cols;
}

DEV void convert_chunk(const float* src, bf16_t* dst, size_t i8) {
    const float4 a = *(const float4*)(src + i8 * 8), b = *(const float4*)(src + i8 * 8 + 4);
    uint4 o; o.x = cvtpk(a.x, a.y); o.y = cvtpk(a.z, a.w); o.z = cvtpk(b.x, b.y); o.w = cvtpk(b.z, b.w);
    *(uint4*)(dst + i8 * 8) = o;
}
DEV void phase_prologue(const Args& a, unsigned char* smem) {
    unsigned char* ws = a.ws;
    const size_t gtid = (size_t)BID() * NTHR + TID(), gn = (size_t)gridDim.x * NTHR;
    {
        { const float* s0 = a.in[I_WUP]; bf16_t* d0 = (bf16_t*)(ws + WS_WUP); const size_t n0 = (size_t)32 * 1024 * 2048 / 8;
          for (size_t i = gtid; i < n0; i += 4 * gn) {
#pragma unroll
              for (int u = 0; u < 4; ++u) if (i + u * gn < n0) convert_chunk(s0, d0, i + u * gn); }
          const float* s1 = a.in[I_WDN]; bf16_t* d1 = (bf16_t*)(ws + WS_WDN); const size_t n1 = (size_t)32 * 1024 * 1024 / 8;
          for (size_t i = gtid; i < n1; i += 4 * gn) {
#pragma unroll
              for (int u = 0; u < 4; ++u) if (i + u * gn < n1) convert_chunk(s1, d1, i + u * gn); } }
        { const float* W = a.in[I_WOUT]; bf16_t* O = (bf16_t*)(ws + WS_WOUT); const float* gnn = a.in[I_GNN]; const float* gnf = a.in[I_GNF];
          for (size_t i = gtid; i < (size_t)1024 * 128; i += gn) { const int k = (int)(i >> 7); const float g_ = k < 512 ? gnn[k] : gnf[k - 512];
              const float4 x = *(const float4*)(W + i * 8), y = *(const float4*)(W + i * 8 + 4);
              uint4 o; o.x = cvtpk(x.x * g_, x.y * g_); o.y = cvtpk(x.z * g_, x.w * g_); o.z = cvtpk(y.x * g_, y.y * g_); o.w = cvtpk(y.z * g_, y.w * g_); *(uint4*)(O + i * 8) = o; } }
        const float* srcs[3] = {a.in[I_WGATE], a.in[I_WPLE], a.in[I_P]};
        bf16_t* dsts[3] = {(bf16_t*)(ws + WS_WGATE), (bf16_t*)(ws + WS_WPLE), (bf16_t*)(ws + WS_PB)};
        const size_t cnt8[3] = {1024 * 1024 / 8, 256 * 1024 / 8, (size_t)NTOK * 256 / 8};
#pragma unroll
        for (int s = 0; s < 3; ++s) for (size_t i = gtid; i < cnt8[s]; i += gn) convert_chunk(srcs[s], dsts[s], i);
        for (size_t i = gtid; i < (size_t)2 * 2048 * 32; i += gn) { const int which = (int)(i / (2048 * 32)); const int k = (int)(i / 32) % 2048, c8 = (int)(i % 32) * 8;
            uint4 o = {0u, 0u, 0u, 0u};
            if (c8 < 128) { const float* W = a.in[which ? I_WC1V : I_WC1K] + (size_t)k * 128 + c8; const float4 x = *(const float4*)W, y = *(const float4*)(W + 4); o.x = cvtpk(x.x, x.y); o.y = cvtpk(x.z, x.w); o.z = cvtpk(y.x, y.y); o.w = cvtpk(y.z, y.w); }
            *(uint4*)((bf16_t*)(ws + WS_WC1) + i * 8) = o; }
        for (size_t i = gtid; i < (size_t)2 * 128 * 32; i += gn) { const int which = (int)(i / (128 * 32)); const int k = (int)(i / 32) % 128, c8 = (int)(i % 32) * 8;
            uint4 o = {0u, 0u, 0u, 0u};
            if (c8 < 64) { const float* W = a.in[which ? I_WC2V : I_WC2K] + (size_t)k * 64 + c8; const float4 x = *(const float4*)W, y = *(const float4*)(W + 4); o.x = cvtpk(x.x, x.y); o.y = cvtpk(x.z, x.w); o.z = cvtpk(y.x, y.y); o.w = cvtpk(y.z, y.w); }
            *(uint4*)((bf16_t*)(ws + WS_WC2) + i * 8) = o; }
    }
    {
        const float* W = a.in[I_WIN]; bf16_t* O = (bf16_t*)(ws + WS_WIN);
        for (size_t i = gtid; i < (size_t)1024 * (NWIN / 8); i += gn) {
            const int k = (int)(i / (NWIN / 8)), j = (int)(i % (NWIN / 8)) * 8;
            uint4 o = {0u, 0u, 0u, 0u};
            if (j < 2848) {
                const int sj = (j < 1280) ? j : (j < 2816) ? j + 24 : (j < 2840) ? j - 1536 : j;
                const float4 x = *(const float4*)(W + (size_t)k * 2848 + sj), y = *(const float4*)(W + (size_t)k * 2848 + sj + 4);
                o.x = cvtpk(x.x, x.y); o.y = cvtpk(x.z, x.w); o.z = cvtpk(y.x, y.y); o.w = cvtpk(y.z, y.w);
            }
            *(uint4*)(O + (size_t)k * NWIN + j) = o;
        }
    }
    const int lane = TID() & 63; const int gw = BID() * NWAVE + (TID() >> 6), ngw = gridDim.x * NWAVE;
    {
        const float* X = a.in[I_X]; const float* g = a.in[I_LN1]; bf16_t* XN = (bf16_t*)(ws + WS_XN);
        for (int m = gw; m < NTOK; m += ngw) {
            float4 v[4]; float s = 0.f;
#pragma unroll
            for (int j = 0; j < 4; ++j) { v[j] = *(const float4*)(X + (size_t)m * 1024 + j * 256 + lane * 4); s += v[j].x * v[j].x + v[j].y * v[j].y + v[j].z * v[j].z + v[j].w * v[j].w; }
            const float rstd = rsqrtf(wave_sum(s) * (1.f / 1024.f) + EPS);
#pragma unroll
            for (int j = 0; j < 4; ++j) { const float4 gg = *(const float4*)(g + j * 256 + lane * 4);
                uint2 o; o.x = cvtpk(v[j].x * rstd * gg.x, v[j].y * rstd * gg.y); o.y = cvtpk(v[j].z * rstd * gg.z, v[j].w * rstd * gg.w);
                *(uint2*)(XN + (size_t)m * 1024 + j * 256 + lane * 4) = o; }
        }
    }
    if (gw < 256) {
        const int which = gw >> 7, n = gw & 127; const float* pe = a.in[which ? I_PEV : I_PEK]; const float* w1 = a.in[which ? I_WC1V : I_WC1K];
        float s = 0.f;
#pragma unroll 8
        for (int i = 0; i < 32; ++i) { const int k = lane + 64 * i; s += pe[k] * w1[(size_t)k * 128 + n]; }
        s = wave_sum(s);
        if (lane == 0) ((float*)(ws + WS_BIAS1))[which * 128 + n] = s;
    }
}

DEV void phase_inproj(const Args& a, unsigned char* smem) {
    const bf16_t* XN = (const bf16_t*)(a.ws + WS_XN); const bf16_t* W = (const bf16_t*)(a.ws + WS_WIN);
    bf16_t* PROJ = (bf16_t*)(a.ws + WS_PROJ); float* GN = (float*)(a.ws + WS_GN); float* LS = (float*)(a.ws + WS_LS); const float* bfg = a.in[I_BFG];
    int lane = TID() & 63, wid = TID() >> 6, wr = wid >> 2, wc = wid & 3; (void)wr; (void)wc; (void)lane;
    for (int item = VBID(); item < 64 * 12; item += gridDim.x) {
        int mt, nt; patch_decode(item, 64, 12, mt, nt);
        f32x4 acc[8][4];
        gemm256<true>(smem, 16, XN + (size_t)mt * 256 * 1024, 128u, [&](int r, int kc) { return (unsigned)(r * 2048 + kc * 16); },
                      W + nt * 256, (unsigned)(64 * NWIN * 2), [&](int k, int nc) { return (unsigned)(k * (NWIN * 2) + nc * 16); }, acc);
        EPI_IDS();
#pragma unroll
        for (int mi = 0; mi < 8; ++mi) {
            const int gm = mt * 256 + wr * 128 + mi * 16 + (lane & 15); const int b = gm >> 13, t = gm & 8191;
#pragma unroll
            for (int ni = 0; ni < 4; ++ni) {
                const int n = wc * 64 + ni * 16 + 4 * (lane >> 4); const f32x4 v = acc[mi][ni];
                if (nt < 11) {
                    const int hs = nt * 4 + wc, d = n & 63; const float sc = (hs < 8 || (hs >= 20 && hs < 28)) ? QS : 1.0f;
                    uint2 o; o.x = cvtpk(v[0] * sc, v[1] * sc); o.y = cvtpk(v[2] * sc, v[3] * sc);
                    *(uint2*)(PROJ + (((size_t)(hs * 2 + b)) * 8192 + t) * 64 + d) = o;
                } else if (n < 24) {
#pragma unroll
                    for (int r = 0; r < 4; ++r) GN[(size_t)gm * 24 + n + r] = sigmoidf_(v[r]);
                } else if (n < 32) {
#pragma unroll
                    for (int r = 0; r < 4; ++r) { const int h = n - 24 + r; LS[((size_t)(b * 8 + h)) * 8192 + t] = logsigmoidf_(v[r] + bfg[h]); }
                }
            }
        }
    }
}

DEV void phase_cmp(const Args& a, unsigned char* smem) {
    const bf16_t* PROJ = (const bf16_t*)(a.ws + WS_PROJ);
    const int tid = TID(); int lane = tid & 63, wid = tid >> 6, wr = wid >> 2, wc = wid & 3; (void)wr; (void)wc; (void)lane;
    for (int item = BID(); item < 16 + 16; item += gridDim.x) {
        if (item < 16) {
            const int which = item >> 3, b = (item >> 2) & 1, g = (item >> 1) & 1, mt = item & 1;
            const bf16_t* base = PROJ + ((size_t)((8 + 2 * which + g) * 2 + b)) * 8192 * 64;
            const bf16_t* W1 = (const bf16_t*)(a.ws + WS_WC1) + (size_t)which * 2048 * 256;
            const bf16_t* W2 = (const bf16_t*)(a.ws + WS_WC2) + (size_t)which * 128 * 256;
            const float* bias1 = (const float*)(a.ws + WS_BIAS1) + which * 128;
            bf16_t* HID = (bf16_t*)(a.ws + WS_HID) + ((size_t)(which * 4 + b * 2 + g)) * 512 * 128;
            bf16_t* OUT = (bf16_t*)(a.ws + WS_KC) + ((size_t)(which * 4 + b * 2 + g)) * 512 * 64;
            f32x4 acc[8][4];
            gemm256<true>(smem, 32, base, 128u, [&](int r, int kc) { int c = mt * 256 + r; c = c > 510 ? 510 : c; return (unsigned)(c * 2048 + kc * 16); },
                          W1, 64u * 512u, [&](int k, int nc) { return (unsigned)(k * 512 + nc * 16); }, acc);
        EPI_IDS();
            if (wc < 2) {
#pragma unroll
                for (int mi = 0; mi < 8; ++mi) { const int c = mt * 256 + wr * 128 + mi * 16 + (lane & 15);
#pragma unroll
                    for (int ni = 0; ni < 4; ++ni) { const int n = wc * 64 + ni * 16 + 4 * (lane >> 4); const f32x4 v = acc[mi][ni]; const float4 bb = *(const float4*)(bias1 + n);
                        uint2 o; o.x = cvtpk(gelu_tanh(v[0] + bb.x), gelu_tanh(v[1] + bb.y)); o.y = cvtpk(gelu_tanh(v[2] + bb.z), gelu_tanh(v[3] + bb.w));
                        *(uint2*)(HID + (size_t)c * 128 + n) = o; } }
            }
            __syncthreads();
            gemm256<true>(smem, 2, HID + (size_t)mt * 256 * 128, 128u, [&](int r, int kc) { return (unsigned)(r * 256 + kc * 16); },
                          W2, 64u * 512u, [&](int k, int nc) { return (unsigned)(k * 512 + nc * 16); }, acc);
        EPI_IDS();
            if (wc == 0) {
#pragma unroll
                for (int mi = 0; mi < 8; ++mi) { const int c = mt * 256 + wr * 128 + mi * 16 + (lane & 15);
#pragma unroll
                    for (int ni = 0; ni < 4; ++ni) { const int n = ni * 16 + 4 * (lane >> 4); const f32x4 v = acc[mi][ni];
                        uint2 o; o.x = cvtpk(v[0], v[1]); o.y = cvtpk(v[2], v[3]);
                        if (c >= 511) { o.x = 0u; o.y = 0u; }
                        *(uint2*)(OUT + (size_t)c * 64 + n) = o; } }
            }
            __syncthreads();
        } else {
            const int bh = item - 16; const float* LS = (const float*)(a.ws + WS_LS) + (size_t)bh * 8192; float* CUM = (float*)(a.ws + WS_CUM) + (size_t)bh * 8192;
            float* sc = (float*)smem;
            float v[16]; float s = 0.f;
#pragma unroll
            for (int j = 0; j < 4; ++j) { const float4 x = *(const float4*)(LS + tid * 16 + j * 4); v[4 * j] = x.x; v[4 * j + 1] = x.y; v[4 * j + 2] = x.z; v[4 * j + 3] = x.w; }
#pragma unroll
            for (int j = 0; j < 16; ++j) { s += v[j]; v[j] = s; }
            sc[tid] = s; __syncthreads();
            if (tid == 0) { float run = 0.f; for (int i = 0; i < NTHR; ++i) { const float x = sc[i]; sc[i] = run; run += x; } }
            __syncthreads();
            const float off = sc[tid];
#pragma unroll
            for (int j = 0; j < 4; ++j) { float4 o = {v[4 * j] + off, v[4 * j + 1] + off, v[4 * j + 2] + off, v[4 * j + 3] + off}; *(float4*)(CUM + tid * 16 + j * 4) = o; }
            __syncthreads();
        }
    }
}

constexpr int AT_STAGE = 16384;
constexpr int AT_BIAS_OFF = 2 * AT_STAGE;
constexpr int AT_IMP_OFF = AT_BIAS_OFF + 1024;
constexpr int AT_SEL_OFF = AT_IMP_OFF + 65536;
constexpr int AT_WUN_OFF = AT_SEL_OFF + 1024;
constexpr int AT_UCNT_OFF = AT_WUN_OFF + 128;
constexpr int AT_ULIST_OFF = AT_UCNT_OFF + 16;
constexpr int AT_ITEM_OFF = AT_ULIST_OFF + 128;
static_assert(AT_ITEM_OFF + 16 <= GEMM_LDS, "attention LDS map");
#define NEG_INF (-__builtin_inff())

#define KV_DECL uint4 rk0_, rv0_
#define KV_GLOAD(Kt, Vt) do { rk0_ = *(const uint4*)((Kt) + tid * 8); rv0_ = *(const uint4*)((Vt) + tid * 8); } while (0)
#define KV_LSTORE(stp) do { unsigned char* st_ = (stp); const int key = tid >> 3, ch = tid & 7; \
      *(uint4*)(st_ + key * 128 + ((ch ^ (key & 7)) << 4)) = rk0_; \
      *(uint4*)(st_ + 8192 + key * 128 + ((((ch >> 2) ^ ((key >> 1) & 1))) << 6) + ((ch & 3) << 4)) = rv0_; } while (0)
DEV void qk_tile(const unsigned char* Kst, const bf16x8 (&qf)[4], f32x16& p0, f32x16& p1, int lane) {
    const int key = lane & 31, hi = lane >> 5;
#pragma unroll
    for (int ks = 0; ks < 4; ++ks) { const int ch = 2 * ks + hi; const int off = key * 128 + ((ch ^ (key & 7)) << 4);
        const bf16x8 k0 = *(const bf16x8*)(Kst + off), k1 = *(const bf16x8*)(Kst + off + 32 * 128);
        p0 = __builtin_amdgcn_mfma_f32_32x32x16_bf16(k0, qf[ks], p0, 0, 0, 0);
        p1 = __builtin_amdgcn_mfma_f32_32x32x16_bf16(k1, qf[ks], p1, 0, 0, 0); }
}
DEV void pv_tile(const unsigned char* Vst, const f32x16& p0, const f32x16& p1, f32x16 (&o)[2], int lane) {
    const int hi = lane >> 5, i = lane & 15, gg = (lane >> 4) & 1;
    bf16x8 pa[4];
#pragma unroll
    for (int s = 0; s < 4; ++s) { const f32x16& p = (s < 2) ? p0 : p1; const int b = (s & 1) * 8;
        unsigned w[4];
#pragma unroll
        for (int j = 0; j < 4; ++j) w[j] = cvtpk(p[b + 2 * j], p[b + 2 * j + 1]);
        typedef unsigned u32x4_t __attribute__((ext_vector_type(4)));
        u32x4_t ww = {w[0], w[1], w[2], w[3]}; pa[s] = __builtin_bit_cast(bf16x8, ww); }
    const int q = i >> 2; const int sw = (q >> 1) & 1;
#pragma unroll
    for (int s = 0; s < 4; ++s) {
#pragma unroll
        for (int dh = 0; dh < 2; ++dh) {
            const int row0 = 16 * s + 4 * hi + q;
            const unsigned char* p = Vst + row0 * 128 + ((dh ^ sw) << 6) + gg * 32 + (i & 3) * 8;
            const s16x4 lo = tr_read(p), hh = tr_read(p + 8 * 128);
            const bf16x8 vf = {lo[0], lo[1], lo[2], lo[3], hh[0], hh[1], hh[2], hh[3]};
            o[dh] = __builtin_amdgcn_mfma_f32_32x32x16_bf16(vf, pa[s], o[dh], 0, 0, 0);
        }
    }
}
DEV float rowmax32(const f32x16& p0, const f32x16& p1) {
    float a = fmaxf(p0[0], p1[0]);
#pragma unroll
    for (int r = 1; r < 16; ++r) a = fmaxf(a, fmaxf(p0[r], p1[r]));
    return fmaxf(a, __shfl_xor(a, 32));
}
DEV void softmax_step(f32x16& p0, f32x16& p1, float& m, float& l, f32x16 (&o)[2]) {
    const float mt = rowmax32(p0, p1); const float mn = fmaxf(m, mt); const float alpha = __builtin_amdgcn_exp2f(m - mn);
    float rs = 0.f;
#pragma unroll
    for (int r = 0; r < 16; ++r) { p0[r] = __builtin_amdgcn_exp2f(p0[r] - mn); p1[r] = __builtin_amdgcn_exp2f(p1[r] - mn); rs += p0[r] + p1[r]; }
    rs += __shfl_xor(rs, 32);
    l = l * alpha + rs; m = mn;
    if (__any(alpha != 1.0f)) { o[0] *= alpha; o[1] *= alpha; }
}
template <int STRIDE> DEV void mask_tile(f32x16& p0, f32x16& p1, int kpos0, int lo, int hi_lim, int hi) {
#pragma unroll
    for (int r = 0; r < 16; ++r) { const int kp = kpos0 + STRIDE * crow(r, hi);
        if (kp < lo || kp > hi_lim) p0[r] = NEG_INF;
        const int kp1 = kp + 32 * STRIDE; if (kp1 < lo || kp1 > hi_lim) p1[r] = NEG_INF; }
}
template <int STRIDE> DEV void alibi_init(f32x16& p0, f32x16& p1, float slope2, int kpos0, int tref, int hi) {
    const float base = slope2 * (float)(kpos0 - tref + STRIDE * 4 * hi);
#pragma unroll
    for (int r = 0; r < 16; ++r) { const float c = (float)(STRIDE * ((r & 3) + 8 * (r >> 2))); p0[r] = fmaf(slope2, c, base); p1[r] = fmaf(slope2, c + (float)(32 * STRIDE), base); }
}
template <class Src, class Body>
DEV void kv_pipeline(unsigned char* smem, int n, const Src& src, const Body& body) {
    if (n <= 0) return;
    KV_DECL; const int tid = TID(); const bf16_t *kp, *vp;
    src(0, kp, vp); KV_GLOAD(kp, vp); KV_LSTORE(smem);
    __syncthreads();
    for (int j = 0; j < n; ++j) {
        const bool more = j + 1 < n;
        if (more) { src(j + 1, kp, vp); KV_GLOAD(kp, vp); }
        body(j, smem + (j & 1) * AT_STAGE);
        if (more) KV_LSTORE(smem + ((j + 1) & 1) * AT_STAGE);
        __syncthreads();
    }
}

DEV void fox_item(const Args& a, unsigned char* smem, int b, int h, int qb) {
    const int tid = TID(), lane = tid & 63, wid = tid >> 6, r32 = lane & 31, hi = lane >> 5;
    const bf16_t* PROJ = (const bf16_t*)(a.ws + WS_PROJ);
    const bf16_t* Q = PROJ + ((size_t)((20 + h) * 2 + b)) * 8192 * 64; const bf16_t* K = PROJ + ((size_t)((28 + h) * 2 + b)) * 8192 * 64; const bf16_t* V = PROJ + ((size_t)((36 + h) * 2 + b)) * 8192 * 64;
    const float* CUM = (const float*)(a.ws + WS_CUM) + (size_t)(b * 8 + h) * 8192;
    const int q0 = qb * 256; const int qrow = q0 + 32 * wid + r32;
    bf16x8 qf[4];
#pragma unroll
    for (int ks = 0; ks < 4; ++ks) qf[ks] = *(const bf16x8*)(Q + (size_t)qrow * 64 + 16 * ks + 8 * hi);
    const float cref = CUM[q0];
    const int ntiles = 4 * qb + 4; const int jmax_w = (q0 + 32 * wid + 31) >> 6; const int jmask_w = (q0 + 32 * wid) >> 6;
    f32x16 o[2]; o[0] = (f32x16){}; o[1] = (f32x16){}; float m = -1e30f, l = 0.f;
    float* biasL = (float*)(smem + AT_BIAS_OFF);
    KV_DECL; float breg = 0.f;
    KV_GLOAD(K, V); if (tid < 64) breg = (cref - CUM[tid]) * LOG2E;
    KV_LSTORE(smem); if (tid < 64) biasL[tid] = breg;
    __syncthreads();
    for (int j = 0; j < ntiles; ++j) {
        const bool more = j + 1 < ntiles;
        if (more) { KV_GLOAD(K + (size_t)(j + 1) * 4096, V + (size_t)(j + 1) * 4096); if (tid < 64) breg = (cref - CUM[(j + 1) * 64 + tid]) * LOG2E; }
        if (j <= jmax_w) {
            const unsigned char* st = smem + (j & 1) * AT_STAGE; const float* bl = biasL + (j & 1) * 64;
            f32x16 p0, p1;
#pragma unroll
            for (int g4 = 0; g4 < 4; ++g4) { const float4 x = *(const float4*)(bl + 8 * g4 + 4 * hi), y = *(const float4*)(bl + 32 + 8 * g4 + 4 * hi);
                p0[4 * g4] = x.x; p0[4 * g4 + 1] = x.y; p0[4 * g4 + 2] = x.z; p0[4 * g4 + 3] = x.w; p1[4 * g4] = y.x; p1[4 * g4 + 1] = y.y; p1[4 * g4 + 2] = y.z; p1[4 * g4 + 3] = y.w; }
            qk_tile(st, qf, p0, p1, lane);
            if (j >= jmask_w) mask_tile<1>(p0, p1, 64 * j, -1, qrow, hi);
            softmax_step(p0, p1, m, l, o);
            pv_tile(st + 8192, p0, p1, o, lane);
        }
        if (more) { KV_LSTORE(smem + ((j + 1) & 1) * AT_STAGE); if (tid < 64) biasL[((j + 1) & 1) * 64 + tid] = breg; }
        __syncthreads();
    }
    const float inv = 1.0f / l; float ss = 0.f;
    const size_t token = (size_t)b * 8192 + qrow;
    bf16_t* O = (bf16_t*)(a.ws + WS_OFOX) + token * 512 + h * 64;
#pragma unroll
    for (int dh = 0; dh < 2; ++dh)
#pragma unroll
        for (int g4 = 0; g4 < 4; ++g4) { const float v0 = o[dh][4 * g4] * inv, v1 = o[dh][4 * g4 + 1] * inv, v2 = o[dh][4 * g4 + 2] * inv, v3 = o[dh][4 * g4 + 3] * inv;
            ss += v0 * v0 + v1 * v1 + v2 * v2 + v3 * v3; uint2 w; w.x = cvtpk(v0, v1); w.y = cvtpk(v2, v3); *(uint2*)(O + 32 * dh + 8 * g4 + 4 * hi) = w; }
    ss += __shfl_xor(ss, 32);
    if (hi == 0) ((float*)(a.ws + WS_SSQ))[token * 16 + 8 + h] = ss;
}

DEV void nsa_item(const Args& a, unsigned char* smem, int b, int g, int tt) {
    const int tid = TID(), lane = tid & 63, wid = tid >> 6, col = lane & 31, hi = lane >> 5;
    const int t0 = tt * 64, tokw = col >> 2, r = col & 3, h = 4 * g + r; const int tokl = wid * 8 + tokw; const int t = t0 + tokl; const size_t token = (size_t)b * 8192 + t;
    const float slope2 = exp2f(-(float)(h + 1)) * LOG2E;
    const bf16_t* PROJ = (const bf16_t*)(a.ws + WS_PROJ);
    const float* GN = (const float*)(a.ws + WS_GN) + token * 24 + h * 3;
    const int cur = tt; const bool need_topk = cur > 15;
    bf16x8 qf[4];
    { const bf16_t* Q = PROJ + (((size_t)(h * 2 + b)) * 8192 + t) * 64;
#pragma unroll
      for (int ks = 0; ks < 4; ++ks) qf[ks] = *(const bf16x8*)(Q + 16 * ks + 8 * hi); }
    float* impw = (float*)(smem + AT_IMP_OFF) + wid * 2048; float* totw = impw + lane;
    unsigned* selmask = (unsigned*)(smem + AT_SEL_OFF); unsigned* wun = (unsigned*)(smem + AT_WUN_OFF); int* ucnt = (int*)(smem + AT_UCNT_OFF); unsigned char* ulist = smem + AT_ULIST_OFF;
    f32x16 o[2]; float m, l;
    const int tmin_w = t0 + wid * 8, tmax_w = tmin_w + 7;
    {
        const bf16_t* KC = (const bf16_t*)(a.ws + WS_KC) + ((size_t)(0 * 4 + b * 2 + g)) * 512 * 64; const bf16_t* VC = (const bf16_t*)(a.ws + WS_KC) + ((size_t)(1 * 4 + b * 2 + g)) * 512 * 64;
        const int ncv = t0 / 16 + 3; const int nct = (ncv + 63) >> 6;
        auto src = [&](int j, const bf16_t*& kp, const bf16_t*& vp) { kp = KC + (size_t)j * 4096; vp = VC + (size_t)j * 4096; };
        m = -1e30f; l = 0.f;
        kv_pipeline(smem, nct, src, [&](int j, const unsigned char* st) {
            const int kpos0 = 1024 * j + 31;
            if (kpos0 > tmax_w) return;
            f32x16 p0, p1; alibi_init<16>(p0, p1, slope2, kpos0, t0, hi);
            qk_tile(st, qf, p0, p1, lane);
            mask_tile<16>(p0, p1, kpos0, -1, t, hi);
            const float mt = rowmax32(p0, p1); const float mn = fmaxf(m, mt); float rs = 0.f;
#pragma unroll
            for (int rr = 0; rr < 16; ++rr) rs += __builtin_amdgcn_exp2f(p0[rr] - mn) + __builtin_amdgcn_exp2f(p1[rr] - mn);
            rs += __shfl_xor(rs, 32);
            l = l * __builtin_amdgcn_exp2f(m - mn) + rs; m = mn;
        });
        const float linv = l > 0.f ? 1.0f / l : 0.f;
        if (need_topk) { for (int i = lane; i < 8 * 129; i += 64) impw[i] = 0.f; }
        o[0] = (f32x16){}; o[1] = (f32x16){};
        kv_pipeline(smem, nct, src, [&](int j, const unsigned char* st) {
            const int kpos0 = 1024 * j + 31;
            if (kpos0 > tmax_w) return;
            f32x16 p0, p1; alibi_init<16>(p0, p1, slope2, kpos0, t0, hi);
            qk_tile(st, qf, p0, p1, lane);
            mask_tile<16>(p0, p1, kpos0, -1, t, hi);
#pragma unroll
            for (int rr = 0; rr < 16; ++rr) { p0[rr] = __builtin_amdgcn_exp2f(p0[rr] - m) * linv; p1[rr] = __builtin_amdgcn_exp2f(p1[rr] - m) * linv; }
            if (need_topk) {
#pragma unroll
                for (int half = 0; half < 2; ++half)
#pragma unroll
                    for (int g4 = 0; g4 < 4; ++g4) { const f32x16& p = half ? p1 : p0;
                        float ms = (p[4 * g4] + p[4 * g4 + 1]) + (p[4 * g4 + 2] + p[4 * g4 + 3]); float ls = p[4 * g4 + 3];
                        ms += __shfl_xor(ms, 1); ms += __shfl_xor(ms, 2); ls += __shfl_xor(ls, 1); ls += __shfl_xor(ls, 2);
                        const int n = 16 * j + 8 * half + 2 * g4 + hi;
                        if (r == 0) { atomicAdd(&impw[tokw * 129 + n], ms); atomicAdd(&impw[tokw * 129 + n + 1], ls); } }
            }
            pv_tile(st + 8192, p0, p1, o, lane);
        });
    }
    {
        unsigned un0 = 0u, un1 = 0u, un2 = 0u, un3 = 0u;
        if (need_topk) {
            for (int tk = 0; tk < 8; ++tk) {
                float v0 = impw[tk * 129 + lane], v1 = impw[tk * 129 + 64 + lane];
                v0 = (lane >= 1 && lane <= cur - 2) ? v0 : -1.0f; v1 = (lane + 64 <= cur - 2) ? v1 : -1.0f;
                unsigned m0 = 1u, m1 = 0u, m2 = 0u, m3 = 0u;
#define SETBIT(n_) do { const int n__ = (n_); const unsigned bit__ = 1u << (n__ & 31); const int w__ = n__ >> 5; if (w__ == 0) m0 |= bit__; else if (w__ == 1) m1 |= bit__; else if (w__ == 2) m2 |= bit__; else m3 |= bit__; } while (0)
                SETBIT(cur); SETBIT(cur - 1);
                for (int it = 0; it < 13; ++it) {
                    float mx = fmaxf(v0, v1);
#pragma unroll
                    for (int off = 1; off < 64; off <<= 1) mx = fmaxf(mx, __shfl_xor(mx, off));
                    const unsigned long long b0 = __ballot(v0 == mx);
                    int n;
                    if (b0) n = __ffsll((long long)b0) - 1; else { const unsigned long long b1 = __ballot(v1 == mx); n = 64 + __ffsll((long long)b1) - 1; }
                    if (lane == (n & 63)) { if (n < 64) v0 = -1.0f; else v1 = -1.0f; }
                    SETBIT(n);
                }
#undef SETBIT
                if (lane == 0) { unsigned* sm_ = selmask + (wid * 8 + tk) * 4; sm_[0] = m0; sm_[1] = m1; sm_[2] = m2; sm_[3] = m3; }
                un0 |= m0; un1 |= m1; un2 |= m2; un3 |= m3;
            }
        } else {
            const unsigned full = (2u << cur) - 1u;
            un0 = full;
            if (lane < 8) { unsigned* sm_ = selmask + (wid * 8 + lane) * 4; sm_[0] = full; sm_[1] = 0u; sm_[2] = 0u; sm_[3] = 0u; }
        }
        if (lane == 0) { wun[wid * 4] = un0; wun[wid * 4 + 1] = un1; wun[wid * 4 + 2] = un2; wun[wid * 4 + 3] = un3; }
        __syncthreads();
        if (tid == 0) { int c = 0;
            for (int w = 0; w < 4; ++w) { unsigned u = 0u; for (int ww = 0; ww < NWAVE; ++ww) u |= wun[ww * 4 + w]; for (int bb = 0; bb < 32; ++bb) if ((u >> bb) & 1u) ulist[c++] = (unsigned char)(w * 32 + bb); }
            ucnt[0] = c; }
        __syncthreads();
    }
    { const float g0 = GN[0];
#pragma unroll
      for (int rr = 0; rr < 16; ++rr) { totw[rr * 64] = o[0][rr] * g0; totw[(16 + rr) * 64] = o[1][rr] * g0; } }
    {
        const bf16_t* KS = PROJ + ((size_t)((12 + g) * 2 + b)) * 8192 * 64; const bf16_t* VS = PROJ + ((size_t)((14 + g) * 2 + b)) * 8192 * 64;
        const int nu = ucnt[0];
        m = -1e30f; l = 0.f; o[0] = (f32x16){}; o[1] = (f32x16){};
        kv_pipeline(smem, nu, [&](int j, const bf16_t*& kp, const bf16_t*& vp) { const int n = ulist[j]; kp = KS + (size_t)n * 4096; vp = VS + (size_t)n * 4096; },
            [&](int j, const unsigned char* st) {
                const int n = ulist[j];
                if (!((wun[wid * 4 + (n >> 5)] >> (n & 31)) & 1u)) return;
                const bool sel = (selmask[tokl * 4 + (n >> 5)] >> (n & 31)) & 1u;
                f32x16 p0, p1; alibi_init<1>(p0, p1, slope2, 64 * n, t0, hi);
                qk_tile(st, qf, p0, p1, lane);
                if (n == cur || !__all(sel)) mask_tile<1>(p0, p1, 64 * n, -1, sel ? t : -1, hi);
                softmax_step(p0, p1, m, l, o);
                pv_tile(st + 8192, p0, p1, o, lane);
            });
        const float g1 = GN[1] / fmaxf(l, 1e-30f);
#pragma unroll
        for (int rr = 0; rr < 16; ++rr) { totw[rr * 64] += o[0][rr] * g1; totw[(16 + rr) * 64] += o[1][rr] * g1; }
    }
    {
        const bf16_t* KW = PROJ + ((size_t)((16 + g) * 2 + b)) * 8192 * 64; const bf16_t* VW = PROJ + ((size_t)((18 + g) * 2 + b)) * 8192 * 64;
        const int jlo = (t0 - 511) > 0 ? ((t0 - 511) >> 6) : 0; const int jhi = cur;
        m = -1e30f; l = 0.f; o[0] = (f32x16){}; o[1] = (f32x16){};
        kv_pipeline(smem, jhi - jlo + 1, [&](int j, const bf16_t*& kp, const bf16_t*& vp) { kp = KW + (size_t)(jlo + j) * 4096; vp = VW + (size_t)(jlo + j) * 4096; },
            [&](int j, const unsigned char* st) {
                const int kpos0 = 64 * (jlo + j);
                if (kpos0 > tmax_w || kpos0 + 63 < tmin_w - 511) return;
                f32x16 p0, p1; alibi_init<1>(p0, p1, slope2, kpos0, t0, hi);
                qk_tile(st, qf, p0, p1, lane);
                if (kpos0 < tmax_w - 511 || kpos0 + 63 > tmin_w) mask_tile<1>(p0, p1, kpos0, t - 511, t, hi);
                softmax_step(p0, p1, m, l, o);
                pv_tile(st + 8192, p0, p1, o, lane);
            });
        const float g2 = GN[2] / fmaxf(l, 1e-30f);
#pragma unroll
        for (int rr = 0; rr < 16; ++rr) { o[0][rr] = totw[rr * 64] + o[0][rr] * g2; o[1][rr] = totw[(16 + rr) * 64] + o[1][rr] * g2; }
    }
    {
        float ss = 0.f; bf16_t* O = (bf16_t*)(a.ws + WS_ONSA) + token * 512 + h * 64;
#pragma unroll
        for (int dh = 0; dh < 2; ++dh)
#pragma unroll
            for (int g4 = 0; g4 < 4; ++g4) { const float v0 = o[dh][4 * g4], v1 = o[dh][4 * g4 + 1], v2 = o[dh][4 * g4 + 2], v3 = o[dh][4 * g4 + 3];
                ss += v0 * v0 + v1 * v1 + v2 * v2 + v3 * v3; uint2 w; w.x = cvtpk(v0, v1); w.y = cvtpk(v2, v3); *(uint2*)(O + 32 * dh + 8 * g4 + 4 * hi) = w; }
        ss += __shfl_xor(ss, 32);
        if (hi == 0) ((float*)(a.ws + WS_SSQ))[token * 16 + h] = ss;
    }
}
#ifndef PROBE_DUP
#define PROBE_DUP 0
#endif
DEV void phase_att(const Args& a, unsigned char* smem) {
    int* qctr = (int*)(a.ws + WS_CTL) + 64; int* sitem = (int*)(smem + AT_ITEM_OFF);
    for (;;) {
        if (TID() == 0) sitem[0] = atomicAdd(qctr, 1);
        __syncthreads();
        int item = sitem[0];
        __syncthreads();
        if ((PROBE_DUP >> PH_ATT) & 1) { if (item >= 2048 + (int)gridDim.x) break; if (item >= 1024 && item < 1024 + (int)gridDim.x) break; if (item >= 1024) item -= 1024 + (int)gridDim.x; }
        else if (item >= 1024) break;
        if (item < 512) { const int qb = 31 - (item >> 4), bh = item & 15; fox_item(a, smem, bh >> 3, bh & 7, qb); }
        else { const int idx = item - 512; const int tt = 127 - (idx >> 2), bg = idx & 3; nsa_item(a, smem, bg >> 1, bg & 1, tt); }
    }
}

DEV void phase_outproj(const Args& a, unsigned char* smem) {
    const bf16_t* ONSA = (const bf16_t*)(a.ws + WS_ONSA); const bf16_t* OFOX = (const bf16_t*)(a.ws + WS_OFOX); const float* SSQ = (const float*)(a.ws + WS_SSQ);
    const bf16_t* W = (const bf16_t*)(a.ws + WS_WOUT); float* H1 = (float*)(a.ws + WS_H1); const float* X = a.in[I_X];
    float* rs = (float*)(smem + MISC_OFF);
    const int tid = TID(); int lane = tid & 63, wid = tid >> 6, wr = wid >> 2, wc = wid & 3; (void)wr; (void)wc; (void)lane;
    for (int item = VBID(); item < 64 * 4; item += gridDim.x) {
        int mt, nt; patch_decode(item, 64, 4, mt, nt);
        if (tid < 256) { const float* s = SSQ + (size_t)(mt * 256 + tid) * 16; float sn = 0.f, sf = 0.f;
#pragma unroll
            for (int j = 0; j < 8; ++j) { sn += s[j]; sf += s[8 + j]; }
            rs[tid * 2] = rsqrtf(sn * (1.f / 512.f) + EPS); rs[tid * 2 + 1] = rsqrtf(sf * (1.f / 512.f) + EPS); }
        __syncthreads();
        f32x4 acc[8][4];
        gemm256<true>(smem, 8, ONSA + (size_t)mt * 256 * 512, 128u, [&](int r, int kc) { return (unsigned)(r * 1024 + kc * 16); },
                      W + nt * 256, 64u * 2048u, [&](int k, int nc) { return (unsigned)(k * 2048 + nc * 16); }, acc);
        EPI_IDS();
#pragma unroll
        for (int mi = 0; mi < 8; ++mi) { const int rl = wr * 128 + mi * 16 + (lane & 15); const float rat = rs[rl * 2] / rs[rl * 2 + 1];
#pragma unroll
            for (int ni = 0; ni < 4; ++ni) acc[mi][ni] *= rat; }
        gemm256<false>(smem, 8, OFOX + (size_t)mt * 256 * 512, 128u, [&](int r, int kc) { return (unsigned)(r * 1024 + kc * 16); },
                       W + (size_t)512 * 1024 + nt * 256, 64u * 2048u, [&](int k, int nc) { return (unsigned)(k * 2048 + nc * 16); }, acc);
        EPI_IDS();
#pragma unroll
        for (int mi = 0; mi < 8; ++mi) { const int rl = wr * 128 + mi * 16 + (lane & 15); const size_t gm = (size_t)mt * 256 + rl; const float rf = rs[rl * 2 + 1];
#pragma unroll
            for (int ni = 0; ni < 4; ++ni) { const int n = nt * 256 + wc * 64 + ni * 16 + 4 * (lane >> 4); const float4 x = *(const float4*)(X + gm * 1024 + n); const f32x4 v = acc[mi][ni] * rf;
                float4 o = {x.x + v[0], x.y + v[1], x.z + v[2], x.w + v[3]}; *(float4*)(H1 + gm * 1024 + n) = o; }
            asm volatile("" ::: "memory"); }
        __syncthreads();
    }
}

DEV void phase_route(const Args& a, unsigned char* smem) {
    const float* H1 = (const float*)(a.ws + WS_H1); bf16_t* XN = (bf16_t*)(a.ws + WS_XN); float* RSTD2 = (float*)(a.ws + WS_RSTD2);
    const float* ln2 = a.in[I_LN2]; const float* wr_ = a.in[I_WR]; const float* br = a.in[I_BR];
    int* CNT = (int*)(a.ws + WS_CTL);
    int* TOPI = (int*)(a.ws + WS_TOPI); int* TOPS = (int*)(a.ws + WS_TOPS); float* TOPW = (float*)(a.ws + WS_TOPW);
    int* TOKOF = (int*)(a.ws + WS_TOKOF); float* ROWW = (float*)(a.ws + WS_ROWW);
    float* part = (float*)smem;
    float* ssqp = part + 8 * 32 * 33;
    int* lcnt = (int*)(ssqp + 256); int* lbase = lcnt + 32; int* te = lbase + 32; int* trk = te + 256; float* tw = (float*)(trk + 256);
    const int tid = TID(), lane = tid & 63, wid = tid >> 6, i32 = lane & 31, kh = lane >> 5; const int tg = wid >> 2, kq = wid & 3;
    for (int item = BID(); item < 256; item += gridDim.x) {
        const int tok = item * 64 + tg * 32 + i32;
        if (tid < 32) lcnt[tid] = 0;
        f32x16 acc = (f32x16){}; float ss = 0.f;
        const float* hrow = H1 + (size_t)tok * 1024 + 256 * kq + 4 * kh; const float* lrow = ln2 + 256 * kq + 4 * kh; bf16_t* xrow = XN + (size_t)tok * 1024 + 256 * kq + 4 * kh;
        const float* wbase = wr_ + (size_t)(256 * kq + 4 * kh) * 32 + i32;
#pragma unroll 4
        for (int c = 0; c < 32; ++c) {
            const float4 hv = *(const float4*)(hrow + 8 * c); const float4 lv = *(const float4*)(lrow + 8 * c);
            ss += hv.x * hv.x + hv.y * hv.y + hv.z * hv.z + hv.w * hv.w;
            const float x0 = hv.x * lv.x, x1 = hv.y * lv.y, x2 = hv.z * lv.z, x3 = hv.w * lv.w;
            uint2 o; o.x = cvtpk(x0, x1); o.y = cvtpk(x2, x3); *(uint2*)(xrow + 8 * c) = o;
            const float* wp = wbase + (size_t)(8 * c) * 32;
            const float w0 = wp[0], w1 = wp[32], w2 = wp[64], w3 = wp[96];
            acc = __builtin_amdgcn_mfma_f32_32x32x2f32(x0, w0, acc, 0, 0, 0);
            acc = __builtin_amdgcn_mfma_f32_32x32x2f32(x1, w1, acc, 0, 0, 0);
            acc = __builtin_amdgcn_mfma_f32_32x32x2f32(x2, w2, acc, 0, 0, 0);
            acc = __builtin_amdgcn_mfma_f32_32x32x2f32(x3, w3, acc, 0, 0, 0);
        }
        ss += __shfl_xor(ss, 32);
        if (kh == 0) ssqp[wid * 32 + i32] = ss;
#pragma unroll
        for (int r = 0; r < 16; ++r) part[(wid * 32 + crow(r, kh)) * 33 + i32] = acc[r];
        __syncthreads();
        if (tid < 64) {
            const int g_ = tid >> 5, i_ = tid & 31; const int w0_ = g_ * 4;
            const float sq = ssqp[(w0_ + 0) * 32 + i_] + ssqp[(w0_ + 1) * 32 + i_] + ssqp[(w0_ + 2) * 32 + i_] + ssqp[(w0_ + 3) * 32 + i_]; const float rstd = rsqrtf(sq * (1.f / 1024.f) + EPS);
            RSTD2[item * 64 + tid] = rstd;
            float lg[32];
#pragma unroll
            for (int e = 0; e < 32; ++e) lg[e] = (part[((w0_ + 0) * 32 + i_) * 33 + e] + part[((w0_ + 1) * 32 + i_) * 33 + e] + part[((w0_ + 2) * 32 + i_) * 33 + e] + part[((w0_ + 3) * 32 + i_) * 33 + e]) * rstd + br[e];
            unsigned taken = 0u; float tv[4]; int ti[4];
#pragma unroll
            for (int k = 0; k < 4; ++k) { float best = -3.0e38f; int bi = 0;
#pragma unroll
                for (int e = 0; e < 32; ++e) { const bool ok = !((taken >> e) & 1u) && lg[e] > best; best = ok ? lg[e] : best; bi = ok ? e : bi; }
                taken |= 1u << bi; tv[k] = best; ti[k] = bi; }
            const float e1 = __expf(tv[1] - tv[0]), e2 = __expf(tv[2] - tv[0]), e3 = __expf(tv[3] - tv[0]); const float inv = 1.0f / (1.0f + e1 + e2 + e3);
            const float wv[4] = {inv, e1 * inv, e2 * inv, e3 * inv};
#pragma unroll
            for (int k = 0; k < 4; ++k) { const int idx = tid * 4 + k; te[idx] = ti[k]; trk[idx] = atomicAdd(&lcnt[ti[k]], 1); tw[idx] = wv[k]; }
        }
        __syncthreads();
        if (tid < 32) lbase[tid] = atomicAdd(&CNT[tid], lcnt[tid]);
        __syncthreads();
        if (tid < 256) { const int idx = tid; const int tk = item * 64 + (idx >> 2); const int e = te[idx]; const int slot = lbase[e] + trk[idx];
          TOPI[(size_t)tk * 4 + (idx & 3)] = e; TOPS[(size_t)tk * 4 + (idx & 3)] = slot; TOPW[(size_t)tk * 4 + (idx & 3)] = tw[idx];
          TOKOF[(size_t)e * 16384 + slot] = tk; ROWW[(size_t)e * 16384 + slot] = tw[idx]; }
        __syncthreads();
    }
}

struct MoeMap { int e, mt, nt, cnt, off; };
DEV void moe_setup(const Args& a, int* sm) {
    if (TID() == 0) { const int* CNT = (const int*)(a.ws + WS_CTL); int tot = 0; for (int e = 0; e < 32; ++e) { const int c = CNT[e]; const int mt = (c + 255) >> 8; sm[e] = mt; sm[32 + e] = tot; tot += mt; } sm[64] = tot; }
    __syncthreads();
}
DEV MoeMap moe_map(const Args& a, const int* sm, int item, int NT) {
    MoeMap mm; int e = 0;
#pragma unroll 1
    for (int i = 1; i < 32; ++i) if (item >= sm[32 + i] * NT) e = i;
    const int local = item - sm[32 + e] * NT; const int mte = sm[e];
    int mt_, nt_; patch_decode(local, mte, NT, mt_, nt_);
    mm.e = __builtin_amdgcn_readfirstlane(e); mm.mt = __builtin_amdgcn_readfirstlane(mt_); mm.nt = __builtin_amdgcn_readfirstlane(nt_);
    mm.cnt = __builtin_amdgcn_readfirstlane(((const int*)(a.ws + WS_CTL))[e]); mm.off = __builtin_amdgcn_readfirstlane(sm[32 + e] * 256); return mm;
}
DEV void phase_up(const Args& a, unsigned char* smem) {
    int* sm = (int*)(smem + MISC_OFF); int* tok = sm + 128; float* rsd = (float*)(tok + 256);
    const bf16_t* XN = (const bf16_t*)(a.ws + WS_XN); const bf16_t* W = (const bf16_t*)(a.ws + WS_WUP); bf16_t* ACT = (bf16_t*)(a.ws + WS_ACT); const float* RSTD2 = (const float*)(a.ws + WS_RSTD2);
    const int* TOKOF = (const int*)(a.ws + WS_TOKOF); const float* bup = a.in[I_BUP];
    const int tid = TID(); int lane = tid & 63, wid = tid >> 6, wr = wid >> 2, wc = wid & 3; (void)wr; (void)wc; (void)lane;
    moe_setup(a, sm);
    const int nitems = __builtin_amdgcn_readfirstlane(sm[64]) * 8;
    for (int item = VBID(); item < nitems; item += gridDim.x) {
        const MoeMap mm = moe_map(a, sm, item, 8);
        if (tid < 256) { const int slot = mm.mt * 256 + tid; const int tk_ = slot < mm.cnt ? TOKOF[(size_t)mm.e * 16384 + slot] : 0; tok[tid] = tk_; rsd[tid] = RSTD2[tk_]; }
        __syncthreads();
        const bf16_t* We = W + (size_t)mm.e * 1024 * 2048;
        f32x4 acc[8][4];
        gemm256<true>(smem, 16, XN, 128u, [&](int r, int kc) { return (unsigned)(tok[r] * 2048 + kc * 16); },
                      We + mm.nt * 128, 64u * 4096u, [&](int k, int nc) { const int ni = (nc >> 1) & 3; const int sc = ((ni >> 1) ? 1024 : 0) + (nc >> 3) * 32 + (ni & 1) * 16 + (nc & 1) * 8;
                          return (unsigned)(k * 4096 + sc * 2); }, acc);
        EPI_IDS();
#pragma unroll
        for (int mi = 0; mi < 8; ++mi) { const int rl_ = wr * 128 + mi * 16 + (lane & 15); const size_t row = (size_t)mm.off + mm.mt * 256 + rl_; const float rs_ = rsd[rl_];
#pragma unroll
            for (int ni = 0; ni < 2; ++ni) { const int jc = mm.nt * 128 + wc * 32 + ni * 16 + 4 * (lane >> 4);
                const float4 bg = *(const float4*)(bup + (size_t)mm.e * 2048 + jc), bl_ = *(const float4*)(bup + (size_t)mm.e * 2048 + 1024 + jc);
                const f32x4 gv = acc[mi][ni], lv = acc[mi][ni + 2]; const float bgv[4] = {bg.x, bg.y, bg.z, bg.w}, blv[4] = {bl_.x, bl_.y, bl_.z, bl_.w}; float r4[4];
#pragma unroll
                for (int r = 0; r < 4; ++r) { const float gg = fminf(gv[r] * rs_ + bgv[r], 7.0f); const float ll = fminf(fmaxf(lv[r] * rs_ + blv[r], -7.0f), 7.0f); r4[r] = gg * sigmoidf_(1.702f * gg) * (ll + 1.0f); }
                uint2 o; o.x = cvtpk(r4[0], r4[1]); o.y = cvtpk(r4[2], r4[3]); *(uint2*)(ACT + row * 1024 + jc) = o; } }
        __syncthreads();
    }
}
DEV void phase_down(const Args& a, unsigned char* smem) {
    int* sm = (int*)(smem + MISC_OFF); float* rw = (float*)(sm + 128);
    const bf16_t* ACT = (const bf16_t*)(a.ws + WS_ACT); const bf16_t* W = (const bf16_t*)(a.ws + WS_WDN); bf16_t* Y = (bf16_t*)(a.ws + WS_Y);
    const float* ROWW = (const float*)(a.ws + WS_ROWW); const float* bdn = a.in[I_BDN];
    const int tid = TID(); int lane = tid & 63, wid = tid >> 6, wr = wid >> 2, wc = wid & 3; (void)wr; (void)wc; (void)lane;
    moe_setup(a, sm);
    const int nitems = __builtin_amdgcn_readfirstlane(sm[64]) * 4;
    for (int item = VBID(); item < nitems; item += gridDim.x) {
        const MoeMap mm = moe_map(a, sm, item, 4);
        if (tid < 256) { const int slot = mm.mt * 256 + tid; rw[tid] = slot < mm.cnt ? ROWW[(size_t)mm.e * 16384 + slot] : 0.f; }
        __syncthreads();
        const bf16_t* We = W + (size_t)mm.e * 1024 * 1024; const bf16_t* Ab = ACT + ((size_t)mm.off + mm.mt * 256) * 1024;
        f32x4 acc[8][4];
        gemm256<true>(smem, 16, Ab, 128u, [&](int r, int kc) { return (unsigned)(r * 2048 + kc * 16); },
                      We + mm.nt * 256, 64u * 2048u, [&](int k, int nc) { return (unsigned)(k * 2048 + nc * 16); }, acc);
        EPI_IDS();
#pragma unroll
        for (int mi = 0; mi < 8; ++mi) { const int rl = wr * 128 + mi * 16 + (lane & 15); const size_t row = (size_t)mm.off + mm.mt * 256 + rl; const float w = rw[rl];
#pragma unroll
            for (int ni = 0; ni < 4; ++ni) { const int n = mm.nt * 256 + wc * 64 + ni * 16 + 4 * (lane >> 4); const float4 bb = *(const float4*)(bdn + (size_t)mm.e * 1024 + n); const f32x4 v = acc[mi][ni];
                uint2 o; o.x = cvtpk((v[0] + bb.x) * w, (v[1] + bb.y) * w); o.y = cvtpk((v[2] + bb.z) * w, (v[3] + bb.w) * w); *(uint2*)(Y + row * 1024 + n) = o; } }
        __syncthreads();
    }
}

DEV void phase_comb(const Args& a, unsigned char* smem) {
    int* sm = (int*)(smem + MISC_OFF);
    moe_setup(a, sm);
    float* H1 = (float*)(a.ws + WS_H1); bf16_t* XN = (bf16_t*)(a.ws + WS_XN); const bf16_t* Y = (const bf16_t*)(a.ws + WS_Y);
    const int* TOPI = (const int*)(a.ws + WS_TOPI); const int* TOPS = (const int*)(a.ws + WS_TOPS); const float* g = a.in[I_LNPLE];
    const int lane = TID() & 63; const int gw = BID() * NWAVE + (TID() >> 6), ngw = gridDim.x * NWAVE;
    for (int tok = gw; tok < NTOK; tok += ngw) {
        float4 v[4];
#pragma unroll
        for (int j = 0; j < 4; ++j) v[j] = *(const float4*)(H1 + (size_t)tok * 1024 + j * 256 + lane * 4);
#pragma unroll
        for (int k = 0; k < 4; ++k) { const int e = TOPI[(size_t)tok * 4 + k]; const size_t row = (size_t)sm[32 + e] * 256 + TOPS[(size_t)tok * 4 + k];
#pragma unroll
            for (int j = 0; j < 4; ++j) { const uint2 u = *(const uint2*)(Y + row * 1024 + j * 256 + lane * 4); v[j].x += bflo(u.x); v[j].y += bfhi(u.x); v[j].z += bflo(u.y); v[j].w += bfhi(u.y); } }
        float s = 0.f;
#pragma unroll
        for (int j = 0; j < 4; ++j) { *(float4*)(H1 + (size_t)tok * 1024 + j * 256 + lane * 4) = v[j]; s += v[j].x * v[j].x + v[j].y * v[j].y + v[j].z * v[j].z + v[j].w * v[j].w; }
        const float rstd = rsqrtf(wave_sum(s) * (1.f / 1024.f) + EPS);
#pragma unroll
        for (int j = 0; j < 4; ++j) { const float4 gg = *(const float4*)(g + j * 256 + lane * 4);
            uint2 o; o.x = cvtpk(v[j].x * rstd * gg.x, v[j].y * rstd * gg.y); o.y = cvtpk(v[j].z * rstd * gg.z, v[j].w * rstd * gg.w); *(uint2*)(XN + (size_t)tok * 1024 + j * 256 + lane * 4) = o; }
    }
}

DEV void phase_gate(const Args& a, unsigned char* smem) {
    const bf16_t* XN = (const bf16_t*)(a.ws + WS_XN); const bf16_t* WG = (const bf16_t*)(a.ws + WS_WGATE); const bf16_t* PB = (const bf16_t*)(a.ws + WS_PB); const bf16_t* WP = (const bf16_t*)(a.ws + WS_WPLE);
    const float* H2 = (const float*)(a.ws + WS_H1); float* OUT = a.out; float* SSQ3 = (float*)(a.ws + WS_SSQ3);
    const int tid = TID(); int lane = tid & 63, wid = tid >> 6, wr = wid >> 2, wc = wid & 3; (void)wr; (void)wc; (void)lane;
    for (int item = VBID(); item < 64 * 4; item += gridDim.x) {
        int mt, nt; patch_decode(item, 64, 4, mt, nt);
        f32x4 acc[8][4];
        gemm256<true>(smem, 16, XN + (size_t)mt * 256 * 1024, 128u, [&](int r, int kc) { return (unsigned)(r * 2048 + kc * 16); },
                      WG + nt * 256, 64u * 2048u, [&](int k, int nc) { return (unsigned)(k * 2048 + nc * 16); }, acc);
        EPI_IDS();
#pragma unroll
        for (int mi = 0; mi < 8; ++mi) { const size_t gm = (size_t)mt * 256 + wr * 128 + mi * 16 + (lane & 15);
#pragma unroll
            for (int ni = 0; ni < 4; ++ni) { const int n = nt * 256 + wc * 64 + ni * 16 + 4 * (lane >> 4); const f32x4 v = acc[mi][ni];
                float4 o = {sigmoidf_(v[0]), sigmoidf_(v[1]), sigmoidf_(v[2]), sigmoidf_(v[3])}; *(float4*)(OUT + gm * 1024 + n) = o; } }
        gemm256<true>(smem, 4, PB + (size_t)mt * 256 * 256, 128u, [&](int r, int kc) { return (unsigned)(r * 512 + kc * 16); },
                      WP + nt * 256, 64u * 2048u, [&](int k, int nc) { return (unsigned)(k * 2048 + nc * 16); }, acc);
        EPI_IDS();
#pragma unroll
        for (int mi = 0; mi < 8; ++mi) { const size_t gm = (size_t)mt * 256 + wr * 128 + mi * 16 + (lane & 15); float ss = 0.f;
#pragma unroll
            for (int ni = 0; ni < 4; ++ni) { const int n = nt * 256 + wc * 64 + ni * 16 + 4 * (lane >> 4); const f32x4 v = acc[mi][ni];
                const float4 gt = *(const float4*)(OUT + gm * 1024 + n); const float4 h = *(const float4*)(H2 + gm * 1024 + n);
                float4 o = {h.x + v[0] * gt.x, h.y + v[1] * gt.y, h.z + v[2] * gt.z, h.w + v[3] * gt.w}; *(float4*)(OUT + gm * 1024 + n) = o;
                ss += o.x * o.x + o.y * o.y + o.z * o.z + o.w * o.w; }
            ss += __shfl_xor(ss, 16); ss += __shfl_xor(ss, 32);
            if (lane < 16) SSQ3[gm * 16 + nt * 4 + wc] = ss;
            asm volatile("" ::: "memory"); }
        __syncthreads();
    }
}

DEV void phase_final(const Args& a) {
    float* OUT = a.out; const float* SSQ3 = (const float*)(a.ws + WS_SSQ3); const float* g = a.in[I_LNF];
    const int lane = TID() & 63; const int gw = BID() * NWAVE + (TID() >> 6), ngw = gridDim.x * NWAVE;
    for (int m = gw; m < NTOK; m += ngw) {
        float s = 0.f;
#pragma unroll
        for (int j = 0; j < 16; ++j) s += SSQ3[(size_t)m * 16 + j];
        const float rstd = rsqrtf(s * (1.f / 1024.f) + EPS);
#pragma unroll
        for (int j = 0; j < 4; ++j) { float4 v = *(const float4*)(OUT + (size_t)m * 1024 + j * 256 + lane * 4); const float4 gg = *(const float4*)(g + j * 256 + lane * 4);
            v.x *= rstd * gg.x; v.y *= rstd * gg.y; v.z *= rstd * gg.z; v.w *= rstd * gg.w; *(float4*)(OUT + (size_t)m * 1024 + j * 256 + lane * 4) = v; }
    }
}

template <int PH> DEV void run_phase(const Args& a, unsigned char* smem) {
    if constexpr (PH == PH_PRO) phase_prologue(a, smem);
    else if constexpr (PH == PH_INPROJ) phase_inproj(a, smem);
    else if constexpr (PH == PH_CMP) phase_cmp(a, smem);
    else if constexpr (PH == PH_ATT) phase_att(a, smem);
    else if constexpr (PH == PH_OUTPROJ) phase_outproj(a, smem);
    else if constexpr (PH == PH_ROUTE) phase_route(a, smem);
    else if constexpr (PH == PH_UP) phase_up(a, smem);
    else if constexpr (PH == PH_DOWN) phase_down(a, smem);
    else if constexpr (PH == PH_COMB) phase_comb(a, smem);
    else if constexpr (PH == PH_GATE) phase_gate(a, smem);
    else if constexpr (PH == PH_FINAL) phase_final(a);
}
#define XB_TMO      128
#define XB_XCNT(j)  (256  + 64 * (j))
#define XB_XSUB(j)  (1280 + 64 * (j))
#define XB_XGEN(j)  (2304 + 64 * (j))
#define XB_TOP      3328
#define XB_TOPGEN   3392
#define XCD_BAR_WORDS 3456
#define XB_SPIN_CAP (1u << 22)
DEV unsigned xb_ld(unsigned* p)              { return __hip_atomic_load(p, __ATOMIC_RELAXED, __HIP_MEMORY_SCOPE_AGENT); }
DEV unsigned xb_add(unsigned* p, unsigned v) { return __hip_atomic_fetch_add(p, v, __ATOMIC_RELAXED, __HIP_MEMORY_SCOPE_AGENT); }
DEV unsigned xb_xcc_id() { return (unsigned)__builtin_amdgcn_s_getreg((3 << 11) | 20) & 0xFu; }
#define XB_SPIN(cond, bar) do { unsigned _sp = 0; while (cond) { __builtin_amdgcn_s_sleep(1); \
    if ((++_sp & 255u) == 0u) { if (xb_ld(&(bar)[XB_TMO])) break; if (_sp > XB_SPIN_CAP) { atomicAdd(&(bar)[XB_TMO], 1u); break; } } } } while (0)
struct XcdBarrier { unsigned* bar; unsigned x; volatile LAS unsigned* st; };
DEV XcdBarrier xcd_barrier_post(unsigned* bar, volatile LAS unsigned* st) {
    XcdBarrier b; b.bar = bar; b.x = xb_xcc_id(); b.st = st;
    if (TID() == 0) (void)xb_add(&bar[XB_XCNT(b.x)], 1u);
    return b;
}
DEV void xcd_barrier_complete(unsigned* bar, unsigned x, unsigned& nloc, unsigned& nx) {
    const unsigned G = gridDim.x * gridDim.y * gridDim.z;
    unsigned sum, cnt, mine, sp = 0u;
    for (;;) {
        sum = 0u; cnt = 0u; mine = 0u;
#pragma unroll
        for (unsigned j = 0; j < 16; ++j) { const unsigned c = xb_ld(&bar[XB_XCNT(j)]); sum += c; cnt += (c > 0u) ? 1u : 0u; mine = (j == x) ? c : mine; }
        if (sum == G) break;
        __builtin_amdgcn_s_sleep(1);
        if ((++sp & 255u) == 0u) { if (xb_ld(&bar[XB_TMO])) break; if (sp > XB_SPIN_CAP) { atomicAdd(&bar[XB_TMO], 1u); break; } }
    }
    nloc = mine > 0u ? mine : 1u; nx = cnt > 0u ? cnt : 1u;
}
DEV void xcd_barrier(const XcdBarrier& b) {
    asm volatile("s_waitcnt vmcnt(0)" ::: "memory");
    __syncthreads();
    if (TID() == 0) {
        unsigned* bar = b.bar;
        __builtin_amdgcn_s_waitcnt(0);
        unsigned nloc = b.st[0], nx = b.st[1];
        if (nloc == 0u) { xcd_barrier_complete(bar, b.x, nloc, nx); b.st[0] = nloc; b.st[1] = nx; }
        const unsigned old = xb_add(&bar[XB_XSUB(b.x)], 1u);
        const unsigned gen = old / nloc;
        if (old + 1u == (gen + 1u) * nloc) {
            __builtin_amdgcn_fence(__ATOMIC_RELEASE, "agent");
            asm volatile("s_waitcnt vmcnt(0)" ::: "memory");
            const unsigned og = xb_add(&bar[XB_TOP], 1u);
            const unsigned tg = og / nx;
            if (og + 1u == (tg + 1u) * nx) xb_add(&bar[XB_TOPGEN], 1u);
            else XB_SPIN(xb_ld(&bar[XB_TOPGEN]) == tg, bar);
            __builtin_amdgcn_fence(__ATOMIC_ACQUIRE, "agent");
            xb_add(&bar[XB_XGEN(b.x)], 1u);
            asm volatile("s_waitcnt vmcnt(0)" ::: "memory");
        } else {
            XB_SPIN(xb_ld(&bar[XB_XGEN(b.x)]) == gen, bar);
            __builtin_amdgcn_fence(__ATOMIC_ACQUIRE, "agent");
            asm volatile("s_waitcnt vmcnt(0)" ::: "memory");
        }
    }
    __syncthreads();
}

__global__ void __launch_bounds__(NTHR, 2) mega(Args a) {
    extern __shared__ __attribute__((aligned(16))) unsigned char smem[];
    volatile LAS unsigned* bst = (volatile LAS unsigned*)(LAS unsigned char*)(smem + MISC_OFF + 4000);
    if (TID() == 0) { bst[0] = 0u; bst[1] = 0u; }
    __syncthreads();
    const XcdBarrier bar = xcd_barrier_post((unsigned*)(a.ws + WS_CTL) + 4096, bst);
#define GSYNC() xcd_barrier(bar)
#define RUN(ph) do { run_phase<ph>(a, smem); if ((PROBE_DUP >> ph) & 1) { GSYNC(); run_phase<ph>(a, smem); } } while (0)
    RUN(PH_PRO); GSYNC();
    RUN(PH_INPROJ); GSYNC();
    RUN(PH_CMP); GSYNC();
    RUN(PH_ATT); GSYNC();
    RUN(PH_OUTPROJ); GSYNC();
    RUN(PH_ROUTE); GSYNC();
    RUN(PH_UP); GSYNC();
    RUN(PH_DOWN); GSYNC();
    RUN(PH_COMB); GSYNC();
    RUN(PH_GATE); GSYNC();
    RUN(PH_FINAL);
#undef RUN
#undef GSYNC
}

extern "C" void kernel_launch(void* const* d_in, const int* in_sizes, int n_in, void* d_out, int out_size, void* d_ws, size_t ws_size, hipStream_t stream) {
    static int grid = 0;
    if (grid == 0) {
        if (n_in != 25 || ws_size < WS_END) { fprintf(stderr, "kernel_launch: unexpected n_in %d / ws %zu\n", n_in, ws_size); grid = -1; return; }
        int dev = 0, cus = 0, per_cu = 0;
        (void)hipGetDevice(&dev); (void)hipDeviceGetAttribute(&cus, hipDeviceAttributeMultiprocessorCount, dev);
        (void)hipFuncSetAttribute((const void*)mega, hipFuncAttributeMaxDynamicSharedMemorySize, LDS_BYTES);
        (void)hipOccupancyMaxActiveBlocksPerMultiprocessor(&per_cu, (const void*)mega, NTHR, LDS_BYTES);
        if (per_cu < 1) { fprintf(stderr, "kernel_launch: occupancy query says %d blocks per CU\n", per_cu); grid = -1; return; }
        grid = cus;
    }
    if (grid < 0) return;
    (void)hipMemsetAsync((char*)d_ws + WS_CTL, 0, 65536, stream);
    Args a{};
    for (int i = 0; i < 25; ++i) a.in[i] = (const float*)d_in[i];
    a.out = (float*)d_out; a.ws = (unsigned char*)d_ws; a.ph_lo = 0; a.ph_hi = PH_N;
    void* args[] = {&a};
    hipError_t e = hipLaunchCooperativeKernel((const void*)mega, dim3(grid), dim3(NTHR), args, LDS_BYTES, stream);
    if (e != hipSuccess) fprintf(stderr, "cooperative launch failed: %s (grid %d)\n", hipGetErrorString(e), grid);
}
```

```cpp
#include <hip/hip_runtime.h>
#include <stdint.h>
#include <cstdio>

#define DEV __device__ __forceinline__
#define LAS __attribute__((address_space(3)))

typedef unsigned short bf16_t;
typedef short bf16x8 __attribute__((ext_vector_type(8)));
typedef short s16x4 __attribute__((ext_vector_type(4)));
typedef float f32x4 __attribute__((ext_vector_type(4)));
typedef float f32x16 __attribute__((ext_vector_type(16)));
typedef float f32x2_t __attribute__((ext_vector_type(2)));
typedef __bf16 bf16x2_t __attribute__((ext_vector_type(2)));

constexpr int NTHR = 512, NWAVE = 8;
constexpr int NTOK = 16384;
constexpr float EPS = 1e-6f;
constexpr float LOG2E = 1.4426950408889634f;
constexpr float QS = 0.125f * LOG2E;
constexpr int NWIN = 3072;

constexpr size_t MiB = 1u << 20;
constexpr size_t WS_CTL = 0;
constexpr size_t WS_WIN = 1 * MiB;
constexpr size_t WS_WOUT = 7 * MiB;
constexpr size_t WS_WGATE = 9 * MiB;
constexpr size_t WS_WPLE = 11 * MiB;
constexpr size_t WS_WC1 = 12 * MiB;
constexpr size_t WS_WC2 = 15 * MiB + 512 * 1024 + 262144;
constexpr size_t WS_BIAS1 = 15 * MiB + 512 * 1024 + 262144 + 131072;
constexpr size_t WS_KC = 14 * MiB;
constexpr size_t WS_HID = 14 * MiB + 512 * 1024;
constexpr size_t WS_GN = 16 * MiB;
constexpr size_t WS_LS = 18 * MiB;
constexpr size_t WS_CUM = 19 * MiB;
constexpr size_t WS_SSQ = 20 * MiB;
constexpr size_t WS_TOPI = 21 * MiB;
constexpr size_t WS_TOPS = 21 * MiB + 262144;
constexpr size_t WS_TOPW = 21 * MiB + 524288;
constexpr size_t WS_TOKOF = 22 * MiB;
constexpr size_t WS_ROWW = 24 * MiB;
constexpr size_t WS_SSQ3 = 26 * MiB;
constexpr size_t WS_RSTD2 = 27 * MiB;
constexpr size_t WS_PB = 28 * MiB;
constexpr size_t WS_XN = 36 * MiB;
constexpr size_t WS_PROJ = 68 * MiB;
constexpr size_t WS_ONSA = 160 * MiB;
constexpr size_t WS_OFOX = 176 * MiB;
constexpr size_t WS_H1 = 192 * MiB;
constexpr size_t WS_WUP = 256 * MiB;
constexpr size_t WS_WDN = 384 * MiB;
constexpr size_t WS_ACT = 448 * MiB;
constexpr size_t WS_Y = 592 * MiB;
constexpr size_t WS_END = 736 * MiB;

enum { PH_PRO = 0, PH_INPROJ, PH_CMP, PH_ATT, PH_OUTPROJ, PH_ROUTE, PH_UP, PH_DOWN, PH_COMB, PH_GATE, PH_FINAL, PH_N };
struct Args { const float* in[25]; float* out; unsigned char* ws; int ph_lo, ph_hi; };
enum { I_X = 0, I_P, I_LN1, I_WIN, I_BFG, I_WC1K, I_WC2K, I_PEK, I_WC1V, I_WC2V, I_PEV, I_GNN, I_GNF, I_WOUT, I_LN2, I_WR, I_BR,
       I_WUP, I_BUP, I_WDN, I_BDN, I_LNPLE, I_WPLE, I_WGATE, I_LNF };

DEV int BID() { int b = (int)blockIdx.x; asm volatile("" : "+s"(b)); return b; }
DEV int VBID() { const int g = (int)gridDim.x, b = BID(); return (g & 7) ? b : (b & 7) * (g >> 3) + (b >> 3); }
DEV int TID() { int t = (int)__builtin_amdgcn_workitem_id_x(); asm volatile("" : "+v"(t)); return t; }
DEV unsigned cvtpk(float lo, float hi) { f32x2_t v = {lo, hi}; bf16x2_t b = __builtin_convertvector(v, bf16x2_t); return __builtin_bit_cast(unsigned, b); }
DEV float bflo(unsigned u) { return __uint_as_float(u << 16); }
DEV float bfhi(unsigned u) { return __uint_as_float(u & 0xffff0000u); }
DEV float wave_sum(float v) {
#pragma unroll
    for (int o = 1; o < 64; o <<= 1) v += __shfl_xor(v, o);
    return v;
}
#define DPP_MOV(x, ctrl) __builtin_bit_cast(float, __builtin_amdgcn_update_dpp(0, __builtin_bit_cast(int, (x)), (ctrl), 0xF, 0xF, true))
DEV float pair_sum(float x) { return x + __shfl_xor(x, 32); }
DEV float pair_max(float x) { return fmaxf(x, __shfl_xor(x, 32)); }
DEV float quad_sum(float x) { x += DPP_MOV(x, 0xB1); x += DPP_MOV(x, 0x4E); return x; }
DEV float wave_max_u(float x) {
    x = fmaxf(x, DPP_MOV(x, 0xB1)); x = fmaxf(x, DPP_MOV(x, 0x4E)); x = fmaxf(x, DPP_MOV(x, 0x141)); x = fmaxf(x, DPP_MOV(x, 0x140));
    const float a = __builtin_bit_cast(float, __builtin_amdgcn_readlane(__builtin_bit_cast(int, x), 0)), b = __builtin_bit_cast(float, __builtin_amdgcn_readlane(__builtin_bit_cast(int, x), 16));
    const float c = __builtin_bit_cast(float, __builtin_amdgcn_readlane(__builtin_bit_cast(int, x), 32)), d = __builtin_bit_cast(float, __builtin_amdgcn_readlane(__builtin_bit_cast(int, x), 48));
    return fmaxf(fmaxf(a, b), fmaxf(c, d));
}
DEV float sigmoidf_(float x) { return 1.0f / (1.0f + __expf(-x)); }
DEV float logsigmoidf_(float x) { return fminf(x, 0.f) - log1pf(__expf(-fabsf(x))); }
DEV float gelu_tanh(float x) { const float u = 0.7978845608028654f * (x + 0.044715f * x * x * x); const float th = 1.0f - 2.0f / (__expf(2.0f * u) + 1.0f); return 0.5f * x * (1.0f + th); }
DEV s16x4 tr_read(const unsigned char* p) {
    typedef short v4i16_t __attribute__((ext_vector_type(4)));
    return __builtin_bit_cast(s16x4, __builtin_amdgcn_ds_read_tr16_b64_v4i16((LAS v4i16_t*)p));
}
DEV int crow(int r, int hi) { return (r & 3) + 8 * (r >> 2) + 4 * hi; }

constexpr int GL_STAGE = 65536;
constexpr int GEMM_LDS = 2 * GL_STAGE;
constexpr int MISC_OFF = GEMM_LDS;
constexpr int LDS_BYTES = GEMM_LDS + 4096;

DEV void glds16s(const void* sbase, unsigned voff, unsigned lds_dst) { unsigned keep;
    asm volatile("s_mov_b32 %0, m0\n\ts_mov_b32 m0, %3\n\ts_nop 0\n\tglobal_load_lds_dwordx4 %1, %2\n\ts_mov_b32 m0, %0" : "=&s"(keep) : "v"(voff), "s"(sbase), "s"(lds_dst) : "memory"); }

DEV const unsigned char* uptr(const void* p) { const unsigned long long v = (unsigned long long)p; const unsigned lo = __builtin_amdgcn_readfirstlane((unsigned)v), hi = __builtin_amdgcn_readfirstlane((unsigned)(v >> 32)); return (const unsigned char*)(((unsigned long long)hi << 32) | lo); }

template <bool ZERO, class AO, class BO>
DEV void gemm256(unsigned char* smem, int nkt, const void* abase, unsigned akstep, const AO& aoff, const void* bbase, unsigned bkstep, const BO& boff, f32x4 (&acc)[8][4]) {
    const int tid = TID(), lane = tid & 63; const int wid = __builtin_amdgcn_readfirstlane(tid >> 6); const int wr = wid >> 2, wc = wid & 3;
    if (ZERO) {
#pragma unroll
        for (int mi = 0; mi < 8; ++mi)
#pragma unroll
            for (int ni = 0; ni < 4; ++ni) acc[mi][ni] = (f32x4){0.f, 0.f, 0.f, 0.f};
    }
    const unsigned lds0 = (unsigned)(uintptr_t)smem;
    const unsigned char* abase_u = uptr(abase); const unsigned char* bbase_u = uptr(bbase); const unsigned akstep_u = __builtin_amdgcn_readfirstlane(akstep), bkstep_u = __builtin_amdgcn_readfirstlane(bkstep);
    unsigned ao[4], bo[4];
#pragma unroll
    for (int i = 0; i < 4; ++i) { const int p = wid + 8 * i; ao[i] = aoff(8 * p + (lane >> 3), (lane & 7) ^ (lane >> 3));
        const int k = 2 * p + (lane >> 5); const int f = (k & 3) + 4 * ((k >> 3) & 1); bo[i] = boff(k, (lane & 31) ^ (f << 1)); }
#define GL_ISSUE(kt, st) do { const unsigned char* ab_ = abase_u + (size_t)(kt) * akstep_u; const unsigned char* bb_ = bbase_u + (size_t)(kt) * bkstep_u; \
        _Pragma("unroll") for (int i_ = 0; i_ < 4; ++i_) glds16s(ab_, ao[i_], (unsigned)__builtin_amdgcn_readfirstlane(lds0 + (st) * GL_STAGE + (wid + 8 * i_) * 1024)); \
        _Pragma("unroll") for (int i_ = 0; i_ < 4; ++i_) glds16s(bb_, bo[i_], (unsigned)__builtin_amdgcn_readfirstlane(lds0 + (st) * GL_STAGE + 32768 + (wid + 8 * i_) * 1024)); } while (0)
    GL_ISSUE(0, 0);
    asm volatile("s_waitcnt vmcnt(0)" ::: "memory");
    __syncthreads();
    for (int kt = 0; kt < nkt; ++kt) {
        if (kt + 1 < nkt) GL_ISSUE(kt + 1, (kt + 1) & 1);
        const unsigned char* A = smem + (kt & 1) * GL_STAGE; const unsigned char* Bt = A + 32768;
#pragma unroll
        for (int ks = 0; ks < 2; ++ks) {
            bf16x8 wf[4];
#pragma unroll
            for (int ni = 0; ni < 4; ++ni) {
                const int i = lane & 15, g = lane >> 4, q = i >> 2; const int row = ks * 32 + 8 * g + q; const int nc = wc * 8 + ni * 2 + ((i & 3) >> 1); const int f = q + 4 * (g & 1);
                const unsigned char* p = Bt + row * 512 + ((nc ^ (f << 1)) << 4) + (i & 1) * 8;
                const s16x4 lo = tr_read(p), hi = tr_read(p + 4 * 512);
                wf[ni] = (bf16x8){lo[0], lo[1], lo[2], lo[3], hi[0], hi[1], hi[2], hi[3]};
            }
#pragma unroll
            for (int mi = 0; mi < 8; ++mi) {
                const int m = wr * 128 + mi * 16 + (lane & 15); const int kc = ks * 4 + (lane >> 4);
                const bf16x8 af = *(const bf16x8*)(A + m * 128 + ((kc ^ (m & 7)) << 4));
#pragma unroll
                for (int ni = 0; ni < 4; ++ni) acc[mi][ni] = __builtin_amdgcn_mfma_f32_16x16x32_bf16(wf[ni], af, acc[mi][ni], 0, 0, 0);
            }
        }
        asm volatile("s_waitcnt vmcnt(0)" ::: "memory");
        __syncthreads();
    }
#undef GL_ISSUE
}

#define EPI_IDS() do { const int etid_ = TID(); lane = etid_ & 63; wid = etid_ >> 6; wr = wid >> 2; wc = wid & 3; } while (0)

DEV void patch_decode(int local, int MT, int NT, int& mt, int& nt) {
    const int per_mtb = 8 * NT; const int mtb = local / per_mtb; const int rem = local - mtb * per_mtb;
    const int rows = (MT - 8 * mtb) < 8 ? (MT - 8 * mtb) : 8;
    const int per_ntb = rows * 8; const int nfull = NT >> 3; int ntb = rem / per_ntb; int cols = 8;
    if (ntb >= nfull) { ntb = nfull; cols = NT - 8 * nfull; }
    const int r2 = rem - ntb * per_ntb;
    mt = 8 * mtb + r2 / cols; nt = 8 * ntb + r2 % cols;
}

DEV void convert_chunk(const float* src, bf16_t* dst, size_t i8) {
    const float4 a = *(const float4*)(src + i8 * 8), b = *(const float4*)(src + i8 * 8 + 4);
    uint4 o; o.x = cvtpk(a.x, a.y); o.y = cvtpk(a.z, a.w); o.z = cvtpk(b.x, b.y); o.w = cvtpk(b.z, b.w);
    *(uint4*)(dst + i8 * 8) = o;
}
DEV void phase_prologue(const Args& a, unsigned char* smem) {
    unsigned char* ws = a.ws;
    const size_t gtid = (size_t)BID() * NTHR + TID(), gn = (size_t)gridDim.x * NTHR;
    {
        { const float* W = a.in[I_WOUT]; bf16_t* O = (bf16_t*)(ws + WS_WOUT); const float* gnn = a.in[I_GNN]; const float* gnf = a.in[I_GNF];
          for (size_t i = gtid; i < (size_t)1024 * 128; i += gn) { const int k = (int)(i >> 7); const float g_ = k < 512 ? gnn[k] : gnf[k - 512];
              const float4 x = *(const float4*)(W + i * 8), y = *(const float4*)(W + i * 8 + 4);
              uint4 o; o.x = cvtpk(x.x * g_, x.y * g_); o.y = cvtpk(x.z * g_, x.w * g_); o.z = cvtpk(y.x * g_, y.y * g_); o.w = cvtpk(y.z * g_, y.w * g_); *(uint4*)(O + i * 8) = o; } }
        const float* srcs[3] = {a.in[I_WGATE], a.in[I_WPLE], a.in[I_P]};
        bf16_t* dsts[3] = {(bf16_t*)(ws + WS_WGATE), (bf16_t*)(ws + WS_WPLE), (bf16_t*)(ws + WS_PB)};
        const size_t cnt8[3] = {1024 * 1024 / 8, 256 * 1024 / 8, (size_t)NTOK * 256 / 8};
#pragma unroll
        for (int s = 0; s < 3; ++s) for (size_t i = gtid; i < cnt8[s]; i += gn) convert_chunk(srcs[s], dsts[s], i);
        for (size_t i = gtid; i < (size_t)2 * 2048 * 32; i += gn) { const int which = (int)(i / (2048 * 32)); const int k = (int)(i / 32) % 2048, c8 = (int)(i % 32) * 8;
            uint4 o = {0u, 0u, 0u, 0u};
            if (c8 < 128) { const float* W = a.in[which ? I_WC1V : I_WC1K] + (size_t)k * 128 + c8; const float4 x = *(const float4*)W, y = *(const float4*)(W + 4); o.x = cvtpk(x.x, x.y); o.y = cvtpk(x.z, x.w); o.z = cvtpk(y.x, y.y); o.w = cvtpk(y.z, y.w); }
            *(uint4*)((bf16_t*)(ws + WS_WC1) + i * 8) = o; }
        for (size_t i = gtid; i < (size_t)2 * 128 * 32; i += gn) { const int which = (int)(i / (128 * 32)); const int k = (int)(i / 32) % 128, c8 = (int)(i % 32) * 8;
            uint4 o = {0u, 0u, 0u, 0u};
            if (c8 < 64) { const float* W = a.in[which ? I_WC2V : I_WC2K] + (size_t)k * 64 + c8; const float4 x = *(const float4*)W, y = *(const float4*)(W + 4); o.x = cvtpk(x.x, x.y); o.y = cvtpk(x.z, x.w); o.z = cvtpk(y.x, y.y); o.w = cvtpk(y.z, y.w); }
            *(uint4*)((bf16_t*)(ws + WS_WC2) + i * 8) = o; }
    }
    {
        const float* W = a.in[I_WIN]; bf16_t* O = (bf16_t*)(ws + WS_WIN);
        for (size_t i = gtid; i < (size_t)1024 * (NWIN / 8); i += gn) {
            const int k = (int)(i / (NWIN / 8)), j = (int)(i % (NWIN / 8)) * 8;
            uint4 o = {0u, 0u, 0u, 0u};
            if (j < 2848) {
                const int sj = (j < 1280) ? j : (j < 2816) ? j + 24 : (j < 2840) ? j - 1536 : j;
                const float4 x = *(const float4*)(W + (size_t)k * 2848 + sj), y = *(const float4*)(W + (size_t)k * 2848 + sj + 4);
                o.x = cvtpk(x.x, x.y); o.y = cvtpk(x.z, x.w); o.z = cvtpk(y.x, y.y); o.w = cvtpk(y.z, y.w);
            }
            *(uint4*)(O + (size_t)k * NWIN + j) = o;
        }
    }
    const int lane = TID() & 63; const int gw = BID() * NWAVE + (TID() >> 6), ngw = gridDim.x * NWAVE;
    {
        const float* X = a.in[I_X]; const float* g = a.in[I_LN1]; bf16_t* XN = (bf16_t*)(ws + WS_XN);
        for (int m = gw; m < NTOK; m += ngw) {
            float4 v[4]; float s = 0.f;
#pragma unroll
            for (int j = 0; j < 4; ++j) { v[j] = *(const float4*)(X + (size_t)m * 1024 + j * 256 + lane * 4); s += v[j].x * v[j].x + v[j].y * v[j].y + v[j].z * v[j].z + v[j].w * v[j].w; }
            const float rstd = rsqrtf(wave_sum(s) * (1.f / 1024.f) + EPS);
#pragma unroll
            for (int j = 0; j < 4; ++j) { const float4 gg = *(const float4*)(g + j * 256 + lane * 4);
                uint2 o; o.x = cvtpk(v[j].x * rstd * gg.x, v[j].y * rstd * gg.y); o.y = cvtpk(v[j].z * rstd * gg.z, v[j].w * rstd * gg.w);
                *(uint2*)(XN + (size_t)m * 1024 + j * 256 + lane * 4) = o; }
        }
    }
    if (gw < 256) {
        const int which = gw >> 7, n = gw & 127; const float* pe = a.in[which ? I_PEV : I_PEK]; const float* w1 = a.in[which ? I_WC1V : I_WC1K];
        float s = 0.f;
#pragma unroll 8
        for (int i = 0; i < 32; ++i) { const int k = lane + 64 * i; s += pe[k] * w1[(size_t)k * 128 + n]; }
        s = wave_sum(s);
        if (lane == 0) ((float*)(ws + WS_BIAS1))[which * 128 + n] = s;
    }
}

DEV void phase_inproj(const Args& a, unsigned char* smem) {
    const bf16_t* XN = (const bf16_t*)(a.ws + WS_XN); const bf16_t* W = (const bf16_t*)(a.ws + WS_WIN);
    bf16_t* PROJ = (bf16_t*)(a.ws + WS_PROJ); float* GN = (float*)(a.ws + WS_GN); float* LS = (float*)(a.ws + WS_LS); const float* bfg = a.in[I_BFG];
    int lane = TID() & 63, wid = TID() >> 6, wr = wid >> 2, wc = wid & 3; (void)wr; (void)wc; (void)lane;
    for (int item = VBID(); item < 64 * 12; item += gridDim.x) {
        int mt, nt; patch_decode(item, 64, 12, mt, nt);
        f32x4 acc[8][4];
        gemm256<true>(smem, 16, XN + (size_t)mt * 256 * 1024, 128u, [&](int r, int kc) { return (unsigned)(r * 2048 + kc * 16); },
                      W + nt * 256, (unsigned)(64 * NWIN * 2), [&](int k, int nc) { return (unsigned)(k * (NWIN * 2) + nc * 16); }, acc);
        EPI_IDS();
#pragma unroll
        for (int mi = 0; mi < 8; ++mi) {
            const int gm = mt * 256 + wr * 128 + mi * 16 + (lane & 15); const int b = gm >> 13, t = gm & 8191;
#pragma unroll
            for (int ni = 0; ni < 4; ++ni) {
                const int n = wc * 64 + ni * 16 + 4 * (lane >> 4); const f32x4 v = acc[mi][ni];
                if (nt < 11) {
                    const int hs = nt * 4 + wc, d = n & 63; const float sc = (hs < 8 || (hs >= 20 && hs < 28)) ? QS : 1.0f;
                    uint2 o; o.x = cvtpk(v[0] * sc, v[1] * sc); o.y = cvtpk(v[2] * sc, v[3] * sc);
                    *(uint2*)(PROJ + (((size_t)(hs * 2 + b)) * 8192 + t) * 64 + d) = o;
                } else if (n < 24) {
#pragma unroll
                    for (int r = 0; r < 4; ++r) GN[(size_t)gm * 24 + n + r] = sigmoidf_(v[r]);
                } else if (n < 32) {
#pragma unroll
                    for (int r = 0; r < 4; ++r) { const int h = n - 24 + r; LS[((size_t)(b * 8 + h)) * 8192 + t] = logsigmoidf_(v[r] + bfg[h]); }
                }
            }
        }
    }
}

DEV void phase_cmp(const Args& a, unsigned char* smem) {
    const bf16_t* PROJ = (const bf16_t*)(a.ws + WS_PROJ);
    const int tid = TID(); int lane = tid & 63, wid = tid >> 6, wr = wid >> 2, wc = wid & 3; (void)wr; (void)wc; (void)lane;
    for (int item = BID(); item < 16 + 16; item += gridDim.x) {
        if (item < 16) {
            const int which = item >> 3, b = (item >> 2) & 1, g = (item >> 1) & 1, mt = item & 1;
            const bf16_t* base = PROJ + ((size_t)((8 + 2 * which + g) * 2 + b)) * 8192 * 64;
            const bf16_t* W1 = (const bf16_t*)(a.ws + WS_WC1) + (size_t)which * 2048 * 256;
            const bf16_t* W2 = (const bf16_t*)(a.ws + WS_WC2) + (size_t)which * 128 * 256;
            const float* bias1 = (const float*)(a.ws + WS_BIAS1) + which * 128;
            bf16_t* HID = (bf16_t*)(a.ws + WS_HID) + ((size_t)(which * 4 + b * 2 + g)) * 512 * 128;
            bf16_t* OUT = (bf16_t*)(a.ws + WS_KC) + ((size_t)(which * 4 + b * 2 + g)) * 512 * 64;
            f32x4 acc[8][4];
            gemm256<true>(smem, 32, base, 128u, [&](int r, int kc) { int c = mt * 256 + r; c = c > 510 ? 510 : c; return (unsigned)(c * 2048 + kc * 16); },
                          W1, 64u * 512u, [&](int k, int nc) { return (unsigned)(k * 512 + nc * 16); }, acc);
        EPI_IDS();
            if (wc < 2) {
#pragma unroll
                for (int mi = 0; mi < 8; ++mi) { const int c = mt * 256 + wr * 128 + mi * 16 + (lane & 15);
#pragma unroll
                    for (int ni = 0; ni < 4; ++ni) { const int n = wc * 64 + ni * 16 + 4 * (lane >> 4); const f32x4 v = acc[mi][ni]; const float4 bb = *(const float4*)(bias1 + n);
                        uint2 o; o.x = cvtpk(gelu_tanh(v[0] + bb.x), gelu_tanh(v[1] + bb.y)); o.y = cvtpk(gelu_tanh(v[2] + bb.z), gelu_tanh(v[3] + bb.w));
                        *(uint2*)(HID + (size_t)c * 128 + n) = o; } }
            }
            __syncthreads();
            gemm256<true>(smem, 2, HID + (size_t)mt * 256 * 128, 128u, [&](int r, int kc) { return (unsigned)(r * 256 + kc * 16); },
                          W2, 64u * 512u, [&](int k, int nc) { return (unsigned)(k * 512 + nc * 16); }, acc);
        EPI_IDS();
            if (wc == 0) {
#pragma unroll
                for (int mi = 0; mi < 8; ++mi) { const int c = mt * 256 + wr * 128 + mi * 16 + (lane & 15);
#pragma unroll
                    for (int ni = 0; ni < 4; ++ni) { const int n = ni * 16 + 4 * (lane >> 4); const f32x4 v = acc[mi][ni];
                        uint2 o; o.x = cvtpk(v[0], v[1]); o.y = cvtpk(v[2], v[3]);
                        if (c >= 511) { o.x = 0u; o.y = 0u; }
                        *(uint2*)(OUT + (size_t)c * 64 + n) = o; } }
            }
            __syncthreads();
        } else {
            const int bh = item - 16; const float* LS = (const float*)(a.ws + WS_LS) + (size_t)bh * 8192; float* CUM = (float*)(a.ws + WS_CUM) + (size_t)bh * 8192;
            float* sc = (float*)smem;
            float v[16]; float s = 0.f;
#pragma unroll
            for (int j = 0; j < 4; ++j) { const float4 x = *(const float4*)(LS + tid * 16 + j * 4); v[4 * j] = x.x; v[4 * j + 1] = x.y; v[4 * j + 2] = x.z; v[4 * j + 3] = x.w; }
#pragma unroll
            for (int j = 0; j < 16; ++j) { s += v[j]; v[j] = s; }
            sc[tid] = s; __syncthreads();
            if (tid == 0) { float run = 0.f; for (int i = 0; i < NTHR; ++i) { const float x = sc[i]; sc[i] = run; run += x; } }
            __syncthreads();
            const float off = sc[tid];
#pragma unroll
            for (int j = 0; j < 4; ++j) { float4 o = {v[4 * j] + off, v[4 * j + 1] + off, v[4 * j + 2] + off, v[4 * j + 3] + off}; *(float4*)(CUM + tid * 16 + j * 4) = o; }
            __syncthreads();
        }
    }
}

constexpr int AT_STAGE = 16384;
constexpr int AT_BIAS_OFF = 3 * AT_STAGE;
constexpr int AT_IMP_OFF = AT_BIAS_OFF + 1024;
constexpr int AT_SEL_OFF = AT_IMP_OFF + 65536;
constexpr int AT_WUN_OFF = AT_SEL_OFF + 1024;
constexpr int AT_UCNT_OFF = AT_WUN_OFF + 128;
constexpr int AT_ULIST_OFF = AT_UCNT_OFF + 16;
constexpr int AT_ITEM_OFF = AT_ULIST_OFF + 128;
static_assert(AT_ITEM_OFF + 16 <= GEMM_LDS, "attention LDS map");
#define NEG_INF (-__builtin_inff())

#define KV_DECL uint4 rk0_, rv0_
#define KV_GLOAD(Kt, Vt) do { rk0_ = *(const uint4*)((Kt) + tid * 8); rv0_ = *(const uint4*)((Vt) + tid * 8); } while (0)
#define KV_LSTORE(stp) do { unsigned char* st_ = (stp); const int key = tid >> 3, ch = tid & 7; \
      *(uint4*)(st_ + key * 128 + ((ch ^ (key & 7)) << 4)) = rk0_; \
      *(uint4*)(st_ + 8192 + key * 128 + ((((ch >> 2) ^ ((key >> 1) & 1))) << 6) + ((ch & 3) << 4)) = rv0_; } while (0)
template <bool FULL>
DEV void qk_tile(const unsigned char* Kst, const bf16x8 (&qf)[4], f32x16& p0, f32x16& p1, int lane) {
    const int key = lane & 31, hi = lane >> 5;
    if (FULL) {
        bf16x8 k0[4], k1[4];
#pragma unroll
        for (int ks = 0; ks < 4; ++ks) { const int ch = 2 * ks + hi; const int off = key * 128 + ((ch ^ (key & 7)) << 4);
            k0[ks] = *(const bf16x8*)(Kst + off); k1[ks] = *(const bf16x8*)(Kst + off + 32 * 128); }
        __builtin_amdgcn_sched_barrier(0);
#pragma unroll
        for (int ks = 0; ks < 4; ++ks) {
            p0 = __builtin_amdgcn_mfma_f32_32x32x16_bf16(k0[ks], qf[ks], p0, 0, 0, 0);
            p1 = __builtin_amdgcn_mfma_f32_32x32x16_bf16(k1[ks], qf[ks], p1, 0, 0, 0); }
    } else {
        bf16x8 kk[4];
#pragma unroll
        for (int ks = 0; ks < 4; ++ks) { const int ch = 2 * ks + hi; kk[ks] = *(const bf16x8*)(Kst + key * 128 + ((ch ^ (key & 7)) << 4)); }
        __builtin_amdgcn_sched_barrier(0);
#pragma unroll
        for (int ks = 0; ks < 4; ++ks) p0 = __builtin_amdgcn_mfma_f32_32x32x16_bf16(kk[ks], qf[ks], p0, 0, 0, 0);
        __builtin_amdgcn_sched_barrier(0);
#pragma unroll
        for (int ks = 0; ks < 4; ++ks) { const int ch = 2 * ks + hi; kk[ks] = *(const bf16x8*)(Kst + key * 128 + ((ch ^ (key & 7)) << 4) + 32 * 128); }
        __builtin_amdgcn_sched_barrier(0);
#pragma unroll
        for (int ks = 0; ks < 4; ++ks) p1 = __builtin_amdgcn_mfma_f32_32x32x16_bf16(kk[ks], qf[ks], p1, 0, 0, 0);
    }
}
template <bool FULL>
DEV void pv_tile(const unsigned char* Vst, const f32x16& p0, const f32x16& p1, f32x16 (&o)[2], int lane) {
    const int hi = lane >> 5, i = lane & 15, gg = (lane >> 4) & 1;
    const int q = i >> 2; const int sw = (q >> 1) & 1;
    bf16x8 pa[4];
#pragma unroll
    for (int s = 0; s < 4; ++s) { const f32x16& p = (s < 2) ? p0 : p1; const int b = (s & 1) * 8;
        unsigned w[4];
#pragma unroll
        for (int j = 0; j < 4; ++j) w[j] = cvtpk(p[b + 2 * j], p[b + 2 * j + 1]);
        typedef unsigned u32x4_t __attribute__((ext_vector_type(4)));
        u32x4_t ww = {w[0], w[1], w[2], w[3]}; pa[s] = __builtin_bit_cast(bf16x8, ww); }
    constexpr int NB = FULL ? 1 : 2, SB = FULL ? 4 : 2;
#pragma unroll
    for (int bt = 0; bt < NB; ++bt) {
        s16x4 vlo[SB][2], vhi[SB][2];
#pragma unroll
        for (int s_ = 0; s_ < SB; ++s_)
#pragma unroll
            for (int dh = 0; dh < 2; ++dh) { const int s = bt * SB + s_; const int row0 = 16 * s + 4 * hi + q;
                const unsigned char* p = Vst + row0 * 128 + ((dh ^ sw) << 6) + gg * 32 + (i & 3) * 8;
                vlo[s_][dh] = tr_read(p); vhi[s_][dh] = tr_read(p + 8 * 128); }
        __builtin_amdgcn_sched_barrier(0);
#pragma unroll
        for (int s_ = 0; s_ < SB; ++s_)
#pragma unroll
            for (int dh = 0; dh < 2; ++dh) { const int s = bt * SB + s_;
                const bf16x8 vf = {vlo[s_][dh][0], vlo[s_][dh][1], vlo[s_][dh][2], vlo[s_][dh][3], vhi[s_][dh][0], vhi[s_][dh][1], vhi[s_][dh][2], vhi[s_][dh][3]};
                o[dh] = __builtin_amdgcn_mfma_f32_32x32x16_bf16(vf, pa[s], o[dh], 0, 0, 0); }
        __builtin_amdgcn_sched_barrier(0);
    }
}
DEV float rowmax32(const f32x16& p0, const f32x16& p1) {
    float a = fmaxf(p0[0], p1[0]), b = fmaxf(p0[1], p1[1]);
#pragma unroll
    for (int r = 2; r < 16; r += 2) { a = fmaxf(fmaxf(a, p0[r]), p1[r]); b = fmaxf(fmaxf(b, p0[r + 1]), p1[r + 1]); }
    return pair_max(fmaxf(a, b));
}
DEV void softmax_step(f32x16& p0, f32x16& p1, float& m, float& l, f32x16 (&o)[2]) {
    const float mt = rowmax32(p0, p1); const float mn = fmaxf(m, mt); const float alpha = __builtin_amdgcn_exp2f(m - mn);
    float rs = 0.f;
#pragma unroll
    for (int r = 0; r < 16; ++r) { p0[r] = __builtin_amdgcn_exp2f(p0[r] - mn); p1[r] = __builtin_amdgcn_exp2f(p1[r] - mn); rs += p0[r] + p1[r]; }
    rs = pair_sum(rs);
    l = l * alpha + rs; m = mn;
    if (__any(alpha != 1.0f)) { o[0] *= alpha; o[1] *= alpha; }
}
template <int STRIDE> DEV void mask_tile(f32x16& p0, f32x16& p1, int kpos0, int lo, int hi_lim, int hi) {
#pragma unroll
    for (int r = 0; r < 16; ++r) { const int kp = kpos0 + STRIDE * crow(r, hi);
        if (kp < lo || kp > hi_lim) p0[r] = NEG_INF;
        const int kp1 = kp + 32 * STRIDE; if (kp1 < lo || kp1 > hi_lim) p1[r] = NEG_INF; }
}
template <int STRIDE> DEV void alibi_init(f32x16& p0, f32x16& p1, float slope2, int kpos0, int tref, int hi) {
    const float base = slope2 * (float)(kpos0 - tref + STRIDE * 4 * hi);
#pragma unroll
    for (int r = 0; r < 16; ++r) { const float c = (float)(STRIDE * ((r & 3) + 8 * (r >> 2))); p0[r] = fmaf(slope2, c, base); p1[r] = fmaf(slope2, c + (float)(32 * STRIDE), base); }
}
template <class Src, class Body>
DEV void kv_pipeline(unsigned char* smem, int n, const Src& src, const Body& body) {
    if (n <= 0) return;
    KV_DECL; const int tid = TID(); const bf16_t *kp, *vp;
    src(0, kp, vp); KV_GLOAD(kp, vp); KV_LSTORE(smem);
    __syncthreads();
    for (int j = 0; j < n; ++j) {
        const bool more = j + 1 < n;
        if (more) { src(j + 1, kp, vp); KV_GLOAD(kp, vp); }
        body(j, smem + (j & 1) * AT_STAGE);
        if (more) KV_LSTORE(smem + ((j + 1) & 1) * AT_STAGE);
        __syncthreads();
    }
}

constexpr int CV_PER_STEP = 373; constexpr int CV_NUP = 32 * 1024 * 2048 / 8, CV_NDN = 32 * 1024 * 1024 / 8;
static_assert((long long)33792 * CV_PER_STEP >= (long long)CV_NUP + CV_NDN, "conversion coverage");
DEV void fox_item(const Args& a, unsigned char* smem, int fi, int b, int h, int qb) {
    const int tid = TID(), lane = tid & 63, wid = tid >> 6, r32 = lane & 31, hi = lane >> 5;
    const bf16_t* PROJ = (const bf16_t*)(a.ws + WS_PROJ);
    const bf16_t* Q = PROJ + ((size_t)((20 + h) * 2 + b)) * 8192 * 64; const bf16_t* K = PROJ + ((size_t)((28 + h) * 2 + b)) * 8192 * 64; const bf16_t* V = PROJ + ((size_t)((36 + h) * 2 + b)) * 8192 * 64;
    const float* CUM = (const float*)(a.ws + WS_CUM) + (size_t)(b * 8 + h) * 8192;
    const int q0 = qb * 256; const int qrow = q0 + 32 * wid + r32;
    bf16x8 qf[4];
#pragma unroll
    for (int ks = 0; ks < 4; ++ks) qf[ks] = *(const bf16x8*)(Q + (size_t)qrow * 64 + 16 * ks + 8 * hi);
    const float cref = CUM[q0];
    const int ntiles = 4 * qb + 4; const int jmax_w = (q0 + 32 * wid + 31) >> 6; const int jmask_w = (q0 + 32 * wid) >> 6;
    f32x16 o[2]; o[0] = (f32x16){}; o[1] = (f32x16){}; float m = -1e30f, l = 0.f;
    float* biasL = (float*)(smem + AT_BIAS_OFF);
    const int gq_ = fi >> 4; const int sidx0 = 16 * (128 * gq_ - 2 * gq_ * (gq_ - 1)) + (fi & 15) * (128 - 4 * gq_);
    const float* cvs = nullptr; bf16_t* cvd = nullptr; float4 cva, cvb;
    KV_DECL; float breg = 0.f;
    KV_GLOAD(K, V); if (tid < 64) breg = (cref - CUM[tid]) * LOG2E;
    KV_LSTORE(smem); if (tid < 64) biasL[tid] = breg;
    KV_GLOAD(K + 4096, V + 4096); if (tid < 64) breg = (cref - CUM[64 + tid]) * LOG2E;
    KV_LSTORE(smem + AT_STAGE); if (tid < 64) biasL[64 + tid] = breg;
    __syncthreads();
#define FOX_QK(P0, P1, jj, sj) do { const float* bl_ = biasL + (sj) * 64; \
        _Pragma("unroll") for (int g4 = 0; g4 < 4; ++g4) { const float4 x_ = *(const float4*)(bl_ + 8 * g4 + 4 * hi), y_ = *(const float4*)(bl_ + 32 + 8 * g4 + 4 * hi); \
            P0[4 * g4] = x_.x; P0[4 * g4 + 1] = x_.y; P0[4 * g4 + 2] = x_.z; P0[4 * g4 + 3] = x_.w; P1[4 * g4] = y_.x; P1[4 * g4 + 1] = y_.y; P1[4 * g4 + 2] = y_.z; P1[4 * g4 + 3] = y_.w; } \
        qk_tile<true>(smem + (sj) * AT_STAGE, qf, P0, P1, lane); \
        if ((jj) >= jmask_w) mask_tile<1>(P0, P1, 64 * (jj), -1, qrow, hi); } while (0)
#define FOX_STEP(CUR0, CUR1, NXT0, NXT1, j) do { \
        const int s_cur = (j) % 3, s_nxt = ((j) + 1) % 3, s_ld = ((j) + 2) % 3; const bool more_ = (j) + 2 < ntiles; \
        if (more_) { KV_GLOAD(K + (size_t)((j) + 2) * 4096, V + (size_t)((j) + 2) * 4096); if (tid < 64) breg = (cref - CUM[((j) + 2) * 64 + tid]) * LOG2E; } \
        { const int c_ = (sidx0 + (j)) * CV_PER_STEP + tid; cvs = nullptr; \
          if (tid < CV_PER_STEP && c_ < CV_NUP + CV_NDN) { if (c_ < CV_NUP) { cvs = a.in[I_WUP] + (size_t)c_ * 8; cvd = (bf16_t*)(a.ws + WS_WUP) + (size_t)c_ * 8; } else { cvs = a.in[I_WDN] + (size_t)(c_ - CV_NUP) * 8; cvd = (bf16_t*)(a.ws + WS_WDN) + (size_t)(c_ - CV_NUP) * 8; } \
              cva = *(const float4*)cvs; cvb = *(const float4*)(cvs + 4); } } \
        if ((j) + 1 < ntiles && (j) + 1 <= jmax_w) FOX_QK(NXT0, NXT1, (j) + 1, s_nxt); \
        __builtin_amdgcn_sched_barrier(0); \
        if ((j) <= jmax_w) { softmax_step(CUR0, CUR1, m, l, o); pv_tile<false>(smem + s_cur * AT_STAGE + 8192, CUR0, CUR1, o, lane); } \
        if (more_) { KV_LSTORE(smem + s_ld * AT_STAGE); if (tid < 64) biasL[s_ld * 64 + tid] = breg; } \
        if (cvs) { uint4 o_; o_.x = cvtpk(cva.x, cva.y); o_.y = cvtpk(cva.z, cva.w); o_.z = cvtpk(cvb.x, cvb.y); o_.w = cvtpk(cvb.z, cvb.w); *(uint4*)cvd = o_; } \
        __syncthreads(); } while (0)
    f32x16 pA0, pA1, pB0, pB1;
    FOX_QK(pA0, pA1, 0, 0);
    for (int j = 0; j < ntiles; j += 2) {
        FOX_STEP(pA0, pA1, pB0, pB1, j);
        FOX_STEP(pB0, pB1, pA0, pA1, j + 1);
    }
#undef FOX_QK
#undef FOX_STEP
    const float inv = 1.0f / l; float ss = 0.f;
    const size_t token = (size_t)b * 8192 + qrow;
    bf16_t* O = (bf16_t*)(a.ws + WS_OFOX) + token * 512 + h * 64;
#pragma unroll
    for (int dh = 0; dh < 2; ++dh)
#pragma unroll
        for (int g4 = 0; g4 < 4; ++g4) { const float v0 = o[dh][4 * g4] * inv, v1 = o[dh][4 * g4 + 1] * inv, v2 = o[dh][4 * g4 + 2] * inv, v3 = o[dh][4 * g4 + 3] * inv;
            ss += v0 * v0 + v1 * v1 + v2 * v2 + v3 * v3; uint2 w; w.x = cvtpk(v0, v1); w.y = cvtpk(v2, v3); *(uint2*)(O + 32 * dh + 8 * g4 + 4 * hi) = w; }
    ss = pair_sum(ss);
    if (hi == 0) ((float*)(a.ws + WS_SSQ))[token * 16 + 8 + h] = ss;
}

DEV void nsa_item(const Args& a, unsigned char* smem, int b, int g, int tt) {
    const int tid = TID(), lane = tid & 63, wid = tid >> 6, col = lane & 31, hi = lane >> 5;
    const int t0 = tt * 64, tokw = col >> 2, r = col & 3, h = 4 * g + r; const int tokl = wid * 8 + tokw; const int t = t0 + tokl; const size_t token = (size_t)b * 8192 + t;
    const float slope2 = exp2f(-(float)(h + 1)) * LOG2E;
    const bf16_t* PROJ = (const bf16_t*)(a.ws + WS_PROJ);
    const float* GN = (const float*)(a.ws + WS_GN) + token * 24 + h * 3;
    const int cur = tt; const bool need_topk = cur > 15;
    bf16x8 qf[4];
    { const bf16_t* Q = PROJ + (((size_t)(h * 2 + b)) * 8192 + t) * 64;
#pragma unroll
      for (int ks = 0; ks < 4; ++ks) qf[ks] = *(const bf16x8*)(Q + 16 * ks + 8 * hi); }
    float* impw = (float*)(smem + AT_IMP_OFF) + wid * 2048; float* totw = impw + lane;
    unsigned* selmask = (unsigned*)(smem + AT_SEL_OFF); unsigned* wun = (unsigned*)(smem + AT_WUN_OFF); int* ucnt = (int*)(smem + AT_UCNT_OFF); unsigned char* ulist = smem + AT_ULIST_OFF;
    f32x16 o[2]; float m, l;
    const int tmin_w = t0 + wid * 8, tmax_w = tmin_w + 7;
    {
        const bf16_t* KC = (const bf16_t*)(a.ws + WS_KC) + ((size_t)(0 * 4 + b * 2 + g)) * 512 * 64; const bf16_t* VC = (const bf16_t*)(a.ws + WS_KC) + ((size_t)(1 * 4 + b * 2 + g)) * 512 * 64;
        const int ncv = t0 / 16 + 3; const int nct = (ncv + 63) >> 6;
        auto src = [&](int j, const bf16_t*& kp, const bf16_t*& vp) { kp = KC + (size_t)j * 4096; vp = VC + (size_t)j * 4096; };
        m = -1e30f; l = 0.f;
        kv_pipeline(smem, nct, src, [&](int j, const unsigned char* st) {
            const int kpos0 = 1024 * j + 31;
            if (kpos0 > tmax_w) return;
            f32x16 p0, p1; alibi_init<16>(p0, p1, slope2, kpos0, t0, hi);
            qk_tile<false>(st, qf, p0, p1, lane);
            mask_tile<16>(p0, p1, kpos0, -1, t, hi);
            const float mt = rowmax32(p0, p1); const float mn = fmaxf(m, mt); float rs = 0.f;
#pragma unroll
            for (int rr = 0; rr < 16; ++rr) rs += __builtin_amdgcn_exp2f(p0[rr] - mn) + __builtin_amdgcn_exp2f(p1[rr] - mn);
            rs = pair_sum(rs);
            l = l * __builtin_amdgcn_exp2f(m - mn) + rs; m = mn;
        });
        const float linv = l > 0.f ? 1.0f / l : 0.f;
        if (need_topk) { for (int i = lane; i < 8 * 129; i += 64) impw[i] = 0.f; }
        o[0] = (f32x16){}; o[1] = (f32x16){};
        kv_pipeline(smem, nct, src, [&](int j, const unsigned char* st) {
            const int kpos0 = 1024 * j + 31;
            if (kpos0 > tmax_w) return;
            f32x16 p0, p1; alibi_init<16>(p0, p1, slope2, kpos0, t0, hi);
            qk_tile<false>(st, qf, p0, p1, lane);
            mask_tile<16>(p0, p1, kpos0, -1, t, hi);
#pragma unroll
            for (int rr = 0; rr < 16; ++rr) { p0[rr] = __builtin_amdgcn_exp2f(p0[rr] - m) * linv; p1[rr] = __builtin_amdgcn_exp2f(p1[rr] - m) * linv; }
            if (need_topk) {
#pragma unroll
                for (int half = 0; half < 2; ++half)
#pragma unroll
                    for (int g4 = 0; g4 < 4; ++g4) { const f32x16& p = half ? p1 : p0;
                        float ms = (p[4 * g4] + p[4 * g4 + 1]) + (p[4 * g4 + 2] + p[4 * g4 + 3]); float ls = p[4 * g4 + 3];
                        ms = quad_sum(ms); ls = quad_sum(ls);
                        const int n = 16 * j + 8 * half + 2 * g4 + hi;
                        if (r == 0) { atomicAdd(&impw[tokw * 129 + n], ms); atomicAdd(&impw[tokw * 129 + n + 1], ls); } }
            }
            pv_tile<false>(st + 8192, p0, p1, o, lane);
        });
    }
    {
        unsigned un0 = 0u, un1 = 0u, un2 = 0u, un3 = 0u;
        if (need_topk) {
            for (int tk = 0; tk < 8; ++tk) {
                float v0 = impw[tk * 129 + lane], v1 = impw[tk * 129 + 64 + lane];
                v0 = (lane >= 1 && lane <= cur - 2) ? v0 : -1.0f; v1 = (lane + 64 <= cur - 2) ? v1 : -1.0f;
                unsigned m0 = 1u, m1 = 0u, m2 = 0u, m3 = 0u;
#define SETBIT(n_) do { const int n__ = (n_); const unsigned bit__ = 1u << (n__ & 31); const int w__ = n__ >> 5; if (w__ == 0) m0 |= bit__; else if (w__ == 1) m1 |= bit__; else if (w__ == 2) m2 |= bit__; else m3 |= bit__; } while (0)
                SETBIT(cur); SETBIT(cur - 1);
                for (int it = 0; it < 13; ++it) {
                    const float mx = wave_max_u(fmaxf(v0, v1));
                    const unsigned long long b0 = __ballot(v0 == mx);
                    int n;
                    if (b0) n = __ffsll((long long)b0) - 1; else { const unsigned long long b1 = __ballot(v1 == mx); n = 64 + __ffsll((long long)b1) - 1; }
                    if (lane == (n & 63)) { if (n < 64) v0 = -1.0f; else v1 = -1.0f; }
                    SETBIT(n);
                }
#undef SETBIT
                if (lane == 0) { unsigned* sm_ = selmask + (wid * 8 + tk) * 4; sm_[0] = m0; sm_[1] = m1; sm_[2] = m2; sm_[3] = m3; }
                un0 |= m0; un1 |= m1; un2 |= m2; un3 |= m3;
            }
        } else {
            const unsigned full = (2u << cur) - 1u;
            un0 = full;
            if (lane < 8) { unsigned* sm_ = selmask + (wid * 8 + lane) * 4; sm_[0] = full; sm_[1] = 0u; sm_[2] = 0u; sm_[3] = 0u; }
        }
        if (lane == 0) { wun[wid * 4] = un0; wun[wid * 4 + 1] = un1; wun[wid * 4 + 2] = un2; wun[wid * 4 + 3] = un3; }
        __syncthreads();
        if (tid == 0) { int c = 0;
            for (int w = 0; w < 4; ++w) { unsigned u = 0u; for (int ww = 0; ww < NWAVE; ++ww) u |= wun[ww * 4 + w]; for (int bb = 0; bb < 32; ++bb) if ((u >> bb) & 1u) ulist[c++] = (unsigned char)(w * 32 + bb); }
            ucnt[0] = c; }
        __syncthreads();
    }
    { const float g0 = GN[0];
#pragma unroll
      for (int rr = 0; rr < 16; ++rr) { totw[rr * 64] = o[0][rr] * g0; totw[(16 + rr) * 64] = o[1][rr] * g0; } }
    {
        const bf16_t* KS = PROJ + ((size_t)((12 + g) * 2 + b)) * 8192 * 64; const bf16_t* VS = PROJ + ((size_t)((14 + g) * 2 + b)) * 8192 * 64;
        const int nu = ucnt[0];
        m = -1e30f; l = 0.f; o[0] = (f32x16){}; o[1] = (f32x16){};
        kv_pipeline(smem, nu, [&](int j, const bf16_t*& kp, const bf16_t*& vp) { const int n = ulist[j]; kp = KS + (size_t)n * 4096; vp = VS + (size_t)n * 4096; },
            [&](int j, const unsigned char* st) {
                const int n = ulist[j];
                if (!((wun[wid * 4 + (n >> 5)] >> (n & 31)) & 1u)) return;
                const bool sel = (selmask[tokl * 4 + (n >> 5)] >> (n & 31)) & 1u;
                f32x16 p0, p1; alibi_init<1>(p0, p1, slope2, 64 * n, t0, hi);
                qk_tile<false>(st, qf, p0, p1, lane);
                if (n == cur || !__all(sel)) mask_tile<1>(p0, p1, 64 * n, -1, sel ? t : -1, hi);
                softmax_step(p0, p1, m, l, o);
                pv_tile<false>(st + 8192, p0, p1, o, lane);
            });
        const float g1 = GN[1] / fmaxf(l, 1e-30f);
#pragma unroll
        for (int rr = 0; rr < 16; ++rr) { totw[rr * 64] += o[0][rr] * g1; totw[(16 + rr) * 64] += o[1][rr] * g1; }
    }
    {
        const bf16_t* KW = PROJ + ((size_t)((16 + g) * 2 + b)) * 8192 * 64; const bf16_t* VW = PROJ + ((size_t)((18 + g) * 2 + b)) * 8192 * 64;
        const int jlo = (t0 - 511) > 0 ? ((t0 - 511) >> 6) : 0; const int jhi = cur;
        m = -1e30f; l = 0.f; o[0] = (f32x16){}; o[1] = (f32x16){};
        kv_pipeline(smem, jhi - jlo + 1, [&](int j, const bf16_t*& kp, const bf16_t*& vp) { kp = KW + (size_t)(jlo + j) * 4096; vp = VW + (size_t)(jlo + j) * 4096; },
            [&](int j, const unsigned char* st) {
                const int kpos0 = 64 * (jlo + j);
                if (kpos0 > tmax_w || kpos0 + 63 < tmin_w - 511) return;
                f32x16 p0, p1; alibi_init<1>(p0, p1, slope2, kpos0, t0, hi);
                qk_tile<false>(st, qf, p0, p1, lane);
                if (kpos0 < tmax_w - 511 || kpos0 + 63 > tmin_w) mask_tile<1>(p0, p1, kpos0, t - 511, t, hi);
                softmax_step(p0, p1, m, l, o);
                pv_tile<false>(st + 8192, p0, p1, o, lane);
            });
        const float g2 = GN[2] / fmaxf(l, 1e-30f);
#pragma unroll
        for (int rr = 0; rr < 16; ++rr) { o[0][rr] = totw[rr * 64] + o[0][rr] * g2; o[1][rr] = totw[(16 + rr) * 64] + o[1][rr] * g2; }
    }
    {
        float ss = 0.f; bf16_t* O = (bf16_t*)(a.ws + WS_ONSA) + token * 512 + h * 64;
#pragma unroll
        for (int dh = 0; dh < 2; ++dh)
#pragma unroll
            for (int g4 = 0; g4 < 4; ++g4) { const float v0 = o[dh][4 * g4], v1 = o[dh][4 * g4 + 1], v2 = o[dh][4 * g4 + 2], v3 = o[dh][4 * g4 + 3];
                ss += v0 * v0 + v1 * v1 + v2 * v2 + v3 * v3; uint2 w; w.x = cvtpk(v0, v1); w.y = cvtpk(v2, v3); *(uint2*)(O + 32 * dh + 8 * g4 + 4 * hi) = w; }
        ss = pair_sum(ss);
        if (hi == 0) ((float*)(a.ws + WS_SSQ))[token * 16 + h] = ss;
    }
}
#ifndef PROBE_DUP
#define PROBE_DUP 0
#endif
DEV void phase_att(const Args& a, unsigned char* smem) {
    int* qctr = (int*)(a.ws + WS_CTL) + 64; int* sitem = (int*)(smem + AT_ITEM_OFF);
    for (;;) {
        if (TID() == 0) sitem[0] = atomicAdd(qctr, 1);
        __syncthreads();
        int item = sitem[0];
        __syncthreads();
        if ((PROBE_DUP >> PH_ATT) & 1) { if (item >= 2048 + (int)gridDim.x) break; if (item >= 1024 && item < 1024 + (int)gridDim.x) break; if (item >= 1024) item -= 1024 + (int)gridDim.x; }
        else if (item >= 1024) break;
        if (item < 512) { const int qb = 31 - (item >> 4), bh = item & 15; fox_item(a, smem, item, bh >> 3, bh & 7, qb); }
        else { const int idx = item - 512; const int tt = 127 - (idx >> 2), bg = idx & 3; nsa_item(a, smem, bg >> 1, bg & 1, tt); }
    }
}

DEV void phase_outproj(const Args& a, unsigned char* smem) {
    const bf16_t* ONSA = (const bf16_t*)(a.ws + WS_ONSA); const bf16_t* OFOX = (const bf16_t*)(a.ws + WS_OFOX); const float* SSQ = (const float*)(a.ws + WS_SSQ);
    const bf16_t* W = (const bf16_t*)(a.ws + WS_WOUT); float* H1 = (float*)(a.ws + WS_H1); const float* X = a.in[I_X];
    float* rs = (float*)(smem + MISC_OFF);
    const int tid = TID(); int lane = tid & 63, wid = tid >> 6, wr = wid >> 2, wc = wid & 3; (void)wr; (void)wc; (void)lane;
    for (int item = VBID(); item < 64 * 4; item += gridDim.x) {
        int mt, nt; patch_decode(item, 64, 4, mt, nt);
        if (tid < 256) { const float* s = SSQ + (size_t)(mt * 256 + tid) * 16; float sn = 0.f, sf = 0.f;
#pragma unroll
            for (int j = 0; j < 8; ++j) { sn += s[j]; sf += s[8 + j]; }
            rs[tid * 2] = rsqrtf(sn * (1.f / 512.f) + EPS); rs[tid * 2 + 1] = rsqrtf(sf * (1.f / 512.f) + EPS); }
        __syncthreads();
        f32x4 acc[8][4];
        gemm256<true>(smem, 8, ONSA + (size_t)mt * 256 * 512, 128u, [&](int r, int kc) { return (unsigned)(r * 1024 + kc * 16); },
                      W + nt * 256, 64u * 2048u, [&](int k, int nc) { return (unsigned)(k * 2048 + nc * 16); }, acc);
        EPI_IDS();
#pragma unroll
        for (int mi = 0; mi < 8; ++mi) { const int rl = wr * 128 + mi * 16 + (lane & 15); const float rat = rs[rl * 2] / rs[rl * 2 + 1];
#pragma unroll
            for (int ni = 0; ni < 4; ++ni) acc[mi][ni] *= rat; }
        gemm256<false>(smem, 8, OFOX + (size_t)mt * 256 * 512, 128u, [&](int r, int kc) { return (unsigned)(r * 1024 + kc * 16); },
                       W + (size_t)512 * 1024 + nt * 256, 64u * 2048u, [&](int k, int nc) { return (unsigned)(k * 2048 + nc * 16); }, acc);
        EPI_IDS();
#pragma unroll
        for (int mi = 0; mi < 8; ++mi) { const int rl = wr * 128 + mi * 16 + (lane & 15); const size_t gm = (size_t)mt * 256 + rl; const float rf = rs[rl * 2 + 1];
#pragma unroll
            for (int ni = 0; ni < 4; ++ni) { const int n = nt * 256 + wc * 64 + ni * 16 + 4 * (lane >> 4); const float4 x = *(const float4*)(X + gm * 1024 + n); const f32x4 v = acc[mi][ni] * rf;
                float4 o = {x.x + v[0], x.y + v[1], x.z + v[2], x.w + v[3]}; *(float4*)(H1 + gm * 1024 + n) = o; }
            asm volatile("" ::: "memory"); }
        __syncthreads();
    }
}

DEV void phase_route(const Args& a, unsigned char* smem) {
    const float* H1 = (const float*)(a.ws + WS_H1); bf16_t* XN = (bf16_t*)(a.ws + WS_XN); float* RSTD2 = (float*)(a.ws + WS_RSTD2);
    const float* ln2 = a.in[I_LN2]; const float* wr_ = a.in[I_WR]; const float* br = a.in[I_BR];
    int* CNT = (int*)(a.ws + WS_CTL);
    int* TOPI = (int*)(a.ws + WS_TOPI); int* TOPS = (int*)(a.ws + WS_TOPS); float* TOPW = (float*)(a.ws + WS_TOPW);
    int* TOKOF = (int*)(a.ws + WS_TOKOF); float* ROWW = (float*)(a.ws + WS_ROWW);
    float* part = (float*)smem;
    float* ssqp = part + 8 * 32 * 33;
    int* lcnt = (int*)(ssqp + 256); int* lbase = lcnt + 32; int* te = lbase + 32; int* trk = te + 256; float* tw = (float*)(trk + 256);
    const int tid = TID(), lane = tid & 63, wid = tid >> 6, i32 = lane & 31, kh = lane >> 5; const int tg = wid >> 2, kq = wid & 3;
    for (int item = BID(); item < 256; item += gridDim.x) {
        const int tok = item * 64 + tg * 32 + i32;
        if (tid < 32) lcnt[tid] = 0;
        f32x16 acc = (f32x16){}; float ss = 0.f;
        const float* hrow = H1 + (size_t)tok * 1024 + 256 * kq + 4 * kh; const float* lrow = ln2 + 256 * kq + 4 * kh; bf16_t* xrow = XN + (size_t)tok * 1024 + 256 * kq + 4 * kh;
        const float* wbase = wr_ + (size_t)(256 * kq + 4 * kh) * 32 + i32;
#pragma unroll 4
        for (int c = 0; c < 32; ++c) {
            const float4 hv = *(const float4*)(hrow + 8 * c); const float4 lv = *(const float4*)(lrow + 8 * c);
            ss += hv.x * hv.x + hv.y * hv.y + hv.z * hv.z + hv.w * hv.w;
            const float x0 = hv.x * lv.x, x1 = hv.y * lv.y, x2 = hv.z * lv.z, x3 = hv.w * lv.w;
            uint2 o; o.x = cvtpk(x0, x1); o.y = cvtpk(x2, x3); *(uint2*)(xrow + 8 * c) = o;
            const float* wp = wbase + (size_t)(8 * c) * 32;
            const float w0 = wp[0], w1 = wp[32], w2 = wp[64], w3 = wp[96];
            acc = __builtin_amdgcn_mfma_f32_32x32x2f32(x0, w0, acc, 0, 0, 0);
            acc = __builtin_amdgcn_mfma_f32_32x32x2f32(x1, w1, acc, 0, 0, 0);
            acc = __builtin_amdgcn_mfma_f32_32x32x2f32(x2, w2, acc, 0, 0, 0);
            acc = __builtin_amdgcn_mfma_f32_32x32x2f32(x3, w3, acc, 0, 0, 0);
        }
        ss = pair_sum(ss);
        if (kh == 0) ssqp[wid * 32 + i32] = ss;
#pragma unroll
        for (int r = 0; r < 16; ++r) part[(wid * 32 + crow(r, kh)) * 33 + i32] = acc[r];
        __syncthreads();
        if (tid < 64) {
            const int g_ = tid >> 5, i_ = tid & 31; const int w0_ = g_ * 4;
            const float sq = ssqp[(w0_ + 0) * 32 + i_] + ssqp[(w0_ + 1) * 32 + i_] + ssqp[(w0_ + 2) * 32 + i_] + ssqp[(w0_ + 3) * 32 + i_]; const float rstd = rsqrtf(sq * (1.f / 1024.f) + EPS);
            RSTD2[item * 64 + tid] = rstd;
            float lg[32];
#pragma unroll
            for (int e = 0; e < 32; ++e) lg[e] = (part[((w0_ + 0) * 32 + i_) * 33 + e] + part[((w0_ + 1) * 32 + i_) * 33 + e] + part[((w0_ + 2) * 32 + i_) * 33 + e] + part[((w0_ + 3) * 32 + i_) * 33 + e]) * rstd + br[e];
            unsigned taken = 0u; float tv[4]; int ti[4];
#pragma unroll
            for (int k = 0; k < 4; ++k) { float best = -3.0e38f; int bi = 0;
#pragma unroll
                for (int e = 0; e < 32; ++e) { const bool ok = !((taken >> e) & 1u) && lg[e] > best; best = ok ? lg[e] : best; bi = ok ? e : bi; }
                taken |= 1u << bi; tv[k] = best; ti[k] = bi; }
            const float e1 = __expf(tv[1] - tv[0]), e2 = __expf(tv[2] - tv[0]), e3 = __expf(tv[3] - tv[0]); const float inv = 1.0f / (1.0f + e1 + e2 + e3);
            const float wv[4] = {inv, e1 * inv, e2 * inv, e3 * inv};
#pragma unroll
            for (int k = 0; k < 4; ++k) { const int idx = tid * 4 + k; te[idx] = ti[k]; trk[idx] = atomicAdd(&lcnt[ti[k]], 1); tw[idx] = wv[k]; }
        }
        __syncthreads();
        if (tid < 32) lbase[tid] = atomicAdd(&CNT[tid], lcnt[tid]);
        __syncthreads();
        if (tid < 256) { const int idx = tid; const int tk = item * 64 + (idx >> 2); const int e = te[idx]; const int slot = lbase[e] + trk[idx];
          TOPI[(size_t)tk * 4 + (idx & 3)] = e; TOPS[(size_t)tk * 4 + (idx & 3)] = slot; TOPW[(size_t)tk * 4 + (idx & 3)] = tw[idx];
          TOKOF[(size_t)e * 16384 + slot] = tk; ROWW[(size_t)e * 16384 + slot] = tw[idx]; }
        __syncthreads();
    }
}

struct MoeMap { int e, mt, nt, cnt, off; };
DEV void moe_setup(const Args& a, int* sm) {
    if (TID() == 0) { const int* CNT = (const int*)(a.ws + WS_CTL); int tot = 0; for (int e = 0; e < 32; ++e) { const int c = CNT[e]; const int mt = (c + 255) >> 8; sm[e] = mt; sm[32 + e] = tot; tot += mt; } sm[64] = tot; }
    __syncthreads();
}
DEV MoeMap moe_map(const Args& a, const int* sm, int item, int NT) {
    MoeMap mm; int e = 0;
#pragma unroll 1
    for (int i = 1; i < 32; ++i) if (item >= sm[32 + i] * NT) e = i;
    const int local = item - sm[32 + e] * NT; const int mte = sm[e];
    int mt_, nt_; patch_decode(local, mte, NT, mt_, nt_);
    mm.e = __builtin_amdgcn_readfirstlane(e); mm.mt = __builtin_amdgcn_readfirstlane(mt_); mm.nt = __builtin_amdgcn_readfirstlane(nt_);
    mm.cnt = __builtin_amdgcn_readfirstlane(((const int*)(a.ws + WS_CTL))[e]); mm.off = __builtin_amdgcn_readfirstlane(sm[32 + e] * 256); return mm;
}
DEV void phase_up(const Args& a, unsigned char* smem) {
    int* sm = (int*)(smem + MISC_OFF); int* tok = sm + 128; float* rsd = (float*)(tok + 256);
    const bf16_t* XN = (const bf16_t*)(a.ws + WS_XN); const bf16_t* W = (const bf16_t*)(a.ws + WS_WUP); bf16_t* ACT = (bf16_t*)(a.ws + WS_ACT); const float* RSTD2 = (const float*)(a.ws + WS_RSTD2);
    const int* TOKOF = (const int*)(a.ws + WS_TOKOF); const float* bup = a.in[I_BUP];
    const int tid = TID(); int lane = tid & 63, wid = tid >> 6, wr = wid >> 2, wc = wid & 3; (void)wr; (void)wc; (void)lane;
    moe_setup(a, sm);
    const int nitems = __builtin_amdgcn_readfirstlane(sm[64]) * 8;
    for (int item = VBID(); item < nitems; item += gridDim.x) {
        const MoeMap mm = moe_map(a, sm, item, 8);
        if (tid < 256) { const int slot = mm.mt * 256 + tid; const int tk_ = slot < mm.cnt ? TOKOF[(size_t)mm.e * 16384 + slot] : 0; tok[tid] = tk_; rsd[tid] = RSTD2[tk_]; }
        __syncthreads();
        const bf16_t* We = W + (size_t)mm.e * 1024 * 2048;
        f32x4 acc[8][4];
        gemm256<true>(smem, 16, XN, 128u, [&](int r, int kc) { return (unsigned)(tok[r] * 2048 + kc * 16); },
                      We + mm.nt * 128, 64u * 4096u, [&](int k, int nc) { const int ni = (nc >> 1) & 3; const int sc = ((ni >> 1) ? 1024 : 0) + (nc >> 3) * 32 + (ni & 1) * 16 + (nc & 1) * 8;
                          return (unsigned)(k * 4096 + sc * 2); }, acc);
        EPI_IDS();
#pragma unroll
        for (int mi = 0; mi < 8; ++mi) { const int rl_ = wr * 128 + mi * 16 + (lane & 15); const size_t row = (size_t)mm.off + mm.mt * 256 + rl_; const float rs_ = rsd[rl_];
#pragma unroll
            for (int ni = 0; ni < 2; ++ni) { const int jc = mm.nt * 128 + wc * 32 + ni * 16 + 4 * (lane >> 4);
                const float4 bg = *(const float4*)(bup + (size_t)mm.e * 2048 + jc), bl_ = *(const float4*)(bup + (size_t)mm.e * 2048 + 1024 + jc);
                const f32x4 gv = acc[mi][ni], lv = acc[mi][ni + 2]; const float bgv[4] = {bg.x, bg.y, bg.z, bg.w}, blv[4] = {bl_.x, bl_.y, bl_.z, bl_.w}; float r4[4];
#pragma unroll
                for (int r = 0; r < 4; ++r) { const float gg = fminf(gv[r] * rs_ + bgv[r], 7.0f); const float ll = fminf(fmaxf(lv[r] * rs_ + blv[r], -7.0f), 7.0f); r4[r] = gg * sigmoidf_(1.702f * gg) * (ll + 1.0f); }
                uint2 o; o.x = cvtpk(r4[0], r4[1]); o.y = cvtpk(r4[2], r4[3]); *(uint2*)(ACT + row * 1024 + jc) = o; } }
        __syncthreads();
    }
}
DEV void phase_down(const Args& a, unsigned char* smem) {
    int* sm = (int*)(smem + MISC_OFF); float* rw = (float*)(sm + 128);
    const bf16_t* ACT = (const bf16_t*)(a.ws + WS_ACT); const bf16_t* W = (const bf16_t*)(a.ws + WS_WDN); bf16_t* Y = (bf16_t*)(a.ws + WS_Y);
    const float* ROWW = (const float*)(a.ws + WS_ROWW); const float* bdn = a.in[I_BDN];
    const int tid = TID(); int lane = tid & 63, wid = tid >> 6, wr = wid >> 2, wc = wid & 3; (void)wr; (void)wc; (void)lane;
    moe_setup(a, sm);
    const int nitems = __builtin_amdgcn_readfirstlane(sm[64]) * 4;
    for (int item = VBID(); item < nitems; item += gridDim.x) {
        const MoeMap mm = moe_map(a, sm, item, 4);
        if (tid < 256) { const int slot = mm.mt * 256 + tid; rw[tid] = slot < mm.cnt ? ROWW[(size_t)mm.e * 16384 + slot] : 0.f; }
        __syncthreads();
        const bf16_t* We = W + (size_t)mm.e * 1024 * 1024; const bf16_t* Ab = ACT + ((size_t)mm.off + mm.mt * 256) * 1024;
        f32x4 acc[8][4];
        gemm256<true>(smem, 16, Ab, 128u, [&](int r, int kc) { return (unsigned)(r * 2048 + kc * 16); },
                      We + mm.nt * 256, 64u * 2048u, [&](int k, int nc) { return (unsigned)(k * 2048 + nc * 16); }, acc);
        EPI_IDS();
#pragma unroll
        for (int mi = 0; mi < 8; ++mi) { const int rl = wr * 128 + mi * 16 + (lane & 15); const size_t row = (size_t)mm.off + mm.mt * 256 + rl; const float w = rw[rl];
#pragma unroll
            for (int ni = 0; ni < 4; ++ni) { const int n = mm.nt * 256 + wc * 64 + ni * 16 + 4 * (lane >> 4); const float4 bb = *(const float4*)(bdn + (size_t)mm.e * 1024 + n); const f32x4 v = acc[mi][ni];
                uint2 o; o.x = cvtpk((v[0] + bb.x) * w, (v[1] + bb.y) * w); o.y = cvtpk((v[2] + bb.z) * w, (v[3] + bb.w) * w); *(uint2*)(Y + row * 1024 + n) = o; } }
        __syncthreads();
    }
}

DEV void phase_comb(const Args& a, unsigned char* smem) {
    int* sm = (int*)(smem + MISC_OFF);
    moe_setup(a, sm);
    float* H1 = (float*)(a.ws + WS_H1); bf16_t* XN = (bf16_t*)(a.ws + WS_XN); const bf16_t* Y = (const bf16_t*)(a.ws + WS_Y);
    const int* TOPI = (const int*)(a.ws + WS_TOPI); const int* TOPS = (const int*)(a.ws + WS_TOPS); const float* g = a.in[I_LNPLE];
    const int lane = TID() & 63; const int gw = BID() * NWAVE + (TID() >> 6), ngw = gridDim.x * NWAVE;
    for (int tok = gw; tok < NTOK; tok += ngw) {
        float4 v[4];
#pragma unroll
        for (int j = 0; j < 4; ++j) v[j] = *(const float4*)(H1 + (size_t)tok * 1024 + j * 256 + lane * 4);
#pragma unroll
        for (int k = 0; k < 4; ++k) { const int e = TOPI[(size_t)tok * 4 + k]; const size_t row = (size_t)sm[32 + e] * 256 + TOPS[(size_t)tok * 4 + k];
#pragma unroll
            for (int j = 0; j < 4; ++j) { const uint2 u = *(const uint2*)(Y + row * 1024 + j * 256 + lane * 4); v[j].x += bflo(u.x); v[j].y += bfhi(u.x); v[j].z += bflo(u.y); v[j].w += bfhi(u.y); } }
        float s = 0.f;
#pragma unroll
        for (int j = 0; j < 4; ++j) { *(float4*)(H1 + (size_t)tok * 1024 + j * 256 + lane * 4) = v[j]; s += v[j].x * v[j].x + v[j].y * v[j].y + v[j].z * v[j].z + v[j].w * v[j].w; }
        const float rstd = rsqrtf(wave_sum(s) * (1.f / 1024.f) + EPS);
#pragma unroll
        for (int j = 0; j < 4; ++j) { const float4 gg = *(const float4*)(g + j * 256 + lane * 4);
            uint2 o; o.x = cvtpk(v[j].x * rstd * gg.x, v[j].y * rstd * gg.y); o.y = cvtpk(v[j].z * rstd * gg.z, v[j].w * rstd * gg.w); *(uint2*)(XN + (size_t)tok * 1024 + j * 256 + lane * 4) = o; }
    }
}

DEV void phase_gate(const Args& a, unsigned char* smem) {
    const bf16_t* XN = (const bf16_t*)(a.ws + WS_XN); const bf16_t* WG = (const bf16_t*)(a.ws + WS_WGATE); const bf16_t* PB = (const bf16_t*)(a.ws + WS_PB); const bf16_t* WP = (const bf16_t*)(a.ws + WS_WPLE);
    const float* H2 = (const float*)(a.ws + WS_H1); float* OUT = a.out; float* SSQ3 = (float*)(a.ws + WS_SSQ3);
    const int tid = TID(); int lane = tid & 63, wid = tid >> 6, wr = wid >> 2, wc = wid & 3; (void)wr; (void)wc; (void)lane;
    for (int item = VBID(); item < 64 * 4; item += gridDim.x) {
        int mt, nt; patch_decode(item, 64, 4, mt, nt);
        f32x4 acc[8][4];
        gemm256<true>(smem, 16, XN + (size_t)mt * 256 * 1024, 128u, [&](int r, int kc) { return (unsigned)(r * 2048 + kc * 16); },
                      WG + nt * 256, 64u * 2048u, [&](int k, int nc) { return (unsigned)(k * 2048 + nc * 16); }, acc);
        EPI_IDS();
#pragma unroll
        for (int mi = 0; mi < 8; ++mi) { const size_t gm = (size_t)mt * 256 + wr * 128 + mi * 16 + (lane & 15);
#pragma unroll
            for (int ni = 0; ni < 4; ++ni) { const int n = nt * 256 + wc * 64 + ni * 16 + 4 * (lane >> 4); const f32x4 v = acc[mi][ni];
                float4 o = {sigmoidf_(v[0]), sigmoidf_(v[1]), sigmoidf_(v[2]), sigmoidf_(v[3])}; *(float4*)(OUT + gm * 1024 + n) = o; } }
        gemm256<true>(smem, 4, PB + (size_t)mt * 256 * 256, 128u, [&](int r, int kc) { return (unsigned)(r * 512 + kc * 16); },
                      WP + nt * 256, 64u * 2048u, [&](int k, int nc) { return (unsigned)(k * 2048 + nc * 16); }, acc);
        EPI_IDS();
#pragma unroll
        for (int mi = 0; mi < 8; ++mi) { const size_t gm = (size_t)mt * 256 + wr * 128 + mi * 16 + (lane & 15); float ss = 0.f;
#pragma unroll
            for (int ni = 0; ni < 4; ++ni) { const int n = nt * 256 + wc * 64 + ni * 16 + 4 * (lane >> 4); const f32x4 v = acc[mi][ni];
                const float4 gt = *(const float4*)(OUT + gm * 1024 + n); const float4 h = *(const float4*)(H2 + gm * 1024 + n);
                float4 o = {h.x + v[0] * gt.x, h.y + v[1] * gt.y, h.z + v[2] * gt.z, h.w + v[3] * gt.w}; *(float4*)(OUT + gm * 1024 + n) = o;
                ss += o.x * o.x + o.y * o.y + o.z * o.z + o.w * o.w; }
            ss += __shfl_xor(ss, 16); ss += __shfl_xor(ss, 32);
            if (lane < 16) SSQ3[gm * 16 + nt * 4 + wc] = ss;
            asm volatile("" ::: "memory"); }
        __syncthreads();
    }
}

DEV void phase_final(const Args& a) {
    float* OUT = a.out; const float* SSQ3 = (const float*)(a.ws + WS_SSQ3); const float* g = a.in[I_LNF];
    const int lane = TID() & 63; const int gw = BID() * NWAVE + (TID() >> 6), ngw = gridDim.x * NWAVE;
    for (int m = gw; m < NTOK; m += ngw) {
        float s = 0.f;
#pragma unroll
        for (int j = 0; j < 16; ++j) s += SSQ3[(size_t)m * 16 + j];
        const float rstd = rsqrtf(s * (1.f / 1024.f) + EPS);
#pragma unroll
        for (int j = 0; j < 4; ++j) { float4 v = *(const float4*)(OUT + (size_t)m * 1024 + j * 256 + lane * 4); const float4 gg = *(const float4*)(g + j * 256 + lane * 4);
            v.x *= rstd * gg.x; v.y *= rstd * gg.y; v.z *= rstd * gg.z; v.w *= rstd * gg.w; *(float4*)(OUT + (size_t)m * 1024 + j * 256 + lane * 4) = v; }
    }
}

template <int PH> DEV void run_phase(const Args& a, unsigned char* smem) {
    if constexpr (PH == PH_PRO) phase_prologue(a, smem);
    else if constexpr (PH == PH_INPROJ) phase_inproj(a, smem);
    else if constexpr (PH == PH_CMP) phase_cmp(a, smem);
    else if constexpr (PH == PH_ATT) phase_att(a, smem);
    else if constexpr (PH == PH_OUTPROJ) phase_outproj(a, smem);
    else if constexpr (PH == PH_ROUTE) phase_route(a, smem);
    else if constexpr (PH == PH_UP) phase_up(a, smem);
    else if constexpr (PH == PH_DOWN) phase_down(a, smem);
    else if constexpr (PH == PH_COMB) phase_comb(a, smem);
    else if constexpr (PH == PH_GATE) phase_gate(a, smem);
    else if constexpr (PH == PH_FINAL) phase_final(a);
}
#define XB_TMO      128
#define XB_XCNT(j)  (256  + 64 * (j))
#define XB_XSUB(j)  (1280 + 64 * (j))
#define XB_XGEN(j)  (2304 + 64 * (j))
#define XB_TOP      3328
#define XB_TOPGEN   3392
#define XCD_BAR_WORDS 3456
#define XB_SPIN_CAP (1u << 22)
DEV unsigned xb_ld(unsigned* p)              { return __hip_atomic_load(p, __ATOMIC_RELAXED, __HIP_MEMORY_SCOPE_AGENT); }
DEV unsigned xb_add(unsigned* p, unsigned v) { return __hip_atomic_fetch_add(p, v, __ATOMIC_RELAXED, __HIP_MEMORY_SCOPE_AGENT); }
DEV unsigned xb_xcc_id() { return (unsigned)__builtin_amdgcn_s_getreg((3 << 11) | 20) & 0xFu; }
#define XB_SPIN(cond, bar) do { unsigned _sp = 0; while (cond) { __builtin_amdgcn_s_sleep(1); \
    if ((++_sp & 255u) == 0u) { if (xb_ld(&(bar)[XB_TMO])) break; if (_sp > XB_SPIN_CAP) { atomicAdd(&(bar)[XB_TMO], 1u); break; } } } } while (0)
struct XcdBarrier { unsigned* bar; unsigned x; volatile LAS unsigned* st; };
DEV XcdBarrier xcd_barrier_post(unsigned* bar, volatile LAS unsigned* st) {
    XcdBarrier b; b.bar = bar; b.x = xb_xcc_id(); b.st = st;
    if (TID() == 0) (void)xb_add(&bar[XB_XCNT(b.x)], 1u);
    return b;
}
DEV void xcd_barrier_complete(unsigned* bar, unsigned x, unsigned& nloc, unsigned& nx) {
    const unsigned G = gridDim.x * gridDim.y * gridDim.z;
    unsigned sum, cnt, mine, sp = 0u;
    for (;;) {
        sum = 0u; cnt = 0u; mine = 0u;
#pragma unroll
        for (unsigned j = 0; j < 16; ++j) { const unsigned c = xb_ld(&bar[XB_XCNT(j)]); sum += c; cnt += (c > 0u) ? 1u : 0u; mine = (j == x) ? c : mine; }
        if (sum == G) break;
        __builtin_amdgcn_s_sleep(1);
        if ((++sp & 255u) == 0u) { if (xb_ld(&bar[XB_TMO])) break; if (sp > XB_SPIN_CAP) { atomicAdd(&bar[XB_TMO], 1u); break; } }
    }
    nloc = mine > 0u ? mine : 1u; nx = cnt > 0u ? cnt : 1u;
}
DEV void xcd_barrier(const XcdBarrier& b) {
    asm volatile("s_waitcnt vmcnt(0)" ::: "memory");
    __syncthreads();
    if (TID() == 0) {
        unsigned* bar = b.bar;
        __builtin_amdgcn_s_waitcnt(0);
        unsigned nloc = b.st[0], nx = b.st[1];
        if (nloc == 0u) { xcd_barrier_complete(bar, b.x, nloc, nx); b.st[0] = nloc; b.st[1] = nx; }
        const unsigned old = xb_add(&bar[XB_XSUB(b.x)], 1u);
        const unsigned gen = old / nloc;
        if (old + 1u == (gen + 1u) * nloc) {
            __builtin_amdgcn_fence(__ATOMIC_RELEASE, "agent");
            asm volatile("s_waitcnt vmcnt(0)" ::: "memory");
            const unsigned og = xb_add(&bar[XB_TOP], 1u);
            const unsigned tg = og / nx;
            if (og + 1u == (tg + 1u) * nx) xb_add(&bar[XB_TOPGEN], 1u);
            else XB_SPIN(xb_ld(&bar[XB_TOPGEN]) == tg, bar);
            __builtin_amdgcn_fence(__ATOMIC_ACQUIRE, "agent");
            xb_add(&bar[XB_XGEN(b.x)], 1u);
            asm volatile("s_waitcnt vmcnt(0)" ::: "memory");
        } else {
            XB_SPIN(xb_ld(&bar[XB_XGEN(b.x)]) == gen, bar);
            __builtin_amdgcn_fence(__ATOMIC_ACQUIRE, "agent");
            asm volatile("s_waitcnt vmcnt(0)" ::: "memory");
        }
    }
    __syncthreads();
}

__global__ void __launch_bounds__(NTHR, 2) mega(Args a) {
    extern __shared__ __attribute__((aligned(16))) unsigned char smem[];
    volatile LAS unsigned* bst = (volatile LAS unsigned*)(LAS unsigned char*)(smem + MISC_OFF + 4000);
    if (TID() == 0) { bst[0] = 0u; bst[1] = 0u; }
    __syncthreads();
    const XcdBarrier bar = xcd_barrier_post((unsigned*)(a.ws + WS_CTL) + 4096, bst);
#define GSYNC() xcd_barrier(bar)
#define RUN(ph) do { run_phase<ph>(a, smem); if ((PROBE_DUP >> ph) & 1) { GSYNC(); run_phase<ph>(a, smem); } } while (0)
    RUN(PH_PRO); GSYNC();
    RUN(PH_INPROJ); GSYNC();
    RUN(PH_CMP); GSYNC();
    RUN(PH_ATT); GSYNC();
    RUN(PH_OUTPROJ); GSYNC();
    RUN(PH_ROUTE); GSYNC();
    RUN(PH_UP); GSYNC();
    RUN(PH_DOWN); GSYNC();
    RUN(PH_COMB); GSYNC();
    RUN(PH_GATE); GSYNC();
    RUN(PH_FINAL);
#undef RUN
#undef GSYNC
}

extern "C" void kernel_launch(void* const* d_in, const int* in_sizes, int n_in, void* d_out, int out_size, void* d_ws, size_t ws_size, hipStream_t stream) {
    static int grid = 0;
    if (grid == 0) {
        if (n_in != 25 || ws_size < WS_END) { fprintf(stderr, "kernel_launch: unexpected n_in %d / ws %zu\n", n_in, ws_size); grid = -1; return; }
        int dev = 0, cus = 0, per_cu = 0;
        (void)hipGetDevice(&dev); (void)hipDeviceGetAttribute(&cus, hipDeviceAttributeMultiprocessorCount, dev);
        (void)hipFuncSetAttribute((const void*)mega, hipFuncAttributeMaxDynamicSharedMemorySize, LDS_BYTES);
        (void)hipOccupancyMaxActiveBlocksPerMultiprocessor(&per_cu, (const void*)mega, NTHR, LDS_BYTES);
        if (per_cu < 1) { fprintf(stderr, "kernel_launch: occupancy query says %d blocks per CU\n", per_cu); grid = -1; return; }
        grid = cus;
    }
    if (grid < 0) return;
    (void)hipMemsetAsync((char*)d_ws + WS_CTL, 0, 65536, stream);
    Args a{};
    for (int i = 0; i < 25; ++i) a.in[i] = (const float*)d_in[i];
    a.out = (float*)d_out; a.ws = (unsigned char*)d_ws; a.ph_lo = 0; a.ph_hi = PH_N;
    void* args[] = {&a};
    hipError_t e = hipLaunchCooperativeKernel((const void*)mega, dim3(grid), dim3(NTHR), args, LDS_BYTES, stream);
    if (e != hipSuccess) fprintf(stderr, "cooperative launch failed: %s (grid %d)\n", hipGetErrorString(e), grid);
}
```

```cpp
#include <hip/hip_runtime.h>
#include <stdint.h>
#include <cstdio>

#define DEV __device__ __forceinline__
#define LAS __attribute__((address_space(3)))

typedef unsigned short bf16_t;
typedef short bf16x8 __attribute__((ext_vector_type(8)));
typedef short s16x4 __attribute__((ext_vector_type(4)));
typedef float f32x4 __attribute__((ext_vector_type(4)));
typedef float f32x16 __attribute__((ext_vector_type(16)));
typedef float f32x2_t __attribute__((ext_vector_type(2)));
typedef __bf16 bf16x2_t __attribute__((ext_vector_type(2)));

constexpr int NTHR = 512, NWAVE = 8;
constexpr int NTOK = 16384;
constexpr float EPS = 1e-6f;
constexpr float LOG2E = 1.4426950408889634f;
constexpr float QS = 0.125f * LOG2E;
constexpr int NWIN = 3072;

constexpr size_t MiB = 1u << 20;
constexpr size_t WS_CTL = 0;
constexpr size_t WS_WIN = 1 * MiB;
constexpr size_t WS_WOUT = 7 * MiB;
constexpr size_t WS_WGATE = 9 * MiB;
constexpr size_t WS_WPLE = 11 * MiB;
constexpr size_t WS_WC1 = 12 * MiB;
constexpr size_t WS_WC2 = 15 * MiB + 512 * 1024 + 262144;
constexpr size_t WS_BIAS1 = 15 * MiB + 512 * 1024 + 262144 + 131072;
constexpr size_t WS_KC = 14 * MiB;
constexpr size_t WS_HID = 14 * MiB + 512 * 1024;
constexpr size_t WS_GN = 16 * MiB;
constexpr size_t WS_LS = 18 * MiB;
constexpr size_t WS_CUM = 19 * MiB;
constexpr size_t WS_SSQ = 20 * MiB;
constexpr size_t WS_TOPI = 21 * MiB;
constexpr size_t WS_TOPS = 21 * MiB + 262144;
constexpr size_t WS_TOPW = 21 * MiB + 524288;
constexpr size_t WS_TOKOF = 22 * MiB;
constexpr size_t WS_ROWW = 24 * MiB;
constexpr size_t WS_SSQ3 = 26 * MiB;
constexpr size_t WS_RSTD2 = 27 * MiB;
constexpr size_t WS_PB = 28 * MiB;
constexpr size_t WS_XN = 36 * MiB;
constexpr size_t WS_PROJ = 68 * MiB;
constexpr size_t WS_ONSA = 160 * MiB;
constexpr size_t WS_OFOX = 176 * MiB;
constexpr size_t WS_H1 = 192 * MiB;
constexpr size_t WS_WUP = 256 * MiB;
constexpr size_t WS_WDN = 384 * MiB;
constexpr size_t WS_ACT = 448 * MiB;
constexpr size_t WS_Y = 592 * MiB;
constexpr size_t WS_END = 736 * MiB;

enum { PH_PRO = 0, PH_INPROJ, PH_CMP, PH_ATT, PH_OUTPROJ, PH_ROUTE, PH_UP, PH_DOWN, PH_COMB, PH_GATE, PH_FINAL, PH_N };
struct Args { const float* in[25]; float* out; unsigned char* ws; int ph_lo, ph_hi; };
enum { I_X = 0, I_P, I_LN1, I_WIN, I_BFG, I_WC1K, I_WC2K, I_PEK, I_WC1V, I_WC2V, I_PEV, I_GNN, I_GNF, I_WOUT, I_LN2, I_WR, I_BR,
       I_WUP, I_BUP, I_WDN, I_BDN, I_LNPLE, I_WPLE, I_WGATE, I_LNF };

DEV int BID() { int b = (int)blockIdx.x; asm volatile("" : "+s"(b)); return b; }
DEV int VBID() { const int g = (int)gridDim.x, b = BID(); return (g & 7) ? b : (b & 7) * (g >> 3) + (b >> 3); }
DEV int TID() { int t = (int)__builtin_amdgcn_workitem_id_x(); asm volatile("" : "+v"(t)); return t; }
DEV unsigned cvtpk(float lo, float hi) { f32x2_t v = {lo, hi}; bf16x2_t b = __builtin_convertvector(v, bf16x2_t); return __builtin_bit_cast(unsigned, b); }
DEV float bflo(unsigned u) { return __uint_as_float(u << 16); }
DEV float bfhi(unsigned u) { return __uint_as_float(u & 0xffff0000u); }
DEV float wave_sum(float v) {
#pragma unroll
    for (int o = 1; o < 64; o <<= 1) v += __shfl_xor(v, o);
    return v;
}
#define DPP_MOV(x, ctrl) __builtin_bit_cast(float, __builtin_amdgcn_update_dpp(0, __builtin_bit_cast(int, (x)), (ctrl), 0xF, 0xF, true))
DEV float pair_sum(float x) { return x + __shfl_xor(x, 32); }
DEV float pair_max(float x) { return fmaxf(x, __shfl_xor(x, 32)); }
DEV float quad_sum(float x) { x += DPP_MOV(x, 0xB1); x += DPP_MOV(x, 0x4E); return x; }
DEV float wave_max_u(float x) {
    x = fmaxf(x, DPP_MOV(x, 0xB1)); x = fmaxf(x, DPP_MOV(x, 0x4E)); x = fmaxf(x, DPP_MOV(x, 0x141)); x = fmaxf(x, DPP_MOV(x, 0x140));
    const float a = __builtin_bit_cast(float, __builtin_amdgcn_readlane(__builtin_bit_cast(int, x), 0)), b = __builtin_bit_cast(float, __builtin_amdgcn_readlane(__builtin_bit_cast(int, x), 16));
    const float c = __builtin_bit_cast(float, __builtin_amdgcn_readlane(__builtin_bit_cast(int, x), 32)), d = __builtin_bit_cast(float, __builtin_amdgcn_readlane(__builtin_bit_cast(int, x), 48));
    return fmaxf(fmaxf(a, b), fmaxf(c, d));
}
DEV float sigmoidf_(float x) { return 1.0f / (1.0f + __expf(-x)); }
DEV float logsigmoidf_(float x) { return fminf(x, 0.f) - log1pf(__expf(-fabsf(x))); }
DEV float gelu_tanh(float x) { const float u = 0.7978845608028654f * (x + 0.044715f * x * x * x); const float th = 1.0f - 2.0f / (__expf(2.0f * u) + 1.0f); return 0.5f * x * (1.0f + th); }
DEV s16x4 tr_read(const unsigned char* p) {
    typedef short v4i16_t __attribute__((ext_vector_type(4)));
    return __builtin_bit_cast(s16x4, __builtin_amdgcn_ds_read_tr16_b64_v4i16((LAS v4i16_t*)p));
}
DEV int crow(int r, int hi) { return (r & 3) + 8 * (r >> 2) + 4 * hi; }

constexpr int GL_STAGE = 65536;
constexpr int GEMM_LDS = 2 * GL_STAGE;
constexpr int MISC_OFF = GEMM_LDS;
constexpr int LDS_BYTES = GEMM_LDS + 8192;

DEV void glds16s(const void* sbase, unsigned voff, unsigned lds_dst) { unsigned keep;
    asm volatile("s_mov_b32 %0, m0\n\ts_mov_b32 m0, %3\n\ts_nop 0\n\tglobal_load_lds_dwordx4 %1, %2\n\ts_mov_b32 m0, %0" : "=&s"(keep) : "v"(voff), "s"(sbase), "s"(lds_dst) : "memory"); }

DEV const unsigned char* uptr(const void* p) { const unsigned long long v = (unsigned long long)p; const unsigned lo = __builtin_amdgcn_readfirstlane((unsigned)v), hi = __builtin_amdgcn_readfirstlane((unsigned)(v >> 32)); return (const unsigned char*)(((unsigned long long)hi << 32) | lo); }

struct NoNext { DEV void operator()() const {} };
template <class AO, class BO>
DEV void gemm256_issue0(unsigned char* smem, const void* abase, const AO& aoff, const void* bbase, const BO& boff) {
    const int tid = TID(), lane = tid & 63; const int wid = __builtin_amdgcn_readfirstlane(tid >> 6);
    const unsigned lds0 = (unsigned)(uintptr_t)smem; const unsigned char* ab_ = uptr(abase); const unsigned char* bb_ = uptr(bbase);
#pragma unroll
    for (int i = 0; i < 4; ++i) { const int p = wid + 8 * i; glds16s(ab_, aoff(8 * p + (lane >> 3), (lane & 7) ^ (lane >> 3)), (unsigned)__builtin_amdgcn_readfirstlane(lds0 + p * 1024)); }
#pragma unroll
    for (int i = 0; i < 4; ++i) { const int p = wid + 8 * i; const int k = 2 * p + (lane >> 5); const int f = (k & 3) + 4 * ((k >> 3) & 1);
        glds16s(bb_, boff(k, (lane & 31) ^ (f << 1)), (unsigned)__builtin_amdgcn_readfirstlane(lds0 + 32768 + p * 1024)); }
}
template <bool ZERO, class AO, class BO, class NX = NoNext>
DEV void gemm256(unsigned char* smem, int nkt, const void* abase, unsigned akstep, const AO& aoff, const void* bbase, unsigned bkstep, const BO& boff, f32x4 (&acc)[8][4], bool pre = false, const NX& next = NX()) {
    const int tid = TID(), lane = tid & 63; const int wid = __builtin_amdgcn_readfirstlane(tid >> 6); const int wr = wid >> 2, wc = wid & 3;
    if (ZERO) {
#pragma unroll
        for (int mi = 0; mi < 8; ++mi)
#pragma unroll
            for (int ni = 0; ni < 4; ++ni) acc[mi][ni] = (f32x4){0.f, 0.f, 0.f, 0.f};
    }
    const unsigned lds0 = (unsigned)(uintptr_t)smem;
    const unsigned char* abase_u = uptr(abase); const unsigned char* bbase_u = uptr(bbase); const unsigned akstep_u = __builtin_amdgcn_readfirstlane(akstep), bkstep_u = __builtin_amdgcn_readfirstlane(bkstep);
    unsigned ao[4], bo[4];
#pragma unroll
    for (int i = 0; i < 4; ++i) { const int p = wid + 8 * i; ao[i] = aoff(8 * p + (lane >> 3), (lane & 7) ^ (lane >> 3));
        const int k = 2 * p + (lane >> 5); const int f = (k & 3) + 4 * ((k >> 3) & 1); bo[i] = boff(k, (lane & 31) ^ (f << 1)); }
#define GL_ISSUE(kt, st) do { const unsigned char* ab_ = abase_u + (size_t)(kt) * akstep_u; const unsigned char* bb_ = bbase_u + (size_t)(kt) * bkstep_u; \
        _Pragma("unroll") for (int i_ = 0; i_ < 4; ++i_) glds16s(ab_, ao[i_], (unsigned)__builtin_amdgcn_readfirstlane(lds0 + (st) * GL_STAGE + (wid + 8 * i_) * 1024)); \
        _Pragma("unroll") for (int i_ = 0; i_ < 4; ++i_) glds16s(bb_, bo[i_], (unsigned)__builtin_amdgcn_readfirstlane(lds0 + (st) * GL_STAGE + 32768 + (wid + 8 * i_) * 1024)); } while (0)
    if (!pre) {
        GL_ISSUE(0, 0);
        asm volatile("s_waitcnt vmcnt(0)" ::: "memory");
        __syncthreads();
    }
    for (int kt = 0; kt < nkt; ++kt) {
        if (kt + 1 < nkt) GL_ISSUE(kt + 1, (kt + 1) & 1); else next();
        const unsigned char* A = smem + (kt & 1) * GL_STAGE; const unsigned char* Bt = A + 32768;
#pragma unroll
        for (int ks = 0; ks < 2; ++ks) {
            bf16x8 wf[4];
#pragma unroll
            for (int ni = 0; ni < 4; ++ni) {
                const int i = lane & 15, g = lane >> 4, q = i >> 2; const int row = ks * 32 + 8 * g + q; const int nc = wc * 8 + ni * 2 + ((i & 3) >> 1); const int f = q + 4 * (g & 1);
                const unsigned char* p = Bt + row * 512 + ((nc ^ (f << 1)) << 4) + (i & 1) * 8;
                const s16x4 lo = tr_read(p), hi = tr_read(p + 4 * 512);
                wf[ni] = (bf16x8){lo[0], lo[1], lo[2], lo[3], hi[0], hi[1], hi[2], hi[3]};
            }
#pragma unroll
            for (int mi = 0; mi < 8; ++mi) {
                const int m = wr * 128 + mi * 16 + (lane & 15); const int kc = ks * 4 + (lane >> 4);
                const bf16x8 af = *(const bf16x8*)(A + m * 128 + ((kc ^ (m & 7)) << 4));
#pragma unroll
                for (int ni = 0; ni < 4; ++ni) acc[mi][ni] = __builtin_amdgcn_mfma_f32_16x16x32_bf16(wf[ni], af, acc[mi][ni], 0, 0, 0);
            }
        }
        asm volatile("s_waitcnt vmcnt(0)" ::: "memory");
        __syncthreads();
    }
#undef GL_ISSUE
}

#define EPI_IDS() do { const int etid_ = TID(); lane = etid_ & 63; wid = etid_ >> 6; wr = wid >> 2; wc = wid & 3; } while (0)

DEV void patch_decode(int local, int MT, int NT, int& mt, int& nt) {
    const int per_mtb = 8 * NT; const int mtb = local / per_mtb; const int rem = local - mtb * per_mtb;
    const int rows = (MT - 8 * mtb) < 8 ? (MT - 8 * mtb) : 8;
    const int per_ntb = rows * 8; const int nfull = NT >> 3; int ntb = rem / per_ntb; int cols = 8;
    if (ntb >= nfull) { ntb = nfull; cols = NT - 8 * nfull; }
    const int r2 = rem - ntb * per_ntb;
    mt = 8 * mtb + r2 / cols; nt = 8 * ntb + r2 % cols;
}

DEV void convert_chunk(const float* src, bf16_t* dst, size_t i8) {
    const float4 a = *(const float4*)(src + i8 * 8), b = *(const float4*)(src + i8 * 8 + 4);
    uint4 o; o.x = cvtpk(a.x, a.y); o.y = cvtpk(a.z, a.w); o.z = cvtpk(b.x, b.y); o.w = cvtpk(b.z, b.w);
    *(uint4*)(dst + i8 * 8) = o;
}
DEV void phase_prologue(const Args& a, unsigned char* smem) {
    unsigned char* ws = a.ws;
    const size_t gtid = (size_t)BID() * NTHR + TID(), gn = (size_t)gridDim.x * NTHR;
    {
        { const float* W = a.in[I_WOUT]; bf16_t* O = (bf16_t*)(ws + WS_WOUT); const float* gnn = a.in[I_GNN]; const float* gnf = a.in[I_GNF];
          for (size_t i = gtid; i < (size_t)1024 * 128; i += gn) { const int k = (int)(i >> 7); const float g_ = k < 512 ? gnn[k] : gnf[k - 512];
              const float4 x = *(const float4*)(W + i * 8), y = *(const float4*)(W + i * 8 + 4);
              uint4 o; o.x = cvtpk(x.x * g_, x.y * g_); o.y = cvtpk(x.z * g_, x.w * g_); o.z = cvtpk(y.x * g_, y.y * g_); o.w = cvtpk(y.z * g_, y.w * g_); *(uint4*)(O + i * 8) = o; } }
        const float* srcs[3] = {a.in[I_WGATE], a.in[I_WPLE], a.in[I_P]};
        bf16_t* dsts[3] = {(bf16_t*)(ws + WS_WGATE), (bf16_t*)(ws + WS_WPLE), (bf16_t*)(ws + WS_PB)};
        const size_t cnt8[3] = {1024 * 1024 / 8, 256 * 1024 / 8, (size_t)NTOK * 256 / 8};
#pragma unroll
        for (int s = 0; s < 3; ++s) for (size_t i = gtid; i < cnt8[s]; i += gn) convert_chunk(srcs[s], dsts[s], i);
        for (size_t i = gtid; i < (size_t)2 * 2048 * 32; i += gn) { const int which = (int)(i / (2048 * 32)); const int k = (int)(i / 32) % 2048, c8 = (int)(i % 32) * 8;
            uint4 o = {0u, 0u, 0u, 0u};
            if (c8 < 128) { const float* W = a.in[which ? I_WC1V : I_WC1K] + (size_t)k * 128 + c8; const float4 x = *(const float4*)W, y = *(const float4*)(W + 4); o.x = cvtpk(x.x, x.y); o.y = cvtpk(x.z, x.w); o.z = cvtpk(y.x, y.y); o.w = cvtpk(y.z, y.w); }
            *(uint4*)((bf16_t*)(ws + WS_WC1) + i * 8) = o; }
        for (size_t i = gtid; i < (size_t)2 * 128 * 32; i += gn) { const int which = (int)(i / (128 * 32)); const int k = (int)(i / 32) % 128, c8 = (int)(i % 32) * 8;
            uint4 o = {0u, 0u, 0u, 0u};
            if (c8 < 64) { const float* W = a.in[which ? I_WC2V : I_WC2K] + (size_t)k * 64 + c8; const float4 x = *(const float4*)W, y = *(const float4*)(W + 4); o.x = cvtpk(x.x, x.y); o.y = cvtpk(x.z, x.w); o.z = cvtpk(y.x, y.y); o.w = cvtpk(y.z, y.w); }
            *(uint4*)((bf16_t*)(ws + WS_WC2) + i * 8) = o; }
    }
    {
        const float* W = a.in[I_WIN]; bf16_t* O = (bf16_t*)(ws + WS_WIN);
        for (size_t i = gtid; i < (size_t)1024 * (NWIN / 8); i += gn) {
            const int k = (int)(i / (NWIN / 8)), j = (int)(i % (NWIN / 8)) * 8;
            uint4 o = {0u, 0u, 0u, 0u};
            if (j < 2848) {
                const int sj = (j < 1280) ? j : (j < 2816) ? j + 24 : (j < 2840) ? j - 1536 : j;
                const float4 x = *(const float4*)(W + (size_t)k * 2848 + sj), y = *(const float4*)(W + (size_t)k * 2848 + sj + 4);
                o.x = cvtpk(x.x, x.y); o.y = cvtpk(x.z, x.w); o.z = cvtpk(y.x, y.y); o.w = cvtpk(y.z, y.w);
            }
            *(uint4*)(O + (size_t)k * NWIN + j) = o;
        }
    }
    const int lane = TID() & 63; const int gw = BID() * NWAVE + (TID() >> 6), ngw = gridDim.x * NWAVE;
    {
        const float* X = a.in[I_X]; const float* g = a.in[I_LN1]; bf16_t* XN = (bf16_t*)(ws + WS_XN);
        for (int m = gw; m < NTOK; m += ngw) {
            float4 v[4]; float s = 0.f;
#pragma unroll
            for (int j = 0; j < 4; ++j) { v[j] = *(const float4*)(X + (size_t)m * 1024 + j * 256 + lane * 4); s += v[j].x * v[j].x + v[j].y * v[j].y + v[j].z * v[j].z + v[j].w * v[j].w; }
            const float rstd = rsqrtf(wave_sum(s) * (1.f / 1024.f) + EPS);
#pragma unroll
            for (int j = 0; j < 4; ++j) { const float4 gg = *(const float4*)(g + j * 256 + lane * 4);
                uint2 o; o.x = cvtpk(v[j].x * rstd * gg.x, v[j].y * rstd * gg.y); o.y = cvtpk(v[j].z * rstd * gg.z, v[j].w * rstd * gg.w);
                *(uint2*)(XN + (size_t)m * 1024 + j * 256 + lane * 4) = o; }
        }
    }
    if (gw < 256) {
        const int which = gw >> 7, n = gw & 127; const float* pe = a.in[which ? I_PEV : I_PEK]; const float* w1 = a.in[which ? I_WC1V : I_WC1K];
        float s = 0.f;
#pragma unroll 8
        for (int i = 0; i < 32; ++i) { const int k = lane + 64 * i; s += pe[k] * w1[(size_t)k * 128 + n]; }
        s = wave_sum(s);
        if (lane == 0) ((float*)(ws + WS_BIAS1))[which * 128 + n] = s;
    }
}

DEV void phase_inproj(const Args& a, unsigned char* smem) {
    const bf16_t* XN = (const bf16_t*)(a.ws + WS_XN); const bf16_t* W = (const bf16_t*)(a.ws + WS_WIN);
    bf16_t* PROJ = (bf16_t*)(a.ws + WS_PROJ); float* GN = (float*)(a.ws + WS_GN); float* LS = (float*)(a.ws + WS_LS); const float* bfg = a.in[I_BFG];
    int lane = TID() & 63, wid = TID() >> 6, wr = wid >> 2, wc = wid & 3; (void)wr; (void)wc; (void)lane;
    bool pre = false;
    for (int item = VBID(); item < 64 * 12; item += gridDim.x) {
        int mt, nt; patch_decode(item, 64, 12, mt, nt);
        const int nitem = item + (int)gridDim.x; const bool has_next = nitem < 64 * 12; int mtn = 0, ntn = 0; if (has_next) patch_decode(nitem, 64, 12, mtn, ntn);
        f32x4 acc[8][4];
        gemm256<true>(smem, 16, XN + (size_t)mt * 256 * 1024, 128u, [&](int r, int kc) { return (unsigned)(r * 2048 + kc * 16); },
                      W + nt * 256, (unsigned)(64 * NWIN * 2), [&](int k, int nc) { return (unsigned)(k * (NWIN * 2) + nc * 16); }, acc, pre,
                      [&]() { if (has_next) gemm256_issue0(smem, XN + (size_t)mtn * 256 * 1024, [&](int r, int kc) { return (unsigned)(r * 2048 + kc * 16); }, W + ntn * 256, [&](int k, int nc) { return (unsigned)(k * (NWIN * 2) + nc * 16); }); });
        pre = has_next;
        EPI_IDS();
#pragma unroll
        for (int mi = 0; mi < 8; ++mi) {
            const int gm = mt * 256 + wr * 128 + mi * 16 + (lane & 15); const int b = gm >> 13, t = gm & 8191;
#pragma unroll
            for (int ni = 0; ni < 4; ++ni) {
                const int n = wc * 64 + ni * 16 + 4 * (lane >> 4); const f32x4 v = acc[mi][ni];
                if (nt < 11) {
                    const int hs = nt * 4 + wc, d = n & 63; const float sc = (hs < 8 || (hs >= 20 && hs < 28)) ? QS : 1.0f;
                    uint2 o; o.x = cvtpk(v[0] * sc, v[1] * sc); o.y = cvtpk(v[2] * sc, v[3] * sc);
                    *(uint2*)(PROJ + (((size_t)(hs * 2 + b)) * 8192 + t) * 64 + d) = o;
                } else if (n < 24) {
#pragma unroll
                    for (int r = 0; r < 4; ++r) GN[(size_t)gm * 24 + n + r] = sigmoidf_(v[r]);
                } else if (n < 32) {
#pragma unroll
                    for (int r = 0; r < 4; ++r) { const int h = n - 24 + r; LS[((size_t)(b * 8 + h)) * 8192 + t] = logsigmoidf_(v[r] + bfg[h]); }
                }
            }
        }
    }
}

DEV void signal_done(unsigned* flag) {
    asm volatile("s_waitcnt vmcnt(0)" ::: "memory");
    __syncthreads();
    if (TID() == 0) { __builtin_amdgcn_fence(__ATOMIC_RELEASE, "agent"); asm volatile("s_waitcnt vmcnt(0)" ::: "memory"); __hip_atomic_fetch_add(flag, 1u, __ATOMIC_RELAXED, __HIP_MEMORY_SCOPE_AGENT); }
}
DEV void wait_flag(unsigned* flag, unsigned target) {
    if (TID() == 0) { unsigned sp = 0u; while (__hip_atomic_load(flag, __ATOMIC_RELAXED, __HIP_MEMORY_SCOPE_AGENT) < target) { __builtin_amdgcn_s_sleep(4); if (++sp > (1u << 24)) break; }
        __builtin_amdgcn_fence(__ATOMIC_ACQUIRE, "agent"); asm volatile("s_waitcnt vmcnt(0)" ::: "memory"); }
    __syncthreads();
}
constexpr int CW_CUMFLAG = 128, CW_CMPFLAG = 192, CW_GATEFLAG = 256;
DEV void cmp_item(const Args& a, unsigned char* smem, int item) {
    const bf16_t* PROJ = (const bf16_t*)(a.ws + WS_PROJ);
    const int tid = TID(); int lane = tid & 63, wid = tid >> 6, wr = wid >> 2, wc = wid & 3; (void)wr; (void)wc; (void)lane;
    {
        if (item < 16) {
            const int which = item >> 3, b = (item >> 2) & 1, g = (item >> 1) & 1, mt = item & 1;
            const bf16_t* base = PROJ + ((size_t)((8 + 2 * which + g) * 2 + b)) * 8192 * 64;
            const bf16_t* W1 = (const bf16_t*)(a.ws + WS_WC1) + (size_t)which * 2048 * 256;
            const bf16_t* W2 = (const bf16_t*)(a.ws + WS_WC2) + (size_t)which * 128 * 256;
            const float* bias1 = (const float*)(a.ws + WS_BIAS1) + which * 128;
            bf16_t* HID = (bf16_t*)(a.ws + WS_HID) + ((size_t)(which * 4 + b * 2 + g)) * 512 * 128;
            bf16_t* OUT = (bf16_t*)(a.ws + WS_KC) + ((size_t)(which * 4 + b * 2 + g)) * 512 * 64;
            f32x4 acc[8][4];
            gemm256<true>(smem, 32, base, 128u, [&](int r, int kc) { int c = mt * 256 + r; c = c > 510 ? 510 : c; return (unsigned)(c * 2048 + kc * 16); },
                          W1, 64u * 512u, [&](int k, int nc) { return (unsigned)(k * 512 + nc * 16); }, acc);
        EPI_IDS();
            if (wc < 2) {
#pragma unroll
                for (int mi = 0; mi < 8; ++mi) { const int c = mt * 256 + wr * 128 + mi * 16 + (lane & 15);
#pragma unroll
                    for (int ni = 0; ni < 4; ++ni) { const int n = wc * 64 + ni * 16 + 4 * (lane >> 4); const f32x4 v = acc[mi][ni]; const float4 bb = *(const float4*)(bias1 + n);
                        uint2 o; o.x = cvtpk(gelu_tanh(v[0] + bb.x), gelu_tanh(v[1] + bb.y)); o.y = cvtpk(gelu_tanh(v[2] + bb.z), gelu_tanh(v[3] + bb.w));
                        *(uint2*)(HID + (size_t)c * 128 + n) = o; } }
            }
            __syncthreads();
            gemm256<true>(smem, 2, HID + (size_t)mt * 256 * 128, 128u, [&](int r, int kc) { return (unsigned)(r * 256 + kc * 16); },
                          W2, 64u * 512u, [&](int k, int nc) { return (unsigned)(k * 512 + nc * 16); }, acc);
        EPI_IDS();
            if (wc == 0) {
#pragma unroll
                for (int mi = 0; mi < 8; ++mi) { const int c = mt * 256 + wr * 128 + mi * 16 + (lane & 15);
#pragma unroll
                    for (int ni = 0; ni < 4; ++ni) { const int n = ni * 16 + 4 * (lane >> 4); const f32x4 v = acc[mi][ni];
                        uint2 o; o.x = cvtpk(v[0], v[1]); o.y = cvtpk(v[2], v[3]);
                        if (c >= 511) { o.x = 0u; o.y = 0u; }
                        *(uint2*)(OUT + (size_t)c * 64 + n) = o; } }
            }
            signal_done((unsigned*)(a.ws + WS_CTL) + CW_CMPFLAG);
        } else {
            const int bh = item - 16; const float* LS = (const float*)(a.ws + WS_LS) + (size_t)bh * 8192; float* CUM = (float*)(a.ws + WS_CUM) + (size_t)bh * 8192;
            float* sc = (float*)smem;
            float v[16]; float s = 0.f;
#pragma unroll
            for (int j = 0; j < 4; ++j) { const float4 x = *(const float4*)(LS + tid * 16 + j * 4); v[4 * j] = x.x; v[4 * j + 1] = x.y; v[4 * j + 2] = x.z; v[4 * j + 3] = x.w; }
#pragma unroll
            for (int j = 0; j < 16; ++j) { s += v[j]; v[j] = s; }
            sc[tid] = s; __syncthreads();
            if (tid == 0) { float run = 0.f; for (int i = 0; i < NTHR; ++i) { const float x = sc[i]; sc[i] = run; run += x; } }
            __syncthreads();
            const float off = sc[tid];
#pragma unroll
            for (int j = 0; j < 4; ++j) { float4 o = {v[4 * j] + off, v[4 * j + 1] + off, v[4 * j + 2] + off, v[4 * j + 3] + off}; *(float4*)(CUM + tid * 16 + j * 4) = o; }
            signal_done((unsigned*)(a.ws + WS_CTL) + CW_CUMFLAG + bh);
        }
    }
}

constexpr int AT_STAGE = 16384;
constexpr int AT_BIAS_OFF = 3 * AT_STAGE;
constexpr int AT_IMP_OFF = AT_BIAS_OFF + 1024;
constexpr int AT_SEL_OFF = AT_IMP_OFF + 65536;
constexpr int AT_WUN_OFF = AT_SEL_OFF + 1024;
constexpr int AT_UCNT_OFF = AT_WUN_OFF + 128;
constexpr int AT_ULIST_OFF = AT_UCNT_OFF + 16;
constexpr int AT_ITEM_OFF = AT_ULIST_OFF + 128;
static_assert(AT_ITEM_OFF + 16 <= GEMM_LDS, "attention LDS map");
#define NEG_INF (-__builtin_inff())

#define KV_DECL uint4 rk0_, rv0_
#define KV_GLOAD(Kt, Vt) do { rk0_ = *(const uint4*)((Kt) + tid * 8); rv0_ = *(const uint4*)((Vt) + tid * 8); } while (0)
#define KV_LSTORE(stp) do { unsigned char* st_ = (stp); const int key = tid >> 3, ch = tid & 7; \
      *(uint4*)(st_ + key * 128 + ((ch ^ (key & 7)) << 4)) = rk0_; \
      *(uint4*)(st_ + 8192 + key * 128 + ((((ch >> 2) ^ ((key >> 1) & 1))) << 6) + ((ch & 3) << 4)) = rv0_; } while (0)
template <bool FULL>
DEV void qk_tile(const unsigned char* Kst, const bf16x8 (&qf)[4], f32x16& p0, f32x16& p1, int lane) {
    const int key = lane & 31, hi = lane >> 5;
    if (FULL) {
        bf16x8 k0[4], k1[4];
#pragma unroll
        for (int ks = 0; ks < 4; ++ks) { const int ch = 2 * ks + hi; const int off = key * 128 + ((ch ^ (key & 7)) << 4);
            k0[ks] = *(const bf16x8*)(Kst + off); k1[ks] = *(const bf16x8*)(Kst + off + 32 * 128); }
        __builtin_amdgcn_sched_barrier(0);
#pragma unroll
        for (int ks = 0; ks < 4; ++ks) {
            p0 = __builtin_amdgcn_mfma_f32_32x32x16_bf16(k0[ks], qf[ks], p0, 0, 0, 0);
            p1 = __builtin_amdgcn_mfma_f32_32x32x16_bf16(k1[ks], qf[ks], p1, 0, 0, 0); }
    } else {
        bf16x8 kk[4];
#pragma unroll
        for (int ks = 0; ks < 4; ++ks) { const int ch = 2 * ks + hi; kk[ks] = *(const bf16x8*)(Kst + key * 128 + ((ch ^ (key & 7)) << 4)); }
        __builtin_amdgcn_sched_barrier(0);
#pragma unroll
        for (int ks = 0; ks < 4; ++ks) p0 = __builtin_amdgcn_mfma_f32_32x32x16_bf16(kk[ks], qf[ks], p0, 0, 0, 0);
        __builtin_amdgcn_sched_barrier(0);
#pragma unroll
        for (int ks = 0; ks < 4; ++ks) { const int ch = 2 * ks + hi; kk[ks] = *(const bf16x8*)(Kst + key * 128 + ((ch ^ (key & 7)) << 4) + 32 * 128); }
        __builtin_amdgcn_sched_barrier(0);
#pragma unroll
        for (int ks = 0; ks < 4; ++ks) p1 = __builtin_amdgcn_mfma_f32_32x32x16_bf16(kk[ks], qf[ks], p1, 0, 0, 0);
    }
}
template <bool FULL>
DEV void pv_tile(const unsigned char* Vst, const f32x16& p0, const f32x16& p1, f32x16 (&o)[2], int lane) {
    const int hi = lane >> 5, i = lane & 15, gg = (lane >> 4) & 1;
    const int q = i >> 2; const int sw = (q >> 1) & 1;
    bf16x8 pa[4];
#pragma unroll
    for (int s = 0; s < 4; ++s) { const f32x16& p = (s < 2) ? p0 : p1; const int b = (s & 1) * 8;
        unsigned w[4];
#pragma unroll
        for (int j = 0; j < 4; ++j) w[j] = cvtpk(p[b + 2 * j], p[b + 2 * j + 1]);
        typedef unsigned u32x4_t __attribute__((ext_vector_type(4)));
        u32x4_t ww = {w[0], w[1], w[2], w[3]}; pa[s] = __builtin_bit_cast(bf16x8, ww); }
    constexpr int NB = FULL ? 1 : 2, SB = FULL ? 4 : 2;
#pragma unroll
    for (int bt = 0; bt < NB; ++bt) {
        s16x4 vlo[SB][2], vhi[SB][2];
#pragma unroll
        for (int s_ = 0; s_ < SB; ++s_)
#pragma unroll
            for (int dh = 0; dh < 2; ++dh) { const int s = bt * SB + s_; const int row0 = 16 * s + 4 * hi + q;
                const unsigned char* p = Vst + row0 * 128 + ((dh ^ sw) << 6) + gg * 32 + (i & 3) * 8;
                vlo[s_][dh] = tr_read(p); vhi[s_][dh] = tr_read(p + 8 * 128); }
        __builtin_amdgcn_sched_barrier(0);
#pragma unroll
        for (int s_ = 0; s_ < SB; ++s_)
#pragma unroll
            for (int dh = 0; dh < 2; ++dh) { const int s = bt * SB + s_;
                const bf16x8 vf = {vlo[s_][dh][0], vlo[s_][dh][1], vlo[s_][dh][2], vlo[s_][dh][3], vhi[s_][dh][0], vhi[s_][dh][1], vhi[s_][dh][2], vhi[s_][dh][3]};
                o[dh] = __builtin_amdgcn_mfma_f32_32x32x16_bf16(vf, pa[s], o[dh], 0, 0, 0); }
        __builtin_amdgcn_sched_barrier(0);
    }
}
DEV float rowmax32(const f32x16& p0, const f32x16& p1) {
    float a = fmaxf(p0[0], p1[0]), b = fmaxf(p0[1], p1[1]);
#pragma unroll
    for (int r = 2; r < 16; r += 2) { a = fmaxf(fmaxf(a, p0[r]), p1[r]); b = fmaxf(fmaxf(b, p0[r + 1]), p1[r + 1]); }
    return pair_max(fmaxf(a, b));
}
DEV void softmax_step(f32x16& p0, f32x16& p1, float& m, float& l, f32x16 (&o)[2]) {
    const float mt = rowmax32(p0, p1); const float mn = fmaxf(m, mt); const float alpha = __builtin_amdgcn_exp2f(m - mn);
    float rs = 0.f;
#pragma unroll
    for (int r = 0; r < 16; ++r) { p0[r] = __builtin_amdgcn_exp2f(p0[r] - mn); p1[r] = __builtin_amdgcn_exp2f(p1[r] - mn); rs += p0[r] + p1[r]; }
    rs = pair_sum(rs);
    l = l * alpha + rs; m = mn;
    if (__any(alpha != 1.0f)) { o[0] *= alpha; o[1] *= alpha; }
}
template <int STRIDE> DEV void mask_tile(f32x16& p0, f32x16& p1, int kpos0, int lo, int hi_lim, int hi) {
#pragma unroll
    for (int r = 0; r < 16; ++r) { const int kp = kpos0 + STRIDE * crow(r, hi);
        if (kp < lo || kp > hi_lim) p0[r] = NEG_INF;
        const int kp1 = kp + 32 * STRIDE; if (kp1 < lo || kp1 > hi_lim) p1[r] = NEG_INF; }
}
template <int STRIDE> DEV void alibi_init(f32x16& p0, f32x16& p1, float slope2, int kpos0, int tref, int hi) {
    const float base = slope2 * (float)(kpos0 - tref + STRIDE * 4 * hi);
#pragma unroll
    for (int r = 0; r < 16; ++r) { const float c = (float)(STRIDE * ((r & 3) + 8 * (r >> 2))); p0[r] = fmaf(slope2, c, base); p1[r] = fmaf(slope2, c + (float)(32 * STRIDE), base); }
}
template <class Src, class Body>
DEV void kv_pipeline(unsigned char* smem, int n, const Src& src, const Body& body) {
    if (n <= 0) return;
    KV_DECL; const int tid = TID(); const bf16_t *kp, *vp;
    src(0, kp, vp); KV_GLOAD(kp, vp); KV_LSTORE(smem);
    __syncthreads();
    for (int j = 0; j < n; ++j) {
        const bool more = j + 1 < n;
        if (more) { src(j + 1, kp, vp); KV_GLOAD(kp, vp); }
        body(j, smem + (j & 1) * AT_STAGE);
        if (more) KV_LSTORE(smem + ((j + 1) & 1) * AT_STAGE);
        __syncthreads();
    }
}

constexpr int CV_PER_STEP = 373; constexpr int CV_NUP = 32 * 1024 * 2048 / 8, CV_NDN = 32 * 1024 * 1024 / 8;
static_assert((long long)33792 * CV_PER_STEP >= (long long)CV_NUP + CV_NDN, "conversion coverage");
DEV void fox_item(const Args& a, unsigned char* smem, int fi, int b, int h, int qb) {
    const int tid = TID(), lane = tid & 63, wid = tid >> 6, r32 = lane & 31, hi = lane >> 5;
    const bf16_t* PROJ = (const bf16_t*)(a.ws + WS_PROJ);
    const bf16_t* Q = PROJ + ((size_t)((20 + h) * 2 + b)) * 8192 * 64; const bf16_t* K = PROJ + ((size_t)((28 + h) * 2 + b)) * 8192 * 64; const bf16_t* V = PROJ + ((size_t)((36 + h) * 2 + b)) * 8192 * 64;
    const float* CUM = (const float*)(a.ws + WS_CUM) + (size_t)(b * 8 + h) * 8192;
    const int q0 = qb * 256; const int qrow = q0 + 32 * wid + r32;
    bf16x8 qf[4];
#pragma unroll
    for (int ks = 0; ks < 4; ++ks) qf[ks] = *(const bf16x8*)(Q + (size_t)qrow * 64 + 16 * ks + 8 * hi);
    const float cref = CUM[q0];
    const int ntiles = 4 * qb + 4; const int jmax_w = (q0 + 32 * wid + 31) >> 6; const int jmask_w = (q0 + 32 * wid) >> 6;
    f32x16 o[2]; o[0] = (f32x16){}; o[1] = (f32x16){}; float m = -1e30f, l = 0.f;
    float* biasL = (float*)(smem + AT_BIAS_OFF);
    const int gq_ = fi >> 4; const int sidx0 = 16 * (128 * gq_ - 2 * gq_ * (gq_ - 1)) + (fi & 15) * (128 - 4 * gq_);
    const float* cvs = nullptr; bf16_t* cvd = nullptr; float4 cva, cvb;
    KV_DECL; float breg = 0.f;
    KV_GLOAD(K, V); if (tid < 64) breg = (cref - CUM[tid]) * LOG2E;
    KV_LSTORE(smem); if (tid < 64) biasL[tid] = breg;
    KV_GLOAD(K + 4096, V + 4096); if (tid < 64) breg = (cref - CUM[64 + tid]) * LOG2E;
    KV_LSTORE(smem + AT_STAGE); if (tid < 64) biasL[64 + tid] = breg;
    __syncthreads();
#define FOX_QK(P0, P1, jj, sj) do { const float* bl_ = biasL + (sj) * 64; \
        _Pragma("unroll") for (int g4 = 0; g4 < 4; ++g4) { const float4 x_ = *(const float4*)(bl_ + 8 * g4 + 4 * hi), y_ = *(const float4*)(bl_ + 32 + 8 * g4 + 4 * hi); \
            P0[4 * g4] = x_.x; P0[4 * g4 + 1] = x_.y; P0[4 * g4 + 2] = x_.z; P0[4 * g4 + 3] = x_.w; P1[4 * g4] = y_.x; P1[4 * g4 + 1] = y_.y; P1[4 * g4 + 2] = y_.z; P1[4 * g4 + 3] = y_.w; } \
        qk_tile<true>(smem + (sj) * AT_STAGE, qf, P0, P1, lane); \
        if ((jj) >= jmask_w) mask_tile<1>(P0, P1, 64 * (jj), -1, qrow, hi); } while (0)
#define FOX_STEP(CUR0, CUR1, NXT0, NXT1, j) do { \
        const int s_cur = (j) % 3, s_nxt = ((j) + 1) % 3, s_ld = ((j) + 2) % 3; const bool more_ = (j) + 2 < ntiles; \
        if (more_) { KV_GLOAD(K + (size_t)((j) + 2) * 4096, V + (size_t)((j) + 2) * 4096); if (tid < 64) breg = (cref - CUM[((j) + 2) * 64 + tid]) * LOG2E; } \
        { const int c_ = (sidx0 + (j)) * CV_PER_STEP + tid; cvs = nullptr; \
          if (tid < CV_PER_STEP && c_ < CV_NUP + CV_NDN) { if (c_ < CV_NUP) { cvs = a.in[I_WUP] + (size_t)c_ * 8; cvd = (bf16_t*)(a.ws + WS_WUP) + (size_t)c_ * 8; } else { cvs = a.in[I_WDN] + (size_t)(c_ - CV_NUP) * 8; cvd = (bf16_t*)(a.ws + WS_WDN) + (size_t)(c_ - CV_NUP) * 8; } \
              cva = *(const float4*)cvs; cvb = *(const float4*)(cvs + 4); } } \
        if ((j) + 1 < ntiles && (j) + 1 <= jmax_w) FOX_QK(NXT0, NXT1, (j) + 1, s_nxt); \
        __builtin_amdgcn_sched_barrier(0); \
        if ((j) <= jmax_w) { softmax_step(CUR0, CUR1, m, l, o); pv_tile<false>(smem + s_cur * AT_STAGE + 8192, CUR0, CUR1, o, lane); } \
        if (more_) { KV_LSTORE(smem + s_ld * AT_STAGE); if (tid < 64) biasL[s_ld * 64 + tid] = breg; } \
        if (cvs) { uint4 o_; o_.x = cvtpk(cva.x, cva.y); o_.y = cvtpk(cva.z, cva.w); o_.z = cvtpk(cvb.x, cvb.y); o_.w = cvtpk(cvb.z, cvb.w); *(uint4*)cvd = o_; } \
        __syncthreads(); } while (0)
    f32x16 pA0, pA1, pB0, pB1;
    FOX_QK(pA0, pA1, 0, 0);
    for (int j = 0; j < ntiles; j += 2) {
        FOX_STEP(pA0, pA1, pB0, pB1, j);
        FOX_STEP(pB0, pB1, pA0, pA1, j + 1);
    }
#undef FOX_QK
#undef FOX_STEP
    const float inv = 1.0f / l; float ss = 0.f;
    const size_t token = (size_t)b * 8192 + qrow;
    bf16_t* O = (bf16_t*)(a.ws + WS_OFOX) + token * 512 + h * 64;
#pragma unroll
    for (int dh = 0; dh < 2; ++dh)
#pragma unroll
        for (int g4 = 0; g4 < 4; ++g4) { const float v0 = o[dh][4 * g4] * inv, v1 = o[dh][4 * g4 + 1] * inv, v2 = o[dh][4 * g4 + 2] * inv, v3 = o[dh][4 * g4 + 3] * inv;
            ss += v0 * v0 + v1 * v1 + v2 * v2 + v3 * v3; uint2 w; w.x = cvtpk(v0, v1); w.y = cvtpk(v2, v3); *(uint2*)(O + 32 * dh + 8 * g4 + 4 * hi) = w; }
    ss = pair_sum(ss);
    if (hi == 0) ((float*)(a.ws + WS_SSQ))[token * 16 + 8 + h] = ss;
}

DEV void nsa_item(const Args& a, unsigned char* smem, int b, int g, int tt) {
    const int tid = TID(), lane = tid & 63, wid = tid >> 6, col = lane & 31, hi = lane >> 5;
    const int t0 = tt * 64, tokw = col >> 2, r = col & 3, h = 4 * g + r; const int tokl = wid * 8 + tokw; const int t = t0 + tokl; const size_t token = (size_t)b * 8192 + t;
    const float slope2 = exp2f(-(float)(h + 1)) * LOG2E;
    const bf16_t* PROJ = (const bf16_t*)(a.ws + WS_PROJ);
    const float* GN = (const float*)(a.ws + WS_GN) + token * 24 + h * 3;
    const int cur = tt; const bool need_topk = cur > 15;
    bf16x8 qf[4];
    { const bf16_t* Q = PROJ + (((size_t)(h * 2 + b)) * 8192 + t) * 64;
#pragma unroll
      for (int ks = 0; ks < 4; ++ks) qf[ks] = *(const bf16x8*)(Q + 16 * ks + 8 * hi); }
    float* impw = (float*)(smem + AT_IMP_OFF) + wid * 2048; float* totw = impw + lane;
    unsigned* selmask = (unsigned*)(smem + AT_SEL_OFF); unsigned* wun = (unsigned*)(smem + AT_WUN_OFF); int* ucnt = (int*)(smem + AT_UCNT_OFF); unsigned char* ulist = smem + AT_ULIST_OFF;
    f32x16 o[2]; float m, l;
    const int tmin_w = t0 + wid * 8, tmax_w = tmin_w + 7;
    {
        const bf16_t* KC = (const bf16_t*)(a.ws + WS_KC) + ((size_t)(0 * 4 + b * 2 + g)) * 512 * 64; const bf16_t* VC = (const bf16_t*)(a.ws + WS_KC) + ((size_t)(1 * 4 + b * 2 + g)) * 512 * 64;
        const int ncv = t0 / 16 + 3; const int nct = (ncv + 63) >> 6;
        auto src = [&](int j, const bf16_t*& kp, const bf16_t*& vp) { kp = KC + (size_t)j * 4096; vp = VC + (size_t)j * 4096; };
        m = -1e30f; l = 0.f;
        kv_pipeline(smem, nct, src, [&](int j, const unsigned char* st) {
            const int kpos0 = 1024 * j + 31;
            if (kpos0 > tmax_w) return;
            f32x16 p0, p1; alibi_init<16>(p0, p1, slope2, kpos0, t0, hi);
            qk_tile<false>(st, qf, p0, p1, lane);
            mask_tile<16>(p0, p1, kpos0, -1, t, hi);
            const float mt = rowmax32(p0, p1); const float mn = fmaxf(m, mt); float rs = 0.f;
#pragma unroll
            for (int rr = 0; rr < 16; ++rr) rs += __builtin_amdgcn_exp2f(p0[rr] - mn) + __builtin_amdgcn_exp2f(p1[rr] - mn);
            rs = pair_sum(rs);
            l = l * __builtin_amdgcn_exp2f(m - mn) + rs; m = mn;
        });
        const float linv = l > 0.f ? 1.0f / l : 0.f;
        if (need_topk) { for (int i = lane; i < 8 * 129; i += 64) impw[i] = 0.f; }
        o[0] = (f32x16){}; o[1] = (f32x16){};
        kv_pipeline(smem, nct, src, [&](int j, const unsigned char* st) {
            const int kpos0 = 1024 * j + 31;
            if (kpos0 > tmax_w) return;
            f32x16 p0, p1; alibi_init<16>(p0, p1, slope2, kpos0, t0, hi);
            qk_tile<false>(st, qf, p0, p1, lane);
            mask_tile<16>(p0, p1, kpos0, -1, t, hi);
#pragma unroll
            for (int rr = 0; rr < 16; ++rr) { p0[rr] = __builtin_amdgcn_exp2f(p0[rr] - m) * linv; p1[rr] = __builtin_amdgcn_exp2f(p1[rr] - m) * linv; }
            if (need_topk) {
#pragma unroll
                for (int half = 0; half < 2; ++half)
#pragma unroll
                    for (int g4 = 0; g4 < 4; ++g4) { const f32x16& p = half ? p1 : p0;
                        float ms = (p[4 * g4] + p[4 * g4 + 1]) + (p[4 * g4 + 2] + p[4 * g4 + 3]); float ls = p[4 * g4 + 3];
                        ms = quad_sum(ms); ls = quad_sum(ls);
                        const int n = 16 * j + 8 * half + 2 * g4 + hi;
                        if (r == 0) { atomicAdd(&impw[tokw * 129 + n], ms); atomicAdd(&impw[tokw * 129 + n + 1], ls); } }
            }
            pv_tile<false>(st + 8192, p0, p1, o, lane);
        });
    }
    {
        unsigned un0 = 0u, un1 = 0u, un2 = 0u, un3 = 0u;
        if (need_topk) {
            for (int tk = 0; tk < 8; ++tk) {
                float v0 = impw[tk * 129 + lane], v1 = impw[tk * 129 + 64 + lane];
                v0 = (lane >= 1 && lane <= cur - 2) ? v0 : -1.0f; v1 = (lane + 64 <= cur - 2) ? v1 : -1.0f;
                unsigned m0 = 1u, m1 = 0u, m2 = 0u, m3 = 0u;
#define SETBIT(n_) do { const int n__ = (n_); const unsigned bit__ = 1u << (n__ & 31); const int w__ = n__ >> 5; if (w__ == 0) m0 |= bit__; else if (w__ == 1) m1 |= bit__; else if (w__ == 2) m2 |= bit__; else m3 |= bit__; } while (0)
                SETBIT(cur); SETBIT(cur - 1);
                for (int it = 0; it < 13; ++it) {
                    const float mx = wave_max_u(fmaxf(v0, v1));
                    const unsigned long long b0 = __ballot(v0 == mx);
                    int n;
                    if (b0) n = __ffsll((long long)b0) - 1; else { const unsigned long long b1 = __ballot(v1 == mx); n = 64 + __ffsll((long long)b1) - 1; }
                    if (lane == (n & 63)) { if (n < 64) v0 = -1.0f; else v1 = -1.0f; }
                    SETBIT(n);
                }
#undef SETBIT
                if (lane == 0) { unsigned* sm_ = selmask + (wid * 8 + tk) * 4; sm_[0] = m0; sm_[1] = m1; sm_[2] = m2; sm_[3] = m3; }
                un0 |= m0; un1 |= m1; un2 |= m2; un3 |= m3;
            }
        } else {
            const unsigned full = (2u << cur) - 1u;
            un0 = full;
            if (lane < 8) { unsigned* sm_ = selmask + (wid * 8 + lane) * 4; sm_[0] = full; sm_[1] = 0u; sm_[2] = 0u; sm_[3] = 0u; }
        }
        if (lane == 0) { wun[wid * 4] = un0; wun[wid * 4 + 1] = un1; wun[wid * 4 + 2] = un2; wun[wid * 4 + 3] = un3; }
        __syncthreads();
        if (tid == 0) { int c = 0;
            for (int w = 0; w < 4; ++w) { unsigned u = 0u; for (int ww = 0; ww < NWAVE; ++ww) u |= wun[ww * 4 + w]; for (int bb = 0; bb < 32; ++bb) if ((u >> bb) & 1u) ulist[c++] = (unsigned char)(w * 32 + bb); }
            ucnt[0] = c; }
        __syncthreads();
    }
    { const float g0 = GN[0];
#pragma unroll
      for (int rr = 0; rr < 16; ++rr) { totw[rr * 64] = o[0][rr] * g0; totw[(16 + rr) * 64] = o[1][rr] * g0; } }
    {
        const bf16_t* KS = PROJ + ((size_t)((12 + g) * 2 + b)) * 8192 * 64; const bf16_t* VS = PROJ + ((size_t)((14 + g) * 2 + b)) * 8192 * 64;
        const int nu = ucnt[0];
        m = -1e30f; l = 0.f; o[0] = (f32x16){}; o[1] = (f32x16){};
        kv_pipeline(smem, nu, [&](int j, const bf16_t*& kp, const bf16_t*& vp) { const int n = ulist[j]; kp = KS + (size_t)n * 4096; vp = VS + (size_t)n * 4096; },
            [&](int j, const unsigned char* st) {
                const int n = ulist[j];
                if (!((wun[wid * 4 + (n >> 5)] >> (n & 31)) & 1u)) return;
                const bool sel = (selmask[tokl * 4 + (n >> 5)] >> (n & 31)) & 1u;
                f32x16 p0, p1; alibi_init<1>(p0, p1, slope2, 64 * n, t0, hi);
                qk_tile<false>(st, qf, p0, p1, lane);
                if (n == cur || !__all(sel)) mask_tile<1>(p0, p1, 64 * n, -1, sel ? t : -1, hi);
                softmax_step(p0, p1, m, l, o);
                pv_tile<false>(st + 8192, p0, p1, o, lane);
            });
        const float g1 = GN[1] / fmaxf(l, 1e-30f);
#pragma unroll
        for (int rr = 0; rr < 16; ++rr) { totw[rr * 64] += o[0][rr] * g1; totw[(16 + rr) * 64] += o[1][rr] * g1; }
    }
    {
        const bf16_t* KW = PROJ + ((size_t)((16 + g) * 2 + b)) * 8192 * 64; const bf16_t* VW = PROJ + ((size_t)((18 + g) * 2 + b)) * 8192 * 64;
        const int jlo = (t0 - 511) > 0 ? ((t0 - 511) >> 6) : 0; const int jhi = cur;
        m = -1e30f; l = 0.f; o[0] = (f32x16){}; o[1] = (f32x16){};
        kv_pipeline(smem, jhi - jlo + 1, [&](int j, const bf16_t*& kp, const bf16_t*& vp) { kp = KW + (size_t)(jlo + j) * 4096; vp = VW + (size_t)(jlo + j) * 4096; },
            [&](int j, const unsigned char* st) {
                const int kpos0 = 64 * (jlo + j);
                if (kpos0 > tmax_w || kpos0 + 63 < tmin_w - 511) return;
                f32x16 p0, p1; alibi_init<1>(p0, p1, slope2, kpos0, t0, hi);
                qk_tile<false>(st, qf, p0, p1, lane);
                if (kpos0 < tmax_w - 511 || kpos0 + 63 > tmin_w) mask_tile<1>(p0, p1, kpos0, t - 511, t, hi);
                softmax_step(p0, p1, m, l, o);
                pv_tile<false>(st + 8192, p0, p1, o, lane);
            });
        const float g2 = GN[2] / fmaxf(l, 1e-30f);
#pragma unroll
        for (int rr = 0; rr < 16; ++rr) { o[0][rr] = totw[rr * 64] + o[0][rr] * g2; o[1][rr] = totw[(16 + rr) * 64] + o[1][rr] * g2; }
    }
    {
        float ss = 0.f; bf16_t* O = (bf16_t*)(a.ws + WS_ONSA) + token * 512 + h * 64;
#pragma unroll
        for (int dh = 0; dh < 2; ++dh)
#pragma unroll
            for (int g4 = 0; g4 < 4; ++g4) { const float v0 = o[dh][4 * g4], v1 = o[dh][4 * g4 + 1], v2 = o[dh][4 * g4 + 2], v3 = o[dh][4 * g4 + 3];
                ss += v0 * v0 + v1 * v1 + v2 * v2 + v3 * v3; uint2 w; w.x = cvtpk(v0, v1); w.y = cvtpk(v2, v3); *(uint2*)(O + 32 * dh + 8 * g4 + 4 * hi) = w; }
        ss = pair_sum(ss);
        if (hi == 0) ((float*)(a.ws + WS_SSQ))[token * 16 + h] = ss;
    }
}
#ifndef PROBE_DUP
#define PROBE_DUP 0
#endif
DEV void phase_att(const Args& a, unsigned char* smem) {
    int* qctr = (int*)(a.ws + WS_CTL) + 64; int* sitem = (int*)(smem + AT_ITEM_OFF);
    unsigned* ctl = (unsigned*)(a.ws + WS_CTL); unsigned* seen = (unsigned*)(smem + AT_ITEM_OFF + 8);
    if (TID() == 0) seen[0] = 0u;
    for (;;) {
        if (TID() == 0) sitem[0] = atomicAdd(qctr, 1);
        __syncthreads();
        const int item = sitem[0];
        __syncthreads();
        if (item >= 32 + 1024) break;
        if (item < 16) cmp_item(a, smem, 16 + item);
        else if (item < 32) cmp_item(a, smem, item - 16);
        else if (item < 32 + 512) { const int fi = item - 32; const int qb = 31 - (fi >> 4), bh = fi & 15; if (!((seen[0] >> bh) & 1u)) { wait_flag(ctl + CW_CUMFLAG + bh, 1u); if (TID() == 0) seen[0] |= 1u << bh; } fox_item(a, smem, fi, bh >> 3, bh & 7, qb); }
        else { const int idx = item - 32 - 512; const int tt = 127 - (idx >> 2), bg = idx & 3; if (!((seen[0] >> 16) & 1u)) { wait_flag(ctl + CW_CMPFLAG, 16u); if (TID() == 0) seen[0] |= 1u << 16; } nsa_item(a, smem, bg >> 1, bg & 1, tt); }
    }
}

DEV void phase_outproj(const Args& a, unsigned char* smem) {
    const bf16_t* ONSA = (const bf16_t*)(a.ws + WS_ONSA); const bf16_t* OFOX = (const bf16_t*)(a.ws + WS_OFOX); const float* SSQ = (const float*)(a.ws + WS_SSQ);
    const bf16_t* W = (const bf16_t*)(a.ws + WS_WOUT); float* H1 = (float*)(a.ws + WS_H1); const float* X = a.in[I_X];
    float* rs = (float*)(smem + MISC_OFF);
    const int tid = TID(); int lane = tid & 63, wid = tid >> 6, wr = wid >> 2, wc = wid & 3; (void)wr; (void)wc; (void)lane;
    auto aoffo = [](int r, int kc) { return (unsigned)(r * 1024 + kc * 16); }; auto boffo = [](int k, int nc) { return (unsigned)(k * 2048 + nc * 16); };
    for (int item = VBID(); item < 64 * 4; item += gridDim.x) {
        int mt, nt; patch_decode(item, 64, 4, mt, nt);
        gemm256_issue0(smem, ONSA + (size_t)mt * 256 * 512, aoffo, W + nt * 256, boffo);
        if (tid < 256) { const float* s_ = SSQ + (size_t)(mt * 256 + tid) * 16; float sn = 0.f, sf = 0.f;
#pragma unroll
            for (int j = 0; j < 8; ++j) { sn += s_[j]; sf += s_[8 + j]; }
            rs[tid * 2] = rsqrtf(sn * (1.f / 512.f) + EPS); rs[tid * 2 + 1] = rsqrtf(sf * (1.f / 512.f) + EPS); }
        asm volatile("s_waitcnt vmcnt(0)" ::: "memory");
        __syncthreads();
        f32x4 acc[8][4];
#pragma unroll
        for (int mi = 0; mi < 8; ++mi) { const size_t gm = (size_t)mt * 256 + wr * 128 + mi * 16 + (lane & 15);
#pragma unroll
            for (int ni = 0; ni < 4; ++ni) { const int n = nt * 256 + wc * 64 + ni * 16 + 4 * (lane >> 4); const float4 x = *(const float4*)(X + gm * 1024 + n); acc[mi][ni] = (f32x4){x.x, x.y, x.z, x.w}; } }
#pragma unroll
        for (int mi = 0; mi < 8; ++mi) { const float ri = 1.0f / rs[(wr * 128 + mi * 16 + (lane & 15)) * 2];
#pragma unroll
            for (int ni = 0; ni < 4; ++ni) acc[mi][ni] *= ri; }
        gemm256<false>(smem, 8, ONSA + (size_t)mt * 256 * 512, 128u, aoffo, W + nt * 256, 64u * 2048u, boffo, acc, true,
                       [&]() { gemm256_issue0(smem, OFOX + (size_t)mt * 256 * 512, aoffo, W + (size_t)512 * 1024 + nt * 256, boffo); });
        EPI_IDS();
#pragma unroll
        for (int mi = 0; mi < 8; ++mi) { const int rl = wr * 128 + mi * 16 + (lane & 15); const float rat = rs[rl * 2] / rs[rl * 2 + 1];
#pragma unroll
            for (int ni = 0; ni < 4; ++ni) acc[mi][ni] *= rat; }
        gemm256<false>(smem, 8, OFOX + (size_t)mt * 256 * 512, 128u, aoffo, W + (size_t)512 * 1024 + nt * 256, 64u * 2048u, boffo, acc, true);
        EPI_IDS();
#pragma unroll
        for (int mi = 0; mi < 8; ++mi) { const int rl = wr * 128 + mi * 16 + (lane & 15); const size_t gm = (size_t)mt * 256 + rl; const float rf = rs[rl * 2 + 1];
#pragma unroll
            for (int ni = 0; ni < 4; ++ni) { const int n = nt * 256 + wc * 64 + ni * 16 + 4 * (lane >> 4); const f32x4 v = acc[mi][ni] * rf;
                float4 o = {v[0], v[1], v[2], v[3]}; *(float4*)(H1 + gm * 1024 + n) = o; } }
        __syncthreads();
    }
}

DEV void phase_route(const Args& a, unsigned char* smem) {
    const float* H1 = (const float*)(a.ws + WS_H1); bf16_t* XN = (bf16_t*)(a.ws + WS_XN); float* RSTD2 = (float*)(a.ws + WS_RSTD2);
    const float* ln2 = a.in[I_LN2]; const float* wr_ = a.in[I_WR]; const float* br = a.in[I_BR];
    int* CNT = (int*)(a.ws + WS_CTL);
    int* TOPI = (int*)(a.ws + WS_TOPI); int* TOPS = (int*)(a.ws + WS_TOPS); float* TOPW = (float*)(a.ws + WS_TOPW);
    int* TOKOF = (int*)(a.ws + WS_TOKOF); float* ROWW = (float*)(a.ws + WS_ROWW);
    float* part = (float*)smem;
    float* ssqp = part + 8 * 32 * 33;
    int* lcnt = (int*)(ssqp + 256); int* lbase = lcnt + 32; int* te = lbase + 32; int* trk = te + 256; float* tw = (float*)(trk + 256);
    const int tid = TID(), lane = tid & 63, wid = tid >> 6, i32 = lane & 31, kh = lane >> 5; const int tg = wid >> 2, kq = wid & 3;
    for (int item = BID(); item < 256; item += gridDim.x) {
        const int tok = item * 64 + tg * 32 + i32;
        if (tid < 32) lcnt[tid] = 0;
        f32x16 acc = (f32x16){}; float ss = 0.f;
        const float* hrow = H1 + (size_t)tok * 1024 + 256 * kq + 4 * kh; const float* lrow = ln2 + 256 * kq + 4 * kh; bf16_t* xrow = XN + (size_t)tok * 1024 + 256 * kq + 4 * kh;
        const float* wbase = wr_ + (size_t)(256 * kq + 4 * kh) * 32 + i32;
#pragma unroll 4
        for (int c = 0; c < 32; ++c) {
            const float4 hv = *(const float4*)(hrow + 8 * c); const float4 lv = *(const float4*)(lrow + 8 * c);
            ss += hv.x * hv.x + hv.y * hv.y + hv.z * hv.z + hv.w * hv.w;
            const float x0 = hv.x * lv.x, x1 = hv.y * lv.y, x2 = hv.z * lv.z, x3 = hv.w * lv.w;
            uint2 o; o.x = cvtpk(x0, x1); o.y = cvtpk(x2, x3); *(uint2*)(xrow + 8 * c) = o;
            const float* wp = wbase + (size_t)(8 * c) * 32;
            const float w0 = wp[0], w1 = wp[32], w2 = wp[64], w3 = wp[96];
            acc = __builtin_amdgcn_mfma_f32_32x32x2f32(x0, w0, acc, 0, 0, 0);
            acc = __builtin_amdgcn_mfma_f32_32x32x2f32(x1, w1, acc, 0, 0, 0);
            acc = __builtin_amdgcn_mfma_f32_32x32x2f32(x2, w2, acc, 0, 0, 0);
            acc = __builtin_amdgcn_mfma_f32_32x32x2f32(x3, w3, acc, 0, 0, 0);
        }
        ss = pair_sum(ss);
        if (kh == 0) ssqp[wid * 32 + i32] = ss;
#pragma unroll
        for (int r = 0; r < 16; ++r) part[(wid * 32 + crow(r, kh)) * 33 + i32] = acc[r];
        __syncthreads();
        if (tid < 64) {
            const int g_ = tid >> 5, i_ = tid & 31; const int w0_ = g_ * 4;
            const float sq = ssqp[(w0_ + 0) * 32 + i_] + ssqp[(w0_ + 1) * 32 + i_] + ssqp[(w0_ + 2) * 32 + i_] + ssqp[(w0_ + 3) * 32 + i_]; const float rstd = rsqrtf(sq * (1.f / 1024.f) + EPS);
            RSTD2[item * 64 + tid] = rstd;
            float lg[32];
#pragma unroll
            for (int e = 0; e < 32; ++e) lg[e] = (part[((w0_ + 0) * 32 + i_) * 33 + e] + part[((w0_ + 1) * 32 + i_) * 33 + e] + part[((w0_ + 2) * 32 + i_) * 33 + e] + part[((w0_ + 3) * 32 + i_) * 33 + e]) * rstd + br[e];
            unsigned taken = 0u; float tv[4]; int ti[4];
#pragma unroll
            for (int k = 0; k < 4; ++k) { float best = -3.0e38f; int bi = 0;
#pragma unroll
                for (int e = 0; e < 32; ++e) { const bool ok = !((taken >> e) & 1u) && lg[e] > best; best = ok ? lg[e] : best; bi = ok ? e : bi; }
                taken |= 1u << bi; tv[k] = best; ti[k] = bi; }
            const float e1 = __expf(tv[1] - tv[0]), e2 = __expf(tv[2] - tv[0]), e3 = __expf(tv[3] - tv[0]); const float inv = 1.0f / (1.0f + e1 + e2 + e3);
            const float wv[4] = {inv, e1 * inv, e2 * inv, e3 * inv};
#pragma unroll
            for (int k = 0; k < 4; ++k) { const int idx = tid * 4 + k; te[idx] = ti[k]; trk[idx] = atomicAdd(&lcnt[ti[k]], 1); tw[idx] = wv[k]; }
        }
        __syncthreads();
        if (tid < 32) lbase[tid] = atomicAdd(&CNT[tid], lcnt[tid]);
        __syncthreads();
        if (tid < 256) { const int idx = tid; const int tk = item * 64 + (idx >> 2); const int e = te[idx]; const int slot = lbase[e] + trk[idx];
          TOPI[(size_t)tk * 4 + (idx & 3)] = e; TOPS[(size_t)tk * 4 + (idx & 3)] = slot; TOPW[(size_t)tk * 4 + (idx & 3)] = tw[idx];
          TOKOF[(size_t)e * 16384 + slot] = tk; ROWW[(size_t)e * 16384 + slot] = tw[idx]; }
        __syncthreads();
    }
}

struct MoeMap { int e, mt, nt, cnt, off; };
DEV void moe_setup(const Args& a, int* sm) {
    if (TID() == 0) { const int* CNT = (const int*)(a.ws + WS_CTL); int tot = 0; for (int e = 0; e < 32; ++e) { const int c = CNT[e]; const int mt = (c + 255) >> 8; sm[e] = mt; sm[32 + e] = tot; tot += mt; } sm[64] = tot; }
    __syncthreads();
}
DEV MoeMap moe_map(const Args& a, const int* sm, int item, int NT) {
    MoeMap mm; int e = 0;
#pragma unroll 1
    for (int i = 1; i < 32; ++i) if (item >= sm[32 + i] * NT) e = i;
    const int local = item - sm[32 + e] * NT; const int mte = sm[e];
    int mt_, nt_; patch_decode(local, mte, NT, mt_, nt_);
    mm.e = __builtin_amdgcn_readfirstlane(e); mm.mt = __builtin_amdgcn_readfirstlane(mt_); mm.nt = __builtin_amdgcn_readfirstlane(nt_);
    mm.cnt = __builtin_amdgcn_readfirstlane(((const int*)(a.ws + WS_CTL))[e]); mm.off = __builtin_amdgcn_readfirstlane(sm[32 + e] * 256); return mm;
}
DEV void phase_up(const Args& a, unsigned char* smem) {
    int* sm = (int*)(smem + MISC_OFF); int* tokb = sm + 128; float* rsdb = (float*)(tokb + 512);
    const bf16_t* XN = (const bf16_t*)(a.ws + WS_XN); const bf16_t* W = (const bf16_t*)(a.ws + WS_WUP); bf16_t* ACT = (bf16_t*)(a.ws + WS_ACT); const float* RSTD2 = (const float*)(a.ws + WS_RSTD2);
    const int* TOKOF = (const int*)(a.ws + WS_TOKOF); const float* bup = a.in[I_BUP];
    const int tid = TID(); int lane = tid & 63, wid = tid >> 6, wr = wid >> 2, wc = wid & 3; (void)wr; (void)wc; (void)lane;
    moe_setup(a, sm);
    const int nitems = __builtin_amdgcn_readfirstlane(sm[64]) * 8;
    auto fill = [&](const MoeMap& m_, int buf) { if (tid < 256) { const int slot = m_.mt * 256 + tid; const int tk_ = slot < m_.cnt ? TOKOF[(size_t)m_.e * 16384 + slot] : 0; tokb[buf * 256 + tid] = tk_; rsdb[buf * 256 + tid] = RSTD2[tk_]; } };
    auto boffu = [](int k, int nc) { const int ni = (nc >> 1) & 3; const int sc = ((ni >> 1) ? 1024 : 0) + (nc >> 3) * 32 + (ni & 1) * 16 + (nc & 1) * 8; return (unsigned)(k * 4096 + sc * 2); };
    int item = VBID(); int buf = 0; bool pre = false; MoeMap mm{};
    if (item < nitems) { mm = moe_map(a, sm, item, 8); fill(mm, 0); }
    __syncthreads();
    while (item < nitems) {
        const int nitem = item + (int)gridDim.x; const bool has_next = nitem < nitems; MoeMap mn{};
        if (has_next) { mn = moe_map(a, sm, nitem, 8); fill(mn, buf ^ 1); }
        const int* tok = tokb + buf * 256; const int* tokn = tokb + (buf ^ 1) * 256; const float* rsd = rsdb + buf * 256;
        const bf16_t* We = W + (size_t)mm.e * 1024 * 2048; const bf16_t* Wn = W + (size_t)mn.e * 1024 * 2048;
        f32x4 acc[8][4];
        gemm256<true>(smem, 16, XN, 128u, [&](int r, int kc) { return (unsigned)(tok[r] * 2048 + kc * 16); }, We + mm.nt * 128, 64u * 4096u, boffu, acc, pre,
                      [&]() { if (has_next) gemm256_issue0(smem, XN, [&](int r, int kc) { return (unsigned)(tokn[r] * 2048 + kc * 16); }, Wn + mn.nt * 128, boffu); });
        EPI_IDS();
#pragma unroll
        for (int mi = 0; mi < 8; ++mi) { const int rl_ = wr * 128 + mi * 16 + (lane & 15); const size_t row = (size_t)mm.off + mm.mt * 256 + rl_; const float rs_ = rsd[rl_];
#pragma unroll
            for (int ni = 0; ni < 2; ++ni) { const int jc = mm.nt * 128 + wc * 32 + ni * 16 + 4 * (lane >> 4);
                const float4 bg = *(const float4*)(bup + (size_t)mm.e * 2048 + jc), bl_ = *(const float4*)(bup + (size_t)mm.e * 2048 + 1024 + jc);
                const f32x4 gv = acc[mi][ni], lv = acc[mi][ni + 2]; const float bgv[4] = {bg.x, bg.y, bg.z, bg.w}, blv[4] = {bl_.x, bl_.y, bl_.z, bl_.w}; float r4[4];
#pragma unroll
                for (int r = 0; r < 4; ++r) { const float gg = fminf(gv[r] * rs_ + bgv[r], 7.0f); const float ll = fminf(fmaxf(lv[r] * rs_ + blv[r], -7.0f), 7.0f); r4[r] = gg * sigmoidf_(1.702f * gg) * (ll + 1.0f); }
                uint2 o; o.x = cvtpk(r4[0], r4[1]); o.y = cvtpk(r4[2], r4[3]); *(uint2*)(ACT + row * 1024 + jc) = o; } }
        __syncthreads();
        item = nitem; mm = mn; buf ^= 1; pre = has_next;
    }
}
DEV void phase_down(const Args& a, unsigned char* smem) {
    int* sm = (int*)(smem + MISC_OFF); float* rwb = (float*)(sm + 128);
    const bf16_t* ACT = (const bf16_t*)(a.ws + WS_ACT); const bf16_t* W = (const bf16_t*)(a.ws + WS_WDN); bf16_t* Y = (bf16_t*)(a.ws + WS_Y);
    const float* ROWW = (const float*)(a.ws + WS_ROWW); const float* bdn = a.in[I_BDN];
    const int tid = TID(); int lane = tid & 63, wid = tid >> 6, wr = wid >> 2, wc = wid & 3; (void)wr; (void)wc; (void)lane;
    moe_setup(a, sm);
    const int nitems = __builtin_amdgcn_readfirstlane(sm[64]) * 4;
    auto fill = [&](const MoeMap& m_, int buf) { if (tid < 256) { const int slot = m_.mt * 256 + tid; rwb[buf * 256 + tid] = slot < m_.cnt ? ROWW[(size_t)m_.e * 16384 + slot] : 0.f; } };
    auto aoffd = [](int r, int kc) { return (unsigned)(r * 2048 + kc * 16); }; auto boffd = [](int k, int nc) { return (unsigned)(k * 2048 + nc * 16); };
    int item = VBID(); int buf = 0; bool pre = false; MoeMap mm{};
    if (item < nitems) { mm = moe_map(a, sm, item, 4); fill(mm, 0); }
    __syncthreads();
    while (item < nitems) {
        const int nitem = item + (int)gridDim.x; const bool has_next = nitem < nitems; MoeMap mn{};
        if (has_next) { mn = moe_map(a, sm, nitem, 4); fill(mn, buf ^ 1); }
        const float* rw = rwb + buf * 256;
        const bf16_t* We = W + (size_t)mm.e * 1024 * 1024; const bf16_t* Ab = ACT + ((size_t)mm.off + mm.mt * 256) * 1024;
        const bf16_t* Wn = W + (size_t)mn.e * 1024 * 1024; const bf16_t* An = ACT + ((size_t)mn.off + mn.mt * 256) * 1024;
        f32x4 acc[8][4];
        gemm256<true>(smem, 16, Ab, 128u, aoffd, We + mm.nt * 256, 64u * 2048u, boffd, acc, pre,
                      [&]() { if (has_next) gemm256_issue0(smem, An, aoffd, Wn + mn.nt * 256, boffd); });
        EPI_IDS();
#pragma unroll
        for (int mi = 0; mi < 8; ++mi) { const int rl = wr * 128 + mi * 16 + (lane & 15); const size_t row = (size_t)mm.off + mm.mt * 256 + rl; const float w = rw[rl];
#pragma unroll
            for (int ni = 0; ni < 4; ++ni) { const int n = mm.nt * 256 + wc * 64 + ni * 16 + 4 * (lane >> 4); const float4 bb = *(const float4*)(bdn + (size_t)mm.e * 1024 + n); const f32x4 v = acc[mi][ni];
                uint2 o; o.x = cvtpk((v[0] + bb.x) * w, (v[1] + bb.y) * w); o.y = cvtpk((v[2] + bb.z) * w, (v[3] + bb.w) * w); *(uint2*)(Y + row * 1024 + n) = o; } }
        __syncthreads();
        item = nitem; mm = mn; buf ^= 1; pre = has_next;
    }
}

DEV void phase_comb(const Args& a, unsigned char* smem) {
    int* sm = (int*)(smem + MISC_OFF);
    moe_setup(a, sm);
    float* H1 = (float*)(a.ws + WS_H1); bf16_t* XN = (bf16_t*)(a.ws + WS_XN); const bf16_t* Y = (const bf16_t*)(a.ws + WS_Y);
    const int* TOPI = (const int*)(a.ws + WS_TOPI); const int* TOPS = (const int*)(a.ws + WS_TOPS); const float* g = a.in[I_LNPLE];
    const int lane = TID() & 63; const int gw = BID() * NWAVE + (TID() >> 6), ngw = gridDim.x * NWAVE;
    for (int tok = gw; tok < NTOK; tok += ngw) {
        float4 v[4];
#pragma unroll
        for (int j = 0; j < 4; ++j) v[j] = *(const float4*)(H1 + (size_t)tok * 1024 + j * 256 + lane * 4);
#pragma unroll
        for (int k = 0; k < 4; ++k) { const int e = TOPI[(size_t)tok * 4 + k]; const size_t row = (size_t)sm[32 + e] * 256 + TOPS[(size_t)tok * 4 + k];
#pragma unroll
            for (int j = 0; j < 4; ++j) { const uint2 u = *(const uint2*)(Y + row * 1024 + j * 256 + lane * 4); v[j].x += bflo(u.x); v[j].y += bfhi(u.x); v[j].z += bflo(u.y); v[j].w += bfhi(u.y); } }
        float s = 0.f;
#pragma unroll
        for (int j = 0; j < 4; ++j) { *(float4*)(H1 + (size_t)tok * 1024 + j * 256 + lane * 4) = v[j]; s += v[j].x * v[j].x + v[j].y * v[j].y + v[j].z * v[j].z + v[j].w * v[j].w; }
        const float rstd = rsqrtf(wave_sum(s) * (1.f / 1024.f) + EPS);
#pragma unroll
        for (int j = 0; j < 4; ++j) { const float4 gg = *(const float4*)(g + j * 256 + lane * 4);
            uint2 o; o.x = cvtpk(v[j].x * rstd * gg.x, v[j].y * rstd * gg.y); o.y = cvtpk(v[j].z * rstd * gg.z, v[j].w * rstd * gg.w); *(uint2*)(XN + (size_t)tok * 1024 + j * 256 + lane * 4) = o; }
    }
}

DEV void phase_gate(const Args& a, unsigned char* smem) {
    const bf16_t* XN = (const bf16_t*)(a.ws + WS_XN); const bf16_t* WG = (const bf16_t*)(a.ws + WS_WGATE); const bf16_t* PB = (const bf16_t*)(a.ws + WS_PB); const bf16_t* WP = (const bf16_t*)(a.ws + WS_WPLE);
    const float* H2 = (const float*)(a.ws + WS_H1); float* OUT = a.out; float* SSQ3 = (float*)(a.ws + WS_SSQ3);
    const int tid = TID(); int lane = tid & 63, wid = tid >> 6, wr = wid >> 2, wc = wid & 3; (void)wr; (void)wc; (void)lane;
    bf16_t* GT = (bf16_t*)(a.ws + WS_ACT);
    auto aoffg = [](int r, int kc) { return (unsigned)(r * 2048 + kc * 16); }; auto aoffp = [](int r, int kc) { return (unsigned)(r * 512 + kc * 16); }; auto boffg = [](int k, int nc) { return (unsigned)(k * 2048 + nc * 16); };
    for (int item = VBID(); item < 64 * 4; item += gridDim.x) {
        int mt, nt; patch_decode(item, 64, 4, mt, nt);
        f32x4 acc[8][4];
        gemm256<true>(smem, 16, XN + (size_t)mt * 256 * 1024, 128u, aoffg, WG + nt * 256, 64u * 2048u, boffg, acc, false,
                      [&]() { gemm256_issue0(smem, PB + (size_t)mt * 256 * 256, aoffp, WP + nt * 256, boffg); });
        EPI_IDS();
#pragma unroll
        for (int mi = 0; mi < 8; ++mi) { const size_t gm = (size_t)mt * 256 + wr * 128 + mi * 16 + (lane & 15);
#pragma unroll
            for (int ni = 0; ni < 4; ++ni) { const int n = nt * 256 + wc * 64 + ni * 16 + 4 * (lane >> 4); const f32x4 v = acc[mi][ni];
                uint2 w; w.x = cvtpk(sigmoidf_(v[0]), sigmoidf_(v[1])); w.y = cvtpk(sigmoidf_(v[2]), sigmoidf_(v[3])); *(uint2*)(GT + gm * 1024 + n) = w;
                const float4 h = *(const float4*)(H2 + gm * 1024 + n);
                acc[mi][ni] = (f32x4){h.x * __builtin_amdgcn_rcpf(bflo(w.x)), h.y * __builtin_amdgcn_rcpf(bfhi(w.x)), h.z * __builtin_amdgcn_rcpf(bflo(w.y)), h.w * __builtin_amdgcn_rcpf(bfhi(w.y))}; }
            asm volatile("" ::: "memory"); }
        gemm256<false>(smem, 4, PB + (size_t)mt * 256 * 256, 128u, aoffp, WP + nt * 256, 64u * 2048u, boffg, acc, true);
        EPI_IDS();
        const bool fused = gridDim.x >= 256;
#pragma unroll
        for (int mi = 0; mi < 8; ++mi) { const size_t gm = (size_t)mt * 256 + wr * 128 + mi * 16 + (lane & 15); float ss = 0.f;
#pragma unroll
            for (int ni = 0; ni < 4; ++ni) { const int n = nt * 256 + wc * 64 + ni * 16 + 4 * (lane >> 4); const f32x4 v = acc[mi][ni];
                const uint2 gw = *(const uint2*)(GT + gm * 1024 + n);
                float4 o = {v[0] * bflo(gw.x), v[1] * bfhi(gw.x), v[2] * bflo(gw.y), v[3] * bfhi(gw.y)};
                if (!fused) *(float4*)(OUT + gm * 1024 + n) = o;
                acc[mi][ni] = (f32x4){o.x, o.y, o.z, o.w};
                ss += o.x * o.x + o.y * o.y + o.z * o.z + o.w * o.w; }
            ss += __shfl_xor(ss, 16); ss += __shfl_xor(ss, 32);
            if (lane < 16) SSQ3[gm * 16 + nt * 4 + wc] = ss;
            asm volatile("" ::: "memory"); }
        if (fused) {
            unsigned* flag = (unsigned*)(a.ws + WS_CTL) + CW_GATEFLAG + mt;
            signal_done(flag); wait_flag(flag, 4u);
            const float* lnf = a.in[I_LNF];
#pragma unroll
            for (int mi = 0; mi < 8; ++mi) { const size_t gm = (size_t)mt * 256 + wr * 128 + mi * 16 + (lane & 15);
                const float4 s0 = *(const float4*)(SSQ3 + gm * 16), s1 = *(const float4*)(SSQ3 + gm * 16 + 4), s2 = *(const float4*)(SSQ3 + gm * 16 + 8), s3 = *(const float4*)(SSQ3 + gm * 16 + 12);
                const float tot = ((s0.x + s0.y) + (s0.z + s0.w)) + ((s1.x + s1.y) + (s1.z + s1.w)) + ((s2.x + s2.y) + (s2.z + s2.w)) + ((s3.x + s3.y) + (s3.z + s3.w));
                const float rstd = rsqrtf(tot * (1.f / 1024.f) + EPS);
#pragma unroll
                for (int ni = 0; ni < 4; ++ni) { const int n = nt * 256 + wc * 64 + ni * 16 + 4 * (lane >> 4); const float4 gg = *(const float4*)(lnf + n); const f32x4 v = acc[mi][ni];
                    float4 o = {v[0] * rstd * gg.x, v[1] * rstd * gg.y, v[2] * rstd * gg.z, v[3] * rstd * gg.w}; *(float4*)(OUT + gm * 1024 + n) = o; }
                asm volatile("" ::: "memory"); }
        }
        __syncthreads();
    }
}

DEV void phase_final(const Args& a) {
    if (gridDim.x >= 256) return;
    float* OUT = a.out; const float* SSQ3 = (const float*)(a.ws + WS_SSQ3); const float* g = a.in[I_LNF];
    const int lane = TID() & 63; const int gw = BID() * NWAVE + (TID() >> 6), ngw = gridDim.x * NWAVE;
    for (int m = gw; m < NTOK; m += ngw) {
        float s = 0.f;
#pragma unroll
        for (int j = 0; j < 16; ++j) s += SSQ3[(size_t)m * 16 + j];
        const float rstd = rsqrtf(s * (1.f / 1024.f) + EPS);
#pragma unroll
        for (int j = 0; j < 4; ++j) { float4 v = *(const float4*)(OUT + (size_t)m * 1024 + j * 256 + lane * 4); const float4 gg = *(const float4*)(g + j * 256 + lane * 4);
            v.x *= rstd * gg.x; v.y *= rstd * gg.y; v.z *= rstd * gg.z; v.w *= rstd * gg.w; *(float4*)(OUT + (size_t)m * 1024 + j * 256 + lane * 4) = v; }
    }
}

template <int PH> DEV void run_phase(const Args& a, unsigned char* smem) {
    if constexpr (PH == PH_PRO) phase_prologue(a, smem);
    else if constexpr (PH == PH_INPROJ) phase_inproj(a, smem);
    else if constexpr (PH == PH_ATT) phase_att(a, smem);
    else if constexpr (PH == PH_OUTPROJ) phase_outproj(a, smem);
    else if constexpr (PH == PH_ROUTE) phase_route(a, smem);
    else if constexpr (PH == PH_UP) phase_up(a, smem);
    else if constexpr (PH == PH_DOWN) phase_down(a, smem);
    else if constexpr (PH == PH_COMB) phase_comb(a, smem);
    else if constexpr (PH == PH_GATE) phase_gate(a, smem);
    else if constexpr (PH == PH_FINAL) phase_final(a);
}
#define XB_TMO      128
#define XB_XCNT(j)  (256  + 64 * (j))
#define XB_XSUB(j)  (1280 + 64 * (j))
#define XB_XGEN(j)  (2304 + 64 * (j))
#define XB_TOP      3328
#define XB_TOPGEN   3392
#define XCD_BAR_WORDS 3456
#define XB_SPIN_CAP (1u << 22)
DEV unsigned xb_ld(unsigned* p)              { return __hip_atomic_load(p, __ATOMIC_RELAXED, __HIP_MEMORY_SCOPE_AGENT); }
DEV unsigned xb_add(unsigned* p, unsigned v) { return __hip_atomic_fetch_add(p, v, __ATOMIC_RELAXED, __HIP_MEMORY_SCOPE_AGENT); }
DEV unsigned xb_xcc_id() { return (unsigned)__builtin_amdgcn_s_getreg((3 << 11) | 20) & 0xFu; }
#define XB_SPIN(cond, bar) do { unsigned _sp = 0; while (cond) { __builtin_amdgcn_s_sleep(1); \
    if ((++_sp & 255u) == 0u) { if (xb_ld(&(bar)[XB_TMO])) break; if (_sp > XB_SPIN_CAP) { atomicAdd(&(bar)[XB_TMO], 1u); break; } } } } while (0)
struct XcdBarrier { unsigned* bar; unsigned x; volatile LAS unsigned* st; };
DEV XcdBarrier xcd_barrier_post(unsigned* bar, volatile LAS unsigned* st) {
    XcdBarrier b; b.bar = bar; b.x = xb_xcc_id(); b.st = st;
    if (TID() == 0) (void)xb_add(&bar[XB_XCNT(b.x)], 1u);
    return b;
}
DEV void xcd_barrier_complete(unsigned* bar, unsigned x, unsigned& nloc, unsigned& nx) {
    const unsigned G = gridDim.x * gridDim.y * gridDim.z;
    unsigned sum, cnt, mine, sp = 0u;
    for (;;) {
        sum = 0u; cnt = 0u; mine = 0u;
#pragma unroll
        for (unsigned j = 0; j < 16; ++j) { const unsigned c = xb_ld(&bar[XB_XCNT(j)]); sum += c; cnt += (c > 0u) ? 1u : 0u; mine = (j == x) ? c : mine; }
        if (sum == G) break;
        __builtin_amdgcn_s_sleep(1);
        if ((++sp & 255u) == 0u) { if (xb_ld(&bar[XB_TMO])) break; if (sp > XB_SPIN_CAP) { atomicAdd(&bar[XB_TMO], 1u); break; } }
    }
    nloc = mine > 0u ? mine : 1u; nx = cnt > 0u ? cnt : 1u;
}
DEV void xcd_barrier(const XcdBarrier& b) {
    asm volatile("s_waitcnt vmcnt(0)" ::: "memory");
    __syncthreads();
    if (TID() == 0) {
        unsigned* bar = b.bar;
        __builtin_amdgcn_s_waitcnt(0);
        unsigned nloc = b.st[0], nx = b.st[1];
        if (nloc == 0u) { xcd_barrier_complete(bar, b.x, nloc, nx); b.st[0] = nloc; b.st[1] = nx; }
        const unsigned old = xb_add(&bar[XB_XSUB(b.x)], 1u);
        const unsigned gen = old / nloc;
        if (old + 1u == (gen + 1u) * nloc) {
            __builtin_amdgcn_fence(__ATOMIC_RELEASE, "agent");
            asm volatile("s_waitcnt vmcnt(0)" ::: "memory");
            const unsigned og = xb_add(&bar[XB_TOP], 1u);
            const unsigned tg = og / nx;
            if (og + 1u == (tg + 1u) * nx) xb_add(&bar[XB_TOPGEN], 1u);
            else XB_SPIN(xb_ld(&bar[XB_TOPGEN]) == tg, bar);
            __builtin_amdgcn_fence(__ATOMIC_ACQUIRE, "agent");
            xb_add(&bar[XB_XGEN(b.x)], 1u);
            asm volatile("s_waitcnt vmcnt(0)" ::: "memory");
        } else {
            XB_SPIN(xb_ld(&bar[XB_XGEN(b.x)]) == gen, bar);
            __builtin_amdgcn_fence(__ATOMIC_ACQUIRE, "agent");
            asm volatile("s_waitcnt vmcnt(0)" ::: "memory");
        }
    }
    __syncthreads();
}

__global__ void __launch_bounds__(NTHR, 2) mega(Args a) {
    extern __shared__ __attribute__((aligned(16))) unsigned char smem[];
    volatile LAS unsigned* bst = (volatile LAS unsigned*)(LAS unsigned char*)(smem + MISC_OFF + 8000);
    if (TID() == 0) { bst[0] = 0u; bst[1] = 0u; }
    __syncthreads();
    const XcdBarrier bar = xcd_barrier_post((unsigned*)(a.ws + WS_CTL) + 4096, bst);
#define GSYNC() xcd_barrier(bar)
#define RUN(ph) do { run_phase<ph>(a, smem); if ((PROBE_DUP >> ph) & 1) { GSYNC(); run_phase<ph>(a, smem); } } while (0)
    RUN(PH_PRO); GSYNC();
    RUN(PH_INPROJ); GSYNC();
    RUN(PH_ATT); GSYNC();
    RUN(PH_OUTPROJ); GSYNC();
    RUN(PH_ROUTE); GSYNC();
    RUN(PH_UP); GSYNC();
    RUN(PH_DOWN); GSYNC();
    RUN(PH_COMB); GSYNC();
    RUN(PH_GATE);
    if (gridDim.x < 256) { GSYNC(); RUN(PH_FINAL); }
#undef RUN
#undef GSYNC
}

extern "C" void kernel_launch(void* const* d_in, const int* in_sizes, int n_in, void* d_out, int out_size, void* d_ws, size_t ws_size, hipStream_t stream) {
    static int grid = 0;
    if (grid == 0) {
        if (n_in != 25 || ws_size < WS_END) { fprintf(stderr, "kernel_launch: unexpected n_in %d / ws %zu\n", n_in, ws_size); grid = -1; return; }
        int dev = 0, cus = 0, per_cu = 0;
        (void)hipGetDevice(&dev); (void)hipDeviceGetAttribute(&cus, hipDeviceAttributeMultiprocessorCount, dev);
        (void)hipFuncSetAttribute((const void*)mega, hipFuncAttributeMaxDynamicSharedMemorySize, LDS_BYTES);
        (void)hipOccupancyMaxActiveBlocksPerMultiprocessor(&per_cu, (const void*)mega, NTHR, LDS_BYTES);
        if (per_cu < 1) { fprintf(stderr, "kernel_launch: occupancy query says %d blocks per CU\n", per_cu); grid = -1; return; }
        grid = cus;
    }
    if (grid < 0) return;
    (void)hipMemsetAsync((char*)d_ws + WS_CTL, 0, 65536, stream);
    Args a{};
    for (int i = 0; i < 25; ++i) a.in[i] = (const float*)d_in[i];
    a.out = (float*)d_out; a.ws = (unsigned char*)d_ws; a.ph_lo = 0; a.ph_hi = PH_N;
    void* args[] = {&a};
    hipError_t e = hipLaunchCooperativeKernel((const void*)mega, dim3(grid), dim3(NTHR), args, LDS_BYTES, stream);
    if (e != hipSuccess) fprintf(stderr, "cooperative launch failed: %s (grid %d)\n", hipGetErrorString(e), grid);
}
```

```cpp
#include <hip/hip_runtime.h>
#include <stdint.h>
#include <cstdio>

#define DEV __device__ __forceinline__
#define LAS __attribute__((address_space(3)))

typedef unsigned short bf16_t;
typedef short bf16x8 __attribute__((ext_vector_type(8)));
typedef short s16x4 __attribute__((ext_vector_type(4)));
typedef float f32x4 __attribute__((ext_vector_type(4)));
typedef float f32x16 __attribute__((ext_vector_type(16)));
typedef float f32x2_t __attribute__((ext_vector_type(2)));
typedef __bf16 bf16x2_t __attribute__((ext_vector_type(2)));

constexpr int NTHR = 512, NWAVE = 8;
constexpr int NTOK = 16384;
constexpr float EPS = 1e-6f;
constexpr float LOG2E = 1.4426950408889634f;
constexpr float QS = 0.125f * LOG2E;
constexpr int NWIN = 3072;

constexpr size_t MiB = 1u << 20;
constexpr size_t WS_CTL = 0;
constexpr size_t WS_WIN = 1 * MiB;
constexpr size_t WS_WOUT = 7 * MiB;
constexpr size_t WS_WGATE = 9 * MiB;
constexpr size_t WS_WPLE = 11 * MiB;
constexpr size_t WS_WC1 = 12 * MiB;
constexpr size_t WS_WC2 = 15 * MiB + 512 * 1024 + 262144;
constexpr size_t WS_BIAS1 = 15 * MiB + 512 * 1024 + 262144 + 131072;
constexpr size_t WS_KC = 14 * MiB;
constexpr size_t WS_HID = 14 * MiB + 512 * 1024;
constexpr size_t WS_GN = 16 * MiB;
constexpr size_t WS_LS = 18 * MiB;
constexpr size_t WS_CUM = 19 * MiB;
constexpr size_t WS_SSQ = 20 * MiB;
constexpr size_t WS_TOPI = 21 * MiB;
constexpr size_t WS_TOPS = 21 * MiB + 262144;
constexpr size_t WS_TOPW = 21 * MiB + 524288;
constexpr size_t WS_TOKOF = 22 * MiB;
constexpr size_t WS_ROWW = 24 * MiB;
constexpr size_t WS_SSQ3 = 26 * MiB;
constexpr size_t WS_RSTD2 = 27 * MiB;
constexpr size_t WS_PB = 28 * MiB;
constexpr size_t WS_XN = 36 * MiB;
constexpr size_t WS_PROJ = 68 * MiB;
constexpr size_t WS_ONSA = 160 * MiB;
constexpr size_t WS_OFOX = 176 * MiB;
constexpr size_t WS_H1 = 192 * MiB;
constexpr size_t WS_WUP = 256 * MiB;
constexpr size_t WS_WDN = 384 * MiB;
constexpr size_t WS_ACT = 448 * MiB;
constexpr size_t WS_Y = 592 * MiB;
constexpr size_t WS_END = 736 * MiB;

enum { PH_PRO = 0, PH_INPROJ, PH_CMP, PH_ATT, PH_OUTPROJ, PH_ROUTE, PH_UP, PH_DOWN, PH_COMB, PH_GATE, PH_FINAL, PH_N };
struct Args { const float* in[25]; float* out; unsigned char* ws; int ph_lo, ph_hi; };
enum { I_X = 0, I_P, I_LN1, I_WIN, I_BFG, I_WC1K, I_WC2K, I_PEK, I_WC1V, I_WC2V, I_PEV, I_GNN, I_GNF, I_WOUT, I_LN2, I_WR, I_BR,
       I_WUP, I_BUP, I_WDN, I_BDN, I_LNPLE, I_WPLE, I_WGATE, I_LNF };

DEV int BID() { int b = (int)blockIdx.x; asm volatile("" : "+s"(b)); return b; }
DEV int VBID() { const int g = (int)gridDim.x, b = BID(); return (g & 7) ? b : (b & 7) * (g >> 3) + (b >> 3); }
DEV int TID() { int t = (int)__builtin_amdgcn_workitem_id_x(); asm volatile("" : "+v"(t)); return t; }
DEV unsigned cvtpk(float lo, float hi) { f32x2_t v = {lo, hi}; bf16x2_t b = __builtin_convertvector(v, bf16x2_t); return __builtin_bit_cast(unsigned, b); }
DEV float bflo(unsigned u) { return __uint_as_float(u << 16); }
DEV float bfhi(unsigned u) { return __uint_as_float(u & 0xffff0000u); }
DEV float wave_sum(float v) {
#pragma unroll
    for (int o = 1; o < 64; o <<= 1) v += __shfl_xor(v, o);
    return v;
}
#define DPP_MOV(x, ctrl) __builtin_bit_cast(float, __builtin_amdgcn_update_dpp(0, __builtin_bit_cast(int, (x)), (ctrl), 0xF, 0xF, true))
DEV float pair_sum(float x) { return x + __shfl_xor(x, 32); }
DEV float pair_max(float x) { return fmaxf(x, __shfl_xor(x, 32)); }
DEV float quad_sum(float x) { x += DPP_MOV(x, 0xB1); x += DPP_MOV(x, 0x4E); return x; }
DEV float wave_max_u(float x) {
    x = fmaxf(x, DPP_MOV(x, 0xB1)); x = fmaxf(x, DPP_MOV(x, 0x4E)); x = fmaxf(x, DPP_MOV(x, 0x141)); x = fmaxf(x, DPP_MOV(x, 0x140));
    const float a = __builtin_bit_cast(float, __builtin_amdgcn_readlane(__builtin_bit_cast(int, x), 0)), b = __builtin_bit_cast(float, __builtin_amdgcn_readlane(__builtin_bit_cast(int, x), 16));
    const float c = __builtin_bit_cast(float, __builtin_amdgcn_readlane(__builtin_bit_cast(int, x), 32)), d = __builtin_bit_cast(float, __builtin_amdgcn_readlane(__builtin_bit_cast(int, x), 48));
    return fmaxf(fmaxf(a, b), fmaxf(c, d));
}
DEV float sigmoidf_(float x) { return 1.0f / (1.0f + __expf(-x)); }
DEV float logsigmoidf_(float x) { return fminf(x, 0.f) - log1pf(__expf(-fabsf(x))); }
DEV float gelu_tanh(float x) { const float u = 0.7978845608028654f * (x + 0.044715f * x * x * x); const float th = 1.0f - 2.0f / (__expf(2.0f * u) + 1.0f); return 0.5f * x * (1.0f + th); }
DEV s16x4 tr_read(const unsigned char* p) {
    typedef short v4i16_t __attribute__((ext_vector_type(4)));
    return __builtin_bit_cast(s16x4, __builtin_amdgcn_ds_read_tr16_b64_v4i16((LAS v4i16_t*)p));
}
DEV int crow(int r, int hi) { return (r & 3) + 8 * (r >> 2) + 4 * hi; }

constexpr int GL_STAGE = 65536;
constexpr int GEMM_LDS = 2 * GL_STAGE;
constexpr int MISC_OFF = GEMM_LDS;
constexpr int LDS_BYTES = GEMM_LDS + 8192;

DEV void glds16s(const void* sbase, unsigned voff, unsigned lds_dst) { unsigned keep;
    asm volatile("s_mov_b32 %0, m0\n\ts_mov_b32 m0, %3\n\ts_nop 0\n\tglobal_load_lds_dwordx4 %1, %2\n\ts_mov_b32 m0, %0" : "=&s"(keep) : "v"(voff), "s"(sbase), "s"(lds_dst) : "memory"); }

DEV const unsigned char* uptr(const void* p) { const unsigned long long v = (unsigned long long)p; const unsigned lo = __builtin_amdgcn_readfirstlane((unsigned)v), hi = __builtin_amdgcn_readfirstlane((unsigned)(v >> 32)); return (const unsigned char*)(((unsigned long long)hi << 32) | lo); }

struct NoNext { DEV void operator()() const {} };
template <class AO, class BO>
DEV void gemm256_issue0(unsigned char* smem, const void* abase, const AO& aoff, const void* bbase, const BO& boff) {
    const int tid = TID(), lane = tid & 63; const int wid = __builtin_amdgcn_readfirstlane(tid >> 6);
    const unsigned lds0 = (unsigned)(uintptr_t)smem; const unsigned char* ab_ = uptr(abase); const unsigned char* bb_ = uptr(bbase);
#pragma unroll
    for (int i = 0; i < 4; ++i) { const int p = wid + 8 * i; glds16s(ab_, aoff(8 * p + (lane >> 3), (lane & 7) ^ (lane >> 3)), (unsigned)__builtin_amdgcn_readfirstlane(lds0 + p * 1024)); }
#pragma unroll
    for (int i = 0; i < 4; ++i) { const int p = wid + 8 * i; const int k = 2 * p + (lane >> 5); const int f = (k & 3) + 4 * ((k >> 3) & 1);
        glds16s(bb_, boff(k, (lane & 31) ^ (f << 1)), (unsigned)__builtin_amdgcn_readfirstlane(lds0 + 32768 + p * 1024)); }
}
template <bool ZERO, class AO, class BO, class NX = NoNext>
DEV void gemm256(unsigned char* smem, int nkt, const void* abase, unsigned akstep, const AO& aoff, const void* bbase, unsigned bkstep, const BO& boff, f32x4 (&acc)[8][4], bool pre = false, const NX& next = NX()) {
    const int tid = TID(), lane = tid & 63; const int wid = __builtin_amdgcn_readfirstlane(tid >> 6); const int wr = wid >> 2, wc = wid & 3;
    if (ZERO) {
#pragma unroll
        for (int mi = 0; mi < 8; ++mi)
#pragma unroll
            for (int ni = 0; ni < 4; ++ni) acc[mi][ni] = (f32x4){0.f, 0.f, 0.f, 0.f};
    }
    const unsigned lds0 = (unsigned)(uintptr_t)smem;
    const unsigned char* abase_u = uptr(abase); const unsigned char* bbase_u = uptr(bbase); const unsigned akstep_u = __builtin_amdgcn_readfirstlane(akstep), bkstep_u = __builtin_amdgcn_readfirstlane(bkstep);
    unsigned ao[4], bo[4];
#pragma unroll
    for (int i = 0; i < 4; ++i) { const int p = wid + 8 * i; ao[i] = aoff(8 * p + (lane >> 3), (lane & 7) ^ (lane >> 3));
        const int k = 2 * p + (lane >> 5); const int f = (k & 3) + 4 * ((k >> 3) & 1); bo[i] = boff(k, (lane & 31) ^ (f << 1)); }
#define GL_ISSUE(kt, st) do { const unsigned char* ab_ = abase_u + (size_t)(kt) * akstep_u; const unsigned char* bb_ = bbase_u + (size_t)(kt) * bkstep_u; \
        _Pragma("unroll") for (int i_ = 0; i_ < 4; ++i_) glds16s(ab_, ao[i_], (unsigned)__builtin_amdgcn_readfirstlane(lds0 + (st) * GL_STAGE + (wid + 8 * i_) * 1024)); \
        _Pragma("unroll") for (int i_ = 0; i_ < 4; ++i_) glds16s(bb_, bo[i_], (unsigned)__builtin_amdgcn_readfirstlane(lds0 + (st) * GL_STAGE + 32768 + (wid + 8 * i_) * 1024)); } while (0)
    if (!pre) {
        GL_ISSUE(0, 0);
        asm volatile("s_waitcnt vmcnt(0)" ::: "memory");
        __syncthreads();
    }
    for (int kt = 0; kt < nkt; ++kt) {
        if (kt + 1 < nkt) GL_ISSUE(kt + 1, (kt + 1) & 1); else next();
        const unsigned char* A = smem + (kt & 1) * GL_STAGE; const unsigned char* Bt = A + 32768;
#pragma unroll
        for (int ks = 0; ks < 2; ++ks) {
            bf16x8 wf[4];
#pragma unroll
            for (int ni = 0; ni < 4; ++ni) {
                const int i = lane & 15, g = lane >> 4, q = i >> 2; const int row = ks * 32 + 8 * g + q; const int nc = wc * 8 + ni * 2 + ((i & 3) >> 1); const int f = q + 4 * (g & 1);
                const unsigned char* p = Bt + row * 512 + ((nc ^ (f << 1)) << 4) + (i & 1) * 8;
                const s16x4 lo = tr_read(p), hi = tr_read(p + 4 * 512);
                wf[ni] = (bf16x8){lo[0], lo[1], lo[2], lo[3], hi[0], hi[1], hi[2], hi[3]};
            }
#pragma unroll
            for (int mi = 0; mi < 8; ++mi) {
                const int m = wr * 128 + mi * 16 + (lane & 15); const int kc = ks * 4 + (lane >> 4);
                const bf16x8 af = *(const bf16x8*)(A + m * 128 + ((kc ^ (m & 7)) << 4));
#pragma unroll
                for (int ni = 0; ni < 4; ++ni) acc[mi][ni] = __builtin_amdgcn_mfma_f32_16x16x32_bf16(wf[ni], af, acc[mi][ni], 0, 0, 0);
            }
        }
        asm volatile("s_waitcnt vmcnt(0)" ::: "memory");
        __syncthreads();
    }
#undef GL_ISSUE
}

#define EPI_IDS() do { const int etid_ = TID(); lane = etid_ & 63; wid = etid_ >> 6; wr = wid >> 2; wc = wid & 3; } while (0)

DEV void patch_decode(int local, int MT, int NT, int& mt, int& nt) {
    const int per_mtb = 8 * NT; const int mtb = local / per_mtb; const int rem = local - mtb * per_mtb;
    const int rows = (MT - 8 * mtb) < 8 ? (MT - 8 * mtb) : 8;
    const int per_ntb = rows * 8; const int nfull = NT >> 3; int ntb = rem / per_ntb; int cols = 8;
    if (ntb >= nfull) { ntb = nfull; cols = NT - 8 * nfull; }
    const int r2 = rem - ntb * per_ntb;
    mt = 8 * mtb + r2 / cols; nt = 8 * ntb + r2 % cols;
}

DEV void convert_chunk(const float* src, bf16_t* dst, size_t i8) {
    const float4 a = *(const float4*)(src + i8 * 8), b = *(const float4*)(src + i8 * 8 + 4);
    uint4 o; o.x = cvtpk(a.x, a.y); o.y = cvtpk(a.z, a.w); o.z = cvtpk(b.x, b.y); o.w = cvtpk(b.z, b.w);
    *(uint4*)(dst + i8 * 8) = o;
}
DEV void phase_prologue(const Args& a, unsigned char* smem) {
    unsigned char* ws = a.ws;
    const size_t gtid = (size_t)BID() * NTHR + TID(), gn = (size_t)gridDim.x * NTHR;
    {
        { const float* W = a.in[I_WOUT]; bf16_t* O = (bf16_t*)(ws + WS_WOUT); const float* gnn = a.in[I_GNN]; const float* gnf = a.in[I_GNF];
          for (size_t i = gtid; i < (size_t)1024 * 128; i += gn) { const int k = (int)(i >> 7); const float g_ = k < 512 ? gnn[k] : gnf[k - 512];
              const float4 x = *(const float4*)(W + i * 8), y = *(const float4*)(W + i * 8 + 4);
              uint4 o; o.x = cvtpk(x.x * g_, x.y * g_); o.y = cvtpk(x.z * g_, x.w * g_); o.z = cvtpk(y.x * g_, y.y * g_); o.w = cvtpk(y.z * g_, y.w * g_); *(uint4*)(O + i * 8) = o; } }
        const float* srcs[3] = {a.in[I_WGATE], a.in[I_WPLE], a.in[I_P]};
        bf16_t* dsts[3] = {(bf16_t*)(ws + WS_WGATE), (bf16_t*)(ws + WS_WPLE), (bf16_t*)(ws + WS_PB)};
        const size_t cnt8[3] = {1024 * 1024 / 8, 256 * 1024 / 8, (size_t)NTOK * 256 / 8};
#pragma unroll
        for (int s = 0; s < 3; ++s) for (size_t i = gtid; i < cnt8[s]; i += gn) convert_chunk(srcs[s], dsts[s], i);
        for (size_t i = gtid; i < (size_t)2 * 2048 * 32; i += gn) { const int which = (int)(i / (2048 * 32)); const int k = (int)(i / 32) % 2048, c8 = (int)(i % 32) * 8;
            uint4 o = {0u, 0u, 0u, 0u};
            if (c8 < 128) { const float* W = a.in[which ? I_WC1V : I_WC1K] + (size_t)k * 128 + c8; const float4 x = *(const float4*)W, y = *(const float4*)(W + 4); o.x = cvtpk(x.x, x.y); o.y = cvtpk(x.z, x.w); o.z = cvtpk(y.x, y.y); o.w = cvtpk(y.z, y.w); }
            *(uint4*)((bf16_t*)(ws + WS_WC1) + i * 8) = o; }
        for (size_t i = gtid; i < (size_t)2 * 128 * 32; i += gn) { const int which = (int)(i / (128 * 32)); const int k = (int)(i / 32) % 128, c8 = (int)(i % 32) * 8;
            uint4 o = {0u, 0u, 0u, 0u};
            if (c8 < 64) { const float* W = a.in[which ? I_WC2V : I_WC2K] + (size_t)k * 64 + c8; const float4 x = *(const float4*)W, y = *(const float4*)(W + 4); o.x = cvtpk(x.x, x.y); o.y = cvtpk(x.z, x.w); o.z = cvtpk(y.x, y.y); o.w = cvtpk(y.z, y.w); }
            *(uint4*)((bf16_t*)(ws + WS_WC2) + i * 8) = o; }
    }
    {
        const float* W = a.in[I_WIN]; bf16_t* O = (bf16_t*)(ws + WS_WIN);
        for (size_t i = gtid; i < (size_t)1024 * (NWIN / 8); i += gn) {
            const int k = (int)(i / (NWIN / 8)), j = (int)(i % (NWIN / 8)) * 8;
            uint4 o = {0u, 0u, 0u, 0u};
            if (j < 2848) {
                const int sj = (j < 1280) ? j : (j < 2816) ? j + 24 : (j < 2840) ? j - 1536 : j;
                const float4 x = *(const float4*)(W + (size_t)k * 2848 + sj), y = *(const float4*)(W + (size_t)k * 2848 + sj + 4);
                o.x = cvtpk(x.x, x.y); o.y = cvtpk(x.z, x.w); o.z = cvtpk(y.x, y.y); o.w = cvtpk(y.z, y.w);
            }
            *(uint4*)(O + (size_t)k * NWIN + j) = o;
        }
    }
    const int lane = TID() & 63; const int gw = BID() * NWAVE + (TID() >> 6), ngw = gridDim.x * NWAVE;
    {
        const float* X = a.in[I_X]; const float* g = a.in[I_LN1]; bf16_t* XN = (bf16_t*)(ws + WS_XN);
        for (int m = gw; m < NTOK; m += ngw) {
            float4 v[4]; float s = 0.f;
#pragma unroll
            for (int j = 0; j < 4; ++j) { v[j] = *(const float4*)(X + (size_t)m * 1024 + j * 256 + lane * 4); s += v[j].x * v[j].x + v[j].y * v[j].y + v[j].z * v[j].z + v[j].w * v[j].w; }
            const float rstd = rsqrtf(wave_sum(s) * (1.f / 1024.f) + EPS);
#pragma unroll
            for (int j = 0; j < 4; ++j) { const float4 gg = *(const float4*)(g + j * 256 + lane * 4);
                uint2 o; o.x = cvtpk(v[j].x * rstd * gg.x, v[j].y * rstd * gg.y); o.y = cvtpk(v[j].z * rstd * gg.z, v[j].w * rstd * gg.w);
                *(uint2*)(XN + (size_t)m * 1024 + j * 256 + lane * 4) = o; }
        }
    }
    if (gw < 256) {
        const int which = gw >> 7, n = gw & 127; const float* pe = a.in[which ? I_PEV : I_PEK]; const float* w1 = a.in[which ? I_WC1V : I_WC1K];
        float s = 0.f;
#pragma unroll 8
        for (int i = 0; i < 32; ++i) { const int k = lane + 64 * i; s += pe[k] * w1[(size_t)k * 128 + n]; }
        s = wave_sum(s);
        if (lane == 0) ((float*)(ws + WS_BIAS1))[which * 128 + n] = s;
    }
}

DEV void phase_inproj(const Args& a, unsigned char* smem) {
    const bf16_t* XN = (const bf16_t*)(a.ws + WS_XN); const bf16_t* W = (const bf16_t*)(a.ws + WS_WIN);
    bf16_t* PROJ = (bf16_t*)(a.ws + WS_PROJ); float* GN = (float*)(a.ws + WS_GN); float* LS = (float*)(a.ws + WS_LS); const float* bfg = a.in[I_BFG];
    int lane = TID() & 63, wid = TID() >> 6, wr = wid >> 2, wc = wid & 3; (void)wr; (void)wc; (void)lane;
    bool pre = false;
    for (int item = VBID(); item < 64 * 12; item += gridDim.x) {
        int mt, nt; patch_decode(item, 64, 12, mt, nt);
        const int nitem = item + (int)gridDim.x; const bool has_next = nitem < 64 * 12; int mtn = 0, ntn = 0; if (has_next) patch_decode(nitem, 64, 12, mtn, ntn);
        f32x4 acc[8][4];
        gemm256<true>(smem, 16, XN + (size_t)mt * 256 * 1024, 128u, [&](int r, int kc) { return (unsigned)(r * 2048 + kc * 16); },
                      W + nt * 256, (unsigned)(64 * NWIN * 2), [&](int k, int nc) { return (unsigned)(k * (NWIN * 2) + nc * 16); }, acc, pre,
                      [&]() { if (has_next) gemm256_issue0(smem, XN + (size_t)mtn * 256 * 1024, [&](int r, int kc) { return (unsigned)(r * 2048 + kc * 16); }, W + ntn * 256, [&](int k, int nc) { return (unsigned)(k * (NWIN * 2) + nc * 16); }); });
        pre = has_next;
        EPI_IDS();
#pragma unroll
        for (int mi = 0; mi < 8; ++mi) {
            const int gm = mt * 256 + wr * 128 + mi * 16 + (lane & 15); const int b = gm >> 13, t = gm & 8191;
#pragma unroll
            for (int ni = 0; ni < 4; ++ni) {
                const int n = wc * 64 + ni * 16 + 4 * (lane >> 4); const f32x4 v = acc[mi][ni];
                if (nt < 11) {
                    const int hs = nt * 4 + wc, d = n & 63; const float sc = (hs < 8 || (hs >= 20 && hs < 28)) ? QS : 1.0f;
                    uint2 o; o.x = cvtpk(v[0] * sc, v[1] * sc); o.y = cvtpk(v[2] * sc, v[3] * sc);
                    *(uint2*)(PROJ + (((size_t)(hs * 2 + b)) * 8192 + t) * 64 + d) = o;
                } else if (n < 24) {
#pragma unroll
                    for (int r = 0; r < 4; ++r) GN[(size_t)gm * 24 + n + r] = sigmoidf_(v[r]);
                } else if (n < 32) {
#pragma unroll
                    for (int r = 0; r < 4; ++r) { const int h = n - 24 + r; LS[((size_t)(b * 8 + h)) * 8192 + t] = logsigmoidf_(v[r] + bfg[h]); }
                }
            }
        }
    }
}

DEV void signal_done(unsigned* flag) {
    asm volatile("s_waitcnt vmcnt(0)" ::: "memory");
    __syncthreads();
    if (TID() == 0) { __builtin_amdgcn_fence(__ATOMIC_RELEASE, "agent"); asm volatile("s_waitcnt vmcnt(0)" ::: "memory"); __hip_atomic_fetch_add(flag, 1u, __ATOMIC_RELAXED, __HIP_MEMORY_SCOPE_AGENT); }
}
DEV void wait_flag(unsigned* flag, unsigned target) {
    if (TID() == 0) { unsigned sp = 0u; while (__hip_atomic_load(flag, __ATOMIC_RELAXED, __HIP_MEMORY_SCOPE_AGENT) < target) { __builtin_amdgcn_s_sleep(4); if (++sp > (1u << 24)) break; }
        __builtin_amdgcn_fence(__ATOMIC_ACQUIRE, "agent"); asm volatile("s_waitcnt vmcnt(0)" ::: "memory"); }
    __syncthreads();
}
constexpr int CW_CUMFLAG = 128, CW_CMPFLAG = 192, CW_GATEFLAG = 256;
DEV void cmp_item(const Args& a, unsigned char* smem, int item) {
    const bf16_t* PROJ = (const bf16_t*)(a.ws + WS_PROJ);
    const int tid = TID(); int lane = tid & 63, wid = tid >> 6, wr = wid >> 2, wc = wid & 3; (void)wr; (void)wc; (void)lane;
    {
        if (item < 16) {
            const int which = item >> 3, b = (item >> 2) & 1, g = (item >> 1) & 1, mt = item & 1;
            const bf16_t* base = PROJ + ((size_t)((8 + 2 * which + g) * 2 + b)) * 8192 * 64;
            const bf16_t* W1 = (const bf16_t*)(a.ws + WS_WC1) + (size_t)which * 2048 * 256;
            const bf16_t* W2 = (const bf16_t*)(a.ws + WS_WC2) + (size_t)which * 128 * 256;
            const float* bias1 = (const float*)(a.ws + WS_BIAS1) + which * 128;
            bf16_t* HID = (bf16_t*)(a.ws + WS_HID) + ((size_t)(which * 4 + b * 2 + g)) * 512 * 128;
            bf16_t* OUT = (bf16_t*)(a.ws + WS_KC) + ((size_t)(which * 4 + b * 2 + g)) * 512 * 64;
            f32x4 acc[8][4];
            gemm256<true>(smem, 32, base, 128u, [&](int r, int kc) { int c = mt * 256 + r; c = c > 510 ? 510 : c; return (unsigned)(c * 2048 + kc * 16); },
                          W1, 64u * 512u, [&](int k, int nc) { return (unsigned)(k * 512 + nc * 16); }, acc);
        EPI_IDS();
            if (wc < 2) {
#pragma unroll
                for (int mi = 0; mi < 8; ++mi) { const int c = mt * 256 + wr * 128 + mi * 16 + (lane & 15);
#pragma unroll
                    for (int ni = 0; ni < 4; ++ni) { const int n = wc * 64 + ni * 16 + 4 * (lane >> 4); const f32x4 v = acc[mi][ni]; const float4 bb = *(const float4*)(bias1 + n);
                        uint2 o; o.x = cvtpk(gelu_tanh(v[0] + bb.x), gelu_tanh(v[1] + bb.y)); o.y = cvtpk(gelu_tanh(v[2] + bb.z), gelu_tanh(v[3] + bb.w));
                        *(uint2*)(HID + (size_t)c * 128 + n) = o; } }
            }
            __syncthreads();
            gemm256<true>(smem, 2, HID + (size_t)mt * 256 * 128, 128u, [&](int r, int kc) { return (unsigned)(r * 256 + kc * 16); },
                          W2, 64u * 512u, [&](int k, int nc) { return (unsigned)(k * 512 + nc * 16); }, acc);
        EPI_IDS();
            if (wc == 0) {
#pragma unroll
                for (int mi = 0; mi < 8; ++mi) { const int c = mt * 256 + wr * 128 + mi * 16 + (lane & 15);
#pragma unroll
                    for (int ni = 0; ni < 4; ++ni) { const int n = ni * 16 + 4 * (lane >> 4); const f32x4 v = acc[mi][ni];
                        uint2 o; o.x = cvtpk(v[0], v[1]); o.y = cvtpk(v[2], v[3]);
                        if (c >= 511) { o.x = 0u; o.y = 0u; }
                        *(uint2*)(OUT + (size_t)c * 64 + n) = o; } }
            }
            signal_done((unsigned*)(a.ws + WS_CTL) + CW_CMPFLAG);
        } else {
            const int bh = item - 16; const float* LS = (const float*)(a.ws + WS_LS) + (size_t)bh * 8192; float* CUM = (float*)(a.ws + WS_CUM) + (size_t)bh * 8192;
            float* sc = (float*)smem;
            float v[16]; float s = 0.f;
#pragma unroll
            for (int j = 0; j < 4; ++j) { const float4 x = *(const float4*)(LS + tid * 16 + j * 4); v[4 * j] = x.x; v[4 * j + 1] = x.y; v[4 * j + 2] = x.z; v[4 * j + 3] = x.w; }
#pragma unroll
            for (int j = 0; j < 16; ++j) { s += v[j]; v[j] = s; }
            sc[tid] = s; __syncthreads();
            if (tid == 0) { float run = 0.f; for (int i = 0; i < NTHR; ++i) { const float x = sc[i]; sc[i] = run; run += x; } }
            __syncthreads();
            const float off = sc[tid];
#pragma unroll
            for (int j = 0; j < 4; ++j) { float4 o = {v[4 * j] + off, v[4 * j + 1] + off, v[4 * j + 2] + off, v[4 * j + 3] + off}; *(float4*)(CUM + tid * 16 + j * 4) = o; }
            signal_done((unsigned*)(a.ws + WS_CTL) + CW_CUMFLAG + bh);
        }
    }
}

constexpr int AT_STAGE = 16384;
constexpr int AT_BIAS_OFF = 3 * AT_STAGE;
constexpr int AT_IMP_OFF = AT_BIAS_OFF + 1024;
constexpr int AT_SEL_OFF = AT_IMP_OFF + 65536;
constexpr int AT_WUN_OFF = AT_SEL_OFF + 1024;
constexpr int AT_UCNT_OFF = AT_WUN_OFF + 128;
constexpr int AT_ULIST_OFF = AT_UCNT_OFF + 16;
constexpr int AT_ITEM_OFF = AT_ULIST_OFF + 128;
static_assert(AT_ITEM_OFF + 16 <= GEMM_LDS, "attention LDS map");
#define NEG_INF (-__builtin_inff())

#define KV_DECL uint4 rk0_, rv0_
#define KV_GLOAD(Kt, Vt) do { rk0_ = *(const uint4*)((Kt) + tid * 8); rv0_ = *(const uint4*)((Vt) + tid * 8); } while (0)
#define KV_LSTORE(stp) do { unsigned char* st_ = (stp); const int key = tid >> 3, ch = tid & 7; \
      *(uint4*)(st_ + key * 128 + ((ch ^ (key & 7)) << 4)) = rk0_; \
      *(uint4*)(st_ + 8192 + key * 128 + ((((ch >> 2) ^ ((key >> 1) & 1))) << 6) + ((ch & 3) << 4)) = rv0_; } while (0)
template <bool FULL>
DEV void qk_tile(const unsigned char* Kst, const bf16x8 (&qf)[4], f32x16& p0, f32x16& p1, int lane) {
    const int key = lane & 31, hi = lane >> 5;
    if (FULL) {
        bf16x8 k0[4], k1[4];
#pragma unroll
        for (int ks = 0; ks < 4; ++ks) { const int ch = 2 * ks + hi; const int off = key * 128 + ((ch ^ (key & 7)) << 4);
            k0[ks] = *(const bf16x8*)(Kst + off); k1[ks] = *(const bf16x8*)(Kst + off + 32 * 128); }
        __builtin_amdgcn_sched_barrier(0);
#pragma unroll
        for (int ks = 0; ks < 4; ++ks) {
            p0 = __builtin_amdgcn_mfma_f32_32x32x16_bf16(k0[ks], qf[ks], p0, 0, 0, 0);
            p1 = __builtin_amdgcn_mfma_f32_32x32x16_bf16(k1[ks], qf[ks], p1, 0, 0, 0); }
    } else {
        bf16x8 kk[4];
#pragma unroll
        for (int ks = 0; ks < 4; ++ks) { const int ch = 2 * ks + hi; kk[ks] = *(const bf16x8*)(Kst + key * 128 + ((ch ^ (key & 7)) << 4)); }
        __builtin_amdgcn_sched_barrier(0);
#pragma unroll
        for (int ks = 0; ks < 4; ++ks) p0 = __builtin_amdgcn_mfma_f32_32x32x16_bf16(kk[ks], qf[ks], p0, 0, 0, 0);
        __builtin_amdgcn_sched_barrier(0);
#pragma unroll
        for (int ks = 0; ks < 4; ++ks) { const int ch = 2 * ks + hi; kk[ks] = *(const bf16x8*)(Kst + key * 128 + ((ch ^ (key & 7)) << 4) + 32 * 128); }
        __builtin_amdgcn_sched_barrier(0);
#pragma unroll
        for (int ks = 0; ks < 4; ++ks) p1 = __builtin_amdgcn_mfma_f32_32x32x16_bf16(kk[ks], qf[ks], p1, 0, 0, 0);
    }
}
template <bool FULL>
DEV void pv_tile(const unsigned char* Vst, const f32x16& p0, const f32x16& p1, f32x16 (&o)[2], int lane) {
    const int hi = lane >> 5, i = lane & 15, gg = (lane >> 4) & 1;
    const int q = i >> 2; const int sw = (q >> 1) & 1;
    bf16x8 pa[4];
#pragma unroll
    for (int s = 0; s < 4; ++s) { const f32x16& p = (s < 2) ? p0 : p1; const int b = (s & 1) * 8;
        unsigned w[4];
#pragma unroll
        for (int j = 0; j < 4; ++j) w[j] = cvtpk(p[b + 2 * j], p[b + 2 * j + 1]);
        typedef unsigned u32x4_t __attribute__((ext_vector_type(4)));
        u32x4_t ww = {w[0], w[1], w[2], w[3]}; pa[s] = __builtin_bit_cast(bf16x8, ww); }
    constexpr int NB = FULL ? 1 : 2, SB = FULL ? 4 : 2;
#pragma unroll
    for (int bt = 0; bt < NB; ++bt) {
        s16x4 vlo[SB][2], vhi[SB][2];
#pragma unroll
        for (int s_ = 0; s_ < SB; ++s_)
#pragma unroll
            for (int dh = 0; dh < 2; ++dh) { const int s = bt * SB + s_; const int row0 = 16 * s + 4 * hi + q;
                const unsigned char* p = Vst + row0 * 128 + ((dh ^ sw) << 6) + gg * 32 + (i & 3) * 8;
                vlo[s_][dh] = tr_read(p); vhi[s_][dh] = tr_read(p + 8 * 128); }
        __builtin_amdgcn_sched_barrier(0);
#pragma unroll
        for (int s_ = 0; s_ < SB; ++s_)
#pragma unroll
            for (int dh = 0; dh < 2; ++dh) { const int s = bt * SB + s_;
                const bf16x8 vf = {vlo[s_][dh][0], vlo[s_][dh][1], vlo[s_][dh][2], vlo[s_][dh][3], vhi[s_][dh][0], vhi[s_][dh][1], vhi[s_][dh][2], vhi[s_][dh][3]};
                o[dh] = __builtin_amdgcn_mfma_f32_32x32x16_bf16(vf, pa[s], o[dh], 0, 0, 0); }
        __builtin_amdgcn_sched_barrier(0);
    }
}
DEV float rowmax32(const f32x16& p0, const f32x16& p1) {
    float a = fmaxf(p0[0], p1[0]), b = fmaxf(p0[1], p1[1]);
#pragma unroll
    for (int r = 2; r < 16; r += 2) { a = fmaxf(fmaxf(a, p0[r]), p1[r]); b = fmaxf(fmaxf(b, p0[r + 1]), p1[r + 1]); }
    return pair_max(fmaxf(a, b));
}
DEV void softmax_step(f32x16& p0, f32x16& p1, float& m, float& l, f32x16 (&o)[2]) {
    const float mt = rowmax32(p0, p1); const float mn = fmaxf(m, mt); const float alpha = __builtin_amdgcn_exp2f(m - mn);
    float rs = 0.f;
#pragma unroll
    for (int r = 0; r < 16; ++r) { p0[r] = __builtin_amdgcn_exp2f(p0[r] - mn); p1[r] = __builtin_amdgcn_exp2f(p1[r] - mn); rs += p0[r] + p1[r]; }
    rs = pair_sum(rs);
    l = l * alpha + rs; m = mn;
    if (__any(alpha != 1.0f)) { o[0] *= alpha; o[1] *= alpha; }
}
template <int STRIDE> DEV void mask_tile(f32x16& p0, f32x16& p1, int kpos0, int lo, int hi_lim, int hi) {
#pragma unroll
    for (int r = 0; r < 16; ++r) { const int kp = kpos0 + STRIDE * crow(r, hi);
        if (kp < lo || kp > hi_lim) p0[r] = NEG_INF;
        const int kp1 = kp + 32 * STRIDE; if (kp1 < lo || kp1 > hi_lim) p1[r] = NEG_INF; }
}
template <int STRIDE> DEV void alibi_init(f32x16& p0, f32x16& p1, float slope2, int kpos0, int tref, int hi) {
    const float base = slope2 * (float)(kpos0 - tref + STRIDE * 4 * hi);
#pragma unroll
    for (int r = 0; r < 16; ++r) { const float c = (float)(STRIDE * ((r & 3) + 8 * (r >> 2))); p0[r] = fmaf(slope2, c, base); p1[r] = fmaf(slope2, c + (float)(32 * STRIDE), base); }
}
template <class Src, class Body>
DEV void kv_pipeline(unsigned char* smem, int n, const Src& src, const Body& body) {
    if (n <= 0) return;
    KV_DECL; const int tid = TID(); const bf16_t *kp, *vp;
    src(0, kp, vp); KV_GLOAD(kp, vp); KV_LSTORE(smem);
    __syncthreads();
    for (int j = 0; j < n; ++j) {
        const bool more = j + 1 < n;
        if (more) { src(j + 1, kp, vp); KV_GLOAD(kp, vp); }
        body(j, smem + (j & 1) * AT_STAGE);
        if (more) KV_LSTORE(smem + ((j + 1) & 1) * AT_STAGE);
        __syncthreads();
    }
}

constexpr int CV_PER_STEP = 373; constexpr int CV_NUP = 32 * 1024 * 2048 / 8, CV_NDN = 32 * 1024 * 1024 / 8;
static_assert((long long)33792 * CV_PER_STEP >= (long long)CV_NUP + CV_NDN, "conversion coverage");
DEV void fox_item(const Args& a, unsigned char* smem, int fi, int b, int h, int qb) {
    const int tid = TID(), lane = tid & 63, wid = tid >> 6, r32 = lane & 31, hi = lane >> 5;
    const bf16_t* PROJ = (const bf16_t*)(a.ws + WS_PROJ);
    const bf16_t* Q = PROJ + ((size_t)((20 + h) * 2 + b)) * 8192 * 64; const bf16_t* K = PROJ + ((size_t)((28 + h) * 2 + b)) * 8192 * 64; const bf16_t* V = PROJ + ((size_t)((36 + h) * 2 + b)) * 8192 * 64;
    const float* CUM = (const float*)(a.ws + WS_CUM) + (size_t)(b * 8 + h) * 8192;
    const int q0 = qb * 256; const int qrow = q0 + 32 * wid + r32;
    bf16x8 qf[4];
#pragma unroll
    for (int ks = 0; ks < 4; ++ks) qf[ks] = *(const bf16x8*)(Q + (size_t)qrow * 64 + 16 * ks + 8 * hi);
    const float cref = CUM[q0];
    const int ntiles = 4 * qb + 4; const int jmax_w = (q0 + 32 * wid + 31) >> 6; const int jmask_w = (q0 + 32 * wid) >> 6;
    f32x16 o[2]; o[0] = (f32x16){}; o[1] = (f32x16){}; float m = -1e30f, l = 0.f;
    float* biasL = (float*)(smem + AT_BIAS_OFF);
    const int gq_ = fi >> 4; const int sidx0 = 16 * (128 * gq_ - 2 * gq_ * (gq_ - 1)) + (fi & 15) * (128 - 4 * gq_);
    bf16_t* cvdA = nullptr; bf16_t* cvdB = nullptr; float4 cvaA, cvbA, cvaB, cvbB;
    KV_DECL; float breg = 0.f;
#define TJ(s_) (ntiles - 1 - (s_))
    KV_GLOAD(K + (size_t)TJ(0) * 4096, V + (size_t)TJ(0) * 4096); if (tid < 64) breg = (cref - CUM[TJ(0) * 64 + tid]) * LOG2E;
    KV_LSTORE(smem); if (tid < 64) biasL[tid] = breg;
    KV_GLOAD(K + (size_t)TJ(1) * 4096, V + (size_t)TJ(1) * 4096); if (tid < 64) breg = (cref - CUM[TJ(1) * 64 + tid]) * LOG2E;
    KV_LSTORE(smem + AT_STAGE); if (tid < 64) biasL[64 + tid] = breg;
    __syncthreads();
#define FOX_QK(P0, P1, jj, sj) do { const float* bl_ = biasL + (sj) * 64; \
        _Pragma("unroll") for (int g4 = 0; g4 < 4; ++g4) { const float4 x_ = *(const float4*)(bl_ + 8 * g4 + 4 * hi), y_ = *(const float4*)(bl_ + 32 + 8 * g4 + 4 * hi); \
            P0[4 * g4] = x_.x; P0[4 * g4 + 1] = x_.y; P0[4 * g4 + 2] = x_.z; P0[4 * g4 + 3] = x_.w; P1[4 * g4] = y_.x; P1[4 * g4 + 1] = y_.y; P1[4 * g4 + 2] = y_.z; P1[4 * g4 + 3] = y_.w; } \
        qk_tile<true>(smem + (sj) * AT_STAGE, qf, P0, P1, lane); \
        if ((jj) >= jmask_w) mask_tile<1>(P0, P1, 64 * (jj), -1, qrow, hi); } while (0)
#define FOX_STEP(CUR0, CUR1, NXT0, NXT1, j, CVD_LD, CVA_LD, CVB_LD, CVD_ST, CVA_ST, CVB_ST) do { \
        const int s_cur = (j) % 3, s_nxt = ((j) + 1) % 3, s_ld = ((j) + 2) % 3; const bool more_ = (j) + 2 < ntiles; \
        if (more_) { KV_GLOAD(K + (size_t)TJ((j) + 2) * 4096, V + (size_t)TJ((j) + 2) * 4096); if (tid < 64) breg = (cref - CUM[TJ((j) + 2) * 64 + tid]) * LOG2E; } \
        { const int c_ = (sidx0 + (j)) * CV_PER_STEP + tid; CVD_LD = nullptr; \
          if (tid < CV_PER_STEP && c_ < CV_NUP + CV_NDN) { const float* cvs_; if (c_ < CV_NUP) { cvs_ = a.in[I_WUP] + (size_t)c_ * 8; CVD_LD = (bf16_t*)(a.ws + WS_WUP) + (size_t)c_ * 8; } else { cvs_ = a.in[I_WDN] + (size_t)(c_ - CV_NUP) * 8; CVD_LD = (bf16_t*)(a.ws + WS_WDN) + (size_t)(c_ - CV_NUP) * 8; } \
              CVA_LD = *(const float4*)cvs_; CVB_LD = *(const float4*)(cvs_ + 4); } } \
        if ((j) + 1 < ntiles && TJ((j) + 1) <= jmax_w) FOX_QK(NXT0, NXT1, TJ((j) + 1), s_nxt); \
        __builtin_amdgcn_sched_barrier(0); \
        if (TJ(j) <= jmax_w) { softmax_step(CUR0, CUR1, m, l, o); pv_tile<false>(smem + s_cur * AT_STAGE + 8192, CUR0, CUR1, o, lane); } \
        if (more_) { KV_LSTORE(smem + s_ld * AT_STAGE); if (tid < 64) biasL[s_ld * 64 + tid] = breg; } \
        if (CVD_ST) { uint4 o_; o_.x = cvtpk(CVA_ST.x, CVA_ST.y); o_.y = cvtpk(CVA_ST.z, CVA_ST.w); o_.z = cvtpk(CVB_ST.x, CVB_ST.y); o_.w = cvtpk(CVB_ST.z, CVB_ST.w); *(uint4*)CVD_ST = o_; CVD_ST = nullptr; } \
        __syncthreads(); } while (0)
    f32x16 pA0, pA1, pB0, pB1;
    if (TJ(0) <= jmax_w) FOX_QK(pA0, pA1, TJ(0), 0);
    for (int j = 0; j < ntiles; j += 2) {
        FOX_STEP(pA0, pA1, pB0, pB1, j, cvdA, cvaA, cvbA, cvdB, cvaB, cvbB);
        FOX_STEP(pB0, pB1, pA0, pA1, j + 1, cvdB, cvaB, cvbB, cvdA, cvaA, cvbA);
    }
    if (cvdB) { uint4 o_; o_.x = cvtpk(cvaB.x, cvaB.y); o_.y = cvtpk(cvaB.z, cvaB.w); o_.z = cvtpk(cvbB.x, cvbB.y); o_.w = cvtpk(cvbB.z, cvbB.w); *(uint4*)cvdB = o_; }
#undef FOX_QK
#undef FOX_STEP
#undef TJ
    const float inv = 1.0f / l; float ss = 0.f;
    const size_t token = (size_t)b * 8192 + qrow;
    bf16_t* O = (bf16_t*)(a.ws + WS_OFOX) + token * 512 + h * 64;
#pragma unroll
    for (int dh = 0; dh < 2; ++dh)
#pragma unroll
        for (int g4 = 0; g4 < 4; ++g4) { const float v0 = o[dh][4 * g4] * inv, v1 = o[dh][4 * g4 + 1] * inv, v2 = o[dh][4 * g4 + 2] * inv, v3 = o[dh][4 * g4 + 3] * inv;
            ss += v0 * v0 + v1 * v1 + v2 * v2 + v3 * v3; uint2 w; w.x = cvtpk(v0, v1); w.y = cvtpk(v2, v3); *(uint2*)(O + 32 * dh + 8 * g4 + 4 * hi) = w; }
    ss = pair_sum(ss);
    if (hi == 0) ((float*)(a.ws + WS_SSQ))[token * 16 + 8 + h] = ss;
}

DEV void nsa_item(const Args& a, unsigned char* smem, int b, int g, int tt) {
    const int tid = TID(), lane = tid & 63, wid = tid >> 6, col = lane & 31, hi = lane >> 5;
    const int t0 = tt * 64, tokw = col >> 2, r = col & 3, h = 4 * g + r; const int tokl = wid * 8 + tokw; const int t = t0 + tokl; const size_t token = (size_t)b * 8192 + t;
    const float slope2 = exp2f(-(float)(h + 1)) * LOG2E;
    const bf16_t* PROJ = (const bf16_t*)(a.ws + WS_PROJ);
    const float* GN = (const float*)(a.ws + WS_GN) + token * 24 + h * 3;
    const int cur = tt; const bool need_topk = cur > 15;
    bf16x8 qf[4];
    { const bf16_t* Q = PROJ + (((size_t)(h * 2 + b)) * 8192 + t) * 64;
#pragma unroll
      for (int ks = 0; ks < 4; ++ks) qf[ks] = *(const bf16x8*)(Q + 16 * ks + 8 * hi); }
    float* impw = (float*)(smem + AT_IMP_OFF) + wid * 2048; float* totw = impw + lane;
    unsigned* selmask = (unsigned*)(smem + AT_SEL_OFF); unsigned* wun = (unsigned*)(smem + AT_WUN_OFF); int* ucnt = (int*)(smem + AT_UCNT_OFF); unsigned char* ulist = smem + AT_ULIST_OFF;
    f32x16 o[2]; float m, l;
    const int tmin_w = t0 + wid * 8, tmax_w = tmin_w + 7;
    {
        const bf16_t* KC = (const bf16_t*)(a.ws + WS_KC) + ((size_t)(0 * 4 + b * 2 + g)) * 512 * 64; const bf16_t* VC = (const bf16_t*)(a.ws + WS_KC) + ((size_t)(1 * 4 + b * 2 + g)) * 512 * 64;
        const int ncv = t0 / 16 + 3; const int nct = (ncv + 63) >> 6;
        auto src = [&](int j, const bf16_t*& kp, const bf16_t*& vp) { kp = KC + (size_t)j * 4096; vp = VC + (size_t)j * 4096; };
        m = -1e30f; l = 0.f;
        kv_pipeline(smem, nct, src, [&](int j, const unsigned char* st) {
            const int kpos0 = 1024 * j + 31;
            if (kpos0 > tmax_w) return;
            f32x16 p0, p1; alibi_init<16>(p0, p1, slope2, kpos0, t0, hi);
            qk_tile<false>(st, qf, p0, p1, lane);
            if (kpos0 + 16 * 63 > tmin_w) mask_tile<16>(p0, p1, kpos0, -1, t, hi);
            const float mt = rowmax32(p0, p1); const float mn = fmaxf(m, mt); float rs = 0.f;
#pragma unroll
            for (int rr = 0; rr < 16; ++rr) rs += __builtin_amdgcn_exp2f(p0[rr] - mn) + __builtin_amdgcn_exp2f(p1[rr] - mn);
            rs = pair_sum(rs);
            l = l * __builtin_amdgcn_exp2f(m - mn) + rs; m = mn;
        });
        const float linv = l > 0.f ? 1.0f / l : 0.f;
        if (need_topk) { for (int i = lane; i < 8 * 129; i += 64) impw[i] = 0.f; }
        o[0] = (f32x16){}; o[1] = (f32x16){};
        kv_pipeline(smem, nct, src, [&](int j, const unsigned char* st) {
            const int kpos0 = 1024 * j + 31;
            if (kpos0 > tmax_w) return;
            f32x16 p0, p1; alibi_init<16>(p0, p1, slope2, kpos0, t0, hi);
            qk_tile<false>(st, qf, p0, p1, lane);
            if (kpos0 + 16 * 63 > tmin_w) mask_tile<16>(p0, p1, kpos0, -1, t, hi);
#pragma unroll
            for (int rr = 0; rr < 16; ++rr) { p0[rr] = __builtin_amdgcn_exp2f(p0[rr] - m) * linv; p1[rr] = __builtin_amdgcn_exp2f(p1[rr] - m) * linv; }
            if (need_topk) {
#pragma unroll
                for (int half = 0; half < 2; ++half)
#pragma unroll
                    for (int g4 = 0; g4 < 4; ++g4) { const f32x16& p = half ? p1 : p0;
                        float ms = (p[4 * g4] + p[4 * g4 + 1]) + (p[4 * g4 + 2] + p[4 * g4 + 3]); float ls = p[4 * g4 + 3];
                        ms = quad_sum(ms); ls = quad_sum(ls);
                        const int n = 16 * j + 8 * half + 2 * g4 + hi;
                        if (r == 0) { atomicAdd(&impw[tokw * 129 + n], ms); atomicAdd(&impw[tokw * 129 + n + 1], ls); } }
            }
            pv_tile<false>(st + 8192, p0, p1, o, lane);
        });
    }
    {
        unsigned un0 = 0u, un1 = 0u, un2 = 0u, un3 = 0u;
        if (need_topk) {
            for (int tk = 0; tk < 8; ++tk) {
                float v0 = impw[tk * 129 + lane], v1 = impw[tk * 129 + 64 + lane];
                v0 = (lane >= 1 && lane <= cur - 2) ? v0 : -1.0f; v1 = (lane + 64 <= cur - 2) ? v1 : -1.0f;
                unsigned m0 = 1u, m1 = 0u, m2 = 0u, m3 = 0u;
#define SETBIT(n_) do { const int n__ = (n_); const unsigned bit__ = 1u << (n__ & 31); const int w__ = n__ >> 5; if (w__ == 0) m0 |= bit__; else if (w__ == 1) m1 |= bit__; else if (w__ == 2) m2 |= bit__; else m3 |= bit__; } while (0)
                SETBIT(cur); SETBIT(cur - 1);
                for (int it = 0; it < 13; ++it) {
                    const float mx = wave_max_u(fmaxf(v0, v1));
                    const unsigned long long b0 = __ballot(v0 == mx);
                    int n;
                    if (b0) n = __ffsll((long long)b0) - 1; else { const unsigned long long b1 = __ballot(v1 == mx); n = 64 + __ffsll((long long)b1) - 1; }
                    if (lane == (n & 63)) { if (n < 64) v0 = -1.0f; else v1 = -1.0f; }
                    SETBIT(n);
                }
#undef SETBIT
                if (lane == 0) { unsigned* sm_ = selmask + (wid * 8 + tk) * 4; sm_[0] = m0; sm_[1] = m1; sm_[2] = m2; sm_[3] = m3; }
                un0 |= m0; un1 |= m1; un2 |= m2; un3 |= m3;
            }
        } else {
            const unsigned full = (2u << cur) - 1u;
            un0 = full;
            if (lane < 8) { unsigned* sm_ = selmask + (wid * 8 + lane) * 4; sm_[0] = full; sm_[1] = 0u; sm_[2] = 0u; sm_[3] = 0u; }
        }
        if (lane == 0) { wun[wid * 4] = un0; wun[wid * 4 + 1] = un1; wun[wid * 4 + 2] = un2; wun[wid * 4 + 3] = un3; }
        __syncthreads();
        if (tid == 0) { int c = 0;
            for (int w = 0; w < 4; ++w) { unsigned u = 0u; for (int ww = 0; ww < NWAVE; ++ww) u |= wun[ww * 4 + w]; for (int bb = 0; bb < 32; ++bb) if ((u >> bb) & 1u) ulist[c++] = (unsigned char)(w * 32 + bb); }
            ucnt[0] = c; }
        __syncthreads();
    }
    { const float g0 = GN[0];
#pragma unroll
      for (int rr = 0; rr < 16; ++rr) { totw[rr * 64] = o[0][rr] * g0; totw[(16 + rr) * 64] = o[1][rr] * g0; } }
    {
        const bf16_t* KS = PROJ + ((size_t)((12 + g) * 2 + b)) * 8192 * 64; const bf16_t* VS = PROJ + ((size_t)((14 + g) * 2 + b)) * 8192 * 64;
        const int nu = ucnt[0];
        m = -1e30f; l = 0.f; o[0] = (f32x16){}; o[1] = (f32x16){};
        kv_pipeline(smem, nu, [&](int j, const bf16_t*& kp, const bf16_t*& vp) { const int n = ulist[nu - 1 - j]; kp = KS + (size_t)n * 4096; vp = VS + (size_t)n * 4096; },
            [&](int j, const unsigned char* st) {
                const int n = ulist[nu - 1 - j];
                if (!((wun[wid * 4 + (n >> 5)] >> (n & 31)) & 1u)) return;
                const bool sel = (selmask[tokl * 4 + (n >> 5)] >> (n & 31)) & 1u;
                f32x16 p0, p1; alibi_init<1>(p0, p1, slope2, 64 * n, t0, hi);
                qk_tile<false>(st, qf, p0, p1, lane);
                if (n == cur || !__all(sel)) mask_tile<1>(p0, p1, 64 * n, -1, sel ? t : -1, hi);
                softmax_step(p0, p1, m, l, o);
                pv_tile<false>(st + 8192, p0, p1, o, lane);
            });
        const float g1 = GN[1] / fmaxf(l, 1e-30f);
#pragma unroll
        for (int rr = 0; rr < 16; ++rr) { totw[rr * 64] += o[0][rr] * g1; totw[(16 + rr) * 64] += o[1][rr] * g1; }
    }
    {
        const bf16_t* KW = PROJ + ((size_t)((16 + g) * 2 + b)) * 8192 * 64; const bf16_t* VW = PROJ + ((size_t)((18 + g) * 2 + b)) * 8192 * 64;
        const int jlo = (t0 - 511) > 0 ? ((t0 - 511) >> 6) : 0; const int jhi = cur;
        m = -1e30f; l = 0.f; o[0] = (f32x16){}; o[1] = (f32x16){};
        kv_pipeline(smem, jhi - jlo + 1, [&](int j, const bf16_t*& kp, const bf16_t*& vp) { kp = KW + (size_t)(jhi - j) * 4096; vp = VW + (size_t)(jhi - j) * 4096; },
            [&](int j, const unsigned char* st) {
                const int kpos0 = 64 * (jhi - j);
                if (kpos0 > tmax_w || kpos0 + 63 < tmin_w - 511) return;
                f32x16 p0, p1; alibi_init<1>(p0, p1, slope2, kpos0, t0, hi);
                qk_tile<false>(st, qf, p0, p1, lane);
                if (kpos0 < tmax_w - 511 || kpos0 + 63 > tmin_w) mask_tile<1>(p0, p1, kpos0, t - 511, t, hi);
                softmax_step(p0, p1, m, l, o);
                pv_tile<false>(st + 8192, p0, p1, o, lane);
            });
        const float g2 = GN[2] / fmaxf(l, 1e-30f);
#pragma unroll
        for (int rr = 0; rr < 16; ++rr) { o[0][rr] = totw[rr * 64] + o[0][rr] * g2; o[1][rr] = totw[(16 + rr) * 64] + o[1][rr] * g2; }
    }
    {
        float ss = 0.f; bf16_t* O = (bf16_t*)(a.ws + WS_ONSA) + token * 512 + h * 64;
#pragma unroll
        for (int dh = 0; dh < 2; ++dh)
#pragma unroll
            for (int g4 = 0; g4 < 4; ++g4) { const float v0 = o[dh][4 * g4], v1 = o[dh][4 * g4 + 1], v2 = o[dh][4 * g4 + 2], v3 = o[dh][4 * g4 + 3];
                ss += v0 * v0 + v1 * v1 + v2 * v2 + v3 * v3; uint2 w; w.x = cvtpk(v0, v1); w.y = cvtpk(v2, v3); *(uint2*)(O + 32 * dh + 8 * g4 + 4 * hi) = w; }
        ss = pair_sum(ss);
        if (hi == 0) ((float*)(a.ws + WS_SSQ))[token * 16 + h] = ss;
    }
}
#ifndef PROBE_DUP
#define PROBE_DUP 0
#endif
DEV void phase_att(const Args& a, unsigned char* smem) {
    int* qctr = (int*)(a.ws + WS_CTL) + 64; int* sitem = (int*)(smem + AT_ITEM_OFF);
    unsigned* ctl = (unsigned*)(a.ws + WS_CTL); unsigned* seen = (unsigned*)(smem + AT_ITEM_OFF + 8);
    if (TID() == 0) seen[0] = 0u;
    for (;;) {
        if (TID() == 0) sitem[0] = atomicAdd(qctr, 1);
        __syncthreads();
        const int item = sitem[0];
        __syncthreads();
        if (item >= 32 + 1024) break;
        if (item < 16) cmp_item(a, smem, 16 + item);
        else if (item < 32) cmp_item(a, smem, item - 16);
        else if (item < 32 + 512) { const int fi = item - 32; const int qb = 31 - (fi >> 4), bh = fi & 15; if (!((seen[0] >> bh) & 1u)) { wait_flag(ctl + CW_CUMFLAG + bh, 1u); if (TID() == 0) seen[0] |= 1u << bh; } fox_item(a, smem, fi, bh >> 3, bh & 7, qb); }
        else { const int idx = item - 32 - 512; const int tt = 127 - (idx >> 2), bg = idx & 3; if (!((seen[0] >> 16) & 1u)) { wait_flag(ctl + CW_CMPFLAG, 16u); if (TID() == 0) seen[0] |= 1u << 16; } nsa_item(a, smem, bg >> 1, bg & 1, tt); }
    }
}

DEV void phase_outproj(const Args& a, unsigned char* smem) {
    const bf16_t* ONSA = (const bf16_t*)(a.ws + WS_ONSA); const bf16_t* OFOX = (const bf16_t*)(a.ws + WS_OFOX); const float* SSQ = (const float*)(a.ws + WS_SSQ);
    const bf16_t* W = (const bf16_t*)(a.ws + WS_WOUT); float* H1 = (float*)(a.ws + WS_H1); const float* X = a.in[I_X];
    float* rs = (float*)(smem + MISC_OFF);
    const int tid = TID(); int lane = tid & 63, wid = tid >> 6, wr = wid >> 2, wc = wid & 3; (void)wr; (void)wc; (void)lane;
    auto aoffo = [](int r, int kc) { return (unsigned)(r * 1024 + kc * 16); }; auto boffo = [](int k, int nc) { return (unsigned)(k * 2048 + nc * 16); };
    for (int item = VBID(); item < 64 * 4; item += gridDim.x) {
        int mt, nt; patch_decode(item, 64, 4, mt, nt);
        gemm256_issue0(smem, ONSA + (size_t)mt * 256 * 512, aoffo, W + nt * 256, boffo);
        if (tid < 256) { const float* s_ = SSQ + (size_t)(mt * 256 + tid) * 16; float sn = 0.f, sf = 0.f;
#pragma unroll
            for (int j = 0; j < 8; ++j) { sn += s_[j]; sf += s_[8 + j]; }
            rs[tid * 2] = rsqrtf(sn * (1.f / 512.f) + EPS); rs[tid * 2 + 1] = rsqrtf(sf * (1.f / 512.f) + EPS); }
        asm volatile("s_waitcnt vmcnt(0)" ::: "memory");
        __syncthreads();
        f32x4 acc[8][4];
#pragma unroll
        for (int mi = 0; mi < 8; ++mi) { const size_t gm = (size_t)mt * 256 + wr * 128 + mi * 16 + (lane & 15);
#pragma unroll
            for (int ni = 0; ni < 4; ++ni) { const int n = nt * 256 + wc * 64 + ni * 16 + 4 * (lane >> 4); const float4 x = *(const float4*)(X + gm * 1024 + n); acc[mi][ni] = (f32x4){x.x, x.y, x.z, x.w}; } }
#pragma unroll
        for (int mi = 0; mi < 8; ++mi) { const float ri = 1.0f / rs[(wr * 128 + mi * 16 + (lane & 15)) * 2];
#pragma unroll
            for (int ni = 0; ni < 4; ++ni) acc[mi][ni] *= ri; }
        gemm256<false>(smem, 8, ONSA + (size_t)mt * 256 * 512, 128u, aoffo, W + nt * 256, 64u * 2048u, boffo, acc, true,
                       [&]() { gemm256_issue0(smem, OFOX + (size_t)mt * 256 * 512, aoffo, W + (size_t)512 * 1024 + nt * 256, boffo); });
        EPI_IDS();
#pragma unroll
        for (int mi = 0; mi < 8; ++mi) { const int rl = wr * 128 + mi * 16 + (lane & 15); const float rat = rs[rl * 2] / rs[rl * 2 + 1];
#pragma unroll
            for (int ni = 0; ni < 4; ++ni) acc[mi][ni] *= rat; }
        gemm256<false>(smem, 8, OFOX + (size_t)mt * 256 * 512, 128u, aoffo, W + (size_t)512 * 1024 + nt * 256, 64u * 2048u, boffo, acc, true);
        EPI_IDS();
#pragma unroll
        for (int mi = 0; mi < 8; ++mi) { const int rl = wr * 128 + mi * 16 + (lane & 15); const size_t gm = (size_t)mt * 256 + rl; const float rf = rs[rl * 2 + 1];
#pragma unroll
            for (int ni = 0; ni < 4; ++ni) { const int n = nt * 256 + wc * 64 + ni * 16 + 4 * (lane >> 4); const f32x4 v = acc[mi][ni] * rf;
                float4 o = {v[0], v[1], v[2], v[3]}; *(float4*)(H1 + gm * 1024 + n) = o; } }
        __syncthreads();
    }
}

DEV void phase_route(const Args& a, unsigned char* smem) {
    const float* H1 = (const float*)(a.ws + WS_H1); bf16_t* XN = (bf16_t*)(a.ws + WS_XN); float* RSTD2 = (float*)(a.ws + WS_RSTD2);
    const float* ln2 = a.in[I_LN2]; const float* wr_ = a.in[I_WR]; const float* br = a.in[I_BR];
    int* CNT = (int*)(a.ws + WS_CTL);
    int* TOPI = (int*)(a.ws + WS_TOPI); int* TOPS = (int*)(a.ws + WS_TOPS); float* TOPW = (float*)(a.ws + WS_TOPW);
    int* TOKOF = (int*)(a.ws + WS_TOKOF); float* ROWW = (float*)(a.ws + WS_ROWW);
    float* part = (float*)smem;
    float* ssqp = part + 8 * 32 * 33;
    int* lcnt = (int*)(ssqp + 256); int* lbase = lcnt + 32; int* te = lbase + 32; int* trk = te + 256; float* tw = (float*)(trk + 256);
    const int tid = TID(), lane = tid & 63, wid = tid >> 6, i32 = lane & 31, kh = lane >> 5; const int tg = wid >> 2, kq = wid & 3;
    for (int item = BID(); item < 256; item += gridDim.x) {
        const int tok = item * 64 + tg * 32 + i32;
        if (tid < 32) lcnt[tid] = 0;
        f32x16 acc = (f32x16){}; float ss = 0.f;
        const float* hrow = H1 + (size_t)tok * 1024 + 256 * kq + 4 * kh; const float* lrow = ln2 + 256 * kq + 4 * kh; bf16_t* xrow = XN + (size_t)tok * 1024 + 256 * kq + 4 * kh;
        const float* wbase = wr_ + (size_t)(256 * kq + 4 * kh) * 32 + i32;
#pragma unroll 4
        for (int c = 0; c < 32; ++c) {
            const float4 hv = *(const float4*)(hrow + 8 * c); const float4 lv = *(const float4*)(lrow + 8 * c);
            ss += hv.x * hv.x + hv.y * hv.y + hv.z * hv.z + hv.w * hv.w;
            const float x0 = hv.x * lv.x, x1 = hv.y * lv.y, x2 = hv.z * lv.z, x3 = hv.w * lv.w;
            uint2 o; o.x = cvtpk(x0, x1); o.y = cvtpk(x2, x3); *(uint2*)(xrow + 8 * c) = o;
            const float* wp = wbase + (size_t)(8 * c) * 32;
            const float w0 = wp[0], w1 = wp[32], w2 = wp[64], w3 = wp[96];
            acc = __builtin_amdgcn_mfma_f32_32x32x2f32(x0, w0, acc, 0, 0, 0);
            acc = __builtin_amdgcn_mfma_f32_32x32x2f32(x1, w1, acc, 0, 0, 0);
            acc = __builtin_amdgcn_mfma_f32_32x32x2f32(x2, w2, acc, 0, 0, 0);
            acc = __builtin_amdgcn_mfma_f32_32x32x2f32(x3, w3, acc, 0, 0, 0);
        }
        ss = pair_sum(ss);
        if (kh == 0) ssqp[wid * 32 + i32] = ss;
#pragma unroll
        for (int r = 0; r < 16; ++r) part[(wid * 32 + crow(r, kh)) * 33 + i32] = acc[r];
        __syncthreads();
        if (tid < 64) {
            const int g_ = tid >> 5, i_ = tid & 31; const int w0_ = g_ * 4;
            const float sq = ssqp[(w0_ + 0) * 32 + i_] + ssqp[(w0_ + 1) * 32 + i_] + ssqp[(w0_ + 2) * 32 + i_] + ssqp[(w0_ + 3) * 32 + i_]; const float rstd = rsqrtf(sq * (1.f / 1024.f) + EPS);
            RSTD2[item * 64 + tid] = rstd;
            float lg[32];
#pragma unroll
            for (int e = 0; e < 32; ++e) lg[e] = (part[((w0_ + 0) * 32 + i_) * 33 + e] + part[((w0_ + 1) * 32 + i_) * 33 + e] + part[((w0_ + 2) * 32 + i_) * 33 + e] + part[((w0_ + 3) * 32 + i_) * 33 + e]) * rstd + br[e];
            unsigned taken = 0u; float tv[4]; int ti[4];
#pragma unroll
            for (int k = 0; k < 4; ++k) { float best = -3.0e38f; int bi = 0;
#pragma unroll
                for (int e = 0; e < 32; ++e) { const bool ok = !((taken >> e) & 1u) && lg[e] > best; best = ok ? lg[e] : best; bi = ok ? e : bi; }
                taken |= 1u << bi; tv[k] = best; ti[k] = bi; }
            const float e1 = __expf(tv[1] - tv[0]), e2 = __expf(tv[2] - tv[0]), e3 = __expf(tv[3] - tv[0]); const float inv = 1.0f / (1.0f + e1 + e2 + e3);
            const float wv[4] = {inv, e1 * inv, e2 * inv, e3 * inv};
#pragma unroll
            for (int k = 0; k < 4; ++k) { const int idx = tid * 4 + k; te[idx] = ti[k]; trk[idx] = atomicAdd(&lcnt[ti[k]], 1); tw[idx] = wv[k]; }
        }
        __syncthreads();
        if (tid < 32) lbase[tid] = atomicAdd(&CNT[tid], lcnt[tid]);
        __syncthreads();
        if (tid < 256) { const int idx = tid; const int tk = item * 64 + (idx >> 2); const int e = te[idx]; const int slot = lbase[e] + trk[idx];
          TOPI[(size_t)tk * 4 + (idx & 3)] = e; TOPS[(size_t)tk * 4 + (idx & 3)] = slot; TOPW[(size_t)tk * 4 + (idx & 3)] = tw[idx];
          TOKOF[(size_t)e * 16384 + slot] = tk; ROWW[(size_t)e * 16384 + slot] = tw[idx]; }
        __syncthreads();
    }
}

struct MoeMap { int e, mt, nt, cnt, off; };
DEV void moe_setup(const Args& a, int* sm) {
    if (TID() == 0) { const int* CNT = (const int*)(a.ws + WS_CTL); int tot = 0; for (int e = 0; e < 32; ++e) { const int c = CNT[e]; const int mt = (c + 255) >> 8; sm[e] = mt; sm[32 + e] = tot; tot += mt; } sm[64] = tot; }
    __syncthreads();
}
DEV MoeMap moe_map(const Args& a, const int* sm, int item, int NT) {
    MoeMap mm; int e = 0;
#pragma unroll 1
    for (int i = 1; i < 32; ++i) if (item >= sm[32 + i] * NT) e = i;
    const int local = item - sm[32 + e] * NT; const int mte = sm[e];
    int mt_, nt_; patch_decode(local, mte, NT, mt_, nt_);
    mm.e = __builtin_amdgcn_readfirstlane(e); mm.mt = __builtin_amdgcn_readfirstlane(mt_); mm.nt = __builtin_amdgcn_readfirstlane(nt_);
    mm.cnt = __builtin_amdgcn_readfirstlane(((const int*)(a.ws + WS_CTL))[e]); mm.off = __builtin_amdgcn_readfirstlane(sm[32 + e] * 256); return mm;
}
DEV void phase_up(const Args& a, unsigned char* smem) {
    int* sm = (int*)(smem + MISC_OFF); int* tokb = sm + 128; float* rsdb = (float*)(tokb + 512);
    const bf16_t* XN = (const bf16_t*)(a.ws + WS_XN); const bf16_t* W = (const bf16_t*)(a.ws + WS_WUP); bf16_t* ACT = (bf16_t*)(a.ws + WS_ACT); const float* RSTD2 = (const float*)(a.ws + WS_RSTD2);
    const int* TOKOF = (const int*)(a.ws + WS_TOKOF); const float* bup = a.in[I_BUP];
    const int tid = TID(); int lane = tid & 63, wid = tid >> 6, wr = wid >> 2, wc = wid & 3; (void)wr; (void)wc; (void)lane;
    moe_setup(a, sm);
    const int nitems = __builtin_amdgcn_readfirstlane(sm[64]) * 8;
    auto fill = [&](const MoeMap& m_, int buf) { if (tid < 256) { const int slot = m_.mt * 256 + tid; const int tk_ = slot < m_.cnt ? TOKOF[(size_t)m_.e * 16384 + slot] : 0; tokb[buf * 256 + tid] = tk_; rsdb[buf * 256 + tid] = RSTD2[tk_]; } };
    auto boffu = [](int k, int nc) { const int ni = (nc >> 1) & 3; const int sc = ((ni >> 1) ? 1024 : 0) + (nc >> 3) * 32 + (ni & 1) * 16 + (nc & 1) * 8; return (unsigned)(k * 4096 + sc * 2); };
    int item = VBID(); int buf = 0; bool pre = false; MoeMap mm{};
    if (item < nitems) { mm = moe_map(a, sm, item, 8); fill(mm, 0); }
    __syncthreads();
    while (item < nitems) {
        const int nitem = item + (int)gridDim.x; const bool has_next = nitem < nitems; MoeMap mn{};
        if (has_next) { mn = moe_map(a, sm, nitem, 8); fill(mn, buf ^ 1); }
        const int* tok = tokb + buf * 256; const int* tokn = tokb + (buf ^ 1) * 256; const float* rsd = rsdb + buf * 256;
        const bf16_t* We = W + (size_t)mm.e * 1024 * 2048; const bf16_t* Wn = W + (size_t)mn.e * 1024 * 2048;
        f32x4 acc[8][4];
        gemm256<true>(smem, 16, XN, 128u, [&](int r, int kc) { return (unsigned)(tok[r] * 2048 + kc * 16); }, We + mm.nt * 128, 64u * 4096u, boffu, acc, pre,
                      [&]() { if (has_next) gemm256_issue0(smem, XN, [&](int r, int kc) { return (unsigned)(tokn[r] * 2048 + kc * 16); }, Wn + mn.nt * 128, boffu); });
        EPI_IDS();
#pragma unroll
        for (int mi = 0; mi < 8; ++mi) { const int rl_ = wr * 128 + mi * 16 + (lane & 15); const size_t row = (size_t)mm.off + mm.mt * 256 + rl_; const float rs_ = rsd[rl_];
#pragma unroll
            for (int ni = 0; ni < 2; ++ni) { const int jc = mm.nt * 128 + wc * 32 + ni * 16 + 4 * (lane >> 4);
                const float4 bg = *(const float4*)(bup + (size_t)mm.e * 2048 + jc), bl_ = *(const float4*)(bup + (size_t)mm.e * 2048 + 1024 + jc);
                const f32x4 gv = acc[mi][ni], lv = acc[mi][ni + 2]; const float bgv[4] = {bg.x, bg.y, bg.z, bg.w}, blv[4] = {bl_.x, bl_.y, bl_.z, bl_.w}; float r4[4];
#pragma unroll
                for (int r = 0; r < 4; ++r) { const float gg = fminf(gv[r] * rs_ + bgv[r], 7.0f); const float ll = fminf(fmaxf(lv[r] * rs_ + blv[r], -7.0f), 7.0f); r4[r] = gg * sigmoidf_(1.702f * gg) * (ll + 1.0f); }
                uint2 o; o.x = cvtpk(r4[0], r4[1]); o.y = cvtpk(r4[2], r4[3]); *(uint2*)(ACT + row * 1024 + jc) = o; } }
        __syncthreads();
        item = nitem; mm = mn; buf ^= 1; pre = has_next;
    }
}
DEV void phase_down(const Args& a, unsigned char* smem) {
    int* sm = (int*)(smem + MISC_OFF); float* rwb = (float*)(sm + 128);
    const bf16_t* ACT = (const bf16_t*)(a.ws + WS_ACT); const bf16_t* W = (const bf16_t*)(a.ws + WS_WDN); bf16_t* Y = (bf16_t*)(a.ws + WS_Y);
    const float* ROWW = (const float*)(a.ws + WS_ROWW); const float* bdn = a.in[I_BDN];
    const int tid = TID(); int lane = tid & 63, wid = tid >> 6, wr = wid >> 2, wc = wid & 3; (void)wr; (void)wc; (void)lane;
    moe_setup(a, sm);
    const int nitems = __builtin_amdgcn_readfirstlane(sm[64]) * 4;
    auto fill = [&](const MoeMap& m_, int buf) { if (tid < 256) { const int slot = m_.mt * 256 + tid; rwb[buf * 256 + tid] = slot < m_.cnt ? ROWW[(size_t)m_.e * 16384 + slot] : 0.f; } };
    auto aoffd = [](int r, int kc) { return (unsigned)(r * 2048 + kc * 16); }; auto boffd = [](int k, int nc) { return (unsigned)(k * 2048 + nc * 16); };
    int item = VBID(); int buf = 0; bool pre = false; MoeMap mm{};
    if (item < nitems) { mm = moe_map(a, sm, item, 4); fill(mm, 0); }
    __syncthreads();
    while (item < nitems) {
        const int nitem = item + (int)gridDim.x; const bool has_next = nitem < nitems; MoeMap mn{};
        if (has_next) { mn = moe_map(a, sm, nitem, 4); fill(mn, buf ^ 1); }
        const float* rw = rwb + buf * 256;
        const bf16_t* We = W + (size_t)mm.e * 1024 * 1024; const bf16_t* Ab = ACT + ((size_t)mm.off + mm.mt * 256) * 1024;
        const bf16_t* Wn = W + (size_t)mn.e * 1024 * 1024; const bf16_t* An = ACT + ((size_t)mn.off + mn.mt * 256) * 1024;
        f32x4 acc[8][4];
        gemm256<true>(smem, 16, Ab, 128u, aoffd, We + mm.nt * 256, 64u * 2048u, boffd, acc, pre,
                      [&]() { if (has_next) gemm256_issue0(smem, An, aoffd, Wn + mn.nt * 256, boffd); });
        EPI_IDS();
#pragma unroll
        for (int mi = 0; mi < 8; ++mi) { const int rl = wr * 128 + mi * 16 + (lane & 15); const size_t row = (size_t)mm.off + mm.mt * 256 + rl; const float w = rw[rl];
#pragma unroll
            for (int ni = 0; ni < 4; ++ni) { const int n = mm.nt * 256 + wc * 64 + ni * 16 + 4 * (lane >> 4); const float4 bb = *(const float4*)(bdn + (size_t)mm.e * 1024 + n); const f32x4 v = acc[mi][ni];
                uint2 o; o.x = cvtpk((v[0] + bb.x) * w, (v[1] + bb.y) * w); o.y = cvtpk((v[2] + bb.z) * w, (v[3] + bb.w) * w); *(uint2*)(Y + row * 1024 + n) = o; } }
        __syncthreads();
        item = nitem; mm = mn; buf ^= 1; pre = has_next;
    }
}

DEV void phase_comb(const Args& a, unsigned char* smem) {
    int* sm = (int*)(smem + MISC_OFF);
    moe_setup(a, sm);
    float* H1 = (float*)(a.ws + WS_H1); bf16_t* XN = (bf16_t*)(a.ws + WS_XN); const bf16_t* Y = (const bf16_t*)(a.ws + WS_Y);
    const int* TOPI = (const int*)(a.ws + WS_TOPI); const int* TOPS = (const int*)(a.ws + WS_TOPS); const float* g = a.in[I_LNPLE];
    const int lane = TID() & 63; const int gw = BID() * NWAVE + (TID() >> 6), ngw = gridDim.x * NWAVE;
    for (int tok = gw; tok < NTOK; tok += ngw) {
        float4 v[4];
#pragma unroll
        for (int j = 0; j < 4; ++j) v[j] = *(const float4*)(H1 + (size_t)tok * 1024 + j * 256 + lane * 4);
#pragma unroll
        for (int k = 0; k < 4; ++k) { const int e = TOPI[(size_t)tok * 4 + k]; const size_t row = (size_t)sm[32 + e] * 256 + TOPS[(size_t)tok * 4 + k];
#pragma unroll
            for (int j = 0; j < 4; ++j) { const uint2 u = *(const uint2*)(Y + row * 1024 + j * 256 + lane * 4); v[j].x += bflo(u.x); v[j].y += bfhi(u.x); v[j].z += bflo(u.y); v[j].w += bfhi(u.y); } }
        float s = 0.f;
#pragma unroll
        for (int j = 0; j < 4; ++j) { *(float4*)(H1 + (size_t)tok * 1024 + j * 256 + lane * 4) = v[j]; s += v[j].x * v[j].x + v[j].y * v[j].y + v[j].z * v[j].z + v[j].w * v[j].w; }
        const float rstd = rsqrtf(wave_sum(s) * (1.f / 1024.f) + EPS);
#pragma unroll
        for (int j = 0; j < 4; ++j) { const float4 gg = *(const float4*)(g + j * 256 + lane * 4);
            uint2 o; o.x = cvtpk(v[j].x * rstd * gg.x, v[j].y * rstd * gg.y); o.y = cvtpk(v[j].z * rstd * gg.z, v[j].w * rstd * gg.w); *(uint2*)(XN + (size_t)tok * 1024 + j * 256 + lane * 4) = o; }
    }
}

DEV void phase_gate(const Args& a, unsigned char* smem) {
    const bf16_t* XN = (const bf16_t*)(a.ws + WS_XN); const bf16_t* WG = (const bf16_t*)(a.ws + WS_WGATE); const bf16_t* PB = (const bf16_t*)(a.ws + WS_PB); const bf16_t* WP = (const bf16_t*)(a.ws + WS_WPLE);
    const float* H2 = (const float*)(a.ws + WS_H1); float* OUT = a.out; float* SSQ3 = (float*)(a.ws + WS_SSQ3);
    const int tid = TID(); int lane = tid & 63, wid = tid >> 6, wr = wid >> 2, wc = wid & 3; (void)wr; (void)wc; (void)lane;
    bf16_t* GT = (bf16_t*)(a.ws + WS_ACT);
    auto aoffg = [](int r, int kc) { return (unsigned)(r * 2048 + kc * 16); }; auto aoffp = [](int r, int kc) { return (unsigned)(r * 512 + kc * 16); }; auto boffg = [](int k, int nc) { return (unsigned)(k * 2048 + nc * 16); };
    for (int item = VBID(); item < 64 * 4; item += gridDim.x) {
        int mt, nt; patch_decode(item, 64, 4, mt, nt);
        f32x4 acc[8][4];
        gemm256<true>(smem, 16, XN + (size_t)mt * 256 * 1024, 128u, aoffg, WG + nt * 256, 64u * 2048u, boffg, acc, false,
                      [&]() { gemm256_issue0(smem, PB + (size_t)mt * 256 * 256, aoffp, WP + nt * 256, boffg); });
        EPI_IDS();
#pragma unroll
        for (int mi = 0; mi < 8; ++mi) { const size_t gm = (size_t)mt * 256 + wr * 128 + mi * 16 + (lane & 15);
#pragma unroll
            for (int ni = 0; ni < 4; ++ni) { const int n = nt * 256 + wc * 64 + ni * 16 + 4 * (lane >> 4); const f32x4 v = acc[mi][ni];
                uint2 w; w.x = cvtpk(sigmoidf_(v[0]), sigmoidf_(v[1])); w.y = cvtpk(sigmoidf_(v[2]), sigmoidf_(v[3])); *(uint2*)(GT + gm * 1024 + n) = w;
                const float4 h = *(const float4*)(H2 + gm * 1024 + n);
                acc[mi][ni] = (f32x4){h.x * __builtin_amdgcn_rcpf(bflo(w.x)), h.y * __builtin_amdgcn_rcpf(bfhi(w.x)), h.z * __builtin_amdgcn_rcpf(bflo(w.y)), h.w * __builtin_amdgcn_rcpf(bfhi(w.y))}; }
            asm volatile("" ::: "memory"); }
        gemm256<false>(smem, 4, PB + (size_t)mt * 256 * 256, 128u, aoffp, WP + nt * 256, 64u * 2048u, boffg, acc, true);
        EPI_IDS();
        const bool fused = gridDim.x >= 256;
#pragma unroll
        for (int mi = 0; mi < 8; ++mi) { const size_t gm = (size_t)mt * 256 + wr * 128 + mi * 16 + (lane & 15); float ss = 0.f;
#pragma unroll
            for (int ni = 0; ni < 4; ++ni) { const int n = nt * 256 + wc * 64 + ni * 16 + 4 * (lane >> 4); const f32x4 v = acc[mi][ni];
                const uint2 gw = *(const uint2*)(GT + gm * 1024 + n);
                float4 o = {v[0] * bflo(gw.x), v[1] * bfhi(gw.x), v[2] * bflo(gw.y), v[3] * bfhi(gw.y)};
                if (!fused) *(float4*)(OUT + gm * 1024 + n) = o;
                acc[mi][ni] = (f32x4){o.x, o.y, o.z, o.w};
                ss += o.x * o.x + o.y * o.y + o.z * o.z + o.w * o.w; }
            ss += __shfl_xor(ss, 16); ss += __shfl_xor(ss, 32);
            if (lane < 16) SSQ3[gm * 16 + nt * 4 + wc] = ss;
            asm volatile("" ::: "memory"); }
        if (fused) {
            unsigned* flag = (unsigned*)(a.ws + WS_CTL) + CW_GATEFLAG + mt;
            signal_done(flag); wait_flag(flag, 4u);
            const float* lnf = a.in[I_LNF];
#pragma unroll
            for (int mi = 0; mi < 8; ++mi) { const size_t gm = (size_t)mt * 256 + wr * 128 + mi * 16 + (lane & 15);
                const float4 s0 = *(const float4*)(SSQ3 + gm * 16), s1 = *(const float4*)(SSQ3 + gm * 16 + 4), s2 = *(const float4*)(SSQ3 + gm * 16 + 8), s3 = *(const float4*)(SSQ3 + gm * 16 + 12);
                const float tot = ((s0.x + s0.y) + (s0.z + s0.w)) + ((s1.x + s1.y) + (s1.z + s1.w)) + ((s2.x + s2.y) + (s2.z + s2.w)) + ((s3.x + s3.y) + (s3.z + s3.w));
                const float rstd = rsqrtf(tot * (1.f / 1024.f) + EPS);
#pragma unroll
                for (int ni = 0; ni < 4; ++ni) { const int n = nt * 256 + wc * 64 + ni * 16 + 4 * (lane >> 4); const float4 gg = *(const float4*)(lnf + n); const f32x4 v = acc[mi][ni];
                    float4 o = {v[0] * rstd * gg.x, v[1] * rstd * gg.y, v[2] * rstd * gg.z, v[3] * rstd * gg.w}; *(float4*)(OUT + gm * 1024 + n) = o; }
                asm volatile("" ::: "memory"); }
        }
        __syncthreads();
    }
}

DEV void phase_final(const Args& a) {
    if (gridDim.x >= 256) return;
    float* OUT = a.out; const float* SSQ3 = (const float*)(a.ws + WS_SSQ3); const float* g = a.in[I_LNF];
    const int lane = TID() & 63; const int gw = BID() * NWAVE + (TID() >> 6), ngw = gridDim.x * NWAVE;
    for (int m = gw; m < NTOK; m += ngw) {
        float s = 0.f;
#pragma unroll
        for (int j = 0; j < 16; ++j) s += SSQ3[(size_t)m * 16 + j];
        const float rstd = rsqrtf(s * (1.f / 1024.f) + EPS);
#pragma unroll
        for (int j = 0; j < 4; ++j) { float4 v = *(const float4*)(OUT + (size_t)m * 1024 + j * 256 + lane * 4); const float4 gg = *(const float4*)(g + j * 256 + lane * 4);
            v.x *= rstd * gg.x; v.y *= rstd * gg.y; v.z *= rstd * gg.z; v.w *= rstd * gg.w; *(float4*)(OUT + (size_t)m * 1024 + j * 256 + lane * 4) = v; }
    }
}

template <int PH> DEV void run_phase(const Args& a, unsigned char* smem) {
    if constexpr (PH == PH_PRO) phase_prologue(a, smem);
    else if constexpr (PH == PH_INPROJ) phase_inproj(a, smem);
    else if constexpr (PH == PH_ATT) phase_att(a, smem);
    else if constexpr (PH == PH_OUTPROJ) phase_outproj(a, smem);
    else if constexpr (PH == PH_ROUTE) phase_route(a, smem);
    else if constexpr (PH == PH_UP) phase_up(a, smem);
    else if constexpr (PH == PH_DOWN) phase_down(a, smem);
    else if constexpr (PH == PH_COMB) phase_comb(a, smem);
    else if constexpr (PH == PH_GATE) phase_gate(a, smem);
    else if constexpr (PH == PH_FINAL) phase_final(a);
}
#define XB_TMO      128
#define XB_XCNT(j)  (256  + 64 * (j))
#define XB_XSUB(j)  (1280 + 64 * (j))
#define XB_XGEN(j)  (2304 + 64 * (j))
#define XB_TOP      3328
#define XB_TOPGEN   3392
#define XCD_BAR_WORDS 3456
#define XB_SPIN_CAP (1u << 22)
DEV unsigned xb_ld(unsigned* p)              { return __hip_atomic_load(p, __ATOMIC_RELAXED, __HIP_MEMORY_SCOPE_AGENT); }
DEV unsigned xb_add(unsigned* p, unsigned v) { return __hip_atomic_fetch_add(p, v, __ATOMIC_RELAXED, __HIP_MEMORY_SCOPE_AGENT); }
DEV unsigned xb_xcc_id() { return (unsigned)__builtin_amdgcn_s_getreg((3 << 11) | 20) & 0xFu; }
#define XB_SPIN(cond, bar) do { unsigned _sp = 0; while (cond) { __builtin_amdgcn_s_sleep(1); \
    if ((++_sp & 255u) == 0u) { if (xb_ld(&(bar)[XB_TMO])) break; if (_sp > XB_SPIN_CAP) { atomicAdd(&(bar)[XB_TMO], 1u); break; } } } } while (0)
struct XcdBarrier { unsigned* bar; unsigned x; volatile LAS unsigned* st; };
DEV XcdBarrier xcd_barrier_post(unsigned* bar, volatile LAS unsigned* st) {
    XcdBarrier b; b.bar = bar; b.x = xb_xcc_id(); b.st = st;
    if (TID() == 0) (void)xb_add(&bar[XB_XCNT(b.x)], 1u);
    return b;
}
DEV void xcd_barrier_complete(unsigned* bar, unsigned x, unsigned& nloc, unsigned& nx) {
    const unsigned G = gridDim.x * gridDim.y * gridDim.z;
    unsigned sum, cnt, mine, sp = 0u;
    for (;;) {
        sum = 0u; cnt = 0u; mine = 0u;
#pragma unroll
        for (unsigned j = 0; j < 16; ++j) { const unsigned c = xb_ld(&bar[XB_XCNT(j)]); sum += c; cnt += (c > 0u) ? 1u : 0u; mine = (j == x) ? c : mine; }
        if (sum == G) break;
        __builtin_amdgcn_s_sleep(1);
        if ((++sp & 255u) == 0u) { if (xb_ld(&bar[XB_TMO])) break; if (sp > XB_SPIN_CAP) { atomicAdd(&bar[XB_TMO], 1u); break; } }
    }
    nloc = mine > 0u ? mine : 1u; nx = cnt > 0u ? cnt : 1u;
}
DEV void xcd_barrier(const XcdBarrier& b) {
    asm volatile("s_waitcnt vmcnt(0)" ::: "memory");
    __syncthreads();
    if (TID() == 0) {
        unsigned* bar = b.bar;
        __builtin_amdgcn_s_waitcnt(0);
        unsigned nloc = b.st[0], nx = b.st[1];
        if (nloc == 0u) { xcd_barrier_complete(bar, b.x, nloc, nx); b.st[0] = nloc; b.st[1] = nx; }
        const unsigned old = xb_add(&bar[XB_XSUB(b.x)], 1u);
        const unsigned gen = old / nloc;
        if (old + 1u == (gen + 1u) * nloc) {
            __builtin_amdgcn_fence(__ATOMIC_RELEASE, "agent");
            asm volatile("s_waitcnt vmcnt(0)" ::: "memory");
            const unsigned og = xb_add(&bar[XB_TOP], 1u);
            const unsigned tg = og / nx;
            if (og + 1u == (tg + 1u) * nx) xb_add(&bar[XB_TOPGEN], 1u);
            else XB_SPIN(xb_ld(&bar[XB_TOPGEN]) == tg, bar);
            __builtin_amdgcn_fence(__ATOMIC_ACQUIRE, "agent");
            xb_add(&bar[XB_XGEN(b.x)], 1u);
            asm volatile("s_waitcnt vmcnt(0)" ::: "memory");
        } else {
            XB_SPIN(xb_ld(&bar[XB_XGEN(b.x)]) == gen, bar);
            __builtin_amdgcn_fence(__ATOMIC_ACQUIRE, "agent");
            asm volatile("s_waitcnt vmcnt(0)" ::: "memory");
        }
    }
    __syncthreads();
}

__global__ void __launch_bounds__(NTHR, 2) mega(Args a) {
    extern __shared__ __attribute__((aligned(16))) unsigned char smem[];
    volatile LAS unsigned* bst = (volatile LAS unsigned*)(LAS unsigned char*)(smem + MISC_OFF + 8000);
    if (TID() == 0) { bst[0] = 0u; bst[1] = 0u; }
    __syncthreads();
    const XcdBarrier bar = xcd_barrier_post((unsigned*)(a.ws + WS_CTL) + 4096, bst);
#define GSYNC() xcd_barrier(bar)
#define RUN(ph) do { run_phase<ph>(a, smem); if ((PROBE_DUP >> ph) & 1) { GSYNC(); run_phase<ph>(a, smem); } } while (0)
    RUN(PH_PRO); GSYNC();
    RUN(PH_INPROJ); GSYNC();
    RUN(PH_ATT); GSYNC();
    RUN(PH_OUTPROJ); GSYNC();
    RUN(PH_ROUTE); GSYNC();
    RUN(PH_UP); GSYNC();
    RUN(PH_DOWN); GSYNC();
    RUN(PH_COMB); GSYNC();
    RUN(PH_GATE);
    if (gridDim.x < 256) { GSYNC(); RUN(PH_FINAL); }
#undef RUN
#undef GSYNC
}

extern "C" void kernel_launch(void* const* d_in, const int* in_sizes, int n_in, void* d_out, int out_size, void* d_ws, size_t ws_size, hipStream_t stream) {
    static int grid = 0;
    if (grid == 0) {
        if (n_in != 25 || ws_size < WS_END) { fprintf(stderr, "kernel_launch: unexpected n_in %d / ws %zu\n", n_in, ws_size); grid = -1; return; }
        int dev = 0, cus = 0, per_cu = 0;
        (void)hipGetDevice(&dev); (void)hipDeviceGetAttribute(&cus, hipDeviceAttributeMultiprocessorCount, dev);
        (void)hipFuncSetAttribute((const void*)mega, hipFuncAttributeMaxDynamicSharedMemorySize, LDS_BYTES);
        (void)hipOccupancyMaxActiveBlocksPerMultiprocessor(&per_cu, (const void*)mega, NTHR, LDS_BYTES);
        if (per_cu < 1) { fprintf(stderr, "kernel_launch: occupancy query says %d blocks per CU\n", per_cu); grid = -1; return; }
        grid = cus;
    }
    if (grid < 0) return;
    (void)hipMemsetAsync((char*)d_ws + WS_CTL, 0, 65536, stream);
    Args a{};
    for (int i = 0; i < 25; ++i) a.in[i] = (const float*)d_in[i];
    a.out = (float*)d_out; a.ws = (unsigned char*)d_ws; a.ph_lo = 0; a.ph_hi = PH_N;
    void* args[] = {&a};
    hipError_t e = hipLaunchCooperativeKernel((const void*)mega, dim3(grid), dim3(NTHR), args, LDS_BYTES, stream);
    if (e != hipSuccess) fprintf(stderr, "cooperative launch failed: %s (grid %d)\n", hipGetErrorString(e), grid);
}
```

```cpp
#include <hip/hip_runtime.h>
#include <stdint.h>
#include <cstdio>

#define DEV __device__ __forceinline__
#define LAS __attribute__((address_space(3)))

typedef unsigned short bf16_t;
typedef short bf16x8 __attribute__((ext_vector_type(8)));
typedef short s16x4 __attribute__((ext_vector_type(4)));
typedef float f32x4 __attribute__((ext_vector_type(4)));
typedef float f32x16 __attribute__((ext_vector_type(16)));
typedef float f32x2_t __attribute__((ext_vector_type(2)));
typedef __bf16 bf16x2_t __attribute__((ext_vector_type(2)));

constexpr int NTHR = 512, NWAVE = 8;
constexpr int NTOK = 16384;
constexpr float EPS = 1e-6f;
constexpr float LOG2E = 1.4426950408889634f;
constexpr float QS = 0.125f * LOG2E;
constexpr int NWIN = 3072;

constexpr size_t MiB = 1u << 20;
constexpr size_t WS_CTL = 0;
constexpr size_t WS_WIN = 1 * MiB;
constexpr size_t WS_WOUT = 7 * MiB;
constexpr size_t WS_WGATE = 9 * MiB;
constexpr size_t WS_WPLE = 11 * MiB;
constexpr size_t WS_WC1 = 12 * MiB;
constexpr size_t WS_WC2 = 15 * MiB + 512 * 1024 + 262144;
constexpr size_t WS_BIAS1 = 15 * MiB + 512 * 1024 + 262144 + 131072;
constexpr size_t WS_KC = 14 * MiB;
constexpr size_t WS_HID = 14 * MiB + 512 * 1024;
constexpr size_t WS_GN = 16 * MiB;
constexpr size_t WS_LS = 18 * MiB;
constexpr size_t WS_CUM = 19 * MiB;
constexpr size_t WS_SSQ = 20 * MiB;
constexpr size_t WS_TOPI = 21 * MiB;
constexpr size_t WS_TOPS = 21 * MiB + 262144;
constexpr size_t WS_TOPW = 21 * MiB + 524288;
constexpr size_t WS_TOKOF = 22 * MiB;
constexpr size_t WS_ROWW = 24 * MiB;
constexpr size_t WS_SSQ3 = 26 * MiB;
constexpr size_t WS_RSTD2 = 27 * MiB;
constexpr size_t WS_PB = 28 * MiB;
constexpr size_t WS_XN = 36 * MiB;
constexpr size_t WS_PROJ = 68 * MiB;
constexpr size_t WS_ONSA = 160 * MiB;
constexpr size_t WS_OFOX = 176 * MiB;
constexpr size_t WS_H1 = 192 * MiB;
constexpr size_t WS_WUP = 256 * MiB;
constexpr size_t WS_WDN = 384 * MiB;
constexpr size_t WS_ACT = 448 * MiB;
constexpr size_t WS_Y = 592 * MiB;
constexpr size_t WS_END = 736 * MiB;

enum { PH_PRO = 0, PH_INPROJ, PH_CMP, PH_ATT, PH_OUTPROJ, PH_ROUTE, PH_UP, PH_DOWN, PH_COMB, PH_GATE, PH_FINAL, PH_N };
struct Args { const float* in[25]; float* out; unsigned char* ws; int ph_lo, ph_hi; };
enum { I_X = 0, I_P, I_LN1, I_WIN, I_BFG, I_WC1K, I_WC2K, I_PEK, I_WC1V, I_WC2V, I_PEV, I_GNN, I_GNF, I_WOUT, I_LN2, I_WR, I_BR,
       I_WUP, I_BUP, I_WDN, I_BDN, I_LNPLE, I_WPLE, I_WGATE, I_LNF };

DEV int BID() { int b = (int)blockIdx.x; asm volatile("" : "+s"(b)); return b; }
DEV int VBID() { const int g = (int)gridDim.x, b = BID(); return (g & 7) ? b : (b & 7) * (g >> 3) + (b >> 3); }
DEV int TID() { int t = (int)__builtin_amdgcn_workitem_id_x(); asm volatile("" : "+v"(t)); return t; }
DEV unsigned cvtpk(float lo, float hi) { f32x2_t v = {lo, hi}; bf16x2_t b = __builtin_convertvector(v, bf16x2_t); return __builtin_bit_cast(unsigned, b); }
DEV float bflo(unsigned u) { return __uint_as_float(u << 16); }
DEV float bfhi(unsigned u) { return __uint_as_float(u & 0xffff0000u); }
DEV float wave_sum(float v) {
#pragma unroll
    for (int o = 1; o < 64; o <<= 1) v += __shfl_xor(v, o);
    return v;
}
#define DPP_MOV(x, ctrl) __builtin_bit_cast(float, __builtin_amdgcn_update_dpp(0, __builtin_bit_cast(int, (x)), (ctrl), 0xF, 0xF, true))
DEV float pair_sum(float x) { return x + __shfl_xor(x, 32); }
DEV float pair_max(float x) { return fmaxf(x, __shfl_xor(x, 32)); }
DEV float quad_sum(float x) { x += DPP_MOV(x, 0xB1); x += DPP_MOV(x, 0x4E); return x; }
DEV float wave_max_u(float x) {
    x = fmaxf(x, DPP_MOV(x, 0xB1)); x = fmaxf(x, DPP_MOV(x, 0x4E)); x = fmaxf(x, DPP_MOV(x, 0x141)); x = fmaxf(x, DPP_MOV(x, 0x140));
    const float a = __builtin_bit_cast(float, __builtin_amdgcn_readlane(__builtin_bit_cast(int, x), 0)), b = __builtin_bit_cast(float, __builtin_amdgcn_readlane(__builtin_bit_cast(int, x), 16));
    const float c = __builtin_bit_cast(float, __builtin_amdgcn_readlane(__builtin_bit_cast(int, x), 32)), d = __builtin_bit_cast(float, __builtin_amdgcn_readlane(__builtin_bit_cast(int, x), 48));
    return fmaxf(fmaxf(a, b), fmaxf(c, d));
}
DEV float sigmoidf_(float x) { return __builtin_amdgcn_rcpf(1.0f + __expf(-x)); }
DEV float logsigmoidf_(float x) { return fminf(x, 0.f) - log1pf(__expf(-fabsf(x))); }
DEV float gelu_tanh(float x) { const float u = 0.7978845608028654f * (x + 0.044715f * x * x * x); const float th = 1.0f - 2.0f * __builtin_amdgcn_rcpf(__expf(2.0f * u) + 1.0f); return 0.5f * x * (1.0f + th); }
DEV s16x4 tr_read(const unsigned char* p) {
    typedef short v4i16_t __attribute__((ext_vector_type(4)));
    return __builtin_bit_cast(s16x4, __builtin_amdgcn_ds_read_tr16_b64_v4i16((LAS v4i16_t*)p));
}
DEV int crow(int r, int hi) { return (r & 3) + 8 * (r >> 2) + 4 * hi; }

constexpr int GL_STAGE = 65536;
constexpr int GEMM_LDS = 2 * GL_STAGE;
constexpr int MISC_OFF = GEMM_LDS;
constexpr int LDS_BYTES = GEMM_LDS + 8192;

DEV void glds16s(const void* sbase, unsigned voff, unsigned lds_dst) { unsigned keep;
    asm volatile("s_mov_b32 %0, m0\n\ts_mov_b32 m0, %3\n\ts_nop 0\n\tglobal_load_lds_dwordx4 %1, %2\n\ts_mov_b32 m0, %0" : "=&s"(keep) : "v"(voff), "s"(sbase), "s"(lds_dst) : "memory"); }

DEV const unsigned char* uptr(const void* p) { const unsigned long long v = (unsigned long long)p; const unsigned lo = __builtin_amdgcn_readfirstlane((unsigned)v), hi = __builtin_amdgcn_readfirstlane((unsigned)(v >> 32)); return (const unsigned char*)(((unsigned long long)hi << 32) | lo); }

struct NoNext { DEV void operator()() const {} };
template <class AO, class BO>
DEV void gemm256_issue0(unsigned char* smem, const void* abase, const AO& aoff, const void* bbase, const BO& boff) {
    const int tid = TID(), lane = tid & 63; const int wid = __builtin_amdgcn_readfirstlane(tid >> 6);
    const unsigned lds0 = (unsigned)(uintptr_t)smem; const unsigned char* ab_ = uptr(abase); const unsigned char* bb_ = uptr(bbase);
#pragma unroll
    for (int i = 0; i < 4; ++i) { const int p = wid + 8 * i; glds16s(ab_, aoff(8 * p + (lane >> 3), (lane & 7) ^ (lane >> 3)), (unsigned)__builtin_amdgcn_readfirstlane(lds0 + p * 1024)); }
#pragma unroll
    for (int i = 0; i < 4; ++i) { const int p = wid + 8 * i; const int k = 2 * p + (lane >> 5); const int f = (k & 3) + 4 * ((k >> 3) & 1);
        glds16s(bb_, boff(k, (lane & 31) ^ (f << 1)), (unsigned)__builtin_amdgcn_readfirstlane(lds0 + 32768 + p * 1024)); }
}
template <bool ZERO, class AO, class BO, class NX = NoNext>
DEV void gemm256(unsigned char* smem, int nkt, const void* abase, unsigned akstep, const AO& aoff, const void* bbase, unsigned bkstep, const BO& boff, f32x4 (&acc)[8][4], bool pre = false, const NX& next = NX()) {
    const int tid = TID(), lane = tid & 63; const int wid = __builtin_amdgcn_readfirstlane(tid >> 6); const int wr = wid >> 2, wc = wid & 3;
    if (ZERO) {
#pragma unroll
        for (int mi = 0; mi < 8; ++mi)
#pragma unroll
            for (int ni = 0; ni < 4; ++ni) acc[mi][ni] = (f32x4){0.f, 0.f, 0.f, 0.f};
    }
    const unsigned lds0 = (unsigned)(uintptr_t)smem;
    const unsigned char* abase_u = uptr(abase); const unsigned char* bbase_u = uptr(bbase); const unsigned akstep_u = __builtin_amdgcn_readfirstlane(akstep), bkstep_u = __builtin_amdgcn_readfirstlane(bkstep);
    unsigned ao[4], bo[4];
#pragma unroll
    for (int i = 0; i < 4; ++i) { const int p = wid + 8 * i; ao[i] = aoff(8 * p + (lane >> 3), (lane & 7) ^ (lane >> 3));
        const int k = 2 * p + (lane >> 5); const int f = (k & 3) + 4 * ((k >> 3) & 1); bo[i] = boff(k, (lane & 31) ^ (f << 1)); }
#define GL_ISSUE(kt, st) do { const unsigned char* ab_ = abase_u + (size_t)(kt) * akstep_u; const unsigned char* bb_ = bbase_u + (size_t)(kt) * bkstep_u; \
        _Pragma("unroll") for (int i_ = 0; i_ < 4; ++i_) glds16s(ab_, ao[i_], (unsigned)__builtin_amdgcn_readfirstlane(lds0 + (st) * GL_STAGE + (wid + 8 * i_) * 1024)); \
        _Pragma("unroll") for (int i_ = 0; i_ < 4; ++i_) glds16s(bb_, bo[i_], (unsigned)__builtin_amdgcn_readfirstlane(lds0 + (st) * GL_STAGE + 32768 + (wid + 8 * i_) * 1024)); } while (0)
    if (!pre) {
        GL_ISSUE(0, 0);
        asm volatile("s_waitcnt vmcnt(0)" ::: "memory");
        __syncthreads();
    }
    for (int kt = 0; kt < nkt; ++kt) {
        if (kt + 1 < nkt) GL_ISSUE(kt + 1, (kt + 1) & 1); else next();
        const unsigned char* A = smem + (kt & 1) * GL_STAGE; const unsigned char* Bt = A + 32768;
#pragma unroll
        for (int ks = 0; ks < 2; ++ks) {
            bf16x8 wf[4];
#pragma unroll
            for (int ni = 0; ni < 4; ++ni) {
                const int i = lane & 15, g = lane >> 4, q = i >> 2; const int row = ks * 32 + 8 * g + q; const int nc = wc * 8 + ni * 2 + ((i & 3) >> 1); const int f = q + 4 * (g & 1);
                const unsigned char* p = Bt + row * 512 + ((nc ^ (f << 1)) << 4) + (i & 1) * 8;
                const s16x4 lo = tr_read(p), hi = tr_read(p + 4 * 512);
                wf[ni] = (bf16x8){lo[0], lo[1], lo[2], lo[3], hi[0], hi[1], hi[2], hi[3]};
            }
#pragma unroll
            for (int mi = 0; mi < 8; ++mi) {
                const int m = wr * 128 + mi * 16 + (lane & 15); const int kc = ks * 4 + (lane >> 4);
                const bf16x8 af = *(const bf16x8*)(A + m * 128 + ((kc ^ (m & 7)) << 4));
#pragma unroll
                for (int ni = 0; ni < 4; ++ni) acc[mi][ni] = __builtin_amdgcn_mfma_f32_16x16x32_bf16(wf[ni], af, acc[mi][ni], 0, 0, 0);
            }
        }
        asm volatile("s_waitcnt vmcnt(0)" ::: "memory");
        __syncthreads();
    }
#undef GL_ISSUE
}

#define EPI_IDS() do { const int etid_ = TID(); lane = etid_ & 63; wid = etid_ >> 6; wr = wid >> 2; wc = wid & 3; } while (0)

DEV void patch_decode(int local, int MT, int NT, int& mt, int& nt) {
    const int per_mtb = 8 * NT; const int mtb = local / per_mtb; const int rem = local - mtb * per_mtb;
    const int rows = (MT - 8 * mtb) < 8 ? (MT - 8 * mtb) : 8;
    const int per_ntb = rows * 8; const int nfull = NT >> 3; int ntb = rem / per_ntb; int cols = 8;
    if (ntb >= nfull) { ntb = nfull; cols = NT - 8 * nfull; }
    const int r2 = rem - ntb * per_ntb;
    mt = 8 * mtb + r2 / cols; nt = 8 * ntb + r2 % cols;
}

DEV void convert_chunk(const float* src, bf16_t* dst, size_t i8) {
    const float4 a = *(const float4*)(src + i8 * 8), b = *(const float4*)(src + i8 * 8 + 4);
    uint4 o; o.x = cvtpk(a.x, a.y); o.y = cvtpk(a.z, a.w); o.z = cvtpk(b.x, b.y); o.w = cvtpk(b.z, b.w);
    *(uint4*)(dst + i8 * 8) = o;
}
DEV void phase_prologue(const Args& a, unsigned char* smem) {
    unsigned char* ws = a.ws;
    const size_t gtid = (size_t)BID() * NTHR + TID(), gn = (size_t)gridDim.x * NTHR;
    {
        { const float* W = a.in[I_WOUT]; bf16_t* O = (bf16_t*)(ws + WS_WOUT); const float* gnn = a.in[I_GNN]; const float* gnf = a.in[I_GNF];
          for (size_t i = gtid; i < (size_t)1024 * 128; i += gn) { const int k = (int)(i >> 7); const float g_ = k < 512 ? gnn[k] : gnf[k - 512];
              const float4 x = *(const float4*)(W + i * 8), y = *(const float4*)(W + i * 8 + 4);
              uint4 o; o.x = cvtpk(x.x * g_, x.y * g_); o.y = cvtpk(x.z * g_, x.w * g_); o.z = cvtpk(y.x * g_, y.y * g_); o.w = cvtpk(y.z * g_, y.w * g_); *(uint4*)(O + i * 8) = o; } }
        const float* srcs[3] = {a.in[I_WGATE], a.in[I_WPLE], a.in[I_P]};
        bf16_t* dsts[3] = {(bf16_t*)(ws + WS_WGATE), (bf16_t*)(ws + WS_WPLE), (bf16_t*)(ws + WS_PB)};
        const size_t cnt8[3] = {1024 * 1024 / 8, 256 * 1024 / 8, (size_t)NTOK * 256 / 8};
#pragma unroll
        for (int s = 0; s < 3; ++s) for (size_t i = gtid; i < cnt8[s]; i += gn) convert_chunk(srcs[s], dsts[s], i);
        for (size_t i = gtid; i < (size_t)2 * 2048 * 32; i += gn) { const int which = (int)(i / (2048 * 32)); const int k = (int)(i / 32) % 2048, c8 = (int)(i % 32) * 8;
            uint4 o = {0u, 0u, 0u, 0u};
            if (c8 < 128) { const float* W = a.in[which ? I_WC1V : I_WC1K] + (size_t)k * 128 + c8; const float4 x = *(const float4*)W, y = *(const float4*)(W + 4); o.x = cvtpk(x.x, x.y); o.y = cvtpk(x.z, x.w); o.z = cvtpk(y.x, y.y); o.w = cvtpk(y.z, y.w); }
            *(uint4*)((bf16_t*)(ws + WS_WC1) + i * 8) = o; }
        for (size_t i = gtid; i < (size_t)2 * 128 * 32; i += gn) { const int which = (int)(i / (128 * 32)); const int k = (int)(i / 32) % 128, c8 = (int)(i % 32) * 8;
            uint4 o = {0u, 0u, 0u, 0u};
            if (c8 < 64) { const float* W = a.in[which ? I_WC2V : I_WC2K] + (size_t)k * 64 + c8; const float4 x = *(const float4*)W, y = *(const float4*)(W + 4); o.x = cvtpk(x.x, x.y); o.y = cvtpk(x.z, x.w); o.z = cvtpk(y.x, y.y); o.w = cvtpk(y.z, y.w); }
            *(uint4*)((bf16_t*)(ws + WS_WC2) + i * 8) = o; }
    }
    {
        const float* W = a.in[I_WIN]; bf16_t* O = (bf16_t*)(ws + WS_WIN);
        for (size_t i = gtid; i < (size_t)1024 * (NWIN / 8); i += gn) {
            const int k = (int)(i / (NWIN / 8)), j = (int)(i % (NWIN / 8)) * 8;
            uint4 o = {0u, 0u, 0u, 0u};
            if (j < 2848) {
                const int sj = (j < 1280) ? j : (j < 2816) ? j + 24 : (j < 2840) ? j - 1536 : j;
                const float4 x = *(const float4*)(W + (size_t)k * 2848 + sj), y = *(const float4*)(W + (size_t)k * 2848 + sj + 4);
                o.x = cvtpk(x.x, x.y); o.y = cvtpk(x.z, x.w); o.z = cvtpk(y.x, y.y); o.w = cvtpk(y.z, y.w);
            }
            *(uint4*)(O + (size_t)k * NWIN + j) = o;
        }
    }
    const int lane = TID() & 63; const int gw = BID() * NWAVE + (TID() >> 6), ngw = gridDim.x * NWAVE;
    {
        const float* X = a.in[I_X]; const float* g = a.in[I_LN1]; bf16_t* XN = (bf16_t*)(ws + WS_XN);
        for (int m = gw; m < NTOK; m += ngw) {
            float4 v[4]; float s = 0.f;
#pragma unroll
            for (int j = 0; j < 4; ++j) { v[j] = *(const float4*)(X + (size_t)m * 1024 + j * 256 + lane * 4); s += v[j].x * v[j].x + v[j].y * v[j].y + v[j].z * v[j].z + v[j].w * v[j].w; }
            const float rstd = rsqrtf(wave_sum(s) * (1.f / 1024.f) + EPS);
#pragma unroll
            for (int j = 0; j < 4; ++j) { const float4 gg = *(const float4*)(g + j * 256 + lane * 4);
                uint2 o; o.x = cvtpk(v[j].x * rstd * gg.x, v[j].y * rstd * gg.y); o.y = cvtpk(v[j].z * rstd * gg.z, v[j].w * rstd * gg.w);
                *(uint2*)(XN + (size_t)m * 1024 + j * 256 + lane * 4) = o; }
        }
    }
    if (gw < 256) {
        const int which = gw >> 7, n = gw & 127; const float* pe = a.in[which ? I_PEV : I_PEK]; const float* w1 = a.in[which ? I_WC1V : I_WC1K];
        float s = 0.f;
#pragma unroll 8
        for (int i = 0; i < 32; ++i) { const int k = lane + 64 * i; s += pe[k] * w1[(size_t)k * 128 + n]; }
        s = wave_sum(s);
        if (lane == 0) ((float*)(ws + WS_BIAS1))[which * 128 + n] = s;
    }
}

DEV void phase_inproj(const Args& a, unsigned char* smem) {
    const bf16_t* XN = (const bf16_t*)(a.ws + WS_XN); const bf16_t* W = (const bf16_t*)(a.ws + WS_WIN);
    bf16_t* PROJ = (bf16_t*)(a.ws + WS_PROJ); float* GN = (float*)(a.ws + WS_GN); float* LS = (float*)(a.ws + WS_LS); const float* bfg = a.in[I_BFG];
    int lane = TID() & 63, wid = TID() >> 6, wr = wid >> 2, wc = wid & 3; (void)wr; (void)wc; (void)lane;
    bool pre = false;
    for (int item = VBID(); item < 64 * 12; item += gridDim.x) {
        int mt, nt; patch_decode(item, 64, 12, mt, nt);
        const int nitem = item + (int)gridDim.x; const bool has_next = nitem < 64 * 12; int mtn = 0, ntn = 0; if (has_next) patch_decode(nitem, 64, 12, mtn, ntn);
        f32x4 acc[8][4];
        gemm256<true>(smem, 16, XN + (size_t)mt * 256 * 1024, 128u, [&](int r, int kc) { return (unsigned)(r * 2048 + kc * 16); },
                      W + nt * 256, (unsigned)(64 * NWIN * 2), [&](int k, int nc) { return (unsigned)(k * (NWIN * 2) + nc * 16); }, acc, pre,
                      [&]() { if (has_next) gemm256_issue0(smem, XN + (size_t)mtn * 256 * 1024, [&](int r, int kc) { return (unsigned)(r * 2048 + kc * 16); }, W + ntn * 256, [&](int k, int nc) { return (unsigned)(k * (NWIN * 2) + nc * 16); }); });
        pre = has_next;
        EPI_IDS();
#pragma unroll
        for (int mi = 0; mi < 8; ++mi) {
            const int gm = mt * 256 + wr * 128 + mi * 16 + (lane & 15); const int b = gm >> 13, t = gm & 8191;
#pragma unroll
            for (int ni = 0; ni < 4; ++ni) {
                const int n = wc * 64 + ni * 16 + 4 * (lane >> 4); const f32x4 v = acc[mi][ni];
                if (nt < 11) {
                    const int hs = nt * 4 + wc, d = n & 63; const float sc = (hs < 8 || (hs >= 20 && hs < 28)) ? QS : 1.0f;
                    uint2 o; o.x = cvtpk(v[0] * sc, v[1] * sc); o.y = cvtpk(v[2] * sc, v[3] * sc);
                    *(uint2*)(PROJ + (((size_t)(hs * 2 + b)) * 8192 + t) * 64 + d) = o;
                } else if (n < 24) {
#pragma unroll
                    for (int r = 0; r < 4; ++r) GN[(size_t)gm * 24 + n + r] = sigmoidf_(v[r]);
                } else if (n < 32) {
#pragma unroll
                    for (int r = 0; r < 4; ++r) { const int h = n - 24 + r; LS[((size_t)(b * 8 + h)) * 8192 + t] = logsigmoidf_(v[r] + bfg[h]); }
                }
            }
        }
    }
}

DEV void signal_done(unsigned* flag) {
    asm volatile("s_waitcnt vmcnt(0)" ::: "memory");
    __syncthreads();
    if (TID() == 0) { __builtin_amdgcn_fence(__ATOMIC_RELEASE, "agent"); asm volatile("s_waitcnt vmcnt(0)" ::: "memory"); __hip_atomic_fetch_add(flag, 1u, __ATOMIC_RELAXED, __HIP_MEMORY_SCOPE_AGENT); }
}
DEV void wait_flag(unsigned* flag, unsigned target) {
    if (TID() == 0) { unsigned sp = 0u; while (__hip_atomic_load(flag, __ATOMIC_RELAXED, __HIP_MEMORY_SCOPE_AGENT) < target) { __builtin_amdgcn_s_sleep(4); if (++sp > (1u << 24)) break; }
        __builtin_amdgcn_fence(__ATOMIC_ACQUIRE, "agent"); asm volatile("s_waitcnt vmcnt(0)" ::: "memory"); }
    __syncthreads();
}
constexpr int CW_CUMFLAG = 128, CW_CMPFLAG = 192, CW_GATEFLAG = 256;
DEV void cmp_item(const Args& a, unsigned char* smem, int item) {
    const bf16_t* PROJ = (const bf16_t*)(a.ws + WS_PROJ);
    const int tid = TID(); int lane = tid & 63, wid = tid >> 6, wr = wid >> 2, wc = wid & 3; (void)wr; (void)wc; (void)lane;
    {
        if (item < 16) {
            const int which = item >> 3, b = (item >> 2) & 1, g = (item >> 1) & 1, mt = item & 1;
            const bf16_t* base = PROJ + ((size_t)((8 + 2 * which + g) * 2 + b)) * 8192 * 64;
            const bf16_t* W1 = (const bf16_t*)(a.ws + WS_WC1) + (size_t)which * 2048 * 256;
            const bf16_t* W2 = (const bf16_t*)(a.ws + WS_WC2) + (size_t)which * 128 * 256;
            const float* bias1 = (const float*)(a.ws + WS_BIAS1) + which * 128;
            bf16_t* HID = (bf16_t*)(a.ws + WS_HID) + ((size_t)(which * 4 + b * 2 + g)) * 512 * 128;
            bf16_t* OUT = (bf16_t*)(a.ws + WS_KC) + ((size_t)(which * 4 + b * 2 + g)) * 512 * 64;
            f32x4 acc[8][4];
            gemm256<true>(smem, 32, base, 128u, [&](int r, int kc) { int c = mt * 256 + r; c = c > 510 ? 510 : c; return (unsigned)(c * 2048 + kc * 16); },
                          W1, 64u * 512u, [&](int k, int nc) { return (unsigned)(k * 512 + nc * 16); }, acc);
        EPI_IDS();
            if (wc < 2) {
#pragma unroll
                for (int mi = 0; mi < 8; ++mi) { const int c = mt * 256 + wr * 128 + mi * 16 + (lane & 15);
#pragma unroll
                    for (int ni = 0; ni < 4; ++ni) { const int n = wc * 64 + ni * 16 + 4 * (lane >> 4); const f32x4 v = acc[mi][ni]; const float4 bb = *(const float4*)(bias1 + n);
                        uint2 o; o.x = cvtpk(gelu_tanh(v[0] + bb.x), gelu_tanh(v[1] + bb.y)); o.y = cvtpk(gelu_tanh(v[2] + bb.z), gelu_tanh(v[3] + bb.w));
                        *(uint2*)(HID + (size_t)c * 128 + n) = o; } }
            }
            __syncthreads();
            gemm256<true>(smem, 2, HID + (size_t)mt * 256 * 128, 128u, [&](int r, int kc) { return (unsigned)(r * 256 + kc * 16); },
                          W2, 64u * 512u, [&](int k, int nc) { return (unsigned)(k * 512 + nc * 16); }, acc);
        EPI_IDS();
            if (wc == 0) {
#pragma unroll
                for (int mi = 0; mi < 8; ++mi) { const int c = mt * 256 + wr * 128 + mi * 16 + (lane & 15);
#pragma unroll
                    for (int ni = 0; ni < 4; ++ni) { const int n = ni * 16 + 4 * (lane >> 4); const f32x4 v = acc[mi][ni];
                        uint2 o; o.x = cvtpk(v[0], v[1]); o.y = cvtpk(v[2], v[3]);
                        if (c >= 511) { o.x = 0u; o.y = 0u; }
                        *(uint2*)(OUT + (size_t)c * 64 + n) = o; } }
            }
            signal_done((unsigned*)(a.ws + WS_CTL) + CW_CMPFLAG);
        } else {
            const int bh = item - 16; const float* LS = (const float*)(a.ws + WS_LS) + (size_t)bh * 8192; float* CUM = (float*)(a.ws + WS_CUM) + (size_t)bh * 8192;
            float* sc = (float*)smem;
            float v[16]; float s = 0.f;
#pragma unroll
            for (int j = 0; j < 4; ++j) { const float4 x = *(const float4*)(LS + tid * 16 + j * 4); v[4 * j] = x.x; v[4 * j + 1] = x.y; v[4 * j + 2] = x.z; v[4 * j + 3] = x.w; }
#pragma unroll
            for (int j = 0; j < 16; ++j) { s += v[j]; v[j] = s; }
            sc[tid] = s; __syncthreads();
            if (tid == 0) { float run = 0.f; for (int i = 0; i < NTHR; ++i) { const float x = sc[i]; sc[i] = run; run += x; } }
            __syncthreads();
            const float off = sc[tid];
#pragma unroll
            for (int j = 0; j < 4; ++j) { float4 o = {v[4 * j] + off, v[4 * j + 1] + off, v[4 * j + 2] + off, v[4 * j + 3] + off}; *(float4*)(CUM + tid * 16 + j * 4) = o; }
            signal_done((unsigned*)(a.ws + WS_CTL) + CW_CUMFLAG + bh);
        }
    }
}

constexpr int AT_STAGE = 16384;
constexpr int AT_BIAS_OFF = 3 * AT_STAGE;
constexpr int AT_IMP_OFF = AT_BIAS_OFF + 1024;
constexpr int AT_SEL_OFF = AT_IMP_OFF + 65536;
constexpr int AT_WUN_OFF = AT_SEL_OFF + 1024;
constexpr int AT_UCNT_OFF = AT_WUN_OFF + 128;
constexpr int AT_ULIST_OFF = AT_UCNT_OFF + 16;
constexpr int AT_ITEM_OFF = AT_ULIST_OFF + 128;
static_assert(AT_ITEM_OFF + 16 <= GEMM_LDS, "attention LDS map");
#define NEG_INF (-__builtin_inff())

#define KV_DECL uint4 rk0_, rv0_
#define KV_GLOAD(Kt, Vt) do { rk0_ = *(const uint4*)((Kt) + tid * 8); rv0_ = *(const uint4*)((Vt) + tid * 8); } while (0)
#define KV_LSTORE(stp) do { unsigned char* st_ = (stp); const int key = tid >> 3, ch = tid & 7; \
      *(uint4*)(st_ + key * 128 + ((ch ^ (key & 7)) << 4)) = rk0_; \
      *(uint4*)(st_ + 8192 + key * 128 + ((((ch >> 2) ^ ((key >> 1) & 1))) << 6) + ((ch & 3) << 4)) = rv0_; } while (0)
template <bool FULL>
DEV void qk_tile(const unsigned char* Kst, const bf16x8 (&qf)[4], f32x16& p0, f32x16& p1, int lane) {
    const int key = lane & 31, hi = lane >> 5;
    if (FULL) {
        bf16x8 k0[4], k1[4];
#pragma unroll
        for (int ks = 0; ks < 4; ++ks) { const int ch = 2 * ks + hi; const int off = key * 128 + ((ch ^ (key & 7)) << 4);
            k0[ks] = *(const bf16x8*)(Kst + off); k1[ks] = *(const bf16x8*)(Kst + off + 32 * 128); }
        __builtin_amdgcn_sched_barrier(0);
#pragma unroll
        for (int ks = 0; ks < 4; ++ks) {
            p0 = __builtin_amdgcn_mfma_f32_32x32x16_bf16(k0[ks], qf[ks], p0, 0, 0, 0);
            p1 = __builtin_amdgcn_mfma_f32_32x32x16_bf16(k1[ks], qf[ks], p1, 0, 0, 0); }
    } else {
        bf16x8 kk[4];
#pragma unroll
        for (int ks = 0; ks < 4; ++ks) { const int ch = 2 * ks + hi; kk[ks] = *(const bf16x8*)(Kst + key * 128 + ((ch ^ (key & 7)) << 4)); }
        __builtin_amdgcn_sched_barrier(0);
#pragma unroll
        for (int ks = 0; ks < 4; ++ks) p0 = __builtin_amdgcn_mfma_f32_32x32x16_bf16(kk[ks], qf[ks], p0, 0, 0, 0);
        __builtin_amdgcn_sched_barrier(0);
#pragma unroll
        for (int ks = 0; ks < 4; ++ks) { const int ch = 2 * ks + hi; kk[ks] = *(const bf16x8*)(Kst + key * 128 + ((ch ^ (key & 7)) << 4) + 32 * 128); }
        __builtin_amdgcn_sched_barrier(0);
#pragma unroll
        for (int ks = 0; ks < 4; ++ks) p1 = __builtin_amdgcn_mfma_f32_32x32x16_bf16(kk[ks], qf[ks], p1, 0, 0, 0);
    }
}
template <bool FULL>
DEV void pv_tile(const unsigned char* Vst, const f32x16& p0, const f32x16& p1, f32x16 (&o)[2], int lane) {
    const int hi = lane >> 5, i = lane & 15, gg = (lane >> 4) & 1;
    const int q = i >> 2; const int sw = (q >> 1) & 1;
    bf16x8 pa[4];
#pragma unroll
    for (int s = 0; s < 4; ++s) { const f32x16& p = (s < 2) ? p0 : p1; const int b = (s & 1) * 8;
        unsigned w[4];
#pragma unroll
        for (int j = 0; j < 4; ++j) w[j] = cvtpk(p[b + 2 * j], p[b + 2 * j + 1]);
        typedef unsigned u32x4_t __attribute__((ext_vector_type(4)));
        u32x4_t ww = {w[0], w[1], w[2], w[3]}; pa[s] = __builtin_bit_cast(bf16x8, ww); }
    constexpr int NB = FULL ? 1 : 2, SB = FULL ? 4 : 2;
#pragma unroll
    for (int bt = 0; bt < NB; ++bt) {
        s16x4 vlo[SB][2], vhi[SB][2];
#pragma unroll
        for (int s_ = 0; s_ < SB; ++s_)
#pragma unroll
            for (int dh = 0; dh < 2; ++dh) { const int s = bt * SB + s_; const int row0 = 16 * s + 4 * hi + q;
                const unsigned char* p = Vst + row0 * 128 + ((dh ^ sw) << 6) + gg * 32 + (i & 3) * 8;
                vlo[s_][dh] = tr_read(p); vhi[s_][dh] = tr_read(p + 8 * 128); }
        __builtin_amdgcn_sched_barrier(0);
#pragma unroll
        for (int s_ = 0; s_ < SB; ++s_)
#pragma unroll
            for (int dh = 0; dh < 2; ++dh) { const int s = bt * SB + s_;
                const bf16x8 vf = {vlo[s_][dh][0], vlo[s_][dh][1], vlo[s_][dh][2], vlo[s_][dh][3], vhi[s_][dh][0], vhi[s_][dh][1], vhi[s_][dh][2], vhi[s_][dh][3]};
                o[dh] = __builtin_amdgcn_mfma_f32_32x32x16_bf16(vf, pa[s], o[dh], 0, 0, 0); }
        __builtin_amdgcn_sched_barrier(0);
    }
}
DEV float rowmax32(const f32x16& p0, const f32x16& p1) {
    float a = fmaxf(p0[0], p1[0]), b = fmaxf(p0[1], p1[1]);
#pragma unroll
    for (int r = 2; r < 16; r += 2) { a = fmaxf(fmaxf(a, p0[r]), p1[r]); b = fmaxf(fmaxf(b, p0[r + 1]), p1[r + 1]); }
    return pair_max(fmaxf(a, b));
}
DEV void softmax_step(f32x16& p0, f32x16& p1, float& m, float& l, f32x16 (&o)[2]) {
    const float mt = rowmax32(p0, p1); const float mn = fmaxf(m, mt); const float alpha = __builtin_amdgcn_exp2f(m - mn);
    float rs = 0.f;
#pragma unroll
    for (int r = 0; r < 16; ++r) { p0[r] = __builtin_amdgcn_exp2f(p0[r] - mn); p1[r] = __builtin_amdgcn_exp2f(p1[r] - mn); rs += p0[r] + p1[r]; }
    rs = pair_sum(rs);
    l = l * alpha + rs; m = mn;
    if (__any(alpha != 1.0f)) { o[0] *= alpha; o[1] *= alpha; }
}
template <int STRIDE> DEV void mask_tile(f32x16& p0, f32x16& p1, int kpos0, int lo, int hi_lim, int hi) {
#pragma unroll
    for (int r = 0; r < 16; ++r) { const int kp = kpos0 + STRIDE * crow(r, hi);
        if (kp < lo || kp > hi_lim) p0[r] = NEG_INF;
        const int kp1 = kp + 32 * STRIDE; if (kp1 < lo || kp1 > hi_lim) p1[r] = NEG_INF; }
}
template <int STRIDE> DEV void alibi_init(f32x16& p0, f32x16& p1, float slope2, int kpos0, int tref, int hi) {
    const float base = slope2 * (float)(kpos0 - tref + STRIDE * 4 * hi);
#pragma unroll
    for (int r = 0; r < 16; ++r) { const float c = (float)(STRIDE * ((r & 3) + 8 * (r >> 2))); p0[r] = fmaf(slope2, c, base); p1[r] = fmaf(slope2, c + (float)(32 * STRIDE), base); }
}
template <class Src, class Body, class NSrc>
DEV int kv_pipeline(unsigned char* smem, int n, const Src& src, const Body& body, int par, bool pre, bool has_next, const NSrc& nsrc) {
    KV_DECL; const int tid = TID(); const bf16_t *kp, *vp;
    if (!pre) { src(0, kp, vp); KV_GLOAD(kp, vp); KV_LSTORE(smem + par * AT_STAGE); __syncthreads(); }
    for (int j = 0; j < n; ++j) {
        const bool more = j + 1 < n; const bool ld = more || has_next;
        if (more) { src(j + 1, kp, vp); KV_GLOAD(kp, vp); } else if (has_next) { nsrc(kp, vp); KV_GLOAD(kp, vp); }
        body(j, smem + ((par + j) & 1) * AT_STAGE);
        if (ld) KV_LSTORE(smem + ((par + j + 1) & 1) * AT_STAGE);
        __syncthreads();
    }
    return (par + n) & 1;
}
struct NoSrc { DEV void operator()(const bf16_t*&, const bf16_t*&) const {} };

constexpr int CV_PER_STEP = 373; constexpr int CV_NUP = 32 * 1024 * 2048 / 8, CV_NDN = 32 * 1024 * 1024 / 8;
static_assert((long long)33792 * CV_PER_STEP >= (long long)CV_NUP + CV_NDN, "conversion coverage");
DEV void fox_item(const Args& a, unsigned char* smem, int fi, int b, int h, int qb) {
    const int tid = TID(), lane = tid & 63, wid = tid >> 6, r32 = lane & 31, hi = lane >> 5;
    const bf16_t* PROJ = (const bf16_t*)(a.ws + WS_PROJ);
    const bf16_t* Q = PROJ + ((size_t)((20 + h) * 2 + b)) * 8192 * 64; const bf16_t* K = PROJ + ((size_t)((28 + h) * 2 + b)) * 8192 * 64; const bf16_t* V = PROJ + ((size_t)((36 + h) * 2 + b)) * 8192 * 64;
    const float* CUM = (const float*)(a.ws + WS_CUM) + (size_t)(b * 8 + h) * 8192;
    const int q0 = qb * 256; const int qrow = q0 + 32 * wid + r32;
    bf16x8 qf[4];
#pragma unroll
    for (int ks = 0; ks < 4; ++ks) qf[ks] = *(const bf16x8*)(Q + (size_t)qrow * 64 + 16 * ks + 8 * hi);
    const float cref = CUM[q0];
    const int ntiles = 4 * qb + 4; const int jmax_w = (q0 + 32 * wid + 31) >> 6; const int jmask_w = (q0 + 32 * wid) >> 6;
    f32x16 o[2]; o[0] = (f32x16){}; o[1] = (f32x16){}; float m = -1e30f, l = 0.f;
    float* biasL = (float*)(smem + AT_BIAS_OFF);
    const int gq_ = fi >> 4; const int sidx0 = 16 * (128 * gq_ - 2 * gq_ * (gq_ - 1)) + (fi & 15) * (128 - 4 * gq_);
    bf16_t* cvdA = nullptr; bf16_t* cvdB = nullptr; float4 cvaA, cvbA, cvaB, cvbB;
    KV_DECL; float breg = 0.f;
#define TJ(s_) (ntiles - 1 - (s_))
    KV_GLOAD(K + (size_t)TJ(0) * 4096, V + (size_t)TJ(0) * 4096); if (tid < 64) breg = (cref - CUM[TJ(0) * 64 + tid]) * LOG2E;
    KV_LSTORE(smem); if (tid < 64) biasL[tid] = breg;
    KV_GLOAD(K + (size_t)TJ(1) * 4096, V + (size_t)TJ(1) * 4096); if (tid < 64) breg = (cref - CUM[TJ(1) * 64 + tid]) * LOG2E;
    KV_LSTORE(smem + AT_STAGE); if (tid < 64) biasL[64 + tid] = breg;
    __syncthreads();
#define FOX_QK(P0, P1, jj, sj) do { const float* bl_ = biasL + (sj) * 64; \
        _Pragma("unroll") for (int g4 = 0; g4 < 4; ++g4) { const float4 x_ = *(const float4*)(bl_ + 8 * g4 + 4 * hi), y_ = *(const float4*)(bl_ + 32 + 8 * g4 + 4 * hi); \
            P0[4 * g4] = x_.x; P0[4 * g4 + 1] = x_.y; P0[4 * g4 + 2] = x_.z; P0[4 * g4 + 3] = x_.w; P1[4 * g4] = y_.x; P1[4 * g4 + 1] = y_.y; P1[4 * g4 + 2] = y_.z; P1[4 * g4 + 3] = y_.w; } \
        qk_tile<true>(smem + (sj) * AT_STAGE, qf, P0, P1, lane); \
        if ((jj) >= jmask_w) mask_tile<1>(P0, P1, 64 * (jj), -1, qrow, hi); } while (0)
#define FOX_STEP(CUR0, CUR1, NXT0, NXT1, j, CVD_LD, CVA_LD, CVB_LD, CVD_ST, CVA_ST, CVB_ST) do { \
        const int s_cur = (j) % 3, s_nxt = ((j) + 1) % 3, s_ld = ((j) + 2) % 3; const bool more_ = (j) + 2 < ntiles; \
        if (more_) { KV_GLOAD(K + (size_t)TJ((j) + 2) * 4096, V + (size_t)TJ((j) + 2) * 4096); if (tid < 64) breg = (cref - CUM[TJ((j) + 2) * 64 + tid]) * LOG2E; } \
        { const int c_ = (sidx0 + (j)) * CV_PER_STEP + tid; CVD_LD = nullptr; \
          if (tid < CV_PER_STEP && c_ < CV_NUP + CV_NDN) { const float* cvs_; if (c_ < CV_NUP) { cvs_ = a.in[I_WUP] + (size_t)c_ * 8; CVD_LD = (bf16_t*)(a.ws + WS_WUP) + (size_t)c_ * 8; } else { cvs_ = a.in[I_WDN] + (size_t)(c_ - CV_NUP) * 8; CVD_LD = (bf16_t*)(a.ws + WS_WDN) + (size_t)(c_ - CV_NUP) * 8; } \
              CVA_LD = *(const float4*)cvs_; CVB_LD = *(const float4*)(cvs_ + 4); } } \
        if ((j) + 1 < ntiles && TJ((j) + 1) <= jmax_w) FOX_QK(NXT0, NXT1, TJ((j) + 1), s_nxt); \
        __builtin_amdgcn_sched_barrier(0); \
        if (TJ(j) <= jmax_w) { softmax_step(CUR0, CUR1, m, l, o); pv_tile<false>(smem + s_cur * AT_STAGE + 8192, CUR0, CUR1, o, lane); } \
        if (more_) { KV_LSTORE(smem + s_ld * AT_STAGE); if (tid < 64) biasL[s_ld * 64 + tid] = breg; } \
        if (CVD_ST) { uint4 o_; o_.x = cvtpk(CVA_ST.x, CVA_ST.y); o_.y = cvtpk(CVA_ST.z, CVA_ST.w); o_.z = cvtpk(CVB_ST.x, CVB_ST.y); o_.w = cvtpk(CVB_ST.z, CVB_ST.w); *(uint4*)CVD_ST = o_; CVD_ST = nullptr; } \
        __syncthreads(); } while (0)
    f32x16 pA0, pA1, pB0, pB1;
    if (TJ(0) <= jmax_w) FOX_QK(pA0, pA1, TJ(0), 0);
    for (int j = 0; j < ntiles; j += 2) {
        FOX_STEP(pA0, pA1, pB0, pB1, j, cvdA, cvaA, cvbA, cvdB, cvaB, cvbB);
        FOX_STEP(pB0, pB1, pA0, pA1, j + 1, cvdB, cvaB, cvbB, cvdA, cvaA, cvbA);
    }
    if (cvdB) { uint4 o_; o_.x = cvtpk(cvaB.x, cvaB.y); o_.y = cvtpk(cvaB.z, cvaB.w); o_.z = cvtpk(cvbB.x, cvbB.y); o_.w = cvtpk(cvbB.z, cvbB.w); *(uint4*)cvdB = o_; }
#undef FOX_QK
#undef FOX_STEP
#undef TJ
    const float inv = 1.0f / l; float ss = 0.f;
    const size_t token = (size_t)b * 8192 + qrow;
    bf16_t* O = (bf16_t*)(a.ws + WS_OFOX) + token * 512 + h * 64;
#pragma unroll
    for (int dh = 0; dh < 2; ++dh)
#pragma unroll
        for (int g4 = 0; g4 < 4; ++g4) { const float v0 = o[dh][4 * g4] * inv, v1 = o[dh][4 * g4 + 1] * inv, v2 = o[dh][4 * g4 + 2] * inv, v3 = o[dh][4 * g4 + 3] * inv;
            ss += v0 * v0 + v1 * v1 + v2 * v2 + v3 * v3; uint2 w; w.x = cvtpk(v0, v1); w.y = cvtpk(v2, v3); *(uint2*)(O + 32 * dh + 8 * g4 + 4 * hi) = w; }
    ss = pair_sum(ss);
    if (hi == 0) ((float*)(a.ws + WS_SSQ))[token * 16 + 8 + h] = ss;
}

DEV void nsa_item(const Args& a, unsigned char* smem, int b, int g, int tt) {
    const int tid = TID(), lane = tid & 63, wid = tid >> 6, col = lane & 31, hi = lane >> 5;
    const int t0 = tt * 64, tokw = col >> 2, r = col & 3, h = 4 * g + r; const int tokl = wid * 8 + tokw; const int t = t0 + tokl; const size_t token = (size_t)b * 8192 + t;
    const float slope2 = exp2f(-(float)(h + 1)) * LOG2E;
    const bf16_t* PROJ = (const bf16_t*)(a.ws + WS_PROJ);
    const float* GN = (const float*)(a.ws + WS_GN) + token * 24 + h * 3;
    const int cur = tt; const bool need_topk = cur > 15;
    bf16x8 qf[4];
    { const bf16_t* Q = PROJ + (((size_t)(h * 2 + b)) * 8192 + t) * 64;
#pragma unroll
      for (int ks = 0; ks < 4; ++ks) qf[ks] = *(const bf16x8*)(Q + 16 * ks + 8 * hi); }
    float* impw = (float*)(smem + AT_IMP_OFF) + wid * 2048; float* totw = impw + lane;
    unsigned* selmask = (unsigned*)(smem + AT_SEL_OFF); unsigned* wun = (unsigned*)(smem + AT_WUN_OFF); int* ucnt = (int*)(smem + AT_UCNT_OFF); unsigned char* ulist = smem + AT_ULIST_OFF;
    f32x16 o[2]; float m, l; int par = 0;
    const int tmin_w = t0 + wid * 8, tmax_w = tmin_w + 7;
    {
        const bf16_t* KC = (const bf16_t*)(a.ws + WS_KC) + ((size_t)(0 * 4 + b * 2 + g)) * 512 * 64; const bf16_t* VC = (const bf16_t*)(a.ws + WS_KC) + ((size_t)(1 * 4 + b * 2 + g)) * 512 * 64;
        const int ncv = t0 / 16 + 3; const int nct = (ncv + 63) >> 6;
        auto src = [&](int j, const bf16_t*& kp, const bf16_t*& vp) { kp = KC + (size_t)j * 4096; vp = VC + (size_t)j * 4096; };
        m = -1e30f; l = 0.f;
        auto src0 = [&](const bf16_t*& kp, const bf16_t*& vp) { kp = KC; vp = VC; };
        par = kv_pipeline(smem, nct, src, [&](int j, const unsigned char* st) {
            const int kpos0 = 1024 * j + 31;
            if (kpos0 > tmax_w) return;
            f32x16 p0, p1; alibi_init<16>(p0, p1, slope2, kpos0, t0, hi);
            qk_tile<false>(st, qf, p0, p1, lane);
            if (kpos0 + 16 * 63 > tmin_w) mask_tile<16>(p0, p1, kpos0, -1, t, hi);
            const float mt = rowmax32(p0, p1); const float mn = fmaxf(m, mt); float rs = 0.f;
#pragma unroll
            for (int rr = 0; rr < 16; ++rr) rs += __builtin_amdgcn_exp2f(p0[rr] - mn) + __builtin_amdgcn_exp2f(p1[rr] - mn);
            rs = pair_sum(rs);
            l = l * __builtin_amdgcn_exp2f(m - mn) + rs; m = mn;
        }, 0, false, true, src0);
        const float linv = l > 0.f ? 1.0f / l : 0.f;
        if (need_topk) { for (int i = lane; i < 8 * 129; i += 64) impw[i] = 0.f; }
        o[0] = (f32x16){}; o[1] = (f32x16){};
        const bf16_t* KS0 = PROJ + ((size_t)((12 + g) * 2 + b)) * 8192 * 64 + (size_t)cur * 4096; const bf16_t* VS0 = PROJ + ((size_t)((14 + g) * 2 + b)) * 8192 * 64 + (size_t)cur * 4096;
        par = kv_pipeline(smem, nct, src, [&](int j, const unsigned char* st) {
            const int kpos0 = 1024 * j + 31;
            if (kpos0 > tmax_w) return;
            f32x16 p0, p1; alibi_init<16>(p0, p1, slope2, kpos0, t0, hi);
            qk_tile<false>(st, qf, p0, p1, lane);
            if (kpos0 + 16 * 63 > tmin_w) mask_tile<16>(p0, p1, kpos0, -1, t, hi);
#pragma unroll
            for (int rr = 0; rr < 16; ++rr) { p0[rr] = __builtin_amdgcn_exp2f(p0[rr] - m) * linv; p1[rr] = __builtin_amdgcn_exp2f(p1[rr] - m) * linv; }
            if (need_topk) {
#pragma unroll
                for (int half = 0; half < 2; ++half)
#pragma unroll
                    for (int g4 = 0; g4 < 4; ++g4) { const f32x16& p = half ? p1 : p0;
                        float ms = (p[4 * g4] + p[4 * g4 + 1]) + (p[4 * g4 + 2] + p[4 * g4 + 3]); float ls = p[4 * g4 + 3];
                        ms = quad_sum(ms); ls = quad_sum(ls);
                        const int n = 16 * j + 8 * half + 2 * g4 + hi;
                        if (r == 0) { atomicAdd(&impw[tokw * 129 + n], ms); atomicAdd(&impw[tokw * 129 + n + 1], ls); } }
            }
            pv_tile<false>(st + 8192, p0, p1, o, lane);
        }, par, true, true, [&](const bf16_t*& kp, const bf16_t*& vp) { kp = KS0; vp = VS0; });
    }
    {
        unsigned un0 = 0u, un1 = 0u, un2 = 0u, un3 = 0u;
        if (need_topk) {
            for (int tk = 0; tk < 8; ++tk) {
                float v0 = impw[tk * 129 + lane], v1 = impw[tk * 129 + 64 + lane];
                v0 = (lane >= 1 && lane <= cur - 2) ? v0 : -1.0f; v1 = (lane + 64 <= cur - 2) ? v1 : -1.0f;
                unsigned m0 = 1u, m1 = 0u, m2 = 0u, m3 = 0u;
#define SETBIT(n_) do { const int n__ = (n_); const unsigned bit__ = 1u << (n__ & 31); const int w__ = n__ >> 5; if (w__ == 0) m0 |= bit__; else if (w__ == 1) m1 |= bit__; else if (w__ == 2) m2 |= bit__; else m3 |= bit__; } while (0)
                SETBIT(cur); SETBIT(cur - 1);
                for (int it = 0; it < 13; ++it) {
                    const float mx = wave_max_u(fmaxf(v0, v1));
                    const unsigned long long b0 = __ballot(v0 == mx);
                    int n;
                    if (b0) n = __ffsll((long long)b0) - 1; else { const unsigned long long b1 = __ballot(v1 == mx); n = 64 + __ffsll((long long)b1) - 1; }
                    if (lane == (n & 63)) { if (n < 64) v0 = -1.0f; else v1 = -1.0f; }
                    SETBIT(n);
                }
#undef SETBIT
                if (lane == 0) { unsigned* sm_ = selmask + (wid * 8 + tk) * 4; sm_[0] = m0; sm_[1] = m1; sm_[2] = m2; sm_[3] = m3; }
                un0 |= m0; un1 |= m1; un2 |= m2; un3 |= m3;
            }
        } else {
            const unsigned full = (2u << cur) - 1u;
            un0 = full;
            if (lane < 8) { unsigned* sm_ = selmask + (wid * 8 + lane) * 4; sm_[0] = full; sm_[1] = 0u; sm_[2] = 0u; sm_[3] = 0u; }
        }
        if (lane == 0) { wun[wid * 4] = un0; wun[wid * 4 + 1] = un1; wun[wid * 4 + 2] = un2; wun[wid * 4 + 3] = un3; }
        __syncthreads();
        if (tid == 0) { int c = 0;
            for (int w = 0; w < 4; ++w) { unsigned u = 0u; for (int ww = 0; ww < NWAVE; ++ww) u |= wun[ww * 4 + w]; for (int bb = 0; bb < 32; ++bb) if ((u >> bb) & 1u) ulist[c++] = (unsigned char)(w * 32 + bb); }
            ucnt[0] = c; }
        __syncthreads();
    }
    { const float g0 = GN[0];
#pragma unroll
      for (int rr = 0; rr < 16; ++rr) { totw[rr * 64] = o[0][rr] * g0; totw[(16 + rr) * 64] = o[1][rr] * g0; } }
    {
        const bf16_t* KS = PROJ + ((size_t)((12 + g) * 2 + b)) * 8192 * 64; const bf16_t* VS = PROJ + ((size_t)((14 + g) * 2 + b)) * 8192 * 64;
        const int nu = ucnt[0];
        m = -1e30f; l = 0.f; o[0] = (f32x16){}; o[1] = (f32x16){};
        const bf16_t* KW0 = PROJ + ((size_t)((16 + g) * 2 + b)) * 8192 * 64 + (size_t)cur * 4096; const bf16_t* VW0 = PROJ + ((size_t)((18 + g) * 2 + b)) * 8192 * 64 + (size_t)cur * 4096;
        par = kv_pipeline(smem, nu, [&](int j, const bf16_t*& kp, const bf16_t*& vp) { const int n = ulist[nu - 1 - j]; kp = KS + (size_t)n * 4096; vp = VS + (size_t)n * 4096; },
            [&](int j, const unsigned char* st) {
                const int n = ulist[nu - 1 - j];
                if (!((wun[wid * 4 + (n >> 5)] >> (n & 31)) & 1u)) return;
                const bool sel = (selmask[tokl * 4 + (n >> 5)] >> (n & 31)) & 1u;
                f32x16 p0, p1; alibi_init<1>(p0, p1, slope2, 64 * n, t0, hi);
                qk_tile<false>(st, qf, p0, p1, lane);
                if (n == cur || !__all(sel)) mask_tile<1>(p0, p1, 64 * n, -1, sel ? t : -1, hi);
                softmax_step(p0, p1, m, l, o);
                pv_tile<false>(st + 8192, p0, p1, o, lane);
            }, par, true, true, [&](const bf16_t*& kp, const bf16_t*& vp) { kp = KW0; vp = VW0; });
        const float g1 = GN[1] / fmaxf(l, 1e-30f);
#pragma unroll
        for (int rr = 0; rr < 16; ++rr) { totw[rr * 64] += o[0][rr] * g1; totw[(16 + rr) * 64] += o[1][rr] * g1; }
    }
    {
        const bf16_t* KW = PROJ + ((size_t)((16 + g) * 2 + b)) * 8192 * 64; const bf16_t* VW = PROJ + ((size_t)((18 + g) * 2 + b)) * 8192 * 64;
        const int jlo = (t0 - 511) > 0 ? ((t0 - 511) >> 6) : 0; const int jhi = cur;
        m = -1e30f; l = 0.f; o[0] = (f32x16){}; o[1] = (f32x16){};
        (void)kv_pipeline(smem, jhi - jlo + 1, [&](int j, const bf16_t*& kp, const bf16_t*& vp) { kp = KW + (size_t)(jhi - j) * 4096; vp = VW + (size_t)(jhi - j) * 4096; },
            [&](int j, const unsigned char* st) {
                const int kpos0 = 64 * (jhi - j);
                if (kpos0 > tmax_w || kpos0 + 63 < tmin_w - 511) return;
                f32x16 p0, p1; alibi_init<1>(p0, p1, slope2, kpos0, t0, hi);
                qk_tile<false>(st, qf, p0, p1, lane);
                if (kpos0 < tmax_w - 511 || kpos0 + 63 > tmin_w) mask_tile<1>(p0, p1, kpos0, t - 511, t, hi);
                softmax_step(p0, p1, m, l, o);
                pv_tile<false>(st + 8192, p0, p1, o, lane);
            }, par, true, false, NoSrc());
        const float g2 = GN[2] / fmaxf(l, 1e-30f);
#pragma unroll
        for (int rr = 0; rr < 16; ++rr) { o[0][rr] = totw[rr * 64] + o[0][rr] * g2; o[1][rr] = totw[(16 + rr) * 64] + o[1][rr] * g2; }
    }
    {
        float ss = 0.f; bf16_t* O = (bf16_t*)(a.ws + WS_ONSA) + token * 512 + h * 64;
#pragma unroll
        for (int dh = 0; dh < 2; ++dh)
#pragma unroll
            for (int g4 = 0; g4 < 4; ++g4) { const float v0 = o[dh][4 * g4], v1 = o[dh][4 * g4 + 1], v2 = o[dh][4 * g4 + 2], v3 = o[dh][4 * g4 + 3];
                ss += v0 * v0 + v1 * v1 + v2 * v2 + v3 * v3; uint2 w; w.x = cvtpk(v0, v1); w.y = cvtpk(v2, v3); *(uint2*)(O + 32 * dh + 8 * g4 + 4 * hi) = w; }
        ss = pair_sum(ss);
        if (hi == 0) ((float*)(a.ws + WS_SSQ))[token * 16 + h] = ss;
    }
}
#ifndef PROBE_DUP
#define PROBE_DUP 0
#endif
DEV void phase_att(const Args& a, unsigned char* smem) {
    int* qctr = (int*)(a.ws + WS_CTL) + 64; int* sitem = (int*)(smem + AT_ITEM_OFF);
    unsigned* ctl = (unsigned*)(a.ws + WS_CTL); unsigned* seen = (unsigned*)(smem + AT_ITEM_OFF + 8);
    if (TID() == 0) seen[0] = 0u;
    for (;;) {
        if (TID() == 0) sitem[0] = atomicAdd(qctr, 1);
        __syncthreads();
        const int item = sitem[0];
        __syncthreads();
        if (item >= 32 + 1024) break;
        if (item < 16) cmp_item(a, smem, 16 + item);
        else if (item < 32) cmp_item(a, smem, item - 16);
        else if (item < 32 + 512) { const int fi = item - 32; const int qb = 31 - (fi >> 4), bh = fi & 15; if (!((seen[0] >> bh) & 1u)) { wait_flag(ctl + CW_CUMFLAG + bh, 1u); if (TID() == 0) seen[0] |= 1u << bh; } fox_item(a, smem, fi, bh >> 3, bh & 7, qb); }
        else { const int idx = item - 32 - 512; const int tt = 127 - (idx >> 2), bg = idx & 3; if (!((seen[0] >> 16) & 1u)) { wait_flag(ctl + CW_CMPFLAG, 16u); if (TID() == 0) seen[0] |= 1u << 16; } nsa_item(a, smem, bg >> 1, bg & 1, tt); }
    }
}

DEV void phase_outproj(const Args& a, unsigned char* smem) {
    const bf16_t* ONSA = (const bf16_t*)(a.ws + WS_ONSA); const bf16_t* OFOX = (const bf16_t*)(a.ws + WS_OFOX); const float* SSQ = (const float*)(a.ws + WS_SSQ);
    const bf16_t* W = (const bf16_t*)(a.ws + WS_WOUT); float* H1 = (float*)(a.ws + WS_H1); const float* X = a.in[I_X];
    float* rs = (float*)(smem + MISC_OFF);
    const int tid = TID(); int lane = tid & 63, wid = tid >> 6, wr = wid >> 2, wc = wid & 3; (void)wr; (void)wc; (void)lane;
    auto aoffo = [](int r, int kc) { return (unsigned)(r * 1024 + kc * 16); }; auto boffo = [](int k, int nc) { return (unsigned)(k * 2048 + nc * 16); };
    for (int item = VBID(); item < 64 * 4; item += gridDim.x) {
        int mt, nt; patch_decode(item, 64, 4, mt, nt);
        gemm256_issue0(smem, ONSA + (size_t)mt * 256 * 512, aoffo, W + nt * 256, boffo);
        if (tid < 256) { const float* s_ = SSQ + (size_t)(mt * 256 + tid) * 16; float sn = 0.f, sf = 0.f;
#pragma unroll
            for (int j = 0; j < 8; ++j) { sn += s_[j]; sf += s_[8 + j]; }
            rs[tid * 2] = rsqrtf(sn * (1.f / 512.f) + EPS); rs[tid * 2 + 1] = rsqrtf(sf * (1.f / 512.f) + EPS); }
        asm volatile("s_waitcnt vmcnt(0)" ::: "memory");
        __syncthreads();
        f32x4 acc[8][4];
#pragma unroll
        for (int mi = 0; mi < 8; ++mi) { const size_t gm = (size_t)mt * 256 + wr * 128 + mi * 16 + (lane & 15);
#pragma unroll
            for (int ni = 0; ni < 4; ++ni) { const int n = nt * 256 + wc * 64 + ni * 16 + 4 * (lane >> 4); const float4 x = *(const float4*)(X + gm * 1024 + n); acc[mi][ni] = (f32x4){x.x, x.y, x.z, x.w}; } }
#pragma unroll
        for (int mi = 0; mi < 8; ++mi) { const float ri = 1.0f / rs[(wr * 128 + mi * 16 + (lane & 15)) * 2];
#pragma unroll
            for (int ni = 0; ni < 4; ++ni) acc[mi][ni] *= ri; }
        gemm256<false>(smem, 8, ONSA + (size_t)mt * 256 * 512, 128u, aoffo, W + nt * 256, 64u * 2048u, boffo, acc, true,
                       [&]() { gemm256_issue0(smem, OFOX + (size_t)mt * 256 * 512, aoffo, W + (size_t)512 * 1024 + nt * 256, boffo); });
        EPI_IDS();
#pragma unroll
        for (int mi = 0; mi < 8; ++mi) { const int rl = wr * 128 + mi * 16 + (lane & 15); const float rat = rs[rl * 2] / rs[rl * 2 + 1];
#pragma unroll
            for (int ni = 0; ni < 4; ++ni) acc[mi][ni] *= rat; }
        gemm256<false>(smem, 8, OFOX + (size_t)mt * 256 * 512, 128u, aoffo, W + (size_t)512 * 1024 + nt * 256, 64u * 2048u, boffo, acc, true);
        EPI_IDS();
#pragma unroll
        for (int mi = 0; mi < 8; ++mi) { const int rl = wr * 128 + mi * 16 + (lane & 15); const size_t gm = (size_t)mt * 256 + rl; const float rf = rs[rl * 2 + 1];
#pragma unroll
            for (int ni = 0; ni < 4; ++ni) { const int n = nt * 256 + wc * 64 + ni * 16 + 4 * (lane >> 4); const f32x4 v = acc[mi][ni] * rf;
                float4 o = {v[0], v[1], v[2], v[3]}; *(float4*)(H1 + gm * 1024 + n) = o; } }
        __syncthreads();
    }
}

DEV void phase_route(const Args& a, unsigned char* smem) {
    const float* H1 = (const float*)(a.ws + WS_H1); bf16_t* XN = (bf16_t*)(a.ws + WS_XN); float* RSTD2 = (float*)(a.ws + WS_RSTD2);
    const float* ln2 = a.in[I_LN2]; const float* wr_ = a.in[I_WR]; const float* br = a.in[I_BR];
    int* CNT = (int*)(a.ws + WS_CTL);
    int* TOPI = (int*)(a.ws + WS_TOPI); int* TOPS = (int*)(a.ws + WS_TOPS); float* TOPW = (float*)(a.ws + WS_TOPW);
    int* TOKOF = (int*)(a.ws + WS_TOKOF); float* ROWW = (float*)(a.ws + WS_ROWW);
    float* part = (float*)smem;
    float* ssqp = part + 8 * 32 * 33;
    int* lcnt = (int*)(ssqp + 256); int* lbase = lcnt + 32; int* te = lbase + 32; int* trk = te + 256; float* tw = (float*)(trk + 256);
    const int tid = TID(), lane = tid & 63, wid = tid >> 6, i32 = lane & 31, kh = lane >> 5; const int tg = wid >> 2, kq = wid & 3;
    for (int item = BID(); item < 256; item += gridDim.x) {
        const int tok = item * 64 + tg * 32 + i32;
        if (tid < 32) lcnt[tid] = 0;
        f32x16 acc = (f32x16){}; float ss = 0.f;
        const float* hrow = H1 + (size_t)tok * 1024 + 256 * kq + 4 * kh; const float* lrow = ln2 + 256 * kq + 4 * kh; bf16_t* xrow = XN + (size_t)tok * 1024 + 256 * kq + 4 * kh;
        const float* wbase = wr_ + (size_t)(256 * kq + 4 * kh) * 32 + i32;
#pragma unroll 4
        for (int c = 0; c < 32; ++c) {
            const float4 hv = *(const float4*)(hrow + 8 * c); const float4 lv = *(const float4*)(lrow + 8 * c);
            ss += hv.x * hv.x + hv.y * hv.y + hv.z * hv.z + hv.w * hv.w;
            const float x0 = hv.x * lv.x, x1 = hv.y * lv.y, x2 = hv.z * lv.z, x3 = hv.w * lv.w;
            uint2 o; o.x = cvtpk(x0, x1); o.y = cvtpk(x2, x3); *(uint2*)(xrow + 8 * c) = o;
            const float* wp = wbase + (size_t)(8 * c) * 32;
            const float w0 = wp[0], w1 = wp[32], w2 = wp[64], w3 = wp[96];
            acc = __builtin_amdgcn_mfma_f32_32x32x2f32(x0, w0, acc, 0, 0, 0);
            acc = __builtin_amdgcn_mfma_f32_32x32x2f32(x1, w1, acc, 0, 0, 0);
            acc = __builtin_amdgcn_mfma_f32_32x32x2f32(x2, w2, acc, 0, 0, 0);
            acc = __builtin_amdgcn_mfma_f32_32x32x2f32(x3, w3, acc, 0, 0, 0);
        }
        ss = pair_sum(ss);
        if (kh == 0) ssqp[wid * 32 + i32] = ss;
#pragma unroll
        for (int r = 0; r < 16; ++r) part[(wid * 32 + crow(r, kh)) * 33 + i32] = acc[r];
        __syncthreads();
        if (tid < 64) {
            const int g_ = tid >> 5, i_ = tid & 31; const int w0_ = g_ * 4;
            const float sq = ssqp[(w0_ + 0) * 32 + i_] + ssqp[(w0_ + 1) * 32 + i_] + ssqp[(w0_ + 2) * 32 + i_] + ssqp[(w0_ + 3) * 32 + i_]; const float rstd = rsqrtf(sq * (1.f / 1024.f) + EPS);
            RSTD2[item * 64 + tid] = rstd;
            float lg[32];
#pragma unroll
            for (int e = 0; e < 32; ++e) lg[e] = (part[((w0_ + 0) * 32 + i_) * 33 + e] + part[((w0_ + 1) * 32 + i_) * 33 + e] + part[((w0_ + 2) * 32 + i_) * 33 + e] + part[((w0_ + 3) * 32 + i_) * 33 + e]) * rstd + br[e];
            unsigned taken = 0u; float tv[4]; int ti[4];
#pragma unroll
            for (int k = 0; k < 4; ++k) { float best = -3.0e38f; int bi = 0;
#pragma unroll
                for (int e = 0; e < 32; ++e) { const bool ok = !((taken >> e) & 1u) && lg[e] > best; best = ok ? lg[e] : best; bi = ok ? e : bi; }
                taken |= 1u << bi; tv[k] = best; ti[k] = bi; }
            const float e1 = __expf(tv[1] - tv[0]), e2 = __expf(tv[2] - tv[0]), e3 = __expf(tv[3] - tv[0]); const float inv = 1.0f / (1.0f + e1 + e2 + e3);
            const float wv[4] = {inv, e1 * inv, e2 * inv, e3 * inv};
#pragma unroll
            for (int k = 0; k < 4; ++k) { const int idx = tid * 4 + k; te[idx] = ti[k]; trk[idx] = atomicAdd(&lcnt[ti[k]], 1); tw[idx] = wv[k]; }
        }
        __syncthreads();
        if (tid < 32) lbase[tid] = atomicAdd(&CNT[tid], lcnt[tid]);
        __syncthreads();
        if (tid < 256) { const int idx = tid; const int tk = item * 64 + (idx >> 2); const int e = te[idx]; const int slot = lbase[e] + trk[idx];
          TOPI[(size_t)tk * 4 + (idx & 3)] = e; TOPS[(size_t)tk * 4 + (idx & 3)] = slot; TOPW[(size_t)tk * 4 + (idx & 3)] = tw[idx];
          TOKOF[(size_t)e * 16384 + slot] = tk; ROWW[(size_t)e * 16384 + slot] = tw[idx]; }
        __syncthreads();
    }
}

struct MoeMap { int e, mt, nt, cnt, off; };
DEV void moe_setup(const Args& a, int* sm) {
    if (TID() == 0) { const int* CNT = (const int*)(a.ws + WS_CTL); int tot = 0; for (int e = 0; e < 32; ++e) { const int c = CNT[e]; const int mt = (c + 255) >> 8; sm[e] = mt; sm[32 + e] = tot; tot += mt; } sm[64] = tot; }
    __syncthreads();
}
DEV MoeMap moe_map(const Args& a, const int* sm, int item, int NT) {
    MoeMap mm; int e = 0;
#pragma unroll 1
    for (int i = 1; i < 32; ++i) if (item >= sm[32 + i] * NT) e = i;
    const int local = item - sm[32 + e] * NT; const int mte = sm[e];
    int mt_, nt_; patch_decode(local, mte, NT, mt_, nt_);
    mm.e = __builtin_amdgcn_readfirstlane(e); mm.mt = __builtin_amdgcn_readfirstlane(mt_); mm.nt = __builtin_amdgcn_readfirstlane(nt_);
    mm.cnt = __builtin_amdgcn_readfirstlane(((const int*)(a.ws + WS_CTL))[e]); mm.off = __builtin_amdgcn_readfirstlane(sm[32 + e] * 256); return mm;
}
DEV void phase_up(const Args& a, unsigned char* smem) {
    int* sm = (int*)(smem + MISC_OFF); int* tokb = sm + 128; float* rsdb = (float*)(tokb + 512);
    const bf16_t* XN = (const bf16_t*)(a.ws + WS_XN); const bf16_t* W = (const bf16_t*)(a.ws + WS_WUP); bf16_t* ACT = (bf16_t*)(a.ws + WS_ACT); const float* RSTD2 = (const float*)(a.ws + WS_RSTD2);
    const int* TOKOF = (const int*)(a.ws + WS_TOKOF); const float* bup = a.in[I_BUP];
    const int tid = TID(); int lane = tid & 63, wid = tid >> 6, wr = wid >> 2, wc = wid & 3; (void)wr; (void)wc; (void)lane;
    moe_setup(a, sm);
    const int nitems = __builtin_amdgcn_readfirstlane(sm[64]) * 8;
    auto fill = [&](const MoeMap& m_, int buf) { if (tid < 256) { const int slot = m_.mt * 256 + tid; const int tk_ = slot < m_.cnt ? TOKOF[(size_t)m_.e * 16384 + slot] : 0; tokb[buf * 256 + tid] = tk_; rsdb[buf * 256 + tid] = RSTD2[tk_]; } };
    auto boffu = [](int k, int nc) { const int ni = (nc >> 1) & 3; const int sc = ((ni >> 1) ? 1024 : 0) + (nc >> 3) * 32 + (ni & 1) * 16 + (nc & 1) * 8; return (unsigned)(k * 4096 + sc * 2); };
    int item = VBID(); int buf = 0; bool pre = false; MoeMap mm{};
    if (item < nitems) { mm = moe_map(a, sm, item, 8); fill(mm, 0); }
    __syncthreads();
    while (item < nitems) {
        const int nitem = item + (int)gridDim.x; const bool has_next = nitem < nitems; MoeMap mn{};
        if (has_next) { mn = moe_map(a, sm, nitem, 8); fill(mn, buf ^ 1); }
        const int* tok = tokb + buf * 256; const int* tokn = tokb + (buf ^ 1) * 256; const float* rsd = rsdb + buf * 256;
        const bf16_t* We = W + (size_t)mm.e * 1024 * 2048; const bf16_t* Wn = W + (size_t)mn.e * 1024 * 2048;
        f32x4 acc[8][4];
        gemm256<true>(smem, 16, XN, 128u, [&](int r, int kc) { return (unsigned)(tok[r] * 2048 + kc * 16); }, We + mm.nt * 128, 64u * 4096u, boffu, acc, pre,
                      [&]() { if (has_next) gemm256_issue0(smem, XN, [&](int r, int kc) { return (unsigned)(tokn[r] * 2048 + kc * 16); }, Wn + mn.nt * 128, boffu); });
        EPI_IDS();
#pragma unroll
        for (int mi = 0; mi < 8; ++mi) { const int rl_ = wr * 128 + mi * 16 + (lane & 15); const size_t row = (size_t)mm.off + mm.mt * 256 + rl_; const float rs_ = rsd[rl_];
#pragma unroll
            for (int ni = 0; ni < 2; ++ni) { const int jc = mm.nt * 128 + wc * 32 + ni * 16 + 4 * (lane >> 4);
                const float4 bg = *(const float4*)(bup + (size_t)mm.e * 2048 + jc), bl_ = *(const float4*)(bup + (size_t)mm.e * 2048 + 1024 + jc);
                const f32x4 gv = acc[mi][ni], lv = acc[mi][ni + 2]; const float bgv[4] = {bg.x, bg.y, bg.z, bg.w}, blv[4] = {bl_.x, bl_.y, bl_.z, bl_.w}; float r4[4];
#pragma unroll
                for (int r = 0; r < 4; ++r) { const float gg = fminf(gv[r] * rs_ + bgv[r], 7.0f); const float ll = fminf(fmaxf(lv[r] * rs_ + blv[r], -7.0f), 7.0f); r4[r] = gg * sigmoidf_(1.702f * gg) * (ll + 1.0f); }
                uint2 o; o.x = cvtpk(r4[0], r4[1]); o.y = cvtpk(r4[2], r4[3]); *(uint2*)(ACT + row * 1024 + jc) = o; } }
        __syncthreads();
        item = nitem; mm = mn; buf ^= 1; pre = has_next;
    }
}
DEV void phase_down(const Args& a, unsigned char* smem) {
    int* sm = (int*)(smem + MISC_OFF); float* rwb = (float*)(sm + 128);
    const bf16_t* ACT = (const bf16_t*)(a.ws + WS_ACT); const bf16_t* W = (const bf16_t*)(a.ws + WS_WDN); bf16_t* Y = (bf16_t*)(a.ws + WS_Y);
    const float* ROWW = (const float*)(a.ws + WS_ROWW); const float* bdn = a.in[I_BDN];
    const int tid = TID(); int lane = tid & 63, wid = tid >> 6, wr = wid >> 2, wc = wid & 3; (void)wr; (void)wc; (void)lane;
    moe_setup(a, sm);
    const int nitems = __builtin_amdgcn_readfirstlane(sm[64]) * 4;
    auto fill = [&](const MoeMap& m_, int buf) { if (tid < 256) { const int slot = m_.mt * 256 + tid; rwb[buf * 256 + tid] = slot < m_.cnt ? ROWW[(size_t)m_.e * 16384 + slot] : 0.f; } };
    auto aoffd = [](int r, int kc) { return (unsigned)(r * 2048 + kc * 16); }; auto boffd = [](int k, int nc) { return (unsigned)(k * 2048 + nc * 16); };
    int item = VBID(); int buf = 0; bool pre = false; MoeMap mm{};
    if (item < nitems) { mm = moe_map(a, sm, item, 4); fill(mm, 0); }
    __syncthreads();
    while (item < nitems) {
        const int nitem = item + (int)gridDim.x; const bool has_next = nitem < nitems; MoeMap mn{};
        if (has_next) { mn = moe_map(a, sm, nitem, 4); fill(mn, buf ^ 1); }
        const float* rw = rwb + buf * 256;
        const bf16_t* We = W + (size_t)mm.e * 1024 * 1024; const bf16_t* Ab = ACT + ((size_t)mm.off + mm.mt * 256) * 1024;
        const bf16_t* Wn = W + (size_t)mn.e * 1024 * 1024; const bf16_t* An = ACT + ((size_t)mn.off + mn.mt * 256) * 1024;
        f32x4 acc[8][4];
        gemm256<true>(smem, 16, Ab, 128u, aoffd, We + mm.nt * 256, 64u * 2048u, boffd, acc, pre,
                      [&]() { if (has_next) gemm256_issue0(smem, An, aoffd, Wn + mn.nt * 256, boffd); });
        EPI_IDS();
#pragma unroll
        for (int mi = 0; mi < 8; ++mi) { const int rl = wr * 128 + mi * 16 + (lane & 15); const size_t row = (size_t)mm.off + mm.mt * 256 + rl; const float w = rw[rl];
#pragma unroll
            for (int ni = 0; ni < 4; ++ni) { const int n = mm.nt * 256 + wc * 64 + ni * 16 + 4 * (lane >> 4); const float4 bb = *(const float4*)(bdn + (size_t)mm.e * 1024 + n); const f32x4 v = acc[mi][ni];
                uint2 o; o.x = cvtpk((v[0] + bb.x) * w, (v[1] + bb.y) * w); o.y = cvtpk((v[2] + bb.z) * w, (v[3] + bb.w) * w); *(uint2*)(Y + row * 1024 + n) = o; } }
        __syncthreads();
        item = nitem; mm = mn; buf ^= 1; pre = has_next;
    }
}

DEV void phase_comb(const Args& a, unsigned char* smem) {
    int* sm = (int*)(smem + MISC_OFF);
    moe_setup(a, sm);
    float* H1 = (float*)(a.ws + WS_H1); bf16_t* XN = (bf16_t*)(a.ws + WS_XN); const bf16_t* Y = (const bf16_t*)(a.ws + WS_Y);
    const int* TOPI = (const int*)(a.ws + WS_TOPI); const int* TOPS = (const int*)(a.ws + WS_TOPS); const float* g = a.in[I_LNPLE];
    const int lane = TID() & 63; const int gw = BID() * NWAVE + (TID() >> 6), ngw = gridDim.x * NWAVE;
    for (int tok = gw; tok < NTOK; tok += ngw) {
        float4 v[4];
#pragma unroll
        for (int j = 0; j < 4; ++j) v[j] = *(const float4*)(H1 + (size_t)tok * 1024 + j * 256 + lane * 4);
#pragma unroll
        for (int k = 0; k < 4; ++k) { const int e = TOPI[(size_t)tok * 4 + k]; const size_t row = (size_t)sm[32 + e] * 256 + TOPS[(size_t)tok * 4 + k];
#pragma unroll
            for (int j = 0; j < 4; ++j) { const uint2 u = *(const uint2*)(Y + row * 1024 + j * 256 + lane * 4); v[j].x += bflo(u.x); v[j].y += bfhi(u.x); v[j].z += bflo(u.y); v[j].w += bfhi(u.y); } }
        float s = 0.f;
#pragma unroll
        for (int j = 0; j < 4; ++j) { *(float4*)(H1 + (size_t)tok * 1024 + j * 256 + lane * 4) = v[j]; s += v[j].x * v[j].x + v[j].y * v[j].y + v[j].z * v[j].z + v[j].w * v[j].w; }
        const float rstd = rsqrtf(wave_sum(s) * (1.f / 1024.f) + EPS);
#pragma unroll
        for (int j = 0; j < 4; ++j) { const float4 gg = *(const float4*)(g + j * 256 + lane * 4);
            uint2 o; o.x = cvtpk(v[j].x * rstd * gg.x, v[j].y * rstd * gg.y); o.y = cvtpk(v[j].z * rstd * gg.z, v[j].w * rstd * gg.w); *(uint2*)(XN + (size_t)tok * 1024 + j * 256 + lane * 4) = o; }
    }
}

DEV void phase_gate(const Args& a, unsigned char* smem) {
    const bf16_t* XN = (const bf16_t*)(a.ws + WS_XN); const bf16_t* WG = (const bf16_t*)(a.ws + WS_WGATE); const bf16_t* PB = (const bf16_t*)(a.ws + WS_PB); const bf16_t* WP = (const bf16_t*)(a.ws + WS_WPLE);
    const float* H2 = (const float*)(a.ws + WS_H1); float* OUT = a.out; float* SSQ3 = (float*)(a.ws + WS_SSQ3);
    const int tid = TID(); int lane = tid & 63, wid = tid >> 6, wr = wid >> 2, wc = wid & 3; (void)wr; (void)wc; (void)lane;
    bf16_t* GT = (bf16_t*)(a.ws + WS_ACT);
    auto aoffg = [](int r, int kc) { return (unsigned)(r * 2048 + kc * 16); }; auto aoffp = [](int r, int kc) { return (unsigned)(r * 512 + kc * 16); }; auto boffg = [](int k, int nc) { return (unsigned)(k * 2048 + nc * 16); };
    for (int item = VBID(); item < 64 * 4; item += gridDim.x) {
        int mt, nt; patch_decode(item, 64, 4, mt, nt);
        f32x4 acc[8][4];
        gemm256<true>(smem, 16, XN + (size_t)mt * 256 * 1024, 128u, aoffg, WG + nt * 256, 64u * 2048u, boffg, acc, false,
                      [&]() { gemm256_issue0(smem, PB + (size_t)mt * 256 * 256, aoffp, WP + nt * 256, boffg); });
        EPI_IDS();
#pragma unroll
        for (int mi = 0; mi < 8; ++mi) { const size_t gm = (size_t)mt * 256 + wr * 128 + mi * 16 + (lane & 15);
#pragma unroll
            for (int ni = 0; ni < 4; ++ni) { const int n = nt * 256 + wc * 64 + ni * 16 + 4 * (lane >> 4); const f32x4 v = acc[mi][ni];
                uint2 w; w.x = cvtpk(sigmoidf_(v[0]), sigmoidf_(v[1])); w.y = cvtpk(sigmoidf_(v[2]), sigmoidf_(v[3])); *(uint2*)(GT + gm * 1024 + n) = w;
                const float4 h = *(const float4*)(H2 + gm * 1024 + n);
                acc[mi][ni] = (f32x4){h.x * __builtin_amdgcn_rcpf(bflo(w.x)), h.y * __builtin_amdgcn_rcpf(bfhi(w.x)), h.z * __builtin_amdgcn_rcpf(bflo(w.y)), h.w * __builtin_amdgcn_rcpf(bfhi(w.y))}; }
            asm volatile("" ::: "memory"); }
        gemm256<false>(smem, 4, PB + (size_t)mt * 256 * 256, 128u, aoffp, WP + nt * 256, 64u * 2048u, boffg, acc, true);
        EPI_IDS();
        const bool fused = gridDim.x >= 256;
#pragma unroll
        for (int mi = 0; mi < 8; ++mi) { const size_t gm = (size_t)mt * 256 + wr * 128 + mi * 16 + (lane & 15); float ss = 0.f;
#pragma unroll
            for (int ni = 0; ni < 4; ++ni) { const int n = nt * 256 + wc * 64 + ni * 16 + 4 * (lane >> 4); const f32x4 v = acc[mi][ni];
                const uint2 gw = *(const uint2*)(GT + gm * 1024 + n);
                float4 o = {v[0] * bflo(gw.x), v[1] * bfhi(gw.x), v[2] * bflo(gw.y), v[3] * bfhi(gw.y)};
                if (!fused) *(float4*)(OUT + gm * 1024 + n) = o;
                acc[mi][ni] = (f32x4){o.x, o.y, o.z, o.w};
                ss += o.x * o.x + o.y * o.y + o.z * o.z + o.w * o.w; }
            ss += __shfl_xor(ss, 16); ss += __shfl_xor(ss, 32);
            if (lane < 16) SSQ3[gm * 16 + nt * 4 + wc] = ss;
            asm volatile("" ::: "memory"); }
        if (fused) {
            unsigned* flag = (unsigned*)(a.ws + WS_CTL) + CW_GATEFLAG + mt;
            signal_done(flag); wait_flag(flag, 4u);
            const float* lnf = a.in[I_LNF];
#pragma unroll
            for (int mi = 0; mi < 8; ++mi) { const size_t gm = (size_t)mt * 256 + wr * 128 + mi * 16 + (lane & 15);
                const float4 s0 = *(const float4*)(SSQ3 + gm * 16), s1 = *(const float4*)(SSQ3 + gm * 16 + 4), s2 = *(const float4*)(SSQ3 + gm * 16 + 8), s3 = *(const float4*)(SSQ3 + gm * 16 + 12);
                const float tot = ((s0.x + s0.y) + (s0.z + s0.w)) + ((s1.x + s1.y) + (s1.z + s1.w)) + ((s2.x + s2.y) + (s2.z + s2.w)) + ((s3.x + s3.y) + (s3.z + s3.w));
                const float rstd = rsqrtf(tot * (1.f / 1024.f) + EPS);
#pragma unroll
                for (int ni = 0; ni < 4; ++ni) { const int n = nt * 256 + wc * 64 + ni * 16 + 4 * (lane >> 4); const float4 gg = *(const float4*)(lnf + n); const f32x4 v = acc[mi][ni];
                    float4 o = {v[0] * rstd * gg.x, v[1] * rstd * gg.y, v[2] * rstd * gg.z, v[3] * rstd * gg.w}; *(float4*)(OUT + gm * 1024 + n) = o; }
                asm volatile("" ::: "memory"); }
        }
        __syncthreads();
    }
}

DEV void phase_final(const Args& a) {
    if (gridDim.x >= 256) return;
    float* OUT = a.out; const float* SSQ3 = (const float*)(a.ws + WS_SSQ3); const float* g = a.in[I_LNF];
    const int lane = TID() & 63; const int gw = BID() * NWAVE + (TID() >> 6), ngw = gridDim.x * NWAVE;
    for (int m = gw; m < NTOK; m += ngw) {
        float s = 0.f;
#pragma unroll
        for (int j = 0; j < 16; ++j) s += SSQ3[(size_t)m * 16 + j];
        const float rstd = rsqrtf(s * (1.f / 1024.f) + EPS);
#pragma unroll
        for (int j = 0; j < 4; ++j) { float4 v = *(const float4*)(OUT + (size_t)m * 1024 + j * 256 + lane * 4); const float4 gg = *(const float4*)(g + j * 256 + lane * 4);
            v.x *= rstd * gg.x; v.y *= rstd * gg.y; v.z *= rstd * gg.z; v.w *= rstd * gg.w; *(float4*)(OUT + (size_t)m * 1024 + j * 256 + lane * 4) = v; }
    }
}

template <int PH> DEV void run_phase(const Args& a, unsigned char* smem) {
    if constexpr (PH == PH_PRO) phase_prologue(a, smem);
    else if constexpr (PH == PH_INPROJ) phase_inproj(a, smem);
    else if constexpr (PH == PH_ATT) phase_att(a, smem);
    else if constexpr (PH == PH_OUTPROJ) phase_outproj(a, smem);
    else if constexpr (PH == PH_ROUTE) phase_route(a, smem);
    else if constexpr (PH == PH_UP) phase_up(a, smem);
    else if constexpr (PH == PH_DOWN) phase_down(a, smem);
    else if constexpr (PH == PH_COMB) phase_comb(a, smem);
    else if constexpr (PH == PH_GATE) phase_gate(a, smem);
    else if constexpr (PH == PH_FINAL) phase_final(a);
}
#define XB_TMO      128
#define XB_XCNT(j)  (256  + 64 * (j))
#define XB_XSUB(j)  (1280 + 64 * (j))
#define XB_XGEN(j)  (2304 + 64 * (j))
#define XB_TOP      3328
#define XB_TOPGEN   3392
#define XCD_BAR_WORDS 3456
#define XB_SPIN_CAP (1u << 22)
DEV unsigned xb_ld(unsigned* p)              { return __hip_atomic_load(p, __ATOMIC_RELAXED, __HIP_MEMORY_SCOPE_AGENT); }
DEV unsigned xb_add(unsigned* p, unsigned v) { return __hip_atomic_fetch_add(p, v, __ATOMIC_RELAXED, __HIP_MEMORY_SCOPE_AGENT); }
DEV unsigned xb_xcc_id() { return (unsigned)__builtin_amdgcn_s_getreg((3 << 11) | 20) & 0xFu; }
#define XB_SPIN(cond, bar) do { unsigned _sp = 0; while (cond) { __builtin_amdgcn_s_sleep(1); \
    if ((++_sp & 255u) == 0u) { if (xb_ld(&(bar)[XB_TMO])) break; if (_sp > XB_SPIN_CAP) { atomicAdd(&(bar)[XB_TMO], 1u); break; } } } } while (0)
struct XcdBarrier { unsigned* bar; unsigned x; volatile LAS unsigned* st; };
DEV XcdBarrier xcd_barrier_post(unsigned* bar, volatile LAS unsigned* st) {
    XcdBarrier b; b.bar = bar; b.x = xb_xcc_id(); b.st = st;
    if (TID() == 0) (void)xb_add(&bar[XB_XCNT(b.x)], 1u);
    return b;
}
DEV void xcd_barrier_complete(unsigned* bar, unsigned x, unsigned& nloc, unsigned& nx) {
    const unsigned G = gridDim.x * gridDim.y * gridDim.z;
    unsigned sum, cnt, mine, sp = 0u;
    for (;;) {
        sum = 0u; cnt = 0u; mine = 0u;
#pragma unroll
        for (unsigned j = 0; j < 16; ++j) { const unsigned c = xb_ld(&bar[XB_XCNT(j)]); sum += c; cnt += (c > 0u) ? 1u : 0u; mine = (j == x) ? c : mine; }
        if (sum == G) break;
        __builtin_amdgcn_s_sleep(1);
        if ((++sp & 255u) == 0u) { if (xb_ld(&bar[XB_TMO])) break; if (sp > XB_SPIN_CAP) { atomicAdd(&bar[XB_TMO], 1u); break; } }
    }
    nloc = mine > 0u ? mine : 1u; nx = cnt > 0u ? cnt : 1u;
}
DEV void xcd_barrier(const XcdBarrier& b) {
    asm volatile("s_waitcnt vmcnt(0)" ::: "memory");
    __syncthreads();
    if (TID() == 0) {
        unsigned* bar = b.bar;
        __builtin_amdgcn_s_waitcnt(0);
        unsigned nloc = b.st[0], nx = b.st[1];
        if (nloc == 0u) { xcd_barrier_complete(bar, b.x, nloc, nx); b.st[0] = nloc; b.st[1] = nx; }
        const unsigned old = xb_add(&bar[XB_XSUB(b.x)], 1u);
        const unsigned gen = old / nloc;
        if (old + 1u == (gen + 1u) * nloc) {
            __builtin_amdgcn_fence(__ATOMIC_RELEASE, "agent");
            asm volatile("s_waitcnt vmcnt(0)" ::: "memory");
            const unsigned og = xb_add(&bar[XB_TOP], 1u);
            const unsigned tg = og / nx;
            if (og + 1u == (tg + 1u) * nx) xb_add(&bar[XB_TOPGEN], 1u);
            else XB_SPIN(xb_ld(&bar[XB_TOPGEN]) == tg, bar);
            __builtin_amdgcn_fence(__ATOMIC_ACQUIRE, "agent");
            xb_add(&bar[XB_XGEN(b.x)], 1u);
            asm volatile("s_waitcnt vmcnt(0)" ::: "memory");
        } else {
            XB_SPIN(xb_ld(&bar[XB_XGEN(b.x)]) == gen, bar);
            __builtin_amdgcn_fence(__ATOMIC_ACQUIRE, "agent");
            asm volatile("s_waitcnt vmcnt(0)" ::: "memory");
        }
    }
    __syncthreads();
}

__global__ void __launch_bounds__(NTHR, 2) mega(Args a) {
    extern __shared__ __attribute__((aligned(16))) unsigned char smem[];
    volatile LAS unsigned* bst = (volatile LAS unsigned*)(LAS unsigned char*)(smem + MISC_OFF + 8000);
    if (TID() == 0) { bst[0] = 0u; bst[1] = 0u; }
    __syncthreads();
    const XcdBarrier bar = xcd_barrier_post((unsigned*)(a.ws + WS_CTL) + 4096, bst);
#define GSYNC() xcd_barrier(bar)
#define RUN(ph) do { run_phase<ph>(a, smem); if ((PROBE_DUP >> ph) & 1) { GSYNC(); run_phase<ph>(a, smem); } } while (0)
    RUN(PH_PRO); GSYNC();
    RUN(PH_INPROJ); GSYNC();
    RUN(PH_ATT); GSYNC();
    RUN(PH_OUTPROJ); GSYNC();
    RUN(PH_ROUTE); GSYNC();
    RUN(PH_UP); GSYNC();
    RUN(PH_DOWN); GSYNC();
    RUN(PH_COMB); GSYNC();
    RUN(PH_GATE);
    if (gridDim.x < 256) { GSYNC(); RUN(PH_FINAL); }
#undef RUN
#undef GSYNC
}

extern "C" void kernel_launch(void* const* d_in, const int* in_sizes, int n_in, void* d_out, int out_size, void* d_ws, size_t ws_size, hipStream_t stream) {
    static int grid = 0;
    if (grid == 0) {
        if (n_in != 25 || ws_size < WS_END) { fprintf(stderr, "kernel_launch: unexpected n_in %d / ws %zu\n", n_in, ws_size); grid = -1; return; }
        int dev = 0, cus = 0, per_cu = 0;
        (void)hipGetDevice(&dev); (void)hipDeviceGetAttribute(&cus, hipDeviceAttributeMultiprocessorCount, dev);
        (void)hipFuncSetAttribute((const void*)mega, hipFuncAttributeMaxDynamicSharedMemorySize, LDS_BYTES);
        (void)hipOccupancyMaxActiveBlocksPerMultiprocessor(&per_cu, (const void*)mega, NTHR, LDS_BYTES);
        if (per_cu < 1) { fprintf(stderr, "kernel_launch: occupancy query says %d blocks per CU\n", per_cu); grid = -1; return; }
        grid = cus;
    }
    if (grid < 0) return;
    (void)hipMemsetAsync((char*)d_ws + WS_CTL, 0, 65536, stream);
    Args a{};
    for (int i = 0; i < 25; ++i) a.in[i] = (const float*)d_in[i];
    a.out = (float*)d_out; a.ws = (unsigned char*)d_ws; a.ph_lo = 0; a.ph_hi = PH_N;
    void* args[] = {&a};
    hipError_t e = hipLaunchCooperativeKernel((const void*)mega, dim3(grid), dim3(NTHR), args, LDS_BYTES, stream);
    if (e != hipSuccess) fprintf(stderr, "cooperative launch failed: %s (grid %d)\n", hipGetErrorString(e), grid);
}
```

```cpp
#include <hip/hip_runtime.h>
#include <stdint.h>
#include <cstdio>

#define DEV __device__ __forceinline__
#define LAS __attribute__((address_space(3)))

typedef unsigned short bf16_t;
typedef short bf16x8 __attribute__((ext_vector_type(8)));
typedef short s16x4 __attribute__((ext_vector_type(4)));
typedef float f32x4 __attribute__((ext_vector_type(4)));
typedef float f32x16 __attribute__((ext_vector_type(16)));
typedef float f32x2_t __attribute__((ext_vector_type(2)));
typedef __bf16 bf16x2_t __attribute__((ext_vector_type(2)));

constexpr int NTHR = 512, NWAVE = 8;
constexpr int NTOK = 16384;
constexpr float EPS = 1e-6f;
constexpr float LOG2E = 1.4426950408889634f;
constexpr float QS = 0.125f * LOG2E;
constexpr int NWIN = 3072;

constexpr size_t MiB = 1u << 20;
constexpr size_t WS_CTL = 0;
constexpr size_t WS_WIN = 1 * MiB;
constexpr size_t WS_WOUT = 7 * MiB;
constexpr size_t WS_WGATE = 9 * MiB;
constexpr size_t WS_WPLE = 11 * MiB;
constexpr size_t WS_WC1 = 12 * MiB;
constexpr size_t WS_WC2 = 15 * MiB + 512 * 1024 + 262144;
constexpr size_t WS_BIAS1 = 15 * MiB + 512 * 1024 + 262144 + 131072;
constexpr size_t WS_KC = 14 * MiB;
constexpr size_t WS_HID = 14 * MiB + 512 * 1024;
constexpr size_t WS_GN = 16 * MiB;
constexpr size_t WS_LS = 18 * MiB;
constexpr size_t WS_CUM = 19 * MiB;
constexpr size_t WS_SSQ = 20 * MiB;
constexpr size_t WS_TOPI = 21 * MiB;
constexpr size_t WS_TOPS = 21 * MiB + 262144;
constexpr size_t WS_TOPW = 21 * MiB + 524288;
constexpr size_t WS_TOKOF = 22 * MiB;
constexpr size_t WS_ROWW = 24 * MiB;
constexpr size_t WS_SSQ3 = 26 * MiB;
constexpr size_t WS_RSTD2 = 27 * MiB;
constexpr size_t WS_PB = 28 * MiB;
constexpr size_t WS_XN = 36 * MiB;
constexpr size_t WS_PROJ = 68 * MiB;
constexpr size_t WS_ONSA = 160 * MiB;
constexpr size_t WS_OFOX = 176 * MiB;
constexpr size_t WS_H1 = 192 * MiB;
constexpr size_t WS_WUP = 256 * MiB;
constexpr size_t WS_WDN = 384 * MiB;
constexpr size_t WS_ACT = 448 * MiB;
constexpr size_t WS_Y = 592 * MiB;
constexpr size_t WS_END = 736 * MiB;

enum { PH_PRO = 0, PH_INPROJ, PH_CMP, PH_ATT, PH_OUTPROJ, PH_ROUTE, PH_UP, PH_DOWN, PH_COMB, PH_GATE, PH_FINAL, PH_N };
struct Args { const float* in[25]; float* out; unsigned char* ws; int ph_lo, ph_hi; };
enum { I_X = 0, I_P, I_LN1, I_WIN, I_BFG, I_WC1K, I_WC2K, I_PEK, I_WC1V, I_WC2V, I_PEV, I_GNN, I_GNF, I_WOUT, I_LN2, I_WR, I_BR,
       I_WUP, I_BUP, I_WDN, I_BDN, I_LNPLE, I_WPLE, I_WGATE, I_LNF };

DEV int BID() { int b = (int)blockIdx.x; asm volatile("" : "+s"(b)); return b; }
DEV int VBID() { const int g = (int)gridDim.x, b = BID(); return (g & 7) ? b : (b & 7) * (g >> 3) + (b >> 3); }
DEV int TID() { int t = (int)__builtin_amdgcn_workitem_id_x(); asm volatile("" : "+v"(t)); return t; }
DEV unsigned cvtpk(float lo, float hi) { f32x2_t v = {lo, hi}; bf16x2_t b = __builtin_convertvector(v, bf16x2_t); return __builtin_bit_cast(unsigned, b); }
DEV float bflo(unsigned u) { return __uint_as_float(u << 16); }
DEV float bfhi(unsigned u) { return __uint_as_float(u & 0xffff0000u); }
DEV float wave_sum(float v) {
#pragma unroll
    for (int o = 1; o < 64; o <<= 1) v += __shfl_xor(v, o);
    return v;
}
#define DPP_MOV(x, ctrl) __builtin_bit_cast(float, __builtin_amdgcn_update_dpp(0, __builtin_bit_cast(int, (x)), (ctrl), 0xF, 0xF, true))
DEV float pair_sum(float x) { return x + __shfl_xor(x, 32); }
DEV float pair_max(float x) { return fmaxf(x, __shfl_xor(x, 32)); }
DEV float quad_sum(float x) { x += DPP_MOV(x, 0xB1); x += DPP_MOV(x, 0x4E); return x; }
DEV float wave_max_u(float x) {
    x = fmaxf(x, DPP_MOV(x, 0xB1)); x = fmaxf(x, DPP_MOV(x, 0x4E)); x = fmaxf(x, DPP_MOV(x, 0x141)); x = fmaxf(x, DPP_MOV(x, 0x140));
    const float a = __builtin_bit_cast(float, __builtin_amdgcn_readlane(__builtin_bit_cast(int, x), 0)), b = __builtin_bit_cast(float, __builtin_amdgcn_readlane(__builtin_bit_cast(int, x), 16));
    const float c = __builtin_bit_cast(float, __builtin_amdgcn_readlane(__builtin_bit_cast(int, x), 32)), d = __builtin_bit_cast(float, __builtin_amdgcn_readlane(__builtin_bit_cast(int, x), 48));
    return fmaxf(fmaxf(a, b), fmaxf(c, d));
}
DEV float sigmoidf_(float x) { return __builtin_amdgcn_rcpf(1.0f + __expf(-x)); }
DEV float logsigmoidf_(float x) { return fminf(x, 0.f) - log1pf(__expf(-fabsf(x))); }
DEV float gelu_tanh(float x) { const float u = 0.7978845608028654f * (x + 0.044715f * x * x * x); const float th = 1.0f - 2.0f * __builtin_amdgcn_rcpf(__expf(2.0f * u) + 1.0f); return 0.5f * x * (1.0f + th); }
DEV s16x4 tr_read(const unsigned char* p) {
    typedef short v4i16_t __attribute__((ext_vector_type(4)));
    return __builtin_bit_cast(s16x4, __builtin_amdgcn_ds_read_tr16_b64_v4i16((LAS v4i16_t*)p));
}
DEV int crow(int r, int hi) { return (r & 3) + 8 * (r >> 2) + 4 * hi; }

constexpr int GL_STAGE = 65536;
constexpr int GEMM_LDS = 2 * GL_STAGE;
constexpr int MISC_OFF = GEMM_LDS;
constexpr int LDS_BYTES = GEMM_LDS + 8192;

DEV void glds16s(const void* sbase, unsigned voff, unsigned lds_dst) { unsigned keep;
    asm volatile("s_mov_b32 %0, m0\n\ts_mov_b32 m0, %3\n\ts_nop 0\n\tglobal_load_lds_dwordx4 %1, %2\n\ts_mov_b32 m0, %0" : "=&s"(keep) : "v"(voff), "s"(sbase), "s"(lds_dst) : "memory"); }

DEV const unsigned char* uptr(const void* p) { const unsigned long long v = (unsigned long long)p; const unsigned lo = __builtin_amdgcn_readfirstlane((unsigned)v), hi = __builtin_amdgcn_readfirstlane((unsigned)(v >> 32)); return (const unsigned char*)(((unsigned long long)hi << 32) | lo); }

struct NoNext { DEV void operator()() const {} };
template <class AO, class BO>
DEV void gemm256_issue0(unsigned char* smem, const void* abase, const AO& aoff, const void* bbase, const BO& boff) {
    const int tid = TID(), lane = tid & 63; const int wid = __builtin_amdgcn_readfirstlane(tid >> 6);
    const unsigned lds0 = (unsigned)(uintptr_t)smem; const unsigned char* ab_ = uptr(abase); const unsigned char* bb_ = uptr(bbase);
#pragma unroll
    for (int i = 0; i < 4; ++i) { const int p = wid + 8 * i; glds16s(ab_, aoff(8 * p + (lane >> 3), (lane & 7) ^ (lane >> 3)), (unsigned)__builtin_amdgcn_readfirstlane(lds0 + p * 1024)); }
#pragma unroll
    for (int i = 0; i < 4; ++i) { const int p = wid + 8 * i; const int k = 2 * p + (lane >> 5); const int f = (k & 3) + 4 * ((k >> 3) & 1);
        glds16s(bb_, boff(k, (lane & 31) ^ (f << 1)), (unsigned)__builtin_amdgcn_readfirstlane(lds0 + 32768 + p * 1024)); }
}
template <bool ZERO, class AO, class BO, class NX = NoNext>
DEV void gemm256(unsigned char* smem, int nkt, const void* abase, unsigned akstep, const AO& aoff, const void* bbase, unsigned bkstep, const BO& boff, f32x4 (&acc)[8][4], bool pre = false, const NX& next = NX()) {
    const int tid = TID(), lane = tid & 63; const int wid = __builtin_amdgcn_readfirstlane(tid >> 6); const int wr = wid >> 2, wc = wid & 3;
    if (ZERO) {
#pragma unroll
        for (int mi = 0; mi < 8; ++mi)
#pragma unroll
            for (int ni = 0; ni < 4; ++ni) acc[mi][ni] = (f32x4){0.f, 0.f, 0.f, 0.f};
    }
    const unsigned lds0 = (unsigned)(uintptr_t)smem;
    const unsigned char* abase_u = uptr(abase); const unsigned char* bbase_u = uptr(bbase); const unsigned akstep_u = __builtin_amdgcn_readfirstlane(akstep), bkstep_u = __builtin_amdgcn_readfirstlane(bkstep);
    unsigned ao[4], bo[4];
#pragma unroll
    for (int i = 0; i < 4; ++i) { const int p = wid + 8 * i; ao[i] = aoff(8 * p + (lane >> 3), (lane & 7) ^ (lane >> 3));
        const int k = 2 * p + (lane >> 5); const int f = (k & 3) + 4 * ((k >> 3) & 1); bo[i] = boff(k, (lane & 31) ^ (f << 1)); }
#define GL_ISSUE(kt, st) do { const unsigned char* ab_ = abase_u + (size_t)(kt) * akstep_u; const unsigned char* bb_ = bbase_u + (size_t)(kt) * bkstep_u; \
        _Pragma("unroll") for (int i_ = 0; i_ < 4; ++i_) glds16s(ab_, ao[i_], (unsigned)__builtin_amdgcn_readfirstlane(lds0 + (st) * GL_STAGE + (wid + 8 * i_) * 1024)); \
        _Pragma("unroll") for (int i_ = 0; i_ < 4; ++i_) glds16s(bb_, bo[i_], (unsigned)__builtin_amdgcn_readfirstlane(lds0 + (st) * GL_STAGE + 32768 + (wid + 8 * i_) * 1024)); } while (0)
    if (!pre) {
        GL_ISSUE(0, 0);
        asm volatile("s_waitcnt vmcnt(0)" ::: "memory");
        __syncthreads();
    }
    for (int kt = 0; kt < nkt; ++kt) {
        if (kt + 1 < nkt) GL_ISSUE(kt + 1, (kt + 1) & 1); else next();
        const unsigned char* A = smem + (kt & 1) * GL_STAGE; const unsigned char* Bt = A + 32768;
#pragma unroll
        for (int ks = 0; ks < 2; ++ks) {
            bf16x8 wf[4];
#pragma unroll
            for (int ni = 0; ni < 4; ++ni) {
                const int i = lane & 15, g = lane >> 4, q = i >> 2; const int row = ks * 32 + 8 * g + q; const int nc = wc * 8 + ni * 2 + ((i & 3) >> 1); const int f = q + 4 * (g & 1);
                const unsigned char* p = Bt + row * 512 + ((nc ^ (f << 1)) << 4) + (i & 1) * 8;
                const s16x4 lo = tr_read(p), hi = tr_read(p + 4 * 512);
                wf[ni] = (bf16x8){lo[0], lo[1], lo[2], lo[3], hi[0], hi[1], hi[2], hi[3]};
            }
#pragma unroll
            for (int mi = 0; mi < 8; ++mi) {
                const int m = wr * 128 + mi * 16 + (lane & 15); const int kc = ks * 4 + (lane >> 4);
                const bf16x8 af = *(const bf16x8*)(A + m * 128 + ((kc ^ (m & 7)) << 4));
#pragma unroll
                for (int ni = 0; ni < 4; ++ni) acc[mi][ni] = __builtin_amdgcn_mfma_f32_16x16x32_bf16(wf[ni], af, acc[mi][ni], 0, 0, 0);
            }
        }
        asm volatile("s_waitcnt vmcnt(0)" ::: "memory");
        __syncthreads();
    }
#undef GL_ISSUE
}

#define EPI_IDS() do { const int etid_ = TID(); lane = etid_ & 63; wid = etid_ >> 6; wr = wid >> 2; wc = wid & 3; } while (0)

DEV void patch_decode(int local, int MT, int NT, int& mt, int& nt) {
    const int per_mtb = 8 * NT; const int mtb = local / per_mtb; const int rem = local - mtb * per_mtb;
    const int rows = (MT - 8 * mtb) < 8 ? (MT - 8 * mtb) : 8;
    const int per_ntb = rows * 8; const int nfull = NT >> 3; int ntb = rem / per_ntb; int cols = 8;
    if (ntb >= nfull) { ntb = nfull; cols = NT - 8 * nfull; }
    const int r2 = rem - ntb * per_ntb;
    mt = 8 * mtb + r2 / cols; nt = 8 * ntb + r2 % cols;
}

DEV void convert_chunk(const float* src, bf16_t* dst, size_t i8) {
    const float4 a = *(const float4*)(src + i8 * 8), b = *(const float4*)(src + i8 * 8 + 4);
    uint4 o; o.x = cvtpk(a.x, a.y); o.y = cvtpk(a.z, a.w); o.z = cvtpk(b.x, b.y); o.w = cvtpk(b.z, b.w);
    *(uint4*)(dst + i8 * 8) = o;
}
DEV void phase_prologue(const Args& a, unsigned char* smem) {
    unsigned char* ws = a.ws;
    const size_t gtid = (size_t)BID() * NTHR + TID(), gn = (size_t)gridDim.x * NTHR;
    {
        { const float* W = a.in[I_WOUT]; bf16_t* O = (bf16_t*)(ws + WS_WOUT); const float* gnn = a.in[I_GNN]; const float* gnf = a.in[I_GNF];
          for (size_t i = gtid; i < (size_t)1024 * 128; i += gn) { const int k = (int)(i >> 7); const float g_ = k < 512 ? gnn[k] : gnf[k - 512];
              const float4 x = *(const float4*)(W + i * 8), y = *(const float4*)(W + i * 8 + 4);
              uint4 o; o.x = cvtpk(x.x * g_, x.y * g_); o.y = cvtpk(x.z * g_, x.w * g_); o.z = cvtpk(y.x * g_, y.y * g_); o.w = cvtpk(y.z * g_, y.w * g_); *(uint4*)(O + i * 8) = o; } }
        const float* srcs[3] = {a.in[I_WGATE], a.in[I_WPLE], a.in[I_P]};
        bf16_t* dsts[3] = {(bf16_t*)(ws + WS_WGATE), (bf16_t*)(ws + WS_WPLE), (bf16_t*)(ws + WS_PB)};
        const size_t cnt8[3] = {1024 * 1024 / 8, 256 * 1024 / 8, (size_t)NTOK * 256 / 8};
#pragma unroll
        for (int s = 0; s < 3; ++s) for (size_t i = gtid; i < cnt8[s]; i += gn) convert_chunk(srcs[s], dsts[s], i);
        for (size_t i = gtid; i < (size_t)2 * 2048 * 32; i += gn) { const int which = (int)(i / (2048 * 32)); const int k = (int)(i / 32) % 2048, c8 = (int)(i % 32) * 8;
            uint4 o = {0u, 0u, 0u, 0u};
            if (c8 < 128) { const float* W = a.in[which ? I_WC1V : I_WC1K] + (size_t)k * 128 + c8; const float4 x = *(const float4*)W, y = *(const float4*)(W + 4); o.x = cvtpk(x.x, x.y); o.y = cvtpk(x.z, x.w); o.z = cvtpk(y.x, y.y); o.w = cvtpk(y.z, y.w); }
            *(uint4*)((bf16_t*)(ws + WS_WC1) + i * 8) = o; }
        for (size_t i = gtid; i < (size_t)2 * 128 * 32; i += gn) { const int which = (int)(i / (128 * 32)); const int k = (int)(i / 32) % 128, c8 = (int)(i % 32) * 8;
            uint4 o = {0u, 0u, 0u, 0u};
            if (c8 < 64) { const float* W = a.in[which ? I_WC2V : I_WC2K] + (size_t)k * 64 + c8; const float4 x = *(const float4*)W, y = *(const float4*)(W + 4); o.x = cvtpk(x.x, x.y); o.y = cvtpk(x.z, x.w); o.z = cvtpk(y.x, y.y); o.w = cvtpk(y.z, y.w); }
            *(uint4*)((bf16_t*)(ws + WS_WC2) + i * 8) = o; }
    }
    {
        const float* W = a.in[I_WIN]; bf16_t* O = (bf16_t*)(ws + WS_WIN);
        for (size_t i = gtid; i < (size_t)1024 * (NWIN / 8); i += gn) {
            const int k = (int)(i / (NWIN / 8)), j = (int)(i % (NWIN / 8)) * 8;
            uint4 o = {0u, 0u, 0u, 0u};
            if (j < 2848) {
                const int sj = (j < 1280) ? j : (j < 2816) ? j + 24 : (j < 2840) ? j - 1536 : j;
                const float4 x = *(const float4*)(W + (size_t)k * 2848 + sj), y = *(const float4*)(W + (size_t)k * 2848 + sj + 4);
                o.x = cvtpk(x.x, x.y); o.y = cvtpk(x.z, x.w); o.z = cvtpk(y.x, y.y); o.w = cvtpk(y.z, y.w);
            }
            *(uint4*)(O + (size_t)k * NWIN + j) = o;
        }
    }
    const int lane = TID() & 63; const int gw = BID() * NWAVE + (TID() >> 6), ngw = gridDim.x * NWAVE;
    {
        const float* X = a.in[I_X]; const float* g = a.in[I_LN1]; bf16_t* XN = (bf16_t*)(ws + WS_XN);
        for (int m = gw; m < NTOK; m += ngw) {
            float4 v[4]; float s = 0.f;
#pragma unroll
            for (int j = 0; j < 4; ++j) { v[j] = *(const float4*)(X + (size_t)m * 1024 + j * 256 + lane * 4); s += v[j].x * v[j].x + v[j].y * v[j].y + v[j].z * v[j].z + v[j].w * v[j].w; }
            const float rstd = rsqrtf(wave_sum(s) * (1.f / 1024.f) + EPS);
#pragma unroll
            for (int j = 0; j < 4; ++j) { const float4 gg = *(const float4*)(g + j * 256 + lane * 4);
                uint2 o; o.x = cvtpk(v[j].x * rstd * gg.x, v[j].y * rstd * gg.y); o.y = cvtpk(v[j].z * rstd * gg.z, v[j].w * rstd * gg.w);
                *(uint2*)(XN + (size_t)m * 1024 + j * 256 + lane * 4) = o; }
        }
    }
    if (gw < 256) {
        const int which = gw >> 7, n = gw & 127; const float* pe = a.in[which ? I_PEV : I_PEK]; const float* w1 = a.in[which ? I_WC1V : I_WC1K];
        float s = 0.f;
#pragma unroll 8
        for (int i = 0; i < 32; ++i) { const int k = lane + 64 * i; s += pe[k] * w1[(size_t)k * 128 + n]; }
        s = wave_sum(s);
        if (lane == 0) ((float*)(ws + WS_BIAS1))[which * 128 + n] = s;
    }
}

DEV void phase_inproj(const Args& a, unsigned char* smem) {
    const bf16_t* XN = (const bf16_t*)(a.ws + WS_XN); const bf16_t* W = (const bf16_t*)(a.ws + WS_WIN);
    bf16_t* PROJ = (bf16_t*)(a.ws + WS_PROJ); float* GN = (float*)(a.ws + WS_GN); float* LS = (float*)(a.ws + WS_LS); const float* bfg = a.in[I_BFG];
    int lane = TID() & 63, wid = TID() >> 6, wr = wid >> 2, wc = wid & 3; (void)wr; (void)wc; (void)lane;
    bool pre = false;
    for (int item = VBID(); item < 64 * 12; item += gridDim.x) {
        int mt, nt; patch_decode(item, 64, 12, mt, nt);
        const int nitem = item + (int)gridDim.x; const bool has_next = nitem < 64 * 12; int mtn = 0, ntn = 0; if (has_next) patch_decode(nitem, 64, 12, mtn, ntn);
        f32x4 acc[8][4];
        gemm256<true>(smem, 16, XN + (size_t)mt * 256 * 1024, 128u, [&](int r, int kc) { return (unsigned)(r * 2048 + kc * 16); },
                      W + nt * 256, (unsigned)(64 * NWIN * 2), [&](int k, int nc) { return (unsigned)(k * (NWIN * 2) + nc * 16); }, acc, pre,
                      [&]() { if (has_next) gemm256_issue0(smem, XN + (size_t)mtn * 256 * 1024, [&](int r, int kc) { return (unsigned)(r * 2048 + kc * 16); }, W + ntn * 256, [&](int k, int nc) { return (unsigned)(k * (NWIN * 2) + nc * 16); }); });
        pre = has_next;
        EPI_IDS();
#pragma unroll
        for (int mi = 0; mi < 8; ++mi) {
            const int gm = mt * 256 + wr * 128 + mi * 16 + (lane & 15); const int b = gm >> 13, t = gm & 8191;
#pragma unroll
            for (int ni = 0; ni < 4; ++ni) {
                const int n = wc * 64 + ni * 16 + 4 * (lane >> 4); const f32x4 v = acc[mi][ni];
                if (nt < 11) {
                    const int hs = nt * 4 + wc, d = n & 63; const float sc = (hs < 8 || (hs >= 20 && hs < 28)) ? QS : 1.0f;
                    uint2 o; o.x = cvtpk(v[0] * sc, v[1] * sc); o.y = cvtpk(v[2] * sc, v[3] * sc);
                    *(uint2*)(PROJ + (((size_t)(hs * 2 + b)) * 8192 + t) * 64 + d) = o;
                } else if (n < 24) {
#pragma unroll
                    for (int r = 0; r < 4; ++r) GN[(size_t)gm * 24 + n + r] = sigmoidf_(v[r]);
                } else if (n < 32) {
#pragma unroll
                    for (int r = 0; r < 4; ++r) { const int h = n - 24 + r; LS[((size_t)(b * 8 + h)) * 8192 + t] = logsigmoidf_(v[r] + bfg[h]); }
                }
            }
        }
    }
}

DEV void signal_done(unsigned* flag) {
    asm volatile("s_waitcnt vmcnt(0)" ::: "memory");
    __syncthreads();
    if (TID() == 0) { __builtin_amdgcn_fence(__ATOMIC_RELEASE, "agent"); asm volatile("s_waitcnt vmcnt(0)" ::: "memory"); __hip_atomic_fetch_add(flag, 1u, __ATOMIC_RELAXED, __HIP_MEMORY_SCOPE_AGENT); }
}
DEV void wait_flag(unsigned* flag, unsigned target) {
    if (TID() == 0) { unsigned sp = 0u; while (__hip_atomic_load(flag, __ATOMIC_RELAXED, __HIP_MEMORY_SCOPE_AGENT) < target) { __builtin_amdgcn_s_sleep(4); if (++sp > (1u << 24)) break; }
        __builtin_amdgcn_fence(__ATOMIC_ACQUIRE, "agent"); asm volatile("s_waitcnt vmcnt(0)" ::: "memory"); }
    __syncthreads();
}
constexpr int CW_CUMFLAG = 128, CW_CMPFLAG = 192, CW_GATEFLAG = 256;
DEV void cmp_item(const Args& a, unsigned char* smem, int item) {
    const bf16_t* PROJ = (const bf16_t*)(a.ws + WS_PROJ);
    const int tid = TID(); int lane = tid & 63, wid = tid >> 6, wr = wid >> 2, wc = wid & 3; (void)wr; (void)wc; (void)lane;
    {
        if (item < 16) {
            const int which = item >> 3, b = (item >> 2) & 1, g = (item >> 1) & 1, mt = item & 1;
            const bf16_t* base = PROJ + ((size_t)((8 + 2 * which + g) * 2 + b)) * 8192 * 64;
            const bf16_t* W1 = (const bf16_t*)(a.ws + WS_WC1) + (size_t)which * 2048 * 256;
            const bf16_t* W2 = (const bf16_t*)(a.ws + WS_WC2) + (size_t)which * 128 * 256;
            const float* bias1 = (const float*)(a.ws + WS_BIAS1) + which * 128;
            bf16_t* HID = (bf16_t*)(a.ws + WS_HID) + ((size_t)(which * 4 + b * 2 + g)) * 512 * 128;
            bf16_t* OUT = (bf16_t*)(a.ws + WS_KC) + ((size_t)(which * 4 + b * 2 + g)) * 512 * 64;
            f32x4 acc[8][4];
            gemm256<true>(smem, 32, base, 128u, [&](int r, int kc) { int c = mt * 256 + r; c = c > 510 ? 510 : c; return (unsigned)(c * 2048 + kc * 16); },
                          W1, 64u * 512u, [&](int k, int nc) { return (unsigned)(k * 512 + nc * 16); }, acc);
        EPI_IDS();
            if (wc < 2) {
#pragma unroll
                for (int mi = 0; mi < 8; ++mi) { const int c = mt * 256 + wr * 128 + mi * 16 + (lane & 15);
#pragma unroll
                    for (int ni = 0; ni < 4; ++ni) { const int n = wc * 64 + ni * 16 + 4 * (lane >> 4); const f32x4 v = acc[mi][ni]; const float4 bb = *(const float4*)(bias1 + n);
                        uint2 o; o.x = cvtpk(gelu_tanh(v[0] + bb.x), gelu_tanh(v[1] + bb.y)); o.y = cvtpk(gelu_tanh(v[2] + bb.z), gelu_tanh(v[3] + bb.w));
                        *(uint2*)(HID + (size_t)c * 128 + n) = o; } }
            }
            __syncthreads();
            gemm256<true>(smem, 2, HID + (size_t)mt * 256 * 128, 128u, [&](int r, int kc) { return (unsigned)(r * 256 + kc * 16); },
                          W2, 64u * 512u, [&](int k, int nc) { return (unsigned)(k * 512 + nc * 16); }, acc);
        EPI_IDS();
            if (wc == 0) {
#pragma unroll
                for (int mi = 0; mi < 8; ++mi) { const int c = mt * 256 + wr * 128 + mi * 16 + (lane & 15);
#pragma unroll
                    for (int ni = 0; ni < 4; ++ni) { const int n = ni * 16 + 4 * (lane >> 4); const f32x4 v = acc[mi][ni];
                        uint2 o; o.x = cvtpk(v[0], v[1]); o.y = cvtpk(v[2], v[3]);
                        if (c >= 511) { o.x = 0u; o.y = 0u; }
                        *(uint2*)(OUT + (size_t)c * 64 + n) = o; } }
            }
            signal_done((unsigned*)(a.ws + WS_CTL) + CW_CMPFLAG);
        } else {
            const int bh = item - 16; const float* LS = (const float*)(a.ws + WS_LS) + (size_t)bh * 8192; float* CUM = (float*)(a.ws + WS_CUM) + (size_t)bh * 8192;
            float* sc = (float*)smem;
            float v[16]; float s = 0.f;
#pragma unroll
            for (int j = 0; j < 4; ++j) { const float4 x = *(const float4*)(LS + tid * 16 + j * 4); v[4 * j] = x.x; v[4 * j + 1] = x.y; v[4 * j + 2] = x.z; v[4 * j + 3] = x.w; }
#pragma unroll
            for (int j = 0; j < 16; ++j) { s += v[j]; v[j] = s; }
            sc[tid] = s; __syncthreads();
            if (tid == 0) { float run = 0.f; for (int i = 0; i < NTHR; ++i) { const float x = sc[i]; sc[i] = run; run += x; } }
            __syncthreads();
            const float off = sc[tid];
#pragma unroll
            for (int j = 0; j < 4; ++j) { float4 o = {v[4 * j] + off, v[4 * j + 1] + off, v[4 * j + 2] + off, v[4 * j + 3] + off}; *(float4*)(CUM + tid * 16 + j * 4) = o; }
            signal_done((unsigned*)(a.ws + WS_CTL) + CW_CUMFLAG + bh);
        }
    }
}

constexpr int AT_STAGE = 16384;
constexpr int AT_BIAS_OFF = 3 * AT_STAGE;
constexpr int AT_IMP_OFF = AT_BIAS_OFF + 1024;
constexpr int AT_SEL_OFF = AT_IMP_OFF + 65536;
constexpr int AT_WUN_OFF = AT_SEL_OFF + 1024;
constexpr int AT_UCNT_OFF = AT_WUN_OFF + 128;
constexpr int AT_ULIST_OFF = AT_UCNT_OFF + 16;
constexpr int AT_ITEM_OFF = AT_ULIST_OFF + 128;
static_assert(AT_ITEM_OFF + 16 <= GEMM_LDS, "attention LDS map");
#define NEG_INF (-__builtin_inff())

#define KV_DECL uint4 rk0_, rv0_
#define KV_GLOAD(Kt, Vt) do { rk0_ = *(const uint4*)((Kt) + tid * 8); rv0_ = *(const uint4*)((Vt) + tid * 8); } while (0)
#define KV_LSTORE(stp) do { unsigned char* st_ = (stp); const int key = tid >> 3, ch = tid & 7; \
      *(uint4*)(st_ + key * 128 + ((ch ^ (key & 7)) << 4)) = rk0_; \
      *(uint4*)(st_ + 8192 + key * 128 + ((((ch >> 2) ^ ((key >> 1) & 1))) << 6) + ((ch & 3) << 4)) = rv0_; } while (0)
template <bool FULL>
DEV void qk_tile(const unsigned char* Kst, const bf16x8 (&qf)[4], f32x16& p0, f32x16& p1, int lane) {
    const int key = lane & 31, hi = lane >> 5;
    if (FULL) {
        bf16x8 k0[4], k1[4];
#pragma unroll
        for (int ks = 0; ks < 4; ++ks) { const int ch = 2 * ks + hi; const int off = key * 128 + ((ch ^ (key & 7)) << 4);
            k0[ks] = *(const bf16x8*)(Kst + off); k1[ks] = *(const bf16x8*)(Kst + off + 32 * 128); }
        __builtin_amdgcn_sched_barrier(0);
#pragma unroll
        for (int ks = 0; ks < 4; ++ks) {
            p0 = __builtin_amdgcn_mfma_f32_32x32x16_bf16(k0[ks], qf[ks], p0, 0, 0, 0);
            p1 = __builtin_amdgcn_mfma_f32_32x32x16_bf16(k1[ks], qf[ks], p1, 0, 0, 0); }
    } else {
        bf16x8 kk[4];
#pragma unroll
        for (int ks = 0; ks < 4; ++ks) { const int ch = 2 * ks + hi; kk[ks] = *(const bf16x8*)(Kst + key * 128 + ((ch ^ (key & 7)) << 4)); }
        __builtin_amdgcn_sched_barrier(0);
#pragma unroll
        for (int ks = 0; ks < 4; ++ks) p0 = __builtin_amdgcn_mfma_f32_32x32x16_bf16(kk[ks], qf[ks], p0, 0, 0, 0);
        __builtin_amdgcn_sched_barrier(0);
#pragma unroll
        for (int ks = 0; ks < 4; ++ks) { const int ch = 2 * ks + hi; kk[ks] = *(const bf16x8*)(Kst + key * 128 + ((ch ^ (key & 7)) << 4) + 32 * 128); }
        __builtin_amdgcn_sched_barrier(0);
#pragma unroll
        for (int ks = 0; ks < 4; ++ks) p1 = __builtin_amdgcn_mfma_f32_32x32x16_bf16(kk[ks], qf[ks], p1, 0, 0, 0);
    }
}
template <bool FULL>
DEV void pv_tile(const unsigned char* Vst, const f32x16& p0, const f32x16& p1, f32x16 (&o)[2], int lane) {
    const int hi = lane >> 5, i = lane & 15, gg = (lane >> 4) & 1;
    const int q = i >> 2; const int sw = (q >> 1) & 1;
    bf16x8 pa[4];
#pragma unroll
    for (int s = 0; s < 4; ++s) { const f32x16& p = (s < 2) ? p0 : p1; const int b = (s & 1) * 8;
        unsigned w[4];
#pragma unroll
        for (int j = 0; j < 4; ++j) w[j] = cvtpk(p[b + 2 * j], p[b + 2 * j + 1]);
        typedef unsigned u32x4_t __attribute__((ext_vector_type(4)));
        u32x4_t ww = {w[0], w[1], w[2], w[3]}; pa[s] = __builtin_bit_cast(bf16x8, ww); }
    constexpr int NB = FULL ? 1 : 2, SB = FULL ? 4 : 2;
#pragma unroll
    for (int bt = 0; bt < NB; ++bt) {
        s16x4 vlo[SB][2], vhi[SB][2];
#pragma unroll
        for (int s_ = 0; s_ < SB; ++s_)
#pragma unroll
            for (int dh = 0; dh < 2; ++dh) { const int s = bt * SB + s_; const int row0 = 16 * s + 4 * hi + q;
                const unsigned char* p = Vst + row0 * 128 + ((dh ^ sw) << 6) + gg * 32 + (i & 3) * 8;
                vlo[s_][dh] = tr_read(p); vhi[s_][dh] = tr_read(p + 8 * 128); }
        __builtin_amdgcn_sched_barrier(0);
#pragma unroll
        for (int s_ = 0; s_ < SB; ++s_)
#pragma unroll
            for (int dh = 0; dh < 2; ++dh) { const int s = bt * SB + s_;
                const bf16x8 vf = {vlo[s_][dh][0], vlo[s_][dh][1], vlo[s_][dh][2], vlo[s_][dh][3], vhi[s_][dh][0], vhi[s_][dh][1], vhi[s_][dh][2], vhi[s_][dh][3]};
                o[dh] = __builtin_amdgcn_mfma_f32_32x32x16_bf16(vf, pa[s], o[dh], 0, 0, 0); }
        __builtin_amdgcn_sched_barrier(0);
    }
}
DEV float rowmax32(const f32x16& p0, const f32x16& p1) {
    float a = fmaxf(p0[0], p1[0]), b = fmaxf(p0[1], p1[1]);
#pragma unroll
    for (int r = 2; r < 16; r += 2) { a = fmaxf(fmaxf(a, p0[r]), p1[r]); b = fmaxf(fmaxf(b, p0[r + 1]), p1[r + 1]); }
    return pair_max(fmaxf(a, b));
}
DEV void softmax_step(f32x16& p0, f32x16& p1, float& m, float& l, f32x16 (&o)[2]) {
    const float mt = rowmax32(p0, p1); const float mn = fmaxf(m, mt); const float alpha = __builtin_amdgcn_exp2f(m - mn);
    float rs = 0.f;
#pragma unroll
    for (int r = 0; r < 16; ++r) { p0[r] = __builtin_amdgcn_exp2f(p0[r] - mn); p1[r] = __builtin_amdgcn_exp2f(p1[r] - mn); rs += p0[r] + p1[r]; }
    rs = pair_sum(rs);
    l = l * alpha + rs; m = mn;
    if (__any(alpha != 1.0f)) { o[0] *= alpha; o[1] *= alpha; }
}
DEV void softmax_step_nosum(f32x16& p0, f32x16& p1, float& m, f32x16 (&o)[2], f32x16& lacc) {
    const float mt = rowmax32(p0, p1); const float mn = fmaxf(m, mt); const float alpha = __builtin_amdgcn_exp2f(m - mn);
#pragma unroll
    for (int r = 0; r < 16; ++r) { p0[r] = __builtin_amdgcn_exp2f(p0[r] - mn); p1[r] = __builtin_amdgcn_exp2f(p1[r] - mn); }
    m = mn;
    if (__any(alpha != 1.0f)) { o[0] *= alpha; o[1] *= alpha; lacc *= alpha; }
}
DEV void pv_tile_sum(const unsigned char* Vst, const f32x16& p0, const f32x16& p1, f32x16 (&o)[2], f32x16& lacc, int lane) {
    const int hi = lane >> 5, i = lane & 15, gg = (lane >> 4) & 1;
    const int q = i >> 2; const int sw = (q >> 1) & 1;
    bf16x8 pa[4];
#pragma unroll
    for (int s = 0; s < 4; ++s) { const f32x16& p = (s < 2) ? p0 : p1; const int b = (s & 1) * 8;
        unsigned w[4];
#pragma unroll
        for (int j = 0; j < 4; ++j) w[j] = cvtpk(p[b + 2 * j], p[b + 2 * j + 1]);
        typedef unsigned u32x4_t __attribute__((ext_vector_type(4)));
        u32x4_t ww = {w[0], w[1], w[2], w[3]}; pa[s] = __builtin_bit_cast(bf16x8, ww); }
    const bf16x8 ones = {0x3f80, 0x3f80, 0x3f80, 0x3f80, 0x3f80, 0x3f80, 0x3f80, 0x3f80};
#pragma unroll
    for (int bt = 0; bt < 2; ++bt) {
        s16x4 vlo[2][2], vhi[2][2];
#pragma unroll
        for (int s_ = 0; s_ < 2; ++s_)
#pragma unroll
            for (int dh = 0; dh < 2; ++dh) { const int s = bt * 2 + s_; const int row0 = 16 * s + 4 * hi + q;
                const unsigned char* p = Vst + row0 * 128 + ((dh ^ sw) << 6) + gg * 32 + (i & 3) * 8;
                vlo[s_][dh] = tr_read(p); vhi[s_][dh] = tr_read(p + 8 * 128); }
        __builtin_amdgcn_sched_barrier(0);
#pragma unroll
        for (int s_ = 0; s_ < 2; ++s_) { const int s = bt * 2 + s_;
            lacc = __builtin_amdgcn_mfma_f32_32x32x16_bf16(ones, pa[s], lacc, 0, 0, 0);
#pragma unroll
            for (int dh = 0; dh < 2; ++dh) {
                const bf16x8 vf = {vlo[s_][dh][0], vlo[s_][dh][1], vlo[s_][dh][2], vlo[s_][dh][3], vhi[s_][dh][0], vhi[s_][dh][1], vhi[s_][dh][2], vhi[s_][dh][3]};
                o[dh] = __builtin_amdgcn_mfma_f32_32x32x16_bf16(vf, pa[s], o[dh], 0, 0, 0); } }
        __builtin_amdgcn_sched_barrier(0);
    }
}
template <int STRIDE> DEV void mask_tile(f32x16& p0, f32x16& p1, int kpos0, int lo, int hi_lim, int hi) {
#pragma unroll
    for (int r = 0; r < 16; ++r) { const int kp = kpos0 + STRIDE * crow(r, hi);
        if (kp < lo || kp > hi_lim) p0[r] = NEG_INF;
        const int kp1 = kp + 32 * STRIDE; if (kp1 < lo || kp1 > hi_lim) p1[r] = NEG_INF; }
}
template <int STRIDE> DEV void alibi_init(f32x16& p0, f32x16& p1, float slope2, int kpos0, int tref, int hi) {
    const float base = slope2 * (float)(kpos0 - tref + STRIDE * 4 * hi);
#pragma unroll
    for (int r = 0; r < 16; ++r) { const float c = (float)(STRIDE * ((r & 3) + 8 * (r >> 2))); p0[r] = fmaf(slope2, c, base); p1[r] = fmaf(slope2, c + (float)(32 * STRIDE), base); }
}
template <class Src, class Body, class NSrc>
DEV int kv_pipeline(unsigned char* smem, int n, const Src& src, const Body& body, int par, bool pre, bool has_next, const NSrc& nsrc) {
    KV_DECL; const int tid = TID(); const bf16_t *kp, *vp;
    if (!pre) { src(0, kp, vp); KV_GLOAD(kp, vp); KV_LSTORE(smem + par * AT_STAGE); __syncthreads(); }
    for (int j = 0; j < n; ++j) {
        const bool more = j + 1 < n; const bool ld = more || has_next;
        if (more) { src(j + 1, kp, vp); KV_GLOAD(kp, vp); } else if (has_next) { nsrc(kp, vp); KV_GLOAD(kp, vp); }
        body(j, smem + ((par + j) & 1) * AT_STAGE);
        if (ld) KV_LSTORE(smem + ((par + j + 1) & 1) * AT_STAGE);
        __syncthreads();
    }
    return (par + n) & 1;
}
struct NoSrc { DEV void operator()(const bf16_t*&, const bf16_t*&) const {} };

constexpr int CV_PER_STEP = 373; constexpr int CV_NUP = 32 * 1024 * 2048 / 8, CV_NDN = 32 * 1024 * 1024 / 8;
static_assert((long long)33792 * CV_PER_STEP >= (long long)CV_NUP + CV_NDN, "conversion coverage");
DEV void fox_item(const Args& a, unsigned char* smem, int fi, int b, int h, int qb) {
    const int tid = TID(), lane = tid & 63, wid = tid >> 6, r32 = lane & 31, hi = lane >> 5;
    const bf16_t* PROJ = (const bf16_t*)(a.ws + WS_PROJ);
    const bf16_t* Q = PROJ + ((size_t)((20 + h) * 2 + b)) * 8192 * 64; const bf16_t* K = PROJ + ((size_t)((28 + h) * 2 + b)) * 8192 * 64; const bf16_t* V = PROJ + ((size_t)((36 + h) * 2 + b)) * 8192 * 64;
    const float* CUM = (const float*)(a.ws + WS_CUM) + (size_t)(b * 8 + h) * 8192;
    const int q0 = qb * 256; const int qrow = q0 + 32 * wid + r32;
    bf16x8 qf[4];
#pragma unroll
    for (int ks = 0; ks < 4; ++ks) qf[ks] = *(const bf16x8*)(Q + (size_t)qrow * 64 + 16 * ks + 8 * hi);
    const float cref = CUM[q0];
    const int ntiles = 4 * qb + 4; const int jmax_w = (q0 + 32 * wid + 31) >> 6; const int jmask_w = (q0 + 32 * wid) >> 6;
    f32x16 o[2]; o[0] = (f32x16){}; o[1] = (f32x16){}; f32x16 lacc = (f32x16){}; float m = -1e30f;
    float* biasL = (float*)(smem + AT_BIAS_OFF);
    const int gq_ = fi >> 4; const int sidx0 = 16 * (128 * gq_ - 2 * gq_ * (gq_ - 1)) + (fi & 15) * (128 - 4 * gq_);
    bf16_t* cvdA = nullptr; bf16_t* cvdB = nullptr; float4 cvaA, cvbA, cvaB, cvbB;
    KV_DECL; float breg = 0.f;
#define TJ(s_) (ntiles - 1 - (s_))
    KV_GLOAD(K + (size_t)TJ(0) * 4096, V + (size_t)TJ(0) * 4096); if (tid < 64) breg = (cref - CUM[TJ(0) * 64 + tid]) * LOG2E;
    KV_LSTORE(smem); if (tid < 64) biasL[tid] = breg;
    KV_GLOAD(K + (size_t)TJ(1) * 4096, V + (size_t)TJ(1) * 4096); if (tid < 64) breg = (cref - CUM[TJ(1) * 64 + tid]) * LOG2E;
    KV_LSTORE(smem + AT_STAGE); if (tid < 64) biasL[64 + tid] = breg;
    __syncthreads();
#define FOX_QK(P0, P1, jj, sj) do { const float* bl_ = biasL + (sj) * 64; \
        _Pragma("unroll") for (int g4 = 0; g4 < 4; ++g4) { const float4 x_ = *(const float4*)(bl_ + 8 * g4 + 4 * hi), y_ = *(const float4*)(bl_ + 32 + 8 * g4 + 4 * hi); \
            P0[4 * g4] = x_.x; P0[4 * g4 + 1] = x_.y; P0[4 * g4 + 2] = x_.z; P0[4 * g4 + 3] = x_.w; P1[4 * g4] = y_.x; P1[4 * g4 + 1] = y_.y; P1[4 * g4 + 2] = y_.z; P1[4 * g4 + 3] = y_.w; } \
        qk_tile<true>(smem + (sj) * AT_STAGE, qf, P0, P1, lane); \
        if ((jj) >= jmask_w) mask_tile<1>(P0, P1, 64 * (jj), -1, qrow, hi); } while (0)
#define FOX_STEP(CUR0, CUR1, NXT0, NXT1, j, CVD_LD, CVA_LD, CVB_LD, CVD_ST, CVA_ST, CVB_ST) do { \
        const int s_cur = (j) % 3, s_nxt = ((j) + 1) % 3, s_ld = ((j) + 2) % 3; const bool more_ = (j) + 2 < ntiles; \
        if (more_) { KV_GLOAD(K + (size_t)TJ((j) + 2) * 4096, V + (size_t)TJ((j) + 2) * 4096); if (tid < 64) breg = (cref - CUM[TJ((j) + 2) * 64 + tid]) * LOG2E; } \
        { const int c_ = (sidx0 + (j)) * CV_PER_STEP + tid; CVD_LD = nullptr; \
          if (tid < CV_PER_STEP && c_ < CV_NUP + CV_NDN) { const float* cvs_; if (c_ < CV_NUP) { cvs_ = a.in[I_WUP] + (size_t)c_ * 8; CVD_LD = (bf16_t*)(a.ws + WS_WUP) + (size_t)c_ * 8; } else { cvs_ = a.in[I_WDN] + (size_t)(c_ - CV_NUP) * 8; CVD_LD = (bf16_t*)(a.ws + WS_WDN) + (size_t)(c_ - CV_NUP) * 8; } \
              CVA_LD = *(const float4*)cvs_; CVB_LD = *(const float4*)(cvs_ + 4); } } \
        if ((j) + 1 < ntiles && TJ((j) + 1) <= jmax_w) FOX_QK(NXT0, NXT1, TJ((j) + 1), s_nxt); \
        __builtin_amdgcn_sched_barrier(0); \
        if (TJ(j) <= jmax_w) { softmax_step_nosum(CUR0, CUR1, m, o, lacc); pv_tile_sum(smem + s_cur * AT_STAGE + 8192, CUR0, CUR1, o, lacc, lane); } \
        if (more_) { KV_LSTORE(smem + s_ld * AT_STAGE); if (tid < 64) biasL[s_ld * 64 + tid] = breg; } \
        if (CVD_ST) { uint4 o_; o_.x = cvtpk(CVA_ST.x, CVA_ST.y); o_.y = cvtpk(CVA_ST.z, CVA_ST.w); o_.z = cvtpk(CVB_ST.x, CVB_ST.y); o_.w = cvtpk(CVB_ST.z, CVB_ST.w); *(uint4*)CVD_ST = o_; CVD_ST = nullptr; } \
        __syncthreads(); } while (0)
    f32x16 pA0, pA1, pB0, pB1;
    if (TJ(0) <= jmax_w) FOX_QK(pA0, pA1, TJ(0), 0);
    for (int j = 0; j < ntiles; j += 2) {
        FOX_STEP(pA0, pA1, pB0, pB1, j, cvdA, cvaA, cvbA, cvdB, cvaB, cvbB);
        FOX_STEP(pB0, pB1, pA0, pA1, j + 1, cvdB, cvaB, cvbB, cvdA, cvaA, cvbA);
    }
    if (cvdB) { uint4 o_; o_.x = cvtpk(cvaB.x, cvaB.y); o_.y = cvtpk(cvaB.z, cvaB.w); o_.z = cvtpk(cvbB.x, cvbB.y); o_.w = cvtpk(cvbB.z, cvbB.w); *(uint4*)cvdB = o_; }
#undef FOX_QK
#undef FOX_STEP
#undef TJ
    const float inv = 1.0f / lacc[0]; float ss = 0.f;
    const size_t token = (size_t)b * 8192 + qrow;
    bf16_t* O = (bf16_t*)(a.ws + WS_OFOX) + token * 512 + h * 64;
#pragma unroll
    for (int dh = 0; dh < 2; ++dh)
#pragma unroll
        for (int g4 = 0; g4 < 4; ++g4) { const float v0 = o[dh][4 * g4] * inv, v1 = o[dh][4 * g4 + 1] * inv, v2 = o[dh][4 * g4 + 2] * inv, v3 = o[dh][4 * g4 + 3] * inv;
            ss += v0 * v0 + v1 * v1 + v2 * v2 + v3 * v3; uint2 w; w.x = cvtpk(v0, v1); w.y = cvtpk(v2, v3); *(uint2*)(O + 32 * dh + 8 * g4 + 4 * hi) = w; }
    ss = pair_sum(ss);
    if (hi == 0) ((float*)(a.ws + WS_SSQ))[token * 16 + 8 + h] = ss;
}

DEV void nsa_item(const Args& a, unsigned char* smem, int b, int g, int tt) {
    const int tid = TID(), lane = tid & 63, wid = tid >> 6, col = lane & 31, hi = lane >> 5;
    const int t0 = tt * 64, tokw = col >> 2, r = col & 3, h = 4 * g + r; const int tokl = wid * 8 + tokw; const int t = t0 + tokl; const size_t token = (size_t)b * 8192 + t;
    const float slope2 = exp2f(-(float)(h + 1)) * LOG2E;
    const bf16_t* PROJ = (const bf16_t*)(a.ws + WS_PROJ);
    const float* GN = (const float*)(a.ws + WS_GN) + token * 24 + h * 3;
    const int cur = tt; const bool need_topk = cur > 15;
    bf16x8 qf[4];
    { const bf16_t* Q = PROJ + (((size_t)(h * 2 + b)) * 8192 + t) * 64;
#pragma unroll
      for (int ks = 0; ks < 4; ++ks) qf[ks] = *(const bf16x8*)(Q + 16 * ks + 8 * hi); }
    float* impw = (float*)(smem + AT_IMP_OFF) + wid * 2048; float* totw = impw + lane;
    unsigned* selmask = (unsigned*)(smem + AT_SEL_OFF); unsigned* wun = (unsigned*)(smem + AT_WUN_OFF); int* ucnt = (int*)(smem + AT_UCNT_OFF); unsigned char* ulist = smem + AT_ULIST_OFF;
    f32x16 o[2]; float m, l; int par = 0;
    const int tmin_w = t0 + wid * 8, tmax_w = tmin_w + 7;
    {
        const bf16_t* KC = (const bf16_t*)(a.ws + WS_KC) + ((size_t)(0 * 4 + b * 2 + g)) * 512 * 64; const bf16_t* VC = (const bf16_t*)(a.ws + WS_KC) + ((size_t)(1 * 4 + b * 2 + g)) * 512 * 64;
        const int ncv = t0 / 16 + 3; const int nct = (ncv + 63) >> 6;
        auto src = [&](int j, const bf16_t*& kp, const bf16_t*& vp) { kp = KC + (size_t)j * 4096; vp = VC + (size_t)j * 4096; };
        m = -1e30f; l = 0.f;
        auto src0 = [&](const bf16_t*& kp, const bf16_t*& vp) { kp = KC; vp = VC; };
        par = kv_pipeline(smem, nct, src, [&](int j, const unsigned char* st) {
            const int kpos0 = 1024 * j + 31;
            if (kpos0 > tmax_w) return;
            f32x16 p0, p1; alibi_init<16>(p0, p1, slope2, kpos0, t0, hi);
            qk_tile<false>(st, qf, p0, p1, lane);
            if (kpos0 + 16 * 63 > tmin_w) mask_tile<16>(p0, p1, kpos0, -1, t, hi);
            const float mt = rowmax32(p0, p1); const float mn = fmaxf(m, mt); float rs = 0.f;
#pragma unroll
            for (int rr = 0; rr < 16; ++rr) rs += __builtin_amdgcn_exp2f(p0[rr] - mn) + __builtin_amdgcn_exp2f(p1[rr] - mn);
            rs = pair_sum(rs);
            l = l * __builtin_amdgcn_exp2f(m - mn) + rs; m = mn;
        }, 0, false, true, src0);
        const float linv = l > 0.f ? 1.0f / l : 0.f;
        if (need_topk) { for (int i = lane; i < 8 * 129; i += 64) impw[i] = 0.f; }
        o[0] = (f32x16){}; o[1] = (f32x16){};
        const bf16_t* KS0 = PROJ + ((size_t)((12 + g) * 2 + b)) * 8192 * 64 + (size_t)cur * 4096; const bf16_t* VS0 = PROJ + ((size_t)((14 + g) * 2 + b)) * 8192 * 64 + (size_t)cur * 4096;
        par = kv_pipeline(smem, nct, src, [&](int j, const unsigned char* st) {
            const int kpos0 = 1024 * j + 31;
            if (kpos0 > tmax_w) return;
            f32x16 p0, p1; alibi_init<16>(p0, p1, slope2, kpos0, t0, hi);
            qk_tile<false>(st, qf, p0, p1, lane);
            if (kpos0 + 16 * 63 > tmin_w) mask_tile<16>(p0, p1, kpos0, -1, t, hi);
#pragma unroll
            for (int rr = 0; rr < 16; ++rr) { p0[rr] = __builtin_amdgcn_exp2f(p0[rr] - m) * linv; p1[rr] = __builtin_amdgcn_exp2f(p1[rr] - m) * linv; }
            if (need_topk) {
#pragma unroll
                for (int half = 0; half < 2; ++half)
#pragma unroll
                    for (int g4 = 0; g4 < 4; ++g4) { const f32x16& p = half ? p1 : p0;
                        float ms = (p[4 * g4] + p[4 * g4 + 1]) + (p[4 * g4 + 2] + p[4 * g4 + 3]); float ls = p[4 * g4 + 3];
                        ms = quad_sum(ms); ls = quad_sum(ls);
                        const int n = 16 * j + 8 * half + 2 * g4 + hi;
                        if (r == 0) { atomicAdd(&impw[tokw * 129 + n], ms); atomicAdd(&impw[tokw * 129 + n + 1], ls); } }
            }
            pv_tile<false>(st + 8192, p0, p1, o, lane);
        }, par, true, true, [&](const bf16_t*& kp, const bf16_t*& vp) { kp = KS0; vp = VS0; });
    }
    {
        unsigned un0 = 0u, un1 = 0u, un2 = 0u, un3 = 0u;
        if (need_topk) {
            for (int tk = 0; tk < 8; ++tk) {
                float v0 = impw[tk * 129 + lane], v1 = impw[tk * 129 + 64 + lane];
                v0 = (lane >= 1 && lane <= cur - 2) ? v0 : -1.0f; v1 = (lane + 64 <= cur - 2) ? v1 : -1.0f;
                unsigned m0 = 1u, m1 = 0u, m2 = 0u, m3 = 0u;
#define SETBIT(n_) do { const int n__ = (n_); const unsigned bit__ = 1u << (n__ & 31); const int w__ = n__ >> 5; if (w__ == 0) m0 |= bit__; else if (w__ == 1) m1 |= bit__; else if (w__ == 2) m2 |= bit__; else m3 |= bit__; } while (0)
                SETBIT(cur); SETBIT(cur - 1);
                for (int it = 0; it < 13; ++it) {
                    const float mx = wave_max_u(fmaxf(v0, v1));
                    const unsigned long long b0 = __ballot(v0 == mx);
                    int n;
                    if (b0) n = __ffsll((long long)b0) - 1; else { const unsigned long long b1 = __ballot(v1 == mx); n = 64 + __ffsll((long long)b1) - 1; }
                    if (lane == (n & 63)) { if (n < 64) v0 = -1.0f; else v1 = -1.0f; }
                    SETBIT(n);
                }
#undef SETBIT
                if (lane == 0) { unsigned* sm_ = selmask + (wid * 8 + tk) * 4; sm_[0] = m0; sm_[1] = m1; sm_[2] = m2; sm_[3] = m3; }
                un0 |= m0; un1 |= m1; un2 |= m2; un3 |= m3;
            }
        } else {
            const unsigned full = (2u << cur) - 1u;
            un0 = full;
            if (lane < 8) { unsigned* sm_ = selmask + (wid * 8 + lane) * 4; sm_[0] = full; sm_[1] = 0u; sm_[2] = 0u; sm_[3] = 0u; }
        }
        if (lane == 0) { wun[wid * 4] = un0; wun[wid * 4 + 1] = un1; wun[wid * 4 + 2] = un2; wun[wid * 4 + 3] = un3; }
        __syncthreads();
        if (tid == 0) { int c = 0;
            for (int w = 0; w < 4; ++w) { unsigned u = 0u; for (int ww = 0; ww < NWAVE; ++ww) u |= wun[ww * 4 + w]; for (int bb = 0; bb < 32; ++bb) if ((u >> bb) & 1u) ulist[c++] = (unsigned char)(w * 32 + bb); }
            ucnt[0] = c; }
        __syncthreads();
    }
    { const float g0 = GN[0];
#pragma unroll
      for (int rr = 0; rr < 16; ++rr) { totw[rr * 64] = o[0][rr] * g0; totw[(16 + rr) * 64] = o[1][rr] * g0; } }
    {
        const bf16_t* KS = PROJ + ((size_t)((12 + g) * 2 + b)) * 8192 * 64; const bf16_t* VS = PROJ + ((size_t)((14 + g) * 2 + b)) * 8192 * 64;
        const int nu = ucnt[0];
        m = -1e30f; f32x16 lacc = (f32x16){}; o[0] = (f32x16){}; o[1] = (f32x16){};
        const bf16_t* KW0 = PROJ + ((size_t)((16 + g) * 2 + b)) * 8192 * 64 + (size_t)cur * 4096; const bf16_t* VW0 = PROJ + ((size_t)((18 + g) * 2 + b)) * 8192 * 64 + (size_t)cur * 4096;
        par = kv_pipeline(smem, nu, [&](int j, const bf16_t*& kp, const bf16_t*& vp) { const int n = ulist[nu - 1 - j]; kp = KS + (size_t)n * 4096; vp = VS + (size_t)n * 4096; },
            [&](int j, const unsigned char* st) {
                const int n = ulist[nu - 1 - j];
                if (!((wun[wid * 4 + (n >> 5)] >> (n & 31)) & 1u)) return;
                const bool sel = (selmask[tokl * 4 + (n >> 5)] >> (n & 31)) & 1u;
                f32x16 p0, p1; alibi_init<1>(p0, p1, slope2, 64 * n, t0, hi);
                qk_tile<false>(st, qf, p0, p1, lane);
                if (n == cur || !__all(sel)) mask_tile<1>(p0, p1, 64 * n, -1, sel ? t : -1, hi);
                softmax_step_nosum(p0, p1, m, o, lacc);
                pv_tile_sum(st + 8192, p0, p1, o, lacc, lane);
            }, par, true, true, [&](const bf16_t*& kp, const bf16_t*& vp) { kp = KW0; vp = VW0; });
        const float g1 = GN[1] / fmaxf(lacc[0], 1e-30f);
#pragma unroll
        for (int rr = 0; rr < 16; ++rr) { totw[rr * 64] += o[0][rr] * g1; totw[(16 + rr) * 64] += o[1][rr] * g1; }
    }
    {
        const bf16_t* KW = PROJ + ((size_t)((16 + g) * 2 + b)) * 8192 * 64; const bf16_t* VW = PROJ + ((size_t)((18 + g) * 2 + b)) * 8192 * 64;
        const int jlo = (t0 - 511) > 0 ? ((t0 - 511) >> 6) : 0; const int jhi = cur;
        m = -1e30f; f32x16 lacc = (f32x16){}; o[0] = (f32x16){}; o[1] = (f32x16){};
        (void)kv_pipeline(smem, jhi - jlo + 1, [&](int j, const bf16_t*& kp, const bf16_t*& vp) { kp = KW + (size_t)(jhi - j) * 4096; vp = VW + (size_t)(jhi - j) * 4096; },
            [&](int j, const unsigned char* st) {
                const int kpos0 = 64 * (jhi - j);
                if (kpos0 > tmax_w || kpos0 + 63 < tmin_w - 511) return;
                f32x16 p0, p1; alibi_init<1>(p0, p1, slope2, kpos0, t0, hi);
                qk_tile<false>(st, qf, p0, p1, lane);
                if (kpos0 < tmax_w - 511 || kpos0 + 63 > tmin_w) mask_tile<1>(p0, p1, kpos0, t - 511, t, hi);
                softmax_step_nosum(p0, p1, m, o, lacc);
                pv_tile_sum(st + 8192, p0, p1, o, lacc, lane);
            }, par, true, false, NoSrc());
        const float g2 = GN[2] / fmaxf(lacc[0], 1e-30f);
#pragma unroll
        for (int rr = 0; rr < 16; ++rr) { o[0][rr] = totw[rr * 64] + o[0][rr] * g2; o[1][rr] = totw[(16 + rr) * 64] + o[1][rr] * g2; }
    }
    {
        float ss = 0.f; bf16_t* O = (bf16_t*)(a.ws + WS_ONSA) + token * 512 + h * 64;
#pragma unroll
        for (int dh = 0; dh < 2; ++dh)
#pragma unroll
            for (int g4 = 0; g4 < 4; ++g4) { const float v0 = o[dh][4 * g4], v1 = o[dh][4 * g4 + 1], v2 = o[dh][4 * g4 + 2], v3 = o[dh][4 * g4 + 3];
                ss += v0 * v0 + v1 * v1 + v2 * v2 + v3 * v3; uint2 w; w.x = cvtpk(v0, v1); w.y = cvtpk(v2, v3); *(uint2*)(O + 32 * dh + 8 * g4 + 4 * hi) = w; }
        ss = pair_sum(ss);
        if (hi == 0) ((float*)(a.ws + WS_SSQ))[token * 16 + h] = ss;
    }
}
#ifndef PROBE_DUP
#define PROBE_DUP 0
#endif
DEV void phase_att(const Args& a, unsigned char* smem) {
    int* qctr = (int*)(a.ws + WS_CTL) + 64; int* sitem = (int*)(smem + AT_ITEM_OFF);
    unsigned* ctl = (unsigned*)(a.ws + WS_CTL); unsigned* seen = (unsigned*)(smem + AT_ITEM_OFF + 8);
    if (TID() == 0) seen[0] = 0u;
    for (;;) {
        if (TID() == 0) sitem[0] = atomicAdd(qctr, 1);
        __syncthreads();
        const int item = sitem[0];
        __syncthreads();
        if (item >= 32 + 1024) break;
        if (item < 16) cmp_item(a, smem, 16 + item);
        else if (item < 32) cmp_item(a, smem, item - 16);
        else if (item < 32 + 512) { const int fi = item - 32; const int qb = 31 - (fi >> 4), bh = fi & 15; if (!((seen[0] >> bh) & 1u)) { wait_flag(ctl + CW_CUMFLAG + bh, 1u); if (TID() == 0) seen[0] |= 1u << bh; } fox_item(a, smem, fi, bh >> 3, bh & 7, qb); }
        else { const int idx = item - 32 - 512; const int tt = 127 - (idx >> 2), bg = idx & 3; if (!((seen[0] >> 16) & 1u)) { wait_flag(ctl + CW_CMPFLAG, 16u); if (TID() == 0) seen[0] |= 1u << 16; } nsa_item(a, smem, bg >> 1, bg & 1, tt); }
    }
}

DEV void phase_outproj(const Args& a, unsigned char* smem) {
    const bf16_t* ONSA = (const bf16_t*)(a.ws + WS_ONSA); const bf16_t* OFOX = (const bf16_t*)(a.ws + WS_OFOX); const float* SSQ = (const float*)(a.ws + WS_SSQ);
    const bf16_t* W = (const bf16_t*)(a.ws + WS_WOUT); float* H1 = (float*)(a.ws + WS_H1); const float* X = a.in[I_X];
    float* rs = (float*)(smem + MISC_OFF);
    const int tid = TID(); int lane = tid & 63, wid = tid >> 6, wr = wid >> 2, wc = wid & 3; (void)wr; (void)wc; (void)lane;
    auto aoffo = [](int r, int kc) { return (unsigned)(r * 1024 + kc * 16); }; auto boffo = [](int k, int nc) { return (unsigned)(k * 2048 + nc * 16); };
    for (int item = VBID(); item < 64 * 4; item += gridDim.x) {
        int mt, nt; patch_decode(item, 64, 4, mt, nt);
        gemm256_issue0(smem, ONSA + (size_t)mt * 256 * 512, aoffo, W + nt * 256, boffo);
        if (tid < 256) { const float* s_ = SSQ + (size_t)(mt * 256 + tid) * 16; float sn = 0.f, sf = 0.f;
#pragma unroll
            for (int j = 0; j < 8; ++j) { sn += s_[j]; sf += s_[8 + j]; }
            rs[tid * 2] = rsqrtf(sn * (1.f / 512.f) + EPS); rs[tid * 2 + 1] = rsqrtf(sf * (1.f / 512.f) + EPS); }
        asm volatile("s_waitcnt vmcnt(0)" ::: "memory");
        __syncthreads();
        f32x4 acc[8][4];
#pragma unroll
        for (int mi = 0; mi < 8; ++mi) { const size_t gm = (size_t)mt * 256 + wr * 128 + mi * 16 + (lane & 15);
#pragma unroll
            for (int ni = 0; ni < 4; ++ni) { const int n = nt * 256 + wc * 64 + ni * 16 + 4 * (lane >> 4); const float4 x = *(const float4*)(X + gm * 1024 + n); acc[mi][ni] = (f32x4){x.x, x.y, x.z, x.w}; } }
#pragma unroll
        for (int mi = 0; mi < 8; ++mi) { const float ri = 1.0f / rs[(wr * 128 + mi * 16 + (lane & 15)) * 2];
#pragma unroll
            for (int ni = 0; ni < 4; ++ni) acc[mi][ni] *= ri; }
        gemm256<false>(smem, 8, ONSA + (size_t)mt * 256 * 512, 128u, aoffo, W + nt * 256, 64u * 2048u, boffo, acc, true,
                       [&]() { gemm256_issue0(smem, OFOX + (size_t)mt * 256 * 512, aoffo, W + (size_t)512 * 1024 + nt * 256, boffo); });
        EPI_IDS();
#pragma unroll
        for (int mi = 0; mi < 8; ++mi) { const int rl = wr * 128 + mi * 16 + (lane & 15); const float rat = rs[rl * 2] / rs[rl * 2 + 1];
#pragma unroll
            for (int ni = 0; ni < 4; ++ni) acc[mi][ni] *= rat; }
        gemm256<false>(smem, 8, OFOX + (size_t)mt * 256 * 512, 128u, aoffo, W + (size_t)512 * 1024 + nt * 256, 64u * 2048u, boffo, acc, true);
        EPI_IDS();
#pragma unroll
        for (int mi = 0; mi < 8; ++mi) { const int rl = wr * 128 + mi * 16 + (lane & 15); const size_t gm = (size_t)mt * 256 + rl; const float rf = rs[rl * 2 + 1];
#pragma unroll
            for (int ni = 0; ni < 4; ++ni) { const int n = nt * 256 + wc * 64 + ni * 16 + 4 * (lane >> 4); const f32x4 v = acc[mi][ni] * rf;
                float4 o = {v[0], v[1], v[2], v[3]}; *(float4*)(H1 + gm * 1024 + n) = o; } }
        __syncthreads();
    }
}

DEV void phase_route(const Args& a, unsigned char* smem) {
    const float* H1 = (const float*)(a.ws + WS_H1); bf16_t* XN = (bf16_t*)(a.ws + WS_XN); float* RSTD2 = (float*)(a.ws + WS_RSTD2);
    const float* ln2 = a.in[I_LN2]; const float* wr_ = a.in[I_WR]; const float* br = a.in[I_BR];
    int* CNT = (int*)(a.ws + WS_CTL);
    int* TOPI = (int*)(a.ws + WS_TOPI); int* TOPS = (int*)(a.ws + WS_TOPS); float* TOPW = (float*)(a.ws + WS_TOPW);
    int* TOKOF = (int*)(a.ws + WS_TOKOF); float* ROWW = (float*)(a.ws + WS_ROWW);
    float* part = (float*)smem;
    float* ssqp = part + 8 * 32 * 33;
    int* lcnt = (int*)(ssqp + 256); int* lbase = lcnt + 32; int* te = lbase + 32; int* trk = te + 256; float* tw = (float*)(trk + 256);
    const int tid = TID(), lane = tid & 63, wid = tid >> 6, i32 = lane & 31, kh = lane >> 5; const int tg = wid >> 2, kq = wid & 3;
    for (int item = BID(); item < 256; item += gridDim.x) {
        const int tok = item * 64 + tg * 32 + i32;
        if (tid < 32) lcnt[tid] = 0;
        f32x16 acc = (f32x16){}; float ss = 0.f;
        const float* hrow = H1 + (size_t)tok * 1024 + 256 * kq + 4 * kh; const float* lrow = ln2 + 256 * kq + 4 * kh; bf16_t* xrow = XN + (size_t)tok * 1024 + 256 * kq + 4 * kh;
        const float* wbase = wr_ + (size_t)(256 * kq + 4 * kh) * 32 + i32;
#pragma unroll 4
        for (int c = 0; c < 32; ++c) {
            const float4 hv = *(const float4*)(hrow + 8 * c); const float4 lv = *(const float4*)(lrow + 8 * c);
            ss += hv.x * hv.x + hv.y * hv.y + hv.z * hv.z + hv.w * hv.w;
            const float x0 = hv.x * lv.x, x1 = hv.y * lv.y, x2 = hv.z * lv.z, x3 = hv.w * lv.w;
            uint2 o; o.x = cvtpk(x0, x1); o.y = cvtpk(x2, x3); *(uint2*)(xrow + 8 * c) = o;
            const float* wp = wbase + (size_t)(8 * c) * 32;
            const float w0 = wp[0], w1 = wp[32], w2 = wp[64], w3 = wp[96];
            acc = __builtin_amdgcn_mfma_f32_32x32x2f32(x0, w0, acc, 0, 0, 0);
            acc = __builtin_amdgcn_mfma_f32_32x32x2f32(x1, w1, acc, 0, 0, 0);
            acc = __builtin_amdgcn_mfma_f32_32x32x2f32(x2, w2, acc, 0, 0, 0);
            acc = __builtin_amdgcn_mfma_f32_32x32x2f32(x3, w3, acc, 0, 0, 0);
        }
        ss = pair_sum(ss);
        if (kh == 0) ssqp[wid * 32 + i32] = ss;
#pragma unroll
        for (int r = 0; r < 16; ++r) part[(wid * 32 + crow(r, kh)) * 33 + i32] = acc[r];
        __syncthreads();
        if (tid < 64) {
            const int g_ = tid >> 5, i_ = tid & 31; const int w0_ = g_ * 4;
            const float sq = ssqp[(w0_ + 0) * 32 + i_] + ssqp[(w0_ + 1) * 32 + i_] + ssqp[(w0_ + 2) * 32 + i_] + ssqp[(w0_ + 3) * 32 + i_]; const float rstd = rsqrtf(sq * (1.f / 1024.f) + EPS);
            RSTD2[item * 64 + tid] = rstd;
            float lg[32];
#pragma unroll
            for (int e = 0; e < 32; ++e) lg[e] = (part[((w0_ + 0) * 32 + i_) * 33 + e] + part[((w0_ + 1) * 32 + i_) * 33 + e] + part[((w0_ + 2) * 32 + i_) * 33 + e] + part[((w0_ + 3) * 32 + i_) * 33 + e]) * rstd + br[e];
            unsigned taken = 0u; float tv[4]; int ti[4];
#pragma unroll
            for (int k = 0; k < 4; ++k) { float best = -3.0e38f; int bi = 0;
#pragma unroll
                for (int e = 0; e < 32; ++e) { const bool ok = !((taken >> e) & 1u) && lg[e] > best; best = ok ? lg[e] : best; bi = ok ? e : bi; }
                taken |= 1u << bi; tv[k] = best; ti[k] = bi; }
            const float e1 = __expf(tv[1] - tv[0]), e2 = __expf(tv[2] - tv[0]), e3 = __expf(tv[3] - tv[0]); const float inv = 1.0f / (1.0f + e1 + e2 + e3);
            const float wv[4] = {inv, e1 * inv, e2 * inv, e3 * inv};
#pragma unroll
            for (int k = 0; k < 4; ++k) { const int idx = tid * 4 + k; te[idx] = ti[k]; trk[idx] = atomicAdd(&lcnt[ti[k]], 1); tw[idx] = wv[k]; }
        }
        __syncthreads();
        if (tid < 32) lbase[tid] = atomicAdd(&CNT[tid], lcnt[tid]);
        __syncthreads();
        if (tid < 256) { const int idx = tid; const int tk = item * 64 + (idx >> 2); const int e = te[idx]; const int slot = lbase[e] + trk[idx];
          TOPI[(size_t)tk * 4 + (idx & 3)] = e; TOPS[(size_t)tk * 4 + (idx & 3)] = slot; TOPW[(size_t)tk * 4 + (idx & 3)] = tw[idx];
          TOKOF[(size_t)e * 16384 + slot] = tk; ROWW[(size_t)e * 16384 + slot] = tw[idx]; }
        __syncthreads();
    }
}

struct MoeMap { int e, mt, nt, cnt, off; };
DEV void moe_setup(const Args& a, int* sm) {
    if (TID() == 0) { const int* CNT = (const int*)(a.ws + WS_CTL); int tot = 0; for (int e = 0; e < 32; ++e) { const int c = CNT[e]; const int mt = (c + 255) >> 8; sm[e] = mt; sm[32 + e] = tot; tot += mt; } sm[64] = tot; }
    __syncthreads();
}
DEV MoeMap moe_map(const Args& a, const int* sm, int item, int NT) {
    MoeMap mm; int e = 0;
#pragma unroll 1
    for (int i = 1; i < 32; ++i) if (item >= sm[32 + i] * NT) e = i;
    const int local = item - sm[32 + e] * NT; const int mte = sm[e];
    int mt_, nt_; patch_decode(local, mte, NT, mt_, nt_);
    mm.e = __builtin_amdgcn_readfirstlane(e); mm.mt = __builtin_amdgcn_readfirstlane(mt_); mm.nt = __builtin_amdgcn_readfirstlane(nt_);
    mm.cnt = __builtin_amdgcn_readfirstlane(((const int*)(a.ws + WS_CTL))[e]); mm.off = __builtin_amdgcn_readfirstlane(sm[32 + e] * 256); return mm;
}
DEV void phase_up(const Args& a, unsigned char* smem) {
    int* sm = (int*)(smem + MISC_OFF); int* tokb = sm + 128; float* rsdb = (float*)(tokb + 512);
    const bf16_t* XN = (const bf16_t*)(a.ws + WS_XN); const bf16_t* W = (const bf16_t*)(a.ws + WS_WUP); bf16_t* ACT = (bf16_t*)(a.ws + WS_ACT); const float* RSTD2 = (const float*)(a.ws + WS_RSTD2);
    const int* TOKOF = (const int*)(a.ws + WS_TOKOF); const float* bup = a.in[I_BUP];
    const int tid = TID(); int lane = tid & 63, wid = tid >> 6, wr = wid >> 2, wc = wid & 3; (void)wr; (void)wc; (void)lane;
    moe_setup(a, sm);
    const int nitems = __builtin_amdgcn_readfirstlane(sm[64]) * 8;
    auto fill = [&](const MoeMap& m_, int buf) { if (tid < 256) { const int slot = m_.mt * 256 + tid; const int tk_ = slot < m_.cnt ? TOKOF[(size_t)m_.e * 16384 + slot] : 0; tokb[buf * 256 + tid] = tk_; rsdb[buf * 256 + tid] = RSTD2[tk_]; } };
    auto boffu = [](int k, int nc) { const int ni = (nc >> 1) & 3; const int sc = ((ni >> 1) ? 1024 : 0) + (nc >> 3) * 32 + (ni & 1) * 16 + (nc & 1) * 8; return (unsigned)(k * 4096 + sc * 2); };
    int item = VBID(); int buf = 0; bool pre = false; MoeMap mm{};
    if (item < nitems) { mm = moe_map(a, sm, item, 8); fill(mm, 0); }
    __syncthreads();
    while (item < nitems) {
        const int nitem = item + (int)gridDim.x; const bool has_next = nitem < nitems; MoeMap mn{};
        if (has_next) { mn = moe_map(a, sm, nitem, 8); fill(mn, buf ^ 1); }
        const int* tok = tokb + buf * 256; const int* tokn = tokb + (buf ^ 1) * 256; const float* rsd = rsdb + buf * 256;
        const bf16_t* We = W + (size_t)mm.e * 1024 * 2048; const bf16_t* Wn = W + (size_t)mn.e * 1024 * 2048;
        f32x4 acc[8][4];
        gemm256<true>(smem, 16, XN, 128u, [&](int r, int kc) { return (unsigned)(tok[r] * 2048 + kc * 16); }, We + mm.nt * 128, 64u * 4096u, boffu, acc, pre,
                      [&]() { if (has_next) gemm256_issue0(smem, XN, [&](int r, int kc) { return (unsigned)(tokn[r] * 2048 + kc * 16); }, Wn + mn.nt * 128, boffu); });
        EPI_IDS();
#pragma unroll
        for (int mi = 0; mi < 8; ++mi) { const int rl_ = wr * 128 + mi * 16 + (lane & 15); const size_t row = (size_t)mm.off + mm.mt * 256 + rl_; const float rs_ = rsd[rl_];
#pragma unroll
            for (int ni = 0; ni < 2; ++ni) { const int jc = mm.nt * 128 + wc * 32 + ni * 16 + 4 * (lane >> 4);
                const float4 bg = *(const float4*)(bup + (size_t)mm.e * 2048 + jc), bl_ = *(const float4*)(bup + (size_t)mm.e * 2048 + 1024 + jc);
                const f32x4 gv = acc[mi][ni], lv = acc[mi][ni + 2]; const float bgv[4] = {bg.x, bg.y, bg.z, bg.w}, blv[4] = {bl_.x, bl_.y, bl_.z, bl_.w}; float r4[4];
#pragma unroll
                for (int r = 0; r < 4; ++r) { const float gg = fminf(gv[r] * rs_ + bgv[r], 7.0f); const float ll = fminf(fmaxf(lv[r] * rs_ + blv[r], -7.0f), 7.0f); r4[r] = gg * sigmoidf_(1.702f * gg) * (ll + 1.0f); }
                uint2 o; o.x = cvtpk(r4[0], r4[1]); o.y = cvtpk(r4[2], r4[3]); *(uint2*)(ACT + row * 1024 + jc) = o; } }
        __syncthreads();
        item = nitem; mm = mn; buf ^= 1; pre = has_next;
    }
}
DEV void phase_down(const Args& a, unsigned char* smem) {
    int* sm = (int*)(smem + MISC_OFF); float* rwb = (float*)(sm + 128);
    const bf16_t* ACT = (const bf16_t*)(a.ws + WS_ACT); const bf16_t* W = (const bf16_t*)(a.ws + WS_WDN); bf16_t* Y = (bf16_t*)(a.ws + WS_Y);
    const float* ROWW = (const float*)(a.ws + WS_ROWW); const float* bdn = a.in[I_BDN];
    const int tid = TID(); int lane = tid & 63, wid = tid >> 6, wr = wid >> 2, wc = wid & 3; (void)wr; (void)wc; (void)lane;
    moe_setup(a, sm);
    const int nitems = __builtin_amdgcn_readfirstlane(sm[64]) * 4;
    auto fill = [&](const MoeMap& m_, int buf) { if (tid < 256) { const int slot = m_.mt * 256 + tid; rwb[buf * 256 + tid] = slot < m_.cnt ? ROWW[(size_t)m_.e * 16384 + slot] : 0.f; } };
    auto aoffd = [](int r, int kc) { return (unsigned)(r * 2048 + kc * 16); }; auto boffd = [](int k, int nc) { return (unsigned)(k * 2048 + nc * 16); };
    int item = VBID(); int buf = 0; bool pre = false; MoeMap mm{};
    if (item < nitems) { mm = moe_map(a, sm, item, 4); fill(mm, 0); }
    __syncthreads();
    while (item < nitems) {
        const int nitem = item + (int)gridDim.x; const bool has_next = nitem < nitems; MoeMap mn{};
        if (has_next) { mn = moe_map(a, sm, nitem, 4); fill(mn, buf ^ 1); }
        const float* rw = rwb + buf * 256;
        const bf16_t* We = W + (size_t)mm.e * 1024 * 1024; const bf16_t* Ab = ACT + ((size_t)mm.off + mm.mt * 256) * 1024;
        const bf16_t* Wn = W + (size_t)mn.e * 1024 * 1024; const bf16_t* An = ACT + ((size_t)mn.off + mn.mt * 256) * 1024;
        f32x4 acc[8][4];
        gemm256<true>(smem, 16, Ab, 128u, aoffd, We + mm.nt * 256, 64u * 2048u, boffd, acc, pre,
                      [&]() { if (has_next) gemm256_issue0(smem, An, aoffd, Wn + mn.nt * 256, boffd); });
        EPI_IDS();
#pragma unroll
        for (int mi = 0; mi < 8; ++mi) { const int rl = wr * 128 + mi * 16 + (lane & 15); const size_t row = (size_t)mm.off + mm.mt * 256 + rl; const float w = rw[rl];
#pragma unroll
            for (int ni = 0; ni < 4; ++ni) { const int n = mm.nt * 256 + wc * 64 + ni * 16 + 4 * (lane >> 4); const float4 bb = *(const float4*)(bdn + (size_t)mm.e * 1024 + n); const f32x4 v = acc[mi][ni];
                uint2 o; o.x = cvtpk((v[0] + bb.x) * w, (v[1] + bb.y) * w); o.y = cvtpk((v[2] + bb.z) * w, (v[3] + bb.w) * w); *(uint2*)(Y + row * 1024 + n) = o; } }
        __syncthreads();
        item = nitem; mm = mn; buf ^= 1; pre = has_next;
    }
}

DEV void phase_comb(const Args& a, unsigned char* smem) {
    int* sm = (int*)(smem + MISC_OFF);
    moe_setup(a, sm);
    float* H1 = (float*)(a.ws + WS_H1); bf16_t* XN = (bf16_t*)(a.ws + WS_XN); const bf16_t* Y = (const bf16_t*)(a.ws + WS_Y);
    const int* TOPI = (const int*)(a.ws + WS_TOPI); const int* TOPS = (const int*)(a.ws + WS_TOPS); const float* g = a.in[I_LNPLE];
    const int lane = TID() & 63; const int gw = BID() * NWAVE + (TID() >> 6), ngw = gridDim.x * NWAVE;
    for (int tok = gw; tok < NTOK; tok += ngw) {
        float4 v[4];
#pragma unroll
        for (int j = 0; j < 4; ++j) v[j] = *(const float4*)(H1 + (size_t)tok * 1024 + j * 256 + lane * 4);
#pragma unroll
        for (int k = 0; k < 4; ++k) { const int e = TOPI[(size_t)tok * 4 + k]; const size_t row = (size_t)sm[32 + e] * 256 + TOPS[(size_t)tok * 4 + k];
#pragma unroll
            for (int j = 0; j < 4; ++j) { const uint2 u = *(const uint2*)(Y + row * 1024 + j * 256 + lane * 4); v[j].x += bflo(u.x); v[j].y += bfhi(u.x); v[j].z += bflo(u.y); v[j].w += bfhi(u.y); } }
        float s = 0.f;
#pragma unroll
        for (int j = 0; j < 4; ++j) { *(float4*)(H1 + (size_t)tok * 1024 + j * 256 + lane * 4) = v[j]; s += v[j].x * v[j].x + v[j].y * v[j].y + v[j].z * v[j].z + v[j].w * v[j].w; }
        const float rstd = rsqrtf(wave_sum(s) * (1.f / 1024.f) + EPS);
#pragma unroll
        for (int j = 0; j < 4; ++j) { const float4 gg = *(const float4*)(g + j * 256 + lane * 4);
            uint2 o; o.x = cvtpk(v[j].x * rstd * gg.x, v[j].y * rstd * gg.y); o.y = cvtpk(v[j].z * rstd * gg.z, v[j].w * rstd * gg.w); *(uint2*)(XN + (size_t)tok * 1024 + j * 256 + lane * 4) = o; }
    }
}

DEV void phase_gate(const Args& a, unsigned char* smem) {
    const bf16_t* XN = (const bf16_t*)(a.ws + WS_XN); const bf16_t* WG = (const bf16_t*)(a.ws + WS_WGATE); const bf16_t* PB = (const bf16_t*)(a.ws + WS_PB); const bf16_t* WP = (const bf16_t*)(a.ws + WS_WPLE);
    const float* H2 = (const float*)(a.ws + WS_H1); float* OUT = a.out; float* SSQ3 = (float*)(a.ws + WS_SSQ3);
    const int tid = TID(); int lane = tid & 63, wid = tid >> 6, wr = wid >> 2, wc = wid & 3; (void)wr; (void)wc; (void)lane;
    bf16_t* GT = (bf16_t*)(a.ws + WS_ACT);
    auto aoffg = [](int r, int kc) { return (unsigned)(r * 2048 + kc * 16); }; auto aoffp = [](int r, int kc) { return (unsigned)(r * 512 + kc * 16); }; auto boffg = [](int k, int nc) { return (unsigned)(k * 2048 + nc * 16); };
    for (int item = VBID(); item < 64 * 4; item += gridDim.x) {
        int mt, nt; patch_decode(item, 64, 4, mt, nt);
        f32x4 acc[8][4];
        gemm256<true>(smem, 16, XN + (size_t)mt * 256 * 1024, 128u, aoffg, WG + nt * 256, 64u * 2048u, boffg, acc, false,
                      [&]() { gemm256_issue0(smem, PB + (size_t)mt * 256 * 256, aoffp, WP + nt * 256, boffg); });
        EPI_IDS();
#pragma unroll
        for (int mi = 0; mi < 8; ++mi) { const size_t gm = (size_t)mt * 256 + wr * 128 + mi * 16 + (lane & 15);
#pragma unroll
            for (int ni = 0; ni < 4; ++ni) { const int n = nt * 256 + wc * 64 + ni * 16 + 4 * (lane >> 4); const f32x4 v = acc[mi][ni];
                uint2 w; w.x = cvtpk(sigmoidf_(v[0]), sigmoidf_(v[1])); w.y = cvtpk(sigmoidf_(v[2]), sigmoidf_(v[3])); *(uint2*)(GT + gm * 1024 + n) = w;
                const float4 h = *(const float4*)(H2 + gm * 1024 + n);
                acc[mi][ni] = (f32x4){h.x * __builtin_amdgcn_rcpf(bflo(w.x)), h.y * __builtin_amdgcn_rcpf(bfhi(w.x)), h.z * __builtin_amdgcn_rcpf(bflo(w.y)), h.w * __builtin_amdgcn_rcpf(bfhi(w.y))}; }
            asm volatile("" ::: "memory"); }
        gemm256<false>(smem, 4, PB + (size_t)mt * 256 * 256, 128u, aoffp, WP + nt * 256, 64u * 2048u, boffg, acc, true);
        EPI_IDS();
        const bool fused = gridDim.x >= 256;
#pragma unroll
        for (int mi = 0; mi < 8; ++mi) { const size_t gm = (size_t)mt * 256 + wr * 128 + mi * 16 + (lane & 15); float ss = 0.f;
#pragma unroll
            for (int ni = 0; ni < 4; ++ni) { const int n = nt * 256 + wc * 64 + ni * 16 + 4 * (lane >> 4); const f32x4 v = acc[mi][ni];
                const uint2 gw = *(const uint2*)(GT + gm * 1024 + n);
                float4 o = {v[0] * bflo(gw.x), v[1] * bfhi(gw.x), v[2] * bflo(gw.y), v[3] * bfhi(gw.y)};
                if (!fused) *(float4*)(OUT + gm * 1024 + n) = o;
                acc[mi][ni] = (f32x4){o.x, o.y, o.z, o.w};
                ss += o.x * o.x + o.y * o.y + o.z * o.z + o.w * o.w; }
            ss += __shfl_xor(ss, 16); ss += __shfl_xor(ss, 32);
            if (lane < 16) SSQ3[gm * 16 + nt * 4 + wc] = ss;
            asm volatile("" ::: "memory"); }
        if (fused) {
            unsigned* flag = (unsigned*)(a.ws + WS_CTL) + CW_GATEFLAG + mt;
            signal_done(flag); wait_flag(flag, 4u);
            const float* lnf = a.in[I_LNF];
#pragma unroll
            for (int mi = 0; mi < 8; ++mi) { const size_t gm = (size_t)mt * 256 + wr * 128 + mi * 16 + (lane & 15);
                const float4 s0 = *(const float4*)(SSQ3 + gm * 16), s1 = *(const float4*)(SSQ3 + gm * 16 + 4), s2 = *(const float4*)(SSQ3 + gm * 16 + 8), s3 = *(const float4*)(SSQ3 + gm * 16 + 12);
                const float tot = ((s0.x + s0.y) + (s0.z + s0.w)) + ((s1.x + s1.y) + (s1.z + s1.w)) + ((s2.x + s2.y) + (s2.z + s2.w)) + ((s3.x + s3.y) + (s3.z + s3.w));
                const float rstd = rsqrtf(tot * (1.f / 1024.f) + EPS);
#pragma unroll
                for (int ni = 0; ni < 4; ++ni) { const int n = nt * 256 + wc * 64 + ni * 16 + 4 * (lane >> 4); const float4 gg = *(const float4*)(lnf + n); const f32x4 v = acc[mi][ni];
                    float4 o = {v[0] * rstd * gg.x, v[1] * rstd * gg.y, v[2] * rstd * gg.z, v[3] * rstd * gg.w}; *(float4*)(OUT + gm * 1024 + n) = o; }
                asm volatile("" ::: "memory"); }
        }
        __syncthreads();
    }
}

DEV void phase_final(const Args& a) {
    if (gridDim.x >= 256) return;
    float* OUT = a.out; const float* SSQ3 = (const float*)(a.ws + WS_SSQ3); const float* g = a.in[I_LNF];
    const int lane = TID() & 63; const int gw = BID() * NWAVE + (TID() >> 6), ngw = gridDim.x * NWAVE;
    for (int m = gw; m < NTOK; m += ngw) {
        float s = 0.f;
#pragma unroll
        for (int j = 0; j < 16; ++j) s += SSQ3[(size_t)m * 16 + j];
        const float rstd = rsqrtf(s * (1.f / 1024.f) + EPS);
#pragma unroll
        for (int j = 0; j < 4; ++j) { float4 v = *(const float4*)(OUT + (size_t)m * 1024 + j * 256 + lane * 4); const float4 gg = *(const float4*)(g + j * 256 + lane * 4);
            v.x *= rstd * gg.x; v.y *= rstd * gg.y; v.z *= rstd * gg.z; v.w *= rstd * gg.w; *(float4*)(OUT + (size_t)m * 1024 + j * 256 + lane * 4) = v; }
    }
}

template <int PH> DEV void run_phase(const Args& a, unsigned char* smem) {
    if constexpr (PH == PH_PRO) phase_prologue(a, smem);
    else if constexpr (PH == PH_INPROJ) phase_inproj(a, smem);
    else if constexpr (PH == PH_ATT) phase_att(a, smem);
    else if constexpr (PH == PH_OUTPROJ) phase_outproj(a, smem);
    else if constexpr (PH == PH_ROUTE) phase_route(a, smem);
    else if constexpr (PH == PH_UP) phase_up(a, smem);
    else if constexpr (PH == PH_DOWN) phase_down(a, smem);
    else if constexpr (PH == PH_COMB) phase_comb(a, smem);
    else if constexpr (PH == PH_GATE) phase_gate(a, smem);
    else if constexpr (PH == PH_FINAL) phase_final(a);
}
#define XB_TMO      128
#define XB_XCNT(j)  (256  + 64 * (j))
#define XB_XSUB(j)  (1280 + 64 * (j))
#define XB_XGEN(j)  (2304 + 64 * (j))
#define XB_TOP      3328
#define XB_TOPGEN   3392
#define XCD_BAR_WORDS 3456
#define XB_SPIN_CAP (1u << 22)
DEV unsigned xb_ld(unsigned* p)              { return __hip_atomic_load(p, __ATOMIC_RELAXED, __HIP_MEMORY_SCOPE_AGENT); }
DEV unsigned xb_add(unsigned* p, unsigned v) { return __hip_atomic_fetch_add(p, v, __ATOMIC_RELAXED, __HIP_MEMORY_SCOPE_AGENT); }
DEV unsigned xb_xcc_id() { return (unsigned)__builtin_amdgcn_s_getreg((3 << 11) | 20) & 0xFu; }
#define XB_SPIN(cond, bar) do { unsigned _sp = 0; while (cond) { __builtin_amdgcn_s_sleep(1); \
    if ((++_sp & 255u) == 0u) { if (xb_ld(&(bar)[XB_TMO])) break; if (_sp > XB_SPIN_CAP) { atomicAdd(&(bar)[XB_TMO], 1u); break; } } } } while (0)
struct XcdBarrier { unsigned* bar; unsigned x; volatile LAS unsigned* st; };
DEV XcdBarrier xcd_barrier_post(unsigned* bar, volatile LAS unsigned* st) {
    XcdBarrier b; b.bar = bar; b.x = xb_xcc_id(); b.st = st;
    if (TID() == 0) (void)xb_add(&bar[XB_XCNT(b.x)], 1u);
    return b;
}
DEV void xcd_barrier_complete(unsigned* bar, unsigned x, unsigned& nloc, unsigned& nx) {
    const unsigned G = gridDim.x * gridDim.y * gridDim.z;
    unsigned sum, cnt, mine, sp = 0u;
    for (;;) {
        sum = 0u; cnt = 0u; mine = 0u;
#pragma unroll
        for (unsigned j = 0; j < 16; ++j) { const unsigned c = xb_ld(&bar[XB_XCNT(j)]); sum += c; cnt += (c > 0u) ? 1u : 0u; mine = (j == x) ? c : mine; }
        if (sum == G) break;
        __builtin_amdgcn_s_sleep(1);
        if ((++sp & 255u) == 0u) { if (xb_ld(&bar[XB_TMO])) break; if (sp > XB_SPIN_CAP) { atomicAdd(&bar[XB_TMO], 1u); break; } }
    }
    nloc = mine > 0u ? mine : 1u; nx = cnt > 0u ? cnt : 1u;
}
DEV void xcd_barrier(const XcdBarrier& b) {
    asm volatile("s_waitcnt vmcnt(0)" ::: "memory");
    __syncthreads();
    if (TID() == 0) {
        unsigned* bar = b.bar;
        __builtin_amdgcn_s_waitcnt(0);
        unsigned nloc = b.st[0], nx = b.st[1];
        if (nloc == 0u) { xcd_barrier_complete(bar, b.x, nloc, nx); b.st[0] = nloc; b.st[1] = nx; }
        const unsigned old = xb_add(&bar[XB_XSUB(b.x)], 1u);
        const unsigned gen = old / nloc;
        if (old + 1u == (gen + 1u) * nloc) {
            __builtin_amdgcn_fence(__ATOMIC_RELEASE, "agent");
            asm volatile("s_waitcnt vmcnt(0)" ::: "memory");
            const unsigned og = xb_add(&bar[XB_TOP], 1u);
            const unsigned tg = og / nx;
            if (og + 1u == (tg + 1u) * nx) xb_add(&bar[XB_TOPGEN], 1u);
            else XB_SPIN(xb_ld(&bar[XB_TOPGEN]) == tg, bar);
            __builtin_amdgcn_fence(__ATOMIC_ACQUIRE, "agent");
            xb_add(&bar[XB_XGEN(b.x)], 1u);
            asm volatile("s_waitcnt vmcnt(0)" ::: "memory");
        } else {
            XB_SPIN(xb_ld(&bar[XB_XGEN(b.x)]) == gen, bar);
            __builtin_amdgcn_fence(__ATOMIC_ACQUIRE, "agent");
            asm volatile("s_waitcnt vmcnt(0)" ::: "memory");
        }
    }
    __syncthreads();
}

__global__ void __launch_bounds__(NTHR, 2) mega(Args a) {
    extern __shared__ __attribute__((aligned(16))) unsigned char smem[];
    volatile LAS unsigned* bst = (volatile LAS unsigned*)(LAS unsigned char*)(smem + MISC_OFF + 8000);
    if (TID() == 0) { bst[0] = 0u; bst[1] = 0u; }
    __syncthreads();
    const XcdBarrier bar = xcd_barrier_post((unsigned*)(a.ws + WS_CTL) + 4096, bst);
#define GSYNC() xcd_barrier(bar)
#define RUN(ph) do { run_phase<ph>(a, smem); if ((PROBE_DUP >> ph) & 1) { GSYNC(); run_phase<ph>(a, smem); } } while (0)
    RUN(PH_PRO); GSYNC();
    RUN(PH_INPROJ); GSYNC();
    RUN(PH_ATT); GSYNC();
    RUN(PH_OUTPROJ); GSYNC();
    RUN(PH_ROUTE); GSYNC();
    RUN(PH_UP); GSYNC();
    RUN(PH_DOWN); GSYNC();
    RUN(PH_COMB); GSYNC();
    RUN(PH_GATE);
    if (gridDim.x < 256) { GSYNC(); RUN(PH_FINAL); }
#undef RUN
#undef GSYNC
}

extern "C" void kernel_launch(void* const* d_in, const int* in_sizes, int n_in, void* d_out, int out_size, void* d_ws, size_t ws_size, hipStream_t stream) {
    static int grid = 0;
    if (grid == 0) {
        if (n_in != 25 || ws_size < WS_END) { fprintf(stderr, "kernel_launch: unexpected n_in %d / ws %zu\n", n_in, ws_size); grid = -1; return; }
        int dev = 0, cus = 0, per_cu = 0;
        (void)hipGetDevice(&dev); (void)hipDeviceGetAttribute(&cus, hipDeviceAttributeMultiprocessorCount, dev);
        (void)hipFuncSetAttribute((const void*)mega, hipFuncAttributeMaxDynamicSharedMemorySize, LDS_BYTES);
        (void)hipOccupancyMaxActiveBlocksPerMultiprocessor(&per_cu, (const void*)mega, NTHR, LDS_BYTES);
        if (per_cu < 1) { fprintf(stderr, "kernel_launch: occupancy query says %d blocks per CU\n", per_cu); grid = -1; return; }
        grid = cus;
    }
    if (grid < 0) return;
    (void)hipMemsetAsync((char*)d_ws + WS_CTL, 0, 65536, stream);
    Args a{};
    for (int i = 0; i < 25; ++i) a.in[i] = (const float*)d_in[i];
    a.out = (float*)d_out; a.ws = (unsigned char*)d_ws; a.ph_lo = 0; a.ph_hi = PH_N;
    void* args[] = {&a};
    hipError_t e = hipLaunchCooperativeKernel((const void*)mega, dim3(grid), dim3(NTHR), args, LDS_BYTES, stream);
    if (e != hipSuccess) fprintf(stderr, "cooperative launch failed: %s (grid %d)\n", hipGetErrorString(e), grid);
}
```

```cpp
#include <hip/hip_runtime.h>
#include <stdint.h>
#include <cstdio>

#define DEV __device__ __forceinline__
#define LAS __attribute__((address_space(3)))

typedef unsigned short bf16_t;
typedef short bf16x8 __attribute__((ext_vector_type(8)));
typedef short s16x4 __attribute__((ext_vector_type(4)));
typedef float f32x4 __attribute__((ext_vector_type(4)));
typedef float f32x16 __attribute__((ext_vector_type(16)));
typedef float f32x2_t __attribute__((ext_vector_type(2)));
typedef __bf16 bf16x2_t __attribute__((ext_vector_type(2)));

constexpr int NTHR = 512, NWAVE = 8;
constexpr int NTOK = 16384;
constexpr float EPS = 1e-6f;
constexpr float LOG2E = 1.4426950408889634f;
constexpr float QS = 0.125f * LOG2E;
constexpr int NWIN = 3072;

constexpr size_t MiB = 1u << 20;
constexpr size_t WS_CTL = 0;
constexpr size_t WS_WIN = 1 * MiB;
constexpr size_t WS_WOUT = 7 * MiB;
constexpr size_t WS_WGATE = 9 * MiB;
constexpr size_t WS_WPLE = 11 * MiB;
constexpr size_t WS_WC1 = 12 * MiB;
constexpr size_t WS_WC2 = 15 * MiB + 512 * 1024 + 262144;
constexpr size_t WS_BIAS1 = 15 * MiB + 512 * 1024 + 262144 + 131072;
constexpr size_t WS_KC = 14 * MiB;
constexpr size_t WS_HID = 14 * MiB + 512 * 1024;
constexpr size_t WS_GN = 16 * MiB;
constexpr size_t WS_LS = 18 * MiB;
constexpr size_t WS_CUM = 19 * MiB;
constexpr size_t WS_SSQ = 20 * MiB;
constexpr size_t WS_TOPI = 21 * MiB;
constexpr size_t WS_TOPS = 21 * MiB + 262144;
constexpr size_t WS_TOPW = 21 * MiB + 524288;
constexpr size_t WS_TOKOF = 22 * MiB;
constexpr size_t WS_ROWW = 24 * MiB;
constexpr size_t WS_SSQ3 = 26 * MiB;
constexpr size_t WS_RSTD2 = 27 * MiB;
constexpr size_t WS_PB = 28 * MiB;
constexpr size_t WS_XN = 36 * MiB;
constexpr size_t WS_PROJ = 68 * MiB;
constexpr size_t WS_ONSA = 160 * MiB;
constexpr size_t WS_OFOX = 176 * MiB;
constexpr size_t WS_H1 = 192 * MiB;
constexpr size_t WS_WUP = 256 * MiB;
constexpr size_t WS_WDN = 384 * MiB;
constexpr size_t WS_ACT = 448 * MiB;
constexpr size_t WS_Y = 592 * MiB;
constexpr size_t WS_END = 736 * MiB;

enum { PH_PRO = 0, PH_INPROJ, PH_CMP, PH_ATT, PH_OUTPROJ, PH_ROUTE, PH_UP, PH_DOWN, PH_COMB, PH_GATE, PH_FINAL, PH_N };
struct Args { const float* in[25]; float* out; unsigned char* ws; int ph_lo, ph_hi; };
enum { I_X = 0, I_P, I_LN1, I_WIN, I_BFG, I_WC1K, I_WC2K, I_PEK, I_WC1V, I_WC2V, I_PEV, I_GNN, I_GNF, I_WOUT, I_LN2, I_WR, I_BR,
       I_WUP, I_BUP, I_WDN, I_BDN, I_LNPLE, I_WPLE, I_WGATE, I_LNF };

DEV int BID() { int b = (int)blockIdx.x; asm volatile("" : "+s"(b)); return b; }
DEV int VBID() { const int g = (int)gridDim.x, b = BID(); return (g & 7) ? b : (b & 7) * (g >> 3) + (b >> 3); }
DEV int TID() { int t = (int)__builtin_amdgcn_workitem_id_x(); asm volatile("" : "+v"(t)); return t; }
DEV unsigned cvtpk(float lo, float hi) { f32x2_t v = {lo, hi}; bf16x2_t b = __builtin_convertvector(v, bf16x2_t); return __builtin_bit_cast(unsigned, b); }
DEV float bflo(unsigned u) { return __uint_as_float(u << 16); }
DEV float bfhi(unsigned u) { return __uint_as_float(u & 0xffff0000u); }
DEV float wave_sum(float v) {
#pragma unroll
    for (int o = 1; o < 64; o <<= 1) v += __shfl_xor(v, o);
    return v;
}
#define DPP_MOV(x, ctrl) __builtin_bit_cast(float, __builtin_amdgcn_update_dpp(0, __builtin_bit_cast(int, (x)), (ctrl), 0xF, 0xF, true))
DEV float pair_sum(float x) { return x + __shfl_xor(x, 32); }
DEV float pair_max(float x) { return fmaxf(x, __shfl_xor(x, 32)); }
DEV float quad_sum(float x) { x += DPP_MOV(x, 0xB1); x += DPP_MOV(x, 0x4E); return x; }
DEV float wave_max_u(float x) {
    x = fmaxf(x, DPP_MOV(x, 0xB1)); x = fmaxf(x, DPP_MOV(x, 0x4E)); x = fmaxf(x, DPP_MOV(x, 0x141)); x = fmaxf(x, DPP_MOV(x, 0x140));
    const float a = __builtin_bit_cast(float, __builtin_amdgcn_readlane(__builtin_bit_cast(int, x), 0)), b = __builtin_bit_cast(float, __builtin_amdgcn_readlane(__builtin_bit_cast(int, x), 16));
    const float c = __builtin_bit_cast(float, __builtin_amdgcn_readlane(__builtin_bit_cast(int, x), 32)), d = __builtin_bit_cast(float, __builtin_amdgcn_readlane(__builtin_bit_cast(int, x), 48));
    return fmaxf(fmaxf(a, b), fmaxf(c, d));
}
DEV float sigmoidf_(float x) { return __builtin_amdgcn_rcpf(1.0f + __expf(-x)); }
DEV float logsigmoidf_(float x) { return fminf(x, 0.f) - log1pf(__expf(-fabsf(x))); }
DEV float gelu_tanh(float x) { const float u = 0.7978845608028654f * (x + 0.044715f * x * x * x); const float th = 1.0f - 2.0f * __builtin_amdgcn_rcpf(__expf(2.0f * u) + 1.0f); return 0.5f * x * (1.0f + th); }
DEV s16x4 tr_read(const unsigned char* p) {
    typedef short v4i16_t __attribute__((ext_vector_type(4)));
    return __builtin_bit_cast(s16x4, __builtin_amdgcn_ds_read_tr16_b64_v4i16((LAS v4i16_t*)p));
}
DEV int crow(int r, int hi) { return (r & 3) + 8 * (r >> 2) + 4 * hi; }

constexpr int GL_STAGE = 65536;
constexpr int GEMM_LDS = 2 * GL_STAGE;
constexpr int MISC_OFF = GEMM_LDS;
constexpr int LDS_BYTES = GEMM_LDS + 8192;

DEV void glds16s(const void* sbase, unsigned voff, unsigned lds_dst) { unsigned keep;
    asm volatile("s_mov_b32 %0, m0\n\ts_mov_b32 m0, %3\n\ts_nop 0\n\tglobal_load_lds_dwordx4 %1, %2\n\ts_mov_b32 m0, %0" : "=&s"(keep) : "v"(voff), "s"(sbase), "s"(lds_dst) : "memory"); }

DEV const unsigned char* uptr(const void* p) { const unsigned long long v = (unsigned long long)p; const unsigned lo = __builtin_amdgcn_readfirstlane((unsigned)v), hi = __builtin_amdgcn_readfirstlane((unsigned)(v >> 32)); return (const unsigned char*)(((unsigned long long)hi << 32) | lo); }

struct NoNext { DEV void operator()() const {} };
template <class AO, class BO>
DEV void gemm256_issue0(unsigned char* smem, const void* abase, const AO& aoff, const void* bbase, const BO& boff) {
    const int tid = TID(), lane = tid & 63; const int wid = __builtin_amdgcn_readfirstlane(tid >> 6);
    const unsigned lds0 = (unsigned)(uintptr_t)smem; const unsigned char* ab_ = uptr(abase); const unsigned char* bb_ = uptr(bbase);
#pragma unroll
    for (int i = 0; i < 4; ++i) { const int p = wid + 8 * i; glds16s(ab_, aoff(8 * p + (lane >> 3), (lane & 7) ^ (lane >> 3)), (unsigned)__builtin_amdgcn_readfirstlane(lds0 + p * 1024)); }
#pragma unroll
    for (int i = 0; i < 4; ++i) { const int p = wid + 8 * i; const int k = 2 * p + (lane >> 5); const int f = (k & 3) + 4 * ((k >> 3) & 1);
        glds16s(bb_, boff(k, (lane & 31) ^ (f << 1)), (unsigned)__builtin_amdgcn_readfirstlane(lds0 + 32768 + p * 1024)); }
}
template <bool ZERO, class AO, class BO, class NX = NoNext>
DEV void gemm256(unsigned char* smem, int nkt, const void* abase, unsigned akstep, const AO& aoff, const void* bbase, unsigned bkstep, const BO& boff, f32x4 (&acc)[8][4], bool pre = false, const NX& next = NX()) {
    const int tid = TID(), lane = tid & 63; const int wid = __builtin_amdgcn_readfirstlane(tid >> 6); const int wr = wid >> 2, wc = wid & 3;
    if (ZERO) {
#pragma unroll
        for (int mi = 0; mi < 8; ++mi)
#pragma unroll
            for (int ni = 0; ni < 4; ++ni) acc[mi][ni] = (f32x4){0.f, 0.f, 0.f, 0.f};
    }
    const unsigned lds0 = (unsigned)(uintptr_t)smem;
    const unsigned char* abase_u = uptr(abase); const unsigned char* bbase_u = uptr(bbase); const unsigned akstep_u = __builtin_amdgcn_readfirstlane(akstep), bkstep_u = __builtin_amdgcn_readfirstlane(bkstep);
    unsigned ao[4], bo[4];
#pragma unroll
    for (int i = 0; i < 4; ++i) { const int p = wid + 8 * i; ao[i] = aoff(8 * p + (lane >> 3), (lane & 7) ^ (lane >> 3));
        const int k = 2 * p + (lane >> 5); const int f = (k & 3) + 4 * ((k >> 3) & 1); bo[i] = boff(k, (lane & 31) ^ (f << 1)); }
#define GL_ISSUE(kt, st) do { const unsigned char* ab_ = abase_u + (size_t)(kt) * akstep_u; const unsigned char* bb_ = bbase_u + (size_t)(kt) * bkstep_u; \
        _Pragma("unroll") for (int i_ = 0; i_ < 4; ++i_) glds16s(ab_, ao[i_], (unsigned)__builtin_amdgcn_readfirstlane(lds0 + (st) * GL_STAGE + (wid + 8 * i_) * 1024)); \
        _Pragma("unroll") for (int i_ = 0; i_ < 4; ++i_) glds16s(bb_, bo[i_], (unsigned)__builtin_amdgcn_readfirstlane(lds0 + (st) * GL_STAGE + 32768 + (wid + 8 * i_) * 1024)); } while (0)
    if (!pre) {
        GL_ISSUE(0, 0);
        asm volatile("s_waitcnt vmcnt(0)" ::: "memory");
        __syncthreads();
    }
    for (int kt = 0; kt < nkt; ++kt) {
        if (kt + 1 < nkt) GL_ISSUE(kt + 1, (kt + 1) & 1); else next();
        const unsigned char* A = smem + (kt & 1) * GL_STAGE; const unsigned char* Bt = A + 32768;
#pragma unroll
        for (int ks = 0; ks < 2; ++ks) {
            bf16x8 wf[4];
#pragma unroll
            for (int ni = 0; ni < 4; ++ni) {
                const int i = lane & 15, g = lane >> 4, q = i >> 2; const int row = ks * 32 + 8 * g + q; const int nc = wc * 8 + ni * 2 + ((i & 3) >> 1); const int f = q + 4 * (g & 1);
                const unsigned char* p = Bt + row * 512 + ((nc ^ (f << 1)) << 4) + (i & 1) * 8;
                const s16x4 lo = tr_read(p), hi = tr_read(p + 4 * 512);
                wf[ni] = (bf16x8){lo[0], lo[1], lo[2], lo[3], hi[0], hi[1], hi[2], hi[3]};
            }
#pragma unroll
            for (int mi = 0; mi < 8; ++mi) {
                const int m = wr * 128 + mi * 16 + (lane & 15); const int kc = ks * 4 + (lane >> 4);
                const bf16x8 af = *(const bf16x8*)(A + m * 128 + ((kc ^ (m & 7)) << 4));
#pragma unroll
                for (int ni = 0; ni < 4; ++ni) acc[mi][ni] = __builtin_amdgcn_mfma_f32_16x16x32_bf16(wf[ni], af, acc[mi][ni], 0, 0, 0);
            }
        }
        asm volatile("s_waitcnt vmcnt(0)" ::: "memory");
        __syncthreads();
    }
#undef GL_ISSUE
}

#define EPI_IDS() do { const int etid_ = TID(); lane = etid_ & 63; wid = etid_ >> 6; wr = wid >> 2; wc = wid & 3; } while (0)

DEV void patch_decode(int local, int MT, int NT, int& mt, int& nt) {
    const int per_mtb = 8 * NT; const int mtb = local / per_mtb; const int rem = local - mtb * per_mtb;
    const int rows = (MT - 8 * mtb) < 8 ? (MT - 8 * mtb) : 8;
    const int per_ntb = rows * 8; const int nfull = NT >> 3; int ntb = rem / per_ntb; int cols = 8;
    if (ntb >= nfull) { ntb = nfull; cols = NT - 8 * nfull; }
    const int r2 = rem - ntb * per_ntb;
    mt = 8 * mtb + r2 / cols; nt = 8 * ntb + r2 % cols;
}

DEV void convert_chunk(const float* src, bf16_t* dst, size_t i8) {
    const float4 a = *(const float4*)(src + i8 * 8), b = *(const float4*)(src + i8 * 8 + 4);
    uint4 o; o.x = cvtpk(a.x, a.y); o.y = cvtpk(a.z, a.w); o.z = cvtpk(b.x, b.y); o.w = cvtpk(b.z, b.w);
    *(uint4*)(dst + i8 * 8) = o;
}
DEV void phase_prologue(const Args& a, unsigned char* smem) {
    unsigned char* ws = a.ws;
    const size_t gtid = (size_t)BID() * NTHR + TID(), gn = (size_t)gridDim.x * NTHR;
    {
        { const float* W = a.in[I_WOUT]; bf16_t* O = (bf16_t*)(ws + WS_WOUT); const float* gnn = a.in[I_GNN]; const float* gnf = a.in[I_GNF];
          for (size_t i = gtid; i < (size_t)1024 * 128; i += gn) { const int k = (int)(i >> 7); const float g_ = k < 512 ? gnn[k] : gnf[k - 512];
              const float4 x = *(const float4*)(W + i * 8), y = *(const float4*)(W + i * 8 + 4);
              uint4 o; o.x = cvtpk(x.x * g_, x.y * g_); o.y = cvtpk(x.z * g_, x.w * g_); o.z = cvtpk(y.x * g_, y.y * g_); o.w = cvtpk(y.z * g_, y.w * g_); *(uint4*)(O + i * 8) = o; } }
        const float* srcs[3] = {a.in[I_WGATE], a.in[I_WPLE], a.in[I_P]};
        bf16_t* dsts[3] = {(bf16_t*)(ws + WS_WGATE), (bf16_t*)(ws + WS_WPLE), (bf16_t*)(ws + WS_PB)};
        const size_t cnt8[3] = {1024 * 1024 / 8, 256 * 1024 / 8, (size_t)NTOK * 256 / 8};
#pragma unroll
        for (int s = 0; s < 3; ++s) for (size_t i = gtid; i < cnt8[s]; i += gn) convert_chunk(srcs[s], dsts[s], i);
        for (size_t i = gtid; i < (size_t)2 * 2048 * 32; i += gn) { const int which = (int)(i / (2048 * 32)); const int k = (int)(i / 32) % 2048, c8 = (int)(i % 32) * 8;
            uint4 o = {0u, 0u, 0u, 0u};
            if (c8 < 128) { const float* W = a.in[which ? I_WC1V : I_WC1K] + (size_t)k * 128 + c8; const float4 x = *(const float4*)W, y = *(const float4*)(W + 4); o.x = cvtpk(x.x, x.y); o.y = cvtpk(x.z, x.w); o.z = cvtpk(y.x, y.y); o.w = cvtpk(y.z, y.w); }
            *(uint4*)((bf16_t*)(ws + WS_WC1) + i * 8) = o; }
        for (size_t i = gtid; i < (size_t)2 * 128 * 32; i += gn) { const int which = (int)(i / (128 * 32)); const int k = (int)(i / 32) % 128, c8 = (int)(i % 32) * 8;
            uint4 o = {0u, 0u, 0u, 0u};
            if (c8 < 64) { const float* W = a.in[which ? I_WC2V : I_WC2K] + (size_t)k * 64 + c8; const float4 x = *(const float4*)W, y = *(const float4*)(W + 4); o.x = cvtpk(x.x, x.y); o.y = cvtpk(x.z, x.w); o.z = cvtpk(y.x, y.y); o.w = cvtpk(y.z, y.w); }
            *(uint4*)((bf16_t*)(ws + WS_WC2) + i * 8) = o; }
    }
    {
        const float* W = a.in[I_WIN]; bf16_t* O = (bf16_t*)(ws + WS_WIN);
        for (size_t i = gtid; i < (size_t)1024 * (NWIN / 8); i += gn) {
            const int k = (int)(i / (NWIN / 8)), j = (int)(i % (NWIN / 8)) * 8;
            uint4 o = {0u, 0u, 0u, 0u};
            if (j < 2848) {
                const int sj = (j < 1280) ? j : (j < 2816) ? j + 24 : (j < 2840) ? j - 1536 : j;
                const float4 x = *(const float4*)(W + (size_t)k * 2848 + sj), y = *(const float4*)(W + (size_t)k * 2848 + sj + 4);
                o.x = cvtpk(x.x, x.y); o.y = cvtpk(x.z, x.w); o.z = cvtpk(y.x, y.y); o.w = cvtpk(y.z, y.w);
            }
            *(uint4*)(O + (size_t)k * NWIN + j) = o;
        }
    }
    const int lane = TID() & 63; const int gw = BID() * NWAVE + (TID() >> 6), ngw = gridDim.x * NWAVE;
    {
        const float* X = a.in[I_X]; const float* g = a.in[I_LN1]; bf16_t* XN = (bf16_t*)(ws + WS_XN);
        for (int m = gw; m < NTOK; m += ngw) {
            float4 v[4]; float s = 0.f;
#pragma unroll
            for (int j = 0; j < 4; ++j) { v[j] = *(const float4*)(X + (size_t)m * 1024 + j * 256 + lane * 4); s += v[j].x * v[j].x + v[j].y * v[j].y + v[j].z * v[j].z + v[j].w * v[j].w; }
            const float rstd = rsqrtf(wave_sum(s) * (1.f / 1024.f) + EPS);
#pragma unroll
            for (int j = 0; j < 4; ++j) { const float4 gg = *(const float4*)(g + j * 256 + lane * 4);
                uint2 o; o.x = cvtpk(v[j].x * rstd * gg.x, v[j].y * rstd * gg.y); o.y = cvtpk(v[j].z * rstd * gg.z, v[j].w * rstd * gg.w);
                *(uint2*)(XN + (size_t)m * 1024 + j * 256 + lane * 4) = o; }
        }
    }
    if (gw < 256) {
        const int which = gw >> 7, n = gw & 127; const float* pe = a.in[which ? I_PEV : I_PEK]; const float* w1 = a.in[which ? I_WC1V : I_WC1K];
        float s = 0.f;
#pragma unroll 8
        for (int i = 0; i < 32; ++i) { const int k = lane + 64 * i; s += pe[k] * w1[(size_t)k * 128 + n]; }
        s = wave_sum(s);
        if (lane == 0) ((float*)(ws + WS_BIAS1))[which * 128 + n] = s;
    }
}

DEV void phase_inproj(const Args& a, unsigned char* smem) {
    const bf16_t* XN = (const bf16_t*)(a.ws + WS_XN); const bf16_t* W = (const bf16_t*)(a.ws + WS_WIN);
    bf16_t* PROJ = (bf16_t*)(a.ws + WS_PROJ); float* GN = (float*)(a.ws + WS_GN); float* LS = (float*)(a.ws + WS_LS); const float* bfg = a.in[I_BFG];
    int lane = TID() & 63, wid = TID() >> 6, wr = wid >> 2, wc = wid & 3; (void)wr; (void)wc; (void)lane;
    bool pre = false;
    for (int item = VBID(); item < 64 * 12; item += gridDim.x) {
        int mt, nt; patch_decode(item, 64, 12, mt, nt);
        const int nitem = item + (int)gridDim.x; const bool has_next = nitem < 64 * 12; int mtn = 0, ntn = 0; if (has_next) patch_decode(nitem, 64, 12, mtn, ntn);
        f32x4 acc[8][4];
        gemm256<true>(smem, 16, XN + (size_t)mt * 256 * 1024, 128u, [&](int r, int kc) { return (unsigned)(r * 2048 + kc * 16); },
                      W + nt * 256, (unsigned)(64 * NWIN * 2), [&](int k, int nc) { return (unsigned)(k * (NWIN * 2) + nc * 16); }, acc, pre,
                      [&]() { if (has_next) gemm256_issue0(smem, XN + (size_t)mtn * 256 * 1024, [&](int r, int kc) { return (unsigned)(r * 2048 + kc * 16); }, W + ntn * 256, [&](int k, int nc) { return (unsigned)(k * (NWIN * 2) + nc * 16); }); });
        pre = has_next;
        EPI_IDS();
#pragma unroll
        for (int mi = 0; mi < 8; ++mi) {
            const int gm = mt * 256 + wr * 128 + mi * 16 + (lane & 15); const int b = gm >> 13, t = gm & 8191;
#pragma unroll
            for (int ni = 0; ni < 4; ++ni) {
                const int n = wc * 64 + ni * 16 + 4 * (lane >> 4); const f32x4 v = acc[mi][ni];
                if (nt < 11) {
                    const int hs = nt * 4 + wc, d = n & 63; const float sc = (hs < 8 || (hs >= 20 && hs < 28)) ? QS : 1.0f;
                    uint2 o; o.x = cvtpk(v[0] * sc, v[1] * sc); o.y = cvtpk(v[2] * sc, v[3] * sc);
                    *(uint2*)(PROJ + (((size_t)(hs * 2 + b)) * 8192 + t) * 64 + d) = o;
                } else if (n < 24) {
#pragma unroll
                    for (int r = 0; r < 4; ++r) GN[(size_t)gm * 24 + n + r] = sigmoidf_(v[r]);
                } else if (n < 32) {
#pragma unroll
                    for (int r = 0; r < 4; ++r) { const int h = n - 24 + r; LS[((size_t)(b * 8 + h)) * 8192 + t] = logsigmoidf_(v[r] + bfg[h]); }
                }
            }
        }
    }
}

DEV void signal_done(unsigned* flag) {
    asm volatile("s_waitcnt vmcnt(0)" ::: "memory");
    __syncthreads();
    if (TID() == 0) { __builtin_amdgcn_fence(__ATOMIC_RELEASE, "agent"); asm volatile("s_waitcnt vmcnt(0)" ::: "memory"); __hip_atomic_fetch_add(flag, 1u, __ATOMIC_RELAXED, __HIP_MEMORY_SCOPE_AGENT); }
}
DEV void wait_flag(unsigned* flag, unsigned target) {
    if (TID() == 0) { unsigned sp = 0u; while (__hip_atomic_load(flag, __ATOMIC_RELAXED, __HIP_MEMORY_SCOPE_AGENT) < target) { __builtin_amdgcn_s_sleep(4); if (++sp > (1u << 24)) break; }
        __builtin_amdgcn_fence(__ATOMIC_ACQUIRE, "agent"); asm volatile("s_waitcnt vmcnt(0)" ::: "memory"); }
    __syncthreads();
}
constexpr int CW_CUMFLAG = 128, CW_CMPFLAG = 192, CW_GATEFLAG = 256;
DEV void cmp_item(const Args& a, unsigned char* smem, int item) {
    const bf16_t* PROJ = (const bf16_t*)(a.ws + WS_PROJ);
    const int tid = TID(); int lane = tid & 63, wid = tid >> 6, wr = wid >> 2, wc = wid & 3; (void)wr; (void)wc; (void)lane;
    {
        if (item < 16) {
            const int which = item >> 3, b = (item >> 2) & 1, g = (item >> 1) & 1, mt = item & 1;
            const bf16_t* base = PROJ + ((size_t)((8 + 2 * which + g) * 2 + b)) * 8192 * 64;
            const bf16_t* W1 = (const bf16_t*)(a.ws + WS_WC1) + (size_t)which * 2048 * 256;
            const bf16_t* W2 = (const bf16_t*)(a.ws + WS_WC2) + (size_t)which * 128 * 256;
            const float* bias1 = (const float*)(a.ws + WS_BIAS1) + which * 128;
            bf16_t* HID = (bf16_t*)(a.ws + WS_HID) + ((size_t)(which * 4 + b * 2 + g)) * 512 * 128;
            bf16_t* OUT = (bf16_t*)(a.ws + WS_KC) + ((size_t)(which * 4 + b * 2 + g)) * 512 * 64;
            f32x4 acc[8][4];
            gemm256<true>(smem, 32, base, 128u, [&](int r, int kc) { int c = mt * 256 + r; c = c > 510 ? 510 : c; return (unsigned)(c * 2048 + kc * 16); },
                          W1, 64u * 512u, [&](int k, int nc) { return (unsigned)(k * 512 + nc * 16); }, acc);
        EPI_IDS();
            if (wc < 2) {
#pragma unroll
                for (int mi = 0; mi < 8; ++mi) { const int c = mt * 256 + wr * 128 + mi * 16 + (lane & 15);
#pragma unroll
                    for (int ni = 0; ni < 4; ++ni) { const int n = wc * 64 + ni * 16 + 4 * (lane >> 4); const f32x4 v = acc[mi][ni]; const float4 bb = *(const float4*)(bias1 + n);
                        uint2 o; o.x = cvtpk(gelu_tanh(v[0] + bb.x), gelu_tanh(v[1] + bb.y)); o.y = cvtpk(gelu_tanh(v[2] + bb.z), gelu_tanh(v[3] + bb.w));
                        *(uint2*)(HID + (size_t)c * 128 + n) = o; } }
            }
            __syncthreads();
            gemm256<true>(smem, 2, HID + (size_t)mt * 256 * 128, 128u, [&](int r, int kc) { return (unsigned)(r * 256 + kc * 16); },
                          W2, 64u * 512u, [&](int k, int nc) { return (unsigned)(k * 512 + nc * 16); }, acc);
        EPI_IDS();
            if (wc == 0) {
#pragma unroll
                for (int mi = 0; mi < 8; ++mi) { const int c = mt * 256 + wr * 128 + mi * 16 + (lane & 15);
#pragma unroll
                    for (int ni = 0; ni < 4; ++ni) { const int n = ni * 16 + 4 * (lane >> 4); const f32x4 v = acc[mi][ni];
                        uint2 o; o.x = cvtpk(v[0], v[1]); o.y = cvtpk(v[2], v[3]);
                        if (c >= 511) { o.x = 0u; o.y = 0u; }
                        *(uint2*)(OUT + (size_t)c * 64 + n) = o; } }
            }
            signal_done((unsigned*)(a.ws + WS_CTL) + CW_CMPFLAG);
        } else {
            const int bh = item - 16; const float* LS = (const float*)(a.ws + WS_LS) + (size_t)bh * 8192; float* CUM = (float*)(a.ws + WS_CUM) + (size_t)bh * 8192;
            float* sc = (float*)smem;
            float v[16]; float s = 0.f;
#pragma unroll
            for (int j = 0; j < 4; ++j) { const float4 x = *(const float4*)(LS + tid * 16 + j * 4); v[4 * j] = x.x; v[4 * j + 1] = x.y; v[4 * j + 2] = x.z; v[4 * j + 3] = x.w; }
#pragma unroll
            for (int j = 0; j < 16; ++j) { s += v[j]; v[j] = s; }
            sc[tid] = s; __syncthreads();
            if (tid == 0) { float run = 0.f; for (int i = 0; i < NTHR; ++i) { const float x = sc[i]; sc[i] = run; run += x; } }
            __syncthreads();
            const float off = sc[tid];
#pragma unroll
            for (int j = 0; j < 4; ++j) { float4 o = {v[4 * j] + off, v[4 * j + 1] + off, v[4 * j + 2] + off, v[4 * j + 3] + off}; *(float4*)(CUM + tid * 16 + j * 4) = o; }
            signal_done((unsigned*)(a.ws + WS_CTL) + CW_CUMFLAG + bh);
        }
    }
}

constexpr int AT_STAGE = 16384;
constexpr int AT_BIAS_OFF = 3 * AT_STAGE;
constexpr int AT_IMP_OFF = AT_BIAS_OFF + 1024;
constexpr int AT_SEL_OFF = AT_IMP_OFF + 65536;
constexpr int AT_WUN_OFF = AT_SEL_OFF + 1024;
constexpr int AT_UCNT_OFF = AT_WUN_OFF + 128;
constexpr int AT_ULIST_OFF = AT_UCNT_OFF + 16;
constexpr int AT_ITEM_OFF = AT_ULIST_OFF + 128;
static_assert(AT_ITEM_OFF + 16 <= GEMM_LDS, "attention LDS map");
#define NEG_INF (-__builtin_inff())

#define KV_DECL uint4 rk0_, rv0_
#define KV_GLOAD(Kt, Vt) do { rk0_ = *(const uint4*)((Kt) + tid * 8); rv0_ = *(const uint4*)((Vt) + tid * 8); } while (0)
#define KV_LSTORE(stp) do { unsigned char* st_ = (stp); const int key = tid >> 3, ch = tid & 7; \
      *(uint4*)(st_ + key * 128 + ((ch ^ (key & 7)) << 4)) = rk0_; \
      *(uint4*)(st_ + 8192 + key * 128 + ((((ch >> 2) ^ ((key >> 1) & 1))) << 6) + ((ch & 3) << 4)) = rv0_; } while (0)
template <bool FULL>
DEV void qk_tile(const unsigned char* Kst, const bf16x8 (&qf)[4], f32x16& p0, f32x16& p1, int lane) {
    const int key = lane & 31, hi = lane >> 5;
    if (FULL) {
        bf16x8 k0[4], k1[4];
#pragma unroll
        for (int ks = 0; ks < 4; ++ks) { const int ch = 2 * ks + hi; const int off = key * 128 + ((ch ^ (key & 7)) << 4);
            k0[ks] = *(const bf16x8*)(Kst + off); k1[ks] = *(const bf16x8*)(Kst + off + 32 * 128); }
        __builtin_amdgcn_sched_barrier(0);
#pragma unroll
        for (int ks = 0; ks < 4; ++ks) {
            p0 = __builtin_amdgcn_mfma_f32_32x32x16_bf16(k0[ks], qf[ks], p0, 0, 0, 0);
            p1 = __builtin_amdgcn_mfma_f32_32x32x16_bf16(k1[ks], qf[ks], p1, 0, 0, 0); }
    } else {
        bf16x8 kk[4];
#pragma unroll
        for (int ks = 0; ks < 4; ++ks) { const int ch = 2 * ks + hi; kk[ks] = *(const bf16x8*)(Kst + key * 128 + ((ch ^ (key & 7)) << 4)); }
        __builtin_amdgcn_sched_barrier(0);
#pragma unroll
        for (int ks = 0; ks < 4; ++ks) p0 = __builtin_amdgcn_mfma_f32_32x32x16_bf16(kk[ks], qf[ks], p0, 0, 0, 0);
        __builtin_amdgcn_sched_barrier(0);
#pragma unroll
        for (int ks = 0; ks < 4; ++ks) { const int ch = 2 * ks + hi; kk[ks] = *(const bf16x8*)(Kst + key * 128 + ((ch ^ (key & 7)) << 4) + 32 * 128); }
        __builtin_amdgcn_sched_barrier(0);
#pragma unroll
        for (int ks = 0; ks < 4; ++ks) p1 = __builtin_amdgcn_mfma_f32_32x32x16_bf16(kk[ks], qf[ks], p1, 0, 0, 0);
    }
}
template <bool FULL>
DEV void pv_tile(const unsigned char* Vst, const f32x16& p0, const f32x16& p1, f32x16 (&o)[2], int lane) {
    const int hi = lane >> 5, i = lane & 15, gg = (lane >> 4) & 1;
    const int q = i >> 2; const int sw = (q >> 1) & 1;
    bf16x8 pa[4];
#pragma unroll
    for (int s = 0; s < 4; ++s) { const f32x16& p = (s < 2) ? p0 : p1; const int b = (s & 1) * 8;
        unsigned w[4];
#pragma unroll
        for (int j = 0; j < 4; ++j) w[j] = cvtpk(p[b + 2 * j], p[b + 2 * j + 1]);
        typedef unsigned u32x4_t __attribute__((ext_vector_type(4)));
        u32x4_t ww = {w[0], w[1], w[2], w[3]}; pa[s] = __builtin_bit_cast(bf16x8, ww); }
    constexpr int NB = FULL ? 1 : 2, SB = FULL ? 4 : 2;
#pragma unroll
    for (int bt = 0; bt < NB; ++bt) {
        s16x4 vlo[SB][2], vhi[SB][2];
#pragma unroll
        for (int s_ = 0; s_ < SB; ++s_)
#pragma unroll
            for (int dh = 0; dh < 2; ++dh) { const int s = bt * SB + s_; const int row0 = 16 * s + 4 * hi + q;
                const unsigned char* p = Vst + row0 * 128 + ((dh ^ sw) << 6) + gg * 32 + (i & 3) * 8;
                vlo[s_][dh] = tr_read(p); vhi[s_][dh] = tr_read(p + 8 * 128); }
        __builtin_amdgcn_sched_barrier(0);
#pragma unroll
        for (int s_ = 0; s_ < SB; ++s_)
#pragma unroll
            for (int dh = 0; dh < 2; ++dh) { const int s = bt * SB + s_;
                const bf16x8 vf = {vlo[s_][dh][0], vlo[s_][dh][1], vlo[s_][dh][2], vlo[s_][dh][3], vhi[s_][dh][0], vhi[s_][dh][1], vhi[s_][dh][2], vhi[s_][dh][3]};
                o[dh] = __builtin_amdgcn_mfma_f32_32x32x16_bf16(vf, pa[s], o[dh], 0, 0, 0); }
        __builtin_amdgcn_sched_barrier(0);
    }
}
DEV float rowmax32(const f32x16& p0, const f32x16& p1) {
    float a = fmaxf(p0[0], p1[0]), b = fmaxf(p0[1], p1[1]);
#pragma unroll
    for (int r = 2; r < 16; r += 2) { a = fmaxf(fmaxf(a, p0[r]), p1[r]); b = fmaxf(fmaxf(b, p0[r + 1]), p1[r + 1]); }
    return pair_max(fmaxf(a, b));
}
DEV void softmax_step(f32x16& p0, f32x16& p1, float& m, float& l, f32x16 (&o)[2]) {
    const float mt = rowmax32(p0, p1); const float mn = fmaxf(m, mt); const float alpha = __builtin_amdgcn_exp2f(m - mn);
    float rs = 0.f;
#pragma unroll
    for (int r = 0; r < 16; ++r) { p0[r] = __builtin_amdgcn_exp2f(p0[r] - mn); p1[r] = __builtin_amdgcn_exp2f(p1[r] - mn); rs += p0[r] + p1[r]; }
    rs = pair_sum(rs);
    l = l * alpha + rs; m = mn;
    if (__any(alpha != 1.0f)) { o[0] *= alpha; o[1] *= alpha; }
}
DEV void softmax_step_nosum(f32x16& p0, f32x16& p1, float& m, f32x16 (&o)[2], f32x16& lacc) {
    const float mt = rowmax32(p0, p1); const float mn = fmaxf(m, mt); const float alpha = __builtin_amdgcn_exp2f(m - mn);
#pragma unroll
    for (int r = 0; r < 16; ++r) { p0[r] = __builtin_amdgcn_exp2f(p0[r] - mn); p1[r] = __builtin_amdgcn_exp2f(p1[r] - mn); }
    m = mn;
    if (__any(alpha != 1.0f)) { o[0] *= alpha; o[1] *= alpha; lacc *= alpha; }
}
DEV void pv_tile_sum(const unsigned char* Vst, const f32x16& p0, const f32x16& p1, f32x16 (&o)[2], f32x16& lacc, int lane) {
    const int hi = lane >> 5, i = lane & 15, gg = (lane >> 4) & 1;
    const int q = i >> 2; const int sw = (q >> 1) & 1;
    bf16x8 pa[4];
#pragma unroll
    for (int s = 0; s < 4; ++s) { const f32x16& p = (s < 2) ? p0 : p1; const int b = (s & 1) * 8;
        unsigned w[4];
#pragma unroll
        for (int j = 0; j < 4; ++j) w[j] = cvtpk(p[b + 2 * j], p[b + 2 * j + 1]);
        typedef unsigned u32x4_t __attribute__((ext_vector_type(4)));
        u32x4_t ww = {w[0], w[1], w[2], w[3]}; pa[s] = __builtin_bit_cast(bf16x8, ww); }
    const bf16x8 ones = {0x3f80, 0x3f80, 0x3f80, 0x3f80, 0x3f80, 0x3f80, 0x3f80, 0x3f80};
#pragma unroll
    for (int bt = 0; bt < 2; ++bt) {
        s16x4 vlo[2][2], vhi[2][2];
#pragma unroll
        for (int s_ = 0; s_ < 2; ++s_)
#pragma unroll
            for (int dh = 0; dh < 2; ++dh) { const int s = bt * 2 + s_; const int row0 = 16 * s + 4 * hi + q;
                const unsigned char* p = Vst + row0 * 128 + ((dh ^ sw) << 6) + gg * 32 + (i & 3) * 8;
                vlo[s_][dh] = tr_read(p); vhi[s_][dh] = tr_read(p + 8 * 128); }
        __builtin_amdgcn_sched_barrier(0);
#pragma unroll
        for (int s_ = 0; s_ < 2; ++s_) { const int s = bt * 2 + s_;
            lacc = __builtin_amdgcn_mfma_f32_32x32x16_bf16(ones, pa[s], lacc, 0, 0, 0);
#pragma unroll
            for (int dh = 0; dh < 2; ++dh) {
                const bf16x8 vf = {vlo[s_][dh][0], vlo[s_][dh][1], vlo[s_][dh][2], vlo[s_][dh][3], vhi[s_][dh][0], vhi[s_][dh][1], vhi[s_][dh][2], vhi[s_][dh][3]};
                o[dh] = __builtin_amdgcn_mfma_f32_32x32x16_bf16(vf, pa[s], o[dh], 0, 0, 0); } }
        __builtin_amdgcn_sched_barrier(0);
    }
}
template <int STRIDE> DEV void mask_tile(f32x16& p0, f32x16& p1, int kpos0, int lo, int hi_lim, int hi) {
#pragma unroll
    for (int r = 0; r < 16; ++r) { const int kp = kpos0 + STRIDE * crow(r, hi);
        if (kp < lo || kp > hi_lim) p0[r] = NEG_INF;
        const int kp1 = kp + 32 * STRIDE; if (kp1 < lo || kp1 > hi_lim) p1[r] = NEG_INF; }
}
template <int STRIDE> DEV void alibi_init(f32x16& p0, f32x16& p1, float slope2, int kpos0, int tref, int hi) {
    const float base = slope2 * (float)(kpos0 - tref + STRIDE * 4 * hi);
#pragma unroll
    for (int r = 0; r < 16; ++r) { const float c = (float)(STRIDE * ((r & 3) + 8 * (r >> 2))); p0[r] = fmaf(slope2, c, base); p1[r] = fmaf(slope2, c + (float)(32 * STRIDE), base); }
}
template <class Src, class Body, class NSrc>
DEV int kv_pipeline(unsigned char* smem, int n, const Src& src, const Body& body, int par, bool pre, bool has_next, const NSrc& nsrc) {
    KV_DECL; const int tid = TID(); const bf16_t *kp, *vp;
    if (!pre) { src(0, kp, vp); KV_GLOAD(kp, vp); KV_LSTORE(smem + par * AT_STAGE); __syncthreads(); }
    for (int j = 0; j < n; ++j) {
        const bool more = j + 1 < n; const bool ld = more || has_next;
        if (more) { src(j + 1, kp, vp); KV_GLOAD(kp, vp); } else if (has_next) { nsrc(kp, vp); KV_GLOAD(kp, vp); }
        body(j, smem + ((par + j) & 1) * AT_STAGE);
        if (ld) KV_LSTORE(smem + ((par + j + 1) & 1) * AT_STAGE);
        __syncthreads();
    }
    return (par + n) & 1;
}
struct NoSrc { DEV void operator()(const bf16_t*&, const bf16_t*&) const {} };

constexpr int CV_PER_STEP = 373; constexpr int CV_NUP = 32 * 1024 * 2048 / 8, CV_NDN = 32 * 1024 * 1024 / 8;
static_assert((long long)33792 * CV_PER_STEP >= (long long)CV_NUP + CV_NDN, "conversion coverage");
DEV void fox_item(const Args& a, unsigned char* smem, int fi, int b, int h, int qb) {
    const int tid = TID(), lane = tid & 63, wid = tid >> 6, r32 = lane & 31, hi = lane >> 5;
    const bf16_t* PROJ = (const bf16_t*)(a.ws + WS_PROJ);
    const bf16_t* Q = PROJ + ((size_t)((20 + h) * 2 + b)) * 8192 * 64; const bf16_t* K = PROJ + ((size_t)((28 + h) * 2 + b)) * 8192 * 64; const bf16_t* V = PROJ + ((size_t)((36 + h) * 2 + b)) * 8192 * 64;
    const float* CUM = (const float*)(a.ws + WS_CUM) + (size_t)(b * 8 + h) * 8192;
    const int q0 = qb * 256; const int qrow = q0 + 32 * wid + r32;
    bf16x8 qf[4];
#pragma unroll
    for (int ks = 0; ks < 4; ++ks) qf[ks] = *(const bf16x8*)(Q + (size_t)qrow * 64 + 16 * ks + 8 * hi);
    const float cref = CUM[q0];
    const int ntiles = 4 * qb + 4; const int jmax_w = (q0 + 32 * wid + 31) >> 6; const int jmask_w = (q0 + 32 * wid) >> 6;
    f32x16 o[2]; o[0] = (f32x16){}; o[1] = (f32x16){}; f32x16 lacc = (f32x16){}; float m = -1e30f;
    float* biasL = (float*)(smem + AT_BIAS_OFF);
    const int gq_ = fi >> 4; const int sidx0 = 16 * (128 * gq_ - 2 * gq_ * (gq_ - 1)) + (fi & 15) * (128 - 4 * gq_);
    bf16_t* cvdA = nullptr; bf16_t* cvdB = nullptr; float4 cvaA, cvbA, cvaB, cvbB;
    KV_DECL; float breg = 0.f;
#define TJ(s_) (ntiles - 1 - (s_))
    KV_GLOAD(K + (size_t)TJ(0) * 4096, V + (size_t)TJ(0) * 4096); if (tid < 64) breg = (cref - CUM[TJ(0) * 64 + tid]) * LOG2E;
    KV_LSTORE(smem); if (tid < 64) biasL[tid] = breg;
    KV_GLOAD(K + (size_t)TJ(1) * 4096, V + (size_t)TJ(1) * 4096); if (tid < 64) breg = (cref - CUM[TJ(1) * 64 + tid]) * LOG2E;
    KV_LSTORE(smem + AT_STAGE); if (tid < 64) biasL[64 + tid] = breg;
    __syncthreads();
#define FOX_QK(P0, P1, jj, sj) do { const float* bl_ = biasL + (sj) * 64; \
        _Pragma("unroll") for (int g4 = 0; g4 < 4; ++g4) { const float4 x_ = *(const float4*)(bl_ + 8 * g4 + 4 * hi), y_ = *(const float4*)(bl_ + 32 + 8 * g4 + 4 * hi); \
            P0[4 * g4] = x_.x; P0[4 * g4 + 1] = x_.y; P0[4 * g4 + 2] = x_.z; P0[4 * g4 + 3] = x_.w; P1[4 * g4] = y_.x; P1[4 * g4 + 1] = y_.y; P1[4 * g4 + 2] = y_.z; P1[4 * g4 + 3] = y_.w; } \
        qk_tile<true>(smem + (sj) * AT_STAGE, qf, P0, P1, lane); \
        if ((jj) >= jmask_w) mask_tile<1>(P0, P1, 64 * (jj), -1, qrow, hi); } while (0)
#define FOX_STEP(CUR0, CUR1, NXT0, NXT1, j, CVD_LD, CVA_LD, CVB_LD, CVD_ST, CVA_ST, CVB_ST) do { \
        const int s_cur = (j) % 3, s_nxt = ((j) + 1) % 3, s_ld = ((j) + 2) % 3; const bool more_ = (j) + 2 < ntiles; \
        if (more_) { KV_GLOAD(K + (size_t)TJ((j) + 2) * 4096, V + (size_t)TJ((j) + 2) * 4096); if (tid < 64) breg = (cref - CUM[TJ((j) + 2) * 64 + tid]) * LOG2E; } \
        { const int c_ = (sidx0 + (j)) * CV_PER_STEP + tid; CVD_LD = nullptr; \
          if (tid < CV_PER_STEP && c_ < CV_NUP + CV_NDN) { const float* cvs_; if (c_ < CV_NUP) { cvs_ = a.in[I_WUP] + (size_t)c_ * 8; CVD_LD = (bf16_t*)(a.ws + WS_WUP) + (size_t)c_ * 8; } else { cvs_ = a.in[I_WDN] + (size_t)(c_ - CV_NUP) * 8; CVD_LD = (bf16_t*)(a.ws + WS_WDN) + (size_t)(c_ - CV_NUP) * 8; } \
              CVA_LD = *(const float4*)cvs_; CVB_LD = *(const float4*)(cvs_ + 4); } } \
        if ((j) + 1 < ntiles && TJ((j) + 1) <= jmax_w) FOX_QK(NXT0, NXT1, TJ((j) + 1), s_nxt); \
        __builtin_amdgcn_sched_barrier(0); \
        if (TJ(j) <= jmax_w) { softmax_step_nosum(CUR0, CUR1, m, o, lacc); pv_tile_sum(smem + s_cur * AT_STAGE + 8192, CUR0, CUR1, o, lacc, lane); } \
        if (more_) { KV_LSTORE(smem + s_ld * AT_STAGE); if (tid < 64) biasL[s_ld * 64 + tid] = breg; } \
        if (CVD_ST) { uint4 o_; o_.x = cvtpk(CVA_ST.x, CVA_ST.y); o_.y = cvtpk(CVA_ST.z, CVA_ST.w); o_.z = cvtpk(CVB_ST.x, CVB_ST.y); o_.w = cvtpk(CVB_ST.z, CVB_ST.w); *(uint4*)CVD_ST = o_; CVD_ST = nullptr; } \
        __syncthreads(); } while (0)
    f32x16 pA0, pA1, pB0, pB1;
    if (TJ(0) <= jmax_w) FOX_QK(pA0, pA1, TJ(0), 0);
    for (int j = 0; j < ntiles; j += 2) {
        FOX_STEP(pA0, pA1, pB0, pB1, j, cvdA, cvaA, cvbA, cvdB, cvaB, cvbB);
        FOX_STEP(pB0, pB1, pA0, pA1, j + 1, cvdB, cvaB, cvbB, cvdA, cvaA, cvbA);
    }
    if (cvdB) { uint4 o_; o_.x = cvtpk(cvaB.x, cvaB.y); o_.y = cvtpk(cvaB.z, cvaB.w); o_.z = cvtpk(cvbB.x, cvbB.y); o_.w = cvtpk(cvbB.z, cvbB.w); *(uint4*)cvdB = o_; }
#undef FOX_QK
#undef FOX_STEP
#undef TJ
    const float inv = 1.0f / lacc[0]; float ss = 0.f;
    const size_t token = (size_t)b * 8192 + qrow;
    bf16_t* O = (bf16_t*)(a.ws + WS_OFOX) + token * 512 + h * 64;
#pragma unroll
    for (int dh = 0; dh < 2; ++dh)
#pragma unroll
        for (int g4 = 0; g4 < 4; ++g4) { const float v0 = o[dh][4 * g4] * inv, v1 = o[dh][4 * g4 + 1] * inv, v2 = o[dh][4 * g4 + 2] * inv, v3 = o[dh][4 * g4 + 3] * inv;
            ss += v0 * v0 + v1 * v1 + v2 * v2 + v3 * v3; uint2 w; w.x = cvtpk(v0, v1); w.y = cvtpk(v2, v3); *(uint2*)(O + 32 * dh + 8 * g4 + 4 * hi) = w; }
    ss = pair_sum(ss);
    if (hi == 0) ((float*)(a.ws + WS_SSQ))[token * 16 + 8 + h] = ss;
}

DEV void nsa_item(const Args& a, unsigned char* smem, int b, int g, int tt) {
    const int tid = TID(), lane = tid & 63, wid = tid >> 6, col = lane & 31, hi = lane >> 5;
    const int t0 = tt * 64, tokw = col >> 2, r = col & 3, h = 4 * g + r; const int tokl = wid * 8 + tokw; const int t = t0 + tokl; const size_t token = (size_t)b * 8192 + t;
    const float slope2 = exp2f(-(float)(h + 1)) * LOG2E;
    const bf16_t* PROJ = (const bf16_t*)(a.ws + WS_PROJ);
    const float* GN = (const float*)(a.ws + WS_GN) + token * 24 + h * 3;
    const int cur = tt; const bool need_topk = cur > 15;
    bf16x8 qf[4];
    { const bf16_t* Q = PROJ + (((size_t)(h * 2 + b)) * 8192 + t) * 64;
#pragma unroll
      for (int ks = 0; ks < 4; ++ks) qf[ks] = *(const bf16x8*)(Q + 16 * ks + 8 * hi); }
    float* impw = (float*)(smem + AT_IMP_OFF) + wid * 2048; float* totw = impw + lane;
    unsigned* selmask = (unsigned*)(smem + AT_SEL_OFF); unsigned* wun = (unsigned*)(smem + AT_WUN_OFF); int* ucnt = (int*)(smem + AT_UCNT_OFF); unsigned char* ulist = smem + AT_ULIST_OFF;
    f32x16 o[2]; float m, l; int par = 0;
    const int tmin_w = t0 + wid * 8, tmax_w = tmin_w + 7;
    {
        const bf16_t* KC = (const bf16_t*)(a.ws + WS_KC) + ((size_t)(0 * 4 + b * 2 + g)) * 512 * 64; const bf16_t* VC = (const bf16_t*)(a.ws + WS_KC) + ((size_t)(1 * 4 + b * 2 + g)) * 512 * 64;
        const int ncv = t0 / 16 + 3; const int nct = (ncv + 63) >> 6;
        auto src = [&](int j, const bf16_t*& kp, const bf16_t*& vp) { kp = KC + (size_t)j * 4096; vp = VC + (size_t)j * 4096; };
        m = -1e30f; l = 0.f;
        auto src0 = [&](const bf16_t*& kp, const bf16_t*& vp) { kp = KC; vp = VC; };
        par = kv_pipeline(smem, nct, src, [&](int j, const unsigned char* st) {
            const int kpos0 = 1024 * j + 31;
            if (kpos0 > tmax_w) return;
            f32x16 p0, p1; alibi_init<16>(p0, p1, slope2, kpos0, t0, hi);
            qk_tile<false>(st, qf, p0, p1, lane);
            if (kpos0 + 16 * 63 > tmin_w) mask_tile<16>(p0, p1, kpos0, -1, t, hi);
            const float mt = rowmax32(p0, p1); const float mn = fmaxf(m, mt); float rs = 0.f;
#pragma unroll
            for (int rr = 0; rr < 16; ++rr) rs += __builtin_amdgcn_exp2f(p0[rr] - mn) + __builtin_amdgcn_exp2f(p1[rr] - mn);
            rs = pair_sum(rs);
            l = l * __builtin_amdgcn_exp2f(m - mn) + rs; m = mn;
        }, 0, false, true, src0);
        const float linv = l > 0.f ? 1.0f / l : 0.f;
        if (need_topk) { for (int i = lane; i < 8 * 129; i += 64) impw[i] = 0.f; }
        o[0] = (f32x16){}; o[1] = (f32x16){};
        const bf16_t* KS0 = PROJ + ((size_t)((12 + g) * 2 + b)) * 8192 * 64 + (size_t)cur * 4096; const bf16_t* VS0 = PROJ + ((size_t)((14 + g) * 2 + b)) * 8192 * 64 + (size_t)cur * 4096;
        par = kv_pipeline(smem, nct, src, [&](int j, const unsigned char* st) {
            const int kpos0 = 1024 * j + 31;
            if (kpos0 > tmax_w) return;
            f32x16 p0, p1; alibi_init<16>(p0, p1, slope2, kpos0, t0, hi);
            qk_tile<false>(st, qf, p0, p1, lane);
            if (kpos0 + 16 * 63 > tmin_w) mask_tile<16>(p0, p1, kpos0, -1, t, hi);
#pragma unroll
            for (int rr = 0; rr < 16; ++rr) { p0[rr] = __builtin_amdgcn_exp2f(p0[rr] - m) * linv; p1[rr] = __builtin_amdgcn_exp2f(p1[rr] - m) * linv; }
            if (need_topk) {
#pragma unroll
                for (int half = 0; half < 2; ++half)
#pragma unroll
                    for (int g4 = 0; g4 < 4; ++g4) { const f32x16& p = half ? p1 : p0;
                        float ms = (p[4 * g4] + p[4 * g4 + 1]) + (p[4 * g4 + 2] + p[4 * g4 + 3]); float ls = p[4 * g4 + 3];
                        ms = quad_sum(ms); ls = quad_sum(ls);
                        const int n = 16 * j + 8 * half + 2 * g4 + hi;
                        if (r == 0) { atomicAdd(&impw[tokw * 129 + n], ms); atomicAdd(&impw[tokw * 129 + n + 1], ls); } }
            }
            pv_tile<false>(st + 8192, p0, p1, o, lane);
        }, par, true, true, [&](const bf16_t*& kp, const bf16_t*& vp) { kp = KS0; vp = VS0; });
    }
    {
        unsigned un0 = 0u, un1 = 0u, un2 = 0u, un3 = 0u;
        if (need_topk) {
#define TK_INIT(V0, V1, M0, M1, M2, M3, tk_) float V0 = impw[(tk_) * 129 + lane], V1 = impw[(tk_) * 129 + 64 + lane]; \
                V0 = (lane >= 1 && lane <= cur - 2) ? V0 : -1.0f; V1 = (lane + 64 <= cur - 2) ? V1 : -1.0f; unsigned M0 = 1u, M1 = 0u, M2 = 0u, M3 = 0u; \
                TK_SET(M0, M1, M2, M3, cur); TK_SET(M0, M1, M2, M3, cur - 1)
#define TK_SET(M0, M1, M2, M3, n_) do { const int n__ = (n_); const unsigned bit__ = 1u << (n__ & 31); const int w__ = n__ >> 5; M0 |= (w__ == 0) ? bit__ : 0u; M1 |= (w__ == 1) ? bit__ : 0u; M2 |= (w__ == 2) ? bit__ : 0u; M3 |= (w__ == 3) ? bit__ : 0u; } while (0)
#define TK_STEP(V0, V1, M0, M1, M2, M3) do { const float mx_ = wave_max_u(fmaxf(V0, V1)); const unsigned long long b0_ = __ballot(V0 == mx_), b1_ = __ballot(V1 == mx_); \
                const int n_ = b0_ ? (__ffsll((long long)b0_) - 1) : (63 + __ffsll((long long)b1_)); const bool hit_ = lane == (n_ & 63); \
                V0 = (hit_ && n_ < 64) ? -1.0f : V0; V1 = (hit_ && n_ >= 64) ? -1.0f : V1; TK_SET(M0, M1, M2, M3, n_); } while (0)
            for (int tk = 0; tk < 8; tk += 4) {
                TK_INIT(a0_, a1_, ma0, ma1, ma2, ma3, tk); TK_INIT(b0v, b1v, mb0, mb1, mb2, mb3, tk + 1); TK_INIT(c0v, c1v, mc0, mc1, mc2, mc3, tk + 2); TK_INIT(d0v, d1v, md0, md1, md2, md3, tk + 3);
                for (int it = 0; it < 13; ++it) { TK_STEP(a0_, a1_, ma0, ma1, ma2, ma3); TK_STEP(b0v, b1v, mb0, mb1, mb2, mb3); TK_STEP(c0v, c1v, mc0, mc1, mc2, mc3); TK_STEP(d0v, d1v, md0, md1, md2, md3); }
                if (lane == 0) { unsigned* sm_ = selmask + (wid * 8 + tk) * 4; sm_[0] = ma0; sm_[1] = ma1; sm_[2] = ma2; sm_[3] = ma3; sm_[4] = mb0; sm_[5] = mb1; sm_[6] = mb2; sm_[7] = mb3;
                    sm_[8] = mc0; sm_[9] = mc1; sm_[10] = mc2; sm_[11] = mc3; sm_[12] = md0; sm_[13] = md1; sm_[14] = md2; sm_[15] = md3; }
                un0 |= ma0 | mb0 | mc0 | md0; un1 |= ma1 | mb1 | mc1 | md1; un2 |= ma2 | mb2 | mc2 | md2; un3 |= ma3 | mb3 | mc3 | md3;
            }
#undef TK_INIT
#undef TK_SET
#undef TK_STEP
        } else {
            const unsigned full = (2u << cur) - 1u;
            un0 = full;
            if (lane < 8) { unsigned* sm_ = selmask + (wid * 8 + lane) * 4; sm_[0] = full; sm_[1] = 0u; sm_[2] = 0u; sm_[3] = 0u; }
        }
        if (lane == 0) { wun[wid * 4] = un0; wun[wid * 4 + 1] = un1; wun[wid * 4 + 2] = un2; wun[wid * 4 + 3] = un3; }
        __syncthreads();
        if (tid == 0) { int c = 0;
            for (int w = 0; w < 4; ++w) { unsigned u = 0u; for (int ww = 0; ww < NWAVE; ++ww) u |= wun[ww * 4 + w]; for (int bb = 0; bb < 32; ++bb) if ((u >> bb) & 1u) ulist[c++] = (unsigned char)(w * 32 + bb); }
            ucnt[0] = c; }
        __syncthreads();
    }
    { const float g0 = GN[0];
#pragma unroll
      for (int rr = 0; rr < 16; ++rr) { totw[rr * 64] = o[0][rr] * g0; totw[(16 + rr) * 64] = o[1][rr] * g0; } }
    {
        const bf16_t* KS = PROJ + ((size_t)((12 + g) * 2 + b)) * 8192 * 64; const bf16_t* VS = PROJ + ((size_t)((14 + g) * 2 + b)) * 8192 * 64;
        const int nu = ucnt[0];
        m = -1e30f; f32x16 lacc = (f32x16){}; o[0] = (f32x16){}; o[1] = (f32x16){};
        const bf16_t* KW0 = PROJ + ((size_t)((16 + g) * 2 + b)) * 8192 * 64 + (size_t)cur * 4096; const bf16_t* VW0 = PROJ + ((size_t)((18 + g) * 2 + b)) * 8192 * 64 + (size_t)cur * 4096;
        par = kv_pipeline(smem, nu, [&](int j, const bf16_t*& kp, const bf16_t*& vp) { const int n = ulist[nu - 1 - j]; kp = KS + (size_t)n * 4096; vp = VS + (size_t)n * 4096; },
            [&](int j, const unsigned char* st) {
                const int n = ulist[nu - 1 - j];
                if (!((wun[wid * 4 + (n >> 5)] >> (n & 31)) & 1u)) return;
                const bool sel = (selmask[tokl * 4 + (n >> 5)] >> (n & 31)) & 1u;
                f32x16 p0, p1; alibi_init<1>(p0, p1, slope2, 64 * n, t0, hi);
                qk_tile<false>(st, qf, p0, p1, lane);
                if (n == cur || !__all(sel)) mask_tile<1>(p0, p1, 64 * n, -1, sel ? t : -1, hi);
                softmax_step_nosum(p0, p1, m, o, lacc);
                pv_tile_sum(st + 8192, p0, p1, o, lacc, lane);
            }, par, true, true, [&](const bf16_t*& kp, const bf16_t*& vp) { kp = KW0; vp = VW0; });
        const float g1 = GN[1] / fmaxf(lacc[0], 1e-30f);
#pragma unroll
        for (int rr = 0; rr < 16; ++rr) { totw[rr * 64] += o[0][rr] * g1; totw[(16 + rr) * 64] += o[1][rr] * g1; }
    }
    {
        const bf16_t* KW = PROJ + ((size_t)((16 + g) * 2 + b)) * 8192 * 64; const bf16_t* VW = PROJ + ((size_t)((18 + g) * 2 + b)) * 8192 * 64;
        const int jlo = (t0 - 511) > 0 ? ((t0 - 511) >> 6) : 0; const int jhi = cur;
        m = -1e30f; f32x16 lacc = (f32x16){}; o[0] = (f32x16){}; o[1] = (f32x16){};
        (void)kv_pipeline(smem, jhi - jlo + 1, [&](int j, const bf16_t*& kp, const bf16_t*& vp) { kp = KW + (size_t)(jhi - j) * 4096; vp = VW + (size_t)(jhi - j) * 4096; },
            [&](int j, const unsigned char* st) {
                const int kpos0 = 64 * (jhi - j);
                if (kpos0 > tmax_w || kpos0 + 63 < tmin_w - 511) return;
                f32x16 p0, p1; alibi_init<1>(p0, p1, slope2, kpos0, t0, hi);
                qk_tile<false>(st, qf, p0, p1, lane);
                if (kpos0 < tmax_w - 511 || kpos0 + 63 > tmin_w) mask_tile<1>(p0, p1, kpos0, t - 511, t, hi);
                softmax_step_nosum(p0, p1, m, o, lacc);
                pv_tile_sum(st + 8192, p0, p1, o, lacc, lane);
            }, par, true, false, NoSrc());
        const float g2 = GN[2] / fmaxf(lacc[0], 1e-30f);
#pragma unroll
        for (int rr = 0; rr < 16; ++rr) { o[0][rr] = totw[rr * 64] + o[0][rr] * g2; o[1][rr] = totw[(16 + rr) * 64] + o[1][rr] * g2; }
    }
    {
        float ss = 0.f; bf16_t* O = (bf16_t*)(a.ws + WS_ONSA) + token * 512 + h * 64;
#pragma unroll
        for (int dh = 0; dh < 2; ++dh)
#pragma unroll
            for (int g4 = 0; g4 < 4; ++g4) { const float v0 = o[dh][4 * g4], v1 = o[dh][4 * g4 + 1], v2 = o[dh][4 * g4 + 2], v3 = o[dh][4 * g4 + 3];
                ss += v0 * v0 + v1 * v1 + v2 * v2 + v3 * v3; uint2 w; w.x = cvtpk(v0, v1); w.y = cvtpk(v2, v3); *(uint2*)(O + 32 * dh + 8 * g4 + 4 * hi) = w; }
        ss = pair_sum(ss);
        if (hi == 0) ((float*)(a.ws + WS_SSQ))[token * 16 + h] = ss;
    }
}
#ifndef PROBE_DUP
#define PROBE_DUP 0
#endif
DEV void phase_att(const Args& a, unsigned char* smem) {
    int* qctr = (int*)(a.ws + WS_CTL) + 64; int* sitem = (int*)(smem + AT_ITEM_OFF);
    unsigned* ctl = (unsigned*)(a.ws + WS_CTL); unsigned* seen = (unsigned*)(smem + AT_ITEM_OFF + 8);
    if (TID() == 0) seen[0] = 0u;
    for (;;) {
        if (TID() == 0) sitem[0] = atomicAdd(qctr, 1);
        __syncthreads();
        const int item = sitem[0];
        __syncthreads();
        if (item >= 32 + 1024) break;
        if (item < 16) cmp_item(a, smem, 16 + item);
        else if (item < 32) cmp_item(a, smem, item - 16);
        else if (item < 32 + 512) { const int fi = item - 32; const int qb = 31 - (fi >> 4), bh = fi & 15; if (!((seen[0] >> bh) & 1u)) { wait_flag(ctl + CW_CUMFLAG + bh, 1u); if (TID() == 0) seen[0] |= 1u << bh; } fox_item(a, smem, fi, bh >> 3, bh & 7, qb); }
        else { const int idx = item - 32 - 512; const int tt = 127 - (idx >> 2), bg = idx & 3; if (!((seen[0] >> 16) & 1u)) { wait_flag(ctl + CW_CMPFLAG, 16u); if (TID() == 0) seen[0] |= 1u << 16; } nsa_item(a, smem, bg >> 1, bg & 1, tt); }
    }
}

DEV void phase_outproj(const Args& a, unsigned char* smem) {
    const bf16_t* ONSA = (const bf16_t*)(a.ws + WS_ONSA); const bf16_t* OFOX = (const bf16_t*)(a.ws + WS_OFOX); const float* SSQ = (const float*)(a.ws + WS_SSQ);
    const bf16_t* W = (const bf16_t*)(a.ws + WS_WOUT); float* H1 = (float*)(a.ws + WS_H1); const float* X = a.in[I_X];
    float* rs = (float*)(smem + MISC_OFF);
    const int tid = TID(); int lane = tid & 63, wid = tid >> 6, wr = wid >> 2, wc = wid & 3; (void)wr; (void)wc; (void)lane;
    auto aoffo = [](int r, int kc) { return (unsigned)(r * 1024 + kc * 16); }; auto boffo = [](int k, int nc) { return (unsigned)(k * 2048 + nc * 16); };
    for (int item = VBID(); item < 64 * 4; item += gridDim.x) {
        int mt, nt; patch_decode(item, 64, 4, mt, nt);
        gemm256_issue0(smem, ONSA + (size_t)mt * 256 * 512, aoffo, W + nt * 256, boffo);
        if (tid < 256) { const float* s_ = SSQ + (size_t)(mt * 256 + tid) * 16; float sn = 0.f, sf = 0.f;
#pragma unroll
            for (int j = 0; j < 8; ++j) { sn += s_[j]; sf += s_[8 + j]; }
            rs[tid * 2] = rsqrtf(sn * (1.f / 512.f) + EPS); rs[tid * 2 + 1] = rsqrtf(sf * (1.f / 512.f) + EPS); }
        asm volatile("s_waitcnt vmcnt(0)" ::: "memory");
        __syncthreads();
        f32x4 acc[8][4];
#pragma unroll
        for (int mi = 0; mi < 8; ++mi) { const size_t gm = (size_t)mt * 256 + wr * 128 + mi * 16 + (lane & 15);
#pragma unroll
            for (int ni = 0; ni < 4; ++ni) { const int n = nt * 256 + wc * 64 + ni * 16 + 4 * (lane >> 4); const float4 x = *(const float4*)(X + gm * 1024 + n); acc[mi][ni] = (f32x4){x.x, x.y, x.z, x.w}; } }
#pragma unroll
        for (int mi = 0; mi < 8; ++mi) { const float ri = 1.0f / rs[(wr * 128 + mi * 16 + (lane & 15)) * 2];
#pragma unroll
            for (int ni = 0; ni < 4; ++ni) acc[mi][ni] *= ri; }
        gemm256<false>(smem, 8, ONSA + (size_t)mt * 256 * 512, 128u, aoffo, W + nt * 256, 64u * 2048u, boffo, acc, true,
                       [&]() { gemm256_issue0(smem, OFOX + (size_t)mt * 256 * 512, aoffo, W + (size_t)512 * 1024 + nt * 256, boffo); });
        EPI_IDS();
#pragma unroll
        for (int mi = 0; mi < 8; ++mi) { const int rl = wr * 128 + mi * 16 + (lane & 15); const float rat = rs[rl * 2] / rs[rl * 2 + 1];
#pragma unroll
            for (int ni = 0; ni < 4; ++ni) acc[mi][ni] *= rat; }
        gemm256<false>(smem, 8, OFOX + (size_t)mt * 256 * 512, 128u, aoffo, W + (size_t)512 * 1024 + nt * 256, 64u * 2048u, boffo, acc, true);
        EPI_IDS();
#pragma unroll
        for (int mi = 0; mi < 8; ++mi) { const int rl = wr * 128 + mi * 16 + (lane & 15); const size_t gm = (size_t)mt * 256 + rl; const float rf = rs[rl * 2 + 1];
#pragma unroll
            for (int ni = 0; ni < 4; ++ni) { const int n = nt * 256 + wc * 64 + ni * 16 + 4 * (lane >> 4); const f32x4 v = acc[mi][ni] * rf;
                float4 o = {v[0], v[1], v[2], v[3]}; *(float4*)(H1 + gm * 1024 + n) = o; } }
        __syncthreads();
    }
}

DEV void phase_route(const Args& a, unsigned char* smem) {
    const float* H1 = (const float*)(a.ws + WS_H1); bf16_t* XN = (bf16_t*)(a.ws + WS_XN); float* RSTD2 = (float*)(a.ws + WS_RSTD2);
    const float* ln2 = a.in[I_LN2]; const float* wr_ = a.in[I_WR]; const float* br = a.in[I_BR];
    int* CNT = (int*)(a.ws + WS_CTL);
    int* TOPI = (int*)(a.ws + WS_TOPI); int* TOPS = (int*)(a.ws + WS_TOPS); float* TOPW = (float*)(a.ws + WS_TOPW);
    int* TOKOF = (int*)(a.ws + WS_TOKOF); float* ROWW = (float*)(a.ws + WS_ROWW);
    float* part = (float*)smem;
    float* ssqp = part + 8 * 32 * 33;
    int* lcnt = (int*)(ssqp + 256); int* lbase = lcnt + 32; int* te = lbase + 32; int* trk = te + 256; float* tw = (float*)(trk + 256);
    const int tid = TID(), lane = tid & 63, wid = tid >> 6, i32 = lane & 31, kh = lane >> 5; const int tg = wid >> 2, kq = wid & 3;
    for (int item = BID(); item < 256; item += gridDim.x) {
        const int tok = item * 64 + tg * 32 + i32;
        if (tid < 32) lcnt[tid] = 0;
        f32x16 acc = (f32x16){}; float ss = 0.f;
        const float* hrow = H1 + (size_t)tok * 1024 + 256 * kq + 4 * kh; const float* lrow = ln2 + 256 * kq + 4 * kh; bf16_t* xrow = XN + (size_t)tok * 1024 + 256 * kq + 4 * kh;
        const float* wbase = wr_ + (size_t)(256 * kq + 4 * kh) * 32 + i32;
#pragma unroll 4
        for (int c = 0; c < 32; ++c) {
            const float4 hv = *(const float4*)(hrow + 8 * c); const float4 lv = *(const float4*)(lrow + 8 * c);
            ss += hv.x * hv.x + hv.y * hv.y + hv.z * hv.z + hv.w * hv.w;
            const float x0 = hv.x * lv.x, x1 = hv.y * lv.y, x2 = hv.z * lv.z, x3 = hv.w * lv.w;
            uint2 o; o.x = cvtpk(x0, x1); o.y = cvtpk(x2, x3); *(uint2*)(xrow + 8 * c) = o;
            const float* wp = wbase + (size_t)(8 * c) * 32;
            const float w0 = wp[0], w1 = wp[32], w2 = wp[64], w3 = wp[96];
            acc = __builtin_amdgcn_mfma_f32_32x32x2f32(x0, w0, acc, 0, 0, 0);
            acc = __builtin_amdgcn_mfma_f32_32x32x2f32(x1, w1, acc, 0, 0, 0);
            acc = __builtin_amdgcn_mfma_f32_32x32x2f32(x2, w2, acc, 0, 0, 0);
            acc = __builtin_amdgcn_mfma_f32_32x32x2f32(x3, w3, acc, 0, 0, 0);
        }
        ss = pair_sum(ss);
        if (kh == 0) ssqp[wid * 32 + i32] = ss;
#pragma unroll
        for (int r = 0; r < 16; ++r) part[(wid * 32 + crow(r, kh)) * 33 + i32] = acc[r];
        __syncthreads();
        if (tid < 64) {
            const int g_ = tid >> 5, i_ = tid & 31; const int w0_ = g_ * 4;
            const float sq = ssqp[(w0_ + 0) * 32 + i_] + ssqp[(w0_ + 1) * 32 + i_] + ssqp[(w0_ + 2) * 32 + i_] + ssqp[(w0_ + 3) * 32 + i_]; const float rstd = rsqrtf(sq * (1.f / 1024.f) + EPS);
            RSTD2[item * 64 + tid] = rstd;
            float lg[32];
#pragma unroll
            for (int e = 0; e < 32; ++e) lg[e] = (part[((w0_ + 0) * 32 + i_) * 33 + e] + part[((w0_ + 1) * 32 + i_) * 33 + e] + part[((w0_ + 2) * 32 + i_) * 33 + e] + part[((w0_ + 3) * 32 + i_) * 33 + e]) * rstd + br[e];
            unsigned taken = 0u; float tv[4]; int ti[4];
#pragma unroll
            for (int k = 0; k < 4; ++k) { float best = -3.0e38f; int bi = 0;
#pragma unroll
                for (int e = 0; e < 32; ++e) { const bool ok = !((taken >> e) & 1u) && lg[e] > best; best = ok ? lg[e] : best; bi = ok ? e : bi; }
                taken |= 1u << bi; tv[k] = best; ti[k] = bi; }
            const float e1 = __expf(tv[1] - tv[0]), e2 = __expf(tv[2] - tv[0]), e3 = __expf(tv[3] - tv[0]); const float inv = 1.0f / (1.0f + e1 + e2 + e3);
            const float wv[4] = {inv, e1 * inv, e2 * inv, e3 * inv};
#pragma unroll
            for (int k = 0; k < 4; ++k) { const int idx = tid * 4 + k; te[idx] = ti[k]; trk[idx] = atomicAdd(&lcnt[ti[k]], 1); tw[idx] = wv[k]; }
        }
        __syncthreads();
        if (tid < 32) lbase[tid] = atomicAdd(&CNT[tid], lcnt[tid]);
        __syncthreads();
        if (tid < 256) { const int idx = tid; const int tk = item * 64 + (idx >> 2); const int e = te[idx]; const int slot = lbase[e] + trk[idx];
          TOPI[(size_t)tk * 4 + (idx & 3)] = e; TOPS[(size_t)tk * 4 + (idx & 3)] = slot; TOPW[(size_t)tk * 4 + (idx & 3)] = tw[idx];
          TOKOF[(size_t)e * 16384 + slot] = tk; ROWW[(size_t)e * 16384 + slot] = tw[idx]; }
        __syncthreads();
    }
}

struct MoeMap { int e, mt, nt, cnt, off; };
DEV void moe_setup(const Args& a, int* sm) {
    if (TID() == 0) { const int* CNT = (const int*)(a.ws + WS_CTL); int tot = 0; for (int e = 0; e < 32; ++e) { const int c = CNT[e]; const int mt = (c + 255) >> 8; sm[e] = mt; sm[32 + e] = tot; tot += mt; } sm[64] = tot; }
    __syncthreads();
}
DEV MoeMap moe_map(const Args& a, const int* sm, int item, int NT) {
    MoeMap mm; int e = 0;
#pragma unroll 1
    for (int i = 1; i < 32; ++i) if (item >= sm[32 + i] * NT) e = i;
    const int local = item - sm[32 + e] * NT; const int mte = sm[e];
    int mt_, nt_; patch_decode(local, mte, NT, mt_, nt_);
    mm.e = __builtin_amdgcn_readfirstlane(e); mm.mt = __builtin_amdgcn_readfirstlane(mt_); mm.nt = __builtin_amdgcn_readfirstlane(nt_);
    mm.cnt = __builtin_amdgcn_readfirstlane(((const int*)(a.ws + WS_CTL))[e]); mm.off = __builtin_amdgcn_readfirstlane(sm[32 + e] * 256); return mm;
}
DEV void phase_up(const Args& a, unsigned char* smem) {
    int* sm = (int*)(smem + MISC_OFF); int* tokb = sm + 128; float* rsdb = (float*)(tokb + 512);
    const bf16_t* XN = (const bf16_t*)(a.ws + WS_XN); const bf16_t* W = (const bf16_t*)(a.ws + WS_WUP); bf16_t* ACT = (bf16_t*)(a.ws + WS_ACT); const float* RSTD2 = (const float*)(a.ws + WS_RSTD2);
    const int* TOKOF = (const int*)(a.ws + WS_TOKOF); const float* bup = a.in[I_BUP];
    const int tid = TID(); int lane = tid & 63, wid = tid >> 6, wr = wid >> 2, wc = wid & 3; (void)wr; (void)wc; (void)lane;
    moe_setup(a, sm);
    const int nitems = __builtin_amdgcn_readfirstlane(sm[64]) * 8;
    auto fill = [&](const MoeMap& m_, int buf) { if (tid < 256) { const int slot = m_.mt * 256 + tid; const int tk_ = slot < m_.cnt ? TOKOF[(size_t)m_.e * 16384 + slot] : 0; tokb[buf * 256 + tid] = tk_; rsdb[buf * 256 + tid] = RSTD2[tk_]; } };
    auto boffu = [](int k, int nc) { const int ni = (nc >> 1) & 3; const int sc = ((ni >> 1) ? 1024 : 0) + (nc >> 3) * 32 + (ni & 1) * 16 + (nc & 1) * 8; return (unsigned)(k * 4096 + sc * 2); };
    int item = VBID(); int buf = 0; bool pre = false; MoeMap mm{};
    if (item < nitems) { mm = moe_map(a, sm, item, 8); fill(mm, 0); }
    __syncthreads();
    while (item < nitems) {
        const int nitem = item + (int)gridDim.x; const bool has_next = nitem < nitems; MoeMap mn{};
        if (has_next) { mn = moe_map(a, sm, nitem, 8); fill(mn, buf ^ 1); }
        const int* tok = tokb + buf * 256; const int* tokn = tokb + (buf ^ 1) * 256; const float* rsd = rsdb + buf * 256;
        const bf16_t* We = W + (size_t)mm.e * 1024 * 2048; const bf16_t* Wn = W + (size_t)mn.e * 1024 * 2048;
        f32x4 acc[8][4];
        gemm256<true>(smem, 16, XN, 128u, [&](int r, int kc) { return (unsigned)(tok[r] * 2048 + kc * 16); }, We + mm.nt * 128, 64u * 4096u, boffu, acc, pre,
                      [&]() { if (has_next) gemm256_issue0(smem, XN, [&](int r, int kc) { return (unsigned)(tokn[r] * 2048 + kc * 16); }, Wn + mn.nt * 128, boffu); });
        EPI_IDS();
#pragma unroll
        for (int mi = 0; mi < 8; ++mi) { const int rl_ = wr * 128 + mi * 16 + (lane & 15); const size_t row = (size_t)mm.off + mm.mt * 256 + rl_; const float rs_ = rsd[rl_];
#pragma unroll
            for (int ni = 0; ni < 2; ++ni) { const int jc = mm.nt * 128 + wc * 32 + ni * 16 + 4 * (lane >> 4);
                const float4 bg = *(const float4*)(bup + (size_t)mm.e * 2048 + jc), bl_ = *(const float4*)(bup + (size_t)mm.e * 2048 + 1024 + jc);
                const f32x4 gv = acc[mi][ni], lv = acc[mi][ni + 2]; const float bgv[4] = {bg.x, bg.y, bg.z, bg.w}, blv[4] = {bl_.x, bl_.y, bl_.z, bl_.w}; float r4[4];
#pragma unroll
                for (int r = 0; r < 4; ++r) { const float gg = fminf(gv[r] * rs_ + bgv[r], 7.0f); const float ll = fminf(fmaxf(lv[r] * rs_ + blv[r], -7.0f), 7.0f); r4[r] = gg * sigmoidf_(1.702f * gg) * (ll + 1.0f); }
                uint2 o; o.x = cvtpk(r4[0], r4[1]); o.y = cvtpk(r4[2], r4[3]); *(uint2*)(ACT + row * 1024 + jc) = o; } }
        __syncthreads();
        item = nitem; mm = mn; buf ^= 1; pre = has_next;
    }
}
DEV void phase_down(const Args& a, unsigned char* smem) {
    int* sm = (int*)(smem + MISC_OFF); float* rwb = (float*)(sm + 128);
    const bf16_t* ACT = (const bf16_t*)(a.ws + WS_ACT); const bf16_t* W = (const bf16_t*)(a.ws + WS_WDN); bf16_t* Y = (bf16_t*)(a.ws + WS_Y);
    const float* ROWW = (const float*)(a.ws + WS_ROWW); const float* bdn = a.in[I_BDN];
    const int tid = TID(); int lane = tid & 63, wid = tid >> 6, wr = wid >> 2, wc = wid & 3; (void)wr; (void)wc; (void)lane;
    moe_setup(a, sm);
    const int nitems = __builtin_amdgcn_readfirstlane(sm[64]) * 4;
    auto fill = [&](const MoeMap& m_, int buf) { if (tid < 256) { const int slot = m_.mt * 256 + tid; rwb[buf * 256 + tid] = slot < m_.cnt ? ROWW[(size_t)m_.e * 16384 + slot] : 0.f; } };
    auto aoffd = [](int r, int kc) { return (unsigned)(r * 2048 + kc * 16); }; auto boffd = [](int k, int nc) { return (unsigned)(k * 2048 + nc * 16); };
    int item = VBID(); int buf = 0; bool pre = false; MoeMap mm{};
    if (item < nitems) { mm = moe_map(a, sm, item, 4); fill(mm, 0); }
    __syncthreads();
    while (item < nitems) {
        const int nitem = item + (int)gridDim.x; const bool has_next = nitem < nitems; MoeMap mn{};
        if (has_next) { mn = moe_map(a, sm, nitem, 4); fill(mn, buf ^ 1); }
        const float* rw = rwb + buf * 256;
        const bf16_t* We = W + (size_t)mm.e * 1024 * 1024; const bf16_t* Ab = ACT + ((size_t)mm.off + mm.mt * 256) * 1024;
        const bf16_t* Wn = W + (size_t)mn.e * 1024 * 1024; const bf16_t* An = ACT + ((size_t)mn.off + mn.mt * 256) * 1024;
        f32x4 acc[8][4];
        gemm256<true>(smem, 16, Ab, 128u, aoffd, We + mm.nt * 256, 64u * 2048u, boffd, acc, pre,
                      [&]() { if (has_next) gemm256_issue0(smem, An, aoffd, Wn + mn.nt * 256, boffd); });
        EPI_IDS();
#pragma unroll
        for (int mi = 0; mi < 8; ++mi) { const int rl = wr * 128 + mi * 16 + (lane & 15); const size_t row = (size_t)mm.off + mm.mt * 256 + rl; const float w = rw[rl];
#pragma unroll
            for (int ni = 0; ni < 4; ++ni) { const int n = mm.nt * 256 + wc * 64 + ni * 16 + 4 * (lane >> 4); const float4 bb = *(const float4*)(bdn + (size_t)mm.e * 1024 + n); const f32x4 v = acc[mi][ni];
                uint2 o; o.x = cvtpk((v[0] + bb.x) * w, (v[1] + bb.y) * w); o.y = cvtpk((v[2] + bb.z) * w, (v[3] + bb.w) * w); *(uint2*)(Y + row * 1024 + n) = o; } }
        __syncthreads();
        item = nitem; mm = mn; buf ^= 1; pre = has_next;
    }
}

DEV void phase_comb(const Args& a, unsigned char* smem) {
    int* sm = (int*)(smem + MISC_OFF);
    moe_setup(a, sm);
    float* H1 = (float*)(a.ws + WS_H1); bf16_t* XN = (bf16_t*)(a.ws + WS_XN); const bf16_t* Y = (const bf16_t*)(a.ws + WS_Y);
    const int* TOPI = (const int*)(a.ws + WS_TOPI); const int* TOPS = (const int*)(a.ws + WS_TOPS); const float* g = a.in[I_LNPLE];
    const int lane = TID() & 63; const int gw = BID() * NWAVE + (TID() >> 6), ngw = gridDim.x * NWAVE;
    for (int tok = gw; tok < NTOK; tok += ngw) {
        float4 v[4];
#pragma unroll
        for (int j = 0; j < 4; ++j) v[j] = *(const float4*)(H1 + (size_t)tok * 1024 + j * 256 + lane * 4);
#pragma unroll
        for (int k = 0; k < 4; ++k) { const int e = TOPI[(size_t)tok * 4 + k]; const size_t row = (size_t)sm[32 + e] * 256 + TOPS[(size_t)tok * 4 + k];
#pragma unroll
            for (int j = 0; j < 4; ++j) { const uint2 u = *(const uint2*)(Y + row * 1024 + j * 256 + lane * 4); v[j].x += bflo(u.x); v[j].y += bfhi(u.x); v[j].z += bflo(u.y); v[j].w += bfhi(u.y); } }
        float s = 0.f;
#pragma unroll
        for (int j = 0; j < 4; ++j) { *(float4*)(H1 + (size_t)tok * 1024 + j * 256 + lane * 4) = v[j]; s += v[j].x * v[j].x + v[j].y * v[j].y + v[j].z * v[j].z + v[j].w * v[j].w; }
        const float rstd = rsqrtf(wave_sum(s) * (1.f / 1024.f) + EPS);
#pragma unroll
        for (int j = 0; j < 4; ++j) { const float4 gg = *(const float4*)(g + j * 256 + lane * 4);
            uint2 o; o.x = cvtpk(v[j].x * rstd * gg.x, v[j].y * rstd * gg.y); o.y = cvtpk(v[j].z * rstd * gg.z, v[j].w * rstd * gg.w); *(uint2*)(XN + (size_t)tok * 1024 + j * 256 + lane * 4) = o; }
    }
}

DEV void phase_gate(const Args& a, unsigned char* smem) {
    const bf16_t* XN = (const bf16_t*)(a.ws + WS_XN); const bf16_t* WG = (const bf16_t*)(a.ws + WS_WGATE); const bf16_t* PB = (const bf16_t*)(a.ws + WS_PB); const bf16_t* WP = (const bf16_t*)(a.ws + WS_WPLE);
    const float* H2 = (const float*)(a.ws + WS_H1); float* OUT = a.out; float* SSQ3 = (float*)(a.ws + WS_SSQ3);
    const int tid = TID(); int lane = tid & 63, wid = tid >> 6, wr = wid >> 2, wc = wid & 3; (void)wr; (void)wc; (void)lane;
    bf16_t* GT = (bf16_t*)(a.ws + WS_ACT);
    auto aoffg = [](int r, int kc) { return (unsigned)(r * 2048 + kc * 16); }; auto aoffp = [](int r, int kc) { return (unsigned)(r * 512 + kc * 16); }; auto boffg = [](int k, int nc) { return (unsigned)(k * 2048 + nc * 16); };
    for (int item = VBID(); item < 64 * 4; item += gridDim.x) {
        int mt, nt; patch_decode(item, 64, 4, mt, nt);
        f32x4 acc[8][4];
        gemm256<true>(smem, 16, XN + (size_t)mt * 256 * 1024, 128u, aoffg, WG + nt * 256, 64u * 2048u, boffg, acc, false,
                      [&]() { gemm256_issue0(smem, PB + (size_t)mt * 256 * 256, aoffp, WP + nt * 256, boffg); });
        EPI_IDS();
#pragma unroll
        for (int mi = 0; mi < 8; ++mi) { const size_t gm = (size_t)mt * 256 + wr * 128 + mi * 16 + (lane & 15);
#pragma unroll
            for (int ni = 0; ni < 4; ++ni) { const int n = nt * 256 + wc * 64 + ni * 16 + 4 * (lane >> 4); const f32x4 v = acc[mi][ni];
                uint2 w; w.x = cvtpk(sigmoidf_(v[0]), sigmoidf_(v[1])); w.y = cvtpk(sigmoidf_(v[2]), sigmoidf_(v[3])); *(uint2*)(GT + gm * 1024 + n) = w;
                const float4 h = *(const float4*)(H2 + gm * 1024 + n);
                acc[mi][ni] = (f32x4){h.x * __builtin_amdgcn_rcpf(bflo(w.x)), h.y * __builtin_amdgcn_rcpf(bfhi(w.x)), h.z * __builtin_amdgcn_rcpf(bflo(w.y)), h.w * __builtin_amdgcn_rcpf(bfhi(w.y))}; }
            asm volatile("" ::: "memory"); }
        gemm256<false>(smem, 4, PB + (size_t)mt * 256 * 256, 128u, aoffp, WP + nt * 256, 64u * 2048u, boffg, acc, true);
        EPI_IDS();
        const bool fused = gridDim.x >= 256;
#pragma unroll
        for (int mi = 0; mi < 8; ++mi) { const size_t gm = (size_t)mt * 256 + wr * 128 + mi * 16 + (lane & 15); float ss = 0.f;
#pragma unroll
            for (int ni = 0; ni < 4; ++ni) { const int n = nt * 256 + wc * 64 + ni * 16 + 4 * (lane >> 4); const f32x4 v = acc[mi][ni];
                const uint2 gw = *(const uint2*)(GT + gm * 1024 + n);
                float4 o = {v[0] * bflo(gw.x), v[1] * bfhi(gw.x), v[2] * bflo(gw.y), v[3] * bfhi(gw.y)};
                if (!fused) *(float4*)(OUT + gm * 1024 + n) = o;
                acc[mi][ni] = (f32x4){o.x, o.y, o.z, o.w};
                ss += o.x * o.x + o.y * o.y + o.z * o.z + o.w * o.w; }
            ss += __shfl_xor(ss, 16); ss += __shfl_xor(ss, 32);
            if (lane < 16) SSQ3[gm * 16 + nt * 4 + wc] = ss;
            asm volatile("" ::: "memory"); }
        if (fused) {
            unsigned* flag = (unsigned*)(a.ws + WS_CTL) + CW_GATEFLAG + mt;
            signal_done(flag); wait_flag(flag, 4u);
            const float* lnf = a.in[I_LNF];
#pragma unroll
            for (int mi = 0; mi < 8; ++mi) { const size_t gm = (size_t)mt * 256 + wr * 128 + mi * 16 + (lane & 15);
                const float4 s0 = *(const float4*)(SSQ3 + gm * 16), s1 = *(const float4*)(SSQ3 + gm * 16 + 4), s2 = *(const float4*)(SSQ3 + gm * 16 + 8), s3 = *(const float4*)(SSQ3 + gm * 16 + 12);
                const float tot = ((s0.x + s0.y) + (s0.z + s0.w)) + ((s1.x + s1.y) + (s1.z + s1.w)) + ((s2.x + s2.y) + (s2.z + s2.w)) + ((s3.x + s3.y) + (s3.z + s3.w));
                const float rstd = rsqrtf(tot * (1.f / 1024.f) + EPS);
#pragma unroll
                for (int ni = 0; ni < 4; ++ni) { const int n = nt * 256 + wc * 64 + ni * 16 + 4 * (lane >> 4); const float4 gg = *(const float4*)(lnf + n); const f32x4 v = acc[mi][ni];
                    float4 o = {v[0] * rstd * gg.x, v[1] * rstd * gg.y, v[2] * rstd * gg.z, v[3] * rstd * gg.w}; *(float4*)(OUT + gm * 1024 + n) = o; }
                asm volatile("" ::: "memory"); }
        }
        __syncthreads();
    }
}

DEV void phase_final(const Args& a) {
    if (gridDim.x >= 256) return;
    float* OUT = a.out; const float* SSQ3 = (const float*)(a.ws + WS_SSQ3); const float* g = a.in[I_LNF];
    const int lane = TID() & 63; const int gw = BID() * NWAVE + (TID() >> 6), ngw = gridDim.x * NWAVE;
    for (int m = gw; m < NTOK; m += ngw) {
        float s = 0.f;
#pragma unroll
        for (int j = 0; j < 16; ++j) s += SSQ3[(size_t)m * 16 + j];
        const float rstd = rsqrtf(s * (1.f / 1024.f) + EPS);
#pragma unroll
        for (int j = 0; j < 4; ++j) { float4 v = *(const float4*)(OUT + (size_t)m * 1024 + j * 256 + lane * 4); const float4 gg = *(const float4*)(g + j * 256 + lane * 4);
            v.x *= rstd * gg.x; v.y *= rstd * gg.y; v.z *= rstd * gg.z; v.w *= rstd * gg.w; *(float4*)(OUT + (size_t)m * 1024 + j * 256 + lane * 4) = v; }
    }
}

template <int PH> DEV void run_phase(const Args& a, unsigned char* smem) {
    if constexpr (PH == PH_PRO) phase_prologue(a, smem);
    else if constexpr (PH == PH_INPROJ) phase_inproj(a, smem);
    else if constexpr (PH == PH_ATT) phase_att(a, smem);
    else if constexpr (PH == PH_OUTPROJ) phase_outproj(a, smem);
    else if constexpr (PH == PH_ROUTE) phase_route(a, smem);
    else if constexpr (PH == PH_UP) phase_up(a, smem);
    else if constexpr (PH == PH_DOWN) phase_down(a, smem);
    else if constexpr (PH == PH_COMB) phase_comb(a, smem);
    else if constexpr (PH == PH_GATE) phase_gate(a, smem);
    else if constexpr (PH == PH_FINAL) phase_final(a);
}
#define XB_TMO      128
#define XB_XCNT(j)  (256  + 64 * (j))
#define XB_XSUB(j)  (1280 + 64 * (j))
#define XB_XGEN(j)  (2304 + 64 * (j))
#define XB_TOP      3328
#define XB_TOPGEN   3392
#define XCD_BAR_WORDS 3456
#define XB_SPIN_CAP (1u << 22)
DEV unsigned xb_ld(unsigned* p)              { return __hip_atomic_load(p, __ATOMIC_RELAXED, __HIP_MEMORY_SCOPE_AGENT); }
DEV unsigned xb_add(unsigned* p, unsigned v) { return __hip_atomic_fetch_add(p, v, __ATOMIC_RELAXED, __HIP_MEMORY_SCOPE_AGENT); }
DEV unsigned xb_xcc_id() { return (unsigned)__builtin_amdgcn_s_getreg((3 << 11) | 20) & 0xFu; }
#define XB_SPIN(cond, bar) do { unsigned _sp = 0; while (cond) { __builtin_amdgcn_s_sleep(1); \
    if ((++_sp & 255u) == 0u) { if (xb_ld(&(bar)[XB_TMO])) break; if (_sp > XB_SPIN_CAP) { atomicAdd(&(bar)[XB_TMO], 1u); break; } } } } while (0)
struct XcdBarrier { unsigned* bar; unsigned x; volatile LAS unsigned* st; };
DEV XcdBarrier xcd_barrier_post(unsigned* bar, volatile LAS unsigned* st) {
    XcdBarrier b; b.bar = bar; b.x = xb_xcc_id(); b.st = st;
    if (TID() == 0) (void)xb_add(&bar[XB_XCNT(b.x)], 1u);
    return b;
}
DEV void xcd_barrier_complete(unsigned* bar, unsigned x, unsigned& nloc, unsigned& nx) {
    const unsigned G = gridDim.x * gridDim.y * gridDim.z;
    unsigned sum, cnt, mine, sp = 0u;
    for (;;) {
        sum = 0u; cnt = 0u; mine = 0u;
#pragma unroll
        for (unsigned j = 0; j < 16; ++j) { const unsigned c = xb_ld(&bar[XB_XCNT(j)]); sum += c; cnt += (c > 0u) ? 1u : 0u; mine = (j == x) ? c : mine; }
        if (sum == G) break;
        __builtin_amdgcn_s_sleep(1);
        if ((++sp & 255u) == 0u) { if (xb_ld(&bar[XB_TMO])) break; if (sp > XB_SPIN_CAP) { atomicAdd(&bar[XB_TMO], 1u); break; } }
    }
    nloc = mine > 0u ? mine : 1u; nx = cnt > 0u ? cnt : 1u;
}
DEV void xcd_barrier(const XcdBarrier& b) {
    asm volatile("s_waitcnt vmcnt(0)" ::: "memory");
    __syncthreads();
    if (TID() == 0) {
        unsigned* bar = b.bar;
        __builtin_amdgcn_s_waitcnt(0);
        unsigned nloc = b.st[0], nx = b.st[1];
        if (nloc == 0u) { xcd_barrier_complete(bar, b.x, nloc, nx); b.st[0] = nloc; b.st[1] = nx; }
        const unsigned old = xb_add(&bar[XB_XSUB(b.x)], 1u);
        const unsigned gen = old / nloc;
        if (old + 1u == (gen + 1u) * nloc) {
            __builtin_amdgcn_fence(__ATOMIC_RELEASE, "agent");
            asm volatile("s_waitcnt vmcnt(0)" ::: "memory");
            const unsigned og = xb_add(&bar[XB_TOP], 1u);
            const unsigned tg = og / nx;
            if (og + 1u == (tg + 1u) * nx) xb_add(&bar[XB_TOPGEN], 1u);
            else XB_SPIN(xb_ld(&bar[XB_TOPGEN]) == tg, bar);
            __builtin_amdgcn_fence(__ATOMIC_ACQUIRE, "agent");
            xb_add(&bar[XB_XGEN(b.x)], 1u);
            asm volatile("s_waitcnt vmcnt(0)" ::: "memory");
        } else {
            XB_SPIN(xb_ld(&bar[XB_XGEN(b.x)]) == gen, bar);
            __builtin_amdgcn_fence(__ATOMIC_ACQUIRE, "agent");
            asm volatile("s_waitcnt vmcnt(0)" ::: "memory");
        }
    }
    __syncthreads();
}

__global__ void __launch_bounds__(NTHR, 2) mega(Args a) {
    extern __shared__ __attribute__((aligned(16))) unsigned char smem[];
    volatile LAS unsigned* bst = (volatile LAS unsigned*)(LAS unsigned char*)(smem + MISC_OFF + 8000);
    if (TID() == 0) { bst[0] = 0u; bst[1] = 0u; }
    __syncthreads();
    const XcdBarrier bar = xcd_barrier_post((unsigned*)(a.ws + WS_CTL) + 4096, bst);
#define GSYNC() xcd_barrier(bar)
#define RUN(ph) do { run_phase<ph>(a, smem); if ((PROBE_DUP >> ph) & 1) { GSYNC(); run_phase<ph>(a, smem); } } while (0)
    RUN(PH_PRO); GSYNC();
    RUN(PH_INPROJ); GSYNC();
    RUN(PH_ATT); GSYNC();
    RUN(PH_OUTPROJ); GSYNC();
    RUN(PH_ROUTE); GSYNC();
    RUN(PH_UP); GSYNC();
    RUN(PH_DOWN); GSYNC();
    RUN(PH_COMB); GSYNC();
    RUN(PH_GATE);
    if (gridDim.x < 256) { GSYNC(); RUN(PH_FINAL); }
#undef RUN
#undef GSYNC
}

extern "C" void kernel_launch(void* const* d_in, const int* in_sizes, int n_in, void* d_out, int out_size, void* d_ws, size_t ws_size, hipStream_t stream) {
    static int grid = 0;
    if (grid == 0) {
        if (n_in != 25 || ws_size < WS_END) { fprintf(stderr, "kernel_launch: unexpected n_in %d / ws %zu\n", n_in, ws_size); grid = -1; return; }
        int dev = 0, cus = 0, per_cu = 0;
        (void)hipGetDevice(&dev); (void)hipDeviceGetAttribute(&cus, hipDeviceAttributeMultiprocessorCount, dev);
        (void)hipFuncSetAttribute((const void*)mega, hipFuncAttributeMaxDynamicSharedMemorySize, LDS_BYTES);
        (void)hipOccupancyMaxActiveBlocksPerMultiprocessor(&per_cu, (const void*)mega, NTHR, LDS_BYTES);
        if (per_cu < 1) { fprintf(stderr, "kernel_launch: occupancy query says %d blocks per CU\n", per_cu); grid = -1; return; }
        grid = cus;
    }
    if (grid < 0) return;
    (void)hipMemsetAsync((char*)d_ws + WS_CTL, 0, 65536, stream);
    Args a{};
    for (int i = 0; i < 25; ++i) a.in[i] = (const float*)d_in[i];
    a.out = (float*)d_out; a.ws = (unsigned char*)d_ws; a.ph_lo = 0; a.ph_hi = PH_N;
    void* args[] = {&a};
    hipError_t e = hipLaunchCooperativeKernel((const void*)mega, dim3(grid), dim3(NTHR), args, LDS_BYTES, stream);
    if (e != hipSuccess) fprintf(stderr, "cooperative launch failed: %s (grid %d)\n", hipGetErrorString(e), grid);
}
```

```cpp
#include <hip/hip_runtime.h>
#include <stdint.h>
#include <cstdio>

#define DEV __device__ __forceinline__
#define LAS __attribute__((address_space(3)))

typedef unsigned short bf16_t;
typedef short bf16x8 __attribute__((ext_vector_type(8)));
typedef short s16x4 __attribute__((ext_vector_type(4)));
typedef float f32x4 __attribute__((ext_vector_type(4)));
typedef float f32x16 __attribute__((ext_vector_type(16)));
typedef float f32x2_t __attribute__((ext_vector_type(2)));
typedef __bf16 bf16x2_t __attribute__((ext_vector_type(2)));

constexpr int NTHR = 512, NWAVE = 8;
constexpr int NTOK = 16384;
constexpr float EPS = 1e-6f;
constexpr float LOG2E = 1.4426950408889634f;
constexpr float QS = 0.125f * LOG2E;
constexpr int NWIN = 3072;

constexpr size_t MiB = 1u << 20;
constexpr size_t WS_CTL = 0;
constexpr size_t WS_WIN = 1 * MiB;
constexpr size_t WS_WOUT = 7 * MiB;
constexpr size_t WS_WGATE = 9 * MiB;
constexpr size_t WS_WPLE = 11 * MiB;
constexpr size_t WS_WC1 = 12 * MiB;
constexpr size_t WS_WC2 = 15 * MiB + 512 * 1024 + 262144;
constexpr size_t WS_BIAS1 = 15 * MiB + 512 * 1024 + 262144 + 131072;
constexpr size_t WS_KC = 14 * MiB;
constexpr size_t WS_HID = 14 * MiB + 512 * 1024;
constexpr size_t WS_GN = 16 * MiB;
constexpr size_t WS_LS = 18 * MiB;
constexpr size_t WS_CUM = 19 * MiB;
constexpr size_t WS_SSQ = 20 * MiB;
constexpr size_t WS_TOPI = 21 * MiB;
constexpr size_t WS_TOPS = 21 * MiB + 262144;
constexpr size_t WS_TOPW = 21 * MiB + 524288;
constexpr size_t WS_TOKOF = 22 * MiB;
constexpr size_t WS_ROWW = 24 * MiB;
constexpr size_t WS_SSQ3 = 26 * MiB;
constexpr size_t WS_RSTD2 = 27 * MiB;
constexpr size_t WS_PB = 28 * MiB;
constexpr size_t WS_XN = 36 * MiB;
constexpr size_t WS_PROJ = 68 * MiB;
constexpr size_t WS_ONSA = 160 * MiB;
constexpr size_t WS_OFOX = 176 * MiB;
constexpr size_t WS_H1 = 192 * MiB;
constexpr size_t WS_WUP = 256 * MiB;
constexpr size_t WS_WDN = 384 * MiB;
constexpr size_t WS_ACT = 448 * MiB;
constexpr size_t WS_Y = 592 * MiB;
constexpr size_t WS_END = 736 * MiB;

enum { PH_PRO = 0, PH_INPROJ, PH_CMP, PH_ATT, PH_OUTPROJ, PH_ROUTE, PH_UP, PH_DOWN, PH_COMB, PH_GATE, PH_FINAL, PH_N };
struct Args { const float* in[25]; float* out; unsigned char* ws; int ph_lo, ph_hi; };
enum { I_X = 0, I_P, I_LN1, I_WIN, I_BFG, I_WC1K, I_WC2K, I_PEK, I_WC1V, I_WC2V, I_PEV, I_GNN, I_GNF, I_WOUT, I_LN2, I_WR, I_BR,
       I_WUP, I_BUP, I_WDN, I_BDN, I_LNPLE, I_WPLE, I_WGATE, I_LNF };

DEV int BID() { int b = (int)blockIdx.x; asm volatile("" : "+s"(b)); return b; }
DEV int VBID() { const int g = (int)gridDim.x, b = BID(); return (g & 7) ? b : (b & 7) * (g >> 3) + (b >> 3); }
DEV int TID() { int t = (int)__builtin_amdgcn_workitem_id_x(); asm volatile("" : "+v"(t)); return t; }
DEV unsigned cvtpk(float lo, float hi) { f32x2_t v = {lo, hi}; bf16x2_t b = __builtin_convertvector(v, bf16x2_t); return __builtin_bit_cast(unsigned, b); }
DEV float bflo(unsigned u) { return __uint_as_float(u << 16); }
DEV float bfhi(unsigned u) { return __uint_as_float(u & 0xffff0000u); }
DEV float wave_sum(float v) {
#pragma unroll
    for (int o = 1; o < 64; o <<= 1) v += __shfl_xor(v, o);
    return v;
}
#define DPP_MOV(x, ctrl) __builtin_bit_cast(float, __builtin_amdgcn_update_dpp(0, __builtin_bit_cast(int, (x)), (ctrl), 0xF, 0xF, true))
DEV float pair_sum(float x) { return x + __shfl_xor(x, 32); }
DEV float pair_max(float x) { return fmaxf(x, __shfl_xor(x, 32)); }
DEV float quad_sum(float x) { x += DPP_MOV(x, 0xB1); x += DPP_MOV(x, 0x4E); return x; }
DEV float wave_max_u(float x) {
    x = fmaxf(x, DPP_MOV(x, 0xB1)); x = fmaxf(x, DPP_MOV(x, 0x4E)); x = fmaxf(x, DPP_MOV(x, 0x141)); x = fmaxf(x, DPP_MOV(x, 0x140));
    const float a = __builtin_bit_cast(float, __builtin_amdgcn_readlane(__builtin_bit_cast(int, x), 0)), b = __builtin_bit_cast(float, __builtin_amdgcn_readlane(__builtin_bit_cast(int, x), 16));
    const float c = __builtin_bit_cast(float, __builtin_amdgcn_readlane(__builtin_bit_cast(int, x), 32)), d = __builtin_bit_cast(float, __builtin_amdgcn_readlane(__builtin_bit_cast(int, x), 48));
    return fmaxf(fmaxf(a, b), fmaxf(c, d));
}
DEV float sigmoidf_(float x) { return __builtin_amdgcn_rcpf(1.0f + __expf(-x)); }
DEV float logsigmoidf_(float x) { return fminf(x, 0.f) - log1pf(__expf(-fabsf(x))); }
DEV float gelu_tanh(float x) { const float u = 0.7978845608028654f * (x + 0.044715f * x * x * x); const float th = 1.0f - 2.0f * __builtin_amdgcn_rcpf(__expf(2.0f * u) + 1.0f); return 0.5f * x * (1.0f + th); }
DEV s16x4 tr_read(const unsigned char* p) {
    typedef short v4i16_t __attribute__((ext_vector_type(4)));
    return __builtin_bit_cast(s16x4, __builtin_amdgcn_ds_read_tr16_b64_v4i16((LAS v4i16_t*)p));
}
DEV int crow(int r, int hi) { return (r & 3) + 8 * (r >> 2) + 4 * hi; }

constexpr int GL_STAGE = 65536;
constexpr int GEMM_LDS = 2 * GL_STAGE;
constexpr int MISC_OFF = GEMM_LDS;
constexpr int LDS_BYTES = GEMM_LDS + 8192;

DEV void glds16s(const void* sbase, unsigned voff, unsigned lds_dst) { unsigned keep;
    asm volatile("s_mov_b32 %0, m0\n\ts_mov_b32 m0, %3\n\ts_nop 0\n\tglobal_load_lds_dwordx4 %1, %2\n\ts_mov_b32 m0, %0" : "=&s"(keep) : "v"(voff), "s"(sbase), "s"(lds_dst) : "memory"); }

DEV const unsigned char* uptr(const void* p) { const unsigned long long v = (unsigned long long)p; const unsigned lo = __builtin_amdgcn_readfirstlane((unsigned)v), hi = __builtin_amdgcn_readfirstlane((unsigned)(v >> 32)); return (const unsigned char*)(((unsigned long long)hi << 32) | lo); }

struct NoNextS { DEV void operator()() const {} };
template <class AO, class BO>
DEV void gemm256s_issue0(unsigned char* smem, const void* abase, const AO& aoff, const void* bbase, const BO& boff) {
    const int tid = TID(), lane = tid & 63; const int wid = __builtin_amdgcn_readfirstlane(tid >> 6);
    const unsigned lds0 = (unsigned)(uintptr_t)smem; const unsigned char* ab_ = uptr(abase); const unsigned char* bb_ = uptr(bbase);
#pragma unroll
    for (int i = 0; i < 4; ++i) { const int p = wid + 8 * i; glds16s(ab_, aoff(8 * p + (lane >> 3), (lane & 7) ^ (lane >> 3)), (unsigned)__builtin_amdgcn_readfirstlane(lds0 + p * 1024)); }
#pragma unroll
    for (int i = 0; i < 4; ++i) { const int p = wid + 8 * i; const int k = 2 * p + (lane >> 5); const int f = (k & 3) + 4 * ((k >> 3) & 1);
        glds16s(bb_, boff(k, (lane & 31) ^ (f << 1)), (unsigned)__builtin_amdgcn_readfirstlane(lds0 + 32768 + p * 1024)); }
}
template <bool ZERO, class AO, class BO, class NX = NoNextS>
DEV void gemm256s(unsigned char* smem, int nkt, const void* abase, unsigned akstep, const AO& aoff, const void* bbase, unsigned bkstep, const BO& boff, f32x4 (&acc)[8][4], bool pre = false, const NX& next = NX()) {
    const int tid = TID(), lane = tid & 63; const int wid = __builtin_amdgcn_readfirstlane(tid >> 6); const int wr = wid >> 2, wc = wid & 3;
    if (ZERO) {
#pragma unroll
        for (int mi = 0; mi < 8; ++mi)
#pragma unroll
            for (int ni = 0; ni < 4; ++ni) acc[mi][ni] = (f32x4){0.f, 0.f, 0.f, 0.f};
    }
    const unsigned lds0 = (unsigned)(uintptr_t)smem;
    const unsigned char* abase_u = uptr(abase); const unsigned char* bbase_u = uptr(bbase); const unsigned akstep_u = __builtin_amdgcn_readfirstlane(akstep), bkstep_u = __builtin_amdgcn_readfirstlane(bkstep);
    unsigned ao[4], bo[4];
#pragma unroll
    for (int i = 0; i < 4; ++i) { const int p = wid + 8 * i; ao[i] = aoff(8 * p + (lane >> 3), (lane & 7) ^ (lane >> 3));
        const int k = 2 * p + (lane >> 5); const int f = (k & 3) + 4 * ((k >> 3) & 1); bo[i] = boff(k, (lane & 31) ^ (f << 1)); }
#define GL_ISSUE(kt, st) do { const unsigned char* ab_ = abase_u + (size_t)(kt) * akstep_u; const unsigned char* bb_ = bbase_u + (size_t)(kt) * bkstep_u; \
        _Pragma("unroll") for (int i_ = 0; i_ < 4; ++i_) glds16s(ab_, ao[i_], (unsigned)__builtin_amdgcn_readfirstlane(lds0 + (st) * GL_STAGE + (wid + 8 * i_) * 1024)); \
        _Pragma("unroll") for (int i_ = 0; i_ < 4; ++i_) glds16s(bb_, bo[i_], (unsigned)__builtin_amdgcn_readfirstlane(lds0 + (st) * GL_STAGE + 32768 + (wid + 8 * i_) * 1024)); } while (0)
    if (!pre) {
        GL_ISSUE(0, 0);
        asm volatile("s_waitcnt vmcnt(0)" ::: "memory");
        __syncthreads();
    }
    for (int kt = 0; kt < nkt; ++kt) {
        if (kt + 1 < nkt) GL_ISSUE(kt + 1, (kt + 1) & 1); else next();
        const unsigned char* A = smem + (kt & 1) * GL_STAGE; const unsigned char* Bt = A + 32768;
#pragma unroll
        for (int ks = 0; ks < 2; ++ks) {
            bf16x8 wf[4];
#pragma unroll
            for (int ni = 0; ni < 4; ++ni) {
                const int i = lane & 15, g = lane >> 4, q = i >> 2; const int row = ks * 32 + 8 * g + q; const int nc = wc * 8 + ni * 2 + ((i & 3) >> 1); const int f = q + 4 * (g & 1);
                const unsigned char* p = Bt + row * 512 + ((nc ^ (f << 1)) << 4) + (i & 1) * 8;
                const s16x4 lo = tr_read(p), hi = tr_read(p + 4 * 512);
                wf[ni] = (bf16x8){lo[0], lo[1], lo[2], lo[3], hi[0], hi[1], hi[2], hi[3]};
            }
#pragma unroll
            for (int mi = 0; mi < 8; ++mi) {
                const int m = wr * 128 + mi * 16 + (lane & 15); const int kc = ks * 4 + (lane >> 4);
                const bf16x8 af = *(const bf16x8*)(A + m * 128 + ((kc ^ (m & 7)) << 4));
#pragma unroll
                for (int ni = 0; ni < 4; ++ni) acc[mi][ni] = __builtin_amdgcn_mfma_f32_16x16x32_bf16(wf[ni], af, acc[mi][ni], 0, 0, 0);
            }
        }
        asm volatile("s_waitcnt vmcnt(0)" ::: "memory");
        __syncthreads();
    }
#undef GL_ISSUE
}

#define G_ROW(mi) ((((mi) >> 2) * 128) + wr * 64 + (((mi) & 3) * 16) + (lane & 15))
#define G_COL(ni) ((((ni) >> 1) * 128) + wc * 32 + (((ni) & 1) * 16) + 4 * (lane >> 4))
#define WAIT_V(n) asm volatile("s_waitcnt vmcnt(" #n ")" ::: "memory")
#define WAIT_L(n) asm volatile("s_waitcnt lgkmcnt(" #n ")" ::: "memory")
#define BAR() __builtin_amdgcn_s_barrier()
#define SCHED() __builtin_amdgcn_sched_barrier(0)
constexpr int SA_(int b, int h) { return b * GL_STAGE + h * 16384; }
constexpr int SB_(int b, int h) { return b * GL_STAGE + 32768 + h * 16384; }
struct NoNext { DEV bool has() const { return false; } template <int P> DEV void issue() const {} };
template <int WHICH, class AO, class BO>
DEV void gemm_issue0(unsigned char* smem, const void* abase, const AO& aoff, const void* bbase, const BO& boff) {
    const int tid = TID(), lane = tid & 63; const int wid = __builtin_amdgcn_readfirstlane(tid >> 6);
    const unsigned lds0 = (unsigned)(uintptr_t)smem; const unsigned char* ab_ = uptr(abase); const unsigned char* bb_ = uptr(bbase);
#pragma unroll
    for (int h = 0; h < 2; ++h) {
        if (WHICH & (1 << (2 * h))) {
#pragma unroll
            for (int i = 0; i < 2; ++i) { const int p = wid + 8 * i; const int k = 4 * p + (lane >> 4); const int f = (k & 3) + 4 * ((k >> 3) & 1);
                glds16s(bb_, boff(k, h * 16 + ((lane & 15) ^ (f << 1))), (unsigned)__builtin_amdgcn_readfirstlane(lds0 + SB_(0, h) + p * 1024)); } }
        if (WHICH & (2 << (2 * h))) {
#pragma unroll
            for (int i = 0; i < 2; ++i) { const int p = wid + 8 * i;
                glds16s(ab_, aoff(h * 128 + 8 * p + (lane >> 3), (lane & 7) ^ (lane >> 3)), (unsigned)__builtin_amdgcn_readfirstlane(lds0 + SA_(0, h) + p * 1024)); } }
    }
}
template <class AO, class BO>
struct NextTile { bool on; unsigned char* smem; const void* abase; AO aoff; const void* bbase; BO boff;
    DEV bool has() const { return on; }
    template <int P> DEV void issue() const { gemm_issue0<P>(smem, abase, aoff, bbase, boff); } };
template <class AO, class BO> DEV NextTile<AO, BO> next_tile(bool on, unsigned char* smem, const void* abase, const AO& aoff, const void* bbase, const BO& boff) { return NextTile<AO, BO>{on, smem, abase, aoff, bbase, boff}; }
template <bool ZERO, class AO, class BO, class NX = NoNext>
DEV void gemm256(unsigned char* smem, int nkt, const void* abase, unsigned akstep, const AO& aoff, const void* bbase, unsigned bkstep, const BO& boff, f32x4 (&acc)[8][4], bool pre = false, const NX& next = NX()) {
    const int tid = TID(), lane = tid & 63; const int wid = __builtin_amdgcn_readfirstlane(tid >> 6); const int wr = wid >> 2, wc = wid & 3;
    if (ZERO) {
#pragma unroll
        for (int mi = 0; mi < 8; ++mi)
#pragma unroll
            for (int ni = 0; ni < 4; ++ni) acc[mi][ni] = (f32x4){0.f, 0.f, 0.f, 0.f};
    }
    const unsigned lds0 = (unsigned)(uintptr_t)smem;
    const unsigned char* abase_u = uptr(abase); const unsigned char* bbase_u = uptr(bbase); const unsigned akstep_u = __builtin_amdgcn_readfirstlane(akstep), bkstep_u = __builtin_amdgcn_readfirstlane(bkstep);
    unsigned ao[4], bo[4];
#pragma unroll
    for (int h = 0; h < 2; ++h)
#pragma unroll
        for (int i = 0; i < 2; ++i) { const int p = wid + 8 * i; ao[h * 2 + i] = aoff(h * 128 + 8 * p + (lane >> 3), (lane & 7) ^ (lane >> 3));
            const int k = 4 * p + (lane >> 4); const int f = (k & 3) + 4 * ((k >> 3) & 1); bo[h * 2 + i] = boff(k, h * 16 + ((lane & 15) ^ (f << 1))); }
    const unsigned char* ard0; const unsigned char* ard1; const unsigned char* brd0; const unsigned char* brd1;
    { const int l15 = lane & 15, g = lane >> 4, q = l15 >> 2; const int f = q + 4 * (g & 1);
      ard0 = smem + (wr * 64 + l15) * 128 + ((g ^ (lane & 7)) << 4); ard1 = smem + (wr * 64 + l15) * 128 + (((4 + g) ^ (lane & 7)) << 4);
      const int nc = wc * 4 + ((l15 & 3) >> 1); const int kr = 8 * g + q;
      brd0 = smem + kr * 256 + ((nc ^ (f << 1)) << 4) + (l15 & 1) * 8; brd1 = smem + kr * 256 + (((nc + 2) ^ (f << 1)) << 4) + (l15 & 1) * 8; }
#define ST_A(b, h, kt) do { const unsigned char* ab_ = abase_u + (size_t)(kt) * akstep_u; \
        _Pragma("unroll") for (int i_ = 0; i_ < 2; ++i_) glds16s(ab_, ao[(h) * 2 + i_], (unsigned)__builtin_amdgcn_readfirstlane(lds0 + SA_(b, h) + (wid + 8 * i_) * 1024)); } while (0)
#define ST_B(b, h, kt) do { const unsigned char* bb_ = bbase_u + (size_t)(kt) * bkstep_u; \
        _Pragma("unroll") for (int i_ = 0; i_ < 2; ++i_) glds16s(bb_, bo[(h) * 2 + i_], (unsigned)__builtin_amdgcn_readfirstlane(lds0 + SB_(b, h) + (wid + 8 * i_) * 1024)); } while (0)
#define LDA(dst, b, h) do { _Pragma("unroll") for (int m_ = 0; m_ < 4; ++m_) { dst[m_][0] = *(const bf16x8*)(ard0 + SA_(b, h) + m_ * 2048); dst[m_][1] = *(const bf16x8*)(ard1 + SA_(b, h) + m_ * 2048); } } while (0)
#define LDB(dst, b, h) do { _Pragma("unroll") for (int n_ = 0; n_ < 2; ++n_) _Pragma("unroll") for (int k_ = 0; k_ < 2; ++k_) { const unsigned char* p_ = (n_ ? brd1 : brd0) + SB_(b, h) + k_ * 8192; \
        const s16x4 lo_ = tr_read(p_), hi_ = tr_read(p_ + 1024); dst[n_][k_] = (bf16x8){lo_[0], lo_[1], lo_[2], lo_[3], hi_[0], hi_[1], hi_[2], hi_[3]}; } } while (0)
#define MMA(ai, bj, Bx) do { __builtin_amdgcn_s_setprio(1); \
        _Pragma("unroll") for (int k_ = 0; k_ < 2; ++k_) _Pragma("unroll") for (int m_ = 0; m_ < 4; ++m_) _Pragma("unroll") for (int n_ = 0; n_ < 2; ++n_) \
            acc[(ai) * 4 + m_][(bj) * 2 + n_] = __builtin_amdgcn_mfma_f32_16x16x32_bf16(Bx[n_][k_], At[m_][k_], acc[(ai) * 4 + m_][(bj) * 2 + n_], 0, 0, 0); \
        __builtin_amdgcn_s_setprio(0); } while (0)
    bf16x8 At[4][2], B0[2][2], B1[2][2];
    if (!pre) { ST_B(0, 0, 0); ST_A(0, 0, 0); ST_B(0, 1, 0); ST_A(0, 1, 0); }
    if (wr == 1) BAR();
    if (!pre) WAIT_V(4);
    BAR();
    ST_B(1, 0, 1); ST_A(1, 0, 1); ST_B(1, 1, 1);
    if (!pre) WAIT_V(6);
    BAR();
    for (int t = 0; t < nkt - 2; t += 2) {
        LDB(B0, 0, 0); SCHED(); LDA(At, 0, 0); ST_A(1, 1, t + 1);
        WAIT_L(8); BAR(); WAIT_L(0); MMA(0, 0, B0); BAR(); SCHED();
        LDB(B1, 0, 1); ST_B(0, 0, t + 2);
        BAR(); WAIT_L(0); MMA(0, 1, B1); BAR();
        LDA(At, 0, 1); ST_A(0, 0, t + 2);
        BAR(); WAIT_L(0); MMA(1, 0, B0); BAR(); SCHED();
        ST_B(0, 1, t + 2);
        WAIT_V(6); BAR(); MMA(1, 1, B1); BAR();
        LDB(B0, 1, 0); SCHED(); LDA(At, 1, 0); ST_A(0, 1, t + 2);
        WAIT_L(8); BAR(); WAIT_L(0); MMA(0, 0, B0); BAR(); SCHED();
        LDB(B1, 1, 1); ST_B(1, 0, t + 3);
        BAR(); WAIT_L(0); MMA(0, 1, B1); BAR();
        LDA(At, 1, 1); ST_A(1, 0, t + 3);
        BAR(); WAIT_L(0); MMA(1, 0, B0); BAR(); SCHED();
        ST_B(1, 1, t + 3);
        WAIT_V(6); BAR(); MMA(1, 1, B1); BAR();
    }
    const bool hn = next.has();
    LDB(B0, 0, 0); LDA(At, 0, 0); ST_A(1, 1, nkt - 1);
    BAR(); WAIT_L(0); MMA(0, 0, B0); BAR();
    LDB(B1, 0, 1); BAR(); WAIT_L(0); MMA(0, 1, B1); BAR();
    LDA(At, 0, 1);
    if (hn) { next.template issue<3>(); WAIT_V(8); } else WAIT_V(4);
    BAR(); WAIT_L(0); MMA(1, 0, B0); MMA(1, 1, B1); BAR();
    LDB(B0, 1, 0); LDA(At, 1, 0);
    if (hn) { next.template issue<4>(); WAIT_V(8); } else WAIT_V(2);
    BAR(); WAIT_L(0); MMA(0, 0, B0); BAR();
    LDB(B1, 1, 1);
    if (hn) { next.template issue<8>(); WAIT_V(8); } else WAIT_V(0);
    BAR(); WAIT_L(0); MMA(0, 1, B1); BAR();
    LDA(At, 1, 1); BAR(); WAIT_L(0); MMA(1, 0, B0); MMA(1, 1, B1);
    WAIT_V(0);
    BAR();
    if (wr == 0) BAR();
#undef ST_A
#undef ST_B
#undef LDA
#undef LDB
#undef MMA
}

#define EPI_IDS() do { const int etid_ = TID(); lane = etid_ & 63; wid = etid_ >> 6; wr = wid >> 2; wc = wid & 3; } while (0)

DEV void patch_decode(int local, int MT, int NT, int& mt, int& nt) {
    const int per_mtb = 8 * NT; const int mtb = local / per_mtb; const int rem = local - mtb * per_mtb;
    const int rows = (MT - 8 * mtb) < 8 ? (MT - 8 * mtb) : 8;
    const int per_ntb = rows * 8; const int nfull = NT >> 3; int ntb = rem / per_ntb; int cols = 8;
    if (ntb >= nfull) { ntb = nfull; cols = NT - 8 * nfull; }
    const int r2 = rem - ntb * per_ntb;
    mt = 8 * mtb + r2 / cols; nt = 8 * ntb + r2 % cols;
}

DEV void convert_chunk(const float* src, bf16_t* dst, size_t i8) {
    const float4 a = *(const float4*)(src + i8 * 8), b = *(const float4*)(src + i8 * 8 + 4);
    uint4 o; o.x = cvtpk(a.x, a.y); o.y = cvtpk(a.z, a.w); o.z = cvtpk(b.x, b.y); o.w = cvtpk(b.z, b.w);
    *(uint4*)(dst + i8 * 8) = o;
}
DEV void phase_prologue(const Args& a, unsigned char* smem) {
    unsigned char* ws = a.ws;
    const size_t gtid = (size_t)BID() * NTHR + TID(), gn = (size_t)gridDim.x * NTHR;
    {
        { const float* W = a.in[I_WOUT]; bf16_t* O = (bf16_t*)(ws + WS_WOUT); const float* gnn = a.in[I_GNN]; const float* gnf = a.in[I_GNF];
          for (size_t i = gtid; i < (size_t)1024 * 128; i += gn) { const int k = (int)(i >> 7); const float g_ = k < 512 ? gnn[k] : gnf[k - 512];
              const float4 x = *(const float4*)(W + i * 8), y = *(const float4*)(W + i * 8 + 4);
              uint4 o; o.x = cvtpk(x.x * g_, x.y * g_); o.y = cvtpk(x.z * g_, x.w * g_); o.z = cvtpk(y.x * g_, y.y * g_); o.w = cvtpk(y.z * g_, y.w * g_); *(uint4*)(O + i * 8) = o; } }
        const float* srcs[3] = {a.in[I_WGATE], a.in[I_WPLE], a.in[I_P]};
        bf16_t* dsts[3] = {(bf16_t*)(ws + WS_WGATE), (bf16_t*)(ws + WS_WPLE), (bf16_t*)(ws + WS_PB)};
        const size_t cnt8[3] = {1024 * 1024 / 8, 256 * 1024 / 8, (size_t)NTOK * 256 / 8};
#pragma unroll
        for (int s = 0; s < 3; ++s) for (size_t i = gtid; i < cnt8[s]; i += gn) convert_chunk(srcs[s], dsts[s], i);
        for (size_t i = gtid; i < (size_t)2 * 2048 * 32; i += gn) { const int which = (int)(i / (2048 * 32)); const int k = (int)(i / 32) % 2048, c8 = (int)(i % 32) * 8;
            uint4 o = {0u, 0u, 0u, 0u};
            if (c8 < 128) { const float* W = a.in[which ? I_WC1V : I_WC1K] + (size_t)k * 128 + c8; const float4 x = *(const float4*)W, y = *(const float4*)(W + 4); o.x = cvtpk(x.x, x.y); o.y = cvtpk(x.z, x.w); o.z = cvtpk(y.x, y.y); o.w = cvtpk(y.z, y.w); }
            *(uint4*)((bf16_t*)(ws + WS_WC1) + i * 8) = o; }
        for (size_t i = gtid; i < (size_t)2 * 128 * 32; i += gn) { const int which = (int)(i / (128 * 32)); const int k = (int)(i / 32) % 128, c8 = (int)(i % 32) * 8;
            uint4 o = {0u, 0u, 0u, 0u};
            if (c8 < 64) { const float* W = a.in[which ? I_WC2V : I_WC2K] + (size_t)k * 64 + c8; const float4 x = *(const float4*)W, y = *(const float4*)(W + 4); o.x = cvtpk(x.x, x.y); o.y = cvtpk(x.z, x.w); o.z = cvtpk(y.x, y.y); o.w = cvtpk(y.z, y.w); }
            *(uint4*)((bf16_t*)(ws + WS_WC2) + i * 8) = o; }
    }
    {
        const float* W = a.in[I_WIN]; bf16_t* O = (bf16_t*)(ws + WS_WIN);
        for (size_t i = gtid; i < (size_t)1024 * (NWIN / 8); i += gn) {
            const int k = (int)(i / (NWIN / 8)), j = (int)(i % (NWIN / 8)) * 8;
            uint4 o = {0u, 0u, 0u, 0u};
            if (j < 2848) {
                const int sj = (j < 1280) ? j : (j < 2816) ? j + 24 : (j < 2840) ? j - 1536 : j;
                const float4 x = *(const float4*)(W + (size_t)k * 2848 + sj), y = *(const float4*)(W + (size_t)k * 2848 + sj + 4);
                o.x = cvtpk(x.x, x.y); o.y = cvtpk(x.z, x.w); o.z = cvtpk(y.x, y.y); o.w = cvtpk(y.z, y.w);
            }
            *(uint4*)(O + (size_t)k * NWIN + j) = o;
        }
    }
    const int lane = TID() & 63; const int gw = BID() * NWAVE + (TID() >> 6), ngw = gridDim.x * NWAVE;
    {
        const float* X = a.in[I_X]; const float* g = a.in[I_LN1]; bf16_t* XN = (bf16_t*)(ws + WS_XN);
        for (int m = gw; m < NTOK; m += ngw) {
            float4 v[4]; float s = 0.f;
#pragma unroll
            for (int j = 0; j < 4; ++j) { v[j] = *(const float4*)(X + (size_t)m * 1024 + j * 256 + lane * 4); s += v[j].x * v[j].x + v[j].y * v[j].y + v[j].z * v[j].z + v[j].w * v[j].w; }
            const float rstd = rsqrtf(wave_sum(s) * (1.f / 1024.f) + EPS);
#pragma unroll
            for (int j = 0; j < 4; ++j) { const float4 gg = *(const float4*)(g + j * 256 + lane * 4);
                uint2 o; o.x = cvtpk(v[j].x * rstd * gg.x, v[j].y * rstd * gg.y); o.y = cvtpk(v[j].z * rstd * gg.z, v[j].w * rstd * gg.w);
                *(uint2*)(XN + (size_t)m * 1024 + j * 256 + lane * 4) = o; }
        }
    }
    if (gw < 256) {
        const int which = gw >> 7, n = gw & 127; const float* pe = a.in[which ? I_PEV : I_PEK]; const float* w1 = a.in[which ? I_WC1V : I_WC1K];
        float s = 0.f;
#pragma unroll 8
        for (int i = 0; i < 32; ++i) { const int k = lane + 64 * i; s += pe[k] * w1[(size_t)k * 128 + n]; }
        s = wave_sum(s);
        if (lane == 0) ((float*)(ws + WS_BIAS1))[which * 128 + n] = s;
    }
}

DEV void phase_inproj(const Args& a, unsigned char* smem) {
    const bf16_t* XN = (const bf16_t*)(a.ws + WS_XN); const bf16_t* W = (const bf16_t*)(a.ws + WS_WIN);
    bf16_t* PROJ = (bf16_t*)(a.ws + WS_PROJ); float* GN = (float*)(a.ws + WS_GN); float* LS = (float*)(a.ws + WS_LS); const float* bfg = a.in[I_BFG];
    int lane = TID() & 63, wid = TID() >> 6, wr = wid >> 2, wc = wid & 3; (void)wr; (void)wc; (void)lane;
    bool pre = false;
    for (int item = VBID(); item < 64 * 12; item += gridDim.x) {
        int mt, nt; patch_decode(item, 64, 12, mt, nt);
        const int nitem = item + (int)gridDim.x; const bool has_next = nitem < 64 * 12; int mtn = 0, ntn = 0; if (has_next) patch_decode(nitem, 64, 12, mtn, ntn);
        f32x4 acc[8][4];
        auto aoffi = [](int r, int kc) { return (unsigned)(r * 2048 + kc * 16); }; auto boffi = [](int k, int nc) { return (unsigned)(k * (NWIN * 2) + nc * 16); };
        gemm256<true>(smem, 16, XN + (size_t)mt * 256 * 1024, 128u, aoffi, W + nt * 256, (unsigned)(64 * NWIN * 2), boffi, acc, pre,
                      next_tile(has_next, smem, XN + (size_t)mtn * 256 * 1024, aoffi, W + ntn * 256, boffi));
        pre = has_next;
        EPI_IDS();
#pragma unroll
        for (int mi = 0; mi < 8; ++mi) {
            const int gm = mt * 256 + G_ROW(mi); const int b = gm >> 13, t = gm & 8191;
#pragma unroll
            for (int ni = 0; ni < 4; ++ni) {
                const int n = G_COL(ni); const f32x4 v = acc[mi][ni];
                if (nt < 11) {
                    const int hs = nt * 4 + (n >> 6), d = n & 63; const float sc = (hs < 8 || (hs >= 20 && hs < 28)) ? QS : 1.0f;
                    uint2 o; o.x = cvtpk(v[0] * sc, v[1] * sc); o.y = cvtpk(v[2] * sc, v[3] * sc);
                    *(uint2*)(PROJ + (((size_t)(hs * 2 + b)) * 8192 + t) * 64 + d) = o;
                } else if (n < 24) {
#pragma unroll
                    for (int r = 0; r < 4; ++r) GN[(size_t)gm * 24 + n + r] = sigmoidf_(v[r]);
                } else if (n < 32) {
#pragma unroll
                    for (int r = 0; r < 4; ++r) { const int h = n - 24 + r; LS[((size_t)(b * 8 + h)) * 8192 + t] = logsigmoidf_(v[r] + bfg[h]); }
                }
            }
        }
    }
}

DEV void signal_done(unsigned* flag) {
    asm volatile("s_waitcnt vmcnt(0)" ::: "memory");
    __syncthreads();
    if (TID() == 0) { __builtin_amdgcn_fence(__ATOMIC_RELEASE, "agent"); asm volatile("s_waitcnt vmcnt(0)" ::: "memory"); __hip_atomic_fetch_add(flag, 1u, __ATOMIC_RELAXED, __HIP_MEMORY_SCOPE_AGENT); }
}
DEV void wait_flag(unsigned* flag, unsigned target) {
    if (TID() == 0) { unsigned sp = 0u; while (__hip_atomic_load(flag, __ATOMIC_RELAXED, __HIP_MEMORY_SCOPE_AGENT) < target) { __builtin_amdgcn_s_sleep(4); if (++sp > (1u << 24)) break; }
        __builtin_amdgcn_fence(__ATOMIC_ACQUIRE, "agent"); asm volatile("s_waitcnt vmcnt(0)" ::: "memory"); }
    __syncthreads();
}
constexpr int CW_CUMFLAG = 128, CW_CMPFLAG = 192, CW_GATEFLAG = 256;
DEV void cmp_item(const Args& a, unsigned char* smem, int item) {
    const bf16_t* PROJ = (const bf16_t*)(a.ws + WS_PROJ);
    const int tid = TID(); int lane = tid & 63, wid = tid >> 6, wr = wid >> 2, wc = wid & 3; (void)wr; (void)wc; (void)lane;
    {
        if (item < 16) {
            const int which = item >> 3, b = (item >> 2) & 1, g = (item >> 1) & 1, mt = item & 1;
            const bf16_t* base = PROJ + ((size_t)((8 + 2 * which + g) * 2 + b)) * 8192 * 64;
            const bf16_t* W1 = (const bf16_t*)(a.ws + WS_WC1) + (size_t)which * 2048 * 256;
            const bf16_t* W2 = (const bf16_t*)(a.ws + WS_WC2) + (size_t)which * 128 * 256;
            const float* bias1 = (const float*)(a.ws + WS_BIAS1) + which * 128;
            bf16_t* HID = (bf16_t*)(a.ws + WS_HID) + ((size_t)(which * 4 + b * 2 + g)) * 512 * 128;
            bf16_t* OUT = (bf16_t*)(a.ws + WS_KC) + ((size_t)(which * 4 + b * 2 + g)) * 512 * 64;
            f32x4 acc[8][4];
            gemm256s<true>(smem, 32, base, 128u, [&](int r, int kc) { int c = mt * 256 + r; c = c > 510 ? 510 : c; return (unsigned)(c * 2048 + kc * 16); },
                          W1, 64u * 512u, [&](int k, int nc) { return (unsigned)(k * 512 + nc * 16); }, acc);
        EPI_IDS();
            if (wc < 2) {
#pragma unroll
                for (int mi = 0; mi < 8; ++mi) { const int c = mt * 256 + wr * 128 + mi * 16 + (lane & 15);
#pragma unroll
                    for (int ni = 0; ni < 4; ++ni) { const int n = wc * 64 + ni * 16 + 4 * (lane >> 4); const f32x4 v = acc[mi][ni]; const float4 bb = *(const float4*)(bias1 + n);
                        uint2 o; o.x = cvtpk(gelu_tanh(v[0] + bb.x), gelu_tanh(v[1] + bb.y)); o.y = cvtpk(gelu_tanh(v[2] + bb.z), gelu_tanh(v[3] + bb.w));
                        *(uint2*)(HID + (size_t)c * 128 + n) = o; } }
            }
            __syncthreads();
            gemm256s<true>(smem, 2, HID + (size_t)mt * 256 * 128, 128u, [&](int r, int kc) { return (unsigned)(r * 256 + kc * 16); },
                          W2, 64u * 512u, [&](int k, int nc) { return (unsigned)(k * 512 + nc * 16); }, acc);
        EPI_IDS();
            if (wc == 0) {
#pragma unroll
                for (int mi = 0; mi < 8; ++mi) { const int c = mt * 256 + wr * 128 + mi * 16 + (lane & 15);
#pragma unroll
                    for (int ni = 0; ni < 4; ++ni) { const int n = ni * 16 + 4 * (lane >> 4); const f32x4 v = acc[mi][ni];
                        uint2 o; o.x = cvtpk(v[0], v[1]); o.y = cvtpk(v[2], v[3]);
                        if (c >= 511) { o.x = 0u; o.y = 0u; }
                        *(uint2*)(OUT + (size_t)c * 64 + n) = o; } }
            }
            signal_done((unsigned*)(a.ws + WS_CTL) + CW_CMPFLAG);
        } else {
            const int bh = item - 16; const float* LS = (const float*)(a.ws + WS_LS) + (size_t)bh * 8192; float* CUM = (float*)(a.ws + WS_CUM) + (size_t)bh * 8192;
            float* sc = (float*)smem;
            float v[16]; float s = 0.f;
#pragma unroll
            for (int j = 0; j < 4; ++j) { const float4 x = *(const float4*)(LS + tid * 16 + j * 4); v[4 * j] = x.x; v[4 * j + 1] = x.y; v[4 * j + 2] = x.z; v[4 * j + 3] = x.w; }
#pragma unroll
            for (int j = 0; j < 16; ++j) { s += v[j]; v[j] = s; }
            sc[tid] = s; __syncthreads();
            if (tid == 0) { float run = 0.f; for (int i = 0; i < NTHR; ++i) { const float x = sc[i]; sc[i] = run; run += x; } }
            __syncthreads();
            const float off = sc[tid];
#pragma unroll
            for (int j = 0; j < 4; ++j) { float4 o = {v[4 * j] + off, v[4 * j + 1] + off, v[4 * j + 2] + off, v[4 * j + 3] + off}; *(float4*)(CUM + tid * 16 + j * 4) = o; }
            signal_done((unsigned*)(a.ws + WS_CTL) + CW_CUMFLAG + bh);
        }
    }
}

constexpr int AT_STAGE = 16384;
constexpr int AT_BIAS_OFF = 3 * AT_STAGE;
constexpr int AT_IMP_OFF = AT_BIAS_OFF + 1024;
constexpr int AT_SEL_OFF = AT_IMP_OFF + 65536;
constexpr int AT_WUN_OFF = AT_SEL_OFF + 1024;
constexpr int AT_UCNT_OFF = AT_WUN_OFF + 128;
constexpr int AT_ULIST_OFF = AT_UCNT_OFF + 16;
constexpr int AT_ITEM_OFF = AT_ULIST_OFF + 128;
static_assert(AT_ITEM_OFF + 16 <= GEMM_LDS, "attention LDS map");
#define NEG_INF (-__builtin_inff())

#define KV_DECL uint4 rk0_, rv0_
#define KV_GLOAD(Kt, Vt) do { rk0_ = *(const uint4*)((Kt) + tid * 8); rv0_ = *(const uint4*)((Vt) + tid * 8); } while (0)
#define KV_LSTORE(stp) do { unsigned char* st_ = (stp); const int key = tid >> 3, ch = tid & 7; \
      *(uint4*)(st_ + key * 128 + ((ch ^ (key & 7)) << 4)) = rk0_; \
      *(uint4*)(st_ + 8192 + key * 128 + ((((ch >> 2) ^ ((key >> 1) & 1))) << 6) + ((ch & 3) << 4)) = rv0_; } while (0)
template <bool FULL>
DEV void qk_tile(const unsigned char* Kst, const bf16x8 (&qf)[4], f32x16& p0, f32x16& p1, int lane) {
    const int key = lane & 31, hi = lane >> 5;
    if (FULL) {
        bf16x8 k0[4], k1[4];
#pragma unroll
        for (int ks = 0; ks < 4; ++ks) { const int ch = 2 * ks + hi; const int off = key * 128 + ((ch ^ (key & 7)) << 4);
            k0[ks] = *(const bf16x8*)(Kst + off); k1[ks] = *(const bf16x8*)(Kst + off + 32 * 128); }
        __builtin_amdgcn_sched_barrier(0);
#pragma unroll
        for (int ks = 0; ks < 4; ++ks) {
            p0 = __builtin_amdgcn_mfma_f32_32x32x16_bf16(k0[ks], qf[ks], p0, 0, 0, 0);
            p1 = __builtin_amdgcn_mfma_f32_32x32x16_bf16(k1[ks], qf[ks], p1, 0, 0, 0); }
    } else {
        bf16x8 kk[4];
#pragma unroll
        for (int ks = 0; ks < 4; ++ks) { const int ch = 2 * ks + hi; kk[ks] = *(const bf16x8*)(Kst + key * 128 + ((ch ^ (key & 7)) << 4)); }
        __builtin_amdgcn_sched_barrier(0);
#pragma unroll
        for (int ks = 0; ks < 4; ++ks) p0 = __builtin_amdgcn_mfma_f32_32x32x16_bf16(kk[ks], qf[ks], p0, 0, 0, 0);
        __builtin_amdgcn_sched_barrier(0);
#pragma unroll
        for (int ks = 0; ks < 4; ++ks) { const int ch = 2 * ks + hi; kk[ks] = *(const bf16x8*)(Kst + key * 128 + ((ch ^ (key & 7)) << 4) + 32 * 128); }
        __builtin_amdgcn_sched_barrier(0);
#pragma unroll
        for (int ks = 0; ks < 4; ++ks) p1 = __builtin_amdgcn_mfma_f32_32x32x16_bf16(kk[ks], qf[ks], p1, 0, 0, 0);
    }
}
template <bool FULL>
DEV void pv_tile(const unsigned char* Vst, const f32x16& p0, const f32x16& p1, f32x16 (&o)[2], int lane) {
    const int hi = lane >> 5, i = lane & 15, gg = (lane >> 4) & 1;
    const int q = i >> 2; const int sw = (q >> 1) & 1;
    bf16x8 pa[4];
#pragma unroll
    for (int s = 0; s < 4; ++s) { const f32x16& p = (s < 2) ? p0 : p1; const int b = (s & 1) * 8;
        unsigned w[4];
#pragma unroll
        for (int j = 0; j < 4; ++j) w[j] = cvtpk(p[b + 2 * j], p[b + 2 * j + 1]);
        typedef unsigned u32x4_t __attribute__((ext_vector_type(4)));
        u32x4_t ww = {w[0], w[1], w[2], w[3]}; pa[s] = __builtin_bit_cast(bf16x8, ww); }
    constexpr int NB = FULL ? 1 : 2, SB = FULL ? 4 : 2;
#pragma unroll
    for (int bt = 0; bt < NB; ++bt) {
        s16x4 vlo[SB][2], vhi[SB][2];
#pragma unroll
        for (int s_ = 0; s_ < SB; ++s_)
#pragma unroll
            for (int dh = 0; dh < 2; ++dh) { const int s = bt * SB + s_; const int row0 = 16 * s + 4 * hi + q;
                const unsigned char* p = Vst + row0 * 128 + ((dh ^ sw) << 6) + gg * 32 + (i & 3) * 8;
                vlo[s_][dh] = tr_read(p); vhi[s_][dh] = tr_read(p + 8 * 128); }
        __builtin_amdgcn_sched_barrier(0);
#pragma unroll
        for (int s_ = 0; s_ < SB; ++s_)
#pragma unroll
            for (int dh = 0; dh < 2; ++dh) { const int s = bt * SB + s_;
                const bf16x8 vf = {vlo[s_][dh][0], vlo[s_][dh][1], vlo[s_][dh][2], vlo[s_][dh][3], vhi[s_][dh][0], vhi[s_][dh][1], vhi[s_][dh][2], vhi[s_][dh][3]};
                o[dh] = __builtin_amdgcn_mfma_f32_32x32x16_bf16(vf, pa[s], o[dh], 0, 0, 0); }
        __builtin_amdgcn_sched_barrier(0);
    }
}
DEV float rowmax32(const f32x16& p0, const f32x16& p1) {
    float a = fmaxf(p0[0], p1[0]), b = fmaxf(p0[1], p1[1]);
#pragma unroll
    for (int r = 2; r < 16; r += 2) { a = fmaxf(fmaxf(a, p0[r]), p1[r]); b = fmaxf(fmaxf(b, p0[r + 1]), p1[r + 1]); }
    return pair_max(fmaxf(a, b));
}
DEV void softmax_step(f32x16& p0, f32x16& p1, float& m, float& l, f32x16 (&o)[2]) {
    const float mt = rowmax32(p0, p1); const float mn = fmaxf(m, mt); const float alpha = __builtin_amdgcn_exp2f(m - mn);
    float rs = 0.f;
#pragma unroll
    for (int r = 0; r < 16; ++r) { p0[r] = __builtin_amdgcn_exp2f(p0[r] - mn); p1[r] = __builtin_amdgcn_exp2f(p1[r] - mn); rs += p0[r] + p1[r]; }
    rs = pair_sum(rs);
    l = l * alpha + rs; m = mn;
    if (__any(alpha != 1.0f)) { o[0] *= alpha; o[1] *= alpha; }
}
DEV void softmax_step_nosum(f32x16& p0, f32x16& p1, float& m, f32x16 (&o)[2], f32x16& lacc) {
    const float mt = rowmax32(p0, p1); const float mn = fmaxf(m, mt); const float alpha = __builtin_amdgcn_exp2f(m - mn);
#pragma unroll
    for (int r = 0; r < 16; ++r) { p0[r] = __builtin_amdgcn_exp2f(p0[r] - mn); p1[r] = __builtin_amdgcn_exp2f(p1[r] - mn); }
    m = mn;
    if (__any(alpha != 1.0f)) { o[0] *= alpha; o[1] *= alpha; lacc *= alpha; }
}
DEV void pv_tile_sum(const unsigned char* Vst, const f32x16& p0, const f32x16& p1, f32x16 (&o)[2], f32x16& lacc, int lane) {
    const int hi = lane >> 5, i = lane & 15, gg = (lane >> 4) & 1;
    const int q = i >> 2; const int sw = (q >> 1) & 1;
    bf16x8 pa[4];
#pragma unroll
    for (int s = 0; s < 4; ++s) { const f32x16& p = (s < 2) ? p0 : p1; const int b = (s & 1) * 8;
        unsigned w[4];
#pragma unroll
        for (int j = 0; j < 4; ++j) w[j] = cvtpk(p[b + 2 * j], p[b + 2 * j + 1]);
        typedef unsigned u32x4_t __attribute__((ext_vector_type(4)));
        u32x4_t ww = {w[0], w[1], w[2], w[3]}; pa[s] = __builtin_bit_cast(bf16x8, ww); }
    const bf16x8 ones = {0x3f80, 0x3f80, 0x3f80, 0x3f80, 0x3f80, 0x3f80, 0x3f80, 0x3f80};
#pragma unroll
    for (int bt = 0; bt < 2; ++bt) {
        s16x4 vlo[2][2], vhi[2][2];
#pragma unroll
        for (int s_ = 0; s_ < 2; ++s_)
#pragma unroll
            for (int dh = 0; dh < 2; ++dh) { const int s = bt * 2 + s_; const int row0 = 16 * s + 4 * hi + q;
                const unsigned char* p = Vst + row0 * 128 + ((dh ^ sw) << 6) + gg * 32 + (i & 3) * 8;
                vlo[s_][dh] = tr_read(p); vhi[s_][dh] = tr_read(p + 8 * 128); }
        __builtin_amdgcn_sched_barrier(0);
#pragma unroll
        for (int s_ = 0; s_ < 2; ++s_) { const int s = bt * 2 + s_;
            lacc = __builtin_amdgcn_mfma_f32_32x32x16_bf16(ones, pa[s], lacc, 0, 0, 0);
#pragma unroll
            for (int dh = 0; dh < 2; ++dh) {
                const bf16x8 vf = {vlo[s_][dh][0], vlo[s_][dh][1], vlo[s_][dh][2], vlo[s_][dh][3], vhi[s_][dh][0], vhi[s_][dh][1], vhi[s_][dh][2], vhi[s_][dh][3]};
                o[dh] = __builtin_amdgcn_mfma_f32_32x32x16_bf16(vf, pa[s], o[dh], 0, 0, 0); } }
        __builtin_amdgcn_sched_barrier(0);
    }
}
template <int STRIDE> DEV void mask_tile(f32x16& p0, f32x16& p1, int kpos0, int lo, int hi_lim, int hi) {
#pragma unroll
    for (int r = 0; r < 16; ++r) { const int kp = kpos0 + STRIDE * crow(r, hi);
        if (kp < lo || kp > hi_lim) p0[r] = NEG_INF;
        const int kp1 = kp + 32 * STRIDE; if (kp1 < lo || kp1 > hi_lim) p1[r] = NEG_INF; }
}
template <int STRIDE> DEV void alibi_init(f32x16& p0, f32x16& p1, float slope2, int kpos0, int tref, int hi) {
    const float base = slope2 * (float)(kpos0 - tref + STRIDE * 4 * hi);
#pragma unroll
    for (int r = 0; r < 16; ++r) { const float c = (float)(STRIDE * ((r & 3) + 8 * (r >> 2))); p0[r] = fmaf(slope2, c, base); p1[r] = fmaf(slope2, c + (float)(32 * STRIDE), base); }
}
template <class Src, class Body, class NSrc>
DEV int kv_pipeline(unsigned char* smem, int n, const Src& src, const Body& body, int par, bool pre, bool has_next, const NSrc& nsrc) {
    KV_DECL; const int tid = TID(); const bf16_t *kp, *vp;
    if (!pre) { src(0, kp, vp); KV_GLOAD(kp, vp); KV_LSTORE(smem + par * AT_STAGE); __syncthreads(); }
    for (int j = 0; j < n; ++j) {
        const bool more = j + 1 < n; const bool ld = more || has_next;
        if (more) { src(j + 1, kp, vp); KV_GLOAD(kp, vp); } else if (has_next) { nsrc(kp, vp); KV_GLOAD(kp, vp); }
        body(j, smem + ((par + j) & 1) * AT_STAGE);
        if (ld) KV_LSTORE(smem + ((par + j + 1) & 1) * AT_STAGE);
        __syncthreads();
    }
    return (par + n) & 1;
}
struct NoSrc { DEV void operator()(const bf16_t*&, const bf16_t*&) const {} };

constexpr int CV_PER_STEP = 373; constexpr int CV_NUP = 32 * 1024 * 2048 / 8, CV_NDN = 32 * 1024 * 1024 / 8;
static_assert((long long)33792 * CV_PER_STEP >= (long long)CV_NUP + CV_NDN, "conversion coverage");
DEV void fox_item(const Args& a, unsigned char* smem, int fi, int b, int h, int qb) {
    const int tid = TID(), lane = tid & 63, wid = tid >> 6, r32 = lane & 31, hi = lane >> 5;
    const bf16_t* PROJ = (const bf16_t*)(a.ws + WS_PROJ);
    const bf16_t* Q = PROJ + ((size_t)((20 + h) * 2 + b)) * 8192 * 64; const bf16_t* K = PROJ + ((size_t)((28 + h) * 2 + b)) * 8192 * 64; const bf16_t* V = PROJ + ((size_t)((36 + h) * 2 + b)) * 8192 * 64;
    const float* CUM = (const float*)(a.ws + WS_CUM) + (size_t)(b * 8 + h) * 8192;
    const int q0 = qb * 256; const int qrow = q0 + 32 * wid + r32;
    bf16x8 qf[4];
#pragma unroll
    for (int ks = 0; ks < 4; ++ks) qf[ks] = *(const bf16x8*)(Q + (size_t)qrow * 64 + 16 * ks + 8 * hi);
    const float cref = CUM[q0];
    const int ntiles = 4 * qb + 4; const int jmax_w = (q0 + 32 * wid + 31) >> 6; const int jmask_w = (q0 + 32 * wid) >> 6;
    f32x16 o[2]; o[0] = (f32x16){}; o[1] = (f32x16){}; f32x16 lacc = (f32x16){}; float m = -1e30f;
    float* biasL = (float*)(smem + AT_BIAS_OFF);
    const int gq_ = fi >> 4; const int sidx0 = 16 * (128 * gq_ - 2 * gq_ * (gq_ - 1)) + (fi & 15) * (128 - 4 * gq_);
    bf16_t* cvdA = nullptr; bf16_t* cvdB = nullptr; float4 cvaA, cvbA, cvaB, cvbB;
    KV_DECL; float breg = 0.f;
#define TJ(s_) (ntiles - 1 - (s_))
    KV_GLOAD(K + (size_t)TJ(0) * 4096, V + (size_t)TJ(0) * 4096); if (tid < 64) breg = (cref - CUM[TJ(0) * 64 + tid]) * LOG2E;
    KV_LSTORE(smem); if (tid < 64) biasL[tid] = breg;
    KV_GLOAD(K + (size_t)TJ(1) * 4096, V + (size_t)TJ(1) * 4096); if (tid < 64) breg = (cref - CUM[TJ(1) * 64 + tid]) * LOG2E;
    KV_LSTORE(smem + AT_STAGE); if (tid < 64) biasL[64 + tid] = breg;
    __syncthreads();
#define FOX_QK(P0, P1, jj, sj) do { const float* bl_ = biasL + (sj) * 64; \
        _Pragma("unroll") for (int g4 = 0; g4 < 4; ++g4) { const float4 x_ = *(const float4*)(bl_ + 8 * g4 + 4 * hi), y_ = *(const float4*)(bl_ + 32 + 8 * g4 + 4 * hi); \
            P0[4 * g4] = x_.x; P0[4 * g4 + 1] = x_.y; P0[4 * g4 + 2] = x_.z; P0[4 * g4 + 3] = x_.w; P1[4 * g4] = y_.x; P1[4 * g4 + 1] = y_.y; P1[4 * g4 + 2] = y_.z; P1[4 * g4 + 3] = y_.w; } \
        qk_tile<true>(smem + (sj) * AT_STAGE, qf, P0, P1, lane); \
        if ((jj) >= jmask_w) mask_tile<1>(P0, P1, 64 * (jj), -1, qrow, hi); } while (0)
#define FOX_STEP(CUR0, CUR1, NXT0, NXT1, j, CVD_LD, CVA_LD, CVB_LD, CVD_ST, CVA_ST, CVB_ST) do { \
        const int s_cur = (j) % 3, s_nxt = ((j) + 1) % 3, s_ld = ((j) + 2) % 3; const bool more_ = (j) + 2 < ntiles; \
        if (more_) { KV_GLOAD(K + (size_t)TJ((j) + 2) * 4096, V + (size_t)TJ((j) + 2) * 4096); if (tid < 64) breg = (cref - CUM[TJ((j) + 2) * 64 + tid]) * LOG2E; } \
        { const int c_ = (sidx0 + (j)) * CV_PER_STEP + tid; CVD_LD = nullptr; \
          if (tid < CV_PER_STEP && c_ < CV_NUP + CV_NDN) { const float* cvs_; if (c_ < CV_NUP) { cvs_ = a.in[I_WUP] + (size_t)c_ * 8; CVD_LD = (bf16_t*)(a.ws + WS_WUP) + (size_t)c_ * 8; } else { cvs_ = a.in[I_WDN] + (size_t)(c_ - CV_NUP) * 8; CVD_LD = (bf16_t*)(a.ws + WS_WDN) + (size_t)(c_ - CV_NUP) * 8; } \
              CVA_LD = *(const float4*)cvs_; CVB_LD = *(const float4*)(cvs_ + 4); } } \
        if ((j) + 1 < ntiles && TJ((j) + 1) <= jmax_w) FOX_QK(NXT0, NXT1, TJ((j) + 1), s_nxt); \
        __builtin_amdgcn_sched_barrier(0); \
        if (TJ(j) <= jmax_w) { softmax_step_nosum(CUR0, CUR1, m, o, lacc); pv_tile_sum(smem + s_cur * AT_STAGE + 8192, CUR0, CUR1, o, lacc, lane); } \
        if (more_) { KV_LSTORE(smem + s_ld * AT_STAGE); if (tid < 64) biasL[s_ld * 64 + tid] = breg; } \
        if (CVD_ST) { uint4 o_; o_.x = cvtpk(CVA_ST.x, CVA_ST.y); o_.y = cvtpk(CVA_ST.z, CVA_ST.w); o_.z = cvtpk(CVB_ST.x, CVB_ST.y); o_.w = cvtpk(CVB_ST.z, CVB_ST.w); *(uint4*)CVD_ST = o_; CVD_ST = nullptr; } \
        __syncthreads(); } while (0)
    f32x16 pA0, pA1, pB0, pB1;
    if (TJ(0) <= jmax_w) FOX_QK(pA0, pA1, TJ(0), 0);
    for (int j = 0; j < ntiles; j += 2) {
        FOX_STEP(pA0, pA1, pB0, pB1, j, cvdA, cvaA, cvbA, cvdB, cvaB, cvbB);
        FOX_STEP(pB0, pB1, pA0, pA1, j + 1, cvdB, cvaB, cvbB, cvdA, cvaA, cvbA);
    }
    if (cvdB) { uint4 o_; o_.x = cvtpk(cvaB.x, cvaB.y); o_.y = cvtpk(cvaB.z, cvaB.w); o_.z = cvtpk(cvbB.x, cvbB.y); o_.w = cvtpk(cvbB.z, cvbB.w); *(uint4*)cvdB = o_; }
#undef FOX_QK
#undef FOX_STEP
#undef TJ
    const float inv = 1.0f / lacc[0]; float ss = 0.f;
    const size_t token = (size_t)b * 8192 + qrow;
    bf16_t* O = (bf16_t*)(a.ws + WS_OFOX) + token * 512 + h * 64;
#pragma unroll
    for (int dh = 0; dh < 2; ++dh)
#pragma unroll
        for (int g4 = 0; g4 < 4; ++g4) { const float v0 = o[dh][4 * g4] * inv, v1 = o[dh][4 * g4 + 1] * inv, v2 = o[dh][4 * g4 + 2] * inv, v3 = o[dh][4 * g4 + 3] * inv;
            ss += v0 * v0 + v1 * v1 + v2 * v2 + v3 * v3; uint2 w; w.x = cvtpk(v0, v1); w.y = cvtpk(v2, v3); *(uint2*)(O + 32 * dh + 8 * g4 + 4 * hi) = w; }
    ss = pair_sum(ss);
    if (hi == 0) ((float*)(a.ws + WS_SSQ))[token * 16 + 8 + h] = ss;
}

DEV void nsa_item(const Args& a, unsigned char* smem, int b, int g, int tt) {
    const int tid = TID(), lane = tid & 63, wid = tid >> 6, col = lane & 31, hi = lane >> 5;
    const int t0 = tt * 64, tokw = col >> 2, r = col & 3, h = 4 * g + r; const int tokl = wid * 8 + tokw; const int t = t0 + tokl; const size_t token = (size_t)b * 8192 + t;
    const float slope2 = exp2f(-(float)(h + 1)) * LOG2E;
    const bf16_t* PROJ = (const bf16_t*)(a.ws + WS_PROJ);
    const float* GN = (const float*)(a.ws + WS_GN) + token * 24 + h * 3;
    const int cur = tt; const bool need_topk = cur > 15;
    bf16x8 qf[4];
    { const bf16_t* Q = PROJ + (((size_t)(h * 2 + b)) * 8192 + t) * 64;
#pragma unroll
      for (int ks = 0; ks < 4; ++ks) qf[ks] = *(const bf16x8*)(Q + 16 * ks + 8 * hi); }
    float* impw = (float*)(smem + AT_IMP_OFF) + wid * 2048; float* totw = impw + lane;
    unsigned* selmask = (unsigned*)(smem + AT_SEL_OFF); unsigned* wun = (unsigned*)(smem + AT_WUN_OFF); int* ucnt = (int*)(smem + AT_UCNT_OFF); unsigned char* ulist = smem + AT_ULIST_OFF;
    f32x16 o[2]; float m, l; int par = 0;
    const int tmin_w = t0 + wid * 8, tmax_w = tmin_w + 7;
    {
        const bf16_t* KC = (const bf16_t*)(a.ws + WS_KC) + ((size_t)(0 * 4 + b * 2 + g)) * 512 * 64; const bf16_t* VC = (const bf16_t*)(a.ws + WS_KC) + ((size_t)(1 * 4 + b * 2 + g)) * 512 * 64;
        const int ncv = t0 / 16 + 3; const int nct = (ncv + 63) >> 6;
        auto src = [&](int j, const bf16_t*& kp, const bf16_t*& vp) { kp = KC + (size_t)j * 4096; vp = VC + (size_t)j * 4096; };
        m = -1e30f; l = 0.f;
        auto src0 = [&](const bf16_t*& kp, const bf16_t*& vp) { kp = KC; vp = VC; };
        par = kv_pipeline(smem, nct, src, [&](int j, const unsigned char* st) {
            const int kpos0 = 1024 * j + 31;
            if (kpos0 > tmax_w) return;
            f32x16 p0, p1; alibi_init<16>(p0, p1, slope2, kpos0, t0, hi);
            qk_tile<false>(st, qf, p0, p1, lane);
            if (kpos0 + 16 * 63 > tmin_w) mask_tile<16>(p0, p1, kpos0, -1, t, hi);
            const float mt = rowmax32(p0, p1); const float mn = fmaxf(m, mt); float rs = 0.f;
#pragma unroll
            for (int rr = 0; rr < 16; ++rr) rs += __builtin_amdgcn_exp2f(p0[rr] - mn) + __builtin_amdgcn_exp2f(p1[rr] - mn);
            rs = pair_sum(rs);
            l = l * __builtin_amdgcn_exp2f(m - mn) + rs; m = mn;
        }, 0, false, true, src0);
        const float linv = l > 0.f ? 1.0f / l : 0.f;
        if (need_topk) { for (int i = lane; i < 8 * 129; i += 64) impw[i] = 0.f; }
        o[0] = (f32x16){}; o[1] = (f32x16){};
        const bf16_t* KS0 = PROJ + ((size_t)((12 + g) * 2 + b)) * 8192 * 64 + (size_t)cur * 4096; const bf16_t* VS0 = PROJ + ((size_t)((14 + g) * 2 + b)) * 8192 * 64 + (size_t)cur * 4096;
        par = kv_pipeline(smem, nct, src, [&](int j, const unsigned char* st) {
            const int kpos0 = 1024 * j + 31;
            if (kpos0 > tmax_w) return;
            f32x16 p0, p1; alibi_init<16>(p0, p1, slope2, kpos0, t0, hi);
            qk_tile<false>(st, qf, p0, p1, lane);
            if (kpos0 + 16 * 63 > tmin_w) mask_tile<16>(p0, p1, kpos0, -1, t, hi);
#pragma unroll
            for (int rr = 0; rr < 16; ++rr) { p0[rr] = __builtin_amdgcn_exp2f(p0[rr] - m) * linv; p1[rr] = __builtin_amdgcn_exp2f(p1[rr] - m) * linv; }
            if (need_topk) {
#pragma unroll
                for (int half = 0; half < 2; ++half)
#pragma unroll
                    for (int g4 = 0; g4 < 4; ++g4) { const f32x16& p = half ? p1 : p0;
                        float ms = (p[4 * g4] + p[4 * g4 + 1]) + (p[4 * g4 + 2] + p[4 * g4 + 3]); float ls = p[4 * g4 + 3];
                        ms = quad_sum(ms); ls = quad_sum(ls);
                        const int n = 16 * j + 8 * half + 2 * g4 + hi;
                        if (r == 0) { atomicAdd(&impw[tokw * 129 + n], ms); atomicAdd(&impw[tokw * 129 + n + 1], ls); } }
            }
            pv_tile<false>(st + 8192, p0, p1, o, lane);
        }, par, true, true, [&](const bf16_t*& kp, const bf16_t*& vp) { kp = KS0; vp = VS0; });
    }
    {
        unsigned un0 = 0u, un1 = 0u, un2 = 0u, un3 = 0u;
        if (need_topk) {
#define TK_INIT(V0, V1, M0, M1, M2, M3, tk_) float V0 = impw[(tk_) * 129 + lane], V1 = impw[(tk_) * 129 + 64 + lane]; \
                V0 = (lane >= 1 && lane <= cur - 2) ? V0 : -1.0f; V1 = (lane + 64 <= cur - 2) ? V1 : -1.0f; unsigned M0 = 1u, M1 = 0u, M2 = 0u, M3 = 0u; \
                TK_SET(M0, M1, M2, M3, cur); TK_SET(M0, M1, M2, M3, cur - 1)
#define TK_SET(M0, M1, M2, M3, n_) do { const int n__ = (n_); const unsigned bit__ = 1u << (n__ & 31); const int w__ = n__ >> 5; M0 |= (w__ == 0) ? bit__ : 0u; M1 |= (w__ == 1) ? bit__ : 0u; M2 |= (w__ == 2) ? bit__ : 0u; M3 |= (w__ == 3) ? bit__ : 0u; } while (0)
#define TK_STEP(V0, V1, M0, M1, M2, M3) do { const float mx_ = wave_max_u(fmaxf(V0, V1)); const unsigned long long b0_ = __ballot(V0 == mx_), b1_ = __ballot(V1 == mx_); \
                const int n_ = b0_ ? (__ffsll((long long)b0_) - 1) : (63 + __ffsll((long long)b1_)); const bool hit_ = lane == (n_ & 63); \
                V0 = (hit_ && n_ < 64) ? -1.0f : V0; V1 = (hit_ && n_ >= 64) ? -1.0f : V1; TK_SET(M0, M1, M2, M3, n_); } while (0)
            for (int tk = 0; tk < 8; tk += 4) {
                TK_INIT(a0_, a1_, ma0, ma1, ma2, ma3, tk); TK_INIT(b0v, b1v, mb0, mb1, mb2, mb3, tk + 1); TK_INIT(c0v, c1v, mc0, mc1, mc2, mc3, tk + 2); TK_INIT(d0v, d1v, md0, md1, md2, md3, tk + 3);
                for (int it = 0; it < 13; ++it) { TK_STEP(a0_, a1_, ma0, ma1, ma2, ma3); TK_STEP(b0v, b1v, mb0, mb1, mb2, mb3); TK_STEP(c0v, c1v, mc0, mc1, mc2, mc3); TK_STEP(d0v, d1v, md0, md1, md2, md3); }
                if (lane == 0) { unsigned* sm_ = selmask + (wid * 8 + tk) * 4; sm_[0] = ma0; sm_[1] = ma1; sm_[2] = ma2; sm_[3] = ma3; sm_[4] = mb0; sm_[5] = mb1; sm_[6] = mb2; sm_[7] = mb3;
                    sm_[8] = mc0; sm_[9] = mc1; sm_[10] = mc2; sm_[11] = mc3; sm_[12] = md0; sm_[13] = md1; sm_[14] = md2; sm_[15] = md3; }
                un0 |= ma0 | mb0 | mc0 | md0; un1 |= ma1 | mb1 | mc1 | md1; un2 |= ma2 | mb2 | mc2 | md2; un3 |= ma3 | mb3 | mc3 | md3;
            }
#undef TK_INIT
#undef TK_SET
#undef TK_STEP
        } else {
            const unsigned full = (2u << cur) - 1u;
            un0 = full;
            if (lane < 8) { unsigned* sm_ = selmask + (wid * 8 + lane) * 4; sm_[0] = full; sm_[1] = 0u; sm_[2] = 0u; sm_[3] = 0u; }
        }
        if (lane == 0) { wun[wid * 4] = un0; wun[wid * 4 + 1] = un1; wun[wid * 4 + 2] = un2; wun[wid * 4 + 3] = un3; }
        __syncthreads();
        if (tid == 0) { int c = 0;
            for (int w = 0; w < 4; ++w) { unsigned u = 0u; for (int ww = 0; ww < NWAVE; ++ww) u |= wun[ww * 4 + w]; for (int bb = 0; bb < 32; ++bb) if ((u >> bb) & 1u) ulist[c++] = (unsigned char)(w * 32 + bb); }
            ucnt[0] = c; }
        __syncthreads();
    }
    { const float g0 = GN[0];
#pragma unroll
      for (int rr = 0; rr < 16; ++rr) { totw[rr * 64] = o[0][rr] * g0; totw[(16 + rr) * 64] = o[1][rr] * g0; } }
    {
        const bf16_t* KS = PROJ + ((size_t)((12 + g) * 2 + b)) * 8192 * 64; const bf16_t* VS = PROJ + ((size_t)((14 + g) * 2 + b)) * 8192 * 64;
        const int nu = ucnt[0];
        m = -1e30f; f32x16 lacc = (f32x16){}; o[0] = (f32x16){}; o[1] = (f32x16){};
        const bf16_t* KW0 = PROJ + ((size_t)((16 + g) * 2 + b)) * 8192 * 64 + (size_t)cur * 4096; const bf16_t* VW0 = PROJ + ((size_t)((18 + g) * 2 + b)) * 8192 * 64 + (size_t)cur * 4096;
        par = kv_pipeline(smem, nu, [&](int j, const bf16_t*& kp, const bf16_t*& vp) { const int n = ulist[nu - 1 - j]; kp = KS + (size_t)n * 4096; vp = VS + (size_t)n * 4096; },
            [&](int j, const unsigned char* st) {
                const int n = ulist[nu - 1 - j];
                if (!((wun[wid * 4 + (n >> 5)] >> (n & 31)) & 1u)) return;
                const bool sel = (selmask[tokl * 4 + (n >> 5)] >> (n & 31)) & 1u;
                f32x16 p0, p1; alibi_init<1>(p0, p1, slope2, 64 * n, t0, hi);
                qk_tile<false>(st, qf, p0, p1, lane);
                if (n == cur || !__all(sel)) mask_tile<1>(p0, p1, 64 * n, -1, sel ? t : -1, hi);
                softmax_step_nosum(p0, p1, m, o, lacc);
                pv_tile_sum(st + 8192, p0, p1, o, lacc, lane);
            }, par, true, true, [&](const bf16_t*& kp, const bf16_t*& vp) { kp = KW0; vp = VW0; });
        const float g1 = GN[1] / fmaxf(lacc[0], 1e-30f);
#pragma unroll
        for (int rr = 0; rr < 16; ++rr) { totw[rr * 64] += o[0][rr] * g1; totw[(16 + rr) * 64] += o[1][rr] * g1; }
    }
    {
        const bf16_t* KW = PROJ + ((size_t)((16 + g) * 2 + b)) * 8192 * 64; const bf16_t* VW = PROJ + ((size_t)((18 + g) * 2 + b)) * 8192 * 64;
        const int jlo = (t0 - 511) > 0 ? ((t0 - 511) >> 6) : 0; const int jhi = cur;
        m = -1e30f; f32x16 lacc = (f32x16){}; o[0] = (f32x16){}; o[1] = (f32x16){};
        (void)kv_pipeline(smem, jhi - jlo + 1, [&](int j, const bf16_t*& kp, const bf16_t*& vp) { kp = KW + (size_t)(jhi - j) * 4096; vp = VW + (size_t)(jhi - j) * 4096; },
            [&](int j, const unsigned char* st) {
                const int kpos0 = 64 * (jhi - j);
                if (kpos0 > tmax_w || kpos0 + 63 < tmin_w - 511) return;
                f32x16 p0, p1; alibi_init<1>(p0, p1, slope2, kpos0, t0, hi);
                qk_tile<false>(st, qf, p0, p1, lane);
                if (kpos0 < tmax_w - 511 || kpos0 + 63 > tmin_w) mask_tile<1>(p0, p1, kpos0, t - 511, t, hi);
                softmax_step_nosum(p0, p1, m, o, lacc);
                pv_tile_sum(st + 8192, p0, p1, o, lacc, lane);
            }, par, true, false, NoSrc());
        const float g2 = GN[2] / fmaxf(lacc[0], 1e-30f);
#pragma unroll
        for (int rr = 0; rr < 16; ++rr) { o[0][rr] = totw[rr * 64] + o[0][rr] * g2; o[1][rr] = totw[(16 + rr) * 64] + o[1][rr] * g2; }
    }
    {
        float ss = 0.f; bf16_t* O = (bf16_t*)(a.ws + WS_ONSA) + token * 512 + h * 64;
#pragma unroll
        for (int dh = 0; dh < 2; ++dh)
#pragma unroll
            for (int g4 = 0; g4 < 4; ++g4) { const float v0 = o[dh][4 * g4], v1 = o[dh][4 * g4 + 1], v2 = o[dh][4 * g4 + 2], v3 = o[dh][4 * g4 + 3];
                ss += v0 * v0 + v1 * v1 + v2 * v2 + v3 * v3; uint2 w; w.x = cvtpk(v0, v1); w.y = cvtpk(v2, v3); *(uint2*)(O + 32 * dh + 8 * g4 + 4 * hi) = w; }
        ss = pair_sum(ss);
        if (hi == 0) ((float*)(a.ws + WS_SSQ))[token * 16 + h] = ss;
    }
}
#ifndef PROBE_DUP
#define PROBE_DUP 0
#endif
DEV void phase_att(const Args& a, unsigned char* smem) {
    int* qctr = (int*)(a.ws + WS_CTL) + 64; int* sitem = (int*)(smem + AT_ITEM_OFF);
    unsigned* ctl = (unsigned*)(a.ws + WS_CTL); unsigned* seen = (unsigned*)(smem + AT_ITEM_OFF + 8);
    if (TID() == 0) seen[0] = 0u;
    for (;;) {
        if (TID() == 0) sitem[0] = atomicAdd(qctr, 1);
        __syncthreads();
        const int item = sitem[0];
        __syncthreads();
        if (item >= 32 + 1024) break;
        if (item < 16) cmp_item(a, smem, 16 + item);
        else if (item < 32) cmp_item(a, smem, item - 16);
        else if (item < 32 + 512) { const int fi = item - 32; const int qb = 31 - (fi >> 4), bh = fi & 15; if (!((seen[0] >> bh) & 1u)) { wait_flag(ctl + CW_CUMFLAG + bh, 1u); if (TID() == 0) seen[0] |= 1u << bh; } fox_item(a, smem, fi, bh >> 3, bh & 7, qb); }
        else { const int idx = item - 32 - 512; const int tt = 127 - (idx >> 2), bg = idx & 3; if (!((seen[0] >> 16) & 1u)) { wait_flag(ctl + CW_CMPFLAG, 16u); if (TID() == 0) seen[0] |= 1u << 16; } nsa_item(a, smem, bg >> 1, bg & 1, tt); }
    }
}

DEV void phase_outproj(const Args& a, unsigned char* smem) {
    const bf16_t* ONSA = (const bf16_t*)(a.ws + WS_ONSA); const bf16_t* OFOX = (const bf16_t*)(a.ws + WS_OFOX); const float* SSQ = (const float*)(a.ws + WS_SSQ);
    const bf16_t* W = (const bf16_t*)(a.ws + WS_WOUT); float* H1 = (float*)(a.ws + WS_H1); const float* X = a.in[I_X];
    float* rs = (float*)(smem + MISC_OFF);
    const int tid = TID(); int lane = tid & 63, wid = tid >> 6, wr = wid >> 2, wc = wid & 3; (void)wr; (void)wc; (void)lane;
    auto aoffo = [](int r, int kc) { return (unsigned)(r * 1024 + kc * 16); }; auto boffo = [](int k, int nc) { return (unsigned)(k * 2048 + nc * 16); };
    for (int item = VBID(); item < 64 * 4; item += gridDim.x) {
        int mt, nt; patch_decode(item, 64, 4, mt, nt);
        gemm_issue0<15>(smem, ONSA + (size_t)mt * 256 * 512, aoffo, W + nt * 256, boffo);
        if (tid < 256) { const float* s_ = SSQ + (size_t)(mt * 256 + tid) * 16; float sn = 0.f, sf = 0.f;
#pragma unroll
            for (int j = 0; j < 8; ++j) { sn += s_[j]; sf += s_[8 + j]; }
            rs[tid * 2] = rsqrtf(sn * (1.f / 512.f) + EPS); rs[tid * 2 + 1] = rsqrtf(sf * (1.f / 512.f) + EPS); }
        asm volatile("s_waitcnt vmcnt(0)" ::: "memory");
        __syncthreads();
        f32x4 acc[8][4];
#pragma unroll
        for (int mi = 0; mi < 8; ++mi) { const size_t gm = (size_t)mt * 256 + G_ROW(mi);
#pragma unroll
            for (int ni = 0; ni < 4; ++ni) { const int n = nt * 256 + G_COL(ni); const float4 x = *(const float4*)(X + gm * 1024 + n); acc[mi][ni] = (f32x4){x.x, x.y, x.z, x.w}; } }
#pragma unroll
        for (int mi = 0; mi < 8; ++mi) { const float ri = 1.0f / rs[(G_ROW(mi)) * 2];
#pragma unroll
            for (int ni = 0; ni < 4; ++ni) acc[mi][ni] *= ri; }
        gemm256<false>(smem, 8, ONSA + (size_t)mt * 256 * 512, 128u, aoffo, W + nt * 256, 64u * 2048u, boffo, acc, true,
                       next_tile(true, smem, OFOX + (size_t)mt * 256 * 512, aoffo, W + (size_t)512 * 1024 + nt * 256, boffo));
        EPI_IDS();
#pragma unroll
        for (int mi = 0; mi < 8; ++mi) { const int rl = G_ROW(mi); const float rat = rs[rl * 2] / rs[rl * 2 + 1];
#pragma unroll
            for (int ni = 0; ni < 4; ++ni) acc[mi][ni] *= rat; }
        gemm256<false>(smem, 8, OFOX + (size_t)mt * 256 * 512, 128u, aoffo, W + (size_t)512 * 1024 + nt * 256, 64u * 2048u, boffo, acc, true);
        EPI_IDS();
#pragma unroll
        for (int mi = 0; mi < 8; ++mi) { const int rl = G_ROW(mi); const size_t gm = (size_t)mt * 256 + rl; const float rf = rs[rl * 2 + 1];
#pragma unroll
            for (int ni = 0; ni < 4; ++ni) { const int n = nt * 256 + G_COL(ni); const f32x4 v = acc[mi][ni] * rf;
                float4 o = {v[0], v[1], v[2], v[3]}; *(float4*)(H1 + gm * 1024 + n) = o; } }
        __syncthreads();
    }
}

DEV void phase_route(const Args& a, unsigned char* smem) {
    const float* H1 = (const float*)(a.ws + WS_H1); bf16_t* XN = (bf16_t*)(a.ws + WS_XN); float* RSTD2 = (float*)(a.ws + WS_RSTD2);
    const float* ln2 = a.in[I_LN2]; const float* wr_ = a.in[I_WR]; const float* br = a.in[I_BR];
    int* CNT = (int*)(a.ws + WS_CTL);
    int* TOPI = (int*)(a.ws + WS_TOPI); int* TOPS = (int*)(a.ws + WS_TOPS); float* TOPW = (float*)(a.ws + WS_TOPW);
    int* TOKOF = (int*)(a.ws + WS_TOKOF); float* ROWW = (float*)(a.ws + WS_ROWW);
    float* part = (float*)smem;
    float* ssqp = part + 8 * 32 * 33;
    int* lcnt = (int*)(ssqp + 256); int* lbase = lcnt + 32; int* te = lbase + 32; int* trk = te + 256; float* tw = (float*)(trk + 256);
    const int tid = TID(), lane = tid & 63, wid = tid >> 6, i32 = lane & 31, kh = lane >> 5; const int tg = wid >> 2, kq = wid & 3;
    for (int item = BID(); item < 256; item += gridDim.x) {
        const int tok = item * 64 + tg * 32 + i32;
        if (tid < 32) lcnt[tid] = 0;
        f32x16 acc = (f32x16){}; float ss = 0.f;
        const float* hrow = H1 + (size_t)tok * 1024 + 256 * kq + 4 * kh; const float* lrow = ln2 + 256 * kq + 4 * kh; bf16_t* xrow = XN + (size_t)tok * 1024 + 256 * kq + 4 * kh;
        const float* wbase = wr_ + (size_t)(256 * kq + 4 * kh) * 32 + i32;
#pragma unroll 4
        for (int c = 0; c < 32; ++c) {
            const float4 hv = *(const float4*)(hrow + 8 * c); const float4 lv = *(const float4*)(lrow + 8 * c);
            ss += hv.x * hv.x + hv.y * hv.y + hv.z * hv.z + hv.w * hv.w;
            const float x0 = hv.x * lv.x, x1 = hv.y * lv.y, x2 = hv.z * lv.z, x3 = hv.w * lv.w;
            uint2 o; o.x = cvtpk(x0, x1); o.y = cvtpk(x2, x3); *(uint2*)(xrow + 8 * c) = o;
            const float* wp = wbase + (size_t)(8 * c) * 32;
            const float w0 = wp[0], w1 = wp[32], w2 = wp[64], w3 = wp[96];
            acc = __builtin_amdgcn_mfma_f32_32x32x2f32(x0, w0, acc, 0, 0, 0);
            acc = __builtin_amdgcn_mfma_f32_32x32x2f32(x1, w1, acc, 0, 0, 0);
            acc = __builtin_amdgcn_mfma_f32_32x32x2f32(x2, w2, acc, 0, 0, 0);
            acc = __builtin_amdgcn_mfma_f32_32x32x2f32(x3, w3, acc, 0, 0, 0);
        }
        ss = pair_sum(ss);
        if (kh == 0) ssqp[wid * 32 + i32] = ss;
#pragma unroll
        for (int r = 0; r < 16; ++r) part[(wid * 32 + crow(r, kh)) * 33 + i32] = acc[r];
        __syncthreads();
        if (tid < 64) {
            const int g_ = tid >> 5, i_ = tid & 31; const int w0_ = g_ * 4;
            const float sq = ssqp[(w0_ + 0) * 32 + i_] + ssqp[(w0_ + 1) * 32 + i_] + ssqp[(w0_ + 2) * 32 + i_] + ssqp[(w0_ + 3) * 32 + i_]; const float rstd = rsqrtf(sq * (1.f / 1024.f) + EPS);
            RSTD2[item * 64 + tid] = rstd;
            float lg[32];
#pragma unroll
            for (int e = 0; e < 32; ++e) lg[e] = (part[((w0_ + 0) * 32 + i_) * 33 + e] + part[((w0_ + 1) * 32 + i_) * 33 + e] + part[((w0_ + 2) * 32 + i_) * 33 + e] + part[((w0_ + 3) * 32 + i_) * 33 + e]) * rstd + br[e];
            unsigned taken = 0u; float tv[4]; int ti[4];
#pragma unroll
            for (int k = 0; k < 4; ++k) { float best = -3.0e38f; int bi = 0;
#pragma unroll
                for (int e = 0; e < 32; ++e) { const bool ok = !((taken >> e) & 1u) && lg[e] > best; best = ok ? lg[e] : best; bi = ok ? e : bi; }
                taken |= 1u << bi; tv[k] = best; ti[k] = bi; }
            const float e1 = __expf(tv[1] - tv[0]), e2 = __expf(tv[2] - tv[0]), e3 = __expf(tv[3] - tv[0]); const float inv = 1.0f / (1.0f + e1 + e2 + e3);
            const float wv[4] = {inv, e1 * inv, e2 * inv, e3 * inv};
#pragma unroll
            for (int k = 0; k < 4; ++k) { const int idx = tid * 4 + k; te[idx] = ti[k]; trk[idx] = atomicAdd(&lcnt[ti[k]], 1); tw[idx] = wv[k]; }
        }
        __syncthreads();
        if (tid < 32) lbase[tid] = atomicAdd(&CNT[tid], lcnt[tid]);
        __syncthreads();
        if (tid < 256) { const int idx = tid; const int tk = item * 64 + (idx >> 2); const int e = te[idx]; const int slot = lbase[e] + trk[idx];
          TOPI[(size_t)tk * 4 + (idx & 3)] = e; TOPS[(size_t)tk * 4 + (idx & 3)] = slot; TOPW[(size_t)tk * 4 + (idx & 3)] = tw[idx];
          TOKOF[(size_t)e * 16384 + slot] = tk; ROWW[(size_t)e * 16384 + slot] = tw[idx]; }
        __syncthreads();
    }
}

struct MoeMap { int e, mt, nt, cnt, off; };
DEV void moe_setup(const Args& a, int* sm) {
    if (TID() == 0) { const int* CNT = (const int*)(a.ws + WS_CTL); int tot = 0; for (int e = 0; e < 32; ++e) { const int c = CNT[e]; const int mt = (c + 255) >> 8; sm[e] = mt; sm[32 + e] = tot; tot += mt; } sm[64] = tot; }
    __syncthreads();
}
DEV MoeMap moe_map(const Args& a, const int* sm, int item, int NT) {
    MoeMap mm; int e = 0;
#pragma unroll 1
    for (int i = 1; i < 32; ++i) if (item >= sm[32 + i] * NT) e = i;
    const int local = item - sm[32 + e] * NT; const int mte = sm[e];
    int mt_, nt_; patch_decode(local, mte, NT, mt_, nt_);
    mm.e = __builtin_amdgcn_readfirstlane(e); mm.mt = __builtin_amdgcn_readfirstlane(mt_); mm.nt = __builtin_amdgcn_readfirstlane(nt_);
    mm.cnt = __builtin_amdgcn_readfirstlane(((const int*)(a.ws + WS_CTL))[e]); mm.off = __builtin_amdgcn_readfirstlane(sm[32 + e] * 256); return mm;
}
DEV void phase_up(const Args& a, unsigned char* smem) {
    int* sm = (int*)(smem + MISC_OFF); int* tokb = sm + 128; float* rsdb = (float*)(tokb + 512);
    const bf16_t* XN = (const bf16_t*)(a.ws + WS_XN); const bf16_t* W = (const bf16_t*)(a.ws + WS_WUP); bf16_t* ACT = (bf16_t*)(a.ws + WS_ACT); const float* RSTD2 = (const float*)(a.ws + WS_RSTD2);
    const int* TOKOF = (const int*)(a.ws + WS_TOKOF); const float* bup = a.in[I_BUP];
    const int tid = TID(); int lane = tid & 63, wid = tid >> 6, wr = wid >> 2, wc = wid & 3; (void)wr; (void)wc; (void)lane;
    moe_setup(a, sm);
    const int nitems = __builtin_amdgcn_readfirstlane(sm[64]) * 8;
    auto fill = [&](const MoeMap& m_, int buf) { if (tid < 256) { const int slot = m_.mt * 256 + tid; const int tk_ = slot < m_.cnt ? TOKOF[(size_t)m_.e * 16384 + slot] : 0; tokb[buf * 256 + tid] = tk_; rsdb[buf * 256 + tid] = RSTD2[tk_]; } };
    auto boffu = [](int k, int nc) { const int sc = ((nc >> 4) ? 1024 : 0) + (nc & 15) * 8; return (unsigned)(k * 4096 + sc * 2); };
    int item = VBID(); int buf = 0; bool pre = false; MoeMap mm{};
    if (item < nitems) { mm = moe_map(a, sm, item, 8); fill(mm, 0); }
    __syncthreads();
    while (item < nitems) {
        const int nitem = item + (int)gridDim.x; const bool has_next = nitem < nitems; MoeMap mn{};
        if (has_next) { mn = moe_map(a, sm, nitem, 8); fill(mn, buf ^ 1); }
        const int* tok = tokb + buf * 256; const int* tokn = tokb + (buf ^ 1) * 256; const float* rsd = rsdb + buf * 256;
        const bf16_t* We = W + (size_t)mm.e * 1024 * 2048; const bf16_t* Wn = W + (size_t)mn.e * 1024 * 2048;
        f32x4 acc[8][4];
        gemm256<true>(smem, 16, XN, 128u, [&](int r, int kc) { return (unsigned)(tok[r] * 2048 + kc * 16); }, We + mm.nt * 128, 64u * 4096u, boffu, acc, pre,
                      next_tile(has_next, smem, XN, [&](int r, int kc) { return (unsigned)(tokn[r] * 2048 + kc * 16); }, Wn + mn.nt * 128, boffu));
        EPI_IDS();
#pragma unroll
        for (int mi = 0; mi < 8; ++mi) { const int rl_ = G_ROW(mi); const size_t row = (size_t)mm.off + mm.mt * 256 + rl_; const float rs_ = rsd[rl_];
#pragma unroll
            for (int ni = 0; ni < 2; ++ni) { const int jc = mm.nt * 128 + wc * 32 + ni * 16 + 4 * (lane >> 4);
                const float4 bg = *(const float4*)(bup + (size_t)mm.e * 2048 + jc), bl_ = *(const float4*)(bup + (size_t)mm.e * 2048 + 1024 + jc);
                const f32x4 gv = acc[mi][ni], lv = acc[mi][ni + 2]; const float bgv[4] = {bg.x, bg.y, bg.z, bg.w}, blv[4] = {bl_.x, bl_.y, bl_.z, bl_.w}; float r4[4];
#pragma unroll
                for (int r = 0; r < 4; ++r) { const float gg = fminf(gv[r] * rs_ + bgv[r], 7.0f); const float ll = fminf(fmaxf(lv[r] * rs_ + blv[r], -7.0f), 7.0f); r4[r] = gg * sigmoidf_(1.702f * gg) * (ll + 1.0f); }
                uint2 o; o.x = cvtpk(r4[0], r4[1]); o.y = cvtpk(r4[2], r4[3]); *(uint2*)(ACT + row * 1024 + jc) = o; } }
        __syncthreads();
        item = nitem; mm = mn; buf ^= 1; pre = has_next;
    }
}
DEV void phase_down(const Args& a, unsigned char* smem) {
    int* sm = (int*)(smem + MISC_OFF); float* rwb = (float*)(sm + 128);
    const bf16_t* ACT = (const bf16_t*)(a.ws + WS_ACT); const bf16_t* W = (const bf16_t*)(a.ws + WS_WDN); bf16_t* Y = (bf16_t*)(a.ws + WS_Y);
    const float* ROWW = (const float*)(a.ws + WS_ROWW); const float* bdn = a.in[I_BDN];
    const int tid = TID(); int lane = tid & 63, wid = tid >> 6, wr = wid >> 2, wc = wid & 3; (void)wr; (void)wc; (void)lane;
    moe_setup(a, sm);
    const int nitems = __builtin_amdgcn_readfirstlane(sm[64]) * 4;
    auto fill = [&](const MoeMap& m_, int buf) { if (tid < 256) { const int slot = m_.mt * 256 + tid; rwb[buf * 256 + tid] = slot < m_.cnt ? ROWW[(size_t)m_.e * 16384 + slot] : 0.f; } };
    auto aoffd = [](int r, int kc) { return (unsigned)(r * 2048 + kc * 16); }; auto boffd = [](int k, int nc) { return (unsigned)(k * 2048 + nc * 16); };
    int item = VBID(); int buf = 0; bool pre = false; MoeMap mm{};
    if (item < nitems) { mm = moe_map(a, sm, item, 4); fill(mm, 0); }
    __syncthreads();
    while (item < nitems) {
        const int nitem = item + (int)gridDim.x; const bool has_next = nitem < nitems; MoeMap mn{};
        if (has_next) { mn = moe_map(a, sm, nitem, 4); fill(mn, buf ^ 1); }
        const float* rw = rwb + buf * 256;
        const bf16_t* We = W + (size_t)mm.e * 1024 * 1024; const bf16_t* Ab = ACT + ((size_t)mm.off + mm.mt * 256) * 1024;
        const bf16_t* Wn = W + (size_t)mn.e * 1024 * 1024; const bf16_t* An = ACT + ((size_t)mn.off + mn.mt * 256) * 1024;
        f32x4 acc[8][4];
        gemm256<true>(smem, 16, Ab, 128u, aoffd, We + mm.nt * 256, 64u * 2048u, boffd, acc, pre,
                      next_tile(has_next, smem, An, aoffd, Wn + mn.nt * 256, boffd));
        EPI_IDS();
#pragma unroll
        for (int mi = 0; mi < 8; ++mi) { const int rl = G_ROW(mi); const size_t row = (size_t)mm.off + mm.mt * 256 + rl; const float w = rw[rl];
#pragma unroll
            for (int ni = 0; ni < 4; ++ni) { const int n = mm.nt * 256 + G_COL(ni); const float4 bb = *(const float4*)(bdn + (size_t)mm.e * 1024 + n); const f32x4 v = acc[mi][ni];
                uint2 o; o.x = cvtpk((v[0] + bb.x) * w, (v[1] + bb.y) * w); o.y = cvtpk((v[2] + bb.z) * w, (v[3] + bb.w) * w); *(uint2*)(Y + row * 1024 + n) = o; } }
        __syncthreads();
        item = nitem; mm = mn; buf ^= 1; pre = has_next;
    }
}

DEV void phase_comb(const Args& a, unsigned char* smem) {
    int* sm = (int*)(smem + MISC_OFF);
    moe_setup(a, sm);
    float* H1 = (float*)(a.ws + WS_H1); bf16_t* XN = (bf16_t*)(a.ws + WS_XN); const bf16_t* Y = (const bf16_t*)(a.ws + WS_Y);
    const int* TOPI = (const int*)(a.ws + WS_TOPI); const int* TOPS = (const int*)(a.ws + WS_TOPS); const float* g = a.in[I_LNPLE];
    const int lane = TID() & 63; const int gw = BID() * NWAVE + (TID() >> 6), ngw = gridDim.x * NWAVE;
    for (int tok = gw; tok < NTOK; tok += ngw) {
        float4 v[4];
#pragma unroll
        for (int j = 0; j < 4; ++j) v[j] = *(const float4*)(H1 + (size_t)tok * 1024 + j * 256 + lane * 4);
#pragma unroll
        for (int k = 0; k < 4; ++k) { const int e = TOPI[(size_t)tok * 4 + k]; const size_t row = (size_t)sm[32 + e] * 256 + TOPS[(size_t)tok * 4 + k];
#pragma unroll
            for (int j = 0; j < 4; ++j) { const uint2 u = *(const uint2*)(Y + row * 1024 + j * 256 + lane * 4); v[j].x += bflo(u.x); v[j].y += bfhi(u.x); v[j].z += bflo(u.y); v[j].w += bfhi(u.y); } }
        float s = 0.f;
#pragma unroll
        for (int j = 0; j < 4; ++j) { *(float4*)(H1 + (size_t)tok * 1024 + j * 256 + lane * 4) = v[j]; s += v[j].x * v[j].x + v[j].y * v[j].y + v[j].z * v[j].z + v[j].w * v[j].w; }
        const float rstd = rsqrtf(wave_sum(s) * (1.f / 1024.f) + EPS);
#pragma unroll
        for (int j = 0; j < 4; ++j) { const float4 gg = *(const float4*)(g + j * 256 + lane * 4);
            uint2 o; o.x = cvtpk(v[j].x * rstd * gg.x, v[j].y * rstd * gg.y); o.y = cvtpk(v[j].z * rstd * gg.z, v[j].w * rstd * gg.w); *(uint2*)(XN + (size_t)tok * 1024 + j * 256 + lane * 4) = o; }
    }
}

DEV void phase_gate(const Args& a, unsigned char* smem) {
    const bf16_t* XN = (const bf16_t*)(a.ws + WS_XN); const bf16_t* WG = (const bf16_t*)(a.ws + WS_WGATE); const bf16_t* PB = (const bf16_t*)(a.ws + WS_PB); const bf16_t* WP = (const bf16_t*)(a.ws + WS_WPLE);
    const float* H2 = (const float*)(a.ws + WS_H1); float* OUT = a.out; float* SSQ3 = (float*)(a.ws + WS_SSQ3);
    const int tid = TID(); int lane = tid & 63, wid = tid >> 6, wr = wid >> 2, wc = wid & 3; (void)wr; (void)wc; (void)lane;
    bf16_t* GT = (bf16_t*)(a.ws + WS_ACT);
    auto aoffg = [](int r, int kc) { return (unsigned)(r * 2048 + kc * 16); }; auto aoffp = [](int r, int kc) { return (unsigned)(r * 512 + kc * 16); }; auto boffg = [](int k, int nc) { return (unsigned)(k * 2048 + nc * 16); };
    for (int item = VBID(); item < 64 * 4; item += gridDim.x) {
        int mt, nt; patch_decode(item, 64, 4, mt, nt);
        f32x4 acc[8][4];
        gemm256<true>(smem, 16, XN + (size_t)mt * 256 * 1024, 128u, aoffg, WG + nt * 256, 64u * 2048u, boffg, acc, false,
                      next_tile(true, smem, PB + (size_t)mt * 256 * 256, aoffp, WP + nt * 256, boffg));
        EPI_IDS();
#pragma unroll
        for (int mi = 0; mi < 8; ++mi) { const size_t gm = (size_t)mt * 256 + G_ROW(mi);
#pragma unroll
            for (int ni = 0; ni < 4; ++ni) { const int n = nt * 256 + G_COL(ni); const f32x4 v = acc[mi][ni];
                uint2 w; w.x = cvtpk(sigmoidf_(v[0]), sigmoidf_(v[1])); w.y = cvtpk(sigmoidf_(v[2]), sigmoidf_(v[3])); *(uint2*)(GT + gm * 1024 + n) = w;
                const float4 h = *(const float4*)(H2 + gm * 1024 + n);
                acc[mi][ni] = (f32x4){h.x * __builtin_amdgcn_rcpf(bflo(w.x)), h.y * __builtin_amdgcn_rcpf(bfhi(w.x)), h.z * __builtin_amdgcn_rcpf(bflo(w.y)), h.w * __builtin_amdgcn_rcpf(bfhi(w.y))}; }
            asm volatile("" ::: "memory"); }
        gemm256<false>(smem, 4, PB + (size_t)mt * 256 * 256, 128u, aoffp, WP + nt * 256, 64u * 2048u, boffg, acc, true);
        EPI_IDS();
        const bool fused = gridDim.x >= 256;
#pragma unroll
        for (int mi = 0; mi < 8; ++mi) { const size_t gm = (size_t)mt * 256 + G_ROW(mi); float ss = 0.f;
#pragma unroll
            for (int ni = 0; ni < 4; ++ni) { const int n = nt * 256 + G_COL(ni); const f32x4 v = acc[mi][ni];
                const uint2 gw = *(const uint2*)(GT + gm * 1024 + n);
                float4 o = {v[0] * bflo(gw.x), v[1] * bfhi(gw.x), v[2] * bflo(gw.y), v[3] * bfhi(gw.y)};
                if (!fused) *(float4*)(OUT + gm * 1024 + n) = o;
                acc[mi][ni] = (f32x4){o.x, o.y, o.z, o.w};
                ss += o.x * o.x + o.y * o.y + o.z * o.z + o.w * o.w; }
            ss += __shfl_xor(ss, 16); ss += __shfl_xor(ss, 32);
            if (lane < 16) SSQ3[gm * 16 + nt * 4 + wc] = ss;
            asm volatile("" ::: "memory"); }
        if (fused) {
            unsigned* flag = (unsigned*)(a.ws + WS_CTL) + CW_GATEFLAG + mt;
            signal_done(flag); wait_flag(flag, 4u);
            const float* lnf = a.in[I_LNF];
#pragma unroll
            for (int mi = 0; mi < 8; ++mi) { const size_t gm = (size_t)mt * 256 + G_ROW(mi);
                const float4 s0 = *(const float4*)(SSQ3 + gm * 16), s1 = *(const float4*)(SSQ3 + gm * 16 + 4), s2 = *(const float4*)(SSQ3 + gm * 16 + 8), s3 = *(const float4*)(SSQ3 + gm * 16 + 12);
                const float tot = ((s0.x + s0.y) + (s0.z + s0.w)) + ((s1.x + s1.y) + (s1.z + s1.w)) + ((s2.x + s2.y) + (s2.z + s2.w)) + ((s3.x + s3.y) + (s3.z + s3.w));
                const float rstd = rsqrtf(tot * (1.f / 1024.f) + EPS);
#pragma unroll
                for (int ni = 0; ni < 4; ++ni) { const int n = nt * 256 + G_COL(ni); const float4 gg = *(const float4*)(lnf + n); const f32x4 v = acc[mi][ni];
                    float4 o = {v[0] * rstd * gg.x, v[1] * rstd * gg.y, v[2] * rstd * gg.z, v[3] * rstd * gg.w}; *(float4*)(OUT + gm * 1024 + n) = o; }
                asm volatile("" ::: "memory"); }
        }
        __syncthreads();
    }
}

DEV void phase_final(const Args& a) {
    if (gridDim.x >= 256) return;
    float* OUT = a.out; const float* SSQ3 = (const float*)(a.ws + WS_SSQ3); const float* g = a.in[I_LNF];
    const int lane = TID() & 63; const int gw = BID() * NWAVE + (TID() >> 6), ngw = gridDim.x * NWAVE;
    for (int m = gw; m < NTOK; m += ngw) {
        float s = 0.f;
#pragma unroll
        for (int j = 0; j < 16; ++j) s += SSQ3[(size_t)m * 16 + j];
        const float rstd = rsqrtf(s * (1.f / 1024.f) + EPS);
#pragma unroll
        for (int j = 0; j < 4; ++j) { float4 v = *(const float4*)(OUT + (size_t)m * 1024 + j * 256 + lane * 4); const float4 gg = *(const float4*)(g + j * 256 + lane * 4);
            v.x *= rstd * gg.x; v.y *= rstd * gg.y; v.z *= rstd * gg.z; v.w *= rstd * gg.w; *(float4*)(OUT + (size_t)m * 1024 + j * 256 + lane * 4) = v; }
    }
}

template <int PH> DEV void run_phase(const Args& a, unsigned char* smem) {
    if constexpr (PH == PH_PRO) phase_prologue(a, smem);
    else if constexpr (PH == PH_INPROJ) phase_inproj(a, smem);
    else if constexpr (PH == PH_ATT) phase_att(a, smem);
    else if constexpr (PH == PH_OUTPROJ) phase_outproj(a, smem);
    else if constexpr (PH == PH_ROUTE) phase_route(a, smem);
    else if constexpr (PH == PH_UP) phase_up(a, smem);
    else if constexpr (PH == PH_DOWN) phase_down(a, smem);
    else if constexpr (PH == PH_COMB) phase_comb(a, smem);
    else if constexpr (PH == PH_GATE) phase_gate(a, smem);
    else if constexpr (PH == PH_FINAL) phase_final(a);
}
#define XB_TMO      128
#define XB_XCNT(j)  (256  + 64 * (j))
#define XB_XSUB(j)  (1280 + 64 * (j))
#define XB_XGEN(j)  (2304 + 64 * (j))
#define XB_TOP      3328
#define XB_TOPGEN   3392
#define XCD_BAR_WORDS 3456
#define XB_SPIN_CAP (1u << 22)
DEV unsigned xb_ld(unsigned* p)              { return __hip_atomic_load(p, __ATOMIC_RELAXED, __HIP_MEMORY_SCOPE_AGENT); }
DEV unsigned xb_add(unsigned* p, unsigned v) { return __hip_atomic_fetch_add(p, v, __ATOMIC_RELAXED, __HIP_MEMORY_SCOPE_AGENT); }
DEV unsigned xb_xcc_id() { return (unsigned)__builtin_amdgcn_s_getreg((3 << 11) | 20) & 0xFu; }
#define XB_SPIN(cond, bar) do { unsigned _sp = 0; while (cond) { __builtin_amdgcn_s_sleep(1); \
    if ((++_sp & 255u) == 0u) { if (xb_ld(&(bar)[XB_TMO])) break; if (_sp > XB_SPIN_CAP) { atomicAdd(&(bar)[XB_TMO], 1u); break; } } } } while (0)
struct XcdBarrier { unsigned* bar; unsigned x; volatile LAS unsigned* st; };
DEV XcdBarrier xcd_barrier_post(unsigned* bar, volatile LAS unsigned* st) {
    XcdBarrier b; b.bar = bar; b.x = xb_xcc_id(); b.st = st;
    if (TID() == 0) (void)xb_add(&bar[XB_XCNT(b.x)], 1u);
    return b;
}
DEV void xcd_barrier_complete(unsigned* bar, unsigned x, unsigned& nloc, unsigned& nx) {
    const unsigned G = gridDim.x * gridDim.y * gridDim.z;
    unsigned sum, cnt, mine, sp = 0u;
    for (;;) {
        sum = 0u; cnt = 0u; mine = 0u;
#pragma unroll
        for (unsigned j = 0; j < 16; ++j) { const unsigned c = xb_ld(&bar[XB_XCNT(j)]); sum += c; cnt += (c > 0u) ? 1u : 0u; mine = (j == x) ? c : mine; }
        if (sum == G) break;
        __builtin_amdgcn_s_sleep(1);
        if ((++sp & 255u) == 0u) { if (xb_ld(&bar[XB_TMO])) break; if (sp > XB_SPIN_CAP) { atomicAdd(&bar[XB_TMO], 1u); break; } }
    }
    nloc = mine > 0u ? mine : 1u; nx = cnt > 0u ? cnt : 1u;
}
DEV void xcd_barrier(const XcdBarrier& b) {
    asm volatile("s_waitcnt vmcnt(0)" ::: "memory");
    __syncthreads();
    if (TID() == 0) {
        unsigned* bar = b.bar;
        __builtin_amdgcn_s_waitcnt(0);
        unsigned nloc = b.st[0], nx = b.st[1];
        if (nloc == 0u) { xcd_barrier_complete(bar, b.x, nloc, nx); b.st[0] = nloc; b.st[1] = nx; }
        const unsigned old = xb_add(&bar[XB_XSUB(b.x)], 1u);
        const unsigned gen = old / nloc;
        if (old + 1u == (gen + 1u) * nloc) {
            __builtin_amdgcn_fence(__ATOMIC_RELEASE, "agent");
            asm volatile("s_waitcnt vmcnt(0)" ::: "memory");
            const unsigned og = xb_add(&bar[XB_TOP], 1u);
            const unsigned tg = og / nx;
            if (og + 1u == (tg + 1u) * nx) xb_add(&bar[XB_TOPGEN], 1u);
            else XB_SPIN(xb_ld(&bar[XB_TOPGEN]) == tg, bar);
            __builtin_amdgcn_fence(__ATOMIC_ACQUIRE, "agent");
            xb_add(&bar[XB_XGEN(b.x)], 1u);
            asm volatile("s_waitcnt vmcnt(0)" ::: "memory");
        } else {
            XB_SPIN(xb_ld(&bar[XB_XGEN(b.x)]) == gen, bar);
            __builtin_amdgcn_fence(__ATOMIC_ACQUIRE, "agent");
            asm volatile("s_waitcnt vmcnt(0)" ::: "memory");
        }
    }
    __syncthreads();
}

__global__ void __launch_bounds__(NTHR, 2) mega(Args a) {
    extern __shared__ __attribute__((aligned(16))) unsigned char smem[];
    volatile LAS unsigned* bst = (volatile LAS unsigned*)(LAS unsigned char*)(smem + MISC_OFF + 8000);
    if (TID() == 0) { bst[0] = 0u; bst[1] = 0u; }
    __syncthreads();
    const XcdBarrier bar = xcd_barrier_post((unsigned*)(a.ws + WS_CTL) + 4096, bst);
#define GSYNC() xcd_barrier(bar)
#define RUN(ph) do { run_phase<ph>(a, smem); if ((PROBE_DUP >> ph) & 1) { GSYNC(); run_phase<ph>(a, smem); } } while (0)
    RUN(PH_PRO); GSYNC();
    RUN(PH_INPROJ); GSYNC();
    RUN(PH_ATT); GSYNC();
    RUN(PH_OUTPROJ); GSYNC();
    RUN(PH_ROUTE); GSYNC();
    RUN(PH_UP); GSYNC();
    RUN(PH_DOWN); GSYNC();
    RUN(PH_COMB); GSYNC();
    RUN(PH_GATE);
    if (gridDim.x < 256) { GSYNC(); RUN(PH_FINAL); }
#undef RUN
#undef GSYNC
}

extern "C" void kernel_launch(void* const* d_in, const int* in_sizes, int n_in, void* d_out, int out_size, void* d_ws, size_t ws_size, hipStream_t stream) {
    static int grid = 0;
    if (grid == 0) {
        if (n_in != 25 || ws_size < WS_END) { fprintf(stderr, "kernel_launch: unexpected n_in %d / ws %zu\n", n_in, ws_size); grid = -1; return; }
        int dev = 0, cus = 0, per_cu = 0;
        (void)hipGetDevice(&dev); (void)hipDeviceGetAttribute(&cus, hipDeviceAttributeMultiprocessorCount, dev);
        (void)hipFuncSetAttribute((const void*)mega, hipFuncAttributeMaxDynamicSharedMemorySize, LDS_BYTES);
        (void)hipOccupancyMaxActiveBlocksPerMultiprocessor(&per_cu, (const void*)mega, NTHR, LDS_BYTES);
        if (per_cu < 1) { fprintf(stderr, "kernel_launch: occupancy query says %d blocks per CU\n", per_cu); grid = -1; return; }
        grid = cus;
    }
    if (grid < 0) return;
    (void)hipMemsetAsync((char*)d_ws + WS_CTL, 0, 65536, stream);
    Args a{};
    for (int i = 0; i < 25; ++i) a.in[i] = (const float*)d_in[i];
    a.out = (float*)d_out; a.ws = (unsigned char*)d_ws; a.ph_lo = 0; a.ph_hi = PH_N;
    void* args[] = {&a};
    hipError_t e = hipLaunchCooperativeKernel((const void*)mega, dim3(grid), dim3(NTHR), args, LDS_BYTES, stream);
    if (e != hipSuccess) fprintf(stderr, "cooperative launch failed: %s (grid %d)\n", hipGetErrorString(e), grid);
}
```

```cpp
#include <hip/hip_runtime.h>
#include <stdint.h>
#include <cstdio>

#define DEV __device__ __forceinline__
#define LAS __attribute__((address_space(3)))

typedef unsigned short bf16_t;
typedef short bf16x8 __attribute__((ext_vector_type(8)));
typedef short s16x4 __attribute__((ext_vector_type(4)));
typedef float f32x4 __attribute__((ext_vector_type(4)));
typedef float f32x16 __attribute__((ext_vector_type(16)));
typedef float f32x2_t __attribute__((ext_vector_type(2)));
typedef __bf16 bf16x2_t __attribute__((ext_vector_type(2)));

constexpr int NTHR = 512, NWAVE = 8;
constexpr int NTOK = 16384;
constexpr float EPS = 1e-6f;
constexpr float LOG2E = 1.4426950408889634f;
constexpr float QS = 0.125f * LOG2E;
constexpr int NWIN = 3072;

constexpr size_t MiB = 1u << 20;
constexpr size_t WS_CTL = 0;
constexpr size_t WS_WIN = 1 * MiB;
constexpr size_t WS_WOUT = 7 * MiB;
constexpr size_t WS_WGATE = 9 * MiB;
constexpr size_t WS_WPLE = 11 * MiB;
constexpr size_t WS_WC1 = 12 * MiB;
constexpr size_t WS_WC2 = 15 * MiB + 512 * 1024 + 262144;
constexpr size_t WS_BIAS1 = 15 * MiB + 512 * 1024 + 262144 + 131072;
constexpr size_t WS_KC = 14 * MiB;
constexpr size_t WS_HID = 14 * MiB + 512 * 1024;
constexpr size_t WS_GN = 16 * MiB;
constexpr size_t WS_LS = 18 * MiB;
constexpr size_t WS_CUM = 19 * MiB;
constexpr size_t WS_SSQ = 20 * MiB;
constexpr size_t WS_TOPI = 21 * MiB;
constexpr size_t WS_TOPS = 21 * MiB + 262144;
constexpr size_t WS_TOPW = 21 * MiB + 524288;
constexpr size_t WS_TOKOF = 22 * MiB;
constexpr size_t WS_ROWW = 24 * MiB;
constexpr size_t WS_SSQ3 = 26 * MiB;
constexpr size_t WS_RSTD2 = 27 * MiB;
constexpr size_t WS_PB = 28 * MiB;
constexpr size_t WS_XN = 36 * MiB;
constexpr size_t WS_PROJ = 68 * MiB;
constexpr size_t WS_ONSA = 160 * MiB;
constexpr size_t WS_OFOX = 176 * MiB;
constexpr size_t WS_H1 = 192 * MiB;
constexpr size_t WS_WUP = 256 * MiB;
constexpr size_t WS_WDN = 384 * MiB;
constexpr size_t WS_ACT = 448 * MiB;
constexpr size_t WS_Y = 592 * MiB;
constexpr size_t WS_RSDS = 736 * MiB;
constexpr size_t WS_END = 738 * MiB;

enum { PH_PRO = 0, PH_INPROJ, PH_CMP, PH_ATT, PH_OUTPROJ, PH_ROUTE, PH_UP, PH_DOWN, PH_COMB, PH_GATE, PH_FINAL, PH_N };
struct Args { const float* in[25]; float* out; unsigned char* ws; int ph_lo, ph_hi; };
enum { I_X = 0, I_P, I_LN1, I_WIN, I_BFG, I_WC1K, I_WC2K, I_PEK, I_WC1V, I_WC2V, I_PEV, I_GNN, I_GNF, I_WOUT, I_LN2, I_WR, I_BR,
       I_WUP, I_BUP, I_WDN, I_BDN, I_LNPLE, I_WPLE, I_WGATE, I_LNF };

DEV int BID() { int b = (int)blockIdx.x; asm volatile("" : "+s"(b)); return b; }
DEV int VBID() { const int g = (int)gridDim.x, b = BID(); return (g & 7) ? b : (b & 7) * (g >> 3) + (b >> 3); }
DEV int TID() { int t = (int)__builtin_amdgcn_workitem_id_x(); asm volatile("" : "+v"(t)); return t; }
DEV unsigned cvtpk(float lo, float hi) { f32x2_t v = {lo, hi}; bf16x2_t b = __builtin_convertvector(v, bf16x2_t); return __builtin_bit_cast(unsigned, b); }
DEV float bflo(unsigned u) { return __uint_as_float(u << 16); }
DEV float bfhi(unsigned u) { return __uint_as_float(u & 0xffff0000u); }
DEV float wave_sum(float v) {
#pragma unroll
    for (int o = 1; o < 64; o <<= 1) v += __shfl_xor(v, o);
    return v;
}
#define DPP_MOV(x, ctrl) __builtin_bit_cast(float, __builtin_amdgcn_update_dpp(0, __builtin_bit_cast(int, (x)), (ctrl), 0xF, 0xF, true))
DEV float pair_sum(float x) { return x + __shfl_xor(x, 32); }
DEV float pair_max(float x) { return fmaxf(x, __shfl_xor(x, 32)); }
DEV float quad_sum(float x) { x += DPP_MOV(x, 0xB1); x += DPP_MOV(x, 0x4E); return x; }
DEV float wave_max_u(float x) {
    x = fmaxf(x, DPP_MOV(x, 0xB1)); x = fmaxf(x, DPP_MOV(x, 0x4E)); x = fmaxf(x, DPP_MOV(x, 0x141)); x = fmaxf(x, DPP_MOV(x, 0x140));
    const float a = __builtin_bit_cast(float, __builtin_amdgcn_readlane(__builtin_bit_cast(int, x), 0)), b = __builtin_bit_cast(float, __builtin_amdgcn_readlane(__builtin_bit_cast(int, x), 16));
    const float c = __builtin_bit_cast(float, __builtin_amdgcn_readlane(__builtin_bit_cast(int, x), 32)), d = __builtin_bit_cast(float, __builtin_amdgcn_readlane(__builtin_bit_cast(int, x), 48));
    return fmaxf(fmaxf(a, b), fmaxf(c, d));
}
DEV float sigmoidf_(float x) { return __builtin_amdgcn_rcpf(1.0f + __expf(-x)); }
DEV float logsigmoidf_(float x) { return fminf(x, 0.f) - log1pf(__expf(-fabsf(x))); }
DEV float gelu_tanh(float x) { const float u = 0.7978845608028654f * (x + 0.044715f * x * x * x); const float th = 1.0f - 2.0f * __builtin_amdgcn_rcpf(__expf(2.0f * u) + 1.0f); return 0.5f * x * (1.0f + th); }
DEV s16x4 tr_read(const unsigned char* p) {
    typedef short v4i16_t __attribute__((ext_vector_type(4)));
    return __builtin_bit_cast(s16x4, __builtin_amdgcn_ds_read_tr16_b64_v4i16((LAS v4i16_t*)p));
}
DEV int crow(int r, int hi) { return (r & 3) + 8 * (r >> 2) + 4 * hi; }

constexpr int GL_STAGE = 65536;
constexpr int GEMM_LDS = 2 * GL_STAGE;
constexpr int MISC_OFF = GEMM_LDS;
constexpr int LDS_BYTES = GEMM_LDS + 16384;

DEV void glds16s(const void* sbase, unsigned voff, unsigned lds_dst) { unsigned keep;
    asm volatile("s_mov_b32 %0, m0\n\ts_mov_b32 m0, %3\n\ts_nop 0\n\tglobal_load_lds_dwordx4 %1, %2\n\ts_mov_b32 m0, %0" : "=&s"(keep) : "v"(voff), "s"(sbase), "s"(lds_dst) : "memory"); }

DEV const unsigned char* uptr(const void* p) { const unsigned long long v = (unsigned long long)p; const unsigned lo = __builtin_amdgcn_readfirstlane((unsigned)v), hi = __builtin_amdgcn_readfirstlane((unsigned)(v >> 32)); return (const unsigned char*)(((unsigned long long)hi << 32) | lo); }

DEV void lds_barrier() { asm volatile("s_waitcnt lgkmcnt(0)\n\ts_barrier" ::: "memory"); }

struct NoNextS { DEV void operator()() const {} };
template <class AO, class BO>
DEV void gemm256s_issue0(unsigned char* smem, const void* abase, const AO& aoff, const void* bbase, const BO& boff) {
    const int tid = TID(), lane = tid & 63; const int wid = __builtin_amdgcn_readfirstlane(tid >> 6);
    const unsigned lds0 = (unsigned)(uintptr_t)smem; const unsigned char* ab_ = uptr(abase); const unsigned char* bb_ = uptr(bbase);
#pragma unroll
    for (int i = 0; i < 4; ++i) { const int p = wid + 8 * i; glds16s(ab_, aoff(8 * p + (lane >> 3), (lane & 7) ^ (lane >> 3)), (unsigned)__builtin_amdgcn_readfirstlane(lds0 + p * 1024)); }
#pragma unroll
    for (int i = 0; i < 4; ++i) { const int p = wid + 8 * i; const int k = 2 * p + (lane >> 5); const int f = (k & 3) + 4 * ((k >> 3) & 1);
        glds16s(bb_, boff(k, (lane & 31) ^ (f << 1)), (unsigned)__builtin_amdgcn_readfirstlane(lds0 + 32768 + p * 1024)); }
}
template <bool ZERO, class AO, class BO, class NX = NoNextS>
DEV void gemm256s(unsigned char* smem, int nkt, const void* abase, unsigned akstep, const AO& aoff, const void* bbase, unsigned bkstep, const BO& boff, f32x4 (&acc)[8][4], bool pre = false, const NX& next = NX()) {
    const int tid = TID(), lane = tid & 63; const int wid = __builtin_amdgcn_readfirstlane(tid >> 6); const int wr = wid >> 2, wc = wid & 3;
    if (ZERO) {
#pragma unroll
        for (int mi = 0; mi < 8; ++mi)
#pragma unroll
            for (int ni = 0; ni < 4; ++ni) acc[mi][ni] = (f32x4){0.f, 0.f, 0.f, 0.f};
    }
    const unsigned lds0 = (unsigned)(uintptr_t)smem;
    const unsigned char* abase_u = uptr(abase); const unsigned char* bbase_u = uptr(bbase); const unsigned akstep_u = __builtin_amdgcn_readfirstlane(akstep), bkstep_u = __builtin_amdgcn_readfirstlane(bkstep);
    unsigned ao[4], bo[4];
#pragma unroll
    for (int i = 0; i < 4; ++i) { const int p = wid + 8 * i; ao[i] = aoff(8 * p + (lane >> 3), (lane & 7) ^ (lane >> 3));
        const int k = 2 * p + (lane >> 5); const int f = (k & 3) + 4 * ((k >> 3) & 1); bo[i] = boff(k, (lane & 31) ^ (f << 1)); }
#define GL_ISSUE(kt, st) do { const unsigned char* ab_ = abase_u + (size_t)(kt) * akstep_u; const unsigned char* bb_ = bbase_u + (size_t)(kt) * bkstep_u; \
        _Pragma("unroll") for (int i_ = 0; i_ < 4; ++i_) glds16s(ab_, ao[i_], (unsigned)__builtin_amdgcn_readfirstlane(lds0 + (st) * GL_STAGE + (wid + 8 * i_) * 1024)); \
        _Pragma("unroll") for (int i_ = 0; i_ < 4; ++i_) glds16s(bb_, bo[i_], (unsigned)__builtin_amdgcn_readfirstlane(lds0 + (st) * GL_STAGE + 32768 + (wid + 8 * i_) * 1024)); } while (0)
    if (!pre) {
        GL_ISSUE(0, 0);
        asm volatile("s_waitcnt vmcnt(0)" ::: "memory");
        __syncthreads();
    }
    for (int kt = 0; kt < nkt; ++kt) {
        if (kt + 1 < nkt) GL_ISSUE(kt + 1, (kt + 1) & 1); else next();
        const unsigned char* A = smem + (kt & 1) * GL_STAGE; const unsigned char* Bt = A + 32768;
#pragma unroll
        for (int ks = 0; ks < 2; ++ks) {
            bf16x8 wf[4];
#pragma unroll
            for (int ni = 0; ni < 4; ++ni) {
                const int i = lane & 15, g = lane >> 4, q = i >> 2; const int row = ks * 32 + 8 * g + q; const int nc = wc * 8 + ni * 2 + ((i & 3) >> 1); const int f = q + 4 * (g & 1);
                const unsigned char* p = Bt + row * 512 + ((nc ^ (f << 1)) << 4) + (i & 1) * 8;
                const s16x4 lo = tr_read(p), hi = tr_read(p + 4 * 512);
                wf[ni] = (bf16x8){lo[0], lo[1], lo[2], lo[3], hi[0], hi[1], hi[2], hi[3]};
            }
#pragma unroll
            for (int mi = 0; mi < 8; ++mi) {
                const int m = wr * 128 + mi * 16 + (lane & 15); const int kc = ks * 4 + (lane >> 4);
                const bf16x8 af = *(const bf16x8*)(A + m * 128 + ((kc ^ (m & 7)) << 4));
#pragma unroll
                for (int ni = 0; ni < 4; ++ni) acc[mi][ni] = __builtin_amdgcn_mfma_f32_16x16x32_bf16(wf[ni], af, acc[mi][ni], 0, 0, 0);
            }
        }
        asm volatile("s_waitcnt vmcnt(0)" ::: "memory");
        __syncthreads();
    }
#undef GL_ISSUE
}

#define G_ROW(mi) ((((mi) >> 2) * 128) + wr * 64 + (((mi) & 3) * 16) + (lane & 15))
#define G_COL(ni) ((((ni) >> 1) * 128) + wc * 32 + (((ni) & 1) * 16) + 4 * (lane >> 4))
#define WAIT_V(n) asm volatile("s_waitcnt vmcnt(" #n ")" ::: "memory")
#define WAIT_L(n) asm volatile("s_waitcnt lgkmcnt(" #n ")" ::: "memory")
#define BAR() __builtin_amdgcn_s_barrier()
#define SCHED() __builtin_amdgcn_sched_barrier(0)
constexpr int SA_(int b, int h) { return b * GL_STAGE + h * 16384; }
constexpr int SB_(int b, int h) { return b * GL_STAGE + 32768 + h * 16384; }
struct NoNext { DEV bool has() const { return false; } template <int P> DEV void issue() const {} };
template <int WHICH, class AO, class BO>
DEV void gemm_issue0(unsigned char* smem, const void* abase, const AO& aoff, const void* bbase, const BO& boff) {
    const int tid = TID(), lane = tid & 63; const int wid = __builtin_amdgcn_readfirstlane(tid >> 6);
    const unsigned lds0 = (unsigned)(uintptr_t)smem; const unsigned char* ab_ = uptr(abase); const unsigned char* bb_ = uptr(bbase);
#pragma unroll
    for (int h = 0; h < 2; ++h) {
        if (WHICH & (1 << (2 * h))) {
#pragma unroll
            for (int i = 0; i < 2; ++i) { const int p = wid + 8 * i; const int k = 4 * p + (lane >> 4); const int f = (k & 3) + 4 * ((k >> 3) & 1);
                glds16s(bb_, boff(k, h * 16 + ((lane & 15) ^ (f << 1))), (unsigned)__builtin_amdgcn_readfirstlane(lds0 + SB_(0, h) + p * 1024)); } }
        if (WHICH & (2 << (2 * h))) {
#pragma unroll
            for (int i = 0; i < 2; ++i) { const int p = wid + 8 * i;
                glds16s(ab_, aoff(h * 128 + 8 * p + (lane >> 3), (lane & 7) ^ (lane >> 3)), (unsigned)__builtin_amdgcn_readfirstlane(lds0 + SA_(0, h) + p * 1024)); } }
    }
}
template <class AO, class BO>
struct NextTile { bool on; unsigned char* smem; const void* abase; AO aoff; const void* bbase; BO boff;
    DEV bool has() const { return on; }
    template <int P> DEV void issue() const { gemm_issue0<P>(smem, abase, aoff, bbase, boff); } };
template <class AO, class BO> DEV NextTile<AO, BO> next_tile(bool on, unsigned char* smem, const void* abase, const AO& aoff, const void* bbase, const BO& boff) { return NextTile<AO, BO>{on, smem, abase, aoff, bbase, boff}; }
template <bool ZERO, class AO, class BO, class NX = NoNext>
DEV void gemm256(unsigned char* smem, int nkt, const void* abase, unsigned akstep, const AO& aoff, const void* bbase, unsigned bkstep, const BO& boff, f32x4 (&acc)[8][4], bool pre = false, const NX& next = NX()) {
    const int tid = TID(), lane = tid & 63; const int wid = __builtin_amdgcn_readfirstlane(tid >> 6); const int wr = wid >> 2, wc = wid & 3;
    if (ZERO) {
#pragma unroll
        for (int mi = 0; mi < 8; ++mi)
#pragma unroll
            for (int ni = 0; ni < 4; ++ni) acc[mi][ni] = (f32x4){0.f, 0.f, 0.f, 0.f};
    }
    const unsigned lds0 = (unsigned)(uintptr_t)smem;
    const unsigned char* abase_u = uptr(abase); const unsigned char* bbase_u = uptr(bbase); const unsigned akstep_u = __builtin_amdgcn_readfirstlane(akstep), bkstep_u = __builtin_amdgcn_readfirstlane(bkstep);
    unsigned ao[4], bo[4];
#pragma unroll
    for (int h = 0; h < 2; ++h)
#pragma unroll
        for (int i = 0; i < 2; ++i) { const int p = wid + 8 * i; ao[h * 2 + i] = aoff(h * 128 + 8 * p + (lane >> 3), (lane & 7) ^ (lane >> 3));
            const int k = 4 * p + (lane >> 4); const int f = (k & 3) + 4 * ((k >> 3) & 1); bo[h * 2 + i] = boff(k, h * 16 + ((lane & 15) ^ (f << 1))); }
    const unsigned char* ard0; const unsigned char* ard1; const unsigned char* brd0; const unsigned char* brd1;
    { const int l15 = lane & 15, g = lane >> 4, q = l15 >> 2; const int f = q + 4 * (g & 1);
      ard0 = smem + (wr * 64 + l15) * 128 + ((g ^ (lane & 7)) << 4); ard1 = smem + (wr * 64 + l15) * 128 + (((4 + g) ^ (lane & 7)) << 4);
      const int nc = wc * 4 + ((l15 & 3) >> 1); const int kr = 8 * g + q;
      brd0 = smem + kr * 256 + ((nc ^ (f << 1)) << 4) + (l15 & 1) * 8; brd1 = smem + kr * 256 + (((nc + 2) ^ (f << 1)) << 4) + (l15 & 1) * 8; }
#define ST_A(b, h, kt) do { const unsigned char* ab_ = abase_u + (size_t)(kt) * akstep_u; \
        _Pragma("unroll") for (int i_ = 0; i_ < 2; ++i_) glds16s(ab_, ao[(h) * 2 + i_], (unsigned)__builtin_amdgcn_readfirstlane(lds0 + SA_(b, h) + (wid + 8 * i_) * 1024)); } while (0)
#define ST_B(b, h, kt) do { const unsigned char* bb_ = bbase_u + (size_t)(kt) * bkstep_u; \
        _Pragma("unroll") for (int i_ = 0; i_ < 2; ++i_) glds16s(bb_, bo[(h) * 2 + i_], (unsigned)__builtin_amdgcn_readfirstlane(lds0 + SB_(b, h) + (wid + 8 * i_) * 1024)); } while (0)
#define LDA(dst, b, h) do { _Pragma("unroll") for (int m_ = 0; m_ < 4; ++m_) { dst[m_][0] = *(const bf16x8*)(ard0 + SA_(b, h) + m_ * 2048); dst[m_][1] = *(const bf16x8*)(ard1 + SA_(b, h) + m_ * 2048); } } while (0)
#define LDB(dst, b, h) do { _Pragma("unroll") for (int n_ = 0; n_ < 2; ++n_) _Pragma("unroll") for (int k_ = 0; k_ < 2; ++k_) { const unsigned char* p_ = (n_ ? brd1 : brd0) + SB_(b, h) + k_ * 8192; \
        const s16x4 lo_ = tr_read(p_), hi_ = tr_read(p_ + 1024); dst[n_][k_] = (bf16x8){lo_[0], lo_[1], lo_[2], lo_[3], hi_[0], hi_[1], hi_[2], hi_[3]}; } } while (0)
#define MMA(ai, bj, Bx) do { __builtin_amdgcn_s_setprio(1); \
        _Pragma("unroll") for (int k_ = 0; k_ < 2; ++k_) _Pragma("unroll") for (int m_ = 0; m_ < 4; ++m_) _Pragma("unroll") for (int n_ = 0; n_ < 2; ++n_) \
            acc[(ai) * 4 + m_][(bj) * 2 + n_] = __builtin_amdgcn_mfma_f32_16x16x32_bf16(Bx[n_][k_], At[m_][k_], acc[(ai) * 4 + m_][(bj) * 2 + n_], 0, 0, 0); \
        __builtin_amdgcn_s_setprio(0); } while (0)
    bf16x8 At[4][2], B0[2][2], B1[2][2];
    if (!pre) { ST_B(0, 0, 0); ST_A(0, 0, 0); ST_B(0, 1, 0); ST_A(0, 1, 0); }
    if (wr == 1) BAR();
    if (!pre) WAIT_V(4);
    BAR();
    ST_B(1, 0, 1); ST_A(1, 0, 1); ST_B(1, 1, 1);
    if (!pre) WAIT_V(6);
    BAR();
    for (int t = 0; t < nkt - 2; t += 2) {
        LDB(B0, 0, 0); SCHED(); LDA(At, 0, 0); ST_A(1, 1, t + 1);
        WAIT_L(8); BAR(); WAIT_L(0); MMA(0, 0, B0); BAR(); SCHED();
        LDB(B1, 0, 1); ST_B(0, 0, t + 2);
        BAR(); WAIT_L(0); MMA(0, 1, B1); BAR();
        LDA(At, 0, 1); ST_A(0, 0, t + 2);
        BAR(); WAIT_L(0); MMA(1, 0, B0); BAR(); SCHED();
        ST_B(0, 1, t + 2);
        WAIT_V(6); BAR(); MMA(1, 1, B1); BAR();
        LDB(B0, 1, 0); SCHED(); LDA(At, 1, 0); ST_A(0, 1, t + 2);
        WAIT_L(8); BAR(); WAIT_L(0); MMA(0, 0, B0); BAR(); SCHED();
        LDB(B1, 1, 1); ST_B(1, 0, t + 3);
        BAR(); WAIT_L(0); MMA(0, 1, B1); BAR();
        LDA(At, 1, 1); ST_A(1, 0, t + 3);
        BAR(); WAIT_L(0); MMA(1, 0, B0); BAR(); SCHED();
        ST_B(1, 1, t + 3);
        WAIT_V(6); BAR(); MMA(1, 1, B1); BAR();
    }
    const bool hn = next.has();
    LDB(B0, 0, 0); LDA(At, 0, 0); ST_A(1, 1, nkt - 1);
    BAR(); WAIT_L(0); MMA(0, 0, B0); BAR();
    LDB(B1, 0, 1); BAR(); WAIT_L(0); MMA(0, 1, B1); BAR();
    LDA(At, 0, 1);
    if (hn) { next.template issue<3>(); WAIT_V(8); } else WAIT_V(4);
    BAR(); WAIT_L(0); MMA(1, 0, B0); MMA(1, 1, B1); BAR();
    LDB(B0, 1, 0); LDA(At, 1, 0);
    if (hn) { next.template issue<4>(); WAIT_V(8); } else WAIT_V(2);
    BAR(); WAIT_L(0); MMA(0, 0, B0); BAR();
    LDB(B1, 1, 1);
    if (hn) { next.template issue<8>(); WAIT_V(8); } else WAIT_V(0);
    BAR(); WAIT_L(0); MMA(0, 1, B1); BAR();
    LDA(At, 1, 1); BAR(); WAIT_L(0); MMA(1, 0, B0); MMA(1, 1, B1);
    WAIT_V(0);
    BAR();
    if (wr == 0) BAR();
#undef ST_A
#undef ST_B
#undef LDA
#undef LDB
#undef MMA
}

#define EPI_IDS() do { const int etid_ = TID(); lane = etid_ & 63; wid = etid_ >> 6; wr = wid >> 2; wc = wid & 3; } while (0)

DEV void patch_decode(int local, int MT, int NT, int& mt, int& nt) {
    const int per_mtb = 8 * NT; const int mtb = local / per_mtb; const int rem = local - mtb * per_mtb;
    const int rows = (MT - 8 * mtb) < 8 ? (MT - 8 * mtb) : 8;
    const int per_ntb = rows * 8; const int nfull = NT >> 3; int ntb = rem / per_ntb; int cols = 8;
    if (ntb >= nfull) { ntb = nfull; cols = NT - 8 * nfull; }
    const int r2 = rem - ntb * per_ntb;
    mt = 8 * mtb + r2 / cols; nt = 8 * ntb + r2 % cols;
}

DEV void convert_chunk(const float* src, bf16_t* dst, size_t i8) {
    const float4 a = *(const float4*)(src + i8 * 8), b = *(const float4*)(src + i8 * 8 + 4);
    uint4 o; o.x = cvtpk(a.x, a.y); o.y = cvtpk(a.z, a.w); o.z = cvtpk(b.x, b.y); o.w = cvtpk(b.z, b.w);
    *(uint4*)(dst + i8 * 8) = o;
}
DEV void phase_prologue(const Args& a, unsigned char* smem) {
    unsigned char* ws = a.ws;
    const size_t gtid = (size_t)BID() * NTHR + TID(), gn = (size_t)gridDim.x * NTHR;
    {
        { const float* W = a.in[I_WOUT]; bf16_t* O = (bf16_t*)(ws + WS_WOUT); const float* gnn = a.in[I_GNN]; const float* gnf = a.in[I_GNF];
          for (size_t i = gtid; i < (size_t)1024 * 128; i += gn) { const int k = (int)(i >> 7); const float g_ = k < 512 ? gnn[k] : gnf[k - 512];
              const float4 x = *(const float4*)(W + i * 8), y = *(const float4*)(W + i * 8 + 4);
              uint4 o; o.x = cvtpk(x.x * g_, x.y * g_); o.y = cvtpk(x.z * g_, x.w * g_); o.z = cvtpk(y.x * g_, y.y * g_); o.w = cvtpk(y.z * g_, y.w * g_); *(uint4*)(O + i * 8) = o; } }
        const float* srcs[3] = {a.in[I_WGATE], a.in[I_WPLE], a.in[I_P]};
        bf16_t* dsts[3] = {(bf16_t*)(ws + WS_WGATE), (bf16_t*)(ws + WS_WPLE), (bf16_t*)(ws + WS_PB)};
        const size_t cnt8[3] = {1024 * 1024 / 8, 256 * 1024 / 8, (size_t)NTOK * 256 / 8};
#pragma unroll
        for (int s = 0; s < 3; ++s) for (size_t i = gtid; i < cnt8[s]; i += gn) convert_chunk(srcs[s], dsts[s], i);
        for (size_t i = gtid; i < (size_t)2 * 2048 * 32; i += gn) { const int which = (int)(i / (2048 * 32)); const int k = (int)(i / 32) % 2048, c8 = (int)(i % 32) * 8;
            uint4 o = {0u, 0u, 0u, 0u};
            if (c8 < 128) { const float* W = a.in[which ? I_WC1V : I_WC1K] + (size_t)k * 128 + c8; const float4 x = *(const float4*)W, y = *(const float4*)(W + 4); o.x = cvtpk(x.x, x.y); o.y = cvtpk(x.z, x.w); o.z = cvtpk(y.x, y.y); o.w = cvtpk(y.z, y.w); }
            *(uint4*)((bf16_t*)(ws + WS_WC1) + i * 8) = o; }
        for (size_t i = gtid; i < (size_t)2 * 128 * 32; i += gn) { const int which = (int)(i / (128 * 32)); const int k = (int)(i / 32) % 128, c8 = (int)(i % 32) * 8;
            uint4 o = {0u, 0u, 0u, 0u};
            if (c8 < 64) { const float* W = a.in[which ? I_WC2V : I_WC2K] + (size_t)k * 64 + c8; const float4 x = *(const float4*)W, y = *(const float4*)(W + 4); o.x = cvtpk(x.x, x.y); o.y = cvtpk(x.z, x.w); o.z = cvtpk(y.x, y.y); o.w = cvtpk(y.z, y.w); }
            *(uint4*)((bf16_t*)(ws + WS_WC2) + i * 8) = o; }
    }
    {
        const float* W = a.in[I_WIN]; bf16_t* O = (bf16_t*)(ws + WS_WIN);
        for (size_t i = gtid; i < (size_t)1024 * (NWIN / 8); i += gn) {
            const int k = (int)(i / (NWIN / 8)), j = (int)(i % (NWIN / 8)) * 8;
            uint4 o = {0u, 0u, 0u, 0u};
            if (j < 2848) {
                const int sj = (j < 1280) ? j : (j < 2816) ? j + 24 : (j < 2840) ? j - 1536 : j;
                const float4 x = *(const float4*)(W + (size_t)k * 2848 + sj), y = *(const float4*)(W + (size_t)k * 2848 + sj + 4);
                o.x = cvtpk(x.x, x.y); o.y = cvtpk(x.z, x.w); o.z = cvtpk(y.x, y.y); o.w = cvtpk(y.z, y.w);
            }
            *(uint4*)(O + (size_t)k * NWIN + j) = o;
        }
    }
    const int lane = TID() & 63; const int gw = BID() * NWAVE + (TID() >> 6), ngw = gridDim.x * NWAVE;
    {
        const float* X = a.in[I_X]; const float* g = a.in[I_LN1]; bf16_t* XN = (bf16_t*)(ws + WS_XN);
        for (int m = gw; m < NTOK; m += ngw) {
            float4 v[4]; float s = 0.f;
#pragma unroll
            for (int j = 0; j < 4; ++j) { v[j] = *(const float4*)(X + (size_t)m * 1024 + j * 256 + lane * 4); s += v[j].x * v[j].x + v[j].y * v[j].y + v[j].z * v[j].z + v[j].w * v[j].w; }
            const float rstd = rsqrtf(wave_sum(s) * (1.f / 1024.f) + EPS);
#pragma unroll
            for (int j = 0; j < 4; ++j) { const float4 gg = *(const float4*)(g + j * 256 + lane * 4);
                uint2 o; o.x = cvtpk(v[j].x * rstd * gg.x, v[j].y * rstd * gg.y); o.y = cvtpk(v[j].z * rstd * gg.z, v[j].w * rstd * gg.w);
                *(uint2*)(XN + (size_t)m * 1024 + j * 256 + lane * 4) = o; }
        }
    }
    if (gw < 256) {
        const int which = gw >> 7, n = gw & 127; const float* pe = a.in[which ? I_PEV : I_PEK]; const float* w1 = a.in[which ? I_WC1V : I_WC1K];
        float s = 0.f;
#pragma unroll 8
        for (int i = 0; i < 32; ++i) { const int k = lane + 64 * i; s += pe[k] * w1[(size_t)k * 128 + n]; }
        s = wave_sum(s);
        if (lane == 0) ((float*)(ws + WS_BIAS1))[which * 128 + n] = s;
    }
}

DEV void phase_inproj(const Args& a, unsigned char* smem) {
    const bf16_t* XN = (const bf16_t*)(a.ws + WS_XN); const bf16_t* W = (const bf16_t*)(a.ws + WS_WIN);
    bf16_t* PROJ = (bf16_t*)(a.ws + WS_PROJ); float* GN = (float*)(a.ws + WS_GN); float* LS = (float*)(a.ws + WS_LS); const float* bfg = a.in[I_BFG];
    int lane = TID() & 63, wid = TID() >> 6, wr = wid >> 2, wc = wid & 3; (void)wr; (void)wc; (void)lane;
    bool pre = false;
    for (int item = VBID(); item < 64 * 12; item += gridDim.x) {
        int mt, nt; patch_decode(item, 64, 12, mt, nt);
        const int nitem = item + (int)gridDim.x; const bool has_next = nitem < 64 * 12; int mtn = 0, ntn = 0; if (has_next) patch_decode(nitem, 64, 12, mtn, ntn);
        f32x4 acc[8][4];
        auto aoffi = [](int r, int kc) { return (unsigned)(r * 2048 + kc * 16); }; auto boffi = [](int k, int nc) { return (unsigned)(k * (NWIN * 2) + nc * 16); };
        gemm256<true>(smem, 16, XN + (size_t)mt * 256 * 1024, 128u, aoffi, W + nt * 256, (unsigned)(64 * NWIN * 2), boffi, acc, pre,
                      next_tile(has_next, smem, XN + (size_t)mtn * 256 * 1024, aoffi, W + ntn * 256, boffi));
        pre = has_next;
        EPI_IDS();
#pragma unroll
        for (int mi = 0; mi < 8; ++mi) {
            const int gm = mt * 256 + G_ROW(mi); const int b = gm >> 13, t = gm & 8191;
#pragma unroll
            for (int ni = 0; ni < 4; ++ni) {
                const int n = G_COL(ni); const f32x4 v = acc[mi][ni];
                if (nt < 11) {
                    const int hs = nt * 4 + (n >> 6), d = n & 63; const float sc = (hs < 8 || (hs >= 20 && hs < 28)) ? QS : 1.0f;
                    uint2 o; o.x = cvtpk(v[0] * sc, v[1] * sc); o.y = cvtpk(v[2] * sc, v[3] * sc);
                    *(uint2*)(PROJ + (((size_t)(hs * 2 + b)) * 8192 + t) * 64 + d) = o;
                } else if (n < 24) {
#pragma unroll
                    for (int r = 0; r < 4; ++r) GN[(size_t)gm * 24 + n + r] = sigmoidf_(v[r]);
                } else if (n < 32) {
#pragma unroll
                    for (int r = 0; r < 4; ++r) { const int h = n - 24 + r; LS[((size_t)(b * 8 + h)) * 8192 + t] = logsigmoidf_(v[r] + bfg[h]); }
                }
            }
        }
    }
}

DEV void signal_done(unsigned* flag) {
    asm volatile("s_waitcnt vmcnt(0)" ::: "memory");
    __syncthreads();
    if (TID() == 0) { __builtin_amdgcn_fence(__ATOMIC_RELEASE, "agent"); asm volatile("s_waitcnt vmcnt(0)" ::: "memory"); __hip_atomic_fetch_add(flag, 1u, __ATOMIC_RELAXED, __HIP_MEMORY_SCOPE_AGENT); }
}
DEV void wait_flag(unsigned* flag, unsigned target) {
    if (TID() == 0) { unsigned sp = 0u; while (__hip_atomic_load(flag, __ATOMIC_RELAXED, __HIP_MEMORY_SCOPE_AGENT) < target) { __builtin_amdgcn_s_sleep(4); if (++sp > (1u << 24)) break; }
        __builtin_amdgcn_fence(__ATOMIC_ACQUIRE, "agent"); asm volatile("s_waitcnt vmcnt(0)" ::: "memory"); }
    __syncthreads();
}
constexpr int CW_CUMFLAG = 128, CW_CMPFLAG = 192, CW_GATEFLAG = 256;
DEV void cmp_item(const Args& a, unsigned char* smem, int item) {
    const bf16_t* PROJ = (const bf16_t*)(a.ws + WS_PROJ);
    const int tid = TID(); int lane = tid & 63, wid = tid >> 6, wr = wid >> 2, wc = wid & 3; (void)wr; (void)wc; (void)lane;
    {
        if (item < 16) {
            const int which = item >> 3, b = (item >> 2) & 1, g = (item >> 1) & 1, mt = item & 1;
            const bf16_t* base = PROJ + ((size_t)((8 + 2 * which + g) * 2 + b)) * 8192 * 64;
            const bf16_t* W1 = (const bf16_t*)(a.ws + WS_WC1) + (size_t)which * 2048 * 256;
            const bf16_t* W2 = (const bf16_t*)(a.ws + WS_WC2) + (size_t)which * 128 * 256;
            const float* bias1 = (const float*)(a.ws + WS_BIAS1) + which * 128;
            bf16_t* HID = (bf16_t*)(a.ws + WS_HID) + ((size_t)(which * 4 + b * 2 + g)) * 512 * 128;
            bf16_t* OUT = (bf16_t*)(a.ws + WS_KC) + ((size_t)(which * 4 + b * 2 + g)) * 512 * 64;
            f32x4 acc[8][4];
            gemm256s<true>(smem, 32, base, 128u, [&](int r, int kc) { int c = mt * 256 + r; c = c > 510 ? 510 : c; return (unsigned)(c * 2048 + kc * 16); },
                          W1, 64u * 512u, [&](int k, int nc) { return (unsigned)(k * 512 + nc * 16); }, acc);
        EPI_IDS();
            if (wc < 2) {
#pragma unroll
                for (int mi = 0; mi < 8; ++mi) { const int c = mt * 256 + wr * 128 + mi * 16 + (lane & 15);
#pragma unroll
                    for (int ni = 0; ni < 4; ++ni) { const int n = wc * 64 + ni * 16 + 4 * (lane >> 4); const f32x4 v = acc[mi][ni]; const float4 bb = *(const float4*)(bias1 + n);
                        uint2 o; o.x = cvtpk(gelu_tanh(v[0] + bb.x), gelu_tanh(v[1] + bb.y)); o.y = cvtpk(gelu_tanh(v[2] + bb.z), gelu_tanh(v[3] + bb.w));
                        *(uint2*)(HID + (size_t)c * 128 + n) = o; } }
            }
            __syncthreads();
            gemm256s<true>(smem, 2, HID + (size_t)mt * 256 * 128, 128u, [&](int r, int kc) { return (unsigned)(r * 256 + kc * 16); },
                          W2, 64u * 512u, [&](int k, int nc) { return (unsigned)(k * 512 + nc * 16); }, acc);
        EPI_IDS();
            if (wc == 0) {
#pragma unroll
                for (int mi = 0; mi < 8; ++mi) { const int c = mt * 256 + wr * 128 + mi * 16 + (lane & 15);
#pragma unroll
                    for (int ni = 0; ni < 4; ++ni) { const int n = ni * 16 + 4 * (lane >> 4); const f32x4 v = acc[mi][ni];
                        uint2 o; o.x = cvtpk(v[0], v[1]); o.y = cvtpk(v[2], v[3]);
                        if (c >= 511) { o.x = 0u; o.y = 0u; }
                        *(uint2*)(OUT + (size_t)c * 64 + n) = o; } }
            }
            signal_done((unsigned*)(a.ws + WS_CTL) + CW_CMPFLAG);
        } else {
            const int bh = item - 16; const float* LS = (const float*)(a.ws + WS_LS) + (size_t)bh * 8192; float* CUM = (float*)(a.ws + WS_CUM) + (size_t)bh * 8192;
            float* sc = (float*)smem;
            float v[16]; float s = 0.f;
#pragma unroll
            for (int j = 0; j < 4; ++j) { const float4 x = *(const float4*)(LS + tid * 16 + j * 4); v[4 * j] = x.x; v[4 * j + 1] = x.y; v[4 * j + 2] = x.z; v[4 * j + 3] = x.w; }
#pragma unroll
            for (int j = 0; j < 16; ++j) { s += v[j]; v[j] = s; }
            sc[tid] = s; __syncthreads();
            if (tid == 0) { float run = 0.f; for (int i = 0; i < NTHR; ++i) { const float x = sc[i]; sc[i] = run; run += x; } }
            __syncthreads();
            const float off = sc[tid];
#pragma unroll
            for (int j = 0; j < 4; ++j) { float4 o = {v[4 * j] + off, v[4 * j + 1] + off, v[4 * j + 2] + off, v[4 * j + 3] + off}; *(float4*)(CUM + tid * 16 + j * 4) = o; }
            signal_done((unsigned*)(a.ws + WS_CTL) + CW_CUMFLAG + bh);
        }
    }
}

constexpr int AT_STAGE = 16384;
constexpr int AT_BIAS_OFF = 3 * AT_STAGE;
constexpr int AT_IMP_OFF = AT_BIAS_OFF + 1024;
constexpr int AT_SEL_OFF = AT_IMP_OFF + 65536;
constexpr int AT_WUN_OFF = AT_SEL_OFF + 1024;
constexpr int AT_UCNT_OFF = AT_WUN_OFF + 128;
constexpr int AT_ULIST_OFF = AT_UCNT_OFF + 16;
constexpr int AT_ITEM_OFF = AT_ULIST_OFF + 128;
static_assert(AT_ITEM_OFF + 16 <= GEMM_LDS, "attention LDS map");
#define NEG_INF (-__builtin_inff())

#define KV_DECL uint4 rk0_, rv0_
#define KV_GLOAD(Kt, Vt) do { rk0_ = *(const uint4*)((Kt) + tid * 8); rv0_ = *(const uint4*)((Vt) + tid * 8); } while (0)
#define KV_LSTORE(stp) do { unsigned char* st_ = (stp); const int key = tid >> 3, ch = tid & 7; \
      *(uint4*)(st_ + key * 128 + ((ch ^ (key & 7)) << 4)) = rk0_; \
      *(uint4*)(st_ + 8192 + key * 128 + ((((ch >> 2) ^ ((key >> 1) & 1))) << 6) + ((ch & 3) << 4)) = rv0_; } while (0)
template <bool FULL>
DEV void qk_tile(const unsigned char* Kst, const bf16x8 (&qf)[4], f32x16& p0, f32x16& p1, int lane) {
    const int key = lane & 31, hi = lane >> 5;
    if (FULL) {
        bf16x8 k0[4], k1[4];
#pragma unroll
        for (int ks = 0; ks < 4; ++ks) { const int ch = 2 * ks + hi; const int off = key * 128 + ((ch ^ (key & 7)) << 4);
            k0[ks] = *(const bf16x8*)(Kst + off); k1[ks] = *(const bf16x8*)(Kst + off + 32 * 128); }
        __builtin_amdgcn_sched_barrier(0);
#pragma unroll
        for (int ks = 0; ks < 4; ++ks) {
            p0 = __builtin_amdgcn_mfma_f32_32x32x16_bf16(k0[ks], qf[ks], p0, 0, 0, 0);
            p1 = __builtin_amdgcn_mfma_f32_32x32x16_bf16(k1[ks], qf[ks], p1, 0, 0, 0); }
    } else {
        bf16x8 kk[4];
#pragma unroll
        for (int ks = 0; ks < 4; ++ks) { const int ch = 2 * ks + hi; kk[ks] = *(const bf16x8*)(Kst + key * 128 + ((ch ^ (key & 7)) << 4)); }
        __builtin_amdgcn_sched_barrier(0);
#pragma unroll
        for (int ks = 0; ks < 4; ++ks) p0 = __builtin_amdgcn_mfma_f32_32x32x16_bf16(kk[ks], qf[ks], p0, 0, 0, 0);
        __builtin_amdgcn_sched_barrier(0);
#pragma unroll
        for (int ks = 0; ks < 4; ++ks) { const int ch = 2 * ks + hi; kk[ks] = *(const bf16x8*)(Kst + key * 128 + ((ch ^ (key & 7)) << 4) + 32 * 128); }
        __builtin_amdgcn_sched_barrier(0);
#pragma unroll
        for (int ks = 0; ks < 4; ++ks) p1 = __builtin_amdgcn_mfma_f32_32x32x16_bf16(kk[ks], qf[ks], p1, 0, 0, 0);
    }
}
template <bool FULL>
DEV void pv_tile(const unsigned char* Vst, const f32x16& p0, const f32x16& p1, f32x16 (&o)[2], int lane) {
    const int hi = lane >> 5, i = lane & 15, gg = (lane >> 4) & 1;
    const int q = i >> 2; const int sw = (q >> 1) & 1;
    bf16x8 pa[4];
#pragma unroll
    for (int s = 0; s < 4; ++s) { const f32x16& p = (s < 2) ? p0 : p1; const int b = (s & 1) * 8;
        unsigned w[4];
#pragma unroll
        for (int j = 0; j < 4; ++j) w[j] = cvtpk(p[b + 2 * j], p[b + 2 * j + 1]);
        typedef unsigned u32x4_t __attribute__((ext_vector_type(4)));
        u32x4_t ww = {w[0], w[1], w[2], w[3]}; pa[s] = __builtin_bit_cast(bf16x8, ww); }
    constexpr int NB = FULL ? 1 : 2, SB = FULL ? 4 : 2;
#pragma unroll
    for (int bt = 0; bt < NB; ++bt) {
        s16x4 vlo[SB][2], vhi[SB][2];
#pragma unroll
        for (int s_ = 0; s_ < SB; ++s_)
#pragma unroll
            for (int dh = 0; dh < 2; ++dh) { const int s = bt * SB + s_; const int row0 = 16 * s + 4 * hi + q;
                const unsigned char* p = Vst + row0 * 128 + ((dh ^ sw) << 6) + gg * 32 + (i & 3) * 8;
                vlo[s_][dh] = tr_read(p); vhi[s_][dh] = tr_read(p + 8 * 128); }
        __builtin_amdgcn_sched_barrier(0);
#pragma unroll
        for (int s_ = 0; s_ < SB; ++s_)
#pragma unroll
            for (int dh = 0; dh < 2; ++dh) { const int s = bt * SB + s_;
                const bf16x8 vf = {vlo[s_][dh][0], vlo[s_][dh][1], vlo[s_][dh][2], vlo[s_][dh][3], vhi[s_][dh][0], vhi[s_][dh][1], vhi[s_][dh][2], vhi[s_][dh][3]};
                o[dh] = __builtin_amdgcn_mfma_f32_32x32x16_bf16(vf, pa[s], o[dh], 0, 0, 0); }
        __builtin_amdgcn_sched_barrier(0);
    }
}
DEV float rowmax32(const f32x16& p0, const f32x16& p1) {
    float a = fmaxf(p0[0], p1[0]), b = fmaxf(p0[1], p1[1]);
#pragma unroll
    for (int r = 2; r < 16; r += 2) { a = fmaxf(fmaxf(a, p0[r]), p1[r]); b = fmaxf(fmaxf(b, p0[r + 1]), p1[r + 1]); }
    return pair_max(fmaxf(a, b));
}
DEV void softmax_step(f32x16& p0, f32x16& p1, float& m, float& l, f32x16 (&o)[2]) {
    const float mt = rowmax32(p0, p1); const float mn = fmaxf(m, mt); const float alpha = __builtin_amdgcn_exp2f(m - mn);
    float rs = 0.f;
#pragma unroll
    for (int r = 0; r < 16; ++r) { p0[r] = __builtin_amdgcn_exp2f(p0[r] - mn); p1[r] = __builtin_amdgcn_exp2f(p1[r] - mn); rs += p0[r] + p1[r]; }
    rs = pair_sum(rs);
    l = l * alpha + rs; m = mn;
    if (__any(alpha != 1.0f)) { o[0] *= alpha; o[1] *= alpha; }
}
DEV void softmax_step_nosum(f32x16& p0, f32x16& p1, float& m, f32x16 (&o)[2], f32x16& lacc) {
    const float mt = rowmax32(p0, p1); const float mn = fmaxf(m, mt); const float alpha = __builtin_amdgcn_exp2f(m - mn);
#pragma unroll
    for (int r = 0; r < 16; ++r) { p0[r] = __builtin_amdgcn_exp2f(p0[r] - mn); p1[r] = __builtin_amdgcn_exp2f(p1[r] - mn); }
    m = mn;
    if (__any(alpha != 1.0f)) { o[0] *= alpha; o[1] *= alpha; lacc *= alpha; }
}
DEV void pv_tile_sum(const unsigned char* Vst, const f32x16& p0, const f32x16& p1, f32x16 (&o)[2], f32x16& lacc, int lane) {
    const int hi = lane >> 5, i = lane & 15, gg = (lane >> 4) & 1;
    const int q = i >> 2; const int sw = (q >> 1) & 1;
    bf16x8 pa[4];
#pragma unroll
    for (int s = 0; s < 4; ++s) { const f32x16& p = (s < 2) ? p0 : p1; const int b = (s & 1) * 8;
        unsigned w[4];
#pragma unroll
        for (int j = 0; j < 4; ++j) w[j] = cvtpk(p[b + 2 * j], p[b + 2 * j + 1]);
        typedef unsigned u32x4_t __attribute__((ext_vector_type(4)));
        u32x4_t ww = {w[0], w[1], w[2], w[3]}; pa[s] = __builtin_bit_cast(bf16x8, ww); }
    const bf16x8 ones = {0x3f80, 0x3f80, 0x3f80, 0x3f80, 0x3f80, 0x3f80, 0x3f80, 0x3f80};
#pragma unroll
    for (int bt = 0; bt < 2; ++bt) {
        s16x4 vlo[2][2], vhi[2][2];
#pragma unroll
        for (int s_ = 0; s_ < 2; ++s_)
#pragma unroll
            for (int dh = 0; dh < 2; ++dh) { const int s = bt * 2 + s_; const int row0 = 16 * s + 4 * hi + q;
                const unsigned char* p = Vst + row0 * 128 + ((dh ^ sw) << 6) + gg * 32 + (i & 3) * 8;
                vlo[s_][dh] = tr_read(p); vhi[s_][dh] = tr_read(p + 8 * 128); }
        __builtin_amdgcn_sched_barrier(0);
#pragma unroll
        for (int s_ = 0; s_ < 2; ++s_) { const int s = bt * 2 + s_;
            lacc = __builtin_amdgcn_mfma_f32_32x32x16_bf16(ones, pa[s], lacc, 0, 0, 0);
#pragma unroll
            for (int dh = 0; dh < 2; ++dh) {
                const bf16x8 vf = {vlo[s_][dh][0], vlo[s_][dh][1], vlo[s_][dh][2], vlo[s_][dh][3], vhi[s_][dh][0], vhi[s_][dh][1], vhi[s_][dh][2], vhi[s_][dh][3]};
                o[dh] = __builtin_amdgcn_mfma_f32_32x32x16_bf16(vf, pa[s], o[dh], 0, 0, 0); } }
        __builtin_amdgcn_sched_barrier(0);
    }
}
template <int STRIDE> DEV void mask_tile(f32x16& p0, f32x16& p1, int kpos0, int lo, int hi_lim, int hi) {
#pragma unroll
    for (int r = 0; r < 16; ++r) { const int kp = kpos0 + STRIDE * crow(r, hi);
        if (kp < lo || kp > hi_lim) p0[r] = NEG_INF;
        const int kp1 = kp + 32 * STRIDE; if (kp1 < lo || kp1 > hi_lim) p1[r] = NEG_INF; }
}
template <int STRIDE> DEV void alibi_init(f32x16& p0, f32x16& p1, float slope2, int kpos0, int tref, int hi) {
    const float base = slope2 * (float)(kpos0 - tref + STRIDE * 4 * hi);
#pragma unroll
    for (int r = 0; r < 16; ++r) { const float c = (float)(STRIDE * ((r & 3) + 8 * (r >> 2))); p0[r] = fmaf(slope2, c, base); p1[r] = fmaf(slope2, c + (float)(32 * STRIDE), base); }
}
template <class Src, class Body, class NSrc>
DEV int kv_pipeline(unsigned char* smem, int n, const Src& src, const Body& body, int par, bool pre, bool has_next, const NSrc& nsrc) {
    KV_DECL; const int tid = TID(); const bf16_t *kp, *vp;
    if (!pre) { src(0, kp, vp); KV_GLOAD(kp, vp); KV_LSTORE(smem + par * AT_STAGE); __syncthreads(); }
    for (int j = 0; j < n; ++j) {
        const bool more = j + 1 < n; const bool ld = more || has_next;
        if (more) { src(j + 1, kp, vp); KV_GLOAD(kp, vp); } else if (has_next) { nsrc(kp, vp); KV_GLOAD(kp, vp); }
        body(j, smem + ((par + j) & 1) * AT_STAGE);
        if (ld) KV_LSTORE(smem + ((par + j + 1) & 1) * AT_STAGE);
        __syncthreads();
    }
    return (par + n) & 1;
}
struct NoSrc { DEV void operator()(const bf16_t*&, const bf16_t*&) const {} };

constexpr int CV_PER_STEP = 373; constexpr int CV_NUP = 32 * 1024 * 2048 / 8, CV_NDN = 32 * 1024 * 1024 / 8;
static_assert((long long)33792 * CV_PER_STEP >= (long long)CV_NUP + CV_NDN, "conversion coverage");
DEV void fox_item(const Args& a, unsigned char* smem, int fi, int b, int h, int qb) {
    const int tid = TID(), lane = tid & 63, wid = tid >> 6, r32 = lane & 31, hi = lane >> 5;
    const bf16_t* PROJ = (const bf16_t*)(a.ws + WS_PROJ);
    const bf16_t* Q = PROJ + ((size_t)((20 + h) * 2 + b)) * 8192 * 64; const bf16_t* K = PROJ + ((size_t)((28 + h) * 2 + b)) * 8192 * 64; const bf16_t* V = PROJ + ((size_t)((36 + h) * 2 + b)) * 8192 * 64;
    const float* CUM = (const float*)(a.ws + WS_CUM) + (size_t)(b * 8 + h) * 8192;
    const int q0 = qb * 256; const int qrow = q0 + 32 * wid + r32;
    bf16x8 qf[4];
#pragma unroll
    for (int ks = 0; ks < 4; ++ks) qf[ks] = *(const bf16x8*)(Q + (size_t)qrow * 64 + 16 * ks + 8 * hi);
    const float cref = CUM[q0];
    const int ntiles = 4 * qb + 4; const int jmax_w = (q0 + 32 * wid + 31) >> 6; const int jmask_w = (q0 + 32 * wid) >> 6;
    f32x16 o[2]; o[0] = (f32x16){}; o[1] = (f32x16){}; f32x16 lacc = (f32x16){}; float m = -1e30f;
    float* biasL = (float*)(smem + AT_BIAS_OFF);
    const int gq_ = fi >> 4; const int sidx0 = 16 * (128 * gq_ - 2 * gq_ * (gq_ - 1)) + (fi & 15) * (128 - 4 * gq_);
    bf16_t* cvdA = nullptr; bf16_t* cvdB = nullptr; float4 cvaA, cvbA, cvaB, cvbB;
    KV_DECL; float breg = 0.f;
#define TJ(s_) (ntiles - 1 - (s_))
    KV_GLOAD(K + (size_t)TJ(0) * 4096, V + (size_t)TJ(0) * 4096); if (tid < 64) breg = (cref - CUM[TJ(0) * 64 + tid]) * LOG2E;
    KV_LSTORE(smem); if (tid < 64) biasL[tid] = breg;
    KV_GLOAD(K + (size_t)TJ(1) * 4096, V + (size_t)TJ(1) * 4096); if (tid < 64) breg = (cref - CUM[TJ(1) * 64 + tid]) * LOG2E;
    KV_LSTORE(smem + AT_STAGE); if (tid < 64) biasL[64 + tid] = breg;
    __syncthreads();
#define FOX_QK(P0, P1, jj, sj) do { const float* bl_ = biasL + (sj) * 64; \
        _Pragma("unroll") for (int g4 = 0; g4 < 4; ++g4) { const float4 x_ = *(const float4*)(bl_ + 8 * g4 + 4 * hi), y_ = *(const float4*)(bl_ + 32 + 8 * g4 + 4 * hi); \
            P0[4 * g4] = x_.x; P0[4 * g4 + 1] = x_.y; P0[4 * g4 + 2] = x_.z; P0[4 * g4 + 3] = x_.w; P1[4 * g4] = y_.x; P1[4 * g4 + 1] = y_.y; P1[4 * g4 + 2] = y_.z; P1[4 * g4 + 3] = y_.w; } \
        qk_tile<true>(smem + (sj) * AT_STAGE, qf, P0, P1, lane); \
        if ((jj) >= jmask_w) mask_tile<1>(P0, P1, 64 * (jj), -1, qrow, hi); } while (0)
#define FOX_STEP(CUR0, CUR1, NXT0, NXT1, j, CVD_LD, CVA_LD, CVB_LD, CVD_ST, CVA_ST, CVB_ST) do { \
        const int s_cur = (j) % 3, s_nxt = ((j) + 1) % 3, s_ld = ((j) + 2) % 3; const bool more_ = (j) + 2 < ntiles; \
        if (more_) { KV_GLOAD(K + (size_t)TJ((j) + 2) * 4096, V + (size_t)TJ((j) + 2) * 4096); if (tid < 64) breg = (cref - CUM[TJ((j) + 2) * 64 + tid]) * LOG2E; } \
        { const int c_ = (sidx0 + (j)) * CV_PER_STEP + tid; CVD_LD = nullptr; \
          if (tid < CV_PER_STEP && c_ < CV_NUP + CV_NDN) { const float* cvs_; if (c_ < CV_NUP) { cvs_ = a.in[I_WUP] + (size_t)c_ * 8; CVD_LD = (bf16_t*)(a.ws + WS_WUP) + (size_t)c_ * 8; } else { cvs_ = a.in[I_WDN] + (size_t)(c_ - CV_NUP) * 8; CVD_LD = (bf16_t*)(a.ws + WS_WDN) + (size_t)(c_ - CV_NUP) * 8; } \
              CVA_LD = *(const float4*)cvs_; CVB_LD = *(const float4*)(cvs_ + 4); } } \
        if ((j) + 1 < ntiles && TJ((j) + 1) <= jmax_w) FOX_QK(NXT0, NXT1, TJ((j) + 1), s_nxt); \
        __builtin_amdgcn_sched_barrier(0); \
        if (TJ(j) <= jmax_w) { softmax_step_nosum(CUR0, CUR1, m, o, lacc); pv_tile_sum(smem + s_cur * AT_STAGE + 8192, CUR0, CUR1, o, lacc, lane); } \
        if (more_) { KV_LSTORE(smem + s_ld * AT_STAGE); if (tid < 64) biasL[s_ld * 64 + tid] = breg; } \
        if (CVD_ST) { uint4 o_; o_.x = cvtpk(CVA_ST.x, CVA_ST.y); o_.y = cvtpk(CVA_ST.z, CVA_ST.w); o_.z = cvtpk(CVB_ST.x, CVB_ST.y); o_.w = cvtpk(CVB_ST.z, CVB_ST.w); *(uint4*)CVD_ST = o_; CVD_ST = nullptr; } \
        __syncthreads(); } while (0)
    f32x16 pA0, pA1, pB0, pB1;
    if (TJ(0) <= jmax_w) FOX_QK(pA0, pA1, TJ(0), 0);
    for (int j = 0; j < ntiles; j += 2) {
        FOX_STEP(pA0, pA1, pB0, pB1, j, cvdA, cvaA, cvbA, cvdB, cvaB, cvbB);
        FOX_STEP(pB0, pB1, pA0, pA1, j + 1, cvdB, cvaB, cvbB, cvdA, cvaA, cvbA);
    }
    if (cvdB) { uint4 o_; o_.x = cvtpk(cvaB.x, cvaB.y); o_.y = cvtpk(cvaB.z, cvaB.w); o_.z = cvtpk(cvbB.x, cvbB.y); o_.w = cvtpk(cvbB.z, cvbB.w); *(uint4*)cvdB = o_; }
#undef FOX_QK
#undef FOX_STEP
#undef TJ
    const float inv = 1.0f / lacc[0]; float ss = 0.f;
    const size_t token = (size_t)b * 8192 + qrow;
    bf16_t* O = (bf16_t*)(a.ws + WS_OFOX) + token * 512 + h * 64;
#pragma unroll
    for (int dh = 0; dh < 2; ++dh)
#pragma unroll
        for (int g4 = 0; g4 < 4; ++g4) { const float v0 = o[dh][4 * g4] * inv, v1 = o[dh][4 * g4 + 1] * inv, v2 = o[dh][4 * g4 + 2] * inv, v3 = o[dh][4 * g4 + 3] * inv;
            ss += v0 * v0 + v1 * v1 + v2 * v2 + v3 * v3; uint2 w; w.x = cvtpk(v0, v1); w.y = cvtpk(v2, v3); *(uint2*)(O + 32 * dh + 8 * g4 + 4 * hi) = w; }
    ss = pair_sum(ss);
    if (hi == 0) ((float*)(a.ws + WS_SSQ))[token * 16 + 8 + h] = ss;
}

DEV void nsa_item(const Args& a, unsigned char* smem, int b, int g, int tt) {
    const int tid = TID(), lane = tid & 63, wid = tid >> 6, col = lane & 31, hi = lane >> 5;
    const int t0 = tt * 64, tokw = col >> 2, r = col & 3, h = 4 * g + r; const int tokl = wid * 8 + tokw; const int t = t0 + tokl; const size_t token = (size_t)b * 8192 + t;
    const float slope2 = exp2f(-(float)(h + 1)) * LOG2E;
    const bf16_t* PROJ = (const bf16_t*)(a.ws + WS_PROJ);
    const float* GN = (const float*)(a.ws + WS_GN) + token * 24 + h * 3;
    const int cur = tt; const bool need_topk = cur > 15;
    bf16x8 qf[4];
    { const bf16_t* Q = PROJ + (((size_t)(h * 2 + b)) * 8192 + t) * 64;
#pragma unroll
      for (int ks = 0; ks < 4; ++ks) qf[ks] = *(const bf16x8*)(Q + 16 * ks + 8 * hi); }
    float* impw = (float*)(smem + AT_IMP_OFF) + wid * 2048; float* totw = impw + lane;
    unsigned* selmask = (unsigned*)(smem + AT_SEL_OFF); unsigned* wun = (unsigned*)(smem + AT_WUN_OFF); int* ucnt = (int*)(smem + AT_UCNT_OFF); unsigned char* ulist = smem + AT_ULIST_OFF;
    f32x16 o[2]; float m, l; int par = 0;
    const int tmin_w = t0 + wid * 8, tmax_w = tmin_w + 7;
    {
        const bf16_t* KC = (const bf16_t*)(a.ws + WS_KC) + ((size_t)(0 * 4 + b * 2 + g)) * 512 * 64; const bf16_t* VC = (const bf16_t*)(a.ws + WS_KC) + ((size_t)(1 * 4 + b * 2 + g)) * 512 * 64;
        const int ncv = t0 / 16 + 3; const int nct = (ncv + 63) >> 6;
        auto src = [&](int j, const bf16_t*& kp, const bf16_t*& vp) { kp = KC + (size_t)j * 4096; vp = VC + (size_t)j * 4096; };
        m = -1e30f; l = 0.f;
        auto src0 = [&](const bf16_t*& kp, const bf16_t*& vp) { kp = KC; vp = VC; };
        par = kv_pipeline(smem, nct, src, [&](int j, const unsigned char* st) {
            const int kpos0 = 1024 * j + 31;
            if (kpos0 > tmax_w) return;
            f32x16 p0, p1; alibi_init<16>(p0, p1, slope2, kpos0, t0, hi);
            qk_tile<false>(st, qf, p0, p1, lane);
            if (kpos0 + 16 * 63 > tmin_w) mask_tile<16>(p0, p1, kpos0, -1, t, hi);
            const float mt = rowmax32(p0, p1); const float mn = fmaxf(m, mt); float rs = 0.f;
#pragma unroll
            for (int rr = 0; rr < 16; ++rr) rs += __builtin_amdgcn_exp2f(p0[rr] - mn) + __builtin_amdgcn_exp2f(p1[rr] - mn);
            rs = pair_sum(rs);
            l = l * __builtin_amdgcn_exp2f(m - mn) + rs; m = mn;
        }, 0, false, true, src0);
        const float linv = l > 0.f ? 1.0f / l : 0.f;
        if (need_topk) { for (int i = lane; i < 8 * 129; i += 64) impw[i] = 0.f; }
        o[0] = (f32x16){}; o[1] = (f32x16){};
        const bf16_t* KS0 = PROJ + ((size_t)((12 + g) * 2 + b)) * 8192 * 64 + (size_t)cur * 4096; const bf16_t* VS0 = PROJ + ((size_t)((14 + g) * 2 + b)) * 8192 * 64 + (size_t)cur * 4096;
        par = kv_pipeline(smem, nct, src, [&](int j, const unsigned char* st) {
            const int kpos0 = 1024 * j + 31;
            if (kpos0 > tmax_w) return;
            f32x16 p0, p1; alibi_init<16>(p0, p1, slope2, kpos0, t0, hi);
            qk_tile<false>(st, qf, p0, p1, lane);
            if (kpos0 + 16 * 63 > tmin_w) mask_tile<16>(p0, p1, kpos0, -1, t, hi);
#pragma unroll
            for (int rr = 0; rr < 16; ++rr) { p0[rr] = __builtin_amdgcn_exp2f(p0[rr] - m) * linv; p1[rr] = __builtin_amdgcn_exp2f(p1[rr] - m) * linv; }
            if (need_topk) {
#pragma unroll
                for (int half = 0; half < 2; ++half)
#pragma unroll
                    for (int g4 = 0; g4 < 4; ++g4) { const f32x16& p = half ? p1 : p0;
                        float ms = (p[4 * g4] + p[4 * g4 + 1]) + (p[4 * g4 + 2] + p[4 * g4 + 3]); float ls = p[4 * g4 + 3];
                        ms = quad_sum(ms); ls = quad_sum(ls);
                        const int n = 16 * j + 8 * half + 2 * g4 + hi;
                        if (r == 0) { atomicAdd(&impw[tokw * 129 + n], ms); atomicAdd(&impw[tokw * 129 + n + 1], ls); } }
            }
            pv_tile<false>(st + 8192, p0, p1, o, lane);
        }, par, true, true, [&](const bf16_t*& kp, const bf16_t*& vp) { kp = KS0; vp = VS0; });
    }
    {
        unsigned un0 = 0u, un1 = 0u, un2 = 0u, un3 = 0u;
        if (need_topk) {
#define TK_INIT(V0, V1, M0, M1, M2, M3, tk_) float V0 = impw[(tk_) * 129 + lane], V1 = impw[(tk_) * 129 + 64 + lane]; \
                V0 = (lane >= 1 && lane <= cur - 2) ? V0 : -1.0f; V1 = (lane + 64 <= cur - 2) ? V1 : -1.0f; unsigned M0 = 1u, M1 = 0u, M2 = 0u, M3 = 0u; \
                TK_SET(M0, M1, M2, M3, cur); TK_SET(M0, M1, M2, M3, cur - 1)
#define TK_SET(M0, M1, M2, M3, n_) do { const int n__ = (n_); const unsigned bit__ = 1u << (n__ & 31); const int w__ = n__ >> 5; M0 |= (w__ == 0) ? bit__ : 0u; M1 |= (w__ == 1) ? bit__ : 0u; M2 |= (w__ == 2) ? bit__ : 0u; M3 |= (w__ == 3) ? bit__ : 0u; } while (0)
#define TK_STEP(V0, V1, M0, M1, M2, M3) do { const float mx_ = wave_max_u(fmaxf(V0, V1)); const unsigned long long b0_ = __ballot(V0 == mx_), b1_ = __ballot(V1 == mx_); \
                const int n_ = b0_ ? (__ffsll((long long)b0_) - 1) : (63 + __ffsll((long long)b1_)); const bool hit_ = lane == (n_ & 63); \
                V0 = (hit_ && n_ < 64) ? -1.0f : V0; V1 = (hit_ && n_ >= 64) ? -1.0f : V1; TK_SET(M0, M1, M2, M3, n_); } while (0)
            for (int tk = 0; tk < 8; tk += 4) {
                TK_INIT(a0_, a1_, ma0, ma1, ma2, ma3, tk); TK_INIT(b0v, b1v, mb0, mb1, mb2, mb3, tk + 1); TK_INIT(c0v, c1v, mc0, mc1, mc2, mc3, tk + 2); TK_INIT(d0v, d1v, md0, md1, md2, md3, tk + 3);
                for (int it = 0; it < 13; ++it) { TK_STEP(a0_, a1_, ma0, ma1, ma2, ma3); TK_STEP(b0v, b1v, mb0, mb1, mb2, mb3); TK_STEP(c0v, c1v, mc0, mc1, mc2, mc3); TK_STEP(d0v, d1v, md0, md1, md2, md3); }
                if (lane == 0) { unsigned* sm_ = selmask + (wid * 8 + tk) * 4; sm_[0] = ma0; sm_[1] = ma1; sm_[2] = ma2; sm_[3] = ma3; sm_[4] = mb0; sm_[5] = mb1; sm_[6] = mb2; sm_[7] = mb3;
                    sm_[8] = mc0; sm_[9] = mc1; sm_[10] = mc2; sm_[11] = mc3; sm_[12] = md0; sm_[13] = md1; sm_[14] = md2; sm_[15] = md3; }
                un0 |= ma0 | mb0 | mc0 | md0; un1 |= ma1 | mb1 | mc1 | md1; un2 |= ma2 | mb2 | mc2 | md2; un3 |= ma3 | mb3 | mc3 | md3;
            }
#undef TK_INIT
#undef TK_SET
#undef TK_STEP
        } else {
            const unsigned full = (2u << cur) - 1u;
            un0 = full;
            if (lane < 8) { unsigned* sm_ = selmask + (wid * 8 + lane) * 4; sm_[0] = full; sm_[1] = 0u; sm_[2] = 0u; sm_[3] = 0u; }
        }
        if (lane == 0) { wun[wid * 4] = un0; wun[wid * 4 + 1] = un1; wun[wid * 4 + 2] = un2; wun[wid * 4 + 3] = un3; }
        __syncthreads();
        if (tid == 0) { int c = 0;
            for (int w = 0; w < 4; ++w) { unsigned u = 0u; for (int ww = 0; ww < NWAVE; ++ww) u |= wun[ww * 4 + w]; for (int bb = 0; bb < 32; ++bb) if ((u >> bb) & 1u) ulist[c++] = (unsigned char)(w * 32 + bb); }
            ucnt[0] = c; }
        __syncthreads();
    }
    { const float g0 = GN[0];
#pragma unroll
      for (int rr = 0; rr < 16; ++rr) { totw[rr * 64] = o[0][rr] * g0; totw[(16 + rr) * 64] = o[1][rr] * g0; } }
    {
        const bf16_t* KS = PROJ + ((size_t)((12 + g) * 2 + b)) * 8192 * 64; const bf16_t* VS = PROJ + ((size_t)((14 + g) * 2 + b)) * 8192 * 64;
        const int nu = ucnt[0];
        m = -1e30f; f32x16 lacc = (f32x16){}; o[0] = (f32x16){}; o[1] = (f32x16){};
        const bf16_t* KW0 = PROJ + ((size_t)((16 + g) * 2 + b)) * 8192 * 64 + (size_t)cur * 4096; const bf16_t* VW0 = PROJ + ((size_t)((18 + g) * 2 + b)) * 8192 * 64 + (size_t)cur * 4096;
        par = kv_pipeline(smem, nu, [&](int j, const bf16_t*& kp, const bf16_t*& vp) { const int n = ulist[nu - 1 - j]; kp = KS + (size_t)n * 4096; vp = VS + (size_t)n * 4096; },
            [&](int j, const unsigned char* st) {
                const int n = ulist[nu - 1 - j];
                if (!((wun[wid * 4 + (n >> 5)] >> (n & 31)) & 1u)) return;
                const bool sel = (selmask[tokl * 4 + (n >> 5)] >> (n & 31)) & 1u;
                f32x16 p0, p1; alibi_init<1>(p0, p1, slope2, 64 * n, t0, hi);
                qk_tile<false>(st, qf, p0, p1, lane);
                if (n == cur || !__all(sel)) mask_tile<1>(p0, p1, 64 * n, -1, sel ? t : -1, hi);
                softmax_step_nosum(p0, p1, m, o, lacc);
                pv_tile_sum(st + 8192, p0, p1, o, lacc, lane);
            }, par, true, true, [&](const bf16_t*& kp, const bf16_t*& vp) { kp = KW0; vp = VW0; });
        const float g1 = GN[1] / fmaxf(lacc[0], 1e-30f);
#pragma unroll
        for (int rr = 0; rr < 16; ++rr) { totw[rr * 64] += o[0][rr] * g1; totw[(16 + rr) * 64] += o[1][rr] * g1; }
    }
    {
        const bf16_t* KW = PROJ + ((size_t)((16 + g) * 2 + b)) * 8192 * 64; const bf16_t* VW = PROJ + ((size_t)((18 + g) * 2 + b)) * 8192 * 64;
        const int jlo = (t0 - 511) > 0 ? ((t0 - 511) >> 6) : 0; const int jhi = cur;
        m = -1e30f; f32x16 lacc = (f32x16){}; o[0] = (f32x16){}; o[1] = (f32x16){};
        (void)kv_pipeline(smem, jhi - jlo + 1, [&](int j, const bf16_t*& kp, const bf16_t*& vp) { kp = KW + (size_t)(jhi - j) * 4096; vp = VW + (size_t)(jhi - j) * 4096; },
            [&](int j, const unsigned char* st) {
                const int kpos0 = 64 * (jhi - j);
                if (kpos0 > tmax_w || kpos0 + 63 < tmin_w - 511) return;
                f32x16 p0, p1; alibi_init<1>(p0, p1, slope2, kpos0, t0, hi);
                qk_tile<false>(st, qf, p0, p1, lane);
                if (kpos0 < tmax_w - 511 || kpos0 + 63 > tmin_w) mask_tile<1>(p0, p1, kpos0, t - 511, t, hi);
                softmax_step_nosum(p0, p1, m, o, lacc);
                pv_tile_sum(st + 8192, p0, p1, o, lacc, lane);
            }, par, true, false, NoSrc());
        const float g2 = GN[2] / fmaxf(lacc[0], 1e-30f);
#pragma unroll
        for (int rr = 0; rr < 16; ++rr) { o[0][rr] = totw[rr * 64] + o[0][rr] * g2; o[1][rr] = totw[(16 + rr) * 64] + o[1][rr] * g2; }
    }
    {
        float ss = 0.f; bf16_t* O = (bf16_t*)(a.ws + WS_ONSA) + token * 512 + h * 64;
#pragma unroll
        for (int dh = 0; dh < 2; ++dh)
#pragma unroll
            for (int g4 = 0; g4 < 4; ++g4) { const float v0 = o[dh][4 * g4], v1 = o[dh][4 * g4 + 1], v2 = o[dh][4 * g4 + 2], v3 = o[dh][4 * g4 + 3];
                ss += v0 * v0 + v1 * v1 + v2 * v2 + v3 * v3; uint2 w; w.x = cvtpk(v0, v1); w.y = cvtpk(v2, v3); *(uint2*)(O + 32 * dh + 8 * g4 + 4 * hi) = w; }
        ss = pair_sum(ss);
        if (hi == 0) ((float*)(a.ws + WS_SSQ))[token * 16 + h] = ss;
    }
}
#ifndef PROBE_DUP
#define PROBE_DUP 0
#endif
DEV void phase_att(const Args& a, unsigned char* smem) {
    int* qctr = (int*)(a.ws + WS_CTL) + 64; int* sitem = (int*)(smem + AT_ITEM_OFF);
    unsigned* ctl = (unsigned*)(a.ws + WS_CTL); unsigned* seen = (unsigned*)(smem + AT_ITEM_OFF + 8);
    if (TID() == 0) seen[0] = 0u;
    for (;;) {
        if (TID() == 0) sitem[0] = atomicAdd(qctr, 1);
        __syncthreads();
        const int item = sitem[0];
        __syncthreads();
        if (item >= 32 + 1024) break;
        if (item < 16) cmp_item(a, smem, 16 + item);
        else if (item < 32) cmp_item(a, smem, item - 16);
        else if (item < 32 + 512) { const int fi = item - 32; const int qb = 31 - (fi >> 4), bh = fi & 15; if (!((seen[0] >> bh) & 1u)) { wait_flag(ctl + CW_CUMFLAG + bh, 1u); if (TID() == 0) seen[0] |= 1u << bh; } fox_item(a, smem, fi, bh >> 3, bh & 7, qb); }
        else { const int idx = item - 32 - 512; const int tt = 127 - (idx >> 2), bg = idx & 3; if (!((seen[0] >> 16) & 1u)) { wait_flag(ctl + CW_CMPFLAG, 16u); if (TID() == 0) seen[0] |= 1u << 16; } nsa_item(a, smem, bg >> 1, bg & 1, tt); }
    }
}

DEV void phase_outproj(const Args& a, unsigned char* smem) {
    const bf16_t* ONSA = (const bf16_t*)(a.ws + WS_ONSA); const bf16_t* OFOX = (const bf16_t*)(a.ws + WS_OFOX); const float* SSQ = (const float*)(a.ws + WS_SSQ);
    const bf16_t* W = (const bf16_t*)(a.ws + WS_WOUT); float* H1 = (float*)(a.ws + WS_H1); const float* X = a.in[I_X];
    float* rs = (float*)(smem + MISC_OFF);
    const int tid = TID(); int lane = tid & 63, wid = tid >> 6, wr = wid >> 2, wc = wid & 3; (void)wr; (void)wc; (void)lane;
    auto aoffo = [](int r, int kc) { return (unsigned)(r * 1024 + kc * 16); }; auto boffo = [](int k, int nc) { return (unsigned)(k * 2048 + nc * 16); };
    for (int item = VBID(); item < 64 * 4; item += gridDim.x) {
        int mt, nt; patch_decode(item, 64, 4, mt, nt);
        gemm_issue0<15>(smem, ONSA + (size_t)mt * 256 * 512, aoffo, W + nt * 256, boffo);
        if (tid < 256) { const float* s_ = SSQ + (size_t)(mt * 256 + tid) * 16; float sn = 0.f, sf = 0.f;
#pragma unroll
            for (int j = 0; j < 8; ++j) { sn += s_[j]; sf += s_[8 + j]; }
            rs[tid * 2] = rsqrtf(sn * (1.f / 512.f) + EPS); rs[tid * 2 + 1] = rsqrtf(sf * (1.f / 512.f) + EPS); }
        asm volatile("s_waitcnt vmcnt(0)" ::: "memory");
        __syncthreads();
        f32x4 acc[8][4];
#pragma unroll
        for (int mi = 0; mi < 8; ++mi) { const size_t gm = (size_t)mt * 256 + G_ROW(mi);
#pragma unroll
            for (int ni = 0; ni < 4; ++ni) { const int n = nt * 256 + G_COL(ni); const float4 x = *(const float4*)(X + gm * 1024 + n); acc[mi][ni] = (f32x4){x.x, x.y, x.z, x.w}; } }
#pragma unroll
        for (int mi = 0; mi < 8; ++mi) { const float ri = 1.0f / rs[(G_ROW(mi)) * 2];
#pragma unroll
            for (int ni = 0; ni < 4; ++ni) acc[mi][ni] *= ri; }
        gemm256<false>(smem, 8, ONSA + (size_t)mt * 256 * 512, 128u, aoffo, W + nt * 256, 64u * 2048u, boffo, acc, true,
                       next_tile(true, smem, OFOX + (size_t)mt * 256 * 512, aoffo, W + (size_t)512 * 1024 + nt * 256, boffo));
        EPI_IDS();
#pragma unroll
        for (int mi = 0; mi < 8; ++mi) { const int rl = G_ROW(mi); const float rat = rs[rl * 2] / rs[rl * 2 + 1];
#pragma unroll
            for (int ni = 0; ni < 4; ++ni) acc[mi][ni] *= rat; }
        gemm256<false>(smem, 8, OFOX + (size_t)mt * 256 * 512, 128u, aoffo, W + (size_t)512 * 1024 + nt * 256, 64u * 2048u, boffo, acc, true);
        EPI_IDS();
#pragma unroll
        for (int mi = 0; mi < 8; ++mi) { const int rl = G_ROW(mi); const size_t gm = (size_t)mt * 256 + rl; const float rf = rs[rl * 2 + 1];
#pragma unroll
            for (int ni = 0; ni < 4; ++ni) { const int n = nt * 256 + G_COL(ni); const f32x4 v = acc[mi][ni] * rf;
                float4 o = {v[0], v[1], v[2], v[3]}; *(float4*)(H1 + gm * 1024 + n) = o; } }
        __syncthreads();
    }
}

DEV void phase_route(const Args& a, unsigned char* smem) {
    const float* H1 = (const float*)(a.ws + WS_H1); bf16_t* XN = (bf16_t*)(a.ws + WS_XN); float* RSTD2 = (float*)(a.ws + WS_RSTD2);
    const float* ln2 = a.in[I_LN2]; const float* wr_ = a.in[I_WR]; const float* br = a.in[I_BR];
    int* CNT = (int*)(a.ws + WS_CTL);
    int* TOPI = (int*)(a.ws + WS_TOPI); int* TOPS = (int*)(a.ws + WS_TOPS); float* TOPW = (float*)(a.ws + WS_TOPW);
    int* TOKOF = (int*)(a.ws + WS_TOKOF); float* ROWW = (float*)(a.ws + WS_ROWW); float* RSDS = (float*)(a.ws + WS_RSDS);
    float* part = (float*)smem;
    float* ssqp = part + 8 * 32 * 33;
    int* lcnt = (int*)(ssqp + 256); int* lbase = lcnt + 32; int* te = lbase + 32; int* trk = te + 256; float* tw = (float*)(trk + 256); float* trs = tw + 256;
    const int tid = TID(), lane = tid & 63, wid = tid >> 6, i32 = lane & 31, kh = lane >> 5; const int tg = wid >> 2, kq = wid & 3;
    for (int item = BID(); item < 256; item += gridDim.x) {
        const int tok = item * 64 + tg * 32 + i32;
        if (tid < 32) lcnt[tid] = 0;
        f32x16 acc = (f32x16){}; float ss = 0.f;
        const float* hrow = H1 + (size_t)tok * 1024 + 256 * kq + 4 * kh; const float* lrow = ln2 + 256 * kq + 4 * kh; bf16_t* xrow = XN + (size_t)tok * 1024 + 256 * kq + 4 * kh;
        const float* wbase = wr_ + (size_t)(256 * kq + 4 * kh) * 32 + i32;
#pragma unroll 4
        for (int c = 0; c < 32; ++c) {
            const float4 hv = *(const float4*)(hrow + 8 * c); const float4 lv = *(const float4*)(lrow + 8 * c);
            ss += hv.x * hv.x + hv.y * hv.y + hv.z * hv.z + hv.w * hv.w;
            const float x0 = hv.x * lv.x, x1 = hv.y * lv.y, x2 = hv.z * lv.z, x3 = hv.w * lv.w;
            uint2 o; o.x = cvtpk(x0, x1); o.y = cvtpk(x2, x3); *(uint2*)(xrow + 8 * c) = o;
            const float* wp = wbase + (size_t)(8 * c) * 32;
            const float w0 = wp[0], w1 = wp[32], w2 = wp[64], w3 = wp[96];
            acc = __builtin_amdgcn_mfma_f32_32x32x2f32(x0, w0, acc, 0, 0, 0);
            acc = __builtin_amdgcn_mfma_f32_32x32x2f32(x1, w1, acc, 0, 0, 0);
            acc = __builtin_amdgcn_mfma_f32_32x32x2f32(x2, w2, acc, 0, 0, 0);
            acc = __builtin_amdgcn_mfma_f32_32x32x2f32(x3, w3, acc, 0, 0, 0);
        }
        ss = pair_sum(ss);
        if (kh == 0) ssqp[wid * 32 + i32] = ss;
#pragma unroll
        for (int r = 0; r < 16; ++r) part[(wid * 32 + crow(r, kh)) * 33 + i32] = acc[r];
        __syncthreads();
        if (tid < 64) {
            const int g_ = tid >> 5, i_ = tid & 31; const int w0_ = g_ * 4;
            const float sq = ssqp[(w0_ + 0) * 32 + i_] + ssqp[(w0_ + 1) * 32 + i_] + ssqp[(w0_ + 2) * 32 + i_] + ssqp[(w0_ + 3) * 32 + i_]; const float rstd = rsqrtf(sq * (1.f / 1024.f) + EPS);
            RSTD2[item * 64 + tid] = rstd; trs[tid] = rstd;
            float lg[32];
#pragma unroll
            for (int e = 0; e < 32; ++e) lg[e] = (part[((w0_ + 0) * 32 + i_) * 33 + e] + part[((w0_ + 1) * 32 + i_) * 33 + e] + part[((w0_ + 2) * 32 + i_) * 33 + e] + part[((w0_ + 3) * 32 + i_) * 33 + e]) * rstd + br[e];
            unsigned taken = 0u; float tv[4]; int ti[4];
#pragma unroll
            for (int k = 0; k < 4; ++k) { float best = -3.0e38f; int bi = 0;
#pragma unroll
                for (int e = 0; e < 32; ++e) { const bool ok = !((taken >> e) & 1u) && lg[e] > best; best = ok ? lg[e] : best; bi = ok ? e : bi; }
                taken |= 1u << bi; tv[k] = best; ti[k] = bi; }
            const float e1 = __expf(tv[1] - tv[0]), e2 = __expf(tv[2] - tv[0]), e3 = __expf(tv[3] - tv[0]); const float inv = 1.0f / (1.0f + e1 + e2 + e3);
            const float wv[4] = {inv, e1 * inv, e2 * inv, e3 * inv};
#pragma unroll
            for (int k = 0; k < 4; ++k) { const int idx = tid * 4 + k; te[idx] = ti[k]; trk[idx] = atomicAdd(&lcnt[ti[k]], 1); tw[idx] = wv[k]; }
        }
        __syncthreads();
        if (tid < 32) lbase[tid] = atomicAdd(&CNT[tid], lcnt[tid]);
        __syncthreads();
        if (tid < 256) { const int idx = tid; const int tk = item * 64 + (idx >> 2); const int e = te[idx]; const int slot = lbase[e] + trk[idx];
          TOPI[(size_t)tk * 4 + (idx & 3)] = e; TOPS[(size_t)tk * 4 + (idx & 3)] = slot; TOPW[(size_t)tk * 4 + (idx & 3)] = tw[idx];
          TOKOF[(size_t)e * 16384 + slot] = tk; ROWW[(size_t)e * 16384 + slot] = tw[idx]; RSDS[(size_t)e * 16384 + slot] = trs[idx >> 2]; }
        __syncthreads();
    }
}

struct MoeMap { int e, mt, nt, cnt, off; };
DEV void moe_setup(const Args& a, int* sm) {
    if (TID() == 0) { const int* CNT = (const int*)(a.ws + WS_CTL); int tot = 0; for (int e = 0; e < 32; ++e) { const int c = CNT[e]; const int mt = (c + 255) >> 8; sm[e] = mt; sm[32 + e] = tot; tot += mt; } sm[64] = tot; }
    __syncthreads();
}
DEV MoeMap moe_map(const Args& a, const int* sm, int item, int NT) {
    MoeMap mm; int e = 0;
#pragma unroll 1
    for (int i = 1; i < 32; ++i) if (item >= sm[32 + i] * NT) e = i;
    const int local = item - sm[32 + e] * NT; const int mte = sm[e];
    int mt_, nt_; patch_decode(local, mte, NT, mt_, nt_);
    mm.e = __builtin_amdgcn_readfirstlane(e); mm.mt = __builtin_amdgcn_readfirstlane(mt_); mm.nt = __builtin_amdgcn_readfirstlane(nt_);
    mm.cnt = __builtin_amdgcn_readfirstlane(((const int*)(a.ws + WS_CTL))[e]); mm.off = __builtin_amdgcn_readfirstlane(sm[32 + e] * 256); return mm;
}
DEV int moe_maps_build(const Args& a, const int* sm, int* maps, int nitems, int NT) {
    const int tid = TID(); const int first = VBID(); const int nmine = first < nitems ? (nitems - first + (int)gridDim.x - 1) / (int)gridDim.x : 0;
    for (int k = tid; k < nmine && k < 64; k += NTHR) { const int item = first + k * (int)gridDim.x; int e = 0;
#pragma unroll 1
        for (int i = 1; i < 32; ++i) if (item >= sm[32 + i] * NT) e = i;
        const int local = item - sm[32 + e] * NT; int mt_, nt_; patch_decode(local, sm[e], NT, mt_, nt_);
        maps[k * 8] = e; maps[k * 8 + 1] = mt_; maps[k * 8 + 2] = nt_; maps[k * 8 + 3] = ((const int*)(a.ws + WS_CTL))[e]; maps[k * 8 + 4] = sm[32 + e] * 256; }
    __syncthreads();
    return nmine < 64 ? nmine : 64;
}
DEV MoeMap moe_get(const int* maps, int k) { MoeMap mm; mm.e = __builtin_amdgcn_readfirstlane(maps[k * 8]); mm.mt = __builtin_amdgcn_readfirstlane(maps[k * 8 + 1]); mm.nt = __builtin_amdgcn_readfirstlane(maps[k * 8 + 2]);
    mm.cnt = __builtin_amdgcn_readfirstlane(maps[k * 8 + 3]); mm.off = __builtin_amdgcn_readfirstlane(maps[k * 8 + 4]); return mm; }
DEV void phase_up(const Args& a, unsigned char* smem) {
    int* sm = (int*)(smem + MISC_OFF); int* maps = (int*)(smem + MISC_OFF + 8192); int* tokb = maps + 512; float* rsdb = (float*)(tokb + 768); float* biab = rsdb + 768;
    const bf16_t* XN = (const bf16_t*)(a.ws + WS_XN); const bf16_t* W = (const bf16_t*)(a.ws + WS_WUP); bf16_t* ACT = (bf16_t*)(a.ws + WS_ACT); const float* RSDS = (const float*)(a.ws + WS_RSDS);
    const int* TOKOF = (const int*)(a.ws + WS_TOKOF); const float* bup = a.in[I_BUP];
    const int tid = TID(); int lane = tid & 63, wid = tid >> 6, wr = wid >> 2, wc = wid & 3; (void)wr; (void)wc; (void)lane;
    moe_setup(a, sm);
    const int nitems = __builtin_amdgcn_readfirstlane(sm[64]) * 8;
    const int nmine = __builtin_amdgcn_readfirstlane(moe_maps_build(a, sm, maps, nitems, 8));
    int tkr = 0; float rsr = 0.f, bir = 0.f;
    auto side_load = [&](const MoeMap& m_) { if (tid < 256) { const int slot = m_.mt * 256 + tid; const bool ok = slot < m_.cnt; tkr = ok ? TOKOF[(size_t)m_.e * 16384 + slot] : 0; rsr = ok ? RSDS[(size_t)m_.e * 16384 + slot] : 0.f;
        bir = bup[(size_t)m_.e * 2048 + (tid < 128 ? m_.nt * 128 + tid : 1024 + m_.nt * 128 + tid - 128)]; } };
    auto side_store = [&](int slot3) { if (tid < 256) { tokb[slot3 * 256 + tid] = tkr; rsdb[slot3 * 256 + tid] = rsr; biab[slot3 * 256 + tid] = bir; } };
    auto boffu = [](int k, int nc) { const int sc = ((nc >> 4) ? 1024 : 0) + (nc & 15) * 8; return (unsigned)(k * 4096 + sc * 2); };
    MoeMap mm{}, mn{};
    if (nmine > 0) { mm = moe_get(maps, 0); side_load(mm); side_store(0); }
    if (nmine > 1) { mn = moe_get(maps, 1); side_load(mn); side_store(1); }
    __syncthreads();
    bool pre = false;
    for (int k = 0; k < nmine; ++k) {
        const bool has_next = k + 1 < nmine, has_nn = k + 2 < nmine;
        if (has_nn) { const MoeMap m2 = moe_get(maps, k + 2); side_load(m2); }
        const int s0 = k % 3, s1 = (k + 1) % 3, s2 = (k + 2) % 3;
        const int* tok = tokb + s0 * 256; const int* tokn = tokb + s1 * 256; const float* rsd = rsdb + s0 * 256; const float* bia = biab + s0 * 256;
        const bf16_t* We = W + (size_t)mm.e * 1024 * 2048; const bf16_t* Wn = W + (size_t)mn.e * 1024 * 2048;
        f32x4 acc[8][4];
        gemm256<true>(smem, 16, XN, 128u, [&](int r, int kc) { return (unsigned)(tok[r] * 2048 + kc * 16); }, We + mm.nt * 128, 64u * 4096u, boffu, acc, pre,
                      next_tile(has_next, smem, XN, [&](int r, int kc) { return (unsigned)(tokn[r] * 2048 + kc * 16); }, Wn + mn.nt * 128, boffu));
        if (has_nn) side_store(s2);
        EPI_IDS();
        float bgv[2][4], blv[2][4];
#pragma unroll
        for (int ni = 0; ni < 2; ++ni) { const int jl = wc * 32 + ni * 16 + 4 * (lane >> 4); const float4 bg = *(const float4*)(bia + jl), bl_ = *(const float4*)(bia + 128 + jl);
            bgv[ni][0] = bg.x; bgv[ni][1] = bg.y; bgv[ni][2] = bg.z; bgv[ni][3] = bg.w; blv[ni][0] = bl_.x; blv[ni][1] = bl_.y; blv[ni][2] = bl_.z; blv[ni][3] = bl_.w; }
#pragma unroll
        for (int mi = 0; mi < 8; ++mi) { const int rl_ = G_ROW(mi); const size_t row = (size_t)mm.off + mm.mt * 256 + rl_; const float rs_ = rsd[rl_];
#pragma unroll
            for (int ni = 0; ni < 2; ++ni) { const int jc = mm.nt * 128 + wc * 32 + ni * 16 + 4 * (lane >> 4);
                const f32x4 gv = acc[mi][ni], lv = acc[mi][ni + 2]; float r4[4];
#pragma unroll
                for (int r = 0; r < 4; ++r) { const float gg = fminf(gv[r] * rs_ + bgv[ni][r], 7.0f); const float ll = fminf(fmaxf(lv[r] * rs_ + blv[ni][r], -7.0f), 7.0f); r4[r] = gg * sigmoidf_(1.702f * gg) * (ll + 1.0f); }
                uint2 o; o.x = cvtpk(r4[0], r4[1]); o.y = cvtpk(r4[2], r4[3]); *(uint2*)(ACT + row * 1024 + jc) = o; } }
        lds_barrier();
        mm = mn; if (has_nn) mn = moe_get(maps, k + 2); pre = has_next;
    }
}
DEV void phase_down(const Args& a, unsigned char* smem) {
    int* sm = (int*)(smem + MISC_OFF); int* maps = (int*)(smem + MISC_OFF + 8192); float* rwb = (float*)(maps + 512); float* biab = rwb + 768;
    const bf16_t* ACT = (const bf16_t*)(a.ws + WS_ACT); const bf16_t* W = (const bf16_t*)(a.ws + WS_WDN); bf16_t* Y = (bf16_t*)(a.ws + WS_Y);
    const float* ROWW = (const float*)(a.ws + WS_ROWW); const float* bdn = a.in[I_BDN];
    const int tid = TID(); int lane = tid & 63, wid = tid >> 6, wr = wid >> 2, wc = wid & 3; (void)wr; (void)wc; (void)lane;
    moe_setup(a, sm);
    const int nitems = __builtin_amdgcn_readfirstlane(sm[64]) * 4;
    const int nmine = __builtin_amdgcn_readfirstlane(moe_maps_build(a, sm, maps, nitems, 4));
    float rwr = 0.f, bir = 0.f;
    auto side_load = [&](const MoeMap& m_) { if (tid < 256) { const int slot = m_.mt * 256 + tid; rwr = slot < m_.cnt ? ROWW[(size_t)m_.e * 16384 + slot] : 0.f; bir = bdn[(size_t)m_.e * 1024 + m_.nt * 256 + tid]; } };
    auto side_store = [&](int slot3) { if (tid < 256) { rwb[slot3 * 256 + tid] = rwr; biab[slot3 * 256 + tid] = bir; } };
    auto aoffd = [](int r, int kc) { return (unsigned)(r * 2048 + kc * 16); }; auto boffd = [](int k, int nc) { return (unsigned)(k * 2048 + nc * 16); };
    MoeMap mm{}, mn{};
    if (nmine > 0) { mm = moe_get(maps, 0); side_load(mm); side_store(0); }
    if (nmine > 1) { mn = moe_get(maps, 1); side_load(mn); side_store(1); }
    __syncthreads();
    bool pre = false;
    for (int k = 0; k < nmine; ++k) {
        const bool has_next = k + 1 < nmine, has_nn = k + 2 < nmine;
        if (has_nn) { const MoeMap m2 = moe_get(maps, k + 2); side_load(m2); }
        const int s0 = k % 3, s2 = (k + 2) % 3;
        const float* rw = rwb + s0 * 256; const float* bia = biab + s0 * 256;
        const bf16_t* We = W + (size_t)mm.e * 1024 * 1024; const bf16_t* Ab = ACT + ((size_t)mm.off + mm.mt * 256) * 1024;
        const bf16_t* Wn = W + (size_t)mn.e * 1024 * 1024; const bf16_t* An = ACT + ((size_t)mn.off + mn.mt * 256) * 1024;
        f32x4 acc[8][4];
        gemm256<true>(smem, 16, Ab, 128u, aoffd, We + mm.nt * 256, 64u * 2048u, boffd, acc, pre,
                      next_tile(has_next, smem, An, aoffd, Wn + mn.nt * 256, boffd));
        if (has_nn) side_store(s2);
        EPI_IDS();
        float4 bb[4];
#pragma unroll
        for (int ni = 0; ni < 4; ++ni) bb[ni] = *(const float4*)(bia + G_COL(ni));
#pragma unroll
        for (int mi = 0; mi < 8; ++mi) { const int rl = G_ROW(mi); const size_t row = (size_t)mm.off + mm.mt * 256 + rl; const float w = rw[rl];
#pragma unroll
            for (int ni = 0; ni < 4; ++ni) { const int n = mm.nt * 256 + G_COL(ni); const f32x4 v = acc[mi][ni];
                uint2 o; o.x = cvtpk((v[0] + bb[ni].x) * w, (v[1] + bb[ni].y) * w); o.y = cvtpk((v[2] + bb[ni].z) * w, (v[3] + bb[ni].w) * w); *(uint2*)(Y + row * 1024 + n) = o; } }
        lds_barrier();
        mm = mn; if (has_nn) mn = moe_get(maps, k + 2); pre = has_next;
    }
}

DEV void phase_comb(const Args& a, unsigned char* smem) {
    int* sm = (int*)(smem + MISC_OFF);
    moe_setup(a, sm);
    float* H1 = (float*)(a.ws + WS_H1); bf16_t* XN = (bf16_t*)(a.ws + WS_XN); const bf16_t* Y = (const bf16_t*)(a.ws + WS_Y);
    const int* TOPI = (const int*)(a.ws + WS_TOPI); const int* TOPS = (const int*)(a.ws + WS_TOPS); const float* g = a.in[I_LNPLE];
    const int lane = TID() & 63; const int gw = BID() * NWAVE + (TID() >> 6), ngw = gridDim.x * NWAVE;
    for (int tok = gw; tok < NTOK; tok += ngw) {
        float4 v[4];
#pragma unroll
        for (int j = 0; j < 4; ++j) v[j] = *(const float4*)(H1 + (size_t)tok * 1024 + j * 256 + lane * 4);
#pragma unroll
        for (int k = 0; k < 4; ++k) { const int e = TOPI[(size_t)tok * 4 + k]; const size_t row = (size_t)sm[32 + e] * 256 + TOPS[(size_t)tok * 4 + k];
#pragma unroll
            for (int j = 0; j < 4; ++j) { const uint2 u = *(const uint2*)(Y + row * 1024 + j * 256 + lane * 4); v[j].x += bflo(u.x); v[j].y += bfhi(u.x); v[j].z += bflo(u.y); v[j].w += bfhi(u.y); } }
        float s = 0.f;
#pragma unroll
        for (int j = 0; j < 4; ++j) { *(float4*)(H1 + (size_t)tok * 1024 + j * 256 + lane * 4) = v[j]; s += v[j].x * v[j].x + v[j].y * v[j].y + v[j].z * v[j].z + v[j].w * v[j].w; }
        const float rstd = rsqrtf(wave_sum(s) * (1.f / 1024.f) + EPS);
#pragma unroll
        for (int j = 0; j < 4; ++j) { const float4 gg = *(const float4*)(g + j * 256 + lane * 4);
            uint2 o; o.x = cvtpk(v[j].x * rstd * gg.x, v[j].y * rstd * gg.y); o.y = cvtpk(v[j].z * rstd * gg.z, v[j].w * rstd * gg.w); *(uint2*)(XN + (size_t)tok * 1024 + j * 256 + lane * 4) = o; }
    }
}

DEV void phase_gate(const Args& a, unsigned char* smem) {
    const bf16_t* XN = (const bf16_t*)(a.ws + WS_XN); const bf16_t* WG = (const bf16_t*)(a.ws + WS_WGATE); const bf16_t* PB = (const bf16_t*)(a.ws + WS_PB); const bf16_t* WP = (const bf16_t*)(a.ws + WS_WPLE);
    const float* H2 = (const float*)(a.ws + WS_H1); float* OUT = a.out; float* SSQ3 = (float*)(a.ws + WS_SSQ3);
    const int tid = TID(); int lane = tid & 63, wid = tid >> 6, wr = wid >> 2, wc = wid & 3; (void)wr; (void)wc; (void)lane;
    bf16_t* GT = (bf16_t*)(a.ws + WS_ACT);
    auto aoffg = [](int r, int kc) { return (unsigned)(r * 2048 + kc * 16); }; auto aoffp = [](int r, int kc) { return (unsigned)(r * 512 + kc * 16); }; auto boffg = [](int k, int nc) { return (unsigned)(k * 2048 + nc * 16); };
    for (int item = VBID(); item < 64 * 4; item += gridDim.x) {
        int mt, nt; patch_decode(item, 64, 4, mt, nt);
        f32x4 acc[8][4];
        gemm256<true>(smem, 16, XN + (size_t)mt * 256 * 1024, 128u, aoffg, WG + nt * 256, 64u * 2048u, boffg, acc, false,
                      next_tile(true, smem, PB + (size_t)mt * 256 * 256, aoffp, WP + nt * 256, boffg));
        EPI_IDS();
        {
            uint2 wq[8][4];
#pragma unroll
            for (int mi = 0; mi < 8; ++mi) { const size_t gm = (size_t)mt * 256 + G_ROW(mi);
#pragma unroll
                for (int ni = 0; ni < 4; ++ni) { const int n = nt * 256 + G_COL(ni); const f32x4 v = acc[mi][ni];
                    uint2 w; w.x = cvtpk(sigmoidf_(v[0]), sigmoidf_(v[1])); w.y = cvtpk(sigmoidf_(v[2]), sigmoidf_(v[3])); wq[mi][ni] = w;
                    const float4 h = *(const float4*)(H2 + gm * 1024 + n); acc[mi][ni] = (f32x4){h.x, h.y, h.z, h.w}; } }
#pragma unroll
            for (int mi = 0; mi < 8; ++mi) { const size_t gm = (size_t)mt * 256 + G_ROW(mi);
#pragma unroll
                for (int ni = 0; ni < 4; ++ni) { const int n = nt * 256 + G_COL(ni); const uint2 w = wq[mi][ni]; *(uint2*)(GT + gm * 1024 + n) = w; const f32x4 h = acc[mi][ni];
                    acc[mi][ni] = (f32x4){h[0] * __builtin_amdgcn_rcpf(bflo(w.x)), h[1] * __builtin_amdgcn_rcpf(bfhi(w.x)), h[2] * __builtin_amdgcn_rcpf(bflo(w.y)), h[3] * __builtin_amdgcn_rcpf(bfhi(w.y))}; } }
        }
        gemm256<false>(smem, 4, PB + (size_t)mt * 256 * 256, 128u, aoffp, WP + nt * 256, 64u * 2048u, boffg, acc, true);
        EPI_IDS();
        const bool fused = gridDim.x >= 256;
        {
            uint2 gq[8][4];
#pragma unroll
            for (int mi = 0; mi < 8; ++mi) { const size_t gm = (size_t)mt * 256 + G_ROW(mi);
#pragma unroll
                for (int ni = 0; ni < 4; ++ni) gq[mi][ni] = *(const uint2*)(GT + gm * 1024 + nt * 256 + G_COL(ni)); }
#pragma unroll
            for (int mi = 0; mi < 8; ++mi) { const size_t gm = (size_t)mt * 256 + G_ROW(mi); float ss = 0.f;
#pragma unroll
                for (int ni = 0; ni < 4; ++ni) { const int n = nt * 256 + G_COL(ni); const f32x4 v = acc[mi][ni]; const uint2 gw = gq[mi][ni];
                    float4 o = {v[0] * bflo(gw.x), v[1] * bfhi(gw.x), v[2] * bflo(gw.y), v[3] * bfhi(gw.y)};
                    if (!fused) *(float4*)(OUT + gm * 1024 + n) = o;
                    acc[mi][ni] = (f32x4){o.x, o.y, o.z, o.w};
                    ss += o.x * o.x + o.y * o.y + o.z * o.z + o.w * o.w; }
                ss += __shfl_xor(ss, 16); ss += __shfl_xor(ss, 32);
                if (lane < 16) SSQ3[gm * 16 + nt * 4 + wc] = ss; }
        }
        if (fused) {
            unsigned* flag = (unsigned*)(a.ws + WS_CTL) + CW_GATEFLAG + mt;
            const float* lnf = a.in[I_LNF]; float4 gg[4];
#pragma unroll
            for (int ni = 0; ni < 4; ++ni) gg[ni] = *(const float4*)(lnf + nt * 256 + G_COL(ni));
            signal_done(flag); wait_flag(flag, 4u);
            float rstd[8];
#pragma unroll
            for (int mi = 0; mi < 8; ++mi) { const size_t gm = (size_t)mt * 256 + G_ROW(mi); const float4 s0 = *(const float4*)(SSQ3 + gm * 16 + 4 * (lane >> 4)); rstd[mi] = (s0.x + s0.y) + (s0.z + s0.w); }
#pragma unroll
            for (int mi = 0; mi < 8; ++mi) { float t_ = rstd[mi]; t_ += __shfl_xor(t_, 16); t_ += __shfl_xor(t_, 32); rstd[mi] = rsqrtf(t_ * (1.f / 1024.f) + EPS); }
#pragma unroll
            for (int mi = 0; mi < 8; ++mi) { const size_t gm = (size_t)mt * 256 + G_ROW(mi);
#pragma unroll
                for (int ni = 0; ni < 4; ++ni) { const int n = nt * 256 + G_COL(ni); const f32x4 v = acc[mi][ni]; const float r_ = rstd[mi];
                    float4 o = {v[0] * r_ * gg[ni].x, v[1] * r_ * gg[ni].y, v[2] * r_ * gg[ni].z, v[3] * r_ * gg[ni].w}; *(float4*)(OUT + gm * 1024 + n) = o; } }
        }
        __syncthreads();
    }
}

DEV void phase_final(const Args& a) {
    if (gridDim.x >= 256) return;
    float* OUT = a.out; const float* SSQ3 = (const float*)(a.ws + WS_SSQ3); const float* g = a.in[I_LNF];
    const int lane = TID() & 63; const int gw = BID() * NWAVE + (TID() >> 6), ngw = gridDim.x * NWAVE;
    for (int m = gw; m < NTOK; m += ngw) {
        float s = 0.f;
#pragma unroll
        for (int j = 0; j < 16; ++j) s += SSQ3[(size_t)m * 16 + j];
        const float rstd = rsqrtf(s * (1.f / 1024.f) + EPS);
#pragma unroll
        for (int j = 0; j < 4; ++j) { float4 v = *(const float4*)(OUT + (size_t)m * 1024 + j * 256 + lane * 4); const float4 gg = *(const float4*)(g + j * 256 + lane * 4);
            v.x *= rstd * gg.x; v.y *= rstd * gg.y; v.z *= rstd * gg.z; v.w *= rstd * gg.w; *(float4*)(OUT + (size_t)m * 1024 + j * 256 + lane * 4) = v; }
    }
}

template <int PH> DEV void run_phase(const Args& a, unsigned char* smem) {
    if constexpr (PH == PH_PRO) phase_prologue(a, smem);
    else if constexpr (PH == PH_INPROJ) phase_inproj(a, smem);
    else if constexpr (PH == PH_ATT) phase_att(a, smem);
    else if constexpr (PH == PH_OUTPROJ) phase_outproj(a, smem);
    else if constexpr (PH == PH_ROUTE) phase_route(a, smem);
    else if constexpr (PH == PH_UP) phase_up(a, smem);
    else if constexpr (PH == PH_DOWN) phase_down(a, smem);
    else if constexpr (PH == PH_COMB) phase_comb(a, smem);
    else if constexpr (PH == PH_GATE) phase_gate(a, smem);
    else if constexpr (PH == PH_FINAL) phase_final(a);
}
#define XB_TMO      128
#define XB_XCNT(j)  (256  + 64 * (j))
#define XB_XSUB(j)  (1280 + 64 * (j))
#define XB_XGEN(j)  (2304 + 64 * (j))
#define XB_TOP      3328
#define XB_TOPGEN   3392
#define XCD_BAR_WORDS 3456
#define XB_SPIN_CAP (1u << 22)
DEV unsigned xb_ld(unsigned* p)              { return __hip_atomic_load(p, __ATOMIC_RELAXED, __HIP_MEMORY_SCOPE_AGENT); }
DEV unsigned xb_add(unsigned* p, unsigned v) { return __hip_atomic_fetch_add(p, v, __ATOMIC_RELAXED, __HIP_MEMORY_SCOPE_AGENT); }
DEV unsigned xb_xcc_id() { return (unsigned)__builtin_amdgcn_s_getreg((3 << 11) | 20) & 0xFu; }
#define XB_SPIN(cond, bar) do { unsigned _sp = 0; while (cond) { __builtin_amdgcn_s_sleep(1); \
    if ((++_sp & 255u) == 0u) { if (xb_ld(&(bar)[XB_TMO])) break; if (_sp > XB_SPIN_CAP) { atomicAdd(&(bar)[XB_TMO], 1u); break; } } } } while (0)
struct XcdBarrier { unsigned* bar; unsigned x; volatile LAS unsigned* st; };
DEV XcdBarrier xcd_barrier_post(unsigned* bar, volatile LAS unsigned* st) {
    XcdBarrier b; b.bar = bar; b.x = xb_xcc_id(); b.st = st;
    if (TID() == 0) (void)xb_add(&bar[XB_XCNT(b.x)], 1u);
    return b;
}
DEV void xcd_barrier_complete(unsigned* bar, unsigned x, unsigned& nloc, unsigned& nx) {
    const unsigned G = gridDim.x * gridDim.y * gridDim.z;
    unsigned sum, cnt, mine, sp = 0u;
    for (;;) {
        sum = 0u; cnt = 0u; mine = 0u;
#pragma unroll
        for (unsigned j = 0; j < 16; ++j) { const unsigned c = xb_ld(&bar[XB_XCNT(j)]); sum += c; cnt += (c > 0u) ? 1u : 0u; mine = (j == x) ? c : mine; }
        if (sum == G) break;
        __builtin_amdgcn_s_sleep(1);
        if ((++sp & 255u) == 0u) { if (xb_ld(&bar[XB_TMO])) break; if (sp > XB_SPIN_CAP) { atomicAdd(&bar[XB_TMO], 1u); break; } }
    }
    nloc = mine > 0u ? mine : 1u; nx = cnt > 0u ? cnt : 1u;
}
DEV void xcd_barrier(const XcdBarrier& b) {
    asm volatile("s_waitcnt vmcnt(0)" ::: "memory");
    __syncthreads();
    if (TID() == 0) {
        unsigned* bar = b.bar;
        __builtin_amdgcn_s_waitcnt(0);
        unsigned nloc = b.st[0], nx = b.st[1];
        if (nloc == 0u) { xcd_barrier_complete(bar, b.x, nloc, nx); b.st[0] = nloc; b.st[1] = nx; }
        const unsigned old = xb_add(&bar[XB_XSUB(b.x)], 1u);
        const unsigned gen = old / nloc;
        if (old + 1u == (gen + 1u) * nloc) {
            __builtin_amdgcn_fence(__ATOMIC_RELEASE, "agent");
            asm volatile("s_waitcnt vmcnt(0)" ::: "memory");
            const unsigned og = xb_add(&bar[XB_TOP], 1u);
            const unsigned tg = og / nx;
            if (og + 1u == (tg + 1u) * nx) xb_add(&bar[XB_TOPGEN], 1u);
            else XB_SPIN(xb_ld(&bar[XB_TOPGEN]) == tg, bar);
            __builtin_amdgcn_fence(__ATOMIC_ACQUIRE, "agent");
            xb_add(&bar[XB_XGEN(b.x)], 1u);
            asm volatile("s_waitcnt vmcnt(0)" ::: "memory");
        } else {
            XB_SPIN(xb_ld(&bar[XB_XGEN(b.x)]) == gen, bar);
            __builtin_amdgcn_fence(__ATOMIC_ACQUIRE, "agent");
            asm volatile("s_waitcnt vmcnt(0)" ::: "memory");
        }
    }
    __syncthreads();
}

__global__ void __launch_bounds__(NTHR, 2) mega(Args a) {
    extern __shared__ __attribute__((aligned(16))) unsigned char smem[];
    volatile LAS unsigned* bst = (volatile LAS unsigned*)(LAS unsigned char*)(smem + MISC_OFF + 8000);
    if (TID() == 0) { bst[0] = 0u; bst[1] = 0u; }
    __syncthreads();
    const XcdBarrier bar = xcd_barrier_post((unsigned*)(a.ws + WS_CTL) + 4096, bst);
#define GSYNC() xcd_barrier(bar)
#define RUN(ph) do { run_phase<ph>(a, smem); if ((PROBE_DUP >> ph) & 1) { GSYNC(); run_phase<ph>(a, smem); } } while (0)
    RUN(PH_PRO); GSYNC();
    RUN(PH_INPROJ); GSYNC();
    RUN(PH_ATT); GSYNC();
    RUN(PH_OUTPROJ); GSYNC();
    RUN(PH_ROUTE); GSYNC();
    RUN(PH_UP); GSYNC();
    RUN(PH_DOWN); GSYNC();
    RUN(PH_COMB); GSYNC();
    RUN(PH_GATE);
    if (gridDim.x < 256) { GSYNC(); RUN(PH_FINAL); }
#undef RUN
#undef GSYNC
}

extern "C" void kernel_launch(void* const* d_in, const int* in_sizes, int n_in, void* d_out, int out_size, void* d_ws, size_t ws_size, hipStream_t stream) {
    static int grid = 0;
    if (grid == 0) {
        if (n_in != 25 || ws_size < WS_END) { fprintf(stderr, "kernel_launch: unexpected n_in %d / ws %zu\n", n_in, ws_size); grid = -1; return; }
        int dev = 0, cus = 0, per_cu = 0;
        (void)hipGetDevice(&dev); (void)hipDeviceGetAttribute(&cus, hipDeviceAttributeMultiprocessorCount, dev);
        (void)hipFuncSetAttribute((const void*)mega, hipFuncAttributeMaxDynamicSharedMemorySize, LDS_BYTES);
        (void)hipOccupancyMaxActiveBlocksPerMultiprocessor(&per_cu, (const void*)mega, NTHR, LDS_BYTES);
        if (per_cu < 1) { fprintf(stderr, "kernel_launch: occupancy query says %d blocks per CU\n", per_cu); grid = -1; return; }
        grid = cus;
    }
    if (grid < 0) return;
    (void)hipMemsetAsync((char*)d_ws + WS_CTL, 0, 65536, stream);
    Args a{};
    for (int i = 0; i < 25; ++i) a.in[i] = (const float*)d_in[i];
    a.out = (float*)d_out; a.ws = (unsigned char*)d_ws; a.ph_lo = 0; a.ph_hi = PH_N;
    void* args[] = {&a};
    hipError_t e = hipLaunchCooperativeKernel((const void*)mega, dim3(grid), dim3(NTHR), args, LDS_BYTES, stream);
    if (e != hipSuccess) fprintf(stderr, "cooperative launch failed: %s (grid %d)\n", hipGetErrorString(e), grid);
}
```

```cpp
#include <hip/hip_runtime.h>
#include <stdint.h>
#include <cstdio>

#define DEV __device__ __forceinline__
#define LAS __attribute__((address_space(3)))

typedef unsigned short bf16_t;
typedef short bf16x8 __attribute__((ext_vector_type(8)));
typedef short s16x4 __attribute__((ext_vector_type(4)));
typedef float f32x4 __attribute__((ext_vector_type(4)));
typedef float f32x16 __attribute__((ext_vector_type(16)));
typedef float f32x2_t __attribute__((ext_vector_type(2)));
typedef __bf16 bf16x2_t __attribute__((ext_vector_type(2)));

constexpr int NTHR = 512, NWAVE = 8;
constexpr int NTOK = 16384;
constexpr float EPS = 1e-6f;
constexpr float LOG2E = 1.4426950408889634f;
constexpr float QS = 0.125f * LOG2E;
constexpr int NWIN = 3072;

constexpr size_t MiB = 1u << 20;
constexpr size_t WS_CTL = 0;
constexpr size_t WS_WIN = 1 * MiB;
constexpr size_t WS_WOUT = 7 * MiB;
constexpr size_t WS_WGATE = 9 * MiB;
constexpr size_t WS_WPLE = 11 * MiB;
constexpr size_t WS_WC1 = 12 * MiB;
constexpr size_t WS_WC2 = 15 * MiB + 512 * 1024 + 262144;
constexpr size_t WS_BIAS1 = 15 * MiB + 512 * 1024 + 262144 + 131072;
constexpr size_t WS_KC = 14 * MiB;
constexpr size_t WS_HID = 14 * MiB + 512 * 1024;
constexpr size_t WS_GN = 16 * MiB;
constexpr size_t WS_LS = 18 * MiB;
constexpr size_t WS_CUM = 19 * MiB;
constexpr size_t WS_SSQ = 20 * MiB;
constexpr size_t WS_TOPI = 21 * MiB;
constexpr size_t WS_TOPS = 21 * MiB + 262144;
constexpr size_t WS_TOPW = 21 * MiB + 524288;
constexpr size_t WS_TOKOF = 22 * MiB;
constexpr size_t WS_ROWW = 24 * MiB;
constexpr size_t WS_SSQ3 = 26 * MiB;
constexpr size_t WS_RSTD2 = 27 * MiB;
constexpr size_t WS_PB = 28 * MiB;
constexpr size_t WS_XN = 36 * MiB;
constexpr size_t WS_PROJ = 68 * MiB;
constexpr size_t WS_ONSA = 160 * MiB;
constexpr size_t WS_OFOX = 176 * MiB;
constexpr size_t WS_H1 = 192 * MiB;
constexpr size_t WS_WUP = 256 * MiB;
constexpr size_t WS_WDN = 384 * MiB;
constexpr size_t WS_ACT = 448 * MiB;
constexpr size_t WS_Y = 592 * MiB;
constexpr size_t WS_RSDS = 736 * MiB;
constexpr size_t WS_END = 738 * MiB;

enum { PH_PRO = 0, PH_INPROJ, PH_CMP, PH_ATT, PH_OUTPROJ, PH_ROUTE, PH_UP, PH_DOWN, PH_COMB, PH_GATE, PH_FINAL, PH_N };
struct Args { const float* in[25]; float* out; unsigned char* ws; int ph_lo, ph_hi; };
enum { I_X = 0, I_P, I_LN1, I_WIN, I_BFG, I_WC1K, I_WC2K, I_PEK, I_WC1V, I_WC2V, I_PEV, I_GNN, I_GNF, I_WOUT, I_LN2, I_WR, I_BR,
       I_WUP, I_BUP, I_WDN, I_BDN, I_LNPLE, I_WPLE, I_WGATE, I_LNF };

DEV int BID() { int b = (int)blockIdx.x; asm volatile("" : "+s"(b)); return b; }
DEV int VBID() { const int g = (int)gridDim.x, b = BID(); return (g & 7) ? b : (b & 7) * (g >> 3) + (b >> 3); }
DEV int TID() { int t = (int)__builtin_amdgcn_workitem_id_x(); asm volatile("" : "+v"(t)); return t; }
DEV unsigned cvtpk(float lo, float hi) { f32x2_t v = {lo, hi}; bf16x2_t b = __builtin_convertvector(v, bf16x2_t); return __builtin_bit_cast(unsigned, b); }
DEV float bflo(unsigned u) { return __uint_as_float(u << 16); }
DEV float bfhi(unsigned u) { return __uint_as_float(u & 0xffff0000u); }
DEV float wave_sum(float v) {
#pragma unroll
    for (int o = 1; o < 64; o <<= 1) v += __shfl_xor(v, o);
    return v;
}
#define DPP_MOV(x, ctrl) __builtin_bit_cast(float, __builtin_amdgcn_update_dpp(0, __builtin_bit_cast(int, (x)), (ctrl), 0xF, 0xF, true))
DEV float pair_sum(float x) { return x + __shfl_xor(x, 32); }
DEV float pair_max(float x) { return fmaxf(x, __shfl_xor(x, 32)); }
DEV float quad_sum(float x) { x += DPP_MOV(x, 0xB1); x += DPP_MOV(x, 0x4E); return x; }
DEV float wave_max_u(float x) {
    x = fmaxf(x, DPP_MOV(x, 0xB1)); x = fmaxf(x, DPP_MOV(x, 0x4E)); x = fmaxf(x, DPP_MOV(x, 0x141)); x = fmaxf(x, DPP_MOV(x, 0x140));
    const float a = __builtin_bit_cast(float, __builtin_amdgcn_readlane(__builtin_bit_cast(int, x), 0)), b = __builtin_bit_cast(float, __builtin_amdgcn_readlane(__builtin_bit_cast(int, x), 16));
    const float c = __builtin_bit_cast(float, __builtin_amdgcn_readlane(__builtin_bit_cast(int, x), 32)), d = __builtin_bit_cast(float, __builtin_amdgcn_readlane(__builtin_bit_cast(int, x), 48));
    return fmaxf(fmaxf(a, b), fmaxf(c, d));
}
DEV float sigmoidf_(float x) { return __builtin_amdgcn_rcpf(1.0f + __expf(-x)); }
DEV float logsigmoidf_(float x) { return fminf(x, 0.f) - log1pf(__expf(-fabsf(x))); }
DEV float gelu_tanh(float x) { const float u = 0.7978845608028654f * (x + 0.044715f * x * x * x); const float th = 1.0f - 2.0f * __builtin_amdgcn_rcpf(__expf(2.0f * u) + 1.0f); return 0.5f * x * (1.0f + th); }
DEV s16x4 tr_read(const unsigned char* p) {
    typedef short v4i16_t __attribute__((ext_vector_type(4)));
    return __builtin_bit_cast(s16x4, __builtin_amdgcn_ds_read_tr16_b64_v4i16((LAS v4i16_t*)p));
}
DEV int crow(int r, int hi) { return (r & 3) + 8 * (r >> 2) + 4 * hi; }

constexpr int GL_STAGE = 65536;
constexpr int GEMM_LDS = 2 * GL_STAGE;
constexpr int MISC_OFF = GEMM_LDS;
constexpr int LDS_BYTES = GEMM_LDS + 8192 + 12288;

DEV void glds16s(const void* sbase, unsigned voff, unsigned lds_dst) { unsigned keep;
    asm volatile("s_mov_b32 %0, m0\n\ts_mov_b32 m0, %3\n\ts_nop 0\n\tglobal_load_lds_dwordx4 %1, %2\n\ts_mov_b32 m0, %0" : "=&s"(keep) : "v"(voff), "s"(sbase), "s"(lds_dst) : "memory"); }

DEV const unsigned char* uptr(const void* p) { const unsigned long long v = (unsigned long long)p; const unsigned lo = __builtin_amdgcn_readfirstlane((unsigned)v), hi = __builtin_amdgcn_readfirstlane((unsigned)(v >> 32)); return (const unsigned char*)(((unsigned long long)hi << 32) | lo); }

DEV void lds_barrier() { asm volatile("s_waitcnt lgkmcnt(0)\n\ts_barrier" ::: "memory"); }

struct NoNextS { DEV void operator()() const {} };
template <class AO, class BO>
DEV void gemm256s_issue0(unsigned char* smem, const void* abase, const AO& aoff, const void* bbase, const BO& boff) {
    const int tid = TID(), lane = tid & 63; const int wid = __builtin_amdgcn_readfirstlane(tid >> 6);
    const unsigned lds0 = (unsigned)(uintptr_t)smem; const unsigned char* ab_ = uptr(abase); const unsigned char* bb_ = uptr(bbase);
#pragma unroll
    for (int i = 0; i < 4; ++i) { const int p = wid + 8 * i; glds16s(ab_, aoff(8 * p + (lane >> 3), (lane & 7) ^ (lane >> 3)), (unsigned)__builtin_amdgcn_readfirstlane(lds0 + p * 1024)); }
#pragma unroll
    for (int i = 0; i < 4; ++i) { const int p = wid + 8 * i; const int k = 2 * p + (lane >> 5); const int f = (k & 3) + 4 * ((k >> 3) & 1);
        glds16s(bb_, boff(k, (lane & 31) ^ (f << 1)), (unsigned)__builtin_amdgcn_readfirstlane(lds0 + 32768 + p * 1024)); }
}
template <bool ZERO, class AO, class BO, class NX = NoNextS>
DEV void gemm256s(unsigned char* smem, int nkt, const void* abase, unsigned akstep, const AO& aoff, const void* bbase, unsigned bkstep, const BO& boff, f32x4 (&acc)[8][4], bool pre = false, const NX& next = NX()) {
    const int tid = TID(), lane = tid & 63; const int wid = __builtin_amdgcn_readfirstlane(tid >> 6); const int wr = wid >> 2, wc = wid & 3;
    if (ZERO) {
#pragma unroll
        for (int mi = 0; mi < 8; ++mi)
#pragma unroll
            for (int ni = 0; ni < 4; ++ni) acc[mi][ni] = (f32x4){0.f, 0.f, 0.f, 0.f};
    }
    const unsigned lds0 = (unsigned)(uintptr_t)smem;
    const unsigned char* abase_u = uptr(abase); const unsigned char* bbase_u = uptr(bbase); const unsigned akstep_u = __builtin_amdgcn_readfirstlane(akstep), bkstep_u = __builtin_amdgcn_readfirstlane(bkstep);
    unsigned ao[4], bo[4];
#pragma unroll
    for (int i = 0; i < 4; ++i) { const int p = wid + 8 * i; ao[i] = aoff(8 * p + (lane >> 3), (lane & 7) ^ (lane >> 3));
        const int k = 2 * p + (lane >> 5); const int f = (k & 3) + 4 * ((k >> 3) & 1); bo[i] = boff(k, (lane & 31) ^ (f << 1)); }
#define GL_ISSUE(kt, st) do { const unsigned char* ab_ = abase_u + (size_t)(kt) * akstep_u; const unsigned char* bb_ = bbase_u + (size_t)(kt) * bkstep_u; \
        _Pragma("unroll") for (int i_ = 0; i_ < 4; ++i_) glds16s(ab_, ao[i_], (unsigned)__builtin_amdgcn_readfirstlane(lds0 + (st) * GL_STAGE + (wid + 8 * i_) * 1024)); \
        _Pragma("unroll") for (int i_ = 0; i_ < 4; ++i_) glds16s(bb_, bo[i_], (unsigned)__builtin_amdgcn_readfirstlane(lds0 + (st) * GL_STAGE + 32768 + (wid + 8 * i_) * 1024)); } while (0)
    if (!pre) {
        GL_ISSUE(0, 0);
        asm volatile("s_waitcnt vmcnt(0)" ::: "memory");
        __syncthreads();
    }
    for (int kt = 0; kt < nkt; ++kt) {
        if (kt + 1 < nkt) GL_ISSUE(kt + 1, (kt + 1) & 1); else next();
        const unsigned char* A = smem + (kt & 1) * GL_STAGE; const unsigned char* Bt = A + 32768;
#pragma unroll
        for (int ks = 0; ks < 2; ++ks) {
            bf16x8 wf[4];
#pragma unroll
            for (int ni = 0; ni < 4; ++ni) {
                const int i = lane & 15, g = lane >> 4, q = i >> 2; const int row = ks * 32 + 8 * g + q; const int nc = wc * 8 + ni * 2 + ((i & 3) >> 1); const int f = q + 4 * (g & 1);
                const unsigned char* p = Bt + row * 512 + ((nc ^ (f << 1)) << 4) + (i & 1) * 8;
                const s16x4 lo = tr_read(p), hi = tr_read(p + 4 * 512);
                wf[ni] = (bf16x8){lo[0], lo[1], lo[2], lo[3], hi[0], hi[1], hi[2], hi[3]};
            }
#pragma unroll
            for (int mi = 0; mi < 8; ++mi) {
                const int m = wr * 128 + mi * 16 + (lane & 15); const int kc = ks * 4 + (lane >> 4);
                const bf16x8 af = *(const bf16x8*)(A + m * 128 + ((kc ^ (m & 7)) << 4));
#pragma unroll
                for (int ni = 0; ni < 4; ++ni) acc[mi][ni] = __builtin_amdgcn_mfma_f32_16x16x32_bf16(wf[ni], af, acc[mi][ni], 0, 0, 0);
            }
        }
        asm volatile("s_waitcnt vmcnt(0)" ::: "memory");
        __syncthreads();
    }
#undef GL_ISSUE
}

#define G_ROW(mi) ((((mi) >> 2) * 128) + wr * 64 + (((mi) & 3) * 16) + (lane & 15))
#define G_COL(ni) ((((ni) >> 1) * 128) + wc * 32 + (((ni) & 1) * 16) + 4 * (lane >> 4))
#define WAIT_V(n) asm volatile("s_waitcnt vmcnt(" #n ")" ::: "memory")
#define WAIT_L(n) asm volatile("s_waitcnt lgkmcnt(" #n ")" ::: "memory")
#define BAR() __builtin_amdgcn_s_barrier()
#define SCHED() __builtin_amdgcn_sched_barrier(0)
constexpr int SA_(int b, int h) { return b * GL_STAGE + h * 16384; }
constexpr int SB_(int b, int h) { return b * GL_STAGE + 32768 + h * 16384; }
struct NoNext { DEV bool has() const { return false; } template <int P> DEV void issue() const {} };
template <int WHICH, class AO, class BO>
DEV void gemm_issue0(unsigned char* smem, const void* abase, const AO& aoff, const void* bbase, const BO& boff) {
    const int tid = TID(), lane = tid & 63; const int wid = __builtin_amdgcn_readfirstlane(tid >> 6);
    const unsigned lds0 = (unsigned)(uintptr_t)smem; const unsigned char* ab_ = uptr(abase); const unsigned char* bb_ = uptr(bbase);
#pragma unroll
    for (int h = 0; h < 2; ++h) {
        if (WHICH & (1 << (2 * h))) {
#pragma unroll
            for (int i = 0; i < 2; ++i) { const int p = wid + 8 * i; const int k = 4 * p + (lane >> 4); const int f = (k & 3) + 4 * ((k >> 3) & 1);
                glds16s(bb_, boff(k, h * 16 + ((lane & 15) ^ (f << 1))), (unsigned)__builtin_amdgcn_readfirstlane(lds0 + SB_(0, h) + p * 1024)); } }
        if (WHICH & (2 << (2 * h))) {
#pragma unroll
            for (int i = 0; i < 2; ++i) { const int p = wid + 8 * i;
                glds16s(ab_, aoff(h * 128 + 8 * p + (lane >> 3), (lane & 7) ^ (lane >> 3)), (unsigned)__builtin_amdgcn_readfirstlane(lds0 + SA_(0, h) + p * 1024)); } }
    }
}
template <class AO, class BO>
struct NextTile { bool on; unsigned char* smem; const void* abase; AO aoff; const void* bbase; BO boff;
    DEV bool has() const { return on; }
    template <int P> DEV void issue() const { gemm_issue0<P>(smem, abase, aoff, bbase, boff); } };
template <class AO, class BO> DEV NextTile<AO, BO> next_tile(bool on, unsigned char* smem, const void* abase, const AO& aoff, const void* bbase, const BO& boff) { return NextTile<AO, BO>{on, smem, abase, aoff, bbase, boff}; }
template <bool ZERO, class AO, class BO, class NX = NoNext>
DEV void gemm256(unsigned char* smem, int nkt, const void* abase, unsigned akstep, const AO& aoff, const void* bbase, unsigned bkstep, const BO& boff, f32x4 (&acc)[8][4], bool pre = false, const NX& next = NX()) {
    const int tid = TID(), lane = tid & 63; const int wid = __builtin_amdgcn_readfirstlane(tid >> 6); const int wr = wid >> 2, wc = wid & 3;
    if (ZERO) {
#pragma unroll
        for (int mi = 0; mi < 8; ++mi)
#pragma unroll
            for (int ni = 0; ni < 4; ++ni) acc[mi][ni] = (f32x4){0.f, 0.f, 0.f, 0.f};
    }
    const unsigned lds0 = (unsigned)(uintptr_t)smem;
    const unsigned char* abase_u = uptr(abase); const unsigned char* bbase_u = uptr(bbase); const unsigned akstep_u = __builtin_amdgcn_readfirstlane(akstep), bkstep_u = __builtin_amdgcn_readfirstlane(bkstep);
    unsigned ao[4], bo[4];
#pragma unroll
    for (int h = 0; h < 2; ++h)
#pragma unroll
        for (int i = 0; i < 2; ++i) { const int p = wid + 8 * i; ao[h * 2 + i] = aoff(h * 128 + 8 * p + (lane >> 3), (lane & 7) ^ (lane >> 3));
            const int k = 4 * p + (lane >> 4); const int f = (k & 3) + 4 * ((k >> 3) & 1); bo[h * 2 + i] = boff(k, h * 16 + ((lane & 15) ^ (f << 1))); }
    const unsigned char* ard0; const unsigned char* ard1; const unsigned char* brd0; const unsigned char* brd1;
    { const int l15 = lane & 15, g = lane >> 4, q = l15 >> 2; const int f = q + 4 * (g & 1);
      ard0 = smem + (wr * 64 + l15) * 128 + ((g ^ (lane & 7)) << 4); ard1 = smem + (wr * 64 + l15) * 128 + (((4 + g) ^ (lane & 7)) << 4);
      const int nc = wc * 4 + ((l15 & 3) >> 1); const int kr = 8 * g + q;
      brd0 = smem + kr * 256 + ((nc ^ (f << 1)) << 4) + (l15 & 1) * 8; brd1 = smem + kr * 256 + (((nc + 2) ^ (f << 1)) << 4) + (l15 & 1) * 8; }
#define ST_A(b, h, kt) do { const unsigned char* ab_ = abase_u + (size_t)(kt) * akstep_u; \
        _Pragma("unroll") for (int i_ = 0; i_ < 2; ++i_) glds16s(ab_, ao[(h) * 2 + i_], (unsigned)__builtin_amdgcn_readfirstlane(lds0 + SA_(b, h) + (wid + 8 * i_) * 1024)); } while (0)
#define ST_B(b, h, kt) do { const unsigned char* bb_ = bbase_u + (size_t)(kt) * bkstep_u; \
        _Pragma("unroll") for (int i_ = 0; i_ < 2; ++i_) glds16s(bb_, bo[(h) * 2 + i_], (unsigned)__builtin_amdgcn_readfirstlane(lds0 + SB_(b, h) + (wid + 8 * i_) * 1024)); } while (0)
#define LDA(dst, b, h) do { _Pragma("unroll") for (int m_ = 0; m_ < 4; ++m_) { dst[m_][0] = *(const bf16x8*)(ard0 + SA_(b, h) + m_ * 2048); dst[m_][1] = *(const bf16x8*)(ard1 + SA_(b, h) + m_ * 2048); } } while (0)
#define LDB(dst, b, h) do { _Pragma("unroll") for (int n_ = 0; n_ < 2; ++n_) _Pragma("unroll") for (int k_ = 0; k_ < 2; ++k_) { const unsigned char* p_ = (n_ ? brd1 : brd0) + SB_(b, h) + k_ * 8192; \
        const s16x4 lo_ = tr_read(p_), hi_ = tr_read(p_ + 1024); dst[n_][k_] = (bf16x8){lo_[0], lo_[1], lo_[2], lo_[3], hi_[0], hi_[1], hi_[2], hi_[3]}; } } while (0)
#define MMA(ai, bj, Bx) do { __builtin_amdgcn_s_setprio(1); \
        _Pragma("unroll") for (int k_ = 0; k_ < 2; ++k_) _Pragma("unroll") for (int m_ = 0; m_ < 4; ++m_) _Pragma("unroll") for (int n_ = 0; n_ < 2; ++n_) \
            acc[(ai) * 4 + m_][(bj) * 2 + n_] = __builtin_amdgcn_mfma_f32_16x16x32_bf16(Bx[n_][k_], At[m_][k_], acc[(ai) * 4 + m_][(bj) * 2 + n_], 0, 0, 0); \
        __builtin_amdgcn_s_setprio(0); } while (0)
    bf16x8 At[4][2], B0[2][2], B1[2][2];
    if (!pre) { ST_B(0, 0, 0); ST_A(0, 0, 0); ST_B(0, 1, 0); ST_A(0, 1, 0); }
    if (wr == 1) BAR();
    if (!pre) WAIT_V(4);
    BAR();
    ST_B(1, 0, 1); ST_A(1, 0, 1); ST_B(1, 1, 1);
    if (!pre) WAIT_V(6);
    BAR();
    for (int t = 0; t < nkt - 2; t += 2) {
        LDB(B0, 0, 0); SCHED(); LDA(At, 0, 0); ST_A(1, 1, t + 1);
        WAIT_L(8); BAR(); WAIT_L(0); MMA(0, 0, B0); BAR(); SCHED();
        LDB(B1, 0, 1); ST_B(0, 0, t + 2);
        BAR(); WAIT_L(0); MMA(0, 1, B1); BAR();
        LDA(At, 0, 1); ST_A(0, 0, t + 2);
        BAR(); WAIT_L(0); MMA(1, 0, B0); BAR(); SCHED();
        ST_B(0, 1, t + 2);
        WAIT_V(6); BAR(); MMA(1, 1, B1); BAR();
        LDB(B0, 1, 0); SCHED(); LDA(At, 1, 0); ST_A(0, 1, t + 2);
        WAIT_L(8); BAR(); WAIT_L(0); MMA(0, 0, B0); BAR(); SCHED();
        LDB(B1, 1, 1); ST_B(1, 0, t + 3);
        BAR(); WAIT_L(0); MMA(0, 1, B1); BAR();
        LDA(At, 1, 1); ST_A(1, 0, t + 3);
        BAR(); WAIT_L(0); MMA(1, 0, B0); BAR(); SCHED();
        ST_B(1, 1, t + 3);
        WAIT_V(6); BAR(); MMA(1, 1, B1); BAR();
    }
    const bool hn = next.has();
    LDB(B0, 0, 0); LDA(At, 0, 0); ST_A(1, 1, nkt - 1);
    BAR(); WAIT_L(0); MMA(0, 0, B0); BAR();
    LDB(B1, 0, 1); BAR(); WAIT_L(0); MMA(0, 1, B1); BAR();
    LDA(At, 0, 1);
    if (hn) { next.template issue<3>(); WAIT_V(8); } else WAIT_V(4);
    BAR(); WAIT_L(0); MMA(1, 0, B0); MMA(1, 1, B1); BAR();
    LDB(B0, 1, 0); LDA(At, 1, 0);
    if (hn) { next.template issue<4>(); WAIT_V(8); } else WAIT_V(2);
    BAR(); WAIT_L(0); MMA(0, 0, B0); BAR();
    LDB(B1, 1, 1);
    if (hn) { next.template issue<8>(); WAIT_V(8); } else WAIT_V(0);
    BAR(); WAIT_L(0); MMA(0, 1, B1); BAR();
    LDA(At, 1, 1); BAR(); WAIT_L(0); MMA(1, 0, B0); MMA(1, 1, B1);
    WAIT_V(0);
    BAR();
    if (wr == 0) BAR();
#undef ST_A
#undef ST_B
#undef LDA
#undef LDB
#undef MMA
}

#define EPI_IDS() do { const int etid_ = TID(); lane = etid_ & 63; wid = etid_ >> 6; wr = wid >> 2; wc = wid & 3; } while (0)

DEV void patch_decode(int local, int MT, int NT, int& mt, int& nt) {
    const int per_mtb = 8 * NT; const int mtb = local / per_mtb; const int rem = local - mtb * per_mtb;
    const int rows = (MT - 8 * mtb) < 8 ? (MT - 8 * mtb) : 8;
    const int per_ntb = rows * 8; const int nfull = NT >> 3; int ntb = rem / per_ntb; int cols = 8;
    if (ntb >= nfull) { ntb = nfull; cols = NT - 8 * nfull; }
    const int r2 = rem - ntb * per_ntb;
    mt = 8 * mtb + r2 / cols; nt = 8 * ntb + r2 % cols;
}

DEV void convert_chunk(const float* src, bf16_t* dst, size_t i8) {
    const float4 a = *(const float4*)(src + i8 * 8), b = *(const float4*)(src + i8 * 8 + 4);
    uint4 o; o.x = cvtpk(a.x, a.y); o.y = cvtpk(a.z, a.w); o.z = cvtpk(b.x, b.y); o.w = cvtpk(b.z, b.w);
    *(uint4*)(dst + i8 * 8) = o;
}
DEV void phase_prologue(const Args& a, unsigned char* smem) {
    unsigned char* ws = a.ws;
    const size_t gtid = (size_t)BID() * NTHR + TID(), gn = (size_t)gridDim.x * NTHR;
    {
        { const float* W = a.in[I_WOUT]; bf16_t* O = (bf16_t*)(ws + WS_WOUT); const float* gnn = a.in[I_GNN]; const float* gnf = a.in[I_GNF];
          for (size_t i = gtid; i < (size_t)1024 * 128; i += gn) { const int k = (int)(i >> 7); const float g_ = k < 512 ? gnn[k] : gnf[k - 512];
              const float4 x = *(const float4*)(W + i * 8), y = *(const float4*)(W + i * 8 + 4);
              uint4 o; o.x = cvtpk(x.x * g_, x.y * g_); o.y = cvtpk(x.z * g_, x.w * g_); o.z = cvtpk(y.x * g_, y.y * g_); o.w = cvtpk(y.z * g_, y.w * g_); *(uint4*)(O + i * 8) = o; } }
        const float* srcs[3] = {a.in[I_WGATE], a.in[I_WPLE], a.in[I_P]};
        bf16_t* dsts[3] = {(bf16_t*)(ws + WS_WGATE), (bf16_t*)(ws + WS_WPLE), (bf16_t*)(ws + WS_PB)};
        const size_t cnt8[3] = {1024 * 1024 / 8, 256 * 1024 / 8, (size_t)NTOK * 256 / 8};
#pragma unroll
        for (int s = 0; s < 3; ++s) for (size_t i = gtid; i < cnt8[s]; i += gn) convert_chunk(srcs[s], dsts[s], i);
        for (size_t i = gtid; i < (size_t)2 * 2048 * 32; i += gn) { const int which = (int)(i / (2048 * 32)); const int k = (int)(i / 32) % 2048, c8 = (int)(i % 32) * 8;
            uint4 o = {0u, 0u, 0u, 0u};
            if (c8 < 128) { const float* W = a.in[which ? I_WC1V : I_WC1K] + (size_t)k * 128 + c8; const float4 x = *(const float4*)W, y = *(const float4*)(W + 4); o.x = cvtpk(x.x, x.y); o.y = cvtpk(x.z, x.w); o.z = cvtpk(y.x, y.y); o.w = cvtpk(y.z, y.w); }
            *(uint4*)((bf16_t*)(ws + WS_WC1) + i * 8) = o; }
        for (size_t i = gtid; i < (size_t)2 * 128 * 32; i += gn) { const int which = (int)(i / (128 * 32)); const int k = (int)(i / 32) % 128, c8 = (int)(i % 32) * 8;
            uint4 o = {0u, 0u, 0u, 0u};
            if (c8 < 64) { const float* W = a.in[which ? I_WC2V : I_WC2K] + (size_t)k * 64 + c8; const float4 x = *(const float4*)W, y = *(const float4*)(W + 4); o.x = cvtpk(x.x, x.y); o.y = cvtpk(x.z, x.w); o.z = cvtpk(y.x, y.y); o.w = cvtpk(y.z, y.w); }
            *(uint4*)((bf16_t*)(ws + WS_WC2) + i * 8) = o; }
    }
    {
        const float* W = a.in[I_WIN]; bf16_t* O = (bf16_t*)(ws + WS_WIN);
        for (size_t i = gtid; i < (size_t)1024 * (NWIN / 8); i += gn) {
            const int k = (int)(i / (NWIN / 8)), j = (int)(i % (NWIN / 8)) * 8;
            uint4 o = {0u, 0u, 0u, 0u};
            if (j < 2848) {
                const int sj = (j < 1280) ? j : (j < 2816) ? j + 24 : (j < 2840) ? j - 1536 : j;
                const float4 x = *(const float4*)(W + (size_t)k * 2848 + sj), y = *(const float4*)(W + (size_t)k * 2848 + sj + 4);
                o.x = cvtpk(x.x, x.y); o.y = cvtpk(x.z, x.w); o.z = cvtpk(y.x, y.y); o.w = cvtpk(y.z, y.w);
            }
            *(uint4*)(O + (size_t)k * NWIN + j) = o;
        }
    }
    const int lane = TID() & 63; const int gw = BID() * NWAVE + (TID() >> 6), ngw = gridDim.x * NWAVE;
    {
        const float* X = a.in[I_X]; const float* g = a.in[I_LN1]; bf16_t* XN = (bf16_t*)(ws + WS_XN);
        for (int m = gw; m < NTOK; m += ngw) {
            float4 v[4]; float s = 0.f;
#pragma unroll
            for (int j = 0; j < 4; ++j) { v[j] = *(const float4*)(X + (size_t)m * 1024 + j * 256 + lane * 4); s += v[j].x * v[j].x + v[j].y * v[j].y + v[j].z * v[j].z + v[j].w * v[j].w; }
            const float rstd = rsqrtf(wave_sum(s) * (1.f / 1024.f) + EPS);
#pragma unroll
            for (int j = 0; j < 4; ++j) { const float4 gg = *(const float4*)(g + j * 256 + lane * 4);
                uint2 o; o.x = cvtpk(v[j].x * rstd * gg.x, v[j].y * rstd * gg.y); o.y = cvtpk(v[j].z * rstd * gg.z, v[j].w * rstd * gg.w);
                *(uint2*)(XN + (size_t)m * 1024 + j * 256 + lane * 4) = o; }
        }
    }
    if (gw < 256) {
        const int which = gw >> 7, n = gw & 127; const float* pe = a.in[which ? I_PEV : I_PEK]; const float* w1 = a.in[which ? I_WC1V : I_WC1K];
        float s = 0.f;
#pragma unroll 8
        for (int i = 0; i < 32; ++i) { const int k = lane + 64 * i; s += pe[k] * w1[(size_t)k * 128 + n]; }
        s = wave_sum(s);
        if (lane == 0) ((float*)(ws + WS_BIAS1))[which * 128 + n] = s;
    }
}

DEV void phase_inproj(const Args& a, unsigned char* smem) {
    const bf16_t* XN = (const bf16_t*)(a.ws + WS_XN); const bf16_t* W = (const bf16_t*)(a.ws + WS_WIN);
    bf16_t* PROJ = (bf16_t*)(a.ws + WS_PROJ); float* GN = (float*)(a.ws + WS_GN); float* LS = (float*)(a.ws + WS_LS); const float* bfg = a.in[I_BFG];
    int lane = TID() & 63, wid = TID() >> 6, wr = wid >> 2, wc = wid & 3; (void)wr; (void)wc; (void)lane;
    bool pre = false;
    for (int item = VBID(); item < 64 * 12; item += gridDim.x) {
        int mt, nt; patch_decode(item, 64, 12, mt, nt);
        const int nitem = item + (int)gridDim.x; const bool has_next = nitem < 64 * 12; int mtn = 0, ntn = 0; if (has_next) patch_decode(nitem, 64, 12, mtn, ntn);
        f32x4 acc[8][4];
        auto aoffi = [](int r, int kc) { return (unsigned)(r * 2048 + kc * 16); }; auto boffi = [](int k, int nc) { return (unsigned)(k * (NWIN * 2) + nc * 16); };
        gemm256<true>(smem, 16, XN + (size_t)mt * 256 * 1024, 128u, aoffi, W + nt * 256, (unsigned)(64 * NWIN * 2), boffi, acc, pre,
                      next_tile(has_next, smem, XN + (size_t)mtn * 256 * 1024, aoffi, W + ntn * 256, boffi));
        pre = has_next;
        EPI_IDS();
#pragma unroll
        for (int mi = 0; mi < 8; ++mi) {
            const int gm = mt * 256 + G_ROW(mi); const int b = gm >> 13, t = gm & 8191;
#pragma unroll
            for (int ni = 0; ni < 4; ++ni) {
                const int n = G_COL(ni); const f32x4 v = acc[mi][ni];
                if (nt < 11) {
                    const int hs = nt * 4 + (n >> 6), d = n & 63; const float sc = (hs < 8 || (hs >= 20 && hs < 28)) ? QS : 1.0f;
                    uint2 o; o.x = cvtpk(v[0] * sc, v[1] * sc); o.y = cvtpk(v[2] * sc, v[3] * sc);
                    *(uint2*)(PROJ + (((size_t)(hs * 2 + b)) * 8192 + t) * 64 + d) = o;
                } else if (n < 24) {
#pragma unroll
                    for (int r = 0; r < 4; ++r) GN[(size_t)gm * 24 + n + r] = sigmoidf_(v[r]);
                } else if (n < 32) {
#pragma unroll
                    for (int r = 0; r < 4; ++r) { const int h = n - 24 + r; LS[((size_t)(b * 8 + h)) * 8192 + t] = logsigmoidf_(v[r] + bfg[h]); }
                }
            }
        }
    }
}

DEV void signal_done(unsigned* flag) {
    asm volatile("s_waitcnt vmcnt(0)" ::: "memory");
    __syncthreads();
    if (TID() == 0) { __builtin_amdgcn_fence(__ATOMIC_RELEASE, "agent"); asm volatile("s_waitcnt vmcnt(0)" ::: "memory"); __hip_atomic_fetch_add(flag, 1u, __ATOMIC_RELAXED, __HIP_MEMORY_SCOPE_AGENT); }
}
DEV void wait_flag(unsigned* flag, unsigned target) {
    if (TID() == 0) { unsigned sp = 0u; while (__hip_atomic_load(flag, __ATOMIC_RELAXED, __HIP_MEMORY_SCOPE_AGENT) < target) { __builtin_amdgcn_s_sleep(4); if (++sp > (1u << 24)) break; }
        __builtin_amdgcn_fence(__ATOMIC_ACQUIRE, "agent"); asm volatile("s_waitcnt vmcnt(0)" ::: "memory"); }
    __syncthreads();
}
constexpr int CW_CUMFLAG = 128, CW_CMPFLAG = 192, CW_GATEFLAG = 256;
DEV void cmp_item(const Args& a, unsigned char* smem, int item) {
    const bf16_t* PROJ = (const bf16_t*)(a.ws + WS_PROJ);
    const int tid = TID(); int lane = tid & 63, wid = tid >> 6, wr = wid >> 2, wc = wid & 3; (void)wr; (void)wc; (void)lane;
    {
        if (item < 16) {
            const int which = item >> 3, b = (item >> 2) & 1, g = (item >> 1) & 1, mt = item & 1;
            const bf16_t* base = PROJ + ((size_t)((8 + 2 * which + g) * 2 + b)) * 8192 * 64;
            const bf16_t* W1 = (const bf16_t*)(a.ws + WS_WC1) + (size_t)which * 2048 * 256;
            const bf16_t* W2 = (const bf16_t*)(a.ws + WS_WC2) + (size_t)which * 128 * 256;
            const float* bias1 = (const float*)(a.ws + WS_BIAS1) + which * 128;
            bf16_t* HID = (bf16_t*)(a.ws + WS_HID) + ((size_t)(which * 4 + b * 2 + g)) * 512 * 128;
            bf16_t* OUT = (bf16_t*)(a.ws + WS_KC) + ((size_t)(which * 4 + b * 2 + g)) * 512 * 64;
            f32x4 acc[8][4];
            gemm256s<true>(smem, 32, base, 128u, [&](int r, int kc) { int c = mt * 256 + r; c = c > 510 ? 510 : c; return (unsigned)(c * 2048 + kc * 16); },
                          W1, 64u * 512u, [&](int k, int nc) { return (unsigned)(k * 512 + nc * 16); }, acc);
        EPI_IDS();
            if (wc < 2) {
#pragma unroll
                for (int mi = 0; mi < 8; ++mi) { const int c = mt * 256 + wr * 128 + mi * 16 + (lane & 15);
#pragma unroll
                    for (int ni = 0; ni < 4; ++ni) { const int n = wc * 64 + ni * 16 + 4 * (lane >> 4); const f32x4 v = acc[mi][ni]; const float4 bb = *(const float4*)(bias1 + n);
                        uint2 o; o.x = cvtpk(gelu_tanh(v[0] + bb.x), gelu_tanh(v[1] + bb.y)); o.y = cvtpk(gelu_tanh(v[2] + bb.z), gelu_tanh(v[3] + bb.w));
                        *(uint2*)(HID + (size_t)c * 128 + n) = o; } }
            }
            __syncthreads();
            gemm256s<true>(smem, 2, HID + (size_t)mt * 256 * 128, 128u, [&](int r, int kc) { return (unsigned)(r * 256 + kc * 16); },
                          W2, 64u * 512u, [&](int k, int nc) { return (unsigned)(k * 512 + nc * 16); }, acc);
        EPI_IDS();
            if (wc == 0) {
#pragma unroll
                for (int mi = 0; mi < 8; ++mi) { const int c = mt * 256 + wr * 128 + mi * 16 + (lane & 15);
#pragma unroll
                    for (int ni = 0; ni < 4; ++ni) { const int n = ni * 16 + 4 * (lane >> 4); const f32x4 v = acc[mi][ni];
                        uint2 o; o.x = cvtpk(v[0], v[1]); o.y = cvtpk(v[2], v[3]);
                        if (c >= 511) { o.x = 0u; o.y = 0u; }
                        *(uint2*)(OUT + (size_t)c * 64 + n) = o; } }
            }
            signal_done((unsigned*)(a.ws + WS_CTL) + CW_CMPFLAG);
        } else {
            const int bh = item - 16; const float* LS = (const float*)(a.ws + WS_LS) + (size_t)bh * 8192; float* CUM = (float*)(a.ws + WS_CUM) + (size_t)bh * 8192;
            float* sc = (float*)smem;
            float v[16]; float s = 0.f;
#pragma unroll
            for (int j = 0; j < 4; ++j) { const float4 x = *(const float4*)(LS + tid * 16 + j * 4); v[4 * j] = x.x; v[4 * j + 1] = x.y; v[4 * j + 2] = x.z; v[4 * j + 3] = x.w; }
#pragma unroll
            for (int j = 0; j < 16; ++j) { s += v[j]; v[j] = s; }
            sc[tid] = s; __syncthreads();
            if (tid == 0) { float run = 0.f; for (int i = 0; i < NTHR; ++i) { const float x = sc[i]; sc[i] = run; run += x; } }
            __syncthreads();
            const float off = sc[tid];
#pragma unroll
            for (int j = 0; j < 4; ++j) { float4 o = {v[4 * j] + off, v[4 * j + 1] + off, v[4 * j + 2] + off, v[4 * j + 3] + off}; *(float4*)(CUM + tid * 16 + j * 4) = o; }
            signal_done((unsigned*)(a.ws + WS_CTL) + CW_CUMFLAG + bh);
        }
    }
}

constexpr int AT_STAGE = 16384;
constexpr int AT_BIAS_OFF = 3 * AT_STAGE;
constexpr int AT_IMP_OFF = AT_BIAS_OFF + 1024;
constexpr int AT_SEL_OFF = AT_IMP_OFF + 65536;
constexpr int AT_WUN_OFF = AT_SEL_OFF + 1024;
constexpr int AT_UCNT_OFF = AT_WUN_OFF + 128;
constexpr int AT_ULIST_OFF = AT_UCNT_OFF + 16;
constexpr int AT_ITEM_OFF = AT_ULIST_OFF + 128;
static_assert(AT_ITEM_OFF + 16 <= GEMM_LDS, "attention LDS map");
#define NEG_INF (-__builtin_inff())

#define KV_DECL uint4 rk0_, rv0_
#define KV_GLOAD(Kt, Vt) do { rk0_ = *(const uint4*)((Kt) + tid * 8); rv0_ = *(const uint4*)((Vt) + tid * 8); } while (0)
#define KV_LSTORE(stp) do { unsigned char* st_ = (stp); const int key = tid >> 3, ch = tid & 7; \
      *(uint4*)(st_ + key * 128 + ((ch ^ (key & 7)) << 4)) = rk0_; \
      *(uint4*)(st_ + 8192 + key * 128 + ((((ch >> 2) ^ ((key >> 1) & 1))) << 6) + ((ch & 3) << 4)) = rv0_; } while (0)
template <bool FULL>
DEV void qk_tile(const unsigned char* Kst, const bf16x8 (&qf)[4], f32x16& p0, f32x16& p1, int lane) {
    const int key = lane & 31, hi = lane >> 5;
    if (FULL) {
        bf16x8 k0[4], k1[4];
#pragma unroll
        for (int ks = 0; ks < 4; ++ks) { const int ch = 2 * ks + hi; const int off = key * 128 + ((ch ^ (key & 7)) << 4);
            k0[ks] = *(const bf16x8*)(Kst + off); k1[ks] = *(const bf16x8*)(Kst + off + 32 * 128); }
        __builtin_amdgcn_sched_barrier(0);
#pragma unroll
        for (int ks = 0; ks < 4; ++ks) {
            p0 = __builtin_amdgcn_mfma_f32_32x32x16_bf16(k0[ks], qf[ks], p0, 0, 0, 0);
            p1 = __builtin_amdgcn_mfma_f32_32x32x16_bf16(k1[ks], qf[ks], p1, 0, 0, 0); }
    } else {
        bf16x8 kk[4];
#pragma unroll
        for (int ks = 0; ks < 4; ++ks) { const int ch = 2 * ks + hi; kk[ks] = *(const bf16x8*)(Kst + key * 128 + ((ch ^ (key & 7)) << 4)); }
        __builtin_amdgcn_sched_barrier(0);
#pragma unroll
        for (int ks = 0; ks < 4; ++ks) p0 = __builtin_amdgcn_mfma_f32_32x32x16_bf16(kk[ks], qf[ks], p0, 0, 0, 0);
        __builtin_amdgcn_sched_barrier(0);
#pragma unroll
        for (int ks = 0; ks < 4; ++ks) { const int ch = 2 * ks + hi; kk[ks] = *(const bf16x8*)(Kst + key * 128 + ((ch ^ (key & 7)) << 4) + 32 * 128); }
        __builtin_amdgcn_sched_barrier(0);
#pragma unroll
        for (int ks = 0; ks < 4; ++ks) p1 = __builtin_amdgcn_mfma_f32_32x32x16_bf16(kk[ks], qf[ks], p1, 0, 0, 0);
    }
}
template <bool FULL>
DEV void pv_tile(const unsigned char* Vst, const f32x16& p0, const f32x16& p1, f32x16 (&o)[2], int lane) {
    const int hi = lane >> 5, i = lane & 15, gg = (lane >> 4) & 1;
    const int q = i >> 2; const int sw = (q >> 1) & 1;
    bf16x8 pa[4];
#pragma unroll
    for (int s = 0; s < 4; ++s) { const f32x16& p = (s < 2) ? p0 : p1; const int b = (s & 1) * 8;
        unsigned w[4];
#pragma unroll
        for (int j = 0; j < 4; ++j) w[j] = cvtpk(p[b + 2 * j], p[b + 2 * j + 1]);
        typedef unsigned u32x4_t __attribute__((ext_vector_type(4)));
        u32x4_t ww = {w[0], w[1], w[2], w[3]}; pa[s] = __builtin_bit_cast(bf16x8, ww); }
    constexpr int NB = FULL ? 1 : 2, SB = FULL ? 4 : 2;
#pragma unroll
    for (int bt = 0; bt < NB; ++bt) {
        s16x4 vlo[SB][2], vhi[SB][2];
#pragma unroll
        for (int s_ = 0; s_ < SB; ++s_)
#pragma unroll
            for (int dh = 0; dh < 2; ++dh) { const int s = bt * SB + s_; const int row0 = 16 * s + 4 * hi + q;
                const unsigned char* p = Vst + row0 * 128 + ((dh ^ sw) << 6) + gg * 32 + (i & 3) * 8;
                vlo[s_][dh] = tr_read(p); vhi[s_][dh] = tr_read(p + 8 * 128); }
        __builtin_amdgcn_sched_barrier(0);
#pragma unroll
        for (int s_ = 0; s_ < SB; ++s_)
#pragma unroll
            for (int dh = 0; dh < 2; ++dh) { const int s = bt * SB + s_;
                const bf16x8 vf = {vlo[s_][dh][0], vlo[s_][dh][1], vlo[s_][dh][2], vlo[s_][dh][3], vhi[s_][dh][0], vhi[s_][dh][1], vhi[s_][dh][2], vhi[s_][dh][3]};
                o[dh] = __builtin_amdgcn_mfma_f32_32x32x16_bf16(vf, pa[s], o[dh], 0, 0, 0); }
        __builtin_amdgcn_sched_barrier(0);
    }
}
DEV float rowmax32(const f32x16& p0, const f32x16& p1) {
    float a = fmaxf(p0[0], p1[0]), b = fmaxf(p0[1], p1[1]);
#pragma unroll
    for (int r = 2; r < 16; r += 2) { a = fmaxf(fmaxf(a, p0[r]), p1[r]); b = fmaxf(fmaxf(b, p0[r + 1]), p1[r + 1]); }
    return pair_max(fmaxf(a, b));
}
DEV void softmax_step(f32x16& p0, f32x16& p1, float& m, float& l, f32x16 (&o)[2]) {
    const float mt = rowmax32(p0, p1); const float mn = fmaxf(m, mt); const float alpha = __builtin_amdgcn_exp2f(m - mn);
    float rs = 0.f;
#pragma unroll
    for (int r = 0; r < 16; ++r) { p0[r] = __builtin_amdgcn_exp2f(p0[r] - mn); p1[r] = __builtin_amdgcn_exp2f(p1[r] - mn); rs += p0[r] + p1[r]; }
    rs = pair_sum(rs);
    l = l * alpha + rs; m = mn;
    if (__any(alpha != 1.0f)) { o[0] *= alpha; o[1] *= alpha; }
}
DEV void softmax_step_nosum(f32x16& p0, f32x16& p1, float& m, f32x16 (&o)[2], f32x16& lacc) {
    const float mt = rowmax32(p0, p1); const float mn = fmaxf(m, mt); const float alpha = __builtin_amdgcn_exp2f(m - mn);
#pragma unroll
    for (int r = 0; r < 16; ++r) { p0[r] = __builtin_amdgcn_exp2f(p0[r] - mn); p1[r] = __builtin_amdgcn_exp2f(p1[r] - mn); }
    m = mn;
    if (__any(alpha != 1.0f)) { o[0] *= alpha; o[1] *= alpha; lacc *= alpha; }
}
DEV void pv_tile_sum(const unsigned char* Vst, const f32x16& p0, const f32x16& p1, f32x16 (&o)[2], f32x16& lacc, int lane) {
    const int hi = lane >> 5, i = lane & 15, gg = (lane >> 4) & 1;
    const int q = i >> 2; const int sw = (q >> 1) & 1;
    bf16x8 pa[4];
#pragma unroll
    for (int s = 0; s < 4; ++s) { const f32x16& p = (s < 2) ? p0 : p1; const int b = (s & 1) * 8;
        unsigned w[4];
#pragma unroll
        for (int j = 0; j < 4; ++j) w[j] = cvtpk(p[b + 2 * j], p[b + 2 * j + 1]);
        typedef unsigned u32x4_t __attribute__((ext_vector_type(4)));
        u32x4_t ww = {w[0], w[1], w[2], w[3]}; pa[s] = __builtin_bit_cast(bf16x8, ww); }
    const bf16x8 ones = {0x3f80, 0x3f80, 0x3f80, 0x3f80, 0x3f80, 0x3f80, 0x3f80, 0x3f80};
#pragma unroll
    for (int bt = 0; bt < 2; ++bt) {
        s16x4 vlo[2][2], vhi[2][2];
#pragma unroll
        for (int s_ = 0; s_ < 2; ++s_)
#pragma unroll
            for (int dh = 0; dh < 2; ++dh) { const int s = bt * 2 + s_; const int row0 = 16 * s + 4 * hi + q;
                const unsigned char* p = Vst + row0 * 128 + ((dh ^ sw) << 6) + gg * 32 + (i & 3) * 8;
                vlo[s_][dh] = tr_read(p); vhi[s_][dh] = tr_read(p + 8 * 128); }
        __builtin_amdgcn_sched_barrier(0);
#pragma unroll
        for (int s_ = 0; s_ < 2; ++s_) { const int s = bt * 2 + s_;
            lacc = __builtin_amdgcn_mfma_f32_32x32x16_bf16(ones, pa[s], lacc, 0, 0, 0);
#pragma unroll
            for (int dh = 0; dh < 2; ++dh) {
                const bf16x8 vf = {vlo[s_][dh][0], vlo[s_][dh][1], vlo[s_][dh][2], vlo[s_][dh][3], vhi[s_][dh][0], vhi[s_][dh][1], vhi[s_][dh][2], vhi[s_][dh][3]};
                o[dh] = __builtin_amdgcn_mfma_f32_32x32x16_bf16(vf, pa[s], o[dh], 0, 0, 0); } }
        __builtin_amdgcn_sched_barrier(0);
    }
}
template <int STRIDE> DEV void mask_tile(f32x16& p0, f32x16& p1, int kpos0, int lo, int hi_lim, int hi) {
#pragma unroll
    for (int r = 0; r < 16; ++r) { const int kp = kpos0 + STRIDE * crow(r, hi);
        if (kp < lo || kp > hi_lim) p0[r] = NEG_INF;
        const int kp1 = kp + 32 * STRIDE; if (kp1 < lo || kp1 > hi_lim) p1[r] = NEG_INF; }
}
template <int STRIDE> DEV void alibi_init(f32x16& p0, f32x16& p1, float slope2, int kpos0, int tref, int hi) {
    const float base = slope2 * (float)(kpos0 - tref + STRIDE * 4 * hi);
#pragma unroll
    for (int r = 0; r < 16; ++r) { const float c = (float)(STRIDE * ((r & 3) + 8 * (r >> 2))); p0[r] = fmaf(slope2, c, base); p1[r] = fmaf(slope2, c + (float)(32 * STRIDE), base); }
}
template <class Src, class Body, class NSrc>
DEV int kv_pipeline(unsigned char* smem, int n, const Src& src, const Body& body, int par, bool pre, bool has_next, const NSrc& nsrc) {
    KV_DECL; const int tid = TID(); const bf16_t *kp, *vp;
    if (!pre) { src(0, kp, vp); KV_GLOAD(kp, vp); KV_LSTORE(smem + par * AT_STAGE); __syncthreads(); }
    for (int j = 0; j < n; ++j) {
        const bool more = j + 1 < n;
        src(more ? j + 1 : j, kp, vp); if (!more && has_next) nsrc(kp, vp);
        KV_GLOAD(kp, vp);
        body(j, smem + ((par + j) & 1) * AT_STAGE);
        KV_LSTORE(smem + ((par + j + 1) & 1) * AT_STAGE);
        __syncthreads();
    }
    return (par + n) & 1;
}
struct NoSrc { DEV void operator()(const bf16_t*&, const bf16_t*&) const {} };

constexpr int CV_PER_STEP = 373; constexpr int CV_NUP = 32 * 1024 * 2048 / 8, CV_NDN = 32 * 1024 * 1024 / 8;
static_assert((long long)33792 * CV_PER_STEP >= (long long)CV_NUP + CV_NDN, "conversion coverage");
DEV void fox_item(const Args& a, unsigned char* smem, int fi, int b, int h, int qb) {
    const int tid = TID(), lane = tid & 63, wid = tid >> 6, r32 = lane & 31, hi = lane >> 5;
    const bf16_t* PROJ = (const bf16_t*)(a.ws + WS_PROJ);
    const bf16_t* Q = PROJ + ((size_t)((20 + h) * 2 + b)) * 8192 * 64; const bf16_t* K = PROJ + ((size_t)((28 + h) * 2 + b)) * 8192 * 64; const bf16_t* V = PROJ + ((size_t)((36 + h) * 2 + b)) * 8192 * 64;
    const float* CUM = (const float*)(a.ws + WS_CUM) + (size_t)(b * 8 + h) * 8192;
    const int q0 = qb * 256; const int qrow = q0 + 32 * wid + r32;
    bf16x8 qf[4];
#pragma unroll
    for (int ks = 0; ks < 4; ++ks) qf[ks] = *(const bf16x8*)(Q + (size_t)qrow * 64 + 16 * ks + 8 * hi);
    const float cref = CUM[q0];
    const int ntiles = 4 * qb + 4; const int jmax_w = (q0 + 32 * wid + 31) >> 6; const int jmask_w = (q0 + 32 * wid) >> 6;
    f32x16 o[2]; o[0] = (f32x16){}; o[1] = (f32x16){}; f32x16 lacc = (f32x16){}; float m = -1e30f;
    float* biasL = (float*)(smem + AT_BIAS_OFF);
    const int gq_ = fi >> 4; const int sidx0 = 16 * (128 * gq_ - 2 * gq_ * (gq_ - 1)) + (fi & 15) * (128 - 4 * gq_);
    bf16_t* cvdA = nullptr; bf16_t* cvdB = nullptr; float4 cvaA, cvbA, cvaB, cvbB;
    KV_DECL; float breg = 0.f;
#define TJ(s_) (ntiles - 1 - (s_))
#define CV_ADDR(st_, SRC, DST) do { int c_ = (sidx0 + (st_)) * CV_PER_STEP + (tid < CV_PER_STEP ? tid : CV_PER_STEP - 1); c_ = c_ < CV_NUP + CV_NDN ? c_ : CV_NUP + CV_NDN - 1; \
        const bool up_ = c_ < CV_NUP; const int cc_ = up_ ? c_ : c_ - CV_NUP; SRC = (up_ ? a.in[I_WUP] : a.in[I_WDN]) + (size_t)cc_ * 8; DST = (bf16_t*)(a.ws + (up_ ? WS_WUP : WS_WDN)) + (size_t)cc_ * 8; } while (0)
    { const float* cvs_; CV_ADDR(0, cvs_, cvdB); cvaB = *(const float4*)cvs_; cvbB = *(const float4*)(cvs_ + 4); }
    KV_GLOAD(K + (size_t)TJ(0) * 4096, V + (size_t)TJ(0) * 4096); breg = CUM[TJ(0) * 64 + lane];
    KV_LSTORE(smem); biasL[lane] = (cref - breg) * LOG2E;
    KV_GLOAD(K + (size_t)TJ(1) * 4096, V + (size_t)TJ(1) * 4096); breg = CUM[TJ(1) * 64 + lane];
    KV_LSTORE(smem + AT_STAGE); biasL[64 + lane] = (cref - breg) * LOG2E;
    __syncthreads();
#define FOX_QK(P0, P1, jj, sj) do { const float* bl_ = biasL + (sj) * 64; \
        _Pragma("unroll") for (int g4 = 0; g4 < 4; ++g4) { const float4 x_ = *(const float4*)(bl_ + 8 * g4 + 4 * hi), y_ = *(const float4*)(bl_ + 32 + 8 * g4 + 4 * hi); \
            P0[4 * g4] = x_.x; P0[4 * g4 + 1] = x_.y; P0[4 * g4 + 2] = x_.z; P0[4 * g4 + 3] = x_.w; P1[4 * g4] = y_.x; P1[4 * g4 + 1] = y_.y; P1[4 * g4 + 2] = y_.z; P1[4 * g4 + 3] = y_.w; } \
        qk_tile<true>(smem + (sj) * AT_STAGE, qf, P0, P1, lane); \
        if ((jj) >= jmask_w) mask_tile<1>(P0, P1, 64 * (jj), -1, qrow, hi); } while (0)
#define FOX_STEP(CUR0, CUR1, NXT0, NXT1, j, CVD_LD, CVA_LD, CVB_LD, CVD_ST, CVA_ST, CVB_ST) do { \
        const int s_cur = (j) % 3, s_nxt = ((j) + 1) % 3, s_ld = ((j) + 2) % 3; const int tl_ = TJ((j) + 2) < 0 ? 0 : TJ((j) + 2);     \
        KV_GLOAD(K + (size_t)tl_ * 4096, V + (size_t)tl_ * 4096); breg = CUM[tl_ * 64 + lane]; \
        { const float* cvs_; CV_ADDR(j, cvs_, CVD_LD); CVA_LD = *(const float4*)cvs_; CVB_LD = *(const float4*)(cvs_ + 4); } \
        if ((j) + 1 < ntiles && TJ((j) + 1) <= jmax_w) FOX_QK(NXT0, NXT1, TJ((j) + 1), s_nxt); \
        __builtin_amdgcn_sched_barrier(0); \
        if (TJ(j) <= jmax_w) { softmax_step_nosum(CUR0, CUR1, m, o, lacc); pv_tile_sum(smem + s_cur * AT_STAGE + 8192, CUR0, CUR1, o, lacc, lane); } \
        KV_LSTORE(smem + s_ld * AT_STAGE); biasL[s_ld * 64 + lane] = (cref - breg) * LOG2E; \
        { uint4 o_; o_.x = cvtpk(CVA_ST.x, CVA_ST.y); o_.y = cvtpk(CVA_ST.z, CVA_ST.w); o_.z = cvtpk(CVB_ST.x, CVB_ST.y); o_.w = cvtpk(CVB_ST.z, CVB_ST.w); *(uint4*)CVD_ST = o_; } \
        __syncthreads(); } while (0)
    f32x16 pA0, pA1, pB0, pB1;
    if (TJ(0) <= jmax_w) FOX_QK(pA0, pA1, TJ(0), 0);
    for (int j = 0; j < ntiles; j += 2) {
        FOX_STEP(pA0, pA1, pB0, pB1, j, cvdA, cvaA, cvbA, cvdB, cvaB, cvbB);
        FOX_STEP(pB0, pB1, pA0, pA1, j + 1, cvdB, cvaB, cvbB, cvdA, cvaA, cvbA);
    }
    { uint4 o_; o_.x = cvtpk(cvaB.x, cvaB.y); o_.y = cvtpk(cvaB.z, cvaB.w); o_.z = cvtpk(cvbB.x, cvbB.y); o_.w = cvtpk(cvbB.z, cvbB.w); *(uint4*)cvdB = o_; }
#undef CV_ADDR
#undef FOX_QK
#undef FOX_STEP
#undef TJ
    const float inv = 1.0f / lacc[0]; float ss = 0.f;
    const size_t token = (size_t)b * 8192 + qrow;
    bf16_t* O = (bf16_t*)(a.ws + WS_OFOX) + token * 512 + h * 64;
#pragma unroll
    for (int dh = 0; dh < 2; ++dh)
#pragma unroll
        for (int g4 = 0; g4 < 4; ++g4) { const float v0 = o[dh][4 * g4] * inv, v1 = o[dh][4 * g4 + 1] * inv, v2 = o[dh][4 * g4 + 2] * inv, v3 = o[dh][4 * g4 + 3] * inv;
            ss += v0 * v0 + v1 * v1 + v2 * v2 + v3 * v3; uint2 w; w.x = cvtpk(v0, v1); w.y = cvtpk(v2, v3); *(uint2*)(O + 32 * dh + 8 * g4 + 4 * hi) = w; }
    ss = pair_sum(ss);
    if (hi == 0) ((float*)(a.ws + WS_SSQ))[token * 16 + 8 + h] = ss;
}

DEV void nsa_item(const Args& a, unsigned char* smem, int b, int g, int tt) {
    const int tid = TID(), lane = tid & 63, wid = tid >> 6, col = lane & 31, hi = lane >> 5;
    const int t0 = tt * 64, tokw = col >> 2, r = col & 3, h = 4 * g + r; const int tokl = wid * 8 + tokw; const int t = t0 + tokl; const size_t token = (size_t)b * 8192 + t;
    const float slope2 = exp2f(-(float)(h + 1)) * LOG2E;
    const bf16_t* PROJ = (const bf16_t*)(a.ws + WS_PROJ);
    const float* GN = (const float*)(a.ws + WS_GN) + token * 24 + h * 3;
    const int cur = tt; const bool need_topk = cur > 15;
    bf16x8 qf[4];
    { const bf16_t* Q = PROJ + (((size_t)(h * 2 + b)) * 8192 + t) * 64;
#pragma unroll
      for (int ks = 0; ks < 4; ++ks) qf[ks] = *(const bf16x8*)(Q + 16 * ks + 8 * hi); }
    float* impw = (float*)(smem + AT_IMP_OFF) + wid * 2048; float* totw = impw + lane;
    unsigned* selmask = (unsigned*)(smem + AT_SEL_OFF); unsigned* wun = (unsigned*)(smem + AT_WUN_OFF); int* ucnt = (int*)(smem + AT_UCNT_OFF); unsigned char* ulist = smem + AT_ULIST_OFF;
    f32x16 o[2]; float m, l; int par = 0;
    const int tmin_w = t0 + wid * 8, tmax_w = tmin_w + 7;
    {
        const bf16_t* KC = (const bf16_t*)(a.ws + WS_KC) + ((size_t)(0 * 4 + b * 2 + g)) * 512 * 64; const bf16_t* VC = (const bf16_t*)(a.ws + WS_KC) + ((size_t)(1 * 4 + b * 2 + g)) * 512 * 64;
        const int ncv = t0 / 16 + 3; const int nct = (ncv + 63) >> 6;
        auto src = [&](int j, const bf16_t*& kp, const bf16_t*& vp) { kp = KC + (size_t)j * 4096; vp = VC + (size_t)j * 4096; };
        m = -1e30f; l = 0.f;
        auto src0 = [&](const bf16_t*& kp, const bf16_t*& vp) { kp = KC; vp = VC; };
        par = kv_pipeline(smem, nct, src, [&](int j, const unsigned char* st) {
            const int kpos0 = 1024 * j + 31;
            if (kpos0 > tmax_w) return;
            f32x16 p0, p1; alibi_init<16>(p0, p1, slope2, kpos0, t0, hi);
            qk_tile<false>(st, qf, p0, p1, lane);
            if (kpos0 + 16 * 63 > tmin_w) mask_tile<16>(p0, p1, kpos0, -1, t, hi);
            const float mt = rowmax32(p0, p1); const float mn = fmaxf(m, mt); float rs = 0.f;
#pragma unroll
            for (int rr = 0; rr < 16; ++rr) rs += __builtin_amdgcn_exp2f(p0[rr] - mn) + __builtin_amdgcn_exp2f(p1[rr] - mn);
            rs = pair_sum(rs);
            l = l * __builtin_amdgcn_exp2f(m - mn) + rs; m = mn;
        }, 0, false, true, src0);
        const float linv = l > 0.f ? 1.0f / l : 0.f;
        if (need_topk) { for (int i = lane; i < 8 * 129; i += 64) impw[i] = 0.f; }
        o[0] = (f32x16){}; o[1] = (f32x16){};
        const bf16_t* KS0 = PROJ + ((size_t)((12 + g) * 2 + b)) * 8192 * 64 + (size_t)cur * 4096; const bf16_t* VS0 = PROJ + ((size_t)((14 + g) * 2 + b)) * 8192 * 64 + (size_t)cur * 4096;
        par = kv_pipeline(smem, nct, src, [&](int j, const unsigned char* st) {
            const int kpos0 = 1024 * j + 31;
            if (kpos0 > tmax_w) return;
            f32x16 p0, p1; alibi_init<16>(p0, p1, slope2, kpos0, t0, hi);
            qk_tile<false>(st, qf, p0, p1, lane);
            if (kpos0 + 16 * 63 > tmin_w) mask_tile<16>(p0, p1, kpos0, -1, t, hi);
#pragma unroll
            for (int rr = 0; rr < 16; ++rr) { p0[rr] = __builtin_amdgcn_exp2f(p0[rr] - m) * linv; p1[rr] = __builtin_amdgcn_exp2f(p1[rr] - m) * linv; }
            if (need_topk) {
#pragma unroll
                for (int half = 0; half < 2; ++half)
#pragma unroll
                    for (int g4 = 0; g4 < 4; ++g4) { const f32x16& p = half ? p1 : p0;
                        float ms = (p[4 * g4] + p[4 * g4 + 1]) + (p[4 * g4 + 2] + p[4 * g4 + 3]); float ls = p[4 * g4 + 3];
                        ms = quad_sum(ms); ls = quad_sum(ls);
                        const int n = 16 * j + 8 * half + 2 * g4 + hi;
                        if (r == 0) { atomicAdd(&impw[tokw * 129 + n], ms); atomicAdd(&impw[tokw * 129 + n + 1], ls); } }
            }
            pv_tile<false>(st + 8192, p0, p1, o, lane);
        }, par, true, true, [&](const bf16_t*& kp, const bf16_t*& vp) { kp = KS0; vp = VS0; });
    }
    {
        unsigned un0 = 0u, un1 = 0u, un2 = 0u, un3 = 0u;
        if (need_topk) {
#define TK_INIT(V0, V1, M0, M1, M2, M3, tk_) float V0 = impw[(tk_) * 129 + lane], V1 = impw[(tk_) * 129 + 64 + lane]; \
                V0 = (lane >= 1 && lane <= cur - 2) ? V0 : -1.0f; V1 = (lane + 64 <= cur - 2) ? V1 : -1.0f; unsigned M0 = 1u, M1 = 0u, M2 = 0u, M3 = 0u; \
                TK_SET(M0, M1, M2, M3, cur); TK_SET(M0, M1, M2, M3, cur - 1)
#define TK_SET(M0, M1, M2, M3, n_) do { const int n__ = (n_); const unsigned bit__ = 1u << (n__ & 31); const int w__ = n__ >> 5; M0 |= (w__ == 0) ? bit__ : 0u; M1 |= (w__ == 1) ? bit__ : 0u; M2 |= (w__ == 2) ? bit__ : 0u; M3 |= (w__ == 3) ? bit__ : 0u; } while (0)
#define TK_STEP(V0, V1, M0, M1, M2, M3) do { const float mx_ = wave_max_u(fmaxf(V0, V1)); const unsigned long long b0_ = __ballot(V0 == mx_), b1_ = __ballot(V1 == mx_); \
                const int n_ = b0_ ? (__ffsll((long long)b0_) - 1) : (63 + __ffsll((long long)b1_)); const bool hit_ = lane == (n_ & 63); \
                V0 = (hit_ && n_ < 64) ? -1.0f : V0; V1 = (hit_ && n_ >= 64) ? -1.0f : V1; TK_SET(M0, M1, M2, M3, n_); } while (0)
            for (int tk = 0; tk < 8; tk += 4) {
                TK_INIT(a0_, a1_, ma0, ma1, ma2, ma3, tk); TK_INIT(b0v, b1v, mb0, mb1, mb2, mb3, tk + 1); TK_INIT(c0v, c1v, mc0, mc1, mc2, mc3, tk + 2); TK_INIT(d0v, d1v, md0, md1, md2, md3, tk + 3);
                for (int it = 0; it < 13; ++it) { TK_STEP(a0_, a1_, ma0, ma1, ma2, ma3); TK_STEP(b0v, b1v, mb0, mb1, mb2, mb3); TK_STEP(c0v, c1v, mc0, mc1, mc2, mc3); TK_STEP(d0v, d1v, md0, md1, md2, md3); }
                if (lane == 0) { unsigned* sm_ = selmask + (wid * 8 + tk) * 4; sm_[0] = ma0; sm_[1] = ma1; sm_[2] = ma2; sm_[3] = ma3; sm_[4] = mb0; sm_[5] = mb1; sm_[6] = mb2; sm_[7] = mb3;
                    sm_[8] = mc0; sm_[9] = mc1; sm_[10] = mc2; sm_[11] = mc3; sm_[12] = md0; sm_[13] = md1; sm_[14] = md2; sm_[15] = md3; }
                un0 |= ma0 | mb0 | mc0 | md0; un1 |= ma1 | mb1 | mc1 | md1; un2 |= ma2 | mb2 | mc2 | md2; un3 |= ma3 | mb3 | mc3 | md3;
            }
#undef TK_INIT
#undef TK_SET
#undef TK_STEP
        } else {
            const unsigned full = (2u << cur) - 1u;
            un0 = full;
            if (lane < 8) { unsigned* sm_ = selmask + (wid * 8 + lane) * 4; sm_[0] = full; sm_[1] = 0u; sm_[2] = 0u; sm_[3] = 0u; }
        }
        if (lane == 0) { wun[wid * 4] = un0; wun[wid * 4 + 1] = un1; wun[wid * 4 + 2] = un2; wun[wid * 4 + 3] = un3; }
        __syncthreads();
        if (tid == 0) { int c = 0;
            for (int w = 0; w < 4; ++w) { unsigned u = 0u; for (int ww = 0; ww < NWAVE; ++ww) u |= wun[ww * 4 + w]; for (int bb = 0; bb < 32; ++bb) if ((u >> bb) & 1u) ulist[c++] = (unsigned char)(w * 32 + bb); }
            ucnt[0] = c; }
        __syncthreads();
    }
    { const float g0 = GN[0];
#pragma unroll
      for (int rr = 0; rr < 16; ++rr) { totw[rr * 64] = o[0][rr] * g0; totw[(16 + rr) * 64] = o[1][rr] * g0; } }
    {
        const bf16_t* KS = PROJ + ((size_t)((12 + g) * 2 + b)) * 8192 * 64; const bf16_t* VS = PROJ + ((size_t)((14 + g) * 2 + b)) * 8192 * 64;
        const int nu = ucnt[0];
        m = -1e30f; f32x16 lacc = (f32x16){}; o[0] = (f32x16){}; o[1] = (f32x16){};
        const bf16_t* KW0 = PROJ + ((size_t)((16 + g) * 2 + b)) * 8192 * 64 + (size_t)cur * 4096; const bf16_t* VW0 = PROJ + ((size_t)((18 + g) * 2 + b)) * 8192 * 64 + (size_t)cur * 4096;
        par = kv_pipeline(smem, nu, [&](int j, const bf16_t*& kp, const bf16_t*& vp) { const int n = ulist[nu - 1 - j]; kp = KS + (size_t)n * 4096; vp = VS + (size_t)n * 4096; },
            [&](int j, const unsigned char* st) {
                const int n = ulist[nu - 1 - j];
                if (!((wun[wid * 4 + (n >> 5)] >> (n & 31)) & 1u)) return;
                const bool sel = (selmask[tokl * 4 + (n >> 5)] >> (n & 31)) & 1u;
                f32x16 p0, p1; alibi_init<1>(p0, p1, slope2, 64 * n, t0, hi);
                qk_tile<false>(st, qf, p0, p1, lane);
                if (n == cur || !__all(sel)) mask_tile<1>(p0, p1, 64 * n, -1, sel ? t : -1, hi);
                softmax_step_nosum(p0, p1, m, o, lacc);
                pv_tile_sum(st + 8192, p0, p1, o, lacc, lane);
            }, par, true, true, [&](const bf16_t*& kp, const bf16_t*& vp) { kp = KW0; vp = VW0; });
        const float g1 = GN[1] / fmaxf(lacc[0], 1e-30f);
#pragma unroll
        for (int rr = 0; rr < 16; ++rr) { totw[rr * 64] += o[0][rr] * g1; totw[(16 + rr) * 64] += o[1][rr] * g1; }
    }
    {
        const bf16_t* KW = PROJ + ((size_t)((16 + g) * 2 + b)) * 8192 * 64; const bf16_t* VW = PROJ + ((size_t)((18 + g) * 2 + b)) * 8192 * 64;
        const int jlo = (t0 - 511) > 0 ? ((t0 - 511) >> 6) : 0; const int jhi = cur;
        m = -1e30f; f32x16 lacc = (f32x16){}; o[0] = (f32x16){}; o[1] = (f32x16){};
        (void)kv_pipeline(smem, jhi - jlo + 1, [&](int j, const bf16_t*& kp, const bf16_t*& vp) { kp = KW + (size_t)(jhi - j) * 4096; vp = VW + (size_t)(jhi - j) * 4096; },
            [&](int j, const unsigned char* st) {
                const int kpos0 = 64 * (jhi - j);
                if (kpos0 > tmax_w || kpos0 + 63 < tmin_w - 511) return;
                f32x16 p0, p1; alibi_init<1>(p0, p1, slope2, kpos0, t0, hi);
                qk_tile<false>(st, qf, p0, p1, lane);
                if (kpos0 < tmax_w - 511 || kpos0 + 63 > tmin_w) mask_tile<1>(p0, p1, kpos0, t - 511, t, hi);
                softmax_step_nosum(p0, p1, m, o, lacc);
                pv_tile_sum(st + 8192, p0, p1, o, lacc, lane);
            }, par, true, false, NoSrc());
        const float g2 = GN[2] / fmaxf(lacc[0], 1e-30f);
#pragma unroll
        for (int rr = 0; rr < 16; ++rr) { o[0][rr] = totw[rr * 64] + o[0][rr] * g2; o[1][rr] = totw[(16 + rr) * 64] + o[1][rr] * g2; }
    }
    {
        float ss = 0.f; bf16_t* O = (bf16_t*)(a.ws + WS_ONSA) + token * 512 + h * 64;
#pragma unroll
        for (int dh = 0; dh < 2; ++dh)
#pragma unroll
            for (int g4 = 0; g4 < 4; ++g4) { const float v0 = o[dh][4 * g4], v1 = o[dh][4 * g4 + 1], v2 = o[dh][4 * g4 + 2], v3 = o[dh][4 * g4 + 3];
                ss += v0 * v0 + v1 * v1 + v2 * v2 + v3 * v3; uint2 w; w.x = cvtpk(v0, v1); w.y = cvtpk(v2, v3); *(uint2*)(O + 32 * dh + 8 * g4 + 4 * hi) = w; }
        ss = pair_sum(ss);
        if (hi == 0) ((float*)(a.ws + WS_SSQ))[token * 16 + h] = ss;
    }
}
#ifndef PROBE_DUP
#define PROBE_DUP 0
#endif
DEV void phase_att(const Args& a, unsigned char* smem) {
    int* qctr = (int*)(a.ws + WS_CTL) + 64; int* sitem = (int*)(smem + AT_ITEM_OFF);
    unsigned* ctl = (unsigned*)(a.ws + WS_CTL); unsigned* seen = (unsigned*)(smem + AT_ITEM_OFF + 8);
    if (TID() == 0) seen[0] = 0u;
    for (;;) {
        if (TID() == 0) sitem[0] = atomicAdd(qctr, 1);
        __syncthreads();
        const int item = sitem[0];
        __syncthreads();
        if (item >= 32 + 1024) break;
        if (item < 16) cmp_item(a, smem, 16 + item);
        else if (item < 32) cmp_item(a, smem, item - 16);
        else if (item < 32 + 512) { const int fi = item - 32; const int qb = 31 - (fi >> 4), bh = fi & 15; if (!((seen[0] >> bh) & 1u)) { wait_flag(ctl + CW_CUMFLAG + bh, 1u); if (TID() == 0) seen[0] |= 1u << bh; } fox_item(a, smem, fi, bh >> 3, bh & 7, qb); }
        else { const int idx = item - 32 - 512; const int tt = 127 - (idx >> 2), bg = idx & 3; if (!((seen[0] >> 16) & 1u)) { wait_flag(ctl + CW_CMPFLAG, 16u); if (TID() == 0) seen[0] |= 1u << 16; } nsa_item(a, smem, bg >> 1, bg & 1, tt); }
    }
}

DEV void phase_outproj(const Args& a, unsigned char* smem) {
    const bf16_t* ONSA = (const bf16_t*)(a.ws + WS_ONSA); const bf16_t* OFOX = (const bf16_t*)(a.ws + WS_OFOX); const float* SSQ = (const float*)(a.ws + WS_SSQ);
    const bf16_t* W = (const bf16_t*)(a.ws + WS_WOUT); float* H1 = (float*)(a.ws + WS_H1); const float* X = a.in[I_X];
    float* rs = (float*)(smem + MISC_OFF);
    const int tid = TID(); int lane = tid & 63, wid = tid >> 6, wr = wid >> 2, wc = wid & 3; (void)wr; (void)wc; (void)lane;
    auto aoffo = [](int r, int kc) { return (unsigned)(r * 1024 + kc * 16); }; auto boffo = [](int k, int nc) { return (unsigned)(k * 2048 + nc * 16); };
    for (int item = VBID(); item < 64 * 4; item += gridDim.x) {
        int mt, nt; patch_decode(item, 64, 4, mt, nt);
        gemm_issue0<15>(smem, ONSA + (size_t)mt * 256 * 512, aoffo, W + nt * 256, boffo);
        if (tid < 256) { const float* s_ = SSQ + (size_t)(mt * 256 + tid) * 16; float sn = 0.f, sf = 0.f;
#pragma unroll
            for (int j = 0; j < 8; ++j) { sn += s_[j]; sf += s_[8 + j]; }
            rs[tid * 2] = rsqrtf(sn * (1.f / 512.f) + EPS); rs[tid * 2 + 1] = rsqrtf(sf * (1.f / 512.f) + EPS); }
        asm volatile("s_waitcnt vmcnt(0)" ::: "memory");
        __syncthreads();
        f32x4 acc[8][4];
#pragma unroll
        for (int mi = 0; mi < 8; ++mi) { const size_t gm = (size_t)mt * 256 + G_ROW(mi);
#pragma unroll
            for (int ni = 0; ni < 4; ++ni) { const int n = nt * 256 + G_COL(ni); const float4 x = *(const float4*)(X + gm * 1024 + n); acc[mi][ni] = (f32x4){x.x, x.y, x.z, x.w}; } }
#pragma unroll
        for (int mi = 0; mi < 8; ++mi) { const float ri = 1.0f / rs[(G_ROW(mi)) * 2];
#pragma unroll
            for (int ni = 0; ni < 4; ++ni) acc[mi][ni] *= ri; }
        gemm256<false>(smem, 8, ONSA + (size_t)mt * 256 * 512, 128u, aoffo, W + nt * 256, 64u * 2048u, boffo, acc, true,
                       next_tile(true, smem, OFOX + (size_t)mt * 256 * 512, aoffo, W + (size_t)512 * 1024 + nt * 256, boffo));
        EPI_IDS();
#pragma unroll
        for (int mi = 0; mi < 8; ++mi) { const int rl = G_ROW(mi); const float rat = rs[rl * 2] / rs[rl * 2 + 1];
#pragma unroll
            for (int ni = 0; ni < 4; ++ni) acc[mi][ni] *= rat; }
        gemm256<false>(smem, 8, OFOX + (size_t)mt * 256 * 512, 128u, aoffo, W + (size_t)512 * 1024 + nt * 256, 64u * 2048u, boffo, acc, true);
        EPI_IDS();
#pragma unroll
        for (int mi = 0; mi < 8; ++mi) { const int rl = G_ROW(mi); const size_t gm = (size_t)mt * 256 + rl; const float rf = rs[rl * 2 + 1];
#pragma unroll
            for (int ni = 0; ni < 4; ++ni) { const int n = nt * 256 + G_COL(ni); const f32x4 v = acc[mi][ni] * rf;
                float4 o = {v[0], v[1], v[2], v[3]}; *(float4*)(H1 + gm * 1024 + n) = o; } }
        __syncthreads();
    }
}

DEV void phase_route(const Args& a, unsigned char* smem) {
    const float* H1 = (const float*)(a.ws + WS_H1); bf16_t* XN = (bf16_t*)(a.ws + WS_XN); float* RSTD2 = (float*)(a.ws + WS_RSTD2);
    const float* ln2 = a.in[I_LN2]; const float* wr_ = a.in[I_WR]; const float* br = a.in[I_BR];
    int* CNT = (int*)(a.ws + WS_CTL);
    int* TOPI = (int*)(a.ws + WS_TOPI); int* TOPS = (int*)(a.ws + WS_TOPS); float* TOPW = (float*)(a.ws + WS_TOPW);
    int* TOKOF = (int*)(a.ws + WS_TOKOF); float* ROWW = (float*)(a.ws + WS_ROWW); float* RSDS = (float*)(a.ws + WS_RSDS);
    float* part = (float*)smem;
    float* ssqp = part + 8 * 32 * 33;
    int* lcnt = (int*)(ssqp + 256); int* lbase = lcnt + 32; int* te = lbase + 32; int* trk = te + 256; float* tw = (float*)(trk + 256); float* trs = tw + 256;
    const int tid = TID(), lane = tid & 63, wid = tid >> 6, i32 = lane & 31, kh = lane >> 5; const int tg = wid >> 2, kq = wid & 3;
    for (int item = BID(); item < 256; item += gridDim.x) {
        const int tok = item * 64 + tg * 32 + i32;
        if (tid < 32) lcnt[tid] = 0;
        f32x16 acc = (f32x16){}; float ss = 0.f;
        const float* hrow = H1 + (size_t)tok * 1024 + 256 * kq + 4 * kh; const float* lrow = ln2 + 256 * kq + 4 * kh; bf16_t* xrow = XN + (size_t)tok * 1024 + 256 * kq + 4 * kh;
        const float* wbase = wr_ + (size_t)(256 * kq + 4 * kh) * 32 + i32;
#pragma unroll 4
        for (int c = 0; c < 32; ++c) {
            const float4 hv = *(const float4*)(hrow + 8 * c); const float4 lv = *(const float4*)(lrow + 8 * c);
            ss += hv.x * hv.x + hv.y * hv.y + hv.z * hv.z + hv.w * hv.w;
            const float x0 = hv.x * lv.x, x1 = hv.y * lv.y, x2 = hv.z * lv.z, x3 = hv.w * lv.w;
            uint2 o; o.x = cvtpk(x0, x1); o.y = cvtpk(x2, x3); *(uint2*)(xrow + 8 * c) = o;
            const float* wp = wbase + (size_t)(8 * c) * 32;
            const float w0 = wp[0], w1 = wp[32], w2 = wp[64], w3 = wp[96];
            acc = __builtin_amdgcn_mfma_f32_32x32x2f32(x0, w0, acc, 0, 0, 0);
            acc = __builtin_amdgcn_mfma_f32_32x32x2f32(x1, w1, acc, 0, 0, 0);
            acc = __builtin_amdgcn_mfma_f32_32x32x2f32(x2, w2, acc, 0, 0, 0);
            acc = __builtin_amdgcn_mfma_f32_32x32x2f32(x3, w3, acc, 0, 0, 0);
        }
        ss = pair_sum(ss);
        if (kh == 0) ssqp[wid * 32 + i32] = ss;
#pragma unroll
        for (int r = 0; r < 16; ++r) part[(wid * 32 + crow(r, kh)) * 33 + i32] = acc[r];
        __syncthreads();
        if (tid < 64) {
            const int g_ = tid >> 5, i_ = tid & 31; const int w0_ = g_ * 4;
            const float sq = ssqp[(w0_ + 0) * 32 + i_] + ssqp[(w0_ + 1) * 32 + i_] + ssqp[(w0_ + 2) * 32 + i_] + ssqp[(w0_ + 3) * 32 + i_]; const float rstd = rsqrtf(sq * (1.f / 1024.f) + EPS);
            RSTD2[item * 64 + tid] = rstd; trs[tid] = rstd;
            float lg[32];
#pragma unroll
            for (int e = 0; e < 32; ++e) lg[e] = (part[((w0_ + 0) * 32 + i_) * 33 + e] + part[((w0_ + 1) * 32 + i_) * 33 + e] + part[((w0_ + 2) * 32 + i_) * 33 + e] + part[((w0_ + 3) * 32 + i_) * 33 + e]) * rstd + br[e];
            unsigned taken = 0u; float tv[4]; int ti[4];
#pragma unroll
            for (int k = 0; k < 4; ++k) { float best = -3.0e38f; int bi = 0;
#pragma unroll
                for (int e = 0; e < 32; ++e) { const bool ok = !((taken >> e) & 1u) && lg[e] > best; best = ok ? lg[e] : best; bi = ok ? e : bi; }
                taken |= 1u << bi; tv[k] = best; ti[k] = bi; }
            const float e1 = __expf(tv[1] - tv[0]), e2 = __expf(tv[2] - tv[0]), e3 = __expf(tv[3] - tv[0]); const float inv = 1.0f / (1.0f + e1 + e2 + e3);
            const float wv[4] = {inv, e1 * inv, e2 * inv, e3 * inv};
#pragma unroll
            for (int k = 0; k < 4; ++k) { const int idx = tid * 4 + k; te[idx] = ti[k]; trk[idx] = atomicAdd(&lcnt[ti[k]], 1); tw[idx] = wv[k]; }
        }
        __syncthreads();
        if (tid < 32) lbase[tid] = atomicAdd(&CNT[tid], lcnt[tid]);
        __syncthreads();
        if (tid < 256) { const int idx = tid; const int tk = item * 64 + (idx >> 2); const int e = te[idx]; const int slot = lbase[e] + trk[idx];
          TOPI[(size_t)tk * 4 + (idx & 3)] = e; TOPS[(size_t)tk * 4 + (idx & 3)] = slot; TOPW[(size_t)tk * 4 + (idx & 3)] = tw[idx];
          TOKOF[(size_t)e * 16384 + slot] = tk; ROWW[(size_t)e * 16384 + slot] = tw[idx]; RSDS[(size_t)e * 16384 + slot] = trs[idx >> 2]; }
        __syncthreads();
    }
}

struct MoeMap { int e, mt, nt, cnt, off; };
DEV void moe_setup(const Args& a, int* sm) {
    if (TID() == 0) { const int* CNT = (const int*)(a.ws + WS_CTL); int tot = 0; for (int e = 0; e < 32; ++e) { const int c = CNT[e]; const int mt = (c + 255) >> 8; sm[e] = mt; sm[32 + e] = tot; tot += mt; } sm[64] = tot; }
    __syncthreads();
}
DEV MoeMap moe_map(const Args& a, const int* sm, int item, int NT) {
    MoeMap mm; int e = 0;
#pragma unroll 1
    for (int i = 1; i < 32; ++i) if (item >= sm[32 + i] * NT) e = i;
    const int local = item - sm[32 + e] * NT; const int mte = sm[e];
    int mt_, nt_; patch_decode(local, mte, NT, mt_, nt_);
    mm.e = __builtin_amdgcn_readfirstlane(e); mm.mt = __builtin_amdgcn_readfirstlane(mt_); mm.nt = __builtin_amdgcn_readfirstlane(nt_);
    mm.cnt = __builtin_amdgcn_readfirstlane(((const int*)(a.ws + WS_CTL))[e]); mm.off = __builtin_amdgcn_readfirstlane(sm[32 + e] * 256); return mm;
}
DEV int moe_maps_build(const Args& a, const int* sm, int* maps, int nitems, int NT) {
    const int tid = TID(); const int first = VBID(); const int nmine = first < nitems ? (nitems - first + (int)gridDim.x - 1) / (int)gridDim.x : 0;
    for (int k = tid; k < nmine && k < 64; k += NTHR) { const int item = first + k * (int)gridDim.x; int e = 0;
#pragma unroll 1
        for (int i = 1; i < 32; ++i) if (item >= sm[32 + i] * NT) e = i;
        const int local = item - sm[32 + e] * NT; int mt_, nt_; patch_decode(local, sm[e], NT, mt_, nt_);
        maps[k * 8] = e; maps[k * 8 + 1] = mt_; maps[k * 8 + 2] = nt_; maps[k * 8 + 3] = ((const int*)(a.ws + WS_CTL))[e]; maps[k * 8 + 4] = sm[32 + e] * 256; }
    __syncthreads();
    return nmine < 64 ? nmine : 64;
}
DEV MoeMap moe_get(const int* maps, int k) { MoeMap mm; mm.e = __builtin_amdgcn_readfirstlane(maps[k * 8]); mm.mt = __builtin_amdgcn_readfirstlane(maps[k * 8 + 1]); mm.nt = __builtin_amdgcn_readfirstlane(maps[k * 8 + 2]);
    mm.cnt = __builtin_amdgcn_readfirstlane(maps[k * 8 + 3]); mm.off = __builtin_amdgcn_readfirstlane(maps[k * 8 + 4]); return mm; }
DEV void phase_up(const Args& a, unsigned char* smem) {
    int* sm = (int*)(smem + MISC_OFF); int* maps = (int*)(smem + MISC_OFF + 8192); int* tokb = maps + 512; float* rsdb = (float*)(tokb + 768); float* biab = rsdb + 768;
    static_assert(8192 + (512 + 3 * 768) * 4 <= 8192 + 12288, "misc LDS");
    const bf16_t* XN = (const bf16_t*)(a.ws + WS_XN); const bf16_t* W = (const bf16_t*)(a.ws + WS_WUP); bf16_t* ACT = (bf16_t*)(a.ws + WS_ACT); const float* RSDS = (const float*)(a.ws + WS_RSDS);
    const int* TOKOF = (const int*)(a.ws + WS_TOKOF); const float* bup = a.in[I_BUP];
    const int tid = TID(); int lane = tid & 63, wid = tid >> 6, wr = wid >> 2, wc = wid & 3; (void)wr; (void)wc; (void)lane;
    moe_setup(a, sm);
    const int nitems = __builtin_amdgcn_readfirstlane(sm[64]) * 8;
    const int nmine = __builtin_amdgcn_readfirstlane(moe_maps_build(a, sm, maps, nitems, 8));
    int tkr = 0; float rsr = 0.f, bir = 0.f;
    const int t8 = tid & 255;
    auto side_load = [&](const MoeMap& m_) { const int slot = m_.mt * 256 + t8; const bool ok = slot < m_.cnt; const size_t sl_ = (size_t)m_.e * 16384 + (ok ? slot : 0); const int tk_ = TOKOF[sl_]; const float rs_ = RSDS[sl_]; tkr = ok ? tk_ : 0; rsr = ok ? rs_ : 0.f;
        bir = bup[(size_t)m_.e * 2048 + (t8 < 128 ? m_.nt * 128 + t8 : 1024 + m_.nt * 128 + t8 - 128)]; };
    auto side_store = [&](int slot3) { tokb[slot3 * 256 + t8] = tkr; rsdb[slot3 * 256 + t8] = rsr; biab[slot3 * 256 + t8] = bir; };
    auto boffu = [](int k, int nc) { const int sc = ((nc >> 4) ? 1024 : 0) + (nc & 15) * 8; return (unsigned)(k * 4096 + sc * 2); };
    MoeMap mm{}, mn{};
    if (nmine > 0) { mm = moe_get(maps, 0); side_load(mm); side_store(0); }
    if (nmine > 1) { mn = moe_get(maps, 1); side_load(mn); side_store(1); }
    __syncthreads();
    bool pre = false;
    for (int k = 0; k < nmine; ++k) {
        const bool has_next = k + 1 < nmine, has_nn = k + 2 < nmine;
        { const MoeMap m2 = moe_get(maps, has_nn ? k + 2 : nmine - 1); side_load(m2); }
        const int s0 = k % 3, s1 = (k + 1) % 3, s2 = (k + 2) % 3;
        const int* tok = tokb + s0 * 256; const int* tokn = tokb + s1 * 256; const float* rsd = rsdb + s0 * 256; const float* bia = biab + s0 * 256;
        const bf16_t* We = W + (size_t)mm.e * 1024 * 2048; const bf16_t* Wn = W + (size_t)mn.e * 1024 * 2048;
        f32x4 acc[8][4];
        gemm256<true>(smem, 16, XN, 128u, [&](int r, int kc) { return (unsigned)(tok[r] * 2048 + kc * 16); }, We + mm.nt * 128, 64u * 4096u, boffu, acc, pre,
                      next_tile(has_next, smem, XN, [&](int r, int kc) { return (unsigned)(tokn[r] * 2048 + kc * 16); }, Wn + mn.nt * 128, boffu));
        side_store(s2);
        EPI_IDS();
        float bgv[2][4], blv[2][4];
#pragma unroll
        for (int ni = 0; ni < 2; ++ni) { const int jl = wc * 32 + ni * 16 + 4 * (lane >> 4); const float4 bg = *(const float4*)(bia + jl), bl_ = *(const float4*)(bia + 128 + jl);
            bgv[ni][0] = bg.x; bgv[ni][1] = bg.y; bgv[ni][2] = bg.z; bgv[ni][3] = bg.w; blv[ni][0] = bl_.x; blv[ni][1] = bl_.y; blv[ni][2] = bl_.z; blv[ni][3] = bl_.w; }
#pragma unroll
        for (int mi = 0; mi < 8; ++mi) { const int rl_ = G_ROW(mi); const size_t row = (size_t)mm.off + mm.mt * 256 + rl_; const float rs_ = rsd[rl_];
#pragma unroll
            for (int ni = 0; ni < 2; ++ni) { const int jc = mm.nt * 128 + wc * 32 + ni * 16 + 4 * (lane >> 4);
                const f32x4 gv = acc[mi][ni], lv = acc[mi][ni + 2]; float r4[4];
#pragma unroll
                for (int r = 0; r < 4; ++r) { const float gg = fminf(gv[r] * rs_ + bgv[ni][r], 7.0f); const float ll = fminf(fmaxf(lv[r] * rs_ + blv[ni][r], -7.0f), 7.0f); r4[r] = gg * sigmoidf_(1.702f * gg) * (ll + 1.0f); }
                uint2 o; o.x = cvtpk(r4[0], r4[1]); o.y = cvtpk(r4[2], r4[3]); *(uint2*)(ACT + row * 1024 + jc) = o; } }
        lds_barrier();
        mm = mn; if (has_nn) mn = moe_get(maps, k + 2); pre = has_next;
    }
}
DEV void phase_down(const Args& a, unsigned char* smem) {
    int* sm = (int*)(smem + MISC_OFF); int* maps = (int*)(smem + MISC_OFF + 8192); float* rwb = (float*)(maps + 512); float* biab = rwb + 768;
    const bf16_t* ACT = (const bf16_t*)(a.ws + WS_ACT); const bf16_t* W = (const bf16_t*)(a.ws + WS_WDN); bf16_t* Y = (bf16_t*)(a.ws + WS_Y);
    const float* ROWW = (const float*)(a.ws + WS_ROWW); const float* bdn = a.in[I_BDN];
    const int tid = TID(); int lane = tid & 63, wid = tid >> 6, wr = wid >> 2, wc = wid & 3; (void)wr; (void)wc; (void)lane;
    moe_setup(a, sm);
    const int nitems = __builtin_amdgcn_readfirstlane(sm[64]) * 4;
    const int nmine = __builtin_amdgcn_readfirstlane(moe_maps_build(a, sm, maps, nitems, 4));
    float rwr = 0.f, bir = 0.f;
    const int t8 = tid & 255;
    auto side_load = [&](const MoeMap& m_) { const int slot = m_.mt * 256 + t8; const bool ok = slot < m_.cnt; const float rw_ = ROWW[(size_t)m_.e * 16384 + (ok ? slot : 0)]; rwr = ok ? rw_ : 0.f; bir = bdn[(size_t)m_.e * 1024 + m_.nt * 256 + t8]; };
    auto side_store = [&](int slot3) { rwb[slot3 * 256 + t8] = rwr; biab[slot3 * 256 + t8] = bir; };
    auto aoffd = [](int r, int kc) { return (unsigned)(r * 2048 + kc * 16); }; auto boffd = [](int k, int nc) { return (unsigned)(k * 2048 + nc * 16); };
    MoeMap mm{}, mn{};
    if (nmine > 0) { mm = moe_get(maps, 0); side_load(mm); side_store(0); }
    if (nmine > 1) { mn = moe_get(maps, 1); side_load(mn); side_store(1); }
    __syncthreads();
    bool pre = false;
    for (int k = 0; k < nmine; ++k) {
        const bool has_next = k + 1 < nmine, has_nn = k + 2 < nmine;
        { const MoeMap m2 = moe_get(maps, has_nn ? k + 2 : nmine - 1); side_load(m2); }
        const int s0 = k % 3, s2 = (k + 2) % 3;
        const float* rw = rwb + s0 * 256; const float* bia = biab + s0 * 256;
        const bf16_t* We = W + (size_t)mm.e * 1024 * 1024; const bf16_t* Ab = ACT + ((size_t)mm.off + mm.mt * 256) * 1024;
        const bf16_t* Wn = W + (size_t)mn.e * 1024 * 1024; const bf16_t* An = ACT + ((size_t)mn.off + mn.mt * 256) * 1024;
        f32x4 acc[8][4];
        gemm256<true>(smem, 16, Ab, 128u, aoffd, We + mm.nt * 256, 64u * 2048u, boffd, acc, pre,
                      next_tile(has_next, smem, An, aoffd, Wn + mn.nt * 256, boffd));
        side_store(s2);
        EPI_IDS();
        float4 bb[4];
#pragma unroll
        for (int ni = 0; ni < 4; ++ni) bb[ni] = *(const float4*)(bia + G_COL(ni));
#pragma unroll
        for (int mi = 0; mi < 8; ++mi) { const int rl = G_ROW(mi); const size_t row = (size_t)mm.off + mm.mt * 256 + rl; const float w = rw[rl];
#pragma unroll
            for (int ni = 0; ni < 4; ++ni) { const int n = mm.nt * 256 + G_COL(ni); const f32x4 v = acc[mi][ni];
                uint2 o; o.x = cvtpk((v[0] + bb[ni].x) * w, (v[1] + bb[ni].y) * w); o.y = cvtpk((v[2] + bb[ni].z) * w, (v[3] + bb[ni].w) * w); *(uint2*)(Y + row * 1024 + n) = o; } }
        lds_barrier();
        mm = mn; if (has_nn) mn = moe_get(maps, k + 2); pre = has_next;
    }
}

DEV void phase_comb(const Args& a, unsigned char* smem) {
    int* sm = (int*)(smem + MISC_OFF);
    moe_setup(a, sm);
    float* H1 = (float*)(a.ws + WS_H1); bf16_t* XN = (bf16_t*)(a.ws + WS_XN); const bf16_t* Y = (const bf16_t*)(a.ws + WS_Y);
    const int* TOPI = (const int*)(a.ws + WS_TOPI); const int* TOPS = (const int*)(a.ws + WS_TOPS); const float* g = a.in[I_LNPLE];
    const int lane = TID() & 63; const int gw = BID() * NWAVE + (TID() >> 6), ngw = gridDim.x * NWAVE;
    for (int tok = gw; tok < NTOK; tok += ngw) {
        float4 v[4];
#pragma unroll
        for (int j = 0; j < 4; ++j) v[j] = *(const float4*)(H1 + (size_t)tok * 1024 + j * 256 + lane * 4);
#pragma unroll
        for (int k = 0; k < 4; ++k) { const int e = TOPI[(size_t)tok * 4 + k]; const size_t row = (size_t)sm[32 + e] * 256 + TOPS[(size_t)tok * 4 + k];
#pragma unroll
            for (int j = 0; j < 4; ++j) { const uint2 u = *(const uint2*)(Y + row * 1024 + j * 256 + lane * 4); v[j].x += bflo(u.x); v[j].y += bfhi(u.x); v[j].z += bflo(u.y); v[j].w += bfhi(u.y); } }
        float s = 0.f;
#pragma unroll
        for (int j = 0; j < 4; ++j) { *(float4*)(H1 + (size_t)tok * 1024 + j * 256 + lane * 4) = v[j]; s += v[j].x * v[j].x + v[j].y * v[j].y + v[j].z * v[j].z + v[j].w * v[j].w; }
        const float rstd = rsqrtf(wave_sum(s) * (1.f / 1024.f) + EPS);
#pragma unroll
        for (int j = 0; j < 4; ++j) { const float4 gg = *(const float4*)(g + j * 256 + lane * 4);
            uint2 o; o.x = cvtpk(v[j].x * rstd * gg.x, v[j].y * rstd * gg.y); o.y = cvtpk(v[j].z * rstd * gg.z, v[j].w * rstd * gg.w); *(uint2*)(XN + (size_t)tok * 1024 + j * 256 + lane * 4) = o; }
    }
}

DEV void phase_gate(const Args& a, unsigned char* smem) {
    const bf16_t* XN = (const bf16_t*)(a.ws + WS_XN); const bf16_t* WG = (const bf16_t*)(a.ws + WS_WGATE); const bf16_t* PB = (const bf16_t*)(a.ws + WS_PB); const bf16_t* WP = (const bf16_t*)(a.ws + WS_WPLE);
    const float* H2 = (const float*)(a.ws + WS_H1); float* OUT = a.out; float* SSQ3 = (float*)(a.ws + WS_SSQ3);
    const int tid = TID(); int lane = tid & 63, wid = tid >> 6, wr = wid >> 2, wc = wid & 3; (void)wr; (void)wc; (void)lane;
    bf16_t* GT = (bf16_t*)(a.ws + WS_ACT);
    auto aoffg = [](int r, int kc) { return (unsigned)(r * 2048 + kc * 16); }; auto aoffp = [](int r, int kc) { return (unsigned)(r * 512 + kc * 16); }; auto boffg = [](int k, int nc) { return (unsigned)(k * 2048 + nc * 16); };
    for (int item = VBID(); item < 64 * 4; item += gridDim.x) {
        int mt, nt; patch_decode(item, 64, 4, mt, nt);
        f32x4 acc[8][4];
        gemm256<true>(smem, 16, XN + (size_t)mt * 256 * 1024, 128u, aoffg, WG + nt * 256, 64u * 2048u, boffg, acc, false,
                      next_tile(true, smem, PB + (size_t)mt * 256 * 256, aoffp, WP + nt * 256, boffg));
        EPI_IDS();
        {
            uint2 wq[8][4];
#pragma unroll
            for (int mi = 0; mi < 8; ++mi) { const size_t gm = (size_t)mt * 256 + G_ROW(mi);
#pragma unroll
                for (int ni = 0; ni < 4; ++ni) { const int n = nt * 256 + G_COL(ni); const f32x4 v = acc[mi][ni];
                    uint2 w; w.x = cvtpk(sigmoidf_(v[0]), sigmoidf_(v[1])); w.y = cvtpk(sigmoidf_(v[2]), sigmoidf_(v[3])); wq[mi][ni] = w;
                    const float4 h = *(const float4*)(H2 + gm * 1024 + n); acc[mi][ni] = (f32x4){h.x, h.y, h.z, h.w}; } }
#pragma unroll
            for (int mi = 0; mi < 8; ++mi) { const size_t gm = (size_t)mt * 256 + G_ROW(mi);
#pragma unroll
                for (int ni = 0; ni < 4; ++ni) { const int n = nt * 256 + G_COL(ni); const uint2 w = wq[mi][ni]; *(uint2*)(GT + gm * 1024 + n) = w; const f32x4 h = acc[mi][ni];
                    acc[mi][ni] = (f32x4){h[0] * __builtin_amdgcn_rcpf(bflo(w.x)), h[1] * __builtin_amdgcn_rcpf(bfhi(w.x)), h[2] * __builtin_amdgcn_rcpf(bflo(w.y)), h[3] * __builtin_amdgcn_rcpf(bfhi(w.y))}; } }
        }
        gemm256<false>(smem, 4, PB + (size_t)mt * 256 * 256, 128u, aoffp, WP + nt * 256, 64u * 2048u, boffg, acc, true);
        EPI_IDS();
        const bool fused = gridDim.x >= 256;
        {
            uint2 gq[8][4];
#pragma unroll
            for (int mi = 0; mi < 8; ++mi) { const size_t gm = (size_t)mt * 256 + G_ROW(mi);
#pragma unroll
                for (int ni = 0; ni < 4; ++ni) gq[mi][ni] = *(const uint2*)(GT + gm * 1024 + nt * 256 + G_COL(ni)); }
#pragma unroll
            for (int mi = 0; mi < 8; ++mi) { const size_t gm = (size_t)mt * 256 + G_ROW(mi); float ss = 0.f;
#pragma unroll
                for (int ni = 0; ni < 4; ++ni) { const int n = nt * 256 + G_COL(ni); const f32x4 v = acc[mi][ni]; const uint2 gw = gq[mi][ni];
                    float4 o = {v[0] * bflo(gw.x), v[1] * bfhi(gw.x), v[2] * bflo(gw.y), v[3] * bfhi(gw.y)};
                    if (!fused) *(float4*)(OUT + gm * 1024 + n) = o;
                    acc[mi][ni] = (f32x4){o.x, o.y, o.z, o.w};
                    ss += o.x * o.x + o.y * o.y + o.z * o.z + o.w * o.w; }
                ss += __shfl_xor(ss, 16); ss += __shfl_xor(ss, 32);
                if (lane < 16) SSQ3[gm * 16 + nt * 4 + wc] = ss; }
        }
        if (fused) {
            unsigned* flag = (unsigned*)(a.ws + WS_CTL) + CW_GATEFLAG + mt;
            const float* lnf = a.in[I_LNF]; float4 gg[4];
#pragma unroll
            for (int ni = 0; ni < 4; ++ni) gg[ni] = *(const float4*)(lnf + nt * 256 + G_COL(ni));
            signal_done(flag); wait_flag(flag, 4u);
            float rstd[8];
#pragma unroll
            for (int mi = 0; mi < 8; ++mi) { const size_t gm = (size_t)mt * 256 + G_ROW(mi); const float4 s0 = *(const float4*)(SSQ3 + gm * 16 + 4 * (lane >> 4)); rstd[mi] = (s0.x + s0.y) + (s0.z + s0.w); }
#pragma unroll
            for (int mi = 0; mi < 8; ++mi) { float t_ = rstd[mi]; t_ += __shfl_xor(t_, 16); t_ += __shfl_xor(t_, 32); rstd[mi] = rsqrtf(t_ * (1.f / 1024.f) + EPS); }
#pragma unroll
            for (int mi = 0; mi < 8; ++mi) { const size_t gm = (size_t)mt * 256 + G_ROW(mi);
#pragma unroll
                for (int ni = 0; ni < 4; ++ni) { const int n = nt * 256 + G_COL(ni); const f32x4 v = acc[mi][ni]; const float r_ = rstd[mi];
                    float4 o = {v[0] * r_ * gg[ni].x, v[1] * r_ * gg[ni].y, v[2] * r_ * gg[ni].z, v[3] * r_ * gg[ni].w}; *(float4*)(OUT + gm * 1024 + n) = o; } }
        }
        __syncthreads();
    }
}

DEV void phase_final(const Args& a) {
    if (gridDim.x >= 256) return;
    float* OUT = a.out; const float* SSQ3 = (const float*)(a.ws + WS_SSQ3); const float* g = a.in[I_LNF];
    const int lane = TID() & 63; const int gw = BID() * NWAVE + (TID() >> 6), ngw = gridDim.x * NWAVE;
    for (int m = gw; m < NTOK; m += ngw) {
        float s = 0.f;
#pragma unroll
        for (int j = 0; j < 16; ++j) s += SSQ3[(size_t)m * 16 + j];
        const float rstd = rsqrtf(s * (1.f / 1024.f) + EPS);
#pragma unroll
        for (int j = 0; j < 4; ++j) { float4 v = *(const float4*)(OUT + (size_t)m * 1024 + j * 256 + lane * 4); const float4 gg = *(const float4*)(g + j * 256 + lane * 4);
            v.x *= rstd * gg.x; v.y *= rstd * gg.y; v.z *= rstd * gg.z; v.w *= rstd * gg.w; *(float4*)(OUT + (size_t)m * 1024 + j * 256 + lane * 4) = v; }
    }
}

template <int PH> DEV void run_phase(const Args& a, unsigned char* smem) {
    if constexpr (PH == PH_PRO) phase_prologue(a, smem);
    else if constexpr (PH == PH_INPROJ) phase_inproj(a, smem);
    else if constexpr (PH == PH_ATT) phase_att(a, smem);
    else if constexpr (PH == PH_OUTPROJ) phase_outproj(a, smem);
    else if constexpr (PH == PH_ROUTE) phase_route(a, smem);
    else if constexpr (PH == PH_UP) phase_up(a, smem);
    else if constexpr (PH == PH_DOWN) phase_down(a, smem);
    else if constexpr (PH == PH_COMB) phase_comb(a, smem);
    else if constexpr (PH == PH_GATE) phase_gate(a, smem);
    else if constexpr (PH == PH_FINAL) phase_final(a);
}
#define XB_TMO      128
#define XB_XCNT(j)  (256  + 64 * (j))
#define XB_XSUB(j)  (1280 + 64 * (j))
#define XB_XGEN(j)  (2304 + 64 * (j))
#define XB_TOP      3328
#define XB_TOPGEN   3392
#define XCD_BAR_WORDS 3456
#define XB_SPIN_CAP (1u << 22)
DEV unsigned xb_ld(unsigned* p)              { return __hip_atomic_load(p, __ATOMIC_RELAXED, __HIP_MEMORY_SCOPE_AGENT); }
DEV unsigned xb_add(unsigned* p, unsigned v) { return __hip_atomic_fetch_add(p, v, __ATOMIC_RELAXED, __HIP_MEMORY_SCOPE_AGENT); }
DEV unsigned xb_xcc_id() { return (unsigned)__builtin_amdgcn_s_getreg((3 << 11) | 20) & 0xFu; }
#define XB_SPIN(cond, bar) do { unsigned _sp = 0; while (cond) { __builtin_amdgcn_s_sleep(1); \
    if ((++_sp & 255u) == 0u) { if (xb_ld(&(bar)[XB_TMO])) break; if (_sp > XB_SPIN_CAP) { atomicAdd(&(bar)[XB_TMO], 1u); break; } } } } while (0)
struct XcdBarrier { unsigned* bar; unsigned x; volatile LAS unsigned* st; };
DEV XcdBarrier xcd_barrier_post(unsigned* bar, volatile LAS unsigned* st) {
    XcdBarrier b; b.bar = bar; b.x = xb_xcc_id(); b.st = st;
    if (TID() == 0) (void)xb_add(&bar[XB_XCNT(b.x)], 1u);
    return b;
}
DEV void xcd_barrier_complete(unsigned* bar, unsigned x, unsigned& nloc, unsigned& nx) {
    const unsigned G = gridDim.x * gridDim.y * gridDim.z;
    unsigned sum, cnt, mine, sp = 0u;
    for (;;) {
        sum = 0u; cnt = 0u; mine = 0u;
#pragma unroll
        for (unsigned j = 0; j < 16; ++j) { const unsigned c = xb_ld(&bar[XB_XCNT(j)]); sum += c; cnt += (c > 0u) ? 1u : 0u; mine = (j == x) ? c : mine; }
        if (sum == G) break;
        __builtin_amdgcn_s_sleep(1);
        if ((++sp & 255u) == 0u) { if (xb_ld(&bar[XB_TMO])) break; if (sp > XB_SPIN_CAP) { atomicAdd(&bar[XB_TMO], 1u); break; } }
    }
    nloc = mine > 0u ? mine : 1u; nx = cnt > 0u ? cnt : 1u;
}
DEV void xcd_barrier(const XcdBarrier& b) {
    asm volatile("s_waitcnt vmcnt(0)" ::: "memory");
    __syncthreads();
    if (TID() == 0) {
        unsigned* bar = b.bar;
        __builtin_amdgcn_s_waitcnt(0);
        unsigned nloc = b.st[0], nx = b.st[1];
        if (nloc == 0u) { xcd_barrier_complete(bar, b.x, nloc, nx); b.st[0] = nloc; b.st[1] = nx; }
        const unsigned old = xb_add(&bar[XB_XSUB(b.x)], 1u);
        const unsigned gen = old / nloc;
        if (old + 1u == (gen + 1u) * nloc) {
            __builtin_amdgcn_fence(__ATOMIC_RELEASE, "agent");
            asm volatile("s_waitcnt vmcnt(0)" ::: "memory");
            const unsigned og = xb_add(&bar[XB_TOP], 1u);
            const unsigned tg = og / nx;
            if (og + 1u == (tg + 1u) * nx) xb_add(&bar[XB_TOPGEN], 1u);
            else XB_SPIN(xb_ld(&bar[XB_TOPGEN]) == tg, bar);
            __builtin_amdgcn_fence(__ATOMIC_ACQUIRE, "agent");
            xb_add(&bar[XB_XGEN(b.x)], 1u);
            asm volatile("s_waitcnt vmcnt(0)" ::: "memory");
        } else {
            XB_SPIN(xb_ld(&bar[XB_XGEN(b.x)]) == gen, bar);
            __builtin_amdgcn_fence(__ATOMIC_ACQUIRE, "agent");
            asm volatile("s_waitcnt vmcnt(0)" ::: "memory");
        }
    }
    __syncthreads();
}

__global__ void __launch_bounds__(NTHR, 2) mega(Args a) {
    extern __shared__ __attribute__((aligned(16))) unsigned char smem[];
    volatile LAS unsigned* bst = (volatile LAS unsigned*)(LAS unsigned char*)(smem + MISC_OFF + 8000);
    if (TID() == 0) { bst[0] = 0u; bst[1] = 0u; }
    __syncthreads();
    const XcdBarrier bar = xcd_barrier_post((unsigned*)(a.ws + WS_CTL) + 4096, bst);
#define GSYNC() xcd_barrier(bar)
#define RUN(ph) do { run_phase<ph>(a, smem); if ((PROBE_DUP >> ph) & 1) { GSYNC(); run_phase<ph>(a, smem); } } while (0)
    RUN(PH_PRO); GSYNC();
    RUN(PH_INPROJ); GSYNC();
    RUN(PH_ATT); GSYNC();
    RUN(PH_OUTPROJ); GSYNC();
    RUN(PH_ROUTE); GSYNC();
    RUN(PH_UP); GSYNC();
    RUN(PH_DOWN); GSYNC();
    RUN(PH_COMB); GSYNC();
    RUN(PH_GATE);
    if (gridDim.x < 256) { GSYNC(); RUN(PH_FINAL); }
#undef RUN
#undef GSYNC
}

extern "C" void kernel_launch(void* const* d_in, const int* in_sizes, int n_in, void* d_out, int out_size, void* d_ws, size_t ws_size, hipStream_t stream) {
    static int grid = 0;
    if (grid == 0) {
        if (n_in != 25 || ws_size < WS_END) { fprintf(stderr, "kernel_launch: unexpected n_in %d / ws %zu\n", n_in, ws_size); grid = -1; return; }
        int dev = 0, cus = 0, per_cu = 0;
        (void)hipGetDevice(&dev); (void)hipDeviceGetAttribute(&cus, hipDeviceAttributeMultiprocessorCount, dev);
        (void)hipFuncSetAttribute((const void*)mega, hipFuncAttributeMaxDynamicSharedMemorySize, LDS_BYTES);
        (void)hipOccupancyMaxActiveBlocksPerMultiprocessor(&per_cu, (const void*)mega, NTHR, LDS_BYTES);
        if (per_cu < 1) { fprintf(stderr, "kernel_launch: occupancy query says %d blocks per CU\n", per_cu); grid = -1; return; }
        grid = cus;
    }
    if (grid < 0) return;
    (void)hipMemsetAsync((char*)d_ws + WS_CTL, 0, 65536, stream);
    Args a{};
    for (int i = 0; i < 25; ++i) a.in[i] = (const float*)d_in[i];
    a.out = (float*)d_out; a.ws = (unsigned char*)d_ws; a.ph_lo = 0; a.ph_hi = PH_N;
    void* args[] = {&a};
    hipError_t e = hipLaunchCooperativeKernel((const void*)mega, dim3(grid), dim3(NTHR), args, LDS_BYTES, stream);
    if (e != hipSuccess) fprintf(stderr, "cooperative launch failed: %s (grid %d)\n", hipGetErrorString(e), grid);
}
```

```cpp
#include <hip/hip_runtime.h>
#include <stdint.h>
#include <cstdio>

#define DEV __device__ __forceinline__
#define LAS __attribute__((address_space(3)))

typedef unsigned short bf16_t;
typedef short bf16x8 __attribute__((ext_vector_type(8)));
typedef short s16x4 __attribute__((ext_vector_type(4)));
typedef float f32x4 __attribute__((ext_vector_type(4)));
typedef float f32x16 __attribute__((ext_vector_type(16)));
typedef float f32x2_t __attribute__((ext_vector_type(2)));
typedef __bf16 bf16x2_t __attribute__((ext_vector_type(2)));

constexpr int NTHR = 512, NWAVE = 8;
constexpr int NTOK = 16384;
constexpr float EPS = 1e-6f;
constexpr float LOG2E = 1.4426950408889634f;
constexpr float QS = 0.125f * LOG2E;
constexpr int NWIN = 3072;

constexpr size_t MiB = 1u << 20;
constexpr size_t WS_CTL = 0;
constexpr size_t WS_WIN = 1 * MiB;
constexpr size_t WS_WOUT = 7 * MiB;
constexpr size_t WS_WGATE = 9 * MiB;
constexpr size_t WS_WPLE = 11 * MiB;
constexpr size_t WS_WC1 = 12 * MiB;
constexpr size_t WS_WC2 = 15 * MiB + 512 * 1024 + 262144;
constexpr size_t WS_BIAS1 = 15 * MiB + 512 * 1024 + 262144 + 131072;
constexpr size_t WS_KC = 14 * MiB;
constexpr size_t WS_HID = 14 * MiB + 512 * 1024;
constexpr size_t WS_GN = 16 * MiB;
constexpr size_t WS_LS = 18 * MiB;
constexpr size_t WS_CUM = 19 * MiB;
constexpr size_t WS_SSQ = 20 * MiB;
constexpr size_t WS_TOPI = 21 * MiB;
constexpr size_t WS_TOPS = 21 * MiB + 262144;
constexpr size_t WS_TOPW = 21 * MiB + 524288;
constexpr size_t WS_TOKOF = 22 * MiB;
constexpr size_t WS_ROWW = 24 * MiB;
constexpr size_t WS_SSQ3 = 26 * MiB;
constexpr size_t WS_RSTD2 = 27 * MiB;
constexpr size_t WS_PB = 28 * MiB;
constexpr size_t WS_XN = 36 * MiB;
constexpr size_t WS_PROJ = 68 * MiB;
constexpr size_t WS_ONSA = 160 * MiB;
constexpr size_t WS_OFOX = 176 * MiB;
constexpr size_t WS_H1 = 192 * MiB;
constexpr size_t WS_WUP = 256 * MiB;
constexpr size_t WS_WDN = 384 * MiB;
constexpr size_t WS_ACT = 448 * MiB;
constexpr size_t WS_Y = 592 * MiB;
constexpr size_t WS_RSDS = 736 * MiB;
constexpr size_t WS_END = 738 * MiB;

enum { PH_PRO = 0, PH_INPROJ, PH_CMP, PH_ATT, PH_OUTPROJ, PH_ROUTE, PH_UP, PH_DOWN, PH_COMB, PH_GATE, PH_FINAL, PH_N };
struct Args { const float* in[25]; float* out; unsigned char* ws; int ph_lo, ph_hi; };
enum { I_X = 0, I_P, I_LN1, I_WIN, I_BFG, I_WC1K, I_WC2K, I_PEK, I_WC1V, I_WC2V, I_PEV, I_GNN, I_GNF, I_WOUT, I_LN2, I_WR, I_BR,
       I_WUP, I_BUP, I_WDN, I_BDN, I_LNPLE, I_WPLE, I_WGATE, I_LNF };

DEV int BID() { int b = (int)blockIdx.x; asm volatile("" : "+s"(b)); return b; }
DEV int VBID() { const int g = (int)gridDim.x, b = BID(); return (g & 7) ? b : (b & 7) * (g >> 3) + (b >> 3); }
DEV int TID() { int t = (int)__builtin_amdgcn_workitem_id_x(); asm volatile("" : "+v"(t)); return t; }
DEV unsigned cvtpk(float lo, float hi) { f32x2_t v = {lo, hi}; bf16x2_t b = __builtin_convertvector(v, bf16x2_t); return __builtin_bit_cast(unsigned, b); }
DEV float bflo(unsigned u) { return __uint_as_float(u << 16); }
DEV float bfhi(unsigned u) { return __uint_as_float(u & 0xffff0000u); }
DEV float wave_sum(float v) {
#pragma unroll
    for (int o = 1; o < 64; o <<= 1) v += __shfl_xor(v, o);
    return v;
}
#define DPP_MOV(x, ctrl) __builtin_bit_cast(float, __builtin_amdgcn_update_dpp(0, __builtin_bit_cast(int, (x)), (ctrl), 0xF, 0xF, true))
DEV float pair_sum(float x) { return x + __shfl_xor(x, 32); }
DEV float pair_max(float x) { return fmaxf(x, __shfl_xor(x, 32)); }
DEV float quad_sum(float x) { x += DPP_MOV(x, 0xB1); x += DPP_MOV(x, 0x4E); return x; }
DEV float wave_max_u(float x) {
    x = fmaxf(x, DPP_MOV(x, 0xB1)); x = fmaxf(x, DPP_MOV(x, 0x4E)); x = fmaxf(x, DPP_MOV(x, 0x141)); x = fmaxf(x, DPP_MOV(x, 0x140));
    const float a = __builtin_bit_cast(float, __builtin_amdgcn_readlane(__builtin_bit_cast(int, x), 0)), b = __builtin_bit_cast(float, __builtin_amdgcn_readlane(__builtin_bit_cast(int, x), 16));
    const float c = __builtin_bit_cast(float, __builtin_amdgcn_readlane(__builtin_bit_cast(int, x), 32)), d = __builtin_bit_cast(float, __builtin_amdgcn_readlane(__builtin_bit_cast(int, x), 48));
    return fmaxf(fmaxf(a, b), fmaxf(c, d));
}
DEV float sigmoidf_(float x) { return __builtin_amdgcn_rcpf(1.0f + __expf(-x)); }
DEV float logsigmoidf_(float x) { return fminf(x, 0.f) - log1pf(__expf(-fabsf(x))); }
DEV float gelu_tanh(float x) { const float u = 0.7978845608028654f * (x + 0.044715f * x * x * x); const float th = 1.0f - 2.0f * __builtin_amdgcn_rcpf(__expf(2.0f * u) + 1.0f); return 0.5f * x * (1.0f + th); }
DEV s16x4 tr_read(const unsigned char* p) {
    typedef short v4i16_t __attribute__((ext_vector_type(4)));
    return __builtin_bit_cast(s16x4, __builtin_amdgcn_ds_read_tr16_b64_v4i16((LAS v4i16_t*)p));
}
DEV s16x4 tr_read_l(unsigned lds_addr) {
    typedef short v4i16_t __attribute__((ext_vector_type(4)));
    return __builtin_bit_cast(s16x4, __builtin_amdgcn_ds_read_tr16_b64_v4i16((LAS v4i16_t*)(uintptr_t)lds_addr));
}
DEV int crow(int r, int hi) { return (r & 3) + 8 * (r >> 2) + 4 * hi; }

constexpr int GL_STAGE = 65536;
constexpr int GEMM_LDS = 2 * GL_STAGE;
constexpr int MISC_OFF = GEMM_LDS;
constexpr int LDS_BYTES = GEMM_LDS + 8192 + 12288;

DEV void glds16s(const void* sbase, unsigned voff, unsigned lds_dst) { unsigned keep;
    asm volatile("s_mov_b32 %0, m0\n\ts_mov_b32 m0, %3\n\ts_nop 0\n\tglobal_load_lds_dwordx4 %1, %2\n\ts_mov_b32 m0, %0" : "=&s"(keep) : "v"(voff), "s"(sbase), "s"(lds_dst) : "memory"); }

DEV const unsigned char* uptr(const void* p) { const unsigned long long v = (unsigned long long)p; const unsigned lo = __builtin_amdgcn_readfirstlane((unsigned)v), hi = __builtin_amdgcn_readfirstlane((unsigned)(v >> 32)); return (const unsigned char*)(((unsigned long long)hi << 32) | lo); }

DEV void lds_barrier() { asm volatile("s_waitcnt lgkmcnt(0)\n\ts_barrier" ::: "memory"); }

struct NoNextS { DEV void operator()() const {} };
template <class AO, class BO>
DEV void gemm256s_issue0(unsigned char* smem, const void* abase, const AO& aoff, const void* bbase, const BO& boff) {
    const int tid = TID(), lane = tid & 63; const int wid = __builtin_amdgcn_readfirstlane(tid >> 6);
    const unsigned lds0 = (unsigned)(uintptr_t)smem; const unsigned char* ab_ = uptr(abase); const unsigned char* bb_ = uptr(bbase);
#pragma unroll
    for (int i = 0; i < 4; ++i) { const int p = wid + 8 * i; glds16s(ab_, aoff(8 * p + (lane >> 3), (lane & 7) ^ (lane >> 3)), (unsigned)__builtin_amdgcn_readfirstlane(lds0 + p * 1024)); }
#pragma unroll
    for (int i = 0; i < 4; ++i) { const int p = wid + 8 * i; const int k = 2 * p + (lane >> 5); const int f = (k & 3) + 4 * ((k >> 3) & 1);
        glds16s(bb_, boff(k, (lane & 31) ^ (f << 1)), (unsigned)__builtin_amdgcn_readfirstlane(lds0 + 32768 + p * 1024)); }
}
template <bool ZERO, class AO, class BO, class NX = NoNextS>
DEV void gemm256s(unsigned char* smem, int nkt, const void* abase, unsigned akstep, const AO& aoff, const void* bbase, unsigned bkstep, const BO& boff, f32x4 (&acc)[8][4], bool pre = false, const NX& next = NX()) {
    const int tid = TID(), lane = tid & 63; const int wid = __builtin_amdgcn_readfirstlane(tid >> 6); const int wr = wid >> 2, wc = wid & 3;
    if (ZERO) {
#pragma unroll
        for (int mi = 0; mi < 8; ++mi)
#pragma unroll
            for (int ni = 0; ni < 4; ++ni) acc[mi][ni] = (f32x4){0.f, 0.f, 0.f, 0.f};
    }
    const unsigned lds0 = (unsigned)(uintptr_t)smem;
    const unsigned char* abase_u = uptr(abase); const unsigned char* bbase_u = uptr(bbase); const unsigned akstep_u = __builtin_amdgcn_readfirstlane(akstep), bkstep_u = __builtin_amdgcn_readfirstlane(bkstep);
    unsigned ao[4], bo[4];
#pragma unroll
    for (int i = 0; i < 4; ++i) { const int p = wid + 8 * i; ao[i] = aoff(8 * p + (lane >> 3), (lane & 7) ^ (lane >> 3));
        const int k = 2 * p + (lane >> 5); const int f = (k & 3) + 4 * ((k >> 3) & 1); bo[i] = boff(k, (lane & 31) ^ (f << 1)); }
#define GL_ISSUE(kt, st) do { const unsigned char* ab_ = abase_u + (size_t)(kt) * akstep_u; const unsigned char* bb_ = bbase_u + (size_t)(kt) * bkstep_u; \
        _Pragma("unroll") for (int i_ = 0; i_ < 4; ++i_) glds16s(ab_, ao[i_], (unsigned)__builtin_amdgcn_readfirstlane(lds0 + (st) * GL_STAGE + (wid + 8 * i_) * 1024)); \
        _Pragma("unroll") for (int i_ = 0; i_ < 4; ++i_) glds16s(bb_, bo[i_], (unsigned)__builtin_amdgcn_readfirstlane(lds0 + (st) * GL_STAGE + 32768 + (wid + 8 * i_) * 1024)); } while (0)
    if (!pre) {
        GL_ISSUE(0, 0);
        asm volatile("s_waitcnt vmcnt(0)" ::: "memory");
        __syncthreads();
    }
    for (int kt = 0; kt < nkt; ++kt) {
        if (kt + 1 < nkt) GL_ISSUE(kt + 1, (kt + 1) & 1); else next();
        const unsigned char* A = smem + (kt & 1) * GL_STAGE; const unsigned char* Bt = A + 32768;
#pragma unroll
        for (int ks = 0; ks < 2; ++ks) {
            bf16x8 wf[4];
#pragma unroll
            for (int ni = 0; ni < 4; ++ni) {
                const int i = lane & 15, g = lane >> 4, q = i >> 2; const int row = ks * 32 + 8 * g + q; const int nc = wc * 8 + ni * 2 + ((i & 3) >> 1); const int f = q + 4 * (g & 1);
                const unsigned char* p = Bt + row * 512 + ((nc ^ (f << 1)) << 4) + (i & 1) * 8;
                const s16x4 lo = tr_read(p), hi = tr_read(p + 4 * 512);
                wf[ni] = (bf16x8){lo[0], lo[1], lo[2], lo[3], hi[0], hi[1], hi[2], hi[3]};
            }
#pragma unroll
            for (int mi = 0; mi < 8; ++mi) {
                const int m = wr * 128 + mi * 16 + (lane & 15); const int kc = ks * 4 + (lane >> 4);
                const bf16x8 af = *(const bf16x8*)(A + m * 128 + ((kc ^ (m & 7)) << 4));
#pragma unroll
                for (int ni = 0; ni < 4; ++ni) acc[mi][ni] = __builtin_amdgcn_mfma_f32_16x16x32_bf16(wf[ni], af, acc[mi][ni], 0, 0, 0);
            }
        }
        asm volatile("s_waitcnt vmcnt(0)" ::: "memory");
        __syncthreads();
    }
#undef GL_ISSUE
}

#define G_ROW(mi) ((((mi) >> 2) * 128) + wr * 64 + (((mi) & 3) * 16) + (lane & 15))
#define G_COL(ni) ((((ni) >> 1) * 128) + wc * 32 + (((ni) & 1) * 16) + 4 * (lane >> 4))
#define WAIT_V(n) asm volatile("s_waitcnt vmcnt(" #n ")" ::: "memory")
#define WAIT_L(n) asm volatile("s_waitcnt lgkmcnt(" #n ")" ::: "memory")
#define BAR() __builtin_amdgcn_s_barrier()
#define SCHED() __builtin_amdgcn_sched_barrier(0)
constexpr int SA_(int b, int h) { return b * GL_STAGE + h * 16384; }
constexpr int SB_(int b, int h) { return b * GL_STAGE + 32768 + h * 16384; }
struct NoNext { DEV bool has() const { return false; } template <int P> DEV void issue() const {} };
template <int WHICH, class AO, class BO>
DEV void gemm_issue0(unsigned char* smem, const void* abase, const AO& aoff, const void* bbase, const BO& boff) {
    const int tid = TID(), lane = tid & 63; const int wid = __builtin_amdgcn_readfirstlane(tid >> 6);
    const unsigned lds0 = (unsigned)(uintptr_t)smem; const unsigned char* ab_ = uptr(abase); const unsigned char* bb_ = uptr(bbase);
#pragma unroll
    for (int h = 0; h < 2; ++h) {
        if (WHICH & (1 << (2 * h))) {
#pragma unroll
            for (int i = 0; i < 2; ++i) { const int p = wid + 8 * i; const int k = 4 * p + (lane >> 4); const int f = (k & 3) + 4 * ((k >> 3) & 1);
                glds16s(bb_, boff(k, h * 16 + ((lane & 15) ^ (f << 1))), (unsigned)__builtin_amdgcn_readfirstlane(lds0 + SB_(0, h) + p * 1024)); } }
        if (WHICH & (2 << (2 * h))) {
#pragma unroll
            for (int i = 0; i < 2; ++i) { const int p = wid + 8 * i;
                glds16s(ab_, aoff(h * 128 + 8 * p + (lane >> 3), (lane & 7) ^ (lane >> 3)), (unsigned)__builtin_amdgcn_readfirstlane(lds0 + SA_(0, h) + p * 1024)); } }
    }
}
template <class AO, class BO>
struct NextTile { bool on; unsigned char* smem; const void* abase; AO aoff; const void* bbase; BO boff;
    DEV bool has() const { return on; }
    template <int P> DEV void issue() const { gemm_issue0<P>(smem, abase, aoff, bbase, boff); } };
template <class AO, class BO> DEV NextTile<AO, BO> next_tile(bool on, unsigned char* smem, const void* abase, const AO& aoff, const void* bbase, const BO& boff) { return NextTile<AO, BO>{on, smem, abase, aoff, bbase, boff}; }
template <bool ZERO, class AO, class BO, class NX = NoNext>
DEV void gemm256(unsigned char* smem, int nkt, const void* abase, unsigned akstep, const AO& aoff, const void* bbase, unsigned bkstep, const BO& boff, f32x4 (&acc)[8][4], bool pre = false, const NX& next = NX()) {
    const int tid = TID(), lane = tid & 63; const int wid = __builtin_amdgcn_readfirstlane(tid >> 6); const int wr = wid >> 2, wc = wid & 3;
    if (ZERO) {
#pragma unroll
        for (int mi = 0; mi < 8; ++mi)
#pragma unroll
            for (int ni = 0; ni < 4; ++ni) acc[mi][ni] = (f32x4){0.f, 0.f, 0.f, 0.f};
    }
    const unsigned lds0 = (unsigned)(uintptr_t)smem;
    const unsigned char* abase_u = uptr(abase); const unsigned char* bbase_u = uptr(bbase); const unsigned akstep_u = __builtin_amdgcn_readfirstlane(akstep), bkstep_u = __builtin_amdgcn_readfirstlane(bkstep);
    unsigned ao[4], bo[4];
#pragma unroll
    for (int h = 0; h < 2; ++h)
#pragma unroll
        for (int i = 0; i < 2; ++i) { const int p = wid + 8 * i; ao[h * 2 + i] = aoff(h * 128 + 8 * p + (lane >> 3), (lane & 7) ^ (lane >> 3));
            const int k = 4 * p + (lane >> 4); const int f = (k & 3) + 4 * ((k >> 3) & 1); bo[h * 2 + i] = boff(k, h * 16 + ((lane & 15) ^ (f << 1))); }
    unsigned ard0[2], ard1[2], brd0[2], brd1[2];
    { const int l15 = lane & 15, g = lane >> 4, q = l15 >> 2; const int f = q + 4 * (g & 1);
      ard0[0] = lds0 + (wr * 64 + l15) * 128 + ((g ^ (lane & 7)) << 4); ard1[0] = lds0 + (wr * 64 + l15) * 128 + (((4 + g) ^ (lane & 7)) << 4);
      const int nc = wc * 4 + ((l15 & 3) >> 1); const int kr = 8 * g + q;
      brd0[0] = lds0 + kr * 256 + ((nc ^ (f << 1)) << 4) + (l15 & 1) * 8; brd1[0] = lds0 + kr * 256 + (((nc + 2) ^ (f << 1)) << 4) + (l15 & 1) * 8;
      ard0[1] = ard0[0] + GL_STAGE; ard1[1] = ard1[0] + GL_STAGE; brd0[1] = brd0[0] + GL_STAGE; brd1[1] = brd1[0] + GL_STAGE;
      asm volatile("" : "+v"(ard0[1]), "+v"(ard1[1]), "+v"(brd0[1]), "+v"(brd1[1])); }
#define ST_A(b, h, kt) do { const unsigned char* ab_ = abase_u + (size_t)(kt) * akstep_u; \
        _Pragma("unroll") for (int i_ = 0; i_ < 2; ++i_) glds16s(ab_, ao[(h) * 2 + i_], (unsigned)__builtin_amdgcn_readfirstlane(lds0 + SA_(b, h) + (wid + 8 * i_) * 1024)); } while (0)
#define ST_B(b, h, kt) do { const unsigned char* bb_ = bbase_u + (size_t)(kt) * bkstep_u; \
        _Pragma("unroll") for (int i_ = 0; i_ < 2; ++i_) glds16s(bb_, bo[(h) * 2 + i_], (unsigned)__builtin_amdgcn_readfirstlane(lds0 + SB_(b, h) + (wid + 8 * i_) * 1024)); } while (0)
#define LDSP(T, a_) ((LAS const T*)(uintptr_t)(a_))
#define LDA(dst, b, h) do { _Pragma("unroll") for (int m_ = 0; m_ < 4; ++m_) { dst[m_][0] = *LDSP(bf16x8, ard0[b] + SA_(0, h) + m_ * 2048); dst[m_][1] = *LDSP(bf16x8, ard1[b] + SA_(0, h) + m_ * 2048); } } while (0)
#define LDB(dst, b, h) do { _Pragma("unroll") for (int n_ = 0; n_ < 2; ++n_) _Pragma("unroll") for (int k_ = 0; k_ < 2; ++k_) { const unsigned p_ = (n_ ? brd1[b] : brd0[b]) + SB_(0, h) + k_ * 8192; \
        const s16x4 lo_ = tr_read_l(p_), hi_ = tr_read_l(p_ + 1024); dst[n_][k_] = (bf16x8){lo_[0], lo_[1], lo_[2], lo_[3], hi_[0], hi_[1], hi_[2], hi_[3]}; } } while (0)
#define MMA(ai, bj, Bx) do { __builtin_amdgcn_s_setprio(1); \
        _Pragma("unroll") for (int k_ = 0; k_ < 2; ++k_) _Pragma("unroll") for (int m_ = 0; m_ < 4; ++m_) _Pragma("unroll") for (int n_ = 0; n_ < 2; ++n_) \
            acc[(ai) * 4 + m_][(bj) * 2 + n_] = __builtin_amdgcn_mfma_f32_16x16x32_bf16(Bx[n_][k_], At[m_][k_], acc[(ai) * 4 + m_][(bj) * 2 + n_], 0, 0, 0); \
        __builtin_amdgcn_s_setprio(0); } while (0)
    bf16x8 At[4][2], B0[2][2], B1[2][2];
    if (!pre) { ST_B(0, 0, 0); ST_A(0, 0, 0); ST_B(0, 1, 0); ST_A(0, 1, 0); }
    if (wr == 1) BAR();
    if (!pre) WAIT_V(4);
    BAR();
    ST_B(1, 0, 1); ST_A(1, 0, 1); ST_B(1, 1, 1);
    if (!pre) WAIT_V(6);
    BAR();
    for (int t = 0; t < nkt - 2; t += 2) {
        LDB(B0, 0, 0); SCHED(); LDA(At, 0, 0); ST_A(1, 1, t + 1);
        WAIT_L(8); BAR(); WAIT_L(0); MMA(0, 0, B0); BAR(); SCHED();
        LDB(B1, 0, 1); ST_B(0, 0, t + 2);
        BAR(); WAIT_L(0); MMA(0, 1, B1); BAR();
        LDA(At, 0, 1); ST_A(0, 0, t + 2);
        BAR(); WAIT_L(0); MMA(1, 0, B0); BAR(); SCHED();
        ST_B(0, 1, t + 2);
        WAIT_V(6); BAR(); MMA(1, 1, B1); BAR();
        LDB(B0, 1, 0); SCHED(); LDA(At, 1, 0); ST_A(0, 1, t + 2);
        WAIT_L(8); BAR(); WAIT_L(0); MMA(0, 0, B0); BAR(); SCHED();
        LDB(B1, 1, 1); ST_B(1, 0, t + 3);
        BAR(); WAIT_L(0); MMA(0, 1, B1); BAR();
        LDA(At, 1, 1); ST_A(1, 0, t + 3);
        BAR(); WAIT_L(0); MMA(1, 0, B0); BAR(); SCHED();
        ST_B(1, 1, t + 3);
        WAIT_V(6); BAR(); MMA(1, 1, B1); BAR();
    }
    const bool hn = next.has();
    LDB(B0, 0, 0); LDA(At, 0, 0); ST_A(1, 1, nkt - 1);
    BAR(); WAIT_L(0); MMA(0, 0, B0); BAR();
    LDB(B1, 0, 1); BAR(); WAIT_L(0); MMA(0, 1, B1); BAR();
    LDA(At, 0, 1);
    if (hn) { next.template issue<3>(); WAIT_V(8); } else WAIT_V(4);
    BAR(); WAIT_L(0); MMA(1, 0, B0); MMA(1, 1, B1); BAR();
    LDB(B0, 1, 0); LDA(At, 1, 0);
    if (hn) { next.template issue<4>(); WAIT_V(8); } else WAIT_V(2);
    BAR(); WAIT_L(0); MMA(0, 0, B0); BAR();
    LDB(B1, 1, 1);
    if (hn) { next.template issue<8>(); WAIT_V(8); } else WAIT_V(0);
    BAR(); WAIT_L(0); MMA(0, 1, B1); BAR();
    LDA(At, 1, 1); BAR(); WAIT_L(0); MMA(1, 0, B0); MMA(1, 1, B1);
    WAIT_V(0);
    BAR();
    if (wr == 0) BAR();
#undef ST_A
#undef ST_B
#undef LDA
#undef LDB
#undef LDSP
#undef MMA
}

DEV uint4 pair16(uint2 a, uint2 b) {
    const auto r0 = __builtin_amdgcn_permlane16_swap(a.x, b.x, false, false); const auto r1 = __builtin_amdgcn_permlane16_swap(a.y, b.y, false, false);
    uint4 o; o.x = r0[0]; o.y = r1[0]; o.z = r0[1]; o.w = r1[1]; return o;
}
DEV void unpair16(uint4 q, uint2& a, uint2& b) {
    const auto r0 = __builtin_amdgcn_permlane16_swap(q.x, q.z, false, false); const auto r1 = __builtin_amdgcn_permlane16_swap(q.y, q.w, false, false);
    a.x = r0[0]; a.y = r1[0]; b.x = r0[1]; b.y = r1[1];
}
#define PAIR16_COL(c0, c1) ((((lane) >> 4) & 1) ? (c1) - 4 : (c0))
#define EPI_IDS() do { const int etid_ = TID(); lane = etid_ & 63; wid = etid_ >> 6; wr = wid >> 2; wc = wid & 3; } while (0)

DEV void patch_decode(int local, int MT, int NT, int& mt, int& nt) {
    const int per_mtb = 8 * NT; const int mtb = local / per_mtb; const int rem = local - mtb * per_mtb;
    const int rows = (MT - 8 * mtb) < 8 ? (MT - 8 * mtb) : 8;
    const int per_ntb = rows * 8; const int nfull = NT >> 3; int ntb = rem / per_ntb; int cols = 8;
    if (ntb >= nfull) { ntb = nfull; cols = NT - 8 * nfull; }
    const int r2 = rem - ntb * per_ntb;
    mt = 8 * mtb + r2 / cols; nt = 8 * ntb + r2 % cols;
}

DEV void convert_chunk(const float* src, bf16_t* dst, size_t i8) {
    const float4 a = *(const float4*)(src + i8 * 8), b = *(const float4*)(src + i8 * 8 + 4);
    uint4 o; o.x = cvtpk(a.x, a.y); o.y = cvtpk(a.z, a.w); o.z = cvtpk(b.x, b.y); o.w = cvtpk(b.z, b.w);
    *(uint4*)(dst + i8 * 8) = o;
}
DEV void phase_prologue(const Args& a, unsigned char* smem) {
    unsigned char* ws = a.ws;
    const size_t gtid = (size_t)BID() * NTHR + TID(), gn = (size_t)gridDim.x * NTHR;
    {
        { const float* W = a.in[I_WOUT]; bf16_t* O = (bf16_t*)(ws + WS_WOUT); const float* gnn = a.in[I_GNN]; const float* gnf = a.in[I_GNF];
          for (size_t i = gtid; i < (size_t)1024 * 128; i += gn) { const int k = (int)(i >> 7); const float g_ = k < 512 ? gnn[k] : gnf[k - 512];
              const float4 x = *(const float4*)(W + i * 8), y = *(const float4*)(W + i * 8 + 4);
              uint4 o; o.x = cvtpk(x.x * g_, x.y * g_); o.y = cvtpk(x.z * g_, x.w * g_); o.z = cvtpk(y.x * g_, y.y * g_); o.w = cvtpk(y.z * g_, y.w * g_); *(uint4*)(O + i * 8) = o; } }
        const float* srcs[3] = {a.in[I_WGATE], a.in[I_WPLE], a.in[I_P]};
        bf16_t* dsts[3] = {(bf16_t*)(ws + WS_WGATE), (bf16_t*)(ws + WS_WPLE), (bf16_t*)(ws + WS_PB)};
        const size_t cnt8[3] = {1024 * 1024 / 8, 256 * 1024 / 8, (size_t)NTOK * 256 / 8};
#pragma unroll
        for (int s = 0; s < 3; ++s) for (size_t i = gtid; i < cnt8[s]; i += gn) convert_chunk(srcs[s], dsts[s], i);
        for (size_t i = gtid; i < (size_t)2 * 2048 * 32; i += gn) { const int which = (int)(i / (2048 * 32)); const int k = (int)(i / 32) % 2048, c8 = (int)(i % 32) * 8;
            uint4 o = {0u, 0u, 0u, 0u};
            if (c8 < 128) { const float* W = a.in[which ? I_WC1V : I_WC1K] + (size_t)k * 128 + c8; const float4 x = *(const float4*)W, y = *(const float4*)(W + 4); o.x = cvtpk(x.x, x.y); o.y = cvtpk(x.z, x.w); o.z = cvtpk(y.x, y.y); o.w = cvtpk(y.z, y.w); }
            *(uint4*)((bf16_t*)(ws + WS_WC1) + i * 8) = o; }
        for (size_t i = gtid; i < (size_t)2 * 128 * 32; i += gn) { const int which = (int)(i / (128 * 32)); const int k = (int)(i / 32) % 128, c8 = (int)(i % 32) * 8;
            uint4 o = {0u, 0u, 0u, 0u};
            if (c8 < 64) { const float* W = a.in[which ? I_WC2V : I_WC2K] + (size_t)k * 64 + c8; const float4 x = *(const float4*)W, y = *(const float4*)(W + 4); o.x = cvtpk(x.x, x.y); o.y = cvtpk(x.z, x.w); o.z = cvtpk(y.x, y.y); o.w = cvtpk(y.z, y.w); }
            *(uint4*)((bf16_t*)(ws + WS_WC2) + i * 8) = o; }
    }
    {
        const float* W = a.in[I_WIN]; bf16_t* O = (bf16_t*)(ws + WS_WIN);
        for (size_t i = gtid; i < (size_t)1024 * (NWIN / 8); i += gn) {
            const int k = (int)(i / (NWIN / 8)), j = (int)(i % (NWIN / 8)) * 8;
            uint4 o = {0u, 0u, 0u, 0u};
            if (j < 2848) {
                const int sj = (j < 1280) ? j : (j < 2816) ? j + 24 : (j < 2840) ? j - 1536 : j;
                const float4 x = *(const float4*)(W + (size_t)k * 2848 + sj), y = *(const float4*)(W + (size_t)k * 2848 + sj + 4);
                o.x = cvtpk(x.x, x.y); o.y = cvtpk(x.z, x.w); o.z = cvtpk(y.x, y.y); o.w = cvtpk(y.z, y.w);
            }
            *(uint4*)(O + (size_t)k * NWIN + j) = o;
        }
    }
    const int lane = TID() & 63; const int gw = BID() * NWAVE + (TID() >> 6), ngw = gridDim.x * NWAVE;
    {
        const float* X = a.in[I_X]; const float* g = a.in[I_LN1]; bf16_t* XN = (bf16_t*)(ws + WS_XN);
        for (int m = gw; m < NTOK; m += ngw) {
            float4 v[4]; float s = 0.f;
#pragma unroll
            for (int j = 0; j < 4; ++j) { v[j] = *(const float4*)(X + (size_t)m * 1024 + j * 256 + lane * 4); s += v[j].x * v[j].x + v[j].y * v[j].y + v[j].z * v[j].z + v[j].w * v[j].w; }
            const float rstd = rsqrtf(wave_sum(s) * (1.f / 1024.f) + EPS);
#pragma unroll
            for (int j = 0; j < 4; ++j) { const float4 gg = *(const float4*)(g + j * 256 + lane * 4);
                uint2 o; o.x = cvtpk(v[j].x * rstd * gg.x, v[j].y * rstd * gg.y); o.y = cvtpk(v[j].z * rstd * gg.z, v[j].w * rstd * gg.w);
                *(uint2*)(XN + (size_t)m * 1024 + j * 256 + lane * 4) = o; }
        }
    }
    if (gw < 256) {
        const int which = gw >> 7, n = gw & 127; const float* pe = a.in[which ? I_PEV : I_PEK]; const float* w1 = a.in[which ? I_WC1V : I_WC1K];
        float s = 0.f;
#pragma unroll 8
        for (int i = 0; i < 32; ++i) { const int k = lane + 64 * i; s += pe[k] * w1[(size_t)k * 128 + n]; }
        s = wave_sum(s);
        if (lane == 0) ((float*)(ws + WS_BIAS1))[which * 128 + n] = s;
    }
}

DEV void phase_inproj(const Args& a, unsigned char* smem) {
    const bf16_t* XN = (const bf16_t*)(a.ws + WS_XN); const bf16_t* W = (const bf16_t*)(a.ws + WS_WIN);
    bf16_t* PROJ = (bf16_t*)(a.ws + WS_PROJ); float* GN = (float*)(a.ws + WS_GN); float* LS = (float*)(a.ws + WS_LS); const float* bfg = a.in[I_BFG];
    int lane = TID() & 63, wid = TID() >> 6, wr = wid >> 2, wc = wid & 3; (void)wr; (void)wc; (void)lane;
    bool pre = false;
    for (int item = VBID(); item < 64 * 12; item += gridDim.x) {
        int mt, nt; patch_decode(item, 64, 12, mt, nt);
        const int nitem = item + (int)gridDim.x; const bool has_next = nitem < 64 * 12; int mtn = 0, ntn = 0; if (has_next) patch_decode(nitem, 64, 12, mtn, ntn);
        f32x4 acc[8][4];
        auto aoffi = [](int r, int kc) { return (unsigned)(r * 2048 + kc * 16); }; auto boffi = [](int k, int nc) { return (unsigned)(k * (NWIN * 2) + nc * 16); };
        gemm256<true>(smem, 16, XN + (size_t)mt * 256 * 1024, 128u, aoffi, W + nt * 256, (unsigned)(64 * NWIN * 2), boffi, acc, pre,
                      next_tile(has_next, smem, XN + (size_t)mtn * 256 * 1024, aoffi, W + ntn * 256, boffi));
        pre = has_next;
        EPI_IDS();
#pragma unroll
        for (int mi = 0; mi < 8; ++mi) {
            const int gm = mt * 256 + G_ROW(mi); const int b = gm >> 13, t = gm & 8191;
            if (nt < 11) {
#pragma unroll
                for (int np = 0; np < 2; ++np) { const int n0 = G_COL(2 * np); const int hs = nt * 4 + (n0 >> 6), d0 = n0 & 63; const float sc = (hs < 8 || (hs >= 20 && hs < 28)) ? QS : 1.0f;
                    const f32x4 v0 = acc[mi][2 * np], v1 = acc[mi][2 * np + 1]; uint2 oa, ob; oa.x = cvtpk(v0[0] * sc, v0[1] * sc); oa.y = cvtpk(v0[2] * sc, v0[3] * sc); ob.x = cvtpk(v1[0] * sc, v1[1] * sc); ob.y = cvtpk(v1[2] * sc, v1[3] * sc);
                    *(uint4*)(PROJ + (((size_t)(hs * 2 + b)) * 8192 + t) * 64 + PAIR16_COL(d0, d0 + 16)) = pair16(oa, ob); }
            }
#pragma unroll
            for (int ni = 0; ni < 4; ++ni) {
                const int n = G_COL(ni); const f32x4 v = acc[mi][ni];
                if (nt < 11) {
                } else if (n < 24) {
#pragma unroll
                    for (int r = 0; r < 4; ++r) GN[(size_t)gm * 24 + n + r] = sigmoidf_(v[r]);
                } else if (n < 32) {
#pragma unroll
                    for (int r = 0; r < 4; ++r) { const int h = n - 24 + r; LS[((size_t)(b * 8 + h)) * 8192 + t] = logsigmoidf_(v[r] + bfg[h]); }
                }
            }
        }
    }
}

DEV void signal_done(unsigned* flag) {
    asm volatile("s_waitcnt vmcnt(0)" ::: "memory");
    __syncthreads();
    if (TID() == 0) { __builtin_amdgcn_fence(__ATOMIC_RELEASE, "agent"); asm volatile("s_waitcnt vmcnt(0)" ::: "memory"); __hip_atomic_fetch_add(flag, 1u, __ATOMIC_RELAXED, __HIP_MEMORY_SCOPE_AGENT); }
}
DEV void wait_flag(unsigned* flag, unsigned target) {
    if (TID() == 0) { unsigned sp = 0u; while (__hip_atomic_load(flag, __ATOMIC_RELAXED, __HIP_MEMORY_SCOPE_AGENT) < target) { __builtin_amdgcn_s_sleep(4); if (++sp > (1u << 24)) break; }
        __builtin_amdgcn_fence(__ATOMIC_ACQUIRE, "agent"); asm volatile("s_waitcnt vmcnt(0)" ::: "memory"); }
    __syncthreads();
}
constexpr int CW_CUMFLAG = 128, CW_CMPFLAG = 192, CW_GATEFLAG = 256;
DEV void cmp_item(const Args& a, unsigned char* smem, int item) {
    const bf16_t* PROJ = (const bf16_t*)(a.ws + WS_PROJ);
    const int tid = TID(); int lane = tid & 63, wid = tid >> 6, wr = wid >> 2, wc = wid & 3; (void)wr; (void)wc; (void)lane;
    {
        if (item < 16) {
            const int which = item >> 3, b = (item >> 2) & 1, g = (item >> 1) & 1, mt = item & 1;
            const bf16_t* base = PROJ + ((size_t)((8 + 2 * which + g) * 2 + b)) * 8192 * 64;
            const bf16_t* W1 = (const bf16_t*)(a.ws + WS_WC1) + (size_t)which * 2048 * 256;
            const bf16_t* W2 = (const bf16_t*)(a.ws + WS_WC2) + (size_t)which * 128 * 256;
            const float* bias1 = (const float*)(a.ws + WS_BIAS1) + which * 128;
            bf16_t* HID = (bf16_t*)(a.ws + WS_HID) + ((size_t)(which * 4 + b * 2 + g)) * 512 * 128;
            bf16_t* OUT = (bf16_t*)(a.ws + WS_KC) + ((size_t)(which * 4 + b * 2 + g)) * 512 * 64;
            f32x4 acc[8][4];
            gemm256s<true>(smem, 32, base, 128u, [&](int r, int kc) { int c = mt * 256 + r; c = c > 510 ? 510 : c; return (unsigned)(c * 2048 + kc * 16); },
                          W1, 64u * 512u, [&](int k, int nc) { return (unsigned)(k * 512 + nc * 16); }, acc);
        EPI_IDS();
            if (wc < 2) {
#pragma unroll
                for (int mi = 0; mi < 8; ++mi) { const int c = mt * 256 + wr * 128 + mi * 16 + (lane & 15);
#pragma unroll
                    for (int ni = 0; ni < 4; ++ni) { const int n = wc * 64 + ni * 16 + 4 * (lane >> 4); const f32x4 v = acc[mi][ni]; const float4 bb = *(const float4*)(bias1 + n);
                        uint2 o; o.x = cvtpk(gelu_tanh(v[0] + bb.x), gelu_tanh(v[1] + bb.y)); o.y = cvtpk(gelu_tanh(v[2] + bb.z), gelu_tanh(v[3] + bb.w));
                        *(uint2*)(HID + (size_t)c * 128 + n) = o; } }
            }
            __syncthreads();
            gemm256s<true>(smem, 2, HID + (size_t)mt * 256 * 128, 128u, [&](int r, int kc) { return (unsigned)(r * 256 + kc * 16); },
                          W2, 64u * 512u, [&](int k, int nc) { return (unsigned)(k * 512 + nc * 16); }, acc);
        EPI_IDS();
            if (wc == 0) {
#pragma unroll
                for (int mi = 0; mi < 8; ++mi) { const int c = mt * 256 + wr * 128 + mi * 16 + (lane & 15);
#pragma unroll
                    for (int ni = 0; ni < 4; ++ni) { const int n = ni * 16 + 4 * (lane >> 4); const f32x4 v = acc[mi][ni];
                        uint2 o; o.x = cvtpk(v[0], v[1]); o.y = cvtpk(v[2], v[3]);
                        if (c >= 511) { o.x = 0u; o.y = 0u; }
                        *(uint2*)(OUT + (size_t)c * 64 + n) = o; } }
            }
            signal_done((unsigned*)(a.ws + WS_CTL) + CW_CMPFLAG);
        } else {
            const int bh = item - 16; const float* LS = (const float*)(a.ws + WS_LS) + (size_t)bh * 8192; float* CUM = (float*)(a.ws + WS_CUM) + (size_t)bh * 8192;
            float* sc = (float*)smem;
            float v[16]; float s = 0.f;
#pragma unroll
            for (int j = 0; j < 4; ++j) { const float4 x = *(const float4*)(LS + tid * 16 + j * 4); v[4 * j] = x.x; v[4 * j + 1] = x.y; v[4 * j + 2] = x.z; v[4 * j + 3] = x.w; }
#pragma unroll
            for (int j = 0; j < 16; ++j) { s += v[j]; v[j] = s; }
            sc[tid] = s; __syncthreads();
            if (tid == 0) { float run = 0.f; for (int i = 0; i < NTHR; ++i) { const float x = sc[i]; sc[i] = run; run += x; } }
            __syncthreads();
            const float off = sc[tid];
#pragma unroll
            for (int j = 0; j < 4; ++j) { float4 o = {v[4 * j] + off, v[4 * j + 1] + off, v[4 * j + 2] + off, v[4 * j + 3] + off}; *(float4*)(CUM + tid * 16 + j * 4) = o; }
            signal_done((unsigned*)(a.ws + WS_CTL) + CW_CUMFLAG + bh);
        }
    }
}

constexpr int AT_STAGE = 16384;
constexpr int AT_BIAS_OFF = 3 * AT_STAGE;
constexpr int AT_IMP_OFF = AT_BIAS_OFF + 1024;
constexpr int AT_SEL_OFF = AT_IMP_OFF + 65536;
constexpr int AT_WUN_OFF = AT_SEL_OFF + 1024;
constexpr int AT_UCNT_OFF = AT_WUN_OFF + 128;
constexpr int AT_ULIST_OFF = AT_UCNT_OFF + 16;
constexpr int AT_ITEM_OFF = AT_ULIST_OFF + 128;
static_assert(AT_ITEM_OFF + 16 <= GEMM_LDS, "attention LDS map");
#define NEG_INF (-__builtin_inff())

#define KV_DECL uint4 rk0_, rv0_
#define KV_GLOAD(Kt, Vt) do { rk0_ = *(const uint4*)((Kt) + tid * 8); rv0_ = *(const uint4*)((Vt) + tid * 8); } while (0)
#define KV_LSTORE(stp) do { unsigned char* st_ = (stp); const int key = tid >> 3, ch = tid & 7; \
      *(uint4*)(st_ + key * 128 + ((ch ^ (key & 7)) << 4)) = rk0_; \
      *(uint4*)(st_ + 8192 + key * 128 + ((((ch >> 2) ^ ((key >> 1) & 1))) << 6) + ((ch & 3) << 4)) = rv0_; } while (0)
template <bool FULL>
DEV void qk_tile(const unsigned char* Kst, const bf16x8 (&qf)[4], f32x16& p0, f32x16& p1, int lane) {
    const int key = lane & 31, hi = lane >> 5;
    if (FULL) {
        bf16x8 k0[4], k1[4];
#pragma unroll
        for (int ks = 0; ks < 4; ++ks) { const int ch = 2 * ks + hi; const int off = key * 128 + ((ch ^ (key & 7)) << 4);
            k0[ks] = *(const bf16x8*)(Kst + off); k1[ks] = *(const bf16x8*)(Kst + off + 32 * 128); }
        __builtin_amdgcn_sched_barrier(0);
#pragma unroll
        for (int ks = 0; ks < 4; ++ks) {
            p0 = __builtin_amdgcn_mfma_f32_32x32x16_bf16(k0[ks], qf[ks], p0, 0, 0, 0);
            p1 = __builtin_amdgcn_mfma_f32_32x32x16_bf16(k1[ks], qf[ks], p1, 0, 0, 0); }
    } else {
        bf16x8 kk[4];
#pragma unroll
        for (int ks = 0; ks < 4; ++ks) { const int ch = 2 * ks + hi; kk[ks] = *(const bf16x8*)(Kst + key * 128 + ((ch ^ (key & 7)) << 4)); }
        __builtin_amdgcn_sched_barrier(0);
#pragma unroll
        for (int ks = 0; ks < 4; ++ks) p0 = __builtin_amdgcn_mfma_f32_32x32x16_bf16(kk[ks], qf[ks], p0, 0, 0, 0);
        __builtin_amdgcn_sched_barrier(0);
#pragma unroll
        for (int ks = 0; ks < 4; ++ks) { const int ch = 2 * ks + hi; kk[ks] = *(const bf16x8*)(Kst + key * 128 + ((ch ^ (key & 7)) << 4) + 32 * 128); }
        __builtin_amdgcn_sched_barrier(0);
#pragma unroll
        for (int ks = 0; ks < 4; ++ks) p1 = __builtin_amdgcn_mfma_f32_32x32x16_bf16(kk[ks], qf[ks], p1, 0, 0, 0);
    }
}
template <bool FULL>
DEV void pv_tile(const unsigned char* Vst, const f32x16& p0, const f32x16& p1, f32x16 (&o)[2], int lane) {
    const int hi = lane >> 5, i = lane & 15, gg = (lane >> 4) & 1;
    const int q = i >> 2; const int sw = (q >> 1) & 1;
    bf16x8 pa[4];
#pragma unroll
    for (int s = 0; s < 4; ++s) { const f32x16& p = (s < 2) ? p0 : p1; const int b = (s & 1) * 8;
        unsigned w[4];
#pragma unroll
        for (int j = 0; j < 4; ++j) w[j] = cvtpk(p[b + 2 * j], p[b + 2 * j + 1]);
        typedef unsigned u32x4_t __attribute__((ext_vector_type(4)));
        u32x4_t ww = {w[0], w[1], w[2], w[3]}; pa[s] = __builtin_bit_cast(bf16x8, ww); }
    constexpr int NB = FULL ? 1 : 2, SB = FULL ? 4 : 2;
#pragma unroll
    for (int bt = 0; bt < NB; ++bt) {
        s16x4 vlo[SB][2], vhi[SB][2];
#pragma unroll
        for (int s_ = 0; s_ < SB; ++s_)
#pragma unroll
            for (int dh = 0; dh < 2; ++dh) { const int s = bt * SB + s_; const int row0 = 16 * s + 4 * hi + q;
                const unsigned char* p = Vst + row0 * 128 + ((dh ^ sw) << 6) + gg * 32 + (i & 3) * 8;
                vlo[s_][dh] = tr_read(p); vhi[s_][dh] = tr_read(p + 8 * 128); }
        __builtin_amdgcn_sched_barrier(0);
#pragma unroll
        for (int s_ = 0; s_ < SB; ++s_)
#pragma unroll
            for (int dh = 0; dh < 2; ++dh) { const int s = bt * SB + s_;
                const bf16x8 vf = {vlo[s_][dh][0], vlo[s_][dh][1], vlo[s_][dh][2], vlo[s_][dh][3], vhi[s_][dh][0], vhi[s_][dh][1], vhi[s_][dh][2], vhi[s_][dh][3]};
                o[dh] = __builtin_amdgcn_mfma_f32_32x32x16_bf16(vf, pa[s], o[dh], 0, 0, 0); }
        __builtin_amdgcn_sched_barrier(0);
    }
}
DEV float rowmax32(const f32x16& p0, const f32x16& p1) {
    float a = fmaxf(p0[0], p1[0]), b = fmaxf(p0[1], p1[1]);
#pragma unroll
    for (int r = 2; r < 16; r += 2) { a = fmaxf(fmaxf(a, p0[r]), p1[r]); b = fmaxf(fmaxf(b, p0[r + 1]), p1[r + 1]); }
    return pair_max(fmaxf(a, b));
}
DEV void softmax_step(f32x16& p0, f32x16& p1, float& m, float& l, f32x16 (&o)[2]) {
    const float mt = rowmax32(p0, p1); const float mn = fmaxf(m, mt); const float alpha = __builtin_amdgcn_exp2f(m - mn);
    float rs = 0.f;
#pragma unroll
    for (int r = 0; r < 16; ++r) { p0[r] = __builtin_amdgcn_exp2f(p0[r] - mn); p1[r] = __builtin_amdgcn_exp2f(p1[r] - mn); rs += p0[r] + p1[r]; }
    rs = pair_sum(rs);
    l = l * alpha + rs; m = mn;
    if (__any(alpha != 1.0f)) { o[0] *= alpha; o[1] *= alpha; }
}
DEV void softmax_step_nosum(f32x16& p0, f32x16& p1, float& m, f32x16 (&o)[2], f32x16& lacc) {
    const float mt = rowmax32(p0, p1); const float mn = fmaxf(m, mt); const float alpha = __builtin_amdgcn_exp2f(m - mn);
#pragma unroll
    for (int r = 0; r < 16; ++r) { p0[r] = __builtin_amdgcn_exp2f(p0[r] - mn); p1[r] = __builtin_amdgcn_exp2f(p1[r] - mn); }
    m = mn;
    if (__any(alpha != 1.0f)) { o[0] *= alpha; o[1] *= alpha; lacc *= alpha; }
}
DEV void pv_tile_sum(const unsigned char* Vst, const f32x16& p0, const f32x16& p1, f32x16 (&o)[2], f32x16& lacc, int lane) {
    const int hi = lane >> 5, i = lane & 15, gg = (lane >> 4) & 1;
    const int q = i >> 2; const int sw = (q >> 1) & 1;
    bf16x8 pa[4];
#pragma unroll
    for (int s = 0; s < 4; ++s) { const f32x16& p = (s < 2) ? p0 : p1; const int b = (s & 1) * 8;
        unsigned w[4];
#pragma unroll
        for (int j = 0; j < 4; ++j) w[j] = cvtpk(p[b + 2 * j], p[b + 2 * j + 1]);
        typedef unsigned u32x4_t __attribute__((ext_vector_type(4)));
        u32x4_t ww = {w[0], w[1], w[2], w[3]}; pa[s] = __builtin_bit_cast(bf16x8, ww); }
    const bf16x8 ones = {0x3f80, 0x3f80, 0x3f80, 0x3f80, 0x3f80, 0x3f80, 0x3f80, 0x3f80};
#pragma unroll
    for (int bt = 0; bt < 2; ++bt) {
        s16x4 vlo[2][2], vhi[2][2];
#pragma unroll
        for (int s_ = 0; s_ < 2; ++s_)
#pragma unroll
            for (int dh = 0; dh < 2; ++dh) { const int s = bt * 2 + s_; const int row0 = 16 * s + 4 * hi + q;
                const unsigned char* p = Vst + row0 * 128 + ((dh ^ sw) << 6) + gg * 32 + (i & 3) * 8;
                vlo[s_][dh] = tr_read(p); vhi[s_][dh] = tr_read(p + 8 * 128); }
        __builtin_amdgcn_sched_barrier(0);
#pragma unroll
        for (int s_ = 0; s_ < 2; ++s_) { const int s = bt * 2 + s_;
            lacc = __builtin_amdgcn_mfma_f32_32x32x16_bf16(ones, pa[s], lacc, 0, 0, 0);
#pragma unroll
            for (int dh = 0; dh < 2; ++dh) {
                const bf16x8 vf = {vlo[s_][dh][0], vlo[s_][dh][1], vlo[s_][dh][2], vlo[s_][dh][3], vhi[s_][dh][0], vhi[s_][dh][1], vhi[s_][dh][2], vhi[s_][dh][3]};
                o[dh] = __builtin_amdgcn_mfma_f32_32x32x16_bf16(vf, pa[s], o[dh], 0, 0, 0); } }
        __builtin_amdgcn_sched_barrier(0);
    }
}
template <int STRIDE> DEV void mask_tile(f32x16& p0, f32x16& p1, int kpos0, int lo, int hi_lim, int hi) {
#pragma unroll
    for (int r = 0; r < 16; ++r) { const int kp = kpos0 + STRIDE * crow(r, hi);
        if (kp < lo || kp > hi_lim) p0[r] = NEG_INF;
        const int kp1 = kp + 32 * STRIDE; if (kp1 < lo || kp1 > hi_lim) p1[r] = NEG_INF; }
}
template <int STRIDE> DEV void alibi_init(f32x16& p0, f32x16& p1, float slope2, int kpos0, int tref, int hi) {
    const float base = slope2 * (float)(kpos0 - tref + STRIDE * 4 * hi);
#pragma unroll
    for (int r = 0; r < 16; ++r) { const float c = (float)(STRIDE * ((r & 3) + 8 * (r >> 2))); p0[r] = fmaf(slope2, c, base); p1[r] = fmaf(slope2, c + (float)(32 * STRIDE), base); }
}
template <class Src, class Body, class NSrc>
DEV int kv_pipeline(unsigned char* smem, int n, const Src& src, const Body& body, int par, bool pre, bool has_next, const NSrc& nsrc) {
    KV_DECL; const int tid = TID(); const bf16_t *kp, *vp;
    if (!pre) { src(0, kp, vp); KV_GLOAD(kp, vp); KV_LSTORE(smem + par * AT_STAGE); __syncthreads(); }
    for (int j = 0; j < n; ++j) {
        const bool more = j + 1 < n;
        src(more ? j + 1 : j, kp, vp); if (!more && has_next) nsrc(kp, vp);
        KV_GLOAD(kp, vp);
        body(j, smem + ((par + j) & 1) * AT_STAGE);
        KV_LSTORE(smem + ((par + j + 1) & 1) * AT_STAGE);
        __syncthreads();
    }
    return (par + n) & 1;
}
struct NoSrc { DEV void operator()(const bf16_t*&, const bf16_t*&) const {} };

constexpr int CV_PER_STEP = 373; constexpr int CV_NUP = 32 * 1024 * 2048 / 8, CV_NDN = 32 * 1024 * 1024 / 8;
static_assert((long long)33792 * CV_PER_STEP >= (long long)CV_NUP + CV_NDN, "conversion coverage");
DEV void fox_item(const Args& a, unsigned char* smem, int fi, int b, int h, int qb) {
    const int tid = TID(), lane = tid & 63, wid = tid >> 6, r32 = lane & 31, hi = lane >> 5;
    const bf16_t* PROJ = (const bf16_t*)(a.ws + WS_PROJ);
    const bf16_t* Q = PROJ + ((size_t)((20 + h) * 2 + b)) * 8192 * 64; const bf16_t* K = PROJ + ((size_t)((28 + h) * 2 + b)) * 8192 * 64; const bf16_t* V = PROJ + ((size_t)((36 + h) * 2 + b)) * 8192 * 64;
    const float* CUM = (const float*)(a.ws + WS_CUM) + (size_t)(b * 8 + h) * 8192;
    const int q0 = qb * 256; const int qrow = q0 + 32 * wid + r32;
    bf16x8 qf[4];
#pragma unroll
    for (int ks = 0; ks < 4; ++ks) qf[ks] = *(const bf16x8*)(Q + (size_t)qrow * 64 + 16 * ks + 8 * hi);
    const float cref = CUM[q0];
    const int ntiles = 4 * qb + 4; const int jmax_w = (q0 + 32 * wid + 31) >> 6; const int jmask_w = (q0 + 32 * wid) >> 6;
    f32x16 o[2]; o[0] = (f32x16){}; o[1] = (f32x16){}; f32x16 lacc = (f32x16){}; float m = -1e30f;
    float* biasL = (float*)(smem + AT_BIAS_OFF);
    const int gq_ = fi >> 4; const int sidx0 = 16 * (128 * gq_ - 2 * gq_ * (gq_ - 1)) + (fi & 15) * (128 - 4 * gq_);
    bf16_t* cvdA = nullptr; bf16_t* cvdB = nullptr; float4 cvaA, cvbA, cvaB, cvbB;
    KV_DECL; float breg = 0.f;
#define TJ(s_) (ntiles - 1 - (s_))
#define CV_ADDR(st_, SRC, DST) do { int c_ = (sidx0 + (st_)) * CV_PER_STEP + (tid < CV_PER_STEP ? tid : CV_PER_STEP - 1); c_ = c_ < CV_NUP + CV_NDN ? c_ : CV_NUP + CV_NDN - 1; \
        const bool up_ = c_ < CV_NUP; const int cc_ = up_ ? c_ : c_ - CV_NUP; SRC = (up_ ? a.in[I_WUP] : a.in[I_WDN]) + (size_t)cc_ * 8; DST = (bf16_t*)(a.ws + (up_ ? WS_WUP : WS_WDN)) + (size_t)cc_ * 8; } while (0)
    { const float* cvs_; CV_ADDR(0, cvs_, cvdB); cvaB = *(const float4*)cvs_; cvbB = *(const float4*)(cvs_ + 4); }
    KV_GLOAD(K + (size_t)TJ(0) * 4096, V + (size_t)TJ(0) * 4096); breg = CUM[TJ(0) * 64 + lane];
    KV_LSTORE(smem); biasL[lane] = (cref - breg) * LOG2E;
    KV_GLOAD(K + (size_t)TJ(1) * 4096, V + (size_t)TJ(1) * 4096); breg = CUM[TJ(1) * 64 + lane];
    KV_LSTORE(smem + AT_STAGE); biasL[64 + lane] = (cref - breg) * LOG2E;
    __syncthreads();
#define FOX_QK(P0, P1, jj, sj) do { const float* bl_ = biasL + (sj) * 64; \
        _Pragma("unroll") for (int g4 = 0; g4 < 4; ++g4) { const float4 x_ = *(const float4*)(bl_ + 8 * g4 + 4 * hi), y_ = *(const float4*)(bl_ + 32 + 8 * g4 + 4 * hi); \
            P0[4 * g4] = x_.x; P0[4 * g4 + 1] = x_.y; P0[4 * g4 + 2] = x_.z; P0[4 * g4 + 3] = x_.w; P1[4 * g4] = y_.x; P1[4 * g4 + 1] = y_.y; P1[4 * g4 + 2] = y_.z; P1[4 * g4 + 3] = y_.w; } \
        qk_tile<true>(smem + (sj) * AT_STAGE, qf, P0, P1, lane); \
        if ((jj) >= jmask_w) mask_tile<1>(P0, P1, 64 * (jj), -1, qrow, hi); } while (0)
#define FOX_STEP(CUR0, CUR1, NXT0, NXT1, j, CVD_LD, CVA_LD, CVB_LD, CVD_ST, CVA_ST, CVB_ST) do { \
        const int s_cur = (j) % 3, s_nxt = ((j) + 1) % 3, s_ld = ((j) + 2) % 3; const int tl_ = TJ((j) + 2) < 0 ? 0 : TJ((j) + 2);     \
        KV_GLOAD(K + (size_t)tl_ * 4096, V + (size_t)tl_ * 4096); breg = CUM[tl_ * 64 + lane]; \
        { const float* cvs_; CV_ADDR(j, cvs_, CVD_LD); CVA_LD = *(const float4*)cvs_; CVB_LD = *(const float4*)(cvs_ + 4); } \
        if ((j) + 1 < ntiles && TJ((j) + 1) <= jmax_w) FOX_QK(NXT0, NXT1, TJ((j) + 1), s_nxt); \
        __builtin_amdgcn_sched_barrier(0); \
        if (TJ(j) <= jmax_w) { softmax_step_nosum(CUR0, CUR1, m, o, lacc); pv_tile_sum(smem + s_cur * AT_STAGE + 8192, CUR0, CUR1, o, lacc, lane); } \
        KV_LSTORE(smem + s_ld * AT_STAGE); biasL[s_ld * 64 + lane] = (cref - breg) * LOG2E; \
        { uint4 o_; o_.x = cvtpk(CVA_ST.x, CVA_ST.y); o_.y = cvtpk(CVA_ST.z, CVA_ST.w); o_.z = cvtpk(CVB_ST.x, CVB_ST.y); o_.w = cvtpk(CVB_ST.z, CVB_ST.w); *(uint4*)CVD_ST = o_; } \
        __syncthreads(); } while (0)
    f32x16 pA0, pA1, pB0, pB1;
    if (TJ(0) <= jmax_w) FOX_QK(pA0, pA1, TJ(0), 0);
    for (int j = 0; j < ntiles; j += 2) {
        FOX_STEP(pA0, pA1, pB0, pB1, j, cvdA, cvaA, cvbA, cvdB, cvaB, cvbB);
        FOX_STEP(pB0, pB1, pA0, pA1, j + 1, cvdB, cvaB, cvbB, cvdA, cvaA, cvbA);
    }
    { uint4 o_; o_.x = cvtpk(cvaB.x, cvaB.y); o_.y = cvtpk(cvaB.z, cvaB.w); o_.z = cvtpk(cvbB.x, cvbB.y); o_.w = cvtpk(cvbB.z, cvbB.w); *(uint4*)cvdB = o_; }
#undef CV_ADDR
#undef FOX_QK
#undef FOX_STEP
#undef TJ
    const float inv = 1.0f / lacc[0]; float ss = 0.f;
    const size_t token = (size_t)b * 8192 + qrow;
    bf16_t* O = (bf16_t*)(a.ws + WS_OFOX) + token * 512 + h * 64;
#pragma unroll
    for (int dh = 0; dh < 2; ++dh)
#pragma unroll
        for (int g4 = 0; g4 < 4; ++g4) { const float v0 = o[dh][4 * g4] * inv, v1 = o[dh][4 * g4 + 1] * inv, v2 = o[dh][4 * g4 + 2] * inv, v3 = o[dh][4 * g4 + 3] * inv;
            ss += v0 * v0 + v1 * v1 + v2 * v2 + v3 * v3; uint2 w; w.x = cvtpk(v0, v1); w.y = cvtpk(v2, v3); *(uint2*)(O + 32 * dh + 8 * g4 + 4 * hi) = w; }
    ss = pair_sum(ss);
    if (hi == 0) ((float*)(a.ws + WS_SSQ))[token * 16 + 8 + h] = ss;
}

DEV void nsa_item(const Args& a, unsigned char* smem, int b, int g, int tt) {
    const int tid = TID(), lane = tid & 63, wid = tid >> 6, col = lane & 31, hi = lane >> 5;
    const int t0 = tt * 64, tokw = col >> 2, r = col & 3, h = 4 * g + r; const int tokl = wid * 8 + tokw; const int t = t0 + tokl; const size_t token = (size_t)b * 8192 + t;
    const float slope2 = exp2f(-(float)(h + 1)) * LOG2E;
    const bf16_t* PROJ = (const bf16_t*)(a.ws + WS_PROJ);
    const float* GN = (const float*)(a.ws + WS_GN) + token * 24 + h * 3;
    const int cur = tt; const bool need_topk = cur > 15;
    bf16x8 qf[4];
    { const bf16_t* Q = PROJ + (((size_t)(h * 2 + b)) * 8192 + t) * 64;
#pragma unroll
      for (int ks = 0; ks < 4; ++ks) qf[ks] = *(const bf16x8*)(Q + 16 * ks + 8 * hi); }
    float* impw = (float*)(smem + AT_IMP_OFF) + wid * 2048; float* totw = impw + lane;
    unsigned* selmask = (unsigned*)(smem + AT_SEL_OFF); unsigned* wun = (unsigned*)(smem + AT_WUN_OFF); int* ucnt = (int*)(smem + AT_UCNT_OFF); unsigned char* ulist = smem + AT_ULIST_OFF;
    f32x16 o[2]; float m, l; int par = 0;
    const int tmin_w = t0 + wid * 8, tmax_w = tmin_w + 7;
    {
        const bf16_t* KC = (const bf16_t*)(a.ws + WS_KC) + ((size_t)(0 * 4 + b * 2 + g)) * 512 * 64; const bf16_t* VC = (const bf16_t*)(a.ws + WS_KC) + ((size_t)(1 * 4 + b * 2 + g)) * 512 * 64;
        const int ncv = t0 / 16 + 3; const int nct = (ncv + 63) >> 6;
        auto src = [&](int j, const bf16_t*& kp, const bf16_t*& vp) { kp = KC + (size_t)j * 4096; vp = VC + (size_t)j * 4096; };
        m = -1e30f; l = 0.f;
        auto src0 = [&](const bf16_t*& kp, const bf16_t*& vp) { kp = KC; vp = VC; };
        par = kv_pipeline(smem, nct, src, [&](int j, const unsigned char* st) {
            const int kpos0 = 1024 * j + 31;
            if (kpos0 > tmax_w) return;
            f32x16 p0, p1; alibi_init<16>(p0, p1, slope2, kpos0, t0, hi);
            qk_tile<false>(st, qf, p0, p1, lane);
            if (kpos0 + 16 * 63 > tmin_w) mask_tile<16>(p0, p1, kpos0, -1, t, hi);
            const float mt = rowmax32(p0, p1); const float mn = fmaxf(m, mt); float rs = 0.f;
#pragma unroll
            for (int rr = 0; rr < 16; ++rr) rs += __builtin_amdgcn_exp2f(p0[rr] - mn) + __builtin_amdgcn_exp2f(p1[rr] - mn);
            rs = pair_sum(rs);
            l = l * __builtin_amdgcn_exp2f(m - mn) + rs; m = mn;
        }, 0, false, true, src0);
        const float linv = l > 0.f ? 1.0f / l : 0.f;
        if (need_topk) { for (int i = lane; i < 8 * 129; i += 64) impw[i] = 0.f; }
        o[0] = (f32x16){}; o[1] = (f32x16){};
        const bf16_t* KS0 = PROJ + ((size_t)((12 + g) * 2 + b)) * 8192 * 64 + (size_t)cur * 4096; const bf16_t* VS0 = PROJ + ((size_t)((14 + g) * 2 + b)) * 8192 * 64 + (size_t)cur * 4096;
        par = kv_pipeline(smem, nct, src, [&](int j, const unsigned char* st) {
            const int kpos0 = 1024 * j + 31;
            if (kpos0 > tmax_w) return;
            f32x16 p0, p1; alibi_init<16>(p0, p1, slope2, kpos0, t0, hi);
            qk_tile<false>(st, qf, p0, p1, lane);
            if (kpos0 + 16 * 63 > tmin_w) mask_tile<16>(p0, p1, kpos0, -1, t, hi);
#pragma unroll
            for (int rr = 0; rr < 16; ++rr) { p0[rr] = __builtin_amdgcn_exp2f(p0[rr] - m) * linv; p1[rr] = __builtin_amdgcn_exp2f(p1[rr] - m) * linv; }
            if (need_topk) {
#pragma unroll
                for (int half = 0; half < 2; ++half)
#pragma unroll
                    for (int g4 = 0; g4 < 4; ++g4) { const f32x16& p = half ? p1 : p0;
                        float ms = (p[4 * g4] + p[4 * g4 + 1]) + (p[4 * g4 + 2] + p[4 * g4 + 3]); float ls = p[4 * g4 + 3];
                        ms = quad_sum(ms); ls = quad_sum(ls);
                        const int n = 16 * j + 8 * half + 2 * g4 + hi;
                        if (r == 0) { atomicAdd(&impw[tokw * 129 + n], ms); atomicAdd(&impw[tokw * 129 + n + 1], ls); } }
            }
            pv_tile<false>(st + 8192, p0, p1, o, lane);
        }, par, true, true, [&](const bf16_t*& kp, const bf16_t*& vp) { kp = KS0; vp = VS0; });
    }
    {
        unsigned un0 = 0u, un1 = 0u, un2 = 0u, un3 = 0u;
        if (need_topk) {
#define TK_INIT(V0, V1, M0, M1, M2, M3, tk_) float V0 = impw[(tk_) * 129 + lane], V1 = impw[(tk_) * 129 + 64 + lane]; \
                V0 = (lane >= 1 && lane <= cur - 2) ? V0 : -1.0f; V1 = (lane + 64 <= cur - 2) ? V1 : -1.0f; unsigned M0 = 1u, M1 = 0u, M2 = 0u, M3 = 0u; \
                TK_SET(M0, M1, M2, M3, cur); TK_SET(M0, M1, M2, M3, cur - 1)
#define TK_SET(M0, M1, M2, M3, n_) do { const int n__ = (n_); const unsigned bit__ = 1u << (n__ & 31); const int w__ = n__ >> 5; M0 |= (w__ == 0) ? bit__ : 0u; M1 |= (w__ == 1) ? bit__ : 0u; M2 |= (w__ == 2) ? bit__ : 0u; M3 |= (w__ == 3) ? bit__ : 0u; } while (0)
#define TK_STEP(V0, V1, M0, M1, M2, M3) do { const float mx_ = wave_max_u(fmaxf(V0, V1)); const unsigned long long b0_ = __ballot(V0 == mx_), b1_ = __ballot(V1 == mx_); \
                const int n_ = b0_ ? (__ffsll((long long)b0_) - 1) : (63 + __ffsll((long long)b1_)); const bool hit_ = lane == (n_ & 63); \
                V0 = (hit_ && n_ < 64) ? -1.0f : V0; V1 = (hit_ && n_ >= 64) ? -1.0f : V1; TK_SET(M0, M1, M2, M3, n_); } while (0)
            for (int tk = 0; tk < 8; tk += 4) {
                TK_INIT(a0_, a1_, ma0, ma1, ma2, ma3, tk); TK_INIT(b0v, b1v, mb0, mb1, mb2, mb3, tk + 1); TK_INIT(c0v, c1v, mc0, mc1, mc2, mc3, tk + 2); TK_INIT(d0v, d1v, md0, md1, md2, md3, tk + 3);
                for (int it = 0; it < 13; ++it) { TK_STEP(a0_, a1_, ma0, ma1, ma2, ma3); TK_STEP(b0v, b1v, mb0, mb1, mb2, mb3); TK_STEP(c0v, c1v, mc0, mc1, mc2, mc3); TK_STEP(d0v, d1v, md0, md1, md2, md3); }
                if (lane == 0) { unsigned* sm_ = selmask + (wid * 8 + tk) * 4; sm_[0] = ma0; sm_[1] = ma1; sm_[2] = ma2; sm_[3] = ma3; sm_[4] = mb0; sm_[5] = mb1; sm_[6] = mb2; sm_[7] = mb3;
                    sm_[8] = mc0; sm_[9] = mc1; sm_[10] = mc2; sm_[11] = mc3; sm_[12] = md0; sm_[13] = md1; sm_[14] = md2; sm_[15] = md3; }
                un0 |= ma0 | mb0 | mc0 | md0; un1 |= ma1 | mb1 | mc1 | md1; un2 |= ma2 | mb2 | mc2 | md2; un3 |= ma3 | mb3 | mc3 | md3;
            }
#undef TK_INIT
#undef TK_SET
#undef TK_STEP
        } else {
            const unsigned full = (2u << cur) - 1u;
            un0 = full;
            if (lane < 8) { unsigned* sm_ = selmask + (wid * 8 + lane) * 4; sm_[0] = full; sm_[1] = 0u; sm_[2] = 0u; sm_[3] = 0u; }
        }
        if (lane == 0) { wun[wid * 4] = un0; wun[wid * 4 + 1] = un1; wun[wid * 4 + 2] = un2; wun[wid * 4 + 3] = un3; }
        __syncthreads();
        if (tid == 0) { int c = 0;
            for (int w = 0; w < 4; ++w) { unsigned u = 0u; for (int ww = 0; ww < NWAVE; ++ww) u |= wun[ww * 4 + w]; for (int bb = 0; bb < 32; ++bb) if ((u >> bb) & 1u) ulist[c++] = (unsigned char)(w * 32 + bb); }
            ucnt[0] = c; }
        __syncthreads();
    }
    { const float g0 = GN[0];
#pragma unroll
      for (int rr = 0; rr < 16; ++rr) { totw[rr * 64] = o[0][rr] * g0; totw[(16 + rr) * 64] = o[1][rr] * g0; } }
    {
        const bf16_t* KS = PROJ + ((size_t)((12 + g) * 2 + b)) * 8192 * 64; const bf16_t* VS = PROJ + ((size_t)((14 + g) * 2 + b)) * 8192 * 64;
        const int nu = ucnt[0];
        m = -1e30f; f32x16 lacc = (f32x16){}; o[0] = (f32x16){}; o[1] = (f32x16){};
        const bf16_t* KW0 = PROJ + ((size_t)((16 + g) * 2 + b)) * 8192 * 64 + (size_t)cur * 4096; const bf16_t* VW0 = PROJ + ((size_t)((18 + g) * 2 + b)) * 8192 * 64 + (size_t)cur * 4096;
        par = kv_pipeline(smem, nu, [&](int j, const bf16_t*& kp, const bf16_t*& vp) { const int n = ulist[nu - 1 - j]; kp = KS + (size_t)n * 4096; vp = VS + (size_t)n * 4096; },
            [&](int j, const unsigned char* st) {
                const int n = ulist[nu - 1 - j];
                if (!((wun[wid * 4 + (n >> 5)] >> (n & 31)) & 1u)) return;
                const bool sel = (selmask[tokl * 4 + (n >> 5)] >> (n & 31)) & 1u;
                f32x16 p0, p1; alibi_init<1>(p0, p1, slope2, 64 * n, t0, hi);
                qk_tile<false>(st, qf, p0, p1, lane);
                if (n == cur || !__all(sel)) mask_tile<1>(p0, p1, 64 * n, -1, sel ? t : -1, hi);
                softmax_step_nosum(p0, p1, m, o, lacc);
                pv_tile_sum(st + 8192, p0, p1, o, lacc, lane);
            }, par, true, true, [&](const bf16_t*& kp, const bf16_t*& vp) { kp = KW0; vp = VW0; });
        const float g1 = GN[1] / fmaxf(lacc[0], 1e-30f);
#pragma unroll
        for (int rr = 0; rr < 16; ++rr) { totw[rr * 64] += o[0][rr] * g1; totw[(16 + rr) * 64] += o[1][rr] * g1; }
    }
    {
        const bf16_t* KW = PROJ + ((size_t)((16 + g) * 2 + b)) * 8192 * 64; const bf16_t* VW = PROJ + ((size_t)((18 + g) * 2 + b)) * 8192 * 64;
        const int jlo = (t0 - 511) > 0 ? ((t0 - 511) >> 6) : 0; const int jhi = cur;
        m = -1e30f; f32x16 lacc = (f32x16){}; o[0] = (f32x16){}; o[1] = (f32x16){};
        (void)kv_pipeline(smem, jhi - jlo + 1, [&](int j, const bf16_t*& kp, const bf16_t*& vp) { kp = KW + (size_t)(jhi - j) * 4096; vp = VW + (size_t)(jhi - j) * 4096; },
            [&](int j, const unsigned char* st) {
                const int kpos0 = 64 * (jhi - j);
                if (kpos0 > tmax_w || kpos0 + 63 < tmin_w - 511) return;
                f32x16 p0, p1; alibi_init<1>(p0, p1, slope2, kpos0, t0, hi);
                qk_tile<false>(st, qf, p0, p1, lane);
                if (kpos0 < tmax_w - 511 || kpos0 + 63 > tmin_w) mask_tile<1>(p0, p1, kpos0, t - 511, t, hi);
                softmax_step_nosum(p0, p1, m, o, lacc);
                pv_tile_sum(st + 8192, p0, p1, o, lacc, lane);
            }, par, true, false, NoSrc());
        const float g2 = GN[2] / fmaxf(lacc[0], 1e-30f);
#pragma unroll
        for (int rr = 0; rr < 16; ++rr) { o[0][rr] = totw[rr * 64] + o[0][rr] * g2; o[1][rr] = totw[(16 + rr) * 64] + o[1][rr] * g2; }
    }
    {
        float ss = 0.f; bf16_t* O = (bf16_t*)(a.ws + WS_ONSA) + token * 512 + h * 64;
#pragma unroll
        for (int dh = 0; dh < 2; ++dh)
#pragma unroll
            for (int g4 = 0; g4 < 4; ++g4) { const float v0 = o[dh][4 * g4], v1 = o[dh][4 * g4 + 1], v2 = o[dh][4 * g4 + 2], v3 = o[dh][4 * g4 + 3];
                ss += v0 * v0 + v1 * v1 + v2 * v2 + v3 * v3; uint2 w; w.x = cvtpk(v0, v1); w.y = cvtpk(v2, v3); *(uint2*)(O + 32 * dh + 8 * g4 + 4 * hi) = w; }
        ss = pair_sum(ss);
        if (hi == 0) ((float*)(a.ws + WS_SSQ))[token * 16 + h] = ss;
    }
}
#ifndef PROBE_DUP
#define PROBE_DUP 0
#endif
DEV void phase_att(const Args& a, unsigned char* smem) {
    int* qctr = (int*)(a.ws + WS_CTL) + 64; int* sitem = (int*)(smem + AT_ITEM_OFF);
    unsigned* ctl = (unsigned*)(a.ws + WS_CTL); unsigned* seen = (unsigned*)(smem + AT_ITEM_OFF + 8);
    if (TID() == 0) seen[0] = 0u;
    for (;;) {
        if (TID() == 0) sitem[0] = atomicAdd(qctr, 1);
        __syncthreads();
        const int item = sitem[0];
        __syncthreads();
        if (item >= 32 + 1024) break;
        if (item < 16) cmp_item(a, smem, 16 + item);
        else if (item < 32) cmp_item(a, smem, item - 16);
        else if (item < 32 + 512) { const int fi = item - 32; const int qb = 31 - (fi >> 4), bh = fi & 15; if (!((seen[0] >> bh) & 1u)) { wait_flag(ctl + CW_CUMFLAG + bh, 1u); if (TID() == 0) seen[0] |= 1u << bh; } fox_item(a, smem, fi, bh >> 3, bh & 7, qb); }
        else { const int idx = item - 32 - 512; const int tt = 127 - (idx >> 2), bg = idx & 3; if (!((seen[0] >> 16) & 1u)) { wait_flag(ctl + CW_CMPFLAG, 16u); if (TID() == 0) seen[0] |= 1u << 16; } nsa_item(a, smem, bg >> 1, bg & 1, tt); }
    }
}

DEV void phase_outproj(const Args& a, unsigned char* smem) {
    const bf16_t* ONSA = (const bf16_t*)(a.ws + WS_ONSA); const bf16_t* OFOX = (const bf16_t*)(a.ws + WS_OFOX); const float* SSQ = (const float*)(a.ws + WS_SSQ);
    const bf16_t* W = (const bf16_t*)(a.ws + WS_WOUT); float* H1 = (float*)(a.ws + WS_H1); const float* X = a.in[I_X];
    float* rs = (float*)(smem + MISC_OFF);
    const int tid = TID(); int lane = tid & 63, wid = tid >> 6, wr = wid >> 2, wc = wid & 3; (void)wr; (void)wc; (void)lane;
    auto aoffo = [](int r, int kc) { return (unsigned)(r * 1024 + kc * 16); }; auto boffo = [](int k, int nc) { return (unsigned)(k * 2048 + nc * 16); };
    for (int item = VBID(); item < 64 * 4; item += gridDim.x) {
        int mt, nt; patch_decode(item, 64, 4, mt, nt);
        gemm_issue0<15>(smem, ONSA + (size_t)mt * 256 * 512, aoffo, W + nt * 256, boffo);
        if (tid < 256) { const float* s_ = SSQ + (size_t)(mt * 256 + tid) * 16; float sn = 0.f, sf = 0.f;
#pragma unroll
            for (int j = 0; j < 8; ++j) { sn += s_[j]; sf += s_[8 + j]; }
            rs[tid * 2] = rsqrtf(sn * (1.f / 512.f) + EPS); rs[tid * 2 + 1] = rsqrtf(sf * (1.f / 512.f) + EPS); }
        asm volatile("s_waitcnt vmcnt(0)" ::: "memory");
        __syncthreads();
        f32x4 acc[8][4];
#pragma unroll
        for (int mi = 0; mi < 8; ++mi) { const size_t gm = (size_t)mt * 256 + G_ROW(mi);
#pragma unroll
            for (int ni = 0; ni < 4; ++ni) { const int n = nt * 256 + G_COL(ni); const float4 x = *(const float4*)(X + gm * 1024 + n); acc[mi][ni] = (f32x4){x.x, x.y, x.z, x.w}; } }
#pragma unroll
        for (int mi = 0; mi < 8; ++mi) { const float ri = 1.0f / rs[(G_ROW(mi)) * 2];
#pragma unroll
            for (int ni = 0; ni < 4; ++ni) acc[mi][ni] *= ri; }
        gemm256<false>(smem, 8, ONSA + (size_t)mt * 256 * 512, 128u, aoffo, W + nt * 256, 64u * 2048u, boffo, acc, true,
                       next_tile(true, smem, OFOX + (size_t)mt * 256 * 512, aoffo, W + (size_t)512 * 1024 + nt * 256, boffo));
        EPI_IDS();
#pragma unroll
        for (int mi = 0; mi < 8; ++mi) { const int rl = G_ROW(mi); const float rat = rs[rl * 2] / rs[rl * 2 + 1];
#pragma unroll
            for (int ni = 0; ni < 4; ++ni) acc[mi][ni] *= rat; }
        gemm256<false>(smem, 8, OFOX + (size_t)mt * 256 * 512, 128u, aoffo, W + (size_t)512 * 1024 + nt * 256, 64u * 2048u, boffo, acc, true);
        EPI_IDS();
#pragma unroll
        for (int mi = 0; mi < 8; ++mi) { const int rl = G_ROW(mi); const size_t gm = (size_t)mt * 256 + rl; const float rf = rs[rl * 2 + 1];
#pragma unroll
            for (int ni = 0; ni < 4; ++ni) { const int n = nt * 256 + G_COL(ni); const f32x4 v = acc[mi][ni] * rf;
                float4 o = {v[0], v[1], v[2], v[3]}; *(float4*)(H1 + gm * 1024 + n) = o; } }
        __syncthreads();
    }
}

DEV void phase_route(const Args& a, unsigned char* smem) {
    const float* H1 = (const float*)(a.ws + WS_H1); bf16_t* XN = (bf16_t*)(a.ws + WS_XN); float* RSTD2 = (float*)(a.ws + WS_RSTD2);
    const float* ln2 = a.in[I_LN2]; const float* wr_ = a.in[I_WR]; const float* br = a.in[I_BR];
    int* CNT = (int*)(a.ws + WS_CTL);
    int* TOPI = (int*)(a.ws + WS_TOPI); int* TOPS = (int*)(a.ws + WS_TOPS); float* TOPW = (float*)(a.ws + WS_TOPW);
    int* TOKOF = (int*)(a.ws + WS_TOKOF); float* ROWW = (float*)(a.ws + WS_ROWW); float* RSDS = (float*)(a.ws + WS_RSDS);
    float* part = (float*)smem;
    float* ssqp = part + 8 * 32 * 33;
    int* lcnt = (int*)(ssqp + 256); int* lbase = lcnt + 32; int* te = lbase + 32; int* trk = te + 256; float* tw = (float*)(trk + 256); float* trs = tw + 256;
    const int tid = TID(), lane = tid & 63, wid = tid >> 6, i32 = lane & 31, kh = lane >> 5; const int tg = wid >> 2, kq = wid & 3;
    for (int item = BID(); item < 256; item += gridDim.x) {
        const int tok = item * 64 + tg * 32 + i32;
        if (tid < 32) lcnt[tid] = 0;
        f32x16 acc = (f32x16){}; float ss = 0.f;
        const float* hrow = H1 + (size_t)tok * 1024 + 256 * kq + 4 * kh; const float* lrow = ln2 + 256 * kq + 4 * kh; bf16_t* xrow = XN + (size_t)tok * 1024 + 256 * kq + 4 * kh;
        const float* wbase = wr_ + (size_t)(256 * kq + 4 * kh) * 32 + i32;
#pragma unroll 4
        for (int c = 0; c < 32; ++c) {
            const float4 hv = *(const float4*)(hrow + 8 * c); const float4 lv = *(const float4*)(lrow + 8 * c);
            ss += hv.x * hv.x + hv.y * hv.y + hv.z * hv.z + hv.w * hv.w;
            const float x0 = hv.x * lv.x, x1 = hv.y * lv.y, x2 = hv.z * lv.z, x3 = hv.w * lv.w;
            uint2 o; o.x = cvtpk(x0, x1); o.y = cvtpk(x2, x3); *(uint2*)(xrow + 8 * c) = o;
            const float* wp = wbase + (size_t)(8 * c) * 32;
            const float w0 = wp[0], w1 = wp[32], w2 = wp[64], w3 = wp[96];
            acc = __builtin_amdgcn_mfma_f32_32x32x2f32(x0, w0, acc, 0, 0, 0);
            acc = __builtin_amdgcn_mfma_f32_32x32x2f32(x1, w1, acc, 0, 0, 0);
            acc = __builtin_amdgcn_mfma_f32_32x32x2f32(x2, w2, acc, 0, 0, 0);
            acc = __builtin_amdgcn_mfma_f32_32x32x2f32(x3, w3, acc, 0, 0, 0);
        }
        ss = pair_sum(ss);
        if (kh == 0) ssqp[wid * 32 + i32] = ss;
#pragma unroll
        for (int r = 0; r < 16; ++r) part[(wid * 32 + crow(r, kh)) * 33 + i32] = acc[r];
        __syncthreads();
        if (tid < 64) {
            const int g_ = tid >> 5, i_ = tid & 31; const int w0_ = g_ * 4;
            const float sq = ssqp[(w0_ + 0) * 32 + i_] + ssqp[(w0_ + 1) * 32 + i_] + ssqp[(w0_ + 2) * 32 + i_] + ssqp[(w0_ + 3) * 32 + i_]; const float rstd = rsqrtf(sq * (1.f / 1024.f) + EPS);
            RSTD2[item * 64 + tid] = rstd; trs[tid] = rstd;
            float lg[32];
#pragma unroll
            for (int e = 0; e < 32; ++e) lg[e] = (part[((w0_ + 0) * 32 + i_) * 33 + e] + part[((w0_ + 1) * 32 + i_) * 33 + e] + part[((w0_ + 2) * 32 + i_) * 33 + e] + part[((w0_ + 3) * 32 + i_) * 33 + e]) * rstd + br[e];
            unsigned taken = 0u; float tv[4]; int ti[4];
#pragma unroll
            for (int k = 0; k < 4; ++k) { float best = -3.0e38f; int bi = 0;
#pragma unroll
                for (int e = 0; e < 32; ++e) { const bool ok = !((taken >> e) & 1u) && lg[e] > best; best = ok ? lg[e] : best; bi = ok ? e : bi; }
                taken |= 1u << bi; tv[k] = best; ti[k] = bi; }
            const float e1 = __expf(tv[1] - tv[0]), e2 = __expf(tv[2] - tv[0]), e3 = __expf(tv[3] - tv[0]); const float inv = 1.0f / (1.0f + e1 + e2 + e3);
            const float wv[4] = {inv, e1 * inv, e2 * inv, e3 * inv};
#pragma unroll
            for (int k = 0; k < 4; ++k) { const int idx = tid * 4 + k; te[idx] = ti[k]; trk[idx] = atomicAdd(&lcnt[ti[k]], 1); tw[idx] = wv[k]; }
        }
        __syncthreads();
        if (tid < 32) lbase[tid] = atomicAdd(&CNT[tid], lcnt[tid]);
        __syncthreads();
        if (tid < 256) { const int idx = tid; const int tk = item * 64 + (idx >> 2); const int e = te[idx]; const int slot = lbase[e] + trk[idx];
          TOPI[(size_t)tk * 4 + (idx & 3)] = e; TOPS[(size_t)tk * 4 + (idx & 3)] = slot; TOPW[(size_t)tk * 4 + (idx & 3)] = tw[idx];
          TOKOF[(size_t)e * 16384 + slot] = tk; ROWW[(size_t)e * 16384 + slot] = tw[idx]; RSDS[(size_t)e * 16384 + slot] = trs[idx >> 2]; }
        __syncthreads();
    }
}

struct MoeMap { int e, mt, nt, cnt, off; };
DEV void moe_setup(const Args& a, int* sm) {
    if (TID() == 0) { const int* CNT = (const int*)(a.ws + WS_CTL); int tot = 0; for (int e = 0; e < 32; ++e) { const int c = CNT[e]; const int mt = (c + 255) >> 8; sm[e] = mt; sm[32 + e] = tot; tot += mt; } sm[64] = tot; }
    __syncthreads();
}
DEV MoeMap moe_map(const Args& a, const int* sm, int item, int NT) {
    MoeMap mm; int e = 0;
#pragma unroll 1
    for (int i = 1; i < 32; ++i) if (item >= sm[32 + i] * NT) e = i;
    const int local = item - sm[32 + e] * NT; const int mte = sm[e];
    int mt_, nt_; patch_decode(local, mte, NT, mt_, nt_);
    mm.e = __builtin_amdgcn_readfirstlane(e); mm.mt = __builtin_amdgcn_readfirstlane(mt_); mm.nt = __builtin_amdgcn_readfirstlane(nt_);
    mm.cnt = __builtin_amdgcn_readfirstlane(((const int*)(a.ws + WS_CTL))[e]); mm.off = __builtin_amdgcn_readfirstlane(sm[32 + e] * 256); return mm;
}
DEV int moe_maps_build(const Args& a, const int* sm, int* maps, int nitems, int NT) {
    const int tid = TID(); const int first = VBID(); const int nmine = first < nitems ? (nitems - first + (int)gridDim.x - 1) / (int)gridDim.x : 0;
    for (int k = tid; k < nmine && k < 64; k += NTHR) { const int item = first + k * (int)gridDim.x; int e = 0;
#pragma unroll 1
        for (int i = 1; i < 32; ++i) if (item >= sm[32 + i] * NT) e = i;
        const int local = item - sm[32 + e] * NT; int mt_, nt_; patch_decode(local, sm[e], NT, mt_, nt_);
        maps[k * 8] = e; maps[k * 8 + 1] = mt_; maps[k * 8 + 2] = nt_; maps[k * 8 + 3] = ((const int*)(a.ws + WS_CTL))[e]; maps[k * 8 + 4] = sm[32 + e] * 256; }
    __syncthreads();
    return nmine < 64 ? nmine : 64;
}
DEV MoeMap moe_get(const int* maps, int k) { MoeMap mm; mm.e = __builtin_amdgcn_readfirstlane(maps[k * 8]); mm.mt = __builtin_amdgcn_readfirstlane(maps[k * 8 + 1]); mm.nt = __builtin_amdgcn_readfirstlane(maps[k * 8 + 2]);
    mm.cnt = __builtin_amdgcn_readfirstlane(maps[k * 8 + 3]); mm.off = __builtin_amdgcn_readfirstlane(maps[k * 8 + 4]); return mm; }
DEV void phase_up(const Args& a, unsigned char* smem) {
    int* sm = (int*)(smem + MISC_OFF); int* maps = (int*)(smem + MISC_OFF + 8192); int* tokb = maps + 512; float* rsdb = (float*)(tokb + 768); float* biab = rsdb + 768;
    static_assert(8192 + (512 + 3 * 768) * 4 <= 8192 + 12288, "misc LDS");
    const bf16_t* XN = (const bf16_t*)(a.ws + WS_XN); const bf16_t* W = (const bf16_t*)(a.ws + WS_WUP); bf16_t* ACT = (bf16_t*)(a.ws + WS_ACT); const float* RSDS = (const float*)(a.ws + WS_RSDS);
    const int* TOKOF = (const int*)(a.ws + WS_TOKOF); const float* bup = a.in[I_BUP];
    const int tid = TID(); int lane = tid & 63, wid = tid >> 6, wr = wid >> 2, wc = wid & 3; (void)wr; (void)wc; (void)lane;
    moe_setup(a, sm);
    const int nitems = __builtin_amdgcn_readfirstlane(sm[64]) * 8;
    const int nmine = __builtin_amdgcn_readfirstlane(moe_maps_build(a, sm, maps, nitems, 8));
    int tkr = 0; float rsr = 0.f, bir = 0.f;
    const int t8 = tid & 255;
    auto side_load = [&](const MoeMap& m_) { const int slot = m_.mt * 256 + t8; const bool ok = slot < m_.cnt; const size_t sl_ = (size_t)m_.e * 16384 + (ok ? slot : 0); const int tk_ = TOKOF[sl_]; const float rs_ = RSDS[sl_]; tkr = ok ? tk_ : 0; rsr = ok ? rs_ : 0.f;
        bir = bup[(size_t)m_.e * 2048 + (t8 < 128 ? m_.nt * 128 + t8 : 1024 + m_.nt * 128 + t8 - 128)]; };
    auto side_store = [&](int slot3) { tokb[slot3 * 256 + t8] = tkr; rsdb[slot3 * 256 + t8] = rsr; biab[slot3 * 256 + t8] = bir; };
    auto boffu = [](int k, int nc) { const int sc = ((nc >> 4) ? 1024 : 0) + (nc & 15) * 8; return (unsigned)(k * 4096 + sc * 2); };
    MoeMap mm{}, mn{};
    if (nmine > 0) { mm = moe_get(maps, 0); side_load(mm); side_store(0); }
    if (nmine > 1) { mn = moe_get(maps, 1); side_load(mn); side_store(1); }
    __syncthreads();
    bool pre = false;
    for (int k = 0; k < nmine; ++k) {
        const bool has_next = k + 1 < nmine, has_nn = k + 2 < nmine;
        { const MoeMap m2 = moe_get(maps, has_nn ? k + 2 : nmine - 1); side_load(m2); }
        const int s0 = k % 3, s1 = (k + 1) % 3, s2 = (k + 2) % 3;
        const int* tok = tokb + s0 * 256; const int* tokn = tokb + s1 * 256; const float* rsd = rsdb + s0 * 256; const float* bia = biab + s0 * 256;
        const bf16_t* We = W + (size_t)mm.e * 1024 * 2048; const bf16_t* Wn = W + (size_t)mn.e * 1024 * 2048;
        f32x4 acc[8][4];
        gemm256<true>(smem, 16, XN, 128u, [&](int r, int kc) { return (unsigned)(tok[r] * 2048 + kc * 16); }, We + mm.nt * 128, 64u * 4096u, boffu, acc, pre,
                      next_tile(has_next, smem, XN, [&](int r, int kc) { return (unsigned)(tokn[r] * 2048 + kc * 16); }, Wn + mn.nt * 128, boffu));
        side_store(s2);
        EPI_IDS();
        float bgv[2][4], blv[2][4];
#pragma unroll
        for (int ni = 0; ni < 2; ++ni) { const int jl = wc * 32 + ni * 16 + 4 * (lane >> 4); const float4 bg = *(const float4*)(bia + jl), bl_ = *(const float4*)(bia + 128 + jl);
            bgv[ni][0] = bg.x; bgv[ni][1] = bg.y; bgv[ni][2] = bg.z; bgv[ni][3] = bg.w; blv[ni][0] = bl_.x; blv[ni][1] = bl_.y; blv[ni][2] = bl_.z; blv[ni][3] = bl_.w; }
#pragma unroll
        for (int mi = 0; mi < 8; ++mi) { const int rl_ = G_ROW(mi); const size_t row = (size_t)mm.off + mm.mt * 256 + rl_; const float rs_ = rsd[rl_];
            uint2 o2[2];
#pragma unroll
            for (int ni = 0; ni < 2; ++ni) {
                const f32x4 gv = acc[mi][ni], lv = acc[mi][ni + 2]; float r4[4];
#pragma unroll
                for (int r = 0; r < 4; ++r) { const float gg = fminf(gv[r] * rs_ + bgv[ni][r], 7.0f); const float ll = fminf(fmaxf(lv[r] * rs_ + blv[ni][r], -7.0f), 7.0f); r4[r] = gg * sigmoidf_(1.702f * gg) * (ll + 1.0f); }
                o2[ni].x = cvtpk(r4[0], r4[1]); o2[ni].y = cvtpk(r4[2], r4[3]); }
            { const int c0 = wc * 32 + 4 * (lane >> 4); *(uint4*)(ACT + row * 1024 + mm.nt * 128 + PAIR16_COL(c0, c0 + 16)) = pair16(o2[0], o2[1]); } }
        lds_barrier();
        mm = mn; if (has_nn) mn = moe_get(maps, k + 2); pre = has_next;
    }
}
DEV void phase_down(const Args& a, unsigned char* smem) {
    int* sm = (int*)(smem + MISC_OFF); int* maps = (int*)(smem + MISC_OFF + 8192); float* rwb = (float*)(maps + 512); float* biab = rwb + 768;
    const bf16_t* ACT = (const bf16_t*)(a.ws + WS_ACT); const bf16_t* W = (const bf16_t*)(a.ws + WS_WDN); bf16_t* Y = (bf16_t*)(a.ws + WS_Y);
    const float* ROWW = (const float*)(a.ws + WS_ROWW); const float* bdn = a.in[I_BDN];
    const int tid = TID(); int lane = tid & 63, wid = tid >> 6, wr = wid >> 2, wc = wid & 3; (void)wr; (void)wc; (void)lane;
    moe_setup(a, sm);
    const int nitems = __builtin_amdgcn_readfirstlane(sm[64]) * 4;
    const int nmine = __builtin_amdgcn_readfirstlane(moe_maps_build(a, sm, maps, nitems, 4));
    float rwr = 0.f, bir = 0.f;
    const int t8 = tid & 255;
    auto side_load = [&](const MoeMap& m_) { const int slot = m_.mt * 256 + t8; const bool ok = slot < m_.cnt; const float rw_ = ROWW[(size_t)m_.e * 16384 + (ok ? slot : 0)]; rwr = ok ? rw_ : 0.f; bir = bdn[(size_t)m_.e * 1024 + m_.nt * 256 + t8]; };
    auto side_store = [&](int slot3) { rwb[slot3 * 256 + t8] = rwr; biab[slot3 * 256 + t8] = bir; };
    auto aoffd = [](int r, int kc) { return (unsigned)(r * 2048 + kc * 16); }; auto boffd = [](int k, int nc) { return (unsigned)(k * 2048 + nc * 16); };
    MoeMap mm{}, mn{};
    if (nmine > 0) { mm = moe_get(maps, 0); side_load(mm); side_store(0); }
    if (nmine > 1) { mn = moe_get(maps, 1); side_load(mn); side_store(1); }
    __syncthreads();
    bool pre = false;
    for (int k = 0; k < nmine; ++k) {
        const bool has_next = k + 1 < nmine, has_nn = k + 2 < nmine;
        { const MoeMap m2 = moe_get(maps, has_nn ? k + 2 : nmine - 1); side_load(m2); }
        const int s0 = k % 3, s2 = (k + 2) % 3;
        const float* rw = rwb + s0 * 256; const float* bia = biab + s0 * 256;
        const bf16_t* We = W + (size_t)mm.e * 1024 * 1024; const bf16_t* Ab = ACT + ((size_t)mm.off + mm.mt * 256) * 1024;
        const bf16_t* Wn = W + (size_t)mn.e * 1024 * 1024; const bf16_t* An = ACT + ((size_t)mn.off + mn.mt * 256) * 1024;
        f32x4 acc[8][4];
        gemm256<true>(smem, 16, Ab, 128u, aoffd, We + mm.nt * 256, 64u * 2048u, boffd, acc, pre,
                      next_tile(has_next, smem, An, aoffd, Wn + mn.nt * 256, boffd));
        side_store(s2);
        EPI_IDS();
        float4 bb[4];
#pragma unroll
        for (int ni = 0; ni < 4; ++ni) bb[ni] = *(const float4*)(bia + G_COL(ni));
#pragma unroll
        for (int mi = 0; mi < 8; ++mi) { const int rl = G_ROW(mi); const size_t row = (size_t)mm.off + mm.mt * 256 + rl; const float w = rw[rl];
#pragma unroll
            for (int np = 0; np < 2; ++np) { uint2 o2[2];
#pragma unroll
                for (int h = 0; h < 2; ++h) { const int ni = 2 * np + h; const f32x4 v = acc[mi][ni]; o2[h].x = cvtpk((v[0] + bb[ni].x) * w, (v[1] + bb[ni].y) * w); o2[h].y = cvtpk((v[2] + bb[ni].z) * w, (v[3] + bb[ni].w) * w); }
                *(uint4*)(Y + row * 1024 + mm.nt * 256 + PAIR16_COL(G_COL(2 * np), G_COL(2 * np + 1))) = pair16(o2[0], o2[1]); } }
        lds_barrier();
        mm = mn; if (has_nn) mn = moe_get(maps, k + 2); pre = has_next;
    }
}

DEV void phase_comb(const Args& a, unsigned char* smem) {
    int* sm = (int*)(smem + MISC_OFF);
    moe_setup(a, sm);
    float* H1 = (float*)(a.ws + WS_H1); bf16_t* XN = (bf16_t*)(a.ws + WS_XN); const bf16_t* Y = (const bf16_t*)(a.ws + WS_Y);
    const int* TOPI = (const int*)(a.ws + WS_TOPI); const int* TOPS = (const int*)(a.ws + WS_TOPS); const float* g = a.in[I_LNPLE];
    const int lane = TID() & 63; const int gw = BID() * NWAVE + (TID() >> 6), ngw = gridDim.x * NWAVE;
    for (int tok = gw; tok < NTOK; tok += ngw) {
        float4 v[4];
#pragma unroll
        for (int j = 0; j < 4; ++j) v[j] = *(const float4*)(H1 + (size_t)tok * 1024 + j * 256 + lane * 4);
#pragma unroll
        for (int k = 0; k < 4; ++k) { const int e = TOPI[(size_t)tok * 4 + k]; const size_t row = (size_t)sm[32 + e] * 256 + TOPS[(size_t)tok * 4 + k];
#pragma unroll
            for (int j = 0; j < 4; ++j) { const uint2 u = *(const uint2*)(Y + row * 1024 + j * 256 + lane * 4); v[j].x += bflo(u.x); v[j].y += bfhi(u.x); v[j].z += bflo(u.y); v[j].w += bfhi(u.y); } }
        float s = 0.f;
#pragma unroll
        for (int j = 0; j < 4; ++j) { *(float4*)(H1 + (size_t)tok * 1024 + j * 256 + lane * 4) = v[j]; s += v[j].x * v[j].x + v[j].y * v[j].y + v[j].z * v[j].z + v[j].w * v[j].w; }
        const float rstd = rsqrtf(wave_sum(s) * (1.f / 1024.f) + EPS);
#pragma unroll
        for (int j = 0; j < 4; ++j) { const float4 gg = *(const float4*)(g + j * 256 + lane * 4);
            uint2 o; o.x = cvtpk(v[j].x * rstd * gg.x, v[j].y * rstd * gg.y); o.y = cvtpk(v[j].z * rstd * gg.z, v[j].w * rstd * gg.w); *(uint2*)(XN + (size_t)tok * 1024 + j * 256 + lane * 4) = o; }
    }
}

DEV void phase_gate(const Args& a, unsigned char* smem) {
    const bf16_t* XN = (const bf16_t*)(a.ws + WS_XN); const bf16_t* WG = (const bf16_t*)(a.ws + WS_WGATE); const bf16_t* PB = (const bf16_t*)(a.ws + WS_PB); const bf16_t* WP = (const bf16_t*)(a.ws + WS_WPLE);
    const float* H2 = (const float*)(a.ws + WS_H1); float* OUT = a.out; float* SSQ3 = (float*)(a.ws + WS_SSQ3);
    const int tid = TID(); int lane = tid & 63, wid = tid >> 6, wr = wid >> 2, wc = wid & 3; (void)wr; (void)wc; (void)lane;
    bf16_t* GT = (bf16_t*)(a.ws + WS_ACT);
    auto aoffg = [](int r, int kc) { return (unsigned)(r * 2048 + kc * 16); }; auto aoffp = [](int r, int kc) { return (unsigned)(r * 512 + kc * 16); }; auto boffg = [](int k, int nc) { return (unsigned)(k * 2048 + nc * 16); };
    for (int item = VBID(); item < 64 * 4; item += gridDim.x) {
        int mt, nt; patch_decode(item, 64, 4, mt, nt);
        f32x4 acc[8][4];
        gemm256<true>(smem, 16, XN + (size_t)mt * 256 * 1024, 128u, aoffg, WG + nt * 256, 64u * 2048u, boffg, acc, false,
                      next_tile(true, smem, PB + (size_t)mt * 256 * 256, aoffp, WP + nt * 256, boffg));
        EPI_IDS();
        {
            uint2 wq[8][4];
#pragma unroll
            for (int mi = 0; mi < 8; ++mi) { const size_t gm = (size_t)mt * 256 + G_ROW(mi);
#pragma unroll
                for (int ni = 0; ni < 4; ++ni) { const int n = nt * 256 + G_COL(ni); const f32x4 v = acc[mi][ni];
                    uint2 w; w.x = cvtpk(sigmoidf_(v[0]), sigmoidf_(v[1])); w.y = cvtpk(sigmoidf_(v[2]), sigmoidf_(v[3])); wq[mi][ni] = w;
                    const float4 h = *(const float4*)(H2 + gm * 1024 + n); acc[mi][ni] = (f32x4){h.x, h.y, h.z, h.w}; } }
#pragma unroll
            for (int mi = 0; mi < 8; ++mi) { const size_t gm = (size_t)mt * 256 + G_ROW(mi);
#pragma unroll
                for (int ni = 0; ni < 4; ++ni) { const int n = nt * 256 + G_COL(ni); const uint2 w = wq[mi][ni]; *(uint2*)(GT + gm * 1024 + n) = w; const f32x4 h = acc[mi][ni];
                    acc[mi][ni] = (f32x4){h[0] * __builtin_amdgcn_rcpf(bflo(w.x)), h[1] * __builtin_amdgcn_rcpf(bfhi(w.x)), h[2] * __builtin_amdgcn_rcpf(bflo(w.y)), h[3] * __builtin_amdgcn_rcpf(bfhi(w.y))}; } }
        }
        gemm256<false>(smem, 4, PB + (size_t)mt * 256 * 256, 128u, aoffp, WP + nt * 256, 64u * 2048u, boffg, acc, true);
        EPI_IDS();
        const bool fused = gridDim.x >= 256;
        {
            uint2 gq[8][4];
#pragma unroll
            for (int mi = 0; mi < 8; ++mi) { const size_t gm = (size_t)mt * 256 + G_ROW(mi);
#pragma unroll
                for (int ni = 0; ni < 4; ++ni) gq[mi][ni] = *(const uint2*)(GT + gm * 1024 + nt * 256 + G_COL(ni)); }
#pragma unroll
            for (int mi = 0; mi < 8; ++mi) { const size_t gm = (size_t)mt * 256 + G_ROW(mi); float ss = 0.f;
                for (int ni = 0; ni < 4; ++ni) { const int n = nt * 256 + G_COL(ni); const f32x4 v = acc[mi][ni]; const uint2 gw = gq[mi][ni];
                    float4 o = {v[0] * bflo(gw.x), v[1] * bfhi(gw.x), v[2] * bflo(gw.y), v[3] * bfhi(gw.y)};
                    if (!fused) *(float4*)(OUT + gm * 1024 + n) = o;
                    acc[mi][ni] = (f32x4){o.x, o.y, o.z, o.w};
                    ss += o.x * o.x + o.y * o.y + o.z * o.z + o.w * o.w; }
                ss += __shfl_xor(ss, 16); ss += __shfl_xor(ss, 32);
                if (lane < 16) SSQ3[gm * 16 + nt * 4 + wc] = ss; }
        }
        if (fused) {
            unsigned* flag = (unsigned*)(a.ws + WS_CTL) + CW_GATEFLAG + mt;
            const float* lnf = a.in[I_LNF]; float4 gg[4];
#pragma unroll
            for (int ni = 0; ni < 4; ++ni) gg[ni] = *(const float4*)(lnf + nt * 256 + G_COL(ni));
            signal_done(flag); wait_flag(flag, 4u);
            float rstd[8];
#pragma unroll
            for (int mi = 0; mi < 8; ++mi) { const size_t gm = (size_t)mt * 256 + G_ROW(mi); const float4 s0 = *(const float4*)(SSQ3 + gm * 16 + 4 * (lane >> 4)); rstd[mi] = (s0.x + s0.y) + (s0.z + s0.w); }
#pragma unroll
            for (int mi = 0; mi < 8; ++mi) { float t_ = rstd[mi]; t_ += __shfl_xor(t_, 16); t_ += __shfl_xor(t_, 32); rstd[mi] = rsqrtf(t_ * (1.f / 1024.f) + EPS); }
#pragma unroll
            for (int mi = 0; mi < 8; ++mi) { const size_t gm = (size_t)mt * 256 + G_ROW(mi);
#pragma unroll
                for (int ni = 0; ni < 4; ++ni) { const int n = nt * 256 + G_COL(ni); const f32x4 v = acc[mi][ni]; const float r_ = rstd[mi];
                    float4 o = {v[0] * r_ * gg[ni].x, v[1] * r_ * gg[ni].y, v[2] * r_ * gg[ni].z, v[3] * r_ * gg[ni].w}; *(float4*)(OUT + gm * 1024 + n) = o; } }
        }
        __syncthreads();
    }
}

DEV void phase_final(const Args& a) {
    if (gridDim.x >= 256) return;
    float* OUT = a.out; const float* SSQ3 = (const float*)(a.ws + WS_SSQ3); const float* g = a.in[I_LNF];
    const int lane = TID() & 63; const int gw = BID() * NWAVE + (TID() >> 6), ngw = gridDim.x * NWAVE;
    for (int m = gw; m < NTOK; m += ngw) {
        float s = 0.f;
#pragma unroll
        for (int j = 0; j < 16; ++j) s += SSQ3[(size_t)m * 16 + j];
        const float rstd = rsqrtf(s * (1.f / 1024.f) + EPS);
#pragma unroll
        for (int j = 0; j < 4; ++j) { float4 v = *(const float4*)(OUT + (size_t)m * 1024 + j * 256 + lane * 4); const float4 gg = *(const float4*)(g + j * 256 + lane * 4);
            v.x *= rstd * gg.x; v.y *= rstd * gg.y; v.z *= rstd * gg.z; v.w *= rstd * gg.w; *(float4*)(OUT + (size_t)m * 1024 + j * 256 + lane * 4) = v; }
    }
}

template <int PH> DEV void run_phase(const Args& a, unsigned char* smem) {
    if constexpr (PH == PH_PRO) phase_prologue(a, smem);
    else if constexpr (PH == PH_INPROJ) phase_inproj(a, smem);
    else if constexpr (PH == PH_ATT) phase_att(a, smem);
    else if constexpr (PH == PH_OUTPROJ) phase_outproj(a, smem);
    else if constexpr (PH == PH_ROUTE) phase_route(a, smem);
    else if constexpr (PH == PH_UP) phase_up(a, smem);
    else if constexpr (PH == PH_DOWN) phase_down(a, smem);
    else if constexpr (PH == PH_COMB) phase_comb(a, smem);
    else if constexpr (PH == PH_GATE) phase_gate(a, smem);
    else if constexpr (PH == PH_FINAL) phase_final(a);
}
#define XB_TMO      128
#define XB_XCNT(j)  (256  + 64 * (j))
#define XB_XSUB(j)  (1280 + 64 * (j))
#define XB_XGEN(j)  (2304 + 64 * (j))
#define XB_TOP      3328
#define XB_TOPGEN   3392
#define XCD_BAR_WORDS 3456
#define XB_SPIN_CAP (1u << 22)
DEV unsigned xb_ld(unsigned* p)              { return __hip_atomic_load(p, __ATOMIC_RELAXED, __HIP_MEMORY_SCOPE_AGENT); }
DEV unsigned xb_add(unsigned* p, unsigned v) { return __hip_atomic_fetch_add(p, v, __ATOMIC_RELAXED, __HIP_MEMORY_SCOPE_AGENT); }
DEV unsigned xb_xcc_id() { return (unsigned)__builtin_amdgcn_s_getreg((3 << 11) | 20) & 0xFu; }
#define XB_SPIN(cond, bar) do { unsigned _sp = 0; while (cond) { __builtin_amdgcn_s_sleep(1); \
    if ((++_sp & 255u) == 0u) { if (xb_ld(&(bar)[XB_TMO])) break; if (_sp > XB_SPIN_CAP) { atomicAdd(&(bar)[XB_TMO], 1u); break; } } } } while (0)
struct XcdBarrier { unsigned* bar; unsigned x; volatile LAS unsigned* st; };
DEV XcdBarrier xcd_barrier_post(unsigned* bar, volatile LAS unsigned* st) {
    XcdBarrier b; b.bar = bar; b.x = xb_xcc_id(); b.st = st;
    if (TID() == 0) (void)xb_add(&bar[XB_XCNT(b.x)], 1u);
    return b;
}
DEV void xcd_barrier_complete(unsigned* bar, unsigned x, unsigned& nloc, unsigned& nx) {
    const unsigned G = gridDim.x * gridDim.y * gridDim.z;
    unsigned sum, cnt, mine, sp = 0u;
    for (;;) {
        sum = 0u; cnt = 0u; mine = 0u;
#pragma unroll
        for (unsigned j = 0; j < 16; ++j) { const unsigned c = xb_ld(&bar[XB_XCNT(j)]); sum += c; cnt += (c > 0u) ? 1u : 0u; mine = (j == x) ? c : mine; }
        if (sum == G) break;
        __builtin_amdgcn_s_sleep(1);
        if ((++sp & 255u) == 0u) { if (xb_ld(&bar[XB_TMO])) break; if (sp > XB_SPIN_CAP) { atomicAdd(&bar[XB_TMO], 1u); break; } }
    }
    nloc = mine > 0u ? mine : 1u; nx = cnt > 0u ? cnt : 1u;
}
DEV void xcd_barrier(const XcdBarrier& b) {
    asm volatile("s_waitcnt vmcnt(0)" ::: "memory");
    __syncthreads();
    if (TID() == 0) {
        unsigned* bar = b.bar;
        __builtin_amdgcn_s_waitcnt(0);
        unsigned nloc = b.st[0], nx = b.st[1];
        if (nloc == 0u) { xcd_barrier_complete(bar, b.x, nloc, nx); b.st[0] = nloc; b.st[1] = nx; }
        const unsigned old = xb_add(&bar[XB_XSUB(b.x)], 1u);
        const unsigned gen = old / nloc;
        if (old + 1u == (gen + 1u) * nloc) {
            __builtin_amdgcn_fence(__ATOMIC_RELEASE, "agent");
            asm volatile("s_waitcnt vmcnt(0)" ::: "memory");
            const unsigned og = xb_add(&bar[XB_TOP], 1u);
            const unsigned tg = og / nx;
            if (og + 1u == (tg + 1u) * nx) xb_add(&bar[XB_TOPGEN], 1u);
            else XB_SPIN(xb_ld(&bar[XB_TOPGEN]) == tg, bar);
            __builtin_amdgcn_fence(__ATOMIC_ACQUIRE, "agent");
            xb_add(&bar[XB_XGEN(b.x)], 1u);
            asm volatile("s_waitcnt vmcnt(0)" ::: "memory");
        } else {
            XB_SPIN(xb_ld(&bar[XB_XGEN(b.x)]) == gen, bar);
            __builtin_amdgcn_fence(__ATOMIC_ACQUIRE, "agent");
            asm volatile("s_waitcnt vmcnt(0)" ::: "memory");
        }
    }
    __syncthreads();
}

__global__ void __launch_bounds__(NTHR, 2) mega(Args a) {
    extern __shared__ __attribute__((aligned(16))) unsigned char smem[];
    volatile LAS unsigned* bst = (volatile LAS unsigned*)(LAS unsigned char*)(smem + MISC_OFF + 8000);
    if (TID() == 0) { bst[0] = 0u; bst[1] = 0u; }
    __syncthreads();
    const XcdBarrier bar = xcd_barrier_post((unsigned*)(a.ws + WS_CTL) + 4096, bst);
#define GSYNC() xcd_barrier(bar)
#define RUN(ph) do { run_phase<ph>(a, smem); if ((PROBE_DUP >> ph) & 1) { GSYNC(); run_phase<ph>(a, smem); } } while (0)
    RUN(PH_PRO); GSYNC();
    RUN(PH_INPROJ); GSYNC();
    RUN(PH_ATT); GSYNC();
    RUN(PH_OUTPROJ); GSYNC();
    RUN(PH_ROUTE); GSYNC();
    RUN(PH_UP); GSYNC();
    RUN(PH_DOWN); GSYNC();
    RUN(PH_COMB); GSYNC();
    RUN(PH_GATE);
    if (gridDim.x < 256) { GSYNC(); RUN(PH_FINAL); }
#undef RUN
#undef GSYNC
}

extern "C" void kernel_launch(void* const* d_in, const int* in_sizes, int n_in, void* d_out, int out_size, void* d_ws, size_t ws_size, hipStream_t stream) {
    static int grid = 0;
    if (grid == 0) {
        if (n_in != 25 || ws_size < WS_END) { fprintf(stderr, "kernel_launch: unexpected n_in %d / ws %zu\n", n_in, ws_size); grid = -1; return; }
        int dev = 0, cus = 0, per_cu = 0;
        (void)hipGetDevice(&dev); (void)hipDeviceGetAttribute(&cus, hipDeviceAttributeMultiprocessorCount, dev);
        (void)hipFuncSetAttribute((const void*)mega, hipFuncAttributeMaxDynamicSharedMemorySize, LDS_BYTES);
        (void)hipOccupancyMaxActiveBlocksPerMultiprocessor(&per_cu, (const void*)mega, NTHR, LDS_BYTES);
        if (per_cu < 1) { fprintf(stderr, "kernel_launch: occupancy query says %d blocks per CU\n", per_cu); grid = -1; return; }
        grid = cus;
    }
    if (grid < 0) return;
    (void)hipMemsetAsync((char*)d_ws + WS_CTL, 0, 65536, stream);
    Args a{};
    for (int i = 0; i < 25; ++i) a.in[i] = (const float*)d_in[i];
    a.out = (float*)d_out; a.ws = (unsigned char*)d_ws; a.ph_lo = 0; a.ph_hi = PH_N;
    void* args[] = {&a};
    hipError_t e = hipLaunchCooperativeKernel((const void*)mega, dim3(grid), dim3(NTHR), args, LDS_BYTES, stream);
    if (e != hipSuccess) fprintf(stderr, "cooperative launch failed: %s (grid %d)\n", hipGetErrorString(e), grid);
}
```

```cpp
#include <hip/hip_runtime.h>
#include <stdint.h>
#include <cstdio>

#define DEV __device__ __forceinline__
#define LAS __attribute__((address_space(3)))

typedef unsigned short bf16_t;
typedef short bf16x8 __attribute__((ext_vector_type(8)));
typedef short s16x4 __attribute__((ext_vector_type(4)));
typedef float f32x4 __attribute__((ext_vector_type(4)));
typedef float f32x16 __attribute__((ext_vector_type(16)));
typedef float f32x2_t __attribute__((ext_vector_type(2)));
typedef __bf16 bf16x2_t __attribute__((ext_vector_type(2)));

constexpr int NTHR = 512, NWAVE = 8;
constexpr int NTOK = 16384;
constexpr float EPS = 1e-6f;
constexpr float LOG2E = 1.4426950408889634f;
constexpr float QS = 0.125f * LOG2E;
constexpr int NWIN = 3072;

constexpr size_t MiB = 1u << 20;
constexpr size_t WS_CTL = 0;
constexpr size_t WS_WIN = 1 * MiB;
constexpr size_t WS_WOUT = 7 * MiB;
constexpr size_t WS_WGATE = 9 * MiB;
constexpr size_t WS_WPLE = 11 * MiB;
constexpr size_t WS_WC1 = 12 * MiB;
constexpr size_t WS_WC2 = 15 * MiB + 512 * 1024 + 262144;
constexpr size_t WS_BIAS1 = 15 * MiB + 512 * 1024 + 262144 + 131072;
constexpr size_t WS_KC = 14 * MiB;
constexpr size_t WS_HID = 14 * MiB + 512 * 1024;
constexpr size_t WS_GN = 16 * MiB;
constexpr size_t WS_LS = 18 * MiB;
constexpr size_t WS_CUM = 19 * MiB;
constexpr size_t WS_SSQ = 20 * MiB;
constexpr size_t WS_TOPI = 21 * MiB;
constexpr size_t WS_TOPS = 21 * MiB + 262144;
constexpr size_t WS_TOPW = 21 * MiB + 524288;
constexpr size_t WS_TOKOF = 22 * MiB;
constexpr size_t WS_ROWW = 24 * MiB;
constexpr size_t WS_SSQ3 = 26 * MiB;
constexpr size_t WS_RSTD2 = 27 * MiB;
constexpr size_t WS_PB = 28 * MiB;
constexpr size_t WS_XN = 36 * MiB;
constexpr size_t WS_PROJ = 68 * MiB;
constexpr size_t WS_ONSA = 160 * MiB;
constexpr size_t WS_OFOX = 176 * MiB;
constexpr size_t WS_H1 = 192 * MiB;
constexpr size_t WS_WUP = 256 * MiB;
constexpr size_t WS_WDN = 384 * MiB;
constexpr size_t WS_ACT = 448 * MiB;
constexpr size_t WS_Y = 592 * MiB;
constexpr size_t WS_RSDS = 736 * MiB;
constexpr size_t WS_END = 738 * MiB;

enum { PH_PRO = 0, PH_INPROJ, PH_CMP, PH_ATT, PH_OUTPROJ, PH_ROUTE, PH_UP, PH_DOWN, PH_COMB, PH_GATE, PH_FINAL, PH_N };
struct Args { const float* in[25]; float* out; unsigned char* ws; int ph_lo, ph_hi; };
enum { I_X = 0, I_P, I_LN1, I_WIN, I_BFG, I_WC1K, I_WC2K, I_PEK, I_WC1V, I_WC2V, I_PEV, I_GNN, I_GNF, I_WOUT, I_LN2, I_WR, I_BR,
       I_WUP, I_BUP, I_WDN, I_BDN, I_LNPLE, I_WPLE, I_WGATE, I_LNF };

DEV int BID() { int b = (int)blockIdx.x; asm volatile("" : "+s"(b)); return b; }
DEV int VBID() { const int g = (int)gridDim.x, b = BID(); return (g & 7) ? b : (b & 7) * (g >> 3) + (b >> 3); }
DEV int TID() { int t = (int)__builtin_amdgcn_workitem_id_x(); asm volatile("" : "+v"(t)); return t; }
DEV unsigned cvtpk(float lo, float hi) { f32x2_t v = {lo, hi}; bf16x2_t b = __builtin_convertvector(v, bf16x2_t); return __builtin_bit_cast(unsigned, b); }
DEV float bflo(unsigned u) { return __uint_as_float(u << 16); }
DEV float bfhi(unsigned u) { return __uint_as_float(u & 0xffff0000u); }
DEV float wave_sum(float v) {
#pragma unroll
    for (int o = 1; o < 64; o <<= 1) v += __shfl_xor(v, o);
    return v;
}
#define DPP_MOV(x, ctrl) __builtin_bit_cast(float, __builtin_amdgcn_update_dpp(0, __builtin_bit_cast(int, (x)), (ctrl), 0xF, 0xF, true))
DEV float pair_sum(float x) { return x + __shfl_xor(x, 32); }
DEV float pair_max(float x) { return fmaxf(x, __shfl_xor(x, 32)); }
DEV float quad_sum(float x) { x += DPP_MOV(x, 0xB1); x += DPP_MOV(x, 0x4E); return x; }
DEV float wave_max_u(float x) {
    x = fmaxf(x, DPP_MOV(x, 0xB1)); x = fmaxf(x, DPP_MOV(x, 0x4E)); x = fmaxf(x, DPP_MOV(x, 0x141)); x = fmaxf(x, DPP_MOV(x, 0x140));
    const float a = __builtin_bit_cast(float, __builtin_amdgcn_readlane(__builtin_bit_cast(int, x), 0)), b = __builtin_bit_cast(float, __builtin_amdgcn_readlane(__builtin_bit_cast(int, x), 16));
    const float c = __builtin_bit_cast(float, __builtin_amdgcn_readlane(__builtin_bit_cast(int, x), 32)), d = __builtin_bit_cast(float, __builtin_amdgcn_readlane(__builtin_bit_cast(int, x), 48));
    return fmaxf(fmaxf(a, b), fmaxf(c, d));
}
DEV float sigmoidf_(float x) { return __builtin_amdgcn_rcpf(1.0f + __expf(-x)); }
DEV float logsigmoidf_(float x) { return fminf(x, 0.f) - log1pf(__expf(-fabsf(x))); }
DEV float gelu_tanh(float x) { const float u = 0.7978845608028654f * (x + 0.044715f * x * x * x); const float th = 1.0f - 2.0f * __builtin_amdgcn_rcpf(__expf(2.0f * u) + 1.0f); return 0.5f * x * (1.0f + th); }
DEV s16x4 tr_read(const unsigned char* p) {
    typedef short v4i16_t __attribute__((ext_vector_type(4)));
    return __builtin_bit_cast(s16x4, __builtin_amdgcn_ds_read_tr16_b64_v4i16((LAS v4i16_t*)p));
}
DEV s16x4 tr_read_l(unsigned lds_addr) {
    typedef short v4i16_t __attribute__((ext_vector_type(4)));
    return __builtin_bit_cast(s16x4, __builtin_amdgcn_ds_read_tr16_b64_v4i16((LAS v4i16_t*)(uintptr_t)lds_addr));
}
DEV int crow(int r, int hi) { return (r & 3) + 8 * (r >> 2) + 4 * hi; }

constexpr int GL_STAGE = 65536;
constexpr int GEMM_LDS = 2 * GL_STAGE;
constexpr int MISC_OFF = GEMM_LDS;
constexpr int LDS_BYTES = GEMM_LDS + 8192 + 12288;

DEV void glds16s(const void* sbase, unsigned voff, unsigned lds_dst) { unsigned keep;
    asm volatile("s_mov_b32 %0, m0\n\ts_mov_b32 m0, %3\n\ts_nop 0\n\tglobal_load_lds_dwordx4 %1, %2\n\ts_mov_b32 m0, %0" : "=&s"(keep) : "v"(voff), "s"(sbase), "s"(lds_dst) : "memory"); }

DEV const unsigned char* uptr(const void* p) { const unsigned long long v = (unsigned long long)p; const unsigned lo = __builtin_amdgcn_readfirstlane((unsigned)v), hi = __builtin_amdgcn_readfirstlane((unsigned)(v >> 32)); return (const unsigned char*)(((unsigned long long)hi << 32) | lo); }

DEV void lds_barrier() { asm volatile("s_waitcnt lgkmcnt(0)\n\ts_barrier" ::: "memory"); }

struct NoNextS { DEV void operator()() const {} };
template <class AO, class BO>
DEV void gemm256s_issue0(unsigned char* smem, const void* abase, const AO& aoff, const void* bbase, const BO& boff) {
    const int tid = TID(), lane = tid & 63; const int wid = __builtin_amdgcn_readfirstlane(tid >> 6);
    const unsigned lds0 = (unsigned)(uintptr_t)smem; const unsigned char* ab_ = uptr(abase); const unsigned char* bb_ = uptr(bbase);
#pragma unroll
    for (int i = 0; i < 4; ++i) { const int p = wid + 8 * i; glds16s(ab_, aoff(8 * p + (lane >> 3), (lane & 7) ^ (lane >> 3)), (unsigned)__builtin_amdgcn_readfirstlane(lds0 + p * 1024)); }
#pragma unroll
    for (int i = 0; i < 4; ++i) { const int p = wid + 8 * i; const int k = 2 * p + (lane >> 5); const int f = (k & 3) + 4 * ((k >> 3) & 1);
        glds16s(bb_, boff(k, (lane & 31) ^ (f << 1)), (unsigned)__builtin_amdgcn_readfirstlane(lds0 + 32768 + p * 1024)); }
}
template <bool ZERO, class AO, class BO, class NX = NoNextS>
DEV void gemm256s(unsigned char* smem, int nkt, const void* abase, unsigned akstep, const AO& aoff, const void* bbase, unsigned bkstep, const BO& boff, f32x4 (&acc)[8][4], bool pre = false, const NX& next = NX()) {
    const int tid = TID(), lane = tid & 63; const int wid = __builtin_amdgcn_readfirstlane(tid >> 6); const int wr = wid >> 2, wc = wid & 3;
    if (ZERO) {
#pragma unroll
        for (int mi = 0; mi < 8; ++mi)
#pragma unroll
            for (int ni = 0; ni < 4; ++ni) acc[mi][ni] = (f32x4){0.f, 0.f, 0.f, 0.f};
    }
    const unsigned lds0 = (unsigned)(uintptr_t)smem;
    const unsigned char* abase_u = uptr(abase); const unsigned char* bbase_u = uptr(bbase); const unsigned akstep_u = __builtin_amdgcn_readfirstlane(akstep), bkstep_u = __builtin_amdgcn_readfirstlane(bkstep);
    unsigned ao[4], bo[4];
#pragma unroll
    for (int i = 0; i < 4; ++i) { const int p = wid + 8 * i; ao[i] = aoff(8 * p + (lane >> 3), (lane & 7) ^ (lane >> 3));
        const int k = 2 * p + (lane >> 5); const int f = (k & 3) + 4 * ((k >> 3) & 1); bo[i] = boff(k, (lane & 31) ^ (f << 1)); }
#define GL_ISSUE(kt, st) do { const unsigned char* ab_ = abase_u + (size_t)(kt) * akstep_u; const unsigned char* bb_ = bbase_u + (size_t)(kt) * bkstep_u; \
        _Pragma("unroll") for (int i_ = 0; i_ < 4; ++i_) glds16s(ab_, ao[i_], (unsigned)__builtin_amdgcn_readfirstlane(lds0 + (st) * GL_STAGE + (wid + 8 * i_) * 1024)); \
        _Pragma("unroll") for (int i_ = 0; i_ < 4; ++i_) glds16s(bb_, bo[i_], (unsigned)__builtin_amdgcn_readfirstlane(lds0 + (st) * GL_STAGE + 32768 + (wid + 8 * i_) * 1024)); } while (0)
    if (!pre) {
        GL_ISSUE(0, 0);
        asm volatile("s_waitcnt vmcnt(0)" ::: "memory");
        __syncthreads();
    }
    for (int kt = 0; kt < nkt; ++kt) {
        if (kt + 1 < nkt) GL_ISSUE(kt + 1, (kt + 1) & 1); else next();
        const unsigned char* A = smem + (kt & 1) * GL_STAGE; const unsigned char* Bt = A + 32768;
#pragma unroll
        for (int ks = 0; ks < 2; ++ks) {
            bf16x8 wf[4];
#pragma unroll
            for (int ni = 0; ni < 4; ++ni) {
                const int i = lane & 15, g = lane >> 4, q = i >> 2; const int row = ks * 32 + 8 * g + q; const int nc = wc * 8 + ni * 2 + ((i & 3) >> 1); const int f = q + 4 * (g & 1);
                const unsigned char* p = Bt + row * 512 + ((nc ^ (f << 1)) << 4) + (i & 1) * 8;
                const s16x4 lo = tr_read(p), hi = tr_read(p + 4 * 512);
                wf[ni] = (bf16x8){lo[0], lo[1], lo[2], lo[3], hi[0], hi[1], hi[2], hi[3]};
            }
#pragma unroll
            for (int mi = 0; mi < 8; ++mi) {
                const int m = wr * 128 + mi * 16 + (lane & 15); const int kc = ks * 4 + (lane >> 4);
                const bf16x8 af = *(const bf16x8*)(A + m * 128 + ((kc ^ (m & 7)) << 4));
#pragma unroll
                for (int ni = 0; ni < 4; ++ni) acc[mi][ni] = __builtin_amdgcn_mfma_f32_16x16x32_bf16(wf[ni], af, acc[mi][ni], 0, 0, 0);
            }
        }
        asm volatile("s_waitcnt vmcnt(0)" ::: "memory");
        __syncthreads();
    }
#undef GL_ISSUE
}

#define G_ROW(mi) ((((mi) >> 2) * 128) + wr * 64 + (((mi) & 3) * 16) + (lane & 15))
#define G_COL(ni) ((((ni) >> 1) * 128) + wc * 32 + (((ni) & 1) * 16) + 4 * (lane >> 4))
#define WAIT_V(n) asm volatile("s_waitcnt vmcnt(" #n ")" ::: "memory")
#define WAIT_L(n) asm volatile("s_waitcnt lgkmcnt(" #n ")" ::: "memory")
#define BAR() __builtin_amdgcn_s_barrier()
#define SCHED() __builtin_amdgcn_sched_barrier(0)
constexpr int SA_(int b, int h) { return b * GL_STAGE + h * 16384; }
constexpr int SB_(int b, int h) { return b * GL_STAGE + 32768 + h * 16384; }
struct NoNext { DEV bool has() const { return false; } template <int P> DEV void issue() const {} };
template <int WHICH, class AO, class BO>
DEV void gemm_issue0(unsigned char* smem, const void* abase, const AO& aoff, const void* bbase, const BO& boff) {
    const int tid = TID(), lane = tid & 63; const int wid = __builtin_amdgcn_readfirstlane(tid >> 6);
    const unsigned lds0 = (unsigned)(uintptr_t)smem; const unsigned char* ab_ = uptr(abase); const unsigned char* bb_ = uptr(bbase);
#pragma unroll
    for (int h = 0; h < 2; ++h) {
        if (WHICH & (1 << (2 * h))) {
#pragma unroll
            for (int i = 0; i < 2; ++i) { const int p = wid + 8 * i; const int k = 4 * p + (lane >> 4); const int f = (k & 3) + 4 * ((k >> 3) & 1);
                glds16s(bb_, boff(k, h * 16 + ((lane & 15) ^ (f << 1))), (unsigned)__builtin_amdgcn_readfirstlane(lds0 + SB_(0, h) + p * 1024)); } }
        if (WHICH & (2 << (2 * h))) {
#pragma unroll
            for (int i = 0; i < 2; ++i) { const int p = wid + 8 * i;
                glds16s(ab_, aoff(h * 128 + 8 * p + (lane >> 3), (lane & 7) ^ (lane >> 3)), (unsigned)__builtin_amdgcn_readfirstlane(lds0 + SA_(0, h) + p * 1024)); } }
    }
}
template <class AO, class BO>
struct NextTile { bool on; unsigned char* smem; const void* abase; AO aoff; const void* bbase; BO boff;
    DEV bool has() const { return on; }
    template <int P> DEV void issue() const { gemm_issue0<P>(smem, abase, aoff, bbase, boff); } };
template <class AO, class BO> DEV NextTile<AO, BO> next_tile(bool on, unsigned char* smem, const void* abase, const AO& aoff, const void* bbase, const BO& boff) { return NextTile<AO, BO>{on, smem, abase, aoff, bbase, boff}; }
template <bool ZERO, class AO, class BO, class NX = NoNext>
DEV void gemm256(unsigned char* smem, int nkt, const void* abase, unsigned akstep, const AO& aoff, const void* bbase, unsigned bkstep, const BO& boff, f32x4 (&acc)[8][4], bool pre = false, const NX& next = NX()) {
    const int tid = TID(), lane = tid & 63; const int wid = __builtin_amdgcn_readfirstlane(tid >> 6); const int wr = wid >> 2, wc = wid & 3;
    if (ZERO) {
#pragma unroll
        for (int mi = 0; mi < 8; ++mi)
#pragma unroll
            for (int ni = 0; ni < 4; ++ni) acc[mi][ni] = (f32x4){0.f, 0.f, 0.f, 0.f};
    }
    const unsigned lds0 = (unsigned)(uintptr_t)smem;
    const unsigned char* abase_u = uptr(abase); const unsigned char* bbase_u = uptr(bbase); const unsigned akstep_u = __builtin_amdgcn_readfirstlane(akstep), bkstep_u = __builtin_amdgcn_readfirstlane(bkstep);
    unsigned ao[4], bo[4];
#pragma unroll
    for (int h = 0; h < 2; ++h)
#pragma unroll
        for (int i = 0; i < 2; ++i) { const int p = wid + 8 * i; ao[h * 2 + i] = aoff(h * 128 + 8 * p + (lane >> 3), (lane & 7) ^ (lane >> 3));
            const int k = 4 * p + (lane >> 4); const int f = (k & 3) + 4 * ((k >> 3) & 1); bo[h * 2 + i] = boff(k, h * 16 + ((lane & 15) ^ (f << 1))); }
    unsigned ard0[2], ard1[2], brd0[2], brd1[2];
    { const int l15 = lane & 15, g = lane >> 4, q = l15 >> 2; const int f = q + 4 * (g & 1);
      ard0[0] = lds0 + (wr * 64 + l15) * 128 + ((g ^ (lane & 7)) << 4); ard1[0] = lds0 + (wr * 64 + l15) * 128 + (((4 + g) ^ (lane & 7)) << 4);
      const int nc = wc * 4 + ((l15 & 3) >> 1); const int kr = 8 * g + q;
      brd0[0] = lds0 + kr * 256 + ((nc ^ (f << 1)) << 4) + (l15 & 1) * 8; brd1[0] = lds0 + kr * 256 + (((nc + 2) ^ (f << 1)) << 4) + (l15 & 1) * 8;
      ard0[1] = ard0[0] + GL_STAGE; ard1[1] = ard1[0] + GL_STAGE; brd0[1] = brd0[0] + GL_STAGE; brd1[1] = brd1[0] + GL_STAGE;
      asm volatile("" : "+v"(ard0[1]), "+v"(ard1[1]), "+v"(brd0[1]), "+v"(brd1[1])); }
#define ST_A(b, h, kt) do { const unsigned char* ab_ = abase_u + (size_t)(kt) * akstep_u; \
        _Pragma("unroll") for (int i_ = 0; i_ < 2; ++i_) glds16s(ab_, ao[(h) * 2 + i_], (unsigned)__builtin_amdgcn_readfirstlane(lds0 + SA_(b, h) + (wid + 8 * i_) * 1024)); } while (0)
#define ST_B(b, h, kt) do { const unsigned char* bb_ = bbase_u + (size_t)(kt) * bkstep_u; \
        _Pragma("unroll") for (int i_ = 0; i_ < 2; ++i_) glds16s(bb_, bo[(h) * 2 + i_], (unsigned)__builtin_amdgcn_readfirstlane(lds0 + SB_(b, h) + (wid + 8 * i_) * 1024)); } while (0)
#define LDSP(T, a_) ((LAS const T*)(uintptr_t)(a_))
#define LDA(dst, b, h) do { _Pragma("unroll") for (int m_ = 0; m_ < 4; ++m_) { dst[m_][0] = *LDSP(bf16x8, ard0[b] + SA_(0, h) + m_ * 2048); dst[m_][1] = *LDSP(bf16x8, ard1[b] + SA_(0, h) + m_ * 2048); } } while (0)
#define LDB(dst, b, h) do { _Pragma("unroll") for (int n_ = 0; n_ < 2; ++n_) _Pragma("unroll") for (int k_ = 0; k_ < 2; ++k_) { const unsigned p_ = (n_ ? brd1[b] : brd0[b]) + SB_(0, h) + k_ * 8192; \
        const s16x4 lo_ = tr_read_l(p_), hi_ = tr_read_l(p_ + 1024); dst[n_][k_] = (bf16x8){lo_[0], lo_[1], lo_[2], lo_[3], hi_[0], hi_[1], hi_[2], hi_[3]}; } } while (0)
#define MMA(ai, bj, Bx) do { __builtin_amdgcn_s_setprio(1); \
        _Pragma("unroll") for (int k_ = 0; k_ < 2; ++k_) _Pragma("unroll") for (int m_ = 0; m_ < 4; ++m_) _Pragma("unroll") for (int n_ = 0; n_ < 2; ++n_) \
            acc[(ai) * 4 + m_][(bj) * 2 + n_] = __builtin_amdgcn_mfma_f32_16x16x32_bf16(Bx[n_][k_], At[m_][k_], acc[(ai) * 4 + m_][(bj) * 2 + n_], 0, 0, 0); \
        __builtin_amdgcn_s_setprio(0); } while (0)
    bf16x8 At[4][2], B0[2][2], B1[2][2];
    if (!pre) { ST_B(0, 0, 0); ST_A(0, 0, 0); ST_B(0, 1, 0); ST_A(0, 1, 0); }
    if (wr == 1) BAR();
    if (!pre) WAIT_V(4);
    BAR();
    ST_B(1, 0, 1); ST_A(1, 0, 1); ST_B(1, 1, 1);
    if (!pre) WAIT_V(6);
    BAR();
    for (int t = 0; t < nkt - 2; t += 2) {
        LDB(B0, 0, 0); SCHED(); LDA(At, 0, 0); ST_A(1, 1, t + 1);
        WAIT_L(8); BAR(); WAIT_L(0); MMA(0, 0, B0); BAR(); SCHED();
        LDB(B1, 0, 1); ST_B(0, 0, t + 2);
        BAR(); WAIT_L(0); MMA(0, 1, B1); BAR();
        LDA(At, 0, 1); ST_A(0, 0, t + 2);
        BAR(); WAIT_L(0); MMA(1, 0, B0); BAR(); SCHED();
        ST_B(0, 1, t + 2);
        WAIT_V(6); BAR(); MMA(1, 1, B1); BAR();
        LDB(B0, 1, 0); SCHED(); LDA(At, 1, 0); ST_A(0, 1, t + 2);
        WAIT_L(8); BAR(); WAIT_L(0); MMA(0, 0, B0); BAR(); SCHED();
        LDB(B1, 1, 1); ST_B(1, 0, t + 3);
        BAR(); WAIT_L(0); MMA(0, 1, B1); BAR();
        LDA(At, 1, 1); ST_A(1, 0, t + 3);
        BAR(); WAIT_L(0); MMA(1, 0, B0); BAR(); SCHED();
        ST_B(1, 1, t + 3);
        WAIT_V(6); BAR(); MMA(1, 1, B1); BAR();
    }
    const bool hn = next.has();
    LDB(B0, 0, 0); LDA(At, 0, 0); ST_A(1, 1, nkt - 1);
    BAR(); WAIT_L(0); MMA(0, 0, B0); BAR();
    LDB(B1, 0, 1); BAR(); WAIT_L(0); MMA(0, 1, B1); BAR();
    LDA(At, 0, 1);
    if (hn) { next.template issue<3>(); WAIT_V(8); } else WAIT_V(4);
    BAR(); WAIT_L(0); MMA(1, 0, B0); MMA(1, 1, B1); BAR();
    LDB(B0, 1, 0); LDA(At, 1, 0);
    if (hn) { next.template issue<4>(); WAIT_V(8); } else WAIT_V(2);
    BAR(); WAIT_L(0); MMA(0, 0, B0); BAR();
    LDB(B1, 1, 1);
    if (hn) { next.template issue<8>(); WAIT_V(8); } else WAIT_V(0);
    BAR(); WAIT_L(0); MMA(0, 1, B1); BAR();
    LDA(At, 1, 1); BAR(); WAIT_L(0); MMA(1, 0, B0); MMA(1, 1, B1);
    WAIT_V(0);
    BAR();
    if (wr == 0) BAR();
#undef ST_A
#undef ST_B
#undef LDA
#undef LDB
#undef LDSP
#undef MMA
}

DEV uint4 pair16(uint2 a, uint2 b) {
    const auto r0 = __builtin_amdgcn_permlane16_swap(a.x, b.x, false, false); const auto r1 = __builtin_amdgcn_permlane16_swap(a.y, b.y, false, false);
    uint4 o; o.x = r0[0]; o.y = r1[0]; o.z = r0[1]; o.w = r1[1]; return o;
}
DEV void unpair16(uint4 q, uint2& a, uint2& b) {
    const auto r0 = __builtin_amdgcn_permlane16_swap(q.x, q.z, false, false); const auto r1 = __builtin_amdgcn_permlane16_swap(q.y, q.w, false, false);
    a.x = r0[0]; a.y = r1[0]; b.x = r0[1]; b.y = r1[1];
}
#define PAIR16_COL(c0, c1) ((((lane) >> 4) & 1) ? (c1) - 4 : (c0))
#define EPI_IDS() do { const int etid_ = TID(); lane = etid_ & 63; wid = etid_ >> 6; wr = wid >> 2; wc = wid & 3; } while (0)

DEV void patch_decode(int local, int MT, int NT, int& mt, int& nt) {
    const int per_mtb = 8 * NT; const int mtb = local / per_mtb; const int rem = local - mtb * per_mtb;
    const int rows = (MT - 8 * mtb) < 8 ? (MT - 8 * mtb) : 8;
    const int per_ntb = rows * 8; const int nfull = NT >> 3; int ntb = rem / per_ntb; int cols = 8;
    if (ntb >= nfull) { ntb = nfull; cols = NT - 8 * nfull; }
    const int r2 = rem - ntb * per_ntb;
    mt = 8 * mtb + r2 / cols; nt = 8 * ntb + r2 % cols;
}

DEV void convert_chunk(const float* src, bf16_t* dst, size_t i8) {
    const float4 a = *(const float4*)(src + i8 * 8), b = *(const float4*)(src + i8 * 8 + 4);
    uint4 o; o.x = cvtpk(a.x, a.y); o.y = cvtpk(a.z, a.w); o.z = cvtpk(b.x, b.y); o.w = cvtpk(b.z, b.w);
    *(uint4*)(dst + i8 * 8) = o;
}
DEV void phase_prologue(const Args& a, unsigned char* smem) {
    unsigned char* ws = a.ws;
    const size_t gtid = (size_t)BID() * NTHR + TID(), gn = (size_t)gridDim.x * NTHR;
    {
        { const float* W = a.in[I_WOUT]; bf16_t* O = (bf16_t*)(ws + WS_WOUT); const float* gnn = a.in[I_GNN]; const float* gnf = a.in[I_GNF];
          for (size_t i = gtid; i < (size_t)1024 * 128; i += gn) { const int k = (int)(i >> 7); const float g_ = k < 512 ? gnn[k] : gnf[k - 512];
              const float4 x = *(const float4*)(W + i * 8), y = *(const float4*)(W + i * 8 + 4);
              uint4 o; o.x = cvtpk(x.x * g_, x.y * g_); o.y = cvtpk(x.z * g_, x.w * g_); o.z = cvtpk(y.x * g_, y.y * g_); o.w = cvtpk(y.z * g_, y.w * g_); *(uint4*)(O + i * 8) = o; } }
        const float* srcs[3] = {a.in[I_WGATE], a.in[I_WPLE], a.in[I_P]};
        bf16_t* dsts[3] = {(bf16_t*)(ws + WS_WGATE), (bf16_t*)(ws + WS_WPLE), (bf16_t*)(ws + WS_PB)};
        const size_t cnt8[3] = {1024 * 1024 / 8, 256 * 1024 / 8, (size_t)NTOK * 256 / 8};
#pragma unroll
        for (int s = 0; s < 3; ++s) for (size_t i = gtid; i < cnt8[s]; i += gn) convert_chunk(srcs[s], dsts[s], i);
        for (size_t i = gtid; i < (size_t)2 * 2048 * 32; i += gn) { const int which = (int)(i / (2048 * 32)); const int k = (int)(i / 32) % 2048, c8 = (int)(i % 32) * 8;
            uint4 o = {0u, 0u, 0u, 0u};
            if (c8 < 128) { const float* W = a.in[which ? I_WC1V : I_WC1K] + (size_t)k * 128 + c8; const float4 x = *(const float4*)W, y = *(const float4*)(W + 4); o.x = cvtpk(x.x, x.y); o.y = cvtpk(x.z, x.w); o.z = cvtpk(y.x, y.y); o.w = cvtpk(y.z, y.w); }
            *(uint4*)((bf16_t*)(ws + WS_WC1) + i * 8) = o; }
        for (size_t i = gtid; i < (size_t)2 * 128 * 32; i += gn) { const int which = (int)(i / (128 * 32)); const int k = (int)(i / 32) % 128, c8 = (int)(i % 32) * 8;
            uint4 o = {0u, 0u, 0u, 0u};
            if (c8 < 64) { const float* W = a.in[which ? I_WC2V : I_WC2K] + (size_t)k * 64 + c8; const float4 x = *(const float4*)W, y = *(const float4*)(W + 4); o.x = cvtpk(x.x, x.y); o.y = cvtpk(x.z, x.w); o.z = cvtpk(y.x, y.y); o.w = cvtpk(y.z, y.w); }
            *(uint4*)((bf16_t*)(ws + WS_WC2) + i * 8) = o; }
    }
    {
        const float* W = a.in[I_WIN]; bf16_t* O = (bf16_t*)(ws + WS_WIN);
        for (size_t i = gtid; i < (size_t)1024 * (NWIN / 8); i += gn) {
            const int k = (int)(i / (NWIN / 8)), j = (int)(i % (NWIN / 8)) * 8;
            uint4 o = {0u, 0u, 0u, 0u};
            if (j < 2848) {
                const int sj = (j < 1280) ? j : (j < 2816) ? j + 24 : (j < 2840) ? j - 1536 : j;
                const float4 x = *(const float4*)(W + (size_t)k * 2848 + sj), y = *(const float4*)(W + (size_t)k * 2848 + sj + 4);
                o.x = cvtpk(x.x, x.y); o.y = cvtpk(x.z, x.w); o.z = cvtpk(y.x, y.y); o.w = cvtpk(y.z, y.w);
            }
            *(uint4*)(O + (size_t)k * NWIN + j) = o;
        }
    }
    const int lane = TID() & 63; const int gw = BID() * NWAVE + (TID() >> 6), ngw = gridDim.x * NWAVE;
    {
        const float* X = a.in[I_X]; const float* g = a.in[I_LN1]; bf16_t* XN = (bf16_t*)(ws + WS_XN);
        for (int m = gw; m < NTOK; m += ngw) {
            float4 v[4]; float s = 0.f;
#pragma unroll
            for (int j = 0; j < 4; ++j) { v[j] = *(const float4*)(X + (size_t)m * 1024 + j * 256 + lane * 4); s += v[j].x * v[j].x + v[j].y * v[j].y + v[j].z * v[j].z + v[j].w * v[j].w; }
            const float rstd = rsqrtf(wave_sum(s) * (1.f / 1024.f) + EPS);
#pragma unroll
            for (int j = 0; j < 4; ++j) { const float4 gg = *(const float4*)(g + j * 256 + lane * 4);
                uint2 o; o.x = cvtpk(v[j].x * rstd * gg.x, v[j].y * rstd * gg.y); o.y = cvtpk(v[j].z * rstd * gg.z, v[j].w * rstd * gg.w);
                *(uint2*)(XN + (size_t)m * 1024 + j * 256 + lane * 4) = o; }
        }
    }
    if (gw < 256) {
        const int which = gw >> 7, n = gw & 127; const float* pe = a.in[which ? I_PEV : I_PEK]; const float* w1 = a.in[which ? I_WC1V : I_WC1K];
        float s = 0.f;
#pragma unroll 8
        for (int i = 0; i < 32; ++i) { const int k = lane + 64 * i; s += pe[k] * w1[(size_t)k * 128 + n]; }
        s = wave_sum(s);
        if (lane == 0) ((float*)(ws + WS_BIAS1))[which * 128 + n] = s;
    }
}

DEV void phase_inproj(const Args& a, unsigned char* smem) {
    const bf16_t* XN = (const bf16_t*)(a.ws + WS_XN); const bf16_t* W = (const bf16_t*)(a.ws + WS_WIN);
    bf16_t* PROJ = (bf16_t*)(a.ws + WS_PROJ); float* GN = (float*)(a.ws + WS_GN); float* LS = (float*)(a.ws + WS_LS); const float* bfg = a.in[I_BFG];
    int lane = TID() & 63, wid = TID() >> 6, wr = wid >> 2, wc = wid & 3; (void)wr; (void)wc; (void)lane;
    bool pre = false;
    for (int item = VBID(); item < 64 * 12; item += gridDim.x) {
        int mt, nt; patch_decode(item, 64, 12, mt, nt);
        const int nitem = item + (int)gridDim.x; const bool has_next = nitem < 64 * 12; int mtn = 0, ntn = 0; if (has_next) patch_decode(nitem, 64, 12, mtn, ntn);
        f32x4 acc[8][4];
        auto aoffi = [](int r, int kc) { return (unsigned)(r * 2048 + kc * 16); }; auto boffi = [](int k, int nc) { return (unsigned)(k * (NWIN * 2) + nc * 16); };
        gemm256<true>(smem, 16, XN + (size_t)mt * 256 * 1024, 128u, aoffi, W + nt * 256, (unsigned)(64 * NWIN * 2), boffi, acc, pre,
                      next_tile(has_next, smem, XN + (size_t)mtn * 256 * 1024, aoffi, W + ntn * 256, boffi));
        pre = has_next;
        EPI_IDS();
#pragma unroll
        for (int mi = 0; mi < 8; ++mi) {
            const int gm = mt * 256 + G_ROW(mi); const int b = gm >> 13, t = gm & 8191;
            if (nt < 11) {
#pragma unroll
                for (int np = 0; np < 2; ++np) { const int n0 = G_COL(2 * np); const int hs = nt * 4 + (n0 >> 6), d0 = n0 & 63; const float sc = (hs < 8 || (hs >= 20 && hs < 28)) ? QS : 1.0f;
                    const f32x4 v0 = acc[mi][2 * np], v1 = acc[mi][2 * np + 1]; uint2 oa, ob; oa.x = cvtpk(v0[0] * sc, v0[1] * sc); oa.y = cvtpk(v0[2] * sc, v0[3] * sc); ob.x = cvtpk(v1[0] * sc, v1[1] * sc); ob.y = cvtpk(v1[2] * sc, v1[3] * sc);
                    *(uint4*)(PROJ + (((size_t)(hs * 2 + b)) * 8192 + t) * 64 + PAIR16_COL(d0, d0 + 16)) = pair16(oa, ob); }
            }
#pragma unroll
            for (int ni = 0; ni < 4; ++ni) {
                const int n = G_COL(ni); const f32x4 v = acc[mi][ni];
                if (nt < 11) {
                } else if (n < 24) {
#pragma unroll
                    for (int r = 0; r < 4; ++r) GN[(size_t)gm * 24 + n + r] = sigmoidf_(v[r]);
                } else if (n < 32) {
#pragma unroll
                    for (int r = 0; r < 4; ++r) { const int h = n - 24 + r; LS[((size_t)(b * 8 + h)) * 8192 + t] = logsigmoidf_(v[r] + bfg[h]); }
                }
            }
        }
    }
}

DEV void signal_done(unsigned* flag) {
    asm volatile("s_waitcnt vmcnt(0)" ::: "memory");
    __syncthreads();
    if (TID() == 0) { __builtin_amdgcn_fence(__ATOMIC_RELEASE, "agent"); asm volatile("s_waitcnt vmcnt(0)" ::: "memory"); __hip_atomic_fetch_add(flag, 1u, __ATOMIC_RELAXED, __HIP_MEMORY_SCOPE_AGENT); }
}
DEV void wait_flag(unsigned* flag, unsigned target) {
    if (TID() == 0) { unsigned sp = 0u; while (__hip_atomic_load(flag, __ATOMIC_RELAXED, __HIP_MEMORY_SCOPE_AGENT) < target) { __builtin_amdgcn_s_sleep(4); if (++sp > (1u << 24)) break; }
        __builtin_amdgcn_fence(__ATOMIC_ACQUIRE, "agent"); asm volatile("s_waitcnt vmcnt(0)" ::: "memory"); }
    __syncthreads();
}
constexpr int CW_CUMFLAG = 128, CW_CMPFLAG = 192, CW_GATEFLAG = 256;
DEV void cmp_item(const Args& a, unsigned char* smem, int item) {
    const bf16_t* PROJ = (const bf16_t*)(a.ws + WS_PROJ);
    const int tid = TID(); int lane = tid & 63, wid = tid >> 6, wr = wid >> 2, wc = wid & 3; (void)wr; (void)wc; (void)lane;
    {
        if (item < 16) {
            const int which = item >> 3, b = (item >> 2) & 1, g = (item >> 1) & 1, mt = item & 1;
            const bf16_t* base = PROJ + ((size_t)((8 + 2 * which + g) * 2 + b)) * 8192 * 64;
            const bf16_t* W1 = (const bf16_t*)(a.ws + WS_WC1) + (size_t)which * 2048 * 256;
            const bf16_t* W2 = (const bf16_t*)(a.ws + WS_WC2) + (size_t)which * 128 * 256;
            const float* bias1 = (const float*)(a.ws + WS_BIAS1) + which * 128;
            bf16_t* HID = (bf16_t*)(a.ws + WS_HID) + ((size_t)(which * 4 + b * 2 + g)) * 512 * 128;
            bf16_t* OUT = (bf16_t*)(a.ws + WS_KC) + ((size_t)(which * 4 + b * 2 + g)) * 512 * 64;
            f32x4 acc[8][4];
            gemm256s<true>(smem, 32, base, 128u, [&](int r, int kc) { int c = mt * 256 + r; c = c > 510 ? 510 : c; return (unsigned)(c * 2048 + kc * 16); },
                          W1, 64u * 512u, [&](int k, int nc) { return (unsigned)(k * 512 + nc * 16); }, acc);
        EPI_IDS();
            if (wc < 2) {
                float4 bb4[4];
#pragma unroll
                for (int ni = 0; ni < 4; ++ni) bb4[ni] = *(const float4*)(bias1 + wc * 64 + ni * 16 + 4 * (lane >> 4));
#pragma unroll
                for (int mi = 0; mi < 8; ++mi) { const int c = mt * 256 + wr * 128 + mi * 16 + (lane & 15);
#pragma unroll
                    for (int ni = 0; ni < 4; ++ni) { const int n = wc * 64 + ni * 16 + 4 * (lane >> 4); const f32x4 v = acc[mi][ni]; const float4 bb = bb4[ni];
                        uint2 o; o.x = cvtpk(gelu_tanh(v[0] + bb.x), gelu_tanh(v[1] + bb.y)); o.y = cvtpk(gelu_tanh(v[2] + bb.z), gelu_tanh(v[3] + bb.w));
                        *(uint2*)(HID + (size_t)c * 128 + n) = o; } }
            }
            __syncthreads();
            gemm256s<true>(smem, 2, HID + (size_t)mt * 256 * 128, 128u, [&](int r, int kc) { return (unsigned)(r * 256 + kc * 16); },
                          W2, 64u * 512u, [&](int k, int nc) { return (unsigned)(k * 512 + nc * 16); }, acc);
        EPI_IDS();
            if (wc == 0) {
#pragma unroll
                for (int mi = 0; mi < 8; ++mi) { const int c = mt * 256 + wr * 128 + mi * 16 + (lane & 15);
#pragma unroll
                    for (int ni = 0; ni < 4; ++ni) { const int n = ni * 16 + 4 * (lane >> 4); const f32x4 v = acc[mi][ni];
                        uint2 o; o.x = cvtpk(v[0], v[1]); o.y = cvtpk(v[2], v[3]);
                        if (c >= 511) { o.x = 0u; o.y = 0u; }
                        *(uint2*)(OUT + (size_t)c * 64 + n) = o; } }
            }
            signal_done((unsigned*)(a.ws + WS_CTL) + CW_CMPFLAG);
        } else {
            const int bh = item - 16; const float* LS = (const float*)(a.ws + WS_LS) + (size_t)bh * 8192; float* CUM = (float*)(a.ws + WS_CUM) + (size_t)bh * 8192;
            float* sc = (float*)smem;
            float v[16]; float s = 0.f;
#pragma unroll
            for (int j = 0; j < 4; ++j) { const float4 x = *(const float4*)(LS + tid * 16 + j * 4); v[4 * j] = x.x; v[4 * j + 1] = x.y; v[4 * j + 2] = x.z; v[4 * j + 3] = x.w; }
#pragma unroll
            for (int j = 0; j < 16; ++j) { s += v[j]; v[j] = s; }
            sc[tid] = s; __syncthreads();
            if (tid == 0) { float run = 0.f; for (int i = 0; i < NTHR; ++i) { const float x = sc[i]; sc[i] = run; run += x; } }
            __syncthreads();
            const float off = sc[tid];
#pragma unroll
            for (int j = 0; j < 4; ++j) { float4 o = {v[4 * j] + off, v[4 * j + 1] + off, v[4 * j + 2] + off, v[4 * j + 3] + off}; *(float4*)(CUM + tid * 16 + j * 4) = o; }
            signal_done((unsigned*)(a.ws + WS_CTL) + CW_CUMFLAG + bh);
        }
    }
}

constexpr int AT_STAGE = 16384;
constexpr int AT_BIAS_OFF = 3 * AT_STAGE;
constexpr int AT_IMP_OFF = AT_BIAS_OFF + 1024;
constexpr int AT_SEL_OFF = AT_IMP_OFF + 65536;
constexpr int AT_WUN_OFF = AT_SEL_OFF + 1024;
constexpr int AT_UCNT_OFF = AT_WUN_OFF + 128;
constexpr int AT_ULIST_OFF = AT_UCNT_OFF + 16;
constexpr int AT_ITEM_OFF = AT_ULIST_OFF + 128;
static_assert(AT_ITEM_OFF + 16 <= GEMM_LDS, "attention LDS map");
#define NEG_INF (-__builtin_inff())

#define KV_DECL uint4 rk0_, rv0_
#define KV_GLOAD(Kt, Vt) do { rk0_ = *(const uint4*)((Kt) + tid * 8); rv0_ = *(const uint4*)((Vt) + tid * 8); } while (0)
#define KV_LSTORE(stp) do { unsigned char* st_ = (stp); const int key = tid >> 3, ch = tid & 7; \
      *(uint4*)(st_ + key * 128 + ((ch ^ (key & 7)) << 4)) = rk0_; \
      *(uint4*)(st_ + 8192 + key * 128 + ((((ch >> 2) ^ ((key >> 1) & 1))) << 6) + ((ch & 3) << 4)) = rv0_; } while (0)
template <bool FULL>
DEV void qk_tile(const unsigned char* Kst, const bf16x8 (&qf)[4], f32x16& p0, f32x16& p1, int lane) {
    const int key = lane & 31, hi = lane >> 5;
    if (FULL) {
        bf16x8 k0[4], k1[4];
#pragma unroll
        for (int ks = 0; ks < 4; ++ks) { const int ch = 2 * ks + hi; const int off = key * 128 + ((ch ^ (key & 7)) << 4);
            k0[ks] = *(const bf16x8*)(Kst + off); k1[ks] = *(const bf16x8*)(Kst + off + 32 * 128); }
        __builtin_amdgcn_sched_barrier(0);
#pragma unroll
        for (int ks = 0; ks < 4; ++ks) {
            p0 = __builtin_amdgcn_mfma_f32_32x32x16_bf16(k0[ks], qf[ks], p0, 0, 0, 0);
            p1 = __builtin_amdgcn_mfma_f32_32x32x16_bf16(k1[ks], qf[ks], p1, 0, 0, 0); }
    } else {
        bf16x8 kk[4];
#pragma unroll
        for (int ks = 0; ks < 4; ++ks) { const int ch = 2 * ks + hi; kk[ks] = *(const bf16x8*)(Kst + key * 128 + ((ch ^ (key & 7)) << 4)); }
        __builtin_amdgcn_sched_barrier(0);
#pragma unroll
        for (int ks = 0; ks < 4; ++ks) p0 = __builtin_amdgcn_mfma_f32_32x32x16_bf16(kk[ks], qf[ks], p0, 0, 0, 0);
        __builtin_amdgcn_sched_barrier(0);
#pragma unroll
        for (int ks = 0; ks < 4; ++ks) { const int ch = 2 * ks + hi; kk[ks] = *(const bf16x8*)(Kst + key * 128 + ((ch ^ (key & 7)) << 4) + 32 * 128); }
        __builtin_amdgcn_sched_barrier(0);
#pragma unroll
        for (int ks = 0; ks < 4; ++ks) p1 = __builtin_amdgcn_mfma_f32_32x32x16_bf16(kk[ks], qf[ks], p1, 0, 0, 0);
    }
}
template <bool FULL>
DEV void pv_tile(const unsigned char* Vst, const f32x16& p0, const f32x16& p1, f32x16 (&o)[2], int lane) {
    const int hi = lane >> 5, i = lane & 15, gg = (lane >> 4) & 1;
    const int q = i >> 2; const int sw = (q >> 1) & 1;
    bf16x8 pa[4];
#pragma unroll
    for (int s = 0; s < 4; ++s) { const f32x16& p = (s < 2) ? p0 : p1; const int b = (s & 1) * 8;
        unsigned w[4];
#pragma unroll
        for (int j = 0; j < 4; ++j) w[j] = cvtpk(p[b + 2 * j], p[b + 2 * j + 1]);
        typedef unsigned u32x4_t __attribute__((ext_vector_type(4)));
        u32x4_t ww = {w[0], w[1], w[2], w[3]}; pa[s] = __builtin_bit_cast(bf16x8, ww); }
    constexpr int NB = FULL ? 1 : 2, SB = FULL ? 4 : 2;
#pragma unroll
    for (int bt = 0; bt < NB; ++bt) {
        s16x4 vlo[SB][2], vhi[SB][2];
#pragma unroll
        for (int s_ = 0; s_ < SB; ++s_)
#pragma unroll
            for (int dh = 0; dh < 2; ++dh) { const int s = bt * SB + s_; const int row0 = 16 * s + 4 * hi + q;
                const unsigned char* p = Vst + row0 * 128 + ((dh ^ sw) << 6) + gg * 32 + (i & 3) * 8;
                vlo[s_][dh] = tr_read(p); vhi[s_][dh] = tr_read(p + 8 * 128); }
        __builtin_amdgcn_sched_barrier(0);
#pragma unroll
        for (int s_ = 0; s_ < SB; ++s_)
#pragma unroll
            for (int dh = 0; dh < 2; ++dh) { const int s = bt * SB + s_;
                const bf16x8 vf = {vlo[s_][dh][0], vlo[s_][dh][1], vlo[s_][dh][2], vlo[s_][dh][3], vhi[s_][dh][0], vhi[s_][dh][1], vhi[s_][dh][2], vhi[s_][dh][3]};
                o[dh] = __builtin_amdgcn_mfma_f32_32x32x16_bf16(vf, pa[s], o[dh], 0, 0, 0); }
        __builtin_amdgcn_sched_barrier(0);
    }
}
DEV float rowmax32(const f32x16& p0, const f32x16& p1) {
    float a = fmaxf(p0[0], p1[0]), b = fmaxf(p0[1], p1[1]);
#pragma unroll
    for (int r = 2; r < 16; r += 2) { a = fmaxf(fmaxf(a, p0[r]), p1[r]); b = fmaxf(fmaxf(b, p0[r + 1]), p1[r + 1]); }
    return pair_max(fmaxf(a, b));
}
DEV void softmax_step(f32x16& p0, f32x16& p1, float& m, float& l, f32x16 (&o)[2]) {
    const float mt = rowmax32(p0, p1); const float mn = fmaxf(m, mt); const float alpha = __builtin_amdgcn_exp2f(m - mn);
    float rs = 0.f;
#pragma unroll
    for (int r = 0; r < 16; ++r) { p0[r] = __builtin_amdgcn_exp2f(p0[r] - mn); p1[r] = __builtin_amdgcn_exp2f(p1[r] - mn); rs += p0[r] + p1[r]; }
    rs = pair_sum(rs);
    l = l * alpha + rs; m = mn;
    if (__any(alpha != 1.0f)) { o[0] *= alpha; o[1] *= alpha; }
}
DEV void softmax_step_nosum(f32x16& p0, f32x16& p1, float& m, f32x16 (&o)[2], f32x16& lacc) {
    const float mt = rowmax32(p0, p1); const float mn = fmaxf(m, mt); const float alpha = __builtin_amdgcn_exp2f(m - mn);
#pragma unroll
    for (int r = 0; r < 16; ++r) { p0[r] = __builtin_amdgcn_exp2f(p0[r] - mn); p1[r] = __builtin_amdgcn_exp2f(p1[r] - mn); }
    m = mn;
    if (__any(alpha != 1.0f)) { o[0] *= alpha; o[1] *= alpha; lacc *= alpha; }
}
DEV void pv_tile_sum(const unsigned char* Vst, const f32x16& p0, const f32x16& p1, f32x16 (&o)[2], f32x16& lacc, int lane) {
    const int hi = lane >> 5, i = lane & 15, gg = (lane >> 4) & 1;
    const int q = i >> 2; const int sw = (q >> 1) & 1;
    bf16x8 pa[4];
#pragma unroll
    for (int s = 0; s < 4; ++s) { const f32x16& p = (s < 2) ? p0 : p1; const int b = (s & 1) * 8;
        unsigned w[4];
#pragma unroll
        for (int j = 0; j < 4; ++j) w[j] = cvtpk(p[b + 2 * j], p[b + 2 * j + 1]);
        typedef unsigned u32x4_t __attribute__((ext_vector_type(4)));
        u32x4_t ww = {w[0], w[1], w[2], w[3]}; pa[s] = __builtin_bit_cast(bf16x8, ww); }
    const bf16x8 ones = {0x3f80, 0x3f80, 0x3f80, 0x3f80, 0x3f80, 0x3f80, 0x3f80, 0x3f80};
#pragma unroll
    for (int bt = 0; bt < 2; ++bt) {
        s16x4 vlo[2][2], vhi[2][2];
#pragma unroll
        for (int s_ = 0; s_ < 2; ++s_)
#pragma unroll
            for (int dh = 0; dh < 2; ++dh) { const int s = bt * 2 + s_; const int row0 = 16 * s + 4 * hi + q;
                const unsigned char* p = Vst + row0 * 128 + ((dh ^ sw) << 6) + gg * 32 + (i & 3) * 8;
                vlo[s_][dh] = tr_read(p); vhi[s_][dh] = tr_read(p + 8 * 128); }
        __builtin_amdgcn_sched_barrier(0);
#pragma unroll
        for (int s_ = 0; s_ < 2; ++s_) { const int s = bt * 2 + s_;
            lacc = __builtin_amdgcn_mfma_f32_32x32x16_bf16(ones, pa[s], lacc, 0, 0, 0);
#pragma unroll
            for (int dh = 0; dh < 2; ++dh) {
                const bf16x8 vf = {vlo[s_][dh][0], vlo[s_][dh][1], vlo[s_][dh][2], vlo[s_][dh][3], vhi[s_][dh][0], vhi[s_][dh][1], vhi[s_][dh][2], vhi[s_][dh][3]};
                o[dh] = __builtin_amdgcn_mfma_f32_32x32x16_bf16(vf, pa[s], o[dh], 0, 0, 0); } }
        __builtin_amdgcn_sched_barrier(0);
    }
}
template <int STRIDE> DEV void mask_tile(f32x16& p0, f32x16& p1, int kpos0, int lo, int hi_lim, int hi) {
#pragma unroll
    for (int r = 0; r < 16; ++r) { const int kp = kpos0 + STRIDE * crow(r, hi);
        if (kp < lo || kp > hi_lim) p0[r] = NEG_INF;
        const int kp1 = kp + 32 * STRIDE; if (kp1 < lo || kp1 > hi_lim) p1[r] = NEG_INF; }
}
template <int STRIDE> DEV void alibi_init(f32x16& p0, f32x16& p1, float slope2, int kpos0, int tref, int hi) {
    const float base = slope2 * (float)(kpos0 - tref + STRIDE * 4 * hi);
#pragma unroll
    for (int r = 0; r < 16; ++r) { const float c = (float)(STRIDE * ((r & 3) + 8 * (r >> 2))); p0[r] = fmaf(slope2, c, base); p1[r] = fmaf(slope2, c + (float)(32 * STRIDE), base); }
}
template <class Src, class Body, class NSrc>
DEV int kv_pipeline(unsigned char* smem, int n, const Src& src, const Body& body, int par, bool pre, bool has_next, const NSrc& nsrc) {
    KV_DECL; const int tid = TID(); const bf16_t *kp, *vp;
    if (!pre) { src(0, kp, vp); KV_GLOAD(kp, vp); KV_LSTORE(smem + par * AT_STAGE); __syncthreads(); }
    for (int j = 0; j < n; ++j) {
        const bool more = j + 1 < n;
        src(more ? j + 1 : j, kp, vp); if (!more && has_next) nsrc(kp, vp);
        KV_GLOAD(kp, vp);
        body(j, smem + ((par + j) & 1) * AT_STAGE);
        KV_LSTORE(smem + ((par + j + 1) & 1) * AT_STAGE);
        __syncthreads();
    }
    return (par + n) & 1;
}
struct NoSrc { DEV void operator()(const bf16_t*&, const bf16_t*&) const {} };

constexpr int CV_PER_STEP = 373; constexpr int CV_NUP = 32 * 1024 * 2048 / 8, CV_NDN = 32 * 1024 * 1024 / 8;
static_assert((long long)33792 * CV_PER_STEP >= (long long)CV_NUP + CV_NDN, "conversion coverage");
DEV void fox_item(const Args& a, unsigned char* smem, int fi, int b, int h, int qb) {
    const int tid = TID(), lane = tid & 63, wid = tid >> 6, r32 = lane & 31, hi = lane >> 5;
    const bf16_t* PROJ = (const bf16_t*)(a.ws + WS_PROJ);
    const bf16_t* Q = PROJ + ((size_t)((20 + h) * 2 + b)) * 8192 * 64; const bf16_t* K = PROJ + ((size_t)((28 + h) * 2 + b)) * 8192 * 64; const bf16_t* V = PROJ + ((size_t)((36 + h) * 2 + b)) * 8192 * 64;
    const float* CUM = (const float*)(a.ws + WS_CUM) + (size_t)(b * 8 + h) * 8192;
    const int q0 = qb * 256; const int qrow = q0 + 32 * wid + r32;
    bf16x8 qf[4];
#pragma unroll
    for (int ks = 0; ks < 4; ++ks) qf[ks] = *(const bf16x8*)(Q + (size_t)qrow * 64 + 16 * ks + 8 * hi);
    const float cref = CUM[q0];
    const int ntiles = 4 * qb + 4; const int jmax_w = (q0 + 32 * wid + 31) >> 6; const int jmask_w = (q0 + 32 * wid) >> 6;
    f32x16 o[2]; o[0] = (f32x16){}; o[1] = (f32x16){}; f32x16 lacc = (f32x16){}; float m = -1e30f;
    float* biasL = (float*)(smem + AT_BIAS_OFF);
    const int gq_ = fi >> 4; const int sidx0 = 16 * (128 * gq_ - 2 * gq_ * (gq_ - 1)) + (fi & 15) * (128 - 4 * gq_);
    bf16_t* cvdA = nullptr; bf16_t* cvdB = nullptr; float4 cvaA, cvbA, cvaB, cvbB;
    KV_DECL; float breg = 0.f;
#define TJ(s_) (ntiles - 1 - (s_))
#define CV_ADDR(st_, SRC, DST) do { int c_ = (sidx0 + (st_)) * CV_PER_STEP + (tid < CV_PER_STEP ? tid : CV_PER_STEP - 1); c_ = c_ < CV_NUP + CV_NDN ? c_ : CV_NUP + CV_NDN - 1; \
        const bool up_ = c_ < CV_NUP; const int cc_ = up_ ? c_ : c_ - CV_NUP; SRC = (up_ ? a.in[I_WUP] : a.in[I_WDN]) + (size_t)cc_ * 8; DST = (bf16_t*)(a.ws + (up_ ? WS_WUP : WS_WDN)) + (size_t)cc_ * 8; } while (0)
    { const float* cvs_; CV_ADDR(0, cvs_, cvdB); cvaB = *(const float4*)cvs_; cvbB = *(const float4*)(cvs_ + 4); }
    KV_GLOAD(K + (size_t)TJ(0) * 4096, V + (size_t)TJ(0) * 4096); breg = CUM[TJ(0) * 64 + lane];
    KV_LSTORE(smem); biasL[lane] = (cref - breg) * LOG2E;
    KV_GLOAD(K + (size_t)TJ(1) * 4096, V + (size_t)TJ(1) * 4096); breg = CUM[TJ(1) * 64 + lane];
    KV_LSTORE(smem + AT_STAGE); biasL[64 + lane] = (cref - breg) * LOG2E;
    __syncthreads();
#define FOX_QK(P0, P1, jj, sj) do { const float* bl_ = biasL + (sj) * 64; \
        _Pragma("unroll") for (int g4 = 0; g4 < 4; ++g4) { const float4 x_ = *(const float4*)(bl_ + 8 * g4 + 4 * hi), y_ = *(const float4*)(bl_ + 32 + 8 * g4 + 4 * hi); \
            P0[4 * g4] = x_.x; P0[4 * g4 + 1] = x_.y; P0[4 * g4 + 2] = x_.z; P0[4 * g4 + 3] = x_.w; P1[4 * g4] = y_.x; P1[4 * g4 + 1] = y_.y; P1[4 * g4 + 2] = y_.z; P1[4 * g4 + 3] = y_.w; } \
        qk_tile<true>(smem + (sj) * AT_STAGE, qf, P0, P1, lane); \
        if ((jj) >= jmask_w) mask_tile<1>(P0, P1, 64 * (jj), -1, qrow, hi); } while (0)
#define FOX_STEP(CUR0, CUR1, NXT0, NXT1, j, CVD_LD, CVA_LD, CVB_LD, CVD_ST, CVA_ST, CVB_ST) do { \
        const int s_cur = (j) % 3, s_nxt = ((j) + 1) % 3, s_ld = ((j) + 2) % 3; const int tl_ = TJ((j) + 2) < 0 ? 0 : TJ((j) + 2);     \
        KV_GLOAD(K + (size_t)tl_ * 4096, V + (size_t)tl_ * 4096); breg = CUM[tl_ * 64 + lane]; \
        { const float* cvs_; CV_ADDR(j, cvs_, CVD_LD); CVA_LD = *(const float4*)cvs_; CVB_LD = *(const float4*)(cvs_ + 4); } \
        if ((j) + 1 < ntiles && TJ((j) + 1) <= jmax_w) FOX_QK(NXT0, NXT1, TJ((j) + 1), s_nxt); \
        __builtin_amdgcn_sched_barrier(0); \
        if (TJ(j) <= jmax_w) { softmax_step_nosum(CUR0, CUR1, m, o, lacc); pv_tile_sum(smem + s_cur * AT_STAGE + 8192, CUR0, CUR1, o, lacc, lane); } \
        KV_LSTORE(smem + s_ld * AT_STAGE); biasL[s_ld * 64 + lane] = (cref - breg) * LOG2E; \
        { uint4 o_; o_.x = cvtpk(CVA_ST.x, CVA_ST.y); o_.y = cvtpk(CVA_ST.z, CVA_ST.w); o_.z = cvtpk(CVB_ST.x, CVB_ST.y); o_.w = cvtpk(CVB_ST.z, CVB_ST.w); *(uint4*)CVD_ST = o_; } \
        __syncthreads(); } while (0)
    f32x16 pA0, pA1, pB0, pB1;
    if (TJ(0) <= jmax_w) FOX_QK(pA0, pA1, TJ(0), 0);
    for (int j = 0; j < ntiles; j += 2) {
        FOX_STEP(pA0, pA1, pB0, pB1, j, cvdA, cvaA, cvbA, cvdB, cvaB, cvbB);
        FOX_STEP(pB0, pB1, pA0, pA1, j + 1, cvdB, cvaB, cvbB, cvdA, cvaA, cvbA);
    }
    { uint4 o_; o_.x = cvtpk(cvaB.x, cvaB.y); o_.y = cvtpk(cvaB.z, cvaB.w); o_.z = cvtpk(cvbB.x, cvbB.y); o_.w = cvtpk(cvbB.z, cvbB.w); *(uint4*)cvdB = o_; }
#undef CV_ADDR
#undef FOX_QK
#undef FOX_STEP
#undef TJ
    const float inv = 1.0f / lacc[0]; float ss = 0.f;
    const size_t token = (size_t)b * 8192 + qrow;
    bf16_t* O = (bf16_t*)(a.ws + WS_OFOX) + token * 512 + h * 64;
#pragma unroll
    for (int dh = 0; dh < 2; ++dh)
#pragma unroll
        for (int g4 = 0; g4 < 4; ++g4) { const float v0 = o[dh][4 * g4] * inv, v1 = o[dh][4 * g4 + 1] * inv, v2 = o[dh][4 * g4 + 2] * inv, v3 = o[dh][4 * g4 + 3] * inv;
            ss += v0 * v0 + v1 * v1 + v2 * v2 + v3 * v3; uint2 w; w.x = cvtpk(v0, v1); w.y = cvtpk(v2, v3); *(uint2*)(O + 32 * dh + 8 * g4 + 4 * hi) = w; }
    ss = pair_sum(ss);
    if (hi == 0) ((float*)(a.ws + WS_SSQ))[token * 16 + 8 + h] = ss;
}

DEV void nsa_item(const Args& a, unsigned char* smem, int b, int g, int tt) {
    const int tid = TID(), lane = tid & 63, wid = tid >> 6, col = lane & 31, hi = lane >> 5;
    const int t0 = tt * 64, tokw = col >> 2, r = col & 3, h = 4 * g + r; const int tokl = wid * 8 + tokw; const int t = t0 + tokl; const size_t token = (size_t)b * 8192 + t;
    const float slope2 = exp2f(-(float)(h + 1)) * LOG2E;
    const bf16_t* PROJ = (const bf16_t*)(a.ws + WS_PROJ);
    const float* GN = (const float*)(a.ws + WS_GN) + token * 24 + h * 3;
    const int cur = tt; const bool need_topk = cur > 15;
    bf16x8 qf[4];
    { const bf16_t* Q = PROJ + (((size_t)(h * 2 + b)) * 8192 + t) * 64;
#pragma unroll
      for (int ks = 0; ks < 4; ++ks) qf[ks] = *(const bf16x8*)(Q + 16 * ks + 8 * hi); }
    float* impw = (float*)(smem + AT_IMP_OFF) + wid * 2048; float* totw = impw + lane;
    unsigned* selmask = (unsigned*)(smem + AT_SEL_OFF); unsigned* wun = (unsigned*)(smem + AT_WUN_OFF); int* ucnt = (int*)(smem + AT_UCNT_OFF); unsigned char* ulist = smem + AT_ULIST_OFF;
    f32x16 o[2]; float m, l; int par = 0;
    const int tmin_w = t0 + wid * 8, tmax_w = tmin_w + 7;
    {
        const bf16_t* KC = (const bf16_t*)(a.ws + WS_KC) + ((size_t)(0 * 4 + b * 2 + g)) * 512 * 64; const bf16_t* VC = (const bf16_t*)(a.ws + WS_KC) + ((size_t)(1 * 4 + b * 2 + g)) * 512 * 64;
        const int ncv = t0 / 16 + 3; const int nct = (ncv + 63) >> 6;
        auto src = [&](int j, const bf16_t*& kp, const bf16_t*& vp) { kp = KC + (size_t)j * 4096; vp = VC + (size_t)j * 4096; };
        m = -1e30f; l = 0.f;
        auto src0 = [&](const bf16_t*& kp, const bf16_t*& vp) { kp = KC; vp = VC; };
        par = kv_pipeline(smem, nct, src, [&](int j, const unsigned char* st) {
            const int kpos0 = 1024 * j + 31;
            if (kpos0 > tmax_w) return;
            f32x16 p0, p1; alibi_init<16>(p0, p1, slope2, kpos0, t0, hi);
            qk_tile<false>(st, qf, p0, p1, lane);
            if (kpos0 + 16 * 63 > tmin_w) mask_tile<16>(p0, p1, kpos0, -1, t, hi);
            const float mt = rowmax32(p0, p1); const float mn = fmaxf(m, mt); float rs = 0.f;
#pragma unroll
            for (int rr = 0; rr < 16; ++rr) rs += __builtin_amdgcn_exp2f(p0[rr] - mn) + __builtin_amdgcn_exp2f(p1[rr] - mn);
            rs = pair_sum(rs);
            l = l * __builtin_amdgcn_exp2f(m - mn) + rs; m = mn;
        }, 0, false, true, src0);
        const float linv = l > 0.f ? 1.0f / l : 0.f;
        if (need_topk) { for (int i = lane; i < 8 * 129; i += 64) impw[i] = 0.f; }
        o[0] = (f32x16){}; o[1] = (f32x16){};
        const bf16_t* KS0 = PROJ + ((size_t)((12 + g) * 2 + b)) * 8192 * 64 + (size_t)cur * 4096; const bf16_t* VS0 = PROJ + ((size_t)((14 + g) * 2 + b)) * 8192 * 64 + (size_t)cur * 4096;
        par = kv_pipeline(smem, nct, src, [&](int j, const unsigned char* st) {
            const int kpos0 = 1024 * j + 31;
            if (kpos0 > tmax_w) return;
            f32x16 p0, p1; alibi_init<16>(p0, p1, slope2, kpos0, t0, hi);
            qk_tile<false>(st, qf, p0, p1, lane);
            if (kpos0 + 16 * 63 > tmin_w) mask_tile<16>(p0, p1, kpos0, -1, t, hi);
#pragma unroll
            for (int rr = 0; rr < 16; ++rr) { p0[rr] = __builtin_amdgcn_exp2f(p0[rr] - m) * linv; p1[rr] = __builtin_amdgcn_exp2f(p1[rr] - m) * linv; }
            if (need_topk) {
#pragma unroll
                for (int half = 0; half < 2; ++half)
#pragma unroll
                    for (int g4 = 0; g4 < 4; ++g4) { const f32x16& p = half ? p1 : p0;
                        float ms = (p[4 * g4] + p[4 * g4 + 1]) + (p[4 * g4 + 2] + p[4 * g4 + 3]); float ls = p[4 * g4 + 3];
                        ms = quad_sum(ms); ls = quad_sum(ls);
                        const int n = 16 * j + 8 * half + 2 * g4 + hi;
                        if (r == 0) { atomicAdd(&impw[tokw * 129 + n], ms); atomicAdd(&impw[tokw * 129 + n + 1], ls); } }
            }
            pv_tile<false>(st + 8192, p0, p1, o, lane);
        }, par, true, true, [&](const bf16_t*& kp, const bf16_t*& vp) { kp = KS0; vp = VS0; });
    }
    {
        unsigned un0 = 0u, un1 = 0u, un2 = 0u, un3 = 0u;
        if (need_topk) {
#define TK_INIT(V0, V1, M0, M1, M2, M3, tk_) float V0 = impw[(tk_) * 129 + lane], V1 = impw[(tk_) * 129 + 64 + lane]; \
                V0 = (lane >= 1 && lane <= cur - 2) ? V0 : -1.0f; V1 = (lane + 64 <= cur - 2) ? V1 : -1.0f; unsigned M0 = 1u, M1 = 0u, M2 = 0u, M3 = 0u; \
                TK_SET(M0, M1, M2, M3, cur); TK_SET(M0, M1, M2, M3, cur - 1)
#define TK_SET(M0, M1, M2, M3, n_) do { const int n__ = (n_); const unsigned bit__ = 1u << (n__ & 31); const int w__ = n__ >> 5; M0 |= (w__ == 0) ? bit__ : 0u; M1 |= (w__ == 1) ? bit__ : 0u; M2 |= (w__ == 2) ? bit__ : 0u; M3 |= (w__ == 3) ? bit__ : 0u; } while (0)
#define TK_STEP(V0, V1, M0, M1, M2, M3) do { const float mx_ = wave_max_u(fmaxf(V0, V1)); const unsigned long long b0_ = __ballot(V0 == mx_), b1_ = __ballot(V1 == mx_); \
                const int n_ = b0_ ? (__ffsll((long long)b0_) - 1) : (63 + __ffsll((long long)b1_)); const bool hit_ = lane == (n_ & 63); \
                V0 = (hit_ && n_ < 64) ? -1.0f : V0; V1 = (hit_ && n_ >= 64) ? -1.0f : V1; TK_SET(M0, M1, M2, M3, n_); } while (0)
            for (int tk = 0; tk < 8; tk += 4) {
                TK_INIT(a0_, a1_, ma0, ma1, ma2, ma3, tk); TK_INIT(b0v, b1v, mb0, mb1, mb2, mb3, tk + 1); TK_INIT(c0v, c1v, mc0, mc1, mc2, mc3, tk + 2); TK_INIT(d0v, d1v, md0, md1, md2, md3, tk + 3);
                for (int it = 0; it < 13; ++it) { TK_STEP(a0_, a1_, ma0, ma1, ma2, ma3); TK_STEP(b0v, b1v, mb0, mb1, mb2, mb3); TK_STEP(c0v, c1v, mc0, mc1, mc2, mc3); TK_STEP(d0v, d1v, md0, md1, md2, md3); }
                if (lane == 0) { unsigned* sm_ = selmask + (wid * 8 + tk) * 4; sm_[0] = ma0; sm_[1] = ma1; sm_[2] = ma2; sm_[3] = ma3; sm_[4] = mb0; sm_[5] = mb1; sm_[6] = mb2; sm_[7] = mb3;
                    sm_[8] = mc0; sm_[9] = mc1; sm_[10] = mc2; sm_[11] = mc3; sm_[12] = md0; sm_[13] = md1; sm_[14] = md2; sm_[15] = md3; }
                un0 |= ma0 | mb0 | mc0 | md0; un1 |= ma1 | mb1 | mc1 | md1; un2 |= ma2 | mb2 | mc2 | md2; un3 |= ma3 | mb3 | mc3 | md3;
            }
#undef TK_INIT
#undef TK_SET
#undef TK_STEP
        } else {
            const unsigned full = (2u << cur) - 1u;
            un0 = full;
            if (lane < 8) { unsigned* sm_ = selmask + (wid * 8 + lane) * 4; sm_[0] = full; sm_[1] = 0u; sm_[2] = 0u; sm_[3] = 0u; }
        }
        if (lane == 0) { wun[wid * 4] = un0; wun[wid * 4 + 1] = un1; wun[wid * 4 + 2] = un2; wun[wid * 4 + 3] = un3; }
        __syncthreads();
        if (tid == 0) { int c = 0;
            for (int w = 0; w < 4; ++w) { unsigned u = 0u; for (int ww = 0; ww < NWAVE; ++ww) u |= wun[ww * 4 + w]; for (int bb = 0; bb < 32; ++bb) if ((u >> bb) & 1u) ulist[c++] = (unsigned char)(w * 32 + bb); }
            ucnt[0] = c; }
        __syncthreads();
    }
    { const float g0 = GN[0];
#pragma unroll
      for (int rr = 0; rr < 16; ++rr) { totw[rr * 64] = o[0][rr] * g0; totw[(16 + rr) * 64] = o[1][rr] * g0; } }
    {
        const bf16_t* KS = PROJ + ((size_t)((12 + g) * 2 + b)) * 8192 * 64; const bf16_t* VS = PROJ + ((size_t)((14 + g) * 2 + b)) * 8192 * 64;
        const int nu = ucnt[0];
        m = -1e30f; f32x16 lacc = (f32x16){}; o[0] = (f32x16){}; o[1] = (f32x16){};
        const bf16_t* KW0 = PROJ + ((size_t)((16 + g) * 2 + b)) * 8192 * 64 + (size_t)cur * 4096; const bf16_t* VW0 = PROJ + ((size_t)((18 + g) * 2 + b)) * 8192 * 64 + (size_t)cur * 4096;
        par = kv_pipeline(smem, nu, [&](int j, const bf16_t*& kp, const bf16_t*& vp) { const int n = ulist[nu - 1 - j]; kp = KS + (size_t)n * 4096; vp = VS + (size_t)n * 4096; },
            [&](int j, const unsigned char* st) {
                const int n = ulist[nu - 1 - j];
                if (!((wun[wid * 4 + (n >> 5)] >> (n & 31)) & 1u)) return;
                const bool sel = (selmask[tokl * 4 + (n >> 5)] >> (n & 31)) & 1u;
                f32x16 p0, p1; alibi_init<1>(p0, p1, slope2, 64 * n, t0, hi);
                qk_tile<false>(st, qf, p0, p1, lane);
                if (n == cur || !__all(sel)) mask_tile<1>(p0, p1, 64 * n, -1, sel ? t : -1, hi);
                softmax_step_nosum(p0, p1, m, o, lacc);
                pv_tile_sum(st + 8192, p0, p1, o, lacc, lane);
            }, par, true, true, [&](const bf16_t*& kp, const bf16_t*& vp) { kp = KW0; vp = VW0; });
        const float g1 = GN[1] / fmaxf(lacc[0], 1e-30f);
#pragma unroll
        for (int rr = 0; rr < 16; ++rr) { totw[rr * 64] += o[0][rr] * g1; totw[(16 + rr) * 64] += o[1][rr] * g1; }
    }
    {
        const bf16_t* KW = PROJ + ((size_t)((16 + g) * 2 + b)) * 8192 * 64; const bf16_t* VW = PROJ + ((size_t)((18 + g) * 2 + b)) * 8192 * 64;
        const int jlo = (t0 - 511) > 0 ? ((t0 - 511) >> 6) : 0; const int jhi = cur;
        m = -1e30f; f32x16 lacc = (f32x16){}; o[0] = (f32x16){}; o[1] = (f32x16){};
        (void)kv_pipeline(smem, jhi - jlo + 1, [&](int j, const bf16_t*& kp, const bf16_t*& vp) { kp = KW + (size_t)(jhi - j) * 4096; vp = VW + (size_t)(jhi - j) * 4096; },
            [&](int j, const unsigned char* st) {
                const int kpos0 = 64 * (jhi - j);
                if (kpos0 > tmax_w || kpos0 + 63 < tmin_w - 511) return;
                f32x16 p0, p1; alibi_init<1>(p0, p1, slope2, kpos0, t0, hi);
                qk_tile<false>(st, qf, p0, p1, lane);
                if (kpos0 < tmax_w - 511 || kpos0 + 63 > tmin_w) mask_tile<1>(p0, p1, kpos0, t - 511, t, hi);
                softmax_step_nosum(p0, p1, m, o, lacc);
                pv_tile_sum(st + 8192, p0, p1, o, lacc, lane);
            }, par, true, false, NoSrc());
        const float g2 = GN[2] / fmaxf(lacc[0], 1e-30f);
#pragma unroll
        for (int rr = 0; rr < 16; ++rr) { o[0][rr] = totw[rr * 64] + o[0][rr] * g2; o[1][rr] = totw[(16 + rr) * 64] + o[1][rr] * g2; }
    }
    {
        float ss = 0.f; bf16_t* O = (bf16_t*)(a.ws + WS_ONSA) + token * 512 + h * 64;
#pragma unroll
        for (int dh = 0; dh < 2; ++dh)
#pragma unroll
            for (int g4 = 0; g4 < 4; ++g4) { const float v0 = o[dh][4 * g4], v1 = o[dh][4 * g4 + 1], v2 = o[dh][4 * g4 + 2], v3 = o[dh][4 * g4 + 3];
                ss += v0 * v0 + v1 * v1 + v2 * v2 + v3 * v3; uint2 w; w.x = cvtpk(v0, v1); w.y = cvtpk(v2, v3); *(uint2*)(O + 32 * dh + 8 * g4 + 4 * hi) = w; }
        ss = pair_sum(ss);
        if (hi == 0) ((float*)(a.ws + WS_SSQ))[token * 16 + h] = ss;
    }
}
#ifndef PROBE_DUP
#define PROBE_DUP 0
#endif
DEV void phase_att(const Args& a, unsigned char* smem) {
    int* qctr = (int*)(a.ws + WS_CTL) + 64; int* sitem = (int*)(smem + AT_ITEM_OFF);
    unsigned* ctl = (unsigned*)(a.ws + WS_CTL); unsigned* seen = (unsigned*)(smem + AT_ITEM_OFF + 8);
    if (TID() == 0) seen[0] = 0u;
    for (;;) {
        if (TID() == 0) sitem[0] = atomicAdd(qctr, 1);
        __syncthreads();
        const int item = sitem[0];
        __syncthreads();
        if (item >= 32 + 1024) break;
        if (item < 16) cmp_item(a, smem, 16 + item);
        else if (item < 32) cmp_item(a, smem, item - 16);
        else if (item < 32 + 512) { const int fi = item - 32; const int qb = 31 - (fi >> 4), bh = fi & 15; if (!((seen[0] >> bh) & 1u)) { wait_flag(ctl + CW_CUMFLAG + bh, 1u); if (TID() == 0) seen[0] |= 1u << bh; } fox_item(a, smem, fi, bh >> 3, bh & 7, qb); }
        else { const int idx = item - 32 - 512; const int tt = 127 - (idx >> 2), bg = idx & 3; if (!((seen[0] >> 16) & 1u)) { wait_flag(ctl + CW_CMPFLAG, 16u); if (TID() == 0) seen[0] |= 1u << 16; } nsa_item(a, smem, bg >> 1, bg & 1, tt); }
    }
}

DEV void phase_outproj(const Args& a, unsigned char* smem) {
    const bf16_t* ONSA = (const bf16_t*)(a.ws + WS_ONSA); const bf16_t* OFOX = (const bf16_t*)(a.ws + WS_OFOX); const float* SSQ = (const float*)(a.ws + WS_SSQ);
    const bf16_t* W = (const bf16_t*)(a.ws + WS_WOUT); float* H1 = (float*)(a.ws + WS_H1); const float* X = a.in[I_X];
    float* rs = (float*)(smem + MISC_OFF);
    const int tid = TID(); int lane = tid & 63, wid = tid >> 6, wr = wid >> 2, wc = wid & 3; (void)wr; (void)wc; (void)lane;
    auto aoffo = [](int r, int kc) { return (unsigned)(r * 1024 + kc * 16); }; auto boffo = [](int k, int nc) { return (unsigned)(k * 2048 + nc * 16); };
    for (int item = VBID(); item < 64 * 4; item += gridDim.x) {
        int mt, nt; patch_decode(item, 64, 4, mt, nt);
        gemm_issue0<15>(smem, ONSA + (size_t)mt * 256 * 512, aoffo, W + nt * 256, boffo);
        if (tid < 256) { const float* s_ = SSQ + (size_t)(mt * 256 + tid) * 16; float sn = 0.f, sf = 0.f;
#pragma unroll
            for (int j = 0; j < 8; ++j) { sn += s_[j]; sf += s_[8 + j]; }
            rs[tid * 2] = rsqrtf(sn * (1.f / 512.f) + EPS); rs[tid * 2 + 1] = rsqrtf(sf * (1.f / 512.f) + EPS); }
        asm volatile("s_waitcnt vmcnt(0)" ::: "memory");
        __syncthreads();
        f32x4 acc[8][4];
#pragma unroll
        for (int mi = 0; mi < 8; ++mi) { const size_t gm = (size_t)mt * 256 + G_ROW(mi);
#pragma unroll
            for (int ni = 0; ni < 4; ++ni) { const int n = nt * 256 + G_COL(ni); const float4 x = *(const float4*)(X + gm * 1024 + n); acc[mi][ni] = (f32x4){x.x, x.y, x.z, x.w}; } }
#pragma unroll
        for (int mi = 0; mi < 8; ++mi) { const float ri = 1.0f / rs[(G_ROW(mi)) * 2];
#pragma unroll
            for (int ni = 0; ni < 4; ++ni) acc[mi][ni] *= ri; }
        gemm256<false>(smem, 8, ONSA + (size_t)mt * 256 * 512, 128u, aoffo, W + nt * 256, 64u * 2048u, boffo, acc, true,
                       next_tile(true, smem, OFOX + (size_t)mt * 256 * 512, aoffo, W + (size_t)512 * 1024 + nt * 256, boffo));
        EPI_IDS();
#pragma unroll
        for (int mi = 0; mi < 8; ++mi) { const int rl = G_ROW(mi); const float rat = rs[rl * 2] / rs[rl * 2 + 1];
#pragma unroll
            for (int ni = 0; ni < 4; ++ni) acc[mi][ni] *= rat; }
        gemm256<false>(smem, 8, OFOX + (size_t)mt * 256 * 512, 128u, aoffo, W + (size_t)512 * 1024 + nt * 256, 64u * 2048u, boffo, acc, true);
        EPI_IDS();
#pragma unroll
        for (int mi = 0; mi < 8; ++mi) { const int rl = G_ROW(mi); const size_t gm = (size_t)mt * 256 + rl; const float rf = rs[rl * 2 + 1];
#pragma unroll
            for (int ni = 0; ni < 4; ++ni) { const int n = nt * 256 + G_COL(ni); const f32x4 v = acc[mi][ni] * rf;
                float4 o = {v[0], v[1], v[2], v[3]}; *(float4*)(H1 + gm * 1024 + n) = o; } }
        __syncthreads();
    }
}

DEV void phase_route(const Args& a, unsigned char* smem) {
    const float* H1 = (const float*)(a.ws + WS_H1); bf16_t* XN = (bf16_t*)(a.ws + WS_XN); float* RSTD2 = (float*)(a.ws + WS_RSTD2);
    const float* ln2 = a.in[I_LN2]; const float* wr_ = a.in[I_WR]; const float* br = a.in[I_BR];
    int* CNT = (int*)(a.ws + WS_CTL);
    int* TOPI = (int*)(a.ws + WS_TOPI); int* TOPS = (int*)(a.ws + WS_TOPS); float* TOPW = (float*)(a.ws + WS_TOPW);
    int* TOKOF = (int*)(a.ws + WS_TOKOF); float* ROWW = (float*)(a.ws + WS_ROWW); float* RSDS = (float*)(a.ws + WS_RSDS);
    float* part = (float*)smem;
    float* ssqp = part + 8 * 32 * 33;
    int* lcnt = (int*)(ssqp + 256); int* lbase = lcnt + 32; int* te = lbase + 32; int* trk = te + 256; float* tw = (float*)(trk + 256); float* trs = tw + 256;
    const int tid = TID(), lane = tid & 63, wid = tid >> 6, i32 = lane & 31, kh = lane >> 5; const int tg = wid >> 2, kq = wid & 3;
    for (int item = BID(); item < 256; item += gridDim.x) {
        const int tok = item * 64 + tg * 32 + i32;
        if (tid < 32) lcnt[tid] = 0;
        f32x16 acc = (f32x16){}; float ss = 0.f;
        const float* hrow = H1 + (size_t)tok * 1024 + 256 * kq + 4 * kh; const float* lrow = ln2 + 256 * kq + 4 * kh; bf16_t* xrow = XN + (size_t)tok * 1024 + 256 * kq + 4 * kh;
        const float* wbase = wr_ + (size_t)(256 * kq + 4 * kh) * 32 + i32;
#pragma unroll 4
        for (int c = 0; c < 32; ++c) {
            const float4 hv = *(const float4*)(hrow + 8 * c); const float4 lv = *(const float4*)(lrow + 8 * c);
            ss += hv.x * hv.x + hv.y * hv.y + hv.z * hv.z + hv.w * hv.w;
            const float x0 = hv.x * lv.x, x1 = hv.y * lv.y, x2 = hv.z * lv.z, x3 = hv.w * lv.w;
            uint2 o; o.x = cvtpk(x0, x1); o.y = cvtpk(x2, x3); *(uint2*)(xrow + 8 * c) = o;
            const float* wp = wbase + (size_t)(8 * c) * 32;
            const float w0 = wp[0], w1 = wp[32], w2 = wp[64], w3 = wp[96];
            acc = __builtin_amdgcn_mfma_f32_32x32x2f32(x0, w0, acc, 0, 0, 0);
            acc = __builtin_amdgcn_mfma_f32_32x32x2f32(x1, w1, acc, 0, 0, 0);
            acc = __builtin_amdgcn_mfma_f32_32x32x2f32(x2, w2, acc, 0, 0, 0);
            acc = __builtin_amdgcn_mfma_f32_32x32x2f32(x3, w3, acc, 0, 0, 0);
        }
        ss = pair_sum(ss);
        if (kh == 0) ssqp[wid * 32 + i32] = ss;
#pragma unroll
        for (int r = 0; r < 16; ++r) part[(wid * 32 + crow(r, kh)) * 33 + i32] = acc[r];
        __syncthreads();
        if (tid < 64) {
            const int g_ = tid >> 5, i_ = tid & 31; const int w0_ = g_ * 4;
            const float sq = ssqp[(w0_ + 0) * 32 + i_] + ssqp[(w0_ + 1) * 32 + i_] + ssqp[(w0_ + 2) * 32 + i_] + ssqp[(w0_ + 3) * 32 + i_]; const float rstd = rsqrtf(sq * (1.f / 1024.f) + EPS);
            RSTD2[item * 64 + tid] = rstd; trs[tid] = rstd;
            float lg[32];
#pragma unroll
            for (int e = 0; e < 32; ++e) lg[e] = (part[((w0_ + 0) * 32 + i_) * 33 + e] + part[((w0_ + 1) * 32 + i_) * 33 + e] + part[((w0_ + 2) * 32 + i_) * 33 + e] + part[((w0_ + 3) * 32 + i_) * 33 + e]) * rstd + br[e];
            unsigned taken = 0u; float tv[4]; int ti[4];
#pragma unroll
            for (int k = 0; k < 4; ++k) { float best = -3.0e38f; int bi = 0;
#pragma unroll
                for (int e = 0; e < 32; ++e) { const bool ok = !((taken >> e) & 1u) && lg[e] > best; best = ok ? lg[e] : best; bi = ok ? e : bi; }
                taken |= 1u << bi; tv[k] = best; ti[k] = bi; }
            const float e1 = __expf(tv[1] - tv[0]), e2 = __expf(tv[2] - tv[0]), e3 = __expf(tv[3] - tv[0]); const float inv = 1.0f / (1.0f + e1 + e2 + e3);
            const float wv[4] = {inv, e1 * inv, e2 * inv, e3 * inv};
#pragma unroll
            for (int k = 0; k < 4; ++k) { const int idx = tid * 4 + k; te[idx] = ti[k]; trk[idx] = atomicAdd(&lcnt[ti[k]], 1); tw[idx] = wv[k]; }
        }
        __syncthreads();
        if (tid < 32) lbase[tid] = atomicAdd(&CNT[tid], lcnt[tid]);
        __syncthreads();
        if (tid < 256) { const int idx = tid; const int tk = item * 64 + (idx >> 2); const int e = te[idx]; const int slot = lbase[e] + trk[idx];
          TOPI[(size_t)tk * 4 + (idx & 3)] = e; TOPS[(size_t)tk * 4 + (idx & 3)] = slot; TOPW[(size_t)tk * 4 + (idx & 3)] = tw[idx];
          TOKOF[(size_t)e * 16384 + slot] = tk; ROWW[(size_t)e * 16384 + slot] = tw[idx]; RSDS[(size_t)e * 16384 + slot] = trs[idx >> 2]; }
        __syncthreads();
    }
}

struct MoeMap { int e, mt, nt, cnt, off; };
DEV void moe_setup(const Args& a, int* sm) {
    if (TID() == 0) { const int* CNT = (const int*)(a.ws + WS_CTL); int tot = 0; for (int e = 0; e < 32; ++e) { const int c = CNT[e]; const int mt = (c + 255) >> 8; sm[e] = mt; sm[32 + e] = tot; tot += mt; } sm[64] = tot; }
    __syncthreads();
}
DEV MoeMap moe_map(const Args& a, const int* sm, int item, int NT) {
    MoeMap mm; int e = 0;
#pragma unroll 1
    for (int i = 1; i < 32; ++i) if (item >= sm[32 + i] * NT) e = i;
    const int local = item - sm[32 + e] * NT; const int mte = sm[e];
    int mt_, nt_; patch_decode(local, mte, NT, mt_, nt_);
    mm.e = __builtin_amdgcn_readfirstlane(e); mm.mt = __builtin_amdgcn_readfirstlane(mt_); mm.nt = __builtin_amdgcn_readfirstlane(nt_);
    mm.cnt = __builtin_amdgcn_readfirstlane(((const int*)(a.ws + WS_CTL))[e]); mm.off = __builtin_amdgcn_readfirstlane(sm[32 + e] * 256); return mm;
}
DEV int moe_maps_build(const Args& a, const int* sm, int* maps, int nitems, int NT) {
    const int tid = TID(); const int first = VBID(); const int nmine = first < nitems ? (nitems - first + (int)gridDim.x - 1) / (int)gridDim.x : 0;
    for (int k = tid; k < nmine && k < 64; k += NTHR) { const int item = first + k * (int)gridDim.x; int e = 0;
#pragma unroll 1
        for (int i = 1; i < 32; ++i) if (item >= sm[32 + i] * NT) e = i;
        const int local = item - sm[32 + e] * NT; int mt_, nt_; patch_decode(local, sm[e], NT, mt_, nt_);
        maps[k * 8] = e; maps[k * 8 + 1] = mt_; maps[k * 8 + 2] = nt_; maps[k * 8 + 3] = ((const int*)(a.ws + WS_CTL))[e]; maps[k * 8 + 4] = sm[32 + e] * 256; }
    __syncthreads();
    return nmine < 64 ? nmine : 64;
}
DEV MoeMap moe_get(const int* maps, int k) { MoeMap mm; mm.e = __builtin_amdgcn_readfirstlane(maps[k * 8]); mm.mt = __builtin_amdgcn_readfirstlane(maps[k * 8 + 1]); mm.nt = __builtin_amdgcn_readfirstlane(maps[k * 8 + 2]);
    mm.cnt = __builtin_amdgcn_readfirstlane(maps[k * 8 + 3]); mm.off = __builtin_amdgcn_readfirstlane(maps[k * 8 + 4]); return mm; }
DEV void phase_up(const Args& a, unsigned char* smem) {
    int* sm = (int*)(smem + MISC_OFF); int* maps = (int*)(smem + MISC_OFF + 8192); int* tokb = maps + 512; float* rsdb = (float*)(tokb + 768); float* biab = rsdb + 768;
    static_assert(8192 + (512 + 3 * 768) * 4 <= 8192 + 12288, "misc LDS");
    const bf16_t* XN = (const bf16_t*)(a.ws + WS_XN); const bf16_t* W = (const bf16_t*)(a.ws + WS_WUP); bf16_t* ACT = (bf16_t*)(a.ws + WS_ACT); const float* RSDS = (const float*)(a.ws + WS_RSDS);
    const int* TOKOF = (const int*)(a.ws + WS_TOKOF); const float* bup = a.in[I_BUP];
    const int tid = TID(); int lane = tid & 63, wid = tid >> 6, wr = wid >> 2, wc = wid & 3; (void)wr; (void)wc; (void)lane;
    moe_setup(a, sm);
    const int nitems = __builtin_amdgcn_readfirstlane(sm[64]) * 8;
    const int nmine = __builtin_amdgcn_readfirstlane(moe_maps_build(a, sm, maps, nitems, 8));
    int tkr = 0; float rsr = 0.f, bir = 0.f;
    const int t8 = tid & 255;
    auto side_load = [&](const MoeMap& m_) { const int slot = m_.mt * 256 + t8; const bool ok = slot < m_.cnt; const size_t sl_ = (size_t)m_.e * 16384 + (ok ? slot : 0); const int tk_ = TOKOF[sl_]; const float rs_ = RSDS[sl_]; tkr = ok ? tk_ : 0; rsr = ok ? rs_ : 0.f;
        bir = bup[(size_t)m_.e * 2048 + (t8 < 128 ? m_.nt * 128 + t8 : 1024 + m_.nt * 128 + t8 - 128)]; };
    auto side_store = [&](int slot3) { tokb[slot3 * 256 + t8] = tkr; rsdb[slot3 * 256 + t8] = rsr; biab[slot3 * 256 + t8] = bir; };
    auto boffu = [](int k, int nc) { const int sc = ((nc >> 4) ? 1024 : 0) + (nc & 15) * 8; return (unsigned)(k * 4096 + sc * 2); };
    MoeMap mm{}, mn{};
    if (nmine > 0) { mm = moe_get(maps, 0); side_load(mm); side_store(0); }
    if (nmine > 1) { mn = moe_get(maps, 1); side_load(mn); side_store(1); }
    __syncthreads();
    bool pre = false;
    for (int k = 0; k < nmine; ++k) {
        const bool has_next = k + 1 < nmine, has_nn = k + 2 < nmine;
        { const MoeMap m2 = moe_get(maps, has_nn ? k + 2 : nmine - 1); side_load(m2); }
        const int s0 = k % 3, s1 = (k + 1) % 3, s2 = (k + 2) % 3;
        const int* tok = tokb + s0 * 256; const int* tokn = tokb + s1 * 256; const float* rsd = rsdb + s0 * 256; const float* bia = biab + s0 * 256;
        const bf16_t* We = W + (size_t)mm.e * 1024 * 2048; const bf16_t* Wn = W + (size_t)mn.e * 1024 * 2048;
        f32x4 acc[8][4];
        gemm256<true>(smem, 16, XN, 128u, [&](int r, int kc) { return (unsigned)(tok[r] * 2048 + kc * 16); }, We + mm.nt * 128, 64u * 4096u, boffu, acc, pre,
                      next_tile(has_next, smem, XN, [&](int r, int kc) { return (unsigned)(tokn[r] * 2048 + kc * 16); }, Wn + mn.nt * 128, boffu));
        side_store(s2);
        EPI_IDS();
        float bgv[2][4], blv[2][4];
#pragma unroll
        for (int ni = 0; ni < 2; ++ni) { const int jl = wc * 32 + ni * 16 + 4 * (lane >> 4); const float4 bg = *(const float4*)(bia + jl), bl_ = *(const float4*)(bia + 128 + jl);
            bgv[ni][0] = bg.x; bgv[ni][1] = bg.y; bgv[ni][2] = bg.z; bgv[ni][3] = bg.w; blv[ni][0] = bl_.x; blv[ni][1] = bl_.y; blv[ni][2] = bl_.z; blv[ni][3] = bl_.w; }
#pragma unroll
        for (int mi = 0; mi < 8; ++mi) { const int rl_ = G_ROW(mi); const size_t row = (size_t)mm.off + mm.mt * 256 + rl_; const float rs_ = rsd[rl_];
            uint2 o2[2];
#pragma unroll
            for (int ni = 0; ni < 2; ++ni) {
                const f32x4 gv = acc[mi][ni], lv = acc[mi][ni + 2]; float r4[4];
#pragma unroll
                for (int r = 0; r < 4; ++r) { const float gg = fminf(gv[r] * rs_ + bgv[ni][r], 7.0f); const float ll = fminf(fmaxf(lv[r] * rs_ + blv[ni][r], -7.0f), 7.0f); r4[r] = gg * sigmoidf_(1.702f * gg) * (ll + 1.0f); }
                o2[ni].x = cvtpk(r4[0], r4[1]); o2[ni].y = cvtpk(r4[2], r4[3]); }
            { const int c0 = wc * 32 + 4 * (lane >> 4); *(uint4*)(ACT + row * 1024 + mm.nt * 128 + PAIR16_COL(c0, c0 + 16)) = pair16(o2[0], o2[1]); } }
        lds_barrier();
        mm = mn; if (has_nn) mn = moe_get(maps, k + 2); pre = has_next;
    }
}
DEV void phase_down(const Args& a, unsigned char* smem) {
    int* sm = (int*)(smem + MISC_OFF); int* maps = (int*)(smem + MISC_OFF + 8192); float* rwb = (float*)(maps + 512); float* biab = rwb + 768;
    const bf16_t* ACT = (const bf16_t*)(a.ws + WS_ACT); const bf16_t* W = (const bf16_t*)(a.ws + WS_WDN); bf16_t* Y = (bf16_t*)(a.ws + WS_Y);
    const float* ROWW = (const float*)(a.ws + WS_ROWW); const float* bdn = a.in[I_BDN];
    const int tid = TID(); int lane = tid & 63, wid = tid >> 6, wr = wid >> 2, wc = wid & 3; (void)wr; (void)wc; (void)lane;
    moe_setup(a, sm);
    const int nitems = __builtin_amdgcn_readfirstlane(sm[64]) * 4;
    const int nmine = __builtin_amdgcn_readfirstlane(moe_maps_build(a, sm, maps, nitems, 4));
    float rwr = 0.f, bir = 0.f;
    const int t8 = tid & 255;
    auto side_load = [&](const MoeMap& m_) { const int slot = m_.mt * 256 + t8; const bool ok = slot < m_.cnt; const float rw_ = ROWW[(size_t)m_.e * 16384 + (ok ? slot : 0)]; rwr = ok ? rw_ : 0.f; bir = bdn[(size_t)m_.e * 1024 + m_.nt * 256 + t8]; };
    auto side_store = [&](int slot3) { rwb[slot3 * 256 + t8] = rwr; biab[slot3 * 256 + t8] = bir; };
    auto aoffd = [](int r, int kc) { return (unsigned)(r * 2048 + kc * 16); }; auto boffd = [](int k, int nc) { return (unsigned)(k * 2048 + nc * 16); };
    MoeMap mm{}, mn{};
    if (nmine > 0) { mm = moe_get(maps, 0); side_load(mm); side_store(0); }
    if (nmine > 1) { mn = moe_get(maps, 1); side_load(mn); side_store(1); }
    __syncthreads();
    bool pre = false;
    for (int k = 0; k < nmine; ++k) {
        const bool has_next = k + 1 < nmine, has_nn = k + 2 < nmine;
        { const MoeMap m2 = moe_get(maps, has_nn ? k + 2 : nmine - 1); side_load(m2); }
        const int s0 = k % 3, s2 = (k + 2) % 3;
        const float* rw = rwb + s0 * 256; const float* bia = biab + s0 * 256;
        const bf16_t* We = W + (size_t)mm.e * 1024 * 1024; const bf16_t* Ab = ACT + ((size_t)mm.off + mm.mt * 256) * 1024;
        const bf16_t* Wn = W + (size_t)mn.e * 1024 * 1024; const bf16_t* An = ACT + ((size_t)mn.off + mn.mt * 256) * 1024;
        f32x4 acc[8][4];
        gemm256<true>(smem, 16, Ab, 128u, aoffd, We + mm.nt * 256, 64u * 2048u, boffd, acc, pre,
                      next_tile(has_next, smem, An, aoffd, Wn + mn.nt * 256, boffd));
        side_store(s2);
        EPI_IDS();
        float4 bb[4];
#pragma unroll
        for (int ni = 0; ni < 4; ++ni) bb[ni] = *(const float4*)(bia + G_COL(ni));
#pragma unroll
        for (int mi = 0; mi < 8; ++mi) { const int rl = G_ROW(mi); const size_t row = (size_t)mm.off + mm.mt * 256 + rl; const float w = rw[rl];
#pragma unroll
            for (int np = 0; np < 2; ++np) { uint2 o2[2];
#pragma unroll
                for (int h = 0; h < 2; ++h) { const int ni = 2 * np + h; const f32x4 v = acc[mi][ni]; o2[h].x = cvtpk((v[0] + bb[ni].x) * w, (v[1] + bb[ni].y) * w); o2[h].y = cvtpk((v[2] + bb[ni].z) * w, (v[3] + bb[ni].w) * w); }
                *(uint4*)(Y + row * 1024 + mm.nt * 256 + PAIR16_COL(G_COL(2 * np), G_COL(2 * np + 1))) = pair16(o2[0], o2[1]); } }
        lds_barrier();
        mm = mn; if (has_nn) mn = moe_get(maps, k + 2); pre = has_next;
    }
}

DEV void phase_comb(const Args& a, unsigned char* smem) {
    int* sm = (int*)(smem + MISC_OFF);
    moe_setup(a, sm);
    float* H1 = (float*)(a.ws + WS_H1); bf16_t* XN = (bf16_t*)(a.ws + WS_XN); const bf16_t* Y = (const bf16_t*)(a.ws + WS_Y);
    const int* TOPI = (const int*)(a.ws + WS_TOPI); const int* TOPS = (const int*)(a.ws + WS_TOPS); const float* g = a.in[I_LNPLE];
    const int lane = TID() & 63; const int gw = BID() * NWAVE + (TID() >> 6), ngw = gridDim.x * NWAVE;
    for (int tok = gw; tok < NTOK; tok += ngw) {
        float4 v[4];
#pragma unroll
        for (int j = 0; j < 4; ++j) v[j] = *(const float4*)(H1 + (size_t)tok * 1024 + j * 256 + lane * 4);
#pragma unroll
        for (int k = 0; k < 4; ++k) { const int e = TOPI[(size_t)tok * 4 + k]; const size_t row = (size_t)sm[32 + e] * 256 + TOPS[(size_t)tok * 4 + k];
#pragma unroll
            for (int j = 0; j < 4; ++j) { const uint2 u = *(const uint2*)(Y + row * 1024 + j * 256 + lane * 4); v[j].x += bflo(u.x); v[j].y += bfhi(u.x); v[j].z += bflo(u.y); v[j].w += bfhi(u.y); } }
        float s = 0.f;
#pragma unroll
        for (int j = 0; j < 4; ++j) { *(float4*)(H1 + (size_t)tok * 1024 + j * 256 + lane * 4) = v[j]; s += v[j].x * v[j].x + v[j].y * v[j].y + v[j].z * v[j].z + v[j].w * v[j].w; }
        const float rstd = rsqrtf(wave_sum(s) * (1.f / 1024.f) + EPS);
#pragma unroll
        for (int j = 0; j < 4; ++j) { const float4 gg = *(const float4*)(g + j * 256 + lane * 4);
            uint2 o; o.x = cvtpk(v[j].x * rstd * gg.x, v[j].y * rstd * gg.y); o.y = cvtpk(v[j].z * rstd * gg.z, v[j].w * rstd * gg.w); *(uint2*)(XN + (size_t)tok * 1024 + j * 256 + lane * 4) = o; }
    }
}

DEV void phase_gate(const Args& a, unsigned char* smem) {
    const bf16_t* XN = (const bf16_t*)(a.ws + WS_XN); const bf16_t* WG = (const bf16_t*)(a.ws + WS_WGATE); const bf16_t* PB = (const bf16_t*)(a.ws + WS_PB); const bf16_t* WP = (const bf16_t*)(a.ws + WS_WPLE);
    const float* H2 = (const float*)(a.ws + WS_H1); float* OUT = a.out; float* SSQ3 = (float*)(a.ws + WS_SSQ3);
    const int tid = TID(); int lane = tid & 63, wid = tid >> 6, wr = wid >> 2, wc = wid & 3; (void)wr; (void)wc; (void)lane;
    bf16_t* GT = (bf16_t*)(a.ws + WS_ACT);
    auto aoffg = [](int r, int kc) { return (unsigned)(r * 2048 + kc * 16); }; auto aoffp = [](int r, int kc) { return (unsigned)(r * 512 + kc * 16); }; auto boffg = [](int k, int nc) { return (unsigned)(k * 2048 + nc * 16); };
    for (int item = VBID(); item < 64 * 4; item += gridDim.x) {
        int mt, nt; patch_decode(item, 64, 4, mt, nt);
        f32x4 acc[8][4];
        gemm256<true>(smem, 16, XN + (size_t)mt * 256 * 1024, 128u, aoffg, WG + nt * 256, 64u * 2048u, boffg, acc, false,
                      next_tile(true, smem, PB + (size_t)mt * 256 * 256, aoffp, WP + nt * 256, boffg));
        EPI_IDS();
#pragma unroll
        for (int hb = 0; hb < 2; ++hb) {
            uint2 wq[4][4];
#pragma unroll
            for (int m4 = 0; m4 < 4; ++m4) { const int mi = hb * 4 + m4; const size_t gm = (size_t)mt * 256 + G_ROW(mi);
#pragma unroll
                for (int ni = 0; ni < 4; ++ni) { const int n = nt * 256 + G_COL(ni); const f32x4 v = acc[mi][ni];
                    uint2 w; w.x = cvtpk(sigmoidf_(v[0]), sigmoidf_(v[1])); w.y = cvtpk(sigmoidf_(v[2]), sigmoidf_(v[3])); wq[m4][ni] = w;
                    const float4 h = *(const float4*)(H2 + gm * 1024 + n); acc[mi][ni] = (f32x4){h.x, h.y, h.z, h.w}; } }
#pragma unroll
            for (int m4 = 0; m4 < 4; ++m4) { const int mi = hb * 4 + m4; const size_t gm = (size_t)mt * 256 + G_ROW(mi);
#pragma unroll
                for (int ni = 0; ni < 4; ++ni) { const uint2 w = wq[m4][ni]; const f32x4 h = acc[mi][ni];
                    if (ni & 1) *(uint4*)(GT + gm * 1024 + nt * 256 + PAIR16_COL(G_COL(ni - 1), G_COL(ni))) = pair16(wq[m4][ni - 1], w);
                    acc[mi][ni] = (f32x4){h[0] * __builtin_amdgcn_rcpf(bflo(w.x)), h[1] * __builtin_amdgcn_rcpf(bfhi(w.x)), h[2] * __builtin_amdgcn_rcpf(bflo(w.y)), h[3] * __builtin_amdgcn_rcpf(bfhi(w.y))}; } }
            asm volatile("" ::: "memory");
        }
        gemm256<false>(smem, 4, PB + (size_t)mt * 256 * 256, 128u, aoffp, WP + nt * 256, 64u * 2048u, boffg, acc, true);
        EPI_IDS();
        const bool fused = gridDim.x >= 256;
#pragma unroll
        for (int hb = 0; hb < 2; ++hb) {
            uint4 gq4[4][2];
#pragma unroll
            for (int m4 = 0; m4 < 4; ++m4) { const size_t gm = (size_t)mt * 256 + G_ROW(hb * 4 + m4);
#pragma unroll
                for (int np = 0; np < 2; ++np) gq4[m4][np] = *(const uint4*)(GT + gm * 1024 + nt * 256 + PAIR16_COL(G_COL(2 * np), G_COL(2 * np + 1))); }
#pragma unroll
            for (int m4 = 0; m4 < 4; ++m4) { const int mi = hb * 4 + m4; const size_t gm = (size_t)mt * 256 + G_ROW(mi); float ss = 0.f;
#pragma unroll
                for (int np = 0; np < 2; ++np) { uint2 g2[2]; unpair16(gq4[m4][np], g2[0], g2[1]);
#pragma unroll
                    for (int h = 0; h < 2; ++h) { const int ni = 2 * np + h; const int n = nt * 256 + G_COL(ni); const f32x4 v = acc[mi][ni]; const uint2 gw = g2[h];
                        float4 o = {v[0] * bflo(gw.x), v[1] * bfhi(gw.x), v[2] * bflo(gw.y), v[3] * bfhi(gw.y)};
                        if (!fused) *(float4*)(OUT + gm * 1024 + n) = o;
                        acc[mi][ni] = (f32x4){o.x, o.y, o.z, o.w};
                        ss += o.x * o.x + o.y * o.y + o.z * o.z + o.w * o.w; } }
                ss += __shfl_xor(ss, 16); ss += __shfl_xor(ss, 32);
                if (lane < 16) SSQ3[gm * 16 + nt * 4 + wc] = ss; }
            asm volatile("" ::: "memory");
        }
        if (fused) {
            unsigned* flag = (unsigned*)(a.ws + WS_CTL) + CW_GATEFLAG + mt;
            const float* lnf = a.in[I_LNF]; float4 gg[4];
#pragma unroll
            for (int ni = 0; ni < 4; ++ni) gg[ni] = *(const float4*)(lnf + nt * 256 + G_COL(ni));
            signal_done(flag); wait_flag(flag, 4u);
            float rstd[8];
#pragma unroll
            for (int mi = 0; mi < 8; ++mi) { const size_t gm = (size_t)mt * 256 + G_ROW(mi); const float4 s0 = *(const float4*)(SSQ3 + gm * 16 + 4 * (lane >> 4)); rstd[mi] = (s0.x + s0.y) + (s0.z + s0.w); }
#pragma unroll
            for (int mi = 0; mi < 8; ++mi) { float t_ = rstd[mi]; t_ += __shfl_xor(t_, 16); t_ += __shfl_xor(t_, 32); rstd[mi] = rsqrtf(t_ * (1.f / 1024.f) + EPS); }
#pragma unroll
            for (int mi = 0; mi < 8; ++mi) { const size_t gm = (size_t)mt * 256 + G_ROW(mi);
#pragma unroll
                for (int ni = 0; ni < 4; ++ni) { const int n = nt * 256 + G_COL(ni); const f32x4 v = acc[mi][ni]; const float r_ = rstd[mi];
                    float4 o = {v[0] * r_ * gg[ni].x, v[1] * r_ * gg[ni].y, v[2] * r_ * gg[ni].z, v[3] * r_ * gg[ni].w}; *(float4*)(OUT + gm * 1024 + n) = o; } }
        }
        __syncthreads();
    }
}

DEV void phase_final(const Args& a) {
    if (gridDim.x >= 256) return;
    float* OUT = a.out; const float* SSQ3 = (const float*)(a.ws + WS_SSQ3); const float* g = a.in[I_LNF];
    const int lane = TID() & 63; const int gw = BID() * NWAVE + (TID() >> 6), ngw = gridDim.x * NWAVE;
    for (int m = gw; m < NTOK; m += ngw) {
        float s = 0.f;
#pragma unroll
        for (int j = 0; j < 16; ++j) s += SSQ3[(size_t)m * 16 + j];
        const float rstd = rsqrtf(s * (1.f / 1024.f) + EPS);
#pragma unroll
        for (int j = 0; j < 4; ++j) { float4 v = *(const float4*)(OUT + (size_t)m * 1024 + j * 256 + lane * 4); const float4 gg = *(const float4*)(g + j * 256 + lane * 4);
            v.x *= rstd * gg.x; v.y *= rstd * gg.y; v.z *= rstd * gg.z; v.w *= rstd * gg.w; *(float4*)(OUT + (size_t)m * 1024 + j * 256 + lane * 4) = v; }
    }
}

template <int PH> DEV void run_phase(const Args& a, unsigned char* smem) {
    if constexpr (PH == PH_PRO) phase_prologue(a, smem);
    else if constexpr (PH == PH_INPROJ) phase_inproj(a, smem);
    else if constexpr (PH == PH_ATT) phase_att(a, smem);
    else if constexpr (PH == PH_OUTPROJ) phase_outproj(a, smem);
    else if constexpr (PH == PH_ROUTE) phase_route(a, smem);
    else if constexpr (PH == PH_UP) phase_up(a, smem);
    else if constexpr (PH == PH_DOWN) phase_down(a, smem);
    else if constexpr (PH == PH_COMB) phase_comb(a, smem);
    else if constexpr (PH == PH_GATE) phase_gate(a, smem);
    else if constexpr (PH == PH_FINAL) phase_final(a);
}
#define XB_TMO      128
#define XB_XCNT(j)  (256  + 64 * (j))
#define XB_XSUB(j)  (1280 + 64 * (j))
#define XB_XGEN(j)  (2304 + 64 * (j))
#define XB_TOP      3328
#define XB_TOPGEN   3392
#define XCD_BAR_WORDS 3456
#define XB_SPIN_CAP (1u << 22)
DEV unsigned xb_ld(unsigned* p)              { return __hip_atomic_load(p, __ATOMIC_RELAXED, __HIP_MEMORY_SCOPE_AGENT); }
DEV unsigned xb_add(unsigned* p, unsigned v) { return __hip_atomic_fetch_add(p, v, __ATOMIC_RELAXED, __HIP_MEMORY_SCOPE_AGENT); }
DEV unsigned xb_xcc_id() { return (unsigned)__builtin_amdgcn_s_getreg((3 << 11) | 20) & 0xFu; }
#define XB_SPIN(cond, bar) do { unsigned _sp = 0; while (cond) { __builtin_amdgcn_s_sleep(1); \
    if ((++_sp & 255u) == 0u) { if (xb_ld(&(bar)[XB_TMO])) break; if (_sp > XB_SPIN_CAP) { atomicAdd(&(bar)[XB_TMO], 1u); break; } } } } while (0)
struct XcdBarrier { unsigned* bar; unsigned x; volatile LAS unsigned* st; };
DEV XcdBarrier xcd_barrier_post(unsigned* bar, volatile LAS unsigned* st) {
    XcdBarrier b; b.bar = bar; b.x = xb_xcc_id(); b.st = st;
    if (TID() == 0) (void)xb_add(&bar[XB_XCNT(b.x)], 1u);
    return b;
}
DEV void xcd_barrier_complete(unsigned* bar, unsigned x, unsigned& nloc, unsigned& nx) {
    const unsigned G = gridDim.x * gridDim.y * gridDim.z;
    unsigned sum, cnt, mine, sp = 0u;
    for (;;) {
        sum = 0u; cnt = 0u; mine = 0u;
#pragma unroll
        for (unsigned j = 0; j < 16; ++j) { const unsigned c = xb_ld(&bar[XB_XCNT(j)]); sum += c; cnt += (c > 0u) ? 1u : 0u; mine = (j == x) ? c : mine; }
        if (sum == G) break;
        __builtin_amdgcn_s_sleep(1);
        if ((++sp & 255u) == 0u) { if (xb_ld(&bar[XB_TMO])) break; if (sp > XB_SPIN_CAP) { atomicAdd(&bar[XB_TMO], 1u); break; } }
    }
    nloc = mine > 0u ? mine : 1u; nx = cnt > 0u ? cnt : 1u;
}
DEV void xcd_barrier(const XcdBarrier& b) {
    asm volatile("s_waitcnt vmcnt(0)" ::: "memory");
    __syncthreads();
    if (TID() == 0) {
        unsigned* bar = b.bar;
        __builtin_amdgcn_s_waitcnt(0);
        unsigned nloc = b.st[0], nx = b.st[1];
        if (nloc == 0u) { xcd_barrier_complete(bar, b.x, nloc, nx); b.st[0] = nloc; b.st[1] = nx; }
        const unsigned old = xb_add(&bar[XB_XSUB(b.x)], 1u);
        const unsigned gen = old / nloc;
        if (old + 1u == (gen + 1u) * nloc) {
            __builtin_amdgcn_fence(__ATOMIC_RELEASE, "agent");
            asm volatile("s_waitcnt vmcnt(0)" ::: "memory");
            const unsigned og = xb_add(&bar[XB_TOP], 1u);
            const unsigned tg = og / nx;
            if (og + 1u == (tg + 1u) * nx) xb_add(&bar[XB_TOPGEN], 1u);
            else XB_SPIN(xb_ld(&bar[XB_TOPGEN]) == tg, bar);
            __builtin_amdgcn_fence(__ATOMIC_ACQUIRE, "agent");
            xb_add(&bar[XB_XGEN(b.x)], 1u);
            asm volatile("s_waitcnt vmcnt(0)" ::: "memory");
        } else {
            XB_SPIN(xb_ld(&bar[XB_XGEN(b.x)]) == gen, bar);
            __builtin_amdgcn_fence(__ATOMIC_ACQUIRE, "agent");
            asm volatile("s_waitcnt vmcnt(0)" ::: "memory");
        }
    }
    __syncthreads();
}

__global__ void __launch_bounds__(NTHR, 2) mega(Args a) {
    extern __shared__ __attribute__((aligned(16))) unsigned char smem[];
    volatile LAS unsigned* bst = (volatile LAS unsigned*)(LAS unsigned char*)(smem + MISC_OFF + 8000);
    if (TID() == 0) { bst[0] = 0u; bst[1] = 0u; }
    __syncthreads();
    const XcdBarrier bar = xcd_barrier_post((unsigned*)(a.ws + WS_CTL) + 4096, bst);
#define GSYNC() xcd_barrier(bar)
#define RUN(ph) do { run_phase<ph>(a, smem); if ((PROBE_DUP >> ph) & 1) { GSYNC(); run_phase<ph>(a, smem); } } while (0)
    RUN(PH_PRO); GSYNC();
    RUN(PH_INPROJ); GSYNC();
    RUN(PH_ATT); GSYNC();
    RUN(PH_OUTPROJ); GSYNC();
    RUN(PH_ROUTE); GSYNC();
    RUN(PH_UP); GSYNC();
    RUN(PH_DOWN); GSYNC();
    RUN(PH_COMB); GSYNC();
    RUN(PH_GATE);
    if (gridDim.x < 256) { GSYNC(); RUN(PH_FINAL); }
#undef RUN
#undef GSYNC
}

extern "C" void kernel_launch(void* const* d_in, const int* in_sizes, int n_in, void* d_out, int out_size, void* d_ws, size_t ws_size, hipStream_t stream) {
    static int grid = 0;
    if (grid == 0) {
        if (n_in != 25 || ws_size < WS_END) { fprintf(stderr, "kernel_launch: unexpected n_in %d / ws %zu\n", n_in, ws_size); grid = -1; return; }
        int dev = 0, cus = 0, per_cu = 0;
        (void)hipGetDevice(&dev); (void)hipDeviceGetAttribute(&cus, hipDeviceAttributeMultiprocessorCount, dev);
        (void)hipFuncSetAttribute((const void*)mega, hipFuncAttributeMaxDynamicSharedMemorySize, LDS_BYTES);
        (void)hipOccupancyMaxActiveBlocksPerMultiprocessor(&per_cu, (const void*)mega, NTHR, LDS_BYTES);
        if (per_cu < 1) { fprintf(stderr, "kernel_launch: occupancy query says %d blocks per CU\n", per_cu); grid = -1; return; }
        grid = cus;
    }
    if (grid < 0) return;
    (void)hipMemsetAsync((char*)d_ws + WS_CTL, 0, 65536, stream);
    Args a{};
    for (int i = 0; i < 25; ++i) a.in[i] = (const float*)d_in[i];
    a.out = (float*)d_out; a.ws = (unsigned char*)d_ws; a.ph_lo = 0; a.ph_hi = PH_N;
    void* args[] = {&a};
    hipError_t e = hipLaunchCooperativeKernel((const void*)mega, dim3(grid), dim3(NTHR), args, LDS_BYTES, stream);
    if (e != hipSuccess) fprintf(stderr, "cooperative launch failed: %s (grid %d)\n", hipGetErrorString(e), grid);
}
```

```cpp
#include <hip/hip_runtime.h>
#include <stdint.h>
#include <cstdio>

#define DEV __device__ __forceinline__
#define LAS __attribute__((address_space(3)))

typedef unsigned short bf16_t;
typedef short bf16x8 __attribute__((ext_vector_type(8)));
typedef short s16x4 __attribute__((ext_vector_type(4)));
typedef float f32x4 __attribute__((ext_vector_type(4)));
typedef float f32x16 __attribute__((ext_vector_type(16)));
typedef float f32x2_t __attribute__((ext_vector_type(2)));
typedef __bf16 bf16x2_t __attribute__((ext_vector_type(2)));

constexpr int NTHR = 512, NWAVE = 8;
constexpr int NTOK = 16384;
constexpr float EPS = 1e-6f;
constexpr float LOG2E = 1.4426950408889634f;
constexpr float QS = 0.125f * LOG2E;
constexpr int NWIN = 3072;

constexpr size_t MiB = 1u << 20;
constexpr size_t WS_CTL = 0;
constexpr size_t WS_WIN = 1 * MiB;
constexpr size_t WS_WOUT = 7 * MiB;
constexpr size_t WS_WGATE = 9 * MiB;
constexpr size_t WS_WPLE = 11 * MiB;
constexpr size_t WS_WC1 = 12 * MiB;
constexpr size_t WS_WC2 = 15 * MiB + 512 * 1024 + 262144;
constexpr size_t WS_BIAS1 = 15 * MiB + 512 * 1024 + 262144 + 131072;
constexpr size_t WS_KC = 14 * MiB;
constexpr size_t WS_HID = 14 * MiB + 512 * 1024;
constexpr size_t WS_GN = 16 * MiB;
constexpr size_t WS_LS = 18 * MiB;
constexpr size_t WS_CUM = 19 * MiB;
constexpr size_t WS_SSQ = 20 * MiB;
constexpr size_t WS_TOPI = 21 * MiB;
constexpr size_t WS_TOPS = 21 * MiB + 262144;
constexpr size_t WS_TOPW = 21 * MiB + 524288;
constexpr size_t WS_TOKOF = 22 * MiB;
constexpr size_t WS_ROWW = 24 * MiB;
constexpr size_t WS_SSQ3 = 26 * MiB;
constexpr size_t WS_RSTD2 = 27 * MiB;
constexpr size_t WS_PB = 28 * MiB;
constexpr size_t WS_XN = 36 * MiB;
constexpr size_t WS_PROJ = 68 * MiB;
constexpr size_t WS_ONSA = 160 * MiB;
constexpr size_t WS_OFOX = 176 * MiB;
constexpr size_t WS_H1 = 192 * MiB;
constexpr size_t WS_WUP = 256 * MiB;
constexpr size_t WS_WDN = 384 * MiB;
constexpr size_t WS_ACT = 448 * MiB;
constexpr size_t WS_Y = 592 * MiB;
constexpr size_t WS_RSDS = 736 * MiB;
constexpr size_t WS_END = 738 * MiB;

enum { PH_PRO = 0, PH_INPROJ, PH_CMP, PH_ATT, PH_OUTPROJ, PH_ROUTE, PH_UP, PH_DOWN, PH_COMB, PH_GATE, PH_FINAL, PH_N };
struct Args { const float* in[25]; float* out; unsigned char* ws; int ph_lo, ph_hi; };
enum { I_X = 0, I_P, I_LN1, I_WIN, I_BFG, I_WC1K, I_WC2K, I_PEK, I_WC1V, I_WC2V, I_PEV, I_GNN, I_GNF, I_WOUT, I_LN2, I_WR, I_BR,
       I_WUP, I_BUP, I_WDN, I_BDN, I_LNPLE, I_WPLE, I_WGATE, I_LNF };

DEV int BID() { int b = (int)blockIdx.x; asm volatile("" : "+s"(b)); return b; }
DEV int VBID() { const int g = (int)gridDim.x, b = BID(); return (g & 7) ? b : (b & 7) * (g >> 3) + (b >> 3); }
DEV int TID() { int t = (int)__builtin_amdgcn_workitem_id_x(); asm volatile("" : "+v"(t)); return t; }
DEV unsigned cvtpk(float lo, float hi) { f32x2_t v = {lo, hi}; bf16x2_t b = __builtin_convertvector(v, bf16x2_t); return __builtin_bit_cast(unsigned, b); }
DEV float bflo(unsigned u) { return __uint_as_float(u << 16); }
DEV float bfhi(unsigned u) { return __uint_as_float(u & 0xffff0000u); }
DEV float wave_sum(float v) {
#pragma unroll
    for (int o = 1; o < 64; o <<= 1) v += __shfl_xor(v, o);
    return v;
}
#define DPP_MOV(x, ctrl) __builtin_bit_cast(float, __builtin_amdgcn_update_dpp(0, __builtin_bit_cast(int, (x)), (ctrl), 0xF, 0xF, true))
DEV float pair_sum(float x) { return x + __shfl_xor(x, 32); }
DEV float pair_max(float x) { return fmaxf(x, __shfl_xor(x, 32)); }
DEV float quad_sum(float x) { x += DPP_MOV(x, 0xB1); x += DPP_MOV(x, 0x4E); return x; }
DEV float wave_max_u(float x) {
    x = fmaxf(x, DPP_MOV(x, 0xB1)); x = fmaxf(x, DPP_MOV(x, 0x4E)); x = fmaxf(x, DPP_MOV(x, 0x141)); x = fmaxf(x, DPP_MOV(x, 0x140));
    const float a = __builtin_bit_cast(float, __builtin_amdgcn_readlane(__builtin_bit_cast(int, x), 0)), b = __builtin_bit_cast(float, __builtin_amdgcn_readlane(__builtin_bit_cast(int, x), 16));
    const float c = __builtin_bit_cast(float, __builtin_amdgcn_readlane(__builtin_bit_cast(int, x), 32)), d = __builtin_bit_cast(float, __builtin_amdgcn_readlane(__builtin_bit_cast(int, x), 48));
    return fmaxf(fmaxf(a, b), fmaxf(c, d));
}
DEV float sigmoidf_(float x) { return __builtin_amdgcn_rcpf(1.0f + __expf(-x)); }
DEV float logsigmoidf_(float x) { return fminf(x, 0.f) - log1pf(__expf(-fabsf(x))); }
DEV float gelu_tanh(float x) { const float u = 0.7978845608028654f * (x + 0.044715f * x * x * x); const float th = 1.0f - 2.0f * __builtin_amdgcn_rcpf(__expf(2.0f * u) + 1.0f); return 0.5f * x * (1.0f + th); }
DEV s16x4 tr_read(const unsigned char* p) {
    typedef short v4i16_t __attribute__((ext_vector_type(4)));
    return __builtin_bit_cast(s16x4, __builtin_amdgcn_ds_read_tr16_b64_v4i16((LAS v4i16_t*)p));
}
DEV s16x4 tr_read_l(unsigned lds_addr) {
    typedef short v4i16_t __attribute__((ext_vector_type(4)));
    return __builtin_bit_cast(s16x4, __builtin_amdgcn_ds_read_tr16_b64_v4i16((LAS v4i16_t*)(uintptr_t)lds_addr));
}
DEV int crow(int r, int hi) { return (r & 3) + 8 * (r >> 2) + 4 * hi; }

constexpr int GL_STAGE = 65536;
constexpr int GEMM_LDS = 2 * GL_STAGE;
constexpr int MISC_OFF = GEMM_LDS;
constexpr int LDS_BYTES = GEMM_LDS + 8192 + 12288;

DEV void glds16s(const void* sbase, unsigned voff, unsigned lds_dst) { unsigned keep;
    asm volatile("s_mov_b32 %0, m0\n\ts_mov_b32 m0, %3\n\ts_nop 0\n\tglobal_load_lds_dwordx4 %1, %2\n\ts_mov_b32 m0, %0" : "=&s"(keep) : "v"(voff), "s"(sbase), "s"(lds_dst) : "memory"); }

DEV const unsigned char* uptr(const void* p) { const unsigned long long v = (unsigned long long)p; const unsigned lo = __builtin_amdgcn_readfirstlane((unsigned)v), hi = __builtin_amdgcn_readfirstlane((unsigned)(v >> 32)); return (const unsigned char*)(((unsigned long long)hi << 32) | lo); }

DEV void lds_barrier() { asm volatile("s_waitcnt lgkmcnt(0)\n\ts_barrier" ::: "memory"); }

struct NoNextS { DEV void operator()() const {} };
template <class AO, class BO>
DEV void gemm256s_issue0(unsigned char* smem, const void* abase, const AO& aoff, const void* bbase, const BO& boff) {
    const int tid = TID(), lane = tid & 63; const int wid = __builtin_amdgcn_readfirstlane(tid >> 6);
    const unsigned lds0 = (unsigned)(uintptr_t)smem; const unsigned char* ab_ = uptr(abase); const unsigned char* bb_ = uptr(bbase);
#pragma unroll
    for (int i = 0; i < 4; ++i) { const int p = wid + 8 * i; glds16s(ab_, aoff(8 * p + (lane >> 3), (lane & 7) ^ (lane >> 3)), (unsigned)__builtin_amdgcn_readfirstlane(lds0 + p * 1024)); }
#pragma unroll
    for (int i = 0; i < 4; ++i) { const int p = wid + 8 * i; const int k = 2 * p + (lane >> 5); const int f = (k & 3) + 4 * ((k >> 3) & 1);
        glds16s(bb_, boff(k, (lane & 31) ^ (f << 1)), (unsigned)__builtin_amdgcn_readfirstlane(lds0 + 32768 + p * 1024)); }
}
template <bool ZERO, class AO, class BO, class NX = NoNextS>
DEV void gemm256s(unsigned char* smem, int nkt, const void* abase, unsigned akstep, const AO& aoff, const void* bbase, unsigned bkstep, const BO& boff, f32x4 (&acc)[8][4], bool pre = false, const NX& next = NX()) {
    const int tid = TID(), lane = tid & 63; const int wid = __builtin_amdgcn_readfirstlane(tid >> 6); const int wr = wid >> 2, wc = wid & 3;
    if (ZERO) {
#pragma unroll
        for (int mi = 0; mi < 8; ++mi)
#pragma unroll
            for (int ni = 0; ni < 4; ++ni) acc[mi][ni] = (f32x4){0.f, 0.f, 0.f, 0.f};
    }
    const unsigned lds0 = (unsigned)(uintptr_t)smem;
    const unsigned char* abase_u = uptr(abase); const unsigned char* bbase_u = uptr(bbase); const unsigned akstep_u = __builtin_amdgcn_readfirstlane(akstep), bkstep_u = __builtin_amdgcn_readfirstlane(bkstep);
    unsigned ao[4], bo[4];
#pragma unroll
    for (int i = 0; i < 4; ++i) { const int p = wid + 8 * i; ao[i] = aoff(8 * p + (lane >> 3), (lane & 7) ^ (lane >> 3));
        const int k = 2 * p + (lane >> 5); const int f = (k & 3) + 4 * ((k >> 3) & 1); bo[i] = boff(k, (lane & 31) ^ (f << 1)); }
#define GL_ISSUE(kt, st) do { const unsigned char* ab_ = abase_u + (size_t)(kt) * akstep_u; const unsigned char* bb_ = bbase_u + (size_t)(kt) * bkstep_u; \
        _Pragma("unroll") for (int i_ = 0; i_ < 4; ++i_) glds16s(ab_, ao[i_], (unsigned)__builtin_amdgcn_readfirstlane(lds0 + (st) * GL_STAGE + (wid + 8 * i_) * 1024)); \
        _Pragma("unroll") for (int i_ = 0; i_ < 4; ++i_) glds16s(bb_, bo[i_], (unsigned)__builtin_amdgcn_readfirstlane(lds0 + (st) * GL_STAGE + 32768 + (wid + 8 * i_) * 1024)); } while (0)
    if (!pre) {
        GL_ISSUE(0, 0);
        asm volatile("s_waitcnt vmcnt(0)" ::: "memory");
        __syncthreads();
    }
    for (int kt = 0; kt < nkt; ++kt) {
        if (kt + 1 < nkt) GL_ISSUE(kt + 1, (kt + 1) & 1); else next();
        const unsigned char* A = smem + (kt & 1) * GL_STAGE; const unsigned char* Bt = A + 32768;
#pragma unroll
        for (int ks = 0; ks < 2; ++ks) {
            bf16x8 wf[4];
#pragma unroll
            for (int ni = 0; ni < 4; ++ni) {
                const int i = lane & 15, g = lane >> 4, q = i >> 2; const int row = ks * 32 + 8 * g + q; const int nc = wc * 8 + ni * 2 + ((i & 3) >> 1); const int f = q + 4 * (g & 1);
                const unsigned char* p = Bt + row * 512 + ((nc ^ (f << 1)) << 4) + (i & 1) * 8;
                const s16x4 lo = tr_read(p), hi = tr_read(p + 4 * 512);
                wf[ni] = (bf16x8){lo[0], lo[1], lo[2], lo[3], hi[0], hi[1], hi[2], hi[3]};
            }
#pragma unroll
            for (int mi = 0; mi < 8; ++mi) {
                const int m = wr * 128 + mi * 16 + (lane & 15); const int kc = ks * 4 + (lane >> 4);
                const bf16x8 af = *(const bf16x8*)(A + m * 128 + ((kc ^ (m & 7)) << 4));
#pragma unroll
                for (int ni = 0; ni < 4; ++ni) acc[mi][ni] = __builtin_amdgcn_mfma_f32_16x16x32_bf16(wf[ni], af, acc[mi][ni], 0, 0, 0);
            }
        }
        asm volatile("s_waitcnt vmcnt(0)" ::: "memory");
        __syncthreads();
    }
#undef GL_ISSUE
}

#define G_ROW(mi) ((((mi) >> 2) * 128) + wr * 64 + (((mi) & 3) * 16) + (lane & 15))
#define G_COL(ni) ((((ni) >> 1) * 128) + wc * 32 + (((ni) & 1) * 16) + 4 * (lane >> 4))
#define WAIT_V(n) asm volatile("s_waitcnt vmcnt(" #n ")" ::: "memory")
#define WAIT_L(n) asm volatile("s_waitcnt lgkmcnt(" #n ")" ::: "memory")
#define BAR() __builtin_amdgcn_s_barrier()
#define SCHED() __builtin_amdgcn_sched_barrier(0)
constexpr int SA_(int b, int h) { return b * GL_STAGE + h * 16384; }
constexpr int SB_(int b, int h) { return b * GL_STAGE + 32768 + h * 16384; }
struct NoNext { DEV bool has() const { return false; } template <int P> DEV void issue() const {} };
template <int WHICH, class AO, class BO>
DEV void gemm_issue0(unsigned char* smem, const void* abase, const AO& aoff, const void* bbase, const BO& boff) {
    const int tid = TID(), lane = tid & 63; const int wid = __builtin_amdgcn_readfirstlane(tid >> 6);
    const unsigned lds0 = (unsigned)(uintptr_t)smem; const unsigned char* ab_ = uptr(abase); const unsigned char* bb_ = uptr(bbase);
#pragma unroll
    for (int h = 0; h < 2; ++h) {
        if (WHICH & (1 << (2 * h))) {
#pragma unroll
            for (int i = 0; i < 2; ++i) { const int p = wid + 8 * i; const int k = 4 * p + (lane >> 4); const int f = (k & 3) + 4 * ((k >> 3) & 1);
                glds16s(bb_, boff(k, h * 16 + ((lane & 15) ^ (f << 1))), (unsigned)__builtin_amdgcn_readfirstlane(lds0 + SB_(0, h) + p * 1024)); } }
        if (WHICH & (2 << (2 * h))) {
#pragma unroll
            for (int i = 0; i < 2; ++i) { const int p = wid + 8 * i;
                glds16s(ab_, aoff(h * 128 + 8 * p + (lane >> 3), (lane & 7) ^ (lane >> 3)), (unsigned)__builtin_amdgcn_readfirstlane(lds0 + SA_(0, h) + p * 1024)); } }
    }
}
template <class AO, class BO>
struct NextTile { bool on; unsigned char* smem; const void* abase; AO aoff; const void* bbase; BO boff;
    DEV bool has() const { return on; }
    template <int P> DEV void issue() const { gemm_issue0<P>(smem, abase, aoff, bbase, boff); } };
template <class AO, class BO> DEV NextTile<AO, BO> next_tile(bool on, unsigned char* smem, const void* abase, const AO& aoff, const void* bbase, const BO& boff) { return NextTile<AO, BO>{on, smem, abase, aoff, bbase, boff}; }
template <bool ZERO, class AO, class BO, class NX = NoNext>
DEV void gemm256(unsigned char* smem, int nkt, const void* abase, unsigned akstep, const AO& aoff, const void* bbase, unsigned bkstep, const BO& boff, f32x4 (&acc)[8][4], bool pre = false, const NX& next = NX()) {
    const int tid = TID(), lane = tid & 63; const int wid = __builtin_amdgcn_readfirstlane(tid >> 6); const int wr = wid >> 2, wc = wid & 3;
    if (ZERO) {
#pragma unroll
        for (int mi = 0; mi < 8; ++mi)
#pragma unroll
            for (int ni = 0; ni < 4; ++ni) acc[mi][ni] = (f32x4){0.f, 0.f, 0.f, 0.f};
    }
    const unsigned lds0 = (unsigned)(uintptr_t)smem;
    const unsigned char* abase_u = uptr(abase); const unsigned char* bbase_u = uptr(bbase); const unsigned akstep_u = __builtin_amdgcn_readfirstlane(akstep), bkstep_u = __builtin_amdgcn_readfirstlane(bkstep);
    unsigned ao[4], bo[4];
#pragma unroll
    for (int h = 0; h < 2; ++h)
#pragma unroll
        for (int i = 0; i < 2; ++i) { const int p = wid + 8 * i; ao[h * 2 + i] = aoff(h * 128 + 8 * p + (lane >> 3), (lane & 7) ^ (lane >> 3));
            const int k = 4 * p + (lane >> 4); const int f = (k & 3) + 4 * ((k >> 3) & 1); bo[h * 2 + i] = boff(k, h * 16 + ((lane & 15) ^ (f << 1))); }
    unsigned ard0[2], ard1[2], brd0[2], brd1[2];
    { const int l15 = lane & 15, g = lane >> 4, q = l15 >> 2; const int f = q + 4 * (g & 1);
      ard0[0] = lds0 + (wr * 64 + l15) * 128 + ((g ^ (lane & 7)) << 4); ard1[0] = lds0 + (wr * 64 + l15) * 128 + (((4 + g) ^ (lane & 7)) << 4);
      const int nc = wc * 4 + ((l15 & 3) >> 1); const int kr = 8 * g + q;
      brd0[0] = lds0 + kr * 256 + ((nc ^ (f << 1)) << 4) + (l15 & 1) * 8; brd1[0] = lds0 + kr * 256 + (((nc + 2) ^ (f << 1)) << 4) + (l15 & 1) * 8;
      ard0[1] = ard0[0] + GL_STAGE; ard1[1] = ard1[0] + GL_STAGE; brd0[1] = brd0[0] + GL_STAGE; brd1[1] = brd1[0] + GL_STAGE;
      asm volatile("" : "+v"(ard0[1]), "+v"(ard1[1]), "+v"(brd0[1]), "+v"(brd1[1])); }
#define ST_A(b, h, kt) do { const unsigned char* ab_ = abase_u + (size_t)(kt) * akstep_u; \
        _Pragma("unroll") for (int i_ = 0; i_ < 2; ++i_) glds16s(ab_, ao[(h) * 2 + i_], (unsigned)__builtin_amdgcn_readfirstlane(lds0 + SA_(b, h) + (wid + 8 * i_) * 1024)); } while (0)
#define ST_B(b, h, kt) do { const unsigned char* bb_ = bbase_u + (size_t)(kt) * bkstep_u; \
        _Pragma("unroll") for (int i_ = 0; i_ < 2; ++i_) glds16s(bb_, bo[(h) * 2 + i_], (unsigned)__builtin_amdgcn_readfirstlane(lds0 + SB_(b, h) + (wid + 8 * i_) * 1024)); } while (0)
#define LDSP(T, a_) ((LAS const T*)(uintptr_t)(a_))
#define LDA(dst, b, h) do { _Pragma("unroll") for (int m_ = 0; m_ < 4; ++m_) { dst[m_][0] = *LDSP(bf16x8, ard0[b] + SA_(0, h) + m_ * 2048); dst[m_][1] = *LDSP(bf16x8, ard1[b] + SA_(0, h) + m_ * 2048); } } while (0)
#define LDB(dst, b, h) do { _Pragma("unroll") for (int n_ = 0; n_ < 2; ++n_) _Pragma("unroll") for (int k_ = 0; k_ < 2; ++k_) { const unsigned p_ = (n_ ? brd1[b] : brd0[b]) + SB_(0, h) + k_ * 8192; \
        const s16x4 lo_ = tr_read_l(p_), hi_ = tr_read_l(p_ + 1024); dst[n_][k_] = (bf16x8){lo_[0], lo_[1], lo_[2], lo_[3], hi_[0], hi_[1], hi_[2], hi_[3]}; } } while (0)
#define MMA(ai, bj, Bx) do { __builtin_amdgcn_s_setprio(1); \
        _Pragma("unroll") for (int k_ = 0; k_ < 2; ++k_) _Pragma("unroll") for (int m_ = 0; m_ < 4; ++m_) _Pragma("unroll") for (int n_ = 0; n_ < 2; ++n_) \
            acc[(ai) * 4 + m_][(bj) * 2 + n_] = __builtin_amdgcn_mfma_f32_16x16x32_bf16(Bx[n_][k_], At[m_][k_], acc[(ai) * 4 + m_][(bj) * 2 + n_], 0, 0, 0); \
        __builtin_amdgcn_s_setprio(0); } while (0)
    bf16x8 At[4][2], B0[2][2], B1[2][2];
    if (!pre) { ST_B(0, 0, 0); ST_A(0, 0, 0); ST_B(0, 1, 0); ST_A(0, 1, 0); }
    if (wr == 1) BAR();
    if (!pre) WAIT_V(4);
    BAR();
    ST_B(1, 0, 1); ST_A(1, 0, 1); ST_B(1, 1, 1);
    if (!pre) WAIT_V(6);
    BAR();
    for (int t = 0; t < nkt - 2; t += 2) {
        LDB(B0, 0, 0); SCHED(); LDA(At, 0, 0); ST_A(1, 1, t + 1);
        WAIT_L(8); BAR(); WAIT_L(0); MMA(0, 0, B0); BAR(); SCHED();
        LDB(B1, 0, 1); ST_B(0, 0, t + 2);
        BAR(); WAIT_L(0); MMA(0, 1, B1); BAR();
        LDA(At, 0, 1); ST_A(0, 0, t + 2);
        BAR(); WAIT_L(0); MMA(1, 0, B0); BAR(); SCHED();
        ST_B(0, 1, t + 2);
        WAIT_V(6); BAR(); MMA(1, 1, B1); BAR();
        LDB(B0, 1, 0); SCHED(); LDA(At, 1, 0); ST_A(0, 1, t + 2);
        WAIT_L(8); BAR(); WAIT_L(0); MMA(0, 0, B0); BAR(); SCHED();
        LDB(B1, 1, 1); ST_B(1, 0, t + 3);
        BAR(); WAIT_L(0); MMA(0, 1, B1); BAR();
        LDA(At, 1, 1); ST_A(1, 0, t + 3);
        BAR(); WAIT_L(0); MMA(1, 0, B0); BAR(); SCHED();
        ST_B(1, 1, t + 3);
        WAIT_V(6); BAR(); MMA(1, 1, B1); BAR();
    }
    const bool hn = next.has();
    LDB(B0, 0, 0); LDA(At, 0, 0); ST_A(1, 1, nkt - 1);
    BAR(); WAIT_L(0); MMA(0, 0, B0); BAR();
    LDB(B1, 0, 1); BAR(); WAIT_L(0); MMA(0, 1, B1); BAR();
    LDA(At, 0, 1);
    if (hn) { next.template issue<3>(); WAIT_V(8); } else WAIT_V(4);
    BAR(); WAIT_L(0); MMA(1, 0, B0); MMA(1, 1, B1); BAR();
    LDB(B0, 1, 0); LDA(At, 1, 0);
    if (hn) { next.template issue<4>(); WAIT_V(8); } else WAIT_V(2);
    BAR(); WAIT_L(0); MMA(0, 0, B0); BAR();
    LDB(B1, 1, 1);
    if (hn) { next.template issue<8>(); WAIT_V(8); } else WAIT_V(0);
    BAR(); WAIT_L(0); MMA(0, 1, B1); BAR();
    LDA(At, 1, 1); BAR(); WAIT_L(0); MMA(1, 0, B0); MMA(1, 1, B1);
    WAIT_V(0);
    BAR();
    if (wr == 0) BAR();
#undef ST_A
#undef ST_B
#undef LDA
#undef LDB
#undef LDSP
#undef MMA
}

DEV uint4 pair16(uint2 a, uint2 b) {
    const auto r0 = __builtin_amdgcn_permlane16_swap(a.x, b.x, false, false); const auto r1 = __builtin_amdgcn_permlane16_swap(a.y, b.y, false, false);
    uint4 o; o.x = r0[0]; o.y = r1[0]; o.z = r0[1]; o.w = r1[1]; return o;
}
DEV void unpair16(uint4 q, uint2& a, uint2& b) {
    const auto r0 = __builtin_amdgcn_permlane16_swap(q.x, q.z, false, false); const auto r1 = __builtin_amdgcn_permlane16_swap(q.y, q.w, false, false);
    a.x = r0[0]; a.y = r1[0]; b.x = r0[1]; b.y = r1[1];
}
#define PAIR16_COL(c0, c1) ((((lane) >> 4) & 1) ? (c1) - 4 : (c0))
#define EPI_IDS() do { const int etid_ = TID(); lane = etid_ & 63; wid = etid_ >> 6; wr = wid >> 2; wc = wid & 3; } while (0)

DEV void patch_decode(int local, int MT, int NT, int& mt, int& nt) {
    const int per_mtb = 8 * NT; const int mtb = local / per_mtb; const int rem = local - mtb * per_mtb;
    const int rows = (MT - 8 * mtb) < 8 ? (MT - 8 * mtb) : 8;
    const int per_ntb = rows * 8; const int nfull = NT >> 3; int ntb = rem / per_ntb; int cols = 8;
    if (ntb >= nfull) { ntb = nfull; cols = NT - 8 * nfull; }
    const int r2 = rem - ntb * per_ntb;
    mt = 8 * mtb + r2 / cols; nt = 8 * ntb + r2 % cols;
}

DEV void convert_chunk(const float* src, bf16_t* dst, size_t i8) {
    const float4 a = *(const float4*)(src + i8 * 8), b = *(const float4*)(src + i8 * 8 + 4);
    uint4 o; o.x = cvtpk(a.x, a.y); o.y = cvtpk(a.z, a.w); o.z = cvtpk(b.x, b.y); o.w = cvtpk(b.z, b.w);
    *(uint4*)(dst + i8 * 8) = o;
}
DEV void phase_prologue(const Args& a, unsigned char* smem) {
    unsigned char* ws = a.ws;
    const size_t gtid = (size_t)BID() * NTHR + TID(), gn = (size_t)gridDim.x * NTHR;
    {
        { const float* W = a.in[I_WOUT]; bf16_t* O = (bf16_t*)(ws + WS_WOUT); const float* gnn = a.in[I_GNN]; const float* gnf = a.in[I_GNF];
          for (size_t i = gtid; i < (size_t)1024 * 128; i += gn) { const int k = (int)(i >> 7); const float g_ = k < 512 ? gnn[k] : gnf[k - 512];
              const float4 x = *(const float4*)(W + i * 8), y = *(const float4*)(W + i * 8 + 4);
              uint4 o; o.x = cvtpk(x.x * g_, x.y * g_); o.y = cvtpk(x.z * g_, x.w * g_); o.z = cvtpk(y.x * g_, y.y * g_); o.w = cvtpk(y.z * g_, y.w * g_); *(uint4*)(O + i * 8) = o; } }
        const float* srcs[3] = {a.in[I_WGATE], a.in[I_WPLE], a.in[I_P]};
        bf16_t* dsts[3] = {(bf16_t*)(ws + WS_WGATE), (bf16_t*)(ws + WS_WPLE), (bf16_t*)(ws + WS_PB)};
        const size_t cnt8[3] = {1024 * 1024 / 8, 256 * 1024 / 8, (size_t)NTOK * 256 / 8};
#pragma unroll
        for (int s = 0; s < 3; ++s) for (size_t i = gtid; i < cnt8[s]; i += gn) convert_chunk(srcs[s], dsts[s], i);
        for (size_t i = gtid; i < (size_t)2 * 2048 * 32; i += gn) { const int which = (int)(i / (2048 * 32)); const int k = (int)(i / 32) % 2048, c8 = (int)(i % 32) * 8;
            uint4 o = {0u, 0u, 0u, 0u};
            if (c8 < 128) { const float* W = a.in[which ? I_WC1V : I_WC1K] + (size_t)k * 128 + c8; const float4 x = *(const float4*)W, y = *(const float4*)(W + 4); o.x = cvtpk(x.x, x.y); o.y = cvtpk(x.z, x.w); o.z = cvtpk(y.x, y.y); o.w = cvtpk(y.z, y.w); }
            *(uint4*)((bf16_t*)(ws + WS_WC1) + i * 8) = o; }
        for (size_t i = gtid; i < (size_t)2 * 128 * 32; i += gn) { const int which = (int)(i / (128 * 32)); const int k = (int)(i / 32) % 128, c8 = (int)(i % 32) * 8;
            uint4 o = {0u, 0u, 0u, 0u};
            if (c8 < 64) { const float* W = a.in[which ? I_WC2V : I_WC2K] + (size_t)k * 64 + c8; const float4 x = *(const float4*)W, y = *(const float4*)(W + 4); o.x = cvtpk(x.x, x.y); o.y = cvtpk(x.z, x.w); o.z = cvtpk(y.x, y.y); o.w = cvtpk(y.z, y.w); }
            *(uint4*)((bf16_t*)(ws + WS_WC2) + i * 8) = o; }
    }
    {
        const float* W = a.in[I_WIN]; bf16_t* O = (bf16_t*)(ws + WS_WIN);
        for (size_t i = gtid; i < (size_t)1024 * (NWIN / 8); i += gn) {
            const int k = (int)(i / (NWIN / 8)), j = (int)(i % (NWIN / 8)) * 8;
            uint4 o = {0u, 0u, 0u, 0u};
            if (j < 2848) {
                const int sj = (j < 1280) ? j : (j < 2816) ? j + 24 : (j < 2840) ? j - 1536 : j;
                const float4 x = *(const float4*)(W + (size_t)k * 2848 + sj), y = *(const float4*)(W + (size_t)k * 2848 + sj + 4);
                o.x = cvtpk(x.x, x.y); o.y = cvtpk(x.z, x.w); o.z = cvtpk(y.x, y.y); o.w = cvtpk(y.z, y.w);
            }
            *(uint4*)(O + (size_t)k * NWIN + j) = o;
        }
    }
    const int lane = TID() & 63; const int gw = BID() * NWAVE + (TID() >> 6), ngw = gridDim.x * NWAVE;
    {
        const float* X = a.in[I_X]; const float* g = a.in[I_LN1]; bf16_t* XN = (bf16_t*)(ws + WS_XN);
        for (int m = gw; m < NTOK; m += ngw) {
            float4 v[4]; float s = 0.f;
#pragma unroll
            for (int j = 0; j < 4; ++j) { v[j] = *(const float4*)(X + (size_t)m * 1024 + j * 256 + lane * 4); s += v[j].x * v[j].x + v[j].y * v[j].y + v[j].z * v[j].z + v[j].w * v[j].w; }
            const float rstd = rsqrtf(wave_sum(s) * (1.f / 1024.f) + EPS);
#pragma unroll
            for (int j = 0; j < 4; ++j) { const float4 gg = *(const float4*)(g + j * 256 + lane * 4);
                uint2 o; o.x = cvtpk(v[j].x * rstd * gg.x, v[j].y * rstd * gg.y); o.y = cvtpk(v[j].z * rstd * gg.z, v[j].w * rstd * gg.w);
                *(uint2*)(XN + (size_t)m * 1024 + j * 256 + lane * 4) = o; }
        }
    }
    if (gw < 256) {
        const int which = gw >> 7, n = gw & 127; const float* pe = a.in[which ? I_PEV : I_PEK]; const float* w1 = a.in[which ? I_WC1V : I_WC1K];
        float s = 0.f;
#pragma unroll 8
        for (int i = 0; i < 32; ++i) { const int k = lane + 64 * i; s += pe[k] * w1[(size_t)k * 128 + n]; }
        s = wave_sum(s);
        if (lane == 0) ((float*)(ws + WS_BIAS1))[which * 128 + n] = s;
    }
}

DEV void phase_inproj(const Args& a, unsigned char* smem) {
    const bf16_t* XN = (const bf16_t*)(a.ws + WS_XN); const bf16_t* W = (const bf16_t*)(a.ws + WS_WIN);
    bf16_t* PROJ = (bf16_t*)(a.ws + WS_PROJ); float* GN = (float*)(a.ws + WS_GN); float* LS = (float*)(a.ws + WS_LS); const float* bfg = a.in[I_BFG];
    int lane = TID() & 63, wid = TID() >> 6, wr = wid >> 2, wc = wid & 3; (void)wr; (void)wc; (void)lane;
    bool pre = false;
    for (int item = VBID(); item < 64 * 12; item += gridDim.x) {
        int mt, nt; patch_decode(item, 64, 12, mt, nt);
        const int nitem = item + (int)gridDim.x; const bool has_next = nitem < 64 * 12; int mtn = 0, ntn = 0; if (has_next) patch_decode(nitem, 64, 12, mtn, ntn);
        f32x4 acc[8][4];
        auto aoffi = [](int r, int kc) { return (unsigned)(r * 2048 + kc * 16); }; auto boffi = [](int k, int nc) { return (unsigned)(k * (NWIN * 2) + nc * 16); };
        gemm256<true>(smem, 16, XN + (size_t)mt * 256 * 1024, 128u, aoffi, W + nt * 256, (unsigned)(64 * NWIN * 2), boffi, acc, pre,
                      next_tile(has_next, smem, XN + (size_t)mtn * 256 * 1024, aoffi, W + ntn * 256, boffi));
        pre = has_next;
        EPI_IDS();
#pragma unroll
        for (int mi = 0; mi < 8; ++mi) {
            const int gm = mt * 256 + G_ROW(mi); const int b = gm >> 13, t = gm & 8191;
            if (nt < 11) {
#pragma unroll
                for (int np = 0; np < 2; ++np) { const int n0 = G_COL(2 * np); const int hs = nt * 4 + (n0 >> 6), d0 = n0 & 63; const float sc = (hs < 8 || (hs >= 20 && hs < 28)) ? QS : 1.0f;
                    const f32x4 v0 = acc[mi][2 * np], v1 = acc[mi][2 * np + 1]; uint2 oa, ob; oa.x = cvtpk(v0[0] * sc, v0[1] * sc); oa.y = cvtpk(v0[2] * sc, v0[3] * sc); ob.x = cvtpk(v1[0] * sc, v1[1] * sc); ob.y = cvtpk(v1[2] * sc, v1[3] * sc);
                    *(uint4*)(PROJ + (((size_t)(hs * 2 + b)) * 8192 + t) * 64 + PAIR16_COL(d0, d0 + 16)) = pair16(oa, ob); }
            }
#pragma unroll
            for (int ni = 0; ni < 4; ++ni) {
                const int n = G_COL(ni); const f32x4 v = acc[mi][ni];
                if (nt < 11) {
                } else if (n < 24) {
#pragma unroll
                    for (int r = 0; r < 4; ++r) GN[(size_t)gm * 24 + n + r] = sigmoidf_(v[r]);
                } else if (n < 32) {
#pragma unroll
                    for (int r = 0; r < 4; ++r) { const int h = n - 24 + r; LS[((size_t)(b * 8 + h)) * 8192 + t] = logsigmoidf_(v[r] + bfg[h]); }
                }
            }
        }
    }
}

DEV void signal_done(unsigned* flag) {
    asm volatile("s_waitcnt vmcnt(0)" ::: "memory");
    __syncthreads();
    if (TID() == 0) { __builtin_amdgcn_fence(__ATOMIC_RELEASE, "agent"); asm volatile("s_waitcnt vmcnt(0)" ::: "memory"); __hip_atomic_fetch_add(flag, 1u, __ATOMIC_RELAXED, __HIP_MEMORY_SCOPE_AGENT); }
}
DEV void wait_flag(unsigned* flag, unsigned target) {
    if (TID() == 0) { unsigned sp = 0u; while (__hip_atomic_load(flag, __ATOMIC_RELAXED, __HIP_MEMORY_SCOPE_AGENT) < target) { __builtin_amdgcn_s_sleep(4); if (++sp > (1u << 24)) break; }
        __builtin_amdgcn_fence(__ATOMIC_ACQUIRE, "agent"); asm volatile("s_waitcnt vmcnt(0)" ::: "memory"); }
    __syncthreads();
}
constexpr int CW_CUMFLAG = 128, CW_CMPFLAG = 192, CW_GATEFLAG = 256;
DEV void cmp_item(const Args& a, unsigned char* smem, int item) {
    const bf16_t* PROJ = (const bf16_t*)(a.ws + WS_PROJ);
    const int tid = TID(); int lane = tid & 63, wid = tid >> 6, wr = wid >> 2, wc = wid & 3; (void)wr; (void)wc; (void)lane;
    {
        if (item < 16) {
            const int which = item >> 3, b = (item >> 2) & 1, g = (item >> 1) & 1, mt = item & 1;
            const bf16_t* base = PROJ + ((size_t)((8 + 2 * which + g) * 2 + b)) * 8192 * 64;
            const bf16_t* W1 = (const bf16_t*)(a.ws + WS_WC1) + (size_t)which * 2048 * 256;
            const bf16_t* W2 = (const bf16_t*)(a.ws + WS_WC2) + (size_t)which * 128 * 256;
            const float* bias1 = (const float*)(a.ws + WS_BIAS1) + which * 128;
            bf16_t* HID = (bf16_t*)(a.ws + WS_HID) + ((size_t)(which * 4 + b * 2 + g)) * 512 * 128;
            bf16_t* OUT = (bf16_t*)(a.ws + WS_KC) + ((size_t)(which * 4 + b * 2 + g)) * 512 * 64;
            f32x4 acc[8][4];
            gemm256s<true>(smem, 32, base, 128u, [&](int r, int kc) { int c = mt * 256 + r; c = c > 510 ? 510 : c; return (unsigned)(c * 2048 + kc * 16); },
                          W1, 64u * 512u, [&](int k, int nc) { return (unsigned)(k * 512 + nc * 16); }, acc);
        EPI_IDS();
            if (wc < 2) {
                float4 bb4[4];
#pragma unroll
                for (int ni = 0; ni < 4; ++ni) bb4[ni] = *(const float4*)(bias1 + wc * 64 + ni * 16 + 4 * (lane >> 4));
#pragma unroll
                for (int mi = 0; mi < 8; ++mi) { const int c = mt * 256 + wr * 128 + mi * 16 + (lane & 15);
#pragma unroll
                    for (int ni = 0; ni < 4; ++ni) { const int n = wc * 64 + ni * 16 + 4 * (lane >> 4); const f32x4 v = acc[mi][ni]; const float4 bb = bb4[ni];
                        uint2 o; o.x = cvtpk(gelu_tanh(v[0] + bb.x), gelu_tanh(v[1] + bb.y)); o.y = cvtpk(gelu_tanh(v[2] + bb.z), gelu_tanh(v[3] + bb.w));
                        *(uint2*)(HID + (size_t)c * 128 + n) = o; } }
            }
            __syncthreads();
            gemm256s<true>(smem, 2, HID + (size_t)mt * 256 * 128, 128u, [&](int r, int kc) { return (unsigned)(r * 256 + kc * 16); },
                          W2, 64u * 512u, [&](int k, int nc) { return (unsigned)(k * 512 + nc * 16); }, acc);
        EPI_IDS();
            if (wc == 0) {
#pragma unroll
                for (int mi = 0; mi < 8; ++mi) { const int c = mt * 256 + wr * 128 + mi * 16 + (lane & 15);
#pragma unroll
                    for (int ni = 0; ni < 4; ++ni) { const int n = ni * 16 + 4 * (lane >> 4); const f32x4 v = acc[mi][ni];
                        uint2 o; o.x = cvtpk(v[0], v[1]); o.y = cvtpk(v[2], v[3]);
                        if (c >= 511) { o.x = 0u; o.y = 0u; }
                        *(uint2*)(OUT + (size_t)c * 64 + n) = o; } }
            }
            signal_done((unsigned*)(a.ws + WS_CTL) + CW_CMPFLAG);
        } else {
            const int bh = item - 16; const float* LS = (const float*)(a.ws + WS_LS) + (size_t)bh * 8192; float* CUM = (float*)(a.ws + WS_CUM) + (size_t)bh * 8192;
            float* sc = (float*)smem;
            float v[16]; float s = 0.f;
#pragma unroll
            for (int j = 0; j < 4; ++j) { const float4 x = *(const float4*)(LS + tid * 16 + j * 4); v[4 * j] = x.x; v[4 * j + 1] = x.y; v[4 * j + 2] = x.z; v[4 * j + 3] = x.w; }
#pragma unroll
            for (int j = 0; j < 16; ++j) { s += v[j]; v[j] = s; }
            sc[tid] = s; __syncthreads();
            if (tid == 0) { float run = 0.f; for (int i = 0; i < NTHR; ++i) { const float x = sc[i]; sc[i] = run; run += x; } }
            __syncthreads();
            const float off = sc[tid];
#pragma unroll
            for (int j = 0; j < 4; ++j) { float4 o = {v[4 * j] + off, v[4 * j + 1] + off, v[4 * j + 2] + off, v[4 * j + 3] + off}; *(float4*)(CUM + tid * 16 + j * 4) = o; }
            signal_done((unsigned*)(a.ws + WS_CTL) + CW_CUMFLAG + bh);
        }
    }
}

constexpr int AT_STAGE = 16384;
constexpr int AT_BIAS_OFF = 3 * AT_STAGE;
constexpr int AT_IMP_OFF = AT_BIAS_OFF + 1024;
constexpr int AT_SEL_OFF = AT_IMP_OFF + 65536;
constexpr int AT_WUN_OFF = AT_SEL_OFF + 1024;
constexpr int AT_UCNT_OFF = AT_WUN_OFF + 128;
constexpr int AT_ULIST_OFF = AT_UCNT_OFF + 16;
constexpr int AT_ITEM_OFF = AT_ULIST_OFF + 128;
static_assert(AT_ITEM_OFF + 16 <= GEMM_LDS, "attention LDS map");
#define NEG_INF (-__builtin_inff())

#define KV_DECL uint4 rk0_, rv0_
#define KV_GLOAD(Kt, Vt) do { rk0_ = *(const uint4*)((Kt) + tid * 8); rv0_ = *(const uint4*)((Vt) + tid * 8); } while (0)
#define KV_LSTORE(stp) do { unsigned char* st_ = (stp); const int key = tid >> 3, ch = tid & 7; \
      *(uint4*)(st_ + key * 128 + ((ch ^ (key & 7)) << 4)) = rk0_; \
      *(uint4*)(st_ + 8192 + key * 128 + ((((ch >> 2) ^ ((key >> 1) & 1))) << 6) + ((ch & 3) << 4)) = rv0_; } while (0)
template <bool FULL>
DEV void qk_tile(const unsigned char* Kst, const bf16x8 (&qf)[4], f32x16& p0, f32x16& p1, int lane) {
    const int key = lane & 31, hi = lane >> 5;
    if (FULL) {
        bf16x8 k0[4], k1[4];
#pragma unroll
        for (int ks = 0; ks < 4; ++ks) { const int ch = 2 * ks + hi; const int off = key * 128 + ((ch ^ (key & 7)) << 4);
            k0[ks] = *(const bf16x8*)(Kst + off); k1[ks] = *(const bf16x8*)(Kst + off + 32 * 128); }
        __builtin_amdgcn_sched_barrier(0);
#pragma unroll
        for (int ks = 0; ks < 4; ++ks) {
            p0 = __builtin_amdgcn_mfma_f32_32x32x16_bf16(k0[ks], qf[ks], p0, 0, 0, 0);
            p1 = __builtin_amdgcn_mfma_f32_32x32x16_bf16(k1[ks], qf[ks], p1, 0, 0, 0); }
    } else {
        bf16x8 kk[4];
#pragma unroll
        for (int ks = 0; ks < 4; ++ks) { const int ch = 2 * ks + hi; kk[ks] = *(const bf16x8*)(Kst + key * 128 + ((ch ^ (key & 7)) << 4)); }
        __builtin_amdgcn_sched_barrier(0);
#pragma unroll
        for (int ks = 0; ks < 4; ++ks) p0 = __builtin_amdgcn_mfma_f32_32x32x16_bf16(kk[ks], qf[ks], p0, 0, 0, 0);
        __builtin_amdgcn_sched_barrier(0);
#pragma unroll
        for (int ks = 0; ks < 4; ++ks) { const int ch = 2 * ks + hi; kk[ks] = *(const bf16x8*)(Kst + key * 128 + ((ch ^ (key & 7)) << 4) + 32 * 128); }
        __builtin_amdgcn_sched_barrier(0);
#pragma unroll
        for (int ks = 0; ks < 4; ++ks) p1 = __builtin_amdgcn_mfma_f32_32x32x16_bf16(kk[ks], qf[ks], p1, 0, 0, 0);
    }
}
template <bool FULL>
DEV void pv_tile(const unsigned char* Vst, const f32x16& p0, const f32x16& p1, f32x16 (&o)[2], int lane) {
    const int hi = lane >> 5, i = lane & 15, gg = (lane >> 4) & 1;
    const int q = i >> 2; const int sw = (q >> 1) & 1;
    bf16x8 pa[4];
#pragma unroll
    for (int s = 0; s < 4; ++s) { const f32x16& p = (s < 2) ? p0 : p1; const int b = (s & 1) * 8;
        unsigned w[4];
#pragma unroll
        for (int j = 0; j < 4; ++j) w[j] = cvtpk(p[b + 2 * j], p[b + 2 * j + 1]);
        typedef unsigned u32x4_t __attribute__((ext_vector_type(4)));
        u32x4_t ww = {w[0], w[1], w[2], w[3]}; pa[s] = __builtin_bit_cast(bf16x8, ww); }
    constexpr int NB = FULL ? 1 : 2, SB = FULL ? 4 : 2;
#pragma unroll
    for (int bt = 0; bt < NB; ++bt) {
        s16x4 vlo[SB][2], vhi[SB][2];
#pragma unroll
        for (int s_ = 0; s_ < SB; ++s_)
#pragma unroll
            for (int dh = 0; dh < 2; ++dh) { const int s = bt * SB + s_; const int row0 = 16 * s + 4 * hi + q;
                const unsigned char* p = Vst + row0 * 128 + ((dh ^ sw) << 6) + gg * 32 + (i & 3) * 8;
                vlo[s_][dh] = tr_read(p); vhi[s_][dh] = tr_read(p + 8 * 128); }
        __builtin_amdgcn_sched_barrier(0);
#pragma unroll
        for (int s_ = 0; s_ < SB; ++s_)
#pragma unroll
            for (int dh = 0; dh < 2; ++dh) { const int s = bt * SB + s_;
                const bf16x8 vf = {vlo[s_][dh][0], vlo[s_][dh][1], vlo[s_][dh][2], vlo[s_][dh][3], vhi[s_][dh][0], vhi[s_][dh][1], vhi[s_][dh][2], vhi[s_][dh][3]};
                o[dh] = __builtin_amdgcn_mfma_f32_32x32x16_bf16(vf, pa[s], o[dh], 0, 0, 0); }
        __builtin_amdgcn_sched_barrier(0);
    }
}
DEV float rowmax32(const f32x16& p0, const f32x16& p1) {
    float a = fmaxf(p0[0], p1[0]), b = fmaxf(p0[1], p1[1]);
#pragma unroll
    for (int r = 2; r < 16; r += 2) { a = fmaxf(fmaxf(a, p0[r]), p1[r]); b = fmaxf(fmaxf(b, p0[r + 1]), p1[r + 1]); }
    return pair_max(fmaxf(a, b));
}
DEV void softmax_step(f32x16& p0, f32x16& p1, float& m, float& l, f32x16 (&o)[2]) {
    const float mt = rowmax32(p0, p1); const float mn = fmaxf(m, mt); const float alpha = __builtin_amdgcn_exp2f(m - mn);
    float rs = 0.f;
#pragma unroll
    for (int r = 0; r < 16; ++r) { p0[r] = __builtin_amdgcn_exp2f(p0[r] - mn); p1[r] = __builtin_amdgcn_exp2f(p1[r] - mn); rs += p0[r] + p1[r]; }
    rs = pair_sum(rs);
    l = l * alpha + rs; m = mn;
    if (__any(alpha != 1.0f)) { o[0] *= alpha; o[1] *= alpha; }
}
DEV void softmax_step_nosum(f32x16& p0, f32x16& p1, float& m, f32x16 (&o)[2], f32x16& lacc) {
    const float mt = rowmax32(p0, p1); const float mn = fmaxf(m, mt); const float alpha = __builtin_amdgcn_exp2f(m - mn);
#pragma unroll
    for (int r = 0; r < 16; ++r) { p0[r] = __builtin_amdgcn_exp2f(p0[r] - mn); p1[r] = __builtin_amdgcn_exp2f(p1[r] - mn); }
    m = mn;
    if (__any(alpha != 1.0f)) { o[0] *= alpha; o[1] *= alpha; lacc *= alpha; }
}
DEV void pv_tile_sum(const unsigned char* Vst, const f32x16& p0, const f32x16& p1, f32x16 (&o)[2], f32x16& lacc, int lane) {
    const int hi = lane >> 5, i = lane & 15, gg = (lane >> 4) & 1;
    const int q = i >> 2; const int sw = (q >> 1) & 1;
    bf16x8 pa[4];
#pragma unroll
    for (int s = 0; s < 4; ++s) { const f32x16& p = (s < 2) ? p0 : p1; const int b = (s & 1) * 8;
        unsigned w[4];
#pragma unroll
        for (int j = 0; j < 4; ++j) w[j] = cvtpk(p[b + 2 * j], p[b + 2 * j + 1]);
        typedef unsigned u32x4_t __attribute__((ext_vector_type(4)));
        u32x4_t ww = {w[0], w[1], w[2], w[3]}; pa[s] = __builtin_bit_cast(bf16x8, ww); }
    const bf16x8 ones = {0x3f80, 0x3f80, 0x3f80, 0x3f80, 0x3f80, 0x3f80, 0x3f80, 0x3f80};
#pragma unroll
    for (int bt = 0; bt < 2; ++bt) {
        s16x4 vlo[2][2], vhi[2][2];
#pragma unroll
        for (int s_ = 0; s_ < 2; ++s_)
#pragma unroll
            for (int dh = 0; dh < 2; ++dh) { const int s = bt * 2 + s_; const int row0 = 16 * s + 4 * hi + q;
                const unsigned char* p = Vst + row0 * 128 + ((dh ^ sw) << 6) + gg * 32 + (i & 3) * 8;
                vlo[s_][dh] = tr_read(p); vhi[s_][dh] = tr_read(p + 8 * 128); }
        __builtin_amdgcn_sched_barrier(0);
#pragma unroll
        for (int s_ = 0; s_ < 2; ++s_) { const int s = bt * 2 + s_;
            lacc = __builtin_amdgcn_mfma_f32_32x32x16_bf16(ones, pa[s], lacc, 0, 0, 0);
#pragma unroll
            for (int dh = 0; dh < 2; ++dh) {
                const bf16x8 vf = {vlo[s_][dh][0], vlo[s_][dh][1], vlo[s_][dh][2], vlo[s_][dh][3], vhi[s_][dh][0], vhi[s_][dh][1], vhi[s_][dh][2], vhi[s_][dh][3]};
                o[dh] = __builtin_amdgcn_mfma_f32_32x32x16_bf16(vf, pa[s], o[dh], 0, 0, 0); } }
        __builtin_amdgcn_sched_barrier(0);
    }
}
template <int STRIDE> DEV void mask_tile(f32x16& p0, f32x16& p1, int kpos0, int lo, int hi_lim, int hi) {
#pragma unroll
    for (int r = 0; r < 16; ++r) { const int kp = kpos0 + STRIDE * crow(r, hi);
        if (kp < lo || kp > hi_lim) p0[r] = NEG_INF;
        const int kp1 = kp + 32 * STRIDE; if (kp1 < lo || kp1 > hi_lim) p1[r] = NEG_INF; }
}
template <int STRIDE> DEV void alibi_init(f32x16& p0, f32x16& p1, float slope2, int kpos0, int tref, int hi) {
    const float base = slope2 * (float)(kpos0 - tref + STRIDE * 4 * hi);
#pragma unroll
    for (int r = 0; r < 16; ++r) { const float c = (float)(STRIDE * ((r & 3) + 8 * (r >> 2))); p0[r] = fmaf(slope2, c, base); p1[r] = fmaf(slope2, c + (float)(32 * STRIDE), base); }
}
template <class Src, class Body, class NSrc>
DEV int kv_pipeline(unsigned char* smem, int n, const Src& src, const Body& body, int par, bool pre, bool has_next, const NSrc& nsrc) {
    KV_DECL; const int tid = TID(); const bf16_t *kp, *vp;
    if (!pre) { src(0, kp, vp); KV_GLOAD(kp, vp); KV_LSTORE(smem + par * AT_STAGE); __syncthreads(); }
    for (int j = 0; j < n; ++j) {
        const bool more = j + 1 < n;
        src(more ? j + 1 : j, kp, vp); if (!more && has_next) nsrc(kp, vp);
        KV_GLOAD(kp, vp);
        body(j, smem + ((par + j) & 1) * AT_STAGE);
        KV_LSTORE(smem + ((par + j + 1) & 1) * AT_STAGE);
        __syncthreads();
    }
    return (par + n) & 1;
}
struct NoSrc { DEV void operator()(const bf16_t*&, const bf16_t*&) const {} };

constexpr int CV_PER_STEP = 373; constexpr int CV_NUP = 32 * 1024 * 2048 / 8, CV_NDN = 32 * 1024 * 1024 / 8;
static_assert((long long)33792 * CV_PER_STEP >= (long long)CV_NUP + CV_NDN, "conversion coverage");
DEV void fox_item(const Args& a, unsigned char* smem, int fi, int b, int h, int qb) {
    const int tid = TID(), lane = tid & 63, wid = tid >> 6, r32 = lane & 31, hi = lane >> 5;
    const bf16_t* PROJ = (const bf16_t*)(a.ws + WS_PROJ);
    const bf16_t* Q = PROJ + ((size_t)((20 + h) * 2 + b)) * 8192 * 64; const bf16_t* K = PROJ + ((size_t)((28 + h) * 2 + b)) * 8192 * 64; const bf16_t* V = PROJ + ((size_t)((36 + h) * 2 + b)) * 8192 * 64;
    const float* CUM = (const float*)(a.ws + WS_CUM) + (size_t)(b * 8 + h) * 8192;
    const int q0 = qb * 256; const int qrow = q0 + 32 * wid + r32;
    bf16x8 qf[4];
#pragma unroll
    for (int ks = 0; ks < 4; ++ks) qf[ks] = *(const bf16x8*)(Q + (size_t)qrow * 64 + 16 * ks + 8 * hi);
    const float cref = CUM[q0];
    const int ntiles = 4 * qb + 4; const int jmax_w = (q0 + 32 * wid + 31) >> 6; const int jmask_w = (q0 + 32 * wid) >> 6;
    f32x16 o[2]; o[0] = (f32x16){}; o[1] = (f32x16){}; f32x16 lacc = (f32x16){}; float m = -1e30f;
    float* biasL = (float*)(smem + AT_BIAS_OFF);
    const int gq_ = fi >> 4; const int sidx0 = 16 * (128 * gq_ - 2 * gq_ * (gq_ - 1)) + (fi & 15) * (128 - 4 * gq_);
    bf16_t* cvdA = nullptr; bf16_t* cvdB = nullptr; float4 cvaA, cvbA, cvaB, cvbB;
    KV_DECL; float breg = 0.f;
#define TJ(s_) (ntiles - 1 - (s_))
#define CV_ADDR(st_, SRC, DST) do { int c_ = (sidx0 + (st_)) * CV_PER_STEP + (tid < CV_PER_STEP ? tid : CV_PER_STEP - 1); c_ = c_ < CV_NUP + CV_NDN ? c_ : CV_NUP + CV_NDN - 1; \
        const bool up_ = c_ < CV_NUP; const int cc_ = up_ ? c_ : c_ - CV_NUP; SRC = (up_ ? a.in[I_WUP] : a.in[I_WDN]) + (size_t)cc_ * 8; DST = (bf16_t*)(a.ws + (up_ ? WS_WUP : WS_WDN)) + (size_t)cc_ * 8; } while (0)
    { const float* cvs_; CV_ADDR(0, cvs_, cvdB); cvaB = *(const float4*)cvs_; cvbB = *(const float4*)(cvs_ + 4); }
    KV_GLOAD(K + (size_t)TJ(0) * 4096, V + (size_t)TJ(0) * 4096); breg = CUM[TJ(0) * 64 + lane];
    KV_LSTORE(smem); biasL[lane] = (cref - breg) * LOG2E;
    KV_GLOAD(K + (size_t)TJ(1) * 4096, V + (size_t)TJ(1) * 4096); breg = CUM[TJ(1) * 64 + lane];
    KV_LSTORE(smem + AT_STAGE); biasL[64 + lane] = (cref - breg) * LOG2E;
    __syncthreads();
#define FOX_QK(P0, P1, jj, sj) do { const float* bl_ = biasL + (sj) * 64; \
        _Pragma("unroll") for (int g4 = 0; g4 < 4; ++g4) { const float4 x_ = *(const float4*)(bl_ + 8 * g4 + 4 * hi), y_ = *(const float4*)(bl_ + 32 + 8 * g4 + 4 * hi); \
            P0[4 * g4] = x_.x; P0[4 * g4 + 1] = x_.y; P0[4 * g4 + 2] = x_.z; P0[4 * g4 + 3] = x_.w; P1[4 * g4] = y_.x; P1[4 * g4 + 1] = y_.y; P1[4 * g4 + 2] = y_.z; P1[4 * g4 + 3] = y_.w; } \
        qk_tile<true>(smem + (sj) * AT_STAGE, qf, P0, P1, lane); \
        if ((jj) >= jmask_w) mask_tile<1>(P0, P1, 64 * (jj), -1, qrow, hi); } while (0)
#define FOX_STEP(CUR0, CUR1, NXT0, NXT1, j, CVD_LD, CVA_LD, CVB_LD, CVD_ST, CVA_ST, CVB_ST) do { \
        const int s_cur = (j) % 3, s_nxt = ((j) + 1) % 3, s_ld = ((j) + 2) % 3; const int tl_ = TJ((j) + 2) < 0 ? 0 : TJ((j) + 2);     \
        KV_GLOAD(K + (size_t)tl_ * 4096, V + (size_t)tl_ * 4096); breg = CUM[tl_ * 64 + lane]; \
        { const float* cvs_; CV_ADDR(j, cvs_, CVD_LD); CVA_LD = *(const float4*)cvs_; CVB_LD = *(const float4*)(cvs_ + 4); } \
        if ((j) + 1 < ntiles && TJ((j) + 1) <= jmax_w) FOX_QK(NXT0, NXT1, TJ((j) + 1), s_nxt); \
        __builtin_amdgcn_sched_barrier(0); \
        if (TJ(j) <= jmax_w) { softmax_step_nosum(CUR0, CUR1, m, o, lacc); pv_tile_sum(smem + s_cur * AT_STAGE + 8192, CUR0, CUR1, o, lacc, lane); } \
        KV_LSTORE(smem + s_ld * AT_STAGE); biasL[s_ld * 64 + lane] = (cref - breg) * LOG2E; \
        { uint4 o_; o_.x = cvtpk(CVA_ST.x, CVA_ST.y); o_.y = cvtpk(CVA_ST.z, CVA_ST.w); o_.z = cvtpk(CVB_ST.x, CVB_ST.y); o_.w = cvtpk(CVB_ST.z, CVB_ST.w); *(uint4*)CVD_ST = o_; } \
        __syncthreads(); } while (0)
    f32x16 pA0, pA1, pB0, pB1;
    if (TJ(0) <= jmax_w) FOX_QK(pA0, pA1, TJ(0), 0);
    for (int j = 0; j < ntiles; j += 2) {
        FOX_STEP(pA0, pA1, pB0, pB1, j, cvdA, cvaA, cvbA, cvdB, cvaB, cvbB);
        FOX_STEP(pB0, pB1, pA0, pA1, j + 1, cvdB, cvaB, cvbB, cvdA, cvaA, cvbA);
    }
    { uint4 o_; o_.x = cvtpk(cvaB.x, cvaB.y); o_.y = cvtpk(cvaB.z, cvaB.w); o_.z = cvtpk(cvbB.x, cvbB.y); o_.w = cvtpk(cvbB.z, cvbB.w); *(uint4*)cvdB = o_; }
#undef CV_ADDR
#undef FOX_QK
#undef FOX_STEP
#undef TJ
    const float inv = 1.0f / lacc[0]; float ss = 0.f;
    const size_t token = (size_t)b * 8192 + qrow;
    bf16_t* O = (bf16_t*)(a.ws + WS_OFOX) + token * 512 + h * 64;
#pragma unroll
    for (int dh = 0; dh < 2; ++dh)
#pragma unroll
        for (int g4 = 0; g4 < 4; ++g4) { const float v0 = o[dh][4 * g4] * inv, v1 = o[dh][4 * g4 + 1] * inv, v2 = o[dh][4 * g4 + 2] * inv, v3 = o[dh][4 * g4 + 3] * inv;
            ss += v0 * v0 + v1 * v1 + v2 * v2 + v3 * v3; uint2 w; w.x = cvtpk(v0, v1); w.y = cvtpk(v2, v3); *(uint2*)(O + 32 * dh + 8 * g4 + 4 * hi) = w; }
    ss = pair_sum(ss);
    if (hi == 0) ((float*)(a.ws + WS_SSQ))[token * 16 + 8 + h] = ss;
}

DEV void nsa_item(const Args& a, unsigned char* smem, int b, int g, int tt) {
    const int tid = TID(), lane = tid & 63, wid = tid >> 6, col = lane & 31, hi = lane >> 5;
    const int t0 = tt * 64, tokw = col >> 2, r = col & 3, h = 4 * g + r; const int tokl = wid * 8 + tokw; const int t = t0 + tokl; const size_t token = (size_t)b * 8192 + t;
    const float slope2 = exp2f(-(float)(h + 1)) * LOG2E;
    const bf16_t* PROJ = (const bf16_t*)(a.ws + WS_PROJ);
    const float* GN = (const float*)(a.ws + WS_GN) + token * 24 + h * 3;
    const int cur = tt; const bool need_topk = cur > 15;
    bf16x8 qf[4];
    { const bf16_t* Q = PROJ + (((size_t)(h * 2 + b)) * 8192 + t) * 64;
#pragma unroll
      for (int ks = 0; ks < 4; ++ks) qf[ks] = *(const bf16x8*)(Q + 16 * ks + 8 * hi); }
    float* impw = (float*)(smem + AT_IMP_OFF) + wid * 2048; float* totw = impw + lane;
    unsigned* selmask = (unsigned*)(smem + AT_SEL_OFF); unsigned* wun = (unsigned*)(smem + AT_WUN_OFF); int* ucnt = (int*)(smem + AT_UCNT_OFF); unsigned char* ulist = smem + AT_ULIST_OFF;
    f32x16 o[2]; float m, l; int par = 0;
    const int tmin_w = t0 + wid * 8, tmax_w = tmin_w + 7;
    {
        const bf16_t* KC = (const bf16_t*)(a.ws + WS_KC) + ((size_t)(0 * 4 + b * 2 + g)) * 512 * 64; const bf16_t* VC = (const bf16_t*)(a.ws + WS_KC) + ((size_t)(1 * 4 + b * 2 + g)) * 512 * 64;
        const int ncv = t0 / 16 + 3; const int nct = (ncv + 63) >> 6;
        auto src = [&](int j, const bf16_t*& kp, const bf16_t*& vp) { kp = KC + (size_t)j * 4096; vp = VC + (size_t)j * 4096; };
        m = -1e30f; l = 0.f;
        auto src0 = [&](const bf16_t*& kp, const bf16_t*& vp) { kp = KC; vp = VC; };
        par = kv_pipeline(smem, nct, src, [&](int j, const unsigned char* st) {
            const int kpos0 = 1024 * j + 31;
            if (kpos0 > tmax_w) return;
            f32x16 p0, p1; alibi_init<16>(p0, p1, slope2, kpos0, t0, hi);
            qk_tile<false>(st, qf, p0, p1, lane);
            if (kpos0 + 16 * 63 > tmin_w) mask_tile<16>(p0, p1, kpos0, -1, t, hi);
            const float mt = rowmax32(p0, p1); const float mn = fmaxf(m, mt); float rs = 0.f;
#pragma unroll
            for (int rr = 0; rr < 16; ++rr) rs += __builtin_amdgcn_exp2f(p0[rr] - mn) + __builtin_amdgcn_exp2f(p1[rr] - mn);
            rs = pair_sum(rs);
            l = l * __builtin_amdgcn_exp2f(m - mn) + rs; m = mn;
        }, 0, false, true, src0);
        const float linv = l > 0.f ? 1.0f / l : 0.f;
        if (need_topk) { for (int i = lane; i < 8 * 129; i += 64) impw[i] = 0.f; }
        o[0] = (f32x16){}; o[1] = (f32x16){};
        const bf16_t* KS0 = PROJ + ((size_t)((12 + g) * 2 + b)) * 8192 * 64 + (size_t)cur * 4096; const bf16_t* VS0 = PROJ + ((size_t)((14 + g) * 2 + b)) * 8192 * 64 + (size_t)cur * 4096;
        par = kv_pipeline(smem, nct, src, [&](int j, const unsigned char* st) {
            const int kpos0 = 1024 * j + 31;
            if (kpos0 > tmax_w) return;
            f32x16 p0, p1; alibi_init<16>(p0, p1, slope2, kpos0, t0, hi);
            qk_tile<false>(st, qf, p0, p1, lane);
            if (kpos0 + 16 * 63 > tmin_w) mask_tile<16>(p0, p1, kpos0, -1, t, hi);
#pragma unroll
            for (int rr = 0; rr < 16; ++rr) { p0[rr] = __builtin_amdgcn_exp2f(p0[rr] - m) * linv; p1[rr] = __builtin_amdgcn_exp2f(p1[rr] - m) * linv; }
            if (need_topk) {
#pragma unroll
                for (int half = 0; half < 2; ++half)
#pragma unroll
                    for (int g4 = 0; g4 < 4; ++g4) { const f32x16& p = half ? p1 : p0;
                        float ms = (p[4 * g4] + p[4 * g4 + 1]) + (p[4 * g4 + 2] + p[4 * g4 + 3]); float ls = p[4 * g4 + 3];
                        ms = quad_sum(ms); ls = quad_sum(ls);
                        const int n = 16 * j + 8 * half + 2 * g4 + hi;
                        if (r == 0) { atomicAdd(&impw[tokw * 129 + n], ms); atomicAdd(&impw[tokw * 129 + n + 1], ls); } }
            }
            pv_tile<false>(st + 8192, p0, p1, o, lane);
        }, par, true, true, [&](const bf16_t*& kp, const bf16_t*& vp) { kp = KS0; vp = VS0; });
    }
    {
        unsigned un0 = 0u, un1 = 0u, un2 = 0u, un3 = 0u;
        if (need_topk) {
#define TK_INIT(V0, V1, M0, M1, M2, M3, tk_) float V0 = impw[(tk_) * 129 + lane], V1 = impw[(tk_) * 129 + 64 + lane]; \
                V0 = (lane >= 1 && lane <= cur - 2) ? V0 : -1.0f; V1 = (lane + 64 <= cur - 2) ? V1 : -1.0f; unsigned M0 = 1u, M1 = 0u, M2 = 0u, M3 = 0u; \
                TK_SET(M0, M1, M2, M3, cur); TK_SET(M0, M1, M2, M3, cur - 1)
#define TK_SET(M0, M1, M2, M3, n_) do { const int n__ = (n_); const unsigned bit__ = 1u << (n__ & 31); const int w__ = n__ >> 5; M0 |= (w__ == 0) ? bit__ : 0u; M1 |= (w__ == 1) ? bit__ : 0u; M2 |= (w__ == 2) ? bit__ : 0u; M3 |= (w__ == 3) ? bit__ : 0u; } while (0)
#define TK_STEP(V0, V1, M0, M1, M2, M3) do { const float mx_ = wave_max_u(fmaxf(V0, V1)); const unsigned long long b0_ = __ballot(V0 == mx_), b1_ = __ballot(V1 == mx_); \
                const int n_ = b0_ ? (__ffsll((long long)b0_) - 1) : (63 + __ffsll((long long)b1_)); const bool hit_ = lane == (n_ & 63); \
                V0 = (hit_ && n_ < 64) ? -1.0f : V0; V1 = (hit_ && n_ >= 64) ? -1.0f : V1; TK_SET(M0, M1, M2, M3, n_); } while (0)
            for (int tk = 0; tk < 8; tk += 4) {
                TK_INIT(a0_, a1_, ma0, ma1, ma2, ma3, tk); TK_INIT(b0v, b1v, mb0, mb1, mb2, mb3, tk + 1); TK_INIT(c0v, c1v, mc0, mc1, mc2, mc3, tk + 2); TK_INIT(d0v, d1v, md0, md1, md2, md3, tk + 3);
                for (int it = 0; it < 13; ++it) { TK_STEP(a0_, a1_, ma0, ma1, ma2, ma3); TK_STEP(b0v, b1v, mb0, mb1, mb2, mb3); TK_STEP(c0v, c1v, mc0, mc1, mc2, mc3); TK_STEP(d0v, d1v, md0, md1, md2, md3); }
                if (lane == 0) { unsigned* sm_ = selmask + (wid * 8 + tk) * 4; sm_[0] = ma0; sm_[1] = ma1; sm_[2] = ma2; sm_[3] = ma3; sm_[4] = mb0; sm_[5] = mb1; sm_[6] = mb2; sm_[7] = mb3;
                    sm_[8] = mc0; sm_[9] = mc1; sm_[10] = mc2; sm_[11] = mc3; sm_[12] = md0; sm_[13] = md1; sm_[14] = md2; sm_[15] = md3; }
                un0 |= ma0 | mb0 | mc0 | md0; un1 |= ma1 | mb1 | mc1 | md1; un2 |= ma2 | mb2 | mc2 | md2; un3 |= ma3 | mb3 | mc3 | md3;
            }
#undef TK_INIT
#undef TK_SET
#undef TK_STEP
        } else {
            const unsigned full = (2u << cur) - 1u;
            un0 = full;
            if (lane < 8) { unsigned* sm_ = selmask + (wid * 8 + lane) * 4; sm_[0] = full; sm_[1] = 0u; sm_[2] = 0u; sm_[3] = 0u; }
        }
        if (lane == 0) { wun[wid * 4] = un0; wun[wid * 4 + 1] = un1; wun[wid * 4 + 2] = un2; wun[wid * 4 + 3] = un3; }
        __syncthreads();
        if (tid == 0) { int c = 0;
            for (int w = 0; w < 4; ++w) { unsigned u = 0u; for (int ww = 0; ww < NWAVE; ++ww) u |= wun[ww * 4 + w]; for (int bb = 0; bb < 32; ++bb) if ((u >> bb) & 1u) ulist[c++] = (unsigned char)(w * 32 + bb); }
            ucnt[0] = c; }
        __syncthreads();
    }
    { const float g0 = GN[0];
#pragma unroll
      for (int rr = 0; rr < 16; ++rr) { totw[rr * 64] = o[0][rr] * g0; totw[(16 + rr) * 64] = o[1][rr] * g0; } }
    {
        const bf16_t* KS = PROJ + ((size_t)((12 + g) * 2 + b)) * 8192 * 64; const bf16_t* VS = PROJ + ((size_t)((14 + g) * 2 + b)) * 8192 * 64;
        const int nu = ucnt[0];
        m = -1e30f; f32x16 lacc = (f32x16){}; o[0] = (f32x16){}; o[1] = (f32x16){};
        const bf16_t* KW0 = PROJ + ((size_t)((16 + g) * 2 + b)) * 8192 * 64 + (size_t)cur * 4096; const bf16_t* VW0 = PROJ + ((size_t)((18 + g) * 2 + b)) * 8192 * 64 + (size_t)cur * 4096;
        par = kv_pipeline(smem, nu, [&](int j, const bf16_t*& kp, const bf16_t*& vp) { const int n = ulist[nu - 1 - j]; kp = KS + (size_t)n * 4096; vp = VS + (size_t)n * 4096; },
            [&](int j, const unsigned char* st) {
                const int n = ulist[nu - 1 - j];
                if (!((wun[wid * 4 + (n >> 5)] >> (n & 31)) & 1u)) return;
                const bool sel = (selmask[tokl * 4 + (n >> 5)] >> (n & 31)) & 1u;
                f32x16 p0, p1; alibi_init<1>(p0, p1, slope2, 64 * n, t0, hi);
                qk_tile<false>(st, qf, p0, p1, lane);
                if (n == cur || !__all(sel)) mask_tile<1>(p0, p1, 64 * n, -1, sel ? t : -1, hi);
                softmax_step_nosum(p0, p1, m, o, lacc);
                pv_tile_sum(st + 8192, p0, p1, o, lacc, lane);
            }, par, true, true, [&](const bf16_t*& kp, const bf16_t*& vp) { kp = KW0; vp = VW0; });
        const float g1 = GN[1] / fmaxf(lacc[0], 1e-30f);
#pragma unroll
        for (int rr = 0; rr < 16; ++rr) { totw[rr * 64] += o[0][rr] * g1; totw[(16 + rr) * 64] += o[1][rr] * g1; }
    }
    {
        const bf16_t* KW = PROJ + ((size_t)((16 + g) * 2 + b)) * 8192 * 64; const bf16_t* VW = PROJ + ((size_t)((18 + g) * 2 + b)) * 8192 * 64;
        const int jlo = (t0 - 511) > 0 ? ((t0 - 511) >> 6) : 0; const int jhi = cur;
        m = -1e30f; f32x16 lacc = (f32x16){}; o[0] = (f32x16){}; o[1] = (f32x16){};
        (void)kv_pipeline(smem, jhi - jlo + 1, [&](int j, const bf16_t*& kp, const bf16_t*& vp) { kp = KW + (size_t)(jhi - j) * 4096; vp = VW + (size_t)(jhi - j) * 4096; },
            [&](int j, const unsigned char* st) {
                const int kpos0 = 64 * (jhi - j);
                if (kpos0 > tmax_w || kpos0 + 63 < tmin_w - 511) return;
                f32x16 p0, p1; alibi_init<1>(p0, p1, slope2, kpos0, t0, hi);
                qk_tile<false>(st, qf, p0, p1, lane);
                if (kpos0 < tmax_w - 511 || kpos0 + 63 > tmin_w) mask_tile<1>(p0, p1, kpos0, t - 511, t, hi);
                softmax_step_nosum(p0, p1, m, o, lacc);
                pv_tile_sum(st + 8192, p0, p1, o, lacc, lane);
            }, par, true, false, NoSrc());
        const float g2 = GN[2] / fmaxf(lacc[0], 1e-30f);
#pragma unroll
        for (int rr = 0; rr < 16; ++rr) { o[0][rr] = totw[rr * 64] + o[0][rr] * g2; o[1][rr] = totw[(16 + rr) * 64] + o[1][rr] * g2; }
    }
    {
        float ss = 0.f; bf16_t* O = (bf16_t*)(a.ws + WS_ONSA) + token * 512 + h * 64;
#pragma unroll
        for (int dh = 0; dh < 2; ++dh)
#pragma unroll
            for (int g4 = 0; g4 < 4; ++g4) { const float v0 = o[dh][4 * g4], v1 = o[dh][4 * g4 + 1], v2 = o[dh][4 * g4 + 2], v3 = o[dh][4 * g4 + 3];
                ss += v0 * v0 + v1 * v1 + v2 * v2 + v3 * v3; uint2 w; w.x = cvtpk(v0, v1); w.y = cvtpk(v2, v3); *(uint2*)(O + 32 * dh + 8 * g4 + 4 * hi) = w; }
        ss = pair_sum(ss);
        if (hi == 0) ((float*)(a.ws + WS_SSQ))[token * 16 + h] = ss;
    }
}
#ifndef PROBE_DUP
#define PROBE_DUP 0
#endif
DEV void phase_att(const Args& a, unsigned char* smem) {
    int* qctr = (int*)(a.ws + WS_CTL) + 64; int* sitem = (int*)(smem + AT_ITEM_OFF);
    unsigned* ctl = (unsigned*)(a.ws + WS_CTL); unsigned* seen = (unsigned*)(smem + AT_ITEM_OFF + 8);
    if (TID() == 0) seen[0] = 0u;
    for (;;) {
        if (TID() == 0) sitem[0] = atomicAdd(qctr, 1);
        __syncthreads();
        const int item = sitem[0];
        __syncthreads();
        if (item >= 32 + 1024) break;
        if (item < 16) cmp_item(a, smem, 16 + item);
        else if (item < 32) cmp_item(a, smem, item - 16);
        else if (item < 32 + 512) { const int fi = item - 32; const int qb = 31 - (fi >> 4), bh = fi & 15; if (!((seen[0] >> bh) & 1u)) { wait_flag(ctl + CW_CUMFLAG + bh, 1u); if (TID() == 0) seen[0] |= 1u << bh; } fox_item(a, smem, fi, bh >> 3, bh & 7, qb); }
        else { const int idx = item - 32 - 512; const int tt = 127 - (idx >> 2), bg = idx & 3; if (!((seen[0] >> 16) & 1u)) { wait_flag(ctl + CW_CMPFLAG, 16u); if (TID() == 0) seen[0] |= 1u << 16; } nsa_item(a, smem, bg >> 1, bg & 1, tt); }
    }
}

DEV void phase_outproj(const Args& a, unsigned char* smem) {
    const bf16_t* ONSA = (const bf16_t*)(a.ws + WS_ONSA); const bf16_t* OFOX = (const bf16_t*)(a.ws + WS_OFOX); const float* SSQ = (const float*)(a.ws + WS_SSQ);
    const bf16_t* W = (const bf16_t*)(a.ws + WS_WOUT); float* H1 = (float*)(a.ws + WS_H1); const float* X = a.in[I_X];
    float* rs = (float*)(smem + MISC_OFF);
    const int tid = TID(); int lane = tid & 63, wid = tid >> 6, wr = wid >> 2, wc = wid & 3; (void)wr; (void)wc; (void)lane;
    auto aoffo = [](int r, int kc) { return (unsigned)(r * 1024 + kc * 16); }; auto boffo = [](int k, int nc) { return (unsigned)(k * 2048 + nc * 16); };
    for (int item = VBID(); item < 64 * 4; item += gridDim.x) {
        int mt, nt; patch_decode(item, 64, 4, mt, nt);
        gemm_issue0<15>(smem, ONSA + (size_t)mt * 256 * 512, aoffo, W + nt * 256, boffo);
        if (tid < 256) { const float* s_ = SSQ + (size_t)(mt * 256 + tid) * 16; float sn = 0.f, sf = 0.f;
#pragma unroll
            for (int j = 0; j < 8; ++j) { sn += s_[j]; sf += s_[8 + j]; }
            rs[tid * 2] = rsqrtf(sn * (1.f / 512.f) + EPS); rs[tid * 2 + 1] = rsqrtf(sf * (1.f / 512.f) + EPS); }
        asm volatile("s_waitcnt vmcnt(0)" ::: "memory");
        __syncthreads();
        f32x4 acc[8][4];
#pragma unroll
        for (int mi = 0; mi < 8; ++mi) { const size_t gm = (size_t)mt * 256 + G_ROW(mi);
#pragma unroll
            for (int ni = 0; ni < 4; ++ni) { const int n = nt * 256 + G_COL(ni); const float4 x = *(const float4*)(X + gm * 1024 + n); acc[mi][ni] = (f32x4){x.x, x.y, x.z, x.w}; } }
#pragma unroll
        for (int mi = 0; mi < 8; ++mi) { const float ri = 1.0f / rs[(G_ROW(mi)) * 2];
#pragma unroll
            for (int ni = 0; ni < 4; ++ni) acc[mi][ni] *= ri; }
        gemm256<false>(smem, 8, ONSA + (size_t)mt * 256 * 512, 128u, aoffo, W + nt * 256, 64u * 2048u, boffo, acc, true,
                       next_tile(true, smem, OFOX + (size_t)mt * 256 * 512, aoffo, W + (size_t)512 * 1024 + nt * 256, boffo));
        EPI_IDS();
#pragma unroll
        for (int mi = 0; mi < 8; ++mi) { const int rl = G_ROW(mi); const float rat = rs[rl * 2] / rs[rl * 2 + 1];
#pragma unroll
            for (int ni = 0; ni < 4; ++ni) acc[mi][ni] *= rat; }
        gemm256<false>(smem, 8, OFOX + (size_t)mt * 256 * 512, 128u, aoffo, W + (size_t)512 * 1024 + nt * 256, 64u * 2048u, boffo, acc, true);
        EPI_IDS();
#pragma unroll
        for (int mi = 0; mi < 8; ++mi) { const int rl = G_ROW(mi); const size_t gm = (size_t)mt * 256 + rl; const float rf = rs[rl * 2 + 1];
#pragma unroll
            for (int ni = 0; ni < 4; ++ni) { const int n = nt * 256 + G_COL(ni); const f32x4 v = acc[mi][ni] * rf;
                float4 o = {v[0], v[1], v[2], v[3]}; *(float4*)(H1 + gm * 1024 + n) = o; } }
        __syncthreads();
    }
}

DEV void phase_route(const Args& a, unsigned char* smem) {
    const float* H1 = (const float*)(a.ws + WS_H1); bf16_t* XN = (bf16_t*)(a.ws + WS_XN); float* RSTD2 = (float*)(a.ws + WS_RSTD2);
    const float* ln2 = a.in[I_LN2]; const float* wr_ = a.in[I_WR]; const float* br = a.in[I_BR];
    int* CNT = (int*)(a.ws + WS_CTL);
    int* TOPI = (int*)(a.ws + WS_TOPI); int* TOPS = (int*)(a.ws + WS_TOPS); float* TOPW = (float*)(a.ws + WS_TOPW);
    int* TOKOF = (int*)(a.ws + WS_TOKOF); float* ROWW = (float*)(a.ws + WS_ROWW); float* RSDS = (float*)(a.ws + WS_RSDS);
    float* part = (float*)smem;
    float* ssqp = part + 8 * 32 * 33;
    int* lcnt = (int*)(ssqp + 256); int* lbase = lcnt + 32; int* te = lbase + 32; int* trk = te + 256; float* tw = (float*)(trk + 256); float* trs = tw + 256;
    const int tid = TID(), lane = tid & 63, wid = tid >> 6, i32 = lane & 31, kh = lane >> 5; const int tg = wid >> 2, kq = wid & 3;
    for (int item = BID(); item < 256; item += gridDim.x) {
        const int tok = item * 64 + tg * 32 + i32;
        if (tid < 32) lcnt[tid] = 0;
        f32x16 acc = (f32x16){}; float ss = 0.f;
        const float* hrow = H1 + (size_t)tok * 1024 + 256 * kq + 8 * kh; const float* lrow = ln2 + 256 * kq + 8 * kh; bf16_t* xrow = XN + (size_t)tok * 1024 + 256 * kq + 8 * kh;
        const float* wbase = wr_ + (size_t)(256 * kq + 8 * kh) * 32 + i32;
#pragma unroll 1
        for (int hb = 0; hb < 2; ++hb) {
            float4 hv[8][2], lv[8][2]; float wv[8][8];
#pragma unroll
            for (int c = 0; c < 8; ++c) { const int cc = hb * 8 + c;
                hv[c][0] = *(const float4*)(hrow + 16 * cc); hv[c][1] = *(const float4*)(hrow + 16 * cc + 4); lv[c][0] = *(const float4*)(lrow + 16 * cc); lv[c][1] = *(const float4*)(lrow + 16 * cc + 4);
#pragma unroll
                for (int r = 0; r < 8; ++r) wv[c][r] = wbase[(size_t)(16 * cc + r) * 32]; }
#pragma unroll
            for (int c = 0; c < 8; ++c) { const int cc = hb * 8 + c; float x[8];
                x[0] = hv[c][0].x * lv[c][0].x; x[1] = hv[c][0].y * lv[c][0].y; x[2] = hv[c][0].z * lv[c][0].z; x[3] = hv[c][0].w * lv[c][0].w;
                x[4] = hv[c][1].x * lv[c][1].x; x[5] = hv[c][1].y * lv[c][1].y; x[6] = hv[c][1].z * lv[c][1].z; x[7] = hv[c][1].w * lv[c][1].w;
                ss += hv[c][0].x * hv[c][0].x + hv[c][0].y * hv[c][0].y + hv[c][0].z * hv[c][0].z + hv[c][0].w * hv[c][0].w + hv[c][1].x * hv[c][1].x + hv[c][1].y * hv[c][1].y + hv[c][1].z * hv[c][1].z + hv[c][1].w * hv[c][1].w;
                uint4 o; o.x = cvtpk(x[0], x[1]); o.y = cvtpk(x[2], x[3]); o.z = cvtpk(x[4], x[5]); o.w = cvtpk(x[6], x[7]); *(uint4*)(xrow + 16 * cc) = o;
#pragma unroll
                for (int r = 0; r < 8; ++r) acc = __builtin_amdgcn_mfma_f32_32x32x2f32(x[r], wv[c][r], acc, 0, 0, 0); }
        }
        ss = pair_sum(ss);
        if (kh == 0) ssqp[wid * 32 + i32] = ss;
#pragma unroll
        for (int r = 0; r < 16; ++r) part[(wid * 32 + crow(r, kh)) * 33 + i32] = acc[r];
        __syncthreads();
        if (tid < 64) {
            const int g_ = tid >> 5, i_ = tid & 31; const int w0_ = g_ * 4;
            const float sq = ssqp[(w0_ + 0) * 32 + i_] + ssqp[(w0_ + 1) * 32 + i_] + ssqp[(w0_ + 2) * 32 + i_] + ssqp[(w0_ + 3) * 32 + i_]; const float rstd = rsqrtf(sq * (1.f / 1024.f) + EPS);
            RSTD2[item * 64 + tid] = rstd; trs[tid] = rstd;
            float lg[32];
#pragma unroll
            for (int e = 0; e < 32; ++e) lg[e] = (part[((w0_ + 0) * 32 + i_) * 33 + e] + part[((w0_ + 1) * 32 + i_) * 33 + e] + part[((w0_ + 2) * 32 + i_) * 33 + e] + part[((w0_ + 3) * 32 + i_) * 33 + e]) * rstd + br[e];
            unsigned taken = 0u; float tv[4]; int ti[4];
#pragma unroll
            for (int k = 0; k < 4; ++k) { float best = -3.0e38f; int bi = 0;
#pragma unroll
                for (int e = 0; e < 32; ++e) { const bool ok = !((taken >> e) & 1u) && lg[e] > best; best = ok ? lg[e] : best; bi = ok ? e : bi; }
                taken |= 1u << bi; tv[k] = best; ti[k] = bi; }
            const float e1 = __expf(tv[1] - tv[0]), e2 = __expf(tv[2] - tv[0]), e3 = __expf(tv[3] - tv[0]); const float inv = 1.0f / (1.0f + e1 + e2 + e3);
            const float wv[4] = {inv, e1 * inv, e2 * inv, e3 * inv};
#pragma unroll
            for (int k = 0; k < 4; ++k) { const int idx = tid * 4 + k; te[idx] = ti[k]; trk[idx] = atomicAdd(&lcnt[ti[k]], 1); tw[idx] = wv[k]; }
        }
        __syncthreads();
        if (tid < 32) lbase[tid] = atomicAdd(&CNT[tid], lcnt[tid]);
        __syncthreads();
        if (tid < 256) { const int idx = tid; const int tk = item * 64 + (idx >> 2); const int e = te[idx]; const int slot = lbase[e] + trk[idx];
          TOPI[(size_t)tk * 4 + (idx & 3)] = e; TOPS[(size_t)tk * 4 + (idx & 3)] = slot; TOPW[(size_t)tk * 4 + (idx & 3)] = tw[idx];
          TOKOF[(size_t)e * 16384 + slot] = tk; ROWW[(size_t)e * 16384 + slot] = tw[idx]; RSDS[(size_t)e * 16384 + slot] = trs[idx >> 2]; }
        __syncthreads();
    }
}

struct MoeMap { int e, mt, nt, cnt, off; };
DEV void moe_setup(const Args& a, int* sm) {
    if (TID() == 0) { const int* CNT = (const int*)(a.ws + WS_CTL); int tot = 0; for (int e = 0; e < 32; ++e) { const int c = CNT[e]; const int mt = (c + 255) >> 8; sm[e] = mt; sm[32 + e] = tot; tot += mt; } sm[64] = tot; }
    __syncthreads();
}
DEV MoeMap moe_map(const Args& a, const int* sm, int item, int NT) {
    MoeMap mm; int e = 0;
#pragma unroll 1
    for (int i = 1; i < 32; ++i) if (item >= sm[32 + i] * NT) e = i;
    const int local = item - sm[32 + e] * NT; const int mte = sm[e];
    int mt_, nt_; patch_decode(local, mte, NT, mt_, nt_);
    mm.e = __builtin_amdgcn_readfirstlane(e); mm.mt = __builtin_amdgcn_readfirstlane(mt_); mm.nt = __builtin_amdgcn_readfirstlane(nt_);
    mm.cnt = __builtin_amdgcn_readfirstlane(((const int*)(a.ws + WS_CTL))[e]); mm.off = __builtin_amdgcn_readfirstlane(sm[32 + e] * 256); return mm;
}
DEV int moe_maps_build(const Args& a, const int* sm, int* maps, int nitems, int NT) {
    const int tid = TID(); const int first = VBID(); const int nmine = first < nitems ? (nitems - first + (int)gridDim.x - 1) / (int)gridDim.x : 0;
    for (int k = tid; k < nmine && k < 64; k += NTHR) { const int item = first + k * (int)gridDim.x; int e = 0;
#pragma unroll 1
        for (int i = 1; i < 32; ++i) if (item >= sm[32 + i] * NT) e = i;
        const int local = item - sm[32 + e] * NT; int mt_, nt_; patch_decode(local, sm[e], NT, mt_, nt_);
        maps[k * 8] = e; maps[k * 8 + 1] = mt_; maps[k * 8 + 2] = nt_; maps[k * 8 + 3] = ((const int*)(a.ws + WS_CTL))[e]; maps[k * 8 + 4] = sm[32 + e] * 256; }
    __syncthreads();
    return nmine < 64 ? nmine : 64;
}
DEV MoeMap moe_get(const int* maps, int k) { MoeMap mm; mm.e = __builtin_amdgcn_readfirstlane(maps[k * 8]); mm.mt = __builtin_amdgcn_readfirstlane(maps[k * 8 + 1]); mm.nt = __builtin_amdgcn_readfirstlane(maps[k * 8 + 2]);
    mm.cnt = __builtin_amdgcn_readfirstlane(maps[k * 8 + 3]); mm.off = __builtin_amdgcn_readfirstlane(maps[k * 8 + 4]); return mm; }
DEV void phase_up(const Args& a, unsigned char* smem) {
    int* sm = (int*)(smem + MISC_OFF); int* maps = (int*)(smem + MISC_OFF + 8192); int* tokb = maps + 512; float* rsdb = (float*)(tokb + 768); float* biab = rsdb + 768;
    static_assert(8192 + (512 + 3 * 768) * 4 <= 8192 + 12288, "misc LDS");
    const bf16_t* XN = (const bf16_t*)(a.ws + WS_XN); const bf16_t* W = (const bf16_t*)(a.ws + WS_WUP); bf16_t* ACT = (bf16_t*)(a.ws + WS_ACT); const float* RSDS = (const float*)(a.ws + WS_RSDS);
    const int* TOKOF = (const int*)(a.ws + WS_TOKOF); const float* bup = a.in[I_BUP];
    const int tid = TID(); int lane = tid & 63, wid = tid >> 6, wr = wid >> 2, wc = wid & 3; (void)wr; (void)wc; (void)lane;
    moe_setup(a, sm);
    const int nitems = __builtin_amdgcn_readfirstlane(sm[64]) * 8;
    const int nmine = __builtin_amdgcn_readfirstlane(moe_maps_build(a, sm, maps, nitems, 8));
    int tkr = 0; float rsr = 0.f, bir = 0.f;
    const int t8 = tid & 255;
    auto side_load = [&](const MoeMap& m_) { const int slot = m_.mt * 256 + t8; const bool ok = slot < m_.cnt; const size_t sl_ = (size_t)m_.e * 16384 + (ok ? slot : 0); const int tk_ = TOKOF[sl_]; const float rs_ = RSDS[sl_]; tkr = ok ? tk_ : 0; rsr = ok ? rs_ : 0.f;
        bir = bup[(size_t)m_.e * 2048 + (t8 < 128 ? m_.nt * 128 + t8 : 1024 + m_.nt * 128 + t8 - 128)]; };
    auto side_store = [&](int slot3) { tokb[slot3 * 256 + t8] = tkr; rsdb[slot3 * 256 + t8] = rsr; biab[slot3 * 256 + t8] = bir; };
    auto boffu = [](int k, int nc) { const int sc = ((nc >> 4) ? 1024 : 0) + (nc & 15) * 8; return (unsigned)(k * 4096 + sc * 2); };
    MoeMap mm{}, mn{};
    if (nmine > 0) { mm = moe_get(maps, 0); side_load(mm); side_store(0); }
    if (nmine > 1) { mn = moe_get(maps, 1); side_load(mn); side_store(1); }
    __syncthreads();
    bool pre = false;
    for (int k = 0; k < nmine; ++k) {
        const bool has_next = k + 1 < nmine, has_nn = k + 2 < nmine;
        { const MoeMap m2 = moe_get(maps, has_nn ? k + 2 : nmine - 1); side_load(m2); }
        const int s0 = k % 3, s1 = (k + 1) % 3, s2 = (k + 2) % 3;
        const int* tok = tokb + s0 * 256; const int* tokn = tokb + s1 * 256; const float* rsd = rsdb + s0 * 256; const float* bia = biab + s0 * 256;
        const bf16_t* We = W + (size_t)mm.e * 1024 * 2048; const bf16_t* Wn = W + (size_t)mn.e * 1024 * 2048;
        f32x4 acc[8][4];
        gemm256<true>(smem, 16, XN, 128u, [&](int r, int kc) { return (unsigned)(tok[r] * 2048 + kc * 16); }, We + mm.nt * 128, 64u * 4096u, boffu, acc, pre,
                      next_tile(has_next, smem, XN, [&](int r, int kc) { return (unsigned)(tokn[r] * 2048 + kc * 16); }, Wn + mn.nt * 128, boffu));
        side_store(s2);
        EPI_IDS();
        float bgv[2][4], blv[2][4];
#pragma unroll
        for (int ni = 0; ni < 2; ++ni) { const int jl = wc * 32 + ni * 16 + 4 * (lane >> 4); const float4 bg = *(const float4*)(bia + jl), bl_ = *(const float4*)(bia + 128 + jl);
            bgv[ni][0] = bg.x; bgv[ni][1] = bg.y; bgv[ni][2] = bg.z; bgv[ni][3] = bg.w; blv[ni][0] = bl_.x; blv[ni][1] = bl_.y; blv[ni][2] = bl_.z; blv[ni][3] = bl_.w; }
#pragma unroll
        for (int mi = 0; mi < 8; ++mi) { const int rl_ = G_ROW(mi); const size_t row = (size_t)mm.off + mm.mt * 256 + rl_; const float rs_ = rsd[rl_];
            uint2 o2[2];
#pragma unroll
            for (int ni = 0; ni < 2; ++ni) {
                const f32x4 gv = acc[mi][ni], lv = acc[mi][ni + 2]; float r4[4];
#pragma unroll
                for (int r = 0; r < 4; ++r) { const float gg = fminf(gv[r] * rs_ + bgv[ni][r], 7.0f); const float ll = fminf(fmaxf(lv[r] * rs_ + blv[ni][r], -7.0f), 7.0f); r4[r] = gg * sigmoidf_(1.702f * gg) * (ll + 1.0f); }
                o2[ni].x = cvtpk(r4[0], r4[1]); o2[ni].y = cvtpk(r4[2], r4[3]); }
            { const int c0 = wc * 32 + 4 * (lane >> 4); *(uint4*)(ACT + row * 1024 + mm.nt * 128 + PAIR16_COL(c0, c0 + 16)) = pair16(o2[0], o2[1]); } }
        lds_barrier();
        mm = mn; if (has_nn) mn = moe_get(maps, k + 2); pre = has_next;
    }
}
DEV void phase_down(const Args& a, unsigned char* smem) {
    int* sm = (int*)(smem + MISC_OFF); int* maps = (int*)(smem + MISC_OFF + 8192); float* rwb = (float*)(maps + 512); float* biab = rwb + 768;
    const bf16_t* ACT = (const bf16_t*)(a.ws + WS_ACT); const bf16_t* W = (const bf16_t*)(a.ws + WS_WDN); bf16_t* Y = (bf16_t*)(a.ws + WS_Y);
    const float* ROWW = (const float*)(a.ws + WS_ROWW); const float* bdn = a.in[I_BDN];
    const int tid = TID(); int lane = tid & 63, wid = tid >> 6, wr = wid >> 2, wc = wid & 3; (void)wr; (void)wc; (void)lane;
    moe_setup(a, sm);
    const int nitems = __builtin_amdgcn_readfirstlane(sm[64]) * 4;
    const int nmine = __builtin_amdgcn_readfirstlane(moe_maps_build(a, sm, maps, nitems, 4));
    float rwr = 0.f, bir = 0.f;
    const int t8 = tid & 255;
    auto side_load = [&](const MoeMap& m_) { const int slot = m_.mt * 256 + t8; const bool ok = slot < m_.cnt; const float rw_ = ROWW[(size_t)m_.e * 16384 + (ok ? slot : 0)]; rwr = ok ? rw_ : 0.f; bir = bdn[(size_t)m_.e * 1024 + m_.nt * 256 + t8]; };
    auto side_store = [&](int slot3) { rwb[slot3 * 256 + t8] = rwr; biab[slot3 * 256 + t8] = bir; };
    auto aoffd = [](int r, int kc) { return (unsigned)(r * 2048 + kc * 16); }; auto boffd = [](int k, int nc) { return (unsigned)(k * 2048 + nc * 16); };
    MoeMap mm{}, mn{};
    if (nmine > 0) { mm = moe_get(maps, 0); side_load(mm); side_store(0); }
    if (nmine > 1) { mn = moe_get(maps, 1); side_load(mn); side_store(1); }
    __syncthreads();
    bool pre = false;
    for (int k = 0; k < nmine; ++k) {
        const bool has_next = k + 1 < nmine, has_nn = k + 2 < nmine;
        { const MoeMap m2 = moe_get(maps, has_nn ? k + 2 : nmine - 1); side_load(m2); }
        const int s0 = k % 3, s2 = (k + 2) % 3;
        const float* rw = rwb + s0 * 256; const float* bia = biab + s0 * 256;
        const bf16_t* We = W + (size_t)mm.e * 1024 * 1024; const bf16_t* Ab = ACT + ((size_t)mm.off + mm.mt * 256) * 1024;
        const bf16_t* Wn = W + (size_t)mn.e * 1024 * 1024; const bf16_t* An = ACT + ((size_t)mn.off + mn.mt * 256) * 1024;
        f32x4 acc[8][4];
        gemm256<true>(smem, 16, Ab, 128u, aoffd, We + mm.nt * 256, 64u * 2048u, boffd, acc, pre,
                      next_tile(has_next, smem, An, aoffd, Wn + mn.nt * 256, boffd));
        side_store(s2);
        EPI_IDS();
        float4 bb[4];
#pragma unroll
        for (int ni = 0; ni < 4; ++ni) bb[ni] = *(const float4*)(bia + G_COL(ni));
#pragma unroll
        for (int mi = 0; mi < 8; ++mi) { const int rl = G_ROW(mi); const size_t row = (size_t)mm.off + mm.mt * 256 + rl; const float w = rw[rl];
#pragma unroll
            for (int np = 0; np < 2; ++np) { uint2 o2[2];
#pragma unroll
                for (int h = 0; h < 2; ++h) { const int ni = 2 * np + h; const f32x4 v = acc[mi][ni]; o2[h].x = cvtpk((v[0] + bb[ni].x) * w, (v[1] + bb[ni].y) * w); o2[h].y = cvtpk((v[2] + bb[ni].z) * w, (v[3] + bb[ni].w) * w); }
                *(uint4*)(Y + row * 1024 + mm.nt * 256 + PAIR16_COL(G_COL(2 * np), G_COL(2 * np + 1))) = pair16(o2[0], o2[1]); } }
        lds_barrier();
        mm = mn; if (has_nn) mn = moe_get(maps, k + 2); pre = has_next;
    }
}

DEV void phase_comb(const Args& a, unsigned char* smem) {
    int* sm = (int*)(smem + MISC_OFF);
    moe_setup(a, sm);
    float* H1 = (float*)(a.ws + WS_H1); bf16_t* XN = (bf16_t*)(a.ws + WS_XN); const bf16_t* Y = (const bf16_t*)(a.ws + WS_Y);
    const int* TOPI = (const int*)(a.ws + WS_TOPI); const int* TOPS = (const int*)(a.ws + WS_TOPS); const float* g = a.in[I_LNPLE];
    const int lane = TID() & 63; const int gw = BID() * NWAVE + (TID() >> 6), ngw = gridDim.x * NWAVE;
    for (int tok = gw; tok < NTOK; tok += ngw) {
        float4 v[4];
#pragma unroll
        for (int j = 0; j < 4; ++j) v[j] = *(const float4*)(H1 + (size_t)tok * 1024 + j * 256 + lane * 4);
#pragma unroll
        for (int k = 0; k < 4; ++k) { const int e = TOPI[(size_t)tok * 4 + k]; const size_t row = (size_t)sm[32 + e] * 256 + TOPS[(size_t)tok * 4 + k];
#pragma unroll
            for (int j = 0; j < 4; ++j) { const uint2 u = *(const uint2*)(Y + row * 1024 + j * 256 + lane * 4); v[j].x += bflo(u.x); v[j].y += bfhi(u.x); v[j].z += bflo(u.y); v[j].w += bfhi(u.y); } }
        float s = 0.f;
#pragma unroll
        for (int j = 0; j < 4; ++j) { *(float4*)(H1 + (size_t)tok * 1024 + j * 256 + lane * 4) = v[j]; s += v[j].x * v[j].x + v[j].y * v[j].y + v[j].z * v[j].z + v[j].w * v[j].w; }
        const float rstd = rsqrtf(wave_sum(s) * (1.f / 1024.f) + EPS);
#pragma unroll
        for (int j = 0; j < 4; ++j) { const float4 gg = *(const float4*)(g + j * 256 + lane * 4);
            uint2 o; o.x = cvtpk(v[j].x * rstd * gg.x, v[j].y * rstd * gg.y); o.y = cvtpk(v[j].z * rstd * gg.z, v[j].w * rstd * gg.w); *(uint2*)(XN + (size_t)tok * 1024 + j * 256 + lane * 4) = o; }
    }
}

DEV void phase_gate(const Args& a, unsigned char* smem) {
    const bf16_t* XN = (const bf16_t*)(a.ws + WS_XN); const bf16_t* WG = (const bf16_t*)(a.ws + WS_WGATE); const bf16_t* PB = (const bf16_t*)(a.ws + WS_PB); const bf16_t* WP = (const bf16_t*)(a.ws + WS_WPLE);
    const float* H2 = (const float*)(a.ws + WS_H1); float* OUT = a.out; float* SSQ3 = (float*)(a.ws + WS_SSQ3);
    const int tid = TID(); int lane = tid & 63, wid = tid >> 6, wr = wid >> 2, wc = wid & 3; (void)wr; (void)wc; (void)lane;
    bf16_t* GT = (bf16_t*)(a.ws + WS_ACT);
    auto aoffg = [](int r, int kc) { return (unsigned)(r * 2048 + kc * 16); }; auto aoffp = [](int r, int kc) { return (unsigned)(r * 512 + kc * 16); }; auto boffg = [](int k, int nc) { return (unsigned)(k * 2048 + nc * 16); };
    for (int item = VBID(); item < 64 * 4; item += gridDim.x) {
        int mt, nt; patch_decode(item, 64, 4, mt, nt);
        f32x4 acc[8][4];
        gemm256<true>(smem, 16, XN + (size_t)mt * 256 * 1024, 128u, aoffg, WG + nt * 256, 64u * 2048u, boffg, acc, false,
                      next_tile(true, smem, PB + (size_t)mt * 256 * 256, aoffp, WP + nt * 256, boffg));
        EPI_IDS();
#pragma unroll
        for (int hb = 0; hb < 2; ++hb) {
            uint2 wq[4][4];
#pragma unroll
            for (int m4 = 0; m4 < 4; ++m4) { const int mi = hb * 4 + m4; const size_t gm = (size_t)mt * 256 + G_ROW(mi);
#pragma unroll
                for (int ni = 0; ni < 4; ++ni) { const int n = nt * 256 + G_COL(ni); const f32x4 v = acc[mi][ni];
                    uint2 w; w.x = cvtpk(sigmoidf_(v[0]), sigmoidf_(v[1])); w.y = cvtpk(sigmoidf_(v[2]), sigmoidf_(v[3])); wq[m4][ni] = w;
                    const float4 h = *(const float4*)(H2 + gm * 1024 + n); acc[mi][ni] = (f32x4){h.x, h.y, h.z, h.w}; } }
#pragma unroll
            for (int m4 = 0; m4 < 4; ++m4) { const int mi = hb * 4 + m4; const size_t gm = (size_t)mt * 256 + G_ROW(mi);
#pragma unroll
                for (int ni = 0; ni < 4; ++ni) { const uint2 w = wq[m4][ni]; const f32x4 h = acc[mi][ni];
                    if (ni & 1) *(uint4*)(GT + gm * 1024 + nt * 256 + PAIR16_COL(G_COL(ni - 1), G_COL(ni))) = pair16(wq[m4][ni - 1], w);
                    acc[mi][ni] = (f32x4){h[0] * __builtin_amdgcn_rcpf(bflo(w.x)), h[1] * __builtin_amdgcn_rcpf(bfhi(w.x)), h[2] * __builtin_amdgcn_rcpf(bflo(w.y)), h[3] * __builtin_amdgcn_rcpf(bfhi(w.y))}; } }
            asm volatile("" ::: "memory");
        }
        gemm256<false>(smem, 4, PB + (size_t)mt * 256 * 256, 128u, aoffp, WP + nt * 256, 64u * 2048u, boffg, acc, true);
        EPI_IDS();
        const bool fused = gridDim.x >= 256;
#pragma unroll
        for (int hb = 0; hb < 2; ++hb) {
            uint4 gq4[4][2];
#pragma unroll
            for (int m4 = 0; m4 < 4; ++m4) { const size_t gm = (size_t)mt * 256 + G_ROW(hb * 4 + m4);
#pragma unroll
                for (int np = 0; np < 2; ++np) gq4[m4][np] = *(const uint4*)(GT + gm * 1024 + nt * 256 + PAIR16_COL(G_COL(2 * np), G_COL(2 * np + 1))); }
#pragma unroll
            for (int m4 = 0; m4 < 4; ++m4) { const int mi = hb * 4 + m4; const size_t gm = (size_t)mt * 256 + G_ROW(mi); float ss = 0.f;
#pragma unroll
                for (int np = 0; np < 2; ++np) { uint2 g2[2]; unpair16(gq4[m4][np], g2[0], g2[1]);
#pragma unroll
                    for (int h = 0; h < 2; ++h) { const int ni = 2 * np + h; const int n = nt * 256 + G_COL(ni); const f32x4 v = acc[mi][ni]; const uint2 gw = g2[h];
                        float4 o = {v[0] * bflo(gw.x), v[1] * bfhi(gw.x), v[2] * bflo(gw.y), v[3] * bfhi(gw.y)};
                        if (!fused) *(float4*)(OUT + gm * 1024 + n) = o;
                        acc[mi][ni] = (f32x4){o.x, o.y, o.z, o.w};
                        ss += o.x * o.x + o.y * o.y + o.z * o.z + o.w * o.w; } }
                ss += __shfl_xor(ss, 16); ss += __shfl_xor(ss, 32);
                if (lane < 16) SSQ3[gm * 16 + nt * 4 + wc] = ss; }
            asm volatile("" ::: "memory");
        }
        if (fused) {
            unsigned* flag = (unsigned*)(a.ws + WS_CTL) + CW_GATEFLAG + mt;
            const float* lnf = a.in[I_LNF]; float4 gg[4];
#pragma unroll
            for (int ni = 0; ni < 4; ++ni) gg[ni] = *(const float4*)(lnf + nt * 256 + G_COL(ni));
            signal_done(flag); wait_flag(flag, 4u);
            float rstd[8];
#pragma unroll
            for (int mi = 0; mi < 8; ++mi) { const size_t gm = (size_t)mt * 256 + G_ROW(mi); const float4 s0 = *(const float4*)(SSQ3 + gm * 16 + 4 * (lane >> 4)); rstd[mi] = (s0.x + s0.y) + (s0.z + s0.w); }
#pragma unroll
            for (int mi = 0; mi < 8; ++mi) { float t_ = rstd[mi]; t_ += __shfl_xor(t_, 16); t_ += __shfl_xor(t_, 32); rstd[mi] = rsqrtf(t_ * (1.f / 1024.f) + EPS); }
#pragma unroll
            for (int mi = 0; mi < 8; ++mi) { const size_t gm = (size_t)mt * 256 + G_ROW(mi);
#pragma unroll
                for (int ni = 0; ni < 4; ++ni) { const int n = nt * 256 + G_COL(ni); const f32x4 v = acc[mi][ni]; const float r_ = rstd[mi];
                    float4 o = {v[0] * r_ * gg[ni].x, v[1] * r_ * gg[ni].y, v[2] * r_ * gg[ni].z, v[3] * r_ * gg[ni].w}; *(float4*)(OUT + gm * 1024 + n) = o; } }
        }
        __syncthreads();
    }
}

DEV void phase_final(const Args& a) {
    if (gridDim.x >= 256) return;
    float* OUT = a.out; const float* SSQ3 = (const float*)(a.ws + WS_SSQ3); const float* g = a.in[I_LNF];
    const int lane = TID() & 63; const int gw = BID() * NWAVE + (TID() >> 6), ngw = gridDim.x * NWAVE;
    for (int m = gw; m < NTOK; m += ngw) {
        float s = 0.f;
#pragma unroll
        for (int j = 0; j < 16; ++j) s += SSQ3[(size_t)m * 16 + j];
        const float rstd = rsqrtf(s * (1.f / 1024.f) + EPS);
#pragma unroll
        for (int j = 0; j < 4; ++j) { float4 v = *(const float4*)(OUT + (size_t)m * 1024 + j * 256 + lane * 4); const float4 gg = *(const float4*)(g + j * 256 + lane * 4);
            v.x *= rstd * gg.x; v.y *= rstd * gg.y; v.z *= rstd * gg.z; v.w *= rstd * gg.w; *(float4*)(OUT + (size_t)m * 1024 + j * 256 + lane * 4) = v; }
    }
}

template <int PH> DEV void run_phase(const Args& a, unsigned char* smem) {
    if constexpr (PH == PH_PRO) phase_prologue(a, smem);
    else if constexpr (PH == PH_INPROJ) phase_inproj(a, smem);
    else if constexpr (PH == PH_ATT) phase_att(a, smem);
    else if constexpr (PH == PH_OUTPROJ) phase_outproj(a, smem);
    else if constexpr (PH == PH_ROUTE) phase_route(a, smem);
    else if constexpr (PH == PH_UP) phase_up(a, smem);
    else if constexpr (PH == PH_DOWN) phase_down(a, smem);
    else if constexpr (PH == PH_COMB) phase_comb(a, smem);
    else if constexpr (PH == PH_GATE) phase_gate(a, smem);
    else if constexpr (PH == PH_FINAL) phase_final(a);
}
#define XB_TMO      128
#define XB_XCNT(j)  (256  + 64 * (j))
#define XB_XSUB(j)  (1280 + 64 * (j))
#define XB_XGEN(j)  (2304 + 64 * (j))
#define XB_TOP      3328
#define XB_TOPGEN   3392
#define XCD_BAR_WORDS 3456
#define XB_SPIN_CAP (1u << 22)
DEV unsigned xb_ld(unsigned* p)              { return __hip_atomic_load(p, __ATOMIC_RELAXED, __HIP_MEMORY_SCOPE_AGENT); }
DEV unsigned xb_add(unsigned* p, unsigned v) { return __hip_atomic_fetch_add(p, v, __ATOMIC_RELAXED, __HIP_MEMORY_SCOPE_AGENT); }
DEV unsigned xb_xcc_id() { return (unsigned)__builtin_amdgcn_s_getreg((3 << 11) | 20) & 0xFu; }
#define XB_SPIN(cond, bar) do { unsigned _sp = 0; while (cond) { __builtin_amdgcn_s_sleep(1); \
    if ((++_sp & 255u) == 0u) { if (xb_ld(&(bar)[XB_TMO])) break; if (_sp > XB_SPIN_CAP) { atomicAdd(&(bar)[XB_TMO], 1u); break; } } } } while (0)
struct XcdBarrier { unsigned* bar; unsigned x; volatile LAS unsigned* st; };
DEV XcdBarrier xcd_barrier_post(unsigned* bar, volatile LAS unsigned* st) {
    XcdBarrier b; b.bar = bar; b.x = xb_xcc_id(); b.st = st;
    if (TID() == 0) (void)xb_add(&bar[XB_XCNT(b.x)], 1u);
    return b;
}
DEV void xcd_barrier_complete(unsigned* bar, unsigned x, unsigned& nloc, unsigned& nx) {
    const unsigned G = gridDim.x * gridDim.y * gridDim.z;
    unsigned sum, cnt, mine, sp = 0u;
    for (;;) {
        sum = 0u; cnt = 0u; mine = 0u;
#pragma unroll
        for (unsigned j = 0; j < 16; ++j) { const unsigned c = xb_ld(&bar[XB_XCNT(j)]); sum += c; cnt += (c > 0u) ? 1u : 0u; mine = (j == x) ? c : mine; }
        if (sum == G) break;
        __builtin_amdgcn_s_sleep(1);
        if ((++sp & 255u) == 0u) { if (xb_ld(&bar[XB_TMO])) break; if (sp > XB_SPIN_CAP) { atomicAdd(&bar[XB_TMO], 1u); break; } }
    }
    nloc = mine > 0u ? mine : 1u; nx = cnt > 0u ? cnt : 1u;
}
DEV void xcd_barrier(const XcdBarrier& b) {
    asm volatile("s_waitcnt vmcnt(0)" ::: "memory");
    __syncthreads();
    if (TID() == 0) {
        unsigned* bar = b.bar;
        __builtin_amdgcn_s_waitcnt(0);
        unsigned nloc = b.st[0], nx = b.st[1];
        if (nloc == 0u) { xcd_barrier_complete(bar, b.x, nloc, nx); b.st[0] = nloc; b.st[1] = nx; }
        const unsigned old = xb_add(&bar[XB_XSUB(b.x)], 1u);
        const unsigned gen = old / nloc;
        if (old + 1u == (gen + 1u) * nloc) {
            __builtin_amdgcn_fence(__ATOMIC_RELEASE, "agent");
            asm volatile("s_waitcnt vmcnt(0)" ::: "memory");
            const unsigned og = xb_add(&bar[XB_TOP], 1u);
            const unsigned tg = og / nx;
            if (og + 1u == (tg + 1u) * nx) xb_add(&bar[XB_TOPGEN], 1u);
            else XB_SPIN(xb_ld(&bar[XB_TOPGEN]) == tg, bar);
            __builtin_amdgcn_fence(__ATOMIC_ACQUIRE, "agent");
            xb_add(&bar[XB_XGEN(b.x)], 1u);
            asm volatile("s_waitcnt vmcnt(0)" ::: "memory");
        } else {
            XB_SPIN(xb_ld(&bar[XB_XGEN(b.x)]) == gen, bar);
            __builtin_amdgcn_fence(__ATOMIC_ACQUIRE, "agent");
            asm volatile("s_waitcnt vmcnt(0)" ::: "memory");
        }
    }
    __syncthreads();
}

__global__ void __launch_bounds__(NTHR, 2) mega(Args a) {
    extern __shared__ __attribute__((aligned(16))) unsigned char smem[];
    volatile LAS unsigned* bst = (volatile LAS unsigned*)(LAS unsigned char*)(smem + MISC_OFF + 8000);
    if (TID() == 0) { bst[0] = 0u; bst[1] = 0u; }
    __syncthreads();
    const XcdBarrier bar = xcd_barrier_post((unsigned*)(a.ws + WS_CTL) + 4096, bst);
#define GSYNC() xcd_barrier(bar)
#define RUN(ph) do { run_phase<ph>(a, smem); if ((PROBE_DUP >> ph) & 1) { GSYNC(); run_phase<ph>(a, smem); } } while (0)
    RUN(PH_PRO); GSYNC();
    RUN(PH_INPROJ); GSYNC();
    RUN(PH_ATT); GSYNC();
    RUN(PH_OUTPROJ); GSYNC();
    RUN(PH_ROUTE); GSYNC();
    RUN(PH_UP); GSYNC();
    RUN(PH_DOWN); GSYNC();
    RUN(PH_COMB); GSYNC();
    RUN(PH_GATE);
    if (gridDim.x < 256) { GSYNC(); RUN(PH_FINAL); }
#undef RUN
#undef GSYNC
}

extern "C" void kernel_launch(void* const* d_in, const int* in_sizes, int n_in, void* d_out, int out_size, void* d_ws, size_t ws_size, hipStream_t stream) {
    static int grid = 0;
    if (grid == 0) {
        if (n_in != 25 || ws_size < WS_END) { fprintf(stderr, "kernel_launch: unexpected n_in %d / ws %zu\n", n_in, ws_size); grid = -1; return; }
        int dev = 0, cus = 0, per_cu = 0;
        (void)hipGetDevice(&dev); (void)hipDeviceGetAttribute(&cus, hipDeviceAttributeMultiprocessorCount, dev);
        (void)hipFuncSetAttribute((const void*)mega, hipFuncAttributeMaxDynamicSharedMemorySize, LDS_BYTES);
        (void)hipOccupancyMaxActiveBlocksPerMultiprocessor(&per_cu, (const void*)mega, NTHR, LDS_BYTES);
        if (per_cu < 1) { fprintf(stderr, "kernel_launch: occupancy query says %d blocks per CU\n", per_cu); grid = -1; return; }
        grid = cus;
    }
    if (grid < 0) return;
    (void)hipMemsetAsync((char*)d_ws + WS_CTL, 0, 65536, stream);
    Args a{};
    for (int i = 0; i < 25; ++i) a.in[i] = (const float*)d_in[i];
    a.out = (float*)d_out; a.ws = (unsigned char*)d_ws; a.ph_lo = 0; a.ph_hi = PH_N;
    void* args[] = {&a};
    hipError_t e = hipLaunchCooperativeKernel((const void*)mega, dim3(grid), dim3(NTHR), args, LDS_BYTES, stream);
    if (e != hipSuccess) fprintf(stderr, "cooperative launch failed: %s (grid %d)\n", hipGetErrorString(e), grid);
}
```

```cpp
#include <hip/hip_runtime.h>
#include <stdint.h>
#include <cstdio>

#define DEV __device__ __forceinline__
#define LAS __attribute__((address_space(3)))

typedef unsigned short bf16_t;
typedef short bf16x8 __attribute__((ext_vector_type(8)));
typedef short s16x4 __attribute__((ext_vector_type(4)));
typedef float f32x4 __attribute__((ext_vector_type(4)));
typedef float f32x16 __attribute__((ext_vector_type(16)));
typedef float f32x2_t __attribute__((ext_vector_type(2)));
typedef __bf16 bf16x2_t __attribute__((ext_vector_type(2)));

constexpr int NTHR = 512, NWAVE = 8;
constexpr int NTOK = 16384;
constexpr float EPS = 1e-6f;
constexpr float LOG2E = 1.4426950408889634f;
constexpr float QS = 0.125f * LOG2E;
constexpr int NWIN = 3072;

constexpr size_t MiB = 1u << 20;
constexpr size_t WS_CTL = 0;
constexpr size_t WS_WIN = 1 * MiB;
constexpr size_t WS_WOUT = 7 * MiB;
constexpr size_t WS_WGATE = 9 * MiB;
constexpr size_t WS_WPLE = 11 * MiB;
constexpr size_t WS_WC1 = 12 * MiB;
constexpr size_t WS_WC2 = 15 * MiB + 512 * 1024 + 262144;
constexpr size_t WS_BIAS1 = 15 * MiB + 512 * 1024 + 262144 + 131072;
constexpr size_t WS_KC = 14 * MiB;
constexpr size_t WS_HID = 14 * MiB + 512 * 1024;
constexpr size_t WS_GN = 16 * MiB;
constexpr size_t WS_LS = 18 * MiB;
constexpr size_t WS_CUM = 19 * MiB;
constexpr size_t WS_SSQ = 20 * MiB;
constexpr size_t WS_TOPI = 21 * MiB;
constexpr size_t WS_TOPS = 21 * MiB + 262144;
constexpr size_t WS_TOPW = 21 * MiB + 524288;
constexpr size_t WS_TOKOF = 22 * MiB;
constexpr size_t WS_ROWW = 24 * MiB;
constexpr size_t WS_SSQ3 = 26 * MiB;
constexpr size_t WS_RSTD2 = 27 * MiB;
constexpr size_t WS_PB = 28 * MiB;
constexpr size_t WS_XN = 36 * MiB;
constexpr size_t WS_PROJ = 68 * MiB;
constexpr size_t WS_ONSA = 160 * MiB;
constexpr size_t WS_OFOX = 176 * MiB;
constexpr size_t WS_H1 = 192 * MiB;
constexpr size_t WS_WUP = 256 * MiB;
constexpr size_t WS_WDN = 384 * MiB;
constexpr size_t WS_ACT = 448 * MiB;
constexpr size_t WS_Y = 592 * MiB;
constexpr size_t WS_RSDS = 736 * MiB;
constexpr size_t WS_END = 738 * MiB;

enum { PH_PRO = 0, PH_INPROJ, PH_CMP, PH_ATT, PH_OUTPROJ, PH_ROUTE, PH_UP, PH_DOWN, PH_COMB, PH_GATE, PH_FINAL, PH_N };
struct Args { const float* in[25]; float* out; unsigned char* ws; int ph_lo, ph_hi; };
enum { I_X = 0, I_P, I_LN1, I_WIN, I_BFG, I_WC1K, I_WC2K, I_PEK, I_WC1V, I_WC2V, I_PEV, I_GNN, I_GNF, I_WOUT, I_LN2, I_WR, I_BR,
       I_WUP, I_BUP, I_WDN, I_BDN, I_LNPLE, I_WPLE, I_WGATE, I_LNF };

DEV int BID() { int b = (int)blockIdx.x; asm volatile("" : "+s"(b)); return b; }
DEV int VBID() { const int g = (int)gridDim.x, b = BID(); return (g & 7) ? b : (b & 7) * (g >> 3) + (b >> 3); }
DEV int TID() { int t = (int)__builtin_amdgcn_workitem_id_x(); asm volatile("" : "+v"(t)); return t; }
DEV unsigned cvtpk(float lo, float hi) { f32x2_t v = {lo, hi}; bf16x2_t b = __builtin_convertvector(v, bf16x2_t); return __builtin_bit_cast(unsigned, b); }
DEV float bflo(unsigned u) { return __uint_as_float(u << 16); }
DEV float bfhi(unsigned u) { return __uint_as_float(u & 0xffff0000u); }
DEV float wave_sum(float v) {
#pragma unroll
    for (int o = 1; o < 64; o <<= 1) v += __shfl_xor(v, o);
    return v;
}
#define DPP_MOV(x, ctrl) __builtin_bit_cast(float, __builtin_amdgcn_update_dpp(0, __builtin_bit_cast(int, (x)), (ctrl), 0xF, 0xF, true))
DEV float pair_sum(float x) { return x + __shfl_xor(x, 32); }
DEV float pair_max(float x) { return fmaxf(x, __shfl_xor(x, 32)); }
DEV float quad_sum(float x) { x += DPP_MOV(x, 0xB1); x += DPP_MOV(x, 0x4E); return x; }
DEV float wave_max_u(float x) {
    x = fmaxf(x, DPP_MOV(x, 0xB1)); x = fmaxf(x, DPP_MOV(x, 0x4E)); x = fmaxf(x, DPP_MOV(x, 0x141)); x = fmaxf(x, DPP_MOV(x, 0x140));
    const float a = __builtin_bit_cast(float, __builtin_amdgcn_readlane(__builtin_bit_cast(int, x), 0)), b = __builtin_bit_cast(float, __builtin_amdgcn_readlane(__builtin_bit_cast(int, x), 16));
    const float c = __builtin_bit_cast(float, __builtin_amdgcn_readlane(__builtin_bit_cast(int, x), 32)), d = __builtin_bit_cast(float, __builtin_amdgcn_readlane(__builtin_bit_cast(int, x), 48));
    return fmaxf(fmaxf(a, b), fmaxf(c, d));
}
DEV float sigmoidf_(float x) { return __builtin_amdgcn_rcpf(1.0f + __expf(-x)); }
DEV float logsigmoidf_(float x) { return fminf(x, 0.f) - log1pf(__expf(-fabsf(x))); }
DEV float gelu_tanh(float x) { const float u = 0.7978845608028654f * (x + 0.044715f * x * x * x); const float th = 1.0f - 2.0f * __builtin_amdgcn_rcpf(__expf(2.0f * u) + 1.0f); return 0.5f * x * (1.0f + th); }
DEV s16x4 tr_read(const unsigned char* p) {
    typedef short v4i16_t __attribute__((ext_vector_type(4)));
    return __builtin_bit_cast(s16x4, __builtin_amdgcn_ds_read_tr16_b64_v4i16((LAS v4i16_t*)p));
}
DEV s16x4 tr_read_l(unsigned lds_addr) {
    typedef short v4i16_t __attribute__((ext_vector_type(4)));
    return __builtin_bit_cast(s16x4, __builtin_amdgcn_ds_read_tr16_b64_v4i16((LAS v4i16_t*)(uintptr_t)lds_addr));
}
DEV int crow(int r, int hi) { return (r & 3) + 8 * (r >> 2) + 4 * hi; }

constexpr int GL_STAGE = 65536;
constexpr int GEMM_LDS = 2 * GL_STAGE;
constexpr int MISC_OFF = GEMM_LDS;
constexpr int LDS_BYTES = GEMM_LDS + 8192 + 12288;

DEV void glds16s(const void* sbase, unsigned voff, unsigned lds_dst) { unsigned keep;
    asm volatile("s_mov_b32 %0, m0\n\ts_mov_b32 m0, %3\n\ts_nop 0\n\tglobal_load_lds_dwordx4 %1, %2\n\ts_mov_b32 m0, %0" : "=&s"(keep) : "v"(voff), "s"(sbase), "s"(lds_dst) : "memory"); }

DEV const unsigned char* uptr(const void* p) { const unsigned long long v = (unsigned long long)p; const unsigned lo = __builtin_amdgcn_readfirstlane((unsigned)v), hi = __builtin_amdgcn_readfirstlane((unsigned)(v >> 32)); return (const unsigned char*)(((unsigned long long)hi << 32) | lo); }

DEV void lds_barrier() { asm volatile("s_waitcnt lgkmcnt(0)\n\ts_barrier" ::: "memory"); }

struct NoNextS { DEV void operator()() const {} };
template <class AO, class BO>
DEV void gemm256s_issue0(unsigned char* smem, const void* abase, const AO& aoff, const void* bbase, const BO& boff) {
    const int tid = TID(), lane = tid & 63; const int wid = __builtin_amdgcn_readfirstlane(tid >> 6);
    const unsigned lds0 = (unsigned)(uintptr_t)smem; const unsigned char* ab_ = uptr(abase); const unsigned char* bb_ = uptr(bbase);
#pragma unroll
    for (int i = 0; i < 4; ++i) { const int p = wid + 8 * i; glds16s(ab_, aoff(8 * p + (lane >> 3), (lane & 7) ^ (lane >> 3)), (unsigned)__builtin_amdgcn_readfirstlane(lds0 + p * 1024)); }
#pragma unroll
    for (int i = 0; i < 4; ++i) { const int p = wid + 8 * i; const int k = 2 * p + (lane >> 5); const int f = (k & 3) + 4 * ((k >> 3) & 1);
        glds16s(bb_, boff(k, (lane & 31) ^ (f << 1)), (unsigned)__builtin_amdgcn_readfirstlane(lds0 + 32768 + p * 1024)); }
}
template <bool ZERO, class AO, class BO, class NX = NoNextS>
DEV void gemm256s(unsigned char* smem, int nkt, const void* abase, unsigned akstep, const AO& aoff, const void* bbase, unsigned bkstep, const BO& boff, f32x4 (&acc)[8][4], bool pre = false, const NX& next = NX()) {
    const int tid = TID(), lane = tid & 63; const int wid = __builtin_amdgcn_readfirstlane(tid >> 6); const int wr = wid >> 2, wc = wid & 3;
    if (ZERO) {
#pragma unroll
        for (int mi = 0; mi < 8; ++mi)
#pragma unroll
            for (int ni = 0; ni < 4; ++ni) acc[mi][ni] = (f32x4){0.f, 0.f, 0.f, 0.f};
    }
    const unsigned lds0 = (unsigned)(uintptr_t)smem;
    const unsigned char* abase_u = uptr(abase); const unsigned char* bbase_u = uptr(bbase); const unsigned akstep_u = __builtin_amdgcn_readfirstlane(akstep), bkstep_u = __builtin_amdgcn_readfirstlane(bkstep);
    unsigned ao[4], bo[4];
#pragma unroll
    for (int i = 0; i < 4; ++i) { const int p = wid + 8 * i; ao[i] = aoff(8 * p + (lane >> 3), (lane & 7) ^ (lane >> 3));
        const int k = 2 * p + (lane >> 5); const int f = (k & 3) + 4 * ((k >> 3) & 1); bo[i] = boff(k, (lane & 31) ^ (f << 1)); }
#define GL_ISSUE(kt, st) do { const unsigned char* ab_ = abase_u + (size_t)(kt) * akstep_u; const unsigned char* bb_ = bbase_u + (size_t)(kt) * bkstep_u; \
        _Pragma("unroll") for (int i_ = 0; i_ < 4; ++i_) glds16s(ab_, ao[i_], (unsigned)__builtin_amdgcn_readfirstlane(lds0 + (st) * GL_STAGE + (wid + 8 * i_) * 1024)); \
        _Pragma("unroll") for (int i_ = 0; i_ < 4; ++i_) glds16s(bb_, bo[i_], (unsigned)__builtin_amdgcn_readfirstlane(lds0 + (st) * GL_STAGE + 32768 + (wid + 8 * i_) * 1024)); } while (0)
    if (!pre) {
        GL_ISSUE(0, 0);
        asm volatile("s_waitcnt vmcnt(0)" ::: "memory");
        __syncthreads();
    }
    for (int kt = 0; kt < nkt; ++kt) {
        if (kt + 1 < nkt) GL_ISSUE(kt + 1, (kt + 1) & 1); else next();
        const unsigned char* A = smem + (kt & 1) * GL_STAGE; const unsigned char* Bt = A + 32768;
#pragma unroll
        for (int ks = 0; ks < 2; ++ks) {
            bf16x8 wf[4];
#pragma unroll
            for (int ni = 0; ni < 4; ++ni) {
                const int i = lane & 15, g = lane >> 4, q = i >> 2; const int row = ks * 32 + 8 * g + q; const int nc = wc * 8 + ni * 2 + ((i & 3) >> 1); const int f = q + 4 * (g & 1);
                const unsigned char* p = Bt + row * 512 + ((nc ^ (f << 1)) << 4) + (i & 1) * 8;
                const s16x4 lo = tr_read(p), hi = tr_read(p + 4 * 512);
                wf[ni] = (bf16x8){lo[0], lo[1], lo[2], lo[3], hi[0], hi[1], hi[2], hi[3]};
            }
#pragma unroll
            for (int mi = 0; mi < 8; ++mi) {
                const int m = wr * 128 + mi * 16 + (lane & 15); const int kc = ks * 4 + (lane >> 4);
                const bf16x8 af = *(const bf16x8*)(A + m * 128 + ((kc ^ (m & 7)) << 4));
#pragma unroll
                for (int ni = 0; ni < 4; ++ni) acc[mi][ni] = __builtin_amdgcn_mfma_f32_16x16x32_bf16(wf[ni], af, acc[mi][ni], 0, 0, 0);
            }
        }
        asm volatile("s_waitcnt vmcnt(0)" ::: "memory");
        __syncthreads();
    }
#undef GL_ISSUE
}

#define G_ROW(mi) ((((mi) >> 2) * 128) + wr * 64 + (((mi) & 3) * 16) + (lane & 15))
#define G_COL(ni) ((((ni) >> 1) * 128) + wc * 32 + (((ni) & 1) * 16) + 4 * (lane >> 4))
#define WAIT_V(n) asm volatile("s_waitcnt vmcnt(" #n ")" ::: "memory")
#define WAIT_L(n) asm volatile("s_waitcnt lgkmcnt(" #n ")" ::: "memory")
#define BAR() __builtin_amdgcn_s_barrier()
#define SCHED() __builtin_amdgcn_sched_barrier(0)
constexpr int SA_(int b, int h) { return b * GL_STAGE + h * 16384; }
constexpr int SB_(int b, int h) { return b * GL_STAGE + 32768 + h * 16384; }
struct NoNext { DEV bool has() const { return false; } template <int P> DEV void issue() const {} };
template <int WHICH, class AO, class BO>
DEV void gemm_issue0(unsigned char* smem, const void* abase, const AO& aoff, const void* bbase, const BO& boff) {
    const int tid = TID(), lane = tid & 63; const int wid = __builtin_amdgcn_readfirstlane(tid >> 6);
    const unsigned lds0 = (unsigned)(uintptr_t)smem; const unsigned char* ab_ = uptr(abase); const unsigned char* bb_ = uptr(bbase);
#pragma unroll
    for (int h = 0; h < 2; ++h) {
        if (WHICH & (1 << (2 * h))) {
#pragma unroll
            for (int i = 0; i < 2; ++i) { const int p = wid + 8 * i; const int k = 4 * p + (lane >> 4); const int f = (k & 3) + 4 * ((k >> 3) & 1);
                glds16s(bb_, boff(k, h * 16 + ((lane & 15) ^ (f << 1))), (unsigned)__builtin_amdgcn_readfirstlane(lds0 + SB_(0, h) + p * 1024)); } }
        if (WHICH & (2 << (2 * h))) {
#pragma unroll
            for (int i = 0; i < 2; ++i) { const int p = wid + 8 * i;
                glds16s(ab_, aoff(h * 128 + 8 * p + (lane >> 3), (lane & 7) ^ (lane >> 3)), (unsigned)__builtin_amdgcn_readfirstlane(lds0 + SA_(0, h) + p * 1024)); } }
    }
}
template <class AO, class BO>
struct NextTile { bool on; unsigned char* smem; const void* abase; AO aoff; const void* bbase; BO boff;
    DEV bool has() const { return on; }
    template <int P> DEV void issue() const { gemm_issue0<P>(smem, abase, aoff, bbase, boff); } };
template <class AO, class BO> DEV NextTile<AO, BO> next_tile(bool on, unsigned char* smem, const void* abase, const AO& aoff, const void* bbase, const BO& boff) { return NextTile<AO, BO>{on, smem, abase, aoff, bbase, boff}; }
template <bool ZERO, class AO, class BO, class NX = NoNext>
DEV void gemm256(unsigned char* smem, int nkt, const void* abase, unsigned akstep, const AO& aoff, const void* bbase, unsigned bkstep, const BO& boff, f32x4 (&acc)[8][4], bool pre = false, const NX& next = NX()) {
    const int tid = TID(), lane = tid & 63; const int wid = __builtin_amdgcn_readfirstlane(tid >> 6); const int wr = wid >> 2, wc = wid & 3;
    if (ZERO) {
#pragma unroll
        for (int mi = 0; mi < 8; ++mi)
#pragma unroll
            for (int ni = 0; ni < 4; ++ni) acc[mi][ni] = (f32x4){0.f, 0.f, 0.f, 0.f};
    }
    const unsigned lds0 = (unsigned)(uintptr_t)smem;
    const unsigned char* abase_u = uptr(abase); const unsigned char* bbase_u = uptr(bbase); const unsigned akstep_u = __builtin_amdgcn_readfirstlane(akstep), bkstep_u = __builtin_amdgcn_readfirstlane(bkstep);
    unsigned ao[4], bo[4];
#pragma unroll
    for (int h = 0; h < 2; ++h)
#pragma unroll
        for (int i = 0; i < 2; ++i) { const int p = wid + 8 * i; ao[h * 2 + i] = aoff(h * 128 + 8 * p + (lane >> 3), (lane & 7) ^ (lane >> 3));
            const int k = 4 * p + (lane >> 4); const int f = (k & 3) + 4 * ((k >> 3) & 1); bo[h * 2 + i] = boff(k, h * 16 + ((lane & 15) ^ (f << 1))); }
    unsigned ard0[2], ard1[2], brd0[2], brd1[2];
    { const int l15 = lane & 15, g = lane >> 4, q = l15 >> 2; const int f = q + 4 * (g & 1);
      ard0[0] = lds0 + (wr * 64 + l15) * 128 + ((g ^ (lane & 7)) << 4); ard1[0] = lds0 + (wr * 64 + l15) * 128 + (((4 + g) ^ (lane & 7)) << 4);
      const int nc = wc * 4 + ((l15 & 3) >> 1); const int kr = 8 * g + q;
      brd0[0] = lds0 + kr * 256 + ((nc ^ (f << 1)) << 4) + (l15 & 1) * 8; brd1[0] = lds0 + kr * 256 + (((nc + 2) ^ (f << 1)) << 4) + (l15 & 1) * 8;
      ard0[1] = ard0[0] + GL_STAGE; ard1[1] = ard1[0] + GL_STAGE; brd0[1] = brd0[0] + GL_STAGE; brd1[1] = brd1[0] + GL_STAGE;
      asm volatile("" : "+v"(ard0[1]), "+v"(ard1[1]), "+v"(brd0[1]), "+v"(brd1[1])); }
#define ST_A(b, h, kt) do { const unsigned char* ab_ = abase_u + (size_t)(kt) * akstep_u; \
        _Pragma("unroll") for (int i_ = 0; i_ < 2; ++i_) glds16s(ab_, ao[(h) * 2 + i_], (unsigned)__builtin_amdgcn_readfirstlane(lds0 + SA_(b, h) + (wid + 8 * i_) * 1024)); } while (0)
#define ST_B(b, h, kt) do { const unsigned char* bb_ = bbase_u + (size_t)(kt) * bkstep_u; \
        _Pragma("unroll") for (int i_ = 0; i_ < 2; ++i_) glds16s(bb_, bo[(h) * 2 + i_], (unsigned)__builtin_amdgcn_readfirstlane(lds0 + SB_(b, h) + (wid + 8 * i_) * 1024)); } while (0)
#define LDSP(T, a_) ((LAS const T*)(uintptr_t)(a_))
#define LDA(dst, b, h) do { _Pragma("unroll") for (int m_ = 0; m_ < 4; ++m_) { dst[m_][0] = *LDSP(bf16x8, ard0[b] + SA_(0, h) + m_ * 2048); dst[m_][1] = *LDSP(bf16x8, ard1[b] + SA_(0, h) + m_ * 2048); } } while (0)
#define LDB(dst, b, h) do { _Pragma("unroll") for (int n_ = 0; n_ < 2; ++n_) _Pragma("unroll") for (int k_ = 0; k_ < 2; ++k_) { const unsigned p_ = (n_ ? brd1[b] : brd0[b]) + SB_(0, h) + k_ * 8192; \
        const s16x4 lo_ = tr_read_l(p_), hi_ = tr_read_l(p_ + 1024); dst[n_][k_] = (bf16x8){lo_[0], lo_[1], lo_[2], lo_[3], hi_[0], hi_[1], hi_[2], hi_[3]}; } } while (0)
#define MMA(ai, bj, Bx) do { __builtin_amdgcn_s_setprio(1); \
        _Pragma("unroll") for (int k_ = 0; k_ < 2; ++k_) _Pragma("unroll") for (int m_ = 0; m_ < 4; ++m_) _Pragma("unroll") for (int n_ = 0; n_ < 2; ++n_) \
            acc[(ai) * 4 + m_][(bj) * 2 + n_] = __builtin_amdgcn_mfma_f32_16x16x32_bf16(Bx[n_][k_], At[m_][k_], acc[(ai) * 4 + m_][(bj) * 2 + n_], 0, 0, 0); \
        __builtin_amdgcn_s_setprio(0); } while (0)
    bf16x8 At[4][2], B0[2][2], B1[2][2];
    if (!pre) { ST_B(0, 0, 0); ST_A(0, 0, 0); ST_B(0, 1, 0); ST_A(0, 1, 0); }
    if (wr == 1) BAR();
    if (!pre) WAIT_V(4);
    BAR();
    ST_B(1, 0, 1); ST_A(1, 0, 1); ST_B(1, 1, 1);
    if (!pre) WAIT_V(6);
    BAR();
    for (int t = 0; t < nkt - 2; t += 2) {
        LDB(B0, 0, 0); SCHED(); LDA(At, 0, 0); ST_A(1, 1, t + 1);
        WAIT_L(8); BAR(); WAIT_L(0); MMA(0, 0, B0); BAR(); SCHED();
        LDB(B1, 0, 1); ST_B(0, 0, t + 2);
        BAR(); WAIT_L(0); MMA(0, 1, B1); BAR();
        LDA(At, 0, 1); ST_A(0, 0, t + 2);
        BAR(); WAIT_L(0); MMA(1, 0, B0); BAR(); SCHED();
        ST_B(0, 1, t + 2);
        WAIT_V(6); BAR(); MMA(1, 1, B1); BAR();
        LDB(B0, 1, 0); SCHED(); LDA(At, 1, 0); ST_A(0, 1, t + 2);
        WAIT_L(8); BAR(); WAIT_L(0); MMA(0, 0, B0); BAR(); SCHED();
        LDB(B1, 1, 1); ST_B(1, 0, t + 3);
        BAR(); WAIT_L(0); MMA(0, 1, B1); BAR();
        LDA(At, 1, 1); ST_A(1, 0, t + 3);
        BAR(); WAIT_L(0); MMA(1, 0, B0); BAR(); SCHED();
        ST_B(1, 1, t + 3);
        WAIT_V(6); BAR(); MMA(1, 1, B1); BAR();
    }
    const bool hn = next.has();
    LDB(B0, 0, 0); LDA(At, 0, 0); ST_A(1, 1, nkt - 1);
    BAR(); WAIT_L(0); MMA(0, 0, B0); BAR();
    LDB(B1, 0, 1); BAR(); WAIT_L(0); MMA(0, 1, B1); BAR();
    LDA(At, 0, 1);
    if (hn) { next.template issue<3>(); WAIT_V(8); } else WAIT_V(4);
    BAR(); WAIT_L(0); MMA(1, 0, B0); MMA(1, 1, B1); BAR();
    LDB(B0, 1, 0); LDA(At, 1, 0);
    if (hn) { next.template issue<4>(); WAIT_V(8); } else WAIT_V(2);
    BAR(); WAIT_L(0); MMA(0, 0, B0); BAR();
    LDB(B1, 1, 1);
    if (hn) { next.template issue<8>(); WAIT_V(8); } else WAIT_V(0);
    BAR(); WAIT_L(0); MMA(0, 1, B1); BAR();
    LDA(At, 1, 1); BAR(); WAIT_L(0); MMA(1, 0, B0); MMA(1, 1, B1);
    WAIT_V(0);
    BAR();
    if (wr == 0) BAR();
#undef ST_A
#undef ST_B
#undef LDA
#undef LDB
#undef LDSP
#undef MMA
}

DEV uint4 pair16(uint2 a, uint2 b) {
    const auto r0 = __builtin_amdgcn_permlane16_swap(a.x, b.x, false, false); const auto r1 = __builtin_amdgcn_permlane16_swap(a.y, b.y, false, false);
    uint4 o; o.x = r0[0]; o.y = r1[0]; o.z = r0[1]; o.w = r1[1]; return o;
}
DEV void unpair16(uint4 q, uint2& a, uint2& b) {
    const auto r0 = __builtin_amdgcn_permlane16_swap(q.x, q.z, false, false); const auto r1 = __builtin_amdgcn_permlane16_swap(q.y, q.w, false, false);
    a.x = r0[0]; a.y = r1[0]; b.x = r0[1]; b.y = r1[1];
}
#define PAIR16_COL(c0, c1) ((((lane) >> 4) & 1) ? (c1) - 4 : (c0))
#define EPI_IDS() do { const int etid_ = TID(); lane = etid_ & 63; wid = etid_ >> 6; wr = wid >> 2; wc = wid & 3; } while (0)

DEV void patch_decode(int local, int MT, int NT, int& mt, int& nt) {
    const int per_mtb = 8 * NT; const int mtb = local / per_mtb; const int rem = local - mtb * per_mtb;
    const int rows = (MT - 8 * mtb) < 8 ? (MT - 8 * mtb) : 8;
    const int per_ntb = rows * 8; const int nfull = NT >> 3; int ntb = rem / per_ntb; int cols = 8;
    if (ntb >= nfull) { ntb = nfull; cols = NT - 8 * nfull; }
    const int r2 = rem - ntb * per_ntb;
    mt = 8 * mtb + r2 / cols; nt = 8 * ntb + r2 % cols;
}

DEV void convert_chunk(const float* src, bf16_t* dst, size_t i8) {
    const float4 a = *(const float4*)(src + i8 * 8), b = *(const float4*)(src + i8 * 8 + 4);
    uint4 o; o.x = cvtpk(a.x, a.y); o.y = cvtpk(a.z, a.w); o.z = cvtpk(b.x, b.y); o.w = cvtpk(b.z, b.w);
    *(uint4*)(dst + i8 * 8) = o;
}
DEV void phase_prologue(const Args& a, unsigned char* smem) {
    unsigned char* ws = a.ws;
    const size_t gtid = (size_t)BID() * NTHR + TID(), gn = (size_t)gridDim.x * NTHR;
    {
        { const float* W = a.in[I_WOUT]; bf16_t* O = (bf16_t*)(ws + WS_WOUT); const float* gnn = a.in[I_GNN]; const float* gnf = a.in[I_GNF];
          for (size_t i = gtid; i < (size_t)1024 * 128; i += gn) { const int k = (int)(i >> 7); const float g_ = k < 512 ? gnn[k] : gnf[k - 512];
              const float4 x = *(const float4*)(W + i * 8), y = *(const float4*)(W + i * 8 + 4);
              uint4 o; o.x = cvtpk(x.x * g_, x.y * g_); o.y = cvtpk(x.z * g_, x.w * g_); o.z = cvtpk(y.x * g_, y.y * g_); o.w = cvtpk(y.z * g_, y.w * g_); *(uint4*)(O + i * 8) = o; } }
        const float* srcs[3] = {a.in[I_WGATE], a.in[I_WPLE], a.in[I_P]};
        bf16_t* dsts[3] = {(bf16_t*)(ws + WS_WGATE), (bf16_t*)(ws + WS_WPLE), (bf16_t*)(ws + WS_PB)};
        const size_t cnt8[3] = {1024 * 1024 / 8, 256 * 1024 / 8, (size_t)NTOK * 256 / 8};
#pragma unroll
        for (int s = 0; s < 3; ++s) for (size_t i = gtid; i < cnt8[s]; i += gn) convert_chunk(srcs[s], dsts[s], i);
        for (size_t i = gtid; i < (size_t)2 * 2048 * 32; i += gn) { const int which = (int)(i / (2048 * 32)); const int k = (int)(i / 32) % 2048, c8 = (int)(i % 32) * 8;
            uint4 o = {0u, 0u, 0u, 0u};
            if (c8 < 128) { const float* W = a.in[which ? I_WC1V : I_WC1K] + (size_t)k * 128 + c8; const float4 x = *(const float4*)W, y = *(const float4*)(W + 4); o.x = cvtpk(x.x, x.y); o.y = cvtpk(x.z, x.w); o.z = cvtpk(y.x, y.y); o.w = cvtpk(y.z, y.w); }
            *(uint4*)((bf16_t*)(ws + WS_WC1) + i * 8) = o; }
        for (size_t i = gtid; i < (size_t)2 * 128 * 32; i += gn) { const int which = (int)(i / (128 * 32)); const int k = (int)(i / 32) % 128, c8 = (int)(i % 32) * 8;
            uint4 o = {0u, 0u, 0u, 0u};
            if (c8 < 64) { const float* W = a.in[which ? I_WC2V : I_WC2K] + (size_t)k * 64 + c8; const float4 x = *(const float4*)W, y = *(const float4*)(W + 4); o.x = cvtpk(x.x, x.y); o.y = cvtpk(x.z, x.w); o.z = cvtpk(y.x, y.y); o.w = cvtpk(y.z, y.w); }
            *(uint4*)((bf16_t*)(ws + WS_WC2) + i * 8) = o; }
    }
    {
        const float* W = a.in[I_WIN]; bf16_t* O = (bf16_t*)(ws + WS_WIN);
        for (size_t i = gtid; i < (size_t)1024 * (NWIN / 8); i += gn) {
            const int k = (int)(i / (NWIN / 8)), j = (int)(i % (NWIN / 8)) * 8;
            uint4 o = {0u, 0u, 0u, 0u};
            if (j < 2848) {
                const int sj = (j < 1280) ? j : (j < 2816) ? j + 24 : (j < 2840) ? j - 1536 : j;
                const float4 x = *(const float4*)(W + (size_t)k * 2848 + sj), y = *(const float4*)(W + (size_t)k * 2848 + sj + 4);
                o.x = cvtpk(x.x, x.y); o.y = cvtpk(x.z, x.w); o.z = cvtpk(y.x, y.y); o.w = cvtpk(y.z, y.w);
            }
            *(uint4*)(O + (size_t)k * NWIN + j) = o;
        }
    }
    const int lane = TID() & 63; const int gw = BID() * NWAVE + (TID() >> 6), ngw = gridDim.x * NWAVE;
    {
        const float* X = a.in[I_X]; const float* g = a.in[I_LN1]; bf16_t* XN = (bf16_t*)(ws + WS_XN);
        for (int m = gw; m < NTOK; m += ngw) {
            float4 v[4]; float s = 0.f;
#pragma unroll
            for (int j = 0; j < 4; ++j) { v[j] = *(const float4*)(X + (size_t)m * 1024 + j * 256 + lane * 4); s += v[j].x * v[j].x + v[j].y * v[j].y + v[j].z * v[j].z + v[j].w * v[j].w; }
            const float rstd = rsqrtf(wave_sum(s) * (1.f / 1024.f) + EPS);
#pragma unroll
            for (int j = 0; j < 4; ++j) { const float4 gg = *(const float4*)(g + j * 256 + lane * 4);
                uint2 o; o.x = cvtpk(v[j].x * rstd * gg.x, v[j].y * rstd * gg.y); o.y = cvtpk(v[j].z * rstd * gg.z, v[j].w * rstd * gg.w);
                *(uint2*)(XN + (size_t)m * 1024 + j * 256 + lane * 4) = o; }
        }
    }
    if (gw < 256) {
        const int which = gw >> 7, n = gw & 127; const float* pe = a.in[which ? I_PEV : I_PEK]; const float* w1 = a.in[which ? I_WC1V : I_WC1K];
        float s = 0.f;
#pragma unroll 8
        for (int i = 0; i < 32; ++i) { const int k = lane + 64 * i; s += pe[k] * w1[(size_t)k * 128 + n]; }
        s = wave_sum(s);
        if (lane == 0) ((float*)(ws + WS_BIAS1))[which * 128 + n] = s;
    }
}

DEV void phase_inproj(const Args& a, unsigned char* smem) {
    const bf16_t* XN = (const bf16_t*)(a.ws + WS_XN); const bf16_t* W = (const bf16_t*)(a.ws + WS_WIN);
    bf16_t* PROJ = (bf16_t*)(a.ws + WS_PROJ); float* GN = (float*)(a.ws + WS_GN); float* LS = (float*)(a.ws + WS_LS); const float* bfg = a.in[I_BFG];
    int lane = TID() & 63, wid = TID() >> 6, wr = wid >> 2, wc = wid & 3; (void)wr; (void)wc; (void)lane;
    bool pre = false;
    for (int item = VBID(); item < 64 * 12; item += gridDim.x) {
        int mt, nt; patch_decode(item, 64, 12, mt, nt);
        const int nitem = item + (int)gridDim.x; const bool has_next = nitem < 64 * 12; int mtn = 0, ntn = 0; if (has_next) patch_decode(nitem, 64, 12, mtn, ntn);
        f32x4 acc[8][4];
        auto aoffi = [](int r, int kc) { return (unsigned)(r * 2048 + kc * 16); }; auto boffi = [](int k, int nc) { return (unsigned)(k * (NWIN * 2) + nc * 16); };
        gemm256<true>(smem, 16, XN + (size_t)mt * 256 * 1024, 128u, aoffi, W + nt * 256, (unsigned)(64 * NWIN * 2), boffi, acc, pre,
                      next_tile(has_next, smem, XN + (size_t)mtn * 256 * 1024, aoffi, W + ntn * 256, boffi));
        pre = has_next;
        EPI_IDS();
#pragma unroll
        for (int mi = 0; mi < 8; ++mi) {
            const int gm = mt * 256 + G_ROW(mi); const int b = gm >> 13, t = gm & 8191;
            if (nt < 11) {
#pragma unroll
                for (int np = 0; np < 2; ++np) { const int n0 = G_COL(2 * np); const int hs = nt * 4 + (n0 >> 6), d0 = n0 & 63; const float sc = (hs < 8 || (hs >= 20 && hs < 28)) ? QS : 1.0f;
                    const f32x4 v0 = acc[mi][2 * np], v1 = acc[mi][2 * np + 1]; uint2 oa, ob; oa.x = cvtpk(v0[0] * sc, v0[1] * sc); oa.y = cvtpk(v0[2] * sc, v0[3] * sc); ob.x = cvtpk(v1[0] * sc, v1[1] * sc); ob.y = cvtpk(v1[2] * sc, v1[3] * sc);
                    *(uint4*)(PROJ + (((size_t)(hs * 2 + b)) * 8192 + t) * 64 + PAIR16_COL(d0, d0 + 16)) = pair16(oa, ob); }
            }
#pragma unroll
            for (int ni = 0; ni < 4; ++ni) {
                const int n = G_COL(ni); const f32x4 v = acc[mi][ni];
                if (nt < 11) {
                } else if (n < 24) {
#pragma unroll
                    for (int r = 0; r < 4; ++r) GN[(size_t)gm * 24 + n + r] = sigmoidf_(v[r]);
                } else if (n < 32) {
#pragma unroll
                    for (int r = 0; r < 4; ++r) { const int h = n - 24 + r; LS[((size_t)(b * 8 + h)) * 8192 + t] = logsigmoidf_(v[r] + bfg[h]); }
                }
            }
        }
    }
}

DEV void signal_done(unsigned* flag) {
    asm volatile("s_waitcnt vmcnt(0)" ::: "memory");
    __syncthreads();
    if (TID() == 0) { __builtin_amdgcn_fence(__ATOMIC_RELEASE, "agent"); asm volatile("s_waitcnt vmcnt(0)" ::: "memory"); __hip_atomic_fetch_add(flag, 1u, __ATOMIC_RELAXED, __HIP_MEMORY_SCOPE_AGENT); }
}
DEV void wait_flag(unsigned* flag, unsigned target) {
    if (TID() == 0) { unsigned sp = 0u; while (__hip_atomic_load(flag, __ATOMIC_RELAXED, __HIP_MEMORY_SCOPE_AGENT) < target) { __builtin_amdgcn_s_sleep(4); if (++sp > (1u << 24)) break; }
        __builtin_amdgcn_fence(__ATOMIC_ACQUIRE, "agent"); asm volatile("s_waitcnt vmcnt(0)" ::: "memory"); }
    __syncthreads();
}
constexpr int CW_CUMFLAG = 128, CW_CMPFLAG = 192, CW_GATEFLAG = 256;
DEV void cmp_item(const Args& a, unsigned char* smem, int item) {
    const bf16_t* PROJ = (const bf16_t*)(a.ws + WS_PROJ);
    const int tid = TID(); int lane = tid & 63, wid = tid >> 6, wr = wid >> 2, wc = wid & 3; (void)wr; (void)wc; (void)lane;
    {
        if (item < 16) {
            const int which = item >> 3, b = (item >> 2) & 1, g = (item >> 1) & 1, mt = item & 1;
            const bf16_t* base = PROJ + ((size_t)((8 + 2 * which + g) * 2 + b)) * 8192 * 64;
            const bf16_t* W1 = (const bf16_t*)(a.ws + WS_WC1) + (size_t)which * 2048 * 256;
            const bf16_t* W2 = (const bf16_t*)(a.ws + WS_WC2) + (size_t)which * 128 * 256;
            const float* bias1 = (const float*)(a.ws + WS_BIAS1) + which * 128;
            bf16_t* HID = (bf16_t*)(a.ws + WS_HID) + ((size_t)(which * 4 + b * 2 + g)) * 512 * 128;
            bf16_t* OUT = (bf16_t*)(a.ws + WS_KC) + ((size_t)(which * 4 + b * 2 + g)) * 512 * 64;
            f32x4 acc[8][4];
            gemm256s<true>(smem, 32, base, 128u, [&](int r, int kc) { int c = mt * 256 + r; c = c > 510 ? 510 : c; return (unsigned)(c * 2048 + kc * 16); },
                          W1, 64u * 512u, [&](int k, int nc) { return (unsigned)(k * 512 + nc * 16); }, acc);
        EPI_IDS();
            if (wc < 2) {
                float4 bb4[4];
#pragma unroll
                for (int ni = 0; ni < 4; ++ni) bb4[ni] = *(const float4*)(bias1 + wc * 64 + ni * 16 + 4 * (lane >> 4));
#pragma unroll
                for (int mi = 0; mi < 8; ++mi) { const int c = mt * 256 + wr * 128 + mi * 16 + (lane & 15);
#pragma unroll
                    for (int ni = 0; ni < 4; ++ni) { const int n = wc * 64 + ni * 16 + 4 * (lane >> 4); const f32x4 v = acc[mi][ni]; const float4 bb = bb4[ni];
                        uint2 o; o.x = cvtpk(gelu_tanh(v[0] + bb.x), gelu_tanh(v[1] + bb.y)); o.y = cvtpk(gelu_tanh(v[2] + bb.z), gelu_tanh(v[3] + bb.w));
                        *(uint2*)(HID + (size_t)c * 128 + n) = o; } }
            }
            __syncthreads();
            gemm256s<true>(smem, 2, HID + (size_t)mt * 256 * 128, 128u, [&](int r, int kc) { return (unsigned)(r * 256 + kc * 16); },
                          W2, 64u * 512u, [&](int k, int nc) { return (unsigned)(k * 512 + nc * 16); }, acc);
        EPI_IDS();
            if (wc == 0) {
#pragma unroll
                for (int mi = 0; mi < 8; ++mi) { const int c = mt * 256 + wr * 128 + mi * 16 + (lane & 15);
#pragma unroll
                    for (int ni = 0; ni < 4; ++ni) { const int n = ni * 16 + 4 * (lane >> 4); const f32x4 v = acc[mi][ni];
                        uint2 o; o.x = cvtpk(v[0], v[1]); o.y = cvtpk(v[2], v[3]);
                        if (c >= 511) { o.x = 0u; o.y = 0u; }
                        *(uint2*)(OUT + (size_t)c * 64 + n) = o; } }
            }
            signal_done((unsigned*)(a.ws + WS_CTL) + CW_CMPFLAG);
        } else {
            const int bh = item - 16; const float* LS = (const float*)(a.ws + WS_LS) + (size_t)bh * 8192; float* CUM = (float*)(a.ws + WS_CUM) + (size_t)bh * 8192;
            float* sc = (float*)smem;
            float v[16]; float s = 0.f;
#pragma unroll
            for (int j = 0; j < 4; ++j) { const float4 x = *(const float4*)(LS + tid * 16 + j * 4); v[4 * j] = x.x; v[4 * j + 1] = x.y; v[4 * j + 2] = x.z; v[4 * j + 3] = x.w; }
#pragma unroll
            for (int j = 0; j < 16; ++j) { s += v[j]; v[j] = s; }
            sc[tid] = s; __syncthreads();
            if (tid == 0) { float run = 0.f; for (int i = 0; i < NTHR; ++i) { const float x = sc[i]; sc[i] = run; run += x; } }
            __syncthreads();
            const float off = sc[tid];
#pragma unroll
            for (int j = 0; j < 4; ++j) { float4 o = {v[4 * j] + off, v[4 * j + 1] + off, v[4 * j + 2] + off, v[4 * j + 3] + off}; *(float4*)(CUM + tid * 16 + j * 4) = o; }
            signal_done((unsigned*)(a.ws + WS_CTL) + CW_CUMFLAG + bh);
        }
    }
}

constexpr int AT_STAGE = 16384;
constexpr int AT_BIAS_OFF = 3 * AT_STAGE;
constexpr int AT_IMP_OFF = AT_BIAS_OFF + 1024;
constexpr int AT_SEL_OFF = AT_IMP_OFF + 65536;
constexpr int AT_WUN_OFF = AT_SEL_OFF + 1024;
constexpr int AT_UCNT_OFF = AT_WUN_OFF + 128;
constexpr int AT_ULIST_OFF = AT_UCNT_OFF + 16;
constexpr int AT_ITEM_OFF = AT_ULIST_OFF + 128;
static_assert(AT_ITEM_OFF + 16 <= GEMM_LDS, "attention LDS map");
#define NEG_INF (-__builtin_inff())

#define KV_DECL uint4 rk0_, rv0_
#define KV_GLOAD(Kt, Vt) do { rk0_ = *(const uint4*)((Kt) + tid * 8); rv0_ = *(const uint4*)((Vt) + tid * 8); } while (0)
#define KV_LSTORE(stp) do { unsigned char* st_ = (stp); const int key = tid >> 3, ch = tid & 7; \
      *(uint4*)(st_ + key * 128 + ((ch ^ (key & 7)) << 4)) = rk0_; \
      *(uint4*)(st_ + 8192 + key * 128 + ((((ch >> 2) ^ ((key >> 1) & 1))) << 6) + ((ch & 3) << 4)) = rv0_; } while (0)
template <bool FULL>
DEV void qk_tile(const unsigned char* Kst, const bf16x8 (&qf)[4], f32x16& p0, f32x16& p1, int lane) {
    const int key = lane & 31, hi = lane >> 5;
    if (FULL) {
        bf16x8 k0[4], k1[4];
#pragma unroll
        for (int ks = 0; ks < 4; ++ks) { const int ch = 2 * ks + hi; const int off = key * 128 + ((ch ^ (key & 7)) << 4);
            k0[ks] = *(const bf16x8*)(Kst + off); k1[ks] = *(const bf16x8*)(Kst + off + 32 * 128); }
        __builtin_amdgcn_sched_barrier(0);
#pragma unroll
        for (int ks = 0; ks < 4; ++ks) {
            p0 = __builtin_amdgcn_mfma_f32_32x32x16_bf16(k0[ks], qf[ks], p0, 0, 0, 0);
            p1 = __builtin_amdgcn_mfma_f32_32x32x16_bf16(k1[ks], qf[ks], p1, 0, 0, 0); }
    } else {
        bf16x8 kk[4];
#pragma unroll
        for (int ks = 0; ks < 4; ++ks) { const int ch = 2 * ks + hi; kk[ks] = *(const bf16x8*)(Kst + key * 128 + ((ch ^ (key & 7)) << 4)); }
        __builtin_amdgcn_sched_barrier(0);
#pragma unroll
        for (int ks = 0; ks < 4; ++ks) p0 = __builtin_amdgcn_mfma_f32_32x32x16_bf16(kk[ks], qf[ks], p0, 0, 0, 0);
        __builtin_amdgcn_sched_barrier(0);
#pragma unroll
        for (int ks = 0; ks < 4; ++ks) { const int ch = 2 * ks + hi; kk[ks] = *(const bf16x8*)(Kst + key * 128 + ((ch ^ (key & 7)) << 4) + 32 * 128); }
        __builtin_amdgcn_sched_barrier(0);
#pragma unroll
        for (int ks = 0; ks < 4; ++ks) p1 = __builtin_amdgcn_mfma_f32_32x32x16_bf16(kk[ks], qf[ks], p1, 0, 0, 0);
    }
}
template <bool FULL>
DEV void pv_tile(const unsigned char* Vst, const f32x16& p0, const f32x16& p1, f32x16 (&o)[2], int lane) {
    const int hi = lane >> 5, i = lane & 15, gg = (lane >> 4) & 1;
    const int q = i >> 2; const int sw = (q >> 1) & 1;
    bf16x8 pa[4];
#pragma unroll
    for (int s = 0; s < 4; ++s) { const f32x16& p = (s < 2) ? p0 : p1; const int b = (s & 1) * 8;
        unsigned w[4];
#pragma unroll
        for (int j = 0; j < 4; ++j) w[j] = cvtpk(p[b + 2 * j], p[b + 2 * j + 1]);
        typedef unsigned u32x4_t __attribute__((ext_vector_type(4)));
        u32x4_t ww = {w[0], w[1], w[2], w[3]}; pa[s] = __builtin_bit_cast(bf16x8, ww); }
    constexpr int NB = FULL ? 1 : 2, SB = FULL ? 4 : 2;
#pragma unroll
    for (int bt = 0; bt < NB; ++bt) {
        s16x4 vlo[SB][2], vhi[SB][2];
#pragma unroll
        for (int s_ = 0; s_ < SB; ++s_)
#pragma unroll
            for (int dh = 0; dh < 2; ++dh) { const int s = bt * SB + s_; const int row0 = 16 * s + 4 * hi + q;
                const unsigned char* p = Vst + row0 * 128 + ((dh ^ sw) << 6) + gg * 32 + (i & 3) * 8;
                vlo[s_][dh] = tr_read(p); vhi[s_][dh] = tr_read(p + 8 * 128); }
        __builtin_amdgcn_sched_barrier(0);
#pragma unroll
        for (int s_ = 0; s_ < SB; ++s_)
#pragma unroll
            for (int dh = 0; dh < 2; ++dh) { const int s = bt * SB + s_;
                const bf16x8 vf = {vlo[s_][dh][0], vlo[s_][dh][1], vlo[s_][dh][2], vlo[s_][dh][3], vhi[s_][dh][0], vhi[s_][dh][1], vhi[s_][dh][2], vhi[s_][dh][3]};
                o[dh] = __builtin_amdgcn_mfma_f32_32x32x16_bf16(vf, pa[s], o[dh], 0, 0, 0); }
        __builtin_amdgcn_sched_barrier(0);
    }
}
DEV float rowmax32(const f32x16& p0, const f32x16& p1) {
    float a = fmaxf(p0[0], p1[0]), b = fmaxf(p0[1], p1[1]);
#pragma unroll
    for (int r = 2; r < 16; r += 2) { a = fmaxf(fmaxf(a, p0[r]), p1[r]); b = fmaxf(fmaxf(b, p0[r + 1]), p1[r + 1]); }
    return pair_max(fmaxf(a, b));
}
DEV void softmax_step(f32x16& p0, f32x16& p1, float& m, float& l, f32x16 (&o)[2]) {
    const float mt = rowmax32(p0, p1); const float mn = fmaxf(m, mt); const float alpha = __builtin_amdgcn_exp2f(m - mn);
    float rs = 0.f;
#pragma unroll
    for (int r = 0; r < 16; ++r) { p0[r] = __builtin_amdgcn_exp2f(p0[r] - mn); p1[r] = __builtin_amdgcn_exp2f(p1[r] - mn); rs += p0[r] + p1[r]; }
    rs = pair_sum(rs);
    l = l * alpha + rs; m = mn;
    if (__any(alpha != 1.0f)) { o[0] *= alpha; o[1] *= alpha; }
}
DEV void softmax_step_nosum(f32x16& p0, f32x16& p1, float& m, f32x16 (&o)[2], f32x16& lacc) {
    const float mt = rowmax32(p0, p1); const float mn = fmaxf(m, mt); const float alpha = __builtin_amdgcn_exp2f(m - mn);
#pragma unroll
    for (int r = 0; r < 16; ++r) { p0[r] = __builtin_amdgcn_exp2f(p0[r] - mn); p1[r] = __builtin_amdgcn_exp2f(p1[r] - mn); }
    m = mn;
    if (__any(alpha != 1.0f)) { o[0] *= alpha; o[1] *= alpha; lacc *= alpha; }
}
DEV void pv_tile_sum(const unsigned char* Vst, const f32x16& p0, const f32x16& p1, f32x16 (&o)[2], f32x16& lacc, int lane) {
    const int hi = lane >> 5, i = lane & 15, gg = (lane >> 4) & 1;
    const int q = i >> 2; const int sw = (q >> 1) & 1;
    bf16x8 pa[4];
#pragma unroll
    for (int s = 0; s < 4; ++s) { const f32x16& p = (s < 2) ? p0 : p1; const int b = (s & 1) * 8;
        unsigned w[4];
#pragma unroll
        for (int j = 0; j < 4; ++j) w[j] = cvtpk(p[b + 2 * j], p[b + 2 * j + 1]);
        typedef unsigned u32x4_t __attribute__((ext_vector_type(4)));
        u32x4_t ww = {w[0], w[1], w[2], w[3]}; pa[s] = __builtin_bit_cast(bf16x8, ww); }
    const bf16x8 ones = {0x3f80, 0x3f80, 0x3f80, 0x3f80, 0x3f80, 0x3f80, 0x3f80, 0x3f80};
#pragma unroll
    for (int bt = 0; bt < 2; ++bt) {
        s16x4 vlo[2][2], vhi[2][2];
#pragma unroll
        for (int s_ = 0; s_ < 2; ++s_)
#pragma unroll
            for (int dh = 0; dh < 2; ++dh) { const int s = bt * 2 + s_; const int row0 = 16 * s + 4 * hi + q;
                const unsigned char* p = Vst + row0 * 128 + ((dh ^ sw) << 6) + gg * 32 + (i & 3) * 8;
                vlo[s_][dh] = tr_read(p); vhi[s_][dh] = tr_read(p + 8 * 128); }
        __builtin_amdgcn_sched_barrier(0);
#pragma unroll
        for (int s_ = 0; s_ < 2; ++s_) { const int s = bt * 2 + s_;
            lacc = __builtin_amdgcn_mfma_f32_32x32x16_bf16(ones, pa[s], lacc, 0, 0, 0);
#pragma unroll
            for (int dh = 0; dh < 2; ++dh) {
                const bf16x8 vf = {vlo[s_][dh][0], vlo[s_][dh][1], vlo[s_][dh][2], vlo[s_][dh][3], vhi[s_][dh][0], vhi[s_][dh][1], vhi[s_][dh][2], vhi[s_][dh][3]};
                o[dh] = __builtin_amdgcn_mfma_f32_32x32x16_bf16(vf, pa[s], o[dh], 0, 0, 0); } }
        __builtin_amdgcn_sched_barrier(0);
    }
}
template <int STRIDE> DEV void mask_tile(f32x16& p0, f32x16& p1, int kpos0, int lo, int hi_lim, int hi) {
#pragma unroll
    for (int r = 0; r < 16; ++r) { const int kp = kpos0 + STRIDE * crow(r, hi);
        if (kp < lo || kp > hi_lim) p0[r] = NEG_INF;
        const int kp1 = kp + 32 * STRIDE; if (kp1 < lo || kp1 > hi_lim) p1[r] = NEG_INF; }
}
template <int STRIDE> DEV void alibi_init(f32x16& p0, f32x16& p1, float slope2, int kpos0, int tref, int hi) {
    const float base = slope2 * (float)(kpos0 - tref + STRIDE * 4 * hi);
#pragma unroll
    for (int r = 0; r < 16; ++r) { const float c = (float)(STRIDE * ((r & 3) + 8 * (r >> 2))); p0[r] = fmaf(slope2, c, base); p1[r] = fmaf(slope2, c + (float)(32 * STRIDE), base); }
}
template <class Src, class Body, class NSrc>
DEV int kv_pipeline(unsigned char* smem, int n, const Src& src, const Body& body, int par, bool pre, bool has_next, const NSrc& nsrc) {
    KV_DECL; const int tid = TID(); const bf16_t *kp, *vp;
    if (!pre) { src(0, kp, vp); KV_GLOAD(kp, vp); KV_LSTORE(smem + par * AT_STAGE); __syncthreads(); }
    for (int j = 0; j < n; ++j) {
        const bool more = j + 1 < n;
        src(more ? j + 1 : j, kp, vp); if (!more && has_next) nsrc(kp, vp);
        KV_GLOAD(kp, vp);
        body(j, smem + ((par + j) & 1) * AT_STAGE);
        KV_LSTORE(smem + ((par + j + 1) & 1) * AT_STAGE);
        __syncthreads();
    }
    return (par + n) & 1;
}
struct NoSrc { DEV void operator()(const bf16_t*&, const bf16_t*&) const {} };

constexpr int CV_PER_STEP = 373; constexpr int CV_NUP = 32 * 1024 * 2048 / 8, CV_NDN = 32 * 1024 * 1024 / 8;
static_assert((long long)33792 * CV_PER_STEP >= (long long)CV_NUP + CV_NDN, "conversion coverage");
DEV void fox_item(const Args& a, unsigned char* smem, int fi, int b, int h, int qb) {
    const int tid = TID(), lane = tid & 63, wid = tid >> 6, r32 = lane & 31, hi = lane >> 5;
    const bf16_t* PROJ = (const bf16_t*)(a.ws + WS_PROJ);
    const bf16_t* Q = PROJ + ((size_t)((20 + h) * 2 + b)) * 8192 * 64; const bf16_t* K = PROJ + ((size_t)((28 + h) * 2 + b)) * 8192 * 64; const bf16_t* V = PROJ + ((size_t)((36 + h) * 2 + b)) * 8192 * 64;
    const float* CUM = (const float*)(a.ws + WS_CUM) + (size_t)(b * 8 + h) * 8192;
    const int q0 = qb * 256; const int qrow = q0 + 32 * wid + r32;
    bf16x8 qf[4];
#pragma unroll
    for (int ks = 0; ks < 4; ++ks) qf[ks] = *(const bf16x8*)(Q + (size_t)qrow * 64 + 16 * ks + 8 * hi);
    const float cref = CUM[q0];
    const int ntiles = 4 * qb + 4; const int jmax_w = (q0 + 32 * wid + 31) >> 6; const int jmask_w = (q0 + 32 * wid) >> 6;
    f32x16 o[2]; o[0] = (f32x16){}; o[1] = (f32x16){}; f32x16 lacc = (f32x16){}; float m = -1e30f;
    float* biasL = (float*)(smem + AT_BIAS_OFF);
    const int gq_ = fi >> 4; const int sidx0 = 16 * (128 * gq_ - 2 * gq_ * (gq_ - 1)) + (fi & 15) * (128 - 4 * gq_);
    bf16_t* cvdA = nullptr; bf16_t* cvdB = nullptr; float4 cvaA, cvbA, cvaB, cvbB;
    KV_DECL; float breg = 0.f;
#define TJ(s_) (ntiles - 1 - (s_))
#define CV_ADDR(st_, SRC, DST) do { int c_ = (sidx0 + (st_)) * CV_PER_STEP + (tid < CV_PER_STEP ? tid : CV_PER_STEP - 1); c_ = c_ < CV_NUP + CV_NDN ? c_ : CV_NUP + CV_NDN - 1; \
        const bool up_ = c_ < CV_NUP; const int cc_ = up_ ? c_ : c_ - CV_NUP; SRC = (up_ ? a.in[I_WUP] : a.in[I_WDN]) + (size_t)cc_ * 8; DST = (bf16_t*)(a.ws + (up_ ? WS_WUP : WS_WDN)) + (size_t)cc_ * 8; } while (0)
    { const float* cvs_; CV_ADDR(0, cvs_, cvdB); cvaB = *(const float4*)cvs_; cvbB = *(const float4*)(cvs_ + 4); }
    KV_GLOAD(K + (size_t)TJ(0) * 4096, V + (size_t)TJ(0) * 4096); breg = CUM[TJ(0) * 64 + lane];
    KV_LSTORE(smem); biasL[lane] = (cref - breg) * LOG2E;
    KV_GLOAD(K + (size_t)TJ(1) * 4096, V + (size_t)TJ(1) * 4096); breg = CUM[TJ(1) * 64 + lane];
    KV_LSTORE(smem + AT_STAGE); biasL[64 + lane] = (cref - breg) * LOG2E;
    __syncthreads();
#define FOX_QK(P0, P1, jj, sj) do { const float* bl_ = biasL + (sj) * 64; \
        _Pragma("unroll") for (int g4 = 0; g4 < 4; ++g4) { const float4 x_ = *(const float4*)(bl_ + 8 * g4 + 4 * hi), y_ = *(const float4*)(bl_ + 32 + 8 * g4 + 4 * hi); \
            P0[4 * g4] = x_.x; P0[4 * g4 + 1] = x_.y; P0[4 * g4 + 2] = x_.z; P0[4 * g4 + 3] = x_.w; P1[4 * g4] = y_.x; P1[4 * g4 + 1] = y_.y; P1[4 * g4 + 2] = y_.z; P1[4 * g4 + 3] = y_.w; } \
        qk_tile<true>(smem + (sj) * AT_STAGE, qf, P0, P1, lane); \
        if ((jj) >= jmask_w) mask_tile<1>(P0, P1, 64 * (jj), -1, qrow, hi); } while (0)
#define FOX_STEP(CUR0, CUR1, NXT0, NXT1, j, CVD_LD, CVA_LD, CVB_LD, CVD_ST, CVA_ST, CVB_ST) do { \
        const int s_cur = (j) % 3, s_nxt = ((j) + 1) % 3, s_ld = ((j) + 2) % 3; const int tl_ = TJ((j) + 2) < 0 ? 0 : TJ((j) + 2);     \
        KV_GLOAD(K + (size_t)tl_ * 4096, V + (size_t)tl_ * 4096); breg = CUM[tl_ * 64 + lane]; \
        { const float* cvs_; CV_ADDR(j, cvs_, CVD_LD); CVA_LD = *(const float4*)cvs_; CVB_LD = *(const float4*)(cvs_ + 4); } \
        if ((j) + 1 < ntiles && TJ((j) + 1) <= jmax_w) FOX_QK(NXT0, NXT1, TJ((j) + 1), s_nxt); \
        __builtin_amdgcn_sched_barrier(0); \
        if (TJ(j) <= jmax_w) { softmax_step_nosum(CUR0, CUR1, m, o, lacc); pv_tile_sum(smem + s_cur * AT_STAGE + 8192, CUR0, CUR1, o, lacc, lane); } \
        KV_LSTORE(smem + s_ld * AT_STAGE); biasL[s_ld * 64 + lane] = (cref - breg) * LOG2E; \
        { uint4 o_; o_.x = cvtpk(CVA_ST.x, CVA_ST.y); o_.y = cvtpk(CVA_ST.z, CVA_ST.w); o_.z = cvtpk(CVB_ST.x, CVB_ST.y); o_.w = cvtpk(CVB_ST.z, CVB_ST.w); *(uint4*)CVD_ST = o_; } \
        __syncthreads(); } while (0)
    f32x16 pA0, pA1, pB0, pB1;
    if (TJ(0) <= jmax_w) FOX_QK(pA0, pA1, TJ(0), 0);
    for (int j = 0; j < ntiles; j += 2) {
        FOX_STEP(pA0, pA1, pB0, pB1, j, cvdA, cvaA, cvbA, cvdB, cvaB, cvbB);
        FOX_STEP(pB0, pB1, pA0, pA1, j + 1, cvdB, cvaB, cvbB, cvdA, cvaA, cvbA);
    }
    { uint4 o_; o_.x = cvtpk(cvaB.x, cvaB.y); o_.y = cvtpk(cvaB.z, cvaB.w); o_.z = cvtpk(cvbB.x, cvbB.y); o_.w = cvtpk(cvbB.z, cvbB.w); *(uint4*)cvdB = o_; }
#undef CV_ADDR
#undef FOX_QK
#undef FOX_STEP
#undef TJ
    const float inv = 1.0f / lacc[0]; float ss = 0.f;
    const size_t token = (size_t)b * 8192 + qrow;
    bf16_t* O = (bf16_t*)(a.ws + WS_OFOX) + token * 512 + h * 64;
#pragma unroll
    for (int dh = 0; dh < 2; ++dh)
#pragma unroll
        for (int g4 = 0; g4 < 4; ++g4) { const float v0 = o[dh][4 * g4] * inv, v1 = o[dh][4 * g4 + 1] * inv, v2 = o[dh][4 * g4 + 2] * inv, v3 = o[dh][4 * g4 + 3] * inv;
            ss += v0 * v0 + v1 * v1 + v2 * v2 + v3 * v3; uint2 w; w.x = cvtpk(v0, v1); w.y = cvtpk(v2, v3); *(uint2*)(O + 32 * dh + 8 * g4 + 4 * hi) = w; }
    ss = pair_sum(ss);
    if (hi == 0) ((float*)(a.ws + WS_SSQ))[token * 16 + 8 + h] = ss;
}

DEV void nsa_item(const Args& a, unsigned char* smem, int b, int g, int tt) {
    const int tid = TID(), lane = tid & 63, wid = tid >> 6, col = lane & 31, hi = lane >> 5;
    const int t0 = tt * 64, tokw = col >> 2, r = col & 3, h = 4 * g + r; const int tokl = wid * 8 + tokw; const int t = t0 + tokl; const size_t token = (size_t)b * 8192 + t;
    const float slope2 = exp2f(-(float)(h + 1)) * LOG2E;
    const bf16_t* PROJ = (const bf16_t*)(a.ws + WS_PROJ);
    const float* GN = (const float*)(a.ws + WS_GN) + token * 24 + h * 3;
    const int cur = tt; const bool need_topk = cur > 15;
    bf16x8 qf[4];
    { const bf16_t* Q = PROJ + (((size_t)(h * 2 + b)) * 8192 + t) * 64;
#pragma unroll
      for (int ks = 0; ks < 4; ++ks) qf[ks] = *(const bf16x8*)(Q + 16 * ks + 8 * hi); }
    float* impw = (float*)(smem + AT_IMP_OFF) + wid * 2048; float* totw = impw + lane;
    unsigned* selmask = (unsigned*)(smem + AT_SEL_OFF); unsigned* wun = (unsigned*)(smem + AT_WUN_OFF); int* ucnt = (int*)(smem + AT_UCNT_OFF); unsigned char* ulist = smem + AT_ULIST_OFF;
    f32x16 o[2]; float m, l; int par = 0;
    const int tmin_w = t0 + wid * 8, tmax_w = tmin_w + 7;
    {
        const bf16_t* KC = (const bf16_t*)(a.ws + WS_KC) + ((size_t)(0 * 4 + b * 2 + g)) * 512 * 64; const bf16_t* VC = (const bf16_t*)(a.ws + WS_KC) + ((size_t)(1 * 4 + b * 2 + g)) * 512 * 64;
        const int ncv = t0 / 16 + 3; const int nct = (ncv + 63) >> 6;
        auto src = [&](int j, const bf16_t*& kp, const bf16_t*& vp) { kp = KC + (size_t)j * 4096; vp = VC + (size_t)j * 4096; };
        m = -1e30f; l = 0.f;
        auto src0 = [&](const bf16_t*& kp, const bf16_t*& vp) { kp = KC; vp = VC; };
        par = kv_pipeline(smem, nct, src, [&](int j, const unsigned char* st) {
            const int kpos0 = 1024 * j + 31;
            if (kpos0 > tmax_w) return;
            f32x16 p0, p1; alibi_init<16>(p0, p1, slope2, kpos0, t0, hi);
            qk_tile<false>(st, qf, p0, p1, lane);
            if (kpos0 + 16 * 63 > tmin_w) mask_tile<16>(p0, p1, kpos0, -1, t, hi);
            const float mt = rowmax32(p0, p1); const float mn = fmaxf(m, mt); float rs = 0.f;
#pragma unroll
            for (int rr = 0; rr < 16; ++rr) rs += __builtin_amdgcn_exp2f(p0[rr] - mn) + __builtin_amdgcn_exp2f(p1[rr] - mn);
            rs = pair_sum(rs);
            l = l * __builtin_amdgcn_exp2f(m - mn) + rs; m = mn;
        }, 0, false, true, src0);
        const float linv = l > 0.f ? 1.0f / l : 0.f;
        if (need_topk) { for (int i = lane; i < 8 * 129; i += 64) impw[i] = 0.f; }
        o[0] = (f32x16){}; o[1] = (f32x16){};
        const bf16_t* KS0 = PROJ + ((size_t)((12 + g) * 2 + b)) * 8192 * 64 + (size_t)cur * 4096; const bf16_t* VS0 = PROJ + ((size_t)((14 + g) * 2 + b)) * 8192 * 64 + (size_t)cur * 4096;
        par = kv_pipeline(smem, nct, src, [&](int j, const unsigned char* st) {
            const int kpos0 = 1024 * j + 31;
            if (kpos0 > tmax_w) return;
            f32x16 p0, p1; alibi_init<16>(p0, p1, slope2, kpos0, t0, hi);
            qk_tile<false>(st, qf, p0, p1, lane);
            if (kpos0 + 16 * 63 > tmin_w) mask_tile<16>(p0, p1, kpos0, -1, t, hi);
#pragma unroll
            for (int rr = 0; rr < 16; ++rr) { p0[rr] = __builtin_amdgcn_exp2f(p0[rr] - m) * linv; p1[rr] = __builtin_amdgcn_exp2f(p1[rr] - m) * linv; }
            if (need_topk) {
#pragma unroll
                for (int half = 0; half < 2; ++half)
#pragma unroll
                    for (int g4 = 0; g4 < 4; ++g4) { const f32x16& p = half ? p1 : p0;
                        float ms = (p[4 * g4] + p[4 * g4 + 1]) + (p[4 * g4 + 2] + p[4 * g4 + 3]); float ls = p[4 * g4 + 3];
                        ms = quad_sum(ms); ls = quad_sum(ls);
                        const int n = 16 * j + 8 * half + 2 * g4 + hi;
                        if (r == 0) { atomicAdd(&impw[tokw * 129 + n], ms); atomicAdd(&impw[tokw * 129 + n + 1], ls); } }
            }
            pv_tile<false>(st + 8192, p0, p1, o, lane);
        }, par, true, true, [&](const bf16_t*& kp, const bf16_t*& vp) { kp = KS0; vp = VS0; });
    }
    {
        unsigned un0 = 0u, un1 = 0u, un2 = 0u, un3 = 0u;
        if (need_topk) {
#define TK_INIT(V0, V1, M0, M1, M2, M3, tk_) float V0 = impw[(tk_) * 129 + lane], V1 = impw[(tk_) * 129 + 64 + lane]; \
                V0 = (lane >= 1 && lane <= cur - 2) ? V0 : -1.0f; V1 = (lane + 64 <= cur - 2) ? V1 : -1.0f; unsigned M0 = 1u, M1 = 0u, M2 = 0u, M3 = 0u; \
                TK_SET(M0, M1, M2, M3, cur); TK_SET(M0, M1, M2, M3, cur - 1)
#define TK_SET(M0, M1, M2, M3, n_) do { const int n__ = (n_); const unsigned bit__ = 1u << (n__ & 31); const int w__ = n__ >> 5; M0 |= (w__ == 0) ? bit__ : 0u; M1 |= (w__ == 1) ? bit__ : 0u; M2 |= (w__ == 2) ? bit__ : 0u; M3 |= (w__ == 3) ? bit__ : 0u; } while (0)
#define TK_STEP(V0, V1, M0, M1, M2, M3) do { const float mx_ = wave_max_u(fmaxf(V0, V1)); const unsigned long long b0_ = __ballot(V0 == mx_), b1_ = __ballot(V1 == mx_); \
                const int n_ = b0_ ? (__ffsll((long long)b0_) - 1) : (63 + __ffsll((long long)b1_)); const bool hit_ = lane == (n_ & 63); \
                V0 = (hit_ && n_ < 64) ? -1.0f : V0; V1 = (hit_ && n_ >= 64) ? -1.0f : V1; TK_SET(M0, M1, M2, M3, n_); } while (0)
            for (int tk = 0; tk < 8; tk += 4) {
                TK_INIT(a0_, a1_, ma0, ma1, ma2, ma3, tk); TK_INIT(b0v, b1v, mb0, mb1, mb2, mb3, tk + 1); TK_INIT(c0v, c1v, mc0, mc1, mc2, mc3, tk + 2); TK_INIT(d0v, d1v, md0, md1, md2, md3, tk + 3);
                for (int it = 0; it < 13; ++it) { TK_STEP(a0_, a1_, ma0, ma1, ma2, ma3); TK_STEP(b0v, b1v, mb0, mb1, mb2, mb3); TK_STEP(c0v, c1v, mc0, mc1, mc2, mc3); TK_STEP(d0v, d1v, md0, md1, md2, md3); }
                if (lane == 0) { unsigned* sm_ = selmask + (wid * 8 + tk) * 4; sm_[0] = ma0; sm_[1] = ma1; sm_[2] = ma2; sm_[3] = ma3; sm_[4] = mb0; sm_[5] = mb1; sm_[6] = mb2; sm_[7] = mb3;
                    sm_[8] = mc0; sm_[9] = mc1; sm_[10] = mc2; sm_[11] = mc3; sm_[12] = md0; sm_[13] = md1; sm_[14] = md2; sm_[15] = md3; }
                un0 |= ma0 | mb0 | mc0 | md0; un1 |= ma1 | mb1 | mc1 | md1; un2 |= ma2 | mb2 | mc2 | md2; un3 |= ma3 | mb3 | mc3 | md3;
            }
#undef TK_INIT
#undef TK_SET
#undef TK_STEP
        } else {
            const unsigned full = (2u << cur) - 1u;
            un0 = full;
            if (lane < 8) { unsigned* sm_ = selmask + (wid * 8 + lane) * 4; sm_[0] = full; sm_[1] = 0u; sm_[2] = 0u; sm_[3] = 0u; }
        }
        if (lane == 0) { wun[wid * 4] = un0; wun[wid * 4 + 1] = un1; wun[wid * 4 + 2] = un2; wun[wid * 4 + 3] = un3; }
        __syncthreads();
        if (tid == 0) { int c = 0;
            for (int w = 0; w < 4; ++w) { unsigned u = 0u; for (int ww = 0; ww < NWAVE; ++ww) u |= wun[ww * 4 + w]; for (int bb = 0; bb < 32; ++bb) if ((u >> bb) & 1u) ulist[c++] = (unsigned char)(w * 32 + bb); }
            ucnt[0] = c; }
        __syncthreads();
    }
    { const float g0 = GN[0];
#pragma unroll
      for (int rr = 0; rr < 16; ++rr) { totw[rr * 64] = o[0][rr] * g0; totw[(16 + rr) * 64] = o[1][rr] * g0; } }
    {
        const bf16_t* KS = PROJ + ((size_t)((12 + g) * 2 + b)) * 8192 * 64; const bf16_t* VS = PROJ + ((size_t)((14 + g) * 2 + b)) * 8192 * 64;
        const int nu = ucnt[0];
        m = -1e30f; f32x16 lacc = (f32x16){}; o[0] = (f32x16){}; o[1] = (f32x16){};
        const bf16_t* KW0 = PROJ + ((size_t)((16 + g) * 2 + b)) * 8192 * 64 + (size_t)cur * 4096; const bf16_t* VW0 = PROJ + ((size_t)((18 + g) * 2 + b)) * 8192 * 64 + (size_t)cur * 4096;
        par = kv_pipeline(smem, nu, [&](int j, const bf16_t*& kp, const bf16_t*& vp) { const int n = ulist[nu - 1 - j]; kp = KS + (size_t)n * 4096; vp = VS + (size_t)n * 4096; },
            [&](int j, const unsigned char* st) {
                const int n = ulist[nu - 1 - j];
                if (!((wun[wid * 4 + (n >> 5)] >> (n & 31)) & 1u)) return;
                const bool sel = (selmask[tokl * 4 + (n >> 5)] >> (n & 31)) & 1u;
                f32x16 p0, p1; alibi_init<1>(p0, p1, slope2, 64 * n, t0, hi);
                qk_tile<false>(st, qf, p0, p1, lane);
                if (n == cur || !__all(sel)) mask_tile<1>(p0, p1, 64 * n, -1, sel ? t : -1, hi);
                softmax_step_nosum(p0, p1, m, o, lacc);
                pv_tile_sum(st + 8192, p0, p1, o, lacc, lane);
            }, par, true, true, [&](const bf16_t*& kp, const bf16_t*& vp) { kp = KW0; vp = VW0; });
        const float g1 = GN[1] / fmaxf(lacc[0], 1e-30f);
#pragma unroll
        for (int rr = 0; rr < 16; ++rr) { totw[rr * 64] += o[0][rr] * g1; totw[(16 + rr) * 64] += o[1][rr] * g1; }
    }
    {
        const bf16_t* KW = PROJ + ((size_t)((16 + g) * 2 + b)) * 8192 * 64; const bf16_t* VW = PROJ + ((size_t)((18 + g) * 2 + b)) * 8192 * 64;
        const int jlo = (t0 - 511) > 0 ? ((t0 - 511) >> 6) : 0; const int jhi = cur;
        m = -1e30f; f32x16 lacc = (f32x16){}; o[0] = (f32x16){}; o[1] = (f32x16){};
        (void)kv_pipeline(smem, jhi - jlo + 1, [&](int j, const bf16_t*& kp, const bf16_t*& vp) { kp = KW + (size_t)(jhi - j) * 4096; vp = VW + (size_t)(jhi - j) * 4096; },
            [&](int j, const unsigned char* st) {
                const int kpos0 = 64 * (jhi - j);
                if (kpos0 > tmax_w || kpos0 + 63 < tmin_w - 511) return;
                f32x16 p0, p1; alibi_init<1>(p0, p1, slope2, kpos0, t0, hi);
                qk_tile<false>(st, qf, p0, p1, lane);
                if (kpos0 < tmax_w - 511 || kpos0 + 63 > tmin_w) mask_tile<1>(p0, p1, kpos0, t - 511, t, hi);
                softmax_step_nosum(p0, p1, m, o, lacc);
                pv_tile_sum(st + 8192, p0, p1, o, lacc, lane);
            }, par, true, false, NoSrc());
        const float g2 = GN[2] / fmaxf(lacc[0], 1e-30f);
#pragma unroll
        for (int rr = 0; rr < 16; ++rr) { o[0][rr] = totw[rr * 64] + o[0][rr] * g2; o[1][rr] = totw[(16 + rr) * 64] + o[1][rr] * g2; }
    }
    {
        float ss = 0.f; bf16_t* O = (bf16_t*)(a.ws + WS_ONSA) + token * 512 + h * 64;
#pragma unroll
        for (int dh = 0; dh < 2; ++dh)
#pragma unroll
            for (int g4 = 0; g4 < 4; ++g4) { const float v0 = o[dh][4 * g4], v1 = o[dh][4 * g4 + 1], v2 = o[dh][4 * g4 + 2], v3 = o[dh][4 * g4 + 3];
                ss += v0 * v0 + v1 * v1 + v2 * v2 + v3 * v3; uint2 w; w.x = cvtpk(v0, v1); w.y = cvtpk(v2, v3); *(uint2*)(O + 32 * dh + 8 * g4 + 4 * hi) = w; }
        ss = pair_sum(ss);
        if (hi == 0) ((float*)(a.ws + WS_SSQ))[token * 16 + h] = ss;
    }
}
#ifndef PROBE_DUP
#define PROBE_DUP 0
#endif
DEV void phase_att(const Args& a, unsigned char* smem) {
    int* qctr = (int*)(a.ws + WS_CTL) + 64; int* sitem = (int*)(smem + AT_ITEM_OFF);
    unsigned* ctl = (unsigned*)(a.ws + WS_CTL); unsigned* seen = (unsigned*)(smem + AT_ITEM_OFF + 8);
    if (TID() == 0) seen[0] = 0u;
    for (;;) {
        if (TID() == 0) sitem[0] = atomicAdd(qctr, 1);
        __syncthreads();
        const int item = sitem[0];
        __syncthreads();
        if (item >= 32 + 1024) break;
        if (item < 16) cmp_item(a, smem, 16 + item);
        else if (item < 32) cmp_item(a, smem, item - 16);
        else if (item < 32 + 512) { const int fi = item - 32; const int qb = 31 - (fi >> 4), bh = fi & 15; if (!((seen[0] >> bh) & 1u)) { wait_flag(ctl + CW_CUMFLAG + bh, 1u); if (TID() == 0) seen[0] |= 1u << bh; } fox_item(a, smem, fi, bh >> 3, bh & 7, qb); }
        else { const int idx = item - 32 - 512; const int tt = 127 - (idx >> 2), bg = idx & 3; if (!((seen[0] >> 16) & 1u)) { wait_flag(ctl + CW_CMPFLAG, 16u); if (TID() == 0) seen[0] |= 1u << 16; } nsa_item(a, smem, bg >> 1, bg & 1, tt); }
    }
}

DEV void phase_outproj(const Args& a, unsigned char* smem) {
    const bf16_t* ONSA = (const bf16_t*)(a.ws + WS_ONSA); const bf16_t* OFOX = (const bf16_t*)(a.ws + WS_OFOX); const float* SSQ = (const float*)(a.ws + WS_SSQ);
    const bf16_t* W = (const bf16_t*)(a.ws + WS_WOUT); bf16_t* H1 = (bf16_t*)(a.ws + WS_H1); const float* X = a.in[I_X];
    float* rs = (float*)(smem + MISC_OFF);
    const int tid = TID(); int lane = tid & 63, wid = tid >> 6, wr = wid >> 2, wc = wid & 3; (void)wr; (void)wc; (void)lane;
    auto aoffo = [](int r, int kc) { return (unsigned)(r * 1024 + kc * 16); }; auto boffo = [](int k, int nc) { return (unsigned)(k * 2048 + nc * 16); };
    for (int item = VBID(); item < 64 * 4; item += gridDim.x) {
        int mt, nt; patch_decode(item, 64, 4, mt, nt);
        gemm_issue0<15>(smem, ONSA + (size_t)mt * 256 * 512, aoffo, W + nt * 256, boffo);
        if (tid < 256) { const float* s_ = SSQ + (size_t)(mt * 256 + tid) * 16; float sn = 0.f, sf = 0.f;
#pragma unroll
            for (int j = 0; j < 8; ++j) { sn += s_[j]; sf += s_[8 + j]; }
            rs[tid * 2] = rsqrtf(sn * (1.f / 512.f) + EPS); rs[tid * 2 + 1] = rsqrtf(sf * (1.f / 512.f) + EPS); }
        asm volatile("s_waitcnt vmcnt(0)" ::: "memory");
        __syncthreads();
        f32x4 acc[8][4];
#pragma unroll
        for (int mi = 0; mi < 8; ++mi) { const size_t gm = (size_t)mt * 256 + G_ROW(mi);
#pragma unroll
            for (int ni = 0; ni < 4; ++ni) { const int n = nt * 256 + G_COL(ni); const float4 x = *(const float4*)(X + gm * 1024 + n); acc[mi][ni] = (f32x4){x.x, x.y, x.z, x.w}; } }
#pragma unroll
        for (int mi = 0; mi < 8; ++mi) { const float ri = 1.0f / rs[(G_ROW(mi)) * 2];
#pragma unroll
            for (int ni = 0; ni < 4; ++ni) acc[mi][ni] *= ri; }
        gemm256<false>(smem, 8, ONSA + (size_t)mt * 256 * 512, 128u, aoffo, W + nt * 256, 64u * 2048u, boffo, acc, true,
                       next_tile(true, smem, OFOX + (size_t)mt * 256 * 512, aoffo, W + (size_t)512 * 1024 + nt * 256, boffo));
        EPI_IDS();
#pragma unroll
        for (int mi = 0; mi < 8; ++mi) { const int rl = G_ROW(mi); const float rat = rs[rl * 2] / rs[rl * 2 + 1];
#pragma unroll
            for (int ni = 0; ni < 4; ++ni) acc[mi][ni] *= rat; }
        gemm256<false>(smem, 8, OFOX + (size_t)mt * 256 * 512, 128u, aoffo, W + (size_t)512 * 1024 + nt * 256, 64u * 2048u, boffo, acc, true);
        EPI_IDS();
#pragma unroll
        for (int mi = 0; mi < 8; ++mi) { const int rl = G_ROW(mi); const size_t gm = (size_t)mt * 256 + rl; const float rf = rs[rl * 2 + 1];
#pragma unroll
            for (int np = 0; np < 2; ++np) { const f32x4 v0 = acc[mi][2 * np] * rf, v1 = acc[mi][2 * np + 1] * rf; uint2 oa, ob;
                oa.x = cvtpk(v0[0], v0[1]); oa.y = cvtpk(v0[2], v0[3]); ob.x = cvtpk(v1[0], v1[1]); ob.y = cvtpk(v1[2], v1[3]);
                *(uint4*)(H1 + gm * 1024 + nt * 256 + PAIR16_COL(G_COL(2 * np), G_COL(2 * np + 1))) = pair16(oa, ob); } }
        __syncthreads();
    }
}

DEV void phase_route(const Args& a, unsigned char* smem) {
    const bf16_t* H1 = (const bf16_t*)(a.ws + WS_H1); bf16_t* XN = (bf16_t*)(a.ws + WS_XN); float* RSTD2 = (float*)(a.ws + WS_RSTD2);
    const float* ln2 = a.in[I_LN2]; const float* wr_ = a.in[I_WR]; const float* br = a.in[I_BR];
    int* CNT = (int*)(a.ws + WS_CTL);
    int* TOPI = (int*)(a.ws + WS_TOPI); int* TOPS = (int*)(a.ws + WS_TOPS); float* TOPW = (float*)(a.ws + WS_TOPW);
    int* TOKOF = (int*)(a.ws + WS_TOKOF); float* ROWW = (float*)(a.ws + WS_ROWW); float* RSDS = (float*)(a.ws + WS_RSDS);
    float* part = (float*)smem;
    float* ssqp = part + 8 * 32 * 33;
    int* lcnt = (int*)(ssqp + 256); int* lbase = lcnt + 32; int* te = lbase + 32; int* trk = te + 256; float* tw = (float*)(trk + 256); float* trs = tw + 256;
    const int tid = TID(), lane = tid & 63, wid = tid >> 6, i32 = lane & 31, kh = lane >> 5; const int tg = wid >> 2, kq = wid & 3;
    for (int item = BID(); item < 256; item += gridDim.x) {
        const int tok = item * 64 + tg * 32 + i32;
        if (tid < 32) lcnt[tid] = 0;
        f32x16 acc = (f32x16){}; float ss = 0.f;
        const bf16_t* hrow = H1 + (size_t)tok * 1024 + 256 * kq + 8 * kh; const float* lrow = ln2 + 256 * kq + 8 * kh; bf16_t* xrow = XN + (size_t)tok * 1024 + 256 * kq + 8 * kh;
        const float* wbase = wr_ + (size_t)(256 * kq + 8 * kh) * 32 + i32;
#pragma unroll 1
        for (int hb = 0; hb < 2; ++hb) {
            float4 hv[8][2], lv[8][2]; float wv[8][8];
#pragma unroll
            for (int c = 0; c < 8; ++c) { const int cc = hb * 8 + c;
                { const uint4 hq = *(const uint4*)(hrow + 16 * cc); hv[c][0] = (float4){bflo(hq.x), bfhi(hq.x), bflo(hq.y), bfhi(hq.y)}; hv[c][1] = (float4){bflo(hq.z), bfhi(hq.z), bflo(hq.w), bfhi(hq.w)}; } lv[c][0] = *(const float4*)(lrow + 16 * cc); lv[c][1] = *(const float4*)(lrow + 16 * cc + 4);
#pragma unroll
                for (int r = 0; r < 8; ++r) wv[c][r] = wbase[(size_t)(16 * cc + r) * 32]; }
#pragma unroll
            for (int c = 0; c < 8; ++c) { const int cc = hb * 8 + c; float x[8];
                x[0] = hv[c][0].x * lv[c][0].x; x[1] = hv[c][0].y * lv[c][0].y; x[2] = hv[c][0].z * lv[c][0].z; x[3] = hv[c][0].w * lv[c][0].w;
                x[4] = hv[c][1].x * lv[c][1].x; x[5] = hv[c][1].y * lv[c][1].y; x[6] = hv[c][1].z * lv[c][1].z; x[7] = hv[c][1].w * lv[c][1].w;
                ss += hv[c][0].x * hv[c][0].x + hv[c][0].y * hv[c][0].y + hv[c][0].z * hv[c][0].z + hv[c][0].w * hv[c][0].w + hv[c][1].x * hv[c][1].x + hv[c][1].y * hv[c][1].y + hv[c][1].z * hv[c][1].z + hv[c][1].w * hv[c][1].w;
                uint4 o; o.x = cvtpk(x[0], x[1]); o.y = cvtpk(x[2], x[3]); o.z = cvtpk(x[4], x[5]); o.w = cvtpk(x[6], x[7]); *(uint4*)(xrow + 16 * cc) = o;
#pragma unroll
                for (int r = 0; r < 8; ++r) acc = __builtin_amdgcn_mfma_f32_32x32x2f32(x[r], wv[c][r], acc, 0, 0, 0); }
        }
        ss = pair_sum(ss);
        if (kh == 0) ssqp[wid * 32 + i32] = ss;
#pragma unroll
        for (int r = 0; r < 16; ++r) part[(wid * 32 + crow(r, kh)) * 33 + i32] = acc[r];
        __syncthreads();
        if (tid < 64) {
            const int g_ = tid >> 5, i_ = tid & 31; const int w0_ = g_ * 4;
            const float sq = ssqp[(w0_ + 0) * 32 + i_] + ssqp[(w0_ + 1) * 32 + i_] + ssqp[(w0_ + 2) * 32 + i_] + ssqp[(w0_ + 3) * 32 + i_]; const float rstd = rsqrtf(sq * (1.f / 1024.f) + EPS);
            RSTD2[item * 64 + tid] = rstd; trs[tid] = rstd;
            float lg[32];
#pragma unroll
            for (int e = 0; e < 32; ++e) lg[e] = (part[((w0_ + 0) * 32 + i_) * 33 + e] + part[((w0_ + 1) * 32 + i_) * 33 + e] + part[((w0_ + 2) * 32 + i_) * 33 + e] + part[((w0_ + 3) * 32 + i_) * 33 + e]) * rstd + br[e];
            unsigned taken = 0u; float tv[4]; int ti[4];
#pragma unroll
            for (int k = 0; k < 4; ++k) { float best = -3.0e38f; int bi = 0;
#pragma unroll
                for (int e = 0; e < 32; ++e) { const bool ok = !((taken >> e) & 1u) && lg[e] > best; best = ok ? lg[e] : best; bi = ok ? e : bi; }
                taken |= 1u << bi; tv[k] = best; ti[k] = bi; }
            const float e1 = __expf(tv[1] - tv[0]), e2 = __expf(tv[2] - tv[0]), e3 = __expf(tv[3] - tv[0]); const float inv = 1.0f / (1.0f + e1 + e2 + e3);
            const float wv[4] = {inv, e1 * inv, e2 * inv, e3 * inv};
#pragma unroll
            for (int k = 0; k < 4; ++k) { const int idx = tid * 4 + k; te[idx] = ti[k]; trk[idx] = atomicAdd(&lcnt[ti[k]], 1); tw[idx] = wv[k]; }
        }
        __syncthreads();
        if (tid < 32) lbase[tid] = atomicAdd(&CNT[tid], lcnt[tid]);
        __syncthreads();
        if (tid < 256) { const int idx = tid; const int tk = item * 64 + (idx >> 2); const int e = te[idx]; const int slot = lbase[e] + trk[idx];
          TOPI[(size_t)tk * 4 + (idx & 3)] = e; TOPS[(size_t)tk * 4 + (idx & 3)] = slot; TOPW[(size_t)tk * 4 + (idx & 3)] = tw[idx];
          TOKOF[(size_t)e * 16384 + slot] = tk; ROWW[(size_t)e * 16384 + slot] = tw[idx]; RSDS[(size_t)e * 16384 + slot] = trs[idx >> 2]; }
        __syncthreads();
    }
}

struct MoeMap { int e, mt, nt, cnt, off; };
DEV void moe_setup(const Args& a, int* sm) {
    if (TID() == 0) { const int* CNT = (const int*)(a.ws + WS_CTL); int tot = 0; for (int e = 0; e < 32; ++e) { const int c = CNT[e]; const int mt = (c + 255) >> 8; sm[e] = mt; sm[32 + e] = tot; tot += mt; } sm[64] = tot; }
    __syncthreads();
}
DEV MoeMap moe_map(const Args& a, const int* sm, int item, int NT) {
    MoeMap mm; int e = 0;
#pragma unroll 1
    for (int i = 1; i < 32; ++i) if (item >= sm[32 + i] * NT) e = i;
    const int local = item - sm[32 + e] * NT; const int mte = sm[e];
    int mt_, nt_; patch_decode(local, mte, NT, mt_, nt_);
    mm.e = __builtin_amdgcn_readfirstlane(e); mm.mt = __builtin_amdgcn_readfirstlane(mt_); mm.nt = __builtin_amdgcn_readfirstlane(nt_);
    mm.cnt = __builtin_amdgcn_readfirstlane(((const int*)(a.ws + WS_CTL))[e]); mm.off = __builtin_amdgcn_readfirstlane(sm[32 + e] * 256); return mm;
}
DEV int moe_maps_build(const Args& a, const int* sm, int* maps, int nitems, int NT) {
    const int tid = TID(); const int first = VBID(); const int nmine = first < nitems ? (nitems - first + (int)gridDim.x - 1) / (int)gridDim.x : 0;
    for (int k = tid; k < nmine && k < 64; k += NTHR) { const int item = first + k * (int)gridDim.x; int e = 0;
#pragma unroll 1
        for (int i = 1; i < 32; ++i) if (item >= sm[32 + i] * NT) e = i;
        const int local = item - sm[32 + e] * NT; int mt_, nt_; patch_decode(local, sm[e], NT, mt_, nt_);
        maps[k * 8] = e; maps[k * 8 + 1] = mt_; maps[k * 8 + 2] = nt_; maps[k * 8 + 3] = ((const int*)(a.ws + WS_CTL))[e]; maps[k * 8 + 4] = sm[32 + e] * 256; }
    __syncthreads();
    return nmine < 64 ? nmine : 64;
}
DEV MoeMap moe_get(const int* maps, int k) { MoeMap mm; mm.e = __builtin_amdgcn_readfirstlane(maps[k * 8]); mm.mt = __builtin_amdgcn_readfirstlane(maps[k * 8 + 1]); mm.nt = __builtin_amdgcn_readfirstlane(maps[k * 8 + 2]);
    mm.cnt = __builtin_amdgcn_readfirstlane(maps[k * 8 + 3]); mm.off = __builtin_amdgcn_readfirstlane(maps[k * 8 + 4]); return mm; }
DEV void phase_up(const Args& a, unsigned char* smem) {
    int* sm = (int*)(smem + MISC_OFF); int* maps = (int*)(smem + MISC_OFF + 8192); int* tokb = maps + 512; float* rsdb = (float*)(tokb + 768); float* biab = rsdb + 768;
    static_assert(8192 + (512 + 3 * 768) * 4 <= 8192 + 12288, "misc LDS");
    const bf16_t* XN = (const bf16_t*)(a.ws + WS_XN); const bf16_t* W = (const bf16_t*)(a.ws + WS_WUP); bf16_t* ACT = (bf16_t*)(a.ws + WS_ACT); const float* RSDS = (const float*)(a.ws + WS_RSDS);
    const int* TOKOF = (const int*)(a.ws + WS_TOKOF); const float* bup = a.in[I_BUP];
    const int tid = TID(); int lane = tid & 63, wid = tid >> 6, wr = wid >> 2, wc = wid & 3; (void)wr; (void)wc; (void)lane;
    moe_setup(a, sm);
    const int nitems = __builtin_amdgcn_readfirstlane(sm[64]) * 8;
    const int nmine = __builtin_amdgcn_readfirstlane(moe_maps_build(a, sm, maps, nitems, 8));
    int tkr = 0; float rsr = 0.f, bir = 0.f;
    const int t8 = tid & 255;
    auto side_load = [&](const MoeMap& m_) { const int slot = m_.mt * 256 + t8; const bool ok = slot < m_.cnt; const size_t sl_ = (size_t)m_.e * 16384 + (ok ? slot : 0); const int tk_ = TOKOF[sl_]; const float rs_ = RSDS[sl_]; tkr = ok ? tk_ : 0; rsr = ok ? rs_ : 0.f;
        bir = bup[(size_t)m_.e * 2048 + (t8 < 128 ? m_.nt * 128 + t8 : 1024 + m_.nt * 128 + t8 - 128)]; };
    auto side_store = [&](int slot3) { tokb[slot3 * 256 + t8] = tkr; rsdb[slot3 * 256 + t8] = rsr; biab[slot3 * 256 + t8] = bir; };
    auto boffu = [](int k, int nc) { const int sc = ((nc >> 4) ? 1024 : 0) + (nc & 15) * 8; return (unsigned)(k * 4096 + sc * 2); };
    MoeMap mm{}, mn{};
    if (nmine > 0) { mm = moe_get(maps, 0); side_load(mm); side_store(0); }
    if (nmine > 1) { mn = moe_get(maps, 1); side_load(mn); side_store(1); }
    __syncthreads();
    bool pre = false;
    for (int k = 0; k < nmine; ++k) {
        const bool has_next = k + 1 < nmine, has_nn = k + 2 < nmine;
        { const MoeMap m2 = moe_get(maps, has_nn ? k + 2 : nmine - 1); side_load(m2); }
        const int s0 = k % 3, s1 = (k + 1) % 3, s2 = (k + 2) % 3;
        const int* tok = tokb + s0 * 256; const int* tokn = tokb + s1 * 256; const float* rsd = rsdb + s0 * 256; const float* bia = biab + s0 * 256;
        const bf16_t* We = W + (size_t)mm.e * 1024 * 2048; const bf16_t* Wn = W + (size_t)mn.e * 1024 * 2048;
        f32x4 acc[8][4];
        gemm256<true>(smem, 16, XN, 128u, [&](int r, int kc) { return (unsigned)(tok[r] * 2048 + kc * 16); }, We + mm.nt * 128, 64u * 4096u, boffu, acc, pre,
                      next_tile(has_next, smem, XN, [&](int r, int kc) { return (unsigned)(tokn[r] * 2048 + kc * 16); }, Wn + mn.nt * 128, boffu));
        side_store(s2);
        EPI_IDS();
        float bgv[2][4], blv[2][4];
#pragma unroll
        for (int ni = 0; ni < 2; ++ni) { const int jl = wc * 32 + ni * 16 + 4 * (lane >> 4); const float4 bg = *(const float4*)(bia + jl), bl_ = *(const float4*)(bia + 128 + jl);
            bgv[ni][0] = bg.x; bgv[ni][1] = bg.y; bgv[ni][2] = bg.z; bgv[ni][3] = bg.w; blv[ni][0] = bl_.x; blv[ni][1] = bl_.y; blv[ni][2] = bl_.z; blv[ni][3] = bl_.w; }
#pragma unroll
        for (int mi = 0; mi < 8; ++mi) { const int rl_ = G_ROW(mi); const size_t row = (size_t)mm.off + mm.mt * 256 + rl_; const float rs_ = rsd[rl_];
            uint2 o2[2];
#pragma unroll
            for (int ni = 0; ni < 2; ++ni) {
                const f32x4 gv = acc[mi][ni], lv = acc[mi][ni + 2]; float r4[4];
#pragma unroll
                for (int r = 0; r < 4; ++r) { const float gg = fminf(gv[r] * rs_ + bgv[ni][r], 7.0f); const float ll = fminf(fmaxf(lv[r] * rs_ + blv[ni][r], -7.0f), 7.0f); r4[r] = gg * sigmoidf_(1.702f * gg) * (ll + 1.0f); }
                o2[ni].x = cvtpk(r4[0], r4[1]); o2[ni].y = cvtpk(r4[2], r4[3]); }
            { const int c0 = wc * 32 + 4 * (lane >> 4); *(uint4*)(ACT + row * 1024 + mm.nt * 128 + PAIR16_COL(c0, c0 + 16)) = pair16(o2[0], o2[1]); } }
        lds_barrier();
        mm = mn; if (has_nn) mn = moe_get(maps, k + 2); pre = has_next;
    }
}
DEV void phase_down(const Args& a, unsigned char* smem) {
    int* sm = (int*)(smem + MISC_OFF); int* maps = (int*)(smem + MISC_OFF + 8192); float* rwb = (float*)(maps + 512); float* biab = rwb + 768;
    const bf16_t* ACT = (const bf16_t*)(a.ws + WS_ACT); const bf16_t* W = (const bf16_t*)(a.ws + WS_WDN); bf16_t* Y = (bf16_t*)(a.ws + WS_Y);
    const float* ROWW = (const float*)(a.ws + WS_ROWW); const float* bdn = a.in[I_BDN];
    const int tid = TID(); int lane = tid & 63, wid = tid >> 6, wr = wid >> 2, wc = wid & 3; (void)wr; (void)wc; (void)lane;
    moe_setup(a, sm);
    const int nitems = __builtin_amdgcn_readfirstlane(sm[64]) * 4;
    const int nmine = __builtin_amdgcn_readfirstlane(moe_maps_build(a, sm, maps, nitems, 4));
    float rwr = 0.f, bir = 0.f;
    const int t8 = tid & 255;
    auto side_load = [&](const MoeMap& m_) { const int slot = m_.mt * 256 + t8; const bool ok = slot < m_.cnt; const float rw_ = ROWW[(size_t)m_.e * 16384 + (ok ? slot : 0)]; rwr = ok ? rw_ : 0.f; bir = bdn[(size_t)m_.e * 1024 + m_.nt * 256 + t8]; };
    auto side_store = [&](int slot3) { rwb[slot3 * 256 + t8] = rwr; biab[slot3 * 256 + t8] = bir; };
    auto aoffd = [](int r, int kc) { return (unsigned)(r * 2048 + kc * 16); }; auto boffd = [](int k, int nc) { return (unsigned)(k * 2048 + nc * 16); };
    MoeMap mm{}, mn{};
    if (nmine > 0) { mm = moe_get(maps, 0); side_load(mm); side_store(0); }
    if (nmine > 1) { mn = moe_get(maps, 1); side_load(mn); side_store(1); }
    __syncthreads();
    bool pre = false;
    for (int k = 0; k < nmine; ++k) {
        const bool has_next = k + 1 < nmine, has_nn = k + 2 < nmine;
        { const MoeMap m2 = moe_get(maps, has_nn ? k + 2 : nmine - 1); side_load(m2); }
        const int s0 = k % 3, s2 = (k + 2) % 3;
        const float* rw = rwb + s0 * 256; const float* bia = biab + s0 * 256;
        const bf16_t* We = W + (size_t)mm.e * 1024 * 1024; const bf16_t* Ab = ACT + ((size_t)mm.off + mm.mt * 256) * 1024;
        const bf16_t* Wn = W + (size_t)mn.e * 1024 * 1024; const bf16_t* An = ACT + ((size_t)mn.off + mn.mt * 256) * 1024;
        f32x4 acc[8][4];
        gemm256<true>(smem, 16, Ab, 128u, aoffd, We + mm.nt * 256, 64u * 2048u, boffd, acc, pre,
                      next_tile(has_next, smem, An, aoffd, Wn + mn.nt * 256, boffd));
        side_store(s2);
        EPI_IDS();
        float4 bb[4];
#pragma unroll
        for (int ni = 0; ni < 4; ++ni) bb[ni] = *(const float4*)(bia + G_COL(ni));
#pragma unroll
        for (int mi = 0; mi < 8; ++mi) { const int rl = G_ROW(mi); const size_t row = (size_t)mm.off + mm.mt * 256 + rl; const float w = rw[rl];
#pragma unroll
            for (int np = 0; np < 2; ++np) { uint2 o2[2];
#pragma unroll
                for (int h = 0; h < 2; ++h) { const int ni = 2 * np + h; const f32x4 v = acc[mi][ni]; o2[h].x = cvtpk((v[0] + bb[ni].x) * w, (v[1] + bb[ni].y) * w); o2[h].y = cvtpk((v[2] + bb[ni].z) * w, (v[3] + bb[ni].w) * w); }
                *(uint4*)(Y + row * 1024 + mm.nt * 256 + PAIR16_COL(G_COL(2 * np), G_COL(2 * np + 1))) = pair16(o2[0], o2[1]); } }
        lds_barrier();
        mm = mn; if (has_nn) mn = moe_get(maps, k + 2); pre = has_next;
    }
}

DEV void phase_comb(const Args& a, unsigned char* smem) {
    int* sm = (int*)(smem + MISC_OFF);
    moe_setup(a, sm);
    bf16_t* H1 = (bf16_t*)(a.ws + WS_H1); bf16_t* XN = (bf16_t*)(a.ws + WS_XN); const bf16_t* Y = (const bf16_t*)(a.ws + WS_Y);
    const int* TOPI = (const int*)(a.ws + WS_TOPI); const int* TOPS = (const int*)(a.ws + WS_TOPS); const float* g = a.in[I_LNPLE];
    const int lane = TID() & 63; const int gw = BID() * NWAVE + (TID() >> 6), ngw = gridDim.x * NWAVE;
    for (int tok = gw; tok < NTOK; tok += ngw) {
        float4 v[4];
#pragma unroll
        for (int j = 0; j < 4; ++j) { const uint2 hq = *(const uint2*)(H1 + (size_t)tok * 1024 + j * 256 + lane * 4); v[j] = (float4){bflo(hq.x), bfhi(hq.x), bflo(hq.y), bfhi(hq.y)}; }
#pragma unroll
        for (int k = 0; k < 4; ++k) { const int e = TOPI[(size_t)tok * 4 + k]; const size_t row = (size_t)sm[32 + e] * 256 + TOPS[(size_t)tok * 4 + k];
#pragma unroll
            for (int j = 0; j < 4; ++j) { const uint2 u = *(const uint2*)(Y + row * 1024 + j * 256 + lane * 4); v[j].x += bflo(u.x); v[j].y += bfhi(u.x); v[j].z += bflo(u.y); v[j].w += bfhi(u.y); } }
        float s = 0.f;
#pragma unroll
        for (int j = 0; j < 4; ++j) { { uint2 hq; hq.x = cvtpk(v[j].x, v[j].y); hq.y = cvtpk(v[j].z, v[j].w); *(uint2*)(H1 + (size_t)tok * 1024 + j * 256 + lane * 4) = hq; } s += v[j].x * v[j].x + v[j].y * v[j].y + v[j].z * v[j].z + v[j].w * v[j].w; }
        const float rstd = rsqrtf(wave_sum(s) * (1.f / 1024.f) + EPS);
#pragma unroll
        for (int j = 0; j < 4; ++j) { const float4 gg = *(const float4*)(g + j * 256 + lane * 4);
            uint2 o; o.x = cvtpk(v[j].x * rstd * gg.x, v[j].y * rstd * gg.y); o.y = cvtpk(v[j].z * rstd * gg.z, v[j].w * rstd * gg.w); *(uint2*)(XN + (size_t)tok * 1024 + j * 256 + lane * 4) = o; }
    }
}

DEV void phase_gate(const Args& a, unsigned char* smem) {
    const bf16_t* XN = (const bf16_t*)(a.ws + WS_XN); const bf16_t* WG = (const bf16_t*)(a.ws + WS_WGATE); const bf16_t* PB = (const bf16_t*)(a.ws + WS_PB); const bf16_t* WP = (const bf16_t*)(a.ws + WS_WPLE);
    const bf16_t* H2 = (const bf16_t*)(a.ws + WS_H1); float* OUT = a.out; float* SSQ3 = (float*)(a.ws + WS_SSQ3);
    const int tid = TID(); int lane = tid & 63, wid = tid >> 6, wr = wid >> 2, wc = wid & 3; (void)wr; (void)wc; (void)lane;
    bf16_t* GT = (bf16_t*)(a.ws + WS_ACT);
    auto aoffg = [](int r, int kc) { return (unsigned)(r * 2048 + kc * 16); }; auto aoffp = [](int r, int kc) { return (unsigned)(r * 512 + kc * 16); }; auto boffg = [](int k, int nc) { return (unsigned)(k * 2048 + nc * 16); };
    for (int item = VBID(); item < 64 * 4; item += gridDim.x) {
        int mt, nt; patch_decode(item, 64, 4, mt, nt);
        f32x4 acc[8][4];
        gemm256<true>(smem, 16, XN + (size_t)mt * 256 * 1024, 128u, aoffg, WG + nt * 256, 64u * 2048u, boffg, acc, false,
                      next_tile(true, smem, PB + (size_t)mt * 256 * 256, aoffp, WP + nt * 256, boffg));
        EPI_IDS();
#pragma unroll
        for (int hb = 0; hb < 2; ++hb) {
            uint2 wq[4][4]; uint4 hq[4][2];
#pragma unroll
            for (int m4 = 0; m4 < 4; ++m4) { const int mi = hb * 4 + m4; const size_t gm = (size_t)mt * 256 + G_ROW(mi);
#pragma unroll
                for (int np = 0; np < 2; ++np) hq[m4][np] = *(const uint4*)(H2 + gm * 1024 + nt * 256 + PAIR16_COL(G_COL(2 * np), G_COL(2 * np + 1)));
#pragma unroll
                for (int ni = 0; ni < 4; ++ni) { const f32x4 v = acc[mi][ni];
                    uint2 w; w.x = cvtpk(sigmoidf_(v[0]), sigmoidf_(v[1])); w.y = cvtpk(sigmoidf_(v[2]), sigmoidf_(v[3])); wq[m4][ni] = w; } }
#pragma unroll
            for (int m4 = 0; m4 < 4; ++m4) { const int mi = hb * 4 + m4; const size_t gm = (size_t)mt * 256 + G_ROW(mi);
#pragma unroll
                for (int np = 0; np < 2; ++np) { uint2 h2[2]; unpair16(hq[m4][np], h2[0], h2[1]);
                    *(uint4*)(GT + gm * 1024 + nt * 256 + PAIR16_COL(G_COL(2 * np), G_COL(2 * np + 1))) = pair16(wq[m4][2 * np], wq[m4][2 * np + 1]);
#pragma unroll
                    for (int h = 0; h < 2; ++h) { const int ni = 2 * np + h; const uint2 w = wq[m4][ni]; const uint2 hh = h2[h];
                        acc[mi][ni] = (f32x4){bflo(hh.x) * __builtin_amdgcn_rcpf(bflo(w.x)), bfhi(hh.x) * __builtin_amdgcn_rcpf(bfhi(w.x)), bflo(hh.y) * __builtin_amdgcn_rcpf(bflo(w.y)), bfhi(hh.y) * __builtin_amdgcn_rcpf(bfhi(w.y))}; } } }
            asm volatile("" ::: "memory");
        }
        gemm256<false>(smem, 4, PB + (size_t)mt * 256 * 256, 128u, aoffp, WP + nt * 256, 64u * 2048u, boffg, acc, true);
        EPI_IDS();
        const bool fused = gridDim.x >= 256;
#pragma unroll
        for (int hb = 0; hb < 2; ++hb) {
            uint4 gq4[4][2];
#pragma unroll
            for (int m4 = 0; m4 < 4; ++m4) { const size_t gm = (size_t)mt * 256 + G_ROW(hb * 4 + m4);
#pragma unroll
                for (int np = 0; np < 2; ++np) gq4[m4][np] = *(const uint4*)(GT + gm * 1024 + nt * 256 + PAIR16_COL(G_COL(2 * np), G_COL(2 * np + 1))); }
#pragma unroll
            for (int m4 = 0; m4 < 4; ++m4) { const int mi = hb * 4 + m4; const size_t gm = (size_t)mt * 256 + G_ROW(mi); float ss = 0.f;
#pragma unroll
                for (int np = 0; np < 2; ++np) { uint2 g2[2]; unpair16(gq4[m4][np], g2[0], g2[1]);
#pragma unroll
                    for (int h = 0; h < 2; ++h) { const int ni = 2 * np + h; const int n = nt * 256 + G_COL(ni); const f32x4 v = acc[mi][ni]; const uint2 gw = g2[h];
                        float4 o = {v[0] * bflo(gw.x), v[1] * bfhi(gw.x), v[2] * bflo(gw.y), v[3] * bfhi(gw.y)};
                        if (!fused) *(float4*)(OUT + gm * 1024 + n) = o;
                        acc[mi][ni] = (f32x4){o.x, o.y, o.z, o.w};
                        ss += o.x * o.x + o.y * o.y + o.z * o.z + o.w * o.w; } }
                ss += __shfl_xor(ss, 16); ss += __shfl_xor(ss, 32);
                if (lane < 16) SSQ3[gm * 16 + nt * 4 + wc] = ss; }
            asm volatile("" ::: "memory");
        }
        if (fused) {
            unsigned* flag = (unsigned*)(a.ws + WS_CTL) + CW_GATEFLAG + mt;
            const float* lnf = a.in[I_LNF]; float4 gg[4];
#pragma unroll
            for (int ni = 0; ni < 4; ++ni) gg[ni] = *(const float4*)(lnf + nt * 256 + G_COL(ni));
            signal_done(flag); wait_flag(flag, 4u);
            float rstd[8];
#pragma unroll
            for (int mi = 0; mi < 8; ++mi) { const size_t gm = (size_t)mt * 256 + G_ROW(mi); const float4 s0 = *(const float4*)(SSQ3 + gm * 16 + 4 * (lane >> 4)); rstd[mi] = (s0.x + s0.y) + (s0.z + s0.w); }
#pragma unroll
            for (int mi = 0; mi < 8; ++mi) { float t_ = rstd[mi]; t_ += __shfl_xor(t_, 16); t_ += __shfl_xor(t_, 32); rstd[mi] = rsqrtf(t_ * (1.f / 1024.f) + EPS); }
#pragma unroll
            for (int mi = 0; mi < 8; ++mi) { const size_t gm = (size_t)mt * 256 + G_ROW(mi);
#pragma unroll
                for (int ni = 0; ni < 4; ++ni) { const int n = nt * 256 + G_COL(ni); const f32x4 v = acc[mi][ni]; const float r_ = rstd[mi];
                    float4 o = {v[0] * r_ * gg[ni].x, v[1] * r_ * gg[ni].y, v[2] * r_ * gg[ni].z, v[3] * r_ * gg[ni].w}; *(float4*)(OUT + gm * 1024 + n) = o; } }
        }
        __syncthreads();
    }
}

DEV void phase_final(const Args& a) {
    if (gridDim.x >= 256) return;
    float* OUT = a.out; const float* SSQ3 = (const float*)(a.ws + WS_SSQ3); const float* g = a.in[I_LNF];
    const int lane = TID() & 63; const int gw = BID() * NWAVE + (TID() >> 6), ngw = gridDim.x * NWAVE;
    for (int m = gw; m < NTOK; m += ngw) {
        float s = 0.f;
#pragma unroll
        for (int j = 0; j < 16; ++j) s += SSQ3[(size_t)m * 16 + j];
        const float rstd = rsqrtf(s * (1.f / 1024.f) + EPS);
#pragma unroll
        for (int j = 0; j < 4; ++j) { float4 v = *(const float4*)(OUT + (size_t)m * 1024 + j * 256 + lane * 4); const float4 gg = *(const float4*)(g + j * 256 + lane * 4);
            v.x *= rstd * gg.x; v.y *= rstd * gg.y; v.z *= rstd * gg.z; v.w *= rstd * gg.w; *(float4*)(OUT + (size_t)m * 1024 + j * 256 + lane * 4) = v; }
    }
}

template <int PH> DEV void run_phase(const Args& a, unsigned char* smem) {
    if constexpr (PH == PH_PRO) phase_prologue(a, smem);
    else if constexpr (PH == PH_INPROJ) phase_inproj(a, smem);
    else if constexpr (PH == PH_ATT) phase_att(a, smem);
    else if constexpr (PH == PH_OUTPROJ) phase_outproj(a, smem);
    else if constexpr (PH == PH_ROUTE) phase_route(a, smem);
    else if constexpr (PH == PH_UP) phase_up(a, smem);
    else if constexpr (PH == PH_DOWN) phase_down(a, smem);
    else if constexpr (PH == PH_COMB) phase_comb(a, smem);
    else if constexpr (PH == PH_GATE) phase_gate(a, smem);
    else if constexpr (PH == PH_FINAL) phase_final(a);
}
#define XB_TMO      128
#define XB_XCNT(j)  (256  + 64 * (j))
#define XB_XSUB(j)  (1280 + 64 * (j))
#define XB_XGEN(j)  (2304 + 64 * (j))
#define XB_TOP      3328
#define XB_TOPGEN   3392
#define XCD_BAR_WORDS 3456
#define XB_SPIN_CAP (1u << 22)
DEV unsigned xb_ld(unsigned* p)              { return __hip_atomic_load(p, __ATOMIC_RELAXED, __HIP_MEMORY_SCOPE_AGENT); }
DEV unsigned xb_add(unsigned* p, unsigned v) { return __hip_atomic_fetch_add(p, v, __ATOMIC_RELAXED, __HIP_MEMORY_SCOPE_AGENT); }
DEV unsigned xb_xcc_id() { return (unsigned)__builtin_amdgcn_s_getreg((3 << 11) | 20) & 0xFu; }
#define XB_SPIN(cond, bar) do { unsigned _sp = 0; while (cond) { __builtin_amdgcn_s_sleep(1); \
    if ((++_sp & 255u) == 0u) { if (xb_ld(&(bar)[XB_TMO])) break; if (_sp > XB_SPIN_CAP) { atomicAdd(&(bar)[XB_TMO], 1u); break; } } } } while (0)
struct XcdBarrier { unsigned* bar; unsigned x; volatile LAS unsigned* st; };
DEV XcdBarrier xcd_barrier_post(unsigned* bar, volatile LAS unsigned* st) {
    XcdBarrier b; b.bar = bar; b.x = xb_xcc_id(); b.st = st;
    if (TID() == 0) (void)xb_add(&bar[XB_XCNT(b.x)], 1u);
    return b;
}
DEV void xcd_barrier_complete(unsigned* bar, unsigned x, unsigned& nloc, unsigned& nx) {
    const unsigned G = gridDim.x * gridDim.y * gridDim.z;
    unsigned sum, cnt, mine, sp = 0u;
    for (;;) {
        sum = 0u; cnt = 0u; mine = 0u;
#pragma unroll
        for (unsigned j = 0; j < 16; ++j) { const unsigned c = xb_ld(&bar[XB_XCNT(j)]); sum += c; cnt += (c > 0u) ? 1u : 0u; mine = (j == x) ? c : mine; }
        if (sum == G) break;
        __builtin_amdgcn_s_sleep(1);
        if ((++sp & 255u) == 0u) { if (xb_ld(&bar[XB_TMO])) break; if (sp > XB_SPIN_CAP) { atomicAdd(&bar[XB_TMO], 1u); break; } }
    }
    nloc = mine > 0u ? mine : 1u; nx = cnt > 0u ? cnt : 1u;
}
DEV void xcd_barrier(const XcdBarrier& b) {
    asm volatile("s_waitcnt vmcnt(0)" ::: "memory");
    __syncthreads();
    if (TID() == 0) {
        unsigned* bar = b.bar;
        __builtin_amdgcn_s_waitcnt(0);
        unsigned nloc = b.st[0], nx = b.st[1];
        if (nloc == 0u) { xcd_barrier_complete(bar, b.x, nloc, nx); b.st[0] = nloc; b.st[1] = nx; }
        const unsigned old = xb_add(&bar[XB_XSUB(b.x)], 1u);
        const unsigned gen = old / nloc;
        if (old + 1u == (gen + 1u) * nloc) {
            __builtin_amdgcn_fence(__ATOMIC_RELEASE, "agent");
            asm volatile("s_waitcnt vmcnt(0)" ::: "memory");
            const unsigned og = xb_add(&bar[XB_TOP], 1u);
            const unsigned tg = og / nx;
            if (og + 1u == (tg + 1u) * nx) xb_add(&bar[XB_TOPGEN], 1u);
            else XB_SPIN(xb_ld(&bar[XB_TOPGEN]) == tg, bar);
            __builtin_amdgcn_fence(__ATOMIC_ACQUIRE, "agent");
            xb_add(&bar[XB_XGEN(b.x)], 1u);
            asm volatile("s_waitcnt vmcnt(0)" ::: "memory");
        } else {
            XB_SPIN(xb_ld(&bar[XB_XGEN(b.x)]) == gen, bar);
            __builtin_amdgcn_fence(__ATOMIC_ACQUIRE, "agent");
            asm volatile("s_waitcnt vmcnt(0)" ::: "memory");
        }
    }
    __syncthreads();
}

__global__ void __launch_bounds__(NTHR, 2) mega(Args a) {
    extern __shared__ __attribute__((aligned(16))) unsigned char smem[];
    volatile LAS unsigned* bst = (volatile LAS unsigned*)(LAS unsigned char*)(smem + MISC_OFF + 8000);
    if (TID() == 0) { bst[0] = 0u; bst[1] = 0u; }
    __syncthreads();
    const XcdBarrier bar = xcd_barrier_post((unsigned*)(a.ws + WS_CTL) + 4096, bst);
#define GSYNC() xcd_barrier(bar)
#define RUN(ph) do { run_phase<ph>(a, smem); if ((PROBE_DUP >> ph) & 1) { GSYNC(); run_phase<ph>(a, smem); } } while (0)
    RUN(PH_PRO); GSYNC();
    RUN(PH_INPROJ); GSYNC();
    RUN(PH_ATT); GSYNC();
    RUN(PH_OUTPROJ); GSYNC();
    RUN(PH_ROUTE); GSYNC();
    RUN(PH_UP); GSYNC();
    RUN(PH_DOWN); GSYNC();
    RUN(PH_COMB); GSYNC();
    RUN(PH_GATE);
    if (gridDim.x < 256) { GSYNC(); RUN(PH_FINAL); }
#undef RUN
#undef GSYNC
}

extern "C" void kernel_launch(void* const* d_in, const int* in_sizes, int n_in, void* d_out, int out_size, void* d_ws, size_t ws_size, hipStream_t stream) {
    static int grid = 0;
    if (grid == 0) {
        if (n_in != 25 || ws_size < WS_END) { fprintf(stderr, "kernel_launch: unexpected n_in %d / ws %zu\n", n_in, ws_size); grid = -1; return; }
        int dev = 0, cus = 0, per_cu = 0;
        (void)hipGetDevice(&dev); (void)hipDeviceGetAttribute(&cus, hipDeviceAttributeMultiprocessorCount, dev);
        (void)hipFuncSetAttribute((const void*)mega, hipFuncAttributeMaxDynamicSharedMemorySize, LDS_BYTES);
        (void)hipOccupancyMaxActiveBlocksPerMultiprocessor(&per_cu, (const void*)mega, NTHR, LDS_BYTES);
        if (per_cu < 1) { fprintf(stderr, "kernel_launch: occupancy query says %d blocks per CU\n", per_cu); grid = -1; return; }
        grid = cus;
    }
    if (grid < 0) return;
    (void)hipMemsetAsync((char*)d_ws + WS_CTL, 0, 65536, stream);
    Args a{};
    for (int i = 0; i < 25; ++i) a.in[i] = (const float*)d_in[i];
    a.out = (float*)d_out; a.ws = (unsigned char*)d_ws; a.ph_lo = 0; a.ph_hi = PH_N;
    void* args[] = {&a};
    hipError_t e = hipLaunchCooperativeKernel((const void*)mega, dim3(grid), dim3(NTHR), args, LDS_BYTES, stream);
    if (e != hipSuccess) fprintf(stderr, "cooperative launch failed: %s (grid %d)\n", hipGetErrorString(e), grid);
}
```

```cpp
#include <hip/hip_runtime.h>
#include <stdint.h>
#include <cstdio>

#define DEV __device__ __forceinline__
#define LAS __attribute__((address_space(3)))

typedef unsigned short bf16_t;
typedef short bf16x8 __attribute__((ext_vector_type(8)));
typedef short s16x4 __attribute__((ext_vector_type(4)));
typedef float f32x4 __attribute__((ext_vector_type(4)));
typedef float f32x16 __attribute__((ext_vector_type(16)));
typedef float f32x2_t __attribute__((ext_vector_type(2)));
typedef __bf16 bf16x2_t __attribute__((ext_vector_type(2)));

constexpr int NTHR = 512, NWAVE = 8;
constexpr int NTOK = 16384;
constexpr float EPS = 1e-6f;
constexpr float LOG2E = 1.4426950408889634f;
constexpr float QS = 0.125f * LOG2E;
constexpr int NWIN = 3072;

constexpr size_t MiB = 1u << 20;
constexpr size_t WS_CTL = 0;
constexpr size_t WS_WIN = 1 * MiB;
constexpr size_t WS_WOUT = 7 * MiB;
constexpr size_t WS_WGATE = 9 * MiB;
constexpr size_t WS_WPLE = 11 * MiB;
constexpr size_t WS_WC1 = 12 * MiB;
constexpr size_t WS_WC2 = 15 * MiB + 512 * 1024 + 262144;
constexpr size_t WS_BIAS1 = 15 * MiB + 512 * 1024 + 262144 + 131072;
constexpr size_t WS_KC = 14 * MiB;
constexpr size_t WS_HID = 14 * MiB + 512 * 1024;
constexpr size_t WS_GN = 16 * MiB;
constexpr size_t WS_LS = 18 * MiB;
constexpr size_t WS_CUM = 19 * MiB;
constexpr size_t WS_SSQ = 20 * MiB;
constexpr size_t WS_TOPI = 21 * MiB;
constexpr size_t WS_TOPS = 21 * MiB + 262144;
constexpr size_t WS_TOPW = 21 * MiB + 524288;
constexpr size_t WS_TOKOF = 22 * MiB;
constexpr size_t WS_ROWW = 24 * MiB;
constexpr size_t WS_SSQ3 = 26 * MiB;
constexpr size_t WS_RSTD2 = 27 * MiB;
constexpr size_t WS_ONE = 27 * MiB + 131072;
constexpr size_t WS_RSTD3 = 27 * MiB + 65536;
constexpr size_t WS_PB = 28 * MiB;
constexpr size_t WS_XN = 36 * MiB;
constexpr size_t WS_PROJ = 68 * MiB;
constexpr size_t WS_ONSA = 160 * MiB;
constexpr size_t WS_OFOX = 176 * MiB;
constexpr size_t WS_H1 = 192 * MiB;
constexpr size_t WS_WUP = 256 * MiB;
constexpr size_t WS_WDN = 384 * MiB;
constexpr size_t WS_ACT = 448 * MiB;
constexpr size_t WS_Y = 592 * MiB;
constexpr size_t WS_RSDS = 736 * MiB;
constexpr size_t WS_END = 738 * MiB;

enum { PH_PRO = 0, PH_INPROJ, PH_CMP, PH_ATT, PH_OUTPROJ, PH_ROUTE, PH_UP, PH_DOWN, PH_COMB, PH_GATE, PH_FINAL, PH_N };
struct Args { const float* in[25]; float* out; unsigned char* ws; int ph_lo, ph_hi; };
enum { I_X = 0, I_P, I_LN1, I_WIN, I_BFG, I_WC1K, I_WC2K, I_PEK, I_WC1V, I_WC2V, I_PEV, I_GNN, I_GNF, I_WOUT, I_LN2, I_WR, I_BR,
       I_WUP, I_BUP, I_WDN, I_BDN, I_LNPLE, I_WPLE, I_WGATE, I_LNF };

DEV int BID() { int b = (int)blockIdx.x; asm volatile("" : "+s"(b)); return b; }
DEV int VBID() { const int g = (int)gridDim.x, b = BID(); return (g & 7) ? b : (b & 7) * (g >> 3) + (b >> 3); }
DEV int TID() { int t = (int)__builtin_amdgcn_workitem_id_x(); asm volatile("" : "+v"(t)); return t; }
DEV unsigned cvtpk(float lo, float hi) { f32x2_t v = {lo, hi}; bf16x2_t b = __builtin_convertvector(v, bf16x2_t); return __builtin_bit_cast(unsigned, b); }
DEV float bflo(unsigned u) { return __uint_as_float(u << 16); }
DEV float bfhi(unsigned u) { return __uint_as_float(u & 0xffff0000u); }
DEV float wave_sum(float v) {
#pragma unroll
    for (int o = 1; o < 64; o <<= 1) v += __shfl_xor(v, o);
    return v;
}
#define DPP_MOV(x, ctrl) __builtin_bit_cast(float, __builtin_amdgcn_update_dpp(0, __builtin_bit_cast(int, (x)), (ctrl), 0xF, 0xF, true))
DEV float pair_sum(float x) { return x + __shfl_xor(x, 32); }
DEV float pair_max(float x) { return fmaxf(x, __shfl_xor(x, 32)); }
DEV float quad_sum(float x) { x += DPP_MOV(x, 0xB1); x += DPP_MOV(x, 0x4E); return x; }
DEV float wave_max_u(float x) {
    x = fmaxf(x, DPP_MOV(x, 0xB1)); x = fmaxf(x, DPP_MOV(x, 0x4E)); x = fmaxf(x, DPP_MOV(x, 0x141)); x = fmaxf(x, DPP_MOV(x, 0x140));
    const float a = __builtin_bit_cast(float, __builtin_amdgcn_readlane(__builtin_bit_cast(int, x), 0)), b = __builtin_bit_cast(float, __builtin_amdgcn_readlane(__builtin_bit_cast(int, x), 16));
    const float c = __builtin_bit_cast(float, __builtin_amdgcn_readlane(__builtin_bit_cast(int, x), 32)), d = __builtin_bit_cast(float, __builtin_amdgcn_readlane(__builtin_bit_cast(int, x), 48));
    return fmaxf(fmaxf(a, b), fmaxf(c, d));
}
DEV float sigmoidf_(float x) { return __builtin_amdgcn_rcpf(1.0f + __expf(-x)); }
DEV float logsigmoidf_(float x) { return fminf(x, 0.f) - log1pf(__expf(-fabsf(x))); }
DEV float gelu_tanh(float x) { const float u = 0.7978845608028654f * (x + 0.044715f * x * x * x); const float th = 1.0f - 2.0f * __builtin_amdgcn_rcpf(__expf(2.0f * u) + 1.0f); return 0.5f * x * (1.0f + th); }
DEV s16x4 tr_read(const unsigned char* p) {
    typedef short v4i16_t __attribute__((ext_vector_type(4)));
    return __builtin_bit_cast(s16x4, __builtin_amdgcn_ds_read_tr16_b64_v4i16((LAS v4i16_t*)p));
}
DEV s16x4 tr_read_l(unsigned lds_addr) {
    typedef short v4i16_t __attribute__((ext_vector_type(4)));
    return __builtin_bit_cast(s16x4, __builtin_amdgcn_ds_read_tr16_b64_v4i16((LAS v4i16_t*)(uintptr_t)lds_addr));
}
DEV int crow(int r, int hi) { return (r & 3) + 8 * (r >> 2) + 4 * hi; }

constexpr int GL_STAGE = 65536;
constexpr int GEMM_LDS = 2 * GL_STAGE;
constexpr int MISC_OFF = GEMM_LDS;
constexpr int LDS_BYTES = GEMM_LDS + 8192 + 12288;

DEV void glds16s(const void* sbase, unsigned voff, unsigned lds_dst) { unsigned keep;
    asm volatile("s_mov_b32 %0, m0\n\ts_mov_b32 m0, %3\n\ts_nop 0\n\tglobal_load_lds_dwordx4 %1, %2\n\ts_mov_b32 m0, %0" : "=&s"(keep) : "v"(voff), "s"(sbase), "s"(lds_dst) : "memory"); }

DEV const unsigned char* uptr(const void* p) { const unsigned long long v = (unsigned long long)p; const unsigned lo = __builtin_amdgcn_readfirstlane((unsigned)v), hi = __builtin_amdgcn_readfirstlane((unsigned)(v >> 32)); return (const unsigned char*)(((unsigned long long)hi << 32) | lo); }

DEV void lds_barrier() { asm volatile("s_waitcnt lgkmcnt(0)\n\ts_barrier" ::: "memory"); }

struct NoNextS { DEV void operator()() const {} };
template <class AO, class BO>
DEV void gemm256s_issue0(unsigned char* smem, const void* abase, const AO& aoff, const void* bbase, const BO& boff) {
    const int tid = TID(), lane = tid & 63; const int wid = __builtin_amdgcn_readfirstlane(tid >> 6);
    const unsigned lds0 = (unsigned)(uintptr_t)smem; const unsigned char* ab_ = uptr(abase); const unsigned char* bb_ = uptr(bbase);
#pragma unroll
    for (int i = 0; i < 4; ++i) { const int p = wid + 8 * i; glds16s(ab_, aoff(8 * p + (lane >> 3), (lane & 7) ^ (lane >> 3)), (unsigned)__builtin_amdgcn_readfirstlane(lds0 + p * 1024)); }
#pragma unroll
    for (int i = 0; i < 4; ++i) { const int p = wid + 8 * i; const int k = 2 * p + (lane >> 5); const int f = (k & 3) + 4 * ((k >> 3) & 1);
        glds16s(bb_, boff(k, (lane & 31) ^ (f << 1)), (unsigned)__builtin_amdgcn_readfirstlane(lds0 + 32768 + p * 1024)); }
}
template <bool ZERO, class AO, class BO, class NX = NoNextS>
DEV void gemm256s(unsigned char* smem, int nkt, const void* abase, unsigned akstep, const AO& aoff, const void* bbase, unsigned bkstep, const BO& boff, f32x4 (&acc)[8][4], bool pre = false, const NX& next = NX()) {
    const int tid = TID(), lane = tid & 63; const int wid = __builtin_amdgcn_readfirstlane(tid >> 6); const int wr = wid >> 2, wc = wid & 3;
    if (ZERO) {
#pragma unroll
        for (int mi = 0; mi < 8; ++mi)
#pragma unroll
            for (int ni = 0; ni < 4; ++ni) acc[mi][ni] = (f32x4){0.f, 0.f, 0.f, 0.f};
    }
    const unsigned lds0 = (unsigned)(uintptr_t)smem;
    const unsigned char* abase_u = uptr(abase); const unsigned char* bbase_u = uptr(bbase); const unsigned akstep_u = __builtin_amdgcn_readfirstlane(akstep), bkstep_u = __builtin_amdgcn_readfirstlane(bkstep);
    unsigned ao[4], bo[4];
#pragma unroll
    for (int i = 0; i < 4; ++i) { const int p = wid + 8 * i; ao[i] = aoff(8 * p + (lane >> 3), (lane & 7) ^ (lane >> 3));
        const int k = 2 * p + (lane >> 5); const int f = (k & 3) + 4 * ((k >> 3) & 1); bo[i] = boff(k, (lane & 31) ^ (f << 1)); }
#define GL_ISSUE(kt, st) do { const unsigned char* ab_ = abase_u + (size_t)(kt) * akstep_u; const unsigned char* bb_ = bbase_u + (size_t)(kt) * bkstep_u; \
        _Pragma("unroll") for (int i_ = 0; i_ < 4; ++i_) glds16s(ab_, ao[i_], (unsigned)__builtin_amdgcn_readfirstlane(lds0 + (st) * GL_STAGE + (wid + 8 * i_) * 1024)); \
        _Pragma("unroll") for (int i_ = 0; i_ < 4; ++i_) glds16s(bb_, bo[i_], (unsigned)__builtin_amdgcn_readfirstlane(lds0 + (st) * GL_STAGE + 32768 + (wid + 8 * i_) * 1024)); } while (0)
    if (!pre) {
        GL_ISSUE(0, 0);
        asm volatile("s_waitcnt vmcnt(0)" ::: "memory");
        __syncthreads();
    }
    for (int kt = 0; kt < nkt; ++kt) {
        if (kt + 1 < nkt) GL_ISSUE(kt + 1, (kt + 1) & 1); else next();
        const unsigned char* A = smem + (kt & 1) * GL_STAGE; const unsigned char* Bt = A + 32768;
#pragma unroll
        for (int ks = 0; ks < 2; ++ks) {
            bf16x8 wf[4];
#pragma unroll
            for (int ni = 0; ni < 4; ++ni) {
                const int i = lane & 15, g = lane >> 4, q = i >> 2; const int row = ks * 32 + 8 * g + q; const int nc = wc * 8 + ni * 2 + ((i & 3) >> 1); const int f = q + 4 * (g & 1);
                const unsigned char* p = Bt + row * 512 + ((nc ^ (f << 1)) << 4) + (i & 1) * 8;
                const s16x4 lo = tr_read(p), hi = tr_read(p + 4 * 512);
                wf[ni] = (bf16x8){lo[0], lo[1], lo[2], lo[3], hi[0], hi[1], hi[2], hi[3]};
            }
#pragma unroll
            for (int mi = 0; mi < 8; ++mi) {
                const int m = wr * 128 + mi * 16 + (lane & 15); const int kc = ks * 4 + (lane >> 4);
                const bf16x8 af = *(const bf16x8*)(A + m * 128 + ((kc ^ (m & 7)) << 4));
#pragma unroll
                for (int ni = 0; ni < 4; ++ni) acc[mi][ni] = __builtin_amdgcn_mfma_f32_16x16x32_bf16(wf[ni], af, acc[mi][ni], 0, 0, 0);
            }
        }
        asm volatile("s_waitcnt vmcnt(0)" ::: "memory");
        __syncthreads();
    }
#undef GL_ISSUE
}

#define G_ROW(mi) ((((mi) >> 2) * 128) + wr * 64 + (((mi) & 3) * 16) + (lane & 15))
#define G_COL(ni) ((((ni) >> 1) * 128) + wc * 32 + (((ni) & 1) * 16) + 4 * (lane >> 4))
#define WAIT_V(n) asm volatile("s_waitcnt vmcnt(" #n ")" ::: "memory")
#define WAIT_L(n) asm volatile("s_waitcnt lgkmcnt(" #n ")" ::: "memory")
#define BAR() __builtin_amdgcn_s_barrier()
#define SCHED() __builtin_amdgcn_sched_barrier(0)
constexpr int SA_(int b, int h) { return b * GL_STAGE + h * 16384; }
constexpr int SB_(int b, int h) { return b * GL_STAGE + 32768 + h * 16384; }
struct NoNext { DEV bool has() const { return false; } template <int P> DEV void issue() const {} };
template <int WHICH, class AO, class BO>
DEV void gemm_issue0(unsigned char* smem, const void* abase, const AO& aoff, const void* bbase, const BO& boff) {
    const int tid = TID(), lane = tid & 63; const int wid = __builtin_amdgcn_readfirstlane(tid >> 6);
    const unsigned lds0 = (unsigned)(uintptr_t)smem; const unsigned char* ab_ = uptr(abase); const unsigned char* bb_ = uptr(bbase);
#pragma unroll
    for (int h = 0; h < 2; ++h) {
        if (WHICH & (1 << (2 * h))) {
#pragma unroll
            for (int i = 0; i < 2; ++i) { const int p = wid + 8 * i; const int k = 4 * p + (lane >> 4); const int f = (k & 3) + 4 * ((k >> 3) & 1);
                glds16s(bb_, boff(k, h * 16 + ((lane & 15) ^ (f << 1))), (unsigned)__builtin_amdgcn_readfirstlane(lds0 + SB_(0, h) + p * 1024)); } }
        if (WHICH & (2 << (2 * h))) {
#pragma unroll
            for (int i = 0; i < 2; ++i) { const int p = wid + 8 * i;
                glds16s(ab_, aoff(h * 128 + 8 * p + (lane >> 3), (lane & 7) ^ (lane >> 3)), (unsigned)__builtin_amdgcn_readfirstlane(lds0 + SA_(0, h) + p * 1024)); } }
    }
}
template <class AO, class BO>
struct NextTile { bool on; unsigned char* smem; const void* abase; AO aoff; const void* bbase; BO boff;
    DEV bool has() const { return on; }
    template <int P> DEV void issue() const { gemm_issue0<P>(smem, abase, aoff, bbase, boff); } };
template <class AO, class BO> DEV NextTile<AO, BO> next_tile(bool on, unsigned char* smem, const void* abase, const AO& aoff, const void* bbase, const BO& boff) { return NextTile<AO, BO>{on, smem, abase, aoff, bbase, boff}; }
template <bool ZERO, class AO, class BO, class NX = NoNext>
DEV void gemm256(unsigned char* smem, int nkt, const void* abase, unsigned akstep, const AO& aoff, const void* bbase, unsigned bkstep, const BO& boff, f32x4 (&acc)[8][4], bool pre = false, const NX& next = NX()) {
    const int tid = TID(), lane = tid & 63; const int wid = __builtin_amdgcn_readfirstlane(tid >> 6); const int wr = wid >> 2, wc = wid & 3;
    if (ZERO) {
#pragma unroll
        for (int mi = 0; mi < 8; ++mi)
#pragma unroll
            for (int ni = 0; ni < 4; ++ni) acc[mi][ni] = (f32x4){0.f, 0.f, 0.f, 0.f};
    }
    const unsigned lds0 = (unsigned)(uintptr_t)smem;
    const unsigned char* abase_u = uptr(abase); const unsigned char* bbase_u = uptr(bbase); const unsigned akstep_u = __builtin_amdgcn_readfirstlane(akstep), bkstep_u = __builtin_amdgcn_readfirstlane(bkstep);
    unsigned ao[4], bo[4];
#pragma unroll
    for (int h = 0; h < 2; ++h)
#pragma unroll
        for (int i = 0; i < 2; ++i) { const int p = wid + 8 * i; ao[h * 2 + i] = aoff(h * 128 + 8 * p + (lane >> 3), (lane & 7) ^ (lane >> 3));
            const int k = 4 * p + (lane >> 4); const int f = (k & 3) + 4 * ((k >> 3) & 1); bo[h * 2 + i] = boff(k, h * 16 + ((lane & 15) ^ (f << 1))); }
    unsigned ard0[2], ard1[2], brd0[2], brd1[2];
    { const int l15 = lane & 15, g = lane >> 4, q = l15 >> 2; const int f = q + 4 * (g & 1);
      ard0[0] = lds0 + (wr * 64 + l15) * 128 + ((g ^ (lane & 7)) << 4); ard1[0] = lds0 + (wr * 64 + l15) * 128 + (((4 + g) ^ (lane & 7)) << 4);
      const int nc = wc * 4 + ((l15 & 3) >> 1); const int kr = 8 * g + q;
      brd0[0] = lds0 + kr * 256 + ((nc ^ (f << 1)) << 4) + (l15 & 1) * 8; brd1[0] = lds0 + kr * 256 + (((nc + 2) ^ (f << 1)) << 4) + (l15 & 1) * 8;
      ard0[1] = ard0[0] + GL_STAGE; ard1[1] = ard1[0] + GL_STAGE; brd0[1] = brd0[0] + GL_STAGE; brd1[1] = brd1[0] + GL_STAGE;
      asm volatile("" : "+v"(ard0[1]), "+v"(ard1[1]), "+v"(brd0[1]), "+v"(brd1[1])); }
#define ST_A(b, h, kt) do { const unsigned char* ab_ = abase_u + (size_t)(kt) * akstep_u; \
        _Pragma("unroll") for (int i_ = 0; i_ < 2; ++i_) glds16s(ab_, ao[(h) * 2 + i_], (unsigned)__builtin_amdgcn_readfirstlane(lds0 + SA_(b, h) + (wid + 8 * i_) * 1024)); } while (0)
#define ST_B(b, h, kt) do { const unsigned char* bb_ = bbase_u + (size_t)(kt) * bkstep_u; \
        _Pragma("unroll") for (int i_ = 0; i_ < 2; ++i_) glds16s(bb_, bo[(h) * 2 + i_], (unsigned)__builtin_amdgcn_readfirstlane(lds0 + SB_(b, h) + (wid + 8 * i_) * 1024)); } while (0)
#define LDSP(T, a_) ((LAS const T*)(uintptr_t)(a_))
#define LDA(dst, b, h) do { _Pragma("unroll") for (int m_ = 0; m_ < 4; ++m_) { dst[m_][0] = *LDSP(bf16x8, ard0[b] + SA_(0, h) + m_ * 2048); dst[m_][1] = *LDSP(bf16x8, ard1[b] + SA_(0, h) + m_ * 2048); } } while (0)
#define LDB(dst, b, h) do { _Pragma("unroll") for (int n_ = 0; n_ < 2; ++n_) _Pragma("unroll") for (int k_ = 0; k_ < 2; ++k_) { const unsigned p_ = (n_ ? brd1[b] : brd0[b]) + SB_(0, h) + k_ * 8192; \
        const s16x4 lo_ = tr_read_l(p_), hi_ = tr_read_l(p_ + 1024); dst[n_][k_] = (bf16x8){lo_[0], lo_[1], lo_[2], lo_[3], hi_[0], hi_[1], hi_[2], hi_[3]}; } } while (0)
#define MMA(ai, bj, Bx) do { __builtin_amdgcn_s_setprio(1); \
        _Pragma("unroll") for (int k_ = 0; k_ < 2; ++k_) _Pragma("unroll") for (int m_ = 0; m_ < 4; ++m_) _Pragma("unroll") for (int n_ = 0; n_ < 2; ++n_) \
            acc[(ai) * 4 + m_][(bj) * 2 + n_] = __builtin_amdgcn_mfma_f32_16x16x32_bf16(Bx[n_][k_], At[m_][k_], acc[(ai) * 4 + m_][(bj) * 2 + n_], 0, 0, 0); \
        __builtin_amdgcn_s_setprio(0); } while (0)
    bf16x8 At[4][2], B0[2][2], B1[2][2];
    if (!pre) { ST_B(0, 0, 0); ST_A(0, 0, 0); ST_B(0, 1, 0); ST_A(0, 1, 0); }
    if (wr == 1) BAR();
    if (!pre) WAIT_V(4);
    BAR();
    ST_B(1, 0, 1); ST_A(1, 0, 1); ST_B(1, 1, 1);
    if (!pre) WAIT_V(6);
    BAR();
    for (int t = 0; t < nkt - 2; t += 2) {
        LDB(B0, 0, 0); SCHED(); LDA(At, 0, 0); ST_A(1, 1, t + 1);
        WAIT_L(8); BAR(); WAIT_L(0); MMA(0, 0, B0); BAR(); SCHED();
        LDB(B1, 0, 1); ST_B(0, 0, t + 2);
        BAR(); WAIT_L(0); MMA(0, 1, B1); BAR();
        LDA(At, 0, 1); ST_A(0, 0, t + 2);
        BAR(); WAIT_L(0); MMA(1, 0, B0); BAR(); SCHED();
        ST_B(0, 1, t + 2);
        WAIT_V(6); BAR(); MMA(1, 1, B1); BAR();
        LDB(B0, 1, 0); SCHED(); LDA(At, 1, 0); ST_A(0, 1, t + 2);
        WAIT_L(8); BAR(); WAIT_L(0); MMA(0, 0, B0); BAR(); SCHED();
        LDB(B1, 1, 1); ST_B(1, 0, t + 3);
        BAR(); WAIT_L(0); MMA(0, 1, B1); BAR();
        LDA(At, 1, 1); ST_A(1, 0, t + 3);
        BAR(); WAIT_L(0); MMA(1, 0, B0); BAR(); SCHED();
        ST_B(1, 1, t + 3);
        WAIT_V(6); BAR(); MMA(1, 1, B1); BAR();
    }
    const bool hn = next.has();
    LDB(B0, 0, 0); LDA(At, 0, 0); ST_A(1, 1, nkt - 1);
    BAR(); WAIT_L(0); MMA(0, 0, B0); BAR();
    LDB(B1, 0, 1); BAR(); WAIT_L(0); MMA(0, 1, B1); BAR();
    LDA(At, 0, 1);
    if (hn) { next.template issue<3>(); WAIT_V(8); } else WAIT_V(4);
    BAR(); WAIT_L(0); MMA(1, 0, B0); MMA(1, 1, B1); BAR();
    LDB(B0, 1, 0); LDA(At, 1, 0);
    if (hn) { next.template issue<4>(); WAIT_V(8); } else WAIT_V(2);
    BAR(); WAIT_L(0); MMA(0, 0, B0); BAR();
    LDB(B1, 1, 1);
    if (hn) { next.template issue<8>(); WAIT_V(8); } else WAIT_V(0);
    BAR(); WAIT_L(0); MMA(0, 1, B1); BAR();
    LDA(At, 1, 1); BAR(); WAIT_L(0); MMA(1, 0, B0); MMA(1, 1, B1);
    WAIT_V(0);
    BAR();
    if (wr == 0) BAR();
#undef ST_A
#undef ST_B
#undef LDA
#undef LDB
#undef LDSP
#undef MMA
}

DEV uint4 pair16(uint2 a, uint2 b) {
    const auto r0 = __builtin_amdgcn_permlane16_swap(a.x, b.x, false, false); const auto r1 = __builtin_amdgcn_permlane16_swap(a.y, b.y, false, false);
    uint4 o; o.x = r0[0]; o.y = r1[0]; o.z = r0[1]; o.w = r1[1]; return o;
}
DEV void unpair16(uint4 q, uint2& a, uint2& b) {
    const auto r0 = __builtin_amdgcn_permlane16_swap(q.x, q.z, false, false); const auto r1 = __builtin_amdgcn_permlane16_swap(q.y, q.w, false, false);
    a.x = r0[0]; a.y = r1[0]; b.x = r0[1]; b.y = r1[1];
}
#define PAIR16_COL(c0, c1) ((((lane) >> 4) & 1) ? (c1) - 4 : (c0))
#define EPI_IDS() do { const int etid_ = TID(); lane = etid_ & 63; wid = etid_ >> 6; wr = wid >> 2; wc = wid & 3; } while (0)

DEV void patch_decode(int local, int MT, int NT, int& mt, int& nt) {
    const int per_mtb = 8 * NT; const int mtb = local / per_mtb; const int rem = local - mtb * per_mtb;
    const int rows = (MT - 8 * mtb) < 8 ? (MT - 8 * mtb) : 8;
    const int per_ntb = rows * 8; const int nfull = NT >> 3; int ntb = rem / per_ntb; int cols = 8;
    if (ntb >= nfull) { ntb = nfull; cols = NT - 8 * nfull; }
    const int r2 = rem - ntb * per_ntb;
    mt = 8 * mtb + r2 / cols; nt = 8 * ntb + r2 % cols;
}

DEV void convert_chunk(const float* src, bf16_t* dst, size_t i8) {
    const float4 a = *(const float4*)(src + i8 * 8), b = *(const float4*)(src + i8 * 8 + 4);
    uint4 o; o.x = cvtpk(a.x, a.y); o.y = cvtpk(a.z, a.w); o.z = cvtpk(b.x, b.y); o.w = cvtpk(b.z, b.w);
    *(uint4*)(dst + i8 * 8) = o;
}
DEV void phase_prologue(const Args& a, unsigned char* smem) {
    unsigned char* ws = a.ws;
    const size_t gtid = (size_t)BID() * NTHR + TID(), gn = (size_t)gridDim.x * NTHR;
    {
        { const float* W = a.in[I_WOUT]; bf16_t* O = (bf16_t*)(ws + WS_WOUT); const float* gnn = a.in[I_GNN]; const float* gnf = a.in[I_GNF];
          for (size_t i = gtid; i < (size_t)1024 * 128; i += gn) { const int k = (int)(i >> 7); const float g_ = k < 512 ? gnn[k] : gnf[k - 512];
              const float4 x = *(const float4*)(W + i * 8), y = *(const float4*)(W + i * 8 + 4);
              uint4 o; o.x = cvtpk(x.x * g_, x.y * g_); o.y = cvtpk(x.z * g_, x.w * g_); o.z = cvtpk(y.x * g_, y.y * g_); o.w = cvtpk(y.z * g_, y.w * g_); *(uint4*)(O + i * 8) = o; } }
        const float* srcs[3] = {a.in[I_WGATE], a.in[I_WPLE], a.in[I_P]};
        bf16_t* dsts[3] = {(bf16_t*)(ws + WS_WGATE), (bf16_t*)(ws + WS_WPLE), (bf16_t*)(ws + WS_PB)};
        const size_t cnt8[3] = {1024 * 1024 / 8, 256 * 1024 / 8, (size_t)NTOK * 256 / 8};
#pragma unroll
        for (int s = 1; s < 3; ++s) for (size_t i = gtid; i < cnt8[s]; i += gn) convert_chunk(srcs[s], dsts[s], i);
        { const float* W = srcs[0]; bf16_t* O = dsts[0]; const float* lp = a.in[I_LNPLE];
          for (size_t i = gtid; i < cnt8[0]; i += gn) { const float g_ = lp[i >> 7];
              const float4 x = *(const float4*)(W + i * 8), y = *(const float4*)(W + i * 8 + 4);
              uint4 o; o.x = cvtpk(x.x * g_, x.y * g_); o.y = cvtpk(x.z * g_, x.w * g_); o.z = cvtpk(y.x * g_, y.y * g_); o.w = cvtpk(y.z * g_, y.w * g_); *(uint4*)(O + i * 8) = o; } }
        for (size_t i = gtid; i < (size_t)2 * 2048 * 32; i += gn) { const int which = (int)(i / (2048 * 32)); const int k = (int)(i / 32) % 2048, c8 = (int)(i % 32) * 8;
            uint4 o = {0u, 0u, 0u, 0u};
            if (c8 < 128) { const float* W = a.in[which ? I_WC1V : I_WC1K] + (size_t)k * 128 + c8; const float4 x = *(const float4*)W, y = *(const float4*)(W + 4); o.x = cvtpk(x.x, x.y); o.y = cvtpk(x.z, x.w); o.z = cvtpk(y.x, y.y); o.w = cvtpk(y.z, y.w); }
            *(uint4*)((bf16_t*)(ws + WS_WC1) + i * 8) = o; }
        for (size_t i = gtid; i < (size_t)2 * 128 * 32; i += gn) { const int which = (int)(i / (128 * 32)); const int k = (int)(i / 32) % 128, c8 = (int)(i % 32) * 8;
            uint4 o = {0u, 0u, 0u, 0u};
            if (c8 < 64) { const float* W = a.in[which ? I_WC2V : I_WC2K] + (size_t)k * 64 + c8; const float4 x = *(const float4*)W, y = *(const float4*)(W + 4); o.x = cvtpk(x.x, x.y); o.y = cvtpk(x.z, x.w); o.z = cvtpk(y.x, y.y); o.w = cvtpk(y.z, y.w); }
            *(uint4*)((bf16_t*)(ws + WS_WC2) + i * 8) = o; }
    }
    {
        const float* W = a.in[I_WIN]; bf16_t* O = (bf16_t*)(ws + WS_WIN);
        for (size_t i = gtid; i < (size_t)1024 * (NWIN / 8); i += gn) {
            const int k = (int)(i / (NWIN / 8)), j = (int)(i % (NWIN / 8)) * 8;
            uint4 o = {0u, 0u, 0u, 0u};
            if (j < 2848) {
                const int sj = (j < 1280) ? j : (j < 2816) ? j + 24 : (j < 2840) ? j - 1536 : j;
                const float4 x = *(const float4*)(W + (size_t)k * 2848 + sj), y = *(const float4*)(W + (size_t)k * 2848 + sj + 4);
                o.x = cvtpk(x.x, x.y); o.y = cvtpk(x.z, x.w); o.z = cvtpk(y.x, y.y); o.w = cvtpk(y.z, y.w);
            }
            *(uint4*)(O + (size_t)k * NWIN + j) = o;
        }
    }
    const int lane = TID() & 63; const int gw = BID() * NWAVE + (TID() >> 6), ngw = gridDim.x * NWAVE;
    {
        const float* X = a.in[I_X]; const float* g = a.in[I_LN1]; bf16_t* XN = (bf16_t*)(ws + WS_XN);
        for (int m = gw; m < NTOK; m += ngw) {
            float4 v[4]; float s = 0.f;
#pragma unroll
            for (int j = 0; j < 4; ++j) { v[j] = *(const float4*)(X + (size_t)m * 1024 + j * 256 + lane * 4); s += v[j].x * v[j].x + v[j].y * v[j].y + v[j].z * v[j].z + v[j].w * v[j].w; }
            const float rstd = rsqrtf(wave_sum(s) * (1.f / 1024.f) + EPS);
#pragma unroll
            for (int j = 0; j < 4; ++j) { const float4 gg = *(const float4*)(g + j * 256 + lane * 4);
                uint2 o; o.x = cvtpk(v[j].x * rstd * gg.x, v[j].y * rstd * gg.y); o.y = cvtpk(v[j].z * rstd * gg.z, v[j].w * rstd * gg.w);
                *(uint2*)(XN + (size_t)m * 1024 + j * 256 + lane * 4) = o; }
        }
    }
    if (gtid == 0) *(float*)(ws + WS_ONE) = 1.0f;
    if (gw < 256) {
        const int which = gw >> 7, n = gw & 127; const float* pe = a.in[which ? I_PEV : I_PEK]; const float* w1 = a.in[which ? I_WC1V : I_WC1K];
        float s = 0.f;
#pragma unroll 8
        for (int i = 0; i < 32; ++i) { const int k = lane + 64 * i; s += pe[k] * w1[(size_t)k * 128 + n]; }
        s = wave_sum(s);
        if (lane == 0) ((float*)(ws + WS_BIAS1))[which * 128 + n] = s;
    }
}

DEV void phase_inproj(const Args& a, unsigned char* smem) {
    const bf16_t* XN = (const bf16_t*)(a.ws + WS_XN); const bf16_t* W = (const bf16_t*)(a.ws + WS_WIN);
    bf16_t* PROJ = (bf16_t*)(a.ws + WS_PROJ); float* GN = (float*)(a.ws + WS_GN); float* LS = (float*)(a.ws + WS_LS); const float* bfg = a.in[I_BFG];
    int lane = TID() & 63, wid = TID() >> 6, wr = wid >> 2, wc = wid & 3; (void)wr; (void)wc; (void)lane;
    bool pre = false;
    for (int item = VBID(); item < 64 * 12; item += gridDim.x) {
        int mt, nt; patch_decode(item, 64, 12, mt, nt);
        const int nitem = item + (int)gridDim.x; const bool has_next = nitem < 64 * 12; int mtn = 0, ntn = 0; if (has_next) patch_decode(nitem, 64, 12, mtn, ntn);
        f32x4 acc[8][4];
        auto aoffi = [](int r, int kc) { return (unsigned)(r * 2048 + kc * 16); }; auto boffi = [](int k, int nc) { return (unsigned)(k * (NWIN * 2) + nc * 16); };
        gemm256<true>(smem, 16, XN + (size_t)mt * 256 * 1024, 128u, aoffi, W + nt * 256, (unsigned)(64 * NWIN * 2), boffi, acc, pre,
                      next_tile(has_next, smem, XN + (size_t)mtn * 256 * 1024, aoffi, W + ntn * 256, boffi));
        pre = has_next;
        EPI_IDS();
#pragma unroll
        for (int mi = 0; mi < 8; ++mi) {
            const int gm = mt * 256 + G_ROW(mi); const int b = gm >> 13, t = gm & 8191;
            if (nt < 11) {
#pragma unroll
                for (int np = 0; np < 2; ++np) { const int n0 = G_COL(2 * np); const int hs = nt * 4 + (n0 >> 6), d0 = n0 & 63; const float sc = (hs < 8 || (hs >= 20 && hs < 28)) ? QS : 1.0f;
                    const f32x4 v0 = acc[mi][2 * np], v1 = acc[mi][2 * np + 1]; uint2 oa, ob; oa.x = cvtpk(v0[0] * sc, v0[1] * sc); oa.y = cvtpk(v0[2] * sc, v0[3] * sc); ob.x = cvtpk(v1[0] * sc, v1[1] * sc); ob.y = cvtpk(v1[2] * sc, v1[3] * sc);
                    *(uint4*)(PROJ + (((size_t)(hs * 2 + b)) * 8192 + t) * 64 + PAIR16_COL(d0, d0 + 16)) = pair16(oa, ob); }
            }
#pragma unroll
            for (int ni = 0; ni < 4; ++ni) {
                const int n = G_COL(ni); const f32x4 v = acc[mi][ni];
                if (nt < 11) {
                } else if (n < 24) {
#pragma unroll
                    for (int r = 0; r < 4; ++r) GN[(size_t)gm * 24 + n + r] = sigmoidf_(v[r]);
                } else if (n < 32) {
#pragma unroll
                    for (int r = 0; r < 4; ++r) { const int h = n - 24 + r; LS[((size_t)(b * 8 + h)) * 8192 + t] = logsigmoidf_(v[r] + bfg[h]); }
                }
            }
        }
    }
}

DEV void signal_done(unsigned* flag) {
    asm volatile("s_waitcnt vmcnt(0)" ::: "memory");
    __syncthreads();
    if (TID() == 0) { __builtin_amdgcn_fence(__ATOMIC_RELEASE, "agent"); asm volatile("s_waitcnt vmcnt(0)" ::: "memory"); __hip_atomic_fetch_add(flag, 1u, __ATOMIC_RELAXED, __HIP_MEMORY_SCOPE_AGENT); }
}
DEV void wait_flag(unsigned* flag, unsigned target) {
    if (TID() == 0) { unsigned sp = 0u; while (__hip_atomic_load(flag, __ATOMIC_RELAXED, __HIP_MEMORY_SCOPE_AGENT) < target) { __builtin_amdgcn_s_sleep(4); if (++sp > (1u << 24)) break; }
        __builtin_amdgcn_fence(__ATOMIC_ACQUIRE, "agent"); asm volatile("s_waitcnt vmcnt(0)" ::: "memory"); }
    __syncthreads();
}
constexpr int CW_CUMFLAG = 128, CW_CMPFLAG = 192, CW_GATEFLAG = 256;
DEV void cmp_item(const Args& a, unsigned char* smem, int item) {
    const bf16_t* PROJ = (const bf16_t*)(a.ws + WS_PROJ);
    const int tid = TID(); int lane = tid & 63, wid = tid >> 6, wr = wid >> 2, wc = wid & 3; (void)wr; (void)wc; (void)lane;
    {
        if (item < 16) {
            const int which = item >> 3, b = (item >> 2) & 1, g = (item >> 1) & 1, mt = item & 1;
            const bf16_t* base = PROJ + ((size_t)((8 + 2 * which + g) * 2 + b)) * 8192 * 64;
            const bf16_t* W1 = (const bf16_t*)(a.ws + WS_WC1) + (size_t)which * 2048 * 256;
            const bf16_t* W2 = (const bf16_t*)(a.ws + WS_WC2) + (size_t)which * 128 * 256;
            const float* bias1 = (const float*)(a.ws + WS_BIAS1) + which * 128;
            bf16_t* HID = (bf16_t*)(a.ws + WS_HID) + ((size_t)(which * 4 + b * 2 + g)) * 512 * 128;
            bf16_t* OUT = (bf16_t*)(a.ws + WS_KC) + ((size_t)(which * 4 + b * 2 + g)) * 512 * 64;
            f32x4 acc[8][4];
            gemm256s<true>(smem, 32, base, 128u, [&](int r, int kc) { int c = mt * 256 + r; c = c > 510 ? 510 : c; return (unsigned)(c * 2048 + kc * 16); },
                          W1, 64u * 512u, [&](int k, int nc) { return (unsigned)(k * 512 + nc * 16); }, acc);
        EPI_IDS();
            if (wc < 2) {
                float4 bb4[4];
#pragma unroll
                for (int ni = 0; ni < 4; ++ni) bb4[ni] = *(const float4*)(bias1 + wc * 64 + ni * 16 + 4 * (lane >> 4));
#pragma unroll
                for (int mi = 0; mi < 8; ++mi) { const int c = mt * 256 + wr * 128 + mi * 16 + (lane & 15);
#pragma unroll
                    for (int ni = 0; ni < 4; ++ni) { const int n = wc * 64 + ni * 16 + 4 * (lane >> 4); const f32x4 v = acc[mi][ni]; const float4 bb = bb4[ni];
                        uint2 o; o.x = cvtpk(gelu_tanh(v[0] + bb.x), gelu_tanh(v[1] + bb.y)); o.y = cvtpk(gelu_tanh(v[2] + bb.z), gelu_tanh(v[3] + bb.w));
                        *(uint2*)(HID + (size_t)c * 128 + n) = o; } }
            }
            __syncthreads();
            gemm256s<true>(smem, 2, HID + (size_t)mt * 256 * 128, 128u, [&](int r, int kc) { return (unsigned)(r * 256 + kc * 16); },
                          W2, 64u * 512u, [&](int k, int nc) { return (unsigned)(k * 512 + nc * 16); }, acc);
        EPI_IDS();
            if (wc == 0) {
#pragma unroll
                for (int mi = 0; mi < 8; ++mi) { const int c = mt * 256 + wr * 128 + mi * 16 + (lane & 15);
#pragma unroll
                    for (int ni = 0; ni < 4; ++ni) { const int n = ni * 16 + 4 * (lane >> 4); const f32x4 v = acc[mi][ni];
                        uint2 o; o.x = cvtpk(v[0], v[1]); o.y = cvtpk(v[2], v[3]);
                        if (c >= 511) { o.x = 0u; o.y = 0u; }
                        *(uint2*)(OUT + (size_t)c * 64 + n) = o; } }
            }
            signal_done((unsigned*)(a.ws + WS_CTL) + CW_CMPFLAG);
        } else {
            const int bh = item - 16; const float* LS = (const float*)(a.ws + WS_LS) + (size_t)bh * 8192; float* CUM = (float*)(a.ws + WS_CUM) + (size_t)bh * 8192;
            float* sc = (float*)smem;
            float v[16]; float s = 0.f;
#pragma unroll
            for (int j = 0; j < 4; ++j) { const float4 x = *(const float4*)(LS + tid * 16 + j * 4); v[4 * j] = x.x; v[4 * j + 1] = x.y; v[4 * j + 2] = x.z; v[4 * j + 3] = x.w; }
#pragma unroll
            for (int j = 0; j < 16; ++j) { s += v[j]; v[j] = s; }
            sc[tid] = s; __syncthreads();
            if (tid == 0) { float run = 0.f; for (int i = 0; i < NTHR; ++i) { const float x = sc[i]; sc[i] = run; run += x; } }
            __syncthreads();
            const float off = sc[tid];
#pragma unroll
            for (int j = 0; j < 4; ++j) { float4 o = {v[4 * j] + off, v[4 * j + 1] + off, v[4 * j + 2] + off, v[4 * j + 3] + off}; *(float4*)(CUM + tid * 16 + j * 4) = o; }
            signal_done((unsigned*)(a.ws + WS_CTL) + CW_CUMFLAG + bh);
        }
    }
}

constexpr int AT_STAGE = 16384;
constexpr int AT_BIAS_OFF = 3 * AT_STAGE;
constexpr int AT_IMP_OFF = AT_BIAS_OFF + 1024;
constexpr int AT_SEL_OFF = AT_IMP_OFF + 65536;
constexpr int AT_WUN_OFF = AT_SEL_OFF + 1024;
constexpr int AT_UCNT_OFF = AT_WUN_OFF + 128;
constexpr int AT_ULIST_OFF = AT_UCNT_OFF + 16;
constexpr int AT_ITEM_OFF = AT_ULIST_OFF + 128;
static_assert(AT_ITEM_OFF + 16 <= GEMM_LDS, "attention LDS map");
#define NEG_INF (-__builtin_inff())

#define KV_DECL uint4 rk0_, rv0_
#define KV_GLOAD(Kt, Vt) do { rk0_ = *(const uint4*)((Kt) + tid * 8); rv0_ = *(const uint4*)((Vt) + tid * 8); } while (0)
#define KV_LSTORE(stp) do { unsigned char* st_ = (stp); const int key = tid >> 3, ch = tid & 7; \
      *(uint4*)(st_ + key * 128 + ((ch ^ (key & 7)) << 4)) = rk0_; \
      *(uint4*)(st_ + 8192 + key * 128 + ((((ch >> 2) ^ ((key >> 1) & 1))) << 6) + ((ch & 3) << 4)) = rv0_; } while (0)
template <bool FULL>
DEV void qk_tile(const unsigned char* Kst, const bf16x8 (&qf)[4], f32x16& p0, f32x16& p1, int lane) {
    const int key = lane & 31, hi = lane >> 5;
    if (FULL) {
        bf16x8 k0[4], k1[4];
#pragma unroll
        for (int ks = 0; ks < 4; ++ks) { const int ch = 2 * ks + hi; const int off = key * 128 + ((ch ^ (key & 7)) << 4);
            k0[ks] = *(const bf16x8*)(Kst + off); k1[ks] = *(const bf16x8*)(Kst + off + 32 * 128); }
        __builtin_amdgcn_sched_barrier(0);
#pragma unroll
        for (int ks = 0; ks < 4; ++ks) {
            p0 = __builtin_amdgcn_mfma_f32_32x32x16_bf16(k0[ks], qf[ks], p0, 0, 0, 0);
            p1 = __builtin_amdgcn_mfma_f32_32x32x16_bf16(k1[ks], qf[ks], p1, 0, 0, 0); }
    } else {
        bf16x8 kk[4];
#pragma unroll
        for (int ks = 0; ks < 4; ++ks) { const int ch = 2 * ks + hi; kk[ks] = *(const bf16x8*)(Kst + key * 128 + ((ch ^ (key & 7)) << 4)); }
        __builtin_amdgcn_sched_barrier(0);
#pragma unroll
        for (int ks = 0; ks < 4; ++ks) p0 = __builtin_amdgcn_mfma_f32_32x32x16_bf16(kk[ks], qf[ks], p0, 0, 0, 0);
        __builtin_amdgcn_sched_barrier(0);
#pragma unroll
        for (int ks = 0; ks < 4; ++ks) { const int ch = 2 * ks + hi; kk[ks] = *(const bf16x8*)(Kst + key * 128 + ((ch ^ (key & 7)) << 4) + 32 * 128); }
        __builtin_amdgcn_sched_barrier(0);
#pragma unroll
        for (int ks = 0; ks < 4; ++ks) p1 = __builtin_amdgcn_mfma_f32_32x32x16_bf16(kk[ks], qf[ks], p1, 0, 0, 0);
    }
}
template <bool FULL>
DEV void pv_tile(const unsigned char* Vst, const f32x16& p0, const f32x16& p1, f32x16 (&o)[2], int lane) {
    const int hi = lane >> 5, i = lane & 15, gg = (lane >> 4) & 1;
    const int q = i >> 2; const int sw = (q >> 1) & 1;
    bf16x8 pa[4];
#pragma unroll
    for (int s = 0; s < 4; ++s) { const f32x16& p = (s < 2) ? p0 : p1; const int b = (s & 1) * 8;
        unsigned w[4];
#pragma unroll
        for (int j = 0; j < 4; ++j) w[j] = cvtpk(p[b + 2 * j], p[b + 2 * j + 1]);
        typedef unsigned u32x4_t __attribute__((ext_vector_type(4)));
        u32x4_t ww = {w[0], w[1], w[2], w[3]}; pa[s] = __builtin_bit_cast(bf16x8, ww); }
    constexpr int NB = FULL ? 1 : 2, SB = FULL ? 4 : 2;
#pragma unroll
    for (int bt = 0; bt < NB; ++bt) {
        s16x4 vlo[SB][2], vhi[SB][2];
#pragma unroll
        for (int s_ = 0; s_ < SB; ++s_)
#pragma unroll
            for (int dh = 0; dh < 2; ++dh) { const int s = bt * SB + s_; const int row0 = 16 * s + 4 * hi + q;
                const unsigned char* p = Vst + row0 * 128 + ((dh ^ sw) << 6) + gg * 32 + (i & 3) * 8;
                vlo[s_][dh] = tr_read(p); vhi[s_][dh] = tr_read(p + 8 * 128); }
        __builtin_amdgcn_sched_barrier(0);
#pragma unroll
        for (int s_ = 0; s_ < SB; ++s_)
#pragma unroll
            for (int dh = 0; dh < 2; ++dh) { const int s = bt * SB + s_;
                const bf16x8 vf = {vlo[s_][dh][0], vlo[s_][dh][1], vlo[s_][dh][2], vlo[s_][dh][3], vhi[s_][dh][0], vhi[s_][dh][1], vhi[s_][dh][2], vhi[s_][dh][3]};
                o[dh] = __builtin_amdgcn_mfma_f32_32x32x16_bf16(vf, pa[s], o[dh], 0, 0, 0); }
        __builtin_amdgcn_sched_barrier(0);
    }
}
DEV float rowmax32(const f32x16& p0, const f32x16& p1) {
    float a = fmaxf(p0[0], p1[0]), b = fmaxf(p0[1], p1[1]);
#pragma unroll
    for (int r = 2; r < 16; r += 2) { a = fmaxf(fmaxf(a, p0[r]), p1[r]); b = fmaxf(fmaxf(b, p0[r + 1]), p1[r + 1]); }
    return pair_max(fmaxf(a, b));
}
DEV void softmax_step(f32x16& p0, f32x16& p1, float& m, float& l, f32x16 (&o)[2]) {
    const float mt = rowmax32(p0, p1); const float mn = fmaxf(m, mt); const float alpha = __builtin_amdgcn_exp2f(m - mn);
    float rs = 0.f;
#pragma unroll
    for (int r = 0; r < 16; ++r) { p0[r] = __builtin_amdgcn_exp2f(p0[r] - mn); p1[r] = __builtin_amdgcn_exp2f(p1[r] - mn); rs += p0[r] + p1[r]; }
    rs = pair_sum(rs);
    l = l * alpha + rs; m = mn;
    if (__any(alpha != 1.0f)) { o[0] *= alpha; o[1] *= alpha; }
}
DEV void softmax_step_nosum(f32x16& p0, f32x16& p1, float& m, f32x16 (&o)[2], f32x16& lacc) {
    const float mt = rowmax32(p0, p1); const float mn = fmaxf(m, mt); const float alpha = __builtin_amdgcn_exp2f(m - mn);
#pragma unroll
    for (int r = 0; r < 16; ++r) { p0[r] = __builtin_amdgcn_exp2f(p0[r] - mn); p1[r] = __builtin_amdgcn_exp2f(p1[r] - mn); }
    m = mn;
    if (__any(alpha != 1.0f)) { o[0] *= alpha; o[1] *= alpha; lacc *= alpha; }
}
DEV void pv_tile_sum(const unsigned char* Vst, const f32x16& p0, const f32x16& p1, f32x16 (&o)[2], f32x16& lacc, int lane) {
    const int hi = lane >> 5, i = lane & 15, gg = (lane >> 4) & 1;
    const int q = i >> 2; const int sw = (q >> 1) & 1;
    bf16x8 pa[4];
#pragma unroll
    for (int s = 0; s < 4; ++s) { const f32x16& p = (s < 2) ? p0 : p1; const int b = (s & 1) * 8;
        unsigned w[4];
#pragma unroll
        for (int j = 0; j < 4; ++j) w[j] = cvtpk(p[b + 2 * j], p[b + 2 * j + 1]);
        typedef unsigned u32x4_t __attribute__((ext_vector_type(4)));
        u32x4_t ww = {w[0], w[1], w[2], w[3]}; pa[s] = __builtin_bit_cast(bf16x8, ww); }
    const bf16x8 ones = {0x3f80, 0x3f80, 0x3f80, 0x3f80, 0x3f80, 0x3f80, 0x3f80, 0x3f80};
#pragma unroll
    for (int bt = 0; bt < 2; ++bt) {
        s16x4 vlo[2][2], vhi[2][2];
#pragma unroll
        for (int s_ = 0; s_ < 2; ++s_)
#pragma unroll
            for (int dh = 0; dh < 2; ++dh) { const int s = bt * 2 + s_; const int row0 = 16 * s + 4 * hi + q;
                const unsigned char* p = Vst + row0 * 128 + ((dh ^ sw) << 6) + gg * 32 + (i & 3) * 8;
                vlo[s_][dh] = tr_read(p); vhi[s_][dh] = tr_read(p + 8 * 128); }
        __builtin_amdgcn_sched_barrier(0);
#pragma unroll
        for (int s_ = 0; s_ < 2; ++s_) { const int s = bt * 2 + s_;
            lacc = __builtin_amdgcn_mfma_f32_32x32x16_bf16(ones, pa[s], lacc, 0, 0, 0);
#pragma unroll
            for (int dh = 0; dh < 2; ++dh) {
                const bf16x8 vf = {vlo[s_][dh][0], vlo[s_][dh][1], vlo[s_][dh][2], vlo[s_][dh][3], vhi[s_][dh][0], vhi[s_][dh][1], vhi[s_][dh][2], vhi[s_][dh][3]};
                o[dh] = __builtin_amdgcn_mfma_f32_32x32x16_bf16(vf, pa[s], o[dh], 0, 0, 0); } }
        __builtin_amdgcn_sched_barrier(0);
    }
}
template <int STRIDE> DEV void mask_tile(f32x16& p0, f32x16& p1, int kpos0, int lo, int hi_lim, int hi) {
#pragma unroll
    for (int r = 0; r < 16; ++r) { const int kp = kpos0 + STRIDE * crow(r, hi);
        if (kp < lo || kp > hi_lim) p0[r] = NEG_INF;
        const int kp1 = kp + 32 * STRIDE; if (kp1 < lo || kp1 > hi_lim) p1[r] = NEG_INF; }
}
template <int STRIDE> DEV void alibi_init(f32x16& p0, f32x16& p1, float slope2, int kpos0, int tref, int hi) {
    const float base = slope2 * (float)(kpos0 - tref + STRIDE * 4 * hi);
#pragma unroll
    for (int r = 0; r < 16; ++r) { const float c = (float)(STRIDE * ((r & 3) + 8 * (r >> 2))); p0[r] = fmaf(slope2, c, base); p1[r] = fmaf(slope2, c + (float)(32 * STRIDE), base); }
}
template <class Src, class Body, class NSrc>
DEV int kv_pipeline(unsigned char* smem, int n, const Src& src, const Body& body, int par, bool pre, bool has_next, const NSrc& nsrc) {
    KV_DECL; const int tid = TID(); const bf16_t *kp, *vp;
    if (!pre) { src(0, kp, vp); KV_GLOAD(kp, vp); KV_LSTORE(smem + par * AT_STAGE); __syncthreads(); }
    for (int j = 0; j < n; ++j) {
        const bool more = j + 1 < n;
        src(more ? j + 1 : j, kp, vp); if (!more && has_next) nsrc(kp, vp);
        KV_GLOAD(kp, vp);
        body(j, smem + ((par + j) & 1) * AT_STAGE);
        KV_LSTORE(smem + ((par + j + 1) & 1) * AT_STAGE);
        __syncthreads();
    }
    return (par + n) & 1;
}
struct NoSrc { DEV void operator()(const bf16_t*&, const bf16_t*&) const {} };

constexpr int CV_PER_STEP = 373; constexpr int CV_NUP = 32 * 1024 * 2048 / 8, CV_NDN = 32 * 1024 * 1024 / 8;
static_assert((long long)33792 * CV_PER_STEP >= (long long)CV_NUP + CV_NDN, "conversion coverage");
DEV void fox_item(const Args& a, unsigned char* smem, int fi, int b, int h, int qb) {
    const int tid = TID(), lane = tid & 63, wid = tid >> 6, r32 = lane & 31, hi = lane >> 5;
    const bf16_t* PROJ = (const bf16_t*)(a.ws + WS_PROJ);
    const bf16_t* Q = PROJ + ((size_t)((20 + h) * 2 + b)) * 8192 * 64; const bf16_t* K = PROJ + ((size_t)((28 + h) * 2 + b)) * 8192 * 64; const bf16_t* V = PROJ + ((size_t)((36 + h) * 2 + b)) * 8192 * 64;
    const float* CUM = (const float*)(a.ws + WS_CUM) + (size_t)(b * 8 + h) * 8192;
    const int q0 = qb * 256; const int qrow = q0 + 32 * wid + r32;
    bf16x8 qf[4];
#pragma unroll
    for (int ks = 0; ks < 4; ++ks) qf[ks] = *(const bf16x8*)(Q + (size_t)qrow * 64 + 16 * ks + 8 * hi);
    const float cref = CUM[q0];
    const int ntiles = 4 * qb + 4; const int jmax_w = (q0 + 32 * wid + 31) >> 6; const int jmask_w = (q0 + 32 * wid) >> 6;
    f32x16 o[2]; o[0] = (f32x16){}; o[1] = (f32x16){}; f32x16 lacc = (f32x16){}; float m = -1e30f;
    float* biasL = (float*)(smem + AT_BIAS_OFF);
    const int gq_ = fi >> 4; const int sidx0 = 16 * (128 * gq_ - 2 * gq_ * (gq_ - 1)) + (fi & 15) * (128 - 4 * gq_);
    bf16_t* cvdA = nullptr; bf16_t* cvdB = nullptr; float4 cvaA, cvbA, cvaB, cvbB; float cvsA = 1.f, cvsB = 1.f;
    KV_DECL; float breg = 0.f;
#define TJ(s_) (ntiles - 1 - (s_))
#define CV_ADDR(st_, SRC, DST, SCP) do { int c_ = (sidx0 + (st_)) * CV_PER_STEP + (tid < CV_PER_STEP ? tid : CV_PER_STEP - 1); c_ = c_ < CV_NUP + CV_NDN ? c_ : CV_NUP + CV_NDN - 1; \
        const bool up_ = c_ < CV_NUP; const int cc_ = up_ ? c_ : c_ - CV_NUP; SRC = (up_ ? a.in[I_WUP] : a.in[I_WDN]) + (size_t)cc_ * 8; DST = (bf16_t*)(a.ws + (up_ ? WS_WUP : WS_WDN)) + (size_t)cc_ * 8; \
        SCP = up_ ? a.in[I_LN2] + ((cc_ >> 8) & 1023) : (const float*)(a.ws + WS_ONE); } while (0)
    { const float* cvs_; const float* scp_; CV_ADDR(0, cvs_, cvdB, scp_); cvaB = *(const float4*)cvs_; cvbB = *(const float4*)(cvs_ + 4); cvsB = *scp_; }
    KV_GLOAD(K + (size_t)TJ(0) * 4096, V + (size_t)TJ(0) * 4096); breg = CUM[TJ(0) * 64 + lane];
    KV_LSTORE(smem); biasL[lane] = (cref - breg) * LOG2E;
    KV_GLOAD(K + (size_t)TJ(1) * 4096, V + (size_t)TJ(1) * 4096); breg = CUM[TJ(1) * 64 + lane];
    KV_LSTORE(smem + AT_STAGE); biasL[64 + lane] = (cref - breg) * LOG2E;
    __syncthreads();
#define FOX_QK(P0, P1, jj, sj) do { const float* bl_ = biasL + (sj) * 64; \
        _Pragma("unroll") for (int g4 = 0; g4 < 4; ++g4) { const float4 x_ = *(const float4*)(bl_ + 8 * g4 + 4 * hi), y_ = *(const float4*)(bl_ + 32 + 8 * g4 + 4 * hi); \
            P0[4 * g4] = x_.x; P0[4 * g4 + 1] = x_.y; P0[4 * g4 + 2] = x_.z; P0[4 * g4 + 3] = x_.w; P1[4 * g4] = y_.x; P1[4 * g4 + 1] = y_.y; P1[4 * g4 + 2] = y_.z; P1[4 * g4 + 3] = y_.w; } \
        qk_tile<true>(smem + (sj) * AT_STAGE, qf, P0, P1, lane); \
        if ((jj) >= jmask_w) mask_tile<1>(P0, P1, 64 * (jj), -1, qrow, hi); } while (0)
#define FOX_STEP(CUR0, CUR1, NXT0, NXT1, j, CVD_LD, CVA_LD, CVB_LD, CVS_LD, CVD_ST, CVA_ST, CVB_ST, CVS_ST) do { \
        const int s_cur = (j) % 3, s_nxt = ((j) + 1) % 3, s_ld = ((j) + 2) % 3; const int tl_ = TJ((j) + 2) < 0 ? 0 : TJ((j) + 2);     \
        KV_GLOAD(K + (size_t)tl_ * 4096, V + (size_t)tl_ * 4096); breg = CUM[tl_ * 64 + lane]; \
        { const float* cvs_; const float* scp_; CV_ADDR(j, cvs_, CVD_LD, scp_); CVA_LD = *(const float4*)cvs_; CVB_LD = *(const float4*)(cvs_ + 4); CVS_LD = *scp_; } \
        if ((j) + 1 < ntiles && TJ((j) + 1) <= jmax_w) FOX_QK(NXT0, NXT1, TJ((j) + 1), s_nxt); \
        __builtin_amdgcn_sched_barrier(0); \
        if (TJ(j) <= jmax_w) { softmax_step_nosum(CUR0, CUR1, m, o, lacc); pv_tile_sum(smem + s_cur * AT_STAGE + 8192, CUR0, CUR1, o, lacc, lane); } \
        KV_LSTORE(smem + s_ld * AT_STAGE); biasL[s_ld * 64 + lane] = (cref - breg) * LOG2E; \
        { uint4 o_; o_.x = cvtpk(CVA_ST.x * CVS_ST, CVA_ST.y * CVS_ST); o_.y = cvtpk(CVA_ST.z * CVS_ST, CVA_ST.w * CVS_ST); o_.z = cvtpk(CVB_ST.x * CVS_ST, CVB_ST.y * CVS_ST); o_.w = cvtpk(CVB_ST.z * CVS_ST, CVB_ST.w * CVS_ST); *(uint4*)CVD_ST = o_; } \
        __syncthreads(); } while (0)
    f32x16 pA0, pA1, pB0, pB1;
    if (TJ(0) <= jmax_w) FOX_QK(pA0, pA1, TJ(0), 0);
    for (int j = 0; j < ntiles; j += 2) {
        FOX_STEP(pA0, pA1, pB0, pB1, j, cvdA, cvaA, cvbA, cvsA, cvdB, cvaB, cvbB, cvsB);
        FOX_STEP(pB0, pB1, pA0, pA1, j + 1, cvdB, cvaB, cvbB, cvsB, cvdA, cvaA, cvbA, cvsA);
    }
    { uint4 o_; o_.x = cvtpk(cvaB.x * cvsB, cvaB.y * cvsB); o_.y = cvtpk(cvaB.z * cvsB, cvaB.w * cvsB); o_.z = cvtpk(cvbB.x * cvsB, cvbB.y * cvsB); o_.w = cvtpk(cvbB.z * cvsB, cvbB.w * cvsB); *(uint4*)cvdB = o_; }
#undef CV_ADDR
#undef FOX_QK
#undef FOX_STEP
#undef TJ
    const float inv = 1.0f / lacc[0]; float ss = 0.f;
    const size_t token = (size_t)b * 8192 + qrow;
    bf16_t* O = (bf16_t*)(a.ws + WS_OFOX) + token * 512 + h * 64;
#pragma unroll
    for (int dh = 0; dh < 2; ++dh)
#pragma unroll
        for (int g4 = 0; g4 < 4; ++g4) { const float v0 = o[dh][4 * g4] * inv, v1 = o[dh][4 * g4 + 1] * inv, v2 = o[dh][4 * g4 + 2] * inv, v3 = o[dh][4 * g4 + 3] * inv;
            ss += v0 * v0 + v1 * v1 + v2 * v2 + v3 * v3; uint2 w; w.x = cvtpk(v0, v1); w.y = cvtpk(v2, v3); *(uint2*)(O + 32 * dh + 8 * g4 + 4 * hi) = w; }
    ss = pair_sum(ss);
    if (hi == 0) ((float*)(a.ws + WS_SSQ))[token * 16 + 8 + h] = ss;
}

DEV void nsa_item(const Args& a, unsigned char* smem, int b, int g, int tt) {
    const int tid = TID(), lane = tid & 63, wid = tid >> 6, col = lane & 31, hi = lane >> 5;
    const int t0 = tt * 64, tokw = col >> 2, r = col & 3, h = 4 * g + r; const int tokl = wid * 8 + tokw; const int t = t0 + tokl; const size_t token = (size_t)b * 8192 + t;
    const float slope2 = exp2f(-(float)(h + 1)) * LOG2E;
    const bf16_t* PROJ = (const bf16_t*)(a.ws + WS_PROJ);
    const float* GN = (const float*)(a.ws + WS_GN) + token * 24 + h * 3;
    const int cur = tt; const bool need_topk = cur > 15;
    bf16x8 qf[4];
    { const bf16_t* Q = PROJ + (((size_t)(h * 2 + b)) * 8192 + t) * 64;
#pragma unroll
      for (int ks = 0; ks < 4; ++ks) qf[ks] = *(const bf16x8*)(Q + 16 * ks + 8 * hi); }
    float* impw = (float*)(smem + AT_IMP_OFF) + wid * 2048; float* totw = impw + lane;
    unsigned* selmask = (unsigned*)(smem + AT_SEL_OFF); unsigned* wun = (unsigned*)(smem + AT_WUN_OFF); int* ucnt = (int*)(smem + AT_UCNT_OFF); unsigned char* ulist = smem + AT_ULIST_OFF;
    f32x16 o[2]; float m, l; int par = 0;
    const int tmin_w = t0 + wid * 8, tmax_w = tmin_w + 7;
    {
        const bf16_t* KC = (const bf16_t*)(a.ws + WS_KC) + ((size_t)(0 * 4 + b * 2 + g)) * 512 * 64; const bf16_t* VC = (const bf16_t*)(a.ws + WS_KC) + ((size_t)(1 * 4 + b * 2 + g)) * 512 * 64;
        const int ncv = t0 / 16 + 3; const int nct = (ncv + 63) >> 6;
        auto src = [&](int j, const bf16_t*& kp, const bf16_t*& vp) { kp = KC + (size_t)j * 4096; vp = VC + (size_t)j * 4096; };
        m = -1e30f; l = 0.f;
        auto src0 = [&](const bf16_t*& kp, const bf16_t*& vp) { kp = KC; vp = VC; };
        par = kv_pipeline(smem, nct, src, [&](int j, const unsigned char* st) {
            const int kpos0 = 1024 * j + 31;
            if (kpos0 > tmax_w) return;
            f32x16 p0, p1; alibi_init<16>(p0, p1, slope2, kpos0, t0, hi);
            qk_tile<false>(st, qf, p0, p1, lane);
            if (kpos0 + 16 * 63 > tmin_w) mask_tile<16>(p0, p1, kpos0, -1, t, hi);
            const float mt = rowmax32(p0, p1); const float mn = fmaxf(m, mt); float rs = 0.f;
#pragma unroll
            for (int rr = 0; rr < 16; ++rr) rs += __builtin_amdgcn_exp2f(p0[rr] - mn) + __builtin_amdgcn_exp2f(p1[rr] - mn);
            rs = pair_sum(rs);
            l = l * __builtin_amdgcn_exp2f(m - mn) + rs; m = mn;
        }, 0, false, true, src0);
        const float linv = l > 0.f ? 1.0f / l : 0.f;
        if (need_topk) { for (int i = lane; i < 8 * 129; i += 64) impw[i] = 0.f; }
        o[0] = (f32x16){}; o[1] = (f32x16){};
        const bf16_t* KS0 = PROJ + ((size_t)((12 + g) * 2 + b)) * 8192 * 64 + (size_t)cur * 4096; const bf16_t* VS0 = PROJ + ((size_t)((14 + g) * 2 + b)) * 8192 * 64 + (size_t)cur * 4096;
        par = kv_pipeline(smem, nct, src, [&](int j, const unsigned char* st) {
            const int kpos0 = 1024 * j + 31;
            if (kpos0 > tmax_w) return;
            f32x16 p0, p1; alibi_init<16>(p0, p1, slope2, kpos0, t0, hi);
            qk_tile<false>(st, qf, p0, p1, lane);
            if (kpos0 + 16 * 63 > tmin_w) mask_tile<16>(p0, p1, kpos0, -1, t, hi);
#pragma unroll
            for (int rr = 0; rr < 16; ++rr) { p0[rr] = __builtin_amdgcn_exp2f(p0[rr] - m) * linv; p1[rr] = __builtin_amdgcn_exp2f(p1[rr] - m) * linv; }
            if (need_topk) {
#pragma unroll
                for (int half = 0; half < 2; ++half)
#pragma unroll
                    for (int g4 = 0; g4 < 4; ++g4) { const f32x16& p = half ? p1 : p0;
                        float ms = (p[4 * g4] + p[4 * g4 + 1]) + (p[4 * g4 + 2] + p[4 * g4 + 3]); float ls = p[4 * g4 + 3];
                        ms = quad_sum(ms); ls = quad_sum(ls);
                        const int n = 16 * j + 8 * half + 2 * g4 + hi;
                        if (r == 0) { atomicAdd(&impw[tokw * 129 + n], ms); atomicAdd(&impw[tokw * 129 + n + 1], ls); } }
            }
            pv_tile<false>(st + 8192, p0, p1, o, lane);
        }, par, true, true, [&](const bf16_t*& kp, const bf16_t*& vp) { kp = KS0; vp = VS0; });
    }
    {
        unsigned un0 = 0u, un1 = 0u, un2 = 0u, un3 = 0u;
        if (need_topk) {
#define TK_INIT(V0, V1, M0, M1, M2, M3, tk_) float V0 = impw[(tk_) * 129 + lane], V1 = impw[(tk_) * 129 + 64 + lane]; \
                V0 = (lane >= 1 && lane <= cur - 2) ? V0 : -1.0f; V1 = (lane + 64 <= cur - 2) ? V1 : -1.0f; unsigned M0 = 1u, M1 = 0u, M2 = 0u, M3 = 0u; \
                TK_SET(M0, M1, M2, M3, cur); TK_SET(M0, M1, M2, M3, cur - 1)
#define TK_SET(M0, M1, M2, M3, n_) do { const int n__ = (n_); const unsigned bit__ = 1u << (n__ & 31); const int w__ = n__ >> 5; M0 |= (w__ == 0) ? bit__ : 0u; M1 |= (w__ == 1) ? bit__ : 0u; M2 |= (w__ == 2) ? bit__ : 0u; M3 |= (w__ == 3) ? bit__ : 0u; } while (0)
#define TK_STEP(V0, V1, M0, M1, M2, M3) do { const float mx_ = wave_max_u(fmaxf(V0, V1)); const unsigned long long b0_ = __ballot(V0 == mx_), b1_ = __ballot(V1 == mx_); \
                const int n_ = b0_ ? (__ffsll((long long)b0_) - 1) : (63 + __ffsll((long long)b1_)); const bool hit_ = lane == (n_ & 63); \
                V0 = (hit_ && n_ < 64) ? -1.0f : V0; V1 = (hit_ && n_ >= 64) ? -1.0f : V1; TK_SET(M0, M1, M2, M3, n_); } while (0)
            for (int tk = 0; tk < 8; tk += 4) {
                TK_INIT(a0_, a1_, ma0, ma1, ma2, ma3, tk); TK_INIT(b0v, b1v, mb0, mb1, mb2, mb3, tk + 1); TK_INIT(c0v, c1v, mc0, mc1, mc2, mc3, tk + 2); TK_INIT(d0v, d1v, md0, md1, md2, md3, tk + 3);
                for (int it = 0; it < 13; ++it) { TK_STEP(a0_, a1_, ma0, ma1, ma2, ma3); TK_STEP(b0v, b1v, mb0, mb1, mb2, mb3); TK_STEP(c0v, c1v, mc0, mc1, mc2, mc3); TK_STEP(d0v, d1v, md0, md1, md2, md3); }
                if (lane == 0) { unsigned* sm_ = selmask + (wid * 8 + tk) * 4; sm_[0] = ma0; sm_[1] = ma1; sm_[2] = ma2; sm_[3] = ma3; sm_[4] = mb0; sm_[5] = mb1; sm_[6] = mb2; sm_[7] = mb3;
                    sm_[8] = mc0; sm_[9] = mc1; sm_[10] = mc2; sm_[11] = mc3; sm_[12] = md0; sm_[13] = md1; sm_[14] = md2; sm_[15] = md3; }
                un0 |= ma0 | mb0 | mc0 | md0; un1 |= ma1 | mb1 | mc1 | md1; un2 |= ma2 | mb2 | mc2 | md2; un3 |= ma3 | mb3 | mc3 | md3;
            }
#undef TK_INIT
#undef TK_SET
#undef TK_STEP
        } else {
            const unsigned full = (2u << cur) - 1u;
            un0 = full;
            if (lane < 8) { unsigned* sm_ = selmask + (wid * 8 + lane) * 4; sm_[0] = full; sm_[1] = 0u; sm_[2] = 0u; sm_[3] = 0u; }
        }
        if (lane == 0) { wun[wid * 4] = un0; wun[wid * 4 + 1] = un1; wun[wid * 4 + 2] = un2; wun[wid * 4 + 3] = un3; }
        __syncthreads();
        if (tid == 0) { int c = 0;
            for (int w = 0; w < 4; ++w) { unsigned u = 0u; for (int ww = 0; ww < NWAVE; ++ww) u |= wun[ww * 4 + w]; for (int bb = 0; bb < 32; ++bb) if ((u >> bb) & 1u) ulist[c++] = (unsigned char)(w * 32 + bb); }
            ucnt[0] = c; }
        __syncthreads();
    }
    { const float g0 = GN[0];
#pragma unroll
      for (int rr = 0; rr < 16; ++rr) { totw[rr * 64] = o[0][rr] * g0; totw[(16 + rr) * 64] = o[1][rr] * g0; } }
    {
        const bf16_t* KS = PROJ + ((size_t)((12 + g) * 2 + b)) * 8192 * 64; const bf16_t* VS = PROJ + ((size_t)((14 + g) * 2 + b)) * 8192 * 64;
        const int nu = ucnt[0];
        m = -1e30f; f32x16 lacc = (f32x16){}; o[0] = (f32x16){}; o[1] = (f32x16){};
        const bf16_t* KW0 = PROJ + ((size_t)((16 + g) * 2 + b)) * 8192 * 64 + (size_t)cur * 4096; const bf16_t* VW0 = PROJ + ((size_t)((18 + g) * 2 + b)) * 8192 * 64 + (size_t)cur * 4096;
        par = kv_pipeline(smem, nu, [&](int j, const bf16_t*& kp, const bf16_t*& vp) { const int n = ulist[nu - 1 - j]; kp = KS + (size_t)n * 4096; vp = VS + (size_t)n * 4096; },
            [&](int j, const unsigned char* st) {
                const int n = ulist[nu - 1 - j];
                if (!((wun[wid * 4 + (n >> 5)] >> (n & 31)) & 1u)) return;
                const bool sel = (selmask[tokl * 4 + (n >> 5)] >> (n & 31)) & 1u;
                f32x16 p0, p1; alibi_init<1>(p0, p1, slope2, 64 * n, t0, hi);
                qk_tile<false>(st, qf, p0, p1, lane);
                if (n == cur || !__all(sel)) mask_tile<1>(p0, p1, 64 * n, -1, sel ? t : -1, hi);
                softmax_step_nosum(p0, p1, m, o, lacc);
                pv_tile_sum(st + 8192, p0, p1, o, lacc, lane);
            }, par, true, true, [&](const bf16_t*& kp, const bf16_t*& vp) { kp = KW0; vp = VW0; });
        const float g1 = GN[1] / fmaxf(lacc[0], 1e-30f);
#pragma unroll
        for (int rr = 0; rr < 16; ++rr) { totw[rr * 64] += o[0][rr] * g1; totw[(16 + rr) * 64] += o[1][rr] * g1; }
    }
    {
        const bf16_t* KW = PROJ + ((size_t)((16 + g) * 2 + b)) * 8192 * 64; const bf16_t* VW = PROJ + ((size_t)((18 + g) * 2 + b)) * 8192 * 64;
        const int jlo = (t0 - 511) > 0 ? ((t0 - 511) >> 6) : 0; const int jhi = cur;
        m = -1e30f; f32x16 lacc = (f32x16){}; o[0] = (f32x16){}; o[1] = (f32x16){};
        (void)kv_pipeline(smem, jhi - jlo + 1, [&](int j, const bf16_t*& kp, const bf16_t*& vp) { kp = KW + (size_t)(jhi - j) * 4096; vp = VW + (size_t)(jhi - j) * 4096; },
            [&](int j, const unsigned char* st) {
                const int kpos0 = 64 * (jhi - j);
                if (kpos0 > tmax_w || kpos0 + 63 < tmin_w - 511) return;
                f32x16 p0, p1; alibi_init<1>(p0, p1, slope2, kpos0, t0, hi);
                qk_tile<false>(st, qf, p0, p1, lane);
                if (kpos0 < tmax_w - 511 || kpos0 + 63 > tmin_w) mask_tile<1>(p0, p1, kpos0, t - 511, t, hi);
                softmax_step_nosum(p0, p1, m, o, lacc);
                pv_tile_sum(st + 8192, p0, p1, o, lacc, lane);
            }, par, true, false, NoSrc());
        const float g2 = GN[2] / fmaxf(lacc[0], 1e-30f);
#pragma unroll
        for (int rr = 0; rr < 16; ++rr) { o[0][rr] = totw[rr * 64] + o[0][rr] * g2; o[1][rr] = totw[(16 + rr) * 64] + o[1][rr] * g2; }
    }
    {
        float ss = 0.f; bf16_t* O = (bf16_t*)(a.ws + WS_ONSA) + token * 512 + h * 64;
#pragma unroll
        for (int dh = 0; dh < 2; ++dh)
#pragma unroll
            for (int g4 = 0; g4 < 4; ++g4) { const float v0 = o[dh][4 * g4], v1 = o[dh][4 * g4 + 1], v2 = o[dh][4 * g4 + 2], v3 = o[dh][4 * g4 + 3];
                ss += v0 * v0 + v1 * v1 + v2 * v2 + v3 * v3; uint2 w; w.x = cvtpk(v0, v1); w.y = cvtpk(v2, v3); *(uint2*)(O + 32 * dh + 8 * g4 + 4 * hi) = w; }
        ss = pair_sum(ss);
        if (hi == 0) ((float*)(a.ws + WS_SSQ))[token * 16 + h] = ss;
    }
}
#ifndef PROBE_DUP
#define PROBE_DUP 0
#endif
DEV void phase_att(const Args& a, unsigned char* smem) {
    int* qctr = (int*)(a.ws + WS_CTL) + 64; int* sitem = (int*)(smem + AT_ITEM_OFF);
    unsigned* ctl = (unsigned*)(a.ws + WS_CTL); unsigned* seen = (unsigned*)(smem + AT_ITEM_OFF + 8);
    if (TID() == 0) seen[0] = 0u;
    for (;;) {
        if (TID() == 0) sitem[0] = atomicAdd(qctr, 1);
        __syncthreads();
        const int item = sitem[0];
        __syncthreads();
        if (item >= 32 + 1024) break;
        if (item < 16) cmp_item(a, smem, 16 + item);
        else if (item < 32) cmp_item(a, smem, item - 16);
        else if (item < 32 + 512) { const int fi = item - 32; const int qb = 31 - (fi >> 4), bh = fi & 15; if (!((seen[0] >> bh) & 1u)) { wait_flag(ctl + CW_CUMFLAG + bh, 1u); if (TID() == 0) seen[0] |= 1u << bh; } fox_item(a, smem, fi, bh >> 3, bh & 7, qb); }
        else { const int idx = item - 32 - 512; const int tt = 127 - (idx >> 2), bg = idx & 3; if (!((seen[0] >> 16) & 1u)) { wait_flag(ctl + CW_CMPFLAG, 16u); if (TID() == 0) seen[0] |= 1u << 16; } nsa_item(a, smem, bg >> 1, bg & 1, tt); }
    }
}

DEV void phase_outproj(const Args& a, unsigned char* smem) {
    const bf16_t* ONSA = (const bf16_t*)(a.ws + WS_ONSA); const bf16_t* OFOX = (const bf16_t*)(a.ws + WS_OFOX); const float* SSQ = (const float*)(a.ws + WS_SSQ);
    const bf16_t* W = (const bf16_t*)(a.ws + WS_WOUT); bf16_t* H1 = (bf16_t*)(a.ws + WS_H1); const float* X = a.in[I_X];
    float* rs = (float*)(smem + MISC_OFF);
    const int tid = TID(); int lane = tid & 63, wid = tid >> 6, wr = wid >> 2, wc = wid & 3; (void)wr; (void)wc; (void)lane;
    auto aoffo = [](int r, int kc) { return (unsigned)(r * 1024 + kc * 16); }; auto boffo = [](int k, int nc) { return (unsigned)(k * 2048 + nc * 16); };
    for (int item = VBID(); item < 64 * 4; item += gridDim.x) {
        int mt, nt; patch_decode(item, 64, 4, mt, nt);
        gemm_issue0<15>(smem, ONSA + (size_t)mt * 256 * 512, aoffo, W + nt * 256, boffo);
        if (tid < 256) { const float* s_ = SSQ + (size_t)(mt * 256 + tid) * 16; float sn = 0.f, sf = 0.f;
#pragma unroll
            for (int j = 0; j < 8; ++j) { sn += s_[j]; sf += s_[8 + j]; }
            rs[tid * 2] = rsqrtf(sn * (1.f / 512.f) + EPS); rs[tid * 2 + 1] = rsqrtf(sf * (1.f / 512.f) + EPS); }
        asm volatile("s_waitcnt vmcnt(0)" ::: "memory");
        __syncthreads();
        f32x4 acc[8][4];
#pragma unroll
        for (int mi = 0; mi < 8; ++mi) { const size_t gm = (size_t)mt * 256 + G_ROW(mi);
#pragma unroll
            for (int ni = 0; ni < 4; ++ni) { const int n = nt * 256 + G_COL(ni); const float4 x = *(const float4*)(X + gm * 1024 + n); acc[mi][ni] = (f32x4){x.x, x.y, x.z, x.w}; } }
#pragma unroll
        for (int mi = 0; mi < 8; ++mi) { const float ri = 1.0f / rs[(G_ROW(mi)) * 2];
#pragma unroll
            for (int ni = 0; ni < 4; ++ni) acc[mi][ni] *= ri; }
        gemm256<false>(smem, 8, ONSA + (size_t)mt * 256 * 512, 128u, aoffo, W + nt * 256, 64u * 2048u, boffo, acc, true,
                       next_tile(true, smem, OFOX + (size_t)mt * 256 * 512, aoffo, W + (size_t)512 * 1024 + nt * 256, boffo));
        EPI_IDS();
#pragma unroll
        for (int mi = 0; mi < 8; ++mi) { const int rl = G_ROW(mi); const float rat = rs[rl * 2] / rs[rl * 2 + 1];
#pragma unroll
            for (int ni = 0; ni < 4; ++ni) acc[mi][ni] *= rat; }
        gemm256<false>(smem, 8, OFOX + (size_t)mt * 256 * 512, 128u, aoffo, W + (size_t)512 * 1024 + nt * 256, 64u * 2048u, boffo, acc, true);
        EPI_IDS();
#pragma unroll
        for (int mi = 0; mi < 8; ++mi) { const int rl = G_ROW(mi); const size_t gm = (size_t)mt * 256 + rl; const float rf = rs[rl * 2 + 1];
#pragma unroll
            for (int np = 0; np < 2; ++np) { const f32x4 v0 = acc[mi][2 * np] * rf, v1 = acc[mi][2 * np + 1] * rf; uint2 oa, ob;
                oa.x = cvtpk(v0[0], v0[1]); oa.y = cvtpk(v0[2], v0[3]); ob.x = cvtpk(v1[0], v1[1]); ob.y = cvtpk(v1[2], v1[3]);
                *(uint4*)(H1 + gm * 1024 + nt * 256 + PAIR16_COL(G_COL(2 * np), G_COL(2 * np + 1))) = pair16(oa, ob); } }
        __syncthreads();
    }
}

DEV void phase_route(const Args& a, unsigned char* smem) {
    const bf16_t* H1 = (const bf16_t*)(a.ws + WS_H1); bf16_t* XN = (bf16_t*)(a.ws + WS_XN); float* RSTD2 = (float*)(a.ws + WS_RSTD2);
    const float* ln2 = a.in[I_LN2]; const float* wr_ = a.in[I_WR]; const float* br = a.in[I_BR];
    int* CNT = (int*)(a.ws + WS_CTL);
    int* TOPI = (int*)(a.ws + WS_TOPI); int* TOPS = (int*)(a.ws + WS_TOPS); float* TOPW = (float*)(a.ws + WS_TOPW);
    int* TOKOF = (int*)(a.ws + WS_TOKOF); float* ROWW = (float*)(a.ws + WS_ROWW); float* RSDS = (float*)(a.ws + WS_RSDS);
    float* part = (float*)smem;
    float* ssqp = part + 8 * 32 * 33;
    int* lcnt = (int*)(ssqp + 256); int* lbase = lcnt + 32; int* te = lbase + 32; int* trk = te + 256; float* tw = (float*)(trk + 256); float* trs = tw + 256;
    const int tid = TID(), lane = tid & 63, wid = tid >> 6, i32 = lane & 31, kh = lane >> 5; const int tg = wid >> 2, kq = wid & 3;
    for (int item = BID(); item < 256; item += gridDim.x) {
        const int tok = item * 64 + tg * 32 + i32;
        if (tid < 32) lcnt[tid] = 0;
        f32x16 acc = (f32x16){}; float ss = 0.f;
        const bf16_t* hrow = H1 + (size_t)tok * 1024 + 256 * kq + 8 * kh; const float* lrow = ln2 + 256 * kq + 8 * kh; bf16_t* xrow = XN + (size_t)tok * 1024 + 256 * kq + 8 * kh;
        const float* wbase = wr_ + (size_t)(256 * kq + 8 * kh) * 32 + i32;
#pragma unroll 1
        for (int hb = 0; hb < 2; ++hb) {
            float4 hv[8][2], lv[8][2]; float wv[8][8];
#pragma unroll
            for (int c = 0; c < 8; ++c) { const int cc = hb * 8 + c;
                { const uint4 hq = *(const uint4*)(hrow + 16 * cc); hv[c][0] = (float4){bflo(hq.x), bfhi(hq.x), bflo(hq.y), bfhi(hq.y)}; hv[c][1] = (float4){bflo(hq.z), bfhi(hq.z), bflo(hq.w), bfhi(hq.w)}; } lv[c][0] = *(const float4*)(lrow + 16 * cc); lv[c][1] = *(const float4*)(lrow + 16 * cc + 4);
#pragma unroll
                for (int r = 0; r < 8; ++r) wv[c][r] = wbase[(size_t)(16 * cc + r) * 32]; }
#pragma unroll
            for (int c = 0; c < 8; ++c) { const int cc = hb * 8 + c; float x[8];
                x[0] = hv[c][0].x * lv[c][0].x; x[1] = hv[c][0].y * lv[c][0].y; x[2] = hv[c][0].z * lv[c][0].z; x[3] = hv[c][0].w * lv[c][0].w;
                x[4] = hv[c][1].x * lv[c][1].x; x[5] = hv[c][1].y * lv[c][1].y; x[6] = hv[c][1].z * lv[c][1].z; x[7] = hv[c][1].w * lv[c][1].w;
                ss += hv[c][0].x * hv[c][0].x + hv[c][0].y * hv[c][0].y + hv[c][0].z * hv[c][0].z + hv[c][0].w * hv[c][0].w + hv[c][1].x * hv[c][1].x + hv[c][1].y * hv[c][1].y + hv[c][1].z * hv[c][1].z + hv[c][1].w * hv[c][1].w;
#pragma unroll
                for (int r = 0; r < 8; ++r) acc = __builtin_amdgcn_mfma_f32_32x32x2f32(x[r], wv[c][r], acc, 0, 0, 0); }
        }
        ss = pair_sum(ss);
        if (kh == 0) ssqp[wid * 32 + i32] = ss;
#pragma unroll
        for (int r = 0; r < 16; ++r) part[(wid * 32 + crow(r, kh)) * 33 + i32] = acc[r];
        __syncthreads();
        if (tid < 64) {
            const int g_ = tid >> 5, i_ = tid & 31; const int w0_ = g_ * 4;
            const float sq = ssqp[(w0_ + 0) * 32 + i_] + ssqp[(w0_ + 1) * 32 + i_] + ssqp[(w0_ + 2) * 32 + i_] + ssqp[(w0_ + 3) * 32 + i_]; const float rstd = rsqrtf(sq * (1.f / 1024.f) + EPS);
            RSTD2[item * 64 + tid] = rstd; trs[tid] = rstd;
            float lg[32];
#pragma unroll
            for (int e = 0; e < 32; ++e) lg[e] = (part[((w0_ + 0) * 32 + i_) * 33 + e] + part[((w0_ + 1) * 32 + i_) * 33 + e] + part[((w0_ + 2) * 32 + i_) * 33 + e] + part[((w0_ + 3) * 32 + i_) * 33 + e]) * rstd + br[e];
            unsigned taken = 0u; float tv[4]; int ti[4];
#pragma unroll
            for (int k = 0; k < 4; ++k) { float best = -3.0e38f; int bi = 0;
#pragma unroll
                for (int e = 0; e < 32; ++e) { const bool ok = !((taken >> e) & 1u) && lg[e] > best; best = ok ? lg[e] : best; bi = ok ? e : bi; }
                taken |= 1u << bi; tv[k] = best; ti[k] = bi; }
            const float e1 = __expf(tv[1] - tv[0]), e2 = __expf(tv[2] - tv[0]), e3 = __expf(tv[3] - tv[0]); const float inv = 1.0f / (1.0f + e1 + e2 + e3);
            const float wv[4] = {inv, e1 * inv, e2 * inv, e3 * inv};
#pragma unroll
            for (int k = 0; k < 4; ++k) { const int idx = tid * 4 + k; te[idx] = ti[k]; trk[idx] = atomicAdd(&lcnt[ti[k]], 1); tw[idx] = wv[k]; }
        }
        __syncthreads();
        if (tid < 32) lbase[tid] = atomicAdd(&CNT[tid], lcnt[tid]);
        __syncthreads();
        if (tid < 256) { const int idx = tid; const int tk = item * 64 + (idx >> 2); const int e = te[idx]; const int slot = lbase[e] + trk[idx];
          TOPI[(size_t)tk * 4 + (idx & 3)] = e; TOPS[(size_t)tk * 4 + (idx & 3)] = slot; TOPW[(size_t)tk * 4 + (idx & 3)] = tw[idx];
          TOKOF[(size_t)e * 16384 + slot] = tk; ROWW[(size_t)e * 16384 + slot] = tw[idx]; RSDS[(size_t)e * 16384 + slot] = trs[idx >> 2]; }
        __syncthreads();
    }
}

struct MoeMap { int e, mt, nt, cnt, off; };
DEV void moe_setup(const Args& a, int* sm) {
    if (TID() == 0) { const int* CNT = (const int*)(a.ws + WS_CTL); int tot = 0; for (int e = 0; e < 32; ++e) { const int c = CNT[e]; const int mt = (c + 255) >> 8; sm[e] = mt; sm[32 + e] = tot; tot += mt; } sm[64] = tot; }
    __syncthreads();
}
DEV MoeMap moe_map(const Args& a, const int* sm, int item, int NT) {
    MoeMap mm; int e = 0;
#pragma unroll 1
    for (int i = 1; i < 32; ++i) if (item >= sm[32 + i] * NT) e = i;
    const int local = item - sm[32 + e] * NT; const int mte = sm[e];
    int mt_, nt_; patch_decode(local, mte, NT, mt_, nt_);
    mm.e = __builtin_amdgcn_readfirstlane(e); mm.mt = __builtin_amdgcn_readfirstlane(mt_); mm.nt = __builtin_amdgcn_readfirstlane(nt_);
    mm.cnt = __builtin_amdgcn_readfirstlane(((const int*)(a.ws + WS_CTL))[e]); mm.off = __builtin_amdgcn_readfirstlane(sm[32 + e] * 256); return mm;
}
DEV int moe_maps_build(const Args& a, const int* sm, int* maps, int nitems, int NT) {
    const int tid = TID(); const int first = VBID(); const int nmine = first < nitems ? (nitems - first + (int)gridDim.x - 1) / (int)gridDim.x : 0;
    for (int k = tid; k < nmine && k < 64; k += NTHR) { const int item = first + k * (int)gridDim.x; int e = 0;
#pragma unroll 1
        for (int i = 1; i < 32; ++i) if (item >= sm[32 + i] * NT) e = i;
        const int local = item - sm[32 + e] * NT; int mt_, nt_; patch_decode(local, sm[e], NT, mt_, nt_);
        maps[k * 8] = e; maps[k * 8 + 1] = mt_; maps[k * 8 + 2] = nt_; maps[k * 8 + 3] = ((const int*)(a.ws + WS_CTL))[e]; maps[k * 8 + 4] = sm[32 + e] * 256; }
    __syncthreads();
    return nmine < 64 ? nmine : 64;
}
DEV MoeMap moe_get(const int* maps, int k) { MoeMap mm; mm.e = __builtin_amdgcn_readfirstlane(maps[k * 8]); mm.mt = __builtin_amdgcn_readfirstlane(maps[k * 8 + 1]); mm.nt = __builtin_amdgcn_readfirstlane(maps[k * 8 + 2]);
    mm.cnt = __builtin_amdgcn_readfirstlane(maps[k * 8 + 3]); mm.off = __builtin_amdgcn_readfirstlane(maps[k * 8 + 4]); return mm; }
DEV void phase_up(const Args& a, unsigned char* smem) {
    int* sm = (int*)(smem + MISC_OFF); int* maps = (int*)(smem + MISC_OFF + 8192); int* tokb = maps + 512; float* rsdb = (float*)(tokb + 768); float* biab = rsdb + 768;
    static_assert(8192 + (512 + 3 * 768) * 4 <= 8192 + 12288, "misc LDS");
    const bf16_t* XN = (const bf16_t*)(a.ws + WS_H1); const bf16_t* W = (const bf16_t*)(a.ws + WS_WUP); bf16_t* ACT = (bf16_t*)(a.ws + WS_ACT); const float* RSDS = (const float*)(a.ws + WS_RSDS);
    const int* TOKOF = (const int*)(a.ws + WS_TOKOF); const float* bup = a.in[I_BUP];
    const int tid = TID(); int lane = tid & 63, wid = tid >> 6, wr = wid >> 2, wc = wid & 3; (void)wr; (void)wc; (void)lane;
    moe_setup(a, sm);
    const int nitems = __builtin_amdgcn_readfirstlane(sm[64]) * 8;
    const int nmine = __builtin_amdgcn_readfirstlane(moe_maps_build(a, sm, maps, nitems, 8));
    int tkr = 0; float rsr = 0.f, bir = 0.f;
    const int t8 = tid & 255;
    auto side_load = [&](const MoeMap& m_) { const int slot = m_.mt * 256 + t8; const bool ok = slot < m_.cnt; const size_t sl_ = (size_t)m_.e * 16384 + (ok ? slot : 0); const int tk_ = TOKOF[sl_]; const float rs_ = RSDS[sl_]; tkr = ok ? tk_ : 0; rsr = ok ? rs_ : 0.f;
        bir = bup[(size_t)m_.e * 2048 + (t8 < 128 ? m_.nt * 128 + t8 : 1024 + m_.nt * 128 + t8 - 128)]; };
    auto side_store = [&](int slot3) { tokb[slot3 * 256 + t8] = tkr; rsdb[slot3 * 256 + t8] = rsr; biab[slot3 * 256 + t8] = bir; };
    auto boffu = [](int k, int nc) { const int sc = ((nc >> 4) ? 1024 : 0) + (nc & 15) * 8; return (unsigned)(k * 4096 + sc * 2); };
    MoeMap mm{}, mn{};
    if (nmine > 0) { mm = moe_get(maps, 0); side_load(mm); side_store(0); }
    if (nmine > 1) { mn = moe_get(maps, 1); side_load(mn); side_store(1); }
    __syncthreads();
    bool pre = false;
    for (int k = 0; k < nmine; ++k) {
        const bool has_next = k + 1 < nmine, has_nn = k + 2 < nmine;
        { const MoeMap m2 = moe_get(maps, has_nn ? k + 2 : nmine - 1); side_load(m2); }
        const int s0 = k % 3, s1 = (k + 1) % 3, s2 = (k + 2) % 3;
        const int* tok = tokb + s0 * 256; const int* tokn = tokb + s1 * 256; const float* rsd = rsdb + s0 * 256; const float* bia = biab + s0 * 256;
        const bf16_t* We = W + (size_t)mm.e * 1024 * 2048; const bf16_t* Wn = W + (size_t)mn.e * 1024 * 2048;
        f32x4 acc[8][4];
        gemm256<true>(smem, 16, XN, 128u, [&](int r, int kc) { return (unsigned)(tok[r] * 2048 + kc * 16); }, We + mm.nt * 128, 64u * 4096u, boffu, acc, pre,
                      next_tile(has_next, smem, XN, [&](int r, int kc) { return (unsigned)(tokn[r] * 2048 + kc * 16); }, Wn + mn.nt * 128, boffu));
        side_store(s2);
        EPI_IDS();
        float bgv[2][4], blv[2][4];
#pragma unroll
        for (int ni = 0; ni < 2; ++ni) { const int jl = wc * 32 + ni * 16 + 4 * (lane >> 4); const float4 bg = *(const float4*)(bia + jl), bl_ = *(const float4*)(bia + 128 + jl);
            bgv[ni][0] = bg.x; bgv[ni][1] = bg.y; bgv[ni][2] = bg.z; bgv[ni][3] = bg.w; blv[ni][0] = bl_.x; blv[ni][1] = bl_.y; blv[ni][2] = bl_.z; blv[ni][3] = bl_.w; }
#pragma unroll
        for (int mi = 0; mi < 8; ++mi) { const int rl_ = G_ROW(mi); const size_t row = (size_t)mm.off + mm.mt * 256 + rl_; const float rs_ = rsd[rl_];
            uint2 o2[2];
#pragma unroll
            for (int ni = 0; ni < 2; ++ni) {
                const f32x4 gv = acc[mi][ni], lv = acc[mi][ni + 2]; float r4[4];
#pragma unroll
                for (int r = 0; r < 4; ++r) { const float gg = fminf(gv[r] * rs_ + bgv[ni][r], 7.0f); const float ll = fminf(fmaxf(lv[r] * rs_ + blv[ni][r], -7.0f), 7.0f); r4[r] = gg * sigmoidf_(1.702f * gg) * (ll + 1.0f); }
                o2[ni].x = cvtpk(r4[0], r4[1]); o2[ni].y = cvtpk(r4[2], r4[3]); }
            { const int c0 = wc * 32 + 4 * (lane >> 4); *(uint4*)(ACT + row * 1024 + mm.nt * 128 + PAIR16_COL(c0, c0 + 16)) = pair16(o2[0], o2[1]); } }
        lds_barrier();
        mm = mn; if (has_nn) mn = moe_get(maps, k + 2); pre = has_next;
    }
}
DEV void phase_down(const Args& a, unsigned char* smem) {
    int* sm = (int*)(smem + MISC_OFF); int* maps = (int*)(smem + MISC_OFF + 8192); float* rwb = (float*)(maps + 512); float* biab = rwb + 768;
    const bf16_t* ACT = (const bf16_t*)(a.ws + WS_ACT); const bf16_t* W = (const bf16_t*)(a.ws + WS_WDN); bf16_t* Y = (bf16_t*)(a.ws + WS_Y);
    const float* ROWW = (const float*)(a.ws + WS_ROWW); const float* bdn = a.in[I_BDN];
    const int tid = TID(); int lane = tid & 63, wid = tid >> 6, wr = wid >> 2, wc = wid & 3; (void)wr; (void)wc; (void)lane;
    moe_setup(a, sm);
    const int nitems = __builtin_amdgcn_readfirstlane(sm[64]) * 4;
    const int nmine = __builtin_amdgcn_readfirstlane(moe_maps_build(a, sm, maps, nitems, 4));
    float rwr = 0.f, bir = 0.f;
    const int t8 = tid & 255;
    auto side_load = [&](const MoeMap& m_) { const int slot = m_.mt * 256 + t8; const bool ok = slot < m_.cnt; const float rw_ = ROWW[(size_t)m_.e * 16384 + (ok ? slot : 0)]; rwr = ok ? rw_ : 0.f; bir = bdn[(size_t)m_.e * 1024 + m_.nt * 256 + t8]; };
    auto side_store = [&](int slot3) { rwb[slot3 * 256 + t8] = rwr; biab[slot3 * 256 + t8] = bir; };
    auto aoffd = [](int r, int kc) { return (unsigned)(r * 2048 + kc * 16); }; auto boffd = [](int k, int nc) { return (unsigned)(k * 2048 + nc * 16); };
    MoeMap mm{}, mn{};
    if (nmine > 0) { mm = moe_get(maps, 0); side_load(mm); side_store(0); }
    if (nmine > 1) { mn = moe_get(maps, 1); side_load(mn); side_store(1); }
    __syncthreads();
    bool pre = false;
    for (int k = 0; k < nmine; ++k) {
        const bool has_next = k + 1 < nmine, has_nn = k + 2 < nmine;
        { const MoeMap m2 = moe_get(maps, has_nn ? k + 2 : nmine - 1); side_load(m2); }
        const int s0 = k % 3, s2 = (k + 2) % 3;
        const float* rw = rwb + s0 * 256; const float* bia = biab + s0 * 256;
        const bf16_t* We = W + (size_t)mm.e * 1024 * 1024; const bf16_t* Ab = ACT + ((size_t)mm.off + mm.mt * 256) * 1024;
        const bf16_t* Wn = W + (size_t)mn.e * 1024 * 1024; const bf16_t* An = ACT + ((size_t)mn.off + mn.mt * 256) * 1024;
        f32x4 acc[8][4];
        gemm256<true>(smem, 16, Ab, 128u, aoffd, We + mm.nt * 256, 64u * 2048u, boffd, acc, pre,
                      next_tile(has_next, smem, An, aoffd, Wn + mn.nt * 256, boffd));
        side_store(s2);
        EPI_IDS();
        float4 bb[4];
#pragma unroll
        for (int ni = 0; ni < 4; ++ni) bb[ni] = *(const float4*)(bia + G_COL(ni));
#pragma unroll
        for (int mi = 0; mi < 8; ++mi) { const int rl = G_ROW(mi); const size_t row = (size_t)mm.off + mm.mt * 256 + rl; const float w = rw[rl];
#pragma unroll
            for (int np = 0; np < 2; ++np) { uint2 o2[2];
#pragma unroll
                for (int h = 0; h < 2; ++h) { const int ni = 2 * np + h; const f32x4 v = acc[mi][ni]; o2[h].x = cvtpk((v[0] + bb[ni].x) * w, (v[1] + bb[ni].y) * w); o2[h].y = cvtpk((v[2] + bb[ni].z) * w, (v[3] + bb[ni].w) * w); }
                *(uint4*)(Y + row * 1024 + mm.nt * 256 + PAIR16_COL(G_COL(2 * np), G_COL(2 * np + 1))) = pair16(o2[0], o2[1]); } }
        lds_barrier();
        mm = mn; if (has_nn) mn = moe_get(maps, k + 2); pre = has_next;
    }
}

DEV void phase_comb(const Args& a, unsigned char* smem) {
    int* sm = (int*)(smem + MISC_OFF);
    moe_setup(a, sm);
    bf16_t* H1 = (bf16_t*)(a.ws + WS_H1); const bf16_t* Y = (const bf16_t*)(a.ws + WS_Y);
    const int* TOPI = (const int*)(a.ws + WS_TOPI); const int* TOPS = (const int*)(a.ws + WS_TOPS);
    const int lane = TID() & 63; const int gw = BID() * NWAVE + (TID() >> 6), ngw = gridDim.x * NWAVE;
    for (int tok = gw; tok < NTOK; tok += ngw) {
        float4 v[4];
#pragma unroll
        for (int j = 0; j < 4; ++j) { const uint2 hq = *(const uint2*)(H1 + (size_t)tok * 1024 + j * 256 + lane * 4); v[j] = (float4){bflo(hq.x), bfhi(hq.x), bflo(hq.y), bfhi(hq.y)}; }
#pragma unroll
        for (int k = 0; k < 4; ++k) { const int e = TOPI[(size_t)tok * 4 + k]; const size_t row = (size_t)sm[32 + e] * 256 + TOPS[(size_t)tok * 4 + k];
#pragma unroll
            for (int j = 0; j < 4; ++j) { const uint2 u = *(const uint2*)(Y + row * 1024 + j * 256 + lane * 4); v[j].x += bflo(u.x); v[j].y += bfhi(u.x); v[j].z += bflo(u.y); v[j].w += bfhi(u.y); } }
        float s = 0.f;
#pragma unroll
        for (int j = 0; j < 4; ++j) { { uint2 hq; hq.x = cvtpk(v[j].x, v[j].y); hq.y = cvtpk(v[j].z, v[j].w); *(uint2*)(H1 + (size_t)tok * 1024 + j * 256 + lane * 4) = hq; } s += v[j].x * v[j].x + v[j].y * v[j].y + v[j].z * v[j].z + v[j].w * v[j].w; }
        const float rstd = rsqrtf(wave_sum(s) * (1.f / 1024.f) + EPS);
        if (lane == 0) ((float*)(a.ws + WS_RSTD3))[tok] = rstd;
    }
}

DEV void phase_gate(const Args& a, unsigned char* smem) {
    const bf16_t* XN = (const bf16_t*)(a.ws + WS_H1); const float* RSTD3 = (const float*)(a.ws + WS_RSTD3); const bf16_t* WG = (const bf16_t*)(a.ws + WS_WGATE); const bf16_t* PB = (const bf16_t*)(a.ws + WS_PB); const bf16_t* WP = (const bf16_t*)(a.ws + WS_WPLE);
    const bf16_t* H2 = (const bf16_t*)(a.ws + WS_H1); float* OUT = a.out; float* SSQ3 = (float*)(a.ws + WS_SSQ3);
    const int tid = TID(); int lane = tid & 63, wid = tid >> 6, wr = wid >> 2, wc = wid & 3; (void)wr; (void)wc; (void)lane;
    bf16_t* GT = (bf16_t*)(a.ws + WS_ACT);
    auto aoffg = [](int r, int kc) { return (unsigned)(r * 2048 + kc * 16); }; auto aoffp = [](int r, int kc) { return (unsigned)(r * 512 + kc * 16); }; auto boffg = [](int k, int nc) { return (unsigned)(k * 2048 + nc * 16); };
    for (int item = VBID(); item < 64 * 4; item += gridDim.x) {
        int mt, nt; patch_decode(item, 64, 4, mt, nt);
        f32x4 acc[8][4];
        gemm256<true>(smem, 16, XN + (size_t)mt * 256 * 1024, 128u, aoffg, WG + nt * 256, 64u * 2048u, boffg, acc, false,
                      next_tile(true, smem, PB + (size_t)mt * 256 * 256, aoffp, WP + nt * 256, boffg));
        EPI_IDS();
#pragma unroll
        for (int hb = 0; hb < 2; ++hb) {
            uint2 wq[4][4]; uint4 hq[4][2];
#pragma unroll
            for (int m4 = 0; m4 < 4; ++m4) { const int mi = hb * 4 + m4; const size_t gm = (size_t)mt * 256 + G_ROW(mi);
#pragma unroll
                for (int np = 0; np < 2; ++np) hq[m4][np] = *(const uint4*)(H2 + gm * 1024 + nt * 256 + PAIR16_COL(G_COL(2 * np), G_COL(2 * np + 1)));
                const float r3 = RSTD3[gm];
#pragma unroll
                for (int ni = 0; ni < 4; ++ni) { const f32x4 v = acc[mi][ni] * r3;
                    uint2 w; w.x = cvtpk(sigmoidf_(v[0]), sigmoidf_(v[1])); w.y = cvtpk(sigmoidf_(v[2]), sigmoidf_(v[3])); wq[m4][ni] = w; } }
#pragma unroll
            for (int m4 = 0; m4 < 4; ++m4) { const int mi = hb * 4 + m4; const size_t gm = (size_t)mt * 256 + G_ROW(mi);
#pragma unroll
                for (int np = 0; np < 2; ++np) { uint2 h2[2]; unpair16(hq[m4][np], h2[0], h2[1]);
                    *(uint4*)(GT + gm * 1024 + nt * 256 + PAIR16_COL(G_COL(2 * np), G_COL(2 * np + 1))) = pair16(wq[m4][2 * np], wq[m4][2 * np + 1]);
#pragma unroll
                    for (int h = 0; h < 2; ++h) { const int ni = 2 * np + h; const uint2 w = wq[m4][ni]; const uint2 hh = h2[h];
                        acc[mi][ni] = (f32x4){bflo(hh.x) * __builtin_amdgcn_rcpf(bflo(w.x)), bfhi(hh.x) * __builtin_amdgcn_rcpf(bfhi(w.x)), bflo(hh.y) * __builtin_amdgcn_rcpf(bflo(w.y)), bfhi(hh.y) * __builtin_amdgcn_rcpf(bfhi(w.y))}; } } }
            asm volatile("" ::: "memory");
        }
        gemm256<false>(smem, 4, PB + (size_t)mt * 256 * 256, 128u, aoffp, WP + nt * 256, 64u * 2048u, boffg, acc, true);
        EPI_IDS();
        const bool fused = gridDim.x >= 256;
#pragma unroll
        for (int hb = 0; hb < 2; ++hb) {
            uint4 gq4[4][2];
#pragma unroll
            for (int m4 = 0; m4 < 4; ++m4) { const size_t gm = (size_t)mt * 256 + G_ROW(hb * 4 + m4);
#pragma unroll
                for (int np = 0; np < 2; ++np) gq4[m4][np] = *(const uint4*)(GT + gm * 1024 + nt * 256 + PAIR16_COL(G_COL(2 * np), G_COL(2 * np + 1))); }
#pragma unroll
            for (int m4 = 0; m4 < 4; ++m4) { const int mi = hb * 4 + m4; const size_t gm = (size_t)mt * 256 + G_ROW(mi); float ss = 0.f;
#pragma unroll
                for (int np = 0; np < 2; ++np) { uint2 g2[2]; unpair16(gq4[m4][np], g2[0], g2[1]);
#pragma unroll
                    for (int h = 0; h < 2; ++h) { const int ni = 2 * np + h; const int n = nt * 256 + G_COL(ni); const f32x4 v = acc[mi][ni]; const uint2 gw = g2[h];
                        float4 o = {v[0] * bflo(gw.x), v[1] * bfhi(gw.x), v[2] * bflo(gw.y), v[3] * bfhi(gw.y)};
                        if (!fused) *(float4*)(OUT + gm * 1024 + n) = o;
                        acc[mi][ni] = (f32x4){o.x, o.y, o.z, o.w};
                        ss += o.x * o.x + o.y * o.y + o.z * o.z + o.w * o.w; } }
                ss += __shfl_xor(ss, 16); ss += __shfl_xor(ss, 32);
                if (lane < 16) SSQ3[gm * 16 + nt * 4 + wc] = ss; }
            asm volatile("" ::: "memory");
        }
        if (fused) {
            unsigned* flag = (unsigned*)(a.ws + WS_CTL) + CW_GATEFLAG + mt;
            const float* lnf = a.in[I_LNF]; float4 gg[4];
#pragma unroll
            for (int ni = 0; ni < 4; ++ni) gg[ni] = *(const float4*)(lnf + nt * 256 + G_COL(ni));
            signal_done(flag); wait_flag(flag, 4u);
            float rstd[8];
#pragma unroll
            for (int mi = 0; mi < 8; ++mi) { const size_t gm = (size_t)mt * 256 + G_ROW(mi); const float4 s0 = *(const float4*)(SSQ3 + gm * 16 + 4 * (lane >> 4)); rstd[mi] = (s0.x + s0.y) + (s0.z + s0.w); }
#pragma unroll
            for (int mi = 0; mi < 8; ++mi) { float t_ = rstd[mi]; t_ += __shfl_xor(t_, 16); t_ += __shfl_xor(t_, 32); rstd[mi] = rsqrtf(t_ * (1.f / 1024.f) + EPS); }
#pragma unroll
            for (int mi = 0; mi < 8; ++mi) { const size_t gm = (size_t)mt * 256 + G_ROW(mi);
#pragma unroll
                for (int ni = 0; ni < 4; ++ni) { const int n = nt * 256 + G_COL(ni); const f32x4 v = acc[mi][ni]; const float r_ = rstd[mi];
                    float4 o = {v[0] * r_ * gg[ni].x, v[1] * r_ * gg[ni].y, v[2] * r_ * gg[ni].z, v[3] * r_ * gg[ni].w}; *(float4*)(OUT + gm * 1024 + n) = o; } }
        }
        __syncthreads();
    }
}

DEV void phase_final(const Args& a) {
    if (gridDim.x >= 256) return;
    float* OUT = a.out; const float* SSQ3 = (const float*)(a.ws + WS_SSQ3); const float* g = a.in[I_LNF];
    const int lane = TID() & 63; const int gw = BID() * NWAVE + (TID() >> 6), ngw = gridDim.x * NWAVE;
    for (int m = gw; m < NTOK; m += ngw) {
        float s = 0.f;
#pragma unroll
        for (int j = 0; j < 16; ++j) s += SSQ3[(size_t)m * 16 + j];
        const float rstd = rsqrtf(s * (1.f / 1024.f) + EPS);
#pragma unroll
        for (int j = 0; j < 4; ++j) { float4 v = *(const float4*)(OUT + (size_t)m * 1024 + j * 256 + lane * 4); const float4 gg = *(const float4*)(g + j * 256 + lane * 4);
            v.x *= rstd * gg.x; v.y *= rstd * gg.y; v.z *= rstd * gg.z; v.w *= rstd * gg.w; *(float4*)(OUT + (size_t)m * 1024 + j * 256 + lane * 4) = v; }
    }
}

template <int PH> DEV void run_phase(const Args& a, unsigned char* smem) {
    if constexpr (PH == PH_PRO) phase_prologue(a, smem);
    else if constexpr (PH == PH_INPROJ) phase_inproj(a, smem);
    else if constexpr (PH == PH_ATT) phase_att(a, smem);
    else if constexpr (PH == PH_OUTPROJ) phase_outproj(a, smem);
    else if constexpr (PH == PH_ROUTE) phase_route(a, smem);
    else if constexpr (PH == PH_UP) phase_up(a, smem);
    else if constexpr (PH == PH_DOWN) phase_down(a, smem);
    else if constexpr (PH == PH_COMB) phase_comb(a, smem);
    else if constexpr (PH == PH_GATE) phase_gate(a, smem);
    else if constexpr (PH == PH_FINAL) phase_final(a);
}
#define XB_TMO      128
#define XB_XCNT(j)  (256  + 64 * (j))
#define XB_XSUB(j)  (1280 + 64 * (j))
#define XB_XGEN(j)  (2304 + 64 * (j))
#define XB_TOP      3328
#define XB_TOPGEN   3392
#define XCD_BAR_WORDS 3456
#define XB_SPIN_CAP (1u << 22)
DEV unsigned xb_ld(unsigned* p)              { return __hip_atomic_load(p, __ATOMIC_RELAXED, __HIP_MEMORY_SCOPE_AGENT); }
DEV unsigned xb_add(unsigned* p, unsigned v) { return __hip_atomic_fetch_add(p, v, __ATOMIC_RELAXED, __HIP_MEMORY_SCOPE_AGENT); }
DEV unsigned xb_xcc_id() { return (unsigned)__builtin_amdgcn_s_getreg((3 << 11) | 20) & 0xFu; }
#define XB_SPIN(cond, bar) do { unsigned _sp = 0; while (cond) { __builtin_amdgcn_s_sleep(1); \
    if ((++_sp & 255u) == 0u) { if (xb_ld(&(bar)[XB_TMO])) break; if (_sp > XB_SPIN_CAP) { atomicAdd(&(bar)[XB_TMO], 1u); break; } } } } while (0)
struct XcdBarrier { unsigned* bar; unsigned x; volatile LAS unsigned* st; };
DEV XcdBarrier xcd_barrier_post(unsigned* bar, volatile LAS unsigned* st) {
    XcdBarrier b; b.bar = bar; b.x = xb_xcc_id(); b.st = st;
    if (TID() == 0) (void)xb_add(&bar[XB_XCNT(b.x)], 1u);
    return b;
}
DEV void xcd_barrier_complete(unsigned* bar, unsigned x, unsigned& nloc, unsigned& nx) {
    const unsigned G = gridDim.x * gridDim.y * gridDim.z;
    unsigned sum, cnt, mine, sp = 0u;
    for (;;) {
        sum = 0u; cnt = 0u; mine = 0u;
#pragma unroll
        for (unsigned j = 0; j < 16; ++j) { const unsigned c = xb_ld(&bar[XB_XCNT(j)]); sum += c; cnt += (c > 0u) ? 1u : 0u; mine = (j == x) ? c : mine; }
        if (sum == G) break;
        __builtin_amdgcn_s_sleep(1);
        if ((++sp & 255u) == 0u) { if (xb_ld(&bar[XB_TMO])) break; if (sp > XB_SPIN_CAP) { atomicAdd(&bar[XB_TMO], 1u); break; } }
    }
    nloc = mine > 0u ? mine : 1u; nx = cnt > 0u ? cnt : 1u;
}
DEV void xcd_barrier(const XcdBarrier& b) {
    asm volatile("s_waitcnt vmcnt(0)" ::: "memory");
    __syncthreads();
    if (TID() == 0) {
        unsigned* bar = b.bar;
        __builtin_amdgcn_s_waitcnt(0);
        unsigned nloc = b.st[0], nx = b.st[1];
        if (nloc == 0u) { xcd_barrier_complete(bar, b.x, nloc, nx); b.st[0] = nloc; b.st[1] = nx; }
        const unsigned old = xb_add(&bar[XB_XSUB(b.x)], 1u);
        const unsigned gen = old / nloc;
        if (old + 1u == (gen + 1u) * nloc) {
            __builtin_amdgcn_fence(__ATOMIC_RELEASE, "agent");
            asm volatile("s_waitcnt vmcnt(0)" ::: "memory");
            const unsigned og = xb_add(&bar[XB_TOP], 1u);
            const unsigned tg = og / nx;
            if (og + 1u == (tg + 1u) * nx) xb_add(&bar[XB_TOPGEN], 1u);
            else XB_SPIN(xb_ld(&bar[XB_TOPGEN]) == tg, bar);
            __builtin_amdgcn_fence(__ATOMIC_ACQUIRE, "agent");
            xb_add(&bar[XB_XGEN(b.x)], 1u);
            asm volatile("s_waitcnt vmcnt(0)" ::: "memory");
        } else {
            XB_SPIN(xb_ld(&bar[XB_XGEN(b.x)]) == gen, bar);
            __builtin_amdgcn_fence(__ATOMIC_ACQUIRE, "agent");
            asm volatile("s_waitcnt vmcnt(0)" ::: "memory");
        }
    }
    __syncthreads();
}

__global__ void __launch_bounds__(NTHR, 2) mega(Args a) {
    extern __shared__ __attribute__((aligned(16))) unsigned char smem[];
    volatile LAS unsigned* bst = (volatile LAS unsigned*)(LAS unsigned char*)(smem + MISC_OFF + 8000);
    if (TID() == 0) { bst[0] = 0u; bst[1] = 0u; }
    __syncthreads();
    const XcdBarrier bar = xcd_barrier_post((unsigned*)(a.ws + WS_CTL) + 4096, bst);
#define GSYNC() xcd_barrier(bar)
#define RUN(ph) do { run_phase<ph>(a, smem); if ((PROBE_DUP >> ph) & 1) { GSYNC(); run_phase<ph>(a, smem); } } while (0)
    RUN(PH_PRO); GSYNC();
    RUN(PH_INPROJ); GSYNC();
    RUN(PH_ATT); GSYNC();
    RUN(PH_OUTPROJ); GSYNC();
    RUN(PH_ROUTE); GSYNC();
    RUN(PH_UP); GSYNC();
    RUN(PH_DOWN); GSYNC();
    RUN(PH_COMB); GSYNC();
    RUN(PH_GATE);
    if (gridDim.x < 256) { GSYNC(); RUN(PH_FINAL); }
#undef RUN
#undef GSYNC
}

extern "C" void kernel_launch(void* const* d_in, const int* in_sizes, int n_in, void* d_out, int out_size, void* d_ws, size_t ws_size, hipStream_t stream) {
    static int grid = 0;
    if (grid == 0) {
        if (n_in != 25 || ws_size < WS_END) { fprintf(stderr, "kernel_launch: unexpected n_in %d / ws %zu\n", n_in, ws_size); grid = -1; return; }
        int dev = 0, cus = 0, per_cu = 0;
        (void)hipGetDevice(&dev); (void)hipDeviceGetAttribute(&cus, hipDeviceAttributeMultiprocessorCount, dev);
        (void)hipFuncSetAttribute((const void*)mega, hipFuncAttributeMaxDynamicSharedMemorySize, LDS_BYTES);
        (void)hipOccupancyMaxActiveBlocksPerMultiprocessor(&per_cu, (const void*)mega, NTHR, LDS_BYTES);
        if (per_cu < 1) { fprintf(stderr, "kernel_launch: occupancy query says %d blocks per CU\n", per_cu); grid = -1; return; }
        grid = cus;
    }
    if (grid < 0) return;
    (void)hipMemsetAsync((char*)d_ws + WS_CTL, 0, 65536, stream);
    Args a{};
    for (int i = 0; i < 25; ++i) a.in[i] = (const float*)d_in[i];
    a.out = (float*)d_out; a.ws = (unsigned char*)d_ws; a.ph_lo = 0; a.ph_hi = PH_N;
    void* args[] = {&a};
    hipError_t e = hipLaunchCooperativeKernel((const void*)mega, dim3(grid), dim3(NTHR), args, LDS_BYTES, stream);
    if (e != hipSuccess) fprintf(stderr, "cooperative launch failed: %s (grid %d)\n", hipGetErrorString(e), grid);
}
```

```cpp
#include <hip/hip_runtime.h>
#include <stdint.h>
#include <cstdio>

#define DEV __device__ __forceinline__
#define LAS __attribute__((address_space(3)))

typedef unsigned short bf16_t;
typedef short bf16x8 __attribute__((ext_vector_type(8)));
typedef short s16x4 __attribute__((ext_vector_type(4)));
typedef float f32x4 __attribute__((ext_vector_type(4)));
typedef float f32x16 __attribute__((ext_vector_type(16)));
typedef float f32x2_t __attribute__((ext_vector_type(2)));
typedef __bf16 bf16x2_t __attribute__((ext_vector_type(2)));

constexpr int NTHR = 512, NWAVE = 8;
constexpr int NTOK = 16384;
constexpr float EPS = 1e-6f;
constexpr float LOG2E = 1.4426950408889634f;
constexpr float QS = 0.125f * LOG2E;
constexpr int NWIN = 3072;

constexpr size_t MiB = 1u << 20;
constexpr size_t WS_CTL = 0;
constexpr size_t WS_WIN = 1 * MiB;
constexpr size_t WS_WOUT = 7 * MiB;
constexpr size_t WS_WGATE = 9 * MiB;
constexpr size_t WS_WPLE = 11 * MiB;
constexpr size_t WS_WC1 = 12 * MiB;
constexpr size_t WS_WC2 = 15 * MiB + 512 * 1024 + 262144;
constexpr size_t WS_BIAS1 = 15 * MiB + 512 * 1024 + 262144 + 131072;
constexpr size_t WS_KC = 14 * MiB;
constexpr size_t WS_HID = 14 * MiB + 512 * 1024;
constexpr size_t WS_GN = 16 * MiB;
constexpr size_t WS_LS = 18 * MiB;
constexpr size_t WS_CUM = 19 * MiB;
constexpr size_t WS_SSQ = 20 * MiB;
constexpr size_t WS_TOPI = 21 * MiB;
constexpr size_t WS_TOPS = 21 * MiB + 262144;
constexpr size_t WS_TOPW = 21 * MiB + 524288;
constexpr size_t WS_TOKOF = 22 * MiB;
constexpr size_t WS_ROWW = 24 * MiB;
constexpr size_t WS_SSQ3 = 26 * MiB;
constexpr size_t WS_RSTD2 = 27 * MiB;
constexpr size_t WS_RSTD1 = 27 * MiB + 196608;
constexpr size_t WS_ONE = 27 * MiB + 131072;
constexpr size_t WS_RSTD3 = 27 * MiB + 65536;
constexpr size_t WS_PB = 28 * MiB;
constexpr size_t WS_XN = 36 * MiB;
constexpr size_t WS_PROJ = 68 * MiB;
constexpr size_t WS_ONSA = 160 * MiB;
constexpr size_t WS_OFOX = 176 * MiB;
constexpr size_t WS_H1 = 192 * MiB;
constexpr size_t WS_WUP = 256 * MiB;
constexpr size_t WS_WDN = 384 * MiB;
constexpr size_t WS_ACT = 448 * MiB;
constexpr size_t WS_Y = 592 * MiB;
constexpr size_t WS_RSDS = 736 * MiB;
constexpr size_t WS_END = 738 * MiB;

enum { PH_PRO = 0, PH_INPROJ, PH_CMP, PH_ATT, PH_OUTPROJ, PH_ROUTE, PH_UP, PH_DOWN, PH_COMB, PH_GATE, PH_FINAL, PH_N };
struct Args { const float* in[25]; float* out; unsigned char* ws; int ph_lo, ph_hi; };
enum { I_X = 0, I_P, I_LN1, I_WIN, I_BFG, I_WC1K, I_WC2K, I_PEK, I_WC1V, I_WC2V, I_PEV, I_GNN, I_GNF, I_WOUT, I_LN2, I_WR, I_BR,
       I_WUP, I_BUP, I_WDN, I_BDN, I_LNPLE, I_WPLE, I_WGATE, I_LNF };

DEV int BID() { int b = (int)blockIdx.x; asm volatile("" : "+s"(b)); return b; }
DEV int VBID() { const int g = (int)gridDim.x, b = BID(); return (g & 7) ? b : (b & 7) * (g >> 3) + (b >> 3); }
DEV int TID() { int t = (int)__builtin_amdgcn_workitem_id_x(); asm volatile("" : "+v"(t)); return t; }
DEV unsigned cvtpk(float lo, float hi) { f32x2_t v = {lo, hi}; bf16x2_t b = __builtin_convertvector(v, bf16x2_t); return __builtin_bit_cast(unsigned, b); }
DEV float bflo(unsigned u) { return __uint_as_float(u << 16); }
DEV float bfhi(unsigned u) { return __uint_as_float(u & 0xffff0000u); }
DEV float wave_sum(float v) {
#pragma unroll
    for (int o = 1; o < 64; o <<= 1) v += __shfl_xor(v, o);
    return v;
}
#define DPP_MOV(x, ctrl) __builtin_bit_cast(float, __builtin_amdgcn_update_dpp(0, __builtin_bit_cast(int, (x)), (ctrl), 0xF, 0xF, true))
DEV float pair_sum(float x) { return x + __shfl_xor(x, 32); }
DEV float pair_max(float x) { return fmaxf(x, __shfl_xor(x, 32)); }
DEV float quad_sum(float x) { x += DPP_MOV(x, 0xB1); x += DPP_MOV(x, 0x4E); return x; }
DEV float wave_max_u(float x) {
    x = fmaxf(x, DPP_MOV(x, 0xB1)); x = fmaxf(x, DPP_MOV(x, 0x4E)); x = fmaxf(x, DPP_MOV(x, 0x141)); x = fmaxf(x, DPP_MOV(x, 0x140));
    const float a = __builtin_bit_cast(float, __builtin_amdgcn_readlane(__builtin_bit_cast(int, x), 0)), b = __builtin_bit_cast(float, __builtin_amdgcn_readlane(__builtin_bit_cast(int, x), 16));
    const float c = __builtin_bit_cast(float, __builtin_amdgcn_readlane(__builtin_bit_cast(int, x), 32)), d = __builtin_bit_cast(float, __builtin_amdgcn_readlane(__builtin_bit_cast(int, x), 48));
    return fmaxf(fmaxf(a, b), fmaxf(c, d));
}
DEV float sigmoidf_(float x) { return __builtin_amdgcn_rcpf(1.0f + __expf(-x)); }
DEV float logsigmoidf_(float x) { return fminf(x, 0.f) - log1pf(__expf(-fabsf(x))); }
DEV float gelu_tanh(float x) { const float u = 0.7978845608028654f * (x + 0.044715f * x * x * x); const float th = 1.0f - 2.0f * __builtin_amdgcn_rcpf(__expf(2.0f * u) + 1.0f); return 0.5f * x * (1.0f + th); }
DEV s16x4 tr_read(const unsigned char* p) {
    typedef short v4i16_t __attribute__((ext_vector_type(4)));
    return __builtin_bit_cast(s16x4, __builtin_amdgcn_ds_read_tr16_b64_v4i16((LAS v4i16_t*)p));
}
DEV s16x4 tr_read_l(unsigned lds_addr) {
    typedef short v4i16_t __attribute__((ext_vector_type(4)));
    return __builtin_bit_cast(s16x4, __builtin_amdgcn_ds_read_tr16_b64_v4i16((LAS v4i16_t*)(uintptr_t)lds_addr));
}
DEV int crow(int r, int hi) { return (r & 3) + 8 * (r >> 2) + 4 * hi; }

constexpr int GL_STAGE = 65536;
constexpr int GEMM_LDS = 2 * GL_STAGE;
constexpr int MISC_OFF = GEMM_LDS;
constexpr int LDS_BYTES = GEMM_LDS + 8192 + 12288;

DEV void glds16s(const void* sbase, unsigned voff, unsigned lds_dst) { unsigned keep;
    asm volatile("s_mov_b32 %0, m0\n\ts_mov_b32 m0, %3\n\ts_nop 0\n\tglobal_load_lds_dwordx4 %1, %2\n\ts_mov_b32 m0, %0" : "=&s"(keep) : "v"(voff), "s"(sbase), "s"(lds_dst) : "memory"); }

DEV const unsigned char* uptr(const void* p) { const unsigned long long v = (unsigned long long)p; const unsigned lo = __builtin_amdgcn_readfirstlane((unsigned)v), hi = __builtin_amdgcn_readfirstlane((unsigned)(v >> 32)); return (const unsigned char*)(((unsigned long long)hi << 32) | lo); }

DEV void lds_barrier() { asm volatile("s_waitcnt lgkmcnt(0)\n\ts_barrier" ::: "memory"); }

struct NoNextS { DEV void operator()() const {} };
template <class AO, class BO>
DEV void gemm256s_issue0(unsigned char* smem, const void* abase, const AO& aoff, const void* bbase, const BO& boff) {
    const int tid = TID(), lane = tid & 63; const int wid = __builtin_amdgcn_readfirstlane(tid >> 6);
    const unsigned lds0 = (unsigned)(uintptr_t)smem; const unsigned char* ab_ = uptr(abase); const unsigned char* bb_ = uptr(bbase);
#pragma unroll
    for (int i = 0; i < 4; ++i) { const int p = wid + 8 * i; glds16s(ab_, aoff(8 * p + (lane >> 3), (lane & 7) ^ (lane >> 3)), (unsigned)__builtin_amdgcn_readfirstlane(lds0 + p * 1024)); }
#pragma unroll
    for (int i = 0; i < 4; ++i) { const int p = wid + 8 * i; const int k = 2 * p + (lane >> 5); const int f = (k & 3) + 4 * ((k >> 3) & 1);
        glds16s(bb_, boff(k, (lane & 31) ^ (f << 1)), (unsigned)__builtin_amdgcn_readfirstlane(lds0 + 32768 + p * 1024)); }
}
template <bool ZERO, class AO, class BO, class NX = NoNextS>
DEV void gemm256s(unsigned char* smem, int nkt, const void* abase, unsigned akstep, const AO& aoff, const void* bbase, unsigned bkstep, const BO& boff, f32x4 (&acc)[8][4], bool pre = false, const NX& next = NX()) {
    const int tid = TID(), lane = tid & 63; const int wid = __builtin_amdgcn_readfirstlane(tid >> 6); const int wr = wid >> 2, wc = wid & 3;
    if (ZERO) {
#pragma unroll
        for (int mi = 0; mi < 8; ++mi)
#pragma unroll
            for (int ni = 0; ni < 4; ++ni) acc[mi][ni] = (f32x4){0.f, 0.f, 0.f, 0.f};
    }
    const unsigned lds0 = (unsigned)(uintptr_t)smem;
    const unsigned char* abase_u = uptr(abase); const unsigned char* bbase_u = uptr(bbase); const unsigned akstep_u = __builtin_amdgcn_readfirstlane(akstep), bkstep_u = __builtin_amdgcn_readfirstlane(bkstep);
    unsigned ao[4], bo[4];
#pragma unroll
    for (int i = 0; i < 4; ++i) { const int p = wid + 8 * i; ao[i] = aoff(8 * p + (lane >> 3), (lane & 7) ^ (lane >> 3));
        const int k = 2 * p + (lane >> 5); const int f = (k & 3) + 4 * ((k >> 3) & 1); bo[i] = boff(k, (lane & 31) ^ (f << 1)); }
#define GL_ISSUE(kt, st) do { const unsigned char* ab_ = abase_u + (size_t)(kt) * akstep_u; const unsigned char* bb_ = bbase_u + (size_t)(kt) * bkstep_u; \
        _Pragma("unroll") for (int i_ = 0; i_ < 4; ++i_) glds16s(ab_, ao[i_], (unsigned)__builtin_amdgcn_readfirstlane(lds0 + (st) * GL_STAGE + (wid + 8 * i_) * 1024)); \
        _Pragma("unroll") for (int i_ = 0; i_ < 4; ++i_) glds16s(bb_, bo[i_], (unsigned)__builtin_amdgcn_readfirstlane(lds0 + (st) * GL_STAGE + 32768 + (wid + 8 * i_) * 1024)); } while (0)
    if (!pre) {
        GL_ISSUE(0, 0);
        asm volatile("s_waitcnt vmcnt(0)" ::: "memory");
        __syncthreads();
    }
    for (int kt = 0; kt < nkt; ++kt) {
        if (kt + 1 < nkt) GL_ISSUE(kt + 1, (kt + 1) & 1); else next();
        const unsigned char* A = smem + (kt & 1) * GL_STAGE; const unsigned char* Bt = A + 32768;
#pragma unroll
        for (int ks = 0; ks < 2; ++ks) {
            bf16x8 wf[4];
#pragma unroll
            for (int ni = 0; ni < 4; ++ni) {
                const int i = lane & 15, g = lane >> 4, q = i >> 2; const int row = ks * 32 + 8 * g + q; const int nc = wc * 8 + ni * 2 + ((i & 3) >> 1); const int f = q + 4 * (g & 1);
                const unsigned char* p = Bt + row * 512 + ((nc ^ (f << 1)) << 4) + (i & 1) * 8;
                const s16x4 lo = tr_read(p), hi = tr_read(p + 4 * 512);
                wf[ni] = (bf16x8){lo[0], lo[1], lo[2], lo[3], hi[0], hi[1], hi[2], hi[3]};
            }
#pragma unroll
            for (int mi = 0; mi < 8; ++mi) {
                const int m = wr * 128 + mi * 16 + (lane & 15); const int kc = ks * 4 + (lane >> 4);
                const bf16x8 af = *(const bf16x8*)(A + m * 128 + ((kc ^ (m & 7)) << 4));
#pragma unroll
                for (int ni = 0; ni < 4; ++ni) acc[mi][ni] = __builtin_amdgcn_mfma_f32_16x16x32_bf16(wf[ni], af, acc[mi][ni], 0, 0, 0);
            }
        }
        asm volatile("s_waitcnt vmcnt(0)" ::: "memory");
        __syncthreads();
    }
#undef GL_ISSUE
}

#define G_ROW(mi) ((((mi) >> 2) * 128) + wr * 64 + (((mi) & 3) * 16) + (lane & 15))
#define G_COL(ni) ((((ni) >> 1) * 128) + wc * 32 + (((ni) & 1) * 16) + 4 * (lane >> 4))
#define WAIT_V(n) asm volatile("s_waitcnt vmcnt(" #n ")" ::: "memory")
#define WAIT_L(n) asm volatile("s_waitcnt lgkmcnt(" #n ")" ::: "memory")
#define BAR() __builtin_amdgcn_s_barrier()
#define SCHED() __builtin_amdgcn_sched_barrier(0)
constexpr int SA_(int b, int h) { return b * GL_STAGE + h * 16384; }
constexpr int SB_(int b, int h) { return b * GL_STAGE + 32768 + h * 16384; }
struct NoNext { DEV bool has() const { return false; } template <int P> DEV void issue() const {} };
template <int WHICH, class AO, class BO>
DEV void gemm_issue0(unsigned char* smem, const void* abase, const AO& aoff, const void* bbase, const BO& boff) {
    const int tid = TID(), lane = tid & 63; const int wid = __builtin_amdgcn_readfirstlane(tid >> 6);
    const unsigned lds0 = (unsigned)(uintptr_t)smem; const unsigned char* ab_ = uptr(abase); const unsigned char* bb_ = uptr(bbase);
#pragma unroll
    for (int h = 0; h < 2; ++h) {
        if (WHICH & (1 << (2 * h))) {
#pragma unroll
            for (int i = 0; i < 2; ++i) { const int p = wid + 8 * i; const int k = 4 * p + (lane >> 4); const int f = (k & 3) + 4 * ((k >> 3) & 1);
                glds16s(bb_, boff(k, h * 16 + ((lane & 15) ^ (f << 1))), (unsigned)__builtin_amdgcn_readfirstlane(lds0 + SB_(0, h) + p * 1024)); } }
        if (WHICH & (2 << (2 * h))) {
#pragma unroll
            for (int i = 0; i < 2; ++i) { const int p = wid + 8 * i;
                glds16s(ab_, aoff(h * 128 + 8 * p + (lane >> 3), (lane & 7) ^ (lane >> 3)), (unsigned)__builtin_amdgcn_readfirstlane(lds0 + SA_(0, h) + p * 1024)); } }
    }
}
template <class AO, class BO>
struct NextTile { bool on; unsigned char* smem; const void* abase; AO aoff; const void* bbase; BO boff;
    DEV bool has() const { return on; }
    template <int P> DEV void issue() const { gemm_issue0<P>(smem, abase, aoff, bbase, boff); } };
template <class AO, class BO> DEV NextTile<AO, BO> next_tile(bool on, unsigned char* smem, const void* abase, const AO& aoff, const void* bbase, const BO& boff) { return NextTile<AO, BO>{on, smem, abase, aoff, bbase, boff}; }
template <bool ZERO, class AO, class BO, class NX = NoNext>
DEV void gemm256(unsigned char* smem, int nkt, const void* abase, unsigned akstep, const AO& aoff, const void* bbase, unsigned bkstep, const BO& boff, f32x4 (&acc)[8][4], bool pre = false, const NX& next = NX()) {
    const int tid = TID(), lane = tid & 63; const int wid = __builtin_amdgcn_readfirstlane(tid >> 6); const int wr = wid >> 2, wc = wid & 3;
    if (ZERO) {
#pragma unroll
        for (int mi = 0; mi < 8; ++mi)
#pragma unroll
            for (int ni = 0; ni < 4; ++ni) acc[mi][ni] = (f32x4){0.f, 0.f, 0.f, 0.f};
    }
    const unsigned lds0 = (unsigned)(uintptr_t)smem;
    const unsigned char* abase_u = uptr(abase); const unsigned char* bbase_u = uptr(bbase); const unsigned akstep_u = __builtin_amdgcn_readfirstlane(akstep), bkstep_u = __builtin_amdgcn_readfirstlane(bkstep);
    unsigned ao[4], bo[4];
#pragma unroll
    for (int h = 0; h < 2; ++h)
#pragma unroll
        for (int i = 0; i < 2; ++i) { const int p = wid + 8 * i; ao[h * 2 + i] = aoff(h * 128 + 8 * p + (lane >> 3), (lane & 7) ^ (lane >> 3));
            const int k = 4 * p + (lane >> 4); const int f = (k & 3) + 4 * ((k >> 3) & 1); bo[h * 2 + i] = boff(k, h * 16 + ((lane & 15) ^ (f << 1))); }
    unsigned ard0[2], ard1[2], brd0[2], brd1[2];
    { const int l15 = lane & 15, g = lane >> 4, q = l15 >> 2; const int f = q + 4 * (g & 1);
      ard0[0] = lds0 + (wr * 64 + l15) * 128 + ((g ^ (lane & 7)) << 4); ard1[0] = lds0 + (wr * 64 + l15) * 128 + (((4 + g) ^ (lane & 7)) << 4);
      const int nc = wc * 4 + ((l15 & 3) >> 1); const int kr = 8 * g + q;
      brd0[0] = lds0 + kr * 256 + ((nc ^ (f << 1)) << 4) + (l15 & 1) * 8; brd1[0] = lds0 + kr * 256 + (((nc + 2) ^ (f << 1)) << 4) + (l15 & 1) * 8;
      ard0[1] = ard0[0] + GL_STAGE; ard1[1] = ard1[0] + GL_STAGE; brd0[1] = brd0[0] + GL_STAGE; brd1[1] = brd1[0] + GL_STAGE;
      asm volatile("" : "+v"(ard0[1]), "+v"(ard1[1]), "+v"(brd0[1]), "+v"(brd1[1])); }
#define ST_A(b, h, kt) do { const unsigned char* ab_ = abase_u + (size_t)(kt) * akstep_u; \
        _Pragma("unroll") for (int i_ = 0; i_ < 2; ++i_) glds16s(ab_, ao[(h) * 2 + i_], (unsigned)__builtin_amdgcn_readfirstlane(lds0 + SA_(b, h) + (wid + 8 * i_) * 1024)); } while (0)
#define ST_B(b, h, kt) do { const unsigned char* bb_ = bbase_u + (size_t)(kt) * bkstep_u; \
        _Pragma("unroll") for (int i_ = 0; i_ < 2; ++i_) glds16s(bb_, bo[(h) * 2 + i_], (unsigned)__builtin_amdgcn_readfirstlane(lds0 + SB_(b, h) + (wid + 8 * i_) * 1024)); } while (0)
#define LDSP(T, a_) ((LAS const T*)(uintptr_t)(a_))
#define LDA(dst, b, h) do { _Pragma("unroll") for (int m_ = 0; m_ < 4; ++m_) { dst[m_][0] = *LDSP(bf16x8, ard0[b] + SA_(0, h) + m_ * 2048); dst[m_][1] = *LDSP(bf16x8, ard1[b] + SA_(0, h) + m_ * 2048); } } while (0)
#define LDB(dst, b, h) do { _Pragma("unroll") for (int n_ = 0; n_ < 2; ++n_) _Pragma("unroll") for (int k_ = 0; k_ < 2; ++k_) { const unsigned p_ = (n_ ? brd1[b] : brd0[b]) + SB_(0, h) + k_ * 8192; \
        const s16x4 lo_ = tr_read_l(p_), hi_ = tr_read_l(p_ + 1024); dst[n_][k_] = (bf16x8){lo_[0], lo_[1], lo_[2], lo_[3], hi_[0], hi_[1], hi_[2], hi_[3]}; } } while (0)
#define MMA(ai, bj, Bx) do { __builtin_amdgcn_s_setprio(1); \
        _Pragma("unroll") for (int k_ = 0; k_ < 2; ++k_) _Pragma("unroll") for (int m_ = 0; m_ < 4; ++m_) _Pragma("unroll") for (int n_ = 0; n_ < 2; ++n_) \
            acc[(ai) * 4 + m_][(bj) * 2 + n_] = __builtin_amdgcn_mfma_f32_16x16x32_bf16(Bx[n_][k_], At[m_][k_], acc[(ai) * 4 + m_][(bj) * 2 + n_], 0, 0, 0); \
        __builtin_amdgcn_s_setprio(0); } while (0)
    bf16x8 At[4][2], B0[2][2], B1[2][2];
    if (!pre) { ST_B(0, 0, 0); ST_A(0, 0, 0); ST_B(0, 1, 0); ST_A(0, 1, 0); }
    if (wr == 1) BAR();
    if (!pre) WAIT_V(4);
    BAR();
    ST_B(1, 0, 1); ST_A(1, 0, 1); ST_B(1, 1, 1);
    if (!pre) WAIT_V(6);
    BAR();
    for (int t = 0; t < nkt - 2; t += 2) {
        LDB(B0, 0, 0); SCHED(); LDA(At, 0, 0); ST_A(1, 1, t + 1);
        WAIT_L(8); BAR(); WAIT_L(0); MMA(0, 0, B0); BAR(); SCHED();
        LDB(B1, 0, 1); ST_B(0, 0, t + 2);
        BAR(); WAIT_L(0); MMA(0, 1, B1); BAR();
        LDA(At, 0, 1); ST_A(0, 0, t + 2);
        BAR(); WAIT_L(0); MMA(1, 0, B0); BAR(); SCHED();
        ST_B(0, 1, t + 2);
        WAIT_V(6); BAR(); MMA(1, 1, B1); BAR();
        LDB(B0, 1, 0); SCHED(); LDA(At, 1, 0); ST_A(0, 1, t + 2);
        WAIT_L(8); BAR(); WAIT_L(0); MMA(0, 0, B0); BAR(); SCHED();
        LDB(B1, 1, 1); ST_B(1, 0, t + 3);
        BAR(); WAIT_L(0); MMA(0, 1, B1); BAR();
        LDA(At, 1, 1); ST_A(1, 0, t + 3);
        BAR(); WAIT_L(0); MMA(1, 0, B0); BAR(); SCHED();
        ST_B(1, 1, t + 3);
        WAIT_V(6); BAR(); MMA(1, 1, B1); BAR();
    }
    const bool hn = next.has();
    LDB(B0, 0, 0); LDA(At, 0, 0); ST_A(1, 1, nkt - 1);
    BAR(); WAIT_L(0); MMA(0, 0, B0); BAR();
    LDB(B1, 0, 1); BAR(); WAIT_L(0); MMA(0, 1, B1); BAR();
    LDA(At, 0, 1);
    if (hn) { next.template issue<3>(); WAIT_V(8); } else WAIT_V(4);
    BAR(); WAIT_L(0); MMA(1, 0, B0); MMA(1, 1, B1); BAR();
    LDB(B0, 1, 0); LDA(At, 1, 0);
    if (hn) { next.template issue<4>(); WAIT_V(8); } else WAIT_V(2);
    BAR(); WAIT_L(0); MMA(0, 0, B0); BAR();
    LDB(B1, 1, 1);
    if (hn) { next.template issue<8>(); WAIT_V(8); } else WAIT_V(0);
    BAR(); WAIT_L(0); MMA(0, 1, B1); BAR();
    LDA(At, 1, 1); BAR(); WAIT_L(0); MMA(1, 0, B0); MMA(1, 1, B1);
    WAIT_V(0);
    BAR();
    if (wr == 0) BAR();
#undef ST_A
#undef ST_B
#undef LDA
#undef LDB
#undef LDSP
#undef MMA
}

DEV uint4 pair16(uint2 a, uint2 b) {
    const auto r0 = __builtin_amdgcn_permlane16_swap(a.x, b.x, false, false); const auto r1 = __builtin_amdgcn_permlane16_swap(a.y, b.y, false, false);
    uint4 o; o.x = r0[0]; o.y = r1[0]; o.z = r0[1]; o.w = r1[1]; return o;
}
DEV void unpair16(uint4 q, uint2& a, uint2& b) {
    const auto r0 = __builtin_amdgcn_permlane16_swap(q.x, q.z, false, false); const auto r1 = __builtin_amdgcn_permlane16_swap(q.y, q.w, false, false);
    a.x = r0[0]; a.y = r1[0]; b.x = r0[1]; b.y = r1[1];
}
#define PAIR16_COL(c0, c1) ((((lane) >> 4) & 1) ? (c1) - 4 : (c0))
#define EPI_IDS() do { const int etid_ = TID(); lane = etid_ & 63; wid = etid_ >> 6; wr = wid >> 2; wc = wid & 3; } while (0)

DEV void patch_decode(int local, int MT, int NT, int& mt, int& nt) {
    const int per_mtb = 8 * NT; const int mtb = local / per_mtb; const int rem = local - mtb * per_mtb;
    const int rows = (MT - 8 * mtb) < 8 ? (MT - 8 * mtb) : 8;
    const int per_ntb = rows * 8; const int nfull = NT >> 3; int ntb = rem / per_ntb; int cols = 8;
    if (ntb >= nfull) { ntb = nfull; cols = NT - 8 * nfull; }
    const int r2 = rem - ntb * per_ntb;
    mt = 8 * mtb + r2 / cols; nt = 8 * ntb + r2 % cols;
}

DEV void convert_chunk(const float* src, bf16_t* dst, size_t i8) {
    const float4 a = *(const float4*)(src + i8 * 8), b = *(const float4*)(src + i8 * 8 + 4);
    uint4 o; o.x = cvtpk(a.x, a.y); o.y = cvtpk(a.z, a.w); o.z = cvtpk(b.x, b.y); o.w = cvtpk(b.z, b.w);
    *(uint4*)(dst + i8 * 8) = o;
}
DEV void phase_prologue(const Args& a, unsigned char* smem) {
    unsigned char* ws = a.ws;
    const size_t gtid = (size_t)BID() * NTHR + TID(), gn = (size_t)gridDim.x * NTHR;
    {
        { const float* W = a.in[I_WOUT]; bf16_t* O = (bf16_t*)(ws + WS_WOUT); const float* gnn = a.in[I_GNN]; const float* gnf = a.in[I_GNF];
          for (size_t i = gtid; i < (size_t)1024 * 128; i += gn) { const int k = (int)(i >> 7); const float g_ = k < 512 ? gnn[k] : gnf[k - 512];
              const float4 x = *(const float4*)(W + i * 8), y = *(const float4*)(W + i * 8 + 4);
              uint4 o; o.x = cvtpk(x.x * g_, x.y * g_); o.y = cvtpk(x.z * g_, x.w * g_); o.z = cvtpk(y.x * g_, y.y * g_); o.w = cvtpk(y.z * g_, y.w * g_); *(uint4*)(O + i * 8) = o; } }
        const float* srcs[3] = {a.in[I_WGATE], a.in[I_WPLE], a.in[I_P]};
        bf16_t* dsts[3] = {(bf16_t*)(ws + WS_WGATE), (bf16_t*)(ws + WS_WPLE), (bf16_t*)(ws + WS_PB)};
        const size_t cnt8[3] = {1024 * 1024 / 8, 256 * 1024 / 8, (size_t)NTOK * 256 / 8};
#pragma unroll
        for (int s = 1; s < 3; ++s) for (size_t i = gtid; i < cnt8[s]; i += gn) convert_chunk(srcs[s], dsts[s], i);
        { const float* W = srcs[0]; bf16_t* O = dsts[0]; const float* lp = a.in[I_LNPLE];
          for (size_t i = gtid; i < cnt8[0]; i += gn) { const float g_ = lp[i >> 7];
              const float4 x = *(const float4*)(W + i * 8), y = *(const float4*)(W + i * 8 + 4);
              uint4 o; o.x = cvtpk(x.x * g_, x.y * g_); o.y = cvtpk(x.z * g_, x.w * g_); o.z = cvtpk(y.x * g_, y.y * g_); o.w = cvtpk(y.z * g_, y.w * g_); *(uint4*)(O + i * 8) = o; } }
        for (size_t i = gtid; i < (size_t)2 * 2048 * 32; i += gn) { const int which = (int)(i / (2048 * 32)); const int k = (int)(i / 32) % 2048, c8 = (int)(i % 32) * 8;
            uint4 o = {0u, 0u, 0u, 0u};
            if (c8 < 128) { const float* W = a.in[which ? I_WC1V : I_WC1K] + (size_t)k * 128 + c8; const float4 x = *(const float4*)W, y = *(const float4*)(W + 4); o.x = cvtpk(x.x, x.y); o.y = cvtpk(x.z, x.w); o.z = cvtpk(y.x, y.y); o.w = cvtpk(y.z, y.w); }
            *(uint4*)((bf16_t*)(ws + WS_WC1) + i * 8) = o; }
        for (size_t i = gtid; i < (size_t)2 * 128 * 32; i += gn) { const int which = (int)(i / (128 * 32)); const int k = (int)(i / 32) % 128, c8 = (int)(i % 32) * 8;
            uint4 o = {0u, 0u, 0u, 0u};
            if (c8 < 64) { const float* W = a.in[which ? I_WC2V : I_WC2K] + (size_t)k * 64 + c8; const float4 x = *(const float4*)W, y = *(const float4*)(W + 4); o.x = cvtpk(x.x, x.y); o.y = cvtpk(x.z, x.w); o.z = cvtpk(y.x, y.y); o.w = cvtpk(y.z, y.w); }
            *(uint4*)((bf16_t*)(ws + WS_WC2) + i * 8) = o; }
    }
    {
        const float* W = a.in[I_WIN]; bf16_t* O = (bf16_t*)(ws + WS_WIN);
        for (size_t i = gtid; i < (size_t)1024 * (NWIN / 8); i += gn) {
            const int k = (int)(i / (NWIN / 8)), j = (int)(i % (NWIN / 8)) * 8;
            uint4 o = {0u, 0u, 0u, 0u};
            if (j < 2848) {
                const int sj = (j < 1280) ? j : (j < 2816) ? j + 24 : (j < 2840) ? j - 1536 : j; const float g_ = a.in[I_LN1][k];
                const float4 x = *(const float4*)(W + (size_t)k * 2848 + sj), y = *(const float4*)(W + (size_t)k * 2848 + sj + 4);
                o.x = cvtpk(x.x * g_, x.y * g_); o.y = cvtpk(x.z * g_, x.w * g_); o.z = cvtpk(y.x * g_, y.y * g_); o.w = cvtpk(y.z * g_, y.w * g_);
            }
            *(uint4*)(O + (size_t)k * NWIN + j) = o;
        }
    }
    const int lane = TID() & 63; const int gw = BID() * NWAVE + (TID() >> 6), ngw = gridDim.x * NWAVE;
    {
        const float* X = a.in[I_X]; bf16_t* XN = (bf16_t*)(ws + WS_XN); float* RSTD1 = (float*)(ws + WS_RSTD1);
        for (int m = gw; m < NTOK; m += ngw) {
            float4 v[4]; float s = 0.f;
#pragma unroll
            for (int j = 0; j < 4; ++j) { v[j] = *(const float4*)(X + (size_t)m * 1024 + j * 256 + lane * 4); s += v[j].x * v[j].x + v[j].y * v[j].y + v[j].z * v[j].z + v[j].w * v[j].w; }
#pragma unroll
            for (int j = 0; j < 4; ++j) { uint2 o; o.x = cvtpk(v[j].x, v[j].y); o.y = cvtpk(v[j].z, v[j].w); *(uint2*)(XN + (size_t)m * 1024 + j * 256 + lane * 4) = o; }
            const float rstd = rsqrtf(wave_sum(s) * (1.f / 1024.f) + EPS);
            if (lane == 0) RSTD1[m] = rstd;
        }
    }
    if (gtid == 0) *(float*)(ws + WS_ONE) = 1.0f;
    if (gw < 256) {
        const int which = gw >> 7, n = gw & 127; const float* pe = a.in[which ? I_PEV : I_PEK]; const float* w1 = a.in[which ? I_WC1V : I_WC1K];
        float s = 0.f;
#pragma unroll 8
        for (int i = 0; i < 32; ++i) { const int k = lane + 64 * i; s += pe[k] * w1[(size_t)k * 128 + n]; }
        s = wave_sum(s);
        if (lane == 0) ((float*)(ws + WS_BIAS1))[which * 128 + n] = s;
    }
}

DEV void phase_inproj(const Args& a, unsigned char* smem) {
    const bf16_t* XN = (const bf16_t*)(a.ws + WS_XN); const bf16_t* W = (const bf16_t*)(a.ws + WS_WIN);
    bf16_t* PROJ = (bf16_t*)(a.ws + WS_PROJ); float* GN = (float*)(a.ws + WS_GN); float* LS = (float*)(a.ws + WS_LS); const float* bfg = a.in[I_BFG];
    int lane = TID() & 63, wid = TID() >> 6, wr = wid >> 2, wc = wid & 3; (void)wr; (void)wc; (void)lane;
    bool pre = false;
    for (int item = VBID(); item < 64 * 12; item += gridDim.x) {
        int mt, nt; patch_decode(item, 64, 12, mt, nt);
        const int nitem = item + (int)gridDim.x; const bool has_next = nitem < 64 * 12; int mtn = 0, ntn = 0; if (has_next) patch_decode(nitem, 64, 12, mtn, ntn);
        f32x4 acc[8][4];
        auto aoffi = [](int r, int kc) { return (unsigned)(r * 2048 + kc * 16); }; auto boffi = [](int k, int nc) { return (unsigned)(k * (NWIN * 2) + nc * 16); };
        gemm256<true>(smem, 16, XN + (size_t)mt * 256 * 1024, 128u, aoffi, W + nt * 256, (unsigned)(64 * NWIN * 2), boffi, acc, pre,
                      next_tile(has_next, smem, XN + (size_t)mtn * 256 * 1024, aoffi, W + ntn * 256, boffi));
        pre = has_next;
        EPI_IDS();
        float r1[8];
#pragma unroll
        for (int mi = 0; mi < 8; ++mi) r1[mi] = ((const float*)(a.ws + WS_RSTD1))[mt * 256 + G_ROW(mi)];
#pragma unroll
        for (int mi = 0; mi < 8; ++mi) {
            const int gm = mt * 256 + G_ROW(mi); const int b = gm >> 13, t = gm & 8191;
            if (nt < 11) {
#pragma unroll
                for (int np = 0; np < 2; ++np) { const int n0 = G_COL(2 * np); const int hs = nt * 4 + (n0 >> 6), d0 = n0 & 63; const float sc = ((hs < 8 || (hs >= 20 && hs < 28)) ? QS : 1.0f) * r1[mi];
                    const f32x4 v0 = acc[mi][2 * np], v1 = acc[mi][2 * np + 1]; uint2 oa, ob; oa.x = cvtpk(v0[0] * sc, v0[1] * sc); oa.y = cvtpk(v0[2] * sc, v0[3] * sc); ob.x = cvtpk(v1[0] * sc, v1[1] * sc); ob.y = cvtpk(v1[2] * sc, v1[3] * sc);
                    *(uint4*)(PROJ + (((size_t)(hs * 2 + b)) * 8192 + t) * 64 + PAIR16_COL(d0, d0 + 16)) = pair16(oa, ob); }
            }
#pragma unroll
            for (int ni = 0; ni < 4; ++ni) {
                const int n = G_COL(ni); const f32x4 v = acc[mi][ni];
                if (nt < 11) {
                } else if (n < 24) {
#pragma unroll
                    for (int r = 0; r < 4; ++r) GN[(size_t)gm * 24 + n + r] = sigmoidf_(v[r] * r1[mi]);
                } else if (n < 32) {
#pragma unroll
                    for (int r = 0; r < 4; ++r) { const int h = n - 24 + r; LS[((size_t)(b * 8 + h)) * 8192 + t] = logsigmoidf_(v[r] * r1[mi] + bfg[h]); }
                }
            }
        }
    }
}

DEV void signal_done(unsigned* flag) {
    asm volatile("s_waitcnt vmcnt(0)" ::: "memory");
    __syncthreads();
    if (TID() == 0) { __builtin_amdgcn_fence(__ATOMIC_RELEASE, "agent"); asm volatile("s_waitcnt vmcnt(0)" ::: "memory"); __hip_atomic_fetch_add(flag, 1u, __ATOMIC_RELAXED, __HIP_MEMORY_SCOPE_AGENT); }
}
DEV void wait_flag(unsigned* flag, unsigned target) {
    if (TID() == 0) { unsigned sp = 0u; while (__hip_atomic_load(flag, __ATOMIC_RELAXED, __HIP_MEMORY_SCOPE_AGENT) < target) { __builtin_amdgcn_s_sleep(4); if (++sp > (1u << 24)) break; }
        __builtin_amdgcn_fence(__ATOMIC_ACQUIRE, "agent"); asm volatile("s_waitcnt vmcnt(0)" ::: "memory"); }
    __syncthreads();
}
constexpr int CW_CUMFLAG = 128, CW_CMPFLAG = 192, CW_GATEFLAG = 256;
DEV void cmp_item(const Args& a, unsigned char* smem, int item) {
    const bf16_t* PROJ = (const bf16_t*)(a.ws + WS_PROJ);
    const int tid = TID(); int lane = tid & 63, wid = tid >> 6, wr = wid >> 2, wc = wid & 3; (void)wr; (void)wc; (void)lane;
    {
        if (item < 16) {
            const int which = item >> 3, b = (item >> 2) & 1, g = (item >> 1) & 1, mt = item & 1;
            const bf16_t* base = PROJ + ((size_t)((8 + 2 * which + g) * 2 + b)) * 8192 * 64;
            const bf16_t* W1 = (const bf16_t*)(a.ws + WS_WC1) + (size_t)which * 2048 * 256;
            const bf16_t* W2 = (const bf16_t*)(a.ws + WS_WC2) + (size_t)which * 128 * 256;
            const float* bias1 = (const float*)(a.ws + WS_BIAS1) + which * 128;
            bf16_t* HID = (bf16_t*)(a.ws + WS_HID) + ((size_t)(which * 4 + b * 2 + g)) * 512 * 128;
            bf16_t* OUT = (bf16_t*)(a.ws + WS_KC) + ((size_t)(which * 4 + b * 2 + g)) * 512 * 64;
            f32x4 acc[8][4];
            gemm256s<true>(smem, 32, base, 128u, [&](int r, int kc) { int c = mt * 256 + r; c = c > 510 ? 510 : c; return (unsigned)(c * 2048 + kc * 16); },
                          W1, 64u * 512u, [&](int k, int nc) { return (unsigned)(k * 512 + nc * 16); }, acc);
        EPI_IDS();
            if (wc < 2) {
                float4 bb4[4];
#pragma unroll
                for (int ni = 0; ni < 4; ++ni) bb4[ni] = *(const float4*)(bias1 + wc * 64 + ni * 16 + 4 * (lane >> 4));
#pragma unroll
                for (int mi = 0; mi < 8; ++mi) { const int c = mt * 256 + wr * 128 + mi * 16 + (lane & 15);
#pragma unroll
                    for (int ni = 0; ni < 4; ++ni) { const int n = wc * 64 + ni * 16 + 4 * (lane >> 4); const f32x4 v = acc[mi][ni]; const float4 bb = bb4[ni];
                        uint2 o; o.x = cvtpk(gelu_tanh(v[0] + bb.x), gelu_tanh(v[1] + bb.y)); o.y = cvtpk(gelu_tanh(v[2] + bb.z), gelu_tanh(v[3] + bb.w));
                        *(uint2*)(HID + (size_t)c * 128 + n) = o; } }
            }
            __syncthreads();
            gemm256s<true>(smem, 2, HID + (size_t)mt * 256 * 128, 128u, [&](int r, int kc) { return (unsigned)(r * 256 + kc * 16); },
                          W2, 64u * 512u, [&](int k, int nc) { return (unsigned)(k * 512 + nc * 16); }, acc);
        EPI_IDS();
            if (wc == 0) {
#pragma unroll
                for (int mi = 0; mi < 8; ++mi) { const int c = mt * 256 + wr * 128 + mi * 16 + (lane & 15);
#pragma unroll
                    for (int ni = 0; ni < 4; ++ni) { const int n = ni * 16 + 4 * (lane >> 4); const f32x4 v = acc[mi][ni];
                        uint2 o; o.x = cvtpk(v[0], v[1]); o.y = cvtpk(v[2], v[3]);
                        if (c >= 511) { o.x = 0u; o.y = 0u; }
                        *(uint2*)(OUT + (size_t)c * 64 + n) = o; } }
            }
            signal_done((unsigned*)(a.ws + WS_CTL) + CW_CMPFLAG);
        } else {
            const int bh = item - 16; const float* LS = (const float*)(a.ws + WS_LS) + (size_t)bh * 8192; float* CUM = (float*)(a.ws + WS_CUM) + (size_t)bh * 8192;
            float* sc = (float*)smem;
            float v[16]; float s = 0.f;
#pragma unroll
            for (int j = 0; j < 4; ++j) { const float4 x = *(const float4*)(LS + tid * 16 + j * 4); v[4 * j] = x.x; v[4 * j + 1] = x.y; v[4 * j + 2] = x.z; v[4 * j + 3] = x.w; }
#pragma unroll
            for (int j = 0; j < 16; ++j) { s += v[j]; v[j] = s; }
            sc[tid] = s; __syncthreads();
            if (tid == 0) { float run = 0.f; for (int i = 0; i < NTHR; ++i) { const float x = sc[i]; sc[i] = run; run += x; } }
            __syncthreads();
            const float off = sc[tid];
#pragma unroll
            for (int j = 0; j < 4; ++j) { float4 o = {v[4 * j] + off, v[4 * j + 1] + off, v[4 * j + 2] + off, v[4 * j + 3] + off}; *(float4*)(CUM + tid * 16 + j * 4) = o; }
            signal_done((unsigned*)(a.ws + WS_CTL) + CW_CUMFLAG + bh);
        }
    }
}

constexpr int AT_STAGE = 16384;
constexpr int AT_BIAS_OFF = 3 * AT_STAGE;
constexpr int AT_IMP_OFF = AT_BIAS_OFF + 1024;
constexpr int AT_SEL_OFF = AT_IMP_OFF + 65536;
constexpr int AT_WUN_OFF = AT_SEL_OFF + 1024;
constexpr int AT_UCNT_OFF = AT_WUN_OFF + 128;
constexpr int AT_ULIST_OFF = AT_UCNT_OFF + 16;
constexpr int AT_ITEM_OFF = AT_ULIST_OFF + 128;
static_assert(AT_ITEM_OFF + 16 <= GEMM_LDS, "attention LDS map");
#define NEG_INF (-__builtin_inff())

#define KV_DECL uint4 rk0_, rv0_
#define KV_GLOAD(Kt, Vt) do { rk0_ = *(const uint4*)((Kt) + tid * 8); rv0_ = *(const uint4*)((Vt) + tid * 8); } while (0)
#define KV_LSTORE(stp) do { unsigned char* st_ = (stp); const int key = tid >> 3, ch = tid & 7; \
      *(uint4*)(st_ + key * 128 + ((ch ^ (key & 7)) << 4)) = rk0_; \
      *(uint4*)(st_ + 8192 + key * 128 + ((((ch >> 2) ^ ((key >> 1) & 1))) << 6) + ((ch & 3) << 4)) = rv0_; } while (0)
template <bool FULL>
DEV void qk_tile(const unsigned char* Kst, const bf16x8 (&qf)[4], f32x16& p0, f32x16& p1, int lane) {
    const int key = lane & 31, hi = lane >> 5;
    if (FULL) {
        bf16x8 k0[4], k1[4];
#pragma unroll
        for (int ks = 0; ks < 4; ++ks) { const int ch = 2 * ks + hi; const int off = key * 128 + ((ch ^ (key & 7)) << 4);
            k0[ks] = *(const bf16x8*)(Kst + off); k1[ks] = *(const bf16x8*)(Kst + off + 32 * 128); }
        __builtin_amdgcn_sched_barrier(0);
#pragma unroll
        for (int ks = 0; ks < 4; ++ks) {
            p0 = __builtin_amdgcn_mfma_f32_32x32x16_bf16(k0[ks], qf[ks], p0, 0, 0, 0);
            p1 = __builtin_amdgcn_mfma_f32_32x32x16_bf16(k1[ks], qf[ks], p1, 0, 0, 0); }
    } else {
        bf16x8 kk[4];
#pragma unroll
        for (int ks = 0; ks < 4; ++ks) { const int ch = 2 * ks + hi; kk[ks] = *(const bf16x8*)(Kst + key * 128 + ((ch ^ (key & 7)) << 4)); }
        __builtin_amdgcn_sched_barrier(0);
#pragma unroll
        for (int ks = 0; ks < 4; ++ks) p0 = __builtin_amdgcn_mfma_f32_32x32x16_bf16(kk[ks], qf[ks], p0, 0, 0, 0);
        __builtin_amdgcn_sched_barrier(0);
#pragma unroll
        for (int ks = 0; ks < 4; ++ks) { const int ch = 2 * ks + hi; kk[ks] = *(const bf16x8*)(Kst + key * 128 + ((ch ^ (key & 7)) << 4) + 32 * 128); }
        __builtin_amdgcn_sched_barrier(0);
#pragma unroll
        for (int ks = 0; ks < 4; ++ks) p1 = __builtin_amdgcn_mfma_f32_32x32x16_bf16(kk[ks], qf[ks], p1, 0, 0, 0);
    }
}
template <bool FULL>
DEV void pv_tile(const unsigned char* Vst, const f32x16& p0, const f32x16& p1, f32x16 (&o)[2], int lane) {
    const int hi = lane >> 5, i = lane & 15, gg = (lane >> 4) & 1;
    const int q = i >> 2; const int sw = (q >> 1) & 1;
    bf16x8 pa[4];
#pragma unroll
    for (int s = 0; s < 4; ++s) { const f32x16& p = (s < 2) ? p0 : p1; const int b = (s & 1) * 8;
        unsigned w[4];
#pragma unroll
        for (int j = 0; j < 4; ++j) w[j] = cvtpk(p[b + 2 * j], p[b + 2 * j + 1]);
        typedef unsigned u32x4_t __attribute__((ext_vector_type(4)));
        u32x4_t ww = {w[0], w[1], w[2], w[3]}; pa[s] = __builtin_bit_cast(bf16x8, ww); }
    constexpr int NB = FULL ? 1 : 2, SB = FULL ? 4 : 2;
#pragma unroll
    for (int bt = 0; bt < NB; ++bt) {
        s16x4 vlo[SB][2], vhi[SB][2];
#pragma unroll
        for (int s_ = 0; s_ < SB; ++s_)
#pragma unroll
            for (int dh = 0; dh < 2; ++dh) { const int s = bt * SB + s_; const int row0 = 16 * s + 4 * hi + q;
                const unsigned char* p = Vst + row0 * 128 + ((dh ^ sw) << 6) + gg * 32 + (i & 3) * 8;
                vlo[s_][dh] = tr_read(p); vhi[s_][dh] = tr_read(p + 8 * 128); }
        __builtin_amdgcn_sched_barrier(0);
#pragma unroll
        for (int s_ = 0; s_ < SB; ++s_)
#pragma unroll
            for (int dh = 0; dh < 2; ++dh) { const int s = bt * SB + s_;
                const bf16x8 vf = {vlo[s_][dh][0], vlo[s_][dh][1], vlo[s_][dh][2], vlo[s_][dh][3], vhi[s_][dh][0], vhi[s_][dh][1], vhi[s_][dh][2], vhi[s_][dh][3]};
                o[dh] = __builtin_amdgcn_mfma_f32_32x32x16_bf16(vf, pa[s], o[dh], 0, 0, 0); }
        __builtin_amdgcn_sched_barrier(0);
    }
}
DEV float rowmax32(const f32x16& p0, const f32x16& p1) {
    float a = fmaxf(p0[0], p1[0]), b = fmaxf(p0[1], p1[1]);
#pragma unroll
    for (int r = 2; r < 16; r += 2) { a = fmaxf(fmaxf(a, p0[r]), p1[r]); b = fmaxf(fmaxf(b, p0[r + 1]), p1[r + 1]); }
    return pair_max(fmaxf(a, b));
}
DEV void softmax_step(f32x16& p0, f32x16& p1, float& m, float& l, f32x16 (&o)[2]) {
    const float mt = rowmax32(p0, p1); const float mn = fmaxf(m, mt); const float alpha = __builtin_amdgcn_exp2f(m - mn);
    float rs = 0.f;
#pragma unroll
    for (int r = 0; r < 16; ++r) { p0[r] = __builtin_amdgcn_exp2f(p0[r] - mn); p1[r] = __builtin_amdgcn_exp2f(p1[r] - mn); rs += p0[r] + p1[r]; }
    rs = pair_sum(rs);
    l = l * alpha + rs; m = mn;
    if (__any(alpha != 1.0f)) { o[0] *= alpha; o[1] *= alpha; }
}
DEV void softmax_step_nosum(f32x16& p0, f32x16& p1, float& m, f32x16 (&o)[2], f32x16& lacc) {
    const float mt = rowmax32(p0, p1); const float mn = fmaxf(m, mt); const float alpha = __builtin_amdgcn_exp2f(m - mn);
#pragma unroll
    for (int r = 0; r < 16; ++r) { p0[r] = __builtin_amdgcn_exp2f(p0[r] - mn); p1[r] = __builtin_amdgcn_exp2f(p1[r] - mn); }
    m = mn;
    if (__any(alpha != 1.0f)) { o[0] *= alpha; o[1] *= alpha; lacc *= alpha; }
}
DEV void pv_tile_sum(const unsigned char* Vst, const f32x16& p0, const f32x16& p1, f32x16 (&o)[2], f32x16& lacc, int lane) {
    const int hi = lane >> 5, i = lane & 15, gg = (lane >> 4) & 1;
    const int q = i >> 2; const int sw = (q >> 1) & 1;
    bf16x8 pa[4];
#pragma unroll
    for (int s = 0; s < 4; ++s) { const f32x16& p = (s < 2) ? p0 : p1; const int b = (s & 1) * 8;
        unsigned w[4];
#pragma unroll
        for (int j = 0; j < 4; ++j) w[j] = cvtpk(p[b + 2 * j], p[b + 2 * j + 1]);
        typedef unsigned u32x4_t __attribute__((ext_vector_type(4)));
        u32x4_t ww = {w[0], w[1], w[2], w[3]}; pa[s] = __builtin_bit_cast(bf16x8, ww); }
    const bf16x8 ones = {0x3f80, 0x3f80, 0x3f80, 0x3f80, 0x3f80, 0x3f80, 0x3f80, 0x3f80};
#pragma unroll
    for (int bt = 0; bt < 2; ++bt) {
        s16x4 vlo[2][2], vhi[2][2];
#pragma unroll
        for (int s_ = 0; s_ < 2; ++s_)
#pragma unroll
            for (int dh = 0; dh < 2; ++dh) { const int s = bt * 2 + s_; const int row0 = 16 * s + 4 * hi + q;
                const unsigned char* p = Vst + row0 * 128 + ((dh ^ sw) << 6) + gg * 32 + (i & 3) * 8;
                vlo[s_][dh] = tr_read(p); vhi[s_][dh] = tr_read(p + 8 * 128); }
        __builtin_amdgcn_sched_barrier(0);
#pragma unroll
        for (int s_ = 0; s_ < 2; ++s_) { const int s = bt * 2 + s_;
            lacc = __builtin_amdgcn_mfma_f32_32x32x16_bf16(ones, pa[s], lacc, 0, 0, 0);
#pragma unroll
            for (int dh = 0; dh < 2; ++dh) {
                const bf16x8 vf = {vlo[s_][dh][0], vlo[s_][dh][1], vlo[s_][dh][2], vlo[s_][dh][3], vhi[s_][dh][0], vhi[s_][dh][1], vhi[s_][dh][2], vhi[s_][dh][3]};
                o[dh] = __builtin_amdgcn_mfma_f32_32x32x16_bf16(vf, pa[s], o[dh], 0, 0, 0); } }
        __builtin_amdgcn_sched_barrier(0);
    }
}
template <int STRIDE> DEV void mask_tile(f32x16& p0, f32x16& p1, int kpos0, int lo, int hi_lim, int hi) {
#pragma unroll
    for (int r = 0; r < 16; ++r) { const int kp = kpos0 + STRIDE * crow(r, hi);
        if (kp < lo || kp > hi_lim) p0[r] = NEG_INF;
        const int kp1 = kp + 32 * STRIDE; if (kp1 < lo || kp1 > hi_lim) p1[r] = NEG_INF; }
}
template <int STRIDE> DEV void alibi_init(f32x16& p0, f32x16& p1, float slope2, int kpos0, int tref, int hi) {
    const float base = slope2 * (float)(kpos0 - tref + STRIDE * 4 * hi);
#pragma unroll
    for (int r = 0; r < 16; ++r) { const float c = (float)(STRIDE * ((r & 3) + 8 * (r >> 2))); p0[r] = fmaf(slope2, c, base); p1[r] = fmaf(slope2, c + (float)(32 * STRIDE), base); }
}
template <class Src, class Body, class NSrc>
DEV int kv_pipeline(unsigned char* smem, int n, const Src& src, const Body& body, int par, bool pre, bool has_next, const NSrc& nsrc) {
    KV_DECL; const int tid = TID(); const bf16_t *kp, *vp;
    if (!pre) { src(0, kp, vp); KV_GLOAD(kp, vp); KV_LSTORE(smem + par * AT_STAGE); __syncthreads(); }
    for (int j = 0; j < n; ++j) {
        const bool more = j + 1 < n;
        src(more ? j + 1 : j, kp, vp); if (!more && has_next) nsrc(kp, vp);
        KV_GLOAD(kp, vp);
        body(j, smem + ((par + j) & 1) * AT_STAGE);
        KV_LSTORE(smem + ((par + j + 1) & 1) * AT_STAGE);
        __syncthreads();
    }
    return (par + n) & 1;
}
struct NoSrc { DEV void operator()(const bf16_t*&, const bf16_t*&) const {} };

constexpr int CV_PER_STEP = 373; constexpr int CV_NUP = 32 * 1024 * 2048 / 8, CV_NDN = 32 * 1024 * 1024 / 8;
static_assert((long long)33792 * CV_PER_STEP >= (long long)CV_NUP + CV_NDN, "conversion coverage");
DEV void fox_item(const Args& a, unsigned char* smem, int fi, int b, int h, int qb) {
    const int tid = TID(), lane = tid & 63, wid = tid >> 6, r32 = lane & 31, hi = lane >> 5;
    const bf16_t* PROJ = (const bf16_t*)(a.ws + WS_PROJ);
    const bf16_t* Q = PROJ + ((size_t)((20 + h) * 2 + b)) * 8192 * 64; const bf16_t* K = PROJ + ((size_t)((28 + h) * 2 + b)) * 8192 * 64; const bf16_t* V = PROJ + ((size_t)((36 + h) * 2 + b)) * 8192 * 64;
    const float* CUM = (const float*)(a.ws + WS_CUM) + (size_t)(b * 8 + h) * 8192;
    const int q0 = qb * 256; const int qrow = q0 + 32 * wid + r32;
    bf16x8 qf[4];
#pragma unroll
    for (int ks = 0; ks < 4; ++ks) qf[ks] = *(const bf16x8*)(Q + (size_t)qrow * 64 + 16 * ks + 8 * hi);
    const float cref = CUM[q0];
    const int ntiles = 4 * qb + 4; const int jmax_w = (q0 + 32 * wid + 31) >> 6; const int jmask_w = (q0 + 32 * wid) >> 6;
    f32x16 o[2]; o[0] = (f32x16){}; o[1] = (f32x16){}; f32x16 lacc = (f32x16){}; float m = -1e30f;
    float* biasL = (float*)(smem + AT_BIAS_OFF);
    const int gq_ = fi >> 4; const int sidx0 = 16 * (128 * gq_ - 2 * gq_ * (gq_ - 1)) + (fi & 15) * (128 - 4 * gq_);
    bf16_t* cvdA = nullptr; bf16_t* cvdB = nullptr; float4 cvaA, cvbA, cvaB, cvbB; float cvsA = 1.f, cvsB = 1.f;
    KV_DECL; float breg = 0.f;
#define TJ(s_) (ntiles - 1 - (s_))
#define CV_ADDR(st_, SRC, DST, SCP) do { int c_ = (sidx0 + (st_)) * CV_PER_STEP + (tid < CV_PER_STEP ? tid : CV_PER_STEP - 1); c_ = c_ < CV_NUP + CV_NDN ? c_ : CV_NUP + CV_NDN - 1; \
        const bool up_ = c_ < CV_NUP; const int cc_ = up_ ? c_ : c_ - CV_NUP; SRC = (up_ ? a.in[I_WUP] : a.in[I_WDN]) + (size_t)cc_ * 8; DST = (bf16_t*)(a.ws + (up_ ? WS_WUP : WS_WDN)) + (size_t)cc_ * 8; \
        SCP = up_ ? a.in[I_LN2] + ((cc_ >> 8) & 1023) : (const float*)(a.ws + WS_ONE); } while (0)
    { const float* cvs_; const float* scp_; CV_ADDR(0, cvs_, cvdB, scp_); cvaB = *(const float4*)cvs_; cvbB = *(const float4*)(cvs_ + 4); cvsB = *scp_; }
    KV_GLOAD(K + (size_t)TJ(0) * 4096, V + (size_t)TJ(0) * 4096); breg = CUM[TJ(0) * 64 + lane];
    KV_LSTORE(smem); biasL[lane] = (cref - breg) * LOG2E;
    KV_GLOAD(K + (size_t)TJ(1) * 4096, V + (size_t)TJ(1) * 4096); breg = CUM[TJ(1) * 64 + lane];
    KV_LSTORE(smem + AT_STAGE); biasL[64 + lane] = (cref - breg) * LOG2E;
    __syncthreads();
#define FOX_QK(P0, P1, jj, sj) do { const float* bl_ = biasL + (sj) * 64; \
        _Pragma("unroll") for (int g4 = 0; g4 < 4; ++g4) { const float4 x_ = *(const float4*)(bl_ + 8 * g4 + 4 * hi), y_ = *(const float4*)(bl_ + 32 + 8 * g4 + 4 * hi); \
            P0[4 * g4] = x_.x; P0[4 * g4 + 1] = x_.y; P0[4 * g4 + 2] = x_.z; P0[4 * g4 + 3] = x_.w; P1[4 * g4] = y_.x; P1[4 * g4 + 1] = y_.y; P1[4 * g4 + 2] = y_.z; P1[4 * g4 + 3] = y_.w; } \
        qk_tile<true>(smem + (sj) * AT_STAGE, qf, P0, P1, lane); \
        if ((jj) >= jmask_w) mask_tile<1>(P0, P1, 64 * (jj), -1, qrow, hi); } while (0)
#define FOX_STEP(CUR0, CUR1, NXT0, NXT1, j, CVD_LD, CVA_LD, CVB_LD, CVS_LD, CVD_ST, CVA_ST, CVB_ST, CVS_ST) do { \
        const int s_cur = (j) % 3, s_nxt = ((j) + 1) % 3, s_ld = ((j) + 2) % 3; const int tl_ = TJ((j) + 2) < 0 ? 0 : TJ((j) + 2);     \
        KV_GLOAD(K + (size_t)tl_ * 4096, V + (size_t)tl_ * 4096); breg = CUM[tl_ * 64 + lane]; \
        { const float* cvs_; const float* scp_; CV_ADDR(j, cvs_, CVD_LD, scp_); CVA_LD = *(const float4*)cvs_; CVB_LD = *(const float4*)(cvs_ + 4); CVS_LD = *scp_; } \
        if ((j) + 1 < ntiles && TJ((j) + 1) <= jmax_w) FOX_QK(NXT0, NXT1, TJ((j) + 1), s_nxt); \
        __builtin_amdgcn_sched_barrier(0); \
        if (TJ(j) <= jmax_w) { softmax_step_nosum(CUR0, CUR1, m, o, lacc); pv_tile_sum(smem + s_cur * AT_STAGE + 8192, CUR0, CUR1, o, lacc, lane); } \
        KV_LSTORE(smem + s_ld * AT_STAGE); biasL[s_ld * 64 + lane] = (cref - breg) * LOG2E; \
        { uint4 o_; o_.x = cvtpk(CVA_ST.x * CVS_ST, CVA_ST.y * CVS_ST); o_.y = cvtpk(CVA_ST.z * CVS_ST, CVA_ST.w * CVS_ST); o_.z = cvtpk(CVB_ST.x * CVS_ST, CVB_ST.y * CVS_ST); o_.w = cvtpk(CVB_ST.z * CVS_ST, CVB_ST.w * CVS_ST); *(uint4*)CVD_ST = o_; } \
        __syncthreads(); } while (0)
    f32x16 pA0, pA1, pB0, pB1;
    if (TJ(0) <= jmax_w) FOX_QK(pA0, pA1, TJ(0), 0);
    for (int j = 0; j < ntiles; j += 2) {
        FOX_STEP(pA0, pA1, pB0, pB1, j, cvdA, cvaA, cvbA, cvsA, cvdB, cvaB, cvbB, cvsB);
        FOX_STEP(pB0, pB1, pA0, pA1, j + 1, cvdB, cvaB, cvbB, cvsB, cvdA, cvaA, cvbA, cvsA);
    }
    { uint4 o_; o_.x = cvtpk(cvaB.x * cvsB, cvaB.y * cvsB); o_.y = cvtpk(cvaB.z * cvsB, cvaB.w * cvsB); o_.z = cvtpk(cvbB.x * cvsB, cvbB.y * cvsB); o_.w = cvtpk(cvbB.z * cvsB, cvbB.w * cvsB); *(uint4*)cvdB = o_; }
#undef CV_ADDR
#undef FOX_QK
#undef FOX_STEP
#undef TJ
    const float inv = 1.0f / lacc[0]; float ss = 0.f;
    const size_t token = (size_t)b * 8192 + qrow;
    bf16_t* O = (bf16_t*)(a.ws + WS_OFOX) + token * 512 + h * 64;
#pragma unroll
    for (int dh = 0; dh < 2; ++dh)
#pragma unroll
        for (int g4 = 0; g4 < 4; ++g4) { const float v0 = o[dh][4 * g4] * inv, v1 = o[dh][4 * g4 + 1] * inv, v2 = o[dh][4 * g4 + 2] * inv, v3 = o[dh][4 * g4 + 3] * inv;
            ss += v0 * v0 + v1 * v1 + v2 * v2 + v3 * v3; uint2 w; w.x = cvtpk(v0, v1); w.y = cvtpk(v2, v3); *(uint2*)(O + 32 * dh + 8 * g4 + 4 * hi) = w; }
    ss = pair_sum(ss);
    if (hi == 0) ((float*)(a.ws + WS_SSQ))[token * 16 + 8 + h] = ss;
}

DEV void nsa_item(const Args& a, unsigned char* smem, int b, int g, int tt) {
    const int tid = TID(), lane = tid & 63, wid = tid >> 6, col = lane & 31, hi = lane >> 5;
    const int t0 = tt * 64, tokw = col >> 2, r = col & 3, h = 4 * g + r; const int tokl = wid * 8 + tokw; const int t = t0 + tokl; const size_t token = (size_t)b * 8192 + t;
    const float slope2 = exp2f(-(float)(h + 1)) * LOG2E;
    const bf16_t* PROJ = (const bf16_t*)(a.ws + WS_PROJ);
    const float* GN = (const float*)(a.ws + WS_GN) + token * 24 + h * 3;
    const int cur = tt; const bool need_topk = cur > 15;
    bf16x8 qf[4];
    { const bf16_t* Q = PROJ + (((size_t)(h * 2 + b)) * 8192 + t) * 64;
#pragma unroll
      for (int ks = 0; ks < 4; ++ks) qf[ks] = *(const bf16x8*)(Q + 16 * ks + 8 * hi); }
    float* impw = (float*)(smem + AT_IMP_OFF) + wid * 2048; float* totw = impw + lane;
    unsigned* selmask = (unsigned*)(smem + AT_SEL_OFF); unsigned* wun = (unsigned*)(smem + AT_WUN_OFF); int* ucnt = (int*)(smem + AT_UCNT_OFF); unsigned char* ulist = smem + AT_ULIST_OFF;
    f32x16 o[2]; float m, l; int par = 0;
    const int tmin_w = t0 + wid * 8, tmax_w = tmin_w + 7;
    {
        const bf16_t* KC = (const bf16_t*)(a.ws + WS_KC) + ((size_t)(0 * 4 + b * 2 + g)) * 512 * 64; const bf16_t* VC = (const bf16_t*)(a.ws + WS_KC) + ((size_t)(1 * 4 + b * 2 + g)) * 512 * 64;
        const int ncv = t0 / 16 + 3; const int nct = (ncv + 63) >> 6;
        auto src = [&](int j, const bf16_t*& kp, const bf16_t*& vp) { kp = KC + (size_t)j * 4096; vp = VC + (size_t)j * 4096; };
        m = -1e30f; l = 0.f;
        auto src0 = [&](const bf16_t*& kp, const bf16_t*& vp) { kp = KC; vp = VC; };
        par = kv_pipeline(smem, nct, src, [&](int j, const unsigned char* st) {
            const int kpos0 = 1024 * j + 31;
            if (kpos0 > tmax_w) return;
            f32x16 p0, p1; alibi_init<16>(p0, p1, slope2, kpos0, t0, hi);
            qk_tile<false>(st, qf, p0, p1, lane);
            if (kpos0 + 16 * 63 > tmin_w) mask_tile<16>(p0, p1, kpos0, -1, t, hi);
            const float mt = rowmax32(p0, p1); const float mn = fmaxf(m, mt); float rs = 0.f;
#pragma unroll
            for (int rr = 0; rr < 16; ++rr) rs += __builtin_amdgcn_exp2f(p0[rr] - mn) + __builtin_amdgcn_exp2f(p1[rr] - mn);
            rs = pair_sum(rs);
            l = l * __builtin_amdgcn_exp2f(m - mn) + rs; m = mn;
        }, 0, false, true, src0);
        const float linv = l > 0.f ? 1.0f / l : 0.f;
        if (need_topk) { for (int i = lane; i < 8 * 129; i += 64) impw[i] = 0.f; }
        o[0] = (f32x16){}; o[1] = (f32x16){};
        const bf16_t* KS0 = PROJ + ((size_t)((12 + g) * 2 + b)) * 8192 * 64 + (size_t)cur * 4096; const bf16_t* VS0 = PROJ + ((size_t)((14 + g) * 2 + b)) * 8192 * 64 + (size_t)cur * 4096;
        par = kv_pipeline(smem, nct, src, [&](int j, const unsigned char* st) {
            const int kpos0 = 1024 * j + 31;
            if (kpos0 > tmax_w) return;
            f32x16 p0, p1; alibi_init<16>(p0, p1, slope2, kpos0, t0, hi);
            qk_tile<false>(st, qf, p0, p1, lane);
            if (kpos0 + 16 * 63 > tmin_w) mask_tile<16>(p0, p1, kpos0, -1, t, hi);
#pragma unroll
            for (int rr = 0; rr < 16; ++rr) { p0[rr] = __builtin_amdgcn_exp2f(p0[rr] - m) * linv; p1[rr] = __builtin_amdgcn_exp2f(p1[rr] - m) * linv; }
            if (need_topk) {
#pragma unroll
                for (int half = 0; half < 2; ++half)
#pragma unroll
                    for (int g4 = 0; g4 < 4; ++g4) { const f32x16& p = half ? p1 : p0;
                        float ms = (p[4 * g4] + p[4 * g4 + 1]) + (p[4 * g4 + 2] + p[4 * g4 + 3]); float ls = p[4 * g4 + 3];
                        ms = quad_sum(ms); ls = quad_sum(ls);
                        const int n = 16 * j + 8 * half + 2 * g4 + hi;
                        if (r == 0) { atomicAdd(&impw[tokw * 129 + n], ms); atomicAdd(&impw[tokw * 129 + n + 1], ls); } }
            }
            pv_tile<false>(st + 8192, p0, p1, o, lane);
        }, par, true, true, [&](const bf16_t*& kp, const bf16_t*& vp) { kp = KS0; vp = VS0; });
    }
    {
        unsigned un0 = 0u, un1 = 0u, un2 = 0u, un3 = 0u;
        if (need_topk) {
#define TK_INIT(V0, V1, M0, M1, M2, M3, tk_) float V0 = impw[(tk_) * 129 + lane], V1 = impw[(tk_) * 129 + 64 + lane]; \
                V0 = (lane >= 1 && lane <= cur - 2) ? V0 : -1.0f; V1 = (lane + 64 <= cur - 2) ? V1 : -1.0f; unsigned M0 = 1u, M1 = 0u, M2 = 0u, M3 = 0u; \
                TK_SET(M0, M1, M2, M3, cur); TK_SET(M0, M1, M2, M3, cur - 1)
#define TK_SET(M0, M1, M2, M3, n_) do { const int n__ = (n_); const unsigned bit__ = 1u << (n__ & 31); const int w__ = n__ >> 5; M0 |= (w__ == 0) ? bit__ : 0u; M1 |= (w__ == 1) ? bit__ : 0u; M2 |= (w__ == 2) ? bit__ : 0u; M3 |= (w__ == 3) ? bit__ : 0u; } while (0)
#define TK_STEP(V0, V1, M0, M1, M2, M3) do { const float mx_ = wave_max_u(fmaxf(V0, V1)); const unsigned long long b0_ = __ballot(V0 == mx_), b1_ = __ballot(V1 == mx_); \
                const int n_ = b0_ ? (__ffsll((long long)b0_) - 1) : (63 + __ffsll((long long)b1_)); const bool hit_ = lane == (n_ & 63); \
                V0 = (hit_ && n_ < 64) ? -1.0f : V0; V1 = (hit_ && n_ >= 64) ? -1.0f : V1; TK_SET(M0, M1, M2, M3, n_); } while (0)
            for (int tk = 0; tk < 8; tk += 4) {
                TK_INIT(a0_, a1_, ma0, ma1, ma2, ma3, tk); TK_INIT(b0v, b1v, mb0, mb1, mb2, mb3, tk + 1); TK_INIT(c0v, c1v, mc0, mc1, mc2, mc3, tk + 2); TK_INIT(d0v, d1v, md0, md1, md2, md3, tk + 3);
                for (int it = 0; it < 13; ++it) { TK_STEP(a0_, a1_, ma0, ma1, ma2, ma3); TK_STEP(b0v, b1v, mb0, mb1, mb2, mb3); TK_STEP(c0v, c1v, mc0, mc1, mc2, mc3); TK_STEP(d0v, d1v, md0, md1, md2, md3); }
                if (lane == 0) { unsigned* sm_ = selmask + (wid * 8 + tk) * 4; sm_[0] = ma0; sm_[1] = ma1; sm_[2] = ma2; sm_[3] = ma3; sm_[4] = mb0; sm_[5] = mb1; sm_[6] = mb2; sm_[7] = mb3;
                    sm_[8] = mc0; sm_[9] = mc1; sm_[10] = mc2; sm_[11] = mc3; sm_[12] = md0; sm_[13] = md1; sm_[14] = md2; sm_[15] = md3; }
                un0 |= ma0 | mb0 | mc0 | md0; un1 |= ma1 | mb1 | mc1 | md1; un2 |= ma2 | mb2 | mc2 | md2; un3 |= ma3 | mb3 | mc3 | md3;
            }
#undef TK_INIT
#undef TK_SET
#undef TK_STEP
        } else {
            const unsigned full = (2u << cur) - 1u;
            un0 = full;
            if (lane < 8) { unsigned* sm_ = selmask + (wid * 8 + lane) * 4; sm_[0] = full; sm_[1] = 0u; sm_[2] = 0u; sm_[3] = 0u; }
        }
        if (lane == 0) { wun[wid * 4] = un0; wun[wid * 4 + 1] = un1; wun[wid * 4 + 2] = un2; wun[wid * 4 + 3] = un3; }
        __syncthreads();
        if (tid == 0) { int c = 0;
            for (int w = 0; w < 4; ++w) { unsigned u = 0u; for (int ww = 0; ww < NWAVE; ++ww) u |= wun[ww * 4 + w]; for (int bb = 0; bb < 32; ++bb) if ((u >> bb) & 1u) ulist[c++] = (unsigned char)(w * 32 + bb); }
            ucnt[0] = c; }
        __syncthreads();
    }
    { const float g0 = GN[0];
#pragma unroll
      for (int rr = 0; rr < 16; ++rr) { totw[rr * 64] = o[0][rr] * g0; totw[(16 + rr) * 64] = o[1][rr] * g0; } }
    {
        const bf16_t* KS = PROJ + ((size_t)((12 + g) * 2 + b)) * 8192 * 64; const bf16_t* VS = PROJ + ((size_t)((14 + g) * 2 + b)) * 8192 * 64;
        const int nu = ucnt[0];
        m = -1e30f; f32x16 lacc = (f32x16){}; o[0] = (f32x16){}; o[1] = (f32x16){};
        const bf16_t* KW0 = PROJ + ((size_t)((16 + g) * 2 + b)) * 8192 * 64 + (size_t)cur * 4096; const bf16_t* VW0 = PROJ + ((size_t)((18 + g) * 2 + b)) * 8192 * 64 + (size_t)cur * 4096;
        par = kv_pipeline(smem, nu, [&](int j, const bf16_t*& kp, const bf16_t*& vp) { const int n = ulist[nu - 1 - j]; kp = KS + (size_t)n * 4096; vp = VS + (size_t)n * 4096; },
            [&](int j, const unsigned char* st) {
                const int n = ulist[nu - 1 - j];
                if (!((wun[wid * 4 + (n >> 5)] >> (n & 31)) & 1u)) return;
                const bool sel = (selmask[tokl * 4 + (n >> 5)] >> (n & 31)) & 1u;
                f32x16 p0, p1; alibi_init<1>(p0, p1, slope2, 64 * n, t0, hi);
                qk_tile<false>(st, qf, p0, p1, lane);
                if (n == cur || !__all(sel)) mask_tile<1>(p0, p1, 64 * n, -1, sel ? t : -1, hi);
                softmax_step_nosum(p0, p1, m, o, lacc);
                pv_tile_sum(st + 8192, p0, p1, o, lacc, lane);
            }, par, true, true, [&](const bf16_t*& kp, const bf16_t*& vp) { kp = KW0; vp = VW0; });
        const float g1 = GN[1] / fmaxf(lacc[0], 1e-30f);
#pragma unroll
        for (int rr = 0; rr < 16; ++rr) { totw[rr * 64] += o[0][rr] * g1; totw[(16 + rr) * 64] += o[1][rr] * g1; }
    }
    {
        const bf16_t* KW = PROJ + ((size_t)((16 + g) * 2 + b)) * 8192 * 64; const bf16_t* VW = PROJ + ((size_t)((18 + g) * 2 + b)) * 8192 * 64;
        const int jlo = (t0 - 511) > 0 ? ((t0 - 511) >> 6) : 0; const int jhi = cur;
        m = -1e30f; f32x16 lacc = (f32x16){}; o[0] = (f32x16){}; o[1] = (f32x16){};
        (void)kv_pipeline(smem, jhi - jlo + 1, [&](int j, const bf16_t*& kp, const bf16_t*& vp) { kp = KW + (size_t)(jhi - j) * 4096; vp = VW + (size_t)(jhi - j) * 4096; },
            [&](int j, const unsigned char* st) {
                const int kpos0 = 64 * (jhi - j);
                if (kpos0 > tmax_w || kpos0 + 63 < tmin_w - 511) return;
                f32x16 p0, p1; alibi_init<1>(p0, p1, slope2, kpos0, t0, hi);
                qk_tile<false>(st, qf, p0, p1, lane);
                if (kpos0 < tmax_w - 511 || kpos0 + 63 > tmin_w) mask_tile<1>(p0, p1, kpos0, t - 511, t, hi);
                softmax_step_nosum(p0, p1, m, o, lacc);
                pv_tile_sum(st + 8192, p0, p1, o, lacc, lane);
            }, par, true, false, NoSrc());
        const float g2 = GN[2] / fmaxf(lacc[0], 1e-30f);
#pragma unroll
        for (int rr = 0; rr < 16; ++rr) { o[0][rr] = totw[rr * 64] + o[0][rr] * g2; o[1][rr] = totw[(16 + rr) * 64] + o[1][rr] * g2; }
    }
    {
        float ss = 0.f; bf16_t* O = (bf16_t*)(a.ws + WS_ONSA) + token * 512 + h * 64;
#pragma unroll
        for (int dh = 0; dh < 2; ++dh)
#pragma unroll
            for (int g4 = 0; g4 < 4; ++g4) { const float v0 = o[dh][4 * g4], v1 = o[dh][4 * g4 + 1], v2 = o[dh][4 * g4 + 2], v3 = o[dh][4 * g4 + 3];
                ss += v0 * v0 + v1 * v1 + v2 * v2 + v3 * v3; uint2 w; w.x = cvtpk(v0, v1); w.y = cvtpk(v2, v3); *(uint2*)(O + 32 * dh + 8 * g4 + 4 * hi) = w; }
        ss = pair_sum(ss);
        if (hi == 0) ((float*)(a.ws + WS_SSQ))[token * 16 + h] = ss;
    }
}
#ifndef PROBE_DUP
#define PROBE_DUP 0
#endif
DEV void phase_att(const Args& a, unsigned char* smem) {
    int* qctr = (int*)(a.ws + WS_CTL) + 64; int* sitem = (int*)(smem + AT_ITEM_OFF);
    unsigned* ctl = (unsigned*)(a.ws + WS_CTL); unsigned* seen = (unsigned*)(smem + AT_ITEM_OFF + 8);
    if (TID() == 0) seen[0] = 0u;
    for (;;) {
        if (TID() == 0) sitem[0] = atomicAdd(qctr, 1);
        __syncthreads();
        const int item = sitem[0];
        __syncthreads();
        if (item >= 32 + 1024) break;
        if (item < 16) cmp_item(a, smem, 16 + item);
        else if (item < 32) cmp_item(a, smem, item - 16);
        else if (item < 32 + 512) { const int fi = item - 32; const int qb = 31 - (fi >> 4), bh = fi & 15; if (!((seen[0] >> bh) & 1u)) { wait_flag(ctl + CW_CUMFLAG + bh, 1u); if (TID() == 0) seen[0] |= 1u << bh; } fox_item(a, smem, fi, bh >> 3, bh & 7, qb); }
        else { const int idx = item - 32 - 512; const int tt = 127 - (idx >> 2), bg = idx & 3; if (!((seen[0] >> 16) & 1u)) { wait_flag(ctl + CW_CMPFLAG, 16u); if (TID() == 0) seen[0] |= 1u << 16; } nsa_item(a, smem, bg >> 1, bg & 1, tt); }
    }
}

DEV void phase_outproj(const Args& a, unsigned char* smem) {
    const bf16_t* ONSA = (const bf16_t*)(a.ws + WS_ONSA); const bf16_t* OFOX = (const bf16_t*)(a.ws + WS_OFOX); const float* SSQ = (const float*)(a.ws + WS_SSQ);
    const bf16_t* W = (const bf16_t*)(a.ws + WS_WOUT); bf16_t* H1 = (bf16_t*)(a.ws + WS_H1); const bf16_t* XB = (const bf16_t*)(a.ws + WS_XN);
    float* rs = (float*)(smem + MISC_OFF);
    const int tid = TID(); int lane = tid & 63, wid = tid >> 6, wr = wid >> 2, wc = wid & 3; (void)wr; (void)wc; (void)lane;
    auto aoffo = [](int r, int kc) { return (unsigned)(r * 1024 + kc * 16); }; auto boffo = [](int k, int nc) { return (unsigned)(k * 2048 + nc * 16); };
    for (int item = VBID(); item < 64 * 4; item += gridDim.x) {
        int mt, nt; patch_decode(item, 64, 4, mt, nt);
        gemm_issue0<15>(smem, ONSA + (size_t)mt * 256 * 512, aoffo, W + nt * 256, boffo);
        if (tid < 256) { const float* s_ = SSQ + (size_t)(mt * 256 + tid) * 16; float sn = 0.f, sf = 0.f;
#pragma unroll
            for (int j = 0; j < 8; ++j) { sn += s_[j]; sf += s_[8 + j]; }
            rs[tid * 2] = rsqrtf(sn * (1.f / 512.f) + EPS); rs[tid * 2 + 1] = rsqrtf(sf * (1.f / 512.f) + EPS); }
        asm volatile("s_waitcnt vmcnt(0)" ::: "memory");
        __syncthreads();
        f32x4 acc[8][4];
#pragma unroll
        for (int mi = 0; mi < 8; ++mi) { const size_t gm = (size_t)mt * 256 + G_ROW(mi);
#pragma unroll
            for (int np = 0; np < 2; ++np) { const uint4 q = *(const uint4*)(XB + gm * 1024 + nt * 256 + PAIR16_COL(G_COL(2 * np), G_COL(2 * np + 1))); uint2 xa, xb; unpair16(q, xa, xb);
                acc[mi][2 * np] = (f32x4){bflo(xa.x), bfhi(xa.x), bflo(xa.y), bfhi(xa.y)}; acc[mi][2 * np + 1] = (f32x4){bflo(xb.x), bfhi(xb.x), bflo(xb.y), bfhi(xb.y)}; } }
#pragma unroll
        for (int mi = 0; mi < 8; ++mi) { const float ri = 1.0f / rs[(G_ROW(mi)) * 2];
#pragma unroll
            for (int ni = 0; ni < 4; ++ni) acc[mi][ni] *= ri; }
        gemm256<false>(smem, 8, ONSA + (size_t)mt * 256 * 512, 128u, aoffo, W + nt * 256, 64u * 2048u, boffo, acc, true,
                       next_tile(true, smem, OFOX + (size_t)mt * 256 * 512, aoffo, W + (size_t)512 * 1024 + nt * 256, boffo));
        EPI_IDS();
#pragma unroll
        for (int mi = 0; mi < 8; ++mi) { const int rl = G_ROW(mi); const float rat = rs[rl * 2] / rs[rl * 2 + 1];
#pragma unroll
            for (int ni = 0; ni < 4; ++ni) acc[mi][ni] *= rat; }
        gemm256<false>(smem, 8, OFOX + (size_t)mt * 256 * 512, 128u, aoffo, W + (size_t)512 * 1024 + nt * 256, 64u * 2048u, boffo, acc, true);
        EPI_IDS();
#pragma unroll
        for (int mi = 0; mi < 8; ++mi) { const int rl = G_ROW(mi); const size_t gm = (size_t)mt * 256 + rl; const float rf = rs[rl * 2 + 1];
#pragma unroll
            for (int np = 0; np < 2; ++np) { const f32x4 v0 = acc[mi][2 * np] * rf, v1 = acc[mi][2 * np + 1] * rf; uint2 oa, ob;
                oa.x = cvtpk(v0[0], v0[1]); oa.y = cvtpk(v0[2], v0[3]); ob.x = cvtpk(v1[0], v1[1]); ob.y = cvtpk(v1[2], v1[3]);
                *(uint4*)(H1 + gm * 1024 + nt * 256 + PAIR16_COL(G_COL(2 * np), G_COL(2 * np + 1))) = pair16(oa, ob); } }
        __syncthreads();
    }
}

DEV void phase_route(const Args& a, unsigned char* smem) {
    const bf16_t* H1 = (const bf16_t*)(a.ws + WS_H1); bf16_t* XN = (bf16_t*)(a.ws + WS_XN); float* RSTD2 = (float*)(a.ws + WS_RSTD2);
    const float* ln2 = a.in[I_LN2]; const float* wr_ = a.in[I_WR]; const float* br = a.in[I_BR];
    int* CNT = (int*)(a.ws + WS_CTL);
    int* TOPI = (int*)(a.ws + WS_TOPI); int* TOPS = (int*)(a.ws + WS_TOPS); float* TOPW = (float*)(a.ws + WS_TOPW);
    int* TOKOF = (int*)(a.ws + WS_TOKOF); float* ROWW = (float*)(a.ws + WS_ROWW); float* RSDS = (float*)(a.ws + WS_RSDS);
    float* part = (float*)smem;
    float* ssqp = part + 8 * 32 * 33;
    int* lcnt = (int*)(ssqp + 256); int* lbase = lcnt + 32; int* te = lbase + 32; int* trk = te + 256; float* tw = (float*)(trk + 256); float* trs = tw + 256;
    const int tid = TID(), lane = tid & 63, wid = tid >> 6, i32 = lane & 31, kh = lane >> 5; const int tg = wid >> 2, kq = wid & 3;
    for (int item = BID(); item < 256; item += gridDim.x) {
        const int tok = item * 64 + tg * 32 + i32;
        if (tid < 32) lcnt[tid] = 0;
        f32x16 acc = (f32x16){}; float ss = 0.f;
        const bf16_t* hrow = H1 + (size_t)tok * 1024 + 256 * kq + 8 * kh; const float* lrow = ln2 + 256 * kq + 8 * kh; bf16_t* xrow = XN + (size_t)tok * 1024 + 256 * kq + 8 * kh;
        const float* wbase = wr_ + (size_t)(256 * kq + 8 * kh) * 32 + i32;
#pragma unroll 1
        for (int hb = 0; hb < 2; ++hb) {
            float4 hv[8][2], lv[8][2]; float wv[8][8];
#pragma unroll
            for (int c = 0; c < 8; ++c) { const int cc = hb * 8 + c;
                { const uint4 hq = *(const uint4*)(hrow + 16 * cc); hv[c][0] = (float4){bflo(hq.x), bfhi(hq.x), bflo(hq.y), bfhi(hq.y)}; hv[c][1] = (float4){bflo(hq.z), bfhi(hq.z), bflo(hq.w), bfhi(hq.w)}; } lv[c][0] = *(const float4*)(lrow + 16 * cc); lv[c][1] = *(const float4*)(lrow + 16 * cc + 4);
#pragma unroll
                for (int r = 0; r < 8; ++r) wv[c][r] = wbase[(size_t)(16 * cc + r) * 32]; }
#pragma unroll
            for (int c = 0; c < 8; ++c) { const int cc = hb * 8 + c; float x[8];
                x[0] = hv[c][0].x * lv[c][0].x; x[1] = hv[c][0].y * lv[c][0].y; x[2] = hv[c][0].z * lv[c][0].z; x[3] = hv[c][0].w * lv[c][0].w;
                x[4] = hv[c][1].x * lv[c][1].x; x[5] = hv[c][1].y * lv[c][1].y; x[6] = hv[c][1].z * lv[c][1].z; x[7] = hv[c][1].w * lv[c][1].w;
                ss += hv[c][0].x * hv[c][0].x + hv[c][0].y * hv[c][0].y + hv[c][0].z * hv[c][0].z + hv[c][0].w * hv[c][0].w + hv[c][1].x * hv[c][1].x + hv[c][1].y * hv[c][1].y + hv[c][1].z * hv[c][1].z + hv[c][1].w * hv[c][1].w;
#pragma unroll
                for (int r = 0; r < 8; ++r) acc = __builtin_amdgcn_mfma_f32_32x32x2f32(x[r], wv[c][r], acc, 0, 0, 0); }
        }
        ss = pair_sum(ss);
        if (kh == 0) ssqp[wid * 32 + i32] = ss;
#pragma unroll
        for (int r = 0; r < 16; ++r) part[(wid * 32 + crow(r, kh)) * 33 + i32] = acc[r];
        __syncthreads();
        if (tid < 64) {
            const int g_ = tid >> 5, i_ = tid & 31; const int w0_ = g_ * 4;
            const float sq = ssqp[(w0_ + 0) * 32 + i_] + ssqp[(w0_ + 1) * 32 + i_] + ssqp[(w0_ + 2) * 32 + i_] + ssqp[(w0_ + 3) * 32 + i_]; const float rstd = rsqrtf(sq * (1.f / 1024.f) + EPS);
            RSTD2[item * 64 + tid] = rstd; trs[tid] = rstd;
            float lg[32];
#pragma unroll
            for (int e = 0; e < 32; ++e) lg[e] = (part[((w0_ + 0) * 32 + i_) * 33 + e] + part[((w0_ + 1) * 32 + i_) * 33 + e] + part[((w0_ + 2) * 32 + i_) * 33 + e] + part[((w0_ + 3) * 32 + i_) * 33 + e]) * rstd + br[e];
            unsigned taken = 0u; float tv[4]; int ti[4];
#pragma unroll
            for (int k = 0; k < 4; ++k) { float best = -3.0e38f; int bi = 0;
#pragma unroll
                for (int e = 0; e < 32; ++e) { const bool ok = !((taken >> e) & 1u) && lg[e] > best; best = ok ? lg[e] : best; bi = ok ? e : bi; }
                taken |= 1u << bi; tv[k] = best; ti[k] = bi; }
            const float e1 = __expf(tv[1] - tv[0]), e2 = __expf(tv[2] - tv[0]), e3 = __expf(tv[3] - tv[0]); const float inv = 1.0f / (1.0f + e1 + e2 + e3);
            const float wv[4] = {inv, e1 * inv, e2 * inv, e3 * inv};
#pragma unroll
            for (int k = 0; k < 4; ++k) { const int idx = tid * 4 + k; te[idx] = ti[k]; trk[idx] = atomicAdd(&lcnt[ti[k]], 1); tw[idx] = wv[k]; }
        }
        __syncthreads();
        if (tid < 32) lbase[tid] = atomicAdd(&CNT[tid], lcnt[tid]);
        __syncthreads();
        if (tid < 256) { const int idx = tid; const int tk = item * 64 + (idx >> 2); const int e = te[idx]; const int slot = lbase[e] + trk[idx];
          TOPI[(size_t)tk * 4 + (idx & 3)] = e; TOPS[(size_t)tk * 4 + (idx & 3)] = slot; TOPW[(size_t)tk * 4 + (idx & 3)] = tw[idx];
          TOKOF[(size_t)e * 16384 + slot] = tk; ROWW[(size_t)e * 16384 + slot] = tw[idx]; RSDS[(size_t)e * 16384 + slot] = trs[idx >> 2]; }
        __syncthreads();
    }
}

struct MoeMap { int e, mt, nt, cnt, off; };
DEV void moe_setup(const Args& a, int* sm) {
    if (TID() == 0) { const int* CNT = (const int*)(a.ws + WS_CTL); int tot = 0; for (int e = 0; e < 32; ++e) { const int c = CNT[e]; const int mt = (c + 255) >> 8; sm[e] = mt; sm[32 + e] = tot; tot += mt; } sm[64] = tot; }
    __syncthreads();
}
DEV MoeMap moe_map(const Args& a, const int* sm, int item, int NT) {
    MoeMap mm; int e = 0;
#pragma unroll 1
    for (int i = 1; i < 32; ++i) if (item >= sm[32 + i] * NT) e = i;
    const int local = item - sm[32 + e] * NT; const int mte = sm[e];
    int mt_, nt_; patch_decode(local, mte, NT, mt_, nt_);
    mm.e = __builtin_amdgcn_readfirstlane(e); mm.mt = __builtin_amdgcn_readfirstlane(mt_); mm.nt = __builtin_amdgcn_readfirstlane(nt_);
    mm.cnt = __builtin_amdgcn_readfirstlane(((const int*)(a.ws + WS_CTL))[e]); mm.off = __builtin_amdgcn_readfirstlane(sm[32 + e] * 256); return mm;
}
DEV int moe_maps_build(const Args& a, const int* sm, int* maps, int nitems, int NT) {
    const int tid = TID(); const int first = VBID(); const int nmine = first < nitems ? (nitems - first + (int)gridDim.x - 1) / (int)gridDim.x : 0;
    for (int k = tid; k < nmine && k < 64; k += NTHR) { const int item = first + k * (int)gridDim.x; int e = 0;
#pragma unroll 1
        for (int i = 1; i < 32; ++i) if (item >= sm[32 + i] * NT) e = i;
        const int local = item - sm[32 + e] * NT; int mt_, nt_; patch_decode(local, sm[e], NT, mt_, nt_);
        maps[k * 8] = e; maps[k * 8 + 1] = mt_; maps[k * 8 + 2] = nt_; maps[k * 8 + 3] = ((const int*)(a.ws + WS_CTL))[e]; maps[k * 8 + 4] = sm[32 + e] * 256; }
    __syncthreads();
    return nmine < 64 ? nmine : 64;
}
DEV MoeMap moe_get(const int* maps, int k) { MoeMap mm; mm.e = __builtin_amdgcn_readfirstlane(maps[k * 8]); mm.mt = __builtin_amdgcn_readfirstlane(maps[k * 8 + 1]); mm.nt = __builtin_amdgcn_readfirstlane(maps[k * 8 + 2]);
    mm.cnt = __builtin_amdgcn_readfirstlane(maps[k * 8 + 3]); mm.off = __builtin_amdgcn_readfirstlane(maps[k * 8 + 4]); return mm; }
DEV void phase_up(const Args& a, unsigned char* smem) {
    int* sm = (int*)(smem + MISC_OFF); int* maps = (int*)(smem + MISC_OFF + 8192); int* tokb = maps + 512; float* rsdb = (float*)(tokb + 768); float* biab = rsdb + 768;
    static_assert(8192 + (512 + 3 * 768) * 4 <= 8192 + 12288, "misc LDS");
    const bf16_t* XN = (const bf16_t*)(a.ws + WS_H1); const bf16_t* W = (const bf16_t*)(a.ws + WS_WUP); bf16_t* ACT = (bf16_t*)(a.ws + WS_ACT); const float* RSDS = (const float*)(a.ws + WS_RSDS);
    const int* TOKOF = (const int*)(a.ws + WS_TOKOF); const float* bup = a.in[I_BUP];
    const int tid = TID(); int lane = tid & 63, wid = tid >> 6, wr = wid >> 2, wc = wid & 3; (void)wr; (void)wc; (void)lane;
    moe_setup(a, sm);
    const int nitems = __builtin_amdgcn_readfirstlane(sm[64]) * 8;
    const int nmine = __builtin_amdgcn_readfirstlane(moe_maps_build(a, sm, maps, nitems, 8));
    int tkr = 0; float rsr = 0.f, bir = 0.f;
    const int t8 = tid & 255;
    auto side_load = [&](const MoeMap& m_) { const int slot = m_.mt * 256 + t8; const bool ok = slot < m_.cnt; const size_t sl_ = (size_t)m_.e * 16384 + (ok ? slot : 0); const int tk_ = TOKOF[sl_]; const float rs_ = RSDS[sl_]; tkr = ok ? tk_ : 0; rsr = ok ? rs_ : 0.f;
        bir = bup[(size_t)m_.e * 2048 + (t8 < 128 ? m_.nt * 128 + t8 : 1024 + m_.nt * 128 + t8 - 128)]; };
    auto side_store = [&](int slot3) { tokb[slot3 * 256 + t8] = tkr; rsdb[slot3 * 256 + t8] = rsr; biab[slot3 * 256 + t8] = bir; };
    auto boffu = [](int k, int nc) { const int sc = ((nc >> 4) ? 1024 : 0) + (nc & 15) * 8; return (unsigned)(k * 4096 + sc * 2); };
    MoeMap mm{}, mn{};
    if (nmine > 0) { mm = moe_get(maps, 0); side_load(mm); side_store(0); }
    if (nmine > 1) { mn = moe_get(maps, 1); side_load(mn); side_store(1); }
    __syncthreads();
    bool pre = false;
    for (int k = 0; k < nmine; ++k) {
        const bool has_next = k + 1 < nmine, has_nn = k + 2 < nmine;
        { const MoeMap m2 = moe_get(maps, has_nn ? k + 2 : nmine - 1); side_load(m2); }
        const int s0 = k % 3, s1 = (k + 1) % 3, s2 = (k + 2) % 3;
        const int* tok = tokb + s0 * 256; const int* tokn = tokb + s1 * 256; const float* rsd = rsdb + s0 * 256; const float* bia = biab + s0 * 256;
        const bf16_t* We = W + (size_t)mm.e * 1024 * 2048; const bf16_t* Wn = W + (size_t)mn.e * 1024 * 2048;
        f32x4 acc[8][4];
        gemm256<true>(smem, 16, XN, 128u, [&](int r, int kc) { return (unsigned)(tok[r] * 2048 + kc * 16); }, We + mm.nt * 128, 64u * 4096u, boffu, acc, pre,
                      next_tile(has_next, smem, XN, [&](int r, int kc) { return (unsigned)(tokn[r] * 2048 + kc * 16); }, Wn + mn.nt * 128, boffu));
        side_store(s2);
        EPI_IDS();
        float bgv[2][4], blv[2][4];
#pragma unroll
        for (int ni = 0; ni < 2; ++ni) { const int jl = wc * 32 + ni * 16 + 4 * (lane >> 4); const float4 bg = *(const float4*)(bia + jl), bl_ = *(const float4*)(bia + 128 + jl);
            bgv[ni][0] = bg.x; bgv[ni][1] = bg.y; bgv[ni][2] = bg.z; bgv[ni][3] = bg.w; blv[ni][0] = bl_.x; blv[ni][1] = bl_.y; blv[ni][2] = bl_.z; blv[ni][3] = bl_.w; }
#pragma unroll
        for (int mi = 0; mi < 8; ++mi) { const int rl_ = G_ROW(mi); const size_t row = (size_t)mm.off + mm.mt * 256 + rl_; const float rs_ = rsd[rl_];
            uint2 o2[2];
#pragma unroll
            for (int ni = 0; ni < 2; ++ni) {
                const f32x4 gv = acc[mi][ni], lv = acc[mi][ni + 2]; float r4[4];
#pragma unroll
                for (int r = 0; r < 4; ++r) { const float gg = fminf(gv[r] * rs_ + bgv[ni][r], 7.0f); const float ll = fminf(fmaxf(lv[r] * rs_ + blv[ni][r], -7.0f), 7.0f); r4[r] = gg * sigmoidf_(1.702f * gg) * (ll + 1.0f); }
                o2[ni].x = cvtpk(r4[0], r4[1]); o2[ni].y = cvtpk(r4[2], r4[3]); }
            { const int c0 = wc * 32 + 4 * (lane >> 4); *(uint4*)(ACT + row * 1024 + mm.nt * 128 + PAIR16_COL(c0, c0 + 16)) = pair16(o2[0], o2[1]); } }
        lds_barrier();
        mm = mn; if (has_nn) mn = moe_get(maps, k + 2); pre = has_next;
    }
}
DEV void phase_down(const Args& a, unsigned char* smem) {
    int* sm = (int*)(smem + MISC_OFF); int* maps = (int*)(smem + MISC_OFF + 8192); float* rwb = (float*)(maps + 512); float* biab = rwb + 768;
    const bf16_t* ACT = (const bf16_t*)(a.ws + WS_ACT); const bf16_t* W = (const bf16_t*)(a.ws + WS_WDN); bf16_t* Y = (bf16_t*)(a.ws + WS_Y);
    const float* ROWW = (const float*)(a.ws + WS_ROWW); const float* bdn = a.in[I_BDN];
    const int tid = TID(); int lane = tid & 63, wid = tid >> 6, wr = wid >> 2, wc = wid & 3; (void)wr; (void)wc; (void)lane;
    moe_setup(a, sm);
    const int nitems = __builtin_amdgcn_readfirstlane(sm[64]) * 4;
    const int nmine = __builtin_amdgcn_readfirstlane(moe_maps_build(a, sm, maps, nitems, 4));
    float rwr = 0.f, bir = 0.f;
    const int t8 = tid & 255;
    auto side_load = [&](const MoeMap& m_) { const int slot = m_.mt * 256 + t8; const bool ok = slot < m_.cnt; const float rw_ = ROWW[(size_t)m_.e * 16384 + (ok ? slot : 0)]; rwr = ok ? rw_ : 0.f; bir = bdn[(size_t)m_.e * 1024 + m_.nt * 256 + t8]; };
    auto side_store = [&](int slot3) { rwb[slot3 * 256 + t8] = rwr; biab[slot3 * 256 + t8] = bir; };
    auto aoffd = [](int r, int kc) { return (unsigned)(r * 2048 + kc * 16); }; auto boffd = [](int k, int nc) { return (unsigned)(k * 2048 + nc * 16); };
    MoeMap mm{}, mn{};
    if (nmine > 0) { mm = moe_get(maps, 0); side_load(mm); side_store(0); }
    if (nmine > 1) { mn = moe_get(maps, 1); side_load(mn); side_store(1); }
    __syncthreads();
    bool pre = false;
    for (int k = 0; k < nmine; ++k) {
        const bool has_next = k + 1 < nmine, has_nn = k + 2 < nmine;
        { const MoeMap m2 = moe_get(maps, has_nn ? k + 2 : nmine - 1); side_load(m2); }
        const int s0 = k % 3, s2 = (k + 2) % 3;
        const float* rw = rwb + s0 * 256; const float* bia = biab + s0 * 256;
        const bf16_t* We = W + (size_t)mm.e * 1024 * 1024; const bf16_t* Ab = ACT + ((size_t)mm.off + mm.mt * 256) * 1024;
        const bf16_t* Wn = W + (size_t)mn.e * 1024 * 1024; const bf16_t* An = ACT + ((size_t)mn.off + mn.mt * 256) * 1024;
        f32x4 acc[8][4];
        gemm256<true>(smem, 16, Ab, 128u, aoffd, We + mm.nt * 256, 64u * 2048u, boffd, acc, pre,
                      next_tile(has_next, smem, An, aoffd, Wn + mn.nt * 256, boffd));
        side_store(s2);
        EPI_IDS();
        float4 bb[4];
#pragma unroll
        for (int ni = 0; ni < 4; ++ni) bb[ni] = *(const float4*)(bia + G_COL(ni));
#pragma unroll
        for (int mi = 0; mi < 8; ++mi) { const int rl = G_ROW(mi); const size_t row = (size_t)mm.off + mm.mt * 256 + rl; const float w = rw[rl];
#pragma unroll
            for (int np = 0; np < 2; ++np) { uint2 o2[2];
#pragma unroll
                for (int h = 0; h < 2; ++h) { const int ni = 2 * np + h; const f32x4 v = acc[mi][ni]; o2[h].x = cvtpk((v[0] + bb[ni].x) * w, (v[1] + bb[ni].y) * w); o2[h].y = cvtpk((v[2] + bb[ni].z) * w, (v[3] + bb[ni].w) * w); }
                *(uint4*)(Y + row * 1024 + mm.nt * 256 + PAIR16_COL(G_COL(2 * np), G_COL(2 * np + 1))) = pair16(o2[0], o2[1]); } }
        lds_barrier();
        mm = mn; if (has_nn) mn = moe_get(maps, k + 2); pre = has_next;
    }
}

DEV void phase_comb(const Args& a, unsigned char* smem) {
    int* sm = (int*)(smem + MISC_OFF);
    moe_setup(a, sm);
    bf16_t* H1 = (bf16_t*)(a.ws + WS_H1); const bf16_t* Y = (const bf16_t*)(a.ws + WS_Y);
    const int* TOPI = (const int*)(a.ws + WS_TOPI); const int* TOPS = (const int*)(a.ws + WS_TOPS);
    const int lane = TID() & 63; const int gw = BID() * NWAVE + (TID() >> 6), ngw = gridDim.x * NWAVE;
    for (int tok = gw; tok < NTOK; tok += ngw) {
        float4 v[4];
#pragma unroll
        for (int j = 0; j < 4; ++j) { const uint2 hq = *(const uint2*)(H1 + (size_t)tok * 1024 + j * 256 + lane * 4); v[j] = (float4){bflo(hq.x), bfhi(hq.x), bflo(hq.y), bfhi(hq.y)}; }
#pragma unroll
        for (int k = 0; k < 4; ++k) { const int e = TOPI[(size_t)tok * 4 + k]; const size_t row = (size_t)sm[32 + e] * 256 + TOPS[(size_t)tok * 4 + k];
#pragma unroll
            for (int j = 0; j < 4; ++j) { const uint2 u = *(const uint2*)(Y + row * 1024 + j * 256 + lane * 4); v[j].x += bflo(u.x); v[j].y += bfhi(u.x); v[j].z += bflo(u.y); v[j].w += bfhi(u.y); } }
        float s = 0.f;
#pragma unroll
        for (int j = 0; j < 4; ++j) { { uint2 hq; hq.x = cvtpk(v[j].x, v[j].y); hq.y = cvtpk(v[j].z, v[j].w); *(uint2*)(H1 + (size_t)tok * 1024 + j * 256 + lane * 4) = hq; } s += v[j].x * v[j].x + v[j].y * v[j].y + v[j].z * v[j].z + v[j].w * v[j].w; }
        const float rstd = rsqrtf(wave_sum(s) * (1.f / 1024.f) + EPS);
        if (lane == 0) ((float*)(a.ws + WS_RSTD3))[tok] = rstd;
    }
}

DEV void phase_gate(const Args& a, unsigned char* smem) {
    const bf16_t* XN = (const bf16_t*)(a.ws + WS_H1); const float* RSTD3 = (const float*)(a.ws + WS_RSTD3); const bf16_t* WG = (const bf16_t*)(a.ws + WS_WGATE); const bf16_t* PB = (const bf16_t*)(a.ws + WS_PB); const bf16_t* WP = (const bf16_t*)(a.ws + WS_WPLE);
    const bf16_t* H2 = (const bf16_t*)(a.ws + WS_H1); float* OUT = a.out; float* SSQ3 = (float*)(a.ws + WS_SSQ3);
    const int tid = TID(); int lane = tid & 63, wid = tid >> 6, wr = wid >> 2, wc = wid & 3; (void)wr; (void)wc; (void)lane;
    bf16_t* GT = (bf16_t*)(a.ws + WS_ACT);
    auto aoffg = [](int r, int kc) { return (unsigned)(r * 2048 + kc * 16); }; auto aoffp = [](int r, int kc) { return (unsigned)(r * 512 + kc * 16); }; auto boffg = [](int k, int nc) { return (unsigned)(k * 2048 + nc * 16); };
    for (int item = VBID(); item < 64 * 4; item += gridDim.x) {
        int mt, nt; patch_decode(item, 64, 4, mt, nt);
        f32x4 acc[8][4];
        gemm256<true>(smem, 16, XN + (size_t)mt * 256 * 1024, 128u, aoffg, WG + nt * 256, 64u * 2048u, boffg, acc, false,
                      next_tile(true, smem, PB + (size_t)mt * 256 * 256, aoffp, WP + nt * 256, boffg));
        EPI_IDS();
#pragma unroll
        for (int hb = 0; hb < 2; ++hb) {
            uint2 wq[4][4]; uint4 hq[4][2];
#pragma unroll
            for (int m4 = 0; m4 < 4; ++m4) { const int mi = hb * 4 + m4; const size_t gm = (size_t)mt * 256 + G_ROW(mi);
#pragma unroll
                for (int np = 0; np < 2; ++np) hq[m4][np] = *(const uint4*)(H2 + gm * 1024 + nt * 256 + PAIR16_COL(G_COL(2 * np), G_COL(2 * np + 1)));
                const float r3 = RSTD3[gm];
#pragma unroll
                for (int ni = 0; ni < 4; ++ni) { const f32x4 v = acc[mi][ni] * r3;
                    uint2 w; w.x = cvtpk(sigmoidf_(v[0]), sigmoidf_(v[1])); w.y = cvtpk(sigmoidf_(v[2]), sigmoidf_(v[3])); wq[m4][ni] = w; } }
#pragma unroll
            for (int m4 = 0; m4 < 4; ++m4) { const int mi = hb * 4 + m4; const size_t gm = (size_t)mt * 256 + G_ROW(mi);
#pragma unroll
                for (int np = 0; np < 2; ++np) { uint2 h2[2]; unpair16(hq[m4][np], h2[0], h2[1]);
                    *(uint4*)(GT + gm * 1024 + nt * 256 + PAIR16_COL(G_COL(2 * np), G_COL(2 * np + 1))) = pair16(wq[m4][2 * np], wq[m4][2 * np + 1]);
#pragma unroll
                    for (int h = 0; h < 2; ++h) { const int ni = 2 * np + h; const uint2 w = wq[m4][ni]; const uint2 hh = h2[h];
                        acc[mi][ni] = (f32x4){bflo(hh.x) * __builtin_amdgcn_rcpf(bflo(w.x)), bfhi(hh.x) * __builtin_amdgcn_rcpf(bfhi(w.x)), bflo(hh.y) * __builtin_amdgcn_rcpf(bflo(w.y)), bfhi(hh.y) * __builtin_amdgcn_rcpf(bfhi(w.y))}; } } }
            asm volatile("" ::: "memory");
        }
        gemm256<false>(smem, 4, PB + (size_t)mt * 256 * 256, 128u, aoffp, WP + nt * 256, 64u * 2048u, boffg, acc, true);
        EPI_IDS();
        const bool fused = gridDim.x >= 256;
#pragma unroll
        for (int hb = 0; hb < 2; ++hb) {
            uint4 gq4[4][2];
#pragma unroll
            for (int m4 = 0; m4 < 4; ++m4) { const size_t gm = (size_t)mt * 256 + G_ROW(hb * 4 + m4);
#pragma unroll
                for (int np = 0; np < 2; ++np) gq4[m4][np] = *(const uint4*)(GT + gm * 1024 + nt * 256 + PAIR16_COL(G_COL(2 * np), G_COL(2 * np + 1))); }
#pragma unroll
            for (int m4 = 0; m4 < 4; ++m4) { const int mi = hb * 4 + m4; const size_t gm = (size_t)mt * 256 + G_ROW(mi); float ss = 0.f;
#pragma unroll
                for (int np = 0; np < 2; ++np) { uint2 g2[2]; unpair16(gq4[m4][np], g2[0], g2[1]);
#pragma unroll
                    for (int h = 0; h < 2; ++h) { const int ni = 2 * np + h; const int n = nt * 256 + G_COL(ni); const f32x4 v = acc[mi][ni]; const uint2 gw = g2[h];
                        float4 o = {v[0] * bflo(gw.x), v[1] * bfhi(gw.x), v[2] * bflo(gw.y), v[3] * bfhi(gw.y)};
                        if (!fused) *(float4*)(OUT + gm * 1024 + n) = o;
                        acc[mi][ni] = (f32x4){o.x, o.y, o.z, o.w};
                        ss += o.x * o.x + o.y * o.y + o.z * o.z + o.w * o.w; } }
                ss += __shfl_xor(ss, 16); ss += __shfl_xor(ss, 32);
                if (lane < 16) SSQ3[gm * 16 + nt * 4 + wc] = ss; }
            asm volatile("" ::: "memory");
        }
        if (fused) {
            unsigned* flag = (unsigned*)(a.ws + WS_CTL) + CW_GATEFLAG + mt;
            const float* lnf = a.in[I_LNF]; float4 gg[4];
#pragma unroll
            for (int ni = 0; ni < 4; ++ni) gg[ni] = *(const float4*)(lnf + nt * 256 + G_COL(ni));
            signal_done(flag); wait_flag(flag, 4u);
            float rstd[8];
#pragma unroll
            for (int mi = 0; mi < 8; ++mi) { const size_t gm = (size_t)mt * 256 + G_ROW(mi); const float4 s0 = *(const float4*)(SSQ3 + gm * 16 + 4 * (lane >> 4)); rstd[mi] = (s0.x + s0.y) + (s0.z + s0.w); }
#pragma unroll
            for (int mi = 0; mi < 8; ++mi) { float t_ = rstd[mi]; t_ += __shfl_xor(t_, 16); t_ += __shfl_xor(t_, 32); rstd[mi] = rsqrtf(t_ * (1.f / 1024.f) + EPS); }
#pragma unroll
            for (int mi = 0; mi < 8; ++mi) { const size_t gm = (size_t)mt * 256 + G_ROW(mi);
#pragma unroll
                for (int ni = 0; ni < 4; ++ni) { const int n = nt * 256 + G_COL(ni); const f32x4 v = acc[mi][ni]; const float r_ = rstd[mi];
                    float4 o = {v[0] * r_ * gg[ni].x, v[1] * r_ * gg[ni].y, v[2] * r_ * gg[ni].z, v[3] * r_ * gg[ni].w}; *(float4*)(OUT + gm * 1024 + n) = o; } }
        }
        __syncthreads();
    }
}

DEV void phase_final(const Args& a) {
    if (gridDim.x >= 256) return;
    float* OUT = a.out; const float* SSQ3 = (const float*)(a.ws + WS_SSQ3); const float* g = a.in[I_LNF];
    const int lane = TID() & 63; const int gw = BID() * NWAVE + (TID() >> 6), ngw = gridDim.x * NWAVE;
    for (int m = gw; m < NTOK; m += ngw) {
        float s = 0.f;
#pragma unroll
        for (int j = 0; j < 16; ++j) s += SSQ3[(size_t)m * 16 + j];
        const float rstd = rsqrtf(s * (1.f / 1024.f) + EPS);
#pragma unroll
        for (int j = 0; j < 4; ++j) { float4 v = *(const float4*)(OUT + (size_t)m * 1024 + j * 256 + lane * 4); const float4 gg = *(const float4*)(g + j * 256 + lane * 4);
            v.x *= rstd * gg.x; v.y *= rstd * gg.y; v.z *= rstd * gg.z; v.w *= rstd * gg.w; *(float4*)(OUT + (size_t)m * 1024 + j * 256 + lane * 4) = v; }
    }
}

template <int PH> DEV void run_phase(const Args& a, unsigned char* smem) {
    if constexpr (PH == PH_PRO) phase_prologue(a, smem);
    else if constexpr (PH == PH_INPROJ) phase_inproj(a, smem);
    else if constexpr (PH == PH_ATT) phase_att(a, smem);
    else if constexpr (PH == PH_OUTPROJ) phase_outproj(a, smem);
    else if constexpr (PH == PH_ROUTE) phase_route(a, smem);
    else if constexpr (PH == PH_UP) phase_up(a, smem);
    else if constexpr (PH == PH_DOWN) phase_down(a, smem);
    else if constexpr (PH == PH_COMB) phase_comb(a, smem);
    else if constexpr (PH == PH_GATE) phase_gate(a, smem);
    else if constexpr (PH == PH_FINAL) phase_final(a);
}
#define XB_TMO      128
#define XB_XCNT(j)  (256  + 64 * (j))
#define XB_XSUB(j)  (1280 + 64 * (j))
#define XB_XGEN(j)  (2304 + 64 * (j))
#define XB_TOP      3328
#define XB_TOPGEN   3392
#define XCD_BAR_WORDS 3456
#define XB_SPIN_CAP (1u << 22)
DEV unsigned xb_ld(unsigned* p)              { return __hip_atomic_load(p, __ATOMIC_RELAXED, __HIP_MEMORY_SCOPE_AGENT); }
DEV unsigned xb_add(unsigned* p, unsigned v) { return __hip_atomic_fetch_add(p, v, __ATOMIC_RELAXED, __HIP_MEMORY_SCOPE_AGENT); }
DEV unsigned xb_xcc_id() { return (unsigned)__builtin_amdgcn_s_getreg((3 << 11) | 20) & 0xFu; }
#define XB_SPIN(cond, bar) do { unsigned _sp = 0; while (cond) { __builtin_amdgcn_s_sleep(1); \
    if ((++_sp & 255u) == 0u) { if (xb_ld(&(bar)[XB_TMO])) break; if (_sp > XB_SPIN_CAP) { atomicAdd(&(bar)[XB_TMO], 1u); break; } } } } while (0)
struct XcdBarrier { unsigned* bar; unsigned x; volatile LAS unsigned* st; };
DEV XcdBarrier xcd_barrier_post(unsigned* bar, volatile LAS unsigned* st) {
    XcdBarrier b; b.bar = bar; b.x = xb_xcc_id(); b.st = st;
    if (TID() == 0) (void)xb_add(&bar[XB_XCNT(b.x)], 1u);
    return b;
}
DEV void xcd_barrier_complete(unsigned* bar, unsigned x, unsigned& nloc, unsigned& nx) {
    const unsigned G = gridDim.x * gridDim.y * gridDim.z;
    unsigned sum, cnt, mine, sp = 0u;
    for (;;) {
        sum = 0u; cnt = 0u; mine = 0u;
#pragma unroll
        for (unsigned j = 0; j < 16; ++j) { const unsigned c = xb_ld(&bar[XB_XCNT(j)]); sum += c; cnt += (c > 0u) ? 1u : 0u; mine = (j == x) ? c : mine; }
        if (sum == G) break;
        __builtin_amdgcn_s_sleep(1);
        if ((++sp & 255u) == 0u) { if (xb_ld(&bar[XB_TMO])) break; if (sp > XB_SPIN_CAP) { atomicAdd(&bar[XB_TMO], 1u); break; } }
    }
    nloc = mine > 0u ? mine : 1u; nx = cnt > 0u ? cnt : 1u;
}
DEV void xcd_barrier(const XcdBarrier& b) {
    asm volatile("s_waitcnt vmcnt(0)" ::: "memory");
    __syncthreads();
    if (TID() == 0) {
        unsigned* bar = b.bar;
        __builtin_amdgcn_s_waitcnt(0);
        unsigned nloc = b.st[0], nx = b.st[1];
        if (nloc == 0u) { xcd_barrier_complete(bar, b.x, nloc, nx); b.st[0] = nloc; b.st[1] = nx; }
        const unsigned old = xb_add(&bar[XB_XSUB(b.x)], 1u);
        const unsigned gen = old / nloc;
        if (old + 1u == (gen + 1u) * nloc) {
            __builtin_amdgcn_fence(__ATOMIC_RELEASE, "agent");
            asm volatile("s_waitcnt vmcnt(0)" ::: "memory");
            const unsigned og = xb_add(&bar[XB_TOP], 1u);
            const unsigned tg = og / nx;
            if (og + 1u == (tg + 1u) * nx) xb_add(&bar[XB_TOPGEN], 1u);
            else XB_SPIN(xb_ld(&bar[XB_TOPGEN]) == tg, bar);
            __builtin_amdgcn_fence(__ATOMIC_ACQUIRE, "agent");
            xb_add(&bar[XB_XGEN(b.x)], 1u);
            asm volatile("s_waitcnt vmcnt(0)" ::: "memory");
        } else {
            XB_SPIN(xb_ld(&bar[XB_XGEN(b.x)]) == gen, bar);
            __builtin_amdgcn_fence(__ATOMIC_ACQUIRE, "agent");
            asm volatile("s_waitcnt vmcnt(0)" ::: "memory");
        }
    }
    __syncthreads();
}

__global__ void __launch_bounds__(NTHR, 2) mega(Args a) {
    extern __shared__ __attribute__((aligned(16))) unsigned char smem[];
    volatile LAS unsigned* bst = (volatile LAS unsigned*)(LAS unsigned char*)(smem + MISC_OFF + 8000);
    if (TID() == 0) { bst[0] = 0u; bst[1] = 0u; }
    __syncthreads();
    const XcdBarrier bar = xcd_barrier_post((unsigned*)(a.ws + WS_CTL) + 4096, bst);
#define GSYNC() xcd_barrier(bar)
#define RUN(ph) do { run_phase<ph>(a, smem); if ((PROBE_DUP >> ph) & 1) { GSYNC(); run_phase<ph>(a, smem); } } while (0)
    RUN(PH_PRO); GSYNC();
    RUN(PH_INPROJ); GSYNC();
    RUN(PH_ATT); GSYNC();
    RUN(PH_OUTPROJ); GSYNC();
    RUN(PH_ROUTE); GSYNC();
    RUN(PH_UP); GSYNC();
    RUN(PH_DOWN); GSYNC();
    RUN(PH_COMB); GSYNC();
    RUN(PH_GATE);
    if (gridDim.x < 256) { GSYNC(); RUN(PH_FINAL); }
#undef RUN
#undef GSYNC
}

extern "C" void kernel_launch(void* const* d_in, const int* in_sizes, int n_in, void* d_out, int out_size, void* d_ws, size_t ws_size, hipStream_t stream) {
    static int grid = 0;
    if (grid == 0) {
        if (n_in != 25 || ws_size < WS_END) { fprintf(stderr, "kernel_launch: unexpected n_in %d / ws %zu\n", n_in, ws_size); grid = -1; return; }
        int dev = 0, cus = 0, per_cu = 0;
        (void)hipGetDevice(&dev); (void)hipDeviceGetAttribute(&cus, hipDeviceAttributeMultiprocessorCount, dev);
        (void)hipFuncSetAttribute((const void*)mega, hipFuncAttributeMaxDynamicSharedMemorySize, LDS_BYTES);
        (void)hipOccupancyMaxActiveBlocksPerMultiprocessor(&per_cu, (const void*)mega, NTHR, LDS_BYTES);
        if (per_cu < 1) { fprintf(stderr, "kernel_launch: occupancy query says %d blocks per CU\n", per_cu); grid = -1; return; }
        grid = cus;
    }
    if (grid < 0) return;
    (void)hipMemsetAsync((char*)d_ws + WS_CTL, 0, 65536, stream);
    Args a{};
    for (int i = 0; i < 25; ++i) a.in[i] = (const float*)d_in[i];
    a.out = (float*)d_out; a.ws = (unsigned char*)d_ws; a.ph_lo = 0; a.ph_hi = PH_N;
    void* args[] = {&a};
    hipError_t e = hipLaunchCooperativeKernel((const void*)mega, dim3(grid), dim3(NTHR), args, LDS_BYTES, stream);
    if (e != hipSuccess) fprintf(stderr, "cooperative launch failed: %s (grid %d)\n", hipGetErrorString(e), grid);
}
```

```cpp
#include <hip/hip_runtime.h>
#include <stdint.h>
#include <cstdio>

#define DEV __device__ __forceinline__
#define LAS __attribute__((address_space(3)))

typedef unsigned short bf16_t;
typedef short bf16x8 __attribute__((ext_vector_type(8)));
typedef short s16x4 __attribute__((ext_vector_type(4)));
typedef float f32x4 __attribute__((ext_vector_type(4)));
typedef float f32x16 __attribute__((ext_vector_type(16)));
typedef float f32x2_t __attribute__((ext_vector_type(2)));
typedef __bf16 bf16x2_t __attribute__((ext_vector_type(2)));

constexpr int NTHR = 512, NWAVE = 8;
constexpr int NTOK = 16384;
constexpr float EPS = 1e-6f;
constexpr float LOG2E = 1.4426950408889634f;
constexpr float QS = 0.125f * LOG2E;
constexpr int NWIN = 3072;

constexpr size_t MiB = 1u << 20;
constexpr size_t WS_CTL = 0;
constexpr size_t WS_WIN = 1 * MiB;
constexpr size_t WS_WOUT = 7 * MiB;
constexpr size_t WS_WGATE = 9 * MiB;
constexpr size_t WS_WPLE = 11 * MiB;
constexpr size_t WS_WC1 = 12 * MiB;
constexpr size_t WS_WC2 = 15 * MiB + 512 * 1024 + 262144;
constexpr size_t WS_BIAS1 = 15 * MiB + 512 * 1024 + 262144 + 131072;
constexpr size_t WS_KC = 14 * MiB;
constexpr size_t WS_HID = 14 * MiB + 512 * 1024;
constexpr size_t WS_GN = 16 * MiB;
constexpr size_t WS_LS = 18 * MiB;
constexpr size_t WS_CUM = 19 * MiB;
constexpr size_t WS_SSQ = 20 * MiB;
constexpr size_t WS_TOPI = 21 * MiB;
constexpr size_t WS_TOPS = 21 * MiB + 262144;
constexpr size_t WS_TOPW = 21 * MiB + 524288;
constexpr size_t WS_TOKOF = 22 * MiB;
constexpr size_t WS_ROWW = 24 * MiB;
constexpr size_t WS_SSQ3 = 26 * MiB;
constexpr size_t WS_RSTD2 = 27 * MiB;
constexpr size_t WS_RSTD1 = 27 * MiB + 196608;
constexpr size_t WS_ONE = 27 * MiB + 131072;
constexpr size_t WS_RSTD3 = 27 * MiB + 65536;
constexpr size_t WS_PB = 28 * MiB;
constexpr size_t WS_XN = 36 * MiB;
constexpr size_t WS_PROJ = 68 * MiB;
constexpr size_t WS_ONSA = 160 * MiB;
constexpr size_t WS_OFOX = 176 * MiB;
constexpr size_t WS_H1 = 192 * MiB;
constexpr size_t WS_WUP = 256 * MiB;
constexpr size_t WS_WDN = 384 * MiB;
constexpr size_t WS_ACT = 448 * MiB;
constexpr size_t WS_Y = 592 * MiB;
constexpr size_t WS_RSDS = 736 * MiB;
constexpr size_t WS_END = 738 * MiB;

enum { PH_PRO = 0, PH_INPROJ, PH_CMP, PH_ATT, PH_OUTPROJ, PH_ROUTE, PH_UP, PH_DOWN, PH_COMB, PH_GATE, PH_FINAL, PH_N };
struct Args { const float* in[25]; float* out; unsigned char* ws; int ph_lo, ph_hi; };
enum { I_X = 0, I_P, I_LN1, I_WIN, I_BFG, I_WC1K, I_WC2K, I_PEK, I_WC1V, I_WC2V, I_PEV, I_GNN, I_GNF, I_WOUT, I_LN2, I_WR, I_BR,
       I_WUP, I_BUP, I_WDN, I_BDN, I_LNPLE, I_WPLE, I_WGATE, I_LNF };

DEV int BID() { int b = (int)blockIdx.x; asm volatile("" : "+s"(b)); return b; }
DEV int VBID() { const int g = (int)gridDim.x, b = BID(); return (g & 7) ? b : (b & 7) * (g >> 3) + (b >> 3); }
DEV int TID() { int t = (int)__builtin_amdgcn_workitem_id_x(); asm volatile("" : "+v"(t)); return t; }
DEV unsigned cvtpk(float lo, float hi) { f32x2_t v = {lo, hi}; bf16x2_t b = __builtin_convertvector(v, bf16x2_t); return __builtin_bit_cast(unsigned, b); }
DEV float bflo(unsigned u) { return __uint_as_float(u << 16); }
DEV float bfhi(unsigned u) { return __uint_as_float(u & 0xffff0000u); }
DEV float wave_sum(float v) {
#pragma unroll
    for (int o = 1; o < 64; o <<= 1) v += __shfl_xor(v, o);
    return v;
}
#define DPP_MOV(x, ctrl) __builtin_bit_cast(float, __builtin_amdgcn_update_dpp(0, __builtin_bit_cast(int, (x)), (ctrl), 0xF, 0xF, true))
DEV float pair_sum(float x) { return x + __shfl_xor(x, 32); }
DEV float pair_max(float x) { return fmaxf(x, __shfl_xor(x, 32)); }
DEV float quad_sum(float x) { x += DPP_MOV(x, 0xB1); x += DPP_MOV(x, 0x4E); return x; }
DEV float wave_max_u(float x) {
    x = fmaxf(x, DPP_MOV(x, 0xB1)); x = fmaxf(x, DPP_MOV(x, 0x4E)); x = fmaxf(x, DPP_MOV(x, 0x141)); x = fmaxf(x, DPP_MOV(x, 0x140));
    const float a = __builtin_bit_cast(float, __builtin_amdgcn_readlane(__builtin_bit_cast(int, x), 0)), b = __builtin_bit_cast(float, __builtin_amdgcn_readlane(__builtin_bit_cast(int, x), 16));
    const float c = __builtin_bit_cast(float, __builtin_amdgcn_readlane(__builtin_bit_cast(int, x), 32)), d = __builtin_bit_cast(float, __builtin_amdgcn_readlane(__builtin_bit_cast(int, x), 48));
    return fmaxf(fmaxf(a, b), fmaxf(c, d));
}
DEV float sigmoidf_(float x) { return __builtin_amdgcn_rcpf(1.0f + __expf(-x)); }
DEV float logsigmoidf_(float x) { return fminf(x, 0.f) - log1pf(__expf(-fabsf(x))); }
DEV float gelu_tanh(float x) { const float u = 0.7978845608028654f * (x + 0.044715f * x * x * x); const float th = 1.0f - 2.0f * __builtin_amdgcn_rcpf(__expf(2.0f * u) + 1.0f); return 0.5f * x * (1.0f + th); }
DEV s16x4 tr_read(const unsigned char* p) {
    typedef short v4i16_t __attribute__((ext_vector_type(4)));
    return __builtin_bit_cast(s16x4, __builtin_amdgcn_ds_read_tr16_b64_v4i16((LAS v4i16_t*)p));
}
DEV s16x4 tr_read_l(unsigned lds_addr) {
    typedef short v4i16_t __attribute__((ext_vector_type(4)));
    return __builtin_bit_cast(s16x4, __builtin_amdgcn_ds_read_tr16_b64_v4i16((LAS v4i16_t*)(uintptr_t)lds_addr));
}
DEV int crow(int r, int hi) { return (r & 3) + 8 * (r >> 2) + 4 * hi; }

constexpr int GL_STAGE = 65536;
constexpr int GEMM_LDS = 2 * GL_STAGE;
constexpr int MISC_OFF = GEMM_LDS;
constexpr int LDS_BYTES = GEMM_LDS + 8192 + 12288;

DEV void glds16s(const void* sbase, unsigned voff, unsigned lds_dst) { unsigned keep;
    asm volatile("s_mov_b32 %0, m0\n\ts_mov_b32 m0, %3\n\ts_nop 0\n\tglobal_load_lds_dwordx4 %1, %2\n\ts_mov_b32 m0, %0" : "=&s"(keep) : "v"(voff), "s"(sbase), "s"(lds_dst) : "memory"); }

DEV const unsigned char* uptr(const void* p) { const unsigned long long v = (unsigned long long)p; const unsigned lo = __builtin_amdgcn_readfirstlane((unsigned)v), hi = __builtin_amdgcn_readfirstlane((unsigned)(v >> 32)); return (const unsigned char*)(((unsigned long long)hi << 32) | lo); }

DEV void lds_barrier() { asm volatile("s_waitcnt lgkmcnt(0)\n\ts_barrier" ::: "memory"); }

struct NoNextS { DEV void operator()() const {} };
template <class AO, class BO>
DEV void gemm256s_issue0(unsigned char* smem, const void* abase, const AO& aoff, const void* bbase, const BO& boff) {
    const int tid = TID(), lane = tid & 63; const int wid = __builtin_amdgcn_readfirstlane(tid >> 6);
    const unsigned lds0 = (unsigned)(uintptr_t)smem; const unsigned char* ab_ = uptr(abase); const unsigned char* bb_ = uptr(bbase);
#pragma unroll
    for (int i = 0; i < 4; ++i) { const int p = wid + 8 * i; glds16s(ab_, aoff(8 * p + (lane >> 3), (lane & 7) ^ (lane >> 3)), (unsigned)__builtin_amdgcn_readfirstlane(lds0 + p * 1024)); }
#pragma unroll
    for (int i = 0; i < 4; ++i) { const int p = wid + 8 * i; const int k = 2 * p + (lane >> 5); const int f = (k & 3) + 4 * ((k >> 3) & 1);
        glds16s(bb_, boff(k, (lane & 31) ^ (f << 1)), (unsigned)__builtin_amdgcn_readfirstlane(lds0 + 32768 + p * 1024)); }
}
template <bool ZERO, class AO, class BO, class NX = NoNextS>
DEV void gemm256s(unsigned char* smem, int nkt, const void* abase, unsigned akstep, const AO& aoff, const void* bbase, unsigned bkstep, const BO& boff, f32x4 (&acc)[8][4], bool pre = false, const NX& next = NX()) {
    const int tid = TID(), lane = tid & 63; const int wid = __builtin_amdgcn_readfirstlane(tid >> 6); const int wr = wid >> 2, wc = wid & 3;
    if (ZERO) {
#pragma unroll
        for (int mi = 0; mi < 8; ++mi)
#pragma unroll
            for (int ni = 0; ni < 4; ++ni) acc[mi][ni] = (f32x4){0.f, 0.f, 0.f, 0.f};
    }
    const unsigned lds0 = (unsigned)(uintptr_t)smem;
    const unsigned char* abase_u = uptr(abase); const unsigned char* bbase_u = uptr(bbase); const unsigned akstep_u = __builtin_amdgcn_readfirstlane(akstep), bkstep_u = __builtin_amdgcn_readfirstlane(bkstep);
    unsigned ao[4], bo[4];
#pragma unroll
    for (int i = 0; i < 4; ++i) { const int p = wid + 8 * i; ao[i] = aoff(8 * p + (lane >> 3), (lane & 7) ^ (lane >> 3));
        const int k = 2 * p + (lane >> 5); const int f = (k & 3) + 4 * ((k >> 3) & 1); bo[i] = boff(k, (lane & 31) ^ (f << 1)); }
#define GL_ISSUE(kt, st) do { const unsigned char* ab_ = abase_u + (size_t)(kt) * akstep_u; const unsigned char* bb_ = bbase_u + (size_t)(kt) * bkstep_u; \
        _Pragma("unroll") for (int i_ = 0; i_ < 4; ++i_) glds16s(ab_, ao[i_], (unsigned)__builtin_amdgcn_readfirstlane(lds0 + (st) * GL_STAGE + (wid + 8 * i_) * 1024)); \
        _Pragma("unroll") for (int i_ = 0; i_ < 4; ++i_) glds16s(bb_, bo[i_], (unsigned)__builtin_amdgcn_readfirstlane(lds0 + (st) * GL_STAGE + 32768 + (wid + 8 * i_) * 1024)); } while (0)
    if (!pre) {
        GL_ISSUE(0, 0);
        asm volatile("s_waitcnt vmcnt(0)" ::: "memory");
        __syncthreads();
    }
    for (int kt = 0; kt < nkt; ++kt) {
        if (kt + 1 < nkt) GL_ISSUE(kt + 1, (kt + 1) & 1); else next();
        const unsigned char* A = smem + (kt & 1) * GL_STAGE; const unsigned char* Bt = A + 32768;
#pragma unroll
        for (int ks = 0; ks < 2; ++ks) {
            bf16x8 wf[4];
#pragma unroll
            for (int ni = 0; ni < 4; ++ni) {
                const int i = lane & 15, g = lane >> 4, q = i >> 2; const int row = ks * 32 + 8 * g + q; const int nc = wc * 8 + ni * 2 + ((i & 3) >> 1); const int f = q + 4 * (g & 1);
                const unsigned char* p = Bt + row * 512 + ((nc ^ (f << 1)) << 4) + (i & 1) * 8;
                const s16x4 lo = tr_read(p), hi = tr_read(p + 4 * 512);
                wf[ni] = (bf16x8){lo[0], lo[1], lo[2], lo[3], hi[0], hi[1], hi[2], hi[3]};
            }
#pragma unroll
            for (int mi = 0; mi < 8; ++mi) {
                const int m = wr * 128 + mi * 16 + (lane & 15); const int kc = ks * 4 + (lane >> 4);
                const bf16x8 af = *(const bf16x8*)(A + m * 128 + ((kc ^ (m & 7)) << 4));
#pragma unroll
                for (int ni = 0; ni < 4; ++ni) acc[mi][ni] = __builtin_amdgcn_mfma_f32_16x16x32_bf16(wf[ni], af, acc[mi][ni], 0, 0, 0);
            }
        }
        asm volatile("s_waitcnt vmcnt(0)" ::: "memory");
        __syncthreads();
    }
#undef GL_ISSUE
}

#define G_ROW(mi) ((((mi) >> 2) * 128) + wr * 64 + (((mi) & 3) * 16) + (lane & 15))
#define G_COL(ni) ((((ni) >> 1) * 128) + wc * 32 + (((ni) & 1) * 16) + 4 * (lane >> 4))
#define WAIT_V(n) asm volatile("s_waitcnt vmcnt(" #n ")" ::: "memory")
#define WAIT_L(n) asm volatile("s_waitcnt lgkmcnt(" #n ")" ::: "memory")
#define BAR() __builtin_amdgcn_s_barrier()
#define SCHED() __builtin_amdgcn_sched_barrier(0)
constexpr int SA_(int b, int h) { return b * GL_STAGE + h * 16384; }
constexpr int SB_(int b, int h) { return b * GL_STAGE + 32768 + h * 16384; }
struct NoNext { DEV bool has() const { return false; } template <int P> DEV void issue() const {} };
template <int WHICH, class AO, class BO>
DEV void gemm_issue0(unsigned char* smem, const void* abase, const AO& aoff, const void* bbase, const BO& boff) {
    const int tid = TID(), lane = tid & 63; const int wid = __builtin_amdgcn_readfirstlane(tid >> 6);
    const unsigned lds0 = (unsigned)(uintptr_t)smem; const unsigned char* ab_ = uptr(abase); const unsigned char* bb_ = uptr(bbase);
#pragma unroll
    for (int h = 0; h < 2; ++h) {
        if (WHICH & (1 << (2 * h))) {
#pragma unroll
            for (int i = 0; i < 2; ++i) { const int p = wid + 8 * i; const int k = 4 * p + (lane >> 4); const int f = (k & 3) + 4 * ((k >> 3) & 1);
                glds16s(bb_, boff(k, h * 16 + ((lane & 15) ^ (f << 1))), (unsigned)__builtin_amdgcn_readfirstlane(lds0 + SB_(0, h) + p * 1024)); } }
        if (WHICH & (2 << (2 * h))) {
#pragma unroll
            for (int i = 0; i < 2; ++i) { const int p = wid + 8 * i;
                glds16s(ab_, aoff(h * 128 + 8 * p + (lane >> 3), (lane & 7) ^ (lane >> 3)), (unsigned)__builtin_amdgcn_readfirstlane(lds0 + SA_(0, h) + p * 1024)); } }
    }
}
template <class AO, class BO>
struct NextTile { bool on; unsigned char* smem; const void* abase; AO aoff; const void* bbase; BO boff;
    DEV bool has() const { return on; }
    template <int P> DEV void issue() const { gemm_issue0<P>(smem, abase, aoff, bbase, boff); } };
template <class AO, class BO> DEV NextTile<AO, BO> next_tile(bool on, unsigned char* smem, const void* abase, const AO& aoff, const void* bbase, const BO& boff) { return NextTile<AO, BO>{on, smem, abase, aoff, bbase, boff}; }
template <bool ZERO, class AO, class BO, class NX = NoNext>
DEV void gemm256(unsigned char* smem, int nkt, const void* abase, unsigned akstep, const AO& aoff, const void* bbase, unsigned bkstep, const BO& boff, f32x4 (&acc)[8][4], bool pre = false, const NX& next = NX()) {
    const int tid = TID(), lane = tid & 63; const int wid = __builtin_amdgcn_readfirstlane(tid >> 6); const int wr = wid >> 2, wc = wid & 3;
    if (ZERO) {
#pragma unroll
        for (int mi = 0; mi < 8; ++mi)
#pragma unroll
            for (int ni = 0; ni < 4; ++ni) acc[mi][ni] = (f32x4){0.f, 0.f, 0.f, 0.f};
    }
    const unsigned lds0 = (unsigned)(uintptr_t)smem;
    const unsigned char* abase_u = uptr(abase); const unsigned char* bbase_u = uptr(bbase); const unsigned akstep_u = __builtin_amdgcn_readfirstlane(akstep), bkstep_u = __builtin_amdgcn_readfirstlane(bkstep);
    unsigned ao[4], bo[4];
#pragma unroll
    for (int h = 0; h < 2; ++h)
#pragma unroll
        for (int i = 0; i < 2; ++i) { const int p = wid + 8 * i; ao[h * 2 + i] = aoff(h * 128 + 8 * p + (lane >> 3), (lane & 7) ^ (lane >> 3));
            const int k = 4 * p + (lane >> 4); const int f = (k & 3) + 4 * ((k >> 3) & 1); bo[h * 2 + i] = boff(k, h * 16 + ((lane & 15) ^ (f << 1))); }
    unsigned ard0[2], ard1[2], brd0[2], brd1[2];
    { const int l15 = lane & 15, g = lane >> 4, q = l15 >> 2; const int f = q + 4 * (g & 1);
      ard0[0] = lds0 + (wr * 64 + l15) * 128 + ((g ^ (lane & 7)) << 4); ard1[0] = lds0 + (wr * 64 + l15) * 128 + (((4 + g) ^ (lane & 7)) << 4);
      const int nc = wc * 4 + ((l15 & 3) >> 1); const int kr = 8 * g + q;
      brd0[0] = lds0 + kr * 256 + ((nc ^ (f << 1)) << 4) + (l15 & 1) * 8; brd1[0] = lds0 + kr * 256 + (((nc + 2) ^ (f << 1)) << 4) + (l15 & 1) * 8;
      ard0[1] = ard0[0] + GL_STAGE; ard1[1] = ard1[0] + GL_STAGE; brd0[1] = brd0[0] + GL_STAGE; brd1[1] = brd1[0] + GL_STAGE;
      asm volatile("" : "+v"(ard0[1]), "+v"(ard1[1]), "+v"(brd0[1]), "+v"(brd1[1])); }
#define ST_A(b, h, kt) do { const unsigned char* ab_ = abase_u + (size_t)(kt) * akstep_u; \
        _Pragma("unroll") for (int i_ = 0; i_ < 2; ++i_) glds16s(ab_, ao[(h) * 2 + i_], (unsigned)__builtin_amdgcn_readfirstlane(lds0 + SA_(b, h) + (wid + 8 * i_) * 1024)); } while (0)
#define ST_B(b, h, kt) do { const unsigned char* bb_ = bbase_u + (size_t)(kt) * bkstep_u; \
        _Pragma("unroll") for (int i_ = 0; i_ < 2; ++i_) glds16s(bb_, bo[(h) * 2 + i_], (unsigned)__builtin_amdgcn_readfirstlane(lds0 + SB_(b, h) + (wid + 8 * i_) * 1024)); } while (0)
#define LDSP(T, a_) ((LAS const T*)(uintptr_t)(a_))
#define LDA(dst, b, h) do { _Pragma("unroll") for (int m_ = 0; m_ < 4; ++m_) { dst[m_][0] = *LDSP(bf16x8, ard0[b] + SA_(0, h) + m_ * 2048); dst[m_][1] = *LDSP(bf16x8, ard1[b] + SA_(0, h) + m_ * 2048); } } while (0)
#define LDB(dst, b, h) do { _Pragma("unroll") for (int n_ = 0; n_ < 2; ++n_) _Pragma("unroll") for (int k_ = 0; k_ < 2; ++k_) { const unsigned p_ = (n_ ? brd1[b] : brd0[b]) + SB_(0, h) + k_ * 8192; \
        const s16x4 lo_ = tr_read_l(p_), hi_ = tr_read_l(p_ + 1024); dst[n_][k_] = (bf16x8){lo_[0], lo_[1], lo_[2], lo_[3], hi_[0], hi_[1], hi_[2], hi_[3]}; } } while (0)
#define MMA(ai, bj, Bx) do { __builtin_amdgcn_s_setprio(1); \
        _Pragma("unroll") for (int k_ = 0; k_ < 2; ++k_) _Pragma("unroll") for (int m_ = 0; m_ < 4; ++m_) _Pragma("unroll") for (int n_ = 0; n_ < 2; ++n_) \
            acc[(ai) * 4 + m_][(bj) * 2 + n_] = __builtin_amdgcn_mfma_f32_16x16x32_bf16(Bx[n_][k_], At[m_][k_], acc[(ai) * 4 + m_][(bj) * 2 + n_], 0, 0, 0); \
        __builtin_amdgcn_s_setprio(0); } while (0)
    bf16x8 At[4][2], B0[2][2], B1[2][2];
    if (!pre) { ST_B(0, 0, 0); ST_A(0, 0, 0); ST_B(0, 1, 0); ST_A(0, 1, 0); }
    if (wr == 1) BAR();
    if (!pre) WAIT_V(4);
    BAR();
    ST_B(1, 0, 1); ST_A(1, 0, 1); ST_B(1, 1, 1);
    if (!pre) WAIT_V(6);
    BAR();
    for (int t = 0; t < nkt - 2; t += 2) {
        LDB(B0, 0, 0); SCHED(); LDA(At, 0, 0); ST_A(1, 1, t + 1);
        WAIT_L(8); BAR(); WAIT_L(0); MMA(0, 0, B0); BAR(); SCHED();
        LDB(B1, 0, 1); ST_B(0, 0, t + 2);
        BAR(); WAIT_L(0); MMA(0, 1, B1); BAR();
        LDA(At, 0, 1); ST_A(0, 0, t + 2);
        BAR(); WAIT_L(0); MMA(1, 0, B0); BAR(); SCHED();
        ST_B(0, 1, t + 2);
        WAIT_V(6); BAR(); MMA(1, 1, B1); BAR();
        LDB(B0, 1, 0); SCHED(); LDA(At, 1, 0); ST_A(0, 1, t + 2);
        WAIT_L(8); BAR(); WAIT_L(0); MMA(0, 0, B0); BAR(); SCHED();
        LDB(B1, 1, 1); ST_B(1, 0, t + 3);
        BAR(); WAIT_L(0); MMA(0, 1, B1); BAR();
        LDA(At, 1, 1); ST_A(1, 0, t + 3);
        BAR(); WAIT_L(0); MMA(1, 0, B0); BAR(); SCHED();
        ST_B(1, 1, t + 3);
        WAIT_V(6); BAR(); MMA(1, 1, B1); BAR();
    }
    const bool hn = next.has();
    LDB(B0, 0, 0); LDA(At, 0, 0); ST_A(1, 1, nkt - 1);
    BAR(); WAIT_L(0); MMA(0, 0, B0); BAR();
    LDB(B1, 0, 1); BAR(); WAIT_L(0); MMA(0, 1, B1); BAR();
    LDA(At, 0, 1);
    if (hn) { next.template issue<3>(); WAIT_V(8); } else WAIT_V(4);
    BAR(); WAIT_L(0); MMA(1, 0, B0); MMA(1, 1, B1); BAR();
    LDB(B0, 1, 0); LDA(At, 1, 0);
    if (hn) { next.template issue<4>(); WAIT_V(8); } else WAIT_V(2);
    BAR(); WAIT_L(0); MMA(0, 0, B0); BAR();
    LDB(B1, 1, 1);
    if (hn) { next.template issue<8>(); WAIT_V(8); } else WAIT_V(0);
    BAR(); WAIT_L(0); MMA(0, 1, B1); BAR();
    LDA(At, 1, 1); BAR(); WAIT_L(0); MMA(1, 0, B0); MMA(1, 1, B1);
    WAIT_V(0);
    BAR();
    if (wr == 0) BAR();
#undef ST_A
#undef ST_B
#undef LDA
#undef LDB
#undef LDSP
#undef MMA
}

DEV uint4 pair16(uint2 a, uint2 b) {
    const auto r0 = __builtin_amdgcn_permlane16_swap(a.x, b.x, false, false); const auto r1 = __builtin_amdgcn_permlane16_swap(a.y, b.y, false, false);
    uint4 o; o.x = r0[0]; o.y = r1[0]; o.z = r0[1]; o.w = r1[1]; return o;
}
DEV void unpair16(uint4 q, uint2& a, uint2& b) {
    const auto r0 = __builtin_amdgcn_permlane16_swap(q.x, q.z, false, false); const auto r1 = __builtin_amdgcn_permlane16_swap(q.y, q.w, false, false);
    a.x = r0[0]; a.y = r1[0]; b.x = r0[1]; b.y = r1[1];
}
#define PAIR16_COL(c0, c1) ((((lane) >> 4) & 1) ? (c1) - 4 : (c0))
#define EPI_IDS() do { const int etid_ = TID(); lane = etid_ & 63; wid = etid_ >> 6; wr = wid >> 2; wc = wid & 3; } while (0)

DEV void patch_decode(int local, int MT, int NT, int& mt, int& nt) {
    const int per_mtb = 8 * NT; const int mtb = local / per_mtb; const int rem = local - mtb * per_mtb;
    const int rows = (MT - 8 * mtb) < 8 ? (MT - 8 * mtb) : 8;
    const int per_ntb = rows * 8; const int nfull = NT >> 3; int ntb = rem / per_ntb; int cols = 8;
    if (ntb >= nfull) { ntb = nfull; cols = NT - 8 * nfull; }
    const int r2 = rem - ntb * per_ntb;
    mt = 8 * mtb + r2 / cols; nt = 8 * ntb + r2 % cols;
}

DEV void convert_chunk(const float* src, bf16_t* dst, size_t i8) {
    const float4 a = *(const float4*)(src + i8 * 8), b = *(const float4*)(src + i8 * 8 + 4);
    uint4 o; o.x = cvtpk(a.x, a.y); o.y = cvtpk(a.z, a.w); o.z = cvtpk(b.x, b.y); o.w = cvtpk(b.z, b.w);
    *(uint4*)(dst + i8 * 8) = o;
}
DEV void phase_prologue(const Args& a, unsigned char* smem) {
    unsigned char* ws = a.ws;
    const size_t gtid = (size_t)BID() * NTHR + TID(), gn = (size_t)gridDim.x * NTHR;
    {
        { const float* W = a.in[I_WOUT]; bf16_t* O = (bf16_t*)(ws + WS_WOUT); const float* gnn = a.in[I_GNN]; const float* gnf = a.in[I_GNF];
          for (size_t i = gtid; i < (size_t)1024 * 128; i += gn) { const int k = (int)(i >> 7); const float g_ = k < 512 ? gnn[k] : gnf[k - 512];
              const float4 x = *(const float4*)(W + i * 8), y = *(const float4*)(W + i * 8 + 4);
              uint4 o; o.x = cvtpk(x.x * g_, x.y * g_); o.y = cvtpk(x.z * g_, x.w * g_); o.z = cvtpk(y.x * g_, y.y * g_); o.w = cvtpk(y.z * g_, y.w * g_); *(uint4*)(O + i * 8) = o; } }
        const float* srcs[3] = {a.in[I_WGATE], a.in[I_WPLE], a.in[I_P]};
        bf16_t* dsts[3] = {(bf16_t*)(ws + WS_WGATE), (bf16_t*)(ws + WS_WPLE), (bf16_t*)(ws + WS_PB)};
        const size_t cnt8[3] = {1024 * 1024 / 8, 256 * 1024 / 8, (size_t)NTOK * 256 / 8};
#pragma unroll
        for (int s = 1; s < 3; ++s) for (size_t i = gtid; i < cnt8[s]; i += gn) convert_chunk(srcs[s], dsts[s], i);
        { const float* W = srcs[0]; bf16_t* O = dsts[0]; const float* lp = a.in[I_LNPLE];
          for (size_t i = gtid; i < cnt8[0]; i += gn) { const float g_ = lp[i >> 7];
              const float4 x = *(const float4*)(W + i * 8), y = *(const float4*)(W + i * 8 + 4);
              uint4 o; o.x = cvtpk(x.x * g_, x.y * g_); o.y = cvtpk(x.z * g_, x.w * g_); o.z = cvtpk(y.x * g_, y.y * g_); o.w = cvtpk(y.z * g_, y.w * g_); *(uint4*)(O + i * 8) = o; } }
        for (size_t i = gtid; i < (size_t)2 * 2048 * 32; i += gn) { const int which = (int)(i / (2048 * 32)); const int k = (int)(i / 32) % 2048, c8 = (int)(i % 32) * 8;
            uint4 o = {0u, 0u, 0u, 0u};
            if (c8 < 128) { const float* W = a.in[which ? I_WC1V : I_WC1K] + (size_t)k * 128 + c8; const float4 x = *(const float4*)W, y = *(const float4*)(W + 4); o.x = cvtpk(x.x, x.y); o.y = cvtpk(x.z, x.w); o.z = cvtpk(y.x, y.y); o.w = cvtpk(y.z, y.w); }
            *(uint4*)((bf16_t*)(ws + WS_WC1) + i * 8) = o; }
        for (size_t i = gtid; i < (size_t)2 * 128 * 32; i += gn) { const int which = (int)(i / (128 * 32)); const int k = (int)(i / 32) % 128, c8 = (int)(i % 32) * 8;
            uint4 o = {0u, 0u, 0u, 0u};
            if (c8 < 64) { const float* W = a.in[which ? I_WC2V : I_WC2K] + (size_t)k * 64 + c8; const float4 x = *(const float4*)W, y = *(const float4*)(W + 4); o.x = cvtpk(x.x, x.y); o.y = cvtpk(x.z, x.w); o.z = cvtpk(y.x, y.y); o.w = cvtpk(y.z, y.w); }
            *(uint4*)((bf16_t*)(ws + WS_WC2) + i * 8) = o; }
    }
    {
        const float* W = a.in[I_WIN]; bf16_t* O = (bf16_t*)(ws + WS_WIN);
        for (size_t i = gtid; i < (size_t)1024 * (NWIN / 8); i += gn) {
            const int k = (int)(i / (NWIN / 8)), j = (int)(i % (NWIN / 8)) * 8;
            uint4 o = {0u, 0u, 0u, 0u};
            if (j < 2848) {
                const int sj = (j < 1280) ? j : (j < 2816) ? j + 24 : (j < 2840) ? j - 1536 : j; const float g_ = a.in[I_LN1][k];
                const float4 x = *(const float4*)(W + (size_t)k * 2848 + sj), y = *(const float4*)(W + (size_t)k * 2848 + sj + 4);
                o.x = cvtpk(x.x * g_, x.y * g_); o.y = cvtpk(x.z * g_, x.w * g_); o.z = cvtpk(y.x * g_, y.y * g_); o.w = cvtpk(y.z * g_, y.w * g_);
            }
            *(uint4*)(O + (size_t)k * NWIN + j) = o;
        }
    }
    const int lane = TID() & 63; const int gw = BID() * NWAVE + (TID() >> 6), ngw = gridDim.x * NWAVE;
    {
        const float* X = a.in[I_X]; bf16_t* XN = (bf16_t*)(ws + WS_XN); float* RSTD1 = (float*)(ws + WS_RSTD1);
        for (int m = gw; m < NTOK; m += ngw) {
            float4 v[4]; float s = 0.f;
#pragma unroll
            for (int j = 0; j < 4; ++j) { v[j] = *(const float4*)(X + (size_t)m * 1024 + j * 256 + lane * 4); s += v[j].x * v[j].x + v[j].y * v[j].y + v[j].z * v[j].z + v[j].w * v[j].w; }
#pragma unroll
            for (int j = 0; j < 4; ++j) { uint2 o; o.x = cvtpk(v[j].x, v[j].y); o.y = cvtpk(v[j].z, v[j].w); *(uint2*)(XN + (size_t)m * 1024 + j * 256 + lane * 4) = o; }
            const float rstd = rsqrtf(wave_sum(s) * (1.f / 1024.f) + EPS);
            if (lane == 0) RSTD1[m] = rstd;
        }
    }
    if (gtid == 0) *(float*)(ws + WS_ONE) = 1.0f;
    if (gw < 256) {
        const int which = gw >> 7, n = gw & 127; const float* pe = a.in[which ? I_PEV : I_PEK]; const float* w1 = a.in[which ? I_WC1V : I_WC1K];
        float s = 0.f;
#pragma unroll 8
        for (int i = 0; i < 32; ++i) { const int k = lane + 64 * i; s += pe[k] * w1[(size_t)k * 128 + n]; }
        s = wave_sum(s);
        if (lane == 0) ((float*)(ws + WS_BIAS1))[which * 128 + n] = s;
    }
}

DEV void phase_inproj(const Args& a, unsigned char* smem) {
    const bf16_t* XN = (const bf16_t*)(a.ws + WS_XN); const bf16_t* W = (const bf16_t*)(a.ws + WS_WIN);
    bf16_t* PROJ = (bf16_t*)(a.ws + WS_PROJ); float* GN = (float*)(a.ws + WS_GN); float* LS = (float*)(a.ws + WS_LS); const float* bfg = a.in[I_BFG];
    int lane = TID() & 63, wid = TID() >> 6, wr = wid >> 2, wc = wid & 3; (void)wr; (void)wc; (void)lane;
    bool pre = false;
    for (int item = VBID(); item < 64 * 12; item += gridDim.x) {
        int mt, nt; patch_decode(item, 64, 12, mt, nt);
        const int nitem = item + (int)gridDim.x; const bool has_next = nitem < 64 * 12; int mtn = 0, ntn = 0; if (has_next) patch_decode(nitem, 64, 12, mtn, ntn);
        f32x4 acc[8][4];
        auto aoffi = [](int r, int kc) { return (unsigned)(r * 2048 + kc * 16); }; auto boffi = [](int k, int nc) { return (unsigned)(k * (NWIN * 2) + nc * 16); };
        gemm256<true>(smem, 16, XN + (size_t)mt * 256 * 1024, 128u, aoffi, W + nt * 256, (unsigned)(64 * NWIN * 2), boffi, acc, pre,
                      next_tile(has_next, smem, XN + (size_t)mtn * 256 * 1024, aoffi, W + ntn * 256, boffi));
        pre = has_next;
        EPI_IDS();
        float r1[8];
#pragma unroll
        for (int mi = 0; mi < 8; ++mi) r1[mi] = ((const float*)(a.ws + WS_RSTD1))[mt * 256 + G_ROW(mi)];
#pragma unroll
        for (int mi = 0; mi < 8; ++mi) {
            const int gm = mt * 256 + G_ROW(mi); const int b = gm >> 13, t = gm & 8191;
            if (nt < 11) {
#pragma unroll
                for (int np = 0; np < 2; ++np) { const int n0 = G_COL(2 * np); const int hs = nt * 4 + (n0 >> 6), d0 = n0 & 63; const float sc = ((hs < 8 || (hs >= 20 && hs < 28)) ? QS : 1.0f) * r1[mi];
                    const f32x4 v0 = acc[mi][2 * np], v1 = acc[mi][2 * np + 1]; uint2 oa, ob; oa.x = cvtpk(v0[0] * sc, v0[1] * sc); oa.y = cvtpk(v0[2] * sc, v0[3] * sc); ob.x = cvtpk(v1[0] * sc, v1[1] * sc); ob.y = cvtpk(v1[2] * sc, v1[3] * sc);
                    *(uint4*)(PROJ + (((size_t)(hs * 2 + b)) * 8192 + t) * 64 + PAIR16_COL(d0, d0 + 16)) = pair16(oa, ob); }
            }
#pragma unroll
            for (int ni = 0; ni < 4; ++ni) {
                const int n = G_COL(ni); const f32x4 v = acc[mi][ni];
                if (nt < 11) {
                } else if (n < 24) {
#pragma unroll
                    for (int r = 0; r < 4; ++r) GN[(size_t)gm * 24 + n + r] = sigmoidf_(v[r] * r1[mi]);
                } else if (n < 32) {
#pragma unroll
                    for (int r = 0; r < 4; ++r) { const int h = n - 24 + r; LS[((size_t)(b * 8 + h)) * 8192 + t] = logsigmoidf_(v[r] * r1[mi] + bfg[h]); }
                }
            }
        }
    }
}

DEV void signal_done(unsigned* flag) {
    asm volatile("s_waitcnt vmcnt(0)" ::: "memory");
    __syncthreads();
    if (TID() == 0) { __builtin_amdgcn_fence(__ATOMIC_RELEASE, "agent"); asm volatile("s_waitcnt vmcnt(0)" ::: "memory"); __hip_atomic_fetch_add(flag, 1u, __ATOMIC_RELAXED, __HIP_MEMORY_SCOPE_AGENT); }
}
DEV void wait_flag(unsigned* flag, unsigned target) {
    if (TID() == 0) { unsigned sp = 0u; while (__hip_atomic_load(flag, __ATOMIC_RELAXED, __HIP_MEMORY_SCOPE_AGENT) < target) { __builtin_amdgcn_s_sleep(4); if (++sp > (1u << 24)) break; }
        __builtin_amdgcn_fence(__ATOMIC_ACQUIRE, "agent"); asm volatile("s_waitcnt vmcnt(0)" ::: "memory"); }
    __syncthreads();
}
constexpr int CW_CUMFLAG = 128, CW_CMPFLAG = 192, CW_GATEFLAG = 256, CW_UPR2 = 384;
DEV void cmp_item(const Args& a, unsigned char* smem, int item) {
    const bf16_t* PROJ = (const bf16_t*)(a.ws + WS_PROJ);
    const int tid = TID(); int lane = tid & 63, wid = tid >> 6, wr = wid >> 2, wc = wid & 3; (void)wr; (void)wc; (void)lane;
    {
        if (item < 16) {
            const int which = item >> 3, b = (item >> 2) & 1, g = (item >> 1) & 1, mt = item & 1;
            const bf16_t* base = PROJ + ((size_t)((8 + 2 * which + g) * 2 + b)) * 8192 * 64;
            const bf16_t* W1 = (const bf16_t*)(a.ws + WS_WC1) + (size_t)which * 2048 * 256;
            const bf16_t* W2 = (const bf16_t*)(a.ws + WS_WC2) + (size_t)which * 128 * 256;
            const float* bias1 = (const float*)(a.ws + WS_BIAS1) + which * 128;
            bf16_t* HID = (bf16_t*)(a.ws + WS_HID) + ((size_t)(which * 4 + b * 2 + g)) * 512 * 128;
            bf16_t* OUT = (bf16_t*)(a.ws + WS_KC) + ((size_t)(which * 4 + b * 2 + g)) * 512 * 64;
            f32x4 acc[8][4];
            gemm256s<true>(smem, 32, base, 128u, [&](int r, int kc) { int c = mt * 256 + r; c = c > 510 ? 510 : c; return (unsigned)(c * 2048 + kc * 16); },
                          W1, 64u * 512u, [&](int k, int nc) { return (unsigned)(k * 512 + nc * 16); }, acc);
        EPI_IDS();
            if (wc < 2) {
                float4 bb4[4];
#pragma unroll
                for (int ni = 0; ni < 4; ++ni) bb4[ni] = *(const float4*)(bias1 + wc * 64 + ni * 16 + 4 * (lane >> 4));
#pragma unroll
                for (int mi = 0; mi < 8; ++mi) { const int c = mt * 256 + wr * 128 + mi * 16 + (lane & 15);
#pragma unroll
                    for (int ni = 0; ni < 4; ++ni) { const int n = wc * 64 + ni * 16 + 4 * (lane >> 4); const f32x4 v = acc[mi][ni]; const float4 bb = bb4[ni];
                        uint2 o; o.x = cvtpk(gelu_tanh(v[0] + bb.x), gelu_tanh(v[1] + bb.y)); o.y = cvtpk(gelu_tanh(v[2] + bb.z), gelu_tanh(v[3] + bb.w));
                        *(uint2*)(HID + (size_t)c * 128 + n) = o; } }
            }
            __syncthreads();
            gemm256s<true>(smem, 2, HID + (size_t)mt * 256 * 128, 128u, [&](int r, int kc) { return (unsigned)(r * 256 + kc * 16); },
                          W2, 64u * 512u, [&](int k, int nc) { return (unsigned)(k * 512 + nc * 16); }, acc);
        EPI_IDS();
            if (wc == 0) {
#pragma unroll
                for (int mi = 0; mi < 8; ++mi) { const int c = mt * 256 + wr * 128 + mi * 16 + (lane & 15);
#pragma unroll
                    for (int ni = 0; ni < 4; ++ni) { const int n = ni * 16 + 4 * (lane >> 4); const f32x4 v = acc[mi][ni];
                        uint2 o; o.x = cvtpk(v[0], v[1]); o.y = cvtpk(v[2], v[3]);
                        if (c >= 511) { o.x = 0u; o.y = 0u; }
                        *(uint2*)(OUT + (size_t)c * 64 + n) = o; } }
            }
            signal_done((unsigned*)(a.ws + WS_CTL) + CW_CMPFLAG);
        } else {
            const int bh = item - 16; const float* LS = (const float*)(a.ws + WS_LS) + (size_t)bh * 8192; float* CUM = (float*)(a.ws + WS_CUM) + (size_t)bh * 8192;
            float* sc = (float*)smem;
            float v[16]; float s = 0.f;
#pragma unroll
            for (int j = 0; j < 4; ++j) { const float4 x = *(const float4*)(LS + tid * 16 + j * 4); v[4 * j] = x.x; v[4 * j + 1] = x.y; v[4 * j + 2] = x.z; v[4 * j + 3] = x.w; }
#pragma unroll
            for (int j = 0; j < 16; ++j) { s += v[j]; v[j] = s; }
            sc[tid] = s; __syncthreads();
            if (tid == 0) { float run = 0.f; for (int i = 0; i < NTHR; ++i) { const float x = sc[i]; sc[i] = run; run += x; } }
            __syncthreads();
            const float off = sc[tid];
#pragma unroll
            for (int j = 0; j < 4; ++j) { float4 o = {v[4 * j] + off, v[4 * j + 1] + off, v[4 * j + 2] + off, v[4 * j + 3] + off}; *(float4*)(CUM + tid * 16 + j * 4) = o; }
            signal_done((unsigned*)(a.ws + WS_CTL) + CW_CUMFLAG + bh);
        }
    }
}

constexpr int AT_STAGE = 16384;
constexpr int AT_BIAS_OFF = 3 * AT_STAGE;
constexpr int AT_IMP_OFF = AT_BIAS_OFF + 1024;
constexpr int AT_SEL_OFF = AT_IMP_OFF + 65536;
constexpr int AT_WUN_OFF = AT_SEL_OFF + 1024;
constexpr int AT_UCNT_OFF = AT_WUN_OFF + 128;
constexpr int AT_ULIST_OFF = AT_UCNT_OFF + 16;
constexpr int AT_ITEM_OFF = AT_ULIST_OFF + 128;
static_assert(AT_ITEM_OFF + 16 <= GEMM_LDS, "attention LDS map");
#define NEG_INF (-__builtin_inff())

#define KV_DECL uint4 rk0_, rv0_
#define KV_GLOAD(Kt, Vt) do { rk0_ = *(const uint4*)((Kt) + tid * 8); rv0_ = *(const uint4*)((Vt) + tid * 8); } while (0)
#define KV_LSTORE(stp) do { unsigned char* st_ = (stp); const int key = tid >> 3, ch = tid & 7; \
      *(uint4*)(st_ + key * 128 + ((ch ^ (key & 7)) << 4)) = rk0_; \
      *(uint4*)(st_ + 8192 + key * 128 + ((((ch >> 2) ^ ((key >> 1) & 1))) << 6) + ((ch & 3) << 4)) = rv0_; } while (0)
template <bool FULL>
DEV void qk_tile(const unsigned char* Kst, const bf16x8 (&qf)[4], f32x16& p0, f32x16& p1, int lane) {
    const int key = lane & 31, hi = lane >> 5;
    if (FULL) {
        bf16x8 k0[4], k1[4];
#pragma unroll
        for (int ks = 0; ks < 4; ++ks) { const int ch = 2 * ks + hi; const int off = key * 128 + ((ch ^ (key & 7)) << 4);
            k0[ks] = *(const bf16x8*)(Kst + off); k1[ks] = *(const bf16x8*)(Kst + off + 32 * 128); }
        __builtin_amdgcn_sched_barrier(0);
#pragma unroll
        for (int ks = 0; ks < 4; ++ks) {
            p0 = __builtin_amdgcn_mfma_f32_32x32x16_bf16(k0[ks], qf[ks], p0, 0, 0, 0);
            p1 = __builtin_amdgcn_mfma_f32_32x32x16_bf16(k1[ks], qf[ks], p1, 0, 0, 0); }
    } else {
        bf16x8 kk[4];
#pragma unroll
        for (int ks = 0; ks < 4; ++ks) { const int ch = 2 * ks + hi; kk[ks] = *(const bf16x8*)(Kst + key * 128 + ((ch ^ (key & 7)) << 4)); }
        __builtin_amdgcn_sched_barrier(0);
#pragma unroll
        for (int ks = 0; ks < 4; ++ks) p0 = __builtin_amdgcn_mfma_f32_32x32x16_bf16(kk[ks], qf[ks], p0, 0, 0, 0);
        __builtin_amdgcn_sched_barrier(0);
#pragma unroll
        for (int ks = 0; ks < 4; ++ks) { const int ch = 2 * ks + hi; kk[ks] = *(const bf16x8*)(Kst + key * 128 + ((ch ^ (key & 7)) << 4) + 32 * 128); }
        __builtin_amdgcn_sched_barrier(0);
#pragma unroll
        for (int ks = 0; ks < 4; ++ks) p1 = __builtin_amdgcn_mfma_f32_32x32x16_bf16(kk[ks], qf[ks], p1, 0, 0, 0);
    }
}
template <bool FULL>
DEV void pv_tile(const unsigned char* Vst, const f32x16& p0, const f32x16& p1, f32x16 (&o)[2], int lane) {
    const int hi = lane >> 5, i = lane & 15, gg = (lane >> 4) & 1;
    const int q = i >> 2; const int sw = (q >> 1) & 1;
    bf16x8 pa[4];
#pragma unroll
    for (int s = 0; s < 4; ++s) { const f32x16& p = (s < 2) ? p0 : p1; const int b = (s & 1) * 8;
        unsigned w[4];
#pragma unroll
        for (int j = 0; j < 4; ++j) w[j] = cvtpk(p[b + 2 * j], p[b + 2 * j + 1]);
        typedef unsigned u32x4_t __attribute__((ext_vector_type(4)));
        u32x4_t ww = {w[0], w[1], w[2], w[3]}; pa[s] = __builtin_bit_cast(bf16x8, ww); }
    constexpr int NB = FULL ? 1 : 2, SB = FULL ? 4 : 2;
#pragma unroll
    for (int bt = 0; bt < NB; ++bt) {
        s16x4 vlo[SB][2], vhi[SB][2];
#pragma unroll
        for (int s_ = 0; s_ < SB; ++s_)
#pragma unroll
            for (int dh = 0; dh < 2; ++dh) { const int s = bt * SB + s_; const int row0 = 16 * s + 4 * hi + q;
                const unsigned char* p = Vst + row0 * 128 + ((dh ^ sw) << 6) + gg * 32 + (i & 3) * 8;
                vlo[s_][dh] = tr_read(p); vhi[s_][dh] = tr_read(p + 8 * 128); }
        __builtin_amdgcn_sched_barrier(0);
#pragma unroll
        for (int s_ = 0; s_ < SB; ++s_)
#pragma unroll
            for (int dh = 0; dh < 2; ++dh) { const int s = bt * SB + s_;
                const bf16x8 vf = {vlo[s_][dh][0], vlo[s_][dh][1], vlo[s_][dh][2], vlo[s_][dh][3], vhi[s_][dh][0], vhi[s_][dh][1], vhi[s_][dh][2], vhi[s_][dh][3]};
                o[dh] = __builtin_amdgcn_mfma_f32_32x32x16_bf16(vf, pa[s], o[dh], 0, 0, 0); }
        __builtin_amdgcn_sched_barrier(0);
    }
}
DEV float rowmax32(const f32x16& p0, const f32x16& p1) {
    float a = fmaxf(p0[0], p1[0]), b = fmaxf(p0[1], p1[1]);
#pragma unroll
    for (int r = 2; r < 16; r += 2) { a = fmaxf(fmaxf(a, p0[r]), p1[r]); b = fmaxf(fmaxf(b, p0[r + 1]), p1[r + 1]); }
    return pair_max(fmaxf(a, b));
}
DEV void softmax_step(f32x16& p0, f32x16& p1, float& m, float& l, f32x16 (&o)[2]) {
    const float mt = rowmax32(p0, p1); const float mn = fmaxf(m, mt); const float alpha = __builtin_amdgcn_exp2f(m - mn);
    float rs = 0.f;
#pragma unroll
    for (int r = 0; r < 16; ++r) { p0[r] = __builtin_amdgcn_exp2f(p0[r] - mn); p1[r] = __builtin_amdgcn_exp2f(p1[r] - mn); rs += p0[r] + p1[r]; }
    rs = pair_sum(rs);
    l = l * alpha + rs; m = mn;
    if (__any(alpha != 1.0f)) { o[0] *= alpha; o[1] *= alpha; }
}
DEV void softmax_step_nosum(f32x16& p0, f32x16& p1, float& m, f32x16 (&o)[2], f32x16& lacc) {
    const float mt = rowmax32(p0, p1); const float mn = fmaxf(m, mt); const float alpha = __builtin_amdgcn_exp2f(m - mn);
#pragma unroll
    for (int r = 0; r < 16; ++r) { p0[r] = __builtin_amdgcn_exp2f(p0[r] - mn); p1[r] = __builtin_amdgcn_exp2f(p1[r] - mn); }
    m = mn;
    if (__any(alpha != 1.0f)) { o[0] *= alpha; o[1] *= alpha; lacc *= alpha; }
}
DEV void pv_tile_sum(const unsigned char* Vst, const f32x16& p0, const f32x16& p1, f32x16 (&o)[2], f32x16& lacc, int lane) {
    const int hi = lane >> 5, i = lane & 15, gg = (lane >> 4) & 1;
    const int q = i >> 2; const int sw = (q >> 1) & 1;
    bf16x8 pa[4];
#pragma unroll
    for (int s = 0; s < 4; ++s) { const f32x16& p = (s < 2) ? p0 : p1; const int b = (s & 1) * 8;
        unsigned w[4];
#pragma unroll
        for (int j = 0; j < 4; ++j) w[j] = cvtpk(p[b + 2 * j], p[b + 2 * j + 1]);
        typedef unsigned u32x4_t __attribute__((ext_vector_type(4)));
        u32x4_t ww = {w[0], w[1], w[2], w[3]}; pa[s] = __builtin_bit_cast(bf16x8, ww); }
    const bf16x8 ones = {0x3f80, 0x3f80, 0x3f80, 0x3f80, 0x3f80, 0x3f80, 0x3f80, 0x3f80};
#pragma unroll
    for (int bt = 0; bt < 2; ++bt) {
        s16x4 vlo[2][2], vhi[2][2];
#pragma unroll
        for (int s_ = 0; s_ < 2; ++s_)
#pragma unroll
            for (int dh = 0; dh < 2; ++dh) { const int s = bt * 2 + s_; const int row0 = 16 * s + 4 * hi + q;
                const unsigned char* p = Vst + row0 * 128 + ((dh ^ sw) << 6) + gg * 32 + (i & 3) * 8;
                vlo[s_][dh] = tr_read(p); vhi[s_][dh] = tr_read(p + 8 * 128); }
        __builtin_amdgcn_sched_barrier(0);
#pragma unroll
        for (int s_ = 0; s_ < 2; ++s_) { const int s = bt * 2 + s_;
            lacc = __builtin_amdgcn_mfma_f32_32x32x16_bf16(ones, pa[s], lacc, 0, 0, 0);
#pragma unroll
            for (int dh = 0; dh < 2; ++dh) {
                const bf16x8 vf = {vlo[s_][dh][0], vlo[s_][dh][1], vlo[s_][dh][2], vlo[s_][dh][3], vhi[s_][dh][0], vhi[s_][dh][1], vhi[s_][dh][2], vhi[s_][dh][3]};
                o[dh] = __builtin_amdgcn_mfma_f32_32x32x16_bf16(vf, pa[s], o[dh], 0, 0, 0); } }
        __builtin_amdgcn_sched_barrier(0);
    }
}
template <int STRIDE> DEV void mask_tile(f32x16& p0, f32x16& p1, int kpos0, int lo, int hi_lim, int hi) {
#pragma unroll
    for (int r = 0; r < 16; ++r) { const int kp = kpos0 + STRIDE * crow(r, hi);
        if (kp < lo || kp > hi_lim) p0[r] = NEG_INF;
        const int kp1 = kp + 32 * STRIDE; if (kp1 < lo || kp1 > hi_lim) p1[r] = NEG_INF; }
}
template <int STRIDE> DEV void alibi_init(f32x16& p0, f32x16& p1, float slope2, int kpos0, int tref, int hi) {
    const float base = slope2 * (float)(kpos0 - tref + STRIDE * 4 * hi);
#pragma unroll
    for (int r = 0; r < 16; ++r) { const float c = (float)(STRIDE * ((r & 3) + 8 * (r >> 2))); p0[r] = fmaf(slope2, c, base); p1[r] = fmaf(slope2, c + (float)(32 * STRIDE), base); }
}
template <class Src, class Body, class NSrc>
DEV int kv_pipeline(unsigned char* smem, int n, const Src& src, const Body& body, int par, bool pre, bool has_next, const NSrc& nsrc) {
    KV_DECL; const int tid = TID(); const bf16_t *kp, *vp;
    if (!pre) { src(0, kp, vp); KV_GLOAD(kp, vp); KV_LSTORE(smem + par * AT_STAGE); __syncthreads(); }
    for (int j = 0; j < n; ++j) {
        const bool more = j + 1 < n;
        src(more ? j + 1 : j, kp, vp); if (!more && has_next) nsrc(kp, vp);
        KV_GLOAD(kp, vp);
        body(j, smem + ((par + j) & 1) * AT_STAGE);
        KV_LSTORE(smem + ((par + j + 1) & 1) * AT_STAGE);
        __syncthreads();
    }
    return (par + n) & 1;
}
struct NoSrc { DEV void operator()(const bf16_t*&, const bf16_t*&) const {} };

constexpr int CV_PER_STEP = 373; constexpr int CV_NUP = 32 * 1024 * 2048 / 8, CV_NDN = 32 * 1024 * 1024 / 8;
static_assert((long long)33792 * CV_PER_STEP >= (long long)CV_NUP + CV_NDN, "conversion coverage");
DEV void fox_item(const Args& a, unsigned char* smem, int fi, int b, int h, int qb) {
    const int tid = TID(), lane = tid & 63, wid = tid >> 6, r32 = lane & 31, hi = lane >> 5;
    const bf16_t* PROJ = (const bf16_t*)(a.ws + WS_PROJ);
    const bf16_t* Q = PROJ + ((size_t)((20 + h) * 2 + b)) * 8192 * 64; const bf16_t* K = PROJ + ((size_t)((28 + h) * 2 + b)) * 8192 * 64; const bf16_t* V = PROJ + ((size_t)((36 + h) * 2 + b)) * 8192 * 64;
    const float* CUM = (const float*)(a.ws + WS_CUM) + (size_t)(b * 8 + h) * 8192;
    const int q0 = qb * 256; const int qrow = q0 + 32 * wid + r32;
    bf16x8 qf[4];
#pragma unroll
    for (int ks = 0; ks < 4; ++ks) qf[ks] = *(const bf16x8*)(Q + (size_t)qrow * 64 + 16 * ks + 8 * hi);
    const float cref = CUM[q0];
    const int ntiles = 4 * qb + 4; const int jmax_w = (q0 + 32 * wid + 31) >> 6; const int jmask_w = (q0 + 32 * wid) >> 6;
    f32x16 o[2]; o[0] = (f32x16){}; o[1] = (f32x16){}; f32x16 lacc = (f32x16){}; float m = -1e30f;
    float* biasL = (float*)(smem + AT_BIAS_OFF);
    const int gq_ = fi >> 4; const int sidx0 = 16 * (128 * gq_ - 2 * gq_ * (gq_ - 1)) + (fi & 15) * (128 - 4 * gq_);
    bf16_t* cvdA = nullptr; bf16_t* cvdB = nullptr; float4 cvaA, cvbA, cvaB, cvbB; float cvsA = 1.f, cvsB = 1.f;
    KV_DECL; float breg = 0.f;
#define TJ(s_) (ntiles - 1 - (s_))
#define CV_ADDR(st_, SRC, DST, SCP) do { int c_ = (sidx0 + (st_)) * CV_PER_STEP + (tid < CV_PER_STEP ? tid : CV_PER_STEP - 1); c_ = c_ < CV_NUP + CV_NDN ? c_ : CV_NUP + CV_NDN - 1; \
        const bool up_ = c_ < CV_NUP; const int cc_ = up_ ? c_ : c_ - CV_NUP; SRC = (up_ ? a.in[I_WUP] : a.in[I_WDN]) + (size_t)cc_ * 8; DST = (bf16_t*)(a.ws + (up_ ? WS_WUP : WS_WDN)) + (size_t)cc_ * 8; \
        SCP = up_ ? a.in[I_LN2] + ((cc_ >> 8) & 1023) : (const float*)(a.ws + WS_ONE); } while (0)
    { const float* cvs_; const float* scp_; CV_ADDR(0, cvs_, cvdB, scp_); cvaB = *(const float4*)cvs_; cvbB = *(const float4*)(cvs_ + 4); cvsB = *scp_; }
    KV_GLOAD(K + (size_t)TJ(0) * 4096, V + (size_t)TJ(0) * 4096); breg = CUM[TJ(0) * 64 + lane];
    KV_LSTORE(smem); biasL[lane] = (cref - breg) * LOG2E;
    KV_GLOAD(K + (size_t)TJ(1) * 4096, V + (size_t)TJ(1) * 4096); breg = CUM[TJ(1) * 64 + lane];
    KV_LSTORE(smem + AT_STAGE); biasL[64 + lane] = (cref - breg) * LOG2E;
    __syncthreads();
#define FOX_QK(P0, P1, jj, sj) do { const float* bl_ = biasL + (sj) * 64; \
        _Pragma("unroll") for (int g4 = 0; g4 < 4; ++g4) { const float4 x_ = *(const float4*)(bl_ + 8 * g4 + 4 * hi), y_ = *(const float4*)(bl_ + 32 + 8 * g4 + 4 * hi); \
            P0[4 * g4] = x_.x; P0[4 * g4 + 1] = x_.y; P0[4 * g4 + 2] = x_.z; P0[4 * g4 + 3] = x_.w; P1[4 * g4] = y_.x; P1[4 * g4 + 1] = y_.y; P1[4 * g4 + 2] = y_.z; P1[4 * g4 + 3] = y_.w; } \
        qk_tile<true>(smem + (sj) * AT_STAGE, qf, P0, P1, lane); \
        if ((jj) >= jmask_w) mask_tile<1>(P0, P1, 64 * (jj), -1, qrow, hi); } while (0)
#define FOX_STEP(CUR0, CUR1, NXT0, NXT1, j, CVD_LD, CVA_LD, CVB_LD, CVS_LD, CVD_ST, CVA_ST, CVB_ST, CVS_ST) do { \
        const int s_cur = (j) % 3, s_nxt = ((j) + 1) % 3, s_ld = ((j) + 2) % 3; const int tl_ = TJ((j) + 2) < 0 ? 0 : TJ((j) + 2);     \
        KV_GLOAD(K + (size_t)tl_ * 4096, V + (size_t)tl_ * 4096); breg = CUM[tl_ * 64 + lane]; \
        { const float* cvs_; const float* scp_; CV_ADDR(j, cvs_, CVD_LD, scp_); CVA_LD = *(const float4*)cvs_; CVB_LD = *(const float4*)(cvs_ + 4); CVS_LD = *scp_; } \
        if ((j) + 1 < ntiles && TJ((j) + 1) <= jmax_w) FOX_QK(NXT0, NXT1, TJ((j) + 1), s_nxt); \
        __builtin_amdgcn_sched_barrier(0); \
        if (TJ(j) <= jmax_w) { softmax_step_nosum(CUR0, CUR1, m, o, lacc); pv_tile_sum(smem + s_cur * AT_STAGE + 8192, CUR0, CUR1, o, lacc, lane); } \
        KV_LSTORE(smem + s_ld * AT_STAGE); biasL[s_ld * 64 + lane] = (cref - breg) * LOG2E; \
        { uint4 o_; o_.x = cvtpk(CVA_ST.x * CVS_ST, CVA_ST.y * CVS_ST); o_.y = cvtpk(CVA_ST.z * CVS_ST, CVA_ST.w * CVS_ST); o_.z = cvtpk(CVB_ST.x * CVS_ST, CVB_ST.y * CVS_ST); o_.w = cvtpk(CVB_ST.z * CVS_ST, CVB_ST.w * CVS_ST); *(uint4*)CVD_ST = o_; } \
        __syncthreads(); } while (0)
    f32x16 pA0, pA1, pB0, pB1;
    if (TJ(0) <= jmax_w) FOX_QK(pA0, pA1, TJ(0), 0);
    for (int j = 0; j < ntiles; j += 2) {
        FOX_STEP(pA0, pA1, pB0, pB1, j, cvdA, cvaA, cvbA, cvsA, cvdB, cvaB, cvbB, cvsB);
        FOX_STEP(pB0, pB1, pA0, pA1, j + 1, cvdB, cvaB, cvbB, cvsB, cvdA, cvaA, cvbA, cvsA);
    }
    { uint4 o_; o_.x = cvtpk(cvaB.x * cvsB, cvaB.y * cvsB); o_.y = cvtpk(cvaB.z * cvsB, cvaB.w * cvsB); o_.z = cvtpk(cvbB.x * cvsB, cvbB.y * cvsB); o_.w = cvtpk(cvbB.z * cvsB, cvbB.w * cvsB); *(uint4*)cvdB = o_; }
#undef CV_ADDR
#undef FOX_QK
#undef FOX_STEP
#undef TJ
    const float inv = 1.0f / lacc[0]; float ss = 0.f;
    const size_t token = (size_t)b * 8192 + qrow;
    bf16_t* O = (bf16_t*)(a.ws + WS_OFOX) + token * 512 + h * 64;
#pragma unroll
    for (int dh = 0; dh < 2; ++dh)
#pragma unroll
        for (int g4 = 0; g4 < 4; ++g4) { const float v0 = o[dh][4 * g4] * inv, v1 = o[dh][4 * g4 + 1] * inv, v2 = o[dh][4 * g4 + 2] * inv, v3 = o[dh][4 * g4 + 3] * inv;
            ss += v0 * v0 + v1 * v1 + v2 * v2 + v3 * v3; uint2 w; w.x = cvtpk(v0, v1); w.y = cvtpk(v2, v3); *(uint2*)(O + 32 * dh + 8 * g4 + 4 * hi) = w; }
    ss = pair_sum(ss);
    if (hi == 0) ((float*)(a.ws + WS_SSQ))[token * 16 + 8 + h] = ss;
}

DEV void nsa_item(const Args& a, unsigned char* smem, int b, int g, int tt) {
    const int tid = TID(), lane = tid & 63, wid = tid >> 6, col = lane & 31, hi = lane >> 5;
    const int t0 = tt * 64, tokw = col >> 2, r = col & 3, h = 4 * g + r; const int tokl = wid * 8 + tokw; const int t = t0 + tokl; const size_t token = (size_t)b * 8192 + t;
    const float slope2 = exp2f(-(float)(h + 1)) * LOG2E;
    const bf16_t* PROJ = (const bf16_t*)(a.ws + WS_PROJ);
    const float* GN = (const float*)(a.ws + WS_GN) + token * 24 + h * 3;
    const int cur = tt; const bool need_topk = cur > 15;
    bf16x8 qf[4];
    { const bf16_t* Q = PROJ + (((size_t)(h * 2 + b)) * 8192 + t) * 64;
#pragma unroll
      for (int ks = 0; ks < 4; ++ks) qf[ks] = *(const bf16x8*)(Q + 16 * ks + 8 * hi); }
    float* impw = (float*)(smem + AT_IMP_OFF) + wid * 2048; float* totw = impw + lane;
    unsigned* selmask = (unsigned*)(smem + AT_SEL_OFF); unsigned* wun = (unsigned*)(smem + AT_WUN_OFF); int* ucnt = (int*)(smem + AT_UCNT_OFF); unsigned char* ulist = smem + AT_ULIST_OFF;
    f32x16 o[2]; float m, l; int par = 0;
    const int tmin_w = t0 + wid * 8, tmax_w = tmin_w + 7;
    {
        const bf16_t* KC = (const bf16_t*)(a.ws + WS_KC) + ((size_t)(0 * 4 + b * 2 + g)) * 512 * 64; const bf16_t* VC = (const bf16_t*)(a.ws + WS_KC) + ((size_t)(1 * 4 + b * 2 + g)) * 512 * 64;
        const int ncv = t0 / 16 + 3; const int nct = (ncv + 63) >> 6;
        auto src = [&](int j, const bf16_t*& kp, const bf16_t*& vp) { kp = KC + (size_t)j * 4096; vp = VC + (size_t)j * 4096; };
        m = -1e30f; l = 0.f;
        auto src0 = [&](const bf16_t*& kp, const bf16_t*& vp) { kp = KC; vp = VC; };
        par = kv_pipeline(smem, nct, src, [&](int j, const unsigned char* st) {
            const int kpos0 = 1024 * j + 31;
            if (kpos0 > tmax_w) return;
            f32x16 p0, p1; alibi_init<16>(p0, p1, slope2, kpos0, t0, hi);
            qk_tile<false>(st, qf, p0, p1, lane);
            if (kpos0 + 16 * 63 > tmin_w) mask_tile<16>(p0, p1, kpos0, -1, t, hi);
            const float mt = rowmax32(p0, p1); const float mn = fmaxf(m, mt); float rs = 0.f;
#pragma unroll
            for (int rr = 0; rr < 16; ++rr) rs += __builtin_amdgcn_exp2f(p0[rr] - mn) + __builtin_amdgcn_exp2f(p1[rr] - mn);
            rs = pair_sum(rs);
            l = l * __builtin_amdgcn_exp2f(m - mn) + rs; m = mn;
        }, 0, false, true, src0);
        const float linv = l > 0.f ? 1.0f / l : 0.f;
        if (need_topk) { for (int i = lane; i < 8 * 129; i += 64) impw[i] = 0.f; }
        o[0] = (f32x16){}; o[1] = (f32x16){};
        const bf16_t* KS0 = PROJ + ((size_t)((12 + g) * 2 + b)) * 8192 * 64 + (size_t)cur * 4096; const bf16_t* VS0 = PROJ + ((size_t)((14 + g) * 2 + b)) * 8192 * 64 + (size_t)cur * 4096;
        par = kv_pipeline(smem, nct, src, [&](int j, const unsigned char* st) {
            const int kpos0 = 1024 * j + 31;
            if (kpos0 > tmax_w) return;
            f32x16 p0, p1; alibi_init<16>(p0, p1, slope2, kpos0, t0, hi);
            qk_tile<false>(st, qf, p0, p1, lane);
            if (kpos0 + 16 * 63 > tmin_w) mask_tile<16>(p0, p1, kpos0, -1, t, hi);
#pragma unroll
            for (int rr = 0; rr < 16; ++rr) { p0[rr] = __builtin_amdgcn_exp2f(p0[rr] - m) * linv; p1[rr] = __builtin_amdgcn_exp2f(p1[rr] - m) * linv; }
            if (need_topk) {
#pragma unroll
                for (int half = 0; half < 2; ++half)
#pragma unroll
                    for (int g4 = 0; g4 < 4; ++g4) { const f32x16& p = half ? p1 : p0;
                        float ms = (p[4 * g4] + p[4 * g4 + 1]) + (p[4 * g4 + 2] + p[4 * g4 + 3]); float ls = p[4 * g4 + 3];
                        ms = quad_sum(ms); ls = quad_sum(ls);
                        const int n = 16 * j + 8 * half + 2 * g4 + hi;
                        if (r == 0) { atomicAdd(&impw[tokw * 129 + n], ms); atomicAdd(&impw[tokw * 129 + n + 1], ls); } }
            }
            pv_tile<false>(st + 8192, p0, p1, o, lane);
        }, par, true, true, [&](const bf16_t*& kp, const bf16_t*& vp) { kp = KS0; vp = VS0; });
    }
    {
        unsigned un0 = 0u, un1 = 0u, un2 = 0u, un3 = 0u;
        if (need_topk) {
#define TK_INIT(V0, V1, M0, M1, M2, M3, tk_) float V0 = impw[(tk_) * 129 + lane], V1 = impw[(tk_) * 129 + 64 + lane]; \
                V0 = (lane >= 1 && lane <= cur - 2) ? V0 : -1.0f; V1 = (lane + 64 <= cur - 2) ? V1 : -1.0f; unsigned M0 = 1u, M1 = 0u, M2 = 0u, M3 = 0u; \
                TK_SET(M0, M1, M2, M3, cur); TK_SET(M0, M1, M2, M3, cur - 1)
#define TK_SET(M0, M1, M2, M3, n_) do { const int n__ = (n_); const unsigned bit__ = 1u << (n__ & 31); const int w__ = n__ >> 5; M0 |= (w__ == 0) ? bit__ : 0u; M1 |= (w__ == 1) ? bit__ : 0u; M2 |= (w__ == 2) ? bit__ : 0u; M3 |= (w__ == 3) ? bit__ : 0u; } while (0)
#define TK_STEP(V0, V1, M0, M1, M2, M3) do { const float mx_ = wave_max_u(fmaxf(V0, V1)); const unsigned long long b0_ = __ballot(V0 == mx_), b1_ = __ballot(V1 == mx_); \
                const int n_ = b0_ ? (__ffsll((long long)b0_) - 1) : (63 + __ffsll((long long)b1_)); const bool hit_ = lane == (n_ & 63); \
                V0 = (hit_ && n_ < 64) ? -1.0f : V0; V1 = (hit_ && n_ >= 64) ? -1.0f : V1; TK_SET(M0, M1, M2, M3, n_); } while (0)
            for (int tk = 0; tk < 8; tk += 4) {
                TK_INIT(a0_, a1_, ma0, ma1, ma2, ma3, tk); TK_INIT(b0v, b1v, mb0, mb1, mb2, mb3, tk + 1); TK_INIT(c0v, c1v, mc0, mc1, mc2, mc3, tk + 2); TK_INIT(d0v, d1v, md0, md1, md2, md3, tk + 3);
                for (int it = 0; it < 13; ++it) { TK_STEP(a0_, a1_, ma0, ma1, ma2, ma3); TK_STEP(b0v, b1v, mb0, mb1, mb2, mb3); TK_STEP(c0v, c1v, mc0, mc1, mc2, mc3); TK_STEP(d0v, d1v, md0, md1, md2, md3); }
                if (lane == 0) { unsigned* sm_ = selmask + (wid * 8 + tk) * 4; sm_[0] = ma0; sm_[1] = ma1; sm_[2] = ma2; sm_[3] = ma3; sm_[4] = mb0; sm_[5] = mb1; sm_[6] = mb2; sm_[7] = mb3;
                    sm_[8] = mc0; sm_[9] = mc1; sm_[10] = mc2; sm_[11] = mc3; sm_[12] = md0; sm_[13] = md1; sm_[14] = md2; sm_[15] = md3; }
                un0 |= ma0 | mb0 | mc0 | md0; un1 |= ma1 | mb1 | mc1 | md1; un2 |= ma2 | mb2 | mc2 | md2; un3 |= ma3 | mb3 | mc3 | md3;
            }
#undef TK_INIT
#undef TK_SET
#undef TK_STEP
        } else {
            const unsigned full = (2u << cur) - 1u;
            un0 = full;
            if (lane < 8) { unsigned* sm_ = selmask + (wid * 8 + lane) * 4; sm_[0] = full; sm_[1] = 0u; sm_[2] = 0u; sm_[3] = 0u; }
        }
        if (lane == 0) { wun[wid * 4] = un0; wun[wid * 4 + 1] = un1; wun[wid * 4 + 2] = un2; wun[wid * 4 + 3] = un3; }
        __syncthreads();
        if (tid == 0) { int c = 0;
            for (int w = 0; w < 4; ++w) { unsigned u = 0u; for (int ww = 0; ww < NWAVE; ++ww) u |= wun[ww * 4 + w]; for (int bb = 0; bb < 32; ++bb) if ((u >> bb) & 1u) ulist[c++] = (unsigned char)(w * 32 + bb); }
            ucnt[0] = c; }
        __syncthreads();
    }
    { const float g0 = GN[0];
#pragma unroll
      for (int rr = 0; rr < 16; ++rr) { totw[rr * 64] = o[0][rr] * g0; totw[(16 + rr) * 64] = o[1][rr] * g0; } }
    {
        const bf16_t* KS = PROJ + ((size_t)((12 + g) * 2 + b)) * 8192 * 64; const bf16_t* VS = PROJ + ((size_t)((14 + g) * 2 + b)) * 8192 * 64;
        const int nu = ucnt[0];
        m = -1e30f; f32x16 lacc = (f32x16){}; o[0] = (f32x16){}; o[1] = (f32x16){};
        const bf16_t* KW0 = PROJ + ((size_t)((16 + g) * 2 + b)) * 8192 * 64 + (size_t)cur * 4096; const bf16_t* VW0 = PROJ + ((size_t)((18 + g) * 2 + b)) * 8192 * 64 + (size_t)cur * 4096;
        par = kv_pipeline(smem, nu, [&](int j, const bf16_t*& kp, const bf16_t*& vp) { const int n = ulist[nu - 1 - j]; kp = KS + (size_t)n * 4096; vp = VS + (size_t)n * 4096; },
            [&](int j, const unsigned char* st) {
                const int n = ulist[nu - 1 - j];
                if (!((wun[wid * 4 + (n >> 5)] >> (n & 31)) & 1u)) return;
                const bool sel = (selmask[tokl * 4 + (n >> 5)] >> (n & 31)) & 1u;
                f32x16 p0, p1; alibi_init<1>(p0, p1, slope2, 64 * n, t0, hi);
                qk_tile<false>(st, qf, p0, p1, lane);
                if (n == cur || !__all(sel)) mask_tile<1>(p0, p1, 64 * n, -1, sel ? t : -1, hi);
                softmax_step_nosum(p0, p1, m, o, lacc);
                pv_tile_sum(st + 8192, p0, p1, o, lacc, lane);
            }, par, true, true, [&](const bf16_t*& kp, const bf16_t*& vp) { kp = KW0; vp = VW0; });
        const float g1 = GN[1] / fmaxf(lacc[0], 1e-30f);
#pragma unroll
        for (int rr = 0; rr < 16; ++rr) { totw[rr * 64] += o[0][rr] * g1; totw[(16 + rr) * 64] += o[1][rr] * g1; }
    }
    {
        const bf16_t* KW = PROJ + ((size_t)((16 + g) * 2 + b)) * 8192 * 64; const bf16_t* VW = PROJ + ((size_t)((18 + g) * 2 + b)) * 8192 * 64;
        const int jlo = (t0 - 511) > 0 ? ((t0 - 511) >> 6) : 0; const int jhi = cur;
        m = -1e30f; f32x16 lacc = (f32x16){}; o[0] = (f32x16){}; o[1] = (f32x16){};
        (void)kv_pipeline(smem, jhi - jlo + 1, [&](int j, const bf16_t*& kp, const bf16_t*& vp) { kp = KW + (size_t)(jhi - j) * 4096; vp = VW + (size_t)(jhi - j) * 4096; },
            [&](int j, const unsigned char* st) {
                const int kpos0 = 64 * (jhi - j);
                if (kpos0 > tmax_w || kpos0 + 63 < tmin_w - 511) return;
                f32x16 p0, p1; alibi_init<1>(p0, p1, slope2, kpos0, t0, hi);
                qk_tile<false>(st, qf, p0, p1, lane);
                if (kpos0 < tmax_w - 511 || kpos0 + 63 > tmin_w) mask_tile<1>(p0, p1, kpos0, t - 511, t, hi);
                softmax_step_nosum(p0, p1, m, o, lacc);
                pv_tile_sum(st + 8192, p0, p1, o, lacc, lane);
            }, par, true, false, NoSrc());
        const float g2 = GN[2] / fmaxf(lacc[0], 1e-30f);
#pragma unroll
        for (int rr = 0; rr < 16; ++rr) { o[0][rr] = totw[rr * 64] + o[0][rr] * g2; o[1][rr] = totw[(16 + rr) * 64] + o[1][rr] * g2; }
    }
    {
        float ss = 0.f; bf16_t* O = (bf16_t*)(a.ws + WS_ONSA) + token * 512 + h * 64;
#pragma unroll
        for (int dh = 0; dh < 2; ++dh)
#pragma unroll
            for (int g4 = 0; g4 < 4; ++g4) { const float v0 = o[dh][4 * g4], v1 = o[dh][4 * g4 + 1], v2 = o[dh][4 * g4 + 2], v3 = o[dh][4 * g4 + 3];
                ss += v0 * v0 + v1 * v1 + v2 * v2 + v3 * v3; uint2 w; w.x = cvtpk(v0, v1); w.y = cvtpk(v2, v3); *(uint2*)(O + 32 * dh + 8 * g4 + 4 * hi) = w; }
        ss = pair_sum(ss);
        if (hi == 0) ((float*)(a.ws + WS_SSQ))[token * 16 + h] = ss;
    }
}
#ifndef PROBE_DUP
#define PROBE_DUP 0
#endif
DEV void phase_att(const Args& a, unsigned char* smem) {
    int* qctr = (int*)(a.ws + WS_CTL) + 64; int* sitem = (int*)(smem + AT_ITEM_OFF);
    unsigned* ctl = (unsigned*)(a.ws + WS_CTL); unsigned* seen = (unsigned*)(smem + AT_ITEM_OFF + 8);
    if (TID() == 0) seen[0] = 0u;
    for (;;) {
        if (TID() == 0) sitem[0] = atomicAdd(qctr, 1);
        __syncthreads();
        const int item = sitem[0];
        __syncthreads();
        if (item >= 32 + 1024) break;
        if (item < 16) cmp_item(a, smem, 16 + item);
        else if (item < 32) cmp_item(a, smem, item - 16);
        else if (item < 32 + 512) { const int fi = item - 32; const int qb = 31 - (fi >> 4), bh = fi & 15; if (!((seen[0] >> bh) & 1u)) { wait_flag(ctl + CW_CUMFLAG + bh, 1u); if (TID() == 0) seen[0] |= 1u << bh; } fox_item(a, smem, fi, bh >> 3, bh & 7, qb); }
        else { const int idx = item - 32 - 512; const int tt = 127 - (idx >> 2), bg = idx & 3; if (!((seen[0] >> 16) & 1u)) { wait_flag(ctl + CW_CMPFLAG, 16u); if (TID() == 0) seen[0] |= 1u << 16; } nsa_item(a, smem, bg >> 1, bg & 1, tt); }
    }
}

DEV void phase_outproj(const Args& a, unsigned char* smem) {
    const bf16_t* ONSA = (const bf16_t*)(a.ws + WS_ONSA); const bf16_t* OFOX = (const bf16_t*)(a.ws + WS_OFOX); const float* SSQ = (const float*)(a.ws + WS_SSQ);
    const bf16_t* W = (const bf16_t*)(a.ws + WS_WOUT); bf16_t* H1 = (bf16_t*)(a.ws + WS_H1); const bf16_t* XB = (const bf16_t*)(a.ws + WS_XN);
    float* rs = (float*)(smem + MISC_OFF);
    const int tid = TID(); int lane = tid & 63, wid = tid >> 6, wr = wid >> 2, wc = wid & 3; (void)wr; (void)wc; (void)lane;
    auto aoffo = [](int r, int kc) { return (unsigned)(r * 1024 + kc * 16); }; auto boffo = [](int k, int nc) { return (unsigned)(k * 2048 + nc * 16); };
    for (int item = VBID(); item < 64 * 4; item += gridDim.x) {
        int mt, nt; patch_decode(item, 64, 4, mt, nt);
        gemm_issue0<15>(smem, ONSA + (size_t)mt * 256 * 512, aoffo, W + nt * 256, boffo);
        if (tid < 256) { const float* s_ = SSQ + (size_t)(mt * 256 + tid) * 16; float sn = 0.f, sf = 0.f;
#pragma unroll
            for (int j = 0; j < 8; ++j) { sn += s_[j]; sf += s_[8 + j]; }
            rs[tid * 2] = rsqrtf(sn * (1.f / 512.f) + EPS); rs[tid * 2 + 1] = rsqrtf(sf * (1.f / 512.f) + EPS); }
        asm volatile("s_waitcnt vmcnt(0)" ::: "memory");
        __syncthreads();
        f32x4 acc[8][4];
#pragma unroll
        for (int mi = 0; mi < 8; ++mi) { const size_t gm = (size_t)mt * 256 + G_ROW(mi);
#pragma unroll
            for (int np = 0; np < 2; ++np) { const uint4 q = *(const uint4*)(XB + gm * 1024 + nt * 256 + PAIR16_COL(G_COL(2 * np), G_COL(2 * np + 1))); uint2 xa, xb; unpair16(q, xa, xb);
                acc[mi][2 * np] = (f32x4){bflo(xa.x), bfhi(xa.x), bflo(xa.y), bfhi(xa.y)}; acc[mi][2 * np + 1] = (f32x4){bflo(xb.x), bfhi(xb.x), bflo(xb.y), bfhi(xb.y)}; } }
#pragma unroll
        for (int mi = 0; mi < 8; ++mi) { const float ri = 1.0f / rs[(G_ROW(mi)) * 2];
#pragma unroll
            for (int ni = 0; ni < 4; ++ni) acc[mi][ni] *= ri; }
        gemm256<false>(smem, 8, ONSA + (size_t)mt * 256 * 512, 128u, aoffo, W + nt * 256, 64u * 2048u, boffo, acc, true,
                       next_tile(true, smem, OFOX + (size_t)mt * 256 * 512, aoffo, W + (size_t)512 * 1024 + nt * 256, boffo));
        EPI_IDS();
#pragma unroll
        for (int mi = 0; mi < 8; ++mi) { const int rl = G_ROW(mi); const float rat = rs[rl * 2] / rs[rl * 2 + 1];
#pragma unroll
            for (int ni = 0; ni < 4; ++ni) acc[mi][ni] *= rat; }
        gemm256<false>(smem, 8, OFOX + (size_t)mt * 256 * 512, 128u, aoffo, W + (size_t)512 * 1024 + nt * 256, 64u * 2048u, boffo, acc, true);
        EPI_IDS();
#pragma unroll
        for (int mi = 0; mi < 8; ++mi) { const int rl = G_ROW(mi); const size_t gm = (size_t)mt * 256 + rl; const float rf = rs[rl * 2 + 1];
#pragma unroll
            for (int np = 0; np < 2; ++np) { const f32x4 v0 = acc[mi][2 * np] * rf, v1 = acc[mi][2 * np + 1] * rf; uint2 oa, ob;
                oa.x = cvtpk(v0[0], v0[1]); oa.y = cvtpk(v0[2], v0[3]); ob.x = cvtpk(v1[0], v1[1]); ob.y = cvtpk(v1[2], v1[3]);
                *(uint4*)(H1 + gm * 1024 + nt * 256 + PAIR16_COL(G_COL(2 * np), G_COL(2 * np + 1))) = pair16(oa, ob); } }
        __syncthreads();
    }
}

DEV void phase_route(const Args& a, unsigned char* smem) {
    const bf16_t* H1 = (const bf16_t*)(a.ws + WS_H1); bf16_t* XN = (bf16_t*)(a.ws + WS_XN); float* RSTD2 = (float*)(a.ws + WS_RSTD2);
    const float* ln2 = a.in[I_LN2]; const float* wr_ = a.in[I_WR]; const float* br = a.in[I_BR];
    int* CNT = (int*)(a.ws + WS_CTL);
    int* TOPI = (int*)(a.ws + WS_TOPI); int* TOPS = (int*)(a.ws + WS_TOPS); float* TOPW = (float*)(a.ws + WS_TOPW);
    int* TOKOF = (int*)(a.ws + WS_TOKOF); float* ROWW = (float*)(a.ws + WS_ROWW); float* RSDS = (float*)(a.ws + WS_RSDS);
    float* part = (float*)smem;
    float* ssqp = part + 8 * 32 * 33;
    int* lcnt = (int*)(ssqp + 256); int* lbase = lcnt + 32; int* te = lbase + 32; int* trk = te + 256; float* tw = (float*)(trk + 256); float* trs = tw + 256;
    const int tid = TID(), lane = tid & 63, wid = tid >> 6, i32 = lane & 31, kh = lane >> 5; const int tg = wid >> 2, kq = wid & 3;
    for (int item = BID(); item < 256; item += gridDim.x) {
        const int tok = item * 64 + tg * 32 + i32;
        if (tid < 32) lcnt[tid] = 0;
        f32x16 acc = (f32x16){}; float ss = 0.f;
        const bf16_t* hrow = H1 + (size_t)tok * 1024 + 256 * kq + 8 * kh; const float* lrow = ln2 + 256 * kq + 8 * kh; bf16_t* xrow = XN + (size_t)tok * 1024 + 256 * kq + 8 * kh;
        const float* wbase = wr_ + (size_t)(256 * kq + 8 * kh) * 32 + i32;
#pragma unroll 1
        for (int hb = 0; hb < 2; ++hb) {
            float4 hv[8][2], lv[8][2]; float wv[8][8];
#pragma unroll
            for (int c = 0; c < 8; ++c) { const int cc = hb * 8 + c;
                { const uint4 hq = *(const uint4*)(hrow + 16 * cc); hv[c][0] = (float4){bflo(hq.x), bfhi(hq.x), bflo(hq.y), bfhi(hq.y)}; hv[c][1] = (float4){bflo(hq.z), bfhi(hq.z), bflo(hq.w), bfhi(hq.w)}; } lv[c][0] = *(const float4*)(lrow + 16 * cc); lv[c][1] = *(const float4*)(lrow + 16 * cc + 4);
#pragma unroll
                for (int r = 0; r < 8; ++r) wv[c][r] = wbase[(size_t)(16 * cc + r) * 32]; }
#pragma unroll
            for (int c = 0; c < 8; ++c) { const int cc = hb * 8 + c; float x[8];
                x[0] = hv[c][0].x * lv[c][0].x; x[1] = hv[c][0].y * lv[c][0].y; x[2] = hv[c][0].z * lv[c][0].z; x[3] = hv[c][0].w * lv[c][0].w;
                x[4] = hv[c][1].x * lv[c][1].x; x[5] = hv[c][1].y * lv[c][1].y; x[6] = hv[c][1].z * lv[c][1].z; x[7] = hv[c][1].w * lv[c][1].w;
                ss += hv[c][0].x * hv[c][0].x + hv[c][0].y * hv[c][0].y + hv[c][0].z * hv[c][0].z + hv[c][0].w * hv[c][0].w + hv[c][1].x * hv[c][1].x + hv[c][1].y * hv[c][1].y + hv[c][1].z * hv[c][1].z + hv[c][1].w * hv[c][1].w;
#pragma unroll
                for (int r = 0; r < 8; ++r) acc = __builtin_amdgcn_mfma_f32_32x32x2f32(x[r], wv[c][r], acc, 0, 0, 0); }
        }
        ss = pair_sum(ss);
        if (kh == 0) ssqp[wid * 32 + i32] = ss;
#pragma unroll
        for (int r = 0; r < 16; ++r) part[(wid * 32 + crow(r, kh)) * 33 + i32] = acc[r];
        __syncthreads();
        if (tid < 64) {
            const int g_ = tid >> 5, i_ = tid & 31; const int w0_ = g_ * 4;
            const float sq = ssqp[(w0_ + 0) * 32 + i_] + ssqp[(w0_ + 1) * 32 + i_] + ssqp[(w0_ + 2) * 32 + i_] + ssqp[(w0_ + 3) * 32 + i_]; const float rstd = rsqrtf(sq * (1.f / 1024.f) + EPS);
            RSTD2[item * 64 + tid] = rstd; trs[tid] = rstd;
            float lg[32];
#pragma unroll
            for (int e = 0; e < 32; ++e) lg[e] = (part[((w0_ + 0) * 32 + i_) * 33 + e] + part[((w0_ + 1) * 32 + i_) * 33 + e] + part[((w0_ + 2) * 32 + i_) * 33 + e] + part[((w0_ + 3) * 32 + i_) * 33 + e]) * rstd + br[e];
            unsigned taken = 0u; float tv[4]; int ti[4];
#pragma unroll
            for (int k = 0; k < 4; ++k) { float best = -3.0e38f; int bi = 0;
#pragma unroll
                for (int e = 0; e < 32; ++e) { const bool ok = !((taken >> e) & 1u) && lg[e] > best; best = ok ? lg[e] : best; bi = ok ? e : bi; }
                taken |= 1u << bi; tv[k] = best; ti[k] = bi; }
            const float e1 = __expf(tv[1] - tv[0]), e2 = __expf(tv[2] - tv[0]), e3 = __expf(tv[3] - tv[0]); const float inv = 1.0f / (1.0f + e1 + e2 + e3);
            const float wv[4] = {inv, e1 * inv, e2 * inv, e3 * inv};
#pragma unroll
            for (int k = 0; k < 4; ++k) { const int idx = tid * 4 + k; te[idx] = ti[k]; trk[idx] = atomicAdd(&lcnt[ti[k]], 1); tw[idx] = wv[k]; }
        }
        __syncthreads();
        if (tid < 32) lbase[tid] = atomicAdd(&CNT[tid], lcnt[tid]);
        __syncthreads();
        if (tid < 256) { const int idx = tid; const int tk = item * 64 + (idx >> 2); const int e = te[idx]; const int slot = lbase[e] + trk[idx];
          TOPI[(size_t)tk * 4 + (idx & 3)] = e; TOPS[(size_t)tk * 4 + (idx & 3)] = slot; TOPW[(size_t)tk * 4 + (idx & 3)] = tw[idx];
          TOKOF[(size_t)e * 16384 + slot] = tk; ROWW[(size_t)e * 16384 + slot] = tw[idx]; RSDS[(size_t)e * 16384 + slot] = trs[idx >> 2]; }
        __syncthreads();
    }
}

struct MoeMap { int e, mt, nt, cnt, off; };
DEV void moe_setup(const Args& a, int* sm) {
    if (TID() == 0) { const int* CNT = (const int*)(a.ws + WS_CTL); int tot = 0; for (int e = 0; e < 32; ++e) { const int c = CNT[e]; const int mt = (c + 255) >> 8; sm[e] = mt; sm[32 + e] = tot; tot += mt; } sm[64] = tot; }
    __syncthreads();
}
DEV MoeMap moe_map(const Args& a, const int* sm, int item, int NT) {
    MoeMap mm; int e = 0;
#pragma unroll 1
    for (int i = 1; i < 32; ++i) if (item >= sm[32 + i] * NT) e = i;
    const int local = item - sm[32 + e] * NT; const int mte = sm[e];
    int mt_, nt_; patch_decode(local, mte, NT, mt_, nt_);
    mm.e = __builtin_amdgcn_readfirstlane(e); mm.mt = __builtin_amdgcn_readfirstlane(mt_); mm.nt = __builtin_amdgcn_readfirstlane(nt_);
    mm.cnt = __builtin_amdgcn_readfirstlane(((const int*)(a.ws + WS_CTL))[e]); mm.off = __builtin_amdgcn_readfirstlane(sm[32 + e] * 256); return mm;
}
DEV int moe_maps_build(const Args& a, const int* sm, int* maps, int nitems, int NT, int first_ = -1) {
    const int tid = TID(); const int first = first_ < 0 ? VBID() : first_; const int nmine = first < nitems ? (nitems - first + (int)gridDim.x - 1) / (int)gridDim.x : 0;
    for (int k = tid; k < nmine && k < 64; k += NTHR) { const int item = first + k * (int)gridDim.x; int e = 0;
#pragma unroll 1
        for (int i = 1; i < 32; ++i) if (item >= sm[32 + i] * NT) e = i;
        const int local = item - sm[32 + e] * NT; int mt_, nt_; patch_decode(local, sm[e], NT, mt_, nt_);
        maps[k * 8] = e; maps[k * 8 + 1] = mt_; maps[k * 8 + 2] = nt_; maps[k * 8 + 3] = ((const int*)(a.ws + WS_CTL))[e]; maps[k * 8 + 4] = sm[32 + e] * 256; }
    __syncthreads();
    return nmine < 64 ? nmine : 64;
}
DEV MoeMap moe_get(const int* maps, int k) { MoeMap mm; mm.e = __builtin_amdgcn_readfirstlane(maps[k * 8]); mm.mt = __builtin_amdgcn_readfirstlane(maps[k * 8 + 1]); mm.nt = __builtin_amdgcn_readfirstlane(maps[k * 8 + 2]);
    mm.cnt = __builtin_amdgcn_readfirstlane(maps[k * 8 + 3]); mm.off = __builtin_amdgcn_readfirstlane(maps[k * 8 + 4]); return mm; }
DEV int moe_early_down(const int* sm, int grid) {
    const int up_items = sm[64] * 8; const int rem = up_items % grid; if (rem == 0 || up_items < 2 * grid) return 0;
    int tiles = 0;
#pragma unroll 1
    for (int e = 0; e < 32; ++e) { if ((sm[32 + e] + sm[e]) * 8 <= 2 * grid) tiles = sm[32 + e] + sm[e]; else break; }
    const int idle = grid - rem; const int cand = tiles * 4;
    return idle < cand ? idle : cand;
}
DEV void down_item_single(const Args& a, unsigned char* smem, const MoeMap& mm, float* sd) {
    const bf16_t* ACT = (const bf16_t*)(a.ws + WS_ACT); const bf16_t* W = (const bf16_t*)(a.ws + WS_WDN); bf16_t* Y = (bf16_t*)(a.ws + WS_Y);
    const float* ROWW = (const float*)(a.ws + WS_ROWW); const float* bdn = a.in[I_BDN];
    const int tid = TID(); int lane = tid & 63, wid = tid >> 6, wr = wid >> 2, wc = wid & 3; (void)wr; (void)wc; (void)lane;
    { const int t8 = tid & 255; const int slot = mm.mt * 256 + t8; const bool ok = slot < mm.cnt; const float rw_ = ROWW[(size_t)mm.e * 16384 + (ok ? slot : 0)];
      sd[t8] = ok ? rw_ : 0.f; sd[256 + t8] = bdn[(size_t)mm.e * 1024 + mm.nt * 256 + t8]; }
    __syncthreads();
    auto aoffd = [](int r, int kc) { return (unsigned)(r * 2048 + kc * 16); }; auto boffd = [](int k, int nc) { return (unsigned)(k * 2048 + nc * 16); };
    const bf16_t* We = W + (size_t)mm.e * 1024 * 1024; const bf16_t* Ab = ACT + ((size_t)mm.off + mm.mt * 256) * 1024;
    f32x4 acc[8][4];
    gemm256<true>(smem, 16, Ab, 128u, aoffd, We + mm.nt * 256, 64u * 2048u, boffd, acc);
    EPI_IDS();
    float4 bb[4];
#pragma unroll
    for (int ni = 0; ni < 4; ++ni) bb[ni] = *(const float4*)(sd + 256 + G_COL(ni));
#pragma unroll
    for (int mi = 0; mi < 8; ++mi) { const int rl = G_ROW(mi); const size_t row = (size_t)mm.off + mm.mt * 256 + rl; const float w = sd[rl];
#pragma unroll
        for (int np = 0; np < 2; ++np) { uint2 o2[2];
#pragma unroll
            for (int h = 0; h < 2; ++h) { const int ni = 2 * np + h; const f32x4 v = acc[mi][ni]; o2[h].x = cvtpk((v[0] + bb[ni].x) * w, (v[1] + bb[ni].y) * w); o2[h].y = cvtpk((v[2] + bb[ni].z) * w, (v[3] + bb[ni].w) * w); }
            *(uint4*)(Y + row * 1024 + mm.nt * 256 + PAIR16_COL(G_COL(2 * np), G_COL(2 * np + 1))) = pair16(o2[0], o2[1]); } }
    __syncthreads();
}
DEV void phase_up(const Args& a, unsigned char* smem) {
    int* sm = (int*)(smem + MISC_OFF); int* maps = (int*)(smem + MISC_OFF + 8192); int* tokb = maps + 512; float* rsdb = (float*)(tokb + 768); float* biab = rsdb + 768;
    static_assert(8192 + (512 + 3 * 768) * 4 <= 8192 + 12288, "misc LDS");
    const bf16_t* XN = (const bf16_t*)(a.ws + WS_H1); const bf16_t* W = (const bf16_t*)(a.ws + WS_WUP); bf16_t* ACT = (bf16_t*)(a.ws + WS_ACT); const float* RSDS = (const float*)(a.ws + WS_RSDS);
    const int* TOKOF = (const int*)(a.ws + WS_TOKOF); const float* bup = a.in[I_BUP];
    const int tid = TID(); int lane = tid & 63, wid = tid >> 6, wr = wid >> 2, wc = wid & 3; (void)wr; (void)wc; (void)lane;
    moe_setup(a, sm);
    const int nitems = __builtin_amdgcn_readfirstlane(sm[64]) * 8;
    const int nmine = __builtin_amdgcn_readfirstlane(moe_maps_build(a, sm, maps, nitems, 8));
    unsigned* upr2 = (unsigned*)(a.ws + WS_CTL) + CW_UPR2; bool published = false;
    int tkr = 0; float rsr = 0.f, bir = 0.f;
    const int t8 = tid & 255;
    auto side_load = [&](const MoeMap& m_) { const int slot = m_.mt * 256 + t8; const bool ok = slot < m_.cnt; const size_t sl_ = (size_t)m_.e * 16384 + (ok ? slot : 0); const int tk_ = TOKOF[sl_]; const float rs_ = RSDS[sl_]; tkr = ok ? tk_ : 0; rsr = ok ? rs_ : 0.f;
        bir = bup[(size_t)m_.e * 2048 + (t8 < 128 ? m_.nt * 128 + t8 : 1024 + m_.nt * 128 + t8 - 128)]; };
    auto side_store = [&](int slot3) { tokb[slot3 * 256 + t8] = tkr; rsdb[slot3 * 256 + t8] = rsr; biab[slot3 * 256 + t8] = bir; };
    auto boffu = [](int k, int nc) { const int sc = ((nc >> 4) ? 1024 : 0) + (nc & 15) * 8; return (unsigned)(k * 4096 + sc * 2); };
    MoeMap mm{}, mn{};
    if (nmine > 0) { mm = moe_get(maps, 0); side_load(mm); side_store(0); }
    if (nmine > 1) { mn = moe_get(maps, 1); side_load(mn); side_store(1); }
    __syncthreads();
    bool pre = false;
    for (int k = 0; k < nmine; ++k) {
        const bool has_next = k + 1 < nmine, has_nn = k + 2 < nmine;
        { const MoeMap m2 = moe_get(maps, has_nn ? k + 2 : nmine - 1); side_load(m2); }
        const int s0 = k % 3, s1 = (k + 1) % 3, s2 = (k + 2) % 3;
        const int* tok = tokb + s0 * 256; const int* tokn = tokb + s1 * 256; const float* rsd = rsdb + s0 * 256; const float* bia = biab + s0 * 256;
        const bf16_t* We = W + (size_t)mm.e * 1024 * 2048; const bf16_t* Wn = W + (size_t)mn.e * 1024 * 2048;
        f32x4 acc[8][4];
        gemm256<true>(smem, 16, XN, 128u, [&](int r, int kc) { return (unsigned)(tok[r] * 2048 + kc * 16); }, We + mm.nt * 128, 64u * 4096u, boffu, acc, pre,
                      next_tile(has_next, smem, XN, [&](int r, int kc) { return (unsigned)(tokn[r] * 2048 + kc * 16); }, Wn + mn.nt * 128, boffu));
        if (k == 2) { if (tid == 0) { __builtin_amdgcn_fence(__ATOMIC_RELEASE, "agent"); asm volatile("s_waitcnt vmcnt(0)" ::: "memory"); __hip_atomic_fetch_add(upr2, 1u, __ATOMIC_RELAXED, __HIP_MEMORY_SCOPE_AGENT); } published = true; }
        side_store(s2);
        EPI_IDS();
        float bgv[2][4], blv[2][4];
#pragma unroll
        for (int ni = 0; ni < 2; ++ni) { const int jl = wc * 32 + ni * 16 + 4 * (lane >> 4); const float4 bg = *(const float4*)(bia + jl), bl_ = *(const float4*)(bia + 128 + jl);
            bgv[ni][0] = bg.x; bgv[ni][1] = bg.y; bgv[ni][2] = bg.z; bgv[ni][3] = bg.w; blv[ni][0] = bl_.x; blv[ni][1] = bl_.y; blv[ni][2] = bl_.z; blv[ni][3] = bl_.w; }
#pragma unroll
        for (int mi = 0; mi < 8; ++mi) { const int rl_ = G_ROW(mi); const size_t row = (size_t)mm.off + mm.mt * 256 + rl_; const float rs_ = rsd[rl_];
            uint2 o2[2];
#pragma unroll
            for (int ni = 0; ni < 2; ++ni) {
                const f32x4 gv = acc[mi][ni], lv = acc[mi][ni + 2]; float r4[4];
#pragma unroll
                for (int r = 0; r < 4; ++r) { const float gg = fminf(gv[r] * rs_ + bgv[ni][r], 7.0f); const float ll = fminf(fmaxf(lv[r] * rs_ + blv[ni][r], -7.0f), 7.0f); r4[r] = gg * sigmoidf_(1.702f * gg) * (ll + 1.0f); }
                o2[ni].x = cvtpk(r4[0], r4[1]); o2[ni].y = cvtpk(r4[2], r4[3]); }
            { const int c0 = wc * 32 + 4 * (lane >> 4); *(uint4*)(ACT + row * 1024 + mm.nt * 128 + PAIR16_COL(c0, c0 + 16)) = pair16(o2[0], o2[1]); } }
        lds_barrier();
        mm = mn; if (has_nn) mn = moe_get(maps, k + 2); pre = has_next;
    }
    if (!published) signal_done(upr2);
    {
        const int grid = (int)gridDim.x; const int nearly = __builtin_amdgcn_readfirstlane(moe_early_down(sm, grid)); const int idx = VBID() - (nitems % grid);
        if (idx >= 0 && idx < nearly) { wait_flag(upr2, (unsigned)grid); const MoeMap md = moe_map(a, sm, idx, 4); down_item_single(a, smem, md, (float*)(maps + 512)); }
    }
}
DEV void phase_down(const Args& a, unsigned char* smem) {
    int* sm = (int*)(smem + MISC_OFF); int* maps = (int*)(smem + MISC_OFF + 8192); float* rwb = (float*)(maps + 512); float* biab = rwb + 768;
    const bf16_t* ACT = (const bf16_t*)(a.ws + WS_ACT); const bf16_t* W = (const bf16_t*)(a.ws + WS_WDN); bf16_t* Y = (bf16_t*)(a.ws + WS_Y);
    const float* ROWW = (const float*)(a.ws + WS_ROWW); const float* bdn = a.in[I_BDN];
    const int tid = TID(); int lane = tid & 63, wid = tid >> 6, wr = wid >> 2, wc = wid & 3; (void)wr; (void)wc; (void)lane;
    moe_setup(a, sm);
    const int nitems = __builtin_amdgcn_readfirstlane(sm[64]) * 4;
    const int nearly = __builtin_amdgcn_readfirstlane(moe_early_down(sm, (int)gridDim.x));
    const int nmine = __builtin_amdgcn_readfirstlane(moe_maps_build(a, sm, maps, nitems, 4, VBID() + nearly));
    float rwr = 0.f, bir = 0.f;
    const int t8 = tid & 255;
    auto side_load = [&](const MoeMap& m_) { const int slot = m_.mt * 256 + t8; const bool ok = slot < m_.cnt; const float rw_ = ROWW[(size_t)m_.e * 16384 + (ok ? slot : 0)]; rwr = ok ? rw_ : 0.f; bir = bdn[(size_t)m_.e * 1024 + m_.nt * 256 + t8]; };
    auto side_store = [&](int slot3) { rwb[slot3 * 256 + t8] = rwr; biab[slot3 * 256 + t8] = bir; };
    auto aoffd = [](int r, int kc) { return (unsigned)(r * 2048 + kc * 16); }; auto boffd = [](int k, int nc) { return (unsigned)(k * 2048 + nc * 16); };
    MoeMap mm{}, mn{};
    if (nmine > 0) { mm = moe_get(maps, 0); side_load(mm); side_store(0); }
    if (nmine > 1) { mn = moe_get(maps, 1); side_load(mn); side_store(1); }
    __syncthreads();
    bool pre = false;
    for (int k = 0; k < nmine; ++k) {
        const bool has_next = k + 1 < nmine, has_nn = k + 2 < nmine;
        { const MoeMap m2 = moe_get(maps, has_nn ? k + 2 : nmine - 1); side_load(m2); }
        const int s0 = k % 3, s2 = (k + 2) % 3;
        const float* rw = rwb + s0 * 256; const float* bia = biab + s0 * 256;
        const bf16_t* We = W + (size_t)mm.e * 1024 * 1024; const bf16_t* Ab = ACT + ((size_t)mm.off + mm.mt * 256) * 1024;
        const bf16_t* Wn = W + (size_t)mn.e * 1024 * 1024; const bf16_t* An = ACT + ((size_t)mn.off + mn.mt * 256) * 1024;
        f32x4 acc[8][4];
        gemm256<true>(smem, 16, Ab, 128u, aoffd, We + mm.nt * 256, 64u * 2048u, boffd, acc, pre,
                      next_tile(has_next, smem, An, aoffd, Wn + mn.nt * 256, boffd));
        side_store(s2);
        EPI_IDS();
        float4 bb[4];
#pragma unroll
        for (int ni = 0; ni < 4; ++ni) bb[ni] = *(const float4*)(bia + G_COL(ni));
#pragma unroll
        for (int mi = 0; mi < 8; ++mi) { const int rl = G_ROW(mi); const size_t row = (size_t)mm.off + mm.mt * 256 + rl; const float w = rw[rl];
#pragma unroll
            for (int np = 0; np < 2; ++np) { uint2 o2[2];
#pragma unroll
                for (int h = 0; h < 2; ++h) { const int ni = 2 * np + h; const f32x4 v = acc[mi][ni]; o2[h].x = cvtpk((v[0] + bb[ni].x) * w, (v[1] + bb[ni].y) * w); o2[h].y = cvtpk((v[2] + bb[ni].z) * w, (v[3] + bb[ni].w) * w); }
                *(uint4*)(Y + row * 1024 + mm.nt * 256 + PAIR16_COL(G_COL(2 * np), G_COL(2 * np + 1))) = pair16(o2[0], o2[1]); } }
        lds_barrier();
        mm = mn; if (has_nn) mn = moe_get(maps, k + 2); pre = has_next;
    }
}

DEV void phase_comb(const Args& a, unsigned char* smem) {
    int* sm = (int*)(smem + MISC_OFF);
    moe_setup(a, sm);
    bf16_t* H1 = (bf16_t*)(a.ws + WS_H1); const bf16_t* Y = (const bf16_t*)(a.ws + WS_Y);
    const int* TOPI = (const int*)(a.ws + WS_TOPI); const int* TOPS = (const int*)(a.ws + WS_TOPS);
    const int lane = TID() & 63; const int gw = BID() * NWAVE + (TID() >> 6), ngw = gridDim.x * NWAVE;
    for (int tok = gw; tok < NTOK; tok += ngw) {
        float4 v[4];
#pragma unroll
        for (int j = 0; j < 4; ++j) { const uint2 hq = *(const uint2*)(H1 + (size_t)tok * 1024 + j * 256 + lane * 4); v[j] = (float4){bflo(hq.x), bfhi(hq.x), bflo(hq.y), bfhi(hq.y)}; }
#pragma unroll
        for (int k = 0; k < 4; ++k) { const int e = TOPI[(size_t)tok * 4 + k]; const size_t row = (size_t)sm[32 + e] * 256 + TOPS[(size_t)tok * 4 + k];
#pragma unroll
            for (int j = 0; j < 4; ++j) { const uint2 u = *(const uint2*)(Y + row * 1024 + j * 256 + lane * 4); v[j].x += bflo(u.x); v[j].y += bfhi(u.x); v[j].z += bflo(u.y); v[j].w += bfhi(u.y); } }
        float s = 0.f;
#pragma unroll
        for (int j = 0; j < 4; ++j) { { uint2 hq; hq.x = cvtpk(v[j].x, v[j].y); hq.y = cvtpk(v[j].z, v[j].w); *(uint2*)(H1 + (size_t)tok * 1024 + j * 256 + lane * 4) = hq; } s += v[j].x * v[j].x + v[j].y * v[j].y + v[j].z * v[j].z + v[j].w * v[j].w; }
        const float rstd = rsqrtf(wave_sum(s) * (1.f / 1024.f) + EPS);
        if (lane == 0) ((float*)(a.ws + WS_RSTD3))[tok] = rstd;
    }
}

DEV void phase_gate(const Args& a, unsigned char* smem) {
    const bf16_t* XN = (const bf16_t*)(a.ws + WS_H1); const float* RSTD3 = (const float*)(a.ws + WS_RSTD3); const bf16_t* WG = (const bf16_t*)(a.ws + WS_WGATE); const bf16_t* PB = (const bf16_t*)(a.ws + WS_PB); const bf16_t* WP = (const bf16_t*)(a.ws + WS_WPLE);
    const bf16_t* H2 = (const bf16_t*)(a.ws + WS_H1); float* OUT = a.out; float* SSQ3 = (float*)(a.ws + WS_SSQ3);
    const int tid = TID(); int lane = tid & 63, wid = tid >> 6, wr = wid >> 2, wc = wid & 3; (void)wr; (void)wc; (void)lane;
    bf16_t* GT = (bf16_t*)(a.ws + WS_ACT);
    auto aoffg = [](int r, int kc) { return (unsigned)(r * 2048 + kc * 16); }; auto aoffp = [](int r, int kc) { return (unsigned)(r * 512 + kc * 16); }; auto boffg = [](int k, int nc) { return (unsigned)(k * 2048 + nc * 16); };
    for (int item = VBID(); item < 64 * 4; item += gridDim.x) {
        int mt, nt; patch_decode(item, 64, 4, mt, nt);
        f32x4 acc[8][4];
        gemm256<true>(smem, 16, XN + (size_t)mt * 256 * 1024, 128u, aoffg, WG + nt * 256, 64u * 2048u, boffg, acc, false,
                      next_tile(true, smem, PB + (size_t)mt * 256 * 256, aoffp, WP + nt * 256, boffg));
        EPI_IDS();
#pragma unroll
        for (int hb = 0; hb < 2; ++hb) {
            uint2 wq[4][4]; uint4 hq[4][2];
#pragma unroll
            for (int m4 = 0; m4 < 4; ++m4) { const int mi = hb * 4 + m4; const size_t gm = (size_t)mt * 256 + G_ROW(mi);
#pragma unroll
                for (int np = 0; np < 2; ++np) hq[m4][np] = *(const uint4*)(H2 + gm * 1024 + nt * 256 + PAIR16_COL(G_COL(2 * np), G_COL(2 * np + 1)));
                const float r3 = RSTD3[gm];
#pragma unroll
                for (int ni = 0; ni < 4; ++ni) { const f32x4 v = acc[mi][ni] * r3;
                    uint2 w; w.x = cvtpk(sigmoidf_(v[0]), sigmoidf_(v[1])); w.y = cvtpk(sigmoidf_(v[2]), sigmoidf_(v[3])); wq[m4][ni] = w; } }
#pragma unroll
            for (int m4 = 0; m4 < 4; ++m4) { const int mi = hb * 4 + m4; const size_t gm = (size_t)mt * 256 + G_ROW(mi);
#pragma unroll
                for (int np = 0; np < 2; ++np) { uint2 h2[2]; unpair16(hq[m4][np], h2[0], h2[1]);
                    *(uint4*)(GT + gm * 1024 + nt * 256 + PAIR16_COL(G_COL(2 * np), G_COL(2 * np + 1))) = pair16(wq[m4][2 * np], wq[m4][2 * np + 1]);
#pragma unroll
                    for (int h = 0; h < 2; ++h) { const int ni = 2 * np + h; const uint2 w = wq[m4][ni]; const uint2 hh = h2[h];
                        acc[mi][ni] = (f32x4){bflo(hh.x) * __builtin_amdgcn_rcpf(bflo(w.x)), bfhi(hh.x) * __builtin_amdgcn_rcpf(bfhi(w.x)), bflo(hh.y) * __builtin_amdgcn_rcpf(bflo(w.y)), bfhi(hh.y) * __builtin_amdgcn_rcpf(bfhi(w.y))}; } } }
            asm volatile("" ::: "memory");
        }
        gemm256<false>(smem, 4, PB + (size_t)mt * 256 * 256, 128u, aoffp, WP + nt * 256, 64u * 2048u, boffg, acc, true);
        EPI_IDS();
        const bool fused = gridDim.x >= 256;
#pragma unroll
        for (int hb = 0; hb < 2; ++hb) {
            uint4 gq4[4][2];
#pragma unroll
            for (int m4 = 0; m4 < 4; ++m4) { const size_t gm = (size_t)mt * 256 + G_ROW(hb * 4 + m4);
#pragma unroll
                for (int np = 0; np < 2; ++np) gq4[m4][np] = *(const uint4*)(GT + gm * 1024 + nt * 256 + PAIR16_COL(G_COL(2 * np), G_COL(2 * np + 1))); }
#pragma unroll
            for (int m4 = 0; m4 < 4; ++m4) { const int mi = hb * 4 + m4; const size_t gm = (size_t)mt * 256 + G_ROW(mi); float ss = 0.f;
#pragma unroll
                for (int np = 0; np < 2; ++np) { uint2 g2[2]; unpair16(gq4[m4][np], g2[0], g2[1]);
#pragma unroll
                    for (int h = 0; h < 2; ++h) { const int ni = 2 * np + h; const int n = nt * 256 + G_COL(ni); const f32x4 v = acc[mi][ni]; const uint2 gw = g2[h];
                        float4 o = {v[0] * bflo(gw.x), v[1] * bfhi(gw.x), v[2] * bflo(gw.y), v[3] * bfhi(gw.y)};
                        if (!fused) *(float4*)(OUT + gm * 1024 + n) = o;
                        acc[mi][ni] = (f32x4){o.x, o.y, o.z, o.w};
                        ss += o.x * o.x + o.y * o.y + o.z * o.z + o.w * o.w; } }
                ss += __shfl_xor(ss, 16); ss += __shfl_xor(ss, 32);
                if (lane < 16) SSQ3[gm * 16 + nt * 4 + wc] = ss; }
            asm volatile("" ::: "memory");
        }
        if (fused) {
            unsigned* flag = (unsigned*)(a.ws + WS_CTL) + CW_GATEFLAG + mt;
            const float* lnf = a.in[I_LNF]; float4 gg[4];
#pragma unroll
            for (int ni = 0; ni < 4; ++ni) gg[ni] = *(const float4*)(lnf + nt * 256 + G_COL(ni));
            signal_done(flag); wait_flag(flag, 4u);
            float rstd[8];
#pragma unroll
            for (int mi = 0; mi < 8; ++mi) { const size_t gm = (size_t)mt * 256 + G_ROW(mi); const float4 s0 = *(const float4*)(SSQ3 + gm * 16 + 4 * (lane >> 4)); rstd[mi] = (s0.x + s0.y) + (s0.z + s0.w); }
#pragma unroll
            for (int mi = 0; mi < 8; ++mi) { float t_ = rstd[mi]; t_ += __shfl_xor(t_, 16); t_ += __shfl_xor(t_, 32); rstd[mi] = rsqrtf(t_ * (1.f / 1024.f) + EPS); }
#pragma unroll
            for (int mi = 0; mi < 8; ++mi) { const size_t gm = (size_t)mt * 256 + G_ROW(mi);
#pragma unroll
                for (int ni = 0; ni < 4; ++ni) { const int n = nt * 256 + G_COL(ni); const f32x4 v = acc[mi][ni]; const float r_ = rstd[mi];
                    float4 o = {v[0] * r_ * gg[ni].x, v[1] * r_ * gg[ni].y, v[2] * r_ * gg[ni].z, v[3] * r_ * gg[ni].w}; *(float4*)(OUT + gm * 1024 + n) = o; } }
        }
        __syncthreads();
    }
}

DEV void phase_final(const Args& a) {
    if (gridDim.x >= 256) return;
    float* OUT = a.out; const float* SSQ3 = (const float*)(a.ws + WS_SSQ3); const float* g = a.in[I_LNF];
    const int lane = TID() & 63; const int gw = BID() * NWAVE + (TID() >> 6), ngw = gridDim.x * NWAVE;
    for (int m = gw; m < NTOK; m += ngw) {
        float s = 0.f;
#pragma unroll
        for (int j = 0; j < 16; ++j) s += SSQ3[(size_t)m * 16 + j];
        const float rstd = rsqrtf(s * (1.f / 1024.f) + EPS);
#pragma unroll
        for (int j = 0; j < 4; ++j) { float4 v = *(const float4*)(OUT + (size_t)m * 1024 + j * 256 + lane * 4); const float4 gg = *(const float4*)(g + j * 256 + lane * 4);
            v.x *= rstd * gg.x; v.y *= rstd * gg.y; v.z *= rstd * gg.z; v.w *= rstd * gg.w; *(float4*)(OUT + (size_t)m * 1024 + j * 256 + lane * 4) = v; }
    }
}

template <int PH> DEV void run_phase(const Args& a, unsigned char* smem) {
    if constexpr (PH == PH_PRO) phase_prologue(a, smem);
    else if constexpr (PH == PH_INPROJ) phase_inproj(a, smem);
    else if constexpr (PH == PH_ATT) phase_att(a, smem);
    else if constexpr (PH == PH_OUTPROJ) phase_outproj(a, smem);
    else if constexpr (PH == PH_ROUTE) phase_route(a, smem);
    else if constexpr (PH == PH_UP) phase_up(a, smem);
    else if constexpr (PH == PH_DOWN) phase_down(a, smem);
    else if constexpr (PH == PH_COMB) phase_comb(a, smem);
    else if constexpr (PH == PH_GATE) phase_gate(a, smem);
    else if constexpr (PH == PH_FINAL) phase_final(a);
}
#define XB_TMO      128
#define XB_XCNT(j)  (256  + 64 * (j))
#define XB_XSUB(j)  (1280 + 64 * (j))
#define XB_XGEN(j)  (2304 + 64 * (j))
#define XB_TOP      3328
#define XB_TOPGEN   3392
#define XCD_BAR_WORDS 3456
#define XB_SPIN_CAP (1u << 22)
DEV unsigned xb_ld(unsigned* p)              { return __hip_atomic_load(p, __ATOMIC_RELAXED, __HIP_MEMORY_SCOPE_AGENT); }
DEV unsigned xb_add(unsigned* p, unsigned v) { return __hip_atomic_fetch_add(p, v, __ATOMIC_RELAXED, __HIP_MEMORY_SCOPE_AGENT); }
DEV unsigned xb_xcc_id() { return (unsigned)__builtin_amdgcn_s_getreg((3 << 11) | 20) & 0xFu; }
#define XB_SPIN(cond, bar) do { unsigned _sp = 0; while (cond) { __builtin_amdgcn_s_sleep(1); \
    if ((++_sp & 255u) == 0u) { if (xb_ld(&(bar)[XB_TMO])) break; if (_sp > XB_SPIN_CAP) { atomicAdd(&(bar)[XB_TMO], 1u); break; } } } } while (0)
struct XcdBarrier { unsigned* bar; unsigned x; volatile LAS unsigned* st; };
DEV XcdBarrier xcd_barrier_post(unsigned* bar, volatile LAS unsigned* st) {
    XcdBarrier b; b.bar = bar; b.x = xb_xcc_id(); b.st = st;
    if (TID() == 0) (void)xb_add(&bar[XB_XCNT(b.x)], 1u);
    return b;
}
DEV void xcd_barrier_complete(unsigned* bar, unsigned x, unsigned& nloc, unsigned& nx) {
    const unsigned G = gridDim.x * gridDim.y * gridDim.z;
    unsigned sum, cnt, mine, sp = 0u;
    for (;;) {
        sum = 0u; cnt = 0u; mine = 0u;
#pragma unroll
        for (unsigned j = 0; j < 16; ++j) { const unsigned c = xb_ld(&bar[XB_XCNT(j)]); sum += c; cnt += (c > 0u) ? 1u : 0u; mine = (j == x) ? c : mine; }
        if (sum == G) break;
        __builtin_amdgcn_s_sleep(1);
        if ((++sp & 255u) == 0u) { if (xb_ld(&bar[XB_TMO])) break; if (sp > XB_SPIN_CAP) { atomicAdd(&bar[XB_TMO], 1u); break; } }
    }
    nloc = mine > 0u ? mine : 1u; nx = cnt > 0u ? cnt : 1u;
}
DEV void xcd_barrier(const XcdBarrier& b) {
    asm volatile("s_waitcnt vmcnt(0)" ::: "memory");
    __syncthreads();
    if (TID() == 0) {
        unsigned* bar = b.bar;
        __builtin_amdgcn_s_waitcnt(0);
        unsigned nloc = b.st[0], nx = b.st[1];
        if (nloc == 0u) { xcd_barrier_complete(bar, b.x, nloc, nx); b.st[0] = nloc; b.st[1] = nx; }
        const unsigned old = xb_add(&bar[XB_XSUB(b.x)], 1u);
        const unsigned gen = old / nloc;
        if (old + 1u == (gen + 1u) * nloc) {
            __builtin_amdgcn_fence(__ATOMIC_RELEASE, "agent");
            asm volatile("s_waitcnt vmcnt(0)" ::: "memory");
            const unsigned og = xb_add(&bar[XB_TOP], 1u);
            const unsigned tg = og / nx;
            if (og + 1u == (tg + 1u) * nx) xb_add(&bar[XB_TOPGEN], 1u);
            else XB_SPIN(xb_ld(&bar[XB_TOPGEN]) == tg, bar);
            __builtin_amdgcn_fence(__ATOMIC_ACQUIRE, "agent");
            xb_add(&bar[XB_XGEN(b.x)], 1u);
            asm volatile("s_waitcnt vmcnt(0)" ::: "memory");
        } else {
            XB_SPIN(xb_ld(&bar[XB_XGEN(b.x)]) == gen, bar);
            __builtin_amdgcn_fence(__ATOMIC_ACQUIRE, "agent");
            asm volatile("s_waitcnt vmcnt(0)" ::: "memory");
        }
    }
    __syncthreads();
}

__global__ void __launch_bounds__(NTHR, 2) mega(Args a) {
    extern __shared__ __attribute__((aligned(16))) unsigned char smem[];
    volatile LAS unsigned* bst = (volatile LAS unsigned*)(LAS unsigned char*)(smem + MISC_OFF + 8000);
    if (TID() == 0) { bst[0] = 0u; bst[1] = 0u; }
    __syncthreads();
    const XcdBarrier bar = xcd_barrier_post((unsigned*)(a.ws + WS_CTL) + 4096, bst);
#define GSYNC() xcd_barrier(bar)
#define RUN(ph) do { run_phase<ph>(a, smem); if ((PROBE_DUP >> ph) & 1) { GSYNC(); run_phase<ph>(a, smem); } } while (0)
    RUN(PH_PRO); GSYNC();
    RUN(PH_INPROJ); GSYNC();
    RUN(PH_ATT); GSYNC();
    RUN(PH_OUTPROJ); GSYNC();
    RUN(PH_ROUTE); GSYNC();
    RUN(PH_UP); GSYNC();
    RUN(PH_DOWN); GSYNC();
    RUN(PH_COMB); GSYNC();
    RUN(PH_GATE);
    if (gridDim.x < 256) { GSYNC(); RUN(PH_FINAL); }
#undef RUN
#undef GSYNC
}

extern "C" void kernel_launch(void* const* d_in, const int* in_sizes, int n_in, void* d_out, int out_size, void* d_ws, size_t ws_size, hipStream_t stream) {
    static int grid = 0;
    if (grid == 0) {
        if (n_in != 25 || ws_size < WS_END) { fprintf(stderr, "kernel_launch: unexpected n_in %d / ws %zu\n", n_in, ws_size); grid = -1; return; }
        int dev = 0, cus = 0, per_cu = 0;
        (void)hipGetDevice(&dev); (void)hipDeviceGetAttribute(&cus, hipDeviceAttributeMultiprocessorCount, dev);
        (void)hipFuncSetAttribute((const void*)mega, hipFuncAttributeMaxDynamicSharedMemorySize, LDS_BYTES);
        (void)hipOccupancyMaxActiveBlocksPerMultiprocessor(&per_cu, (const void*)mega, NTHR, LDS_BYTES);
        if (per_cu < 1) { fprintf(stderr, "kernel_launch: occupancy query says %d blocks per CU\n", per_cu); grid = -1; return; }
        grid = cus;
    }
    if (grid < 0) return;
    (void)hipMemsetAsync((char*)d_ws + WS_CTL, 0, 65536, stream);
    Args a{};
    for (int i = 0; i < 25; ++i) a.in[i] = (const float*)d_in[i];
    a.out = (float*)d_out; a.ws = (unsigned char*)d_ws; a.ph_lo = 0; a.ph_hi = PH_N;
    void* args[] = {&a};
    hipError_t e = hipLaunchCooperativeKernel((const void*)mega, dim3(grid), dim3(NTHR), args, LDS_BYTES, stream);
    if (e != hipSuccess) fprintf(stderr, "cooperative launch failed: %s (grid %d)\n", hipGetErrorString(e), grid);
}
```
